# Optimizing an MI355X kernel written in HIP

```python
import math
import jax, jax.numpy as jnp
from jax import lax
import numpy as np

D_MODEL = 1024
BATCH = 4
SEQ = 8192
DEPTH = 2

N_BRANCH = 4
BRANCH_W = D_MODEL // 4
GM_CHUNK = 128
GM_GROUPS = 4
ATT_HEAD_DIM = 64
ATT_HEADS = BRANCH_W // ATT_HEAD_DIM
IDX_HEADS = 4
IDX_DIM = 64
TOPK_MAX = 256
Q_BLOCK = 128
ROPE_THETA = 500000.0
ROPE_FRAC = 4
S5_GROUP = 16
S5_GROUPS = BRANCH_W // S5_GROUP
S5_STATE = 64
SSD_HEAD_DIM = 64
SSD_HEADS = BRANCH_W // SSD_HEAD_DIM
SSD_GROUPS = 2
SSD_STATE = 64
SSD_CONV = 4
SSD_CHUNK = 128
SSD_XBC = BRANCH_W + 2 * SSD_GROUPS * SSD_STATE
N_EXPERTS = 32
TOP_K = 8
N_EXPERT_GROUPS = 8
TOPK_GROUPS = 4
EXPERT_FF = D_MODEL // 4
SHARED_FF = EXPERT_FF
ROUTED_SCALE = 2.5
DN_ALPHA = (2 * DEPTH) ** 0.25
DN_BETA = (8 * DEPTH) ** -0.25
LN_EPS = 1e-5
RMS_EPS = 1e-6

IN_SPLITS = (BRANCH_W, BRANCH_W,
             ATT_HEADS * ATT_HEAD_DIM, ATT_HEAD_DIM, ATT_HEAD_DIM,
             IDX_HEADS * IDX_DIM, IDX_DIM, IDX_HEADS,
             BRANCH_W,
             BRANCH_W, SSD_XBC, SSD_HEADS)
D_IN = sum(IN_SPLITS)

kernel_name = "hybrid_gated_gmlp_dsa_s5_ssd_moe"


def layer_norm(x, g, b):
    xf = x.astype(jnp.float32)
    mu = jnp.mean(xf, -1, keepdims=True)
    var = jnp.mean(jnp.square(xf - mu), -1, keepdims=True)
    return ((xf - mu) * lax.rsqrt(var + LN_EPS) * g.astype(jnp.float32) + b.astype(jnp.float32)).astype(x.dtype)


def rope_tables(positions):
    rot = ATT_HEAD_DIM // ROPE_FRAC
    inv = ROPE_THETA ** (-jnp.arange(0, rot, 2, dtype=jnp.float32) / rot)
    ang = positions.astype(jnp.float32)[..., None] * inv
    return jnp.cos(ang), jnp.sin(ang)


def apply_partial_rope(t, cos, sin):
    half = cos.shape[-1]
    shp = cos.shape[:2] + (1,) * (t.ndim - 3) + (half,)
    cs, sn = cos.reshape(shp), sin.reshape(shp)
    tf = t.astype(jnp.float32)
    t1, t2 = tf[..., :half], tf[..., half:2 * half]
    return jnp.concatenate([t1 * cs - t2 * sn, t2 * cs + t1 * sn, tf[..., 2 * half:]], -1).astype(t.dtype)


def gmlp_mixer(u, v, ln_g, ln_b, sg_w, sg_b):
    B_, S_, W = u.shape
    u = jax.nn.gelu(u)
    v = layer_norm(jax.nn.gelu(v), ln_g, ln_b)
    v = v.reshape(B_, S_ // GM_CHUNK, GM_CHUNK, GM_GROUPS, W // GM_GROUPS)
    w = sg_w * jnp.tril(jnp.ones((GM_CHUNK, GM_CHUNK), sg_w.dtype))
    sv = jnp.einsum('gts,bnsgc->bntgc', w, v) + sg_b.T[:, :, None]
    return u * sv.reshape(B_, S_, W)


def dsa_attention(q, k, v, qi, ki, wi):
    B_, S_ = q.shape[:2]
    n_sel = min(TOPK_MAX, S_ // 4)
    nb = S_ // Q_BLOCK
    wi = wi.astype(jnp.float32) * (IDX_HEADS ** -0.5 * IDX_DIM ** -0.5)
    key_pos = jnp.arange(S_)

    def blocks(t):
        return jnp.moveaxis(t.reshape((B_, nb, Q_BLOCK) + t.shape[2:]), 1, 0)

    def one_block(args):
        qb, qib, wib, start = args
        qpos = start + jnp.arange(Q_BLOCK)
        idx_logits = jnp.einsum('bqhd,bsd->bqhs', qib, ki).astype(jnp.float32)
        score = jnp.einsum('bqhs,bqh->bqs', jax.nn.relu(idx_logits), wib)
        causal = key_pos[None, :] <= qpos[:, None]
        score = jnp.where(causal[None], score, -jnp.inf)
        _, sel = lax.top_k(score, n_sel)
        k_sel = jax.vmap(lambda kb, ib: kb[ib])(k, sel)
        v_sel = jax.vmap(lambda vb, ib: vb[ib])(v, sel)
        valid = sel <= qpos[None, :, None]
        logits = jnp.einsum('bqhd,bqnd->bhqn', qb, k_sel).astype(jnp.float32) * ATT_HEAD_DIM ** -0.5
        logits = jnp.where(valid[:, None], logits, -jnp.inf)
        p = jax.nn.softmax(logits, axis=-1).astype(v.dtype)
        return jnp.einsum('bhqn,bqnd->bqhd', p, v_sel)

    starts = jnp.arange(nb) * Q_BLOCK
    out = lax.map(one_block, (blocks(q), blocks(qi), blocks(wi), starts))
    return jnp.moveaxis(out, 0, 1).reshape(B_, S_, ATT_HEADS * ATT_HEAD_DIM)


def s5_mixer(u, lam_re, lam_im, log_step, b_re, b_im, c_re, c_im, d_skip, glu_w, glu_b):
    B_, S_, W = u.shape
    f32 = jnp.float32
    uf = u.astype(f32)
    ug = uf.reshape(B_, S_, S5_GROUPS, S5_GROUP)
    lr, li = lam_re.astype(f32), lam_im.astype(f32)
    step = jnp.exp(log_step.astype(f32))[:, None]
    mag = jnp.exp(lr * step)
    ab_re, ab_im = mag * jnp.cos(li * step), mag * jnp.sin(li * step)
    den = lr * lr + li * li
    nr = ab_re - 1.0
    cr = (nr * lr + ab_im * li) / den
    ci = (ab_im * lr - nr * li) / den
    br, bi = b_re.astype(f32), b_im.astype(f32)
    bb_re = cr[..., None] * br - ci[..., None] * bi
    bb_im = cr[..., None] * bi + ci[..., None] * br
    x_re = jnp.einsum('bsgc,gpc->bsgp', ug, bb_re)
    x_im = jnp.einsum('bsgc,gpc->bsgp', ug, bb_im)
    a_re = jnp.broadcast_to(ab_re, x_re.shape)
    a_im = jnp.broadcast_to(ab_im, x_im.shape)

    def combine(e1, e2):
        a1r, a1i, b1r, b1i = e1
        a2r, a2i, b2r, b2i = e2
        return (a2r * a1r - a2i * a1i, a2r * a1i + a2i * a1r,
                a2r * b1r - a2i * b1i + b2r, a2r * b1i + a2i * b1r + b2i)

    _, _, h_re, h_im = lax.associative_scan(combine, (a_re, a_im, x_re, x_im), axis=1)
    y = (jnp.einsum('bsgp,gcp->bsgc', h_re, c_re.astype(f32))
         - jnp.einsum('bsgp,gcp->bsgc', h_im, c_im.astype(f32)))
    y = y.reshape(B_, S_, W) + d_skip.astype(f32) * uf
    y = jax.nn.gelu(y).astype(u.dtype)
    return y * jax.nn.sigmoid(y @ glu_w + glu_b)


def segsum(a):
    T = a.shape[-1]
    ar = jnp.broadcast_to(a[..., None], a.shape + (T,))
    strict = jnp.tril(jnp.ones((T, T), bool), -1)
    cs = jnp.cumsum(jnp.where(strict, ar, 0.0), axis=-2)
    return jnp.where(jnp.tril(jnp.ones((T, T), bool)), cs, -jnp.inf)


def ssd_mixer(z, xbc, dt, conv_w, conv_b, dt_bias, a_log, d_skip, norm_g):
    B_, S_, _ = xbc.shape
    f32 = jnp.float32
    conv = lax.conv_general_dilated(xbc, conv_w[:, None, :], window_strides=(1,),
                                    padding=[(SSD_CONV - 1, 0)],
                                    dimension_numbers=('NWC', 'WIO', 'NWC'),
                                    feature_group_count=xbc.shape[-1])
    xbc = jax.nn.silu(conv + conv_b)
    x, bm, cm = jnp.split(xbc, [BRANCH_W, BRANCH_W + SSD_GROUPS * SSD_STATE], axis=-1)
    hpg = SSD_HEADS // SSD_GROUPS
    nc = S_ // SSD_CHUNK
    dt = jax.nn.softplus(dt.astype(f32) + dt_bias.astype(f32))
    a = -jnp.exp(a_log.astype(f32))
    xf = x.astype(f32)
    X = xf.reshape(B_, nc, SSD_CHUNK, SSD_GROUPS, hpg, SSD_HEAD_DIM)
    Xdt = X * dt.reshape(B_, nc, SSD_CHUNK, SSD_GROUPS, hpg)[..., None]
    Adt = (dt * a).reshape(B_, nc, SSD_CHUNK, SSD_GROUPS, hpg).transpose(0, 3, 4, 1, 2)
    Bm = bm.astype(f32).reshape(B_, nc, SSD_CHUNK, SSD_GROUPS, SSD_STATE)
    Cm = cm.astype(f32).reshape(B_, nc, SSD_CHUNK, SSD_GROUPS, SSD_STATE)
    a_cum = jnp.cumsum(Adt, axis=-1)
    Lmat = jnp.exp(segsum(Adt))
    y_diag = jnp.einsum('bclgn,bcsgn,bgjcls,bcsgjp->bclgjp', Cm, Bm, Lmat, Xdt)
    decay_states = jnp.exp(a_cum[..., -1:] - a_cum)
    states = jnp.einsum('bclgn,bgjcl,bclgjp->bcgjpn', Bm, decay_states, Xdt)
    states = jnp.concatenate([jnp.zeros_like(states[:, :1]), states], axis=1)
    chunk_a = jnp.pad(a_cum[..., -1], ((0, 0), (0, 0), (0, 0), (1, 0)))
    decay_chunk = jnp.exp(segsum(chunk_a))
    states = jnp.einsum('bgjzc,bcgjpn->bzgjpn', decay_chunk, states)[:, :-1]
    y_off = jnp.einsum('bclgn,bcgjpn,bgjcl->bclgjp', Cm, states, jnp.exp(a_cum))
    y = (y_diag + y_off).reshape(B_, S_, SSD_HEADS, SSD_HEAD_DIM)
    y = y + d_skip.astype(f32)[:, None] * xf.reshape(B_, S_, SSD_HEADS, SSD_HEAD_DIM)
    y = (y.reshape(B_, S_, BRANCH_W) * jax.nn.silu(z.astype(f32))).reshape(B_, S_, SSD_GROUPS, -1)
    y = y * lax.rsqrt(jnp.mean(jnp.square(y), -1, keepdims=True) + RMS_EPS)
    return (y.reshape(B_, S_, BRANCH_W) * norm_g.astype(f32)).astype(z.dtype)


def hybrid_mixer(h, cos, sin, w_in, gm_ln_g, gm_ln_b, gm_w, gm_b,
                 s5_lam_re, s5_lam_im, s5_log_step, s5_b_re, s5_b_im, s5_c_re, s5_c_im, s5_d,
                 s5_glu_w, s5_glu_b, ssd_conv_w, ssd_conv_b, ssd_dt_bias, ssd_a_log, ssd_d, ssd_norm_g,
                 w_branch, w_gate, w_out):
    B_, S_, _ = h.shape
    proj = h @ w_in
    cuts = [int(i) for i in np.cumsum(IN_SPLITS)[:-1]]
    gm_u, gm_v, q, k, v, qi, ki, wi, s5_u, z, xbc, dt = jnp.split(proj, cuts, axis=-1)
    y_a = gmlp_mixer(gm_u, gm_v, gm_ln_g, gm_ln_b, gm_w, gm_b)
    q = apply_partial_rope(q.reshape(B_, S_, ATT_HEADS, ATT_HEAD_DIM), cos, sin)
    k = apply_partial_rope(k, cos, sin)
    qi = apply_partial_rope(qi.reshape(B_, S_, IDX_HEADS, IDX_DIM), cos, sin)
    ki = apply_partial_rope(ki, cos, sin)
    y_b = dsa_attention(q, k, v, qi, ki, wi)
    y_c = s5_mixer(s5_u, s5_lam_re, s5_lam_im, s5_log_step, s5_b_re, s5_b_im, s5_c_re, s5_c_im,
                   s5_d, s5_glu_w, s5_glu_b)
    y_d = ssd_mixer(z, xbc, dt, ssd_conv_w, ssd_conv_b, ssd_dt_bias, ssd_a_log, ssd_d, ssd_norm_g)
    branches = (y_a, y_b, y_c, y_d)
    merged = jax.nn.sigmoid(h @ w_gate[0]) * (branches[0].astype(h.dtype) @ w_branch[0])
    for i in range(1, N_BRANCH):
        merged = merged + jax.nn.sigmoid(h @ w_gate[i]) * (branches[i].astype(h.dtype) @ w_branch[i])
    return merged @ w_out


def moe_ffn(h, router_w, router_bias, w1, w3, w2, sw1, sw3, sw2):
    B_, S_, _ = h.shape
    f32 = jnp.float32
    scores = jax.nn.sigmoid((h @ router_w).astype(f32))
    biased = scores + router_bias.astype(f32)
    grp = biased.reshape(B_, S_, N_EXPERT_GROUPS, N_EXPERTS // N_EXPERT_GROUPS)
    grp_score = jnp.sum(lax.top_k(grp, 2)[0], -1)
    _, gidx = lax.top_k(grp_score, TOPK_GROUPS)
    gmask = jnp.sum(jax.nn.one_hot(gidx, N_EXPERT_GROUPS, dtype=f32), -2) > 0
    emask = jnp.repeat(gmask, N_EXPERTS // N_EXPERT_GROUPS, axis=-1)
    _, eidx = lax.top_k(jnp.where(emask, biased, -jnp.inf), TOP_K)
    w = jnp.take_along_axis(scores, eidx, axis=-1)
    w = w / jnp.sum(w, -1, keepdims=True) * ROUTED_SCALE
    gates = jnp.sum(jax.nn.one_hot(eidx, N_EXPERTS, dtype=f32) * w[..., None], -2)

    def per_seq(args):
        hs, gs = args
        a = jnp.einsum('sd,edf->sef', hs, w1)
        b = jnp.einsum('sd,edf->sef', hs, w3)
        act = jax.nn.silu(a) * b * gs[..., None].astype(hs.dtype)
        return jnp.einsum('sef,efd->sd', act, w2)

    routed = lax.map(per_seq, (h, gates))
    shared = (jax.nn.silu(h @ sw1) * (h @ sw3)) @ sw2
    return routed + shared


def adaln(c, w, b):
    m = c @ w + b
    shift, scale, gate = jnp.split(m, 3, axis=-1)
    return shift[:, None], scale[:, None], gate[:, None]


def setup_inputs(seed: int = 0) -> dict:
    key = jax.random.key(seed)
    keys = jax.random.split(key, 64)
    cnt = [0]
    f32 = jnp.float32
    L, D, W = DEPTH, D_MODEL, BRANCH_W

    def nk():
        k = keys[cnt[0]]
        cnt[0] += 1
        return k

    def nrm(shape, scale):
        return jax.random.normal(nk(), shape, f32) * scale

    def near_one(shape, s=0.02):
        return 1.0 + nrm(shape, s)

    x = nrm((BATCH, SEQ, D), 1.0)
    c = nrm((BATCH, D), 1.0)
    offset = jax.random.randint(nk(), (BATCH, 1), 0, 4096)
    positions = (offset + jnp.arange(SEQ)[None, :]).astype(jnp.int32)

    mod1_w = nrm((L, D, 3 * D), 0.2 * D ** -0.5)
    mod1_b = nrm((L, 3 * D), 0.02)
    w_in = nrm((L, D, D_IN), D ** -0.5)
    gm_ln_g = near_one((L, W))
    gm_ln_b = nrm((L, W), 0.02)
    gm_w = nrm((L, GM_GROUPS, GM_CHUNK, GM_CHUNK), GM_CHUNK ** -0.5)
    gm_b = near_one((L, GM_GROUPS, GM_CHUNK), 0.1)

    s5_lam_re = -0.5 + nrm((L, S5_GROUPS, S5_STATE), 0.01)
    s5_lam_im = math.pi * jnp.arange(S5_STATE, dtype=f32) + nrm((L, S5_GROUPS, S5_STATE), 0.01)
    s5_log_step = jax.random.uniform(nk(), (L, S5_GROUPS), f32, math.log(1e-3), math.log(1e-1))
    s5_b_re = nrm((L, S5_GROUPS, S5_STATE, S5_GROUP), (2 * S5_GROUP) ** -0.5)
    s5_b_im = nrm((L, S5_GROUPS, S5_STATE, S5_GROUP), (2 * S5_GROUP) ** -0.5)
    s5_c_re = nrm((L, S5_GROUPS, S5_GROUP, S5_STATE), S5_STATE ** -0.5)
    s5_c_im = nrm((L, S5_GROUPS, S5_GROUP, S5_STATE), S5_STATE ** -0.5)
    s5_d = nrm((L, W), 1.0)
    s5_glu_w = nrm((L, W, W), W ** -0.5)
    s5_glu_b = nrm((L, W), 0.02)

    ssd_conv_w = nrm((L, SSD_CONV, SSD_XBC), SSD_CONV ** -0.5)
    ssd_conv_b = nrm((L, SSD_XBC), 0.02)
    dt0 = jnp.exp(jax.random.uniform(nk(), (L, SSD_HEADS), f32, math.log(1e-3), math.log(1e-1)))
    ssd_dt_bias = dt0 + jnp.log(-jnp.expm1(-dt0))
    ssd_a_log = jnp.log(jax.random.uniform(nk(), (L, SSD_HEADS), f32, 1.0, 16.0))
    ssd_d = near_one((L, SSD_HEADS), 0.1)
    ssd_norm_g = near_one((L, W))

    w_branch = nrm((L, N_BRANCH, W, D), W ** -0.5)
    w_gate = nrm((L, N_BRANCH, D, D), D ** -0.5)
    w_out = nrm((L, D, D), D ** -0.5 * DN_BETA)
    ln1_g = near_one((L, D))
    ln1_b = nrm((L, D), 0.02)

    mod2_w = nrm((L, D, 3 * D), 0.2 * D ** -0.5)
    mod2_b = nrm((L, 3 * D), 0.02)
    router_w = nrm((L, D, N_EXPERTS), D ** -0.5)
    router_bias = nrm((L, N_EXPERTS), 0.01)
    exp_w1 = nrm((L, N_EXPERTS, D, EXPERT_FF), D ** -0.5)
    exp_w3 = nrm((L, N_EXPERTS, D, EXPERT_FF), D ** -0.5)
    exp_w2 = nrm((L, N_EXPERTS, EXPERT_FF, D), EXPERT_FF ** -0.5 * DN_BETA)
    sh_w1 = nrm((L, D, SHARED_FF), D ** -0.5)
    sh_w3 = nrm((L, D, SHARED_FF), D ** -0.5)
    sh_w2 = nrm((L, SHARED_FF, D), SHARED_FF ** -0.5 * DN_BETA)
    ln2_g = near_one((L, D))
    ln2_b = nrm((L, D), 0.02)

    return {"x": x, "c": c, "positions": positions,
            "mod1_w": mod1_w, "mod1_b": mod1_b, "w_in": w_in,
            "gm_ln_g": gm_ln_g, "gm_ln_b": gm_ln_b, "gm_w": gm_w, "gm_b": gm_b,
            "s5_lam_re": s5_lam_re, "s5_lam_im": s5_lam_im, "s5_log_step": s5_log_step,
            "s5_b_re": s5_b_re, "s5_b_im": s5_b_im, "s5_c_re": s5_c_re, "s5_c_im": s5_c_im,
            "s5_d": s5_d, "s5_glu_w": s5_glu_w, "s5_glu_b": s5_glu_b,
            "ssd_conv_w": ssd_conv_w, "ssd_conv_b": ssd_conv_b, "ssd_dt_bias": ssd_dt_bias,
            "ssd_a_log": ssd_a_log, "ssd_d": ssd_d, "ssd_norm_g": ssd_norm_g,
            "w_branch": w_branch, "w_gate": w_gate, "w_out": w_out, "ln1_g": ln1_g, "ln1_b": ln1_b,
            "mod2_w": mod2_w, "mod2_b": mod2_b, "router_w": router_w, "router_bias": router_bias,
            "exp_w1": exp_w1, "exp_w3": exp_w3, "exp_w2": exp_w2,
            "sh_w1": sh_w1, "sh_w3": sh_w3, "sh_w2": sh_w2, "ln2_g": ln2_g, "ln2_b": ln2_b}


def reference(x, c, positions, mod1_w, mod1_b, w_in, gm_ln_g, gm_ln_b, gm_w, gm_b,
              s5_lam_re, s5_lam_im, s5_log_step, s5_b_re, s5_b_im, s5_c_re, s5_c_im,
              s5_d, s5_glu_w, s5_glu_b, ssd_conv_w, ssd_conv_b, ssd_dt_bias, ssd_a_log, ssd_d, ssd_norm_g,
              w_branch, w_gate, w_out, ln1_g, ln1_b, mod2_w, mod2_b, router_w, router_bias,
              exp_w1, exp_w3, exp_w2, sh_w1, sh_w3, sh_w2, ln2_g, ln2_b):
    cos, sin = rope_tables(positions)
    for l in range(DEPTH):
        shift, scale, gate = adaln(c, mod1_w[l], mod1_b[l])
        h = x * (1.0 + scale) + shift
        mix = hybrid_mixer(h, cos, sin, w_in[l], gm_ln_g[l], gm_ln_b[l], gm_w[l], gm_b[l],
                           s5_lam_re[l], s5_lam_im[l], s5_log_step[l], s5_b_re[l], s5_b_im[l],
                           s5_c_re[l], s5_c_im[l], s5_d[l], s5_glu_w[l], s5_glu_b[l],
                           ssd_conv_w[l], ssd_conv_b[l], ssd_dt_bias[l], ssd_a_log[l], ssd_d[l],
                           ssd_norm_g[l], w_branch[l], w_gate[l], w_out[l])
        x = layer_norm(DN_ALPHA * x + (1.0 + gate) * mix, ln1_g[l], ln1_b[l])

        shift, scale, gate = adaln(c, mod2_w[l], mod2_b[l])
        h = x * (1.0 + scale) + shift
        ffn = moe_ffn(h, router_w[l], router_bias[l], exp_w1[l], exp_w3[l], exp_w2[l],
                      sh_w1[l], sh_w3[l], sh_w2[l])
        x = layer_norm(DN_ALPHA * x + (1.0 + gate) * ffn, ln2_g[l], ln2_b[l])
    return x
```

```cpp
#include <hip/hip_runtime.h>
#include <cstdio>
#include <cstdint>


#ifndef MK_PER_PHASE
#define MK_PER_PHASE 1
#endif

#ifndef EN_PROLOGUE
#define EN_PROLOGUE 1
#endif
#ifndef EN_WCONV
#define EN_WCONV 1
#endif
#ifndef EN_GWIN
#define EN_GWIN 1
#endif
#ifndef EN_MX1
#define EN_MX1 1
#endif
#ifndef EN_MX2
#define EN_MX2 1
#endif
#ifndef EN_GLU
#define EN_GLU 1
#endif
#ifndef EN_GP
#define EN_GP 1
#endif
#ifndef EN_GGATE
#define EN_GGATE 1
#endif
#ifndef EN_GOUT
#define EN_GOUT 1
#endif
#ifndef EN_LN1
#define EN_LN1 1
#endif
#ifndef EN_FILL
#define EN_FILL 1
#endif
#ifndef EN_MOE1
#define EN_MOE1 1
#endif
#ifndef EN_MOE2
#define EN_MOE2 1
#endif
#ifndef EN_FIN
#define EN_FIN 1
#endif
#ifndef G_ALIGN
#define G_ALIGN true
#endif
#ifndef G_SP2
#define G_SP2 true
#endif
#define LAS __attribute__((address_space(3)))
#define GAS __attribute__((address_space(1)))
typedef unsigned short bf16_t;
typedef short bf16x8 __attribute__((ext_vector_type(8)));
typedef float f32x4 __attribute__((ext_vector_type(4)));
typedef float f32x2 __attribute__((ext_vector_type(2)));
typedef unsigned u32x4 __attribute__((ext_vector_type(4)));
typedef unsigned u32x2 __attribute__((ext_vector_type(2)));

constexpr int NB = 4, SEQ = 8192, M = NB * SEQ, D = 1024, DEPTH = 2;
constexpr int PJ = 2304;
constexpr int C_GU = 0, C_GV = 256, C_Q = 512, C_K = 768, C_V = 832, C_QI = 896, C_KI = 1152, C_S5 = 1216, C_Z = 1472, C_XBC = 1728, C_WI = 2240, C_DT = 2244;
constexpr int D_IN = 2248;
constexpr int NEXP = 32, NE1 = 33;
constexpr int NCH = 4, CHTOK = M / NCH;
constexpr int CH_ROWS = CHTOK * 8 + CHTOK + NE1 * 256;
constexpr float DN_ALPHA = 1.41421356237f;
constexpr float LN_EPS = 1e-5f, RMS_EPS = 1e-6f;

constexpr size_t MiB = 1u << 20;
constexpr size_t WS_CTL = 0, CTL_BYTES = 1 * MiB;
constexpr size_t WS_MODV = 1 * MiB;
constexpr size_t WS_S5B = WS_MODV + 256 * 1024;
constexpr size_t WS_S5C = WS_S5B + 64 * 1024;
constexpr size_t WS_S5A = WS_S5C + 64 * 1024;
constexpr size_t WS_GMW = WS_S5A + 64 * 1024;
constexpr size_t WS_S5ST = 2 * MiB;
constexpr size_t WS_ATOT = 3 * MiB;
constexpr size_t WS_WGBASE = 3 * MiB + 64 * 1024;
constexpr size_t WS_PINFO = 4 * MiB;
constexpr size_t WS_PGATE = 5 * MiB;
constexpr size_t WS_SLOT = 6 * MiB;
constexpr size_t WS_ROWTOK = 7 * MiB;
constexpr size_t WS_ROWGATE = 9 * MiB;
constexpr size_t WS_W = 24 * MiB;
constexpr size_t WO_IN = 0, WO_GATE = WO_IN + (size_t)PJ * 1024 * 2, WO_BR = WO_GATE + (size_t)4096 * 1024 * 2, WO_OUT = WO_BR + (size_t)4 * 1024 * 256 * 2,
                 WO_GLU = WO_OUT + (size_t)1024 * 1024 * 2, WO_13 = WO_GLU + (size_t)256 * 256 * 2, WO_2 = WO_13 + (size_t)NE1 * 512 * 1024 * 2, WO_END = WO_2 + (size_t)NE1 * 1024 * 256 * 2;
static_assert(WO_END <= 72 * MiB, "weights region");
constexpr size_t WS_H = 96 * MiB;
constexpr size_t WS_Y = 160 * MiB;
constexpr size_t WS_PROJ = 224 * MiB;
constexpr size_t WS_P = 224 * MiB;
constexpr size_t WS_SSDST = 368 * MiB;
constexpr size_t WS_YCPRE = 384 * MiB;
constexpr size_t WS_ACT = 224 * MiB;
constexpr size_t WS_OPAIR = 272 * MiB;
static_assert(WS_ACT + (size_t)CH_ROWS * 512 <= WS_OPAIR && WS_OPAIR + (size_t)CH_ROWS * 2048 <= 512 * MiB, "moe buffers");
constexpr size_t WS_NEED = 512 * MiB;
constexpr int CW_BAR = 4096;
constexpr int CW_CNT = 16384;

constexpr int LDS_BYTES = 160 * 1024;
constexpr int LDS_TAB = 131072;
constexpr int LDS_MISC = LDS_BYTES - 256;

__device__ __forceinline__ unsigned f2bf(float f) { unsigned u = __builtin_bit_cast(unsigned, f); return (u + 0x7fffu + ((u >> 16) & 1u)) >> 16; }
__device__ __forceinline__ unsigned pk2(float lo, float hi) { return f2bf(lo) | (f2bf(hi) << 16); }
__device__ __forceinline__ float bf2f(unsigned short b) { return __builtin_bit_cast(float, (unsigned)b << 16); }
__device__ __forceinline__ float bflo(unsigned w) { return __builtin_bit_cast(float, w << 16); }
__device__ __forceinline__ float bfhi(unsigned w) { return __builtin_bit_cast(float, w & 0xffff0000u); }
__device__ __forceinline__ float wave_sum(float v) {
#pragma unroll
    for (int o = 1; o < 64; o <<= 1) v += __shfl_xor(v, o);
    return v;
}
__device__ __forceinline__ float wave_max(float v) {
#pragma unroll
    for (int o = 1; o < 64; o <<= 1) v = fmaxf(v, __shfl_xor(v, o));
    return v;
}
__device__ __forceinline__ int wave_sum_i(int v) {
#pragma unroll
    for (int o = 1; o < 64; o <<= 1) v += __shfl_xor(v, o);
    return v;
}
__device__ __forceinline__ float sigmoidf_(float x) { return 1.0f / (1.0f + __expf(-x)); }
__device__ __forceinline__ float siluf_(float x) { return x / (1.0f + __expf(-x)); }
__device__ __forceinline__ float gelu_tanh(float x) { const float u = 1.5957691216057308f * (x + 0.044715f * x * x * x); return x / (1.0f + __expf(-u)); }
__device__ __forceinline__ float softplusf_(float x) { return fmaxf(x, 0.f) + log1pf(__expf(-fabsf(x))); }
__device__ __forceinline__ void sincos_red(float ang, float& sn, float& cs) {
    const double a = (double)ang; const double q = __builtin_rint(a * 0.63661977236758134308);
    const float r = (float)(a - q * 1.57079632679489661923); const int qi = (int)q & 3;
    const float r2 = r * r;
    const float s = r * (1.0f + r2 * (-1.6666667e-1f + r2 * (8.3333333e-3f + r2 * (-1.9841270e-4f + r2 * 2.7557319e-6f))));
    const float c = 1.0f + r2 * (-0.5f + r2 * (4.1666667e-2f + r2 * (-1.3888889e-3f + r2 * (2.4801587e-5f + r2 * -2.7557319e-7f))));
    sn = (qi == 0) ? s : (qi == 1) ? c : (qi == 2) ? -s : -c;
    cs = (qi == 0) ? c : (qi == 1) ? -s : (qi == 2) ? -c : s;
}
__device__ __forceinline__ f32x4 mfma16(bf16x8 a, bf16x8 b, f32x4 c) { return __builtin_amdgcn_mfma_f32_16x16x32_bf16(a, b, c, 0, 0, 0); }
__device__ __forceinline__ unsigned cvt_pk_bf16(float lo, float hi) { unsigned r; asm volatile("v_cvt_pk_bf16_f32 %0, %1, %2" : "=v"(r) : "v"(lo), "v"(hi)); return r; }

namespace pg8 {
constexpr int BM = 256, BK = 64, HALF = 128, HTB = HALF * BK * 2, STAGE_BYTES = 8 * HTB, NXCD = 8, WGM = 8;
__host__ __device__ __forceinline__ int lds_byte(int r, int c) { const int st = (r >> 4) * 2 + (c >> 5), rr = r & 15, cc = c & 31, ob = rr * 64 + cc * 2; return st * 1024 + (ob ^ (((ob >> 9) & 1) << 5)); }
__host__ __device__ __forceinline__ void stage_rc(int b, int& R, int& C) { const int st = b / 1024, sb = b % 1024, swz = sb ^ (((sb >> 9) & 1) << 5); R = (st >> 1) * 16 + swz / 64; C = (st & 1) * 32 + (swz % 64) / 2; }
__host__ __device__ __forceinline__ int perm32(int rho) { const int n = rho >> 4, i = rho & 15; return 8 * (i >> 2) + 4 * n + (i & 3); }

struct Unit { int pm, pn, bt, ab; };
struct Gemm { const bf16_t* A; const bf16_t* Bt; int K; size_t a_sel_stride; };

__device__ __forceinline__ int xcd_remap(int wgid, int nwg) { const int q = nwg / NXCD, r = nwg % NXCD, xcd = wgid % NXCD, off = wgid / NXCD; return (xcd < r ? xcd * (q + 1) : r * (q + 1) + (xcd - r) * q) + off; }

struct StaticOrder {
    static constexpr bool GATHER = false;
    int nM, nN, nwg, G, c;
    __device__ void init(int Mr, int N, int G_, int c_) { nM = Mr / BM; nN = N / BM; nwg = nM * nN; G = G_; c = c_; }
    __device__ __forceinline__ bool next(int i, Unit& u) const {
        const long L = (long)i * G + c; if (L >= nwg) return false;
        const int wgid = xcd_remap((int)L, nwg);
        const int nig = WGM * nN, gid = wgid / nig, fm = gid * WGM, gsz = (nM - fm) < WGM ? (nM - fm) : WGM;
        u.pm = fm + ((wgid % nig) % gsz); u.pn = (wgid % nig) / gsz; u.bt = u.pn; u.ab = 0; return true;
    }
    __device__ __forceinline__ void a_ready(const Unit&) const {}
    __device__ __forceinline__ void done(const Unit&) const {}
};

template <class Epi, class Sched, bool ALIGN_EPI = false, bool SP2 = true>
__device__ __forceinline__ void gemm_phase(LAS unsigned char* lds, const Gemm g, const Sched& S, const Epi& E, const int tid) {
    const int wid = __builtin_amdgcn_readfirstlane(tid >> 6), lane = tid & 63, wr = wid >> 2, wc = wid & 3, fr = lane & 15, fq = lane >> 4;
    const int K = g.K, nt = K / BK;
    unsigned voffA[2], voffB[2];
#pragma unroll
    for (int i = 0; i < 2; ++i) { int R, C; stage_rc(tid * 16 + i * 8192, R, C); const int Rb = Epi::PERM ? ((R & ~31) + perm32(R & 31)) : R;
        voffA[i] = (unsigned)(R * K + C) * 2u; voffB[i] = (unsigned)(Rb * K + C) * 2u; }
    const size_t kstep = (size_t)(BK * 2);
    const size_t hstep = (size_t)HALF * K * 2;
    const size_t tstep = 2 * hstep;
    const unsigned ldsw = (unsigned)wid * 1024u;
    const int aoff = lds_byte(wr * 64 + fr, fq * 8), boff = lds_byte(wc * 32 + fr, fq * 8);
#define PG8_SA(b, h) (((b) * 2 + (h)) * HTB)
#define PG8_SB(b, h) ((4 + (b) * 2 + (h)) * HTB)
#define PG8_STAGE(bufoff, gbase, voff) do { _Pragma("unroll") for (int _i = 0; _i < 2; ++_i) \
        __builtin_amdgcn_global_load_lds((const unsigned*)((const char*)(gbase) + (voff)[_i]), (LAS unsigned*)(lds + (bufoff) + ldsw + _i * 8192), 16, 0, 0); } while (0)
#define PG8_GO(u) do { _Pragma("unroll") for (int _h = 0; _h < 2; ++_h) _Pragma("unroll") for (int _i = 0; _i < 2; ++_i) { int _R, _C; stage_rc(tid * 16 + _i * 8192, _R, _C); \
        cgo[_h][_i] = (unsigned)S.row_of(u, _h * HALF + _R) * (unsigned)(K * 2) + (unsigned)_C * 2u; } } while (0)
#define PG8_STAGE_A(bufoff, base, h, kb, NX) do { if constexpr (Sched::GATHER) { _Pragma("unroll") for (int _i = 0; _i < 2; ++_i) \
        __builtin_amdgcn_global_load_lds((const unsigned*)((const char*)g.A + (kb) + cgo[h][_i]), (LAS unsigned*)(lds + (bufoff) + ldsw + _i * 8192), 16, 0, 0); } \
        else { PG8_STAGE(bufoff, (base) + (size_t)(h) * hstep + (kb), voffA); } } while (0)
#define PG8_LDA(dst, b, h) do { _Pragma("unroll") for (int m = 0; m < 4; ++m) _Pragma("unroll") for (int k = 0; k < 2; ++k) dst[m][k] = *(const LAS bf16x8*)(lds + PG8_SA(b, h) + aoff + m * 2048 + k * 1024); } while (0)
#define PG8_LDB(dst, b, h) do { _Pragma("unroll") for (int n = 0; n < 2; ++n) _Pragma("unroll") for (int k = 0; k < 2; ++k) dst[n][k] = *(const LAS bf16x8*)(lds + PG8_SB(b, h) + boff + n * 2048 + k * 1024); } while (0)
#define PG8_MMA(ai, bj, At, Bt) do { __builtin_amdgcn_s_setprio(1); _Pragma("unroll") for (int m = 0; m < 4; ++m) _Pragma("unroll") for (int n = 0; n < 2; ++n) _Pragma("unroll") for (int k = 0; k < 2; ++k) \
        acc[ai][bj][m][n] = __builtin_amdgcn_mfma_f32_16x16x32_bf16(Bt[n][k], At[m][k], acc[ai][bj][m][n], 0, 0, 0); __builtin_amdgcn_s_setprio(0); } while (0)
#define PG8_WAIT_V(n) asm volatile("s_waitcnt vmcnt(" #n ")" ::: "memory")
#define PG8_WAIT_L(n) asm volatile("s_waitcnt lgkmcnt(" #n ")" ::: "memory")
#define PG8_BAR __builtin_amdgcn_s_barrier()
#define PG8_SCHED __builtin_amdgcn_sched_barrier(0)
    Unit cur, nxt; int ui = 0;
    if (!S.next(0, cur)) return;
    f32x4 acc[2][2][4][2];
#pragma unroll
    for (int a = 0; a < 2; ++a)
#pragma unroll
        for (int b = 0; b < 2; ++b)
#pragma unroll
            for (int m = 0; m < 4; ++m)
#pragma unroll
                for (int n = 0; n < 2; ++n) acc[a][b][m][n] = (f32x4){0.f, 0.f, 0.f, 0.f};
    bf16x8 At[4][2], B0[2][2], B1[2][2];
    unsigned cgo[2][2];
    if constexpr (Sched::GATHER) PG8_GO(cur);
    const char* cA = (const char*)(g.A + (size_t)cur.ab * g.a_sel_stride) + (size_t)cur.pm * tstep; const char* cB = (const char*)g.Bt + (size_t)cur.bt * tstep;
    S.a_ready(cur);
    if constexpr (SP2) {
        PG8_STAGE(PG8_SB(0, 0), cB, voffB); PG8_STAGE(PG8_SB(0, 1), cB + hstep, voffB); PG8_STAGE_A(PG8_SA(0, 0), cA, 0, (size_t)0, false); PG8_STAGE_A(PG8_SA(0, 1), cA, 1, (size_t)0, false);
        if (wr == 1) PG8_BAR;
        PG8_WAIT_V(2); PG8_BAR;
        PG8_STAGE(PG8_SB(1, 0), cB + kstep, voffB); PG8_STAGE_A(PG8_SA(1, 0), cA, 0, kstep, false); PG8_STAGE(PG8_SB(1, 1), cB + hstep + kstep, voffB);
        PG8_WAIT_V(6); PG8_BAR;
    } else {
        PG8_STAGE(PG8_SB(0, 0), cB, voffB); PG8_STAGE_A(PG8_SA(0, 0), cA, 0, (size_t)0, false); PG8_STAGE(PG8_SB(0, 1), cB + hstep, voffB); PG8_STAGE_A(PG8_SA(0, 1), cA, 1, (size_t)0, false);
        if (wr == 1) PG8_BAR;
        PG8_WAIT_V(4); PG8_BAR;
        PG8_STAGE(PG8_SB(1, 0), cB + kstep, voffB); PG8_STAGE_A(PG8_SA(1, 0), cA, 0, kstep, false); PG8_STAGE(PG8_SB(1, 1), cB + hstep + kstep, voffB);
        PG8_WAIT_V(6); PG8_BAR;
    }
    for (;;) {
        const bool has_next = S.next(ui + 1, nxt);
        const char* nA = has_next ? (const char*)(g.A + (size_t)nxt.ab * g.a_sel_stride) + (size_t)nxt.pm * tstep : cA; const char* nB = has_next ? (const char*)g.Bt + (size_t)nxt.bt * tstep : cB;
#pragma nounroll
        for (int t = 0; t < nt; t += 2) {
            const bool last = (t == nt - 2);
            const size_t k1 = (size_t)(t + 1) * kstep;
            const char* a2b = last ? nA : cA; const size_t k2 = last ? (size_t)0 : (size_t)(t + 2) * kstep; const size_t k3 = k2 + kstep;
            const char* b2 = last ? nB : cB + (size_t)(t + 2) * kstep; const char* b3 = b2 + kstep;
            if (last && has_next) S.a_ready(nxt);
            if constexpr (SP2) {
            PG8_LDB(B0, 0, 0); PG8_LDB(B1, 0, 1); PG8_SCHED; PG8_LDA(At, 0, 0); PG8_STAGE_A(PG8_SA(1, 1), cA, 1, k1, false);
            if constexpr (Sched::GATHER) { if (last && has_next) PG8_GO(nxt); }
            PG8_WAIT_V(8); PG8_WAIT_L(0); PG8_BAR; PG8_MMA(0, 0, At, B0); PG8_MMA(0, 1, At, B1); PG8_BAR; PG8_SCHED;
            PG8_LDA(At, 0, 1); PG8_STAGE(PG8_SB(0, 0), b2, voffB); PG8_STAGE(PG8_SB(0, 1), b2 + hstep, voffB); PG8_STAGE_A(PG8_SA(0, 0), a2b, 0, k2, last);
            PG8_WAIT_V(8); PG8_WAIT_L(0); PG8_BAR; PG8_MMA(1, 0, At, B0); PG8_MMA(1, 1, At, B1); PG8_BAR; PG8_SCHED;
            PG8_LDB(B0, 1, 0); PG8_LDB(B1, 1, 1); PG8_SCHED; PG8_LDA(At, 1, 0); PG8_STAGE_A(PG8_SA(0, 1), a2b, 1, k2, last);
            PG8_WAIT_V(8); PG8_WAIT_L(0); PG8_BAR; PG8_MMA(0, 0, At, B0); PG8_MMA(0, 1, At, B1); PG8_BAR; PG8_SCHED;
            PG8_LDA(At, 1, 1); PG8_STAGE(PG8_SB(1, 0), b3, voffB); PG8_STAGE(PG8_SB(1, 1), b3 + hstep, voffB); PG8_STAGE_A(PG8_SA(1, 0), a2b, 0, k3, last);
            PG8_WAIT_V(8); PG8_WAIT_L(0); PG8_BAR; PG8_MMA(1, 0, At, B0); PG8_MMA(1, 1, At, B1); PG8_BAR; PG8_SCHED;
            } else {
            PG8_LDB(B0, 0, 0); PG8_SCHED; PG8_LDA(At, 0, 0); PG8_STAGE_A(PG8_SA(1, 1), cA, 1, k1, false);
            if constexpr (Sched::GATHER) { if (last && has_next) PG8_GO(nxt); }
            PG8_WAIT_L(8); PG8_BAR; PG8_WAIT_L(0); PG8_MMA(0, 0, At, B0); PG8_BAR; PG8_SCHED;
            PG8_LDB(B1, 0, 1); PG8_STAGE(PG8_SB(0, 0), b2, voffB);
            PG8_BAR; PG8_WAIT_L(0); PG8_MMA(0, 1, At, B1); PG8_BAR;
            PG8_LDA(At, 0, 1); PG8_STAGE_A(PG8_SA(0, 0), a2b, 0, k2, last);
            PG8_BAR; PG8_WAIT_L(0); PG8_MMA(1, 0, At, B0); PG8_BAR; PG8_SCHED;
            PG8_STAGE(PG8_SB(0, 1), b2 + hstep, voffB);
            PG8_WAIT_V(6); PG8_BAR; PG8_MMA(1, 1, At, B1); PG8_BAR;
            PG8_LDB(B0, 1, 0); PG8_SCHED; PG8_LDA(At, 1, 0); PG8_STAGE_A(PG8_SA(0, 1), a2b, 1, k2, last);
            PG8_WAIT_L(8); PG8_BAR; PG8_WAIT_L(0); PG8_MMA(0, 0, At, B0); PG8_BAR; PG8_SCHED;
            PG8_LDB(B1, 1, 1); PG8_STAGE(PG8_SB(1, 0), b3, voffB);
            PG8_BAR; PG8_WAIT_L(0); PG8_MMA(0, 1, At, B1); PG8_BAR;
            PG8_LDA(At, 1, 1); PG8_STAGE_A(PG8_SA(1, 0), a2b, 0, k3, last);
            PG8_BAR; PG8_WAIT_L(0); PG8_MMA(1, 0, At, B0); PG8_BAR; PG8_SCHED;
            PG8_STAGE(PG8_SB(1, 1), b3 + hstep, voffB);
            PG8_WAIT_V(6); PG8_BAR; PG8_MMA(1, 1, At, B1); PG8_BAR;
            }
        }
        if constexpr (ALIGN_EPI) { if (wr == 0) PG8_BAR; }
        E(acc, cur, wr, wc, fr, fq); S.done(cur);
        if (!has_next) break;
#pragma unroll
        for (int a = 0; a < 2; ++a)
#pragma unroll
            for (int b = 0; b < 2; ++b)
#pragma unroll
                for (int m = 0; m < 4; ++m)
#pragma unroll
                    for (int n = 0; n < 2; ++n) acc[a][b][m][n] = (f32x4){0.f, 0.f, 0.f, 0.f};
        cur = nxt; cA = nA; cB = nB; ++ui;
        if constexpr (ALIGN_EPI) { if (wr == 1) PG8_BAR; }
    }
    PG8_WAIT_V(0);
    if constexpr (!ALIGN_EPI) { if (wr == 0) PG8_BAR; }
    PG8_BAR;
#undef PG8_SA
#undef PG8_SB
#undef PG8_STAGE
#undef PG8_STAGE_A
#undef PG8_GO
#undef PG8_LDA
#undef PG8_LDB
#undef PG8_MMA
#undef PG8_WAIT_V
#undef PG8_WAIT_L
#undef PG8_BAR
#undef PG8_SCHED
}

struct EpiBf16 {
    static constexpr bool PERM = true;
    bf16_t* O; int ldc;
    __device__ __forceinline__ void operator()(const f32x4 (&acc)[2][2][4][2], const Unit& u, int wr, int wc, int fr, int fq) const {
        const int row0 = u.pm * BM + wr * 64 + fr, col0 = u.pn * BM + wc * 32 + 8 * fq;
#pragma unroll
        for (int ai = 0; ai < 2; ++ai)
#pragma unroll
            for (int m = 0; m < 4; ++m) { bf16_t* rowp = O + (size_t)(row0 + ai * HALF + m * 16) * ldc + col0;
#pragma unroll
                for (int bj = 0; bj < 2; ++bj) { const f32x4 v0 = acc[ai][bj][m][0], v1 = acc[ai][bj][m][1];
                    u32x4 w; w.x = cvt_pk_bf16(v0[0], v0[1]); w.y = cvt_pk_bf16(v0[2], v0[3]); w.z = cvt_pk_bf16(v1[0], v1[1]); w.w = cvt_pk_bf16(v1[2], v1[3]);
                    *(u32x4*)(rowp + bj * HALF) = w; } }
    }
};
struct EpiGlu {
    static constexpr bool PERM = true;
    const bf16_t* Ysrc; bf16_t* O; const float* bias;
    __device__ __forceinline__ void operator()(const f32x4 (&acc)[2][2][4][2], const Unit& u, int wr, int wc, int fr, int fq) const {
        const int row0 = u.pm * BM + wr * 64 + fr, col0 = u.pn * BM + wc * 32 + 8 * fq;
#pragma unroll
        for (int ai = 0; ai < 2; ++ai)
#pragma unroll
            for (int m = 0; m < 4; ++m) { const size_t ro = (size_t)(row0 + ai * HALF + m * 16) * 256 + col0;
#pragma unroll
                for (int bj = 0; bj < 2; ++bj) { const f32x4 v0 = acc[ai][bj][m][0], v1 = acc[ai][bj][m][1];
                    const u32x4 yv = *(const u32x4*)(Ysrc + ro + bj * HALF);
                    const f32x4 b0 = *(const f32x4*)(bias + col0 + bj * HALF), b1 = *(const f32x4*)(bias + col0 + bj * HALF + 4);
                    float o[8];
                    o[0] = bflo(yv.x) * sigmoidf_(v0[0] + b0[0]); o[1] = bfhi(yv.x) * sigmoidf_(v0[1] + b0[1]); o[2] = bflo(yv.y) * sigmoidf_(v0[2] + b0[2]); o[3] = bfhi(yv.y) * sigmoidf_(v0[3] + b0[3]);
                    o[4] = bflo(yv.z) * sigmoidf_(v1[0] + b1[0]); o[5] = bfhi(yv.z) * sigmoidf_(v1[1] + b1[1]); o[6] = bflo(yv.w) * sigmoidf_(v1[2] + b1[2]); o[7] = bfhi(yv.w) * sigmoidf_(v1[3] + b1[3]);
                    u32x4 w; w.x = cvt_pk_bf16(o[0], o[1]); w.y = cvt_pk_bf16(o[2], o[3]); w.z = cvt_pk_bf16(o[4], o[5]); w.w = cvt_pk_bf16(o[6], o[7]);
                    *(u32x4*)(O + ro + bj * HALF) = w; } }
    }
};
struct EpiGateMerge {
    static constexpr bool PERM = true;
    const bf16_t* P; bf16_t* Mg;
    __device__ __forceinline__ void operator()(const f32x4 (&acc)[2][2][4][2], const Unit& u, int wr, int wc, int fr, int fq) const {
        const int i = u.pn >> 2, mt = u.pn & 3;
        const int row0 = u.pm * BM + wr * 64 + fr, col0 = mt * BM + wc * 32 + 8 * fq;
#pragma unroll
        for (int ai = 0; ai < 2; ++ai)
#pragma unroll
            for (int m = 0; m < 4; ++m) { const size_t r = (size_t)(row0 + ai * HALF + m * 16);
#pragma unroll
                for (int bj = 0; bj < 2; ++bj) { const f32x4 v0 = acc[ai][bj][m][0], v1 = acc[ai][bj][m][1];
                    const u32x4 pv = *(const u32x4*)(P + r * 4096 + i * 1024 + col0 + bj * HALF);
                    u32x4 mv = (u32x4){0u, 0u, 0u, 0u};
                    if (i > 0) mv = *(const u32x4*)(Mg + r * 1024 + col0 + bj * HALF);
                    float o[8];
                    o[0] = bflo(mv.x) + bflo(pv.x) * sigmoidf_(v0[0]); o[1] = bfhi(mv.x) + bfhi(pv.x) * sigmoidf_(v0[1]); o[2] = bflo(mv.y) + bflo(pv.y) * sigmoidf_(v0[2]); o[3] = bfhi(mv.y) + bfhi(pv.y) * sigmoidf_(v0[3]);
                    o[4] = bflo(mv.z) + bflo(pv.z) * sigmoidf_(v1[0]); o[5] = bfhi(mv.z) + bfhi(pv.z) * sigmoidf_(v1[1]); o[6] = bflo(mv.w) + bflo(pv.w) * sigmoidf_(v1[2]); o[7] = bfhi(mv.w) + bfhi(pv.w) * sigmoidf_(v1[3]);
                    u32x4 w; w.x = cvt_pk_bf16(o[0], o[1]); w.y = cvt_pk_bf16(o[2], o[3]); w.z = cvt_pk_bf16(o[4], o[5]); w.w = cvt_pk_bf16(o[6], o[7]);
                    *(u32x4*)(Mg + r * 1024 + col0 + bj * HALF) = w; } }
    }
};
struct EpiResid {
    static constexpr bool PERM = false;
    const float* xin; float* out; const float* gate;
    __device__ __forceinline__ void operator()(const f32x4 (&acc)[2][2][4][2], const Unit& u, int wr, int wc, int fr, int fq) const {
        const int row0 = u.pm * BM + wr * 64 + fr, col0 = u.pn * BM + wc * 32 + 4 * fq;
        const int b = (u.pm * BM) / SEQ;
        f32x4 gv[2][2];
#pragma unroll
        for (int bj = 0; bj < 2; ++bj)
#pragma unroll
            for (int n = 0; n < 2; ++n) gv[bj][n] = *(const f32x4*)(gate + b * 3072 + 2048 + col0 + bj * HALF + n * 16) + 1.0f;
#pragma unroll
        for (int ai = 0; ai < 2; ++ai)
#pragma unroll
            for (int m = 0; m < 4; ++m) { const size_t ro = (size_t)(row0 + ai * HALF + m * 16) * D + col0;
#pragma unroll
                for (int bj = 0; bj < 2; ++bj)
#pragma unroll
                    for (int n = 0; n < 2; ++n) { const f32x4 xv = *(const f32x4*)(xin + ro + bj * HALF + n * 16);
                        *(f32x4*)(out + ro + bj * HALF + n * 16) = xv * DN_ALPHA + gv[bj][n] * acc[ai][bj][m][n]; } }
    }
};
struct EpiMoe1 {
    static constexpr bool PERM = false;
    bf16_t* Act; const float* rowgate;
    __device__ __forceinline__ void operator()(const f32x4 (&acc)[2][2][4][2], const Unit& u, int wr, int wc, int fr, int fq) const {
        const int row0 = u.pm * BM + wr * 64 + fr, f0 = u.pn * 128 + wc * 16 + 4 * fq;
#pragma unroll
        for (int ai = 0; ai < 2; ++ai)
#pragma unroll
            for (int m = 0; m < 4; ++m) { const int r = row0 + ai * HALF + m * 16; const float gt = rowgate[r];
#pragma unroll
                for (int bj = 0; bj < 2; ++bj) { const f32x4 a = acc[ai][bj][m][0], b = acc[ai][bj][m][1];
                    u32x2 w; w.x = cvt_pk_bf16(siluf_(a[0]) * b[0] * gt, siluf_(a[1]) * b[1] * gt); w.y = cvt_pk_bf16(siluf_(a[2]) * b[2] * gt, siluf_(a[3]) * b[3] * gt);
                    *(u32x2*)(Act + (size_t)r * 256 + f0 + bj * 64) = w; } }
    }
};
}

#define XB_TMO      128
#define XB_XCNT(j)  (256  + 64 * (j))
#define XB_XSUB(j)  (1280 + 64 * (j))
#define XB_XGEN(j)  (2304 + 64 * (j))
#define XB_TOP      3328
#define XB_TOPGEN   3392
#define XCD_BAR_WORDS 3456
#define XB_SPIN_CAP (1u << 22)
__device__ __forceinline__ unsigned xb_ld(unsigned* p)              { return __hip_atomic_load(p, __ATOMIC_RELAXED, __HIP_MEMORY_SCOPE_AGENT); }
__device__ __forceinline__ unsigned xb_add(unsigned* p, unsigned v) { return __hip_atomic_fetch_add(p, v, __ATOMIC_RELAXED, __HIP_MEMORY_SCOPE_AGENT); }
__device__ __forceinline__ unsigned xb_xcc_id() { return (unsigned)__builtin_amdgcn_s_getreg((3 << 11) | 20) & 0xFu; }
#define XB_SPIN(cond, bar) do { unsigned _sp = 0; while (cond) { __builtin_amdgcn_s_sleep(1); \
    if ((++_sp & 255u) == 0u) { if (xb_ld(&(bar)[XB_TMO])) break; if (_sp > XB_SPIN_CAP) { atomicAdd(&(bar)[XB_TMO], 1u); break; } } } } while (0)
struct XcdBarrier { unsigned* bar; unsigned x; volatile LAS unsigned* st; };
__device__ __forceinline__ XcdBarrier xcd_barrier_post(unsigned* bar, volatile LAS unsigned* st) {
    XcdBarrier b; b.bar = bar; b.x = xb_xcc_id(); b.st = st;
    if (threadIdx.x == 0) (void)xb_add(&bar[XB_XCNT(b.x)], 1u);
    return b;
}
__device__ __forceinline__ void xcd_barrier_complete(unsigned* bar, unsigned x, unsigned& nloc, unsigned& nx) {
    const unsigned G = gridDim.x * gridDim.y * gridDim.z;
    unsigned sum, cnt, mine, sp = 0u;
    for (;;) {
        sum = 0u; cnt = 0u; mine = 0u;
#pragma unroll
        for (unsigned j = 0; j < 16; ++j) { const unsigned c = xb_ld(&bar[XB_XCNT(j)]); sum += c; cnt += (c > 0u) ? 1u : 0u; mine = (j == x) ? c : mine; }
        if (sum == G) break;
        __builtin_amdgcn_s_sleep(1);
        if ((++sp & 255u) == 0u) { if (xb_ld(&bar[XB_TMO])) break; if (sp > XB_SPIN_CAP) { atomicAdd(&bar[XB_TMO], 1u); break; } }
    }
    nloc = mine > 0u ? mine : 1u; nx = cnt > 0u ? cnt : 1u;
}
__device__ __forceinline__ void xcd_barrier(const XcdBarrier& b) {
    asm volatile("s_waitcnt vmcnt(0)" ::: "memory");
    __syncthreads();
    if (threadIdx.x == 0) {
        unsigned* bar = b.bar;
        __builtin_amdgcn_s_waitcnt(0);
        unsigned nloc = b.st[0], nx = b.st[1];
        if (nloc == 0u) { xcd_barrier_complete(bar, b.x, nloc, nx); b.st[0] = nloc; b.st[1] = nx; }
        const unsigned old = xb_add(&bar[XB_XSUB(b.x)], 1u);
        const unsigned gen = old / nloc;
        if (old + 1u == (gen + 1u) * nloc) {
            __builtin_amdgcn_fence(__ATOMIC_RELEASE, "agent");
            asm volatile("s_waitcnt vmcnt(0)" ::: "memory");
            const unsigned og = xb_add(&bar[XB_TOP], 1u);
            const unsigned tg = og / nx;
            if (og + 1u == (tg + 1u) * nx) xb_add(&bar[XB_TOPGEN], 1u);
            else XB_SPIN(xb_ld(&bar[XB_TOPGEN]) == tg, bar);
            __builtin_amdgcn_fence(__ATOMIC_ACQUIRE, "agent");
            xb_add(&bar[XB_XGEN(b.x)], 1u);
            asm volatile("s_waitcnt vmcnt(0)" ::: "memory");
        } else {
            XB_SPIN(xb_ld(&bar[XB_XGEN(b.x)]) == gen, bar);
            __builtin_amdgcn_fence(__ATOMIC_ACQUIRE, "agent");
            asm volatile("s_waitcnt vmcnt(0)" ::: "memory");
        }
    }
    __syncthreads();
}

struct Args {
    const float* in[43]; const int* positions; float* out; unsigned char* ws; int ph_lo, ph_hi;
};
enum { I_X = 0, I_C = 1, I_POS = 2, I_MOD1W = 3, I_MOD1B = 4, I_WIN = 5, I_GMLNG = 6, I_GMLNB = 7, I_GMW = 8, I_GMB = 9,
       I_S5LRE = 10, I_S5LIM = 11, I_S5STEP = 12, I_S5BRE = 13, I_S5BIM = 14, I_S5CRE = 15, I_S5CIM = 16, I_S5D = 17, I_S5GLUW = 18, I_S5GLUB = 19,
       I_CONVW = 20, I_CONVB = 21, I_DTBIAS = 22, I_ALOG = 23, I_SSDD = 24, I_SSDNG = 25, I_WBR = 26, I_WGATE = 27, I_WOUT = 28, I_LN1G = 29, I_LN1B = 30,
       I_MOD2W = 31, I_MOD2B = 32, I_RW = 33, I_RB = 34, I_EW1 = 35, I_EW3 = 36, I_EW2 = 37, I_SW1 = 38, I_SW3 = 39, I_SW2 = 40, I_LN2G = 41, I_LN2B = 42 };

typedef const __attribute__((address_space(4))) Args* ArgsP;
struct Ctx {
    ArgsP a; unsigned char* ws; LAS unsigned char* lds; int tid, lane, wave, c, G, bx;
    __device__ __forceinline__ const float* in(int i) const { return a->in[i]; }
    __device__ __forceinline__ bf16_t* proj() const { return (bf16_t*)(ws + WS_PROJ); }
    __device__ __forceinline__ bf16_t* hbuf() const { return (bf16_t*)(ws + WS_H); }
    __device__ __forceinline__ bf16_t* ybuf() const { return (bf16_t*)(ws + WS_Y); }
    __device__ __forceinline__ float* modv(int l, int w) const { return (float*)(ws + WS_MODV) + (size_t)(l * 2 + w) * NB * 3072; }
};

__device__ __forceinline__ void ph_prologue(const Ctx& X) {
    LAS float* red = (LAS float*)X.lds;
    for (int it = X.c; it < DEPTH * 2 * 48; it += X.G) {
        const int l = it / 96, w = (it / 48) & 1, jb = it % 48, j = jb * 64 + X.lane;
        const float* W = X.in(w ? I_MOD2W : I_MOD1W) + (size_t)l * D * 3072; const float* cv = X.in(I_C);
        float a0 = 0.f, a1 = 0.f, a2 = 0.f, a3 = 0.f;
        const int k0 = X.wave * 128;
        for (int k = k0; k < k0 + 128; ++k) { const float wv = W[(size_t)k * 3072 + j]; a0 += cv[k] * wv; a1 += cv[D + k] * wv; a2 += cv[2 * D + k] * wv; a3 += cv[3 * D + k] * wv; }
        red[(X.wave * 4 + 0) * 64 + X.lane] = a0; red[(X.wave * 4 + 1) * 64 + X.lane] = a1; red[(X.wave * 4 + 2) * 64 + X.lane] = a2; red[(X.wave * 4 + 3) * 64 + X.lane] = a3;
        __syncthreads();
        if (X.tid < 256) { const int b = X.tid >> 6, ln = X.tid & 63; float s = 0.f;
#pragma unroll
            for (int q = 0; q < 8; ++q) s += red[(q * 4 + b) * 64 + ln];
            const int jj = jb * 64 + ln; X.modv(l, w)[b * 3072 + jj] = s + X.in(w ? I_MOD2B : I_MOD1B)[(size_t)l * 3072 + jj]; }
        __syncthreads();
    }
}

template <class Src>
__device__ __forceinline__ void tr_item(const Src& src, bf16_t* WT, int K, int rowbase, int kb, int nb, LAS float* scr, int lane) {
    const int k0 = 64 * kb, n0 = 32 * nb;
#pragma unroll 8
    for (int i = 0; i < 32; ++i) { const int kk = 2 * i + (lane >> 5); scr[kk * 33 + (lane & 31)] = src(k0 + kk, n0 + (lane & 31)); }
    asm volatile("s_waitcnt lgkmcnt(0)" ::: "memory");
    const int c = lane & 7;
#pragma unroll
    for (int j = 0; j < 4; ++j) { const int n = (lane >> 3) + 8 * j; const LAS float* s = scr + (8 * c) * 33 + n;
        u32x4 o; o.x = pk2(s[0 * 33], s[1 * 33]); o.y = pk2(s[2 * 33], s[3 * 33]); o.z = pk2(s[4 * 33], s[5 * 33]); o.w = pk2(s[6 * 33], s[7 * 33]);
        *(u32x4*)(WT + (size_t)(rowbase + n0 + n) * K + k0 + 8 * c) = o; }
    asm volatile("s_waitcnt lgkmcnt(0)" ::: "memory");
}
struct SrcPlain { const float* W; int N; __device__ __forceinline__ float operator()(int k, int n) const { return W[(size_t)k * N + n]; } };
struct SrcWin { const float* W; __device__ __forceinline__ float operator()(int k, int n) const {
    if (n >= D_IN) return 0.f; const int o = (n < 1216) ? n : (n < 2240) ? n + 4 : (n < 2244) ? 1216 + (n - 2240) : n; return W[(size_t)k * D_IN + o]; } };
struct Src13 { const float* W1; const float* W3; __device__ __forceinline__ float operator()(int k, int n) const {
    const int f = (n >> 5) * 16 + (n & 15); const long d = (n & 16) ? (long)(W3 - W1) : 0l; return W1[d + (long)k * 256 + f]; } };

__device__ __forceinline__ void ph_wconv(const Ctx& X, int l) {
    LAS float* scr = (LAS float*)(X.lds + X.wave * 16384);
    unsigned char* wb = X.ws + WS_W;
    const int gw = X.c * 8 + X.wave, NGW = X.G * 8;
    constexpr int I_A = 16 * 72, I_B = 4 * 16 * 32, I_C2 = 4 * 4 * 32, I_D = 16 * 32, I_E = 4 * 8, I_F = NE1 * 16 * 16, I_G = NE1 * 4 * 32;
    constexpr int NIT = I_A + I_B + I_C2 + I_D + I_E + I_F + I_G;
    for (int it = gw; it < NIT; it += NGW) {
        int r = it;
        if (r < I_A) { SrcWin s{X.in(I_WIN) + (size_t)l * D * D_IN}; tr_item(s, (bf16_t*)(wb + WO_IN), 1024, 0, r / 72, r % 72, scr, X.lane); continue; } r -= I_A;
        if (r < I_B) { const int i = r / 512, q = r % 512; SrcPlain s{X.in(I_WGATE) + ((size_t)l * 4 + i) * D * D, D}; tr_item(s, (bf16_t*)(wb + WO_GATE), 1024, i * 1024, q / 32, q % 32, scr, X.lane); continue; } r -= I_B;
        if (r < I_C2) { const int i = r / 128, q = r % 128; SrcPlain s{X.in(I_WBR) + ((size_t)l * 4 + i) * 256 * D, D}; tr_item(s, (bf16_t*)(wb + WO_BR) + (size_t)i * 1024 * 256, 256, 0, q / 32, q % 32, scr, X.lane); continue; } r -= I_C2;
        if (r < I_D) { SrcPlain s{X.in(I_WOUT) + (size_t)l * D * D, D}; tr_item(s, (bf16_t*)(wb + WO_OUT), 1024, 0, r / 32, r % 32, scr, X.lane); continue; } r -= I_D;
        if (r < I_E) { SrcPlain s{X.in(I_S5GLUW) + (size_t)l * 256 * 256, 256}; tr_item(s, (bf16_t*)(wb + WO_GLU), 256, 0, r / 8, r % 8, scr, X.lane); continue; } r -= I_E;
        if (r < I_F) { const int e = r / 256, q = r % 256;
            const Src13 s{(e < NEXP) ? X.in(I_EW1) + ((size_t)l * NEXP + e) * D * 256 : X.in(I_SW1) + (size_t)l * D * 256, (e < NEXP) ? X.in(I_EW3) + ((size_t)l * NEXP + e) * D * 256 : X.in(I_SW3) + (size_t)l * D * 256};
            tr_item(s, (bf16_t*)(wb + WO_13) + (size_t)e * 512 * 1024, 1024, 0, q / 16, q % 16, scr, X.lane); continue; } r -= I_F;
        { const int e = r / 128, q = r % 128; SrcPlain s{e < NEXP ? X.in(I_EW2) + ((size_t)l * NEXP + e) * 256 * D : X.in(I_SW2) + (size_t)l * 256 * D, D};
            tr_item(s, (bf16_t*)(wb + WO_2) + (size_t)e * 1024 * 256, 256, 0, q / 32, q % 32, scr, X.lane); }
    }
    const int gt = X.c * 512 + X.tid, NGT = X.G * 512;
    { bf16_t* gmw = (bf16_t*)(X.ws + WS_GMW); const float* src = X.in(I_GMW) + (size_t)l * 4 * 128 * 128;
      for (int i = gt; i < 4 * 128 * 128; i += NGT) { const int t = (i >> 7) & 127, s = i & 127; gmw[i] = (bf16_t)f2bf(s <= t ? src[i] : 0.f); } }
    for (int i = gt; i < 16 * 64; i += NGT) {
        const int g = i >> 6, p = i & 63;
        const float step = expf(X.in(I_S5STEP)[l * 16 + g]); const float lr = X.in(I_S5LRE)[(size_t)l * 1024 + i], li = X.in(I_S5LIM)[(size_t)l * 1024 + i];
        const float mag = expf(lr * step); float sn, cs; sincos_red(li * step, sn, cs);
        const float abr = mag * cs, abi = mag * sn, den = lr * lr + li * li, nr = abr - 1.0f;
        const float cr = (nr * lr + abi * li) / den, ci = (abi * lr - nr * li) / den;
        float* sa = (float*)(X.ws + WS_S5A); sa[i * 2] = abr; sa[i * 2 + 1] = abi;
        bf16_t* bb = (bf16_t*)(X.ws + WS_S5B); bf16_t* cm = (bf16_t*)(X.ws + WS_S5C);
        const float* bre = X.in(I_S5BRE) + ((size_t)l * 1024 + i) * 16; const float* bim = X.in(I_S5BIM) + ((size_t)l * 1024 + i) * 16;
#pragma unroll
        for (int ch = 0; ch < 16; ++ch) { const float br = bre[ch], bi = bim[ch];
            bb[(g * 128 + p) * 16 + ch] = (bf16_t)f2bf(cr * br - ci * bi); bb[(g * 128 + 64 + p) * 16 + ch] = (bf16_t)f2bf(cr * bi + ci * br);
            cm[(g * 16 + ch) * 128 + p] = (bf16_t)f2bf(X.in(I_S5CRE)[(((size_t)l * 16 + g) * 16 + ch) * 64 + p]);
            cm[(g * 16 + ch) * 128 + 64 + p] = (bf16_t)f2bf(-X.in(I_S5CIM)[(((size_t)l * 16 + g) * 16 + ch) * 64 + p]); }
    }
    if (l == 0) {
        const float* x = X.in(I_X); bf16_t* h = X.hbuf(); const float* mv = X.modv(0, 0);
        for (size_t i = (size_t)gt; i < (size_t)M * D / 8; i += NGT) {
            const size_t e = i * 8; const int col = (int)(e & 1023), b = (int)(e >> 23);
            const f32x4 x0 = *(const f32x4*)(x + e), x1 = *(const f32x4*)(x + e + 4);
            const f32x4 sh0 = *(const f32x4*)(mv + b * 3072 + col), sh1 = *(const f32x4*)(mv + b * 3072 + col + 4), sc0 = *(const f32x4*)(mv + b * 3072 + 1024 + col), sc1 = *(const f32x4*)(mv + b * 3072 + 1024 + col + 4);
            const f32x4 h0 = x0 * (sc0 + 1.0f) + sh0, h1 = x1 * (sc1 + 1.0f) + sh1;
            u32x4 w; w.x = pk2(h0[0], h0[1]); w.y = pk2(h0[2], h0[3]); w.z = pk2(h1[0], h1[1]); w.w = pk2(h1[2], h1[3]);
            *(u32x4*)(h + e) = w; }
    }
}

__device__ __forceinline__ void mx_rope(const Ctx& X) {
    bf16_t* pj = X.proj(); const int* pos = X.a->positions;
    const int gt = X.c * 512 + X.tid, NGT = X.G * 512;
    for (int i = gt; i < M * 10; i += NGT) {
        const int tok = i / 10, hh = i % 10;
        const int col = (hh < 4) ? C_Q + hh * 64 : (hh == 4) ? C_K : (hh < 9) ? C_QI + (hh - 5) * 64 : C_KI;
        bf16_t* p = pj + (size_t)tok * PJ + col;
        const u32x4 a = *(const u32x4*)p, b = *(const u32x4*)(p + 8);
        const float pf = (float)pos[tok];
        float t1[8], t2[8]; t1[0] = bflo(a.x); t1[1] = bfhi(a.x); t1[2] = bflo(a.y); t1[3] = bfhi(a.y); t1[4] = bflo(a.z); t1[5] = bfhi(a.z); t1[6] = bflo(a.w); t1[7] = bfhi(a.w);
        t2[0] = bflo(b.x); t2[1] = bfhi(b.x); t2[2] = bflo(b.y); t2[3] = bfhi(b.y); t2[4] = bflo(b.z); t2[5] = bfhi(b.z); t2[6] = bflo(b.w); t2[7] = bfhi(b.w);
        float o1[8], o2[8];
        const float inv[8] = {1.0f, 0.1939227432f, 0.0376060307f, 0.00729266461f, 0.00141421356f, 0.000274248188f, 5.31829610e-05f, 1.03133862e-05f};
#pragma unroll
        for (int j = 0; j < 8; ++j) { float sn, cs; sincos_red(pf * inv[j], sn, cs); o1[j] = t1[j] * cs - t2[j] * sn; o2[j] = t2[j] * cs + t1[j] * sn; }
        u32x4 wa, wb; wa.x = pk2(o1[0], o1[1]); wa.y = pk2(o1[2], o1[3]); wa.z = pk2(o1[4], o1[5]); wa.w = pk2(o1[6], o1[7]);
        wb.x = pk2(o2[0], o2[1]); wb.y = pk2(o2[2], o2[3]); wb.z = pk2(o2[4], o2[5]); wb.w = pk2(o2[6], o2[7]);
        *(u32x4*)p = wa; *(u32x4*)(p + 8) = wb;
    }
}

__device__ __forceinline__ void mx_gmlp(const Ctx& X, int l, int unit) {
    const int lane = X.lane, w = X.wave;
    const int row0 = unit * 128;
    LAS bf16_t* Vt = (LAS bf16_t*)X.lds;
    const bf16_t* pj = X.proj();
    const float* lng = X.in(I_GMLNG) + l * 256; const float* lnb = X.in(I_GMLNB) + l * 256;
    float g4[4], b4[4];
#pragma unroll
    for (int j = 0; j < 4; ++j) { g4[j] = lng[lane + 64 * j]; b4[j] = lnb[lane + 64 * j]; }
    for (int i = 0; i < 16; ++i) {
        const int s = w * 16 + i; const bf16_t* rp = pj + (size_t)(row0 + s) * PJ + C_GV;
        float v[4]; float sm = 0.f;
#pragma unroll
        for (int j = 0; j < 4; ++j) { v[j] = gelu_tanh(bf2f(rp[lane + 64 * j])); sm += v[j]; }
        const float mean = wave_sum(sm) * (1.0f / 256.0f); float q = 0.f;
#pragma unroll
        for (int j = 0; j < 4; ++j) { v[j] -= mean; q += v[j] * v[j]; }
        const float rstd = rsqrtf(wave_sum(q) * (1.0f / 256.0f) + LN_EPS);
#pragma unroll
        for (int j = 0; j < 4; ++j) Vt[(lane + 64 * j) * 136 + s] = (bf16_t)f2bf(v[j] * rstd * g4[j] + b4[j]);
    }
    __syncthreads();
    const int g = w >> 1, c0 = g * 64 + (w & 1) * 32, fr = lane & 15, fq = lane >> 4;
    const bf16_t* gmw = (const bf16_t*)(X.ws + WS_GMW) + (size_t)g * 128 * 128;
    const float* gmb = X.in(I_GMB) + ((size_t)l * 4 + g) * 128;
    bf16_t* ya = X.ybuf();
    for (int tt = 0; tt < 8; ++tt) {
        f32x4 acc0 = (f32x4){0.f, 0.f, 0.f, 0.f}, acc1 = acc0;
        for (int ks = 0; ks <= (tt >> 1); ++ks) {
            const bf16x8 wf = *(const bf16x8*)(gmw + (tt * 16 + fr) * 128 + ks * 32 + 8 * fq);
            const bf16x8 v0 = *(const LAS bf16x8*)(Vt + (c0 + fr) * 136 + ks * 32 + 8 * fq), v1 = *(const LAS bf16x8*)(Vt + (c0 + 16 + fr) * 136 + ks * 32 + 8 * fq);
            acc0 = mfma16(v0, wf, acc0); acc1 = mfma16(v1, wf, acc1);
        }
        const int t = tt * 16 + fr; const float bias = gmb[t];
#pragma unroll
        for (int c2 = 0; c2 < 2; ++c2) { const f32x4 a = c2 ? acc1 : acc0; const int cc = c0 + c2 * 16 + 4 * fq;
            const u32x2 uv = *(const u32x2*)(pj + (size_t)(row0 + t) * PJ + C_GU + cc);
            u32x2 o; o.x = pk2(gelu_tanh(bflo(uv.x)) * (a[0] + bias), gelu_tanh(bfhi(uv.x)) * (a[1] + bias)); o.y = pk2(gelu_tanh(bflo(uv.y)) * (a[2] + bias), gelu_tanh(bfhi(uv.y)) * (a[3] + bias));
            *(u32x2*)(ya + (size_t)(row0 + t) * 256 + cc) = o; }
    }
    __syncthreads();
}

template <int PASS>
__device__ __forceinline__ void mx_s5(const Ctx& X, int l, int wu) {
    const int lane = X.lane, fr = lane & 15, fq = lane >> 4;
    const int wgi = wu >> 3, wv = wu & 7; const int b = wgi >> 6, g = ((wgi >> 4) & 3) * 4 + (wv & 3), ch = (wgi & 15) * 2 + (wv >> 2);
    const int tb = b * SEQ + ch * 256;
    LAS float* xl = (LAS float*)(X.lds + X.wave * 16384);
    LAS bf16_t* hb = (LAS bf16_t*)(X.lds + X.wave * 16384 + 8192);
    const bf16_t* pj = X.proj();
    const bf16_t* bbT = (const bf16_t*)(X.ws + WS_S5B) + (size_t)g * 128 * 16;
    bf16x8 Bf[8];
#pragma unroll
    for (int ct = 0; ct < 8; ++ct) { Bf[ct] = (bf16x8){0, 0, 0, 0, 0, 0, 0, 0}; if (fq < 2) Bf[ct] = *(const bf16x8*)(bbT + (ct * 16 + fr) * 16 + 8 * fq); }
    const float* sa = (const float*)(X.ws + WS_S5A) + (g * 64 + lane) * 2; const float ar = sa[0], ai = sa[1];
    float hr = 0.f, hi = 0.f;
    float* st = (float*)(X.ws + WS_S5ST) + (size_t)((b * 16 + g) * 32) * 128;
    bf16x8 Cf[4]; float dsk[4];
    if (PASS == 3) {
        float pr = ar, pi = ai;
#pragma unroll
        for (int q = 0; q < 8; ++q) { const float nr = pr * pr - pi * pi, ni = 2.f * pr * pi; pr = nr; pi = ni; }
        for (int j = 0; j < ch; ++j) { const float sr = st[j * 128 + lane], si = st[j * 128 + 64 + lane]; const float nr = pr * hr - pi * hi + sr, ni = pr * hi + pi * hr + si; hr = nr; hi = ni; }
        const bf16_t* cm = (const bf16_t*)(X.ws + WS_S5C) + (size_t)g * 16 * 128;
#pragma unroll
        for (int ks = 0; ks < 4; ++ks) Cf[ks] = *(const bf16x8*)(cm + fr * 128 + ks * 32 + 8 * fq);
#pragma unroll
        for (int i = 0; i < 4; ++i) dsk[i] = X.in(I_S5D)[l * 256 + g * 16 + 4 * fq + i];
    }
    bf16_t* ycp = (bf16_t*)(X.ws + WS_YCPRE);
    for (int blk = 0; blk < 16; ++blk) {
        const int t0 = tb + blk * 16;
        bf16x8 uf = (bf16x8){0, 0, 0, 0, 0, 0, 0, 0};
        if (fq < 2) uf = *(const bf16x8*)(pj + (size_t)(t0 + fr) * PJ + C_S5 + g * 16 + 8 * fq);
#pragma unroll
        for (int ct = 0; ct < 8; ++ct) { const f32x4 a = mfma16(uf, Bf[ct], (f32x4){0.f, 0.f, 0.f, 0.f});
#pragma unroll
            for (int i = 0; i < 4; ++i) xl[(4 * fq + i) * 128 + ct * 16 + fr] = a[i]; }
#pragma unroll
        for (int t = 0; t < 16; ++t) { const float xr = xl[t * 128 + lane], xi = xl[t * 128 + 64 + lane];
            const float nr = ar * hr - ai * hi + xr, ni = ar * hi + ai * hr + xi; hr = nr; hi = ni;
            if (PASS == 3) { hb[t * 136 + lane] = (bf16_t)f2bf(hr); hb[t * 136 + 64 + lane] = (bf16_t)f2bf(hi); } }
        if (PASS == 3) {
            asm volatile("s_waitcnt lgkmcnt(0)" ::: "memory"); __builtin_amdgcn_wave_barrier();
            f32x4 acc = (f32x4){0.f, 0.f, 0.f, 0.f};
#pragma unroll
            for (int ks = 0; ks < 4; ++ks) { const bf16x8 hf = *(const LAS bf16x8*)(hb + fr * 136 + ks * 32 + 8 * fq); acc = mfma16(Cf[ks], hf, acc); }
            const u32x2 uv = *(const u32x2*)(pj + (size_t)(t0 + fr) * PJ + C_S5 + g * 16 + 4 * fq);
            const float y0 = gelu_tanh(acc[0] + dsk[0] * bflo(uv.x)), y1 = gelu_tanh(acc[1] + dsk[1] * bfhi(uv.x)), y2 = gelu_tanh(acc[2] + dsk[2] * bflo(uv.y)), y3 = gelu_tanh(acc[3] + dsk[3] * bfhi(uv.y));
            u32x2 o; o.x = pk2(y0, y1); o.y = pk2(y2, y3);
            *(u32x2*)(ycp + (size_t)(t0 + fr) * 256 + g * 16 + 4 * fq) = o;
        }
    }
    if (PASS == 1) { st[ch * 128 + lane] = hr; st[ch * 128 + 64 + lane] = hi; }
}

constexpr int SD_CM = 0, SD_BM = 18432, SD_BT = 36864, SD_XT0 = 54272, SD_XT1 = 71680, SD_MM = 89088, SD_SIN0 = 123904, SD_SIN1 = 133120, SD_DT = 142336, SD_AC = 143360, SD_END = 144384;
static_assert(SD_END <= LDS_MISC, "ssd lds");
template <int PASS>
__device__ __forceinline__ void mx_ssd(const Ctx& X, int l, int unit) {
    const int tid = X.tid, lane = X.lane, w = X.wave, fr = lane & 15, fq = lane >> 4;
    const int b = unit >> 6, c = unit & 63; const int r0 = unit * 128;
    const bf16_t* pj = X.proj();
    LAS bf16_t* Cm = (LAS bf16_t*)(X.lds + SD_CM); LAS bf16_t* Bm = (LAS bf16_t*)(X.lds + SD_BM); LAS bf16_t* Bt = (LAS bf16_t*)(X.lds + SD_BT);
    LAS bf16_t* Mm = (LAS bf16_t*)(X.lds + SD_MM);
    LAS float* dtv = (LAS float*)(X.lds + SD_DT); LAS float* acm = (LAS float*)(X.lds + SD_AC);
    const float* convw = X.in(I_CONVW) + (size_t)l * 4 * 512; const float* convb = X.in(I_CONVB) + (size_t)l * 512;
    float* sst = (float*)(X.ws + WS_SSDST); float* atot = (float*)(X.ws + WS_ATOT);
    for (int g = 0; g < 2; ++g) {
        if (tid < 256) { const int j = tid >> 7, rl = tid & 127, h = 2 * g + j;
            const float raw = bf2f(pj[(size_t)(r0 + rl) * PJ + C_DT + h]) + X.in(I_DTBIAS)[l * 4 + h];
            const float dt = softplusf_(raw); dtv[j * 128 + rl] = dt; acm[j * 128 + rl] = -expf(X.in(I_ALOG)[l * 4 + h]) * dt; }
        __syncthreads();
        float cum = 0.f;
        if (tid < 256) { const int j = tid >> 7, rl = tid & 127; for (int k = 0; k <= rl; ++k) cum += acm[j * 128 + k]; }
        __syncthreads();
        if (tid < 256) acm[tid] = cum;
        __syncthreads();
        if (PASS == 1 && tid < 2) atot[(b * 64 + c) * 32 + 2 * g + tid] = acm[tid * 128 + 127];
        constexpr int NCG = (PASS == 1) ? 24 : 32;
        for (int it = tid; it < NCG * 128; it += 512) {
            const int rl = it & 127, cg = it >> 7;
            const int chn = (cg < 16) ? g * 128 + cg * 8 : (cg < 24) ? 256 + g * 64 + (cg - 16) * 8 : 384 + g * 64 + (cg - 24) * 8;
            float a8[8];
            { const f32x4 c0 = *(const f32x4*)(convb + chn), c1 = *(const f32x4*)(convb + chn + 4); a8[0] = c0[0]; a8[1] = c0[1]; a8[2] = c0[2]; a8[3] = c0[3]; a8[4] = c1[0]; a8[5] = c1[1]; a8[6] = c1[2]; a8[7] = c1[3]; }
#pragma unroll
            for (int k = 0; k < 4; ++k) { const int sq = c * 128 + rl - 3 + k;
                if (sq >= 0) { const u32x4 xv = *(const u32x4*)(pj + (size_t)(b * SEQ + sq) * PJ + C_XBC + chn);
                    const f32x4 w0 = *(const f32x4*)(convw + k * 512 + chn), w1 = *(const f32x4*)(convw + k * 512 + chn + 4);
                    a8[0] += w0[0] * bflo(xv.x); a8[1] += w0[1] * bfhi(xv.x); a8[2] += w0[2] * bflo(xv.y); a8[3] += w0[3] * bfhi(xv.y);
                    a8[4] += w1[0] * bflo(xv.z); a8[5] += w1[1] * bfhi(xv.z); a8[6] += w1[2] * bflo(xv.w); a8[7] += w1[3] * bfhi(xv.w); } }
#pragma unroll
            for (int q = 0; q < 8; ++q) a8[q] = siluf_(a8[q]);
            if (cg < 16) { const int j = cg >> 3, p0 = (cg & 7) * 8; LAS bf16_t* Xt = (LAS bf16_t*)(X.lds + (j ? SD_XT1 : SD_XT0));
                float sc = 1.0f; if (PASS == 1) sc = __expf(acm[j * 128 + 127] - acm[j * 128 + rl]) * dtv[j * 128 + rl];
#pragma unroll
                for (int q = 0; q < 8; ++q) Xt[(p0 + q) * 136 + rl] = (bf16_t)f2bf(a8[q] * sc); }
            else if (cg < 24) { const int n0 = (cg - 16) * 8;
                if (PASS == 1) {
#pragma unroll
                    for (int q = 0; q < 8; ++q) Bt[(n0 + q) * 136 + rl] = (bf16_t)f2bf(a8[q]); }
                else { u32x4 o; o.x = pk2(a8[0], a8[1]); o.y = pk2(a8[2], a8[3]); o.z = pk2(a8[4], a8[5]); o.w = pk2(a8[6], a8[7]); *(LAS u32x4*)(Bm + rl * 72 + n0) = o; } }
            else { const int n0 = (cg - 24) * 8; u32x4 o; o.x = pk2(a8[0], a8[1]); o.y = pk2(a8[2], a8[3]); o.z = pk2(a8[4], a8[5]); o.w = pk2(a8[6], a8[7]); *(LAS u32x4*)(Cm + rl * 72 + n0) = o; }
        }
        if (PASS == 3) {
            float s0[8], s1[8];
#pragma unroll
            for (int q = 0; q < 8; ++q) { s0[q] = 0.f; s1[q] = 0.f; }
            for (int cc = 0; cc < c; ++cc) { const float* sp = sst + ((size_t)((b * 64 + cc) * 4 + 2 * g) * 4096) + tid * 8;
                const float d0 = __expf(atot[(b * 64 + cc) * 32 + 2 * g]), d1 = __expf(atot[(b * 64 + cc) * 32 + 2 * g + 1]);
                const f32x4 a0 = *(const f32x4*)sp, a1 = *(const f32x4*)(sp + 4), b0 = *(const f32x4*)(sp + 4096), b1 = *(const f32x4*)(sp + 4100);
#pragma unroll
                for (int q = 0; q < 4; ++q) { s0[q] = d0 * s0[q] + a0[q]; s0[4 + q] = d0 * s0[4 + q] + a1[q]; s1[q] = d1 * s1[q] + b0[q]; s1[4 + q] = d1 * s1[4 + q] + b1[q]; } }
            const int p = tid >> 3, n0 = (tid & 7) * 8;
            u32x4 o; o.x = pk2(s0[0], s0[1]); o.y = pk2(s0[2], s0[3]); o.z = pk2(s0[4], s0[5]); o.w = pk2(s0[6], s0[7]); *(LAS u32x4*)((LAS bf16_t*)(X.lds + SD_SIN0) + p * 72 + n0) = o;
            o.x = pk2(s1[0], s1[1]); o.y = pk2(s1[2], s1[3]); o.z = pk2(s1[4], s1[5]); o.w = pk2(s1[6], s1[7]); *(LAS u32x4*)((LAS bf16_t*)(X.lds + SD_SIN1) + p * 72 + n0) = o;
        }
        __syncthreads();
        if (PASS == 1) {
            const int j = w >> 2, pt = w & 3; const LAS bf16_t* Xt = (const LAS bf16_t*)(X.lds + (j ? SD_XT1 : SD_XT0));
            f32x4 acc[4];
#pragma unroll
            for (int nt = 0; nt < 4; ++nt) acc[nt] = (f32x4){0.f, 0.f, 0.f, 0.f};
#pragma unroll
            for (int ks = 0; ks < 4; ++ks) { const bf16x8 xf = *(const LAS bf16x8*)(Xt + (pt * 16 + fr) * 136 + ks * 32 + 8 * fq);
#pragma unroll
                for (int nt = 0; nt < 4; ++nt) { const bf16x8 bf = *(const LAS bf16x8*)(Bt + (nt * 16 + fr) * 136 + ks * 32 + 8 * fq); acc[nt] = mfma16(xf, bf, acc[nt]); } }
            float* sp = sst + (size_t)((b * 64 + c) * 4 + 2 * g + j) * 4096;
#pragma unroll
            for (int nt = 0; nt < 4; ++nt)
#pragma unroll
                for (int i = 0; i < 4; ++i) sp[(pt * 16 + 4 * fq + i) * 64 + nt * 16 + fr] = acc[nt][i];
        } else {
            const int lrow = w * 16 + fr;
            float yv[2][4][4];
#pragma unroll
            for (int j = 0; j < 2; ++j) {
                const LAS bf16_t* Xt = (const LAS bf16_t*)(X.lds + (j ? SD_XT1 : SD_XT0)); const LAS bf16_t* Sin = (const LAS bf16_t*)(X.lds + (j ? SD_SIN1 : SD_SIN0));
                const float al = acm[j * 128 + lrow];
                const bf16x8 cf0 = *(const LAS bf16x8*)(Cm + lrow * 72 + 8 * fq), cf1 = *(const LAS bf16x8*)(Cm + lrow * 72 + 32 + 8 * fq);
                const int stmax = w | 1;
                for (int st = 0; st <= stmax; ++st) {
                    f32x4 ag = (f32x4){0.f, 0.f, 0.f, 0.f};
                    if (st <= w) { const bf16x8 b0 = *(const LAS bf16x8*)(Bm + (st * 16 + fr) * 72 + 8 * fq), b1 = *(const LAS bf16x8*)(Bm + (st * 16 + fr) * 72 + 32 + 8 * fq);
                        ag = mfma16(b0, cf0, ag); ag = mfma16(b1, cf1, ag); }
                    float mv[4];
#pragma unroll
                    for (int i = 0; i < 4; ++i) { const int s = st * 16 + 4 * fq + i; mv[i] = (s <= lrow) ? ag[i] * __expf(al - acm[j * 128 + s]) * dtv[j * 128 + s] : 0.f; }
                    u32x2 o; o.x = pk2(mv[0], mv[1]); o.y = pk2(mv[2], mv[3]); *(LAS u32x2*)(Mm + lrow * 136 + st * 16 + 4 * fq) = o;
                }
                const float eal = __expf(al); const float dsk = X.in(I_SSDD)[l * 4 + 2 * g + j];
#pragma unroll
                for (int pt = 0; pt < 4; ++pt) {
                    f32x4 ad = (f32x4){0.f, 0.f, 0.f, 0.f}, ao = ad;
                    for (int ks = 0; ks <= (w >> 1); ++ks) { const bf16x8 xf = *(const LAS bf16x8*)(Xt + (pt * 16 + fr) * 136 + ks * 32 + 8 * fq), mf = *(const LAS bf16x8*)(Mm + lrow * 136 + ks * 32 + 8 * fq); ad = mfma16(xf, mf, ad); }
                    { const bf16x8 s0 = *(const LAS bf16x8*)(Sin + (pt * 16 + fr) * 72 + 8 * fq), s1 = *(const LAS bf16x8*)(Sin + (pt * 16 + fr) * 72 + 32 + 8 * fq); ao = mfma16(s0, cf0, ao); ao = mfma16(s1, cf1, ao); }
                    const int h = 2 * g + j; const u32x2 zv = *(const u32x2*)(pj + (size_t)(r0 + lrow) * PJ + C_Z + h * 64 + pt * 16 + 4 * fq);
                    const float z4[4] = {bflo(zv.x), bfhi(zv.x), bflo(zv.y), bfhi(zv.y)};
#pragma unroll
                    for (int i = 0; i < 4; ++i) { const float xs = bf2f(Xt[(pt * 16 + 4 * fq + i) * 136 + lrow]); yv[j][pt][i] = (ad[i] + eal * ao[i] + dsk * xs) * siluf_(z4[i]); }
                }
            }
            float ss = 0.f;
#pragma unroll
            for (int j = 0; j < 2; ++j)
#pragma unroll
                for (int pt = 0; pt < 4; ++pt)
#pragma unroll
                    for (int i = 0; i < 4; ++i) ss += yv[j][pt][i] * yv[j][pt][i];
            ss += __shfl_xor(ss, 16); ss += __shfl_xor(ss, 32);
            const float rs = rsqrtf(ss * (1.0f / 128.0f) + RMS_EPS);
            const float* ng = X.in(I_SSDNG) + l * 256 + g * 128; bf16_t* yd = X.ybuf() + (size_t)3 * M * 256;
#pragma unroll
            for (int j = 0; j < 2; ++j)
#pragma unroll
                for (int pt = 0; pt < 4; ++pt) { const int cc = j * 64 + pt * 16 + 4 * fq; const f32x4 gv = *(const f32x4*)(ng + cc);
                    u32x2 o; o.x = pk2(yv[j][pt][0] * rs * gv[0], yv[j][pt][1] * rs * gv[1]); o.y = pk2(yv[j][pt][2] * rs * gv[2], yv[j][pt][3] * rs * gv[3]);
                    *(u32x2*)(yd + (size_t)(r0 + lrow) * 256 + g * 128 + cc) = o; }
        }
        __syncthreads();
    }
}

__device__ __forceinline__ unsigned ord16(float s) { const _Float16 hf = (_Float16)s; const unsigned bits = (unsigned)__builtin_bit_cast(unsigned short, hf); return bits ^ ((bits & 0x8000u) ? 0xFFFFu : 0x8000u); }
__device__ __forceinline__ int cnt_ge8(const u32x4 v, unsigned c) {
    int n = 0;
    n += ((v.x & 0xFFFFu) >= c) + ((v.x >> 16) >= c); n += ((v.y & 0xFFFFu) >= c) + ((v.y >> 16) >= c);
    n += ((v.z & 0xFFFFu) >= c) + ((v.z >> 16) >= c); n += ((v.w & 0xFFFFu) >= c) + ((v.w >> 16) >= c);
    return n;
}
__device__ __forceinline__ void mx_dsa(const Ctx& X, int b, int t0) {
    const int tid = X.tid, lane = X.lane, w = X.wave, fr = lane & 15, fq = lane >> 4;
    const bf16_t* pj = X.proj(); const size_t rb = (size_t)b * SEQ;
    LAS unsigned short* sc = (LAS unsigned short*)X.lds;
    const int nk = t0 + 8, nkt = (nk + 15) >> 4;
    bf16x8 qf[2][2]; float wq[2];
#pragma unroll
    for (int ct = 0; ct < 2; ++ct) { const int q = 4 * ct + (fr >> 2), hh = fr & 3; const bf16_t* qp = pj + (rb + t0 + q) * PJ;
        qf[ct][0] = *(const bf16x8*)(qp + C_QI + hh * 64 + 8 * fq); qf[ct][1] = *(const bf16x8*)(qp + C_QI + hh * 64 + 32 + 8 * fq); wq[ct] = bf2f(qp[C_WI + hh]) * 0.0625f; }
    for (int kt = w; kt < nkt; kt += 8) {
        const bf16_t* kp = pj + (rb + kt * 16 + fr) * PJ + C_KI;
        const bf16x8 k0 = *(const bf16x8*)(kp + 8 * fq), k1 = *(const bf16x8*)(kp + 32 + 8 * fq);
#pragma unroll
        for (int ct = 0; ct < 2; ++ct) {
            f32x4 a = mfma16(k0, qf[ct][0], (f32x4){0.f, 0.f, 0.f, 0.f}); a = mfma16(k1, qf[ct][1], a);
            const int q = 4 * ct + (fr >> 2); unsigned kk[4];
#pragma unroll
            for (int i = 0; i < 4; ++i) { float s = fmaxf(a[i], 0.f) * wq[ct]; s += __shfl_xor(s, 1); s += __shfl_xor(s, 2); s += 0.0f;
                const int key = kt * 16 + 4 * fq + i; kk[i] = (key <= t0 + q) ? ord16(s) : 0u; }
            if ((fr & 3) == 0) { u32x2 o; o.x = kk[0] | (kk[1] << 16); o.y = kk[2] | (kk[3] << 16); *(LAS u32x2*)(sc + q * 8192 + kt * 16 + 4 * fq) = o; }
        }
    }
    { const int z0 = nkt * 16, z1 = ((nk + 511) >> 9) << 9;
        for (int i = z0 + tid; i < z1; i += 512) {
#pragma unroll
            for (int q = 0; q < 8; ++q) sc[q * 8192 + i] = 0; } }
    __syncthreads();
    const int t = t0 + w, nv = t + 1;
    LAS unsigned short* row = sc + w * 8192;
    LAS unsigned short* list = (LAS unsigned short*)(X.lds + 131072 + w * 512);
    const int nsel = nv < 256 ? nv : 256;
    if (nv <= 256) { for (int n = lane; n < 256; n += 64) list[n] = (unsigned short)n; }
    else {
        const int nit = (nv + 511) >> 9;
        unsigned thr = 0u; int cge = nv;
        for (int bit = 15; bit >= 0; --bit) { const unsigned cand = thr | (1u << bit); int n = 0;
            for (int it = 0; it < nit; ++it) n += cnt_ge8(*(const LAS u32x4*)(row + (it * 64 + lane) * 8), cand);
            n = wave_sum_i(n); if (n >= 256) { thr = cand; cge = n; } }
        int cgt = 0;
        { const unsigned cand = thr + 1u; int n = 0; for (int it = 0; it < nit; ++it) n += cnt_ge8(*(const LAS u32x4*)(row + (it * 64 + lane) * 8), cand); cgt = wave_sum_i(n); }
        const int r = 256 - cgt, ties = cge - cgt;
        const unsigned cmin = (ties == r) ? thr : thr + 1u;
        const unsigned long long lt_mask = (1ull << lane) - 1ull; int bcnt = 0;
        for (int it = 0; it < nit; ++it) { const u32x4 v = *(const LAS u32x4*)(row + (it * 64 + lane) * 8); const int base = (it * 64 + lane) * 8;
            const unsigned e[8] = {v.x & 0xFFFFu, v.x >> 16, v.y & 0xFFFFu, v.y >> 16, v.z & 0xFFFFu, v.z >> 16, v.w & 0xFFFFu, v.w >> 16};
#pragma unroll
            for (int j = 0; j < 8; ++j) { const bool sl = e[j] >= cmin; const unsigned long long bm = __ballot(sl);
                if (sl) list[(bcnt + __popcll(bm & lt_mask)) & 255] = (unsigned short)(base + j); bcnt += __popcll(bm); } }
        if (ties != r) {
            int taken = 0;
            for (int it = 0; it < nit && taken < r; ++it) { const u32x4 v = *(const LAS u32x4*)(row + (it * 64 + lane) * 8); const int base = (it * 64 + lane) * 8;
                const unsigned e[8] = {v.x & 0xFFFFu, v.x >> 16, v.y & 0xFFFFu, v.y >> 16, v.z & 0xFFFFu, v.z >> 16, v.w & 0xFFFFu, v.w >> 16};
                int mcount = 0;
#pragma unroll
                for (int j = 0; j < 8; ++j) mcount += (e[j] == thr);
                int incl = mcount;
#pragma unroll
                for (int o = 1; o < 64; o <<= 1) { const int up = __shfl_up(incl, o); if (lane >= o) incl += up; }
                const int total = __shfl(incl, 63); int rk = taken + incl - mcount;
#pragma unroll
                for (int j = 0; j < 8; ++j) if (e[j] == thr) { if (rk < r) list[cgt + rk] = (unsigned short)(base + j); ++rk; }
                taken += total; }
        }
    }
    __builtin_amdgcn_fence(__ATOMIC_RELEASE, "workgroup"); __builtin_amdgcn_wave_barrier();
    const bf16_t* qrow = pj + (rb + t) * PJ;
    bf16x8 qb0 = (bf16x8){0, 0, 0, 0, 0, 0, 0, 0}, qb1 = qb0;
    if (fr < 4) { qb0 = *(const bf16x8*)(qrow + C_Q + fr * 64 + 8 * fq); qb1 = *(const bf16x8*)(qrow + C_Q + fr * 64 + 32 + 8 * fq); }
    LAS float* Pb = (LAS float*)row;
    LAS float* pinv = (LAS float*)(X.lds + 131072 + 4096 + 256 + w * 16);
#pragma unroll 2
    for (int tile = 0; tile < 16; ++tile) {
        const int n = tile * 16 + fr; const int idx = (n < nsel) ? (int)list[n] : 0;
        const bf16_t* kp = pj + (rb + idx) * PJ + C_K;
        const bf16x8 k0 = *(const bf16x8*)(kp + 8 * fq), k1 = *(const bf16x8*)(kp + 32 + 8 * fq);
        f32x4 a = mfma16(k0, qb0, (f32x4){0.f, 0.f, 0.f, 0.f}); a = mfma16(k1, qb1, a);
        if (fr < 4) {
#pragma unroll
            for (int i = 0; i < 4; ++i) { const int nn = tile * 16 + 4 * fq + i; Pb[nn * 4 + fr] = (nn < nsel) ? a[i] * 0.125f : -3.0e38f; } }
    }
    __builtin_amdgcn_fence(__ATOMIC_RELEASE, "workgroup"); __builtin_amdgcn_wave_barrier();
    { const int hd = lane & 3, nb0 = lane >> 2;
        float v16[16]; float mx = -3.0e38f;
#pragma unroll
        for (int j = 0; j < 16; ++j) { v16[j] = Pb[(nb0 + 16 * j) * 4 + hd]; mx = fmaxf(mx, v16[j]); }
        mx = fmaxf(mx, __shfl_xor(mx, 4)); mx = fmaxf(mx, __shfl_xor(mx, 8)); mx = fmaxf(mx, __shfl_xor(mx, 16)); mx = fmaxf(mx, __shfl_xor(mx, 32));
        float sm = 0.f;
#pragma unroll
        for (int j = 0; j < 16; ++j) { const float p = (v16[j] > -1.0e38f) ? __expf(v16[j] - mx) : 0.f; sm += p; Pb[(nb0 + 16 * j) * 4 + hd] = p; }
        sm += __shfl_xor(sm, 4); sm += __shfl_xor(sm, 8); sm += __shfl_xor(sm, 16); sm += __shfl_xor(sm, 32);
        if (lane < 4) pinv[lane] = 1.0f / sm; }
    __builtin_amdgcn_fence(__ATOMIC_RELEASE, "workgroup"); __builtin_amdgcn_wave_barrier();
    float o4[4][4];
#pragma unroll
    for (int h = 0; h < 4; ++h)
#pragma unroll
        for (int dd = 0; dd < 4; ++dd) o4[h][dd] = 0.f;
    const int d4 = fr * 4;
    for (int n0 = 0; n0 < nsel; n0 += 4) { const int n = n0 + fq;
        if (n < nsel) { const int idx = (int)list[n]; const u32x2 vv = *(const u32x2*)(pj + (rb + idx) * PJ + C_V + d4); const f32x4 p4 = *(const LAS f32x4*)(Pb + n * 4);
            const float v0 = bflo(vv.x), v1 = bfhi(vv.x), v2 = bflo(vv.y), v3 = bfhi(vv.y);
#pragma unroll
            for (int h = 0; h < 4; ++h) { o4[h][0] += p4[h] * v0; o4[h][1] += p4[h] * v1; o4[h][2] += p4[h] * v2; o4[h][3] += p4[h] * v3; } } }
#pragma unroll
    for (int h = 0; h < 4; ++h)
#pragma unroll
        for (int dd = 0; dd < 4; ++dd) { float v = o4[h][dd]; v += __shfl_xor(v, 16); v += __shfl_xor(v, 32); o4[h][dd] = v; }
    { const int h = fq; const float iv = pinv[h];
        float r4[4];
#pragma unroll
        for (int dd = 0; dd < 4; ++dd) r4[dd] = ((h == 0) ? o4[0][dd] : (h == 1) ? o4[1][dd] : (h == 2) ? o4[2][dd] : o4[3][dd]) * iv;
        u32x2 o; o.x = pk2(r4[0], r4[1]); o.y = pk2(r4[2], r4[3]);
        *(u32x2*)(X.ybuf() + (size_t)1 * M * 256 + (rb + t) * 256 + h * 64 + d4) = o; }
    __syncthreads();
}

__device__ __forceinline__ void ph_ln1_router(const Ctx& X, int l) {
    const int lane = X.lane, w = X.wave, tid = X.tid;
    LAS float* rw = (LAS float*)X.lds;
    LAS float* hrow = (LAS float*)(X.lds + 131072 + w * 2048);
    LAS unsigned* wgcnt = (LAS unsigned*)(X.lds + 131072 + 16384);
    { const float* src = X.in(I_RW) + (size_t)l * D * NEXP; for (int i = tid; i < D * NEXP / 4; i += 512) *(LAS f32x4*)(rw + 4 * i) = *(const f32x4*)(src + 4 * i); }
    if (tid < 32) wgcnt[tid] = 0u;
    __syncthreads();
    float* xo = X.a->out; bf16_t* hb = X.hbuf();
    const int tok0 = X.c * 128, b = tok0 >> 13;
    const float* mv = X.modv(l, 1) + b * 3072;
    const float* lg = X.in(I_LN1G) + l * D; const float* lb = X.in(I_LN1B) + l * D;
    const int e = lane & 31, half = lane >> 5;
    const float rbias = X.in(I_RB)[l * NEXP + e];
    unsigned* pinfo = (unsigned*)(X.ws + WS_PINFO); float* pgate = (float*)(X.ws + WS_PGATE);
    for (int i = 0; i < 16; ++i) {
        const int tok = tok0 + w * 16 + i;
        f32x4 v[4]; float s = 0.f;
#pragma unroll
        for (int j = 0; j < 4; ++j) { v[j] = *(const f32x4*)(xo + (size_t)tok * D + 4 * lane + 256 * j); s += (v[j][0] + v[j][1]) + (v[j][2] + v[j][3]); }
        const float mean = wave_sum(s) * (1.0f / D); float q = 0.f;
#pragma unroll
        for (int j = 0; j < 4; ++j) { v[j] = v[j] - mean; q += (v[j][0] * v[j][0] + v[j][1] * v[j][1]) + (v[j][2] * v[j][2] + v[j][3] * v[j][3]); }
        const float rstd = rsqrtf(wave_sum(q) * (1.0f / D) + LN_EPS);
        f32x4 hv[4];
#pragma unroll
        for (int j = 0; j < 4; ++j) { const int col = 4 * lane + 256 * j;
            const f32x4 x1 = v[j] * rstd * *(const f32x4*)(lg + col) + *(const f32x4*)(lb + col);
            *(f32x4*)(xo + (size_t)tok * D + col) = x1 * DN_ALPHA;
            hv[j] = x1 * (*(const f32x4*)(mv + 1024 + col) + 1.0f) + *(const f32x4*)(mv + col);
            u32x2 o; o.x = pk2(hv[j][0], hv[j][1]); o.y = pk2(hv[j][2], hv[j][3]); *(u32x2*)(hb + (size_t)tok * D + col) = o; }
        float accr = 0.f;
#pragma unroll
        for (int blk = 0; blk < 2; ++blk) {
            *(LAS f32x4*)(hrow + 4 * lane) = hv[2 * blk]; *(LAS f32x4*)(hrow + 256 + 4 * lane) = hv[2 * blk + 1];
            __builtin_amdgcn_fence(__ATOMIC_RELEASE, "workgroup"); __builtin_amdgcn_wave_barrier();
            const LAS float* hp = hrow + half * 256; const LAS float* rp = rw + (size_t)(blk * 512 + half * 256) * 32 + e;
#pragma unroll 8
            for (int d = 0; d < 256; d += 4) { const f32x4 h4 = *(const LAS f32x4*)(hp + d);
                accr += h4[0] * rp[(d + 0) * 32]; accr += h4[1] * rp[(d + 1) * 32]; accr += h4[2] * rp[(d + 2) * 32]; accr += h4[3] * rp[(d + 3) * 32]; }
            __builtin_amdgcn_fence(__ATOMIC_RELEASE, "workgroup"); __builtin_amdgcn_wave_barrier();
        }
        accr += __shfl_xor(accr, 32);
        const float score = sigmoidf_(accr), biased = score + rbias;
        const int gbase = lane & ~3;
        const float v0 = __shfl(biased, gbase), v1 = __shfl(biased, gbase + 1), v2 = __shfl(biased, gbase + 2), v3 = __shfl(biased, gbase + 3);
        const float a_ = fmaxf(v0, v1), b_ = fminf(v0, v1), c_ = fmaxf(v2, v3), d_ = fminf(v2, v3);
        const float gs = fmaxf(a_, c_) + fmaxf(fminf(a_, c_), fmaxf(b_, d_));
        const int myg = e >> 2; int grank = 0;
#pragma unroll
        for (int g2 = 0; g2 < 8; ++g2) { const float o = __shfl(gs, 4 * g2); grank += (o > gs || (o == gs && g2 < myg)) ? 1 : 0; }
        const float masked = (grank < 4) ? biased : -3.0e38f;
        int erank = 0;
#pragma unroll
        for (int e2 = 0; e2 < 32; ++e2) { const float o = __shfl(masked, e2); erank += (o > masked || (o == masked && e2 < e)) ? 1 : 0; }
        const bool sel = (erank < 8) && (lane < 32);
        const float wsum = wave_sum(sel ? score : 0.f);
        const float gate = score / wsum * 2.5f;
        const unsigned long long bal = __ballot(sel);
        if (sel) { const int k = __popcll(bal & ((1ull << lane) - 1ull));
            const unsigned lr = __hip_atomic_fetch_add(wgcnt + e, 1u, __ATOMIC_RELAXED, __HIP_MEMORY_SCOPE_WORKGROUP);
            pinfo[(size_t)tok * 8 + k] = (unsigned)e | (lr << 8); pgate[(size_t)tok * 8 + k] = gate; }
    }
    __syncthreads();
    if (tid < 32) { const int chunk = tok0 / CHTOK; unsigned* cnt = (unsigned*)(X.ws + WS_CTL) + CW_CNT + (l * NCH + chunk) * 64;
        const unsigned base = __hip_atomic_fetch_add(cnt + tid, wgcnt[tid], __ATOMIC_RELAXED, __HIP_MEMORY_SCOPE_AGENT);
        ((unsigned*)(X.ws + WS_WGBASE))[X.c * 32 + tid] = base; }
    __syncthreads();
}

__device__ __forceinline__ void moe_offsets(const Ctx& X, int l, int chunk, LAS int* off  , LAS int* cntl  ) {
    if (X.tid == 0) { const unsigned* cnt = (const unsigned*)(X.ws + WS_CTL) + CW_CNT + (l * NCH + chunk) * 64; int o = 0;
        for (int e = 0; e < NE1; ++e) { const int cn = (e < NEXP) ? (int)__hip_atomic_load(cnt + e, __ATOMIC_RELAXED, __HIP_MEMORY_SCOPE_AGENT) : CHTOK; off[e] = o; cntl[e] = cn; o += ((cn + 255) >> 8) << 8; }
        off[NE1] = o; }
    __syncthreads();
}
#define ST_WT(p, v) __hip_atomic_store((p), (v), __ATOMIC_RELAXED, __HIP_MEMORY_SCOPE_AGENT)
__device__ __forceinline__ void ph_fill(const Ctx& X, int l) {
    LAS int* off = (LAS int*)(X.lds); LAS int* cntl = off + 64;
    const int tok0 = X.c * 128, chunk = tok0 / CHTOK;
    moe_offsets(X, l, chunk, off, cntl);
    unsigned* rowtok = (unsigned*)(X.ws + WS_ROWTOK) + (size_t)chunk * CH_ROWS; float* rowgate = (float*)(X.ws + WS_ROWGATE) + (size_t)chunk * CH_ROWS;
    const unsigned* pinfo = (const unsigned*)(X.ws + WS_PINFO); const float* pgate = (const float*)(X.ws + WS_PGATE); unsigned* slot = (unsigned*)(X.ws + WS_SLOT);
    const unsigned* wgb = (const unsigned*)(X.ws + WS_WGBASE) + X.c * 32;
    for (int i = X.tid; i < 1024; i += 512) { const size_t pi = (size_t)tok0 * 8 + i; const unsigned inf = pinfo[pi]; const int e = inf & 255, lr = inf >> 8;
        const int pos = off[e] + (int)wgb[e] + lr; ST_WT(rowtok + pos, (unsigned)(tok0 + (i >> 3))); ST_WT((unsigned*)rowgate + pos, __builtin_bit_cast(unsigned, pgate[pi])); slot[pi] = (unsigned)pos; }
    if (X.tid < 128) { const int tok = tok0 + X.tid; const int pos = off[NEXP] + (tok - chunk * CHTOK); ST_WT(rowtok + pos, (unsigned)tok); ST_WT((unsigned*)rowgate + pos, __builtin_bit_cast(unsigned, 1.0f)); }
    const int wl = X.c & 63;
    if (wl < NEXP) { const int e = wl; const int p0 = off[e] + cntl[e], p1 = off[e + 1]; for (int p = p0 + X.tid; p < p1; p += 512) { ST_WT(rowtok + p, (unsigned)(chunk * CHTOK)); ST_WT((unsigned*)rowgate + p, 0u); } }
    __syncthreads();
}

template <int NT, bool GATH>
struct MoeOrder {
    static constexpr bool GATHER = GATH;
    int nwg, G, c; const LAS unsigned char* tile_e; const LAS int* rowtab;
    __device__ __forceinline__ bool next(int i, pg8::Unit& u) const {
        const long L = (long)i * G + c; if (L >= nwg) return false;
        const int wgid = pg8::xcd_remap((int)L, nwg); const int tau = wgid / NT, pn = wgid % NT;
        u.pm = tau; u.pn = pn; u.bt = (int)tile_e[tau] * NT + pn; u.ab = i; return true;
    }
    __device__ __forceinline__ int row_of(const pg8::Unit& u, int r) const { return rowtab[u.ab * 256 + r]; }
    __device__ __forceinline__ void a_ready(const pg8::Unit&) const {}
    __device__ __forceinline__ void done(const pg8::Unit&) const {}
};
__device__ __forceinline__ int moe_tiles(const Ctx& X, int l, int chunk, LAS unsigned char* tile_e, LAS int* off, LAS int* cntl) {
    moe_offsets(X, l, chunk, off, cntl);
    const int ntile = off[NE1] >> 8;
    for (int t = X.tid; t < ntile; t += 512) { int e = 0; for (int q = 1; q < NE1; ++q) e += (off[q] <= t * 256) ? 1 : 0; tile_e[t] = (unsigned char)e; }
    __syncthreads();
    return ntile;
}

__device__ __forceinline__ void ph_combine(const Ctx& X, int l, int chunk, LAS int* off) {
    const int lane = X.lane; const int gw = X.c * 8 + X.wave;
    float* xo = X.a->out; bf16_t* hb = X.hbuf();
    const bf16_t* op = (const bf16_t*)(X.ws + WS_OPAIR); const unsigned* slot = (const unsigned*)(X.ws + WS_SLOT);
    const int b = (chunk * CHTOK) >> 13; const float* mv2 = X.modv(l, 1) + b * 3072;
    const float* lg = X.in(I_LN2G) + l * D; const float* lb = X.in(I_LN2B) + l * D;
    const int offsh = off[NEXP];
    for (int i = 0; i < 4; ++i) {
        const int tok = chunk * CHTOK + gw * 4 + i;
        f32x4 sm[4];
#pragma unroll
        for (int j = 0; j < 4; ++j) sm[j] = (f32x4){0.f, 0.f, 0.f, 0.f};
#pragma unroll
        for (int k = 0; k < 9; ++k) { const int pos = (k < 8) ? (int)slot[(size_t)tok * 8 + k] : offsh + (tok - chunk * CHTOK);
            const bf16_t* rp = op + (size_t)pos * 1024 + 4 * lane;
#pragma unroll
            for (int j = 0; j < 4; ++j) { const u32x2 q = *(const u32x2*)(rp + 256 * j); sm[j][0] += bflo(q.x); sm[j][1] += bfhi(q.x); sm[j][2] += bflo(q.y); sm[j][3] += bfhi(q.y); } }
        f32x4 v[4]; float s = 0.f;
#pragma unroll
        for (int j = 0; j < 4; ++j) { const int col = 4 * lane + 256 * j; v[j] = *(const f32x4*)(xo + (size_t)tok * D + col) + (*(const f32x4*)(mv2 + 2048 + col) + 1.0f) * sm[j]; s += (v[j][0] + v[j][1]) + (v[j][2] + v[j][3]); }
        const float mean = wave_sum(s) * (1.0f / D); float q = 0.f;
#pragma unroll
        for (int j = 0; j < 4; ++j) { v[j] = v[j] - mean; q += (v[j][0] * v[j][0] + v[j][1] * v[j][1]) + (v[j][2] * v[j][2] + v[j][3] * v[j][3]); }
        const float rstd = rsqrtf(wave_sum(q) * (1.0f / D) + LN_EPS);
#pragma unroll
        for (int j = 0; j < 4; ++j) { const int col = 4 * lane + 256 * j;
            const f32x4 x2 = v[j] * rstd * *(const f32x4*)(lg + col) + *(const f32x4*)(lb + col);
            *(f32x4*)(xo + (size_t)tok * D + col) = x2;
            if (l + 1 < DEPTH) { const float* mv1 = X.modv(l + 1, 0) + b * 3072; const f32x4 hn = x2 * (*(const f32x4*)(mv1 + 1024 + col) + 1.0f) + *(const f32x4*)(mv1 + col);
                u32x2 o; o.x = pk2(hn[0], hn[1]); o.y = pk2(hn[2], hn[3]); *(u32x2*)(hb + (size_t)tok * D + col) = o; } }
    }
}

struct POrder : pg8::StaticOrder { __device__ __forceinline__ bool next(int i, pg8::Unit& u) const { if (!pg8::StaticOrder::next(i, u)) return false; u.ab = u.pn >> 2; return true; } };
struct GOrder { static constexpr bool GATHER = false; int G, c;
    __device__ __forceinline__ bool next(int i, pg8::Unit& u) const { const int tile = (i >> 2) * G + c; if (tile >= 512) return false; const int wg = pg8::xcd_remap(tile, 512); const int br = i & 3, mt = wg & 3;
        u.pm = wg >> 2; u.pn = br * 4 + mt; u.bt = br * 4 + mt; u.ab = 0; return true; }
    __device__ __forceinline__ void a_ready(const pg8::Unit&) const {} __device__ __forceinline__ void done(const pg8::Unit&) const {} };
__global__ void __launch_bounds__(512, 2) fwd_kernel(Args args) {
    extern __shared__ __attribute__((aligned(16))) unsigned char lds_raw[];
    ArgsP ap = (ArgsP)__builtin_amdgcn_kernarg_segment_ptr();
    Ctx X; X.a = ap; X.ws = ap->ws; X.lds = (LAS unsigned char*)lds_raw;
    X.tid = threadIdx.x; X.lane = X.tid & 63; X.wave = __builtin_amdgcn_readfirstlane(X.tid >> 6); X.G = gridDim.x;
    { const int bx = blockIdx.x; X.bx = bx; X.c = (X.G % 8 == 0) ? (bx % 8) * (X.G / 8) + bx / 8 : bx; }
    volatile LAS unsigned* misc = (volatile LAS unsigned*)(X.lds + LDS_MISC);
    if (X.tid < 16) misc[X.tid] = 0u;
    __syncthreads();
    XcdBarrier bar; bar.bar = (unsigned*)(X.ws + WS_CTL) + CW_BAR; bar.x = 0; bar.st = misc;
#if !MK_PER_PHASE
    bar = xcd_barrier_post((unsigned*)(X.ws + WS_CTL) + CW_BAR, misc);
#endif
    const int lo = ap->ph_lo, hi = ap->ph_hi; int ph = 0;
#define PH_BEGIN if (ph >= lo && ph < hi) { { ArgsP apl = ap; asm volatile("" : "+s"(apl)); X.a = apl; X.ws = apl->ws; int t_ = threadIdx.x; asm volatile("" : "+v"(t_)); X.tid = t_; X.lane = t_ & 63; X.wave = __builtin_amdgcn_readfirstlane(t_ >> 6); } unsigned char* wb = X.ws + WS_W; LAS unsigned char* gl = X.lds; const float* xin = (l_ == 0) ? X.in(I_X) : (const float*)X.a->out; (void)wb; (void)gl; (void)xin;
#if MK_PER_PHASE
#define PH_END } ++ph;
#else
#define PH_END if (ph + 1 < hi) xcd_barrier(bar); } ++ph;
#endif
    int l_ = 0;
    PH_BEGIN if (EN_PROLOGUE)  ph_prologue(X); PH_END
    for (int l = 0; l < DEPTH; ++l) {
        l_ = l;
        PH_BEGIN if (EN_WCONV)  ph_wconv(X, l); PH_END
        PH_BEGIN if (EN_GWIN)  { pg8::Gemm g{X.hbuf(), (const bf16_t*)(wb + WO_IN), 1024, 0}; pg8::StaticOrder S; S.init(M, PJ, X.G, X.bx); pg8::EpiBf16 E{X.proj(), PJ};
            pg8::gemm_phase<pg8::EpiBf16, pg8::StaticOrder, G_ALIGN, G_SP2>(gl, g, S, E, X.tid); } PH_END
        PH_BEGIN if (EN_MX1)  {
            mx_rope(X);
            for (int u = X.c; u < 256; u += X.G) mx_gmlp(X, l, u);
            for (int wu = X.c * 8 + X.wave; wu < 2048; wu += X.G * 8) mx_s5<1>(X, l, wu);
            __syncthreads();
            for (int u = X.c; u < 256; u += X.G) mx_ssd<1>(X, l, u);
        } PH_END
        PH_BEGIN if (EN_MX2)  {
            for (int r = 0; r < 16; ++r) { const int uu = (r & 1) ? r * 256 + 255 - X.c : r * 256 + X.c; if (X.c < 256) mx_dsa(X, uu & 3, (uu >> 2) * 8); }
            __syncthreads();
            for (int wu = X.c * 8 + X.wave; wu < 2048; wu += X.G * 8) mx_s5<3>(X, l, wu);
            __syncthreads();
            for (int u = X.c; u < 256; u += X.G) mx_ssd<3>(X, l, u);
        } PH_END
        PH_BEGIN if (EN_GLU)  { pg8::Gemm g{(const bf16_t*)(X.ws + WS_YCPRE), (const bf16_t*)(wb + WO_GLU), 256, 0}; pg8::StaticOrder S; S.init(M, 256, X.G, X.bx);
            pg8::EpiGlu E{(const bf16_t*)(X.ws + WS_YCPRE), X.ybuf() + (size_t)2 * M * 256, X.in(I_S5GLUB) + l * 256};
            pg8::gemm_phase<pg8::EpiGlu, pg8::StaticOrder, G_ALIGN, G_SP2>(gl, g, S, E, X.tid); } PH_END
        PH_BEGIN if (EN_GP)  { pg8::Gemm g{X.ybuf(), (const bf16_t*)(wb + WO_BR), 256, (size_t)M * 256};
            POrder S;
            S.init(M, 4096, X.G, X.bx); pg8::EpiBf16 E{(bf16_t*)(X.ws + WS_P), 4096};
            pg8::gemm_phase<pg8::EpiBf16, POrder, G_ALIGN, G_SP2>(gl, g, S, E, X.tid); } PH_END
        PH_BEGIN if (EN_GGATE)  { pg8::Gemm g{X.hbuf(), (const bf16_t*)(wb + WO_GATE), 1024, 0};
            GOrder S{X.G, X.bx};
            pg8::EpiGateMerge E{(const bf16_t*)(X.ws + WS_P), X.ybuf()};
            pg8::gemm_phase<pg8::EpiGateMerge, GOrder, G_ALIGN, G_SP2>(gl, g, S, E, X.tid); } PH_END
        PH_BEGIN if (EN_GOUT)  { pg8::Gemm g{X.ybuf(), (const bf16_t*)(wb + WO_OUT), 1024, 0}; pg8::StaticOrder S; S.init(M, 1024, X.G, X.bx);
            pg8::EpiResid E{xin, X.a->out, X.modv(l, 0)};
            pg8::gemm_phase<pg8::EpiResid, pg8::StaticOrder, G_ALIGN, G_SP2>(gl, g, S, E, X.tid); } PH_END
        PH_BEGIN if (EN_LN1)  ph_ln1_router(X, l); PH_END
        PH_BEGIN if (EN_FILL)  ph_fill(X, l); PH_END
        for (int ch = 0; ch < NCH; ++ch) {
            PH_BEGIN if (EN_MOE1)  {
                LAS int* off = (LAS int*)(X.lds + LDS_TAB + 1024); LAS int* cntl = off + 64; LAS unsigned char* tile_e = (LAS unsigned char*)(X.lds + LDS_TAB + 2048);
                if (ch > 0) { moe_offsets(X, l, ch - 1, off, cntl); ph_combine(X, l, ch - 1, off); __syncthreads(); }
                const int ntile = moe_tiles(X, l, ch, tile_e, off, cntl);
                pg8::Gemm g{X.hbuf(), (const bf16_t*)(wb + WO_13), 1024, 0};
                LAS int* rowtab = (LAS int*)(X.lds + LDS_TAB + 4096);
                MoeOrder<2, true> S{ntile * 2, X.G, X.bx, tile_e, rowtab};
                { const unsigned* rowtok = (const unsigned*)(X.ws + WS_ROWTOK) + (size_t)ch * CH_ROWS; pg8::Unit uu;
                  for (int i = 0; i < 4; ++i) { if (!S.next(i, uu)) break; if (X.tid < 256) rowtab[i * 256 + X.tid] = (int)rowtok[uu.pm * 256 + X.tid]; } }
                __syncthreads();
                pg8::EpiMoe1 E{(bf16_t*)(X.ws + WS_ACT), (const float*)(X.ws + WS_ROWGATE) + (size_t)ch * CH_ROWS};
                pg8::gemm_phase<pg8::EpiMoe1, MoeOrder<2, true>, G_ALIGN, G_SP2>(gl, g, S, E, X.tid);
            } PH_END
            PH_BEGIN if (EN_MOE2)  {
                LAS int* off = (LAS int*)(X.lds + LDS_TAB + 1024); LAS int* cntl = off + 64; LAS unsigned char* tile_e = (LAS unsigned char*)(X.lds + LDS_TAB + 2048);
                const int ntile = moe_tiles(X, l, ch, tile_e, off, cntl);
                pg8::Gemm g{(const bf16_t*)(X.ws + WS_ACT), (const bf16_t*)(wb + WO_2), 256, 0};
                MoeOrder<4, false> S{ntile * 4, X.G, X.bx, tile_e, nullptr};
                pg8::EpiBf16 E{(bf16_t*)(X.ws + WS_OPAIR), 1024};
                pg8::gemm_phase<pg8::EpiBf16, MoeOrder<4, false>, G_ALIGN, G_SP2>(gl, g, S, E, X.tid);
            } PH_END
        }
        PH_BEGIN if (EN_FIN)  { LAS int* off = (LAS int*)(X.lds + LDS_TAB + 1024); LAS int* cntl = off + 64; moe_offsets(X, l, NCH - 1, off, cntl); ph_combine(X, l, NCH - 1, off); } PH_END
    }
#undef PH_BEGIN
#undef PH_END
}
constexpr int N_PHASES = 1 + DEPTH * (10 + 2 * NCH + 1);

#ifdef DBG_DUMP_OFF
__global__ void dbg_dump(const bf16_t* src, float* out, size_t n) { for (size_t i = (size_t)blockIdx.x * blockDim.x + threadIdx.x; i < n; i += (size_t)gridDim.x * blockDim.x) {
#ifdef DBG_HASH_OUT
    const unsigned bits = __builtin_bit_cast(unsigned, out[i]); out[i] = (float)((bits * 2654435761u) >> 8) * (1.0f / 16777216.0f);
#else
    const unsigned bits = src[i]; out[i] = (float)(((bits + 1u) * 2654435761u) >> 8) * (1.0f / 16777216.0f);
#endif
} }
#endif
extern "C" void kernel_launch(void* const* d_in, const int* in_sizes, int n_in, void* d_out, int out_size, void* d_ws, size_t ws_size, hipStream_t stream) {
    static int grid = 0;
    if (grid == 0) {
        if (n_in != 43 || out_size != M * D || ws_size < WS_NEED) { fprintf(stderr, "kernel_launch: unexpected shapes (n_in %d out %d ws %zu)\n", n_in, out_size, ws_size); grid = -1; return; }
        int dev = 0, cus = 0, per_cu = 0;
        if (hipGetDevice(&dev) != hipSuccess || hipDeviceGetAttribute(&cus, hipDeviceAttributeMultiprocessorCount, dev) != hipSuccess) { grid = -1; return; }
        if (hipFuncSetAttribute((const void*)fwd_kernel, hipFuncAttributeMaxDynamicSharedMemorySize, LDS_BYTES) != hipSuccess) { fprintf(stderr, "kernel_launch: hipFuncSetAttribute failed\n"); grid = -1; return; }
        if (hipOccupancyMaxActiveBlocksPerMultiprocessor(&per_cu, (const void*)fwd_kernel, 512, LDS_BYTES) != hipSuccess || per_cu < 1) fprintf(stderr, "kernel_launch: occupancy query says %d\n", per_cu);
        (void)hipGetLastError();
        grid = cus < 256 ? cus : 256;
    }
    if (grid < 0) return;
    (void)hipMemsetAsync((char*)d_ws + WS_CTL, 0, CTL_BYTES, stream);
#ifdef DBG_POISON
    (void)hipMemsetAsync((char*)d_ws + CTL_BYTES, 0xFF, WS_NEED - CTL_BYTES, stream);
    (void)hipMemsetAsync((char*)d_out, 0xFF, (size_t)M * D * 4, stream);
#endif
    Args a{};
    for (int i = 0; i < 43; ++i) a.in[i] = (const float*)d_in[i];
    a.positions = (const int*)d_in[I_POS]; a.out = (float*)d_out; a.ws = (unsigned char*)d_ws;
#if MK_PER_PHASE
#ifndef DBG_NPH
#define DBG_NPH N_PHASES
#endif
    for (int p = 0; p < DBG_NPH; ++p) { a.ph_lo = p; a.ph_hi = p + 1; hipLaunchKernelGGL(fwd_kernel, dim3(grid), dim3(512), LDS_BYTES, stream, a); }
#ifdef DBG_DUMP_OFF
    hipLaunchKernelGGL(dbg_dump, dim3(2048), dim3(256), 0, stream, (const bf16_t*)((const char*)d_ws + (size_t)(DBG_DUMP_OFF)), (float*)d_out, (size_t)M * D);
#endif
#else
    a.ph_lo = 0; a.ph_hi = N_PHASES; hipLaunchKernelGGL(fwd_kernel, dim3(grid), dim3(512), LDS_BYTES, stream, a);
#endif
}
```

```cpp
#include <hip/hip_runtime.h>
#include <cstdio>
#include <cstdint>


#ifndef MK_PER_PHASE
#define MK_PER_PHASE 0
#endif

#ifndef EN_PROLOGUE
#define EN_PROLOGUE 1
#endif
#ifndef EN_WCONV
#define EN_WCONV 1
#endif
#ifndef EN_GWIN
#define EN_GWIN 1
#endif
#ifndef EN_MX1
#define EN_MX1 1
#endif
#ifndef EN_MX2
#define EN_MX2 1
#endif
#ifndef EN_GLU
#define EN_GLU 1
#endif
#ifndef EN_GP
#define EN_GP 1
#endif
#ifndef EN_GGATE
#define EN_GGATE 1
#endif
#ifndef EN_GOUT
#define EN_GOUT 1
#endif
#ifndef EN_LN1
#define EN_LN1 1
#endif
#ifndef EN_FILL
#define EN_FILL 1
#endif
#ifndef EN_MOE1
#define EN_MOE1 1
#endif
#ifndef EN_MOE2
#define EN_MOE2 1
#endif
#ifndef EN_FIN
#define EN_FIN 1
#endif
#ifndef G_ALIGN
#define G_ALIGN true
#endif
#ifndef G_SP2
#define G_SP2 true
#endif
#define LAS __attribute__((address_space(3)))
#define GAS __attribute__((address_space(1)))
typedef unsigned short bf16_t;
typedef short bf16x8 __attribute__((ext_vector_type(8)));
typedef float f32x4 __attribute__((ext_vector_type(4)));
typedef float f32x2 __attribute__((ext_vector_type(2)));
typedef unsigned u32x4 __attribute__((ext_vector_type(4)));
typedef unsigned u32x2 __attribute__((ext_vector_type(2)));

constexpr int NB = 4, SEQ = 8192, M = NB * SEQ, D = 1024, DEPTH = 2;
constexpr int PJ = 2304;
constexpr int C_GU = 0, C_GV = 256, C_Q = 512, C_K = 768, C_V = 832, C_QI = 896, C_KI = 1152, C_S5 = 1216, C_Z = 1472, C_XBC = 1728, C_WI = 2240, C_DT = 2244;
constexpr int D_IN = 2248;
constexpr int NEXP = 32, NE1 = 33;
constexpr int NCH = 4, CHTOK = M / NCH;
constexpr int CH_ROWS = CHTOK * 8 + CHTOK + NE1 * 256;
constexpr float DN_ALPHA = 1.41421356237f;
constexpr float LN_EPS = 1e-5f, RMS_EPS = 1e-6f;

constexpr size_t MiB = 1u << 20;
constexpr size_t WS_CTL = 0, CTL_BYTES = 1 * MiB;
constexpr size_t WS_MODV = 1 * MiB;
constexpr size_t WS_S5B = WS_MODV + 256 * 1024;
constexpr size_t WS_S5C = WS_S5B + 64 * 1024;
constexpr size_t WS_S5A = WS_S5C + 64 * 1024;
constexpr size_t WS_GMW = WS_S5A + 64 * 1024;
constexpr size_t WS_S5ST = 2 * MiB;
constexpr size_t WS_ATOT = 3 * MiB;
constexpr size_t WS_WGBASE = 3 * MiB + 64 * 1024;
constexpr size_t WS_PINFO = 4 * MiB;
constexpr size_t WS_PGATE = 5 * MiB;
constexpr size_t WS_SLOT = 6 * MiB;
constexpr size_t WS_ROWTOK = 7 * MiB;
constexpr size_t WS_ROWGATE = 9 * MiB;
constexpr size_t WS_W = 24 * MiB;
constexpr size_t WO_IN = 0, WO_GATE = WO_IN + (size_t)PJ * 1024 * 2, WO_BR = WO_GATE + (size_t)4096 * 1024 * 2, WO_OUT = WO_BR + (size_t)4 * 1024 * 256 * 2,
                 WO_GLU = WO_OUT + (size_t)1024 * 1024 * 2, WO_13 = WO_GLU + (size_t)256 * 256 * 2, WO_2 = WO_13 + (size_t)NE1 * 512 * 1024 * 2, WO_END = WO_2 + (size_t)NE1 * 1024 * 256 * 2;
static_assert(WO_END <= 72 * MiB, "weights region");
constexpr size_t WS_H = 96 * MiB;
constexpr size_t WS_Y = 160 * MiB;
constexpr size_t WS_PROJ = 224 * MiB;
constexpr size_t WS_P = 224 * MiB;
constexpr size_t WS_SSDST = 368 * MiB;
constexpr size_t WS_YCPRE = 384 * MiB;
constexpr size_t WS_ACT = 224 * MiB;
constexpr size_t WS_OPAIR = 272 * MiB;
static_assert(WS_ACT + (size_t)CH_ROWS * 512 <= WS_OPAIR && WS_OPAIR + (size_t)CH_ROWS * 2048 <= 512 * MiB, "moe buffers");
constexpr size_t WS_NEED = 512 * MiB;
constexpr int CW_BAR = 4096;
constexpr int CW_CNT = 16384;

constexpr int LDS_BYTES = 160 * 1024;
constexpr int LDS_TAB = 131072;
constexpr int LDS_MISC = LDS_BYTES - 256;

__device__ __forceinline__ unsigned f2bf(float f) { unsigned u = __builtin_bit_cast(unsigned, f); return (u + 0x7fffu + ((u >> 16) & 1u)) >> 16; }
__device__ __forceinline__ unsigned pk2(float lo, float hi) { return f2bf(lo) | (f2bf(hi) << 16); }
__device__ __forceinline__ float bf2f(unsigned short b) { return __builtin_bit_cast(float, (unsigned)b << 16); }
__device__ __forceinline__ float bflo(unsigned w) { return __builtin_bit_cast(float, w << 16); }
__device__ __forceinline__ float bfhi(unsigned w) { return __builtin_bit_cast(float, w & 0xffff0000u); }
__device__ __forceinline__ float wave_sum(float v) {
#pragma unroll
    for (int o = 1; o < 64; o <<= 1) v += __shfl_xor(v, o);
    return v;
}
__device__ __forceinline__ float wave_max(float v) {
#pragma unroll
    for (int o = 1; o < 64; o <<= 1) v = fmaxf(v, __shfl_xor(v, o));
    return v;
}
__device__ __forceinline__ int wave_sum_i(int v) {
#pragma unroll
    for (int o = 1; o < 64; o <<= 1) v += __shfl_xor(v, o);
    return v;
}
__device__ __forceinline__ float sigmoidf_(float x) { return 1.0f / (1.0f + __expf(-x)); }
__device__ __forceinline__ float siluf_(float x) { return x / (1.0f + __expf(-x)); }
__device__ __forceinline__ float gelu_tanh(float x) { const float u = 1.5957691216057308f * (x + 0.044715f * x * x * x); return x / (1.0f + __expf(-u)); }
__device__ __forceinline__ float softplusf_(float x) { return fmaxf(x, 0.f) + log1pf(__expf(-fabsf(x))); }
__device__ __forceinline__ void sincos_red(float ang, float& sn, float& cs) {
    const double a = (double)ang; const double q = __builtin_rint(a * 0.63661977236758134308);
    const float r = (float)(a - q * 1.57079632679489661923); const int qi = (int)q & 3;
    const float r2 = r * r;
    const float s = r * (1.0f + r2 * (-1.6666667e-1f + r2 * (8.3333333e-3f + r2 * (-1.9841270e-4f + r2 * 2.7557319e-6f))));
    const float c = 1.0f + r2 * (-0.5f + r2 * (4.1666667e-2f + r2 * (-1.3888889e-3f + r2 * (2.4801587e-5f + r2 * -2.7557319e-7f))));
    sn = (qi == 0) ? s : (qi == 1) ? c : (qi == 2) ? -s : -c;
    cs = (qi == 0) ? c : (qi == 1) ? -s : (qi == 2) ? -c : s;
}
__device__ __forceinline__ f32x4 mfma16(bf16x8 a, bf16x8 b, f32x4 c) { return __builtin_amdgcn_mfma_f32_16x16x32_bf16(a, b, c, 0, 0, 0); }
__device__ __forceinline__ unsigned cvt_pk_bf16(float lo, float hi) { unsigned r; asm volatile("v_cvt_pk_bf16_f32 %0, %1, %2" : "=v"(r) : "v"(lo), "v"(hi)); return r; }

namespace pg8 {
constexpr int BM = 256, BK = 64, HALF = 128, HTB = HALF * BK * 2, STAGE_BYTES = 8 * HTB, NXCD = 8, WGM = 8;
__host__ __device__ __forceinline__ int lds_byte(int r, int c) { const int st = (r >> 4) * 2 + (c >> 5), rr = r & 15, cc = c & 31, ob = rr * 64 + cc * 2; return st * 1024 + (ob ^ (((ob >> 9) & 1) << 5)); }
__host__ __device__ __forceinline__ void stage_rc(int b, int& R, int& C) { const int st = b / 1024, sb = b % 1024, swz = sb ^ (((sb >> 9) & 1) << 5); R = (st >> 1) * 16 + swz / 64; C = (st & 1) * 32 + (swz % 64) / 2; }
__host__ __device__ __forceinline__ int perm32(int rho) { const int n = rho >> 4, i = rho & 15; return 8 * (i >> 2) + 4 * n + (i & 3); }

struct Unit { int pm, pn, bt, ab; };
struct Gemm { const bf16_t* A; const bf16_t* Bt; int K; size_t a_sel_stride; };

__device__ __forceinline__ int xcd_remap(int wgid, int nwg) { const int q = nwg / NXCD, r = nwg % NXCD, xcd = wgid % NXCD, off = wgid / NXCD; return (xcd < r ? xcd * (q + 1) : r * (q + 1) + (xcd - r) * q) + off; }

struct StaticOrder {
    static constexpr bool GATHER = false;
    int nM, nN, nwg, G, c;
    __device__ void init(int Mr, int N, int G_, int c_) { nM = Mr / BM; nN = N / BM; nwg = nM * nN; G = G_; c = c_; }
    __device__ __forceinline__ bool next(int i, Unit& u) const {
        const long L = (long)i * G + c; if (L >= nwg) return false;
        const int wgid = xcd_remap((int)L, nwg);
        const int nig = WGM * nN, gid = wgid / nig, fm = gid * WGM, gsz = (nM - fm) < WGM ? (nM - fm) : WGM;
        u.pm = fm + ((wgid % nig) % gsz); u.pn = (wgid % nig) / gsz; u.bt = u.pn; u.ab = 0; return true;
    }
    __device__ __forceinline__ void a_ready(const Unit&) const {}
    __device__ __forceinline__ void done(const Unit&) const {}
};

template <class Epi, class Sched, bool ALIGN_EPI = false, bool SP2 = true>
__device__ __forceinline__ void gemm_phase(LAS unsigned char* lds, const Gemm g, const Sched& S, const Epi& E, const int tid) {
    const int wid = __builtin_amdgcn_readfirstlane(tid >> 6), lane = tid & 63, wr = wid >> 2, wc = wid & 3, fr = lane & 15, fq = lane >> 4;
    const int K = g.K, nt = K / BK;
    unsigned voffA[2], voffB[2];
#pragma unroll
    for (int i = 0; i < 2; ++i) { int R, C; stage_rc(tid * 16 + i * 8192, R, C); const int Rb = Epi::PERM ? ((R & ~31) + perm32(R & 31)) : R;
        voffA[i] = (unsigned)(R * K + C) * 2u; voffB[i] = (unsigned)(Rb * K + C) * 2u; }
    const size_t kstep = (size_t)(BK * 2);
    const size_t hstep = (size_t)HALF * K * 2;
    const size_t tstep = 2 * hstep;
    const unsigned ldsw = (unsigned)wid * 1024u;
    const int aoff = lds_byte(wr * 64 + fr, fq * 8), boff = lds_byte(wc * 32 + fr, fq * 8);
#define PG8_SA(b, h) (((b) * 2 + (h)) * HTB)
#define PG8_SB(b, h) ((4 + (b) * 2 + (h)) * HTB)
#define PG8_STAGE(bufoff, gbase, voff) do { _Pragma("unroll") for (int _i = 0; _i < 2; ++_i) \
        __builtin_amdgcn_global_load_lds((const unsigned*)((const char*)(gbase) + (voff)[_i]), (LAS unsigned*)(lds + (bufoff) + ldsw + _i * 8192), 16, 0, 0); } while (0)
#define PG8_GO(u) do { _Pragma("unroll") for (int _h = 0; _h < 2; ++_h) _Pragma("unroll") for (int _i = 0; _i < 2; ++_i) { int _R, _C; stage_rc(tid * 16 + _i * 8192, _R, _C); \
        cgo[_h][_i] = (unsigned)S.row_of(u, _h * HALF + _R) * (unsigned)(K * 2) + (unsigned)_C * 2u; } } while (0)
#define PG8_STAGE_A(bufoff, base, h, kb, NX) do { if constexpr (Sched::GATHER) { _Pragma("unroll") for (int _i = 0; _i < 2; ++_i) \
        __builtin_amdgcn_global_load_lds((const unsigned*)((const char*)g.A + (kb) + cgo[h][_i]), (LAS unsigned*)(lds + (bufoff) + ldsw + _i * 8192), 16, 0, 0); } \
        else { PG8_STAGE(bufoff, (base) + (size_t)(h) * hstep + (kb), voffA); } } while (0)
#define PG8_LDA(dst, b, h) do { _Pragma("unroll") for (int m = 0; m < 4; ++m) _Pragma("unroll") for (int k = 0; k < 2; ++k) dst[m][k] = *(const LAS bf16x8*)(lds + PG8_SA(b, h) + aoff + m * 2048 + k * 1024); } while (0)
#define PG8_LDB(dst, b, h) do { _Pragma("unroll") for (int n = 0; n < 2; ++n) _Pragma("unroll") for (int k = 0; k < 2; ++k) dst[n][k] = *(const LAS bf16x8*)(lds + PG8_SB(b, h) + boff + n * 2048 + k * 1024); } while (0)
#define PG8_MMA(ai, bj, At, Bt) do { __builtin_amdgcn_s_setprio(1); _Pragma("unroll") for (int m = 0; m < 4; ++m) _Pragma("unroll") for (int n = 0; n < 2; ++n) _Pragma("unroll") for (int k = 0; k < 2; ++k) \
        acc[ai][bj][m][n] = __builtin_amdgcn_mfma_f32_16x16x32_bf16(Bt[n][k], At[m][k], acc[ai][bj][m][n], 0, 0, 0); __builtin_amdgcn_s_setprio(0); } while (0)
#define PG8_WAIT_V(n) asm volatile("s_waitcnt vmcnt(" #n ")" ::: "memory")
#define PG8_WAIT_L(n) asm volatile("s_waitcnt lgkmcnt(" #n ")" ::: "memory")
#define PG8_BAR __builtin_amdgcn_s_barrier()
#define PG8_SCHED __builtin_amdgcn_sched_barrier(0)
    Unit cur, nxt; int ui = 0;
    if (!S.next(0, cur)) return;
    f32x4 acc[2][2][4][2];
#pragma unroll
    for (int a = 0; a < 2; ++a)
#pragma unroll
        for (int b = 0; b < 2; ++b)
#pragma unroll
            for (int m = 0; m < 4; ++m)
#pragma unroll
                for (int n = 0; n < 2; ++n) acc[a][b][m][n] = (f32x4){0.f, 0.f, 0.f, 0.f};
    bf16x8 At[4][2], B0[2][2], B1[2][2];
    unsigned cgo[2][2];
    if constexpr (Sched::GATHER) PG8_GO(cur);
    const char* cA = (const char*)(g.A + (size_t)cur.ab * g.a_sel_stride) + (size_t)cur.pm * tstep; const char* cB = (const char*)g.Bt + (size_t)cur.bt * tstep;
    S.a_ready(cur);
    if constexpr (SP2) {
        PG8_STAGE(PG8_SB(0, 0), cB, voffB); PG8_STAGE(PG8_SB(0, 1), cB + hstep, voffB); PG8_STAGE_A(PG8_SA(0, 0), cA, 0, (size_t)0, false); PG8_STAGE_A(PG8_SA(0, 1), cA, 1, (size_t)0, false);
        if (wr == 1) PG8_BAR;
        PG8_WAIT_V(2); PG8_BAR;
        PG8_STAGE(PG8_SB(1, 0), cB + kstep, voffB); PG8_STAGE_A(PG8_SA(1, 0), cA, 0, kstep, false); PG8_STAGE(PG8_SB(1, 1), cB + hstep + kstep, voffB);
        PG8_WAIT_V(6); PG8_BAR;
    } else {
        PG8_STAGE(PG8_SB(0, 0), cB, voffB); PG8_STAGE_A(PG8_SA(0, 0), cA, 0, (size_t)0, false); PG8_STAGE(PG8_SB(0, 1), cB + hstep, voffB); PG8_STAGE_A(PG8_SA(0, 1), cA, 1, (size_t)0, false);
        if (wr == 1) PG8_BAR;
        PG8_WAIT_V(4); PG8_BAR;
        PG8_STAGE(PG8_SB(1, 0), cB + kstep, voffB); PG8_STAGE_A(PG8_SA(1, 0), cA, 0, kstep, false); PG8_STAGE(PG8_SB(1, 1), cB + hstep + kstep, voffB);
        PG8_WAIT_V(6); PG8_BAR;
    }
    for (;;) {
        const bool has_next = S.next(ui + 1, nxt);
        const char* nA = has_next ? (const char*)(g.A + (size_t)nxt.ab * g.a_sel_stride) + (size_t)nxt.pm * tstep : cA; const char* nB = has_next ? (const char*)g.Bt + (size_t)nxt.bt * tstep : cB;
#pragma nounroll
        for (int t = 0; t < nt; t += 2) {
            const bool last = (t == nt - 2);
            const size_t k1 = (size_t)(t + 1) * kstep;
            const char* a2b = last ? nA : cA; const size_t k2 = last ? (size_t)0 : (size_t)(t + 2) * kstep; const size_t k3 = k2 + kstep;
            const char* b2 = last ? nB : cB + (size_t)(t + 2) * kstep; const char* b3 = b2 + kstep;
            if (last && has_next) S.a_ready(nxt);
            if constexpr (SP2) {
            PG8_LDB(B0, 0, 0); PG8_LDB(B1, 0, 1); PG8_SCHED; PG8_LDA(At, 0, 0); PG8_STAGE_A(PG8_SA(1, 1), cA, 1, k1, false);
            if constexpr (Sched::GATHER) { if (last && has_next) PG8_GO(nxt); }
            PG8_WAIT_V(8); PG8_WAIT_L(0); PG8_BAR; PG8_MMA(0, 0, At, B0); PG8_MMA(0, 1, At, B1); PG8_BAR; PG8_SCHED;
            PG8_LDA(At, 0, 1); PG8_STAGE(PG8_SB(0, 0), b2, voffB); PG8_STAGE(PG8_SB(0, 1), b2 + hstep, voffB); PG8_STAGE_A(PG8_SA(0, 0), a2b, 0, k2, last);
            PG8_WAIT_V(8); PG8_WAIT_L(0); PG8_BAR; PG8_MMA(1, 0, At, B0); PG8_MMA(1, 1, At, B1); PG8_BAR; PG8_SCHED;
            PG8_LDB(B0, 1, 0); PG8_LDB(B1, 1, 1); PG8_SCHED; PG8_LDA(At, 1, 0); PG8_STAGE_A(PG8_SA(0, 1), a2b, 1, k2, last);
            PG8_WAIT_V(8); PG8_WAIT_L(0); PG8_BAR; PG8_MMA(0, 0, At, B0); PG8_MMA(0, 1, At, B1); PG8_BAR; PG8_SCHED;
            PG8_LDA(At, 1, 1); PG8_STAGE(PG8_SB(1, 0), b3, voffB); PG8_STAGE(PG8_SB(1, 1), b3 + hstep, voffB); PG8_STAGE_A(PG8_SA(1, 0), a2b, 0, k3, last);
            PG8_WAIT_V(8); PG8_WAIT_L(0); PG8_BAR; PG8_MMA(1, 0, At, B0); PG8_MMA(1, 1, At, B1); PG8_BAR; PG8_SCHED;
            } else {
            PG8_LDB(B0, 0, 0); PG8_SCHED; PG8_LDA(At, 0, 0); PG8_STAGE_A(PG8_SA(1, 1), cA, 1, k1, false);
            if constexpr (Sched::GATHER) { if (last && has_next) PG8_GO(nxt); }
            PG8_WAIT_L(8); PG8_BAR; PG8_WAIT_L(0); PG8_MMA(0, 0, At, B0); PG8_BAR; PG8_SCHED;
            PG8_LDB(B1, 0, 1); PG8_STAGE(PG8_SB(0, 0), b2, voffB);
            PG8_BAR; PG8_WAIT_L(0); PG8_MMA(0, 1, At, B1); PG8_BAR;
            PG8_LDA(At, 0, 1); PG8_STAGE_A(PG8_SA(0, 0), a2b, 0, k2, last);
            PG8_BAR; PG8_WAIT_L(0); PG8_MMA(1, 0, At, B0); PG8_BAR; PG8_SCHED;
            PG8_STAGE(PG8_SB(0, 1), b2 + hstep, voffB);
            PG8_WAIT_V(6); PG8_BAR; PG8_MMA(1, 1, At, B1); PG8_BAR;
            PG8_LDB(B0, 1, 0); PG8_SCHED; PG8_LDA(At, 1, 0); PG8_STAGE_A(PG8_SA(0, 1), a2b, 1, k2, last);
            PG8_WAIT_L(8); PG8_BAR; PG8_WAIT_L(0); PG8_MMA(0, 0, At, B0); PG8_BAR; PG8_SCHED;
            PG8_LDB(B1, 1, 1); PG8_STAGE(PG8_SB(1, 0), b3, voffB);
            PG8_BAR; PG8_WAIT_L(0); PG8_MMA(0, 1, At, B1); PG8_BAR;
            PG8_LDA(At, 1, 1); PG8_STAGE_A(PG8_SA(1, 0), a2b, 0, k3, last);
            PG8_BAR; PG8_WAIT_L(0); PG8_MMA(1, 0, At, B0); PG8_BAR; PG8_SCHED;
            PG8_STAGE(PG8_SB(1, 1), b3 + hstep, voffB);
            PG8_WAIT_V(6); PG8_BAR; PG8_MMA(1, 1, At, B1); PG8_BAR;
            }
        }
        if constexpr (ALIGN_EPI) { if (wr == 0) PG8_BAR; }
        E(acc, cur, wr, wc, fr, fq); S.done(cur);
        if (!has_next) break;
#pragma unroll
        for (int a = 0; a < 2; ++a)
#pragma unroll
            for (int b = 0; b < 2; ++b)
#pragma unroll
                for (int m = 0; m < 4; ++m)
#pragma unroll
                    for (int n = 0; n < 2; ++n) acc[a][b][m][n] = (f32x4){0.f, 0.f, 0.f, 0.f};
        cur = nxt; cA = nA; cB = nB; ++ui;
        if constexpr (ALIGN_EPI) { if (wr == 1) PG8_BAR; }
    }
    PG8_WAIT_V(0);
    if constexpr (!ALIGN_EPI) { if (wr == 0) PG8_BAR; }
    PG8_BAR;
#undef PG8_SA
#undef PG8_SB
#undef PG8_STAGE
#undef PG8_STAGE_A
#undef PG8_GO
#undef PG8_LDA
#undef PG8_LDB
#undef PG8_MMA
#undef PG8_WAIT_V
#undef PG8_WAIT_L
#undef PG8_BAR
#undef PG8_SCHED
}

struct EpiBf16 {
    static constexpr bool PERM = true;
    bf16_t* O; int ldc;
    __device__ __forceinline__ void operator()(const f32x4 (&acc)[2][2][4][2], const Unit& u, int wr, int wc, int fr, int fq) const {
        const int row0 = u.pm * BM + wr * 64 + fr, col0 = u.pn * BM + wc * 32 + 8 * fq;
#pragma unroll
        for (int ai = 0; ai < 2; ++ai)
#pragma unroll
            for (int m = 0; m < 4; ++m) { bf16_t* rowp = O + (size_t)(row0 + ai * HALF + m * 16) * ldc + col0;
#pragma unroll
                for (int bj = 0; bj < 2; ++bj) { const f32x4 v0 = acc[ai][bj][m][0], v1 = acc[ai][bj][m][1];
                    u32x4 w; w.x = cvt_pk_bf16(v0[0], v0[1]); w.y = cvt_pk_bf16(v0[2], v0[3]); w.z = cvt_pk_bf16(v1[0], v1[1]); w.w = cvt_pk_bf16(v1[2], v1[3]);
                    *(u32x4*)(rowp + bj * HALF) = w; } }
    }
};
struct EpiGlu {
    static constexpr bool PERM = true;
    const bf16_t* Ysrc; bf16_t* O; const float* bias;
    __device__ __forceinline__ void operator()(const f32x4 (&acc)[2][2][4][2], const Unit& u, int wr, int wc, int fr, int fq) const {
        const int row0 = u.pm * BM + wr * 64 + fr, col0 = u.pn * BM + wc * 32 + 8 * fq;
#pragma unroll
        for (int ai = 0; ai < 2; ++ai)
#pragma unroll
            for (int m = 0; m < 4; ++m) { const size_t ro = (size_t)(row0 + ai * HALF + m * 16) * 256 + col0;
#pragma unroll
                for (int bj = 0; bj < 2; ++bj) { const f32x4 v0 = acc[ai][bj][m][0], v1 = acc[ai][bj][m][1];
                    const u32x4 yv = *(const u32x4*)(Ysrc + ro + bj * HALF);
                    const f32x4 b0 = *(const f32x4*)(bias + col0 + bj * HALF), b1 = *(const f32x4*)(bias + col0 + bj * HALF + 4);
                    float o[8];
                    o[0] = bflo(yv.x) * sigmoidf_(v0[0] + b0[0]); o[1] = bfhi(yv.x) * sigmoidf_(v0[1] + b0[1]); o[2] = bflo(yv.y) * sigmoidf_(v0[2] + b0[2]); o[3] = bfhi(yv.y) * sigmoidf_(v0[3] + b0[3]);
                    o[4] = bflo(yv.z) * sigmoidf_(v1[0] + b1[0]); o[5] = bfhi(yv.z) * sigmoidf_(v1[1] + b1[1]); o[6] = bflo(yv.w) * sigmoidf_(v1[2] + b1[2]); o[7] = bfhi(yv.w) * sigmoidf_(v1[3] + b1[3]);
                    u32x4 w; w.x = cvt_pk_bf16(o[0], o[1]); w.y = cvt_pk_bf16(o[2], o[3]); w.z = cvt_pk_bf16(o[4], o[5]); w.w = cvt_pk_bf16(o[6], o[7]);
                    *(u32x4*)(O + ro + bj * HALF) = w; } }
    }
};
struct EpiGateMerge {
    static constexpr bool PERM = true;
    const bf16_t* P; bf16_t* Mg;
    __device__ __forceinline__ void operator()(const f32x4 (&acc)[2][2][4][2], const Unit& u, int wr, int wc, int fr, int fq) const {
        const int i = u.pn >> 2, mt = u.pn & 3;
        const int row0 = u.pm * BM + wr * 64 + fr, col0 = mt * BM + wc * 32 + 8 * fq;
#pragma unroll
        for (int ai = 0; ai < 2; ++ai)
#pragma unroll
            for (int m = 0; m < 4; ++m) { const size_t r = (size_t)(row0 + ai * HALF + m * 16);
#pragma unroll
                for (int bj = 0; bj < 2; ++bj) { const f32x4 v0 = acc[ai][bj][m][0], v1 = acc[ai][bj][m][1];
                    const u32x4 pv = *(const u32x4*)(P + r * 4096 + i * 1024 + col0 + bj * HALF);
                    u32x4 mv = (u32x4){0u, 0u, 0u, 0u};
                    if (i > 0) mv = *(const u32x4*)(Mg + r * 1024 + col0 + bj * HALF);
                    float o[8];
                    o[0] = bflo(mv.x) + bflo(pv.x) * sigmoidf_(v0[0]); o[1] = bfhi(mv.x) + bfhi(pv.x) * sigmoidf_(v0[1]); o[2] = bflo(mv.y) + bflo(pv.y) * sigmoidf_(v0[2]); o[3] = bfhi(mv.y) + bfhi(pv.y) * sigmoidf_(v0[3]);
                    o[4] = bflo(mv.z) + bflo(pv.z) * sigmoidf_(v1[0]); o[5] = bfhi(mv.z) + bfhi(pv.z) * sigmoidf_(v1[1]); o[6] = bflo(mv.w) + bflo(pv.w) * sigmoidf_(v1[2]); o[7] = bfhi(mv.w) + bfhi(pv.w) * sigmoidf_(v1[3]);
                    u32x4 w; w.x = cvt_pk_bf16(o[0], o[1]); w.y = cvt_pk_bf16(o[2], o[3]); w.z = cvt_pk_bf16(o[4], o[5]); w.w = cvt_pk_bf16(o[6], o[7]);
                    *(u32x4*)(Mg + r * 1024 + col0 + bj * HALF) = w; } }
    }
};
struct EpiResid {
    static constexpr bool PERM = false;
    const float* xin; float* out; const float* gate;
    __device__ __forceinline__ void operator()(const f32x4 (&acc)[2][2][4][2], const Unit& u, int wr, int wc, int fr, int fq) const {
        const int row0 = u.pm * BM + wr * 64 + fr, col0 = u.pn * BM + wc * 32 + 4 * fq;
        const int b = (u.pm * BM) / SEQ;
        f32x4 gv[2][2];
#pragma unroll
        for (int bj = 0; bj < 2; ++bj)
#pragma unroll
            for (int n = 0; n < 2; ++n) gv[bj][n] = *(const f32x4*)(gate + b * 3072 + 2048 + col0 + bj * HALF + n * 16) + 1.0f;
#pragma unroll
        for (int ai = 0; ai < 2; ++ai)
#pragma unroll
            for (int m = 0; m < 4; ++m) { const size_t ro = (size_t)(row0 + ai * HALF + m * 16) * D + col0;
#pragma unroll
                for (int bj = 0; bj < 2; ++bj)
#pragma unroll
                    for (int n = 0; n < 2; ++n) { const f32x4 xv = *(const f32x4*)(xin + ro + bj * HALF + n * 16);
                        *(f32x4*)(out + ro + bj * HALF + n * 16) = xv * DN_ALPHA + gv[bj][n] * acc[ai][bj][m][n]; } }
    }
};
struct EpiMoe1 {
    static constexpr bool PERM = false;
    bf16_t* Act; const float* rowgate;
    __device__ __forceinline__ void operator()(const f32x4 (&acc)[2][2][4][2], const Unit& u, int wr, int wc, int fr, int fq) const {
        const int row0 = u.pm * BM + wr * 64 + fr, f0 = u.pn * 128 + wc * 16 + 4 * fq;
#pragma unroll
        for (int ai = 0; ai < 2; ++ai)
#pragma unroll
            for (int m = 0; m < 4; ++m) { const int r = row0 + ai * HALF + m * 16; const float gt = rowgate[r];
#pragma unroll
                for (int bj = 0; bj < 2; ++bj) { const f32x4 a = acc[ai][bj][m][0], b = acc[ai][bj][m][1];
                    u32x2 w; w.x = cvt_pk_bf16(siluf_(a[0]) * b[0] * gt, siluf_(a[1]) * b[1] * gt); w.y = cvt_pk_bf16(siluf_(a[2]) * b[2] * gt, siluf_(a[3]) * b[3] * gt);
                    *(u32x2*)(Act + (size_t)r * 256 + f0 + bj * 64) = w; } }
    }
};
}

#define XB_TMO      128
#define XB_XCNT(j)  (256  + 64 * (j))
#define XB_XSUB(j)  (1280 + 64 * (j))
#define XB_XGEN(j)  (2304 + 64 * (j))
#define XB_TOP      3328
#define XB_TOPGEN   3392
#define XCD_BAR_WORDS 3456
#define XB_SPIN_CAP (1u << 22)
__device__ __forceinline__ unsigned xb_ld(unsigned* p)              { return __hip_atomic_load(p, __ATOMIC_RELAXED, __HIP_MEMORY_SCOPE_AGENT); }
__device__ __forceinline__ unsigned xb_add(unsigned* p, unsigned v) { return __hip_atomic_fetch_add(p, v, __ATOMIC_RELAXED, __HIP_MEMORY_SCOPE_AGENT); }
__device__ __forceinline__ unsigned xb_xcc_id() { return (unsigned)__builtin_amdgcn_s_getreg((3 << 11) | 20) & 0xFu; }
#define XB_SPIN(cond, bar) do { unsigned _sp = 0; while (cond) { __builtin_amdgcn_s_sleep(1); \
    if ((++_sp & 255u) == 0u) { if (xb_ld(&(bar)[XB_TMO])) break; if (_sp > XB_SPIN_CAP) { atomicAdd(&(bar)[XB_TMO], 1u); break; } } } } while (0)
struct XcdBarrier { unsigned* bar; unsigned x; volatile LAS unsigned* st; };
__device__ __forceinline__ XcdBarrier xcd_barrier_post(unsigned* bar, volatile LAS unsigned* st) {
    XcdBarrier b; b.bar = bar; b.x = xb_xcc_id(); b.st = st;
    if (threadIdx.x == 0) (void)xb_add(&bar[XB_XCNT(b.x)], 1u);
    return b;
}
__device__ __forceinline__ void xcd_barrier_complete(unsigned* bar, unsigned x, unsigned& nloc, unsigned& nx) {
    const unsigned G = gridDim.x * gridDim.y * gridDim.z;
    unsigned sum, cnt, mine, sp = 0u;
    for (;;) {
        sum = 0u; cnt = 0u; mine = 0u;
#pragma unroll
        for (unsigned j = 0; j < 16; ++j) { const unsigned c = xb_ld(&bar[XB_XCNT(j)]); sum += c; cnt += (c > 0u) ? 1u : 0u; mine = (j == x) ? c : mine; }
        if (sum == G) break;
        __builtin_amdgcn_s_sleep(1);
        if ((++sp & 255u) == 0u) { if (xb_ld(&bar[XB_TMO])) break; if (sp > XB_SPIN_CAP) { atomicAdd(&bar[XB_TMO], 1u); break; } }
    }
    nloc = mine > 0u ? mine : 1u; nx = cnt > 0u ? cnt : 1u;
}
__device__ __forceinline__ void xcd_barrier(const XcdBarrier& b) {
    asm volatile("s_waitcnt vmcnt(0)" ::: "memory");
    __syncthreads();
    if (threadIdx.x == 0) {
        unsigned* bar = b.bar;
        __builtin_amdgcn_s_waitcnt(0);
        unsigned nloc = b.st[0], nx = b.st[1];
        if (nloc == 0u) { xcd_barrier_complete(bar, b.x, nloc, nx); b.st[0] = nloc; b.st[1] = nx; }
        const unsigned old = xb_add(&bar[XB_XSUB(b.x)], 1u);
        const unsigned gen = old / nloc;
        if (old + 1u == (gen + 1u) * nloc) {
            __builtin_amdgcn_fence(__ATOMIC_RELEASE, "agent");
            asm volatile("s_waitcnt vmcnt(0)" ::: "memory");
            const unsigned og = xb_add(&bar[XB_TOP], 1u);
            const unsigned tg = og / nx;
            if (og + 1u == (tg + 1u) * nx) xb_add(&bar[XB_TOPGEN], 1u);
            else XB_SPIN(xb_ld(&bar[XB_TOPGEN]) == tg, bar);
            __builtin_amdgcn_fence(__ATOMIC_ACQUIRE, "agent");
            xb_add(&bar[XB_XGEN(b.x)], 1u);
            asm volatile("s_waitcnt vmcnt(0)" ::: "memory");
        } else {
            XB_SPIN(xb_ld(&bar[XB_XGEN(b.x)]) == gen, bar);
            __builtin_amdgcn_fence(__ATOMIC_ACQUIRE, "agent");
            asm volatile("s_waitcnt vmcnt(0)" ::: "memory");
        }
    }
    __syncthreads();
}

struct Args {
    const float* in[43]; const int* positions; float* out; unsigned char* ws; int ph_lo, ph_hi;
};
enum { I_X = 0, I_C = 1, I_POS = 2, I_MOD1W = 3, I_MOD1B = 4, I_WIN = 5, I_GMLNG = 6, I_GMLNB = 7, I_GMW = 8, I_GMB = 9,
       I_S5LRE = 10, I_S5LIM = 11, I_S5STEP = 12, I_S5BRE = 13, I_S5BIM = 14, I_S5CRE = 15, I_S5CIM = 16, I_S5D = 17, I_S5GLUW = 18, I_S5GLUB = 19,
       I_CONVW = 20, I_CONVB = 21, I_DTBIAS = 22, I_ALOG = 23, I_SSDD = 24, I_SSDNG = 25, I_WBR = 26, I_WGATE = 27, I_WOUT = 28, I_LN1G = 29, I_LN1B = 30,
       I_MOD2W = 31, I_MOD2B = 32, I_RW = 33, I_RB = 34, I_EW1 = 35, I_EW3 = 36, I_EW2 = 37, I_SW1 = 38, I_SW3 = 39, I_SW2 = 40, I_LN2G = 41, I_LN2B = 42 };

typedef const __attribute__((address_space(4))) Args* ArgsP;
struct Ctx {
    ArgsP a; unsigned char* ws; LAS unsigned char* lds; int tid, lane, wave, c, G, bx;
    __device__ __forceinline__ const float* in(int i) const { return a->in[i]; }
    __device__ __forceinline__ bf16_t* proj() const { return (bf16_t*)(ws + WS_PROJ); }
    __device__ __forceinline__ bf16_t* hbuf() const { return (bf16_t*)(ws + WS_H); }
    __device__ __forceinline__ bf16_t* ybuf() const { return (bf16_t*)(ws + WS_Y); }
    __device__ __forceinline__ float* modv(int l, int w) const { return (float*)(ws + WS_MODV) + (size_t)(l * 2 + w) * NB * 3072; }
};

__device__ __forceinline__ void ph_prologue(const Ctx& X) {
    LAS float* red = (LAS float*)X.lds;
    for (int it = X.c; it < DEPTH * 2 * 48; it += X.G) {
        const int l = it / 96, w = (it / 48) & 1, jb = it % 48, j = jb * 64 + X.lane;
        const float* W = X.in(w ? I_MOD2W : I_MOD1W) + (size_t)l * D * 3072; const float* cv = X.in(I_C);
        float a0 = 0.f, a1 = 0.f, a2 = 0.f, a3 = 0.f;
        const int k0 = X.wave * 128;
        for (int k = k0; k < k0 + 128; ++k) { const float wv = W[(size_t)k * 3072 + j]; a0 += cv[k] * wv; a1 += cv[D + k] * wv; a2 += cv[2 * D + k] * wv; a3 += cv[3 * D + k] * wv; }
        red[(X.wave * 4 + 0) * 64 + X.lane] = a0; red[(X.wave * 4 + 1) * 64 + X.lane] = a1; red[(X.wave * 4 + 2) * 64 + X.lane] = a2; red[(X.wave * 4 + 3) * 64 + X.lane] = a3;
        __syncthreads();
        if (X.tid < 256) { const int b = X.tid >> 6, ln = X.tid & 63; float s = 0.f;
#pragma unroll
            for (int q = 0; q < 8; ++q) s += red[(q * 4 + b) * 64 + ln];
            const int jj = jb * 64 + ln; X.modv(l, w)[b * 3072 + jj] = s + X.in(w ? I_MOD2B : I_MOD1B)[(size_t)l * 3072 + jj]; }
        __syncthreads();
    }
}

template <class Src>
__device__ __forceinline__ void tr_item(const Src& src, bf16_t* WT, int K, int rowbase, int kb, int nb, LAS float* scr, int lane) {
    const int k0 = 64 * kb, n0 = 32 * nb;
#pragma unroll 8
    for (int i = 0; i < 32; ++i) { const int kk = 2 * i + (lane >> 5); scr[kk * 33 + (lane & 31)] = src(k0 + kk, n0 + (lane & 31)); }
    asm volatile("s_waitcnt lgkmcnt(0)" ::: "memory");
    const int c = lane & 7;
#pragma unroll
    for (int j = 0; j < 4; ++j) { const int n = (lane >> 3) + 8 * j; const LAS float* s = scr + (8 * c) * 33 + n;
        u32x4 o; o.x = pk2(s[0 * 33], s[1 * 33]); o.y = pk2(s[2 * 33], s[3 * 33]); o.z = pk2(s[4 * 33], s[5 * 33]); o.w = pk2(s[6 * 33], s[7 * 33]);
        *(u32x4*)(WT + (size_t)(rowbase + n0 + n) * K + k0 + 8 * c) = o; }
    asm volatile("s_waitcnt lgkmcnt(0)" ::: "memory");
}
struct SrcPlain { const float* W; int N; __device__ __forceinline__ float operator()(int k, int n) const { return W[(size_t)k * N + n]; } };
struct SrcWin { const float* W; __device__ __forceinline__ float operator()(int k, int n) const {
    if (n >= D_IN) return 0.f; const int o = (n < 1216) ? n : (n < 2240) ? n + 4 : (n < 2244) ? 1216 + (n - 2240) : n; return W[(size_t)k * D_IN + o]; } };
struct Src13 { const float* W1; const float* W3; __device__ __forceinline__ float operator()(int k, int n) const {
    const int f = (n >> 5) * 16 + (n & 15); const long d = (n & 16) ? (long)(W3 - W1) : 0l; return W1[d + (long)k * 256 + f]; } };

__device__ __forceinline__ void ph_wconv(const Ctx& X, int l) {
    LAS float* scr = (LAS float*)(X.lds + X.wave * 16384);
    unsigned char* wb = X.ws + WS_W;
    const int gw = X.c * 8 + X.wave, NGW = X.G * 8;
    constexpr int I_A = 16 * 72, I_B = 4 * 16 * 32, I_C2 = 4 * 4 * 32, I_D = 16 * 32, I_E = 4 * 8, I_F = NE1 * 16 * 16, I_G = NE1 * 4 * 32;
    constexpr int NIT = I_A + I_B + I_C2 + I_D + I_E + I_F + I_G;
    for (int it = gw; it < NIT; it += NGW) {
        int r = it;
        if (r < I_A) { SrcWin s{X.in(I_WIN) + (size_t)l * D * D_IN}; tr_item(s, (bf16_t*)(wb + WO_IN), 1024, 0, r / 72, r % 72, scr, X.lane); continue; } r -= I_A;
        if (r < I_B) { const int i = r / 512, q = r % 512; SrcPlain s{X.in(I_WGATE) + ((size_t)l * 4 + i) * D * D, D}; tr_item(s, (bf16_t*)(wb + WO_GATE), 1024, i * 1024, q / 32, q % 32, scr, X.lane); continue; } r -= I_B;
        if (r < I_C2) { const int i = r / 128, q = r % 128; SrcPlain s{X.in(I_WBR) + ((size_t)l * 4 + i) * 256 * D, D}; tr_item(s, (bf16_t*)(wb + WO_BR) + (size_t)i * 1024 * 256, 256, 0, q / 32, q % 32, scr, X.lane); continue; } r -= I_C2;
        if (r < I_D) { SrcPlain s{X.in(I_WOUT) + (size_t)l * D * D, D}; tr_item(s, (bf16_t*)(wb + WO_OUT), 1024, 0, r / 32, r % 32, scr, X.lane); continue; } r -= I_D;
        if (r < I_E) { SrcPlain s{X.in(I_S5GLUW) + (size_t)l * 256 * 256, 256}; tr_item(s, (bf16_t*)(wb + WO_GLU), 256, 0, r / 8, r % 8, scr, X.lane); continue; } r -= I_E;
        if (r < I_F) { const int e = r / 256, q = r % 256;
            const Src13 s{(e < NEXP) ? X.in(I_EW1) + ((size_t)l * NEXP + e) * D * 256 : X.in(I_SW1) + (size_t)l * D * 256, (e < NEXP) ? X.in(I_EW3) + ((size_t)l * NEXP + e) * D * 256 : X.in(I_SW3) + (size_t)l * D * 256};
            tr_item(s, (bf16_t*)(wb + WO_13) + (size_t)e * 512 * 1024, 1024, 0, q / 16, q % 16, scr, X.lane); continue; } r -= I_F;
        { const int e = r / 128, q = r % 128; SrcPlain s{e < NEXP ? X.in(I_EW2) + ((size_t)l * NEXP + e) * 256 * D : X.in(I_SW2) + (size_t)l * 256 * D, D};
            tr_item(s, (bf16_t*)(wb + WO_2) + (size_t)e * 1024 * 256, 256, 0, q / 32, q % 32, scr, X.lane); }
    }
    const int gt = X.c * 512 + X.tid, NGT = X.G * 512;
    { bf16_t* gmw = (bf16_t*)(X.ws + WS_GMW); const float* src = X.in(I_GMW) + (size_t)l * 4 * 128 * 128;
      for (int i = gt; i < 4 * 128 * 128; i += NGT) { const int t = (i >> 7) & 127, s = i & 127; gmw[i] = (bf16_t)f2bf(s <= t ? src[i] : 0.f); } }
    for (int i = gt; i < 16 * 64; i += NGT) {
        const int g = i >> 6, p = i & 63;
        const float step = expf(X.in(I_S5STEP)[l * 16 + g]); const float lr = X.in(I_S5LRE)[(size_t)l * 1024 + i], li = X.in(I_S5LIM)[(size_t)l * 1024 + i];
        const float mag = expf(lr * step); float sn, cs; sincos_red(li * step, sn, cs);
        const float abr = mag * cs, abi = mag * sn, den = lr * lr + li * li, nr = abr - 1.0f;
        const float cr = (nr * lr + abi * li) / den, ci = (abi * lr - nr * li) / den;
        float* sa = (float*)(X.ws + WS_S5A); sa[i * 2] = abr; sa[i * 2 + 1] = abi;
        bf16_t* bb = (bf16_t*)(X.ws + WS_S5B); bf16_t* cm = (bf16_t*)(X.ws + WS_S5C);
        const float* bre = X.in(I_S5BRE) + ((size_t)l * 1024 + i) * 16; const float* bim = X.in(I_S5BIM) + ((size_t)l * 1024 + i) * 16;
#pragma unroll
        for (int ch = 0; ch < 16; ++ch) { const float br = bre[ch], bi = bim[ch];
            bb[(g * 128 + p) * 16 + ch] = (bf16_t)f2bf(cr * br - ci * bi); bb[(g * 128 + 64 + p) * 16 + ch] = (bf16_t)f2bf(cr * bi + ci * br);
            cm[(g * 16 + ch) * 128 + p] = (bf16_t)f2bf(X.in(I_S5CRE)[(((size_t)l * 16 + g) * 16 + ch) * 64 + p]);
            cm[(g * 16 + ch) * 128 + 64 + p] = (bf16_t)f2bf(-X.in(I_S5CIM)[(((size_t)l * 16 + g) * 16 + ch) * 64 + p]); }
    }
    if (l == 0) {
        const float* x = X.in(I_X); bf16_t* h = X.hbuf(); const float* mv = X.modv(0, 0);
        for (size_t i = (size_t)gt; i < (size_t)M * D / 8; i += NGT) {
            const size_t e = i * 8; const int col = (int)(e & 1023), b = (int)(e >> 23);
            const f32x4 x0 = *(const f32x4*)(x + e), x1 = *(const f32x4*)(x + e + 4);
            const f32x4 sh0 = *(const f32x4*)(mv + b * 3072 + col), sh1 = *(const f32x4*)(mv + b * 3072 + col + 4), sc0 = *(const f32x4*)(mv + b * 3072 + 1024 + col), sc1 = *(const f32x4*)(mv + b * 3072 + 1024 + col + 4);
            const f32x4 h0 = x0 * (sc0 + 1.0f) + sh0, h1 = x1 * (sc1 + 1.0f) + sh1;
            u32x4 w; w.x = pk2(h0[0], h0[1]); w.y = pk2(h0[2], h0[3]); w.z = pk2(h1[0], h1[1]); w.w = pk2(h1[2], h1[3]);
            *(u32x4*)(h + e) = w; }
    }
}

__device__ __forceinline__ void mx_rope(const Ctx& X) {
    bf16_t* pj = X.proj(); const int* pos = X.a->positions;
    const int gt = X.c * 512 + X.tid, NGT = X.G * 512;
    for (int i = gt; i < M * 10; i += NGT) {
        const int tok = i / 10, hh = i % 10;
        const int col = (hh < 4) ? C_Q + hh * 64 : (hh == 4) ? C_K : (hh < 9) ? C_QI + (hh - 5) * 64 : C_KI;
        bf16_t* p = pj + (size_t)tok * PJ + col;
        const u32x4 a = *(const u32x4*)p, b = *(const u32x4*)(p + 8);
        const float pf = (float)pos[tok];
        float t1[8], t2[8]; t1[0] = bflo(a.x); t1[1] = bfhi(a.x); t1[2] = bflo(a.y); t1[3] = bfhi(a.y); t1[4] = bflo(a.z); t1[5] = bfhi(a.z); t1[6] = bflo(a.w); t1[7] = bfhi(a.w);
        t2[0] = bflo(b.x); t2[1] = bfhi(b.x); t2[2] = bflo(b.y); t2[3] = bfhi(b.y); t2[4] = bflo(b.z); t2[5] = bfhi(b.z); t2[6] = bflo(b.w); t2[7] = bfhi(b.w);
        float o1[8], o2[8];
        const float inv[8] = {1.0f, 0.1939227432f, 0.0376060307f, 0.00729266461f, 0.00141421356f, 0.000274248188f, 5.31829610e-05f, 1.03133862e-05f};
#pragma unroll
        for (int j = 0; j < 8; ++j) { float sn, cs; sincos_red(pf * inv[j], sn, cs); o1[j] = t1[j] * cs - t2[j] * sn; o2[j] = t2[j] * cs + t1[j] * sn; }
        u32x4 wa, wb; wa.x = pk2(o1[0], o1[1]); wa.y = pk2(o1[2], o1[3]); wa.z = pk2(o1[4], o1[5]); wa.w = pk2(o1[6], o1[7]);
        wb.x = pk2(o2[0], o2[1]); wb.y = pk2(o2[2], o2[3]); wb.z = pk2(o2[4], o2[5]); wb.w = pk2(o2[6], o2[7]);
        *(u32x4*)p = wa; *(u32x4*)(p + 8) = wb;
    }
}

__device__ __forceinline__ void mx_gmlp(const Ctx& X, int l, int unit) {
    const int lane = X.lane, w = X.wave;
    const int row0 = unit * 128;
    LAS bf16_t* Vt = (LAS bf16_t*)X.lds;
    const bf16_t* pj = X.proj();
    const float* lng = X.in(I_GMLNG) + l * 256; const float* lnb = X.in(I_GMLNB) + l * 256;
    float g4[4], b4[4];
#pragma unroll
    for (int j = 0; j < 4; ++j) { g4[j] = lng[lane + 64 * j]; b4[j] = lnb[lane + 64 * j]; }
    for (int i = 0; i < 16; ++i) {
        const int s = w * 16 + i; const bf16_t* rp = pj + (size_t)(row0 + s) * PJ + C_GV;
        float v[4]; float sm = 0.f;
#pragma unroll
        for (int j = 0; j < 4; ++j) { v[j] = gelu_tanh(bf2f(rp[lane + 64 * j])); sm += v[j]; }
        const float mean = wave_sum(sm) * (1.0f / 256.0f); float q = 0.f;
#pragma unroll
        for (int j = 0; j < 4; ++j) { v[j] -= mean; q += v[j] * v[j]; }
        const float rstd = rsqrtf(wave_sum(q) * (1.0f / 256.0f) + LN_EPS);
#pragma unroll
        for (int j = 0; j < 4; ++j) Vt[(lane + 64 * j) * 136 + s] = (bf16_t)f2bf(v[j] * rstd * g4[j] + b4[j]);
    }
    __syncthreads();
    const int g = w >> 1, c0 = g * 64 + (w & 1) * 32, fr = lane & 15, fq = lane >> 4;
    const bf16_t* gmw = (const bf16_t*)(X.ws + WS_GMW) + (size_t)g * 128 * 128;
    const float* gmb = X.in(I_GMB) + ((size_t)l * 4 + g) * 128;
    bf16_t* ya = X.ybuf();
    for (int tt = 0; tt < 8; ++tt) {
        f32x4 acc0 = (f32x4){0.f, 0.f, 0.f, 0.f}, acc1 = acc0;
        for (int ks = 0; ks <= (tt >> 1); ++ks) {
            const bf16x8 wf = *(const bf16x8*)(gmw + (tt * 16 + fr) * 128 + ks * 32 + 8 * fq);
            const bf16x8 v0 = *(const LAS bf16x8*)(Vt + (c0 + fr) * 136 + ks * 32 + 8 * fq), v1 = *(const LAS bf16x8*)(Vt + (c0 + 16 + fr) * 136 + ks * 32 + 8 * fq);
            acc0 = mfma16(v0, wf, acc0); acc1 = mfma16(v1, wf, acc1);
        }
        const int t = tt * 16 + fr; const float bias = gmb[t];
#pragma unroll
        for (int c2 = 0; c2 < 2; ++c2) { const f32x4 a = c2 ? acc1 : acc0; const int cc = c0 + c2 * 16 + 4 * fq;
            const u32x2 uv = *(const u32x2*)(pj + (size_t)(row0 + t) * PJ + C_GU + cc);
            u32x2 o; o.x = pk2(gelu_tanh(bflo(uv.x)) * (a[0] + bias), gelu_tanh(bfhi(uv.x)) * (a[1] + bias)); o.y = pk2(gelu_tanh(bflo(uv.y)) * (a[2] + bias), gelu_tanh(bfhi(uv.y)) * (a[3] + bias));
            *(u32x2*)(ya + (size_t)(row0 + t) * 256 + cc) = o; }
    }
    __syncthreads();
}

template <int PASS>
__device__ __forceinline__ void mx_s5(const Ctx& X, int l, int wu) {
    const int lane = X.lane, fr = lane & 15, fq = lane >> 4;
    const int wgi = wu >> 3, wv = wu & 7; const int b = wgi >> 6, g = ((wgi >> 4) & 3) * 4 + (wv & 3), ch = (wgi & 15) * 2 + (wv >> 2);
    const int tb = b * SEQ + ch * 256;
    LAS float* xl = (LAS float*)(X.lds + X.wave * 16384);
    LAS bf16_t* hb = (LAS bf16_t*)(X.lds + X.wave * 16384 + 8192);
    const bf16_t* pj = X.proj();
    const bf16_t* bbT = (const bf16_t*)(X.ws + WS_S5B) + (size_t)g * 128 * 16;
    bf16x8 Bf[8];
#pragma unroll
    for (int ct = 0; ct < 8; ++ct) { Bf[ct] = (bf16x8){0, 0, 0, 0, 0, 0, 0, 0}; if (fq < 2) Bf[ct] = *(const bf16x8*)(bbT + (ct * 16 + fr) * 16 + 8 * fq); }
    const float* sa = (const float*)(X.ws + WS_S5A) + (g * 64 + lane) * 2; const float ar = sa[0], ai = sa[1];
    float hr = 0.f, hi = 0.f;
    float* st = (float*)(X.ws + WS_S5ST) + (size_t)((b * 16 + g) * 32) * 128;
    bf16x8 Cf[4]; float dsk[4];
    if (PASS == 3) {
        float pr = ar, pi = ai;
#pragma unroll
        for (int q = 0; q < 8; ++q) { const float nr = pr * pr - pi * pi, ni = 2.f * pr * pi; pr = nr; pi = ni; }
        for (int j = 0; j < ch; ++j) { const float sr = st[j * 128 + lane], si = st[j * 128 + 64 + lane]; const float nr = pr * hr - pi * hi + sr, ni = pr * hi + pi * hr + si; hr = nr; hi = ni; }
        const bf16_t* cm = (const bf16_t*)(X.ws + WS_S5C) + (size_t)g * 16 * 128;
#pragma unroll
        for (int ks = 0; ks < 4; ++ks) Cf[ks] = *(const bf16x8*)(cm + fr * 128 + ks * 32 + 8 * fq);
#pragma unroll
        for (int i = 0; i < 4; ++i) dsk[i] = X.in(I_S5D)[l * 256 + g * 16 + 4 * fq + i];
    }
    bf16_t* ycp = (bf16_t*)(X.ws + WS_YCPRE);
    for (int blk = 0; blk < 16; ++blk) {
        const int t0 = tb + blk * 16;
        bf16x8 uf = (bf16x8){0, 0, 0, 0, 0, 0, 0, 0};
        if (fq < 2) uf = *(const bf16x8*)(pj + (size_t)(t0 + fr) * PJ + C_S5 + g * 16 + 8 * fq);
#pragma unroll
        for (int ct = 0; ct < 8; ++ct) { const f32x4 a = mfma16(uf, Bf[ct], (f32x4){0.f, 0.f, 0.f, 0.f});
#pragma unroll
            for (int i = 0; i < 4; ++i) xl[(4 * fq + i) * 128 + ct * 16 + fr] = a[i]; }
#pragma unroll
        for (int t = 0; t < 16; ++t) { const float xr = xl[t * 128 + lane], xi = xl[t * 128 + 64 + lane];
            const float nr = ar * hr - ai * hi + xr, ni = ar * hi + ai * hr + xi; hr = nr; hi = ni;
            if (PASS == 3) { hb[t * 136 + lane] = (bf16_t)f2bf(hr); hb[t * 136 + 64 + lane] = (bf16_t)f2bf(hi); } }
        if (PASS == 3) {
            asm volatile("s_waitcnt lgkmcnt(0)" ::: "memory"); __builtin_amdgcn_wave_barrier();
            f32x4 acc = (f32x4){0.f, 0.f, 0.f, 0.f};
#pragma unroll
            for (int ks = 0; ks < 4; ++ks) { const bf16x8 hf = *(const LAS bf16x8*)(hb + fr * 136 + ks * 32 + 8 * fq); acc = mfma16(Cf[ks], hf, acc); }
            const u32x2 uv = *(const u32x2*)(pj + (size_t)(t0 + fr) * PJ + C_S5 + g * 16 + 4 * fq);
            const float y0 = gelu_tanh(acc[0] + dsk[0] * bflo(uv.x)), y1 = gelu_tanh(acc[1] + dsk[1] * bfhi(uv.x)), y2 = gelu_tanh(acc[2] + dsk[2] * bflo(uv.y)), y3 = gelu_tanh(acc[3] + dsk[3] * bfhi(uv.y));
            u32x2 o; o.x = pk2(y0, y1); o.y = pk2(y2, y3);
            *(u32x2*)(ycp + (size_t)(t0 + fr) * 256 + g * 16 + 4 * fq) = o;
        }
    }
    if (PASS == 1) { st[ch * 128 + lane] = hr; st[ch * 128 + 64 + lane] = hi; }
}

constexpr int SD_CM = 0, SD_BM = 18432, SD_BT = 36864, SD_XT0 = 54272, SD_XT1 = 71680, SD_MM = 89088, SD_SIN0 = 123904, SD_SIN1 = 133120, SD_DT = 142336, SD_AC = 143360, SD_END = 144384;
static_assert(SD_END <= LDS_MISC, "ssd lds");
template <int PASS>
__device__ __forceinline__ void mx_ssd(const Ctx& X, int l, int unit) {
    const int tid = X.tid, lane = X.lane, w = X.wave, fr = lane & 15, fq = lane >> 4;
    const int b = unit >> 6, c = unit & 63; const int r0 = unit * 128;
    const bf16_t* pj = X.proj();
    LAS bf16_t* Cm = (LAS bf16_t*)(X.lds + SD_CM); LAS bf16_t* Bm = (LAS bf16_t*)(X.lds + SD_BM); LAS bf16_t* Bt = (LAS bf16_t*)(X.lds + SD_BT);
    LAS bf16_t* Mm = (LAS bf16_t*)(X.lds + SD_MM);
    LAS float* dtv = (LAS float*)(X.lds + SD_DT); LAS float* acm = (LAS float*)(X.lds + SD_AC);
    const float* convw = X.in(I_CONVW) + (size_t)l * 4 * 512; const float* convb = X.in(I_CONVB) + (size_t)l * 512;
    float* sst = (float*)(X.ws + WS_SSDST); float* atot = (float*)(X.ws + WS_ATOT);
    for (int g = 0; g < 2; ++g) {
        if (tid < 256) { const int j = tid >> 7, rl = tid & 127, h = 2 * g + j;
            const float raw = bf2f(pj[(size_t)(r0 + rl) * PJ + C_DT + h]) + X.in(I_DTBIAS)[l * 4 + h];
            const float dt = softplusf_(raw); dtv[j * 128 + rl] = dt; acm[j * 128 + rl] = -expf(X.in(I_ALOG)[l * 4 + h]) * dt; }
        __syncthreads();
        float cum = 0.f;
        if (tid < 256) { const int j = tid >> 7, rl = tid & 127; for (int k = 0; k <= rl; ++k) cum += acm[j * 128 + k]; }
        __syncthreads();
        if (tid < 256) acm[tid] = cum;
        __syncthreads();
        if (PASS == 1 && tid < 2) atot[(b * 64 + c) * 32 + 2 * g + tid] = acm[tid * 128 + 127];
        constexpr int NCG = (PASS == 1) ? 24 : 32;
        for (int it = tid; it < NCG * 128; it += 512) {
            const int rl = it & 127, cg = it >> 7;
            const int chn = (cg < 16) ? g * 128 + cg * 8 : (cg < 24) ? 256 + g * 64 + (cg - 16) * 8 : 384 + g * 64 + (cg - 24) * 8;
            float a8[8];
            { const f32x4 c0 = *(const f32x4*)(convb + chn), c1 = *(const f32x4*)(convb + chn + 4); a8[0] = c0[0]; a8[1] = c0[1]; a8[2] = c0[2]; a8[3] = c0[3]; a8[4] = c1[0]; a8[5] = c1[1]; a8[6] = c1[2]; a8[7] = c1[3]; }
#pragma unroll
            for (int k = 0; k < 4; ++k) { const int sq = c * 128 + rl - 3 + k;
                if (sq >= 0) { const u32x4 xv = *(const u32x4*)(pj + (size_t)(b * SEQ + sq) * PJ + C_XBC + chn);
                    const f32x4 w0 = *(const f32x4*)(convw + k * 512 + chn), w1 = *(const f32x4*)(convw + k * 512 + chn + 4);
                    a8[0] += w0[0] * bflo(xv.x); a8[1] += w0[1] * bfhi(xv.x); a8[2] += w0[2] * bflo(xv.y); a8[3] += w0[3] * bfhi(xv.y);
                    a8[4] += w1[0] * bflo(xv.z); a8[5] += w1[1] * bfhi(xv.z); a8[6] += w1[2] * bflo(xv.w); a8[7] += w1[3] * bfhi(xv.w); } }
#pragma unroll
            for (int q = 0; q < 8; ++q) a8[q] = siluf_(a8[q]);
            if (cg < 16) { const int j = cg >> 3, p0 = (cg & 7) * 8; LAS bf16_t* Xt = (LAS bf16_t*)(X.lds + (j ? SD_XT1 : SD_XT0));
                float sc = 1.0f; if (PASS == 1) sc = __expf(acm[j * 128 + 127] - acm[j * 128 + rl]) * dtv[j * 128 + rl];
#pragma unroll
                for (int q = 0; q < 8; ++q) Xt[(p0 + q) * 136 + rl] = (bf16_t)f2bf(a8[q] * sc); }
            else if (cg < 24) { const int n0 = (cg - 16) * 8;
                if (PASS == 1) {
#pragma unroll
                    for (int q = 0; q < 8; ++q) Bt[(n0 + q) * 136 + rl] = (bf16_t)f2bf(a8[q]); }
                else { u32x4 o; o.x = pk2(a8[0], a8[1]); o.y = pk2(a8[2], a8[3]); o.z = pk2(a8[4], a8[5]); o.w = pk2(a8[6], a8[7]); *(LAS u32x4*)(Bm + rl * 72 + n0) = o; } }
            else { const int n0 = (cg - 24) * 8; u32x4 o; o.x = pk2(a8[0], a8[1]); o.y = pk2(a8[2], a8[3]); o.z = pk2(a8[4], a8[5]); o.w = pk2(a8[6], a8[7]); *(LAS u32x4*)(Cm + rl * 72 + n0) = o; }
        }
        if (PASS == 3) {
            float s0[8], s1[8];
#pragma unroll
            for (int q = 0; q < 8; ++q) { s0[q] = 0.f; s1[q] = 0.f; }
            for (int cc = 0; cc < c; ++cc) { const float* sp = sst + ((size_t)((b * 64 + cc) * 4 + 2 * g) * 4096) + tid * 8;
                const float d0 = __expf(atot[(b * 64 + cc) * 32 + 2 * g]), d1 = __expf(atot[(b * 64 + cc) * 32 + 2 * g + 1]);
                const f32x4 a0 = *(const f32x4*)sp, a1 = *(const f32x4*)(sp + 4), b0 = *(const f32x4*)(sp + 4096), b1 = *(const f32x4*)(sp + 4100);
#pragma unroll
                for (int q = 0; q < 4; ++q) { s0[q] = d0 * s0[q] + a0[q]; s0[4 + q] = d0 * s0[4 + q] + a1[q]; s1[q] = d1 * s1[q] + b0[q]; s1[4 + q] = d1 * s1[4 + q] + b1[q]; } }
            const int p = tid >> 3, n0 = (tid & 7) * 8;
            u32x4 o; o.x = pk2(s0[0], s0[1]); o.y = pk2(s0[2], s0[3]); o.z = pk2(s0[4], s0[5]); o.w = pk2(s0[6], s0[7]); *(LAS u32x4*)((LAS bf16_t*)(X.lds + SD_SIN0) + p * 72 + n0) = o;
            o.x = pk2(s1[0], s1[1]); o.y = pk2(s1[2], s1[3]); o.z = pk2(s1[4], s1[5]); o.w = pk2(s1[6], s1[7]); *(LAS u32x4*)((LAS bf16_t*)(X.lds + SD_SIN1) + p * 72 + n0) = o;
        }
        __syncthreads();
        if (PASS == 1) {
            const int j = w >> 2, pt = w & 3; const LAS bf16_t* Xt = (const LAS bf16_t*)(X.lds + (j ? SD_XT1 : SD_XT0));
            f32x4 acc[4];
#pragma unroll
            for (int nt = 0; nt < 4; ++nt) acc[nt] = (f32x4){0.f, 0.f, 0.f, 0.f};
#pragma unroll
            for (int ks = 0; ks < 4; ++ks) { const bf16x8 xf = *(const LAS bf16x8*)(Xt + (pt * 16 + fr) * 136 + ks * 32 + 8 * fq);
#pragma unroll
                for (int nt = 0; nt < 4; ++nt) { const bf16x8 bf = *(const LAS bf16x8*)(Bt + (nt * 16 + fr) * 136 + ks * 32 + 8 * fq); acc[nt] = mfma16(xf, bf, acc[nt]); } }
            float* sp = sst + (size_t)((b * 64 + c) * 4 + 2 * g + j) * 4096;
#pragma unroll
            for (int nt = 0; nt < 4; ++nt)
#pragma unroll
                for (int i = 0; i < 4; ++i) sp[(pt * 16 + 4 * fq + i) * 64 + nt * 16 + fr] = acc[nt][i];
        } else {
            const int lrow = w * 16 + fr;
            float yv[2][4][4];
#pragma unroll
            for (int j = 0; j < 2; ++j) {
                const LAS bf16_t* Xt = (const LAS bf16_t*)(X.lds + (j ? SD_XT1 : SD_XT0)); const LAS bf16_t* Sin = (const LAS bf16_t*)(X.lds + (j ? SD_SIN1 : SD_SIN0));
                const float al = acm[j * 128 + lrow];
                const bf16x8 cf0 = *(const LAS bf16x8*)(Cm + lrow * 72 + 8 * fq), cf1 = *(const LAS bf16x8*)(Cm + lrow * 72 + 32 + 8 * fq);
                const int stmax = w | 1;
                for (int st = 0; st <= stmax; ++st) {
                    f32x4 ag = (f32x4){0.f, 0.f, 0.f, 0.f};
                    if (st <= w) { const bf16x8 b0 = *(const LAS bf16x8*)(Bm + (st * 16 + fr) * 72 + 8 * fq), b1 = *(const LAS bf16x8*)(Bm + (st * 16 + fr) * 72 + 32 + 8 * fq);
                        ag = mfma16(b0, cf0, ag); ag = mfma16(b1, cf1, ag); }
                    float mv[4];
#pragma unroll
                    for (int i = 0; i < 4; ++i) { const int s = st * 16 + 4 * fq + i; mv[i] = (s <= lrow) ? ag[i] * __expf(al - acm[j * 128 + s]) * dtv[j * 128 + s] : 0.f; }
                    u32x2 o; o.x = pk2(mv[0], mv[1]); o.y = pk2(mv[2], mv[3]); *(LAS u32x2*)(Mm + lrow * 136 + st * 16 + 4 * fq) = o;
                }
                const float eal = __expf(al); const float dsk = X.in(I_SSDD)[l * 4 + 2 * g + j];
#pragma unroll
                for (int pt = 0; pt < 4; ++pt) {
                    f32x4 ad = (f32x4){0.f, 0.f, 0.f, 0.f}, ao = ad;
                    for (int ks = 0; ks <= (w >> 1); ++ks) { const bf16x8 xf = *(const LAS bf16x8*)(Xt + (pt * 16 + fr) * 136 + ks * 32 + 8 * fq), mf = *(const LAS bf16x8*)(Mm + lrow * 136 + ks * 32 + 8 * fq); ad = mfma16(xf, mf, ad); }
                    { const bf16x8 s0 = *(const LAS bf16x8*)(Sin + (pt * 16 + fr) * 72 + 8 * fq), s1 = *(const LAS bf16x8*)(Sin + (pt * 16 + fr) * 72 + 32 + 8 * fq); ao = mfma16(s0, cf0, ao); ao = mfma16(s1, cf1, ao); }
                    const int h = 2 * g + j; const u32x2 zv = *(const u32x2*)(pj + (size_t)(r0 + lrow) * PJ + C_Z + h * 64 + pt * 16 + 4 * fq);
                    const float z4[4] = {bflo(zv.x), bfhi(zv.x), bflo(zv.y), bfhi(zv.y)};
#pragma unroll
                    for (int i = 0; i < 4; ++i) { const float xs = bf2f(Xt[(pt * 16 + 4 * fq + i) * 136 + lrow]); yv[j][pt][i] = (ad[i] + eal * ao[i] + dsk * xs) * siluf_(z4[i]); }
                }
            }
            float ss = 0.f;
#pragma unroll
            for (int j = 0; j < 2; ++j)
#pragma unroll
                for (int pt = 0; pt < 4; ++pt)
#pragma unroll
                    for (int i = 0; i < 4; ++i) ss += yv[j][pt][i] * yv[j][pt][i];
            ss += __shfl_xor(ss, 16); ss += __shfl_xor(ss, 32);
            const float rs = rsqrtf(ss * (1.0f / 128.0f) + RMS_EPS);
            const float* ng = X.in(I_SSDNG) + l * 256 + g * 128; bf16_t* yd = X.ybuf() + (size_t)3 * M * 256;
#pragma unroll
            for (int j = 0; j < 2; ++j)
#pragma unroll
                for (int pt = 0; pt < 4; ++pt) { const int cc = j * 64 + pt * 16 + 4 * fq; const f32x4 gv = *(const f32x4*)(ng + cc);
                    u32x2 o; o.x = pk2(yv[j][pt][0] * rs * gv[0], yv[j][pt][1] * rs * gv[1]); o.y = pk2(yv[j][pt][2] * rs * gv[2], yv[j][pt][3] * rs * gv[3]);
                    *(u32x2*)(yd + (size_t)(r0 + lrow) * 256 + g * 128 + cc) = o; }
        }
        __syncthreads();
    }
}

__device__ __forceinline__ unsigned ord16(float s) { const _Float16 hf = (_Float16)s; const unsigned bits = (unsigned)__builtin_bit_cast(unsigned short, hf); return bits ^ ((bits & 0x8000u) ? 0xFFFFu : 0x8000u); }
__device__ __forceinline__ int cnt_ge8(const u32x4 v, unsigned c) {
    int n = 0;
    n += ((v.x & 0xFFFFu) >= c) + ((v.x >> 16) >= c); n += ((v.y & 0xFFFFu) >= c) + ((v.y >> 16) >= c);
    n += ((v.z & 0xFFFFu) >= c) + ((v.z >> 16) >= c); n += ((v.w & 0xFFFFu) >= c) + ((v.w >> 16) >= c);
    return n;
}
__device__ __forceinline__ void mx_dsa(const Ctx& X, int b, int t0) {
    const int tid = X.tid, lane = X.lane, w = X.wave, fr = lane & 15, fq = lane >> 4;
    const bf16_t* pj = X.proj(); const size_t rb = (size_t)b * SEQ;
    LAS unsigned short* sc = (LAS unsigned short*)X.lds;
    const int nk = t0 + 8, nkt = (nk + 15) >> 4;
    bf16x8 qf[2][2]; float wq[2];
#pragma unroll
    for (int ct = 0; ct < 2; ++ct) { const int q = 4 * ct + (fr >> 2), hh = fr & 3; const bf16_t* qp = pj + (rb + t0 + q) * PJ;
        qf[ct][0] = *(const bf16x8*)(qp + C_QI + hh * 64 + 8 * fq); qf[ct][1] = *(const bf16x8*)(qp + C_QI + hh * 64 + 32 + 8 * fq); wq[ct] = bf2f(qp[C_WI + hh]) * 0.0625f; }
    for (int kt = w; kt < nkt; kt += 8) {
        const bf16_t* kp = pj + (rb + kt * 16 + fr) * PJ + C_KI;
        const bf16x8 k0 = *(const bf16x8*)(kp + 8 * fq), k1 = *(const bf16x8*)(kp + 32 + 8 * fq);
#pragma unroll
        for (int ct = 0; ct < 2; ++ct) {
            f32x4 a = mfma16(k0, qf[ct][0], (f32x4){0.f, 0.f, 0.f, 0.f}); a = mfma16(k1, qf[ct][1], a);
            const int q = 4 * ct + (fr >> 2); unsigned kk[4];
#pragma unroll
            for (int i = 0; i < 4; ++i) { float s = fmaxf(a[i], 0.f) * wq[ct]; s += __shfl_xor(s, 1); s += __shfl_xor(s, 2); s += 0.0f;
                const int key = kt * 16 + 4 * fq + i; kk[i] = (key <= t0 + q) ? ord16(s) : 0u; }
            if ((fr & 3) == 0) { u32x2 o; o.x = kk[0] | (kk[1] << 16); o.y = kk[2] | (kk[3] << 16); *(LAS u32x2*)(sc + q * 8192 + kt * 16 + 4 * fq) = o; }
        }
    }
    { const int z0 = nkt * 16, z1 = ((nk + 511) >> 9) << 9;
        for (int i = z0 + tid; i < z1; i += 512) {
#pragma unroll
            for (int q = 0; q < 8; ++q) sc[q * 8192 + i] = 0; } }
    __syncthreads();
    const int t = t0 + w, nv = t + 1;
    LAS unsigned short* row = sc + w * 8192;
    LAS unsigned short* list = (LAS unsigned short*)(X.lds + 131072 + w * 512);
    const int nsel = nv < 256 ? nv : 256;
    if (nv <= 256) { for (int n = lane; n < 256; n += 64) list[n] = (unsigned short)n; }
    else {
        const int nit = (nv + 511) >> 9;
        unsigned thr = 0u; int cge = nv;
        for (int bit = 15; bit >= 0; --bit) { const unsigned cand = thr | (1u << bit); int n = 0;
            for (int it = 0; it < nit; ++it) n += cnt_ge8(*(const LAS u32x4*)(row + (it * 64 + lane) * 8), cand);
            n = wave_sum_i(n); if (n >= 256) { thr = cand; cge = n; } }
        int cgt = 0;
        { const unsigned cand = thr + 1u; int n = 0; for (int it = 0; it < nit; ++it) n += cnt_ge8(*(const LAS u32x4*)(row + (it * 64 + lane) * 8), cand); cgt = wave_sum_i(n); }
        const int r = 256 - cgt, ties = cge - cgt;
        const unsigned cmin = (ties == r) ? thr : thr + 1u;
        const unsigned long long lt_mask = (1ull << lane) - 1ull; int bcnt = 0;
        for (int it = 0; it < nit; ++it) { const u32x4 v = *(const LAS u32x4*)(row + (it * 64 + lane) * 8); const int base = (it * 64 + lane) * 8;
            const unsigned e[8] = {v.x & 0xFFFFu, v.x >> 16, v.y & 0xFFFFu, v.y >> 16, v.z & 0xFFFFu, v.z >> 16, v.w & 0xFFFFu, v.w >> 16};
#pragma unroll
            for (int j = 0; j < 8; ++j) { const bool sl = e[j] >= cmin; const unsigned long long bm = __ballot(sl);
                if (sl) list[(bcnt + __popcll(bm & lt_mask)) & 255] = (unsigned short)(base + j); bcnt += __popcll(bm); } }
        if (ties != r) {
            int taken = 0;
            for (int it = 0; it < nit && taken < r; ++it) { const u32x4 v = *(const LAS u32x4*)(row + (it * 64 + lane) * 8); const int base = (it * 64 + lane) * 8;
                const unsigned e[8] = {v.x & 0xFFFFu, v.x >> 16, v.y & 0xFFFFu, v.y >> 16, v.z & 0xFFFFu, v.z >> 16, v.w & 0xFFFFu, v.w >> 16};
                int mcount = 0;
#pragma unroll
                for (int j = 0; j < 8; ++j) mcount += (e[j] == thr);
                int incl = mcount;
#pragma unroll
                for (int o = 1; o < 64; o <<= 1) { const int up = __shfl_up(incl, o); if (lane >= o) incl += up; }
                const int total = __shfl(incl, 63); int rk = taken + incl - mcount;
#pragma unroll
                for (int j = 0; j < 8; ++j) if (e[j] == thr) { if (rk < r) list[cgt + rk] = (unsigned short)(base + j); ++rk; }
                taken += total; }
        }
    }
    __builtin_amdgcn_fence(__ATOMIC_RELEASE, "workgroup"); __builtin_amdgcn_wave_barrier();
    const bf16_t* qrow = pj + (rb + t) * PJ;
    bf16x8 qb0 = (bf16x8){0, 0, 0, 0, 0, 0, 0, 0}, qb1 = qb0;
    if (fr < 4) { qb0 = *(const bf16x8*)(qrow + C_Q + fr * 64 + 8 * fq); qb1 = *(const bf16x8*)(qrow + C_Q + fr * 64 + 32 + 8 * fq); }
    LAS float* Pb = (LAS float*)row;
    LAS float* pinv = (LAS float*)(X.lds + 131072 + 4096 + 256 + w * 16);
#pragma unroll 2
    for (int tile = 0; tile < 16; ++tile) {
        const int n = tile * 16 + fr; const int idx = (n < nsel) ? (int)list[n] : 0;
        const bf16_t* kp = pj + (rb + idx) * PJ + C_K;
        const bf16x8 k0 = *(const bf16x8*)(kp + 8 * fq), k1 = *(const bf16x8*)(kp + 32 + 8 * fq);
        f32x4 a = mfma16(k0, qb0, (f32x4){0.f, 0.f, 0.f, 0.f}); a = mfma16(k1, qb1, a);
        if (fr < 4) {
#pragma unroll
            for (int i = 0; i < 4; ++i) { const int nn = tile * 16 + 4 * fq + i; Pb[nn * 4 + fr] = (nn < nsel) ? a[i] * 0.125f : -3.0e38f; } }
    }
    __builtin_amdgcn_fence(__ATOMIC_RELEASE, "workgroup"); __builtin_amdgcn_wave_barrier();
    { const int hd = lane & 3, nb0 = lane >> 2;
        float v16[16]; float mx = -3.0e38f;
#pragma unroll
        for (int j = 0; j < 16; ++j) { v16[j] = Pb[(nb0 + 16 * j) * 4 + hd]; mx = fmaxf(mx, v16[j]); }
        mx = fmaxf(mx, __shfl_xor(mx, 4)); mx = fmaxf(mx, __shfl_xor(mx, 8)); mx = fmaxf(mx, __shfl_xor(mx, 16)); mx = fmaxf(mx, __shfl_xor(mx, 32));
        float sm = 0.f;
#pragma unroll
        for (int j = 0; j < 16; ++j) { const float p = (v16[j] > -1.0e38f) ? __expf(v16[j] - mx) : 0.f; sm += p; Pb[(nb0 + 16 * j) * 4 + hd] = p; }
        sm += __shfl_xor(sm, 4); sm += __shfl_xor(sm, 8); sm += __shfl_xor(sm, 16); sm += __shfl_xor(sm, 32);
        if (lane < 4) pinv[lane] = 1.0f / sm; }
    __builtin_amdgcn_fence(__ATOMIC_RELEASE, "workgroup"); __builtin_amdgcn_wave_barrier();
    float o4[4][4];
#pragma unroll
    for (int h = 0; h < 4; ++h)
#pragma unroll
        for (int dd = 0; dd < 4; ++dd) o4[h][dd] = 0.f;
    const int d4 = fr * 4;
    for (int n0 = 0; n0 < nsel; n0 += 4) { const int n = n0 + fq;
        if (n < nsel) { const int idx = (int)list[n]; const u32x2 vv = *(const u32x2*)(pj + (rb + idx) * PJ + C_V + d4); const f32x4 p4 = *(const LAS f32x4*)(Pb + n * 4);
            const float v0 = bflo(vv.x), v1 = bfhi(vv.x), v2 = bflo(vv.y), v3 = bfhi(vv.y);
#pragma unroll
            for (int h = 0; h < 4; ++h) { o4[h][0] += p4[h] * v0; o4[h][1] += p4[h] * v1; o4[h][2] += p4[h] * v2; o4[h][3] += p4[h] * v3; } } }
#pragma unroll
    for (int h = 0; h < 4; ++h)
#pragma unroll
        for (int dd = 0; dd < 4; ++dd) { float v = o4[h][dd]; v += __shfl_xor(v, 16); v += __shfl_xor(v, 32); o4[h][dd] = v; }
    { const int h = fq; const float iv = pinv[h];
        float r4[4];
#pragma unroll
        for (int dd = 0; dd < 4; ++dd) r4[dd] = ((h == 0) ? o4[0][dd] : (h == 1) ? o4[1][dd] : (h == 2) ? o4[2][dd] : o4[3][dd]) * iv;
        u32x2 o; o.x = pk2(r4[0], r4[1]); o.y = pk2(r4[2], r4[3]);
        *(u32x2*)(X.ybuf() + (size_t)1 * M * 256 + (rb + t) * 256 + h * 64 + d4) = o; }
    __syncthreads();
}

__device__ __forceinline__ void ph_ln1_router(const Ctx& X, int l) {
    const int lane = X.lane, w = X.wave, tid = X.tid;
    LAS float* rw = (LAS float*)X.lds;
    LAS float* hrow = (LAS float*)(X.lds + 131072 + w * 2048);
    LAS unsigned* wgcnt = (LAS unsigned*)(X.lds + 131072 + 16384);
    { const float* src = X.in(I_RW) + (size_t)l * D * NEXP; for (int i = tid; i < D * NEXP / 4; i += 512) *(LAS f32x4*)(rw + 4 * i) = *(const f32x4*)(src + 4 * i); }
    if (tid < 32) wgcnt[tid] = 0u;
    __syncthreads();
    float* xo = X.a->out; bf16_t* hb = X.hbuf();
    const int tok0 = X.c * 128, b = tok0 >> 13;
    const float* mv = X.modv(l, 1) + b * 3072;
    const float* lg = X.in(I_LN1G) + l * D; const float* lb = X.in(I_LN1B) + l * D;
    const int e = lane & 31, half = lane >> 5;
    const float rbias = X.in(I_RB)[l * NEXP + e];
    unsigned* pinfo = (unsigned*)(X.ws + WS_PINFO); float* pgate = (float*)(X.ws + WS_PGATE);
    for (int i = 0; i < 16; ++i) {
        const int tok = tok0 + w * 16 + i;
        f32x4 v[4]; float s = 0.f;
#pragma unroll
        for (int j = 0; j < 4; ++j) { v[j] = *(const f32x4*)(xo + (size_t)tok * D + 4 * lane + 256 * j); s += (v[j][0] + v[j][1]) + (v[j][2] + v[j][3]); }
        const float mean = wave_sum(s) * (1.0f / D); float q = 0.f;
#pragma unroll
        for (int j = 0; j < 4; ++j) { v[j] = v[j] - mean; q += (v[j][0] * v[j][0] + v[j][1] * v[j][1]) + (v[j][2] * v[j][2] + v[j][3] * v[j][3]); }
        const float rstd = rsqrtf(wave_sum(q) * (1.0f / D) + LN_EPS);
        f32x4 hv[4];
#pragma unroll
        for (int j = 0; j < 4; ++j) { const int col = 4 * lane + 256 * j;
            const f32x4 x1 = v[j] * rstd * *(const f32x4*)(lg + col) + *(const f32x4*)(lb + col);
            *(f32x4*)(xo + (size_t)tok * D + col) = x1 * DN_ALPHA;
            hv[j] = x1 * (*(const f32x4*)(mv + 1024 + col) + 1.0f) + *(const f32x4*)(mv + col);
            u32x2 o; o.x = pk2(hv[j][0], hv[j][1]); o.y = pk2(hv[j][2], hv[j][3]); *(u32x2*)(hb + (size_t)tok * D + col) = o; }
        float accr = 0.f;
#pragma unroll
        for (int blk = 0; blk < 2; ++blk) {
            *(LAS f32x4*)(hrow + 4 * lane) = hv[2 * blk]; *(LAS f32x4*)(hrow + 256 + 4 * lane) = hv[2 * blk + 1];
            __builtin_amdgcn_fence(__ATOMIC_RELEASE, "workgroup"); __builtin_amdgcn_wave_barrier();
            const LAS float* hp = hrow + half * 256; const LAS float* rp = rw + (size_t)(blk * 512 + half * 256) * 32 + e;
#pragma unroll 8
            for (int d = 0; d < 256; d += 4) { const f32x4 h4 = *(const LAS f32x4*)(hp + d);
                accr += h4[0] * rp[(d + 0) * 32]; accr += h4[1] * rp[(d + 1) * 32]; accr += h4[2] * rp[(d + 2) * 32]; accr += h4[3] * rp[(d + 3) * 32]; }
            __builtin_amdgcn_fence(__ATOMIC_RELEASE, "workgroup"); __builtin_amdgcn_wave_barrier();
        }
        accr += __shfl_xor(accr, 32);
        const float score = sigmoidf_(accr), biased = score + rbias;
        const int gbase = lane & ~3;
        const float v0 = __shfl(biased, gbase), v1 = __shfl(biased, gbase + 1), v2 = __shfl(biased, gbase + 2), v3 = __shfl(biased, gbase + 3);
        const float a_ = fmaxf(v0, v1), b_ = fminf(v0, v1), c_ = fmaxf(v2, v3), d_ = fminf(v2, v3);
        const float gs = fmaxf(a_, c_) + fmaxf(fminf(a_, c_), fmaxf(b_, d_));
        const int myg = e >> 2; int grank = 0;
#pragma unroll
        for (int g2 = 0; g2 < 8; ++g2) { const float o = __shfl(gs, 4 * g2); grank += (o > gs || (o == gs && g2 < myg)) ? 1 : 0; }
        const float masked = (grank < 4) ? biased : -3.0e38f;
        int erank = 0;
#pragma unroll
        for (int e2 = 0; e2 < 32; ++e2) { const float o = __shfl(masked, e2); erank += (o > masked || (o == masked && e2 < e)) ? 1 : 0; }
        const bool sel = (erank < 8) && (lane < 32);
        const float wsum = wave_sum(sel ? score : 0.f);
        const float gate = score / wsum * 2.5f;
        const unsigned long long bal = __ballot(sel);
        if (sel) { const int k = __popcll(bal & ((1ull << lane) - 1ull));
            const unsigned lr = __hip_atomic_fetch_add(wgcnt + e, 1u, __ATOMIC_RELAXED, __HIP_MEMORY_SCOPE_WORKGROUP);
            pinfo[(size_t)tok * 8 + k] = (unsigned)e | (lr << 8); pgate[(size_t)tok * 8 + k] = gate; }
    }
    __syncthreads();
    if (tid < 32) { const int chunk = tok0 / CHTOK; unsigned* cnt = (unsigned*)(X.ws + WS_CTL) + CW_CNT + (l * NCH + chunk) * 64;
        const unsigned base = __hip_atomic_fetch_add(cnt + tid, wgcnt[tid], __ATOMIC_RELAXED, __HIP_MEMORY_SCOPE_AGENT);
        ((unsigned*)(X.ws + WS_WGBASE))[X.c * 32 + tid] = base; }
    __syncthreads();
}

__device__ __forceinline__ void moe_offsets(const Ctx& X, int l, int chunk, LAS int* off  , LAS int* cntl  ) {
    if (X.tid == 0) { const unsigned* cnt = (const unsigned*)(X.ws + WS_CTL) + CW_CNT + (l * NCH + chunk) * 64; int o = 0;
        for (int e = 0; e < NE1; ++e) { const int cn = (e < NEXP) ? (int)__hip_atomic_load(cnt + e, __ATOMIC_RELAXED, __HIP_MEMORY_SCOPE_AGENT) : CHTOK; off[e] = o; cntl[e] = cn; o += ((cn + 255) >> 8) << 8; }
        off[NE1] = o; }
    __syncthreads();
}
#define ST_WT(p, v) __hip_atomic_store((p), (v), __ATOMIC_RELAXED, __HIP_MEMORY_SCOPE_AGENT)
__device__ __forceinline__ void ph_fill(const Ctx& X, int l) {
    LAS int* off = (LAS int*)(X.lds); LAS int* cntl = off + 64;
    const int tok0 = X.c * 128, chunk = tok0 / CHTOK;
    moe_offsets(X, l, chunk, off, cntl);
    unsigned* rowtok = (unsigned*)(X.ws + WS_ROWTOK) + (size_t)chunk * CH_ROWS; float* rowgate = (float*)(X.ws + WS_ROWGATE) + (size_t)chunk * CH_ROWS;
    const unsigned* pinfo = (const unsigned*)(X.ws + WS_PINFO); const float* pgate = (const float*)(X.ws + WS_PGATE); unsigned* slot = (unsigned*)(X.ws + WS_SLOT);
    const unsigned* wgb = (const unsigned*)(X.ws + WS_WGBASE) + X.c * 32;
    for (int i = X.tid; i < 1024; i += 512) { const size_t pi = (size_t)tok0 * 8 + i; const unsigned inf = pinfo[pi]; const int e = inf & 255, lr = inf >> 8;
        const int pos = off[e] + (int)wgb[e] + lr; ST_WT(rowtok + pos, (unsigned)(tok0 + (i >> 3))); ST_WT((unsigned*)rowgate + pos, __builtin_bit_cast(unsigned, pgate[pi])); slot[pi] = (unsigned)pos; }
    if (X.tid < 128) { const int tok = tok0 + X.tid; const int pos = off[NEXP] + (tok - chunk * CHTOK); ST_WT(rowtok + pos, (unsigned)tok); ST_WT((unsigned*)rowgate + pos, __builtin_bit_cast(unsigned, 1.0f)); }
    const int wl = X.c & 63;
    if (wl < NEXP) { const int e = wl; const int p0 = off[e] + cntl[e], p1 = off[e + 1]; for (int p = p0 + X.tid; p < p1; p += 512) { ST_WT(rowtok + p, (unsigned)(chunk * CHTOK)); ST_WT((unsigned*)rowgate + p, 0u); } }
    __syncthreads();
}

template <int NT, bool GATH>
struct MoeOrder {
    static constexpr bool GATHER = GATH;
    int nwg, G, c; const LAS unsigned char* tile_e; const LAS int* rowtab;
    __device__ __forceinline__ bool next(int i, pg8::Unit& u) const {
        const long L = (long)i * G + c; if (L >= nwg) return false;
        const int wgid = pg8::xcd_remap((int)L, nwg); const int tau = wgid / NT, pn = wgid % NT;
        u.pm = tau; u.pn = pn; u.bt = (int)tile_e[tau] * NT + pn; u.ab = i; return true;
    }
    __device__ __forceinline__ int row_of(const pg8::Unit& u, int r) const { return rowtab[u.ab * 256 + r]; }
    __device__ __forceinline__ void a_ready(const pg8::Unit&) const {}
    __device__ __forceinline__ void done(const pg8::Unit&) const {}
};
__device__ __forceinline__ int moe_tiles(const Ctx& X, int l, int chunk, LAS unsigned char* tile_e, LAS int* off, LAS int* cntl) {
    moe_offsets(X, l, chunk, off, cntl);
    const int ntile = off[NE1] >> 8;
    for (int t = X.tid; t < ntile; t += 512) { int e = 0; for (int q = 1; q < NE1; ++q) e += (off[q] <= t * 256) ? 1 : 0; tile_e[t] = (unsigned char)e; }
    __syncthreads();
    return ntile;
}

__device__ __forceinline__ void ph_combine(const Ctx& X, int l, int chunk, LAS int* off) {
    const int lane = X.lane; const int gw = X.c * 8 + X.wave;
    float* xo = X.a->out; bf16_t* hb = X.hbuf();
    const bf16_t* op = (const bf16_t*)(X.ws + WS_OPAIR); const unsigned* slot = (const unsigned*)(X.ws + WS_SLOT);
    const int b = (chunk * CHTOK) >> 13; const float* mv2 = X.modv(l, 1) + b * 3072;
    const float* lg = X.in(I_LN2G) + l * D; const float* lb = X.in(I_LN2B) + l * D;
    const int offsh = off[NEXP];
    for (int i = 0; i < 4; ++i) {
        const int tok = chunk * CHTOK + gw * 4 + i;
        f32x4 sm[4];
#pragma unroll
        for (int j = 0; j < 4; ++j) sm[j] = (f32x4){0.f, 0.f, 0.f, 0.f};
#pragma unroll
        for (int k = 0; k < 9; ++k) { const int pos = (k < 8) ? (int)slot[(size_t)tok * 8 + k] : offsh + (tok - chunk * CHTOK);
            const bf16_t* rp = op + (size_t)pos * 1024 + 4 * lane;
#pragma unroll
            for (int j = 0; j < 4; ++j) { const u32x2 q = *(const u32x2*)(rp + 256 * j); sm[j][0] += bflo(q.x); sm[j][1] += bfhi(q.x); sm[j][2] += bflo(q.y); sm[j][3] += bfhi(q.y); } }
        f32x4 v[4]; float s = 0.f;
#pragma unroll
        for (int j = 0; j < 4; ++j) { const int col = 4 * lane + 256 * j; v[j] = *(const f32x4*)(xo + (size_t)tok * D + col) + (*(const f32x4*)(mv2 + 2048 + col) + 1.0f) * sm[j]; s += (v[j][0] + v[j][1]) + (v[j][2] + v[j][3]); }
        const float mean = wave_sum(s) * (1.0f / D); float q = 0.f;
#pragma unroll
        for (int j = 0; j < 4; ++j) { v[j] = v[j] - mean; q += (v[j][0] * v[j][0] + v[j][1] * v[j][1]) + (v[j][2] * v[j][2] + v[j][3] * v[j][3]); }
        const float rstd = rsqrtf(wave_sum(q) * (1.0f / D) + LN_EPS);
#pragma unroll
        for (int j = 0; j < 4; ++j) { const int col = 4 * lane + 256 * j;
            const f32x4 x2 = v[j] * rstd * *(const f32x4*)(lg + col) + *(const f32x4*)(lb + col);
            *(f32x4*)(xo + (size_t)tok * D + col) = x2;
            if (l + 1 < DEPTH) { const float* mv1 = X.modv(l + 1, 0) + b * 3072; const f32x4 hn = x2 * (*(const f32x4*)(mv1 + 1024 + col) + 1.0f) + *(const f32x4*)(mv1 + col);
                u32x2 o; o.x = pk2(hn[0], hn[1]); o.y = pk2(hn[2], hn[3]); *(u32x2*)(hb + (size_t)tok * D + col) = o; } }
    }
}

struct POrder : pg8::StaticOrder { __device__ __forceinline__ bool next(int i, pg8::Unit& u) const { if (!pg8::StaticOrder::next(i, u)) return false; u.ab = u.pn >> 2; return true; } };
struct GOrder { static constexpr bool GATHER = false; int G, c;
    __device__ __forceinline__ bool next(int i, pg8::Unit& u) const { const int tile = (i >> 2) * G + c; if (tile >= 512) return false; const int wg = pg8::xcd_remap(tile, 512); const int br = i & 3, mt = wg & 3;
        u.pm = wg >> 2; u.pn = br * 4 + mt; u.bt = br * 4 + mt; u.ab = 0; return true; }
    __device__ __forceinline__ void a_ready(const pg8::Unit&) const {} __device__ __forceinline__ void done(const pg8::Unit&) const {} };
__global__ void __launch_bounds__(512, 2) fwd_kernel(Args args) {
    extern __shared__ __attribute__((aligned(16))) unsigned char lds_raw[];
    ArgsP ap = (ArgsP)__builtin_amdgcn_kernarg_segment_ptr();
    Ctx X; X.a = ap; X.ws = ap->ws; X.lds = (LAS unsigned char*)lds_raw;
    X.tid = threadIdx.x; X.lane = X.tid & 63; X.wave = __builtin_amdgcn_readfirstlane(X.tid >> 6); X.G = gridDim.x;
    { const int bx = blockIdx.x; X.bx = bx; X.c = (X.G % 8 == 0) ? (bx % 8) * (X.G / 8) + bx / 8 : bx; }
    volatile LAS unsigned* misc = (volatile LAS unsigned*)(X.lds + LDS_MISC);
    if (X.tid < 16) misc[X.tid] = 0u;
    __syncthreads();
    XcdBarrier bar; bar.bar = (unsigned*)(X.ws + WS_CTL) + CW_BAR; bar.x = 0; bar.st = misc;
#if !MK_PER_PHASE
    bar = xcd_barrier_post((unsigned*)(X.ws + WS_CTL) + CW_BAR, misc);
#endif
    const int lo = ap->ph_lo, hi = ap->ph_hi; int ph = 0;
#define PH_BEGIN if (ph >= lo && ph < hi) { { ArgsP apl = ap; asm volatile("" : "+s"(apl)); X.a = apl; X.ws = apl->ws; int t_ = threadIdx.x; asm volatile("" : "+v"(t_)); X.tid = t_; X.lane = t_ & 63; X.wave = __builtin_amdgcn_readfirstlane(t_ >> 6); } unsigned char* wb = X.ws + WS_W; LAS unsigned char* gl = X.lds; const float* xin = (l_ == 0) ? X.in(I_X) : (const float*)X.a->out; (void)wb; (void)gl; (void)xin;
#if MK_PER_PHASE
#define PH_END } ++ph;
#else
#define PH_END if (ph + 1 < hi) xcd_barrier(bar); } ++ph;
#endif
    int l_ = 0;
    PH_BEGIN if (EN_PROLOGUE)  ph_prologue(X); PH_END
    for (int l = 0; l < DEPTH; ++l) {
        l_ = l;
        PH_BEGIN if (EN_WCONV)  ph_wconv(X, l); PH_END
        PH_BEGIN if (EN_GWIN)  { pg8::Gemm g{X.hbuf(), (const bf16_t*)(wb + WO_IN), 1024, 0}; pg8::StaticOrder S; S.init(M, PJ, X.G, X.bx); pg8::EpiBf16 E{X.proj(), PJ};
            pg8::gemm_phase<pg8::EpiBf16, pg8::StaticOrder, G_ALIGN, G_SP2>(gl, g, S, E, X.tid); } PH_END
        PH_BEGIN if (EN_MX1)  {
            mx_rope(X);
            for (int u = X.c; u < 256; u += X.G) mx_gmlp(X, l, u);
            for (int wu = X.c * 8 + X.wave; wu < 2048; wu += X.G * 8) mx_s5<1>(X, l, wu);
            __syncthreads();
            for (int u = X.c; u < 256; u += X.G) mx_ssd<1>(X, l, u);
        } PH_END
        PH_BEGIN if (EN_MX2)  {
            for (int r = 0; r < 16; ++r) { const int uu = (r & 1) ? r * 256 + 255 - X.c : r * 256 + X.c; if (X.c < 256) mx_dsa(X, uu & 3, (uu >> 2) * 8); }
            __syncthreads();
            for (int wu = X.c * 8 + X.wave; wu < 2048; wu += X.G * 8) mx_s5<3>(X, l, wu);
            __syncthreads();
            for (int u = X.c; u < 256; u += X.G) mx_ssd<3>(X, l, u);
        } PH_END
        PH_BEGIN if (EN_GLU)  { pg8::Gemm g{(const bf16_t*)(X.ws + WS_YCPRE), (const bf16_t*)(wb + WO_GLU), 256, 0}; pg8::StaticOrder S; S.init(M, 256, X.G, X.bx);
            pg8::EpiGlu E{(const bf16_t*)(X.ws + WS_YCPRE), X.ybuf() + (size_t)2 * M * 256, X.in(I_S5GLUB) + l * 256};
            pg8::gemm_phase<pg8::EpiGlu, pg8::StaticOrder, G_ALIGN, G_SP2>(gl, g, S, E, X.tid); } PH_END
        PH_BEGIN if (EN_GP)  { pg8::Gemm g{X.ybuf(), (const bf16_t*)(wb + WO_BR), 256, (size_t)M * 256};
            POrder S;
            S.init(M, 4096, X.G, X.bx); pg8::EpiBf16 E{(bf16_t*)(X.ws + WS_P), 4096};
            pg8::gemm_phase<pg8::EpiBf16, POrder, G_ALIGN, G_SP2>(gl, g, S, E, X.tid); } PH_END
        PH_BEGIN if (EN_GGATE)  { pg8::Gemm g{X.hbuf(), (const bf16_t*)(wb + WO_GATE), 1024, 0};
            GOrder S{X.G, X.bx};
            pg8::EpiGateMerge E{(const bf16_t*)(X.ws + WS_P), X.ybuf()};
            pg8::gemm_phase<pg8::EpiGateMerge, GOrder, G_ALIGN, G_SP2>(gl, g, S, E, X.tid); } PH_END
        PH_BEGIN if (EN_GOUT)  { pg8::Gemm g{X.ybuf(), (const bf16_t*)(wb + WO_OUT), 1024, 0}; pg8::StaticOrder S; S.init(M, 1024, X.G, X.bx);
            pg8::EpiResid E{xin, X.a->out, X.modv(l, 0)};
            pg8::gemm_phase<pg8::EpiResid, pg8::StaticOrder, G_ALIGN, G_SP2>(gl, g, S, E, X.tid); } PH_END
        PH_BEGIN if (EN_LN1)  ph_ln1_router(X, l); PH_END
        PH_BEGIN if (EN_FILL)  ph_fill(X, l); PH_END
        for (int ch = 0; ch < NCH; ++ch) {
            PH_BEGIN if (EN_MOE1)  {
                LAS int* off = (LAS int*)(X.lds + LDS_TAB + 1024); LAS int* cntl = off + 64; LAS unsigned char* tile_e = (LAS unsigned char*)(X.lds + LDS_TAB + 2048);
                if (ch > 0) { moe_offsets(X, l, ch - 1, off, cntl); ph_combine(X, l, ch - 1, off); __syncthreads(); }
                const int ntile = moe_tiles(X, l, ch, tile_e, off, cntl);
                pg8::Gemm g{X.hbuf(), (const bf16_t*)(wb + WO_13), 1024, 0};
                LAS int* rowtab = (LAS int*)(X.lds + LDS_TAB + 4096);
                MoeOrder<2, true> S{ntile * 2, X.G, X.bx, tile_e, rowtab};
                { const unsigned* rowtok = (const unsigned*)(X.ws + WS_ROWTOK) + (size_t)ch * CH_ROWS; pg8::Unit uu;
                  for (int i = 0; i < 4; ++i) { if (!S.next(i, uu)) break; if (X.tid < 256) rowtab[i * 256 + X.tid] = (int)rowtok[uu.pm * 256 + X.tid]; } }
                __syncthreads();
                pg8::EpiMoe1 E{(bf16_t*)(X.ws + WS_ACT), (const float*)(X.ws + WS_ROWGATE) + (size_t)ch * CH_ROWS};
                pg8::gemm_phase<pg8::EpiMoe1, MoeOrder<2, true>, G_ALIGN, G_SP2>(gl, g, S, E, X.tid);
            } PH_END
            PH_BEGIN if (EN_MOE2)  {
                LAS int* off = (LAS int*)(X.lds + LDS_TAB + 1024); LAS int* cntl = off + 64; LAS unsigned char* tile_e = (LAS unsigned char*)(X.lds + LDS_TAB + 2048);
                const int ntile = moe_tiles(X, l, ch, tile_e, off, cntl);
                pg8::Gemm g{(const bf16_t*)(X.ws + WS_ACT), (const bf16_t*)(wb + WO_2), 256, 0};
                MoeOrder<4, false> S{ntile * 4, X.G, X.bx, tile_e, nullptr};
                pg8::EpiBf16 E{(bf16_t*)(X.ws + WS_OPAIR), 1024};
                pg8::gemm_phase<pg8::EpiBf16, MoeOrder<4, false>, G_ALIGN, G_SP2>(gl, g, S, E, X.tid);
            } PH_END
        }
        PH_BEGIN if (EN_FIN)  { LAS int* off = (LAS int*)(X.lds + LDS_TAB + 1024); LAS int* cntl = off + 64; moe_offsets(X, l, NCH - 1, off, cntl); ph_combine(X, l, NCH - 1, off); } PH_END
    }
#undef PH_BEGIN
#undef PH_END
}
constexpr int N_PHASES = 1 + DEPTH * (10 + 2 * NCH + 1);

#ifdef DBG_DUMP_OFF
__global__ void dbg_dump(const bf16_t* src, float* out, size_t n) { for (size_t i = (size_t)blockIdx.x * blockDim.x + threadIdx.x; i < n; i += (size_t)gridDim.x * blockDim.x) {
#ifdef DBG_HASH_OUT
    const unsigned bits = __builtin_bit_cast(unsigned, out[i]); out[i] = (float)((bits * 2654435761u) >> 8) * (1.0f / 16777216.0f);
#else
    const unsigned bits = src[i]; out[i] = (float)(((bits + 1u) * 2654435761u) >> 8) * (1.0f / 16777216.0f);
#endif
} }
#endif
extern "C" void kernel_launch(void* const* d_in, const int* in_sizes, int n_in, void* d_out, int out_size, void* d_ws, size_t ws_size, hipStream_t stream) {
    static int grid = 0;
    if (grid == 0) {
        if (n_in != 43 || out_size != M * D || ws_size < WS_NEED) { fprintf(stderr, "kernel_launch: unexpected shapes (n_in %d out %d ws %zu)\n", n_in, out_size, ws_size); grid = -1; return; }
        int dev = 0, cus = 0, per_cu = 0;
        if (hipGetDevice(&dev) != hipSuccess || hipDeviceGetAttribute(&cus, hipDeviceAttributeMultiprocessorCount, dev) != hipSuccess) { grid = -1; return; }
        if (hipFuncSetAttribute((const void*)fwd_kernel, hipFuncAttributeMaxDynamicSharedMemorySize, LDS_BYTES) != hipSuccess) { fprintf(stderr, "kernel_launch: hipFuncSetAttribute failed\n"); grid = -1; return; }
        if (hipOccupancyMaxActiveBlocksPerMultiprocessor(&per_cu, (const void*)fwd_kernel, 512, LDS_BYTES) != hipSuccess || per_cu < 1) fprintf(stderr, "kernel_launch: occupancy query says %d\n", per_cu);
        (void)hipGetLastError();
        grid = cus < 256 ? cus : 256;
    }
    if (grid < 0) return;
    (void)hipMemsetAsync((char*)d_ws + WS_CTL, 0, CTL_BYTES, stream);
#ifdef DBG_POISON
    (void)hipMemsetAsync((char*)d_ws + CTL_BYTES, 0xFF, WS_NEED - CTL_BYTES, stream);
    (void)hipMemsetAsync((char*)d_out, 0xFF, (size_t)M * D * 4, stream);
#endif
    Args a{};
    for (int i = 0; i < 43; ++i) a.in[i] = (const float*)d_in[i];
    a.positions = (const int*)d_in[I_POS]; a.out = (float*)d_out; a.ws = (unsigned char*)d_ws;
#if MK_PER_PHASE
#ifndef DBG_NPH
#define DBG_NPH N_PHASES
#endif
    for (int p = 0; p < DBG_NPH; ++p) { a.ph_lo = p; a.ph_hi = p + 1; hipLaunchKernelGGL(fwd_kernel, dim3(grid), dim3(512), LDS_BYTES, stream, a); }
#ifdef DBG_DUMP_OFF
    hipLaunchKernelGGL(dbg_dump, dim3(2048), dim3(256), 0, stream, (const bf16_t*)((const char*)d_ws + (size_t)(DBG_DUMP_OFF)), (float*)d_out, (size_t)M * D);
#endif
#else
    a.ph_lo = 0; a.ph_hi = N_PHASES; hipLaunchKernelGGL(fwd_kernel, dim3(grid), dim3(512), LDS_BYTES, stream, a);
#endif
}
```

```cpp
#include <hip/hip_runtime.h>
#include <cstdio>
#include <cstdint>


#ifndef DSA_PM
#define DSA_PM 0
#endif
#ifndef R_S1
#define R_S1 1
#endif
#ifndef R_S2
#define R_S2 1
#endif
#ifndef R_S3
#define R_S3 1
#endif
#ifndef EN_DSA
#define EN_DSA 1
#endif
#ifndef EN_S53
#define EN_S53 1
#endif
#ifndef EN_SSD3
#define EN_SSD3 1
#endif
#ifndef R_GWIN
#define R_GWIN 1
#endif
#ifndef R_GLU
#define R_GLU 1
#endif
#ifndef R_GP
#define R_GP 1
#endif
#ifndef R_GGATE
#define R_GGATE 1
#endif
#ifndef R_DENSE
#define R_DENSE 1
#endif
#ifndef R_MOE
#define R_MOE 1
#endif
#ifndef R_DSA
#define R_DSA 1
#endif
#ifndef R_MIX
#define R_MIX 1
#endif
#ifndef R_MISC
#define R_MISC 1
#endif
#ifndef MK_PER_PHASE
#define MK_PER_PHASE 0
#endif

#ifndef EN_PROLOGUE
#define EN_PROLOGUE 1
#endif
#ifndef EN_WCONV
#define EN_WCONV 1
#endif
#ifndef EN_GWIN
#define EN_GWIN 1
#endif
#ifndef EN_MX1
#define EN_MX1 1
#endif
#ifndef EN_MX2
#define EN_MX2 1
#endif
#ifndef EN_GLU
#define EN_GLU 1
#endif
#ifndef EN_GP
#define EN_GP 1
#endif
#ifndef EN_GGATE
#define EN_GGATE 1
#endif
#ifndef EN_GOUT
#define EN_GOUT 1
#endif
#ifndef EN_LN1
#define EN_LN1 1
#endif
#ifndef EN_FILL
#define EN_FILL 1
#endif
#ifndef EN_MOE1
#define EN_MOE1 1
#endif
#ifndef EN_MOE2
#define EN_MOE2 1
#endif
#ifndef EN_FIN
#define EN_FIN 1
#endif
#ifndef G_ALIGN
#define G_ALIGN true
#endif
#ifndef G_SP2
#define G_SP2 true
#endif
#define LAS __attribute__((address_space(3)))
#define GAS __attribute__((address_space(1)))
typedef unsigned short bf16_t;
typedef short bf16x8 __attribute__((ext_vector_type(8)));
typedef float f32x4 __attribute__((ext_vector_type(4)));
typedef float f32x2 __attribute__((ext_vector_type(2)));
typedef unsigned u32x4 __attribute__((ext_vector_type(4)));
typedef unsigned u32x2 __attribute__((ext_vector_type(2)));

constexpr int NB = 4, SEQ = 8192, M = NB * SEQ, D = 1024, DEPTH = 2;
constexpr int PJ = 2304;
constexpr int C_GU = 0, C_GV = 256, C_Q = 512, C_K = 768, C_V = 832, C_QI = 896, C_KI = 1152, C_S5 = 1216, C_Z = 1472, C_XBC = 1728, C_WI = 2240, C_DT = 2244;
constexpr int D_IN = 2248;
constexpr int NEXP = 32, NE1 = 33;
constexpr int NCH = 4, CHTOK = M / NCH;
constexpr int CH_ROWS = CHTOK * 8 + CHTOK + NE1 * 256;
constexpr float DN_ALPHA = 1.41421356237f;
constexpr float LN_EPS = 1e-5f, RMS_EPS = 1e-6f;

constexpr size_t MiB = 1u << 20;
constexpr size_t WS_CTL = 0, CTL_BYTES = 1 * MiB;
constexpr size_t WS_MODV = 1 * MiB;
constexpr size_t WS_S5B = WS_MODV + 256 * 1024;
constexpr size_t WS_S5C = WS_S5B + 64 * 1024;
constexpr size_t WS_S5A = WS_S5C + 64 * 1024;
constexpr size_t WS_GMW = WS_S5A + 64 * 1024;
constexpr size_t WS_S5ST = 2 * MiB;
constexpr size_t WS_ATOT = 3 * MiB;
constexpr size_t WS_WGBASE = 3 * MiB + 64 * 1024;
constexpr size_t WS_PINFO = 4 * MiB;
constexpr size_t WS_PGATE = 5 * MiB;
constexpr size_t WS_SLOT = 6 * MiB;
constexpr size_t WS_ROWTOK = 7 * MiB;
constexpr size_t WS_ROWGATE = 9 * MiB;
constexpr size_t WS_W = 24 * MiB;
constexpr size_t WO_IN = 0, WO_GATE = WO_IN + (size_t)PJ * 1024 * 2, WO_BR = WO_GATE + (size_t)4096 * 1024 * 2, WO_OUT = WO_BR + (size_t)4 * 1024 * 256 * 2,
                 WO_GLU = WO_OUT + (size_t)1024 * 1024 * 2, WO_13 = WO_GLU + (size_t)256 * 256 * 2, WO_2 = WO_13 + (size_t)NE1 * 512 * 1024 * 2, WO_END = WO_2 + (size_t)NE1 * 1024 * 256 * 2;
static_assert(WO_END <= 72 * MiB, "weights region");
constexpr size_t WS_H = 96 * MiB;
constexpr size_t WS_Y = 160 * MiB;
constexpr size_t WS_PROJ = 224 * MiB;
constexpr size_t WS_P = 224 * MiB;
constexpr size_t WS_SSDST = 368 * MiB;
constexpr size_t WS_SSDSIN = 400 * MiB;
constexpr size_t WS_KI2 = 408 * MiB, WS_K2 = 412 * MiB, WS_V2 = 416 * MiB;
constexpr size_t WS_YCPRE = 384 * MiB;
constexpr size_t WS_ACT = 224 * MiB;
constexpr size_t WS_OPAIR = 272 * MiB;
static_assert(WS_ACT + (size_t)CH_ROWS * 512 <= WS_OPAIR && WS_OPAIR + (size_t)CH_ROWS * 2048 <= 512 * MiB, "moe buffers");
constexpr size_t WS_NEED = 512 * MiB;
constexpr int CW_BAR = 4096;
constexpr int CW_CNT = 16384;

constexpr int LDS_BYTES = 160 * 1024;
constexpr int LDS_TAB = 131072;
constexpr int LDS_MISC = LDS_BYTES - 256;

__device__ __forceinline__ unsigned f2bf(float f) { unsigned u = __builtin_bit_cast(unsigned, f); return (u + 0x7fffu + ((u >> 16) & 1u)) >> 16; }
__device__ __forceinline__ unsigned pk2(float lo, float hi) { return f2bf(lo) | (f2bf(hi) << 16); }
__device__ __forceinline__ float bf2f(unsigned short b) { return __builtin_bit_cast(float, (unsigned)b << 16); }
__device__ __forceinline__ float bflo(unsigned w) { return __builtin_bit_cast(float, w << 16); }
__device__ __forceinline__ float bfhi(unsigned w) { return __builtin_bit_cast(float, w & 0xffff0000u); }
__device__ __forceinline__ float wave_sum(float v) {
#pragma unroll
    for (int o = 1; o < 64; o <<= 1) v += __shfl_xor(v, o);
    return v;
}
__device__ __forceinline__ float wave_max(float v) {
#pragma unroll
    for (int o = 1; o < 64; o <<= 1) v = fmaxf(v, __shfl_xor(v, o));
    return v;
}
__device__ __forceinline__ int wave_sum_i(int v) {
#pragma unroll
    for (int o = 1; o < 64; o <<= 1) v += __shfl_xor(v, o);
    return v;
}
__device__ __forceinline__ float sigmoidf_(float x) { return 1.0f / (1.0f + __expf(-x)); }
__device__ __forceinline__ float siluf_(float x) { return x / (1.0f + __expf(-x)); }
__device__ __forceinline__ float gelu_tanh(float x) { const float u = 1.5957691216057308f * (x + 0.044715f * x * x * x); return x / (1.0f + __expf(-u)); }
__device__ __forceinline__ float softplusf_(float x) { return fmaxf(x, 0.f) + log1pf(__expf(-fabsf(x))); }
__device__ __forceinline__ void sincos_red(float ang, float& sn, float& cs) {
    const double a = (double)ang; const double q = __builtin_rint(a * 0.63661977236758134308);
    const float r = (float)(a - q * 1.57079632679489661923); const int qi = (int)q & 3;
    const float r2 = r * r;
    const float s = r * (1.0f + r2 * (-1.6666667e-1f + r2 * (8.3333333e-3f + r2 * (-1.9841270e-4f + r2 * 2.7557319e-6f))));
    const float c = 1.0f + r2 * (-0.5f + r2 * (4.1666667e-2f + r2 * (-1.3888889e-3f + r2 * (2.4801587e-5f + r2 * -2.7557319e-7f))));
    sn = (qi == 0) ? s : (qi == 1) ? c : (qi == 2) ? -s : -c;
    cs = (qi == 0) ? c : (qi == 1) ? -s : (qi == 2) ? -c : s;
}
__device__ __forceinline__ f32x4 mfma16(bf16x8 a, bf16x8 b, f32x4 c) { return __builtin_amdgcn_mfma_f32_16x16x32_bf16(a, b, c, 0, 0, 0); }
__device__ __forceinline__ unsigned cvt_pk_bf16(float lo, float hi) { unsigned r; asm volatile("v_cvt_pk_bf16_f32 %0, %1, %2" : "=v"(r) : "v"(lo), "v"(hi)); return r; }

namespace pg8 {
constexpr int BM = 256, BK = 64, HALF = 128, HTB = HALF * BK * 2, STAGE_BYTES = 8 * HTB, NXCD = 8, WGM = 8;
__host__ __device__ __forceinline__ int lds_byte(int r, int c) { const int st = (r >> 4) * 2 + (c >> 5), rr = r & 15, cc = c & 31, ob = rr * 64 + cc * 2; return st * 1024 + (ob ^ (((ob >> 9) & 1) << 5)); }
__host__ __device__ __forceinline__ void stage_rc(int b, int& R, int& C) { const int st = b / 1024, sb = b % 1024, swz = sb ^ (((sb >> 9) & 1) << 5); R = (st >> 1) * 16 + swz / 64; C = (st & 1) * 32 + (swz % 64) / 2; }
__host__ __device__ __forceinline__ int perm32(int rho) { const int n = rho >> 4, i = rho & 15; return 8 * (i >> 2) + 4 * n + (i & 3); }

struct Unit { int pm, pn, bt, ab; };
struct Gemm { const bf16_t* A; const bf16_t* Bt; int K; size_t a_sel_stride; };

__device__ __forceinline__ int xcd_remap(int wgid, int nwg) { const int q = nwg / NXCD, r = nwg % NXCD, xcd = wgid % NXCD, off = wgid / NXCD; return (xcd < r ? xcd * (q + 1) : r * (q + 1) + (xcd - r) * q) + off; }

struct StaticOrder {
    static constexpr bool GATHER = false;
    int nM, nN, nwg, G, c;
    __device__ void init(int Mr, int N, int G_, int c_) { nM = Mr / BM; nN = N / BM; nwg = nM * nN; G = G_; c = c_; }
    __device__ __forceinline__ bool next(int i, Unit& u) const {
        const long L = (long)i * G + c; if (L >= nwg) return false;
        const int wgid = xcd_remap((int)L, nwg);
        const int nig = WGM * nN, gid = wgid / nig, fm = gid * WGM, gsz = (nM - fm) < WGM ? (nM - fm) : WGM;
        u.pm = fm + ((wgid % nig) % gsz); u.pn = (wgid % nig) / gsz; u.bt = u.pn; u.ab = 0; return true;
    }
    __device__ __forceinline__ void a_ready(const Unit&) const {}
    __device__ __forceinline__ void done(const Unit&) const {}
};

template <class Epi, class Sched, bool ALIGN_EPI = false, bool SP2 = true>
__device__ __forceinline__ void gemm_phase(LAS unsigned char* lds, const Gemm g, const Sched& S, const Epi& E, const int tid) {
    const int wid = __builtin_amdgcn_readfirstlane(tid >> 6), lane = tid & 63, wr = wid >> 2, wc = wid & 3, fr = lane & 15, fq = lane >> 4;
    const int K = g.K, nt = K / BK;
    unsigned voffA[2], voffB[2];
#pragma unroll
    for (int i = 0; i < 2; ++i) { int R, C; stage_rc(tid * 16 + i * 8192, R, C); const int Rb = Epi::PERM ? ((R & ~31) + perm32(R & 31)) : R;
        voffA[i] = (unsigned)(R * K + C) * 2u; voffB[i] = (unsigned)(Rb * K + C) * 2u; }
    const size_t kstep = (size_t)(BK * 2);
    const size_t hstep = (size_t)HALF * K * 2;
    const size_t tstep = 2 * hstep;
    const unsigned ldsw = (unsigned)wid * 1024u;
    const int aoff = lds_byte(wr * 64 + fr, fq * 8), boff = lds_byte(wc * 32 + fr, fq * 8);
#define PG8_SA(b, h) (((b) * 2 + (h)) * HTB)
#define PG8_SB(b, h) ((4 + (b) * 2 + (h)) * HTB)
#define PG8_STAGE(bufoff, gbase, voff) do { _Pragma("unroll") for (int _i = 0; _i < 2; ++_i) \
        __builtin_amdgcn_global_load_lds((const unsigned*)((const char*)(gbase) + (voff)[_i]), (LAS unsigned*)(lds + (bufoff) + ldsw + _i * 8192), 16, 0, 0); } while (0)
#define PG8_GO(u) do { _Pragma("unroll") for (int _h = 0; _h < 2; ++_h) _Pragma("unroll") for (int _i = 0; _i < 2; ++_i) { int _R, _C; stage_rc(tid * 16 + _i * 8192, _R, _C); \
        cgo[_h][_i] = (unsigned)S.row_of(u, _h * HALF + _R) * (unsigned)(K * 2) + (unsigned)_C * 2u; } } while (0)
#define PG8_STAGE_A(bufoff, base, h, kb, NX) do { if constexpr (Sched::GATHER) { _Pragma("unroll") for (int _i = 0; _i < 2; ++_i) \
        __builtin_amdgcn_global_load_lds((const unsigned*)((const char*)g.A + (kb) + cgo[h][_i]), (LAS unsigned*)(lds + (bufoff) + ldsw + _i * 8192), 16, 0, 0); } \
        else { PG8_STAGE(bufoff, (base) + (size_t)(h) * hstep + (kb), voffA); } } while (0)
#define PG8_LDA(dst, b, h) do { _Pragma("unroll") for (int m = 0; m < 4; ++m) _Pragma("unroll") for (int k = 0; k < 2; ++k) dst[m][k] = *(const LAS bf16x8*)(lds + PG8_SA(b, h) + aoff + m * 2048 + k * 1024); } while (0)
#define PG8_LDB(dst, b, h) do { _Pragma("unroll") for (int n = 0; n < 2; ++n) _Pragma("unroll") for (int k = 0; k < 2; ++k) dst[n][k] = *(const LAS bf16x8*)(lds + PG8_SB(b, h) + boff + n * 2048 + k * 1024); } while (0)
#define PG8_MMA(ai, bj, At, Bt) do { __builtin_amdgcn_s_setprio(1); _Pragma("unroll") for (int m = 0; m < 4; ++m) _Pragma("unroll") for (int n = 0; n < 2; ++n) _Pragma("unroll") for (int k = 0; k < 2; ++k) \
        acc[ai][bj][m][n] = __builtin_amdgcn_mfma_f32_16x16x32_bf16(Bt[n][k], At[m][k], acc[ai][bj][m][n], 0, 0, 0); __builtin_amdgcn_s_setprio(0); } while (0)
#define PG8_WAIT_V(n) asm volatile("s_waitcnt vmcnt(" #n ")" ::: "memory")
#define PG8_WAIT_L(n) asm volatile("s_waitcnt lgkmcnt(" #n ")" ::: "memory")
#define PG8_BAR __builtin_amdgcn_s_barrier()
#define PG8_SCHED __builtin_amdgcn_sched_barrier(0)
    Unit cur, nxt; int ui = 0;
    if (!S.next(0, cur)) return;
    f32x4 acc[2][2][4][2];
#pragma unroll
    for (int a = 0; a < 2; ++a)
#pragma unroll
        for (int b = 0; b < 2; ++b)
#pragma unroll
            for (int m = 0; m < 4; ++m)
#pragma unroll
                for (int n = 0; n < 2; ++n) acc[a][b][m][n] = (f32x4){0.f, 0.f, 0.f, 0.f};
    bf16x8 At[4][2], B0[2][2], B1[2][2];
    unsigned cgo[2][2];
    if constexpr (Sched::GATHER) PG8_GO(cur);
    const char* cA = (const char*)(g.A + (size_t)cur.ab * g.a_sel_stride) + (size_t)cur.pm * tstep; const char* cB = (const char*)g.Bt + (size_t)cur.bt * tstep;
    S.a_ready(cur);
    if constexpr (SP2) {
        PG8_STAGE(PG8_SB(0, 0), cB, voffB); PG8_STAGE(PG8_SB(0, 1), cB + hstep, voffB); PG8_STAGE_A(PG8_SA(0, 0), cA, 0, (size_t)0, false); PG8_STAGE_A(PG8_SA(0, 1), cA, 1, (size_t)0, false);
        if (wr == 1) PG8_BAR;
        PG8_WAIT_V(2); PG8_BAR;
        PG8_STAGE(PG8_SB(1, 0), cB + kstep, voffB); PG8_STAGE_A(PG8_SA(1, 0), cA, 0, kstep, false); PG8_STAGE(PG8_SB(1, 1), cB + hstep + kstep, voffB);
        PG8_WAIT_V(6); PG8_BAR;
    } else {
        PG8_STAGE(PG8_SB(0, 0), cB, voffB); PG8_STAGE_A(PG8_SA(0, 0), cA, 0, (size_t)0, false); PG8_STAGE(PG8_SB(0, 1), cB + hstep, voffB); PG8_STAGE_A(PG8_SA(0, 1), cA, 1, (size_t)0, false);
        if (wr == 1) PG8_BAR;
        PG8_WAIT_V(4); PG8_BAR;
        PG8_STAGE(PG8_SB(1, 0), cB + kstep, voffB); PG8_STAGE_A(PG8_SA(1, 0), cA, 0, kstep, false); PG8_STAGE(PG8_SB(1, 1), cB + hstep + kstep, voffB);
        PG8_WAIT_V(6); PG8_BAR;
    }
    for (;;) {
        const bool has_next = S.next(ui + 1, nxt);
        const char* nA = has_next ? (const char*)(g.A + (size_t)nxt.ab * g.a_sel_stride) + (size_t)nxt.pm * tstep : cA; const char* nB = has_next ? (const char*)g.Bt + (size_t)nxt.bt * tstep : cB;
#pragma nounroll
        for (int t = 0; t < nt; t += 2) {
            const bool last = (t == nt - 2);
            const size_t k1 = (size_t)(t + 1) * kstep;
            const char* a2b = last ? nA : cA; const size_t k2 = last ? (size_t)0 : (size_t)(t + 2) * kstep; const size_t k3 = k2 + kstep;
            const char* b2 = last ? nB : cB + (size_t)(t + 2) * kstep; const char* b3 = b2 + kstep;
            if (last && has_next) S.a_ready(nxt);
            if constexpr (SP2) {
            PG8_LDB(B0, 0, 0); PG8_LDB(B1, 0, 1); PG8_SCHED; PG8_LDA(At, 0, 0); PG8_STAGE_A(PG8_SA(1, 1), cA, 1, k1, false);
            if constexpr (Sched::GATHER) { if (last && has_next) PG8_GO(nxt); }
            PG8_WAIT_V(8); PG8_WAIT_L(0); PG8_BAR; PG8_MMA(0, 0, At, B0); PG8_MMA(0, 1, At, B1); PG8_BAR; PG8_SCHED;
            PG8_LDA(At, 0, 1); PG8_STAGE(PG8_SB(0, 0), b2, voffB); PG8_STAGE(PG8_SB(0, 1), b2 + hstep, voffB); PG8_STAGE_A(PG8_SA(0, 0), a2b, 0, k2, last);
            PG8_WAIT_V(8); PG8_WAIT_L(0); PG8_BAR; PG8_MMA(1, 0, At, B0); PG8_MMA(1, 1, At, B1); PG8_BAR; PG8_SCHED;
            PG8_LDB(B0, 1, 0); PG8_LDB(B1, 1, 1); PG8_SCHED; PG8_LDA(At, 1, 0); PG8_STAGE_A(PG8_SA(0, 1), a2b, 1, k2, last);
            PG8_WAIT_V(8); PG8_WAIT_L(0); PG8_BAR; PG8_MMA(0, 0, At, B0); PG8_MMA(0, 1, At, B1); PG8_BAR; PG8_SCHED;
            PG8_LDA(At, 1, 1); PG8_STAGE(PG8_SB(1, 0), b3, voffB); PG8_STAGE(PG8_SB(1, 1), b3 + hstep, voffB); PG8_STAGE_A(PG8_SA(1, 0), a2b, 0, k3, last);
            PG8_WAIT_V(8); PG8_WAIT_L(0); PG8_BAR; PG8_MMA(1, 0, At, B0); PG8_MMA(1, 1, At, B1); PG8_BAR; PG8_SCHED;
            } else {
            PG8_LDB(B0, 0, 0); PG8_SCHED; PG8_LDA(At, 0, 0); PG8_STAGE_A(PG8_SA(1, 1), cA, 1, k1, false);
            if constexpr (Sched::GATHER) { if (last && has_next) PG8_GO(nxt); }
            PG8_WAIT_L(8); PG8_BAR; PG8_WAIT_L(0); PG8_MMA(0, 0, At, B0); PG8_BAR; PG8_SCHED;
            PG8_LDB(B1, 0, 1); PG8_STAGE(PG8_SB(0, 0), b2, voffB);
            PG8_BAR; PG8_WAIT_L(0); PG8_MMA(0, 1, At, B1); PG8_BAR;
            PG8_LDA(At, 0, 1); PG8_STAGE_A(PG8_SA(0, 0), a2b, 0, k2, last);
            PG8_BAR; PG8_WAIT_L(0); PG8_MMA(1, 0, At, B0); PG8_BAR; PG8_SCHED;
            PG8_STAGE(PG8_SB(0, 1), b2 + hstep, voffB);
            PG8_WAIT_V(6); PG8_BAR; PG8_MMA(1, 1, At, B1); PG8_BAR;
            PG8_LDB(B0, 1, 0); PG8_SCHED; PG8_LDA(At, 1, 0); PG8_STAGE_A(PG8_SA(0, 1), a2b, 1, k2, last);
            PG8_WAIT_L(8); PG8_BAR; PG8_WAIT_L(0); PG8_MMA(0, 0, At, B0); PG8_BAR; PG8_SCHED;
            PG8_LDB(B1, 1, 1); PG8_STAGE(PG8_SB(1, 0), b3, voffB);
            PG8_BAR; PG8_WAIT_L(0); PG8_MMA(0, 1, At, B1); PG8_BAR;
            PG8_LDA(At, 1, 1); PG8_STAGE_A(PG8_SA(1, 0), a2b, 0, k3, last);
            PG8_BAR; PG8_WAIT_L(0); PG8_MMA(1, 0, At, B0); PG8_BAR; PG8_SCHED;
            PG8_STAGE(PG8_SB(1, 1), b3 + hstep, voffB);
            PG8_WAIT_V(6); PG8_BAR; PG8_MMA(1, 1, At, B1); PG8_BAR;
            }
        }
        if constexpr (ALIGN_EPI) { if (wr == 0) PG8_BAR; }
        E(acc, cur, wr, wc, fr, fq); S.done(cur);
        if (!has_next) break;
#pragma unroll
        for (int a = 0; a < 2; ++a)
#pragma unroll
            for (int b = 0; b < 2; ++b)
#pragma unroll
                for (int m = 0; m < 4; ++m)
#pragma unroll
                    for (int n = 0; n < 2; ++n) acc[a][b][m][n] = (f32x4){0.f, 0.f, 0.f, 0.f};
        cur = nxt; cA = nA; cB = nB; ++ui;
        if constexpr (ALIGN_EPI) { if (wr == 1) PG8_BAR; }
    }
    PG8_WAIT_V(0);
    if constexpr (!ALIGN_EPI) { if (wr == 0) PG8_BAR; }
    PG8_BAR;
#undef PG8_SA
#undef PG8_SB
#undef PG8_STAGE
#undef PG8_STAGE_A
#undef PG8_GO
#undef PG8_LDA
#undef PG8_LDB
#undef PG8_MMA
#undef PG8_WAIT_V
#undef PG8_WAIT_L
#undef PG8_BAR
#undef PG8_SCHED
}

struct EpiBf16 {
    static constexpr bool PERM = true;
    bf16_t* O; int ldc;
    __device__ __forceinline__ void operator()(const f32x4 (&acc)[2][2][4][2], const Unit& u, int wr, int wc, int fr, int fq) const {
        const int row0 = u.pm * BM + wr * 64 + fr, col0 = u.pn * BM + wc * 32 + 8 * fq;
#pragma unroll
        for (int ai = 0; ai < 2; ++ai)
#pragma unroll
            for (int m = 0; m < 4; ++m) { bf16_t* rowp = O + (size_t)(row0 + ai * HALF + m * 16) * ldc + col0;
#pragma unroll
                for (int bj = 0; bj < 2; ++bj) { const f32x4 v0 = acc[ai][bj][m][0], v1 = acc[ai][bj][m][1];
                    u32x4 w; w.x = cvt_pk_bf16(v0[0], v0[1]); w.y = cvt_pk_bf16(v0[2], v0[3]); w.z = cvt_pk_bf16(v1[0], v1[1]); w.w = cvt_pk_bf16(v1[2], v1[3]);
                    *(u32x4*)(rowp + bj * HALF) = w; } }
    }
};
struct EpiGlu {
    static constexpr bool PERM = true;
    const bf16_t* Ysrc; bf16_t* O; const float* bias;
    __device__ __forceinline__ void operator()(const f32x4 (&acc)[2][2][4][2], const Unit& u, int wr, int wc, int fr, int fq) const {
        const int row0 = u.pm * BM + wr * 64 + fr, col0 = u.pn * BM + wc * 32 + 8 * fq;
#pragma unroll
        for (int ai = 0; ai < 2; ++ai)
#pragma unroll
            for (int m = 0; m < 4; ++m) { const size_t ro = (size_t)(row0 + ai * HALF + m * 16) * 256 + col0;
#pragma unroll
                for (int bj = 0; bj < 2; ++bj) { const f32x4 v0 = acc[ai][bj][m][0], v1 = acc[ai][bj][m][1];
                    const u32x4 yv = *(const u32x4*)(Ysrc + ro + bj * HALF);
                    const f32x4 b0 = *(const f32x4*)(bias + col0 + bj * HALF), b1 = *(const f32x4*)(bias + col0 + bj * HALF + 4);
                    float o[8];
                    o[0] = bflo(yv.x) * sigmoidf_(v0[0] + b0[0]); o[1] = bfhi(yv.x) * sigmoidf_(v0[1] + b0[1]); o[2] = bflo(yv.y) * sigmoidf_(v0[2] + b0[2]); o[3] = bfhi(yv.y) * sigmoidf_(v0[3] + b0[3]);
                    o[4] = bflo(yv.z) * sigmoidf_(v1[0] + b1[0]); o[5] = bfhi(yv.z) * sigmoidf_(v1[1] + b1[1]); o[6] = bflo(yv.w) * sigmoidf_(v1[2] + b1[2]); o[7] = bfhi(yv.w) * sigmoidf_(v1[3] + b1[3]);
                    u32x4 w; w.x = cvt_pk_bf16(o[0], o[1]); w.y = cvt_pk_bf16(o[2], o[3]); w.z = cvt_pk_bf16(o[4], o[5]); w.w = cvt_pk_bf16(o[6], o[7]);
                    *(u32x4*)(O + ro + bj * HALF) = w; } }
    }
};
struct EpiGateMerge {
    static constexpr bool PERM = true;
    const bf16_t* P; bf16_t* Mg;
    __device__ __forceinline__ void operator()(const f32x4 (&acc)[2][2][4][2], const Unit& u, int wr, int wc, int fr, int fq) const {
        const int i = u.pn >> 2, mt = u.pn & 3;
        const int row0 = u.pm * BM + wr * 64 + fr, col0 = mt * BM + wc * 32 + 8 * fq;
#pragma unroll
        for (int ai = 0; ai < 2; ++ai)
#pragma unroll
            for (int m = 0; m < 4; ++m) { const size_t r = (size_t)(row0 + ai * HALF + m * 16);
#pragma unroll
                for (int bj = 0; bj < 2; ++bj) { const f32x4 v0 = acc[ai][bj][m][0], v1 = acc[ai][bj][m][1];
                    const u32x4 pv = *(const u32x4*)(P + r * 4096 + i * 1024 + col0 + bj * HALF);
                    u32x4 mv = (u32x4){0u, 0u, 0u, 0u};
                    if (i > 0) mv = *(const u32x4*)(Mg + r * 1024 + col0 + bj * HALF);
                    float o[8];
                    o[0] = bflo(mv.x) + bflo(pv.x) * sigmoidf_(v0[0]); o[1] = bfhi(mv.x) + bfhi(pv.x) * sigmoidf_(v0[1]); o[2] = bflo(mv.y) + bflo(pv.y) * sigmoidf_(v0[2]); o[3] = bfhi(mv.y) + bfhi(pv.y) * sigmoidf_(v0[3]);
                    o[4] = bflo(mv.z) + bflo(pv.z) * sigmoidf_(v1[0]); o[5] = bfhi(mv.z) + bfhi(pv.z) * sigmoidf_(v1[1]); o[6] = bflo(mv.w) + bflo(pv.w) * sigmoidf_(v1[2]); o[7] = bfhi(mv.w) + bfhi(pv.w) * sigmoidf_(v1[3]);
                    u32x4 w; w.x = cvt_pk_bf16(o[0], o[1]); w.y = cvt_pk_bf16(o[2], o[3]); w.z = cvt_pk_bf16(o[4], o[5]); w.w = cvt_pk_bf16(o[6], o[7]);
                    *(u32x4*)(Mg + r * 1024 + col0 + bj * HALF) = w; } }
    }
};
struct EpiResid {
    static constexpr bool PERM = false;
    const float* xin; float* out; const float* gate;
    __device__ __forceinline__ void operator()(const f32x4 (&acc)[2][2][4][2], const Unit& u, int wr, int wc, int fr, int fq) const {
        const int row0 = u.pm * BM + wr * 64 + fr, col0 = u.pn * BM + wc * 32 + 4 * fq;
        const int b = (u.pm * BM) / SEQ;
        f32x4 gv[2][2];
#pragma unroll
        for (int bj = 0; bj < 2; ++bj)
#pragma unroll
            for (int n = 0; n < 2; ++n) gv[bj][n] = *(const f32x4*)(gate + b * 3072 + 2048 + col0 + bj * HALF + n * 16) + 1.0f;
#pragma unroll
        for (int ai = 0; ai < 2; ++ai)
#pragma unroll
            for (int m = 0; m < 4; ++m) { const size_t ro = (size_t)(row0 + ai * HALF + m * 16) * D + col0;
#pragma unroll
                for (int bj = 0; bj < 2; ++bj)
#pragma unroll
                    for (int n = 0; n < 2; ++n) { const f32x4 xv = *(const f32x4*)(xin + ro + bj * HALF + n * 16);
                        *(f32x4*)(out + ro + bj * HALF + n * 16) = xv * DN_ALPHA + gv[bj][n] * acc[ai][bj][m][n]; } }
    }
};
struct EpiMoe1 {
    static constexpr bool PERM = false;
    bf16_t* Act; const float* rowgate;
    __device__ __forceinline__ void operator()(const f32x4 (&acc)[2][2][4][2], const Unit& u, int wr, int wc, int fr, int fq) const {
        const int row0 = u.pm * BM + wr * 64 + fr, f0 = u.pn * 128 + wc * 16 + 4 * fq;
#pragma unroll
        for (int ai = 0; ai < 2; ++ai)
#pragma unroll
            for (int m = 0; m < 4; ++m) { const int r = row0 + ai * HALF + m * 16; const float gt = rowgate[r];
#pragma unroll
                for (int bj = 0; bj < 2; ++bj) { const f32x4 a = acc[ai][bj][m][0], b = acc[ai][bj][m][1];
                    u32x2 w; w.x = cvt_pk_bf16(siluf_(a[0]) * b[0] * gt, siluf_(a[1]) * b[1] * gt); w.y = cvt_pk_bf16(siluf_(a[2]) * b[2] * gt, siluf_(a[3]) * b[3] * gt);
                    *(u32x2*)(Act + (size_t)r * 256 + f0 + bj * 64) = w; } }
    }
};
}

#define XB_TMO      128
#define XB_XCNT(j)  (256  + 64 * (j))
#define XB_XSUB(j)  (1280 + 64 * (j))
#define XB_XGEN(j)  (2304 + 64 * (j))
#define XB_TOP      3328
#define XB_TOPGEN   3392
#define XCD_BAR_WORDS 3456
#define XB_SPIN_CAP (1u << 22)
__device__ __forceinline__ unsigned xb_ld(unsigned* p)              { return __hip_atomic_load(p, __ATOMIC_RELAXED, __HIP_MEMORY_SCOPE_AGENT); }
__device__ __forceinline__ unsigned xb_add(unsigned* p, unsigned v) { return __hip_atomic_fetch_add(p, v, __ATOMIC_RELAXED, __HIP_MEMORY_SCOPE_AGENT); }
__device__ __forceinline__ unsigned xb_xcc_id() { return (unsigned)__builtin_amdgcn_s_getreg((3 << 11) | 20) & 0xFu; }
#define XB_SPIN(cond, bar) do { unsigned _sp = 0; while (cond) { __builtin_amdgcn_s_sleep(1); \
    if ((++_sp & 255u) == 0u) { if (xb_ld(&(bar)[XB_TMO])) break; if (_sp > XB_SPIN_CAP) { atomicAdd(&(bar)[XB_TMO], 1u); break; } } } } while (0)
struct XcdBarrier { unsigned* bar; unsigned x; volatile LAS unsigned* st; };
__device__ __forceinline__ XcdBarrier xcd_barrier_post(unsigned* bar, volatile LAS unsigned* st) {
    XcdBarrier b; b.bar = bar; b.x = xb_xcc_id(); b.st = st;
    if (threadIdx.x == 0) (void)xb_add(&bar[XB_XCNT(b.x)], 1u);
    return b;
}
__device__ __forceinline__ void xcd_barrier_complete(unsigned* bar, unsigned x, unsigned& nloc, unsigned& nx) {
    const unsigned G = gridDim.x * gridDim.y * gridDim.z;
    unsigned sum, cnt, mine, sp = 0u;
    for (;;) {
        sum = 0u; cnt = 0u; mine = 0u;
#pragma unroll
        for (unsigned j = 0; j < 16; ++j) { const unsigned c = xb_ld(&bar[XB_XCNT(j)]); sum += c; cnt += (c > 0u) ? 1u : 0u; mine = (j == x) ? c : mine; }
        if (sum == G) break;
        __builtin_amdgcn_s_sleep(1);
        if ((++sp & 255u) == 0u) { if (xb_ld(&bar[XB_TMO])) break; if (sp > XB_SPIN_CAP) { atomicAdd(&bar[XB_TMO], 1u); break; } }
    }
    nloc = mine > 0u ? mine : 1u; nx = cnt > 0u ? cnt : 1u;
}
__device__ __forceinline__ void xcd_barrier(const XcdBarrier& b) {
    asm volatile("s_waitcnt vmcnt(0)" ::: "memory");
    __syncthreads();
    if (threadIdx.x == 0) {
        unsigned* bar = b.bar;
        __builtin_amdgcn_s_waitcnt(0);
        unsigned nloc = b.st[0], nx = b.st[1];
        if (nloc == 0u) { xcd_barrier_complete(bar, b.x, nloc, nx); b.st[0] = nloc; b.st[1] = nx; }
        const unsigned old = xb_add(&bar[XB_XSUB(b.x)], 1u);
        const unsigned gen = old / nloc;
        if (old + 1u == (gen + 1u) * nloc) {
            __builtin_amdgcn_fence(__ATOMIC_RELEASE, "agent");
            asm volatile("s_waitcnt vmcnt(0)" ::: "memory");
            const unsigned og = xb_add(&bar[XB_TOP], 1u);
            const unsigned tg = og / nx;
            if (og + 1u == (tg + 1u) * nx) xb_add(&bar[XB_TOPGEN], 1u);
            else XB_SPIN(xb_ld(&bar[XB_TOPGEN]) == tg, bar);
            __builtin_amdgcn_fence(__ATOMIC_ACQUIRE, "agent");
            xb_add(&bar[XB_XGEN(b.x)], 1u);
            asm volatile("s_waitcnt vmcnt(0)" ::: "memory");
        } else {
            XB_SPIN(xb_ld(&bar[XB_XGEN(b.x)]) == gen, bar);
            __builtin_amdgcn_fence(__ATOMIC_ACQUIRE, "agent");
            asm volatile("s_waitcnt vmcnt(0)" ::: "memory");
        }
    }
    __syncthreads();
}

struct Args {
    const float* in[43]; const int* positions; float* out; unsigned char* ws; int ph_lo, ph_hi;
};
enum { I_X = 0, I_C = 1, I_POS = 2, I_MOD1W = 3, I_MOD1B = 4, I_WIN = 5, I_GMLNG = 6, I_GMLNB = 7, I_GMW = 8, I_GMB = 9,
       I_S5LRE = 10, I_S5LIM = 11, I_S5STEP = 12, I_S5BRE = 13, I_S5BIM = 14, I_S5CRE = 15, I_S5CIM = 16, I_S5D = 17, I_S5GLUW = 18, I_S5GLUB = 19,
       I_CONVW = 20, I_CONVB = 21, I_DTBIAS = 22, I_ALOG = 23, I_SSDD = 24, I_SSDNG = 25, I_WBR = 26, I_WGATE = 27, I_WOUT = 28, I_LN1G = 29, I_LN1B = 30,
       I_MOD2W = 31, I_MOD2B = 32, I_RW = 33, I_RB = 34, I_EW1 = 35, I_EW3 = 36, I_EW2 = 37, I_SW1 = 38, I_SW3 = 39, I_SW2 = 40, I_LN2G = 41, I_LN2B = 42 };

typedef const __attribute__((address_space(4))) Args* ArgsP;
struct Ctx {
    ArgsP a; unsigned char* ws; LAS unsigned char* lds; int tid, lane, wave, c, G, bx;
    __device__ __forceinline__ const float* in(int i) const { return a->in[i]; }
    __device__ __forceinline__ bf16_t* proj() const { return (bf16_t*)(ws + WS_PROJ); }
    __device__ __forceinline__ bf16_t* hbuf() const { return (bf16_t*)(ws + WS_H); }
    __device__ __forceinline__ bf16_t* ybuf() const { return (bf16_t*)(ws + WS_Y); }
    __device__ __forceinline__ float* modv(int l, int w) const { return (float*)(ws + WS_MODV) + (size_t)(l * 2 + w) * NB * 3072; }
};

__device__ __forceinline__ void ph_prologue(const Ctx& X) {
    LAS float* red = (LAS float*)X.lds;
    for (int it = X.c; it < DEPTH * 2 * 48; it += X.G) {
        const int l = it / 96, w = (it / 48) & 1, jb = it % 48, j = jb * 64 + X.lane;
        const float* W = X.in(w ? I_MOD2W : I_MOD1W) + (size_t)l * D * 3072; const float* cv = X.in(I_C);
        float a0 = 0.f, a1 = 0.f, a2 = 0.f, a3 = 0.f;
        const int k0 = X.wave * 128;
        for (int k = k0; k < k0 + 128; ++k) { const float wv = W[(size_t)k * 3072 + j]; a0 += cv[k] * wv; a1 += cv[D + k] * wv; a2 += cv[2 * D + k] * wv; a3 += cv[3 * D + k] * wv; }
        red[(X.wave * 4 + 0) * 64 + X.lane] = a0; red[(X.wave * 4 + 1) * 64 + X.lane] = a1; red[(X.wave * 4 + 2) * 64 + X.lane] = a2; red[(X.wave * 4 + 3) * 64 + X.lane] = a3;
        __syncthreads();
        if (X.tid < 256) { const int b = X.tid >> 6, ln = X.tid & 63; float s = 0.f;
#pragma unroll
            for (int q = 0; q < 8; ++q) s += red[(q * 4 + b) * 64 + ln];
            const int jj = jb * 64 + ln; X.modv(l, w)[b * 3072 + jj] = s + X.in(w ? I_MOD2B : I_MOD1B)[(size_t)l * 3072 + jj]; }
        __syncthreads();
    }
}

template <class Src>
__device__ __forceinline__ void tr_item(const Src& src, bf16_t* WT, int K, int rowbase, int kb, int nb, LAS float* scr, int lane) {
    const int k0 = 64 * kb, n0 = 32 * nb;
    f32x4 v[8];
#pragma unroll
    for (int i = 0; i < 8; ++i) v[i] = src.load4(k0 + 8 * i + (lane >> 3), n0 + 4 * (lane & 7));
#pragma unroll
    for (int i = 0; i < 8; ++i) { LAS float* d = scr + (8 * i + (lane >> 3)) * 33 + 4 * (lane & 7); d[0] = v[i][0]; d[1] = v[i][1]; d[2] = v[i][2]; d[3] = v[i][3]; }
    asm volatile("s_waitcnt lgkmcnt(0)" ::: "memory");
    const int c = lane & 7;
#pragma unroll
    for (int j = 0; j < 4; ++j) { const int n = (lane >> 3) + 8 * j; const LAS float* s = scr + (8 * c) * 33 + n;
        u32x4 o; o.x = pk2(s[0 * 33], s[1 * 33]); o.y = pk2(s[2 * 33], s[3 * 33]); o.z = pk2(s[4 * 33], s[5 * 33]); o.w = pk2(s[6 * 33], s[7 * 33]);
        *(u32x4*)(WT + (size_t)(rowbase + n0 + n) * K + k0 + 8 * c) = o; }
    asm volatile("s_waitcnt lgkmcnt(0)" ::: "memory");
}
struct SrcPlain { const float* W; int N; __device__ __forceinline__ f32x4 load4(int k, int n) const { return *(const f32x4*)(W + (size_t)k * N + n); } };
struct SrcWin { const float* W; __device__ __forceinline__ f32x4 load4(int k, int n) const {
    if (n >= D_IN) return (f32x4){0.f, 0.f, 0.f, 0.f}; const int o = (n < 1216) ? n : (n < 2240) ? n + 4 : (n < 2244) ? 1216 + (n - 2240) : n; return *(const f32x4*)(W + (size_t)k * D_IN + o); } };
struct Src13 { const float* W1; const float* W3; __device__ __forceinline__ f32x4 load4(int k, int n) const {
    const int f = (n >> 5) * 16 + (n & 15); const long d = (n & 16) ? (long)(W3 - W1) : 0l; return *(const f32x4*)(W1 + d + (long)k * 256 + f); } };

__device__ __forceinline__ void ph_wconv(const Ctx& X, int l) {
    LAS float* scr = (LAS float*)(X.lds + X.wave * 16384);
    unsigned char* wb = X.ws + WS_W;
    const int gw = X.c * 8 + X.wave, NGW = X.G * 8;
    constexpr int I_A = 16 * 72, I_B = 4 * 16 * 32, I_C2 = 4 * 4 * 32, I_D = 16 * 32, I_E = 4 * 8, I_F = NE1 * 16 * 16, I_G = NE1 * 4 * 32;
    constexpr int NIT = I_A + I_B + I_C2 + I_D + I_E + I_F + I_G;
    for (int it = gw; it < NIT; it += NGW) {
        int r = it;
        if (r < I_A) { SrcWin s{X.in(I_WIN) + (size_t)l * D * D_IN}; tr_item(s, (bf16_t*)(wb + WO_IN), 1024, 0, r / 72, r % 72, scr, X.lane); continue; } r -= I_A;
        if (r < I_B) { const int i = r / 512, q = r % 512; SrcPlain s{X.in(I_WGATE) + ((size_t)l * 4 + i) * D * D, D}; tr_item(s, (bf16_t*)(wb + WO_GATE), 1024, i * 1024, q / 32, q % 32, scr, X.lane); continue; } r -= I_B;
        if (r < I_C2) { const int i = r / 128, q = r % 128; SrcPlain s{X.in(I_WBR) + ((size_t)l * 4 + i) * 256 * D, D}; tr_item(s, (bf16_t*)(wb + WO_BR) + (size_t)i * 1024 * 256, 256, 0, q / 32, q % 32, scr, X.lane); continue; } r -= I_C2;
        if (r < I_D) { SrcPlain s{X.in(I_WOUT) + (size_t)l * D * D, D}; tr_item(s, (bf16_t*)(wb + WO_OUT), 1024, 0, r / 32, r % 32, scr, X.lane); continue; } r -= I_D;
        if (r < I_E) { SrcPlain s{X.in(I_S5GLUW) + (size_t)l * 256 * 256, 256}; tr_item(s, (bf16_t*)(wb + WO_GLU), 256, 0, r / 8, r % 8, scr, X.lane); continue; } r -= I_E;
        if (r < I_F) { const int e = r / 256, q = r % 256;
            const Src13 s{(e < NEXP) ? X.in(I_EW1) + ((size_t)l * NEXP + e) * D * 256 : X.in(I_SW1) + (size_t)l * D * 256, (e < NEXP) ? X.in(I_EW3) + ((size_t)l * NEXP + e) * D * 256 : X.in(I_SW3) + (size_t)l * D * 256};
            tr_item(s, (bf16_t*)(wb + WO_13) + (size_t)e * 512 * 1024, 1024, 0, q / 16, q % 16, scr, X.lane); continue; } r -= I_F;
        { const int e = r / 128, q = r % 128; SrcPlain s{e < NEXP ? X.in(I_EW2) + ((size_t)l * NEXP + e) * 256 * D : X.in(I_SW2) + (size_t)l * 256 * D, D};
            tr_item(s, (bf16_t*)(wb + WO_2) + (size_t)e * 1024 * 256, 256, 0, q / 32, q % 32, scr, X.lane); }
    }
    const int gt = X.c * 512 + X.tid, NGT = X.G * 512;
    { bf16_t* gmw = (bf16_t*)(X.ws + WS_GMW); const float* src = X.in(I_GMW) + (size_t)l * 4 * 128 * 128;
      for (int i = gt; i < 4 * 128 * 128; i += NGT) { const int t = (i >> 7) & 127, s = i & 127; gmw[i] = (bf16_t)f2bf(s <= t ? src[i] : 0.f); } }
    for (int i = gt; i < 16 * 64; i += NGT) {
        const int g = i >> 6, p = i & 63;
        const float step = expf(X.in(I_S5STEP)[l * 16 + g]); const float lr = X.in(I_S5LRE)[(size_t)l * 1024 + i], li = X.in(I_S5LIM)[(size_t)l * 1024 + i];
        const float mag = expf(lr * step); float sn, cs; sincos_red(li * step, sn, cs);
        const float abr = mag * cs, abi = mag * sn, den = lr * lr + li * li, nr = abr - 1.0f;
        const float cr = (nr * lr + abi * li) / den, ci = (abi * lr - nr * li) / den;
        float* sa = (float*)(X.ws + WS_S5A); sa[i * 2] = abr; sa[i * 2 + 1] = abi;
        bf16_t* bb = (bf16_t*)(X.ws + WS_S5B); bf16_t* cm = (bf16_t*)(X.ws + WS_S5C);
        const float* bre = X.in(I_S5BRE) + ((size_t)l * 1024 + i) * 16; const float* bim = X.in(I_S5BIM) + ((size_t)l * 1024 + i) * 16;
#pragma unroll
        for (int ch = 0; ch < 16; ++ch) { const float br = bre[ch], bi = bim[ch];
            bb[(g * 128 + p) * 16 + ch] = (bf16_t)f2bf(cr * br - ci * bi); bb[(g * 128 + 64 + p) * 16 + ch] = (bf16_t)f2bf(cr * bi + ci * br);
            cm[(g * 16 + ch) * 128 + p] = (bf16_t)f2bf(X.in(I_S5CRE)[(((size_t)l * 16 + g) * 16 + ch) * 64 + p]);
            cm[(g * 16 + ch) * 128 + 64 + p] = (bf16_t)f2bf(-X.in(I_S5CIM)[(((size_t)l * 16 + g) * 16 + ch) * 64 + p]); }
    }
    if (l == 0) {
        const float* x = X.in(I_X); bf16_t* h = X.hbuf(); const float* mv = X.modv(0, 0);
        for (size_t i = (size_t)gt; i < (size_t)M * D / 8; i += NGT) {
            const size_t e = i * 8; const int col = (int)(e & 1023), b = (int)(e >> 23);
            const f32x4 x0 = *(const f32x4*)(x + e), x1 = *(const f32x4*)(x + e + 4);
            const f32x4 sh0 = *(const f32x4*)(mv + b * 3072 + col), sh1 = *(const f32x4*)(mv + b * 3072 + col + 4), sc0 = *(const f32x4*)(mv + b * 3072 + 1024 + col), sc1 = *(const f32x4*)(mv + b * 3072 + 1024 + col + 4);
            const f32x4 h0 = x0 * (sc0 + 1.0f) + sh0, h1 = x1 * (sc1 + 1.0f) + sh1;
            u32x4 w; w.x = pk2(h0[0], h0[1]); w.y = pk2(h0[2], h0[3]); w.z = pk2(h1[0], h1[1]); w.w = pk2(h1[2], h1[3]);
            *(u32x4*)(h + e) = w; }
    }
}

__device__ __forceinline__ void rope8(const u32x4 a, const u32x4 b, float pf, u32x4& wa, u32x4& wb) {
    float t1[8], t2[8]; t1[0] = bflo(a.x); t1[1] = bfhi(a.x); t1[2] = bflo(a.y); t1[3] = bfhi(a.y); t1[4] = bflo(a.z); t1[5] = bfhi(a.z); t1[6] = bflo(a.w); t1[7] = bfhi(a.w);
    t2[0] = bflo(b.x); t2[1] = bfhi(b.x); t2[2] = bflo(b.y); t2[3] = bfhi(b.y); t2[4] = bflo(b.z); t2[5] = bfhi(b.z); t2[6] = bflo(b.w); t2[7] = bfhi(b.w);
    float o1[8], o2[8];
    const float inv[8] = {1.0f, 0.1939227432f, 0.0376060307f, 0.00729266461f, 0.00141421356f, 0.000274248188f, 5.31829610e-05f, 1.03133862e-05f};
#pragma unroll
    for (int j = 0; j < 8; ++j) { float sn, cs; sincos_red(pf * inv[j], sn, cs); o1[j] = t1[j] * cs - t2[j] * sn; o2[j] = t2[j] * cs + t1[j] * sn; }
    wa.x = pk2(o1[0], o1[1]); wa.y = pk2(o1[2], o1[3]); wa.z = pk2(o1[4], o1[5]); wa.w = pk2(o1[6], o1[7]);
    wb.x = pk2(o2[0], o2[1]); wb.y = pk2(o2[2], o2[3]); wb.z = pk2(o2[4], o2[5]); wb.w = pk2(o2[6], o2[7]);
}
__device__ __forceinline__ void mx_rope(const Ctx& X) {
    bf16_t* pj = X.proj(); const int* pos = X.a->positions;
    const int gt = X.c * 512 + X.tid, NGT = X.G * 512;
    for (int i = gt; i < M * 10; i += NGT) {
        const int tok = i / 10, hh = i % 10;
        if (hh == 9) { const u32x4* sp = (const u32x4*)(pj + (size_t)tok * PJ + C_V); u32x4* dp = (u32x4*)((bf16_t*)(X.ws + WS_V2) + (size_t)tok * 64);
#pragma unroll
            for (int q = 0; q < 8; ++q) dp[q] = sp[q];
            continue; }
        const int col = (hh < 4) ? C_Q + hh * 64 : (hh < 8) ? C_QI + (hh - 4) * 64 : C_K;
        bf16_t* p = pj + (size_t)tok * PJ + col;
        const u32x4 a = *(const u32x4*)p, b = *(const u32x4*)(p + 8);
        u32x4 wa, wb; rope8(a, b, (float)pos[tok], wa, wb);
        if (hh < 8) { *(u32x4*)p = wa; *(u32x4*)(p + 8) = wb; }
        else { u32x4* dp = (u32x4*)((bf16_t*)(X.ws + WS_K2) + (size_t)tok * 64); const u32x4* sp = (const u32x4*)p; dp[0] = wa; dp[1] = wb;
#pragma unroll
            for (int q = 2; q < 8; ++q) dp[q] = sp[q]; }
    }
    for (int i = gt; i < (M / 16) * 16; i += NGT) {
        const int hf = i & 1, pc = (i >> 1) & 7, tile = i >> 4; const int ks = pc >> 2, fq = pc & 3;
        u32x4* dp = (u32x4*)((bf16_t*)(X.ws + WS_KI2) + (size_t)tile * 1024 + pc * 128 + hf * 64);
#pragma unroll
        for (int j = 0; j < 8; ++j) { const int tok = tile * 16 + hf * 8 + j; const bf16_t* rp = pj + (size_t)tok * PJ + C_KI;
            u32x4 v = *(const u32x4*)(rp + ks * 32 + fq * 8);
            if (pc < 2) { const u32x4 a = *(const u32x4*)rp, b = *(const u32x4*)(rp + 8); u32x4 wa, wb; rope8(a, b, (float)pos[tok], wa, wb); v = pc ? wb : wa; }
            dp[j] = v; }
    }
}

__device__ __forceinline__ void mx_gmlp(const Ctx& X, int l, int unit) {
    const int lane = X.lane, w = X.wave;
    const int row0 = unit * 128;
    LAS bf16_t* Vt = (LAS bf16_t*)X.lds;
    const bf16_t* pj = X.proj();
    const float* lng = X.in(I_GMLNG) + l * 256; const float* lnb = X.in(I_GMLNB) + l * 256;
    float g4[4], b4[4];
#pragma unroll
    for (int j = 0; j < 4; ++j) { g4[j] = lng[lane + 64 * j]; b4[j] = lnb[lane + 64 * j]; }
    for (int i = 0; i < 16; ++i) {
        const int s = w * 16 + i; const bf16_t* rp = pj + (size_t)(row0 + s) * PJ + C_GV;
        float v[4]; float sm = 0.f;
#pragma unroll
        for (int j = 0; j < 4; ++j) { v[j] = gelu_tanh(bf2f(rp[lane + 64 * j])); sm += v[j]; }
        const float mean = wave_sum(sm) * (1.0f / 256.0f); float q = 0.f;
#pragma unroll
        for (int j = 0; j < 4; ++j) { v[j] -= mean; q += v[j] * v[j]; }
        const float rstd = rsqrtf(wave_sum(q) * (1.0f / 256.0f) + LN_EPS);
#pragma unroll
        for (int j = 0; j < 4; ++j) Vt[(lane + 64 * j) * 136 + s] = (bf16_t)f2bf(v[j] * rstd * g4[j] + b4[j]);
    }
    __syncthreads();
    const int g = w >> 1, c0 = g * 64 + (w & 1) * 32, fr = lane & 15, fq = lane >> 4;
    const bf16_t* gmw = (const bf16_t*)(X.ws + WS_GMW) + (size_t)g * 128 * 128;
    const float* gmb = X.in(I_GMB) + ((size_t)l * 4 + g) * 128;
    bf16_t* ya = X.ybuf();
    for (int tt = 0; tt < 8; ++tt) {
        f32x4 acc0 = (f32x4){0.f, 0.f, 0.f, 0.f}, acc1 = acc0;
        for (int ks = 0; ks <= (tt >> 1); ++ks) {
            const bf16x8 wf = *(const bf16x8*)(gmw + (tt * 16 + fr) * 128 + ks * 32 + 8 * fq);
            const bf16x8 v0 = *(const LAS bf16x8*)(Vt + (c0 + fr) * 136 + ks * 32 + 8 * fq), v1 = *(const LAS bf16x8*)(Vt + (c0 + 16 + fr) * 136 + ks * 32 + 8 * fq);
            acc0 = mfma16(v0, wf, acc0); acc1 = mfma16(v1, wf, acc1);
        }
        const int t = tt * 16 + fr; const float bias = gmb[t];
#pragma unroll
        for (int c2 = 0; c2 < 2; ++c2) { const f32x4 a = c2 ? acc1 : acc0; const int cc = c0 + c2 * 16 + 4 * fq;
            const u32x2 uv = *(const u32x2*)(pj + (size_t)(row0 + t) * PJ + C_GU + cc);
            u32x2 o; o.x = pk2(gelu_tanh(bflo(uv.x)) * (a[0] + bias), gelu_tanh(bfhi(uv.x)) * (a[1] + bias)); o.y = pk2(gelu_tanh(bflo(uv.y)) * (a[2] + bias), gelu_tanh(bfhi(uv.y)) * (a[3] + bias));
            *(u32x2*)(ya + (size_t)(row0 + t) * 256 + cc) = o; }
    }
    __syncthreads();
}

template <int PASS>
__device__ __forceinline__ void mx_s5(const Ctx& X, int l, int wu) {
    const int lane = X.lane, fr = lane & 15, fq = lane >> 4;
    const int wgi = wu >> 3, wv = wu & 7; const int b = wgi >> 6, g = ((wgi >> 4) & 3) * 4 + (wv & 3), ch = (wgi & 15) * 2 + (wv >> 2);
    const int tb = b * SEQ + ch * 256;
    LAS float* xl = (LAS float*)(X.lds + X.wave * 16384);
    LAS bf16_t* hb = (LAS bf16_t*)(X.lds + X.wave * 16384 + 8192);
    const bf16_t* pj = X.proj();
    const bf16_t* bbT = (const bf16_t*)(X.ws + WS_S5B) + (size_t)g * 128 * 16;
    bf16x8 Bf[8];
#pragma unroll
    for (int ct = 0; ct < 8; ++ct) { Bf[ct] = (bf16x8){0, 0, 0, 0, 0, 0, 0, 0}; if (fq < 2) Bf[ct] = *(const bf16x8*)(bbT + (ct * 16 + fr) * 16 + 8 * fq); }
    const float* sa = (const float*)(X.ws + WS_S5A) + (g * 64 + lane) * 2; const float ar = sa[0], ai = sa[1];
    float hr = 0.f, hi = 0.f;
    float* st = (float*)(X.ws + WS_S5ST) + (size_t)((b * 16 + g) * 32) * 128;
    bf16x8 Cf[4]; float dsk[4];
    if (PASS == 3) {
        float pr = ar, pi = ai;
#pragma unroll
        for (int q = 0; q < 8; ++q) { const float nr = pr * pr - pi * pi, ni = 2.f * pr * pi; pr = nr; pi = ni; }
        for (int j = 0; j < ch; ++j) { const float sr = st[j * 128 + lane], si = st[j * 128 + 64 + lane]; const float nr = pr * hr - pi * hi + sr, ni = pr * hi + pi * hr + si; hr = nr; hi = ni; }
        const bf16_t* cm = (const bf16_t*)(X.ws + WS_S5C) + (size_t)g * 16 * 128;
#pragma unroll
        for (int ks = 0; ks < 4; ++ks) Cf[ks] = *(const bf16x8*)(cm + fr * 128 + ks * 32 + 8 * fq);
#pragma unroll
        for (int i = 0; i < 4; ++i) dsk[i] = X.in(I_S5D)[l * 256 + g * 16 + 4 * fq + i];
    }
    bf16_t* ycp = (bf16_t*)(X.ws + WS_YCPRE);
    for (int blk = 0; blk < 16; ++blk) {
        const int t0 = tb + blk * 16;
        bf16x8 uf = (bf16x8){0, 0, 0, 0, 0, 0, 0, 0};
        if (fq < 2) uf = *(const bf16x8*)(pj + (size_t)(t0 + fr) * PJ + C_S5 + g * 16 + 8 * fq);
#pragma unroll
        for (int ct = 0; ct < 8; ++ct) { const f32x4 a = mfma16(uf, Bf[ct], (f32x4){0.f, 0.f, 0.f, 0.f});
#pragma unroll
            for (int i = 0; i < 4; ++i) xl[(4 * fq + i) * 128 + ct * 16 + fr] = a[i]; }
#pragma unroll
        for (int t = 0; t < 16; ++t) { const float xr = xl[t * 128 + lane], xi = xl[t * 128 + 64 + lane];
            const float nr = ar * hr - ai * hi + xr, ni = ar * hi + ai * hr + xi; hr = nr; hi = ni;
            if (PASS == 3) { hb[t * 136 + lane] = (bf16_t)f2bf(hr); hb[t * 136 + 64 + lane] = (bf16_t)f2bf(hi); } }
        if (PASS == 3) {
            asm volatile("s_waitcnt lgkmcnt(0)" ::: "memory"); __builtin_amdgcn_wave_barrier();
            f32x4 acc = (f32x4){0.f, 0.f, 0.f, 0.f};
#pragma unroll
            for (int ks = 0; ks < 4; ++ks) { const bf16x8 hf = *(const LAS bf16x8*)(hb + fr * 136 + ks * 32 + 8 * fq); acc = mfma16(Cf[ks], hf, acc); }
            const u32x2 uv = *(const u32x2*)(pj + (size_t)(t0 + fr) * PJ + C_S5 + g * 16 + 4 * fq);
            const float y0 = gelu_tanh(acc[0] + dsk[0] * bflo(uv.x)), y1 = gelu_tanh(acc[1] + dsk[1] * bfhi(uv.x)), y2 = gelu_tanh(acc[2] + dsk[2] * bflo(uv.y)), y3 = gelu_tanh(acc[3] + dsk[3] * bfhi(uv.y));
            u32x2 o; o.x = pk2(y0, y1); o.y = pk2(y2, y3);
            *(u32x2*)(ycp + (size_t)(t0 + fr) * 256 + g * 16 + 4 * fq) = o;
        }
    }
    if (PASS == 1) { st[ch * 128 + lane] = hr; st[ch * 128 + 64 + lane] = hi; }
}

constexpr int SD_CM = 0, SD_BM = 18432, SD_BT = 36864, SD_XT0 = 54272, SD_XT1 = 71680, SD_MM = 89088, SD_SIN0 = 123904, SD_SIN1 = 133120, SD_DT = 142336, SD_AC = 143360, SD_END = 144384;
static_assert(SD_END <= LDS_MISC, "ssd lds");
template <int PASS>
__device__ __forceinline__ void mx_ssd(const Ctx& X, int l, int unit) {
    const int tid = X.tid, lane = X.lane, w = X.wave, fr = lane & 15, fq = lane >> 4;
    const int b = unit >> 6, c = unit & 63; const int r0 = unit * 128;
    const bf16_t* pj = X.proj();
    LAS bf16_t* Cm = (LAS bf16_t*)(X.lds + SD_CM); LAS bf16_t* Bm = (LAS bf16_t*)(X.lds + SD_BM); LAS bf16_t* Bt = (LAS bf16_t*)(X.lds + SD_BT);
    LAS bf16_t* Mm = (LAS bf16_t*)(X.lds + SD_MM);
    LAS float* dtv = (LAS float*)(X.lds + SD_DT); LAS float* acm = (LAS float*)(X.lds + SD_AC);
    const float* convw = X.in(I_CONVW) + (size_t)l * 4 * 512; const float* convb = X.in(I_CONVB) + (size_t)l * 512;
    float* sst = (float*)(X.ws + WS_SSDST); float* atot = (float*)(X.ws + WS_ATOT);
    for (int g = 0; g < 2; ++g) {
        if (tid < 256) { const int j = tid >> 7, rl = tid & 127, h = 2 * g + j;
            const float raw = bf2f(pj[(size_t)(r0 + rl) * PJ + C_DT + h]) + X.in(I_DTBIAS)[l * 4 + h];
            const float dt = softplusf_(raw); dtv[j * 128 + rl] = dt; acm[j * 128 + rl] = -expf(X.in(I_ALOG)[l * 4 + h]) * dt; }
        __syncthreads();
        float cum = 0.f;
        if (tid < 256) { const int j = tid >> 7, rl = tid & 127; for (int k = 0; k <= rl; ++k) cum += acm[j * 128 + k]; }
        __syncthreads();
        if (tid < 256) acm[tid] = cum;
        __syncthreads();
        if (PASS == 1 && tid < 2) atot[(b * 64 + c) * 32 + 2 * g + tid] = acm[tid * 128 + 127];
        constexpr int NCG = (PASS == 1) ? 24 : 32;
        for (int it = tid; it < NCG * 128; it += 512) {
            const int rl = it & 127, cg = it >> 7;
            const int chn = (cg < 16) ? g * 128 + cg * 8 : (cg < 24) ? 256 + g * 64 + (cg - 16) * 8 : 384 + g * 64 + (cg - 24) * 8;
            float a8[8];
            { const f32x4 c0 = *(const f32x4*)(convb + chn), c1 = *(const f32x4*)(convb + chn + 4); a8[0] = c0[0]; a8[1] = c0[1]; a8[2] = c0[2]; a8[3] = c0[3]; a8[4] = c1[0]; a8[5] = c1[1]; a8[6] = c1[2]; a8[7] = c1[3]; }
#pragma unroll
            for (int k = 0; k < 4; ++k) { const int sq = c * 128 + rl - 3 + k;
                if (sq >= 0) { const u32x4 xv = *(const u32x4*)(pj + (size_t)(b * SEQ + sq) * PJ + C_XBC + chn);
                    const f32x4 w0 = *(const f32x4*)(convw + k * 512 + chn), w1 = *(const f32x4*)(convw + k * 512 + chn + 4);
                    a8[0] += w0[0] * bflo(xv.x); a8[1] += w0[1] * bfhi(xv.x); a8[2] += w0[2] * bflo(xv.y); a8[3] += w0[3] * bfhi(xv.y);
                    a8[4] += w1[0] * bflo(xv.z); a8[5] += w1[1] * bfhi(xv.z); a8[6] += w1[2] * bflo(xv.w); a8[7] += w1[3] * bfhi(xv.w); } }
#pragma unroll
            for (int q = 0; q < 8; ++q) a8[q] = siluf_(a8[q]);
            if (cg < 16) { const int j = cg >> 3, p0 = (cg & 7) * 8; LAS bf16_t* Xt = (LAS bf16_t*)(X.lds + (j ? SD_XT1 : SD_XT0));
                float sc = 1.0f; if (PASS == 1) sc = __expf(acm[j * 128 + 127] - acm[j * 128 + rl]) * dtv[j * 128 + rl];
#pragma unroll
                for (int q = 0; q < 8; ++q) Xt[(p0 + q) * 136 + rl] = (bf16_t)f2bf(a8[q] * sc); }
            else if (cg < 24) { const int n0 = (cg - 16) * 8;
                if (PASS == 1) {
#pragma unroll
                    for (int q = 0; q < 8; ++q) Bt[(n0 + q) * 136 + rl] = (bf16_t)f2bf(a8[q]); }
                else { u32x4 o; o.x = pk2(a8[0], a8[1]); o.y = pk2(a8[2], a8[3]); o.z = pk2(a8[4], a8[5]); o.w = pk2(a8[6], a8[7]); *(LAS u32x4*)(Bm + rl * 72 + n0) = o; } }
            else { const int n0 = (cg - 24) * 8; u32x4 o; o.x = pk2(a8[0], a8[1]); o.y = pk2(a8[2], a8[3]); o.z = pk2(a8[4], a8[5]); o.w = pk2(a8[6], a8[7]); *(LAS u32x4*)(Cm + rl * 72 + n0) = o; }
        }
        if (PASS == 3) {
            const bf16_t* sin = (const bf16_t*)(X.ws + WS_SSDSIN) + (size_t)((b * 64 + c) * 4 + 2 * g) * 4096 + tid * 8;
            const int p = tid >> 3, n0 = (tid & 7) * 8;
            *(LAS u32x4*)((LAS bf16_t*)(X.lds + SD_SIN0) + p * 72 + n0) = *(const u32x4*)sin;
            *(LAS u32x4*)((LAS bf16_t*)(X.lds + SD_SIN1) + p * 72 + n0) = *(const u32x4*)(sin + 4096);
        }
        __syncthreads();
        if (PASS == 1) {
            const int j = w >> 2, pt = w & 3; const LAS bf16_t* Xt = (const LAS bf16_t*)(X.lds + (j ? SD_XT1 : SD_XT0));
            f32x4 acc[4];
#pragma unroll
            for (int nt = 0; nt < 4; ++nt) acc[nt] = (f32x4){0.f, 0.f, 0.f, 0.f};
#pragma unroll
            for (int ks = 0; ks < 4; ++ks) { const bf16x8 xf = *(const LAS bf16x8*)(Xt + (pt * 16 + fr) * 136 + ks * 32 + 8 * fq);
#pragma unroll
                for (int nt = 0; nt < 4; ++nt) { const bf16x8 bf = *(const LAS bf16x8*)(Bt + (nt * 16 + fr) * 136 + ks * 32 + 8 * fq); acc[nt] = mfma16(xf, bf, acc[nt]); } }
            float* sp = sst + (size_t)((b * 64 + c) * 4 + 2 * g + j) * 4096;
#pragma unroll
            for (int nt = 0; nt < 4; ++nt)
#pragma unroll
                for (int i = 0; i < 4; ++i) sp[(pt * 16 + 4 * fq + i) * 64 + nt * 16 + fr] = acc[nt][i];
        } else {
            const int lrow = w * 16 + fr;
            float yv[2][4][4];
#pragma unroll
            for (int j = 0; j < 2; ++j) {
                const LAS bf16_t* Xt = (const LAS bf16_t*)(X.lds + (j ? SD_XT1 : SD_XT0)); const LAS bf16_t* Sin = (const LAS bf16_t*)(X.lds + (j ? SD_SIN1 : SD_SIN0));
                const float al = acm[j * 128 + lrow];
                const bf16x8 cf0 = *(const LAS bf16x8*)(Cm + lrow * 72 + 8 * fq), cf1 = *(const LAS bf16x8*)(Cm + lrow * 72 + 32 + 8 * fq);
                const int stmax = w | 1;
                for (int st = 0; st <= stmax; ++st) {
                    f32x4 ag = (f32x4){0.f, 0.f, 0.f, 0.f};
                    if (st <= w) { const bf16x8 b0 = *(const LAS bf16x8*)(Bm + (st * 16 + fr) * 72 + 8 * fq), b1 = *(const LAS bf16x8*)(Bm + (st * 16 + fr) * 72 + 32 + 8 * fq);
                        ag = mfma16(b0, cf0, ag); ag = mfma16(b1, cf1, ag); }
                    float mv[4];
#pragma unroll
                    for (int i = 0; i < 4; ++i) { const int s = st * 16 + 4 * fq + i; mv[i] = (s <= lrow) ? ag[i] * __expf(al - acm[j * 128 + s]) * dtv[j * 128 + s] : 0.f; }
                    u32x2 o; o.x = pk2(mv[0], mv[1]); o.y = pk2(mv[2], mv[3]); *(LAS u32x2*)(Mm + lrow * 136 + st * 16 + 4 * fq) = o;
                }
                const float eal = __expf(al); const float dsk = X.in(I_SSDD)[l * 4 + 2 * g + j];
#pragma unroll
                for (int pt = 0; pt < 4; ++pt) {
                    f32x4 ad = (f32x4){0.f, 0.f, 0.f, 0.f}, ao = ad;
                    for (int ks = 0; ks <= (w >> 1); ++ks) { const bf16x8 xf = *(const LAS bf16x8*)(Xt + (pt * 16 + fr) * 136 + ks * 32 + 8 * fq), mf = *(const LAS bf16x8*)(Mm + lrow * 136 + ks * 32 + 8 * fq); ad = mfma16(xf, mf, ad); }
                    { const bf16x8 s0 = *(const LAS bf16x8*)(Sin + (pt * 16 + fr) * 72 + 8 * fq), s1 = *(const LAS bf16x8*)(Sin + (pt * 16 + fr) * 72 + 32 + 8 * fq); ao = mfma16(s0, cf0, ao); ao = mfma16(s1, cf1, ao); }
                    const int h = 2 * g + j; const u32x2 zv = *(const u32x2*)(pj + (size_t)(r0 + lrow) * PJ + C_Z + h * 64 + pt * 16 + 4 * fq);
                    const float z4[4] = {bflo(zv.x), bfhi(zv.x), bflo(zv.y), bfhi(zv.y)};
#pragma unroll
                    for (int i = 0; i < 4; ++i) { const float xs = bf2f(Xt[(pt * 16 + 4 * fq + i) * 136 + lrow]); yv[j][pt][i] = (ad[i] + eal * ao[i] + dsk * xs) * siluf_(z4[i]); }
                }
            }
            float ss = 0.f;
#pragma unroll
            for (int j = 0; j < 2; ++j)
#pragma unroll
                for (int pt = 0; pt < 4; ++pt)
#pragma unroll
                    for (int i = 0; i < 4; ++i) ss += yv[j][pt][i] * yv[j][pt][i];
            ss += __shfl_xor(ss, 16); ss += __shfl_xor(ss, 32);
            const float rs = rsqrtf(ss * (1.0f / 128.0f) + RMS_EPS);
            const float* ng = X.in(I_SSDNG) + l * 256 + g * 128; bf16_t* yd = X.ybuf() + (size_t)3 * M * 256;
#pragma unroll
            for (int j = 0; j < 2; ++j)
#pragma unroll
                for (int pt = 0; pt < 4; ++pt) { const int cc = j * 64 + pt * 16 + 4 * fq; const f32x4 gv = *(const f32x4*)(ng + cc);
                    u32x2 o; o.x = pk2(yv[j][pt][0] * rs * gv[0], yv[j][pt][1] * rs * gv[1]); o.y = pk2(yv[j][pt][2] * rs * gv[2], yv[j][pt][3] * rs * gv[3]);
                    *(u32x2*)(yd + (size_t)(r0 + lrow) * 256 + g * 128 + cc) = o; }
        }
        __syncthreads();
    }
}

__device__ __forceinline__ void mx_ssd_carry(const Ctx& X) {
    const float* sst = (const float*)(X.ws + WS_SSDST); const float* atot = (const float*)(X.ws + WS_ATOT); bf16_t* sin = (bf16_t*)(X.ws + WS_SSDSIN);
    for (int i = X.c * 512 + X.tid; i < NB * 4 * 1024; i += X.G * 512) {
        const int e4 = i & 1023, h = (i >> 10) & 3, b = i >> 12;
        f32x4 S = (f32x4){0.f, 0.f, 0.f, 0.f};
#pragma unroll 8
        for (int c = 0; c < 64; ++c) { const size_t o = (size_t)((b * 64 + c) * 4 + h) * 4096 + e4 * 4;
            u32x2 w; w.x = pk2(S[0], S[1]); w.y = pk2(S[2], S[3]); *(u32x2*)(sin + o) = w;
            const f32x4 st = *(const f32x4*)(sst + o); const float d = __expf(atot[(b * 64 + c) * 32 + h]); S = S * d + st; }
    }
}

__device__ __forceinline__ unsigned ord16(float s) { const _Float16 hf = (_Float16)s; const unsigned bits = (unsigned)__builtin_bit_cast(unsigned short, hf); return bits ^ ((bits & 0x8000u) ? 0xFFFFu : 0x8000u); }
__device__ __forceinline__ int cnt_ge8(const u32x4 v, unsigned c) {
    int n = 0;
    n += ((v.x & 0xFFFFu) >= c) + ((v.x >> 16) >= c); n += ((v.y & 0xFFFFu) >= c) + ((v.y >> 16) >= c);
    n += ((v.z & 0xFFFFu) >= c) + ((v.z >> 16) >= c); n += ((v.w & 0xFFFFu) >= c) + ((v.w >> 16) >= c);
    return n;
}
template <int CTRL> __device__ __forceinline__ float dpp_f(float v) { return __builtin_bit_cast(float, __builtin_amdgcn_update_dpp(0, __builtin_bit_cast(int, v), CTRL, 0xF, 0xF, true)); }
__device__ __forceinline__ void mx_dsa(const Ctx& X, int b, int t0) {
    const int tid = X.tid, lane = X.lane, w = X.wave, fr = lane & 15, fq = lane >> 4;
    const bf16_t* pj = X.proj() + (size_t)b * SEQ * PJ; const unsigned rb = 0u;
    const bf16_t* ki2 = (const bf16_t*)(X.ws + WS_KI2) + (size_t)b * SEQ * 64; const bf16_t* k2 = (const bf16_t*)(X.ws + WS_K2) + (size_t)b * SEQ * 64; const bf16_t* v2 = (const bf16_t*)(X.ws + WS_V2) + (size_t)b * SEQ * 64;
    LAS unsigned short* sc = (LAS unsigned short*)X.lds;
    const int nk = t0 + 8, nkt = (nk + 15) >> 4;
    LAS unsigned* hist = (LAS unsigned*)(X.lds + 131072 + 8192);
    for (int i = tid; i < 8 * 4 * 128 / 4; i += 512) *(LAS u32x4*)(hist + 4 * i) = (u32x4){0u, 0u, 0u, 0u};
    bf16x8 qf[2][2]; f32x4 wq[2];
#pragma unroll
    for (int ct = 0; ct < 2; ++ct) { const int q = 4 * ct + (fr >> 2), hh = fr & 3; const bf16_t* qp = pj + (unsigned)(t0 + q) * (unsigned)PJ;
        qf[ct][0] = *(const bf16x8*)(qp + C_QI + hh * 64 + 8 * fq); qf[ct][1] = *(const bf16x8*)(qp + C_QI + hh * 64 + 32 + 8 * fq);
        const u32x2 wv = *(const u32x2*)(pj + (unsigned)(t0 + 4 * ct + fq) * (unsigned)PJ + C_WI);
        wq[ct] = (f32x4){bflo(wv.x) * 0.0625f, bfhi(wv.x) * 0.0625f, bflo(wv.y) * 0.0625f, bfhi(wv.y) * 0.0625f}; }
    const int ntw = (nkt > w) ? ((nkt - w + 7) >> 3) : 0;
    __syncthreads();
#define DSA_LOAD4(KF, I0) do { _Pragma("unroll") for (int j = 0; j < 4; ++j) { int kt_ = w + 8 * ((I0) + j); kt_ = kt_ < nkt ? kt_ : nkt - 1; \
        const unsigned ko_ = (unsigned)kt_ * 1024u + (unsigned)lane * 8u; KF[j][0] = *(const bf16x8*)(ki2 + ko_); KF[j][1] = *(const bf16x8*)(ki2 + ko_ + 512u); } } while (0)
#define DSA_COMP4(KF, I0) do { if (DSA_PM == 2 && rs1 > 0) { _Pragma("unroll") for (int j = 0; j < 4; ++j) dummy_ ^= KF[j][0][0] ^ KF[j][1][3]; break; } \
      _Pragma("unroll") for (int jh = 0; jh < 4; jh += 2) { f32x4 ac_[2][2]; \
        _Pragma("unroll") for (int j = 0; j < 2; ++j) _Pragma("unroll") for (int ct = 0; ct < 2; ++ct) { \
            ac_[j][ct] = mfma16(qf[ct][0], KF[jh + j][0], (f32x4){0.f, 0.f, 0.f, 0.f}); ac_[j][ct] = mfma16(qf[ct][1], KF[jh + j][1], ac_[j][ct]); } \
        _Pragma("unroll") for (int j = 0; j < 2; ++j) { if ((I0) + jh + j < ntw) { const int kt_ = w + 8 * ((I0) + jh + j); const bool full_ = (kt_ * 16 + 15 <= t0); const int key_ = kt_ * 16 + fr; \
        _Pragma("unroll") for (int ct = 0; ct < 2; ++ct) { const f32x4 a_ = ac_[j][ct]; \
            float tt_ = __builtin_fmaf(__builtin_amdgcn_fmed3f(a_[0], 0.f, 3.0e38f), wq[ct][0], 0.0f); tt_ = __builtin_fmaf(__builtin_amdgcn_fmed3f(a_[1], 0.f, 3.0e38f), wq[ct][1], tt_); \
            tt_ = __builtin_fmaf(__builtin_amdgcn_fmed3f(a_[2], 0.f, 3.0e38f), wq[ct][2], tt_); tt_ = __builtin_fmaf(__builtin_amdgcn_fmed3f(a_[3], 0.f, 3.0e38f), wq[ct][3], tt_); \
            const int q_ = 4 * ct + fq; unsigned kk_ = ord16(tt_ + 0.0f); \
            if (!full_) kk_ = (key_ <= t0 + q_) ? kk_ : 0u; \
            if (DSA_PM == 1 && rs1 > 0) dummy_ ^= (short)kk_; else sc[q_ * 8192 + key_] = (unsigned short)kk_; \
            if ((R_S1 == 1 || rs1 == 0) && (full_ || kk_ != 0u)) __hip_atomic_fetch_add(hist + (q_ * 4 + (fr & 3)) * 128 + (kk_ >> 9), (kk_ & 0x100u) ? 65536u : 1u, __ATOMIC_RELAXED, __HIP_MEMORY_SCOPE_WORKGROUP); } } } } } while (0)
    short dummy_ = 0;
    _Pragma("nounroll") for (int rs1 = 0; rs1 < R_S1; ++rs1)
    { bf16x8 ka[4][2], kb[4][2];
      if (ntw > 0) { DSA_LOAD4(ka, 0);
#pragma nounroll
        for (int i0 = 0; i0 < ntw; i0 += 8) { DSA_LOAD4(kb, i0 + 4); DSA_COMP4(ka, i0); DSA_LOAD4(ka, i0 + 8); DSA_COMP4(kb, i0 + 4); } } }
#undef DSA_LOAD4
#undef DSA_COMP4
    if (dummy_ == (short)0x1234 && t0 == 123457) sc[0] = 1;
    { const int z0 = nkt * 16, z1 = ((nk + 511) >> 9) << 9;
        for (int i = z0 + tid; i < z1; i += 512) {
#pragma unroll
            for (int q = 0; q < 8; ++q) sc[q * 8192 + i] = 0; } }
    __syncthreads();
    const int t = t0 + w, nv = t + 1;
    LAS unsigned short* row = sc + w * 8192;
    LAS unsigned short* list = (LAS unsigned short*)(X.lds + 131072 + w * 512);
    const int nsel = nv < 256 ? nv : 256;
    if (nv <= 256) { for (int n = lane; n < 256; n += 64) list[n] = (unsigned short)n; }
    else {
        const int nit = (nv + 511) >> 9;
        LAS unsigned* H = hist + w * 512;
        int T1, above1;
        { u32x4 h4 = (u32x4){0u, 0u, 0u, 0u};
#pragma unroll
          for (int c4 = 0; c4 < 4; ++c4) { const u32x2 pw = *(const LAS u32x2*)(H + c4 * 128 + 2 * lane); h4.x += pw.x & 0xFFFFu; h4.y += pw.x >> 16; h4.z += pw.y & 0xFFFFu; h4.w += pw.y >> 16; }
          const int sl = (int)(h4.x + h4.y + h4.z + h4.w);
          int suf = sl;
#pragma unroll
          for (int o = 1; o < 64; o <<= 1) { const int dn = __shfl_down(suf, o); if (lane + o < 64) suf += dn; }
          const unsigned long long bm = __ballot(suf >= 256); const int L = 63 - __builtin_clzll(bm);
          const int hx = __shfl((int)h4.x, L), hy = __shfl((int)h4.y, L), hz = __shfl((int)h4.z, L), hw = __shfl((int)h4.w, L);
          const int sufn = __shfl(suf, L) - (hx + hy + hz + hw);
          int cb = sufn; T1 = 4 * L + 3; above1 = cb;
          if (cb + hw >= 256) { T1 = 4 * L + 3; above1 = cb; } else { cb += hw; if (cb + hz >= 256) { T1 = 4 * L + 2; above1 = cb; } else { cb += hz; if (cb + hy >= 256) { T1 = 4 * L + 1; above1 = cb; } else { cb += hy; T1 = 4 * L; above1 = cb; } } } }
        _Pragma("nounroll") for (int rs2 = 0; rs2 < R_S2; ++rs2) {
        *(LAS u32x4*)(H + 4 * lane) = (u32x4){0u, 0u, 0u, 0u};
        for (int it = 0; it < nit; ++it) { const u32x4 v = *(const LAS u32x4*)(row + (it * 64 + lane) * 8);
            const unsigned e[8] = {v.x & 0xFFFFu, v.x >> 16, v.y & 0xFFFFu, v.y >> 16, v.z & 0xFFFFu, v.z >> 16, v.w & 0xFFFFu, v.w >> 16};
#pragma unroll
            for (int j = 0; j < 8; ++j) if ((int)(e[j] >> 8) == T1) __hip_atomic_fetch_add(H + (e[j] & 255u), 1u, __ATOMIC_RELAXED, __HIP_MEMORY_SCOPE_WORKGROUP); }
        unsigned thr; int cgt, cge;
        { const u32x4 h4 = *(const LAS u32x4*)(H + 4 * lane); const int sl = (int)(h4.x + h4.y + h4.z + h4.w);
          int suf = sl;
#pragma unroll
          for (int o = 1; o < 64; o <<= 1) { const int dn = __shfl_down(suf, o); if (lane + o < 64) suf += dn; }
          const int need = 256 - above1;
          const unsigned long long bm = __ballot(suf >= need); const int L = 63 - __builtin_clzll(bm);
          const int hx = __shfl((int)h4.x, L), hy = __shfl((int)h4.y, L), hz = __shfl((int)h4.z, L), hw = __shfl((int)h4.w, L);
          int cb = __shfl(suf, L) - (hx + hy + hz + hw); int T2, hT;
          if (cb + hw >= need) { T2 = 4 * L + 3; hT = hw; } else { cb += hw; if (cb + hz >= need) { T2 = 4 * L + 2; hT = hz; } else { cb += hz; if (cb + hy >= need) { T2 = 4 * L + 1; hT = hy; } else { cb += hy; T2 = 4 * L; hT = hx; } } }
          thr = ((unsigned)T1 << 8) | (unsigned)T2; cgt = above1 + cb; cge = cgt + hT; }
        const bool exact = (cge == 256);
        const int r = 256 - cgt;
        const unsigned cmin = exact ? thr : thr + 1u;
        const unsigned long long lt_mask = (1ull << lane) - 1ull; int bcnt = 0;
        for (int it = 0; it < nit; ++it) { const u32x4 v = *(const LAS u32x4*)(row + (it * 64 + lane) * 8); const int base = (it * 64 + lane) * 8;
            const unsigned e[8] = {v.x & 0xFFFFu, v.x >> 16, v.y & 0xFFFFu, v.y >> 16, v.z & 0xFFFFu, v.z >> 16, v.w & 0xFFFFu, v.w >> 16};
#pragma unroll
            for (int j = 0; j < 8; ++j) { const bool sl = e[j] >= cmin; const unsigned long long bm = __ballot(sl);
                if (bm != 0ull) { if (sl) list[(bcnt + __popcll(bm & lt_mask)) & 255] = (unsigned short)(base + j); bcnt += __popcll(bm); } } }
        if (!exact) {
            int taken = 0;
            for (int it = 0; it < nit && taken < r; ++it) { const u32x4 v = *(const LAS u32x4*)(row + (it * 64 + lane) * 8); const int base = (it * 64 + lane) * 8;
                const unsigned e[8] = {v.x & 0xFFFFu, v.x >> 16, v.y & 0xFFFFu, v.y >> 16, v.z & 0xFFFFu, v.z >> 16, v.w & 0xFFFFu, v.w >> 16};
                int mcount = 0;
#pragma unroll
                for (int j = 0; j < 8; ++j) mcount += (e[j] == thr);
                if (__ballot(mcount != 0) == 0ull) continue;
                int incl = mcount;
#pragma unroll
                for (int o = 1; o < 64; o <<= 1) { const int up = __shfl_up(incl, o); if (lane >= o) incl += up; }
                const int total = __shfl(incl, 63); int rk = taken + incl - mcount;
#pragma unroll
                for (int j = 0; j < 8; ++j) if (e[j] == thr) { if (rk < r) list[(cgt + rk) & 255] = (unsigned short)(base + j); ++rk; }
                taken += total; }
        }
        }
    }
    __builtin_amdgcn_fence(__ATOMIC_RELEASE, "workgroup"); __builtin_amdgcn_wave_barrier();
    const bf16_t* qrow = pj + (unsigned)t * (unsigned)PJ;
    bf16x8 qb0 = (bf16x8){0, 0, 0, 0, 0, 0, 0, 0}, qb1 = qb0;
    if (fr < 4) { qb0 = *(const bf16x8*)(qrow + C_Q + fr * 64 + 8 * fq); qb1 = *(const bf16x8*)(qrow + C_Q + fr * 64 + 32 + 8 * fq); }
    LAS float* Pb = (LAS float*)row;
    LAS float* pinv = (LAS float*)(X.lds + 131072 + 4096 + 256 + w * 16);
    _Pragma("nounroll") for (int rs3 = 0; rs3 < R_S3; ++rs3) {
#define QK_LOAD8(KF, T0) do { _Pragma("unroll") for (int j = 0; j < 4; ++j) { const unsigned ko_ = (unsigned)list[((T0) + j) * 16 + fr] * 64u + (unsigned)(8 * fq); \
        KF[j][0] = *(const bf16x8*)(k2 + ko_); KF[j][1] = *(const bf16x8*)(k2 + ko_ + 32u); } } while (0)
#define QK_COMP8(KF, T0) do { _Pragma("unroll") for (int j = 0; j < 4; ++j) { f32x4 a_ = mfma16(KF[j][0], qb0, (f32x4){0.f, 0.f, 0.f, 0.f}); a_ = mfma16(KF[j][1], qb1, a_); \
        if (fr < 4) { _Pragma("unroll") for (int i = 0; i < 4; ++i) { const int nn_ = ((T0) + j) * 16 + 4 * fq + i; Pb[nn_ * 4 + fr] = (nn_ < nsel) ? a_[i] * 0.125f : -3.0e38f; } } } } while (0)
    { bf16x8 qa[4][2], qc[4][2]; QK_LOAD8(qa, 0); QK_LOAD8(qc, 4); QK_COMP8(qa, 0); QK_LOAD8(qa, 8); QK_COMP8(qc, 4); QK_LOAD8(qc, 12); QK_COMP8(qa, 8); QK_COMP8(qc, 12); }
#undef QK_LOAD8
#undef QK_COMP8
    __builtin_amdgcn_fence(__ATOMIC_RELEASE, "workgroup"); __builtin_amdgcn_wave_barrier();
    { const int hd = lane & 3, nb0 = lane >> 2;
        float v16[16]; float mx = -3.0e38f;
#pragma unroll
        for (int j = 0; j < 16; ++j) { v16[j] = Pb[(nb0 + 16 * j) * 4 + hd]; mx = fmaxf(mx, v16[j]); }
        mx = fmaxf(mx, __shfl_xor(mx, 4)); mx = fmaxf(mx, __shfl_xor(mx, 8)); mx = fmaxf(mx, __shfl_xor(mx, 16)); mx = fmaxf(mx, __shfl_xor(mx, 32));
        float sm = 0.f;
#pragma unroll
        for (int j = 0; j < 16; ++j) { const float p = (v16[j] > -1.0e38f) ? __expf(v16[j] - mx) : 0.f; sm += p; Pb[(nb0 + 16 * j) * 4 + hd] = p; }
        sm += __shfl_xor(sm, 4); sm += __shfl_xor(sm, 8); sm += __shfl_xor(sm, 16); sm += __shfl_xor(sm, 32);
        if (lane < 4) pinv[lane] = 1.0f / sm; }
    __builtin_amdgcn_fence(__ATOMIC_RELEASE, "workgroup"); __builtin_amdgcn_wave_barrier();
    float o4[4][4];
#pragma unroll
    for (int h = 0; h < 4; ++h)
#pragma unroll
        for (int dd = 0; dd < 4; ++dd) o4[h][dd] = 0.f;
    const int d4 = fr * 4;
#define PV_LOAD(VV, B) do { _Pragma("unroll") for (int j = 0; j < 8; ++j) { const unsigned vo_ = (unsigned)list[(B) * 32 + 4 * j + fq] * 64u + (unsigned)d4; VV[j] = *(const u32x2*)(v2 + vo_); } } while (0)
#define PV_COMP(VV, B) do { _Pragma("unroll") for (int j = 0; j < 8; ++j) { const f32x4 p4_ = *(const LAS f32x4*)(Pb + ((B) * 32 + 4 * j + fq) * 4); \
        const float v0_ = bflo(VV[j].x), v1_ = bfhi(VV[j].x), v2_ = bflo(VV[j].y), v3_ = bfhi(VV[j].y); \
        _Pragma("unroll") for (int h = 0; h < 4; ++h) { o4[h][0] += p4_[h] * v0_; o4[h][1] += p4_[h] * v1_; o4[h][2] += p4_[h] * v2_; o4[h][3] += p4_[h] * v3_; } } } while (0)
    { u32x2 va[8], vb[8]; PV_LOAD(va, 0); PV_LOAD(vb, 1); PV_COMP(va, 0); PV_LOAD(va, 2); PV_COMP(vb, 1); PV_LOAD(vb, 3); PV_COMP(va, 2); PV_LOAD(va, 4); PV_COMP(vb, 3); PV_LOAD(vb, 5);
      PV_COMP(va, 4); PV_LOAD(va, 6); PV_COMP(vb, 5); PV_LOAD(vb, 7); PV_COMP(va, 6); PV_COMP(vb, 7); }
#undef PV_LOAD
#undef PV_COMP
#pragma unroll
    for (int h = 0; h < 4; ++h)
#pragma unroll
        for (int dd = 0; dd < 4; ++dd) { float v = o4[h][dd]; v += __shfl_xor(v, 16); v += __shfl_xor(v, 32); o4[h][dd] = v; }
    { const int h = fq; const float iv = pinv[h];
        float r4[4];
#pragma unroll
        for (int dd = 0; dd < 4; ++dd) r4[dd] = ((h == 0) ? o4[0][dd] : (h == 1) ? o4[1][dd] : (h == 2) ? o4[2][dd] : o4[3][dd]) * iv;
        u32x2 o; o.x = pk2(r4[0], r4[1]); o.y = pk2(r4[2], r4[3]);
        *(u32x2*)(X.ybuf() + (size_t)1 * M * 256 + ((size_t)b * SEQ + t) * 256 + h * 64 + d4) = o; }
    __builtin_amdgcn_fence(__ATOMIC_RELEASE, "workgroup"); __builtin_amdgcn_wave_barrier(); }
    __syncthreads();
}

__device__ __forceinline__ void ph_ln1_router(const Ctx& X, int l) {
    const int lane = X.lane, w = X.wave, tid = X.tid;
    LAS float* rw = (LAS float*)X.lds;
    LAS float* hrow = (LAS float*)(X.lds + 131072 + w * 2048);
    LAS unsigned* wgcnt = (LAS unsigned*)(X.lds + 131072 + 16384);
    { const float* src = X.in(I_RW) + (size_t)l * D * NEXP; for (int i = tid; i < D * NEXP / 4; i += 512) *(LAS f32x4*)(rw + 4 * i) = *(const f32x4*)(src + 4 * i); }
    if (tid < 32) wgcnt[tid] = 0u;
    __syncthreads();
    float* xo = X.a->out; bf16_t* hb = X.hbuf();
    const int tok0 = X.c * 128, b = tok0 >> 13;
    const float* mv = X.modv(l, 1) + b * 3072;
    const float* lg = X.in(I_LN1G) + l * D; const float* lb = X.in(I_LN1B) + l * D;
    const int e = lane & 31, half = lane >> 5;
    const float rbias = X.in(I_RB)[l * NEXP + e];
    unsigned* pinfo = (unsigned*)(X.ws + WS_PINFO); float* pgate = (float*)(X.ws + WS_PGATE);
    for (int i = 0; i < 16; ++i) {
        const int tok = tok0 + w * 16 + i;
        f32x4 v[4]; float s = 0.f;
#pragma unroll
        for (int j = 0; j < 4; ++j) { v[j] = *(const f32x4*)(xo + (size_t)tok * D + 4 * lane + 256 * j); s += (v[j][0] + v[j][1]) + (v[j][2] + v[j][3]); }
        const float mean = wave_sum(s) * (1.0f / D); float q = 0.f;
#pragma unroll
        for (int j = 0; j < 4; ++j) { v[j] = v[j] - mean; q += (v[j][0] * v[j][0] + v[j][1] * v[j][1]) + (v[j][2] * v[j][2] + v[j][3] * v[j][3]); }
        const float rstd = rsqrtf(wave_sum(q) * (1.0f / D) + LN_EPS);
        f32x4 hv[4];
#pragma unroll
        for (int j = 0; j < 4; ++j) { const int col = 4 * lane + 256 * j;
            const f32x4 x1 = v[j] * rstd * *(const f32x4*)(lg + col) + *(const f32x4*)(lb + col);
            *(f32x4*)(xo + (size_t)tok * D + col) = x1 * DN_ALPHA;
            hv[j] = x1 * (*(const f32x4*)(mv + 1024 + col) + 1.0f) + *(const f32x4*)(mv + col);
            u32x2 o; o.x = pk2(hv[j][0], hv[j][1]); o.y = pk2(hv[j][2], hv[j][3]); *(u32x2*)(hb + (size_t)tok * D + col) = o; }
        float accr = 0.f;
#pragma unroll
        for (int blk = 0; blk < 2; ++blk) {
            *(LAS f32x4*)(hrow + 4 * lane) = hv[2 * blk]; *(LAS f32x4*)(hrow + 256 + 4 * lane) = hv[2 * blk + 1];
            __builtin_amdgcn_fence(__ATOMIC_RELEASE, "workgroup"); __builtin_amdgcn_wave_barrier();
            const LAS float* hp = hrow + half * 256; const LAS float* rp = rw + (size_t)(blk * 512 + half * 256) * 32 + e;
#pragma unroll 8
            for (int d = 0; d < 256; d += 4) { const f32x4 h4 = *(const LAS f32x4*)(hp + d);
                accr += h4[0] * rp[(d + 0) * 32]; accr += h4[1] * rp[(d + 1) * 32]; accr += h4[2] * rp[(d + 2) * 32]; accr += h4[3] * rp[(d + 3) * 32]; }
            __builtin_amdgcn_fence(__ATOMIC_RELEASE, "workgroup"); __builtin_amdgcn_wave_barrier();
        }
        accr += __shfl_xor(accr, 32);
        const float score = sigmoidf_(accr), biased = score + rbias;
        const int gbase = lane & ~3;
        const float v0 = __shfl(biased, gbase), v1 = __shfl(biased, gbase + 1), v2 = __shfl(biased, gbase + 2), v3 = __shfl(biased, gbase + 3);
        const float a_ = fmaxf(v0, v1), b_ = fminf(v0, v1), c_ = fmaxf(v2, v3), d_ = fminf(v2, v3);
        const float gs = fmaxf(a_, c_) + fmaxf(fminf(a_, c_), fmaxf(b_, d_));
        const int myg = e >> 2; int grank = 0;
#pragma unroll
        for (int g2 = 0; g2 < 8; ++g2) { const float o = __shfl(gs, 4 * g2); grank += (o > gs || (o == gs && g2 < myg)) ? 1 : 0; }
        const float masked = (grank < 4) ? biased : -3.0e38f;
        int erank = 0;
#pragma unroll
        for (int e2 = 0; e2 < 32; ++e2) { const float o = __shfl(masked, e2); erank += (o > masked || (o == masked && e2 < e)) ? 1 : 0; }
        const bool sel = (erank < 8) && (lane < 32);
        const float wsum = wave_sum(sel ? score : 0.f);
        const float gate = score / wsum * 2.5f;
        const unsigned long long bal = __ballot(sel);
        if (sel) { const int k = __popcll(bal & ((1ull << lane) - 1ull));
            const unsigned lr = __hip_atomic_fetch_add(wgcnt + e, 1u, __ATOMIC_RELAXED, __HIP_MEMORY_SCOPE_WORKGROUP);
            pinfo[(size_t)tok * 8 + k] = (unsigned)e | (lr << 8); pgate[(size_t)tok * 8 + k] = gate; }
    }
    __syncthreads();
    if (tid < 32) { const int chunk = tok0 / CHTOK; unsigned* cnt = (unsigned*)(X.ws + WS_CTL) + CW_CNT + (l * NCH + chunk) * 64;
        const unsigned base = __hip_atomic_fetch_add(cnt + tid, wgcnt[tid], __ATOMIC_RELAXED, __HIP_MEMORY_SCOPE_AGENT);
        ((unsigned*)(X.ws + WS_WGBASE))[X.c * 32 + tid] = base; }
    __syncthreads();
}

__device__ __forceinline__ void moe_offsets(const Ctx& X, int l, int chunk, LAS int* off  , LAS int* cntl  ) {
    if (X.tid == 0) { const unsigned* cnt = (const unsigned*)(X.ws + WS_CTL) + CW_CNT + (l * NCH + chunk) * 64; int o = 0;
        for (int e = 0; e < NE1; ++e) { const int cn = (e < NEXP) ? (int)__hip_atomic_load(cnt + e, __ATOMIC_RELAXED, __HIP_MEMORY_SCOPE_AGENT) : CHTOK; off[e] = o; cntl[e] = cn; o += ((cn + 255) >> 8) << 8; }
        off[NE1] = o; }
    __syncthreads();
}
#define ST_WT(p, v) __hip_atomic_store((p), (v), __ATOMIC_RELAXED, __HIP_MEMORY_SCOPE_AGENT)
__device__ __forceinline__ void ph_fill(const Ctx& X, int l) {
    LAS int* off = (LAS int*)(X.lds); LAS int* cntl = off + 64;
    const int tok0 = X.c * 128, chunk = tok0 / CHTOK;
    moe_offsets(X, l, chunk, off, cntl);
    unsigned* rowtok = (unsigned*)(X.ws + WS_ROWTOK) + (size_t)chunk * CH_ROWS; float* rowgate = (float*)(X.ws + WS_ROWGATE) + (size_t)chunk * CH_ROWS;
    const unsigned* pinfo = (const unsigned*)(X.ws + WS_PINFO); const float* pgate = (const float*)(X.ws + WS_PGATE); unsigned* slot = (unsigned*)(X.ws + WS_SLOT);
    const unsigned* wgb = (const unsigned*)(X.ws + WS_WGBASE) + X.c * 32;
    for (int i = X.tid; i < 1024; i += 512) { const size_t pi = (size_t)tok0 * 8 + i; const unsigned inf = pinfo[pi]; const int e = inf & 255, lr = inf >> 8;
        const int pos = off[e] + (int)wgb[e] + lr; ST_WT(rowtok + pos, (unsigned)(tok0 + (i >> 3))); ST_WT((unsigned*)rowgate + pos, __builtin_bit_cast(unsigned, pgate[pi])); slot[pi] = (unsigned)pos; }
    if (X.tid < 128) { const int tok = tok0 + X.tid; const int pos = off[NEXP] + (tok - chunk * CHTOK); ST_WT(rowtok + pos, (unsigned)tok); ST_WT((unsigned*)rowgate + pos, __builtin_bit_cast(unsigned, 1.0f)); }
    const int wl = X.c & 63;
    if (wl < NEXP) { const int e = wl; const int p0 = off[e] + cntl[e], p1 = off[e + 1]; for (int p = p0 + X.tid; p < p1; p += 512) { ST_WT(rowtok + p, (unsigned)(chunk * CHTOK)); ST_WT((unsigned*)rowgate + p, 0u); } }
    __syncthreads();
}

template <int NT, bool GATH>
struct MoeOrder {
    static constexpr bool GATHER = GATH;
    int nwg, G, c; const LAS unsigned char* tile_e; const LAS int* rowtab;
    __device__ __forceinline__ bool next(int i, pg8::Unit& u) const {
        const long L = (long)i * G + c; if (L >= nwg) return false;
        const int wgid = pg8::xcd_remap((int)L, nwg); const int tau = wgid / NT, pn = wgid % NT;
        u.pm = tau; u.pn = pn; u.bt = (int)tile_e[tau] * NT + pn; u.ab = i; return true;
    }
    __device__ __forceinline__ int row_of(const pg8::Unit& u, int r) const { return rowtab[u.ab * 256 + r]; }
    __device__ __forceinline__ void a_ready(const pg8::Unit&) const {}
    __device__ __forceinline__ void done(const pg8::Unit&) const {}
};
__device__ __forceinline__ int moe_tiles(const Ctx& X, int l, int chunk, LAS unsigned char* tile_e, LAS int* off, LAS int* cntl) {
    moe_offsets(X, l, chunk, off, cntl);
    const int ntile = off[NE1] >> 8;
    for (int t = X.tid; t < ntile; t += 512) { int e = 0; for (int q = 1; q < NE1; ++q) e += (off[q] <= t * 256) ? 1 : 0; tile_e[t] = (unsigned char)e; }
    __syncthreads();
    return ntile;
}

__device__ __forceinline__ void ph_combine(const Ctx& X, int l, int chunk, LAS int* off) {
    const int lane = X.lane; const int gw = X.c * 8 + X.wave;
    float* xo = X.a->out; bf16_t* hb = X.hbuf();
    const bf16_t* op = (const bf16_t*)(X.ws + WS_OPAIR); const unsigned* slot = (const unsigned*)(X.ws + WS_SLOT);
    const int b = (chunk * CHTOK) >> 13; const float* mv2 = X.modv(l, 1) + b * 3072;
    const float* lg = X.in(I_LN2G) + l * D; const float* lb = X.in(I_LN2B) + l * D;
    const int offsh = off[NEXP];
    for (int i = 0; i < 4; ++i) {
        const int tok = chunk * CHTOK + gw * 4 + i;
        f32x4 sm[4];
#pragma unroll
        for (int j = 0; j < 4; ++j) sm[j] = (f32x4){0.f, 0.f, 0.f, 0.f};
#pragma unroll
        for (int k = 0; k < 9; ++k) { const int pos = (k < 8) ? (int)slot[(size_t)tok * 8 + k] : offsh + (tok - chunk * CHTOK);
            const bf16_t* rp = op + (size_t)pos * 1024 + 4 * lane;
#pragma unroll
            for (int j = 0; j < 4; ++j) { const u32x2 q = *(const u32x2*)(rp + 256 * j); sm[j][0] += bflo(q.x); sm[j][1] += bfhi(q.x); sm[j][2] += bflo(q.y); sm[j][3] += bfhi(q.y); } }
        f32x4 v[4]; float s = 0.f;
#pragma unroll
        for (int j = 0; j < 4; ++j) { const int col = 4 * lane + 256 * j; v[j] = *(const f32x4*)(xo + (size_t)tok * D + col) + (*(const f32x4*)(mv2 + 2048 + col) + 1.0f) * sm[j]; s += (v[j][0] + v[j][1]) + (v[j][2] + v[j][3]); }
        const float mean = wave_sum(s) * (1.0f / D); float q = 0.f;
#pragma unroll
        for (int j = 0; j < 4; ++j) { v[j] = v[j] - mean; q += (v[j][0] * v[j][0] + v[j][1] * v[j][1]) + (v[j][2] * v[j][2] + v[j][3] * v[j][3]); }
        const float rstd = rsqrtf(wave_sum(q) * (1.0f / D) + LN_EPS);
#pragma unroll
        for (int j = 0; j < 4; ++j) { const int col = 4 * lane + 256 * j;
            const f32x4 x2 = v[j] * rstd * *(const f32x4*)(lg + col) + *(const f32x4*)(lb + col);
            *(f32x4*)(xo + (size_t)tok * D + col) = x2;
            if (l + 1 < DEPTH) { const float* mv1 = X.modv(l + 1, 0) + b * 3072; const f32x4 hn = x2 * (*(const f32x4*)(mv1 + 1024 + col) + 1.0f) + *(const f32x4*)(mv1 + col);
                u32x2 o; o.x = pk2(hn[0], hn[1]); o.y = pk2(hn[2], hn[3]); *(u32x2*)(hb + (size_t)tok * D + col) = o; } }
    }
}

struct POrder : pg8::StaticOrder { __device__ __forceinline__ bool next(int i, pg8::Unit& u) const { if (!pg8::StaticOrder::next(i, u)) return false; u.ab = u.pn >> 2; return true; } };
struct GOrder { static constexpr bool GATHER = false; int G, c;
    __device__ __forceinline__ bool next(int i, pg8::Unit& u) const { const int tile = (i >> 2) * G + c; if (tile >= 512) return false; const int wg = pg8::xcd_remap(tile, 512); const int br = i & 3, mt = wg & 3;
        u.pm = wg >> 2; u.pn = br * 4 + mt; u.bt = br * 4 + mt; u.ab = 0; return true; }
    __device__ __forceinline__ void a_ready(const pg8::Unit&) const {} __device__ __forceinline__ void done(const pg8::Unit&) const {} };
__global__ void __launch_bounds__(512, 2) fwd_kernel(Args args) {
    extern __shared__ __attribute__((aligned(16))) unsigned char lds_raw[];
    ArgsP ap = (ArgsP)__builtin_amdgcn_kernarg_segment_ptr();
    Ctx X; X.a = ap; X.ws = ap->ws; X.lds = (LAS unsigned char*)lds_raw;
    X.tid = threadIdx.x; X.lane = X.tid & 63; X.wave = __builtin_amdgcn_readfirstlane(X.tid >> 6); X.G = gridDim.x;
    { const int bx = blockIdx.x; X.bx = bx; X.c = (X.G % 8 == 0) ? (bx % 8) * (X.G / 8) + bx / 8 : bx; }
    const int c0_ = X.c, g0_ = X.G, bx0_ = X.bx;
    volatile LAS unsigned* misc = (volatile LAS unsigned*)(X.lds + LDS_MISC);
    if (X.tid < 16) misc[X.tid] = 0u;
    __syncthreads();
    XcdBarrier bar; bar.bar = (unsigned*)(X.ws + WS_CTL) + CW_BAR; bar.x = 0; bar.st = misc;
#if !MK_PER_PHASE
    bar = xcd_barrier_post((unsigned*)(X.ws + WS_CTL) + CW_BAR, misc);
#endif
    const int lo = ap->ph_lo, hi = ap->ph_hi; int ph = 0;
#define RELAUNDER() do { int t_ = threadIdx.x; asm volatile("" : "+v"(t_)); X.tid = t_; X.lane = t_ & 63; X.wave = __builtin_amdgcn_readfirstlane(t_ >> 6); } while (0)
#define REPEAT(N, stmt) _Pragma("nounroll") for (int rp_ = 0; rp_ < (N); ++rp_) { stmt; if (rp_ + 1 < (N)) xcd_barrier(bar); }
#define PH_BEGIN if (ph >= lo && ph < hi) { { ArgsP apl = ap; asm volatile("" : "+s"(apl)); X.a = apl; X.ws = apl->ws; int t_ = threadIdx.x; asm volatile("" : "+v"(t_)); X.tid = t_; X.lane = t_ & 63; X.wave = __builtin_amdgcn_readfirstlane(t_ >> 6); int c_ = c0_, g_ = g0_, b_ = bx0_; asm volatile("" : "+s"(c_), "+s"(g_), "+s"(b_)); X.c = c_; X.G = g_; X.bx = b_; } unsigned char* wb = X.ws + WS_W; LAS unsigned char* gl = X.lds; const float* xin = (l_ == 0) ? X.in(I_X) : (const float*)X.a->out; (void)wb; (void)gl; (void)xin;
#if MK_PER_PHASE
#define PH_END } ++ph;
#else
#define PH_END if (ph + 1 < hi) xcd_barrier(bar); } ++ph;
#endif
    int l_ = 0;
    PH_BEGIN if (EN_PROLOGUE) { REPEAT(R_MISC, ph_prologue(X)) } PH_END
    for (int l = 0; l < DEPTH; ++l) {
        l_ = l;
        PH_BEGIN if (EN_WCONV) { REPEAT(R_MISC, ph_wconv(X, l)) } PH_END
        PH_BEGIN if (EN_GWIN)  { pg8::Gemm g{X.hbuf(), (const bf16_t*)(wb + WO_IN), 1024, 0}; pg8::StaticOrder S; S.init(M, PJ, X.G, X.bx); pg8::EpiBf16 E{X.proj(), PJ};
            REPEAT(R_GWIN, (pg8::gemm_phase<pg8::EpiBf16, pg8::StaticOrder, G_ALIGN, G_SP2>(gl, g, S, E, X.tid))) } PH_END
        PH_BEGIN if (EN_MX1)  {
            mx_rope(X);
            _Pragma("nounroll") for (int rp_ = 0; rp_ < R_MIX; ++rp_) {
            for (int u = X.c; u < 256; u += X.G) mx_gmlp(X, l, u);
            for (int wu = X.c * 8 + X.wave; wu < 2048; wu += X.G * 8) mx_s5<1>(X, l, wu);
            __syncthreads();
            for (int u = X.c; u < 256; u += X.G) mx_ssd<1>(X, l, u); }
        } PH_END
        PH_BEGIN if (EN_MX2)  {
            mx_ssd_carry(X); RELAUNDER();
            for (int r = 0; r < 16; ++r) { const int cl = X.c & 63; const int uu = (r & 1) ? r * 64 + 63 - cl : r * 64 + cl; if (EN_DSA && X.c < 256) mx_dsa(X, X.c >> 6, uu * 8); }
            __syncthreads(); RELAUNDER();
            for (int wu = X.c * 8 + X.wave; EN_S53 && wu < 2048; wu += X.G * 8) mx_s5<3>(X, l, wu);
        } PH_END
        PH_BEGIN if (EN_GLU)  { for (int u = X.c; EN_SSD3 && u < 256; u += X.G) mx_ssd<3>(X, l, u);
            __syncthreads(); RELAUNDER();
            pg8::Gemm g{(const bf16_t*)(X.ws + WS_YCPRE), (const bf16_t*)(wb + WO_GLU), 256, 0}; pg8::StaticOrder S; S.init(M, 256, X.G, X.bx);
            pg8::EpiGlu E{(const bf16_t*)(X.ws + WS_YCPRE), X.ybuf() + (size_t)2 * M * 256, X.in(I_S5GLUB) + l * 256};
            REPEAT(R_GLU, (pg8::gemm_phase<pg8::EpiGlu, pg8::StaticOrder, G_ALIGN, G_SP2>(gl, g, S, E, X.tid))) } PH_END
        PH_BEGIN if (EN_GP)  { pg8::Gemm g{X.ybuf(), (const bf16_t*)(wb + WO_BR), 256, (size_t)M * 256};
            POrder S;
            S.init(M, 4096, X.G, X.bx); pg8::EpiBf16 E{(bf16_t*)(X.ws + WS_P), 4096};
            REPEAT(R_GP, (pg8::gemm_phase<pg8::EpiBf16, POrder, G_ALIGN, G_SP2>(gl, g, S, E, X.tid))) } PH_END
        PH_BEGIN if (EN_GGATE)  { pg8::Gemm g{X.hbuf(), (const bf16_t*)(wb + WO_GATE), 1024, 0};
            GOrder S{X.G, X.bx};
            pg8::EpiGateMerge E{(const bf16_t*)(X.ws + WS_P), X.ybuf()};
            REPEAT(R_GGATE, (pg8::gemm_phase<pg8::EpiGateMerge, GOrder, G_ALIGN, G_SP2>(gl, g, S, E, X.tid))) } PH_END
        PH_BEGIN if (EN_GOUT)  { pg8::Gemm g{X.ybuf(), (const bf16_t*)(wb + WO_OUT), 1024, 0}; pg8::StaticOrder S; S.init(M, 1024, X.G, X.bx);
            pg8::EpiResid E{xin, X.a->out, X.modv(l, 0)};
            pg8::gemm_phase<pg8::EpiResid, pg8::StaticOrder, G_ALIGN, G_SP2>(gl, g, S, E, X.tid); } PH_END
        PH_BEGIN if (EN_LN1)  ph_ln1_router(X, l); PH_END
        PH_BEGIN if (EN_FILL) { REPEAT(R_MISC, ph_fill(X, l)) } PH_END
        for (int ch = 0; ch < NCH; ++ch) {
            PH_BEGIN if (EN_MOE1)  {
                LAS int* off = (LAS int*)(X.lds + LDS_TAB + 1024); LAS int* cntl = off + 64; LAS unsigned char* tile_e = (LAS unsigned char*)(X.lds + LDS_TAB + 2048);
                if (ch > 0) { moe_offsets(X, l, ch - 1, off, cntl); ph_combine(X, l, ch - 1, off); __syncthreads(); }
                const int ntile = moe_tiles(X, l, ch, tile_e, off, cntl);
                pg8::Gemm g{X.hbuf(), (const bf16_t*)(wb + WO_13), 1024, 0};
                LAS int* rowtab = (LAS int*)(X.lds + LDS_TAB + 4096);
                MoeOrder<2, true> S{ntile * 2, X.G, X.bx, tile_e, rowtab};
                { const unsigned* rowtok = (const unsigned*)(X.ws + WS_ROWTOK) + (size_t)ch * CH_ROWS; pg8::Unit uu;
                  for (int i = 0; i < 4; ++i) { if (!S.next(i, uu)) break; if (X.tid < 256) rowtab[i * 256 + X.tid] = (int)rowtok[uu.pm * 256 + X.tid]; } }
                __syncthreads();
                pg8::EpiMoe1 E{(bf16_t*)(X.ws + WS_ACT), (const float*)(X.ws + WS_ROWGATE) + (size_t)ch * CH_ROWS};
                REPEAT(R_MOE, (pg8::gemm_phase<pg8::EpiMoe1, MoeOrder<2, true>, G_ALIGN, G_SP2>(gl, g, S, E, X.tid)))
            } PH_END
            PH_BEGIN if (EN_MOE2)  {
                LAS int* off = (LAS int*)(X.lds + LDS_TAB + 1024); LAS int* cntl = off + 64; LAS unsigned char* tile_e = (LAS unsigned char*)(X.lds + LDS_TAB + 2048);
                const int ntile = moe_tiles(X, l, ch, tile_e, off, cntl);
                pg8::Gemm g{(const bf16_t*)(X.ws + WS_ACT), (const bf16_t*)(wb + WO_2), 256, 0};
                MoeOrder<4, false> S{ntile * 4, X.G, X.bx, tile_e, nullptr};
                pg8::EpiBf16 E{(bf16_t*)(X.ws + WS_OPAIR), 1024};
                REPEAT(R_MOE, (pg8::gemm_phase<pg8::EpiBf16, MoeOrder<4, false>, G_ALIGN, G_SP2>(gl, g, S, E, X.tid)))
            } PH_END
        }
        PH_BEGIN if (EN_FIN)  { LAS int* off = (LAS int*)(X.lds + LDS_TAB + 1024); LAS int* cntl = off + 64; moe_offsets(X, l, NCH - 1, off, cntl); ph_combine(X, l, NCH - 1, off); } PH_END
    }
#undef PH_BEGIN
#undef PH_END
}
constexpr int N_PHASES = 1 + DEPTH * (10 + 2 * NCH + 1);

#ifdef DBG_DUMP_OFF
__global__ void dbg_dump(const bf16_t* src, float* out, size_t n) { for (size_t i = (size_t)blockIdx.x * blockDim.x + threadIdx.x; i < n; i += (size_t)gridDim.x * blockDim.x) {
#ifdef DBG_HASH_OUT
    const unsigned bits = __builtin_bit_cast(unsigned, out[i]); out[i] = (float)((bits * 2654435761u) >> 8) * (1.0f / 16777216.0f);
#else
    const unsigned bits = src[i]; out[i] = (float)(((bits + 1u) * 2654435761u) >> 8) * (1.0f / 16777216.0f);
#endif
} }
#endif
extern "C" void kernel_launch(void* const* d_in, const int* in_sizes, int n_in, void* d_out, int out_size, void* d_ws, size_t ws_size, hipStream_t stream) {
    static int grid = 0;
    if (grid == 0) {
        if (n_in != 43 || out_size != M * D || ws_size < WS_NEED) { fprintf(stderr, "kernel_launch: unexpected shapes (n_in %d out %d ws %zu)\n", n_in, out_size, ws_size); grid = -1; return; }
        int dev = 0, cus = 0, per_cu = 0;
        if (hipGetDevice(&dev) != hipSuccess || hipDeviceGetAttribute(&cus, hipDeviceAttributeMultiprocessorCount, dev) != hipSuccess) { grid = -1; return; }
        if (hipFuncSetAttribute((const void*)fwd_kernel, hipFuncAttributeMaxDynamicSharedMemorySize, LDS_BYTES) != hipSuccess) { fprintf(stderr, "kernel_launch: hipFuncSetAttribute failed\n"); grid = -1; return; }
        if (hipOccupancyMaxActiveBlocksPerMultiprocessor(&per_cu, (const void*)fwd_kernel, 512, LDS_BYTES) != hipSuccess || per_cu < 1) fprintf(stderr, "kernel_launch: occupancy query says %d\n", per_cu);
        (void)hipGetLastError();
        grid = cus < 256 ? cus : 256;
    }
    if (grid < 0) return;
    (void)hipMemsetAsync((char*)d_ws + WS_CTL, 0, CTL_BYTES, stream);
#ifdef DBG_POISON
    (void)hipMemsetAsync((char*)d_ws + CTL_BYTES, 0xFF, WS_NEED - CTL_BYTES, stream);
    (void)hipMemsetAsync((char*)d_out, 0xFF, (size_t)M * D * 4, stream);
#endif
    Args a{};
    for (int i = 0; i < 43; ++i) a.in[i] = (const float*)d_in[i];
    a.positions = (const int*)d_in[I_POS]; a.out = (float*)d_out; a.ws = (unsigned char*)d_ws;
#if MK_PER_PHASE
#ifndef DBG_NPH
#define DBG_NPH N_PHASES
#endif
    for (int p = 0; p < DBG_NPH; ++p) { a.ph_lo = p; a.ph_hi = p + 1; hipLaunchKernelGGL(fwd_kernel, dim3(grid), dim3(512), LDS_BYTES, stream, a); }
#ifdef DBG_DUMP_OFF
    hipLaunchKernelGGL(dbg_dump, dim3(2048), dim3(256), 0, stream, (const bf16_t*)((const char*)d_ws + (size_t)(DBG_DUMP_OFF)), (float*)d_out, (size_t)M * D);
#endif
#else
    a.ph_lo = 0; a.ph_hi = N_PHASES; hipLaunchKernelGGL(fwd_kernel, dim3(grid), dim3(512), LDS_BYTES, stream, a);
#ifdef DBG_EXTRA_PH
    for (int rep = 0; rep < DBG_EXTRA_REP; ++rep) { a.ph_lo = DBG_EXTRA_PH; a.ph_hi = DBG_EXTRA_PH + 1; hipLaunchKernelGGL(fwd_kernel, dim3(grid), dim3(512), LDS_BYTES, stream, a); }
#endif
#endif
}
```

```cpp
#include <hip/hip_runtime.h>
#include <cstdio>
#include <cstdint>


#ifndef DSA_SKIP
#define DSA_SKIP 0
#endif
#ifndef DSA_PM
#define DSA_PM 0
#endif
#ifndef R_S1
#define R_S1 1
#endif
#ifndef R_S2
#define R_S2 1
#endif
#ifndef R_S3
#define R_S3 1
#endif
#ifndef EN_DSA
#define EN_DSA 1
#endif
#ifndef EN_S53
#define EN_S53 1
#endif
#ifndef EN_SSD3
#define EN_SSD3 1
#endif
#ifndef R_GWIN
#define R_GWIN 1
#endif
#ifndef R_GLU
#define R_GLU 1
#endif
#ifndef R_GP
#define R_GP 1
#endif
#ifndef R_GGATE
#define R_GGATE 1
#endif
#ifndef R_DENSE
#define R_DENSE 1
#endif
#ifndef R_MOE
#define R_MOE 1
#endif
#ifndef R_DSA
#define R_DSA 1
#endif
#ifndef R_MIX
#define R_MIX 1
#endif
#ifndef R_MISC
#define R_MISC 1
#endif
#ifndef MK_PER_PHASE
#define MK_PER_PHASE 0
#endif

#ifndef EN_PROLOGUE
#define EN_PROLOGUE 1
#endif
#ifndef EN_WCONV
#define EN_WCONV 1
#endif
#ifndef EN_GWIN
#define EN_GWIN 1
#endif
#ifndef EN_MX1
#define EN_MX1 1
#endif
#ifndef EN_MX2
#define EN_MX2 1
#endif
#ifndef EN_GLU
#define EN_GLU 1
#endif
#ifndef EN_GP
#define EN_GP 1
#endif
#ifndef EN_GGATE
#define EN_GGATE 1
#endif
#ifndef EN_GOUT
#define EN_GOUT 1
#endif
#ifndef EN_LN1
#define EN_LN1 1
#endif
#ifndef EN_FILL
#define EN_FILL 1
#endif
#ifndef EN_MOE1
#define EN_MOE1 1
#endif
#ifndef EN_MOE2
#define EN_MOE2 1
#endif
#ifndef EN_FIN
#define EN_FIN 1
#endif
#ifndef G_ALIGN
#define G_ALIGN true
#endif
#ifndef G_SP2
#define G_SP2 true
#endif
#define LAS __attribute__((address_space(3)))
#define GAS __attribute__((address_space(1)))
typedef unsigned short bf16_t;
typedef short bf16x8 __attribute__((ext_vector_type(8)));
typedef float f32x4 __attribute__((ext_vector_type(4)));
typedef float f32x2 __attribute__((ext_vector_type(2)));
typedef unsigned u32x4 __attribute__((ext_vector_type(4)));
typedef unsigned u32x2 __attribute__((ext_vector_type(2)));

constexpr int NB = 4, SEQ = 8192, M = NB * SEQ, D = 1024, DEPTH = 2;
constexpr int PJ = 2304;
constexpr int C_GU = 0, C_GV = 256, C_Q = 512, C_K = 768, C_V = 832, C_QI = 896, C_KI = 1152, C_S5 = 1216, C_Z = 1472, C_XBC = 1728, C_WI = 2240, C_DT = 2244;
constexpr int D_IN = 2248;
constexpr int NEXP = 32, NE1 = 33;
constexpr int NCH = 4, CHTOK = M / NCH;
constexpr int CH_ROWS = CHTOK * 8 + CHTOK + NE1 * 256;
constexpr float DN_ALPHA = 1.41421356237f;
constexpr float LN_EPS = 1e-5f, RMS_EPS = 1e-6f;

constexpr size_t MiB = 1u << 20;
constexpr size_t WS_CTL = 0, CTL_BYTES = 1 * MiB;
constexpr size_t WS_MODV = 1 * MiB;
constexpr size_t WS_S5B = WS_MODV + 256 * 1024;
constexpr size_t WS_S5C = WS_S5B + 64 * 1024;
constexpr size_t WS_S5A = WS_S5C + 64 * 1024;
constexpr size_t WS_GMW = WS_S5A + 64 * 1024;
constexpr size_t WS_RFR = WS_GMW + 128 * 1024;
static_assert(WS_RFR + 128 * 1024 <= 2 * MiB, "misc tables");
constexpr size_t WS_S5ST = 2 * MiB;
constexpr size_t WS_ATOT = 3 * MiB;
constexpr size_t WS_WGBASE = 3 * MiB + 64 * 1024;
constexpr size_t WS_PINFO = 4 * MiB;
constexpr size_t WS_PGATE = 5 * MiB;
constexpr size_t WS_SLOT = 6 * MiB;
constexpr size_t WS_ROWTOK = 7 * MiB;
constexpr size_t WS_ROWGATE = 9 * MiB;
constexpr size_t WS_W = 24 * MiB;
constexpr size_t WO_IN = 0, WO_GATE = WO_IN + (size_t)PJ * 1024 * 2, WO_BR = WO_GATE + (size_t)4096 * 1024 * 2, WO_OUT = WO_BR + (size_t)4 * 1024 * 256 * 2,
                 WO_GLU = WO_OUT + (size_t)1024 * 1024 * 2, WO_13 = WO_GLU + (size_t)256 * 256 * 2, WO_2 = WO_13 + (size_t)NE1 * 512 * 1024 * 2, WO_END = WO_2 + (size_t)NE1 * 1024 * 256 * 2;
static_assert(WO_END <= 72 * MiB, "weights region");
constexpr size_t WS_H = 96 * MiB;
constexpr size_t WS_Y = 160 * MiB;
constexpr size_t WS_PROJ = 224 * MiB;
constexpr size_t WS_P = 224 * MiB;
constexpr size_t WS_SSDST = 368 * MiB;
constexpr size_t WS_SSDSIN = 400 * MiB;
constexpr size_t WS_KI2 = 408 * MiB, WS_K2 = 412 * MiB, WS_V2 = 416 * MiB;
constexpr size_t WS_YCPRE = 384 * MiB;
constexpr size_t WS_ACT = 160 * MiB;
constexpr size_t WS_OPAIR = 321 * MiB;
static_assert(CH_ROWS % 256 == 0 && WS_ACT + (size_t)NCH * CH_ROWS * 512 <= WS_OPAIR && WS_OPAIR + (size_t)CH_ROWS * 2048 <= 512 * MiB, "moe buffers");
constexpr int CH_TILES = CH_ROWS / 256;
constexpr size_t WS_NEED = 512 * MiB;
constexpr int CW_BAR = 4096;
constexpr int CW_CNT = 16384;

constexpr int LDS_BYTES = 160 * 1024;
constexpr int LDS_TAB = 131072;
constexpr int LDS_MISC = LDS_BYTES - 256;

__device__ __forceinline__ unsigned f2bf(float f) { unsigned u = __builtin_bit_cast(unsigned, f); return (u + 0x7fffu + ((u >> 16) & 1u)) >> 16; }
__device__ __forceinline__ unsigned pk2(float lo, float hi) { return f2bf(lo) | (f2bf(hi) << 16); }
__device__ __forceinline__ float bf2f(unsigned short b) { return __builtin_bit_cast(float, (unsigned)b << 16); }
__device__ __forceinline__ float bflo(unsigned w) { return __builtin_bit_cast(float, w << 16); }
__device__ __forceinline__ float bfhi(unsigned w) { return __builtin_bit_cast(float, w & 0xffff0000u); }
__device__ __forceinline__ float wave_sum(float v) {
#pragma unroll
    for (int o = 1; o < 64; o <<= 1) v += __shfl_xor(v, o);
    return v;
}
__device__ __forceinline__ float wave_max(float v) {
#pragma unroll
    for (int o = 1; o < 64; o <<= 1) v = fmaxf(v, __shfl_xor(v, o));
    return v;
}
__device__ __forceinline__ int wave_sum_i(int v) {
#pragma unroll
    for (int o = 1; o < 64; o <<= 1) v += __shfl_xor(v, o);
    return v;
}
__device__ __forceinline__ float sigmoidf_(float x) { return __builtin_amdgcn_rcpf(1.0f + __expf(-x)); }
__device__ __forceinline__ float siluf_(float x) { return x * __builtin_amdgcn_rcpf(1.0f + __expf(-x)); }
__device__ __forceinline__ float gelu_tanh(float x) { const float u = 1.5957691216057308f * (x + 0.044715f * x * x * x); return x * __builtin_amdgcn_rcpf(1.0f + __expf(-u)); }
__device__ __forceinline__ float softplusf_(float x) { return fmaxf(x, 0.f) + log1pf(__expf(-fabsf(x))); }
__device__ __forceinline__ void sincos_red(float ang, float& sn, float& cs) {
    const double a = (double)ang; const double q = __builtin_rint(a * 0.63661977236758134308);
    const float r = (float)(a - q * 1.57079632679489661923); const int qi = (int)q & 3;
    const float r2 = r * r;
    const float s = r * (1.0f + r2 * (-1.6666667e-1f + r2 * (8.3333333e-3f + r2 * (-1.9841270e-4f + r2 * 2.7557319e-6f))));
    const float c = 1.0f + r2 * (-0.5f + r2 * (4.1666667e-2f + r2 * (-1.3888889e-3f + r2 * (2.4801587e-5f + r2 * -2.7557319e-7f))));
    sn = (qi == 0) ? s : (qi == 1) ? c : (qi == 2) ? -s : -c;
    cs = (qi == 0) ? c : (qi == 1) ? -s : (qi == 2) ? -c : s;
}
__device__ __forceinline__ f32x4 mfma16(bf16x8 a, bf16x8 b, f32x4 c) { return __builtin_amdgcn_mfma_f32_16x16x32_bf16(a, b, c, 0, 0, 0); }
__device__ __forceinline__ unsigned cvt_pk_bf16(float lo, float hi) { unsigned r; asm volatile("v_cvt_pk_bf16_f32 %0, %1, %2" : "=v"(r) : "v"(lo), "v"(hi)); return r; }

namespace pg8 {
constexpr int BM = 256, BK = 64, HALF = 128, HTB = HALF * BK * 2, STAGE_BYTES = 8 * HTB, NXCD = 8, WGM = 8;
__host__ __device__ __forceinline__ int lds_byte(int r, int c) { const int st = (r >> 4) * 2 + (c >> 5), rr = r & 15, cc = c & 31, ob = rr * 64 + cc * 2; return st * 1024 + (ob ^ (((ob >> 9) & 1) << 5)); }
__host__ __device__ __forceinline__ void stage_rc(int b, int& R, int& C) { const int st = b / 1024, sb = b % 1024, swz = sb ^ (((sb >> 9) & 1) << 5); R = (st >> 1) * 16 + swz / 64; C = (st & 1) * 32 + (swz % 64) / 2; }
__host__ __device__ __forceinline__ int perm32(int rho) { const int n = rho >> 4, i = rho & 15; return 8 * (i >> 2) + 4 * n + (i & 3); }

struct Unit { int pm, pn, bt, ab; };
struct Gemm { const bf16_t* A; const bf16_t* Bt; int K; size_t a_sel_stride; };

__device__ __forceinline__ int xcd_remap(int wgid, int nwg) { const int q = nwg / NXCD, r = nwg % NXCD, xcd = wgid % NXCD, off = wgid / NXCD; return (xcd < r ? xcd * (q + 1) : r * (q + 1) + (xcd - r) * q) + off; }

struct StaticOrder {
    static constexpr bool GATHER = false;
    int nM, nN, nwg, G, c;
    __device__ void init(int Mr, int N, int G_, int c_) { nM = Mr / BM; nN = N / BM; nwg = nM * nN; G = G_; c = c_; }
    __device__ __forceinline__ bool next(int i, Unit& u) const {
        const long L = (long)i * G + c; if (L >= nwg) return false;
        const int wgid = xcd_remap((int)L, nwg);
        const int nig = WGM * nN, gid = wgid / nig, fm = gid * WGM, gsz = (nM - fm) < WGM ? (nM - fm) : WGM;
        u.pm = fm + ((wgid % nig) % gsz); u.pn = (wgid % nig) / gsz; u.bt = u.pn; u.ab = 0; return true;
    }
    __device__ __forceinline__ void a_ready(const Unit&) const {}
    __device__ __forceinline__ void done(const Unit&) const {}
};

template <class Epi, class Sched, bool ALIGN_EPI = false, bool SP2 = true>
__device__ __forceinline__ void gemm_phase(LAS unsigned char* lds, const Gemm g, const Sched& S, const Epi& E, const int tid) {
    const int wid = __builtin_amdgcn_readfirstlane(tid >> 6), lane = tid & 63, wr = wid >> 2, wc = wid & 3, fr = lane & 15, fq = lane >> 4;
    const int K = g.K, nt = K / BK;
    unsigned voffA[2], voffB[2];
#pragma unroll
    for (int i = 0; i < 2; ++i) { int R, C; stage_rc(tid * 16 + i * 8192, R, C); const int Rb = Epi::PERM ? ((R & ~31) + perm32(R & 31)) : R;
        voffA[i] = (unsigned)(R * K + C) * 2u; voffB[i] = (unsigned)(Rb * K + C) * 2u; }
    const size_t kstep = (size_t)(BK * 2);
    const size_t hstep = (size_t)HALF * K * 2;
    const size_t tstep = 2 * hstep;
    const unsigned ldsw = (unsigned)wid * 1024u;
    const int aoff = lds_byte(wr * 64 + fr, fq * 8), boff = lds_byte(wc * 32 + fr, fq * 8);
#define PG8_SA(b, h) (((b) * 2 + (h)) * HTB)
#define PG8_SB(b, h) ((4 + (b) * 2 + (h)) * HTB)
#define PG8_STAGE(bufoff, gbase, voff) do { _Pragma("unroll") for (int _i = 0; _i < 2; ++_i) \
        __builtin_amdgcn_global_load_lds((const unsigned*)((const char*)(gbase) + (voff)[_i]), (LAS unsigned*)(lds + (bufoff) + ldsw + _i * 8192), 16, 0, 0); } while (0)
#define PG8_GO(u) do { _Pragma("unroll") for (int _h = 0; _h < 2; ++_h) _Pragma("unroll") for (int _i = 0; _i < 2; ++_i) { int _R, _C; stage_rc(tid * 16 + _i * 8192, _R, _C); \
        cgo[_h][_i] = (unsigned)S.row_of(u, _h * HALF + _R) * (unsigned)(K * 2) + (unsigned)_C * 2u; } } while (0)
#define PG8_STAGE_A(bufoff, base, h, kb, NX) do { if constexpr (Sched::GATHER) { _Pragma("unroll") for (int _i = 0; _i < 2; ++_i) \
        __builtin_amdgcn_global_load_lds((const unsigned*)((const char*)g.A + (kb) + cgo[h][_i]), (LAS unsigned*)(lds + (bufoff) + ldsw + _i * 8192), 16, 0, 0); } \
        else { PG8_STAGE(bufoff, (base) + (size_t)(h) * hstep + (kb), voffA); } } while (0)
#define PG8_LDA(dst, b, h) do { _Pragma("unroll") for (int m = 0; m < 4; ++m) _Pragma("unroll") for (int k = 0; k < 2; ++k) dst[m][k] = *(const LAS bf16x8*)(lds + PG8_SA(b, h) + aoff + m * 2048 + k * 1024); } while (0)
#define PG8_LDB(dst, b, h) do { _Pragma("unroll") for (int n = 0; n < 2; ++n) _Pragma("unroll") for (int k = 0; k < 2; ++k) dst[n][k] = *(const LAS bf16x8*)(lds + PG8_SB(b, h) + boff + n * 2048 + k * 1024); } while (0)
#define PG8_MMA(ai, bj, At, Bt) do { __builtin_amdgcn_s_setprio(1); _Pragma("unroll") for (int m = 0; m < 4; ++m) _Pragma("unroll") for (int n = 0; n < 2; ++n) _Pragma("unroll") for (int k = 0; k < 2; ++k) \
        acc[ai][bj][m][n] = __builtin_amdgcn_mfma_f32_16x16x32_bf16(Bt[n][k], At[m][k], acc[ai][bj][m][n], 0, 0, 0); __builtin_amdgcn_s_setprio(0); } while (0)
#define PG8_WAIT_V(n) asm volatile("s_waitcnt vmcnt(" #n ")" ::: "memory")
#define PG8_WAIT_L(n) asm volatile("s_waitcnt lgkmcnt(" #n ")" ::: "memory")
#define PG8_BAR __builtin_amdgcn_s_barrier()
#define PG8_SCHED __builtin_amdgcn_sched_barrier(0)
    Unit cur, nxt; int ui = 0;
    if (!S.next(0, cur)) return;
    f32x4 acc[2][2][4][2];
#pragma unroll
    for (int a = 0; a < 2; ++a)
#pragma unroll
        for (int b = 0; b < 2; ++b)
#pragma unroll
            for (int m = 0; m < 4; ++m)
#pragma unroll
                for (int n = 0; n < 2; ++n) acc[a][b][m][n] = (f32x4){0.f, 0.f, 0.f, 0.f};
    bf16x8 At[4][2], B0[2][2], B1[2][2];
    unsigned cgo[2][2];
    if constexpr (Sched::GATHER) PG8_GO(cur);
    const char* cA = (const char*)(g.A + (size_t)cur.ab * g.a_sel_stride) + (size_t)cur.pm * tstep; const char* cB = (const char*)g.Bt + (size_t)cur.bt * tstep;
    S.a_ready(cur);
    if constexpr (SP2) {
        PG8_STAGE(PG8_SB(0, 0), cB, voffB); PG8_STAGE(PG8_SB(0, 1), cB + hstep, voffB); PG8_STAGE_A(PG8_SA(0, 0), cA, 0, (size_t)0, false); PG8_STAGE_A(PG8_SA(0, 1), cA, 1, (size_t)0, false);
        if (wr == 1) PG8_BAR;
        PG8_WAIT_V(2); PG8_BAR;
        PG8_STAGE(PG8_SB(1, 0), cB + kstep, voffB); PG8_STAGE_A(PG8_SA(1, 0), cA, 0, kstep, false); PG8_STAGE(PG8_SB(1, 1), cB + hstep + kstep, voffB);
        PG8_WAIT_V(6); PG8_BAR;
    } else {
        PG8_STAGE(PG8_SB(0, 0), cB, voffB); PG8_STAGE_A(PG8_SA(0, 0), cA, 0, (size_t)0, false); PG8_STAGE(PG8_SB(0, 1), cB + hstep, voffB); PG8_STAGE_A(PG8_SA(0, 1), cA, 1, (size_t)0, false);
        if (wr == 1) PG8_BAR;
        PG8_WAIT_V(4); PG8_BAR;
        PG8_STAGE(PG8_SB(1, 0), cB + kstep, voffB); PG8_STAGE_A(PG8_SA(1, 0), cA, 0, kstep, false); PG8_STAGE(PG8_SB(1, 1), cB + hstep + kstep, voffB);
        PG8_WAIT_V(6); PG8_BAR;
    }
    for (;;) {
        const bool has_next = S.next(ui + 1, nxt);
        const char* nA = has_next ? (const char*)(g.A + (size_t)nxt.ab * g.a_sel_stride) + (size_t)nxt.pm * tstep : cA; const char* nB = has_next ? (const char*)g.Bt + (size_t)nxt.bt * tstep : cB;
#pragma nounroll
        for (int t = 0; t < nt; t += 2) {
            const bool last = (t == nt - 2);
            const size_t k1 = (size_t)(t + 1) * kstep;
            const char* a2b = last ? nA : cA; const size_t k2 = last ? (size_t)0 : (size_t)(t + 2) * kstep; const size_t k3 = k2 + kstep;
            const char* b2 = last ? nB : cB + (size_t)(t + 2) * kstep; const char* b3 = b2 + kstep;
            if (last && has_next) S.a_ready(nxt);
            if constexpr (SP2) {
            PG8_LDB(B0, 0, 0); PG8_LDB(B1, 0, 1); PG8_SCHED; PG8_LDA(At, 0, 0); PG8_STAGE_A(PG8_SA(1, 1), cA, 1, k1, false);
            if constexpr (Sched::GATHER) { if (last && has_next) PG8_GO(nxt); }
            PG8_WAIT_V(8); PG8_WAIT_L(0); PG8_BAR; PG8_MMA(0, 0, At, B0); PG8_MMA(0, 1, At, B1); PG8_BAR; PG8_SCHED;
            PG8_LDA(At, 0, 1); PG8_STAGE(PG8_SB(0, 0), b2, voffB); PG8_STAGE(PG8_SB(0, 1), b2 + hstep, voffB); PG8_STAGE_A(PG8_SA(0, 0), a2b, 0, k2, last);
            PG8_WAIT_V(8); PG8_WAIT_L(0); PG8_BAR; PG8_MMA(1, 0, At, B0); PG8_MMA(1, 1, At, B1); PG8_BAR; PG8_SCHED;
            PG8_LDB(B0, 1, 0); PG8_LDB(B1, 1, 1); PG8_SCHED; PG8_LDA(At, 1, 0); PG8_STAGE_A(PG8_SA(0, 1), a2b, 1, k2, last);
            PG8_WAIT_V(8); PG8_WAIT_L(0); PG8_BAR; PG8_MMA(0, 0, At, B0); PG8_MMA(0, 1, At, B1); PG8_BAR; PG8_SCHED;
            PG8_LDA(At, 1, 1); PG8_STAGE(PG8_SB(1, 0), b3, voffB); PG8_STAGE(PG8_SB(1, 1), b3 + hstep, voffB); PG8_STAGE_A(PG8_SA(1, 0), a2b, 0, k3, last);
            PG8_WAIT_V(8); PG8_WAIT_L(0); PG8_BAR; PG8_MMA(1, 0, At, B0); PG8_MMA(1, 1, At, B1); PG8_BAR; PG8_SCHED;
            } else {
            PG8_LDB(B0, 0, 0); PG8_SCHED; PG8_LDA(At, 0, 0); PG8_STAGE_A(PG8_SA(1, 1), cA, 1, k1, false);
            if constexpr (Sched::GATHER) { if (last && has_next) PG8_GO(nxt); }
            PG8_WAIT_L(8); PG8_BAR; PG8_WAIT_L(0); PG8_MMA(0, 0, At, B0); PG8_BAR; PG8_SCHED;
            PG8_LDB(B1, 0, 1); PG8_STAGE(PG8_SB(0, 0), b2, voffB);
            PG8_BAR; PG8_WAIT_L(0); PG8_MMA(0, 1, At, B1); PG8_BAR;
            PG8_LDA(At, 0, 1); PG8_STAGE_A(PG8_SA(0, 0), a2b, 0, k2, last);
            PG8_BAR; PG8_WAIT_L(0); PG8_MMA(1, 0, At, B0); PG8_BAR; PG8_SCHED;
            PG8_STAGE(PG8_SB(0, 1), b2 + hstep, voffB);
            PG8_WAIT_V(6); PG8_BAR; PG8_MMA(1, 1, At, B1); PG8_BAR;
            PG8_LDB(B0, 1, 0); PG8_SCHED; PG8_LDA(At, 1, 0); PG8_STAGE_A(PG8_SA(0, 1), a2b, 1, k2, last);
            PG8_WAIT_L(8); PG8_BAR; PG8_WAIT_L(0); PG8_MMA(0, 0, At, B0); PG8_BAR; PG8_SCHED;
            PG8_LDB(B1, 1, 1); PG8_STAGE(PG8_SB(1, 0), b3, voffB);
            PG8_BAR; PG8_WAIT_L(0); PG8_MMA(0, 1, At, B1); PG8_BAR;
            PG8_LDA(At, 1, 1); PG8_STAGE_A(PG8_SA(1, 0), a2b, 0, k3, last);
            PG8_BAR; PG8_WAIT_L(0); PG8_MMA(1, 0, At, B0); PG8_BAR; PG8_SCHED;
            PG8_STAGE(PG8_SB(1, 1), b3 + hstep, voffB);
            PG8_WAIT_V(6); PG8_BAR; PG8_MMA(1, 1, At, B1); PG8_BAR;
            }
        }
        if constexpr (ALIGN_EPI) { if (wr == 0) PG8_BAR; }
        E(acc, cur, wr, wc, fr, fq); S.done(cur);
        if (!has_next) break;
#pragma unroll
        for (int a = 0; a < 2; ++a)
#pragma unroll
            for (int b = 0; b < 2; ++b)
#pragma unroll
                for (int m = 0; m < 4; ++m)
#pragma unroll
                    for (int n = 0; n < 2; ++n) acc[a][b][m][n] = (f32x4){0.f, 0.f, 0.f, 0.f};
        cur = nxt; cA = nA; cB = nB; ++ui;
        if constexpr (ALIGN_EPI) { if (wr == 1) PG8_BAR; }
    }
    PG8_WAIT_V(0);
    if constexpr (!ALIGN_EPI) { if (wr == 0) PG8_BAR; }
    PG8_BAR;
#undef PG8_SA
#undef PG8_SB
#undef PG8_STAGE
#undef PG8_STAGE_A
#undef PG8_GO
#undef PG8_LDA
#undef PG8_LDB
#undef PG8_MMA
#undef PG8_WAIT_V
#undef PG8_WAIT_L
#undef PG8_BAR
#undef PG8_SCHED
}

struct EpiBf16 {
    static constexpr bool PERM = true;
    bf16_t* O; int ldc;
    __device__ __forceinline__ void operator()(const f32x4 (&acc)[2][2][4][2], const Unit& u, int wr, int wc, int fr, int fq) const {
        const int row0 = u.pm * BM + wr * 64 + fr, col0 = u.pn * BM + wc * 32 + 8 * fq;
#pragma unroll
        for (int ai = 0; ai < 2; ++ai)
#pragma unroll
            for (int m = 0; m < 4; ++m) { bf16_t* rowp = O + (size_t)(row0 + ai * HALF + m * 16) * ldc + col0;
#pragma unroll
                for (int bj = 0; bj < 2; ++bj) { const f32x4 v0 = acc[ai][bj][m][0], v1 = acc[ai][bj][m][1];
                    u32x4 w; w.x = cvt_pk_bf16(v0[0], v0[1]); w.y = cvt_pk_bf16(v0[2], v0[3]); w.z = cvt_pk_bf16(v1[0], v1[1]); w.w = cvt_pk_bf16(v1[2], v1[3]);
                    *(u32x4*)(rowp + bj * HALF) = w; } }
    }
};
struct EpiGlu {
    static constexpr bool PERM = true;
    const bf16_t* Ysrc; bf16_t* O; const float* bias;
    __device__ __forceinline__ void operator()(const f32x4 (&acc)[2][2][4][2], const Unit& u, int wr, int wc, int fr, int fq) const {
        const int row0 = u.pm * BM + wr * 64 + fr, col0 = u.pn * BM + wc * 32 + 8 * fq;
#pragma unroll
        for (int ai = 0; ai < 2; ++ai)
#pragma unroll
            for (int m = 0; m < 4; ++m) { const size_t ro = (size_t)(row0 + ai * HALF + m * 16) * 256 + col0;
#pragma unroll
                for (int bj = 0; bj < 2; ++bj) { const f32x4 v0 = acc[ai][bj][m][0], v1 = acc[ai][bj][m][1];
                    const u32x4 yv = *(const u32x4*)(Ysrc + ro + bj * HALF);
                    const f32x4 b0 = *(const f32x4*)(bias + col0 + bj * HALF), b1 = *(const f32x4*)(bias + col0 + bj * HALF + 4);
                    float o[8];
                    o[0] = bflo(yv.x) * sigmoidf_(v0[0] + b0[0]); o[1] = bfhi(yv.x) * sigmoidf_(v0[1] + b0[1]); o[2] = bflo(yv.y) * sigmoidf_(v0[2] + b0[2]); o[3] = bfhi(yv.y) * sigmoidf_(v0[3] + b0[3]);
                    o[4] = bflo(yv.z) * sigmoidf_(v1[0] + b1[0]); o[5] = bfhi(yv.z) * sigmoidf_(v1[1] + b1[1]); o[6] = bflo(yv.w) * sigmoidf_(v1[2] + b1[2]); o[7] = bfhi(yv.w) * sigmoidf_(v1[3] + b1[3]);
                    u32x4 w; w.x = cvt_pk_bf16(o[0], o[1]); w.y = cvt_pk_bf16(o[2], o[3]); w.z = cvt_pk_bf16(o[4], o[5]); w.w = cvt_pk_bf16(o[6], o[7]);
                    *(u32x4*)(O + ro + bj * HALF) = w; } }
    }
};
struct EpiGateMerge {
    static constexpr bool PERM = true;
    const bf16_t* P; bf16_t* Mg;
    __device__ __forceinline__ void operator()(const f32x4 (&acc)[2][2][4][2], const Unit& u, int wr, int wc, int fr, int fq) const {
        const int i = u.pn >> 2, mt = u.pn & 3;
        const int row0 = u.pm * BM + wr * 64 + fr, col0 = mt * BM + wc * 32 + 8 * fq;
#pragma unroll
        for (int ai = 0; ai < 2; ++ai) {
            u32x4 pv[4][2], mv[4][2];
#pragma unroll
            for (int m = 0; m < 4; ++m)
#pragma unroll
                for (int bj = 0; bj < 2; ++bj) { const size_t r = (size_t)(row0 + ai * HALF + m * 16);
                    pv[m][bj] = *(const u32x4*)(P + r * 4096 + i * 1024 + col0 + bj * HALF);
                    mv[m][bj] = (u32x4){0u, 0u, 0u, 0u}; if (i > 0) mv[m][bj] = *(const u32x4*)(Mg + r * 1024 + col0 + bj * HALF); }
#pragma unroll
            for (int m = 0; m < 4; ++m)
#pragma unroll
                for (int bj = 0; bj < 2; ++bj) { const size_t r = (size_t)(row0 + ai * HALF + m * 16); const f32x4 v0 = acc[ai][bj][m][0], v1 = acc[ai][bj][m][1]; const u32x4 p4 = pv[m][bj], m4 = mv[m][bj];
                    float o[8];
                    o[0] = bflo(m4.x) + bflo(p4.x) * sigmoidf_(v0[0]); o[1] = bfhi(m4.x) + bfhi(p4.x) * sigmoidf_(v0[1]); o[2] = bflo(m4.y) + bflo(p4.y) * sigmoidf_(v0[2]); o[3] = bfhi(m4.y) + bfhi(p4.y) * sigmoidf_(v0[3]);
                    o[4] = bflo(m4.z) + bflo(p4.z) * sigmoidf_(v1[0]); o[5] = bfhi(m4.z) + bfhi(p4.z) * sigmoidf_(v1[1]); o[6] = bflo(m4.w) + bflo(p4.w) * sigmoidf_(v1[2]); o[7] = bfhi(m4.w) + bfhi(p4.w) * sigmoidf_(v1[3]);
                    u32x4 w; w.x = cvt_pk_bf16(o[0], o[1]); w.y = cvt_pk_bf16(o[2], o[3]); w.z = cvt_pk_bf16(o[4], o[5]); w.w = cvt_pk_bf16(o[6], o[7]);
                    *(u32x4*)(Mg + r * 1024 + col0 + bj * HALF) = w; }
        }
    }
};
struct EpiResid {
    static constexpr bool PERM = false;
    const float* xin; float* out; const float* gate;
    __device__ __forceinline__ void operator()(const f32x4 (&acc)[2][2][4][2], const Unit& u, int wr, int wc, int fr, int fq) const {
        const int row0 = u.pm * BM + wr * 64 + fr, col0 = u.pn * BM + wc * 32 + 4 * fq;
        const int b = (u.pm * BM) / SEQ;
        f32x4 gv[2][2];
#pragma unroll
        for (int bj = 0; bj < 2; ++bj)
#pragma unroll
            for (int n = 0; n < 2; ++n) gv[bj][n] = *(const f32x4*)(gate + b * 3072 + 2048 + col0 + bj * HALF + n * 16) + 1.0f;
#pragma unroll
        for (int ai = 0; ai < 2; ++ai)
#pragma unroll
            for (int mh = 0; mh < 4; mh += 2) {
                f32x4 xv[2][2][2];
#pragma unroll
                for (int m = 0; m < 2; ++m)
#pragma unroll
                    for (int bj = 0; bj < 2; ++bj)
#pragma unroll
                        for (int n = 0; n < 2; ++n) xv[m][bj][n] = *(const f32x4*)(xin + (size_t)(row0 + ai * HALF + (mh + m) * 16) * D + col0 + bj * HALF + n * 16);
#pragma unroll
                for (int m = 0; m < 2; ++m)
#pragma unroll
                    for (int bj = 0; bj < 2; ++bj)
#pragma unroll
                        for (int n = 0; n < 2; ++n) *(f32x4*)(out + (size_t)(row0 + ai * HALF + (mh + m) * 16) * D + col0 + bj * HALF + n * 16) = xv[m][bj][n] * DN_ALPHA + gv[bj][n] * acc[ai][bj][mh + m][n]; }
    }
};
struct EpiMoe1 {
    static constexpr bool PERM = false;
    bf16_t* Act; const float* rowgate;
    __device__ __forceinline__ void operator()(const f32x4 (&acc)[2][2][4][2], const Unit& u, int wr, int wc, int fr, int fq) const {
        const int row0 = u.pm * BM + wr * 64 + fr, f0 = u.pn * 128 + wc * 16 + 4 * fq;
#pragma unroll
        for (int ai = 0; ai < 2; ++ai)
#pragma unroll
            for (int m = 0; m < 4; ++m) { const int r = row0 + ai * HALF + m * 16; const float gt = rowgate[r];
#pragma unroll
                for (int bj = 0; bj < 2; ++bj) { const f32x4 a = acc[ai][bj][m][0], b = acc[ai][bj][m][1];
                    u32x2 w; w.x = cvt_pk_bf16(siluf_(a[0]) * b[0] * gt, siluf_(a[1]) * b[1] * gt); w.y = cvt_pk_bf16(siluf_(a[2]) * b[2] * gt, siluf_(a[3]) * b[3] * gt);
                    *(u32x2*)(Act + (size_t)r * 256 + f0 + bj * 64) = w; } }
    }
};
}

#define XB_TMO      128
#define XB_XCNT(j)  (256  + 64 * (j))
#define XB_XSUB(j)  (1280 + 64 * (j))
#define XB_XGEN(j)  (2304 + 64 * (j))
#define XB_TOP      3328
#define XB_TOPGEN   3392
#define XCD_BAR_WORDS 3456
#define XB_SPIN_CAP (1u << 22)
__device__ __forceinline__ unsigned xb_ld(unsigned* p)              { return __hip_atomic_load(p, __ATOMIC_RELAXED, __HIP_MEMORY_SCOPE_AGENT); }
__device__ __forceinline__ unsigned xb_add(unsigned* p, unsigned v) { return __hip_atomic_fetch_add(p, v, __ATOMIC_RELAXED, __HIP_MEMORY_SCOPE_AGENT); }
__device__ __forceinline__ unsigned xb_xcc_id() { return (unsigned)__builtin_amdgcn_s_getreg((3 << 11) | 20) & 0xFu; }
#define XB_SPIN(cond, bar) do { unsigned _sp = 0; while (cond) { __builtin_amdgcn_s_sleep(1); \
    if ((++_sp & 255u) == 0u) { if (xb_ld(&(bar)[XB_TMO])) break; if (_sp > XB_SPIN_CAP) { atomicAdd(&(bar)[XB_TMO], 1u); break; } } } } while (0)
struct XcdBarrier { unsigned* bar; unsigned x; volatile LAS unsigned* st; };
__device__ __forceinline__ XcdBarrier xcd_barrier_post(unsigned* bar, volatile LAS unsigned* st) {
    XcdBarrier b; b.bar = bar; b.x = xb_xcc_id(); b.st = st;
    if (threadIdx.x == 0) (void)xb_add(&bar[XB_XCNT(b.x)], 1u);
    return b;
}
__device__ __forceinline__ void xcd_barrier_complete(unsigned* bar, unsigned x, unsigned& nloc, unsigned& nx) {
    const unsigned G = gridDim.x * gridDim.y * gridDim.z;
    unsigned sum, cnt, mine, sp = 0u;
    for (;;) {
        sum = 0u; cnt = 0u; mine = 0u;
#pragma unroll
        for (unsigned j = 0; j < 16; ++j) { const unsigned c = xb_ld(&bar[XB_XCNT(j)]); sum += c; cnt += (c > 0u) ? 1u : 0u; mine = (j == x) ? c : mine; }
        if (sum == G) break;
        __builtin_amdgcn_s_sleep(1);
        if ((++sp & 255u) == 0u) { if (xb_ld(&bar[XB_TMO])) break; if (sp > XB_SPIN_CAP) { atomicAdd(&bar[XB_TMO], 1u); break; } }
    }
    nloc = mine > 0u ? mine : 1u; nx = cnt > 0u ? cnt : 1u;
}
__device__ __forceinline__ void xcd_barrier(const XcdBarrier& b) {
    asm volatile("s_waitcnt vmcnt(0)" ::: "memory");
    __syncthreads();
    if (threadIdx.x == 0) {
        unsigned* bar = b.bar;
        __builtin_amdgcn_s_waitcnt(0);
        unsigned nloc = b.st[0], nx = b.st[1];
        if (nloc == 0u) { xcd_barrier_complete(bar, b.x, nloc, nx); b.st[0] = nloc; b.st[1] = nx; }
        const unsigned old = xb_add(&bar[XB_XSUB(b.x)], 1u);
        const unsigned gen = old / nloc;
        if (old + 1u == (gen + 1u) * nloc) {
            __builtin_amdgcn_fence(__ATOMIC_RELEASE, "agent");
            asm volatile("s_waitcnt vmcnt(0)" ::: "memory");
            const unsigned og = xb_add(&bar[XB_TOP], 1u);
            const unsigned tg = og / nx;
            if (og + 1u == (tg + 1u) * nx) xb_add(&bar[XB_TOPGEN], 1u);
            else XB_SPIN(xb_ld(&bar[XB_TOPGEN]) == tg, bar);
            __builtin_amdgcn_fence(__ATOMIC_ACQUIRE, "agent");
            xb_add(&bar[XB_XGEN(b.x)], 1u);
            asm volatile("s_waitcnt vmcnt(0)" ::: "memory");
        } else {
            XB_SPIN(xb_ld(&bar[XB_XGEN(b.x)]) == gen, bar);
            __builtin_amdgcn_fence(__ATOMIC_ACQUIRE, "agent");
            asm volatile("s_waitcnt vmcnt(0)" ::: "memory");
        }
    }
    __syncthreads();
}

struct Args {
    const float* in[43]; const int* positions; float* out; unsigned char* ws; int ph_lo, ph_hi, dbg, pad;
};
enum { I_X = 0, I_C = 1, I_POS = 2, I_MOD1W = 3, I_MOD1B = 4, I_WIN = 5, I_GMLNG = 6, I_GMLNB = 7, I_GMW = 8, I_GMB = 9,
       I_S5LRE = 10, I_S5LIM = 11, I_S5STEP = 12, I_S5BRE = 13, I_S5BIM = 14, I_S5CRE = 15, I_S5CIM = 16, I_S5D = 17, I_S5GLUW = 18, I_S5GLUB = 19,
       I_CONVW = 20, I_CONVB = 21, I_DTBIAS = 22, I_ALOG = 23, I_SSDD = 24, I_SSDNG = 25, I_WBR = 26, I_WGATE = 27, I_WOUT = 28, I_LN1G = 29, I_LN1B = 30,
       I_MOD2W = 31, I_MOD2B = 32, I_RW = 33, I_RB = 34, I_EW1 = 35, I_EW3 = 36, I_EW2 = 37, I_SW1 = 38, I_SW3 = 39, I_SW2 = 40, I_LN2G = 41, I_LN2B = 42 };

typedef const __attribute__((address_space(4))) Args* ArgsP;
struct Ctx {
    ArgsP a; unsigned char* ws; LAS unsigned char* lds; int tid, lane, wave, c, G, bx, dbg;
    __device__ __forceinline__ const float* in(int i) const { return a->in[i]; }
    __device__ __forceinline__ bf16_t* proj() const { return (bf16_t*)(ws + WS_PROJ); }
    __device__ __forceinline__ bf16_t* hbuf() const { return (bf16_t*)(ws + WS_H); }
    __device__ __forceinline__ bf16_t* ybuf() const { return (bf16_t*)(ws + WS_Y); }
    __device__ __forceinline__ float* modv(int l, int w) const { return (float*)(ws + WS_MODV) + (size_t)(l * 2 + w) * NB * 3072; }
};

__device__ __forceinline__ void ph_prologue(const Ctx& X) {
    LAS float* red = (LAS float*)X.lds;
    for (int it = X.c; it < DEPTH * 2 * 48; it += X.G) {
        const int l = it / 96, w = (it / 48) & 1, jb = it % 48, j = jb * 64 + X.lane;
        const float* W = X.in(w ? I_MOD2W : I_MOD1W) + (size_t)l * D * 3072; const float* cv = X.in(I_C);
        float a0 = 0.f, a1 = 0.f, a2 = 0.f, a3 = 0.f;
        const int k0 = X.wave * 128;
        for (int k = k0; k < k0 + 128; ++k) { const float wv = W[(size_t)k * 3072 + j]; a0 += cv[k] * wv; a1 += cv[D + k] * wv; a2 += cv[2 * D + k] * wv; a3 += cv[3 * D + k] * wv; }
        red[(X.wave * 4 + 0) * 64 + X.lane] = a0; red[(X.wave * 4 + 1) * 64 + X.lane] = a1; red[(X.wave * 4 + 2) * 64 + X.lane] = a2; red[(X.wave * 4 + 3) * 64 + X.lane] = a3;
        __syncthreads();
        if (X.tid < 256) { const int b = X.tid >> 6, ln = X.tid & 63; float s = 0.f;
#pragma unroll
            for (int q = 0; q < 8; ++q) s += red[(q * 4 + b) * 64 + ln];
            const int jj = jb * 64 + ln; X.modv(l, w)[b * 3072 + jj] = s + X.in(w ? I_MOD2B : I_MOD1B)[(size_t)l * 3072 + jj]; }
        __syncthreads();
    }
}

template <class Src>
__device__ __forceinline__ void tr_item(const Src& src, bf16_t* WT, int K, int rowbase, int kb, int nb, LAS float* scr, int lane) {
    const int k0 = 64 * kb, n0 = 32 * nb;
    f32x4 v[8];
#pragma unroll
    for (int i = 0; i < 8; ++i) v[i] = src.load4(k0 + 8 * i + (lane >> 3), n0 + 4 * (lane & 7));
#pragma unroll
    for (int i = 0; i < 8; ++i) { LAS float* d = scr + (8 * i + (lane >> 3)) * 33 + 4 * (lane & 7); d[0] = v[i][0]; d[1] = v[i][1]; d[2] = v[i][2]; d[3] = v[i][3]; }
    asm volatile("s_waitcnt lgkmcnt(0)" ::: "memory");
    const int c = lane & 7;
#pragma unroll
    for (int j = 0; j < 4; ++j) { const int n = (lane >> 3) + 8 * j; const LAS float* s = scr + (8 * c) * 33 + n;
        u32x4 o; o.x = pk2(s[0 * 33], s[1 * 33]); o.y = pk2(s[2 * 33], s[3 * 33]); o.z = pk2(s[4 * 33], s[5 * 33]); o.w = pk2(s[6 * 33], s[7 * 33]);
        *(u32x4*)(WT + (size_t)(rowbase + n0 + n) * K + k0 + 8 * c) = o; }
    asm volatile("s_waitcnt lgkmcnt(0)" ::: "memory");
}
struct SrcPlain { const float* W; int N; __device__ __forceinline__ f32x4 load4(int k, int n) const { return *(const f32x4*)(W + (size_t)k * N + n); } };
struct SrcWin { const float* W; __device__ __forceinline__ f32x4 load4(int k, int n) const {
    if (n >= D_IN) return (f32x4){0.f, 0.f, 0.f, 0.f}; const int o = (n < 1216) ? n : (n < 2240) ? n + 4 : (n < 2244) ? 1216 + (n - 2240) : n; return *(const f32x4*)(W + (size_t)k * D_IN + o); } };
struct Src13 { const float* W1; const float* W3; __device__ __forceinline__ f32x4 load4(int k, int n) const {
    const int f = (n >> 5) * 16 + (n & 15); const long d = (n & 16) ? (long)(W3 - W1) : 0l; return *(const f32x4*)(W1 + d + (long)k * 256 + f); } };

__device__ __forceinline__ void ph_wconv(const Ctx& X, int l) {
    LAS float* scr = (LAS float*)(X.lds + X.wave * 16384);
    unsigned char* wb = X.ws + WS_W;
    const int gw = X.c * 8 + X.wave, NGW = X.G * 8;
    constexpr int I_A = 16 * 72, I_B = 4 * 16 * 32, I_C2 = 4 * 4 * 32, I_D = 16 * 32, I_E = 4 * 8, I_F = NE1 * 16 * 16, I_G = NE1 * 4 * 32;
    constexpr int NIT = I_A + I_B + I_C2 + I_D + I_E + I_F + I_G;
    for (int it = gw; it < NIT; it += NGW) {
        int r = it;
        if (r < I_A) { SrcWin s{X.in(I_WIN) + (size_t)l * D * D_IN}; tr_item(s, (bf16_t*)(wb + WO_IN), 1024, 0, r / 72, r % 72, scr, X.lane); continue; } r -= I_A;
        if (r < I_B) { const int i = r / 512, q = r % 512; SrcPlain s{X.in(I_WGATE) + ((size_t)l * 4 + i) * D * D, D}; tr_item(s, (bf16_t*)(wb + WO_GATE), 1024, i * 1024, q / 32, q % 32, scr, X.lane); continue; } r -= I_B;
        if (r < I_C2) { const int i = r / 128, q = r % 128; SrcPlain s{X.in(I_WBR) + ((size_t)l * 4 + i) * 256 * D, D}; tr_item(s, (bf16_t*)(wb + WO_BR) + (size_t)i * 1024 * 256, 256, 0, q / 32, q % 32, scr, X.lane); continue; } r -= I_C2;
        if (r < I_D) { SrcPlain s{X.in(I_WOUT) + (size_t)l * D * D, D}; tr_item(s, (bf16_t*)(wb + WO_OUT), 1024, 0, r / 32, r % 32, scr, X.lane); continue; } r -= I_D;
        if (r < I_E) { SrcPlain s{X.in(I_S5GLUW) + (size_t)l * 256 * 256, 256}; tr_item(s, (bf16_t*)(wb + WO_GLU), 256, 0, r / 8, r % 8, scr, X.lane); continue; } r -= I_E;
        if (r < I_F) { const int e = r / 256, q = r % 256;
            const Src13 s{(e < NEXP) ? X.in(I_EW1) + ((size_t)l * NEXP + e) * D * 256 : X.in(I_SW1) + (size_t)l * D * 256, (e < NEXP) ? X.in(I_EW3) + ((size_t)l * NEXP + e) * D * 256 : X.in(I_SW3) + (size_t)l * D * 256};
            tr_item(s, (bf16_t*)(wb + WO_13) + (size_t)e * 512 * 1024, 1024, 0, q / 16, q % 16, scr, X.lane); continue; } r -= I_F;
        { const int e = r / 128, q = r % 128; SrcPlain s{e < NEXP ? X.in(I_EW2) + ((size_t)l * NEXP + e) * 256 * D : X.in(I_SW2) + (size_t)l * 256 * D, D};
            tr_item(s, (bf16_t*)(wb + WO_2) + (size_t)e * 1024 * 256, 256, 0, q / 32, q % 32, scr, X.lane); }
    }
    const int gt = X.c * 512 + X.tid, NGT = X.G * 512;
    { bf16_t* gmw = (bf16_t*)(X.ws + WS_GMW); const float* src = X.in(I_GMW) + (size_t)l * 4 * 128 * 128;
      for (int i = gt; i < 4 * 128 * 128; i += NGT) { const int t = (i >> 7) & 127, s = i & 127; gmw[i] = (bf16_t)f2bf(s <= t ? src[i] : 0.f); } }
    for (int i = gt; i < 16 * 64; i += NGT) {
        const int g = i >> 6, p = i & 63;
        const float step = expf(X.in(I_S5STEP)[l * 16 + g]); const float lr = X.in(I_S5LRE)[(size_t)l * 1024 + i], li = X.in(I_S5LIM)[(size_t)l * 1024 + i];
        const float mag = expf(lr * step); float sn, cs; sincos_red(li * step, sn, cs);
        const float abr = mag * cs, abi = mag * sn, den = lr * lr + li * li, nr = abr - 1.0f;
        const float cr = (nr * lr + abi * li) / den, ci = (abi * lr - nr * li) / den;
        float* sa = (float*)(X.ws + WS_S5A); sa[i * 2] = abr; sa[i * 2 + 1] = abi;
        bf16_t* bb = (bf16_t*)(X.ws + WS_S5B); bf16_t* cm = (bf16_t*)(X.ws + WS_S5C);
        const float* bre = X.in(I_S5BRE) + ((size_t)l * 1024 + i) * 16; const float* bim = X.in(I_S5BIM) + ((size_t)l * 1024 + i) * 16;
#pragma unroll
        for (int ch = 0; ch < 16; ++ch) { const float br = bre[ch], bi = bim[ch];
            bb[(g * 128 + p) * 16 + ch] = (bf16_t)f2bf(cr * br - ci * bi); bb[(g * 128 + 64 + p) * 16 + ch] = (bf16_t)f2bf(cr * bi + ci * br);
            cm[(g * 16 + ch) * 128 + p] = (bf16_t)f2bf(X.in(I_S5CRE)[(((size_t)l * 16 + g) * 16 + ch) * 64 + p]);
            cm[(g * 16 + ch) * 128 + 64 + p] = (bf16_t)f2bf(-X.in(I_S5CIM)[(((size_t)l * 16 + g) * 16 + ch) * 64 + p]); }
    }
    { bf16_t* rf = (bf16_t*)(X.ws + WS_RFR); const float* rw = X.in(I_RW) + (size_t)l * D * NEXP;
      for (int i = gt; i < 2 * 32 * 64 * 8; i += NGT) { const int j = i & 7, ln = (i >> 3) & 63, ks = (i >> 9) & 31, rt = i >> 14;
          const float v = rw[(size_t)(ks * 32 + 8 * (ln >> 4) + j) * NEXP + rt * 16 + (ln & 15)]; const unsigned hi = f2bf(v); const float lo = v - bflo(hi);
          rf[i] = (bf16_t)hi; rf[32768 + i] = (bf16_t)f2bf(lo); } }
    if (l == 0) {
        const float* x = X.in(I_X); bf16_t* h = X.hbuf(); const float* mv = X.modv(0, 0);
        for (size_t i = (size_t)gt; i < (size_t)M * D / 8; i += NGT) {
            const size_t e = i * 8; const int col = (int)(e & 1023), b = (int)(e >> 23);
            const f32x4 x0 = *(const f32x4*)(x + e), x1 = *(const f32x4*)(x + e + 4);
            const f32x4 sh0 = *(const f32x4*)(mv + b * 3072 + col), sh1 = *(const f32x4*)(mv + b * 3072 + col + 4), sc0 = *(const f32x4*)(mv + b * 3072 + 1024 + col), sc1 = *(const f32x4*)(mv + b * 3072 + 1024 + col + 4);
            const f32x4 h0 = x0 * (sc0 + 1.0f) + sh0, h1 = x1 * (sc1 + 1.0f) + sh1;
            u32x4 w; w.x = pk2(h0[0], h0[1]); w.y = pk2(h0[2], h0[3]); w.z = pk2(h1[0], h1[1]); w.w = pk2(h1[2], h1[3]);
            *(u32x4*)(h + e) = w; }
    }
}

__device__ __forceinline__ void rope8(const u32x4 a, const u32x4 b, float pf, u32x4& wa, u32x4& wb) {
    float t1[8], t2[8]; t1[0] = bflo(a.x); t1[1] = bfhi(a.x); t1[2] = bflo(a.y); t1[3] = bfhi(a.y); t1[4] = bflo(a.z); t1[5] = bfhi(a.z); t1[6] = bflo(a.w); t1[7] = bfhi(a.w);
    t2[0] = bflo(b.x); t2[1] = bfhi(b.x); t2[2] = bflo(b.y); t2[3] = bfhi(b.y); t2[4] = bflo(b.z); t2[5] = bfhi(b.z); t2[6] = bflo(b.w); t2[7] = bfhi(b.w);
    float o1[8], o2[8];
    const float inv[8] = {1.0f, 0.1939227432f, 0.0376060307f, 0.00729266461f, 0.00141421356f, 0.000274248188f, 5.31829610e-05f, 1.03133862e-05f};
#pragma unroll
    for (int j = 0; j < 8; ++j) { float sn, cs; sincos_red(pf * inv[j], sn, cs); o1[j] = t1[j] * cs - t2[j] * sn; o2[j] = t2[j] * cs + t1[j] * sn; }
    wa.x = pk2(o1[0], o1[1]); wa.y = pk2(o1[2], o1[3]); wa.z = pk2(o1[4], o1[5]); wa.w = pk2(o1[6], o1[7]);
    wb.x = pk2(o2[0], o2[1]); wb.y = pk2(o2[2], o2[3]); wb.z = pk2(o2[4], o2[5]); wb.w = pk2(o2[6], o2[7]);
}
__device__ __forceinline__ void mx_rope(const Ctx& X) {
    bf16_t* pj = X.proj(); const int* pos = X.a->positions;
    const int gt = X.c * 512 + X.tid, NGT = X.G * 512;
    for (int i = gt; i < M * 10; i += NGT) {
        const int tok = i / 10, hh = i % 10;
        if (hh == 9) { const u32x4* sp = (const u32x4*)(pj + (size_t)tok * PJ + C_V); u32x4* dp = (u32x4*)((bf16_t*)(X.ws + WS_V2) + (size_t)tok * 64);
#pragma unroll
            for (int q = 0; q < 8; ++q) dp[q] = sp[q];
            continue; }
        const int col = (hh < 4) ? C_Q + hh * 64 : (hh < 8) ? C_QI + (hh - 4) * 64 : C_K;
        bf16_t* p = pj + (size_t)tok * PJ + col;
        const u32x4 a = *(const u32x4*)p, b = *(const u32x4*)(p + 8);
        u32x4 wa, wb; rope8(a, b, (float)pos[tok], wa, wb);
        if (hh < 8) { *(u32x4*)p = wa; *(u32x4*)(p + 8) = wb; }
        else { u32x4* dp = (u32x4*)((bf16_t*)(X.ws + WS_K2) + (size_t)tok * 64); const u32x4* sp = (const u32x4*)p; dp[0] = wa; dp[1] = wb;
#pragma unroll
            for (int q = 2; q < 8; ++q) dp[q] = sp[q]; }
    }
    for (int i = gt; i < (M / 16) * 16; i += NGT) {
        const int hf = i & 1, pc = (i >> 1) & 7, tile = i >> 4; const int ks = pc >> 2, fq = pc & 3;
        u32x4* dp = (u32x4*)((bf16_t*)(X.ws + WS_KI2) + (size_t)tile * 1024 + pc * 128 + hf * 64);
#pragma unroll
        for (int j = 0; j < 8; ++j) { const int tok = tile * 16 + hf * 8 + j; const bf16_t* rp = pj + (size_t)tok * PJ + C_KI;
            u32x4 v = *(const u32x4*)(rp + ks * 32 + fq * 8);
            if (pc < 2) { const u32x4 a = *(const u32x4*)rp, b = *(const u32x4*)(rp + 8); u32x4 wa, wb; rope8(a, b, (float)pos[tok], wa, wb); v = pc ? wb : wa; }
            dp[j] = v; }
    }
}

__device__ __forceinline__ void mx_gmlp(const Ctx& X, int l, int unit) {
    const int lane = X.lane, w = X.wave;
    const int row0 = unit * 128;
    LAS bf16_t* Vt = (LAS bf16_t*)X.lds;
    const bf16_t* pj = X.proj();
    const float* lng = X.in(I_GMLNG) + l * 256; const float* lnb = X.in(I_GMLNB) + l * 256;
    float g4[4], b4[4];
#pragma unroll
    for (int j = 0; j < 4; ++j) { g4[j] = lng[lane + 64 * j]; b4[j] = lnb[lane + 64 * j]; }
    for (int i = 0; i < 16; ++i) {
        const int s = w * 16 + i; const bf16_t* rp = pj + (size_t)(row0 + s) * PJ + C_GV;
        float v[4]; float sm = 0.f;
#pragma unroll
        for (int j = 0; j < 4; ++j) { v[j] = gelu_tanh(bf2f(rp[lane + 64 * j])); sm += v[j]; }
        const float mean = wave_sum(sm) * (1.0f / 256.0f); float q = 0.f;
#pragma unroll
        for (int j = 0; j < 4; ++j) { v[j] -= mean; q += v[j] * v[j]; }
        const float rstd = rsqrtf(wave_sum(q) * (1.0f / 256.0f) + LN_EPS);
#pragma unroll
        for (int j = 0; j < 4; ++j) Vt[(lane + 64 * j) * 136 + s] = (bf16_t)f2bf(v[j] * rstd * g4[j] + b4[j]);
    }
    __syncthreads();
    const int g = w >> 1, c0 = g * 64 + (w & 1) * 32, fr = lane & 15, fq = lane >> 4;
    const bf16_t* gmw = (const bf16_t*)(X.ws + WS_GMW) + (size_t)g * 128 * 128;
    const float* gmb = X.in(I_GMB) + ((size_t)l * 4 + g) * 128;
    bf16_t* ya = X.ybuf();
    for (int tt = 0; tt < 8; ++tt) {
        f32x4 acc0 = (f32x4){0.f, 0.f, 0.f, 0.f}, acc1 = acc0;
        for (int ks = 0; ks <= (tt >> 1); ++ks) {
            const bf16x8 wf = *(const bf16x8*)(gmw + (tt * 16 + fr) * 128 + ks * 32 + 8 * fq);
            const bf16x8 v0 = *(const LAS bf16x8*)(Vt + (c0 + fr) * 136 + ks * 32 + 8 * fq), v1 = *(const LAS bf16x8*)(Vt + (c0 + 16 + fr) * 136 + ks * 32 + 8 * fq);
            acc0 = mfma16(v0, wf, acc0); acc1 = mfma16(v1, wf, acc1);
        }
        const int t = tt * 16 + fr; const float bias = gmb[t];
#pragma unroll
        for (int c2 = 0; c2 < 2; ++c2) { const f32x4 a = c2 ? acc1 : acc0; const int cc = c0 + c2 * 16 + 4 * fq;
            const u32x2 uv = *(const u32x2*)(pj + (size_t)(row0 + t) * PJ + C_GU + cc);
            u32x2 o; o.x = pk2(gelu_tanh(bflo(uv.x)) * (a[0] + bias), gelu_tanh(bfhi(uv.x)) * (a[1] + bias)); o.y = pk2(gelu_tanh(bflo(uv.y)) * (a[2] + bias), gelu_tanh(bfhi(uv.y)) * (a[3] + bias));
            *(u32x2*)(ya + (size_t)(row0 + t) * 256 + cc) = o; }
    }
    __syncthreads();
}

template <int PASS>
__device__ __forceinline__ void mx_s5(const Ctx& X, int l, int wu) {
    const int lane = X.lane, fr = lane & 15, fq = lane >> 4;
    const int wgi = wu >> 3, wv = wu & 7; const int b = wgi >> 6, g = ((wgi >> 4) & 3) * 4 + (wv & 3), ch = (wgi & 15) * 2 + (wv >> 2);
    const int tb = b * SEQ + ch * 256;
    LAS float* xl = (LAS float*)(X.lds + X.wave * 16384);
    LAS bf16_t* hb = (LAS bf16_t*)(X.lds + X.wave * 16384 + 8192);
    const bf16_t* pj = X.proj();
    const bf16_t* bbT = (const bf16_t*)(X.ws + WS_S5B) + (size_t)g * 128 * 16;
    bf16x8 Bf[8];
#pragma unroll
    for (int ct = 0; ct < 8; ++ct) { Bf[ct] = (bf16x8){0, 0, 0, 0, 0, 0, 0, 0}; if (fq < 2) Bf[ct] = *(const bf16x8*)(bbT + (ct * 16 + fr) * 16 + 8 * fq); }
    const float* sa = (const float*)(X.ws + WS_S5A) + (g * 64 + lane) * 2; const float ar = sa[0], ai = sa[1];
    float hr = 0.f, hi = 0.f;
    float* st = (float*)(X.ws + WS_S5ST) + (size_t)((b * 16 + g) * 32) * 128;
    bf16x8 Cf[4]; float dsk[4];
    if (PASS == 3) {
        float pr = ar, pi = ai;
#pragma unroll
        for (int q = 0; q < 8; ++q) { const float nr = pr * pr - pi * pi, ni = 2.f * pr * pi; pr = nr; pi = ni; }
        for (int j = 0; j < ch; ++j) { const float sr = st[j * 128 + lane], si = st[j * 128 + 64 + lane]; const float nr = pr * hr - pi * hi + sr, ni = pr * hi + pi * hr + si; hr = nr; hi = ni; }
        const bf16_t* cm = (const bf16_t*)(X.ws + WS_S5C) + (size_t)g * 16 * 128;
#pragma unroll
        for (int ks = 0; ks < 4; ++ks) Cf[ks] = *(const bf16x8*)(cm + fr * 128 + ks * 32 + 8 * fq);
#pragma unroll
        for (int i = 0; i < 4; ++i) dsk[i] = X.in(I_S5D)[l * 256 + g * 16 + 4 * fq + i];
    }
    bf16_t* ycp = (bf16_t*)(X.ws + WS_YCPRE);
    for (int blk = 0; blk < 16; ++blk) {
        const int t0 = tb + blk * 16;
        bf16x8 uf = (bf16x8){0, 0, 0, 0, 0, 0, 0, 0};
        if (fq < 2) uf = *(const bf16x8*)(pj + (size_t)(t0 + fr) * PJ + C_S5 + g * 16 + 8 * fq);
#pragma unroll
        for (int ct = 0; ct < 8; ++ct) { const f32x4 a = mfma16(uf, Bf[ct], (f32x4){0.f, 0.f, 0.f, 0.f});
#pragma unroll
            for (int i = 0; i < 4; ++i) xl[(4 * fq + i) * 128 + ct * 16 + fr] = a[i]; }
#pragma unroll
        for (int t = 0; t < 16; ++t) { const float xr = xl[t * 128 + lane], xi = xl[t * 128 + 64 + lane];
            const float nr = ar * hr - ai * hi + xr, ni = ar * hi + ai * hr + xi; hr = nr; hi = ni;
            if (PASS == 3) { hb[t * 136 + lane] = (bf16_t)f2bf(hr); hb[t * 136 + 64 + lane] = (bf16_t)f2bf(hi); } }
        if (PASS == 3) {
            asm volatile("s_waitcnt lgkmcnt(0)" ::: "memory"); __builtin_amdgcn_wave_barrier();
            f32x4 acc = (f32x4){0.f, 0.f, 0.f, 0.f};
#pragma unroll
            for (int ks = 0; ks < 4; ++ks) { const bf16x8 hf = *(const LAS bf16x8*)(hb + fr * 136 + ks * 32 + 8 * fq); acc = mfma16(Cf[ks], hf, acc); }
            const u32x2 uv = *(const u32x2*)(pj + (size_t)(t0 + fr) * PJ + C_S5 + g * 16 + 4 * fq);
            const float y0 = gelu_tanh(acc[0] + dsk[0] * bflo(uv.x)), y1 = gelu_tanh(acc[1] + dsk[1] * bfhi(uv.x)), y2 = gelu_tanh(acc[2] + dsk[2] * bflo(uv.y)), y3 = gelu_tanh(acc[3] + dsk[3] * bfhi(uv.y));
            u32x2 o; o.x = pk2(y0, y1); o.y = pk2(y2, y3);
            *(u32x2*)(ycp + (size_t)(t0 + fr) * 256 + g * 16 + 4 * fq) = o;
        }
    }
    if (PASS == 1) { st[ch * 128 + lane] = hr; st[ch * 128 + 64 + lane] = hi; }
}

constexpr int SD_CM = 0, SD_BM = 18432, SD_BT = 36864, SD_XT0 = 54272, SD_XT1 = 71680, SD_MM = 89088, SD_SIN0 = 123904, SD_SIN1 = 133120, SD_DT = 142336, SD_AC = 143360, SD_END = 144384;
static_assert(SD_END <= LDS_MISC, "ssd lds");
template <int PASS>
__device__ __forceinline__ void mx_ssd(const Ctx& X, int l, int unit) {
    const int tid = X.tid, lane = X.lane, w = X.wave, fr = lane & 15, fq = lane >> 4;
    const int b = unit >> 6, c = unit & 63; const int r0 = unit * 128;
    const bf16_t* pj = X.proj();
    LAS bf16_t* Cm = (LAS bf16_t*)(X.lds + SD_CM); LAS bf16_t* Bm = (LAS bf16_t*)(X.lds + SD_BM); LAS bf16_t* Bt = (LAS bf16_t*)(X.lds + SD_BT);
    LAS bf16_t* Mm = (LAS bf16_t*)(X.lds + SD_MM);
    LAS float* dtv = (LAS float*)(X.lds + SD_DT); LAS float* acm = (LAS float*)(X.lds + SD_AC);
    const float* convw = X.in(I_CONVW) + (size_t)l * 4 * 512; const float* convb = X.in(I_CONVB) + (size_t)l * 512;
    float* sst = (float*)(X.ws + WS_SSDST); float* atot = (float*)(X.ws + WS_ATOT);
    for (int g = 0; g < 2; ++g) {
        if (tid < 256) { const int j = tid >> 7, rl = tid & 127, h = 2 * g + j;
            const float raw = bf2f(pj[(size_t)(r0 + rl) * PJ + C_DT + h]) + X.in(I_DTBIAS)[l * 4 + h];
            const float dt = softplusf_(raw); dtv[j * 128 + rl] = dt; acm[j * 128 + rl] = -expf(X.in(I_ALOG)[l * 4 + h]) * dt; }
        __syncthreads();
        float cum = 0.f;
        if (tid < 256) { const int j = tid >> 7, rl = tid & 127; for (int k = 0; k <= rl; ++k) cum += acm[j * 128 + k]; }
        __syncthreads();
        if (tid < 256) acm[tid] = cum;
        __syncthreads();
        if (PASS == 1 && tid < 2) atot[(b * 64 + c) * 32 + 2 * g + tid] = acm[tid * 128 + 127];
        constexpr int NCG = (PASS == 1) ? 24 : 32;
        for (int it = tid; it < NCG * 128; it += 512) {
            const int rl = it & 127, cg = it >> 7;
            const int chn = (cg < 16) ? g * 128 + cg * 8 : (cg < 24) ? 256 + g * 64 + (cg - 16) * 8 : 384 + g * 64 + (cg - 24) * 8;
            float a8[8];
            { const f32x4 c0 = *(const f32x4*)(convb + chn), c1 = *(const f32x4*)(convb + chn + 4); a8[0] = c0[0]; a8[1] = c0[1]; a8[2] = c0[2]; a8[3] = c0[3]; a8[4] = c1[0]; a8[5] = c1[1]; a8[6] = c1[2]; a8[7] = c1[3]; }
#pragma unroll
            for (int k = 0; k < 4; ++k) { const int sq = c * 128 + rl - 3 + k;
                if (sq >= 0) { const u32x4 xv = *(const u32x4*)(pj + (size_t)(b * SEQ + sq) * PJ + C_XBC + chn);
                    const f32x4 w0 = *(const f32x4*)(convw + k * 512 + chn), w1 = *(const f32x4*)(convw + k * 512 + chn + 4);
                    a8[0] += w0[0] * bflo(xv.x); a8[1] += w0[1] * bfhi(xv.x); a8[2] += w0[2] * bflo(xv.y); a8[3] += w0[3] * bfhi(xv.y);
                    a8[4] += w1[0] * bflo(xv.z); a8[5] += w1[1] * bfhi(xv.z); a8[6] += w1[2] * bflo(xv.w); a8[7] += w1[3] * bfhi(xv.w); } }
#pragma unroll
            for (int q = 0; q < 8; ++q) a8[q] = siluf_(a8[q]);
            if (cg < 16) { const int j = cg >> 3, p0 = (cg & 7) * 8; LAS bf16_t* Xt = (LAS bf16_t*)(X.lds + (j ? SD_XT1 : SD_XT0));
                float sc = 1.0f; if (PASS == 1) sc = __expf(acm[j * 128 + 127] - acm[j * 128 + rl]) * dtv[j * 128 + rl];
#pragma unroll
                for (int q = 0; q < 8; ++q) Xt[(p0 + q) * 136 + rl] = (bf16_t)f2bf(a8[q] * sc); }
            else if (cg < 24) { const int n0 = (cg - 16) * 8;
                if (PASS == 1) {
#pragma unroll
                    for (int q = 0; q < 8; ++q) Bt[(n0 + q) * 136 + rl] = (bf16_t)f2bf(a8[q]); }
                else { u32x4 o; o.x = pk2(a8[0], a8[1]); o.y = pk2(a8[2], a8[3]); o.z = pk2(a8[4], a8[5]); o.w = pk2(a8[6], a8[7]); *(LAS u32x4*)(Bm + rl * 72 + n0) = o; } }
            else { const int n0 = (cg - 24) * 8; u32x4 o; o.x = pk2(a8[0], a8[1]); o.y = pk2(a8[2], a8[3]); o.z = pk2(a8[4], a8[5]); o.w = pk2(a8[6], a8[7]); *(LAS u32x4*)(Cm + rl * 72 + n0) = o; }
        }
        if (PASS == 3) {
            const bf16_t* sin = (const bf16_t*)(X.ws + WS_SSDSIN) + (size_t)((b * 64 + c) * 4 + 2 * g) * 4096 + tid * 8;
            const int p = tid >> 3, n0 = (tid & 7) * 8;
            *(LAS u32x4*)((LAS bf16_t*)(X.lds + SD_SIN0) + p * 72 + n0) = *(const u32x4*)sin;
            *(LAS u32x4*)((LAS bf16_t*)(X.lds + SD_SIN1) + p * 72 + n0) = *(const u32x4*)(sin + 4096);
        }
        __syncthreads();
        if (PASS == 1) {
            const int j = w >> 2, pt = w & 3; const LAS bf16_t* Xt = (const LAS bf16_t*)(X.lds + (j ? SD_XT1 : SD_XT0));
            f32x4 acc[4];
#pragma unroll
            for (int nt = 0; nt < 4; ++nt) acc[nt] = (f32x4){0.f, 0.f, 0.f, 0.f};
#pragma unroll
            for (int ks = 0; ks < 4; ++ks) { const bf16x8 xf = *(const LAS bf16x8*)(Xt + (pt * 16 + fr) * 136 + ks * 32 + 8 * fq);
#pragma unroll
                for (int nt = 0; nt < 4; ++nt) { const bf16x8 bf = *(const LAS bf16x8*)(Bt + (nt * 16 + fr) * 136 + ks * 32 + 8 * fq); acc[nt] = mfma16(xf, bf, acc[nt]); } }
            float* sp = sst + (size_t)((b * 64 + c) * 4 + 2 * g + j) * 4096;
#pragma unroll
            for (int nt = 0; nt < 4; ++nt)
#pragma unroll
                for (int i = 0; i < 4; ++i) sp[(pt * 16 + 4 * fq + i) * 64 + nt * 16 + fr] = acc[nt][i];
        } else {
            const int lrow = w * 16 + fr;
            float yv[2][4][4];
#pragma unroll
            for (int j = 0; j < 2; ++j) {
                const LAS bf16_t* Xt = (const LAS bf16_t*)(X.lds + (j ? SD_XT1 : SD_XT0)); const LAS bf16_t* Sin = (const LAS bf16_t*)(X.lds + (j ? SD_SIN1 : SD_SIN0));
                const float al = acm[j * 128 + lrow];
                const bf16x8 cf0 = *(const LAS bf16x8*)(Cm + lrow * 72 + 8 * fq), cf1 = *(const LAS bf16x8*)(Cm + lrow * 72 + 32 + 8 * fq);
                const int stmax = w | 1;
                for (int st = 0; st <= stmax; ++st) {
                    f32x4 ag = (f32x4){0.f, 0.f, 0.f, 0.f};
                    if (st <= w) { const bf16x8 b0 = *(const LAS bf16x8*)(Bm + (st * 16 + fr) * 72 + 8 * fq), b1 = *(const LAS bf16x8*)(Bm + (st * 16 + fr) * 72 + 32 + 8 * fq);
                        ag = mfma16(b0, cf0, ag); ag = mfma16(b1, cf1, ag); }
                    float mv[4];
#pragma unroll
                    for (int i = 0; i < 4; ++i) { const int s = st * 16 + 4 * fq + i; mv[i] = (s <= lrow) ? ag[i] * __expf(al - acm[j * 128 + s]) * dtv[j * 128 + s] : 0.f; }
                    u32x2 o; o.x = pk2(mv[0], mv[1]); o.y = pk2(mv[2], mv[3]); *(LAS u32x2*)(Mm + lrow * 136 + st * 16 + 4 * fq) = o;
                }
                const float eal = __expf(al); const float dsk = X.in(I_SSDD)[l * 4 + 2 * g + j];
#pragma unroll
                for (int pt = 0; pt < 4; ++pt) {
                    f32x4 ad = (f32x4){0.f, 0.f, 0.f, 0.f}, ao = ad;
                    for (int ks = 0; ks <= (w >> 1); ++ks) { const bf16x8 xf = *(const LAS bf16x8*)(Xt + (pt * 16 + fr) * 136 + ks * 32 + 8 * fq), mf = *(const LAS bf16x8*)(Mm + lrow * 136 + ks * 32 + 8 * fq); ad = mfma16(xf, mf, ad); }
                    { const bf16x8 s0 = *(const LAS bf16x8*)(Sin + (pt * 16 + fr) * 72 + 8 * fq), s1 = *(const LAS bf16x8*)(Sin + (pt * 16 + fr) * 72 + 32 + 8 * fq); ao = mfma16(s0, cf0, ao); ao = mfma16(s1, cf1, ao); }
                    const int h = 2 * g + j; const u32x2 zv = *(const u32x2*)(pj + (size_t)(r0 + lrow) * PJ + C_Z + h * 64 + pt * 16 + 4 * fq);
                    const float z4[4] = {bflo(zv.x), bfhi(zv.x), bflo(zv.y), bfhi(zv.y)};
#pragma unroll
                    for (int i = 0; i < 4; ++i) { const float xs = bf2f(Xt[(pt * 16 + 4 * fq + i) * 136 + lrow]); yv[j][pt][i] = (ad[i] + eal * ao[i] + dsk * xs) * siluf_(z4[i]); }
                }
            }
            float ss = 0.f;
#pragma unroll
            for (int j = 0; j < 2; ++j)
#pragma unroll
                for (int pt = 0; pt < 4; ++pt)
#pragma unroll
                    for (int i = 0; i < 4; ++i) ss += yv[j][pt][i] * yv[j][pt][i];
            ss += __shfl_xor(ss, 16); ss += __shfl_xor(ss, 32);
            const float rs = rsqrtf(ss * (1.0f / 128.0f) + RMS_EPS);
            const float* ng = X.in(I_SSDNG) + l * 256 + g * 128; bf16_t* yd = X.ybuf() + (size_t)3 * M * 256;
#pragma unroll
            for (int j = 0; j < 2; ++j)
#pragma unroll
                for (int pt = 0; pt < 4; ++pt) { const int cc = j * 64 + pt * 16 + 4 * fq; const f32x4 gv = *(const f32x4*)(ng + cc);
                    u32x2 o; o.x = pk2(yv[j][pt][0] * rs * gv[0], yv[j][pt][1] * rs * gv[1]); o.y = pk2(yv[j][pt][2] * rs * gv[2], yv[j][pt][3] * rs * gv[3]);
                    *(u32x2*)(yd + (size_t)(r0 + lrow) * 256 + g * 128 + cc) = o; }
        }
        __syncthreads();
    }
}

__device__ __forceinline__ void mx_ssd_carry(const Ctx& X) {
    const float* sst = (const float*)(X.ws + WS_SSDST); const float* atot = (const float*)(X.ws + WS_ATOT); bf16_t* sin = (bf16_t*)(X.ws + WS_SSDSIN);
    for (int i = X.c * 512 + X.tid; i < NB * 4 * 1024; i += X.G * 512) {
        const int e4 = i & 1023, h = (i >> 10) & 3, b = i >> 12;
        f32x4 S = (f32x4){0.f, 0.f, 0.f, 0.f};
#pragma unroll 8
        for (int c = 0; c < 64; ++c) { const size_t o = (size_t)((b * 64 + c) * 4 + h) * 4096 + e4 * 4;
            u32x2 w; w.x = pk2(S[0], S[1]); w.y = pk2(S[2], S[3]); *(u32x2*)(sin + o) = w;
            const f32x4 st = *(const f32x4*)(sst + o); const float d = __expf(atot[(b * 64 + c) * 32 + h]); S = S * d + st; }
    }
}

__device__ __forceinline__ unsigned ord16(float s) { const _Float16 hf = (_Float16)s; const unsigned bits = (unsigned)__builtin_bit_cast(unsigned short, hf); return bits ^ ((bits & 0x8000u) ? 0xFFFFu : 0x8000u); }
__device__ __forceinline__ int cnt_ge8(const u32x4 v, unsigned c) {
    int n = 0;
    n += ((v.x & 0xFFFFu) >= c) + ((v.x >> 16) >= c); n += ((v.y & 0xFFFFu) >= c) + ((v.y >> 16) >= c);
    n += ((v.z & 0xFFFFu) >= c) + ((v.z >> 16) >= c); n += ((v.w & 0xFFFFu) >= c) + ((v.w >> 16) >= c);
    return n;
}
template <int CTRL> __device__ __forceinline__ float dpp_f(float v) { return __builtin_bit_cast(float, __builtin_amdgcn_update_dpp(0, __builtin_bit_cast(int, v), CTRL, 0xF, 0xF, true)); }
__device__ __forceinline__ void mx_dsa(const Ctx& X, int b, int t0) {
    const int tid = X.tid, lane = X.lane, w = X.wave, fr = lane & 15, fq = lane >> 4;
    const bf16_t* pj = X.proj() + (size_t)b * SEQ * PJ; const unsigned rb = 0u;
    const bf16_t* ki2 = (const bf16_t*)(X.ws + WS_KI2) + (size_t)b * SEQ * 64; const bf16_t* k2 = (const bf16_t*)(X.ws + WS_K2) + (size_t)b * SEQ * 64; const bf16_t* v2 = (const bf16_t*)(X.ws + WS_V2) + (size_t)b * SEQ * 64;
    LAS unsigned short* sc = (LAS unsigned short*)X.lds;
    const int nk = t0 + 8, nkt = (nk + 15) >> 4;
    LAS unsigned* hist = (LAS unsigned*)(X.lds + 131072 + 8192);
    for (int i = tid; i < 8 * 4 * 128 / 4; i += 512) *(LAS u32x4*)(hist + 4 * i) = (u32x4){0u, 0u, 0u, 0u};
    bf16x8 qf[2][2]; f32x4 wq[2];
#pragma unroll
    for (int ct = 0; ct < 2; ++ct) { const int q = 4 * ct + (fr >> 2), hh = fr & 3; const bf16_t* qp = pj + (unsigned)(t0 + q) * (unsigned)PJ;
        qf[ct][0] = *(const bf16x8*)(qp + C_QI + hh * 64 + 8 * fq); qf[ct][1] = *(const bf16x8*)(qp + C_QI + hh * 64 + 32 + 8 * fq);
        const u32x2 wv = *(const u32x2*)(pj + (unsigned)(t0 + 4 * ct + fq) * (unsigned)PJ + C_WI);
        wq[ct] = (f32x4){bflo(wv.x) * 0.0625f, bfhi(wv.x) * 0.0625f, bflo(wv.y) * 0.0625f, bfhi(wv.y) * 0.0625f}; }
    const int ntw = (nkt > w) ? ((nkt - w + 7) >> 3) : 0;
    __syncthreads();
#define DSA_LOAD4(KF, I0) do { _Pragma("unroll") for (int j = 0; j < 4; ++j) { int kt_ = w + 8 * ((I0) + j); kt_ = kt_ < nkt ? kt_ : nkt - 1; \
        const unsigned ko_ = (unsigned)kt_ * 1024u + (unsigned)lane * 8u; KF[j][0] = *(const bf16x8*)(ki2 + ko_); KF[j][1] = *(const bf16x8*)(ki2 + ko_ + 512u); } } while (0)
#define DSA_COMP4(KF, I0) do { if (DSA_PM == 2 && rs1 > 0) { _Pragma("unroll") for (int j = 0; j < 4; ++j) dummy_ ^= KF[j][0][0] ^ KF[j][1][3]; break; } \
      _Pragma("unroll") for (int jh = 0; jh < 4; jh += 2) { f32x4 ac_[2][2]; \
        _Pragma("unroll") for (int j = 0; j < 2; ++j) _Pragma("unroll") for (int ct = 0; ct < 2; ++ct) { \
            ac_[j][ct] = mfma16(qf[ct][0], KF[jh + j][0], (f32x4){0.f, 0.f, 0.f, 0.f}); ac_[j][ct] = mfma16(qf[ct][1], KF[jh + j][1], ac_[j][ct]); } \
        _Pragma("unroll") for (int j = 0; j < 2; ++j) { if ((I0) + jh + j < ntw) { const int kt_ = w + 8 * ((I0) + jh + j); const bool full_ = (kt_ * 16 + 15 <= t0); const int key_ = kt_ * 16 + fr; \
        _Pragma("unroll") for (int ct = 0; ct < 2; ++ct) { const f32x4 a_ = ac_[j][ct]; \
            float tt_ = __builtin_fmaf(__builtin_amdgcn_fmed3f(a_[0], 0.f, 3.0e38f), wq[ct][0], 0.0f); tt_ = __builtin_fmaf(__builtin_amdgcn_fmed3f(a_[1], 0.f, 3.0e38f), wq[ct][1], tt_); \
            tt_ = __builtin_fmaf(__builtin_amdgcn_fmed3f(a_[2], 0.f, 3.0e38f), wq[ct][2], tt_); tt_ = __builtin_fmaf(__builtin_amdgcn_fmed3f(a_[3], 0.f, 3.0e38f), wq[ct][3], tt_); \
            const int q_ = 4 * ct + fq; unsigned kk_ = ord16(tt_ + 0.0f); \
            if (!full_) kk_ = (key_ <= t0 + q_) ? kk_ : 0u; \
            if (DSA_PM == 1 && rs1 > 0) dummy_ ^= (short)kk_; else sc[q_ * 8192 + key_] = (unsigned short)kk_; \
            if ((R_S1 == 1 || rs1 == 0) && (full_ || kk_ != 0u)) __hip_atomic_fetch_add(hist + (q_ * 4 + (fr & 3)) * 128 + (kk_ >> 9), (kk_ & 0x100u) ? 65536u : 1u, __ATOMIC_RELAXED, __HIP_MEMORY_SCOPE_WORKGROUP); } } } } } while (0)
    short dummy_ = 0;
    _Pragma("nounroll") for (int rs1 = 0; rs1 < (((DSA_SKIP | X.dbg) & 1) ? 0 : R_S1); ++rs1)
    { bf16x8 ka[4][2], kb[4][2];
      if (ntw > 0) { DSA_LOAD4(ka, 0);
#pragma nounroll
        for (int i0 = 0; i0 < ntw; i0 += 8) { DSA_LOAD4(kb, i0 + 4); DSA_COMP4(ka, i0); DSA_LOAD4(ka, i0 + 8); DSA_COMP4(kb, i0 + 4); } } }
#undef DSA_LOAD4
#undef DSA_COMP4
    if (dummy_ == (short)0x1234 && t0 == 123457) sc[0] = 1;
    { const int z0 = nkt * 16, z1 = ((nk + 511) >> 9) << 9;
        for (int i = z0 + tid; i < z1; i += 512) {
#pragma unroll
            for (int q = 0; q < 8; ++q) sc[q * 8192 + i] = 0; } }
    __syncthreads();
    const int t = t0 + w, nv = t + 1;
    LAS unsigned short* row = sc + w * 8192;
    LAS unsigned short* list = (LAS unsigned short*)(X.lds + 131072 + w * 512);
    const int nsel = nv < 256 ? nv : 256;
    if (((DSA_SKIP | X.dbg) & 2) || nv <= 256) { for (int n = lane; n < 256; n += 64) list[n] = (unsigned short)n; }
    else {
        const int nit = (nv + 511) >> 9;
        LAS unsigned* H = hist + w * 512;
        int T1, above1;
        { u32x4 h4 = (u32x4){0u, 0u, 0u, 0u};
#pragma unroll
          for (int c4 = 0; c4 < 4; ++c4) { const u32x2 pw = *(const LAS u32x2*)(H + c4 * 128 + 2 * lane); h4.x += pw.x & 0xFFFFu; h4.y += pw.x >> 16; h4.z += pw.y & 0xFFFFu; h4.w += pw.y >> 16; }
          const int sl = (int)(h4.x + h4.y + h4.z + h4.w);
          int suf = sl;
#pragma unroll
          for (int o = 1; o < 64; o <<= 1) { const int dn = __shfl_down(suf, o); if (lane + o < 64) suf += dn; }
          const unsigned long long bm = __ballot(suf >= 256); const int L = 63 - __builtin_clzll(bm);
          const int hx = __shfl((int)h4.x, L), hy = __shfl((int)h4.y, L), hz = __shfl((int)h4.z, L), hw = __shfl((int)h4.w, L);
          const int sufn = __shfl(suf, L) - (hx + hy + hz + hw);
          int cb = sufn; T1 = 4 * L + 3; above1 = cb;
          if (cb + hw >= 256) { T1 = 4 * L + 3; above1 = cb; } else { cb += hw; if (cb + hz >= 256) { T1 = 4 * L + 2; above1 = cb; } else { cb += hz; if (cb + hy >= 256) { T1 = 4 * L + 1; above1 = cb; } else { cb += hy; T1 = 4 * L; above1 = cb; } } } }
        _Pragma("nounroll") for (int rs2 = 0; rs2 < R_S2; ++rs2) {
        *(LAS u32x4*)(H + 4 * lane) = (u32x4){0u, 0u, 0u, 0u};
        for (int it = 0; it < nit; ++it) { const u32x4 v = *(const LAS u32x4*)(row + (it * 64 + lane) * 8);
            const unsigned e[8] = {v.x & 0xFFFFu, v.x >> 16, v.y & 0xFFFFu, v.y >> 16, v.z & 0xFFFFu, v.z >> 16, v.w & 0xFFFFu, v.w >> 16};
#pragma unroll
            for (int j = 0; j < 8; ++j) if ((int)(e[j] >> 8) == T1) __hip_atomic_fetch_add(H + (e[j] & 255u), 1u, __ATOMIC_RELAXED, __HIP_MEMORY_SCOPE_WORKGROUP); }
        unsigned thr; int cgt, cge;
        { const u32x4 h4 = *(const LAS u32x4*)(H + 4 * lane); const int sl = (int)(h4.x + h4.y + h4.z + h4.w);
          int suf = sl;
#pragma unroll
          for (int o = 1; o < 64; o <<= 1) { const int dn = __shfl_down(suf, o); if (lane + o < 64) suf += dn; }
          const int need = 256 - above1;
          const unsigned long long bm = __ballot(suf >= need); const int L = 63 - __builtin_clzll(bm);
          const int hx = __shfl((int)h4.x, L), hy = __shfl((int)h4.y, L), hz = __shfl((int)h4.z, L), hw = __shfl((int)h4.w, L);
          int cb = __shfl(suf, L) - (hx + hy + hz + hw); int T2, hT;
          if (cb + hw >= need) { T2 = 4 * L + 3; hT = hw; } else { cb += hw; if (cb + hz >= need) { T2 = 4 * L + 2; hT = hz; } else { cb += hz; if (cb + hy >= need) { T2 = 4 * L + 1; hT = hy; } else { cb += hy; T2 = 4 * L; hT = hx; } } }
          thr = ((unsigned)T1 << 8) | (unsigned)T2; cgt = above1 + cb; cge = cgt + hT; }
        const bool exact = (cge == 256);
        const int r = 256 - cgt;
        const unsigned cmin = exact ? thr : thr + 1u;
        const unsigned long long lt_mask = (1ull << lane) - 1ull; int bcnt = 0;
        for (int it = 0; it < nit; ++it) { const u32x4 v = *(const LAS u32x4*)(row + (it * 64 + lane) * 8); const int base = (it * 64 + lane) * 8;
            const unsigned e[8] = {v.x & 0xFFFFu, v.x >> 16, v.y & 0xFFFFu, v.y >> 16, v.z & 0xFFFFu, v.z >> 16, v.w & 0xFFFFu, v.w >> 16};
#pragma unroll
            for (int j = 0; j < 8; ++j) { const bool sl = e[j] >= cmin; const unsigned long long bm = __ballot(sl);
                if (bm != 0ull) { if (sl) list[(bcnt + __popcll(bm & lt_mask)) & 255] = (unsigned short)(base + j); bcnt += __popcll(bm); } } }
        if (!exact) {
            int taken = 0;
            for (int it = 0; it < nit && taken < r; ++it) { const u32x4 v = *(const LAS u32x4*)(row + (it * 64 + lane) * 8); const int base = (it * 64 + lane) * 8;
                const unsigned e[8] = {v.x & 0xFFFFu, v.x >> 16, v.y & 0xFFFFu, v.y >> 16, v.z & 0xFFFFu, v.z >> 16, v.w & 0xFFFFu, v.w >> 16};
                int mcount = 0;
#pragma unroll
                for (int j = 0; j < 8; ++j) mcount += (e[j] == thr);
                if (__ballot(mcount != 0) == 0ull) continue;
                int incl = mcount;
#pragma unroll
                for (int o = 1; o < 64; o <<= 1) { const int up = __shfl_up(incl, o); if (lane >= o) incl += up; }
                const int total = __shfl(incl, 63); int rk = taken + incl - mcount;
#pragma unroll
                for (int j = 0; j < 8; ++j) if (e[j] == thr) { if (rk < r) list[(cgt + rk) & 255] = (unsigned short)(base + j); ++rk; }
                taken += total; }
        }
        }
    }
    __builtin_amdgcn_fence(__ATOMIC_RELEASE, "workgroup"); __builtin_amdgcn_wave_barrier();
    const bf16_t* qrow = pj + (unsigned)t * (unsigned)PJ;
    bf16x8 qb0 = (bf16x8){0, 0, 0, 0, 0, 0, 0, 0}, qb1 = qb0;
    if (fr < 4) { qb0 = *(const bf16x8*)(qrow + C_Q + fr * 64 + 8 * fq); qb1 = *(const bf16x8*)(qrow + C_Q + fr * 64 + 32 + 8 * fq); }
    LAS float* Pb = (LAS float*)row;
    LAS float* pinv = (LAS float*)(X.lds + 131072 + 4096 + 256 + w * 16);
    _Pragma("nounroll") for (int rs3 = 0; rs3 < (((DSA_SKIP | X.dbg) & 4) ? 0 : R_S3); ++rs3) {
#define QK_LOAD8(KF, T0) do { _Pragma("unroll") for (int j = 0; j < 8; ++j) { const unsigned ko_ = (unsigned)list[((T0) + j) * 16 + fr] * 64u + (unsigned)(8 * fq); \
        KF[j][0] = *(const bf16x8*)(k2 + ko_); KF[j][1] = *(const bf16x8*)(k2 + ko_ + 32u); } } while (0)
#define QK_COMP8(KF, T0) do { _Pragma("unroll") for (int j = 0; j < 8; ++j) { f32x4 a_ = mfma16(KF[j][0], qb0, (f32x4){0.f, 0.f, 0.f, 0.f}); a_ = mfma16(KF[j][1], qb1, a_); \
        if (fr < 4) { _Pragma("unroll") for (int i = 0; i < 4; ++i) { const int nn_ = ((T0) + j) * 16 + 4 * fq + i; Pb[nn_ * 4 + fr] = (nn_ < nsel) ? a_[i] * 0.125f : -3.0e38f; } } } } while (0)
    { bf16x8 qa[8][2]; QK_LOAD8(qa, 0); QK_COMP8(qa, 0); QK_LOAD8(qa, 8); QK_COMP8(qa, 8); }
#undef QK_LOAD8
#undef QK_COMP8
    __builtin_amdgcn_fence(__ATOMIC_RELEASE, "workgroup"); __builtin_amdgcn_wave_barrier();
    { const int hd = lane & 3, nb0 = lane >> 2;
        float v16[16]; float mx = -3.0e38f;
#pragma unroll
        for (int j = 0; j < 16; ++j) { v16[j] = Pb[(nb0 + 16 * j) * 4 + hd]; mx = fmaxf(mx, v16[j]); }
        mx = fmaxf(mx, __shfl_xor(mx, 4)); mx = fmaxf(mx, __shfl_xor(mx, 8)); mx = fmaxf(mx, __shfl_xor(mx, 16)); mx = fmaxf(mx, __shfl_xor(mx, 32));
        float sm = 0.f;
#pragma unroll
        for (int j = 0; j < 16; ++j) { const float p = (v16[j] > -1.0e38f) ? __expf(v16[j] - mx) : 0.f; sm += p; Pb[(nb0 + 16 * j) * 4 + hd] = p; }
        sm += __shfl_xor(sm, 4); sm += __shfl_xor(sm, 8); sm += __shfl_xor(sm, 16); sm += __shfl_xor(sm, 32);
        if (lane < 4) pinv[lane] = 1.0f / sm; }
    __builtin_amdgcn_fence(__ATOMIC_RELEASE, "workgroup"); __builtin_amdgcn_wave_barrier();
    float o4[4][4];
#pragma unroll
    for (int h = 0; h < 4; ++h)
#pragma unroll
        for (int dd = 0; dd < 4; ++dd) o4[h][dd] = 0.f;
    const int d4 = fr * 4;
#define PV_LOAD(VV, B) do { _Pragma("unroll") for (int j = 0; j < 16; ++j) { const unsigned vo_ = (unsigned)list[(B) * 64 + 4 * j + fq] * 64u + (unsigned)d4; VV[j] = *(const u32x2*)(v2 + vo_); } } while (0)
#define PV_COMP(VV, B) do { _Pragma("unroll") for (int j = 0; j < 16; ++j) { const f32x4 p4_ = *(const LAS f32x4*)(Pb + ((B) * 64 + 4 * j + fq) * 4); \
        const float v0_ = bflo(VV[j].x), v1_ = bfhi(VV[j].x), v2_ = bflo(VV[j].y), v3_ = bfhi(VV[j].y); \
        _Pragma("unroll") for (int h = 0; h < 4; ++h) { o4[h][0] += p4_[h] * v0_; o4[h][1] += p4_[h] * v1_; o4[h][2] += p4_[h] * v2_; o4[h][3] += p4_[h] * v3_; } } } while (0)
    { u32x2 va[16], vb[16]; PV_LOAD(va, 0); PV_LOAD(vb, 1); PV_COMP(va, 0); PV_LOAD(va, 2); PV_COMP(vb, 1); PV_LOAD(vb, 3); PV_COMP(va, 2); PV_COMP(vb, 3); }
#undef PV_LOAD
#undef PV_COMP
#pragma unroll
    for (int h = 0; h < 4; ++h)
#pragma unroll
        for (int dd = 0; dd < 4; ++dd) { float v = o4[h][dd]; v += __shfl_xor(v, 16); v += __shfl_xor(v, 32); o4[h][dd] = v; }
    { const int h = fq; const float iv = pinv[h];
        float r4[4];
#pragma unroll
        for (int dd = 0; dd < 4; ++dd) r4[dd] = ((h == 0) ? o4[0][dd] : (h == 1) ? o4[1][dd] : (h == 2) ? o4[2][dd] : o4[3][dd]) * iv;
        u32x2 o; o.x = pk2(r4[0], r4[1]); o.y = pk2(r4[2], r4[3]);
        *(u32x2*)(X.ybuf() + (size_t)1 * M * 256 + ((size_t)b * SEQ + t) * 256 + h * 64 + d4) = o; }
    __builtin_amdgcn_fence(__ATOMIC_RELEASE, "workgroup"); __builtin_amdgcn_wave_barrier(); }
    __syncthreads();
}

constexpr int LR_HH = 0, LR_HL = 33280, LR_PART = 66560, LR_LG = 82944, LR_CNT = 84992, LR_PITCH = 1032;
__device__ __forceinline__ void ph_ln1_router(const Ctx& X, int l) {
    const int lane = X.lane, w = X.wave, tid = X.tid, fr = lane & 15, fq = lane >> 4;
    LAS bf16_t* Hh = (LAS bf16_t*)(X.lds + LR_HH); LAS bf16_t* Hl = (LAS bf16_t*)(X.lds + LR_HL);
    LAS float* part = (LAS float*)(X.lds + LR_PART);
    LAS float* lgt = (LAS float*)(X.lds + LR_LG);
    LAS unsigned* wgcnt = (LAS unsigned*)(X.lds + LR_CNT);
    if (tid < 32) wgcnt[tid] = 0u;
    bf16x8 Ahi[2][4], Alo[2][4];
    { const bf16_t* rf = (const bf16_t*)(X.ws + WS_RFR);
#pragma unroll
      for (int rt = 0; rt < 2; ++rt)
#pragma unroll
          for (int q = 0; q < 4; ++q) { const size_t o = ((size_t)(rt * 32 + 4 * w + q) * 64 + lane) * 8; Ahi[rt][q] = *(const bf16x8*)(rf + o); Alo[rt][q] = *(const bf16x8*)(rf + 32768 + o); } }
    float* xo = X.a->out; bf16_t* hb = X.hbuf(); float* xw = (X.dbg & 8) ? (float*)(X.ws + WS_ACT) : xo;
    const int tok0 = X.c * 128, b = tok0 >> 13;
    const float* mv = X.modv(l, 1) + b * 3072;
    const float* lg = X.in(I_LN1G) + l * D; const float* lb = X.in(I_LN1B) + l * D;
    const int e = lane & 31;
    const float rbias = X.in(I_RB)[l * NEXP + e];
    unsigned* pinfo = (unsigned*)(X.ws + WS_PINFO); float* pgate = (float*)(X.ws + WS_PGATE);
    __syncthreads();
    for (int pass = 0; pass < 8; ++pass) {
#pragma unroll
        for (int jj = 0; jj < 2; ++jj) {
            const int r = 2 * w + jj, tok = tok0 + pass * 16 + r;
            f32x4 v[4]; float s = 0.f;
#pragma unroll
            for (int j = 0; j < 4; ++j) { v[j] = *(const f32x4*)(xo + (size_t)tok * D + 4 * lane + 256 * j); s += (v[j][0] + v[j][1]) + (v[j][2] + v[j][3]); }
            const float mean = wave_sum(s) * (1.0f / D); float q = 0.f;
#pragma unroll
            for (int j = 0; j < 4; ++j) { v[j] = v[j] - mean; q += (v[j][0] * v[j][0] + v[j][1] * v[j][1]) + (v[j][2] * v[j][2] + v[j][3] * v[j][3]); }
            const float rstd = rsqrtf(wave_sum(q) * (1.0f / D) + LN_EPS);
#pragma unroll
            for (int j = 0; j < 4; ++j) { const int col = 4 * lane + 256 * j;
                const f32x4 x1 = v[j] * rstd * *(const f32x4*)(lg + col) + *(const f32x4*)(lb + col);
                *(f32x4*)(xw + (size_t)tok * D + col) = x1 * DN_ALPHA;
                const f32x4 hv = x1 * (*(const f32x4*)(mv + 1024 + col) + 1.0f) + *(const f32x4*)(mv + col);
                const unsigned h0 = f2bf(hv[0]), h1 = f2bf(hv[1]), h2 = f2bf(hv[2]), h3 = f2bf(hv[3]);
                u32x2 o; o.x = h0 | (h1 << 16); o.y = h2 | (h3 << 16); *(u32x2*)(hb + (size_t)tok * D + col) = o;
                *(LAS u32x2*)(Hh + r * LR_PITCH + col) = o;
                u32x2 ol; ol.x = pk2(hv[0] - bflo(h0), hv[1] - bflo(h1)); ol.y = pk2(hv[2] - bflo(h2), hv[3] - bflo(h3)); *(LAS u32x2*)(Hl + r * LR_PITCH + col) = ol; }
        }
        __syncthreads();
        {
            f32x4 acc0 = (f32x4){0.f, 0.f, 0.f, 0.f}, acc1 = acc0;
#pragma unroll
            for (int q = 0; q < 4; ++q) { const int ko = fr * LR_PITCH + (4 * w + q) * 32 + 8 * fq;
                const bf16x8 bh = *(const LAS bf16x8*)(Hh + ko), bl = *(const LAS bf16x8*)(Hl + ko);
                acc0 = mfma16(Ahi[0][q], bh, acc0); acc0 = mfma16(Ahi[0][q], bl, acc0); acc0 = mfma16(Alo[0][q], bh, acc0);
                acc1 = mfma16(Ahi[1][q], bh, acc1); acc1 = mfma16(Ahi[1][q], bl, acc1); acc1 = mfma16(Alo[1][q], bh, acc1); }
#pragma unroll
            for (int i = 0; i < 4; ++i) { part[(w * 32 + 4 * fq + i) * 16 + fr] = acc0[i]; part[(w * 32 + 16 + 4 * fq + i) * 16 + fr] = acc1[i]; }
        }
        __syncthreads();
        { const int ee = tid >> 4, tk = tid & 15; float sm = 0.f;
#pragma unroll
          for (int q = 0; q < 8; ++q) sm += part[(q * 32 + ee) * 16 + tk];
          lgt[tk * 32 + ee] = sm; }
        __syncthreads();
#pragma unroll
        for (int jj = 0; jj < 2; ++jj) {
            const int r = 2 * w + jj, tok = tok0 + pass * 16 + r;
            const float score = sigmoidf_(lgt[r * 32 + e]), biased = score + rbias;
            const int gbase = lane & ~3;
            const float v0 = __shfl(biased, gbase), v1 = __shfl(biased, gbase + 1), v2 = __shfl(biased, gbase + 2), v3 = __shfl(biased, gbase + 3);
            const float a_ = fmaxf(v0, v1), b_ = fminf(v0, v1), c_ = fmaxf(v2, v3), d_ = fminf(v2, v3);
            const float gs = fmaxf(a_, c_) + fmaxf(fminf(a_, c_), fmaxf(b_, d_));
            const int myg = e >> 2; int grank = 0;
#pragma unroll
            for (int g2 = 0; g2 < 8; ++g2) { const float o = __shfl(gs, 4 * g2); grank += (o > gs || (o == gs && g2 < myg)) ? 1 : 0; }
            const float masked = (grank < 4) ? biased : -3.0e38f;
            int erank = 0;
#pragma unroll
            for (int e2 = 0; e2 < 32; ++e2) { const float o = __shfl(masked, e2); erank += (o > masked || (o == masked && e2 < e)) ? 1 : 0; }
            const bool sel = (erank < 8) && (lane < 32);
            const float wsum = wave_sum(sel ? score : 0.f);
            const float gate = score / wsum * 2.5f;
            const unsigned long long bal = __ballot(sel);
            if (sel) { const int k = __popcll(bal & ((1ull << lane) - 1ull));
                const unsigned lr = __hip_atomic_fetch_add(wgcnt + e, 1u, __ATOMIC_RELAXED, __HIP_MEMORY_SCOPE_WORKGROUP);
                pinfo[(size_t)tok * 8 + k] = (unsigned)e | (lr << 8); pgate[(size_t)tok * 8 + k] = gate; }
        }
    }
    __syncthreads();
    if (tid < 32) { const int chunk = tok0 / CHTOK; unsigned* cnt = (unsigned*)(X.ws + WS_CTL) + CW_CNT + (l * NCH + chunk) * 64;
        const unsigned base = __hip_atomic_fetch_add(cnt + tid, wgcnt[tid], __ATOMIC_RELAXED, __HIP_MEMORY_SCOPE_AGENT);
        ((unsigned*)(X.ws + WS_WGBASE))[X.c * 32 + tid] = base; }
    __syncthreads();
}

__device__ __forceinline__ void moe_offsets(const Ctx& X, int l, int chunk, LAS int* off  , LAS int* cntl  ) {
    if (X.tid == 0) { const unsigned* cnt = (const unsigned*)(X.ws + WS_CTL) + CW_CNT + (l * NCH + chunk) * 64; int o = 0;
        for (int e = 0; e < NE1; ++e) { const int cn = (e < NEXP) ? (int)__hip_atomic_load(cnt + e, __ATOMIC_RELAXED, __HIP_MEMORY_SCOPE_AGENT) : CHTOK; off[e] = o; cntl[e] = cn; o += ((cn + 255) >> 8) << 8; }
        off[NE1] = o; }
    __syncthreads();
}
#define ST_WT(p, v) __hip_atomic_store((p), (v), __ATOMIC_RELAXED, __HIP_MEMORY_SCOPE_AGENT)
__device__ __forceinline__ void ph_fill(const Ctx& X, int l) {
    LAS int* off = (LAS int*)(X.lds); LAS int* cntl = off + 64;
    const int tok0 = X.c * 128, chunk = tok0 / CHTOK;
    moe_offsets(X, l, chunk, off, cntl);
    unsigned* rowtok = (unsigned*)(X.ws + WS_ROWTOK) + (size_t)chunk * CH_ROWS; float* rowgate = (float*)(X.ws + WS_ROWGATE) + (size_t)chunk * CH_ROWS;
    const unsigned* pinfo = (const unsigned*)(X.ws + WS_PINFO); const float* pgate = (const float*)(X.ws + WS_PGATE); unsigned* slot = (unsigned*)(X.ws + WS_SLOT);
    const unsigned* wgb = (const unsigned*)(X.ws + WS_WGBASE) + X.c * 32;
    for (int i = X.tid; i < 1024; i += 512) { const size_t pi = (size_t)tok0 * 8 + i; const unsigned inf = pinfo[pi]; const int e = inf & 255, lr = inf >> 8;
        const int pos = off[e] + (int)wgb[e] + lr; ST_WT(rowtok + pos, (unsigned)(tok0 + (i >> 3))); ST_WT((unsigned*)rowgate + pos, __builtin_bit_cast(unsigned, pgate[pi])); slot[pi] = (unsigned)pos; }
    if (X.tid < 128) { const int tok = tok0 + X.tid; const int pos = off[NEXP] + (tok - chunk * CHTOK); ST_WT(rowtok + pos, (unsigned)tok); ST_WT((unsigned*)rowgate + pos, __builtin_bit_cast(unsigned, 1.0f)); }
    const int wl = X.c & 63;
    if (wl < NEXP) { const int e = wl; const int p0 = off[e] + cntl[e], p1 = off[e + 1]; for (int p = p0 + X.tid; p < p1; p += 512) { ST_WT(rowtok + p, (unsigned)(chunk * CHTOK)); ST_WT((unsigned*)rowgate + p, 0u); } }
    __syncthreads();
}

template <int NT, bool GATH>
struct MoeOrder {
    static constexpr bool GATHER = GATH;
    int nwg, G, c; const LAS unsigned char* tile_e; const LAS int* rowtab;
    __device__ __forceinline__ bool next(int i, pg8::Unit& u) const {
        const long L = (long)i * G + c; if (L >= nwg) return false;
        const int wgid = pg8::xcd_remap((int)L, nwg); const int tau = wgid / NT, pn = wgid % NT;
        u.pm = tau; u.pn = pn; u.bt = __builtin_amdgcn_readfirstlane((int)tile_e[tau]) * NT + pn; u.ab = i; return true;
    }
    __device__ __forceinline__ int row_of(const pg8::Unit& u, int r) const { return rowtab[u.ab * 256 + r]; }
    __device__ __forceinline__ void a_ready(const pg8::Unit&) const {}
    __device__ __forceinline__ void done(const pg8::Unit&) const {}
};
struct MoeOrderAll {
    static constexpr bool GATHER = true;
    int nwg, G, c; const LAS unsigned char* tile_e4; const LAS int* tprefix; const LAS int* rowtab;
    __device__ __forceinline__ bool next(int i, pg8::Unit& u) const {
        const long L = (long)i * G + c; if (L >= nwg) return false;
        const int wgid = pg8::xcd_remap((int)L, nwg); const int gt = wgid >> 1, pn = wgid & 1;
        int ch = 0;
#pragma unroll
        for (int q = 1; q < NCH; ++q) ch += (tprefix[q] <= gt) ? 1 : 0;
        ch = __builtin_amdgcn_readfirstlane(ch); const int tau = gt - __builtin_amdgcn_readfirstlane(tprefix[ch]);
        u.pm = ch * CH_TILES + tau; u.pn = pn; u.bt = __builtin_amdgcn_readfirstlane((int)tile_e4[ch * 336 + tau]) * 2 + pn; u.ab = i; return true;
    }
    __device__ __forceinline__ int row_of(const pg8::Unit& u, int r) const { return rowtab[u.ab * 256 + r]; }
    __device__ __forceinline__ void a_ready(const pg8::Unit&) const {}
    __device__ __forceinline__ void done(const pg8::Unit&) const {}
};
__device__ __forceinline__ int moe_tiles(const Ctx& X, int l, int chunk, LAS unsigned char* tile_e, LAS int* off, LAS int* cntl) {
    moe_offsets(X, l, chunk, off, cntl);
    const int ntile = off[NE1] >> 8;
    for (int t = X.tid; t < ntile; t += 512) { int e = 0; for (int q = 1; q < NE1; ++q) e += (off[q] <= t * 256) ? 1 : 0; tile_e[t] = (unsigned char)e; }
    __syncthreads();
    return ntile;
}

__device__ __forceinline__ void ph_combine(const Ctx& X, int l, int chunk, LAS int* off) {
    const int lane = X.lane; const int gw = X.c * 8 + X.wave;
    float* xo = X.a->out; bf16_t* hb = X.hbuf(); float* xw = (X.dbg & 8) ? (float*)(X.ws + WS_ACT) : xo;
    const bf16_t* op = (const bf16_t*)(X.ws + WS_OPAIR); const unsigned* slot = (const unsigned*)(X.ws + WS_SLOT);
    const int b = (chunk * CHTOK) >> 13; const float* mv2 = X.modv(l, 1) + b * 3072;
    const float* lg = X.in(I_LN2G) + l * D; const float* lb = X.in(I_LN2B) + l * D;
    const int offsh = off[NEXP];
    for (int i = 0; i < 4; ++i) {
        const int tok = chunk * CHTOK + gw * 4 + i;
        f32x4 sm[4];
#pragma unroll
        for (int j = 0; j < 4; ++j) sm[j] = (f32x4){0.f, 0.f, 0.f, 0.f};
#pragma unroll
        for (int k = 0; k < 9; ++k) { const int pos = (k < 8) ? (int)slot[(size_t)tok * 8 + k] : offsh + (tok - chunk * CHTOK);
            const bf16_t* rp = op + (size_t)pos * 1024 + 4 * lane;
#pragma unroll
            for (int j = 0; j < 4; ++j) { const u32x2 q = *(const u32x2*)(rp + 256 * j); sm[j][0] += bflo(q.x); sm[j][1] += bfhi(q.x); sm[j][2] += bflo(q.y); sm[j][3] += bfhi(q.y); } }
        f32x4 v[4]; float s = 0.f;
#pragma unroll
        for (int j = 0; j < 4; ++j) { const int col = 4 * lane + 256 * j; v[j] = *(const f32x4*)(xo + (size_t)tok * D + col) + (*(const f32x4*)(mv2 + 2048 + col) + 1.0f) * sm[j]; s += (v[j][0] + v[j][1]) + (v[j][2] + v[j][3]); }
        const float mean = wave_sum(s) * (1.0f / D); float q = 0.f;
#pragma unroll
        for (int j = 0; j < 4; ++j) { v[j] = v[j] - mean; q += (v[j][0] * v[j][0] + v[j][1] * v[j][1]) + (v[j][2] * v[j][2] + v[j][3] * v[j][3]); }
        const float rstd = rsqrtf(wave_sum(q) * (1.0f / D) + LN_EPS);
#pragma unroll
        for (int j = 0; j < 4; ++j) { const int col = 4 * lane + 256 * j;
            const f32x4 x2 = v[j] * rstd * *(const f32x4*)(lg + col) + *(const f32x4*)(lb + col);
            *(f32x4*)(xw + (size_t)tok * D + col) = x2;
            if (l + 1 < DEPTH) { const float* mv1 = X.modv(l + 1, 0) + b * 3072; const f32x4 hn = x2 * (*(const f32x4*)(mv1 + 1024 + col) + 1.0f) + *(const f32x4*)(mv1 + col);
                u32x2 o; o.x = pk2(hn[0], hn[1]); o.y = pk2(hn[2], hn[3]); *(u32x2*)(hb + (size_t)tok * D + col) = o; } }
    }
}

struct POrder : pg8::StaticOrder { __device__ __forceinline__ bool next(int i, pg8::Unit& u) const { if (!pg8::StaticOrder::next(i, u)) return false; u.ab = u.pn >> 2; return true; } };
struct GOrder { static constexpr bool GATHER = false; int G, c;
    __device__ __forceinline__ bool next(int i, pg8::Unit& u) const { const int tile = (i >> 2) * G + c; if (tile >= 512) return false; const int wg = pg8::xcd_remap(tile, 512); const int br = i & 3, mt = wg & 3;
        u.pm = wg >> 2; u.pn = br * 4 + mt; u.bt = br * 4 + mt; u.ab = 0; return true; }
    __device__ __forceinline__ void a_ready(const pg8::Unit&) const {} __device__ __forceinline__ void done(const pg8::Unit&) const {} };
__global__ void __launch_bounds__(512, 2) fwd_kernel(Args args) {
    extern __shared__ __attribute__((aligned(16))) unsigned char lds_raw[];
    ArgsP ap = (ArgsP)__builtin_amdgcn_kernarg_segment_ptr();
    Ctx X; X.a = ap; X.ws = ap->ws; X.lds = (LAS unsigned char*)lds_raw;
    X.tid = threadIdx.x; X.lane = X.tid & 63; X.wave = __builtin_amdgcn_readfirstlane(X.tid >> 6); X.G = gridDim.x;
    { const int bx = blockIdx.x; X.bx = bx; X.c = (X.G % 8 == 0) ? (bx % 8) * (X.G / 8) + bx / 8 : bx; }
    const int c0_ = X.c, g0_ = X.G, bx0_ = X.bx;
    volatile LAS unsigned* misc = (volatile LAS unsigned*)(X.lds + LDS_MISC);
    if (X.tid < 16) misc[X.tid] = 0u;
    __syncthreads();
    XcdBarrier bar; bar.bar = (unsigned*)(X.ws + WS_CTL) + CW_BAR; bar.x = 0; bar.st = misc;
#if !MK_PER_PHASE
    bar = xcd_barrier_post((unsigned*)(X.ws + WS_CTL) + CW_BAR, misc);
#endif
    const int lo = ap->ph_lo, hi = ap->ph_hi; int ph = 0;
#define RELAUNDER() do { int t_ = threadIdx.x; asm volatile("" : "+v"(t_)); X.tid = t_; X.lane = t_ & 63; X.wave = __builtin_amdgcn_readfirstlane(t_ >> 6); } while (0)
#define REPEAT(N, stmt) _Pragma("nounroll") for (int rp_ = 0; rp_ < (N); ++rp_) { stmt; if (rp_ + 1 < (N)) xcd_barrier(bar); }
#define PH_BEGIN if (ph >= lo && ph < hi) { { ArgsP apl = ap; asm volatile("" : "+s"(apl)); X.a = apl; X.ws = apl->ws; X.dbg = apl->dbg; int t_ = threadIdx.x; asm volatile("" : "+v"(t_)); X.tid = t_; X.lane = t_ & 63; X.wave = __builtin_amdgcn_readfirstlane(t_ >> 6); int c_ = c0_, g_ = g0_, b_ = bx0_; asm volatile("" : "+s"(c_), "+s"(g_), "+s"(b_)); X.c = c_; X.G = g_; X.bx = b_; } unsigned char* wb = X.ws + WS_W; LAS unsigned char* gl = X.lds; const float* xin = (l_ == 0) ? X.in(I_X) : (const float*)X.a->out; (void)wb; (void)gl; (void)xin;
#if MK_PER_PHASE
#define PH_END } ++ph;
#else
#define PH_END if (ph + 1 < hi) xcd_barrier(bar); } ++ph;
#endif
    int l_ = 0;
    PH_BEGIN if (EN_PROLOGUE) { REPEAT(R_MISC, ph_prologue(X)) } PH_END
    for (int l = 0; l < DEPTH; ++l) {
        l_ = l;
        PH_BEGIN if (EN_WCONV) { REPEAT(R_MISC, ph_wconv(X, l)) } PH_END
        PH_BEGIN if (EN_GWIN)  { pg8::Gemm g{X.hbuf(), (const bf16_t*)(wb + WO_IN), 1024, 0}; pg8::StaticOrder S; S.init(M, PJ, X.G, X.bx); pg8::EpiBf16 E{X.proj(), PJ};
            REPEAT(R_GWIN, (pg8::gemm_phase<pg8::EpiBf16, pg8::StaticOrder, G_ALIGN, G_SP2>(gl, g, S, E, X.tid))) } PH_END
        PH_BEGIN if (EN_MX1)  {
            mx_rope(X);
            _Pragma("nounroll") for (int rp_ = 0; rp_ < R_MIX; ++rp_) {
            for (int u = X.c; u < 256; u += X.G) mx_gmlp(X, l, u);
            for (int wu = X.c * 8 + X.wave; wu < 2048; wu += X.G * 8) mx_s5<1>(X, l, wu);
            __syncthreads();
            for (int u = X.c; u < 256; u += X.G) mx_ssd<1>(X, l, u); }
        } PH_END
        PH_BEGIN if (EN_MX2)  {
            mx_ssd_carry(X); RELAUNDER();
            _Pragma("nounroll") for (int rp_ = 0; rp_ < R_DSA; ++rp_)
            for (int r = 0; r < 16; ++r) { const int cl = X.c & 63; const int uu = (r & 1) ? r * 64 + 63 - cl : r * 64 + cl; if (EN_DSA && X.c < 256) mx_dsa(X, X.c >> 6, uu * 8); }
            __syncthreads(); RELAUNDER();
            for (int wu = X.c * 8 + X.wave; EN_S53 && wu < 2048; wu += X.G * 8) mx_s5<3>(X, l, wu);
        } PH_END
        PH_BEGIN if (EN_GLU)  { for (int u = X.c; EN_SSD3 && u < 256; u += X.G) mx_ssd<3>(X, l, u);
            __syncthreads(); RELAUNDER();
            pg8::Gemm g{(const bf16_t*)(X.ws + WS_YCPRE), (const bf16_t*)(wb + WO_GLU), 256, 0}; pg8::StaticOrder S; S.init(M, 256, X.G, X.bx);
            pg8::EpiGlu E{(const bf16_t*)(X.ws + WS_YCPRE), X.ybuf() + (size_t)2 * M * 256, X.in(I_S5GLUB) + l * 256};
            REPEAT(R_GLU, (pg8::gemm_phase<pg8::EpiGlu, pg8::StaticOrder, G_ALIGN, G_SP2>(gl, g, S, E, X.tid))) } PH_END
        PH_BEGIN if (EN_GP)  { pg8::Gemm g{X.ybuf(), (const bf16_t*)(wb + WO_BR), 256, (size_t)M * 256};
            POrder S;
            S.init(M, 4096, X.G, X.bx); pg8::EpiBf16 E{(bf16_t*)(X.ws + WS_P), 4096};
            REPEAT(R_GP, (pg8::gemm_phase<pg8::EpiBf16, POrder, G_ALIGN, G_SP2>(gl, g, S, E, X.tid))) } PH_END
        PH_BEGIN if (EN_GGATE)  { pg8::Gemm g{X.hbuf(), (const bf16_t*)(wb + WO_GATE), 1024, 0};
            GOrder S{X.G, X.bx};
            pg8::EpiGateMerge E{(const bf16_t*)(X.ws + WS_P), X.ybuf()};
            REPEAT(R_GGATE, (pg8::gemm_phase<pg8::EpiGateMerge, GOrder, G_ALIGN, G_SP2>(gl, g, S, E, X.tid))) } PH_END
        PH_BEGIN if (EN_GOUT)  { pg8::Gemm g{X.ybuf(), (const bf16_t*)(wb + WO_OUT), 1024, 0}; pg8::StaticOrder S; S.init(M, 1024, X.G, X.bx);
            pg8::EpiResid E{xin, X.a->out, X.modv(l, 0)};
            pg8::gemm_phase<pg8::EpiResid, pg8::StaticOrder, G_ALIGN, G_SP2>(gl, g, S, E, X.tid); } PH_END
        PH_BEGIN if (EN_LN1)  ph_ln1_router(X, l); PH_END
        PH_BEGIN if (EN_FILL) { REPEAT(R_MISC, ph_fill(X, l)) } PH_END
        PH_BEGIN if (EN_MOE1)  {
            LAS int* off4 = (LAS int*)(X.lds + LDS_TAB + 1024); LAS unsigned char* tile_e4 = (LAS unsigned char*)(X.lds + LDS_TAB + 2048); LAS int* tprefix = (LAS int*)(X.lds + LDS_TAB + 3584);
            if (X.tid < NCH) { const int chn = X.tid; const unsigned* cnt = (const unsigned*)(X.ws + WS_CTL) + CW_CNT + (l * NCH + chn) * 64; int o = 0;
                for (int e = 0; e < NE1; ++e) { const int cn = (e < NEXP) ? (int)__hip_atomic_load(cnt + e, __ATOMIC_RELAXED, __HIP_MEMORY_SCOPE_AGENT) : CHTOK; off4[chn * 64 + e] = o; o += ((cn + 255) >> 8) << 8; }
                off4[chn * 64 + NE1] = o; }
            __syncthreads();
            if (X.tid == 0) { int a = 0; for (int q = 0; q < NCH; ++q) { tprefix[q] = a; a += off4[q * 64 + NE1] >> 8; } tprefix[NCH] = a; }
            for (int t = X.tid; t < NCH * 336; t += 512) { const int chn = t / 336, tau = t % 336; int e = 0; for (int q = 1; q < NE1; ++q) e += (off4[chn * 64 + q] <= tau * 256) ? 1 : 0; tile_e4[t] = (unsigned char)e; }
            __syncthreads();
            pg8::Gemm g{X.hbuf(), (const bf16_t*)(wb + WO_13), 1024, 0};
            LAS int* rowtab = (LAS int*)(X.lds + LDS_TAB + 4096);
            MoeOrderAll S{tprefix[NCH] * 2, X.G, X.bx, tile_e4, tprefix, rowtab};
            { const unsigned* rowtok = (const unsigned*)(X.ws + WS_ROWTOK); pg8::Unit uu;
              _Pragma("nounroll") for (int i = 0; i < 12; ++i) { if (!S.next(i, uu)) break; const int pmu = __builtin_amdgcn_readfirstlane(uu.pm); if (X.tid < 256) rowtab[i * 256 + X.tid] = (int)rowtok[(size_t)pmu * 256 + X.tid]; } }
            __syncthreads();
            pg8::EpiMoe1 E{(bf16_t*)(X.ws + WS_ACT), (const float*)(X.ws + WS_ROWGATE)};
            REPEAT(R_MOE, (pg8::gemm_phase<pg8::EpiMoe1, MoeOrderAll, G_ALIGN, G_SP2>(gl, g, S, E, X.tid)))
        } PH_END
        for (int ch = 0; ch < NCH; ++ch) {
            PH_BEGIN if (EN_MOE2)  {
                LAS int* off = (LAS int*)(X.lds + LDS_TAB + 1024); LAS int* cntl = off + 64; LAS unsigned char* tile_e = (LAS unsigned char*)(X.lds + LDS_TAB + 2048);
                const int ntile = moe_tiles(X, l, ch, tile_e, off, cntl);
                pg8::Gemm g{(const bf16_t*)(X.ws + WS_ACT) + (size_t)ch * CH_ROWS * 256, (const bf16_t*)(wb + WO_2), 256, 0};
                MoeOrder<4, false> S{ntile * 4, X.G, X.bx, tile_e, nullptr};
                pg8::EpiBf16 E{(bf16_t*)(X.ws + WS_OPAIR), 1024};
                REPEAT(R_MOE, (pg8::gemm_phase<pg8::EpiBf16, MoeOrder<4, false>, G_ALIGN, G_SP2>(gl, g, S, E, X.tid)))
            } PH_END
            if (ch + 1 < NCH) {
            PH_BEGIN if (EN_FIN)  { LAS int* off = (LAS int*)(X.lds + LDS_TAB + 1024); LAS int* cntl = off + 64; moe_offsets(X, l, ch, off, cntl); ph_combine(X, l, ch, off); } PH_END
            }
        }
        PH_BEGIN if (EN_FIN)  { LAS int* off = (LAS int*)(X.lds + LDS_TAB + 1024); LAS int* cntl = off + 64; moe_offsets(X, l, NCH - 1, off, cntl); ph_combine(X, l, NCH - 1, off); } PH_END
    }
#undef PH_BEGIN
#undef PH_END
}
constexpr int N_PHASES = 1 + DEPTH * (10 + 2 * NCH + 1);

#ifdef DBG_DUMP_OFF
__global__ void dbg_dump(const bf16_t* src, float* out, size_t n) { for (size_t i = (size_t)blockIdx.x * blockDim.x + threadIdx.x; i < n; i += (size_t)gridDim.x * blockDim.x) {
#ifdef DBG_HASH_OUT
    const unsigned bits = __builtin_bit_cast(unsigned, out[i]); out[i] = (float)((bits * 2654435761u) >> 8) * (1.0f / 16777216.0f);
#else
    const unsigned bits = src[i]; out[i] = (float)(((bits + 1u) * 2654435761u) >> 8) * (1.0f / 16777216.0f);
#endif
} }
#endif
extern "C" void kernel_launch(void* const* d_in, const int* in_sizes, int n_in, void* d_out, int out_size, void* d_ws, size_t ws_size, hipStream_t stream) {
    static int grid = 0;
    if (grid == 0) {
        if (n_in != 43 || out_size != M * D || ws_size < WS_NEED) { fprintf(stderr, "kernel_launch: unexpected shapes (n_in %d out %d ws %zu)\n", n_in, out_size, ws_size); grid = -1; return; }
        int dev = 0, cus = 0, per_cu = 0;
        if (hipGetDevice(&dev) != hipSuccess || hipDeviceGetAttribute(&cus, hipDeviceAttributeMultiprocessorCount, dev) != hipSuccess) { grid = -1; return; }
        if (hipFuncSetAttribute((const void*)fwd_kernel, hipFuncAttributeMaxDynamicSharedMemorySize, LDS_BYTES) != hipSuccess) { fprintf(stderr, "kernel_launch: hipFuncSetAttribute failed\n"); grid = -1; return; }
        if (hipOccupancyMaxActiveBlocksPerMultiprocessor(&per_cu, (const void*)fwd_kernel, 512, LDS_BYTES) != hipSuccess || per_cu < 1) fprintf(stderr, "kernel_launch: occupancy query says %d\n", per_cu);
        (void)hipGetLastError();
        grid = cus < 256 ? cus : 256;
    }
    if (grid < 0) return;
    (void)hipMemsetAsync((char*)d_ws + WS_CTL, 0, CTL_BYTES, stream);
#ifdef DBG_POISON
    (void)hipMemsetAsync((char*)d_ws + CTL_BYTES, 0xFF, WS_NEED - CTL_BYTES, stream);
    (void)hipMemsetAsync((char*)d_out, 0xFF, (size_t)M * D * 4, stream);
#endif
    Args a{};
    for (int i = 0; i < 43; ++i) a.in[i] = (const float*)d_in[i];
    a.positions = (const int*)d_in[I_POS]; a.out = (float*)d_out; a.ws = (unsigned char*)d_ws;
#if MK_PER_PHASE
#ifndef DBG_NPH
#define DBG_NPH N_PHASES
#endif
    for (int p = 0; p < DBG_NPH; ++p) { a.ph_lo = p; a.ph_hi = p + 1; hipLaunchKernelGGL(fwd_kernel, dim3(grid), dim3(512), LDS_BYTES, stream, a); }
#ifdef DBG_DUMP_OFF
    hipLaunchKernelGGL(dbg_dump, dim3(2048), dim3(256), 0, stream, (const bf16_t*)((const char*)d_ws + (size_t)(DBG_DUMP_OFF)), (float*)d_out, (size_t)M * D);
#endif
#else
    a.ph_lo = 0; a.ph_hi = N_PHASES; hipLaunchKernelGGL(fwd_kernel, dim3(grid), dim3(512), LDS_BYTES, stream, a);
#ifdef DBG_EXTRA_PH
    a.dbg = DBG_EXTRA_FLAGS;
    for (int rep = 0; rep < DBG_EXTRA_REP; ++rep) { a.ph_lo = DBG_EXTRA_PH; a.ph_hi = DBG_EXTRA_PH + 1; hipLaunchKernelGGL(fwd_kernel, dim3(grid), dim3(512), LDS_BYTES, stream, a); }
#endif
#endif
}
```

```cpp
#include <hip/hip_runtime.h>
#include <cstdio>
#include <cstdint>


#ifndef DSA_SKIP
#define DSA_SKIP 0
#endif
#ifndef DSA_PM
#define DSA_PM 0
#endif
#ifndef R_S1
#define R_S1 1
#endif
#ifndef R_S2
#define R_S2 1
#endif
#ifndef R_S3
#define R_S3 1
#endif
#ifndef EN_DSA
#define EN_DSA 1
#endif
#ifndef EN_S53
#define EN_S53 1
#endif
#ifndef EN_SSD3
#define EN_SSD3 1
#endif
#ifndef R_GWIN
#define R_GWIN 1
#endif
#ifndef R_GLU
#define R_GLU 1
#endif
#ifndef R_GP
#define R_GP 1
#endif
#ifndef R_GGATE
#define R_GGATE 1
#endif
#ifndef R_DENSE
#define R_DENSE 1
#endif
#ifndef R_MOE
#define R_MOE 1
#endif
#ifndef R_DSA
#define R_DSA 1
#endif
#ifndef R_MIX
#define R_MIX 1
#endif
#ifndef R_MISC
#define R_MISC 1
#endif
#ifndef MK_PER_PHASE
#define MK_PER_PHASE 0
#endif

#ifndef EN_PROLOGUE
#define EN_PROLOGUE 1
#endif
#ifndef EN_WCONV
#define EN_WCONV 1
#endif
#ifndef EN_GWIN
#define EN_GWIN 1
#endif
#ifndef EN_MX1
#define EN_MX1 1
#endif
#ifndef EN_MX2
#define EN_MX2 1
#endif
#ifndef EN_GLU
#define EN_GLU 1
#endif
#ifndef EN_GP
#define EN_GP 1
#endif
#ifndef EN_GGATE
#define EN_GGATE 1
#endif
#ifndef EN_GOUT
#define EN_GOUT 1
#endif
#ifndef EN_LN1
#define EN_LN1 1
#endif
#ifndef EN_FILL
#define EN_FILL 1
#endif
#ifndef EN_MOE1
#define EN_MOE1 1
#endif
#ifndef EN_MOE2
#define EN_MOE2 1
#endif
#ifndef EN_FIN
#define EN_FIN 1
#endif
#ifndef G_ALIGN
#define G_ALIGN true
#endif
#ifndef G_SP2
#define G_SP2 true
#endif
#define LAS __attribute__((address_space(3)))
#define GAS __attribute__((address_space(1)))
typedef unsigned short bf16_t;
typedef short bf16x8 __attribute__((ext_vector_type(8)));
typedef float f32x4 __attribute__((ext_vector_type(4)));
typedef float f32x2 __attribute__((ext_vector_type(2)));
typedef unsigned u32x4 __attribute__((ext_vector_type(4)));
typedef unsigned u32x2 __attribute__((ext_vector_type(2)));

constexpr int NB = 4, SEQ = 8192, M = NB * SEQ, D = 1024, DEPTH = 2;
constexpr int PJ = 2304;
constexpr int C_GU = 0, C_GV = 256, C_Q = 512, C_K = 768, C_V = 832, C_QI = 896, C_KI = 1152, C_S5 = 1216, C_Z = 1472, C_XBC = 1728, C_WI = 2240, C_DT = 2244;
constexpr int D_IN = 2248;
constexpr int NEXP = 32, NE1 = 33;
constexpr int NCH = 4, CHTOK = M / NCH;
constexpr int CH_ROWS = CHTOK * 8 + CHTOK + NE1 * 256;
constexpr float DN_ALPHA = 1.41421356237f;
constexpr float LN_EPS = 1e-5f, RMS_EPS = 1e-6f;

constexpr size_t MiB = 1u << 20;
constexpr size_t WS_CTL = 0, CTL_BYTES = 1 * MiB;
constexpr size_t WS_MODV = 1 * MiB;
constexpr size_t WS_S5B = WS_MODV + 256 * 1024;
constexpr size_t WS_S5C = WS_S5B + 64 * 1024;
constexpr size_t WS_S5A = WS_S5C + 64 * 1024;
constexpr size_t WS_GMW = WS_S5A + 64 * 1024;
constexpr size_t WS_RFR = WS_GMW + 128 * 1024;
static_assert(WS_RFR + 128 * 1024 <= 2 * MiB, "misc tables");
constexpr size_t WS_S5ST = 2 * MiB;
constexpr size_t WS_ATOT = 3 * MiB;
constexpr size_t WS_WGBASE = 3 * MiB + 64 * 1024;
constexpr size_t WS_PINFO = 4 * MiB;
constexpr size_t WS_PGATE = 5 * MiB;
constexpr size_t WS_SLOT = 6 * MiB;
constexpr size_t WS_ROWTOK = 7 * MiB;
constexpr size_t WS_ROWGATE = 9 * MiB;
constexpr size_t WS_S5HIN = 11 * MiB;
constexpr size_t WS_W = 24 * MiB;
constexpr size_t WO_IN = 0, WO_GATE = WO_IN + (size_t)PJ * 1024 * 2, WO_BR = WO_GATE + (size_t)4096 * 1024 * 2, WO_OUT = WO_BR + (size_t)4 * 1024 * 256 * 2,
                 WO_GLU = WO_OUT + (size_t)1024 * 1024 * 2, WO_13 = WO_GLU + (size_t)256 * 256 * 2, WO_2 = WO_13 + (size_t)NE1 * 512 * 1024 * 2, WO_END = WO_2 + (size_t)NE1 * 1024 * 256 * 2;
static_assert(WO_END <= 72 * MiB, "weights region");
constexpr size_t WS_H = 96 * MiB;
constexpr size_t WS_Y = 160 * MiB;
constexpr size_t WS_PROJ = 224 * MiB;
constexpr size_t WS_P = 224 * MiB;
constexpr size_t WS_SSDST = 368 * MiB;
constexpr size_t WS_SSDSIN = 400 * MiB;
constexpr size_t WS_KI2 = 408 * MiB, WS_K2 = 412 * MiB, WS_V2 = 416 * MiB;
constexpr size_t WS_YCPRE = 384 * MiB;
constexpr size_t WS_V16 = 224 * MiB;
constexpr size_t WS_ACT = 160 * MiB;
constexpr size_t WS_OPAIR = 321 * MiB;
static_assert(CH_ROWS % 256 == 0 && WS_ACT + (size_t)NCH * CH_ROWS * 512 <= WS_OPAIR && WS_OPAIR + (size_t)CH_ROWS * 2048 <= 512 * MiB, "moe buffers");
constexpr int CH_TILES = CH_ROWS / 256;
constexpr size_t WS_NEED = 512 * MiB;
constexpr int CW_BAR = 4096;
constexpr int CW_CNT = 16384;

constexpr int LDS_BYTES = 160 * 1024;
constexpr int LDS_TAB = 131072;
constexpr int LDS_MISC = LDS_BYTES - 256;

__device__ __forceinline__ unsigned f2bf(float f) { unsigned u = __builtin_bit_cast(unsigned, f); return (u + 0x7fffu + ((u >> 16) & 1u)) >> 16; }
__device__ __forceinline__ unsigned pk2(float lo, float hi) { return f2bf(lo) | (f2bf(hi) << 16); }
__device__ __forceinline__ float bf2f(unsigned short b) { return __builtin_bit_cast(float, (unsigned)b << 16); }
__device__ __forceinline__ float bflo(unsigned w) { return __builtin_bit_cast(float, w << 16); }
__device__ __forceinline__ float bfhi(unsigned w) { return __builtin_bit_cast(float, w & 0xffff0000u); }
__device__ __forceinline__ float wave_sum(float v) {
#pragma unroll
    for (int o = 1; o < 64; o <<= 1) v += __shfl_xor(v, o);
    return v;
}
__device__ __forceinline__ float wave_max(float v) {
#pragma unroll
    for (int o = 1; o < 64; o <<= 1) v = fmaxf(v, __shfl_xor(v, o));
    return v;
}
__device__ __forceinline__ int wave_sum_i(int v) {
#pragma unroll
    for (int o = 1; o < 64; o <<= 1) v += __shfl_xor(v, o);
    return v;
}
__device__ __forceinline__ float sigmoidf_(float x) { return __builtin_amdgcn_rcpf(1.0f + __expf(-x)); }
__device__ __forceinline__ float siluf_(float x) { return x * __builtin_amdgcn_rcpf(1.0f + __expf(-x)); }
__device__ __forceinline__ float gelu_tanh(float x) { const float u = 1.5957691216057308f * (x + 0.044715f * x * x * x); return x * __builtin_amdgcn_rcpf(1.0f + __expf(-u)); }
__device__ __forceinline__ float softplusf_(float x) { return fmaxf(x, 0.f) + log1pf(__expf(-fabsf(x))); }
__device__ __forceinline__ void sincos_red(float ang, float& sn, float& cs) {
    const double a = (double)ang; const double q = __builtin_rint(a * 0.63661977236758134308);
    const float r = (float)(a - q * 1.57079632679489661923); const int qi = (int)q & 3;
    const float r2 = r * r;
    const float s = r * (1.0f + r2 * (-1.6666667e-1f + r2 * (8.3333333e-3f + r2 * (-1.9841270e-4f + r2 * 2.7557319e-6f))));
    const float c = 1.0f + r2 * (-0.5f + r2 * (4.1666667e-2f + r2 * (-1.3888889e-3f + r2 * (2.4801587e-5f + r2 * -2.7557319e-7f))));
    sn = (qi == 0) ? s : (qi == 1) ? c : (qi == 2) ? -s : -c;
    cs = (qi == 0) ? c : (qi == 1) ? -s : (qi == 2) ? -c : s;
}
__device__ __forceinline__ f32x4 mfma16(bf16x8 a, bf16x8 b, f32x4 c) { return __builtin_amdgcn_mfma_f32_16x16x32_bf16(a, b, c, 0, 0, 0); }
__device__ __forceinline__ unsigned cvt_pk_bf16(float lo, float hi) { unsigned r; asm volatile("v_cvt_pk_bf16_f32 %0, %1, %2" : "=v"(r) : "v"(lo), "v"(hi)); return r; }

namespace pg8 {
constexpr int BM = 256, BK = 64, HALF = 128, HTB = HALF * BK * 2, STAGE_BYTES = 8 * HTB, NXCD = 8, WGM = 8;
__host__ __device__ __forceinline__ int lds_byte(int r, int c) { const int st = (r >> 4) * 2 + (c >> 5), rr = r & 15, cc = c & 31, ob = rr * 64 + cc * 2; return st * 1024 + (ob ^ (((ob >> 9) & 1) << 5)); }
__host__ __device__ __forceinline__ void stage_rc(int b, int& R, int& C) { const int st = b / 1024, sb = b % 1024, swz = sb ^ (((sb >> 9) & 1) << 5); R = (st >> 1) * 16 + swz / 64; C = (st & 1) * 32 + (swz % 64) / 2; }
__host__ __device__ __forceinline__ int perm32(int rho) { const int n = rho >> 4, i = rho & 15; return 8 * (i >> 2) + 4 * n + (i & 3); }

struct Unit { int pm, pn, bt, ab; };
struct Gemm { const bf16_t* A; const bf16_t* Bt; int K; size_t a_sel_stride; };

__device__ __forceinline__ int xcd_remap(int wgid, int nwg) { const int q = nwg / NXCD, r = nwg % NXCD, xcd = wgid % NXCD, off = wgid / NXCD; return (xcd < r ? xcd * (q + 1) : r * (q + 1) + (xcd - r) * q) + off; }

struct StaticOrder {
    static constexpr bool GATHER = false;
    int nM, nN, nwg, G, c;
    __device__ void init(int Mr, int N, int G_, int c_) { nM = Mr / BM; nN = N / BM; nwg = nM * nN; G = G_; c = c_; }
    __device__ __forceinline__ bool next(int i, Unit& u) const {
        const long L = (long)i * G + c; if (L >= nwg) return false;
        const int wgid = xcd_remap((int)L, nwg);
        const int nig = WGM * nN, gid = wgid / nig, fm = gid * WGM, gsz = (nM - fm) < WGM ? (nM - fm) : WGM;
        u.pm = fm + ((wgid % nig) % gsz); u.pn = (wgid % nig) / gsz; u.bt = u.pn; u.ab = 0; return true;
    }
    __device__ __forceinline__ void a_ready(const Unit&) const {}
    __device__ __forceinline__ void done(const Unit&) const {}
};

template <class Epi, class Sched, bool ALIGN_EPI = false, bool SP2 = true>
__device__ __forceinline__ void gemm_phase(LAS unsigned char* lds, const Gemm g, const Sched& S, const Epi& E, const int tid) {
    const int wid = __builtin_amdgcn_readfirstlane(tid >> 6), lane = tid & 63, wr = wid >> 2, wc = wid & 3, fr = lane & 15, fq = lane >> 4;
    const int K = g.K, nt = K / BK;
    unsigned voffA[2], voffB[2];
#pragma unroll
    for (int i = 0; i < 2; ++i) { int R, C; stage_rc(tid * 16 + i * 8192, R, C); const int Rb = Epi::PERM ? ((R & ~31) + perm32(R & 31)) : R;
        voffA[i] = (unsigned)(R * K + C) * 2u; voffB[i] = (unsigned)(Rb * K + C) * 2u; }
    const size_t kstep = (size_t)(BK * 2);
    const size_t hstep = (size_t)HALF * K * 2;
    const size_t tstep = 2 * hstep;
    const unsigned ldsw = (unsigned)wid * 1024u;
    const int aoff = lds_byte(wr * 64 + fr, fq * 8), boff = lds_byte(wc * 32 + fr, fq * 8);
#define PG8_SA(b, h) (((b) * 2 + (h)) * HTB)
#define PG8_SB(b, h) ((4 + (b) * 2 + (h)) * HTB)
#define PG8_STAGE(bufoff, gbase, voff) do { _Pragma("unroll") for (int _i = 0; _i < 2; ++_i) \
        __builtin_amdgcn_global_load_lds((const unsigned*)((const char*)(gbase) + (voff)[_i]), (LAS unsigned*)(lds + (bufoff) + ldsw + _i * 8192), 16, 0, 0); } while (0)
#define PG8_GO(u) do { _Pragma("unroll") for (int _h = 0; _h < 2; ++_h) _Pragma("unroll") for (int _i = 0; _i < 2; ++_i) { int _R, _C; stage_rc(tid * 16 + _i * 8192, _R, _C); \
        cgo[_h][_i] = (unsigned)S.row_of(u, _h * HALF + _R) * (unsigned)(K * 2) + (unsigned)_C * 2u; } } while (0)
#define PG8_STAGE_A(bufoff, base, h, kb, NX) do { if constexpr (Sched::GATHER) { _Pragma("unroll") for (int _i = 0; _i < 2; ++_i) \
        __builtin_amdgcn_global_load_lds((const unsigned*)((const char*)g.A + (kb) + cgo[h][_i]), (LAS unsigned*)(lds + (bufoff) + ldsw + _i * 8192), 16, 0, 0); } \
        else { PG8_STAGE(bufoff, (base) + (size_t)(h) * hstep + (kb), voffA); } } while (0)
#define PG8_LDA(dst, b, h) do { _Pragma("unroll") for (int m = 0; m < 4; ++m) _Pragma("unroll") for (int k = 0; k < 2; ++k) dst[m][k] = *(const LAS bf16x8*)(lds + PG8_SA(b, h) + aoff + m * 2048 + k * 1024); } while (0)
#define PG8_LDB(dst, b, h) do { _Pragma("unroll") for (int n = 0; n < 2; ++n) _Pragma("unroll") for (int k = 0; k < 2; ++k) dst[n][k] = *(const LAS bf16x8*)(lds + PG8_SB(b, h) + boff + n * 2048 + k * 1024); } while (0)
#define PG8_MMA(ai, bj, At, Bt) do { __builtin_amdgcn_s_setprio(1); _Pragma("unroll") for (int m = 0; m < 4; ++m) _Pragma("unroll") for (int n = 0; n < 2; ++n) _Pragma("unroll") for (int k = 0; k < 2; ++k) \
        acc[ai][bj][m][n] = __builtin_amdgcn_mfma_f32_16x16x32_bf16(Bt[n][k], At[m][k], acc[ai][bj][m][n], 0, 0, 0); __builtin_amdgcn_s_setprio(0); } while (0)
#define PG8_WAIT_V(n) asm volatile("s_waitcnt vmcnt(" #n ")" ::: "memory")
#define PG8_WAIT_L(n) asm volatile("s_waitcnt lgkmcnt(" #n ")" ::: "memory")
#define PG8_BAR __builtin_amdgcn_s_barrier()
#define PG8_SCHED __builtin_amdgcn_sched_barrier(0)
    Unit cur, nxt; int ui = 0;
    if (!S.next(0, cur)) return;
    f32x4 acc[2][2][4][2];
#pragma unroll
    for (int a = 0; a < 2; ++a)
#pragma unroll
        for (int b = 0; b < 2; ++b)
#pragma unroll
            for (int m = 0; m < 4; ++m)
#pragma unroll
                for (int n = 0; n < 2; ++n) acc[a][b][m][n] = (f32x4){0.f, 0.f, 0.f, 0.f};
    bf16x8 At[4][2], B0[2][2], B1[2][2];
    unsigned cgo[2][2];
    if constexpr (Sched::GATHER) PG8_GO(cur);
    const char* cA = (const char*)(g.A + (size_t)cur.ab * g.a_sel_stride) + (size_t)cur.pm * tstep; const char* cB = (const char*)g.Bt + (size_t)cur.bt * tstep;
    S.a_ready(cur);
    if constexpr (SP2) {
        PG8_STAGE(PG8_SB(0, 0), cB, voffB); PG8_STAGE(PG8_SB(0, 1), cB + hstep, voffB); PG8_STAGE_A(PG8_SA(0, 0), cA, 0, (size_t)0, false); PG8_STAGE_A(PG8_SA(0, 1), cA, 1, (size_t)0, false);
        if (wr == 1) PG8_BAR;
        PG8_WAIT_V(2); PG8_BAR;
        PG8_STAGE(PG8_SB(1, 0), cB + kstep, voffB); PG8_STAGE_A(PG8_SA(1, 0), cA, 0, kstep, false); PG8_STAGE(PG8_SB(1, 1), cB + hstep + kstep, voffB);
        PG8_WAIT_V(6); PG8_BAR;
    } else {
        PG8_STAGE(PG8_SB(0, 0), cB, voffB); PG8_STAGE_A(PG8_SA(0, 0), cA, 0, (size_t)0, false); PG8_STAGE(PG8_SB(0, 1), cB + hstep, voffB); PG8_STAGE_A(PG8_SA(0, 1), cA, 1, (size_t)0, false);
        if (wr == 1) PG8_BAR;
        PG8_WAIT_V(4); PG8_BAR;
        PG8_STAGE(PG8_SB(1, 0), cB + kstep, voffB); PG8_STAGE_A(PG8_SA(1, 0), cA, 0, kstep, false); PG8_STAGE(PG8_SB(1, 1), cB + hstep + kstep, voffB);
        PG8_WAIT_V(6); PG8_BAR;
    }
    for (;;) {
        const bool has_next = S.next(ui + 1, nxt);
        const char* nA = has_next ? (const char*)(g.A + (size_t)nxt.ab * g.a_sel_stride) + (size_t)nxt.pm * tstep : cA; const char* nB = has_next ? (const char*)g.Bt + (size_t)nxt.bt * tstep : cB;
#pragma nounroll
        for (int t = 0; t < nt; t += 2) {
            const bool last = (t == nt - 2);
            const size_t k1 = (size_t)(t + 1) * kstep;
            const char* a2b = last ? nA : cA; const size_t k2 = last ? (size_t)0 : (size_t)(t + 2) * kstep; const size_t k3 = k2 + kstep;
            const char* b2 = last ? nB : cB + (size_t)(t + 2) * kstep; const char* b3 = b2 + kstep;
            if (last && has_next) S.a_ready(nxt);
            if constexpr (SP2) {
            PG8_LDB(B0, 0, 0); PG8_LDB(B1, 0, 1); PG8_SCHED; PG8_LDA(At, 0, 0); PG8_STAGE_A(PG8_SA(1, 1), cA, 1, k1, false);
            if constexpr (Sched::GATHER) { if (last && has_next) PG8_GO(nxt); }
            PG8_WAIT_V(8); PG8_WAIT_L(0); PG8_BAR; PG8_MMA(0, 0, At, B0); PG8_MMA(0, 1, At, B1); PG8_BAR; PG8_SCHED;
            PG8_LDA(At, 0, 1); PG8_STAGE(PG8_SB(0, 0), b2, voffB); PG8_STAGE(PG8_SB(0, 1), b2 + hstep, voffB); PG8_STAGE_A(PG8_SA(0, 0), a2b, 0, k2, last);
            PG8_WAIT_V(8); PG8_WAIT_L(0); PG8_BAR; PG8_MMA(1, 0, At, B0); PG8_MMA(1, 1, At, B1); PG8_BAR; PG8_SCHED;
            PG8_LDB(B0, 1, 0); PG8_LDB(B1, 1, 1); PG8_SCHED; PG8_LDA(At, 1, 0); PG8_STAGE_A(PG8_SA(0, 1), a2b, 1, k2, last);
            PG8_WAIT_V(8); PG8_WAIT_L(0); PG8_BAR; PG8_MMA(0, 0, At, B0); PG8_MMA(0, 1, At, B1); PG8_BAR; PG8_SCHED;
            PG8_LDA(At, 1, 1); PG8_STAGE(PG8_SB(1, 0), b3, voffB); PG8_STAGE(PG8_SB(1, 1), b3 + hstep, voffB); PG8_STAGE_A(PG8_SA(1, 0), a2b, 0, k3, last);
            PG8_WAIT_V(8); PG8_WAIT_L(0); PG8_BAR; PG8_MMA(1, 0, At, B0); PG8_MMA(1, 1, At, B1); PG8_BAR; PG8_SCHED;
            } else {
            PG8_LDB(B0, 0, 0); PG8_SCHED; PG8_LDA(At, 0, 0); PG8_STAGE_A(PG8_SA(1, 1), cA, 1, k1, false);
            if constexpr (Sched::GATHER) { if (last && has_next) PG8_GO(nxt); }
            PG8_WAIT_L(8); PG8_BAR; PG8_WAIT_L(0); PG8_MMA(0, 0, At, B0); PG8_BAR; PG8_SCHED;
            PG8_LDB(B1, 0, 1); PG8_STAGE(PG8_SB(0, 0), b2, voffB);
            PG8_BAR; PG8_WAIT_L(0); PG8_MMA(0, 1, At, B1); PG8_BAR;
            PG8_LDA(At, 0, 1); PG8_STAGE_A(PG8_SA(0, 0), a2b, 0, k2, last);
            PG8_BAR; PG8_WAIT_L(0); PG8_MMA(1, 0, At, B0); PG8_BAR; PG8_SCHED;
            PG8_STAGE(PG8_SB(0, 1), b2 + hstep, voffB);
            PG8_WAIT_V(6); PG8_BAR; PG8_MMA(1, 1, At, B1); PG8_BAR;
            PG8_LDB(B0, 1, 0); PG8_SCHED; PG8_LDA(At, 1, 0); PG8_STAGE_A(PG8_SA(0, 1), a2b, 1, k2, last);
            PG8_WAIT_L(8); PG8_BAR; PG8_WAIT_L(0); PG8_MMA(0, 0, At, B0); PG8_BAR; PG8_SCHED;
            PG8_LDB(B1, 1, 1); PG8_STAGE(PG8_SB(1, 0), b3, voffB);
            PG8_BAR; PG8_WAIT_L(0); PG8_MMA(0, 1, At, B1); PG8_BAR;
            PG8_LDA(At, 1, 1); PG8_STAGE_A(PG8_SA(1, 0), a2b, 0, k3, last);
            PG8_BAR; PG8_WAIT_L(0); PG8_MMA(1, 0, At, B0); PG8_BAR; PG8_SCHED;
            PG8_STAGE(PG8_SB(1, 1), b3 + hstep, voffB);
            PG8_WAIT_V(6); PG8_BAR; PG8_MMA(1, 1, At, B1); PG8_BAR;
            }
        }
        if constexpr (ALIGN_EPI) { if (wr == 0) PG8_BAR; }
        E(acc, cur, wr, wc, fr, fq); S.done(cur);
        if (!has_next) break;
#pragma unroll
        for (int a = 0; a < 2; ++a)
#pragma unroll
            for (int b = 0; b < 2; ++b)
#pragma unroll
                for (int m = 0; m < 4; ++m)
#pragma unroll
                    for (int n = 0; n < 2; ++n) acc[a][b][m][n] = (f32x4){0.f, 0.f, 0.f, 0.f};
        cur = nxt; cA = nA; cB = nB; ++ui;
        if constexpr (ALIGN_EPI) { if (wr == 1) PG8_BAR; }
    }
    PG8_WAIT_V(0);
    if constexpr (!ALIGN_EPI) { if (wr == 0) PG8_BAR; }
    PG8_BAR;
#undef PG8_SA
#undef PG8_SB
#undef PG8_STAGE
#undef PG8_STAGE_A
#undef PG8_GO
#undef PG8_LDA
#undef PG8_LDB
#undef PG8_MMA
#undef PG8_WAIT_V
#undef PG8_WAIT_L
#undef PG8_BAR
#undef PG8_SCHED
}

struct EpiBf16 {
    static constexpr bool PERM = true;
    bf16_t* O; int ldc;
    __device__ __forceinline__ void operator()(const f32x4 (&acc)[2][2][4][2], const Unit& u, int wr, int wc, int fr, int fq) const {
        const int row0 = u.pm * BM + wr * 64 + fr, col0 = u.pn * BM + wc * 32 + 8 * fq;
#pragma unroll
        for (int ai = 0; ai < 2; ++ai)
#pragma unroll
            for (int m = 0; m < 4; ++m) { bf16_t* rowp = O + (size_t)(row0 + ai * HALF + m * 16) * ldc + col0;
#pragma unroll
                for (int bj = 0; bj < 2; ++bj) { const f32x4 v0 = acc[ai][bj][m][0], v1 = acc[ai][bj][m][1];
                    u32x4 w; w.x = cvt_pk_bf16(v0[0], v0[1]); w.y = cvt_pk_bf16(v0[2], v0[3]); w.z = cvt_pk_bf16(v1[0], v1[1]); w.w = cvt_pk_bf16(v1[2], v1[3]);
                    *(u32x4*)(rowp + bj * HALF) = w; } }
    }
};
struct EpiGlu {
    static constexpr bool PERM = true;
    const bf16_t* Ysrc; bf16_t* O; const float* bias;
    __device__ __forceinline__ void operator()(const f32x4 (&acc)[2][2][4][2], const Unit& u, int wr, int wc, int fr, int fq) const {
        const int row0 = u.pm * BM + wr * 64 + fr, col0 = u.pn * BM + wc * 32 + 8 * fq;
#pragma unroll
        for (int ai = 0; ai < 2; ++ai)
#pragma unroll
            for (int m = 0; m < 4; ++m) { const size_t ro = (size_t)(row0 + ai * HALF + m * 16) * 256 + col0;
#pragma unroll
                for (int bj = 0; bj < 2; ++bj) { const f32x4 v0 = acc[ai][bj][m][0], v1 = acc[ai][bj][m][1];
                    const u32x4 yv = *(const u32x4*)(Ysrc + ro + bj * HALF);
                    const f32x4 b0 = *(const f32x4*)(bias + col0 + bj * HALF), b1 = *(const f32x4*)(bias + col0 + bj * HALF + 4);
                    float o[8];
                    o[0] = bflo(yv.x) * sigmoidf_(v0[0] + b0[0]); o[1] = bfhi(yv.x) * sigmoidf_(v0[1] + b0[1]); o[2] = bflo(yv.y) * sigmoidf_(v0[2] + b0[2]); o[3] = bfhi(yv.y) * sigmoidf_(v0[3] + b0[3]);
                    o[4] = bflo(yv.z) * sigmoidf_(v1[0] + b1[0]); o[5] = bfhi(yv.z) * sigmoidf_(v1[1] + b1[1]); o[6] = bflo(yv.w) * sigmoidf_(v1[2] + b1[2]); o[7] = bfhi(yv.w) * sigmoidf_(v1[3] + b1[3]);
                    u32x4 w; w.x = cvt_pk_bf16(o[0], o[1]); w.y = cvt_pk_bf16(o[2], o[3]); w.z = cvt_pk_bf16(o[4], o[5]); w.w = cvt_pk_bf16(o[6], o[7]);
                    *(u32x4*)(O + ro + bj * HALF) = w; } }
    }
};
struct EpiGateMerge {
    static constexpr bool PERM = true;
    const bf16_t* P; bf16_t* Mg;
    __device__ __forceinline__ void operator()(const f32x4 (&acc)[2][2][4][2], const Unit& u, int wr, int wc, int fr, int fq) const {
        const int i = u.pn >> 2, mt = u.pn & 3;
        const int row0 = u.pm * BM + wr * 64 + fr, col0 = mt * BM + wc * 32 + 8 * fq;
#pragma unroll
        for (int ai = 0; ai < 2; ++ai) {
            u32x4 pv[4][2], mv[4][2];
#pragma unroll
            for (int m = 0; m < 4; ++m)
#pragma unroll
                for (int bj = 0; bj < 2; ++bj) { const size_t r = (size_t)(row0 + ai * HALF + m * 16);
                    pv[m][bj] = *(const u32x4*)(P + r * 4096 + i * 1024 + col0 + bj * HALF);
                    mv[m][bj] = (u32x4){0u, 0u, 0u, 0u}; if (i > 0) mv[m][bj] = *(const u32x4*)(Mg + r * 1024 + col0 + bj * HALF); }
#pragma unroll
            for (int m = 0; m < 4; ++m)
#pragma unroll
                for (int bj = 0; bj < 2; ++bj) { const size_t r = (size_t)(row0 + ai * HALF + m * 16); const f32x4 v0 = acc[ai][bj][m][0], v1 = acc[ai][bj][m][1]; const u32x4 p4 = pv[m][bj], m4 = mv[m][bj];
                    float o[8];
                    o[0] = bflo(m4.x) + bflo(p4.x) * sigmoidf_(v0[0]); o[1] = bfhi(m4.x) + bfhi(p4.x) * sigmoidf_(v0[1]); o[2] = bflo(m4.y) + bflo(p4.y) * sigmoidf_(v0[2]); o[3] = bfhi(m4.y) + bfhi(p4.y) * sigmoidf_(v0[3]);
                    o[4] = bflo(m4.z) + bflo(p4.z) * sigmoidf_(v1[0]); o[5] = bfhi(m4.z) + bfhi(p4.z) * sigmoidf_(v1[1]); o[6] = bflo(m4.w) + bflo(p4.w) * sigmoidf_(v1[2]); o[7] = bfhi(m4.w) + bfhi(p4.w) * sigmoidf_(v1[3]);
                    u32x4 w; w.x = cvt_pk_bf16(o[0], o[1]); w.y = cvt_pk_bf16(o[2], o[3]); w.z = cvt_pk_bf16(o[4], o[5]); w.w = cvt_pk_bf16(o[6], o[7]);
                    *(u32x4*)(Mg + r * 1024 + col0 + bj * HALF) = w; }
        }
    }
};
struct EpiResid {
    static constexpr bool PERM = false;
    const float* xin; bf16_t* out; const float* gate;
    __device__ __forceinline__ void operator()(const f32x4 (&acc)[2][2][4][2], const Unit& u, int wr, int wc, int fr, int fq) const {
        const int row0 = u.pm * BM + wr * 64 + fr, col0 = u.pn * BM + wc * 32 + 4 * fq;
        const int b = (u.pm * BM) / SEQ;
        f32x4 gv[2][2];
#pragma unroll
        for (int bj = 0; bj < 2; ++bj)
#pragma unroll
            for (int n = 0; n < 2; ++n) gv[bj][n] = *(const f32x4*)(gate + b * 3072 + 2048 + col0 + bj * HALF + n * 16) + 1.0f;
#pragma unroll
        for (int ai = 0; ai < 2; ++ai)
#pragma unroll
            for (int mh = 0; mh < 4; mh += 2) {
                f32x4 xv[2][2][2];
#pragma unroll
                for (int m = 0; m < 2; ++m)
#pragma unroll
                    for (int bj = 0; bj < 2; ++bj)
#pragma unroll
                        for (int n = 0; n < 2; ++n) xv[m][bj][n] = *(const f32x4*)(xin + (size_t)(row0 + ai * HALF + (mh + m) * 16) * D + col0 + bj * HALF + n * 16);
#pragma unroll
                for (int m = 0; m < 2; ++m)
#pragma unroll
                    for (int bj = 0; bj < 2; ++bj)
#pragma unroll
                        for (int n = 0; n < 2; ++n) { const f32x4 v = xv[m][bj][n] * DN_ALPHA + gv[bj][n] * acc[ai][bj][mh + m][n];
                            u32x2 w; w.x = cvt_pk_bf16(v[0], v[1]); w.y = cvt_pk_bf16(v[2], v[3]);
                            *(u32x2*)(out + (size_t)(row0 + ai * HALF + (mh + m) * 16) * D + col0 + bj * HALF + n * 16) = w; } }
    }
};
struct EpiMoe1 {
    static constexpr bool PERM = false;
    bf16_t* Act; const float* rowgate;
    __device__ __forceinline__ void operator()(const f32x4 (&acc)[2][2][4][2], const Unit& u, int wr, int wc, int fr, int fq) const {
        const int row0 = u.pm * BM + wr * 64 + fr, f0 = u.pn * 128 + wc * 16 + 4 * fq;
#pragma unroll
        for (int ai = 0; ai < 2; ++ai)
#pragma unroll
            for (int m = 0; m < 4; ++m) { const int r = row0 + ai * HALF + m * 16; const float gt = rowgate[r];
#pragma unroll
                for (int bj = 0; bj < 2; ++bj) { const f32x4 a = acc[ai][bj][m][0], b = acc[ai][bj][m][1];
                    u32x2 w; w.x = cvt_pk_bf16(siluf_(a[0]) * b[0] * gt, siluf_(a[1]) * b[1] * gt); w.y = cvt_pk_bf16(siluf_(a[2]) * b[2] * gt, siluf_(a[3]) * b[3] * gt);
                    *(u32x2*)(Act + (size_t)r * 256 + f0 + bj * 64) = w; } }
    }
};
}

#define XB_TMO      128
#define XB_XCNT(j)  (256  + 64 * (j))
#define XB_XSUB(j)  (1280 + 64 * (j))
#define XB_XGEN(j)  (2304 + 64 * (j))
#define XB_TOP      3328
#define XB_TOPGEN   3392
#define XCD_BAR_WORDS 3456
#define XB_SPIN_CAP (1u << 22)
__device__ __forceinline__ unsigned xb_ld(unsigned* p)              { return __hip_atomic_load(p, __ATOMIC_RELAXED, __HIP_MEMORY_SCOPE_AGENT); }
__device__ __forceinline__ unsigned xb_add(unsigned* p, unsigned v) { return __hip_atomic_fetch_add(p, v, __ATOMIC_RELAXED, __HIP_MEMORY_SCOPE_AGENT); }
__device__ __forceinline__ unsigned xb_xcc_id() { return (unsigned)__builtin_amdgcn_s_getreg((3 << 11) | 20) & 0xFu; }
#define XB_SPIN(cond, bar) do { unsigned _sp = 0; while (cond) { __builtin_amdgcn_s_sleep(1); \
    if ((++_sp & 255u) == 0u) { if (xb_ld(&(bar)[XB_TMO])) break; if (_sp > XB_SPIN_CAP) { atomicAdd(&(bar)[XB_TMO], 1u); break; } } } } while (0)
struct XcdBarrier { unsigned* bar; unsigned x; volatile LAS unsigned* st; };
__device__ __forceinline__ XcdBarrier xcd_barrier_post(unsigned* bar, volatile LAS unsigned* st) {
    XcdBarrier b; b.bar = bar; b.x = xb_xcc_id(); b.st = st;
    if (threadIdx.x == 0) (void)xb_add(&bar[XB_XCNT(b.x)], 1u);
    return b;
}
__device__ __forceinline__ void xcd_barrier_complete(unsigned* bar, unsigned x, unsigned& nloc, unsigned& nx) {
    const unsigned G = gridDim.x * gridDim.y * gridDim.z;
    unsigned sum, cnt, mine, sp = 0u;
    for (;;) {
        sum = 0u; cnt = 0u; mine = 0u;
#pragma unroll
        for (unsigned j = 0; j < 16; ++j) { const unsigned c = xb_ld(&bar[XB_XCNT(j)]); sum += c; cnt += (c > 0u) ? 1u : 0u; mine = (j == x) ? c : mine; }
        if (sum == G) break;
        __builtin_amdgcn_s_sleep(1);
        if ((++sp & 255u) == 0u) { if (xb_ld(&bar[XB_TMO])) break; if (sp > XB_SPIN_CAP) { atomicAdd(&bar[XB_TMO], 1u); break; } }
    }
    nloc = mine > 0u ? mine : 1u; nx = cnt > 0u ? cnt : 1u;
}
__device__ __forceinline__ void xcd_barrier(const XcdBarrier& b) {
    asm volatile("s_waitcnt vmcnt(0)" ::: "memory");
    __syncthreads();
    if (threadIdx.x == 0) {
        unsigned* bar = b.bar;
        __builtin_amdgcn_s_waitcnt(0);
        unsigned nloc = b.st[0], nx = b.st[1];
        if (nloc == 0u) { xcd_barrier_complete(bar, b.x, nloc, nx); b.st[0] = nloc; b.st[1] = nx; }
        const unsigned old = xb_add(&bar[XB_XSUB(b.x)], 1u);
        const unsigned gen = old / nloc;
        if (old + 1u == (gen + 1u) * nloc) {
            __builtin_amdgcn_fence(__ATOMIC_RELEASE, "agent");
            asm volatile("s_waitcnt vmcnt(0)" ::: "memory");
            const unsigned og = xb_add(&bar[XB_TOP], 1u);
            const unsigned tg = og / nx;
            if (og + 1u == (tg + 1u) * nx) xb_add(&bar[XB_TOPGEN], 1u);
            else XB_SPIN(xb_ld(&bar[XB_TOPGEN]) == tg, bar);
            __builtin_amdgcn_fence(__ATOMIC_ACQUIRE, "agent");
            xb_add(&bar[XB_XGEN(b.x)], 1u);
            asm volatile("s_waitcnt vmcnt(0)" ::: "memory");
        } else {
            XB_SPIN(xb_ld(&bar[XB_XGEN(b.x)]) == gen, bar);
            __builtin_amdgcn_fence(__ATOMIC_ACQUIRE, "agent");
            asm volatile("s_waitcnt vmcnt(0)" ::: "memory");
        }
    }
    __syncthreads();
}

struct Args {
    const float* in[43]; const int* positions; float* out; unsigned char* ws; int ph_lo, ph_hi, dbg, pad;
};
enum { I_X = 0, I_C = 1, I_POS = 2, I_MOD1W = 3, I_MOD1B = 4, I_WIN = 5, I_GMLNG = 6, I_GMLNB = 7, I_GMW = 8, I_GMB = 9,
       I_S5LRE = 10, I_S5LIM = 11, I_S5STEP = 12, I_S5BRE = 13, I_S5BIM = 14, I_S5CRE = 15, I_S5CIM = 16, I_S5D = 17, I_S5GLUW = 18, I_S5GLUB = 19,
       I_CONVW = 20, I_CONVB = 21, I_DTBIAS = 22, I_ALOG = 23, I_SSDD = 24, I_SSDNG = 25, I_WBR = 26, I_WGATE = 27, I_WOUT = 28, I_LN1G = 29, I_LN1B = 30,
       I_MOD2W = 31, I_MOD2B = 32, I_RW = 33, I_RB = 34, I_EW1 = 35, I_EW3 = 36, I_EW2 = 37, I_SW1 = 38, I_SW3 = 39, I_SW2 = 40, I_LN2G = 41, I_LN2B = 42 };

typedef const __attribute__((address_space(4))) Args* ArgsP;
struct Ctx {
    ArgsP a; unsigned char* ws; LAS unsigned char* lds; int tid, lane, wave, c, G, bx, dbg;
    __device__ __forceinline__ const float* in(int i) const { return a->in[i]; }
    __device__ __forceinline__ bf16_t* proj() const { return (bf16_t*)(ws + WS_PROJ); }
    __device__ __forceinline__ bf16_t* hbuf() const { return (bf16_t*)(ws + WS_H); }
    __device__ __forceinline__ bf16_t* ybuf() const { return (bf16_t*)(ws + WS_Y); }
    __device__ __forceinline__ float* modv(int l, int w) const { return (float*)(ws + WS_MODV) + (size_t)(l * 2 + w) * NB * 3072; }
};

__device__ __forceinline__ void ph_prologue(const Ctx& X) {
    LAS float* red = (LAS float*)X.lds;
    for (int it = X.c; it < DEPTH * 2 * 48; it += X.G) {
        const int l = it / 96, w = (it / 48) & 1, jb = it % 48, j = jb * 64 + X.lane;
        const float* W = X.in(w ? I_MOD2W : I_MOD1W) + (size_t)l * D * 3072; const float* cv = X.in(I_C);
        float a0 = 0.f, a1 = 0.f, a2 = 0.f, a3 = 0.f;
        const int k0 = X.wave * 128;
        for (int k = k0; k < k0 + 128; ++k) { const float wv = W[(size_t)k * 3072 + j]; a0 += cv[k] * wv; a1 += cv[D + k] * wv; a2 += cv[2 * D + k] * wv; a3 += cv[3 * D + k] * wv; }
        red[(X.wave * 4 + 0) * 64 + X.lane] = a0; red[(X.wave * 4 + 1) * 64 + X.lane] = a1; red[(X.wave * 4 + 2) * 64 + X.lane] = a2; red[(X.wave * 4 + 3) * 64 + X.lane] = a3;
        __syncthreads();
        if (X.tid < 256) { const int b = X.tid >> 6, ln = X.tid & 63; float s = 0.f;
#pragma unroll
            for (int q = 0; q < 8; ++q) s += red[(q * 4 + b) * 64 + ln];
            const int jj = jb * 64 + ln; X.modv(l, w)[b * 3072 + jj] = s + X.in(w ? I_MOD2B : I_MOD1B)[(size_t)l * 3072 + jj]; }
        __syncthreads();
    }
}

template <class Src>
__device__ __forceinline__ void tr_item(const Src& src, bf16_t* WT, int K, int rowbase, int kb, int nb, LAS float* scr, int lane) {
    const int k0 = 64 * kb, n0 = 32 * nb;
    f32x4 v[8];
#pragma unroll
    for (int i = 0; i < 8; ++i) v[i] = src.load4(k0 + 8 * i + (lane >> 3), n0 + 4 * (lane & 7));
#pragma unroll
    for (int i = 0; i < 8; ++i) { LAS float* d = scr + (8 * i + (lane >> 3)) * 33 + 4 * (lane & 7); d[0] = v[i][0]; d[1] = v[i][1]; d[2] = v[i][2]; d[3] = v[i][3]; }
    asm volatile("s_waitcnt lgkmcnt(0)" ::: "memory");
    const int c = lane & 7;
#pragma unroll
    for (int j = 0; j < 4; ++j) { const int n = (lane >> 3) + 8 * j; const LAS float* s = scr + (8 * c) * 33 + n;
        u32x4 o; o.x = pk2(s[0 * 33], s[1 * 33]); o.y = pk2(s[2 * 33], s[3 * 33]); o.z = pk2(s[4 * 33], s[5 * 33]); o.w = pk2(s[6 * 33], s[7 * 33]);
        *(u32x4*)(WT + (size_t)(rowbase + n0 + n) * K + k0 + 8 * c) = o; }
    asm volatile("s_waitcnt lgkmcnt(0)" ::: "memory");
}
struct SrcPlain { const float* W; int N; __device__ __forceinline__ f32x4 load4(int k, int n) const { return *(const f32x4*)(W + (size_t)k * N + n); } };
struct SrcWin { const float* W; __device__ __forceinline__ f32x4 load4(int k, int n) const {
    if (n >= D_IN) return (f32x4){0.f, 0.f, 0.f, 0.f}; const int o = (n < 1216) ? n : (n < 2240) ? n + 4 : (n < 2244) ? 1216 + (n - 2240) : n; return *(const f32x4*)(W + (size_t)k * D_IN + o); } };
struct Src13 { const float* W1; const float* W3; __device__ __forceinline__ f32x4 load4(int k, int n) const {
    const int f = (n >> 5) * 16 + (n & 15); const long d = (n & 16) ? (long)(W3 - W1) : 0l; return *(const f32x4*)(W1 + d + (long)k * 256 + f); } };

__device__ __forceinline__ void ph_wconv(const Ctx& X, int l) {
    LAS float* scr = (LAS float*)(X.lds + X.wave * 16384);
    unsigned char* wb = X.ws + WS_W;
    const int gw = X.c * 8 + X.wave, NGW = X.G * 8;
    constexpr int I_A = 16 * 72, I_B = 4 * 16 * 32, I_C2 = 4 * 4 * 32, I_D = 16 * 32, I_E = 4 * 8, I_F = NE1 * 16 * 16, I_G = NE1 * 4 * 32;
    constexpr int NIT = I_A + I_B + I_C2 + I_D + I_E + I_F + I_G;
    for (int it = gw; it < NIT; it += NGW) {
        int r = it;
        if (r < I_A) { SrcWin s{X.in(I_WIN) + (size_t)l * D * D_IN}; tr_item(s, (bf16_t*)(wb + WO_IN), 1024, 0, r / 72, r % 72, scr, X.lane); continue; } r -= I_A;
        if (r < I_B) { const int i = r / 512, q = r % 512; SrcPlain s{X.in(I_WGATE) + ((size_t)l * 4 + i) * D * D, D}; tr_item(s, (bf16_t*)(wb + WO_GATE), 1024, i * 1024, q / 32, q % 32, scr, X.lane); continue; } r -= I_B;
        if (r < I_C2) { const int i = r / 128, q = r % 128; SrcPlain s{X.in(I_WBR) + ((size_t)l * 4 + i) * 256 * D, D}; tr_item(s, (bf16_t*)(wb + WO_BR) + (size_t)i * 1024 * 256, 256, 0, q / 32, q % 32, scr, X.lane); continue; } r -= I_C2;
        if (r < I_D) { SrcPlain s{X.in(I_WOUT) + (size_t)l * D * D, D}; tr_item(s, (bf16_t*)(wb + WO_OUT), 1024, 0, r / 32, r % 32, scr, X.lane); continue; } r -= I_D;
        if (r < I_E) { SrcPlain s{X.in(I_S5GLUW) + (size_t)l * 256 * 256, 256}; tr_item(s, (bf16_t*)(wb + WO_GLU), 256, 0, r / 8, r % 8, scr, X.lane); continue; } r -= I_E;
        if (r < I_F) { const int e = r / 256, q = r % 256;
            const Src13 s{(e < NEXP) ? X.in(I_EW1) + ((size_t)l * NEXP + e) * D * 256 : X.in(I_SW1) + (size_t)l * D * 256, (e < NEXP) ? X.in(I_EW3) + ((size_t)l * NEXP + e) * D * 256 : X.in(I_SW3) + (size_t)l * D * 256};
            tr_item(s, (bf16_t*)(wb + WO_13) + (size_t)e * 512 * 1024, 1024, 0, q / 16, q % 16, scr, X.lane); continue; } r -= I_F;
        { const int e = r / 128, q = r % 128; SrcPlain s{e < NEXP ? X.in(I_EW2) + ((size_t)l * NEXP + e) * 256 * D : X.in(I_SW2) + (size_t)l * 256 * D, D};
            tr_item(s, (bf16_t*)(wb + WO_2) + (size_t)e * 1024 * 256, 256, 0, q / 32, q % 32, scr, X.lane); }
    }
    const int gt = X.c * 512 + X.tid, NGT = X.G * 512;
    { bf16_t* gmw = (bf16_t*)(X.ws + WS_GMW); const float* src = X.in(I_GMW) + (size_t)l * 4 * 128 * 128;
      for (int i = gt; i < 4 * 128 * 128; i += NGT) { const int t = (i >> 7) & 127, s = i & 127; gmw[i] = (bf16_t)f2bf(s <= t ? src[i] : 0.f); } }
    for (int i = gt; i < 16 * 64; i += NGT) {
        const int g = i >> 6, p = i & 63;
        const float step = expf(X.in(I_S5STEP)[l * 16 + g]); const float lr = X.in(I_S5LRE)[(size_t)l * 1024 + i], li = X.in(I_S5LIM)[(size_t)l * 1024 + i];
        const float mag = expf(lr * step); float sn, cs; sincos_red(li * step, sn, cs);
        const float abr = mag * cs, abi = mag * sn, den = lr * lr + li * li, nr = abr - 1.0f;
        const float cr = (nr * lr + abi * li) / den, ci = (abi * lr - nr * li) / den;
        float* sa = (float*)(X.ws + WS_S5A); sa[i * 2] = abr; sa[i * 2 + 1] = abi;
        bf16_t* bb = (bf16_t*)(X.ws + WS_S5B); bf16_t* cm = (bf16_t*)(X.ws + WS_S5C);
        const float* bre = X.in(I_S5BRE) + ((size_t)l * 1024 + i) * 16; const float* bim = X.in(I_S5BIM) + ((size_t)l * 1024 + i) * 16;
#pragma unroll
        for (int ch = 0; ch < 16; ++ch) { const float br = bre[ch], bi = bim[ch];
            bb[(g * 128 + p) * 16 + ch] = (bf16_t)f2bf(cr * br - ci * bi); bb[(g * 128 + 64 + p) * 16 + ch] = (bf16_t)f2bf(cr * bi + ci * br);
            cm[(g * 16 + ch) * 128 + p] = (bf16_t)f2bf(X.in(I_S5CRE)[(((size_t)l * 16 + g) * 16 + ch) * 64 + p]);
            cm[(g * 16 + ch) * 128 + 64 + p] = (bf16_t)f2bf(-X.in(I_S5CIM)[(((size_t)l * 16 + g) * 16 + ch) * 64 + p]); }
    }
    { bf16_t* rf = (bf16_t*)(X.ws + WS_RFR); const float* rw = X.in(I_RW) + (size_t)l * D * NEXP;
      for (int i = gt; i < 2 * 32 * 64 * 8; i += NGT) { const int j = i & 7, ln = (i >> 3) & 63, ks = (i >> 9) & 31, rt = i >> 14;
          const float v = rw[(size_t)(ks * 32 + 8 * (ln >> 4) + j) * NEXP + rt * 16 + (ln & 15)]; const unsigned hi = f2bf(v); const float lo = v - bflo(hi);
          rf[i] = (bf16_t)hi; rf[32768 + i] = (bf16_t)f2bf(lo); } }
    if (l == 0) {
        const float* x = X.in(I_X); bf16_t* h = X.hbuf(); const float* mv = X.modv(0, 0);
        for (size_t i = (size_t)gt; i < (size_t)M * D / 8; i += NGT) {
            const size_t e = i * 8; const int col = (int)(e & 1023), b = (int)(e >> 23);
            const f32x4 x0 = *(const f32x4*)(x + e), x1 = *(const f32x4*)(x + e + 4);
            const f32x4 sh0 = *(const f32x4*)(mv + b * 3072 + col), sh1 = *(const f32x4*)(mv + b * 3072 + col + 4), sc0 = *(const f32x4*)(mv + b * 3072 + 1024 + col), sc1 = *(const f32x4*)(mv + b * 3072 + 1024 + col + 4);
            const f32x4 h0 = x0 * (sc0 + 1.0f) + sh0, h1 = x1 * (sc1 + 1.0f) + sh1;
            u32x4 w; w.x = pk2(h0[0], h0[1]); w.y = pk2(h0[2], h0[3]); w.z = pk2(h1[0], h1[1]); w.w = pk2(h1[2], h1[3]);
            *(u32x4*)(h + e) = w; }
    }
}

__device__ __forceinline__ void rope8(const u32x4 a, const u32x4 b, float pf, u32x4& wa, u32x4& wb) {
    float t1[8], t2[8]; t1[0] = bflo(a.x); t1[1] = bfhi(a.x); t1[2] = bflo(a.y); t1[3] = bfhi(a.y); t1[4] = bflo(a.z); t1[5] = bfhi(a.z); t1[6] = bflo(a.w); t1[7] = bfhi(a.w);
    t2[0] = bflo(b.x); t2[1] = bfhi(b.x); t2[2] = bflo(b.y); t2[3] = bfhi(b.y); t2[4] = bflo(b.z); t2[5] = bfhi(b.z); t2[6] = bflo(b.w); t2[7] = bfhi(b.w);
    float o1[8], o2[8];
    const float inv[8] = {1.0f, 0.1939227432f, 0.0376060307f, 0.00729266461f, 0.00141421356f, 0.000274248188f, 5.31829610e-05f, 1.03133862e-05f};
#pragma unroll
    for (int j = 0; j < 8; ++j) { float sn, cs; sincos_red(pf * inv[j], sn, cs); o1[j] = t1[j] * cs - t2[j] * sn; o2[j] = t2[j] * cs + t1[j] * sn; }
    wa.x = pk2(o1[0], o1[1]); wa.y = pk2(o1[2], o1[3]); wa.z = pk2(o1[4], o1[5]); wa.w = pk2(o1[6], o1[7]);
    wb.x = pk2(o2[0], o2[1]); wb.y = pk2(o2[2], o2[3]); wb.z = pk2(o2[4], o2[5]); wb.w = pk2(o2[6], o2[7]);
}
__device__ __forceinline__ void mx_rope(const Ctx& X) {
    bf16_t* pj = X.proj(); const int* pos = X.a->positions;
    const int gt = X.c * 512 + X.tid, NGT = X.G * 512;
    for (int i = gt; i < M * 10; i += NGT) {
        const int tok = i / 10, hh = i % 10;
        if (hh == 9) { const u32x4* sp = (const u32x4*)(pj + (size_t)tok * PJ + C_V); u32x4* dp = (u32x4*)((bf16_t*)(X.ws + WS_V2) + (size_t)tok * 64);
#pragma unroll
            for (int q = 0; q < 8; ++q) dp[q] = sp[q];
            continue; }
        const int col = (hh < 4) ? C_Q + hh * 64 : (hh < 8) ? C_QI + (hh - 4) * 64 : C_K;
        bf16_t* p = pj + (size_t)tok * PJ + col;
        const u32x4 a = *(const u32x4*)p, b = *(const u32x4*)(p + 8);
        u32x4 wa, wb; rope8(a, b, (float)pos[tok], wa, wb);
        if (hh < 8) { *(u32x4*)p = wa; *(u32x4*)(p + 8) = wb; }
        else { u32x4* dp = (u32x4*)((bf16_t*)(X.ws + WS_K2) + (size_t)tok * 64); const u32x4* sp = (const u32x4*)p; dp[0] = wa; dp[1] = wb;
#pragma unroll
            for (int q = 2; q < 8; ++q) dp[q] = sp[q]; }
    }
    for (int i = gt; i < (M / 16) * 16; i += NGT) {
        const int hf = i & 1, pc = (i >> 1) & 7, tile = i >> 4; const int ks = pc >> 2, fq = pc & 3;
        u32x4* dp = (u32x4*)((bf16_t*)(X.ws + WS_KI2) + (size_t)tile * 1024 + pc * 128 + hf * 64);
#pragma unroll
        for (int j = 0; j < 8; ++j) { const int tok = tile * 16 + hf * 8 + j; const bf16_t* rp = pj + (size_t)tok * PJ + C_KI;
            u32x4 v = *(const u32x4*)(rp + ks * 32 + fq * 8);
            if (pc < 2) { const u32x4 a = *(const u32x4*)rp, b = *(const u32x4*)(rp + 8); u32x4 wa, wb; rope8(a, b, (float)pos[tok], wa, wb); v = pc ? wb : wa; }
            dp[j] = v; }
    }
}

__device__ __forceinline__ void mx_gmlp(const Ctx& X, int l, int unit) {
    const int lane = X.lane, w = X.wave;
    const int row0 = unit * 128;
    LAS bf16_t* Vt = (LAS bf16_t*)X.lds;
    const bf16_t* pj = X.proj();
    const float* lng = X.in(I_GMLNG) + l * 256; const float* lnb = X.in(I_GMLNB) + l * 256;
    float g4[4], b4[4];
#pragma unroll
    for (int j = 0; j < 4; ++j) { g4[j] = lng[lane + 64 * j]; b4[j] = lnb[lane + 64 * j]; }
    for (int i = 0; i < 16; ++i) {
        const int s = w * 16 + i; const bf16_t* rp = pj + (size_t)(row0 + s) * PJ + C_GV;
        float v[4]; float sm = 0.f;
#pragma unroll
        for (int j = 0; j < 4; ++j) { v[j] = gelu_tanh(bf2f(rp[lane + 64 * j])); sm += v[j]; }
        const float mean = wave_sum(sm) * (1.0f / 256.0f); float q = 0.f;
#pragma unroll
        for (int j = 0; j < 4; ++j) { v[j] -= mean; q += v[j] * v[j]; }
        const float rstd = rsqrtf(wave_sum(q) * (1.0f / 256.0f) + LN_EPS);
#pragma unroll
        for (int j = 0; j < 4; ++j) Vt[(lane + 64 * j) * 136 + s] = (bf16_t)f2bf(v[j] * rstd * g4[j] + b4[j]);
    }
    __syncthreads();
    const int g = w >> 1, c0 = g * 64 + (w & 1) * 32, fr = lane & 15, fq = lane >> 4;
    const bf16_t* gmw = (const bf16_t*)(X.ws + WS_GMW) + (size_t)g * 128 * 128;
    const float* gmb = X.in(I_GMB) + ((size_t)l * 4 + g) * 128;
    bf16_t* ya = X.ybuf();
    for (int tt = 0; tt < 8; ++tt) {
        f32x4 acc0 = (f32x4){0.f, 0.f, 0.f, 0.f}, acc1 = acc0;
        for (int ks = 0; ks <= (tt >> 1); ++ks) {
            const bf16x8 wf = *(const bf16x8*)(gmw + (tt * 16 + fr) * 128 + ks * 32 + 8 * fq);
            const bf16x8 v0 = *(const LAS bf16x8*)(Vt + (c0 + fr) * 136 + ks * 32 + 8 * fq), v1 = *(const LAS bf16x8*)(Vt + (c0 + 16 + fr) * 136 + ks * 32 + 8 * fq);
            acc0 = mfma16(v0, wf, acc0); acc1 = mfma16(v1, wf, acc1);
        }
        const int t = tt * 16 + fr; const float bias = gmb[t];
#pragma unroll
        for (int c2 = 0; c2 < 2; ++c2) { const f32x4 a = c2 ? acc1 : acc0; const int cc = c0 + c2 * 16 + 4 * fq;
            const u32x2 uv = *(const u32x2*)(pj + (size_t)(row0 + t) * PJ + C_GU + cc);
            u32x2 o; o.x = pk2(gelu_tanh(bflo(uv.x)) * (a[0] + bias), gelu_tanh(bfhi(uv.x)) * (a[1] + bias)); o.y = pk2(gelu_tanh(bflo(uv.y)) * (a[2] + bias), gelu_tanh(bfhi(uv.y)) * (a[3] + bias));
            *(u32x2*)(ya + (size_t)(row0 + t) * 256 + cc) = o; }
    }
    __syncthreads();
}

template <int PASS>
__device__ __forceinline__ void mx_s5(const Ctx& X, int l, int wu) {
    const int lane = X.lane, fr = lane & 15, fq = lane >> 4;
    const int wgi = wu >> 3, wv = wu & 7; const int b = wgi >> 6, g = ((wgi >> 4) & 3) * 4 + (wv & 3), ch = (wgi & 15) * 2 + (wv >> 2);
    const int tb = b * SEQ + ch * 256;
    LAS float* xl = (LAS float*)(X.lds + X.wave * 16384);
    LAS bf16_t* hb = (LAS bf16_t*)(X.lds + X.wave * 16384 + 8192);
    const bf16_t* pj = X.proj();
    const bf16_t* bbT = (const bf16_t*)(X.ws + WS_S5B) + (size_t)g * 128 * 16;
    bf16x8 Bf[8];
#pragma unroll
    for (int ct = 0; ct < 8; ++ct) { Bf[ct] = (bf16x8){0, 0, 0, 0, 0, 0, 0, 0}; if (fq < 2) Bf[ct] = *(const bf16x8*)(bbT + (ct * 16 + fr) * 16 + 8 * fq); }
    const float* sa = (const float*)(X.ws + WS_S5A) + (g * 64 + lane) * 2; const float ar = sa[0], ai = sa[1];
    float hr = 0.f, hi = 0.f;
    float* st = (float*)(X.ws + WS_S5ST) + (size_t)((b * 16 + g) * 32) * 128;
    bf16x8 Cf[4]; float dsk[4];
    if (PASS == 3) {
        { const float* hin = (const float*)(X.ws + WS_S5HIN) + (size_t)((b * 16 + g) * 32 + ch) * 128; hr = hin[lane]; hi = hin[64 + lane]; }
        const bf16_t* cm = (const bf16_t*)(X.ws + WS_S5C) + (size_t)g * 16 * 128;
#pragma unroll
        for (int ks = 0; ks < 4; ++ks) Cf[ks] = *(const bf16x8*)(cm + fr * 128 + ks * 32 + 8 * fq);
#pragma unroll
        for (int i = 0; i < 4; ++i) dsk[i] = X.in(I_S5D)[l * 256 + g * 16 + 4 * fq + i];
    }
    bf16_t* ycp = (bf16_t*)(X.ws + WS_YCPRE);
    for (int blk = 0; blk < 16; ++blk) {
        const int t0 = tb + blk * 16;
        bf16x8 uf = (bf16x8){0, 0, 0, 0, 0, 0, 0, 0};
        if (fq < 2) uf = *(const bf16x8*)(pj + (size_t)(t0 + fr) * PJ + C_S5 + g * 16 + 8 * fq);
#pragma unroll
        for (int ct = 0; ct < 8; ++ct) { const f32x4 a = mfma16(uf, Bf[ct], (f32x4){0.f, 0.f, 0.f, 0.f});
#pragma unroll
            for (int i = 0; i < 4; ++i) xl[(4 * fq + i) * 128 + ct * 16 + fr] = a[i]; }
#pragma unroll
        for (int t = 0; t < 16; ++t) { const float xr = xl[t * 128 + lane], xi = xl[t * 128 + 64 + lane];
            const float nr = ar * hr - ai * hi + xr, ni = ar * hi + ai * hr + xi; hr = nr; hi = ni;
            if (PASS == 3) { hb[t * 136 + lane] = (bf16_t)f2bf(hr); hb[t * 136 + 64 + lane] = (bf16_t)f2bf(hi); } }
        if (PASS == 3) {
            asm volatile("s_waitcnt lgkmcnt(0)" ::: "memory"); __builtin_amdgcn_wave_barrier();
            f32x4 acc = (f32x4){0.f, 0.f, 0.f, 0.f};
#pragma unroll
            for (int ks = 0; ks < 4; ++ks) { const bf16x8 hf = *(const LAS bf16x8*)(hb + fr * 136 + ks * 32 + 8 * fq); acc = mfma16(Cf[ks], hf, acc); }
            const u32x2 uv = *(const u32x2*)(pj + (size_t)(t0 + fr) * PJ + C_S5 + g * 16 + 4 * fq);
            const float y0 = gelu_tanh(acc[0] + dsk[0] * bflo(uv.x)), y1 = gelu_tanh(acc[1] + dsk[1] * bfhi(uv.x)), y2 = gelu_tanh(acc[2] + dsk[2] * bflo(uv.y)), y3 = gelu_tanh(acc[3] + dsk[3] * bfhi(uv.y));
            u32x2 o; o.x = pk2(y0, y1); o.y = pk2(y2, y3);
            *(u32x2*)(ycp + (size_t)(t0 + fr) * 256 + g * 16 + 4 * fq) = o;
        }
    }
    if (PASS == 1) { st[ch * 128 + lane] = hr; st[ch * 128 + 64 + lane] = hi; }
}

constexpr int SD_CM = 0, SD_BM = 18432, SD_BT = 36864, SD_XT0 = 54272, SD_XT1 = 71680, SD_MM = 89088, SD_SIN0 = 123904, SD_SIN1 = 133120, SD_DT = 142336, SD_AC = 143360 + 64, SD_END = 144384 + 64;
static_assert(SD_END <= LDS_MISC, "ssd lds");
template <int PASS>
__device__ __forceinline__ void mx_ssd(const Ctx& X, int l, int unit) {
    const int tid = X.tid, lane = X.lane, w = X.wave, fr = lane & 15, fq = lane >> 4;
    const int b = unit >> 6, c = unit & 63; const int r0 = unit * 128;
    const bf16_t* pj = X.proj();
    LAS bf16_t* Cm = (LAS bf16_t*)(X.lds + SD_CM); LAS bf16_t* Bm = (LAS bf16_t*)(X.lds + SD_BM); LAS bf16_t* Bt = (LAS bf16_t*)(X.lds + SD_BT);
    LAS bf16_t* Mm = (LAS bf16_t*)(X.lds + SD_MM);
    LAS float* dtv = (LAS float*)(X.lds + SD_DT); LAS float* acm = (LAS float*)(X.lds + SD_AC);
    const float* convw = X.in(I_CONVW) + (size_t)l * 4 * 512; const float* convb = X.in(I_CONVB) + (size_t)l * 512;
    float* sst = (float*)(X.ws + WS_SSDST); float* atot = (float*)(X.ws + WS_ATOT);
    for (int g = 0; g < 2; ++g) {
        if (tid < 256) { const int j = tid >> 7, rl = tid & 127, h = 2 * g + j;
            const float raw = bf2f(pj[(size_t)(r0 + rl) * PJ + C_DT + h]) + X.in(I_DTBIAS)[l * 4 + h];
            const float dt = softplusf_(raw); dtv[j * 128 + rl] = dt; acm[j * 128 + rl] = -expf(X.in(I_ALOG)[l * 4 + h]) * dt; }
        __syncthreads();
        if (tid < 256) {
            float cum = acm[tid];
#pragma unroll
            for (int o = 1; o < 64; o <<= 1) { const float up = __shfl_up(cum, o); if (lane >= o) cum += up; }
            if (lane == 63) dtv[256 + w] = cum;
            __builtin_amdgcn_fence(__ATOMIC_RELEASE, "workgroup");
            acm[tid] = cum; }
        __syncthreads();
        if (tid < 256 && (w & 1)) acm[tid] += dtv[256 + w - 1];
        __syncthreads();
        if (PASS == 1 && tid < 2) atot[(b * 64 + c) * 32 + 2 * g + tid] = acm[tid * 128 + 127];
        constexpr int NCG = (PASS == 1) ? 24 : 32;
        for (int it = tid; it < NCG * 128; it += 512) {
            const int rl = it & 127, cg = it >> 7;
            const int chn = (cg < 16) ? g * 128 + cg * 8 : (cg < 24) ? 256 + g * 64 + (cg - 16) * 8 : 384 + g * 64 + (cg - 24) * 8;
            float a8[8];
            { const f32x4 c0 = *(const f32x4*)(convb + chn), c1 = *(const f32x4*)(convb + chn + 4); a8[0] = c0[0]; a8[1] = c0[1]; a8[2] = c0[2]; a8[3] = c0[3]; a8[4] = c1[0]; a8[5] = c1[1]; a8[6] = c1[2]; a8[7] = c1[3]; }
#pragma unroll
            for (int k = 0; k < 4; ++k) { const int sq = c * 128 + rl - 3 + k;
                if (sq >= 0) { const u32x4 xv = *(const u32x4*)(pj + (size_t)(b * SEQ + sq) * PJ + C_XBC + chn);
                    const f32x4 w0 = *(const f32x4*)(convw + k * 512 + chn), w1 = *(const f32x4*)(convw + k * 512 + chn + 4);
                    a8[0] += w0[0] * bflo(xv.x); a8[1] += w0[1] * bfhi(xv.x); a8[2] += w0[2] * bflo(xv.y); a8[3] += w0[3] * bfhi(xv.y);
                    a8[4] += w1[0] * bflo(xv.z); a8[5] += w1[1] * bfhi(xv.z); a8[6] += w1[2] * bflo(xv.w); a8[7] += w1[3] * bfhi(xv.w); } }
#pragma unroll
            for (int q = 0; q < 8; ++q) a8[q] = siluf_(a8[q]);
            if (cg < 16) { const int j = cg >> 3, p0 = (cg & 7) * 8; LAS bf16_t* Xt = (LAS bf16_t*)(X.lds + (j ? SD_XT1 : SD_XT0));
                float sc = 1.0f; if (PASS == 1) sc = __expf(acm[j * 128 + 127] - acm[j * 128 + rl]) * dtv[j * 128 + rl];
#pragma unroll
                for (int q = 0; q < 8; ++q) Xt[(p0 + q) * 136 + rl] = (bf16_t)f2bf(a8[q] * sc); }
            else if (cg < 24) { const int n0 = (cg - 16) * 8;
                if (PASS == 1) {
#pragma unroll
                    for (int q = 0; q < 8; ++q) Bt[(n0 + q) * 136 + rl] = (bf16_t)f2bf(a8[q]); }
                else { u32x4 o; o.x = pk2(a8[0], a8[1]); o.y = pk2(a8[2], a8[3]); o.z = pk2(a8[4], a8[5]); o.w = pk2(a8[6], a8[7]); *(LAS u32x4*)(Bm + rl * 72 + n0) = o; } }
            else { const int n0 = (cg - 24) * 8; u32x4 o; o.x = pk2(a8[0], a8[1]); o.y = pk2(a8[2], a8[3]); o.z = pk2(a8[4], a8[5]); o.w = pk2(a8[6], a8[7]); *(LAS u32x4*)(Cm + rl * 72 + n0) = o; }
        }
        if (PASS == 3) {
            const bf16_t* sin = (const bf16_t*)(X.ws + WS_SSDSIN) + (size_t)((b * 64 + c) * 4 + 2 * g) * 4096 + tid * 8;
            const int p = tid >> 3, n0 = (tid & 7) * 8;
            *(LAS u32x4*)((LAS bf16_t*)(X.lds + SD_SIN0) + p * 72 + n0) = *(const u32x4*)sin;
            *(LAS u32x4*)((LAS bf16_t*)(X.lds + SD_SIN1) + p * 72 + n0) = *(const u32x4*)(sin + 4096);
        }
        __syncthreads();
        if (PASS == 1) {
            const int j = w >> 2, pt = w & 3; const LAS bf16_t* Xt = (const LAS bf16_t*)(X.lds + (j ? SD_XT1 : SD_XT0));
            f32x4 acc[4];
#pragma unroll
            for (int nt = 0; nt < 4; ++nt) acc[nt] = (f32x4){0.f, 0.f, 0.f, 0.f};
#pragma unroll
            for (int ks = 0; ks < 4; ++ks) { const bf16x8 xf = *(const LAS bf16x8*)(Xt + (pt * 16 + fr) * 136 + ks * 32 + 8 * fq);
#pragma unroll
                for (int nt = 0; nt < 4; ++nt) { const bf16x8 bf = *(const LAS bf16x8*)(Bt + (nt * 16 + fr) * 136 + ks * 32 + 8 * fq); acc[nt] = mfma16(xf, bf, acc[nt]); } }
            float* sp = sst + (size_t)((b * 64 + c) * 4 + 2 * g + j) * 4096;
#pragma unroll
            for (int nt = 0; nt < 4; ++nt)
#pragma unroll
                for (int i = 0; i < 4; ++i) sp[(pt * 16 + 4 * fq + i) * 64 + nt * 16 + fr] = acc[nt][i];
        } else {
            const int lrow = w * 16 + fr;
            float yv[2][4][4];
#pragma unroll
            for (int j = 0; j < 2; ++j) {
                const LAS bf16_t* Xt = (const LAS bf16_t*)(X.lds + (j ? SD_XT1 : SD_XT0)); const LAS bf16_t* Sin = (const LAS bf16_t*)(X.lds + (j ? SD_SIN1 : SD_SIN0));
                const float al = acm[j * 128 + lrow];
                const bf16x8 cf0 = *(const LAS bf16x8*)(Cm + lrow * 72 + 8 * fq), cf1 = *(const LAS bf16x8*)(Cm + lrow * 72 + 32 + 8 * fq);
                const int stmax = w | 1;
                for (int st = 0; st <= stmax; ++st) {
                    f32x4 ag = (f32x4){0.f, 0.f, 0.f, 0.f};
                    if (st <= w) { const bf16x8 b0 = *(const LAS bf16x8*)(Bm + (st * 16 + fr) * 72 + 8 * fq), b1 = *(const LAS bf16x8*)(Bm + (st * 16 + fr) * 72 + 32 + 8 * fq);
                        ag = mfma16(b0, cf0, ag); ag = mfma16(b1, cf1, ag); }
                    float mv[4];
#pragma unroll
                    for (int i = 0; i < 4; ++i) { const int s = st * 16 + 4 * fq + i; mv[i] = (s <= lrow) ? ag[i] * __expf(al - acm[j * 128 + s]) * dtv[j * 128 + s] : 0.f; }
                    u32x2 o; o.x = pk2(mv[0], mv[1]); o.y = pk2(mv[2], mv[3]); *(LAS u32x2*)(Mm + lrow * 136 + st * 16 + 4 * fq) = o;
                }
                const float eal = __expf(al); const float dsk = X.in(I_SSDD)[l * 4 + 2 * g + j];
#pragma unroll
                for (int pt = 0; pt < 4; ++pt) {
                    f32x4 ad = (f32x4){0.f, 0.f, 0.f, 0.f}, ao = ad;
                    for (int ks = 0; ks <= (w >> 1); ++ks) { const bf16x8 xf = *(const LAS bf16x8*)(Xt + (pt * 16 + fr) * 136 + ks * 32 + 8 * fq), mf = *(const LAS bf16x8*)(Mm + lrow * 136 + ks * 32 + 8 * fq); ad = mfma16(xf, mf, ad); }
                    { const bf16x8 s0 = *(const LAS bf16x8*)(Sin + (pt * 16 + fr) * 72 + 8 * fq), s1 = *(const LAS bf16x8*)(Sin + (pt * 16 + fr) * 72 + 32 + 8 * fq); ao = mfma16(s0, cf0, ao); ao = mfma16(s1, cf1, ao); }
                    const int h = 2 * g + j; const u32x2 zv = *(const u32x2*)(pj + (size_t)(r0 + lrow) * PJ + C_Z + h * 64 + pt * 16 + 4 * fq);
                    const float z4[4] = {bflo(zv.x), bfhi(zv.x), bflo(zv.y), bfhi(zv.y)};
#pragma unroll
                    for (int i = 0; i < 4; ++i) { const float xs = bf2f(Xt[(pt * 16 + 4 * fq + i) * 136 + lrow]); yv[j][pt][i] = (ad[i] + eal * ao[i] + dsk * xs) * siluf_(z4[i]); }
                }
            }
            float ss = 0.f;
#pragma unroll
            for (int j = 0; j < 2; ++j)
#pragma unroll
                for (int pt = 0; pt < 4; ++pt)
#pragma unroll
                    for (int i = 0; i < 4; ++i) ss += yv[j][pt][i] * yv[j][pt][i];
            ss += __shfl_xor(ss, 16); ss += __shfl_xor(ss, 32);
            const float rs = rsqrtf(ss * (1.0f / 128.0f) + RMS_EPS);
            const float* ng = X.in(I_SSDNG) + l * 256 + g * 128; bf16_t* yd = X.ybuf() + (size_t)3 * M * 256;
#pragma unroll
            for (int j = 0; j < 2; ++j)
#pragma unroll
                for (int pt = 0; pt < 4; ++pt) { const int cc = j * 64 + pt * 16 + 4 * fq; const f32x4 gv = *(const f32x4*)(ng + cc);
                    u32x2 o; o.x = pk2(yv[j][pt][0] * rs * gv[0], yv[j][pt][1] * rs * gv[1]); o.y = pk2(yv[j][pt][2] * rs * gv[2], yv[j][pt][3] * rs * gv[3]);
                    *(u32x2*)(yd + (size_t)(r0 + lrow) * 256 + g * 128 + cc) = o; }
        }
        __syncthreads();
    }
}

__device__ __forceinline__ void mx_s5_carry(const Ctx& X) {
    const float* st = (const float*)(X.ws + WS_S5ST); float* hin = (float*)(X.ws + WS_S5HIN); const float* sa = (const float*)(X.ws + WS_S5A);
    for (int i = (X.c - 128) * 512 + X.tid; X.c >= 128 && i < NB * 16 * 64; i += X.G * 512) {
        const int p = i & 63, g = (i >> 6) & 15, b = i >> 10;
        float pr = sa[(g * 64 + p) * 2], pi = sa[(g * 64 + p) * 2 + 1];
#pragma unroll
        for (int q = 0; q < 8; ++q) { const float nr = pr * pr - pi * pi, ni = 2.f * pr * pi; pr = nr; pi = ni; }
        float hr = 0.f, hi = 0.f; const size_t base = (size_t)((b * 16 + g) * 32) * 128 + p;
#pragma unroll 8
        for (int ch = 0; ch < 32; ++ch) { hin[base + ch * 128] = hr; hin[base + ch * 128 + 64] = hi;
            const float sr = st[base + ch * 128], si = st[base + ch * 128 + 64]; const float nr = pr * hr - pi * hi + sr, ni = pr * hi + pi * hr + si; hr = nr; hi = ni; }
    }
}

__device__ __forceinline__ void mx_ssd_carry(const Ctx& X) {
    const float* sst = (const float*)(X.ws + WS_SSDST); const float* atot = (const float*)(X.ws + WS_ATOT); bf16_t* sin = (bf16_t*)(X.ws + WS_SSDSIN);
    for (int i = X.c * 512 + X.tid; i < NB * 4 * 4096; i += X.G * 512) {
        const int e1 = i & 4095, h = (i >> 12) & 3, b = i >> 14;
        float S = 0.f;
#pragma unroll 16
        for (int c = 0; c < 64; ++c) { const size_t o = (size_t)((b * 64 + c) * 4 + h) * 4096 + e1;
            sin[o] = (bf16_t)f2bf(S);
            S = S * __expf(atot[(b * 64 + c) * 32 + h]) + sst[o]; }
    }
}

__device__ __forceinline__ unsigned ord16(float s) { const _Float16 hf = (_Float16)s; const unsigned bits = (unsigned)__builtin_bit_cast(unsigned short, hf); return bits ^ ((bits & 0x8000u) ? 0xFFFFu : 0x8000u); }
__device__ __forceinline__ int cnt_ge8(const u32x4 v, unsigned c) {
    int n = 0;
    n += ((v.x & 0xFFFFu) >= c) + ((v.x >> 16) >= c); n += ((v.y & 0xFFFFu) >= c) + ((v.y >> 16) >= c);
    n += ((v.z & 0xFFFFu) >= c) + ((v.z >> 16) >= c); n += ((v.w & 0xFFFFu) >= c) + ((v.w >> 16) >= c);
    return n;
}
template <int CTRL> __device__ __forceinline__ float dpp_f(float v) { return __builtin_bit_cast(float, __builtin_amdgcn_update_dpp(0, __builtin_bit_cast(int, v), CTRL, 0xF, 0xF, true)); }
__device__ __forceinline__ void mx_dsa(const Ctx& X, int b, int t0) {
    const int tid = X.tid, lane = X.lane, w = X.wave, fr = lane & 15, fq = lane >> 4;
    const bf16_t* pj = X.proj() + (size_t)b * SEQ * PJ; const unsigned rb = 0u;
    const bf16_t* ki2 = (const bf16_t*)(X.ws + WS_KI2) + (size_t)b * SEQ * 64; const bf16_t* k2 = (const bf16_t*)(X.ws + WS_K2) + (size_t)b * SEQ * 64; const bf16_t* v2 = (const bf16_t*)(X.ws + WS_V2) + (size_t)b * SEQ * 64;
    LAS unsigned short* sc = (LAS unsigned short*)X.lds;
    const int nk = t0 + 8, nkt = (nk + 15) >> 4;
    LAS unsigned* hist = (LAS unsigned*)(X.lds + 131072 + 8192);
    for (int i = tid; i < 8 * 4 * 128 / 4; i += 512) *(LAS u32x4*)(hist + 4 * i) = (u32x4){0u, 0u, 0u, 0u};
    bf16x8 qf[2][2]; f32x4 wq[2];
#pragma unroll
    for (int ct = 0; ct < 2; ++ct) { const int q = 4 * ct + (fr >> 2), hh = fr & 3; const bf16_t* qp = pj + (unsigned)(t0 + q) * (unsigned)PJ;
        qf[ct][0] = *(const bf16x8*)(qp + C_QI + hh * 64 + 8 * fq); qf[ct][1] = *(const bf16x8*)(qp + C_QI + hh * 64 + 32 + 8 * fq);
        const u32x2 wv = *(const u32x2*)(pj + (unsigned)(t0 + 4 * ct + fq) * (unsigned)PJ + C_WI);
        wq[ct] = (f32x4){bflo(wv.x) * 0.0625f, bfhi(wv.x) * 0.0625f, bflo(wv.y) * 0.0625f, bfhi(wv.y) * 0.0625f}; }
    const int ntw = (nkt > w) ? ((nkt - w + 7) >> 3) : 0;
    __syncthreads();
#define DSA_LOAD4(KF, I0) do { _Pragma("unroll") for (int j = 0; j < 4; ++j) { int kt_ = w + 8 * ((I0) + j); kt_ = kt_ < nkt ? kt_ : nkt - 1; \
        const unsigned ko_ = (unsigned)kt_ * 1024u + (unsigned)lane * 8u; KF[j][0] = *(const bf16x8*)(ki2 + ko_); KF[j][1] = *(const bf16x8*)(ki2 + ko_ + 512u); } } while (0)
#define DSA_COMP4(KF, I0) do { if (DSA_PM == 2 && rs1 > 0) { _Pragma("unroll") for (int j = 0; j < 4; ++j) dummy_ ^= KF[j][0][0] ^ KF[j][1][3]; break; } \
      _Pragma("unroll") for (int jh = 0; jh < 4; jh += 2) { f32x4 ac_[2][2]; \
        _Pragma("unroll") for (int j = 0; j < 2; ++j) _Pragma("unroll") for (int ct = 0; ct < 2; ++ct) { \
            ac_[j][ct] = mfma16(qf[ct][0], KF[jh + j][0], (f32x4){0.f, 0.f, 0.f, 0.f}); ac_[j][ct] = mfma16(qf[ct][1], KF[jh + j][1], ac_[j][ct]); } \
        _Pragma("unroll") for (int j = 0; j < 2; ++j) { if ((I0) + jh + j < ntw) { const int kt_ = w + 8 * ((I0) + jh + j); const bool full_ = (kt_ * 16 + 15 <= t0); const int key_ = kt_ * 16 + fr; \
        _Pragma("unroll") for (int ct = 0; ct < 2; ++ct) { const f32x4 a_ = ac_[j][ct]; \
            float tt_ = __builtin_fmaf(__builtin_amdgcn_fmed3f(a_[0], 0.f, 3.0e38f), wq[ct][0], 0.0f); tt_ = __builtin_fmaf(__builtin_amdgcn_fmed3f(a_[1], 0.f, 3.0e38f), wq[ct][1], tt_); \
            tt_ = __builtin_fmaf(__builtin_amdgcn_fmed3f(a_[2], 0.f, 3.0e38f), wq[ct][2], tt_); tt_ = __builtin_fmaf(__builtin_amdgcn_fmed3f(a_[3], 0.f, 3.0e38f), wq[ct][3], tt_); \
            const int q_ = 4 * ct + fq; unsigned kk_ = ord16(tt_ + 0.0f); \
            if (!full_) kk_ = (key_ <= t0 + q_) ? kk_ : 0u; \
            if (DSA_PM == 1 && rs1 > 0) dummy_ ^= (short)kk_; else sc[q_ * 8192 + key_] = (unsigned short)kk_; \
            if ((R_S1 == 1 || rs1 == 0) && (full_ || kk_ != 0u)) __hip_atomic_fetch_add(hist + (q_ * 4 + (fr & 3)) * 128 + (kk_ >> 9), (kk_ & 0x100u) ? 65536u : 1u, __ATOMIC_RELAXED, __HIP_MEMORY_SCOPE_WORKGROUP); } } } } } while (0)
    short dummy_ = 0;
    _Pragma("nounroll") for (int rs1 = 0; rs1 < (((DSA_SKIP | X.dbg) & 1) ? 0 : R_S1); ++rs1)
    { bf16x8 ka[4][2], kb[4][2];
      if (ntw > 0) { DSA_LOAD4(ka, 0);
#pragma nounroll
        for (int i0 = 0; i0 < ntw; i0 += 8) { DSA_LOAD4(kb, i0 + 4); DSA_COMP4(ka, i0); DSA_LOAD4(ka, i0 + 8); DSA_COMP4(kb, i0 + 4); } } }
#undef DSA_LOAD4
#undef DSA_COMP4
    if (dummy_ == (short)0x1234 && t0 == 123457) sc[0] = 1;
    { const int z0 = nkt * 16, z1 = ((nk + 511) >> 9) << 9;
        for (int i = z0 + tid; i < z1; i += 512) {
#pragma unroll
            for (int q = 0; q < 8; ++q) sc[q * 8192 + i] = 0; } }
    __syncthreads();
    const int t = t0 + w, nv = t + 1;
    LAS unsigned short* row = sc + w * 8192;
    LAS unsigned short* list = (LAS unsigned short*)(X.lds + 131072 + w * 512);
    const int nsel = nv < 256 ? nv : 256;
    if (((DSA_SKIP | X.dbg) & 2) || nv <= 256) { for (int n = lane; n < 256; n += 64) list[n] = (unsigned short)n; }
    else {
        const int nit = (nv + 511) >> 9;
        LAS unsigned* H = hist + w * 512;
        int T1, above1;
        { u32x4 h4 = (u32x4){0u, 0u, 0u, 0u};
#pragma unroll
          for (int c4 = 0; c4 < 4; ++c4) { const u32x2 pw = *(const LAS u32x2*)(H + c4 * 128 + 2 * lane); h4.x += pw.x & 0xFFFFu; h4.y += pw.x >> 16; h4.z += pw.y & 0xFFFFu; h4.w += pw.y >> 16; }
          const int sl = (int)(h4.x + h4.y + h4.z + h4.w);
          int suf = sl;
#pragma unroll
          for (int o = 1; o < 64; o <<= 1) { const int dn = __shfl_down(suf, o); if (lane + o < 64) suf += dn; }
          const unsigned long long bm = __ballot(suf >= 256); const int L = 63 - __builtin_clzll(bm);
          const int hx = __shfl((int)h4.x, L), hy = __shfl((int)h4.y, L), hz = __shfl((int)h4.z, L), hw = __shfl((int)h4.w, L);
          const int sufn = __shfl(suf, L) - (hx + hy + hz + hw);
          int cb = sufn; T1 = 4 * L + 3; above1 = cb;
          if (cb + hw >= 256) { T1 = 4 * L + 3; above1 = cb; } else { cb += hw; if (cb + hz >= 256) { T1 = 4 * L + 2; above1 = cb; } else { cb += hz; if (cb + hy >= 256) { T1 = 4 * L + 1; above1 = cb; } else { cb += hy; T1 = 4 * L; above1 = cb; } } } }
        _Pragma("nounroll") for (int rs2 = 0; rs2 < R_S2; ++rs2) {
        *(LAS u32x4*)(H + 4 * lane) = (u32x4){0u, 0u, 0u, 0u};
        for (int it = 0; it < nit; ++it) { const u32x4 v = *(const LAS u32x4*)(row + (it * 64 + lane) * 8);
            const unsigned e[8] = {v.x & 0xFFFFu, v.x >> 16, v.y & 0xFFFFu, v.y >> 16, v.z & 0xFFFFu, v.z >> 16, v.w & 0xFFFFu, v.w >> 16};
#pragma unroll
            for (int j = 0; j < 8; ++j) if ((int)(e[j] >> 8) == T1) __hip_atomic_fetch_add(H + (e[j] & 255u), 1u, __ATOMIC_RELAXED, __HIP_MEMORY_SCOPE_WORKGROUP); }
        unsigned thr; int cgt, cge;
        { const u32x4 h4 = *(const LAS u32x4*)(H + 4 * lane); const int sl = (int)(h4.x + h4.y + h4.z + h4.w);
          int suf = sl;
#pragma unroll
          for (int o = 1; o < 64; o <<= 1) { const int dn = __shfl_down(suf, o); if (lane + o < 64) suf += dn; }
          const int need = 256 - above1;
          const unsigned long long bm = __ballot(suf >= need); const int L = 63 - __builtin_clzll(bm);
          const int hx = __shfl((int)h4.x, L), hy = __shfl((int)h4.y, L), hz = __shfl((int)h4.z, L), hw = __shfl((int)h4.w, L);
          int cb = __shfl(suf, L) - (hx + hy + hz + hw); int T2, hT;
          if (cb + hw >= need) { T2 = 4 * L + 3; hT = hw; } else { cb += hw; if (cb + hz >= need) { T2 = 4 * L + 2; hT = hz; } else { cb += hz; if (cb + hy >= need) { T2 = 4 * L + 1; hT = hy; } else { cb += hy; T2 = 4 * L; hT = hx; } } }
          thr = ((unsigned)T1 << 8) | (unsigned)T2; cgt = above1 + cb; cge = cgt + hT; }
        const bool exact = (cge == 256);
        const int r = 256 - cgt;
        const unsigned cmin = exact ? thr : thr + 1u;
        const unsigned long long lt_mask = (1ull << lane) - 1ull; int bcnt = 0;
        for (int it = 0; it < nit; ++it) { const u32x4 v = *(const LAS u32x4*)(row + (it * 64 + lane) * 8); const int base = (it * 64 + lane) * 8;
            const unsigned e[8] = {v.x & 0xFFFFu, v.x >> 16, v.y & 0xFFFFu, v.y >> 16, v.z & 0xFFFFu, v.z >> 16, v.w & 0xFFFFu, v.w >> 16};
#pragma unroll
            for (int j = 0; j < 8; ++j) { const bool sl = e[j] >= cmin; const unsigned long long bm = __ballot(sl);
                if (bm != 0ull) { if (sl) list[(bcnt + __popcll(bm & lt_mask)) & 255] = (unsigned short)(base + j); bcnt += __popcll(bm); } } }
        if (!exact) {
            int taken = 0;
            for (int it = 0; it < nit && taken < r; ++it) { const u32x4 v = *(const LAS u32x4*)(row + (it * 64 + lane) * 8); const int base = (it * 64 + lane) * 8;
                const unsigned e[8] = {v.x & 0xFFFFu, v.x >> 16, v.y & 0xFFFFu, v.y >> 16, v.z & 0xFFFFu, v.z >> 16, v.w & 0xFFFFu, v.w >> 16};
                int mcount = 0;
#pragma unroll
                for (int j = 0; j < 8; ++j) mcount += (e[j] == thr);
                if (__ballot(mcount != 0) == 0ull) continue;
                int incl = mcount;
#pragma unroll
                for (int o = 1; o < 64; o <<= 1) { const int up = __shfl_up(incl, o); if (lane >= o) incl += up; }
                const int total = __shfl(incl, 63); int rk = taken + incl - mcount;
#pragma unroll
                for (int j = 0; j < 8; ++j) if (e[j] == thr) { if (rk < r) list[(cgt + rk) & 255] = (unsigned short)(base + j); ++rk; }
                taken += total; }
        }
        }
    }
    __builtin_amdgcn_fence(__ATOMIC_RELEASE, "workgroup"); __builtin_amdgcn_wave_barrier();
    const bf16_t* qrow = pj + (unsigned)t * (unsigned)PJ;
    bf16x8 qb0 = (bf16x8){0, 0, 0, 0, 0, 0, 0, 0}, qb1 = qb0;
    if (fr < 4) { qb0 = *(const bf16x8*)(qrow + C_Q + fr * 64 + 8 * fq); qb1 = *(const bf16x8*)(qrow + C_Q + fr * 64 + 32 + 8 * fq); }
    LAS float* Pb = (LAS float*)row;
    LAS float* pinv = (LAS float*)(X.lds + 131072 + 4096 + 256 + w * 16);
    _Pragma("nounroll") for (int rs3 = 0; rs3 < (((DSA_SKIP | X.dbg) & 4) ? 0 : R_S3); ++rs3) {
    { LAS unsigned char* kbuf = (LAS unsigned char*)row + 4096;
      const int drow = lane >> 3, dchk = (lane & 7) ^ (drow & 7);
#define QK_DMA(G) do { _Pragma("unroll") for (int i_ = 0; i_ < 4; ++i_) { const unsigned ko_ = (unsigned)list[(G) * 32 + i_ * 8 + drow] * 64u + (unsigned)(dchk * 8); \
        __builtin_amdgcn_global_load_lds((const unsigned*)(k2 + ko_), (LAS unsigned*)(kbuf + ((G) % 3) * 4096 + i_ * 1024), 16, 0, 0); } } while (0)
#define QK_COMP(G) do { _Pragma("unroll") for (int j = 0; j < 2; ++j) { const LAS unsigned char* tb_ = kbuf + ((G) % 3) * 4096 + j * 2048 + fr * 128; \
        const bf16x8 k0_ = *(const LAS bf16x8*)(tb_ + ((fq ^ (fr & 7)) * 16)), k1_ = *(const LAS bf16x8*)(tb_ + (((4 + fq) ^ (fr & 7)) * 16)); \
        f32x4 a_ = mfma16(k0_, qb0, (f32x4){0.f, 0.f, 0.f, 0.f}); a_ = mfma16(k1_, qb1, a_); \
        if (fr < 4) { _Pragma("unroll") for (int i = 0; i < 4; ++i) { const int nn_ = ((G) * 2 + j) * 16 + 4 * fq + i; Pb[nn_ * 4 + fr] = (nn_ < nsel) ? a_[i] * 0.125f : -3.0e38f; } } } } while (0)
      asm volatile("s_waitcnt vmcnt(0)" ::: "memory");
      QK_DMA(0); QK_DMA(1);
      asm volatile("s_waitcnt vmcnt(4)" ::: "memory"); QK_COMP(0); QK_DMA(2);
      asm volatile("s_waitcnt vmcnt(4)" ::: "memory"); QK_COMP(1); asm volatile("s_waitcnt lgkmcnt(0)" ::: "memory"); QK_DMA(3);
      asm volatile("s_waitcnt vmcnt(4)" ::: "memory"); QK_COMP(2); asm volatile("s_waitcnt lgkmcnt(0)" ::: "memory"); QK_DMA(4);
      asm volatile("s_waitcnt vmcnt(4)" ::: "memory"); QK_COMP(3); asm volatile("s_waitcnt lgkmcnt(0)" ::: "memory"); QK_DMA(5);
      asm volatile("s_waitcnt vmcnt(4)" ::: "memory"); QK_COMP(4); asm volatile("s_waitcnt lgkmcnt(0)" ::: "memory"); QK_DMA(6);
      asm volatile("s_waitcnt vmcnt(4)" ::: "memory"); QK_COMP(5); asm volatile("s_waitcnt lgkmcnt(0)" ::: "memory"); QK_DMA(7);
      asm volatile("s_waitcnt vmcnt(4)" ::: "memory"); QK_COMP(6);
      asm volatile("s_waitcnt vmcnt(0)" ::: "memory"); QK_COMP(7);
#undef QK_DMA
#undef QK_COMP
    }
    __builtin_amdgcn_fence(__ATOMIC_RELEASE, "workgroup"); __builtin_amdgcn_wave_barrier();
    { const int hd = lane & 3, nb0 = lane >> 2;
        float v16[16]; float mx = -3.0e38f;
#pragma unroll
        for (int j = 0; j < 16; ++j) { v16[j] = Pb[(nb0 + 16 * j) * 4 + hd]; mx = fmaxf(mx, v16[j]); }
        mx = fmaxf(mx, __shfl_xor(mx, 4)); mx = fmaxf(mx, __shfl_xor(mx, 8)); mx = fmaxf(mx, __shfl_xor(mx, 16)); mx = fmaxf(mx, __shfl_xor(mx, 32));
        float sm = 0.f;
#pragma unroll
        for (int j = 0; j < 16; ++j) { const float p = (v16[j] > -1.0e38f) ? __expf(v16[j] - mx) : 0.f; sm += p; Pb[(nb0 + 16 * j) * 4 + hd] = p; }
        sm += __shfl_xor(sm, 4); sm += __shfl_xor(sm, 8); sm += __shfl_xor(sm, 16); sm += __shfl_xor(sm, 32);
        if (lane < 4) pinv[lane] = 1.0f / sm; }
    __builtin_amdgcn_fence(__ATOMIC_RELEASE, "workgroup"); __builtin_amdgcn_wave_barrier();
    f32x2 o2[4][2];
#pragma unroll
    for (int h = 0; h < 4; ++h) { o2[h][0] = (f32x2){0.f, 0.f}; o2[h][1] = (f32x2){0.f, 0.f}; }
    const int d4 = fr * 4;
#define PV_LOAD(VV, B) do { _Pragma("unroll") for (int j = 0; j < 16; ++j) { const unsigned vo_ = (unsigned)list[(B) * 64 + 4 * j + fq] * 64u + (unsigned)d4; VV[j] = *(const u32x2*)(v2 + vo_); } } while (0)
#define PV_COMP(VV, B) do { _Pragma("unroll") for (int j = 0; j < 16; ++j) { const f32x4 p4_ = *(const LAS f32x4*)(Pb + ((B) * 64 + 4 * j + fq) * 4); \
        const f32x2 va_ = (f32x2){bflo(VV[j].x), bfhi(VV[j].x)}, vb_ = (f32x2){bflo(VV[j].y), bfhi(VV[j].y)}; \
        _Pragma("unroll") for (int h = 0; h < 4; ++h) { const f32x2 pp_ = (f32x2){p4_[h], p4_[h]}; o2[h][0] = __builtin_elementwise_fma(va_, pp_, o2[h][0]); o2[h][1] = __builtin_elementwise_fma(vb_, pp_, o2[h][1]); } } } while (0)
    { u32x2 va[16], vb[16]; PV_LOAD(va, 0); PV_LOAD(vb, 1); PV_COMP(va, 0); PV_LOAD(va, 2); PV_COMP(vb, 1); PV_LOAD(vb, 3); PV_COMP(va, 2); PV_COMP(vb, 3); }
#undef PV_LOAD
#undef PV_COMP
    float o4[4][4];
#pragma unroll
    for (int h = 0; h < 4; ++h)
#pragma unroll
        for (int dd = 0; dd < 4; ++dd) { float v = o2[h][dd >> 1][dd & 1]; v += __shfl_xor(v, 16); v += __shfl_xor(v, 32); o4[h][dd] = v; }
    { const int h = fq; const float iv = pinv[h];
        float r4[4];
#pragma unroll
        for (int dd = 0; dd < 4; ++dd) r4[dd] = ((h == 0) ? o4[0][dd] : (h == 1) ? o4[1][dd] : (h == 2) ? o4[2][dd] : o4[3][dd]) * iv;
        u32x2 o; o.x = pk2(r4[0], r4[1]); o.y = pk2(r4[2], r4[3]);
        *(u32x2*)(X.ybuf() + (size_t)1 * M * 256 + ((size_t)b * SEQ + t) * 256 + h * 64 + d4) = o; }
    __builtin_amdgcn_fence(__ATOMIC_RELEASE, "workgroup"); __builtin_amdgcn_wave_barrier(); }
    __syncthreads();
}

constexpr int LR_HH = 0, LR_HL = 33280, LR_PART = 66560, LR_LG = 82944, LR_CNT = 84992, LR_PITCH = 1032;
__device__ __forceinline__ void ph_ln1_router(const Ctx& X, int l) {
    const int lane = X.lane, w = X.wave, tid = X.tid, fr = lane & 15, fq = lane >> 4;
    LAS bf16_t* Hh = (LAS bf16_t*)(X.lds + LR_HH); LAS bf16_t* Hl = (LAS bf16_t*)(X.lds + LR_HL);
    LAS float* part = (LAS float*)(X.lds + LR_PART);
    LAS float* lgt = (LAS float*)(X.lds + LR_LG);
    LAS unsigned* wgcnt = (LAS unsigned*)(X.lds + LR_CNT);
    if (tid < 32) wgcnt[tid] = 0u;
    bf16x8 Ahi[2][4], Alo[2][4];
    { const bf16_t* rf = (const bf16_t*)(X.ws + WS_RFR);
#pragma unroll
      for (int rt = 0; rt < 2; ++rt)
#pragma unroll
          for (int q = 0; q < 4; ++q) { const size_t o = ((size_t)(rt * 32 + 4 * w + q) * 64 + lane) * 8; Ahi[rt][q] = *(const bf16x8*)(rf + o); Alo[rt][q] = *(const bf16x8*)(rf + 32768 + o); } }
    float* xo = X.a->out; bf16_t* hb = X.hbuf(); float* xw = (X.dbg & 8) ? (float*)(X.ws + WS_ACT) : xo; const bf16_t* v16 = (const bf16_t*)(X.ws + WS_V16);
    const int tok0 = X.c * 128, b = tok0 >> 13;
    const float* mv = X.modv(l, 1) + b * 3072;
    const float* lg = X.in(I_LN1G) + l * D; const float* lb = X.in(I_LN1B) + l * D;
    const int e = lane & 31;
    const float rbias = X.in(I_RB)[l * NEXP + e];
    unsigned* pinfo = (unsigned*)(X.ws + WS_PINFO); float* pgate = (float*)(X.ws + WS_PGATE);
    __syncthreads();
    for (int pass = 0; pass < 8; ++pass) {
#pragma unroll
        for (int jj = 0; jj < 2; ++jj) {
            const int r = 2 * w + jj, tok = tok0 + pass * 16 + r;
            f32x4 v[4]; float s = 0.f;
#pragma unroll
            for (int j = 0; j < 4; ++j) { const u32x2 q2 = *(const u32x2*)(v16 + (size_t)tok * D + 4 * lane + 256 * j); v[j] = (f32x4){bflo(q2.x), bfhi(q2.x), bflo(q2.y), bfhi(q2.y)}; s += (v[j][0] + v[j][1]) + (v[j][2] + v[j][3]); }
            const float mean = wave_sum(s) * (1.0f / D); float q = 0.f;
#pragma unroll
            for (int j = 0; j < 4; ++j) { v[j] = v[j] - mean; q += (v[j][0] * v[j][0] + v[j][1] * v[j][1]) + (v[j][2] * v[j][2] + v[j][3] * v[j][3]); }
            const float rstd = rsqrtf(wave_sum(q) * (1.0f / D) + LN_EPS);
#pragma unroll
            for (int j = 0; j < 4; ++j) { const int col = 4 * lane + 256 * j;
                const f32x4 x1 = v[j] * rstd * *(const f32x4*)(lg + col) + *(const f32x4*)(lb + col);
                *(f32x4*)(xw + (size_t)tok * D + col) = x1 * DN_ALPHA;
                const f32x4 hv = x1 * (*(const f32x4*)(mv + 1024 + col) + 1.0f) + *(const f32x4*)(mv + col);
                const unsigned h0 = f2bf(hv[0]), h1 = f2bf(hv[1]), h2 = f2bf(hv[2]), h3 = f2bf(hv[3]);
                u32x2 o; o.x = h0 | (h1 << 16); o.y = h2 | (h3 << 16); *(u32x2*)(hb + (size_t)tok * D + col) = o;
                *(LAS u32x2*)(Hh + r * LR_PITCH + col) = o;
                u32x2 ol; ol.x = pk2(hv[0] - bflo(h0), hv[1] - bflo(h1)); ol.y = pk2(hv[2] - bflo(h2), hv[3] - bflo(h3)); *(LAS u32x2*)(Hl + r * LR_PITCH + col) = ol; }
        }
        __syncthreads();
        {
            f32x4 acc0 = (f32x4){0.f, 0.f, 0.f, 0.f}, acc1 = acc0;
#pragma unroll
            for (int q = 0; q < 4; ++q) { const int ko = fr * LR_PITCH + (4 * w + q) * 32 + 8 * fq;
                const bf16x8 bh = *(const LAS bf16x8*)(Hh + ko), bl = *(const LAS bf16x8*)(Hl + ko);
                acc0 = mfma16(Ahi[0][q], bh, acc0); acc0 = mfma16(Ahi[0][q], bl, acc0); acc0 = mfma16(Alo[0][q], bh, acc0);
                acc1 = mfma16(Ahi[1][q], bh, acc1); acc1 = mfma16(Ahi[1][q], bl, acc1); acc1 = mfma16(Alo[1][q], bh, acc1); }
#pragma unroll
            for (int i = 0; i < 4; ++i) { part[(w * 32 + 4 * fq + i) * 16 + fr] = acc0[i]; part[(w * 32 + 16 + 4 * fq + i) * 16 + fr] = acc1[i]; }
        }
        __syncthreads();
        { const int ee = tid >> 4, tk = tid & 15; float sm = 0.f;
#pragma unroll
          for (int q = 0; q < 8; ++q) sm += part[(q * 32 + ee) * 16 + tk];
          lgt[tk * 32 + ee] = sm; }
        __syncthreads();
#pragma unroll
        for (int jj = 0; jj < 2; ++jj) {
            const int r = 2 * w + jj, tok = tok0 + pass * 16 + r;
            const float score = sigmoidf_(lgt[r * 32 + e]), biased = score + rbias;
            const int gbase = lane & ~3;
            const float v0 = __shfl(biased, gbase), v1 = __shfl(biased, gbase + 1), v2 = __shfl(biased, gbase + 2), v3 = __shfl(biased, gbase + 3);
            const float a_ = fmaxf(v0, v1), b_ = fminf(v0, v1), c_ = fmaxf(v2, v3), d_ = fminf(v2, v3);
            const float gs = fmaxf(a_, c_) + fmaxf(fminf(a_, c_), fmaxf(b_, d_));
            const int myg = e >> 2; int grank = 0;
#pragma unroll
            for (int g2 = 0; g2 < 8; ++g2) { const float o = __shfl(gs, 4 * g2); grank += (o > gs || (o == gs && g2 < myg)) ? 1 : 0; }
            const float masked = (grank < 4) ? biased : -3.0e38f;
            int erank = 0;
#pragma unroll
            for (int e2 = 0; e2 < 32; ++e2) { const float o = __shfl(masked, e2); erank += (o > masked || (o == masked && e2 < e)) ? 1 : 0; }
            const bool sel = (erank < 8) && (lane < 32);
            const float wsum = wave_sum(sel ? score : 0.f);
            const float gate = score / wsum * 2.5f;
            const unsigned long long bal = __ballot(sel);
            if (sel) { const int k = __popcll(bal & ((1ull << lane) - 1ull));
                const unsigned lr = __hip_atomic_fetch_add(wgcnt + e, 1u, __ATOMIC_RELAXED, __HIP_MEMORY_SCOPE_WORKGROUP);
                pinfo[(size_t)tok * 8 + k] = (unsigned)e | (lr << 8); pgate[(size_t)tok * 8 + k] = gate; }
        }
    }
    __syncthreads();
    if (tid < 32) { const int chunk = tok0 / CHTOK; unsigned* cnt = (unsigned*)(X.ws + WS_CTL) + CW_CNT + (l * NCH + chunk) * 64;
        const unsigned base = __hip_atomic_fetch_add(cnt + tid, wgcnt[tid], __ATOMIC_RELAXED, __HIP_MEMORY_SCOPE_AGENT);
        ((unsigned*)(X.ws + WS_WGBASE))[X.c * 32 + tid] = base; }
    __syncthreads();
}

__device__ __forceinline__ void moe_offsets(const Ctx& X, int l, int chunk, LAS int* off  , LAS int* cntl  ) {
    if (X.tid == 0) { const unsigned* cnt = (const unsigned*)(X.ws + WS_CTL) + CW_CNT + (l * NCH + chunk) * 64; int o = 0;
        for (int e = 0; e < NE1; ++e) { const int cn = (e < NEXP) ? (int)__hip_atomic_load(cnt + e, __ATOMIC_RELAXED, __HIP_MEMORY_SCOPE_AGENT) : CHTOK; off[e] = o; cntl[e] = cn; o += ((cn + 255) >> 8) << 8; }
        off[NE1] = o; }
    __syncthreads();
}
#define ST_WT(p, v) __hip_atomic_store((p), (v), __ATOMIC_RELAXED, __HIP_MEMORY_SCOPE_AGENT)
__device__ __forceinline__ void ph_fill(const Ctx& X, int l) {
    LAS int* off = (LAS int*)(X.lds); LAS int* cntl = off + 64;
    const int tok0 = X.c * 128, chunk = tok0 / CHTOK;
    moe_offsets(X, l, chunk, off, cntl);
    unsigned* rowtok = (unsigned*)(X.ws + WS_ROWTOK) + (size_t)chunk * CH_ROWS; float* rowgate = (float*)(X.ws + WS_ROWGATE) + (size_t)chunk * CH_ROWS;
    const unsigned* pinfo = (const unsigned*)(X.ws + WS_PINFO); const float* pgate = (const float*)(X.ws + WS_PGATE); unsigned* slot = (unsigned*)(X.ws + WS_SLOT);
    const unsigned* wgb = (const unsigned*)(X.ws + WS_WGBASE) + X.c * 32;
    for (int i = X.tid; i < 1024; i += 512) { const size_t pi = (size_t)tok0 * 8 + i; const unsigned inf = pinfo[pi]; const int e = inf & 255, lr = inf >> 8;
        const int pos = off[e] + (int)wgb[e] + lr; ST_WT(rowtok + pos, (unsigned)(tok0 + (i >> 3))); ST_WT((unsigned*)rowgate + pos, __builtin_bit_cast(unsigned, pgate[pi])); slot[pi] = (unsigned)pos; }
    if (X.tid < 128) { const int tok = tok0 + X.tid; const int pos = off[NEXP] + (tok - chunk * CHTOK); ST_WT(rowtok + pos, (unsigned)tok); ST_WT((unsigned*)rowgate + pos, __builtin_bit_cast(unsigned, 1.0f)); }
    const int wl = X.c & 63;
    if (wl < NEXP) { const int e = wl; const int p0 = off[e] + cntl[e], p1 = off[e + 1]; for (int p = p0 + X.tid; p < p1; p += 512) { ST_WT(rowtok + p, (unsigned)(chunk * CHTOK)); ST_WT((unsigned*)rowgate + p, 0u); } }
    __syncthreads();
}

template <int NT, bool GATH>
struct MoeOrder {
    static constexpr bool GATHER = GATH;
    int nwg, G, c; const LAS unsigned char* tile_e; const LAS int* rowtab;
    __device__ __forceinline__ bool next(int i, pg8::Unit& u) const {
        const long L = (long)i * G + c; if (L >= nwg) return false;
        const int wgid = pg8::xcd_remap((int)L, nwg); const int tau = wgid / NT, pn = wgid % NT;
        u.pm = tau; u.pn = pn; u.bt = __builtin_amdgcn_readfirstlane((int)tile_e[tau]) * NT + pn; u.ab = i; return true;
    }
    __device__ __forceinline__ int row_of(const pg8::Unit& u, int r) const { return rowtab[u.ab * 256 + r]; }
    __device__ __forceinline__ void a_ready(const pg8::Unit&) const {}
    __device__ __forceinline__ void done(const pg8::Unit&) const {}
};
struct MoeOrderAll {
    static constexpr bool GATHER = true;
    int nwg, G, c; const LAS unsigned char* tile_e4; const LAS int* tprefix; const LAS int* rowtab;
    __device__ __forceinline__ bool next(int i, pg8::Unit& u) const {
        const long L = (long)i * G + c; if (L >= nwg) return false;
        const int wgid = pg8::xcd_remap((int)L, nwg); const int gt = wgid >> 1, pn = wgid & 1;
        int ch = 0;
#pragma unroll
        for (int q = 1; q < NCH; ++q) ch += (tprefix[q] <= gt) ? 1 : 0;
        ch = __builtin_amdgcn_readfirstlane(ch); const int tau = gt - __builtin_amdgcn_readfirstlane(tprefix[ch]);
        u.pm = ch * CH_TILES + tau; u.pn = pn; u.bt = __builtin_amdgcn_readfirstlane((int)tile_e4[ch * 336 + tau]) * 2 + pn; u.ab = i; return true;
    }
    __device__ __forceinline__ int row_of(const pg8::Unit& u, int r) const { return rowtab[u.ab * 256 + r]; }
    __device__ __forceinline__ void a_ready(const pg8::Unit&) const {}
    __device__ __forceinline__ void done(const pg8::Unit&) const {}
};
__device__ __forceinline__ int moe_tiles(const Ctx& X, int l, int chunk, LAS unsigned char* tile_e, LAS int* off, LAS int* cntl) {
    moe_offsets(X, l, chunk, off, cntl);
    const int ntile = off[NE1] >> 8;
    for (int t = X.tid; t < ntile; t += 512) { int e = 0; for (int q = 1; q < NE1; ++q) e += (off[q] <= t * 256) ? 1 : 0; tile_e[t] = (unsigned char)e; }
    __syncthreads();
    return ntile;
}

__device__ __forceinline__ void ph_combine(const Ctx& X, int l, int chunk, LAS int* off) {
    const int lane = X.lane; const int gw = X.c * 8 + X.wave;
    float* xo = X.a->out; bf16_t* hb = X.hbuf(); float* xw = (X.dbg & 8) ? (float*)(X.ws + WS_ACT) : xo;
    const bf16_t* op = (const bf16_t*)(X.ws + WS_OPAIR); const unsigned* slot = (const unsigned*)(X.ws + WS_SLOT);
    const int b = (chunk * CHTOK) >> 13; const float* mv2 = X.modv(l, 1) + b * 3072;
    const float* lg = X.in(I_LN2G) + l * D; const float* lb = X.in(I_LN2B) + l * D;
    const int offsh = off[NEXP];
    for (int i = 0; i < 4; ++i) {
        const int tok = chunk * CHTOK + gw * 4 + i;
        f32x4 sm[4];
#pragma unroll
        for (int j = 0; j < 4; ++j) sm[j] = (f32x4){0.f, 0.f, 0.f, 0.f};
#pragma unroll
        for (int k = 0; k < 9; ++k) { const int pos = (k < 8) ? (int)slot[(size_t)tok * 8 + k] : offsh + (tok - chunk * CHTOK);
            const bf16_t* rp = op + (size_t)pos * 1024 + 4 * lane;
#pragma unroll
            for (int j = 0; j < 4; ++j) { const u32x2 q = *(const u32x2*)(rp + 256 * j); sm[j][0] += bflo(q.x); sm[j][1] += bfhi(q.x); sm[j][2] += bflo(q.y); sm[j][3] += bfhi(q.y); } }
        f32x4 v[4]; float s = 0.f;
#pragma unroll
        for (int j = 0; j < 4; ++j) { const int col = 4 * lane + 256 * j; v[j] = *(const f32x4*)(xo + (size_t)tok * D + col) + (*(const f32x4*)(mv2 + 2048 + col) + 1.0f) * sm[j]; s += (v[j][0] + v[j][1]) + (v[j][2] + v[j][3]); }
        const float mean = wave_sum(s) * (1.0f / D); float q = 0.f;
#pragma unroll
        for (int j = 0; j < 4; ++j) { v[j] = v[j] - mean; q += (v[j][0] * v[j][0] + v[j][1] * v[j][1]) + (v[j][2] * v[j][2] + v[j][3] * v[j][3]); }
        const float rstd = rsqrtf(wave_sum(q) * (1.0f / D) + LN_EPS);
#pragma unroll
        for (int j = 0; j < 4; ++j) { const int col = 4 * lane + 256 * j;
            const f32x4 x2 = v[j] * rstd * *(const f32x4*)(lg + col) + *(const f32x4*)(lb + col);
            *(f32x4*)(xw + (size_t)tok * D + col) = x2;
            if (l + 1 < DEPTH) { const float* mv1 = X.modv(l + 1, 0) + b * 3072; const f32x4 hn = x2 * (*(const f32x4*)(mv1 + 1024 + col) + 1.0f) + *(const f32x4*)(mv1 + col);
                u32x2 o; o.x = pk2(hn[0], hn[1]); o.y = pk2(hn[2], hn[3]); *(u32x2*)(hb + (size_t)tok * D + col) = o; } }
    }
}

struct POrder : pg8::StaticOrder { __device__ __forceinline__ bool next(int i, pg8::Unit& u) const { if (!pg8::StaticOrder::next(i, u)) return false; u.ab = u.pn >> 2; return true; } };
struct GOrder { static constexpr bool GATHER = false; int G, c;
    __device__ __forceinline__ bool next(int i, pg8::Unit& u) const { const int tile = (i >> 2) * G + c; if (tile >= 512) return false; const int wg = pg8::xcd_remap(tile, 512); const int br = i & 3, mt = wg & 3;
        u.pm = wg >> 2; u.pn = br * 4 + mt; u.bt = br * 4 + mt; u.ab = 0; return true; }
    __device__ __forceinline__ void a_ready(const pg8::Unit&) const {} __device__ __forceinline__ void done(const pg8::Unit&) const {} };
__global__ void __launch_bounds__(512, 2) fwd_kernel(Args args) {
    extern __shared__ __attribute__((aligned(16))) unsigned char lds_raw[];
    ArgsP ap = (ArgsP)__builtin_amdgcn_kernarg_segment_ptr();
    Ctx X; X.a = ap; X.ws = ap->ws; X.lds = (LAS unsigned char*)lds_raw;
    X.tid = threadIdx.x; X.lane = X.tid & 63; X.wave = __builtin_amdgcn_readfirstlane(X.tid >> 6); X.G = gridDim.x;
    { const int bx = blockIdx.x; X.bx = bx; X.c = (X.G % 8 == 0) ? (bx % 8) * (X.G / 8) + bx / 8 : bx; }
    const int c0_ = X.c, g0_ = X.G, bx0_ = X.bx, wave0_ = X.wave;
    volatile LAS unsigned* misc = (volatile LAS unsigned*)(X.lds + LDS_MISC);
    if (X.tid < 16) misc[X.tid] = 0u;
    __syncthreads();
    XcdBarrier bar; bar.bar = (unsigned*)(X.ws + WS_CTL) + CW_BAR; bar.x = 0; bar.st = misc;
#if !MK_PER_PHASE
    bar = xcd_barrier_post((unsigned*)(X.ws + WS_CTL) + CW_BAR, misc);
#endif
    const int lo = ap->ph_lo, hi = ap->ph_hi; int ph = 0;
#define RELAUNDER() do { int wv_ = wave0_; asm volatile("" : "+s"(wv_)); int t_ = wv_ * 64 + (int)__builtin_amdgcn_mbcnt_hi(~0u, __builtin_amdgcn_mbcnt_lo(~0u, 0u)); asm volatile("" : "+v"(t_)); X.tid = t_; X.lane = t_ & 63; X.wave = wv_; } while (0)
#define REPEAT(N, stmt) _Pragma("nounroll") for (int rp_ = 0; rp_ < (N); ++rp_) { stmt; if (rp_ + 1 < (N)) xcd_barrier(bar); }
#define PH_BEGIN if (ph >= lo && ph < hi) { { ArgsP apl = ap; asm volatile("" : "+s"(apl)); X.a = apl; X.ws = apl->ws; X.dbg = apl->dbg; int wv_ = wave0_; asm volatile("" : "+s"(wv_)); int t_ = wv_ * 64 + (int)__builtin_amdgcn_mbcnt_hi(~0u, __builtin_amdgcn_mbcnt_lo(~0u, 0u)); asm volatile("" : "+v"(t_)); X.tid = t_; X.lane = t_ & 63; X.wave = wv_; int c_ = c0_, g_ = g0_, b_ = bx0_; asm volatile("" : "+s"(c_), "+s"(g_), "+s"(b_)); X.c = c_; X.G = g_; X.bx = b_; } unsigned char* wb = X.ws + WS_W; LAS unsigned char* gl = X.lds; const float* xin = (l_ == 0) ? X.in(I_X) : (const float*)X.a->out; (void)wb; (void)gl; (void)xin;
#if MK_PER_PHASE
#define PH_END } ++ph;
#else
#define PH_END if (ph + 1 < hi) xcd_barrier(bar); } ++ph;
#endif
    int l_ = 0;
    PH_BEGIN if (EN_PROLOGUE) { REPEAT(R_MISC, ph_prologue(X)) } PH_END
    for (int l = 0; l < DEPTH; ++l) {
        l_ = l;
        PH_BEGIN if (EN_WCONV) { REPEAT(R_MISC, ph_wconv(X, l)) } PH_END
        PH_BEGIN if (EN_GWIN)  { pg8::Gemm g{X.hbuf(), (const bf16_t*)(wb + WO_IN), 1024, 0}; pg8::StaticOrder S; S.init(M, PJ, X.G, X.bx); pg8::EpiBf16 E{X.proj(), PJ};
            REPEAT(R_GWIN, (pg8::gemm_phase<pg8::EpiBf16, pg8::StaticOrder, G_ALIGN, G_SP2>(gl, g, S, E, X.tid))) } PH_END
        PH_BEGIN if (EN_MX1)  {
            if (!(X.dbg & 1)) mx_rope(X);
            _Pragma("nounroll") for (int rp_ = 0; rp_ < R_MIX; ++rp_) {
            if (!(X.dbg & 2)) for (int u = X.c; u < 256; u += X.G) mx_gmlp(X, l, u);
            if (!(X.dbg & 4)) for (int wu = X.c * 8 + X.wave; wu < 2048; wu += X.G * 8) mx_s5<1>(X, l, wu);
            __syncthreads();
            if (!(X.dbg & 8)) for (int u = X.c; u < 256; u += X.G) mx_ssd<1>(X, l, u); }
        } PH_END
        PH_BEGIN if (EN_MX2)  {
            if (!(X.dbg & 32)) { mx_ssd_carry(X); mx_s5_carry(X); } RELAUNDER();
            _Pragma("nounroll") for (int rp_ = 0; rp_ < R_DSA; ++rp_)
            for (int r = 0; r < 16; ++r) { const int cl = X.c & 63; const int uu = (r & 1) ? r * 64 + 63 - cl : r * 64 + cl; if (EN_DSA && !(X.dbg & 64) && X.c < 256) mx_dsa(X, X.c >> 6, uu * 8); }
            __syncthreads(); RELAUNDER();
            for (int wu = X.c * 8 + X.wave; EN_S53 && !(X.dbg & 16) && wu < 2048; wu += X.G * 8) mx_s5<3>(X, l, wu);
        } PH_END
        PH_BEGIN if (EN_GLU)  { for (int u = X.c; EN_SSD3 && u < 256; u += X.G) mx_ssd<3>(X, l, u);
            __syncthreads(); RELAUNDER();
            pg8::Gemm g{(const bf16_t*)(X.ws + WS_YCPRE), (const bf16_t*)(wb + WO_GLU), 256, 0}; pg8::StaticOrder S; S.init(M, 256, X.G, X.bx);
            pg8::EpiGlu E{(const bf16_t*)(X.ws + WS_YCPRE), X.ybuf() + (size_t)2 * M * 256, X.in(I_S5GLUB) + l * 256};
            REPEAT(R_GLU, (pg8::gemm_phase<pg8::EpiGlu, pg8::StaticOrder, G_ALIGN, G_SP2>(gl, g, S, E, X.tid))) } PH_END
        PH_BEGIN if (EN_GP)  { pg8::Gemm g{X.ybuf(), (const bf16_t*)(wb + WO_BR), 256, (size_t)M * 256};
            POrder S;
            S.init(M, 4096, X.G, X.bx); pg8::EpiBf16 E{(bf16_t*)(X.ws + WS_P), 4096};
            REPEAT(R_GP, (pg8::gemm_phase<pg8::EpiBf16, POrder, G_ALIGN, G_SP2>(gl, g, S, E, X.tid))) } PH_END
        PH_BEGIN if (EN_GGATE)  { pg8::Gemm g{X.hbuf(), (const bf16_t*)(wb + WO_GATE), 1024, 0};
            GOrder S{X.G, X.bx};
            pg8::EpiGateMerge E{(const bf16_t*)(X.ws + WS_P), X.ybuf()};
            REPEAT(R_GGATE, (pg8::gemm_phase<pg8::EpiGateMerge, GOrder, G_ALIGN, G_SP2>(gl, g, S, E, X.tid))) } PH_END
        PH_BEGIN if (EN_GOUT)  { pg8::Gemm g{X.ybuf(), (const bf16_t*)(wb + WO_OUT), 1024, 0}; pg8::StaticOrder S; S.init(M, 1024, X.G, X.bx);
            pg8::EpiResid E{xin, (bf16_t*)(X.ws + WS_V16), X.modv(l, 0)};
            pg8::gemm_phase<pg8::EpiResid, pg8::StaticOrder, G_ALIGN, G_SP2>(gl, g, S, E, X.tid); } PH_END
        PH_BEGIN if (EN_LN1)  ph_ln1_router(X, l); PH_END
        PH_BEGIN if (EN_FILL) { REPEAT(R_MISC, ph_fill(X, l)) } PH_END
        PH_BEGIN if (EN_MOE1)  {
            LAS int* off4 = (LAS int*)(X.lds + LDS_TAB + 1024); LAS unsigned char* tile_e4 = (LAS unsigned char*)(X.lds + LDS_TAB + 2048); LAS int* tprefix = (LAS int*)(X.lds + LDS_TAB + 3584);
            if (X.tid < NCH) { const int chn = X.tid; const unsigned* cnt = (const unsigned*)(X.ws + WS_CTL) + CW_CNT + (l * NCH + chn) * 64; int o = 0;
                for (int e = 0; e < NE1; ++e) { const int cn = (e < NEXP) ? (int)__hip_atomic_load(cnt + e, __ATOMIC_RELAXED, __HIP_MEMORY_SCOPE_AGENT) : CHTOK; off4[chn * 64 + e] = o; o += ((cn + 255) >> 8) << 8; }
                off4[chn * 64 + NE1] = o; }
            __syncthreads();
            if (X.tid == 0) { int a = 0; for (int q = 0; q < NCH; ++q) { tprefix[q] = a; a += off4[q * 64 + NE1] >> 8; } tprefix[NCH] = a; }
            for (int t = X.tid; t < NCH * 336; t += 512) { const int chn = t / 336, tau = t % 336; int e = 0; for (int q = 1; q < NE1; ++q) e += (off4[chn * 64 + q] <= tau * 256) ? 1 : 0; tile_e4[t] = (unsigned char)e; }
            __syncthreads();
            pg8::Gemm g{X.hbuf(), (const bf16_t*)(wb + WO_13), 1024, 0};
            LAS int* rowtab = (LAS int*)(X.lds + LDS_TAB + 4096);
            MoeOrderAll S{tprefix[NCH] * 2, X.G, X.bx, tile_e4, tprefix, rowtab};
            { const unsigned* rowtok = (const unsigned*)(X.ws + WS_ROWTOK); pg8::Unit uu;
              _Pragma("nounroll") for (int i = 0; i < 12; ++i) { if (!S.next(i, uu)) break; const int pmu = __builtin_amdgcn_readfirstlane(uu.pm); if (X.tid < 256) rowtab[i * 256 + X.tid] = (int)rowtok[(size_t)pmu * 256 + X.tid]; } }
            __syncthreads();
            pg8::EpiMoe1 E{(bf16_t*)(X.ws + WS_ACT), (const float*)(X.ws + WS_ROWGATE)};
            REPEAT(R_MOE, (pg8::gemm_phase<pg8::EpiMoe1, MoeOrderAll, G_ALIGN, G_SP2>(gl, g, S, E, X.tid)))
        } PH_END
        for (int ch = 0; ch < NCH; ++ch) {
            PH_BEGIN if (EN_MOE2)  {
                LAS int* off = (LAS int*)(X.lds + LDS_TAB + 1024); LAS int* cntl = off + 64; LAS unsigned char* tile_e = (LAS unsigned char*)(X.lds + LDS_TAB + 2048);
                const int ntile = moe_tiles(X, l, ch, tile_e, off, cntl);
                pg8::Gemm g{(const bf16_t*)(X.ws + WS_ACT) + (size_t)ch * CH_ROWS * 256, (const bf16_t*)(wb + WO_2), 256, 0};
                MoeOrder<4, false> S{ntile * 4, X.G, X.bx, tile_e, nullptr};
                pg8::EpiBf16 E{(bf16_t*)(X.ws + WS_OPAIR), 1024};
                REPEAT(R_MOE, (pg8::gemm_phase<pg8::EpiBf16, MoeOrder<4, false>, G_ALIGN, G_SP2>(gl, g, S, E, X.tid)))
            } PH_END
            if (ch + 1 < NCH) {
            PH_BEGIN if (EN_FIN)  { LAS int* off = (LAS int*)(X.lds + LDS_TAB + 1024); LAS int* cntl = off + 64; moe_offsets(X, l, ch, off, cntl); ph_combine(X, l, ch, off); } PH_END
            }
        }
        PH_BEGIN if (EN_FIN)  { LAS int* off = (LAS int*)(X.lds + LDS_TAB + 1024); LAS int* cntl = off + 64; moe_offsets(X, l, NCH - 1, off, cntl); ph_combine(X, l, NCH - 1, off); } PH_END
    }
#undef PH_BEGIN
#undef PH_END
}
constexpr int N_PHASES = 1 + DEPTH * (10 + 2 * NCH + 1);

#ifdef DBG_DUMP_OFF
__global__ void dbg_dump(const bf16_t* src, float* out, size_t n) { for (size_t i = (size_t)blockIdx.x * blockDim.x + threadIdx.x; i < n; i += (size_t)gridDim.x * blockDim.x) {
#ifdef DBG_HASH_OUT
    const unsigned bits = __builtin_bit_cast(unsigned, out[i]); out[i] = (float)((bits * 2654435761u) >> 8) * (1.0f / 16777216.0f);
#else
    const unsigned bits = src[i]; out[i] = (float)(((bits + 1u) * 2654435761u) >> 8) * (1.0f / 16777216.0f);
#endif
} }
#endif
extern "C" void kernel_launch(void* const* d_in, const int* in_sizes, int n_in, void* d_out, int out_size, void* d_ws, size_t ws_size, hipStream_t stream) {
    static int grid = 0;
    if (grid == 0) {
        if (n_in != 43 || out_size != M * D || ws_size < WS_NEED) { fprintf(stderr, "kernel_launch: unexpected shapes (n_in %d out %d ws %zu)\n", n_in, out_size, ws_size); grid = -1; return; }
        int dev = 0, cus = 0, per_cu = 0;
        if (hipGetDevice(&dev) != hipSuccess || hipDeviceGetAttribute(&cus, hipDeviceAttributeMultiprocessorCount, dev) != hipSuccess) { grid = -1; return; }
        if (hipFuncSetAttribute((const void*)fwd_kernel, hipFuncAttributeMaxDynamicSharedMemorySize, LDS_BYTES) != hipSuccess) { fprintf(stderr, "kernel_launch: hipFuncSetAttribute failed\n"); grid = -1; return; }
        if (hipOccupancyMaxActiveBlocksPerMultiprocessor(&per_cu, (const void*)fwd_kernel, 512, LDS_BYTES) != hipSuccess || per_cu < 1) fprintf(stderr, "kernel_launch: occupancy query says %d\n", per_cu);
        (void)hipGetLastError();
        grid = cus < 256 ? cus : 256;
    }
    if (grid < 0) return;
    (void)hipMemsetAsync((char*)d_ws + WS_CTL, 0, CTL_BYTES, stream);
#ifdef DBG_POISON
    (void)hipMemsetAsync((char*)d_ws + CTL_BYTES, 0xFF, WS_NEED - CTL_BYTES, stream);
    (void)hipMemsetAsync((char*)d_out, 0xFF, (size_t)M * D * 4, stream);
#endif
    Args a{};
    for (int i = 0; i < 43; ++i) a.in[i] = (const float*)d_in[i];
    a.positions = (const int*)d_in[I_POS]; a.out = (float*)d_out; a.ws = (unsigned char*)d_ws;
#if MK_PER_PHASE
#ifndef DBG_NPH
#define DBG_NPH N_PHASES
#endif
    for (int p = 0; p < DBG_NPH; ++p) { a.ph_lo = p; a.ph_hi = p + 1; hipLaunchKernelGGL(fwd_kernel, dim3(grid), dim3(512), LDS_BYTES, stream, a); }
#ifdef DBG_DUMP_OFF
    hipLaunchKernelGGL(dbg_dump, dim3(2048), dim3(256), 0, stream, (const bf16_t*)((const char*)d_ws + (size_t)(DBG_DUMP_OFF)), (float*)d_out, (size_t)M * D);
#endif
#else
    a.ph_lo = 0; a.ph_hi = N_PHASES; hipLaunchKernelGGL(fwd_kernel, dim3(grid), dim3(512), LDS_BYTES, stream, a);
#ifdef DBG_EXTRA_PH
    a.dbg = DBG_EXTRA_FLAGS;
    for (int rep = 0; rep < DBG_EXTRA_REP; ++rep) { a.ph_lo = DBG_EXTRA_PH; a.ph_hi = DBG_EXTRA_PH + 1; hipLaunchKernelGGL(fwd_kernel, dim3(grid), dim3(512), LDS_BYTES, stream, a); }
#endif
#endif
}
```

```cpp
#include <hip/hip_runtime.h>
#include <cstdio>
#include <cstdint>


#ifndef DSA_SKIP
#define DSA_SKIP 0
#endif
#ifndef DSA_PM
#define DSA_PM 0
#endif
#ifndef R_S1
#define R_S1 1
#endif
#ifndef R_S2
#define R_S2 1
#endif
#ifndef R_S3
#define R_S3 1
#endif
#ifndef EN_DSA
#define EN_DSA 1
#endif
#ifndef EN_S53
#define EN_S53 1
#endif
#ifndef EN_SSD3
#define EN_SSD3 1
#endif
#ifndef R_GWIN
#define R_GWIN 1
#endif
#ifndef R_GLU
#define R_GLU 1
#endif
#ifndef R_GP
#define R_GP 1
#endif
#ifndef R_GGATE
#define R_GGATE 1
#endif
#ifndef R_DENSE
#define R_DENSE 1
#endif
#ifndef R_MOE
#define R_MOE 1
#endif
#ifndef R_DSA
#define R_DSA 1
#endif
#ifndef R_MIX
#define R_MIX 1
#endif
#ifndef R_MISC
#define R_MISC 1
#endif
#ifndef MK_PER_PHASE
#define MK_PER_PHASE 0
#endif

#ifndef EN_PROLOGUE
#define EN_PROLOGUE 1
#endif
#ifndef EN_WCONV
#define EN_WCONV 1
#endif
#ifndef EN_GWIN
#define EN_GWIN 1
#endif
#ifndef EN_MX1
#define EN_MX1 1
#endif
#ifndef EN_MX2
#define EN_MX2 1
#endif
#ifndef EN_GLU
#define EN_GLU 1
#endif
#ifndef EN_GP
#define EN_GP 1
#endif
#ifndef EN_GGATE
#define EN_GGATE 1
#endif
#ifndef EN_GOUT
#define EN_GOUT 1
#endif
#ifndef EN_LN1
#define EN_LN1 1
#endif
#ifndef EN_FILL
#define EN_FILL 1
#endif
#ifndef EN_MOE1
#define EN_MOE1 1
#endif
#ifndef EN_MOE2
#define EN_MOE2 1
#endif
#ifndef EN_FIN
#define EN_FIN 1
#endif
#ifndef G_ALIGN
#define G_ALIGN true
#endif
#ifndef G_SP2
#define G_SP2 true
#endif
#define LAS __attribute__((address_space(3)))
#define GAS __attribute__((address_space(1)))
typedef unsigned short bf16_t;
typedef short bf16x8 __attribute__((ext_vector_type(8)));
typedef float f32x4 __attribute__((ext_vector_type(4)));
typedef float f32x2 __attribute__((ext_vector_type(2)));
typedef unsigned u32x4 __attribute__((ext_vector_type(4)));
typedef unsigned u32x2 __attribute__((ext_vector_type(2)));

constexpr int NB = 4, SEQ = 8192, M = NB * SEQ, D = 1024, DEPTH = 2;
constexpr int PJ = 2304;
constexpr int C_GU = 0, C_GV = 256, C_Q = 512, C_K = 768, C_V = 832, C_QI = 896, C_KI = 1152, C_S5 = 1216, C_Z = 1472, C_XBC = 1728, C_WI = 2240, C_DT = 2244;
constexpr int D_IN = 2248;
constexpr int NEXP = 32, NE1 = 33;
constexpr int NCH = 4, CHTOK = M / NCH;
constexpr int CH_ROWS = CHTOK * 8 + CHTOK + NE1 * 256;
constexpr float DN_ALPHA = 1.41421356237f;
constexpr float LN_EPS = 1e-5f, RMS_EPS = 1e-6f;
#ifndef PFP8
#define PFP8 1
#endif
constexpr float P_SCALE = 8.0f, O_SCALE = 32.0f;

constexpr size_t MiB = 1u << 20;
constexpr size_t WS_CTL = 0, CTL_BYTES = 1 * MiB;
constexpr size_t WS_MODV = 1 * MiB;
constexpr size_t WS_S5B = WS_MODV + 256 * 1024;
constexpr size_t WS_S5C = WS_S5B + 64 * 1024;
constexpr size_t WS_S5A = WS_S5C + 64 * 1024;
constexpr size_t WS_GMW = WS_S5A + 64 * 1024;
constexpr size_t WS_RFR = WS_GMW + 128 * 1024;
static_assert(WS_RFR + 128 * 1024 <= 2 * MiB, "misc tables");
constexpr size_t WS_S5ST = 2 * MiB;
constexpr size_t WS_ATOT = 3 * MiB;
constexpr size_t WS_WGBASE = 3 * MiB + 64 * 1024;
constexpr size_t WS_PINFO = 4 * MiB;
constexpr size_t WS_PGATE = 5 * MiB;
constexpr size_t WS_SLOT = 6 * MiB;
constexpr size_t WS_ROWTOK = 7 * MiB;
constexpr size_t WS_ROWGATE = 9 * MiB;
constexpr size_t WS_S5HIN = 11 * MiB;
constexpr size_t WS_ROPE = 12 * MiB;
constexpr size_t WS_W = 24 * MiB;
constexpr size_t WO_IN = 0, WO_GATE = WO_IN + (size_t)PJ * 1024 * 2, WO_BR = WO_GATE + (size_t)4096 * 1024 * 2, WO_OUT = WO_BR + (size_t)4 * 1024 * 256 * 2,
                 WO_GLU = WO_OUT + (size_t)1024 * 1024 * 2, WO_13 = WO_GLU + (size_t)256 * 256 * 2, WO_2 = WO_13 + (size_t)NE1 * 512 * 1024 * 2, WO_END = WO_2 + (size_t)NE1 * 1024 * 256 * 2;
static_assert(WO_END <= 72 * MiB, "weights region");
constexpr size_t WS_H = 96 * MiB;
constexpr size_t WS_Y = 160 * MiB;
constexpr size_t WS_PROJ = 224 * MiB;
constexpr size_t WS_P = 224 * MiB;
constexpr size_t WS_SSDST = 368 * MiB;
constexpr size_t WS_SSDSIN = 400 * MiB;
constexpr size_t WS_KI2 = 408 * MiB, WS_K2 = 412 * MiB, WS_V2 = 416 * MiB;
constexpr size_t WS_YCPRE = 384 * MiB;
constexpr size_t WS_V16 = 224 * MiB;
constexpr size_t WS_ACT = 160 * MiB;
constexpr size_t WS_OPAIR = 321 * MiB;
static_assert(CH_ROWS % 256 == 0 && WS_ACT + (size_t)NCH * CH_ROWS * 512 <= WS_OPAIR && WS_OPAIR + (size_t)CH_ROWS * 2048 <= 512 * MiB, "moe buffers");
constexpr int CH_TILES = CH_ROWS / 256;
constexpr size_t WS_NEED = 512 * MiB;
constexpr int CW_BAR = 4096;
constexpr int CW_CNT = 16384;

constexpr int LDS_BYTES = 160 * 1024;
constexpr int LDS_TAB = 131072;
constexpr int LDS_MISC = LDS_BYTES - 256;

__device__ __forceinline__ unsigned f2bf(float f) { unsigned u = __builtin_bit_cast(unsigned, f); return (u + 0x7fffu + ((u >> 16) & 1u)) >> 16; }
__device__ __forceinline__ unsigned pk2(float lo, float hi) { return f2bf(lo) | (f2bf(hi) << 16); }
__device__ __forceinline__ float bf2f(unsigned short b) { return __builtin_bit_cast(float, (unsigned)b << 16); }
__device__ __forceinline__ float bflo(unsigned w) { return __builtin_bit_cast(float, w << 16); }
__device__ __forceinline__ float bfhi(unsigned w) { return __builtin_bit_cast(float, w & 0xffff0000u); }
__device__ __forceinline__ float wave_sum(float v) {
#pragma unroll
    for (int o = 1; o < 64; o <<= 1) v += __shfl_xor(v, o);
    return v;
}
__device__ __forceinline__ float wave_max(float v) {
#pragma unroll
    for (int o = 1; o < 64; o <<= 1) v = fmaxf(v, __shfl_xor(v, o));
    return v;
}
__device__ __forceinline__ int wave_sum_i(int v) {
#pragma unroll
    for (int o = 1; o < 64; o <<= 1) v += __shfl_xor(v, o);
    return v;
}
__device__ __forceinline__ float sigmoidf_(float x) { return __builtin_amdgcn_rcpf(1.0f + __expf(-x)); }
__device__ __forceinline__ float siluf_(float x) { return x * __builtin_amdgcn_rcpf(1.0f + __expf(-x)); }
__device__ __forceinline__ float gelu_tanh(float x) { const float u = 1.5957691216057308f * (x + 0.044715f * x * x * x); return x * __builtin_amdgcn_rcpf(1.0f + __expf(-u)); }
__device__ __forceinline__ float softplusf_(float x) { return fmaxf(x, 0.f) + log1pf(__expf(-fabsf(x))); }
__device__ __forceinline__ void sincos_red(float ang, float& sn, float& cs) {
    const double a = (double)ang; const double q = __builtin_rint(a * 0.63661977236758134308);
    const float r = (float)(a - q * 1.57079632679489661923); const int qi = (int)q & 3;
    const float r2 = r * r;
    const float s = r * (1.0f + r2 * (-1.6666667e-1f + r2 * (8.3333333e-3f + r2 * (-1.9841270e-4f + r2 * 2.7557319e-6f))));
    const float c = 1.0f + r2 * (-0.5f + r2 * (4.1666667e-2f + r2 * (-1.3888889e-3f + r2 * (2.4801587e-5f + r2 * -2.7557319e-7f))));
    sn = (qi == 0) ? s : (qi == 1) ? c : (qi == 2) ? -s : -c;
    cs = (qi == 0) ? c : (qi == 1) ? -s : (qi == 2) ? -c : s;
}
__device__ __forceinline__ f32x4 mfma16(bf16x8 a, bf16x8 b, f32x4 c) { return __builtin_amdgcn_mfma_f32_16x16x32_bf16(a, b, c, 0, 0, 0); }
__device__ __forceinline__ unsigned cvt_pk_bf16(float lo, float hi) { unsigned r; asm volatile("v_cvt_pk_bf16_f32 %0, %1, %2" : "=v"(r) : "v"(lo), "v"(hi)); return r; }

namespace pg8 {
constexpr int BM = 256, BK = 64, HALF = 128, HTB = HALF * BK * 2, STAGE_BYTES = 8 * HTB, NXCD = 8, WGM = 8;
__host__ __device__ __forceinline__ int lds_byte(int r, int c) { const int st = (r >> 4) * 2 + (c >> 5), rr = r & 15, cc = c & 31, ob = rr * 64 + cc * 2; return st * 1024 + (ob ^ (((ob >> 9) & 1) << 5)); }
__host__ __device__ __forceinline__ void stage_rc(int b, int& R, int& C) { const int st = b / 1024, sb = b % 1024, swz = sb ^ (((sb >> 9) & 1) << 5); R = (st >> 1) * 16 + swz / 64; C = (st & 1) * 32 + (swz % 64) / 2; }
__host__ __device__ __forceinline__ int perm32(int rho) { const int n = rho >> 4, i = rho & 15; return 8 * (i >> 2) + 4 * n + (i & 3); }

struct Unit { int pm, pn, bt, ab; };
struct Gemm { const bf16_t* A; const bf16_t* Bt; int K; size_t a_sel_stride; };

__device__ __forceinline__ int xcd_remap(int wgid, int nwg) { const int q = nwg / NXCD, r = nwg % NXCD, xcd = wgid % NXCD, off = wgid / NXCD; return (xcd < r ? xcd * (q + 1) : r * (q + 1) + (xcd - r) * q) + off; }

struct StaticOrder {
    static constexpr bool GATHER = false;
    int nM, nN, nwg, G, c;
    __device__ void init(int Mr, int N, int G_, int c_) { nM = Mr / BM; nN = N / BM; nwg = nM * nN; G = G_; c = c_; }
    __device__ __forceinline__ bool next(int i, Unit& u) const {
        const long L = (long)i * G + c; if (L >= nwg) return false;
        const int wgid = xcd_remap((int)L, nwg);
        const int nig = WGM * nN, gid = wgid / nig, fm = gid * WGM, gsz = (nM - fm) < WGM ? (nM - fm) : WGM;
        u.pm = fm + ((wgid % nig) % gsz); u.pn = (wgid % nig) / gsz; u.bt = u.pn; u.ab = 0; return true;
    }
    __device__ __forceinline__ void a_ready(const Unit&) const {}
    __device__ __forceinline__ void done(const Unit&) const {}
};

template <class Epi, class Sched, bool ALIGN_EPI = false, bool SP2 = true>
__device__ __forceinline__ void gemm_phase(LAS unsigned char* lds, const Gemm g, const Sched& S, const Epi& E, const int tid) {
    const int wid = __builtin_amdgcn_readfirstlane(tid >> 6), lane = tid & 63, wr = wid >> 2, wc = wid & 3, fr = lane & 15, fq = lane >> 4;
    const int K = g.K, nt = K / BK;
    unsigned voffA[2], voffB[2];
#pragma unroll
    for (int i = 0; i < 2; ++i) { int R, C; stage_rc(tid * 16 + i * 8192, R, C); const int Rb = Epi::PERM ? ((R & ~31) + perm32(R & 31)) : R;
        voffA[i] = (unsigned)(R * K + C) * 2u; voffB[i] = (unsigned)(Rb * K + C) * 2u; }
    const size_t kstep = (size_t)(BK * 2);
    const size_t hstep = (size_t)HALF * K * 2;
    const size_t tstep = 2 * hstep;
    const unsigned ldsw = (unsigned)wid * 1024u;
    const int aoff = lds_byte(wr * 64 + fr, fq * 8), boff = lds_byte(wc * 32 + fr, fq * 8);
#define PG8_SA(b, h) (((b) * 2 + (h)) * HTB)
#define PG8_SB(b, h) ((4 + (b) * 2 + (h)) * HTB)
#define PG8_STAGE(bufoff, gbase, voff) do { _Pragma("unroll") for (int _i = 0; _i < 2; ++_i) \
        __builtin_amdgcn_global_load_lds((const unsigned*)((const char*)(gbase) + (voff)[_i]), (LAS unsigned*)(lds + (bufoff) + ldsw + _i * 8192), 16, 0, 0); } while (0)
#define PG8_GO(u) do { _Pragma("unroll") for (int _h = 0; _h < 2; ++_h) _Pragma("unroll") for (int _i = 0; _i < 2; ++_i) { int _R, _C; stage_rc(tid * 16 + _i * 8192, _R, _C); \
        cgo[_h][_i] = (unsigned)S.row_of(u, _h * HALF + _R) * (unsigned)(K * 2) + (unsigned)_C * 2u; } } while (0)
#define PG8_STAGE_A(bufoff, base, h, kb, NX) do { if constexpr (Sched::GATHER) { _Pragma("unroll") for (int _i = 0; _i < 2; ++_i) \
        __builtin_amdgcn_global_load_lds((const unsigned*)((const char*)g.A + (kb) + cgo[h][_i]), (LAS unsigned*)(lds + (bufoff) + ldsw + _i * 8192), 16, 0, 0); } \
        else { PG8_STAGE(bufoff, (base) + (size_t)(h) * hstep + (kb), voffA); } } while (0)
#define PG8_LDA(dst, b, h) do { _Pragma("unroll") for (int m = 0; m < 4; ++m) _Pragma("unroll") for (int k = 0; k < 2; ++k) dst[m][k] = *(const LAS bf16x8*)(lds + PG8_SA(b, h) + aoff + m * 2048 + k * 1024); } while (0)
#define PG8_LDB(dst, b, h) do { _Pragma("unroll") for (int n = 0; n < 2; ++n) _Pragma("unroll") for (int k = 0; k < 2; ++k) dst[n][k] = *(const LAS bf16x8*)(lds + PG8_SB(b, h) + boff + n * 2048 + k * 1024); } while (0)
#define PG8_MMA(ai, bj, At, Bt) do { __builtin_amdgcn_s_setprio(1); _Pragma("unroll") for (int m = 0; m < 4; ++m) _Pragma("unroll") for (int n = 0; n < 2; ++n) _Pragma("unroll") for (int k = 0; k < 2; ++k) \
        acc[ai][bj][m][n] = __builtin_amdgcn_mfma_f32_16x16x32_bf16(Bt[n][k], At[m][k], acc[ai][bj][m][n], 0, 0, 0); __builtin_amdgcn_s_setprio(0); } while (0)
#define PG8_WAIT_V(n) asm volatile("s_waitcnt vmcnt(" #n ")" ::: "memory")
#define PG8_WAIT_L(n) asm volatile("s_waitcnt lgkmcnt(" #n ")" ::: "memory")
#define PG8_BAR __builtin_amdgcn_s_barrier()
#define PG8_SCHED __builtin_amdgcn_sched_barrier(0)
    Unit cur, nxt; int ui = 0;
    if (!S.next(0, cur)) return;
    f32x4 acc[2][2][4][2];
#pragma unroll
    for (int a = 0; a < 2; ++a)
#pragma unroll
        for (int b = 0; b < 2; ++b)
#pragma unroll
            for (int m = 0; m < 4; ++m)
#pragma unroll
                for (int n = 0; n < 2; ++n) acc[a][b][m][n] = (f32x4){0.f, 0.f, 0.f, 0.f};
    bf16x8 At[4][2], B0[2][2], B1[2][2];
    unsigned cgo[2][2];
    if constexpr (Sched::GATHER) PG8_GO(cur);
    const char* cA = (const char*)(g.A + (size_t)cur.ab * g.a_sel_stride) + (size_t)cur.pm * tstep; const char* cB = (const char*)g.Bt + (size_t)cur.bt * tstep;
    S.a_ready(cur);
    if constexpr (SP2) {
        PG8_STAGE(PG8_SB(0, 0), cB, voffB); PG8_STAGE(PG8_SB(0, 1), cB + hstep, voffB); PG8_STAGE_A(PG8_SA(0, 0), cA, 0, (size_t)0, false); PG8_STAGE_A(PG8_SA(0, 1), cA, 1, (size_t)0, false);
        if (wr == 1) PG8_BAR;
        PG8_WAIT_V(2); PG8_BAR;
        PG8_STAGE(PG8_SB(1, 0), cB + kstep, voffB); PG8_STAGE_A(PG8_SA(1, 0), cA, 0, kstep, false); PG8_STAGE(PG8_SB(1, 1), cB + hstep + kstep, voffB);
        PG8_WAIT_V(6); PG8_BAR;
    } else {
        PG8_STAGE(PG8_SB(0, 0), cB, voffB); PG8_STAGE_A(PG8_SA(0, 0), cA, 0, (size_t)0, false); PG8_STAGE(PG8_SB(0, 1), cB + hstep, voffB); PG8_STAGE_A(PG8_SA(0, 1), cA, 1, (size_t)0, false);
        if (wr == 1) PG8_BAR;
        PG8_WAIT_V(4); PG8_BAR;
        PG8_STAGE(PG8_SB(1, 0), cB + kstep, voffB); PG8_STAGE_A(PG8_SA(1, 0), cA, 0, kstep, false); PG8_STAGE(PG8_SB(1, 1), cB + hstep + kstep, voffB);
        PG8_WAIT_V(6); PG8_BAR;
    }
    for (;;) {
        const bool has_next = S.next(ui + 1, nxt);
        const char* nA = has_next ? (const char*)(g.A + (size_t)nxt.ab * g.a_sel_stride) + (size_t)nxt.pm * tstep : cA; const char* nB = has_next ? (const char*)g.Bt + (size_t)nxt.bt * tstep : cB;
#pragma nounroll
        for (int t = 0; t < nt; t += 2) {
            const bool last = (t == nt - 2);
            const size_t k1 = (size_t)(t + 1) * kstep;
            const char* a2b = last ? nA : cA; const size_t k2 = last ? (size_t)0 : (size_t)(t + 2) * kstep; const size_t k3 = k2 + kstep;
            const char* b2 = last ? nB : cB + (size_t)(t + 2) * kstep; const char* b3 = b2 + kstep;
            if (last && has_next) S.a_ready(nxt);
            if constexpr (SP2) {
            PG8_LDB(B0, 0, 0); PG8_LDB(B1, 0, 1); PG8_SCHED; PG8_LDA(At, 0, 0); PG8_STAGE_A(PG8_SA(1, 1), cA, 1, k1, false);
            if constexpr (Sched::GATHER) { if (last && has_next) PG8_GO(nxt); }
            PG8_WAIT_V(8); PG8_WAIT_L(0); PG8_BAR; PG8_MMA(0, 0, At, B0); PG8_MMA(0, 1, At, B1); PG8_BAR; PG8_SCHED;
            PG8_LDA(At, 0, 1); PG8_STAGE(PG8_SB(0, 0), b2, voffB); PG8_STAGE(PG8_SB(0, 1), b2 + hstep, voffB); PG8_STAGE_A(PG8_SA(0, 0), a2b, 0, k2, last);
            PG8_WAIT_V(8); PG8_WAIT_L(0); PG8_BAR; PG8_MMA(1, 0, At, B0); PG8_MMA(1, 1, At, B1); PG8_BAR; PG8_SCHED;
            PG8_LDB(B0, 1, 0); PG8_LDB(B1, 1, 1); PG8_SCHED; PG8_LDA(At, 1, 0); PG8_STAGE_A(PG8_SA(0, 1), a2b, 1, k2, last);
            PG8_WAIT_V(8); PG8_WAIT_L(0); PG8_BAR; PG8_MMA(0, 0, At, B0); PG8_MMA(0, 1, At, B1); PG8_BAR; PG8_SCHED;
            PG8_LDA(At, 1, 1); PG8_STAGE(PG8_SB(1, 0), b3, voffB); PG8_STAGE(PG8_SB(1, 1), b3 + hstep, voffB); PG8_STAGE_A(PG8_SA(1, 0), a2b, 0, k3, last);
            PG8_WAIT_V(8); PG8_WAIT_L(0); PG8_BAR; PG8_MMA(1, 0, At, B0); PG8_MMA(1, 1, At, B1); PG8_BAR; PG8_SCHED;
            } else {
            PG8_LDB(B0, 0, 0); PG8_SCHED; PG8_LDA(At, 0, 0); PG8_STAGE_A(PG8_SA(1, 1), cA, 1, k1, false);
            if constexpr (Sched::GATHER) { if (last && has_next) PG8_GO(nxt); }
            PG8_WAIT_L(8); PG8_BAR; PG8_WAIT_L(0); PG8_MMA(0, 0, At, B0); PG8_BAR; PG8_SCHED;
            PG8_LDB(B1, 0, 1); PG8_STAGE(PG8_SB(0, 0), b2, voffB);
            PG8_BAR; PG8_WAIT_L(0); PG8_MMA(0, 1, At, B1); PG8_BAR;
            PG8_LDA(At, 0, 1); PG8_STAGE_A(PG8_SA(0, 0), a2b, 0, k2, last);
            PG8_BAR; PG8_WAIT_L(0); PG8_MMA(1, 0, At, B0); PG8_BAR; PG8_SCHED;
            PG8_STAGE(PG8_SB(0, 1), b2 + hstep, voffB);
            PG8_WAIT_V(6); PG8_BAR; PG8_MMA(1, 1, At, B1); PG8_BAR;
            PG8_LDB(B0, 1, 0); PG8_SCHED; PG8_LDA(At, 1, 0); PG8_STAGE_A(PG8_SA(0, 1), a2b, 1, k2, last);
            PG8_WAIT_L(8); PG8_BAR; PG8_WAIT_L(0); PG8_MMA(0, 0, At, B0); PG8_BAR; PG8_SCHED;
            PG8_LDB(B1, 1, 1); PG8_STAGE(PG8_SB(1, 0), b3, voffB);
            PG8_BAR; PG8_WAIT_L(0); PG8_MMA(0, 1, At, B1); PG8_BAR;
            PG8_LDA(At, 1, 1); PG8_STAGE_A(PG8_SA(1, 0), a2b, 0, k3, last);
            PG8_BAR; PG8_WAIT_L(0); PG8_MMA(1, 0, At, B0); PG8_BAR; PG8_SCHED;
            PG8_STAGE(PG8_SB(1, 1), b3 + hstep, voffB);
            PG8_WAIT_V(6); PG8_BAR; PG8_MMA(1, 1, At, B1); PG8_BAR;
            }
        }
        if constexpr (ALIGN_EPI) { if (wr == 0) PG8_BAR; }
        E(acc, cur, wr, wc, fr, fq); S.done(cur);
        if (!has_next) break;
#pragma unroll
        for (int a = 0; a < 2; ++a)
#pragma unroll
            for (int b = 0; b < 2; ++b)
#pragma unroll
                for (int m = 0; m < 4; ++m)
#pragma unroll
                    for (int n = 0; n < 2; ++n) acc[a][b][m][n] = (f32x4){0.f, 0.f, 0.f, 0.f};
        cur = nxt; cA = nA; cB = nB; ++ui;
        if constexpr (ALIGN_EPI) { if (wr == 1) PG8_BAR; }
    }
    PG8_WAIT_V(0);
    if constexpr (!ALIGN_EPI) { if (wr == 0) PG8_BAR; }
    PG8_BAR;
#undef PG8_SA
#undef PG8_SB
#undef PG8_STAGE
#undef PG8_STAGE_A
#undef PG8_GO
#undef PG8_LDA
#undef PG8_LDB
#undef PG8_MMA
#undef PG8_WAIT_V
#undef PG8_WAIT_L
#undef PG8_BAR
#undef PG8_SCHED
}

struct EpiBf16 {
    static constexpr bool PERM = true;
    bf16_t* O; int ldc;
    __device__ __forceinline__ void operator()(const f32x4 (&acc)[2][2][4][2], const Unit& u, int wr, int wc, int fr, int fq) const {
        const int row0 = u.pm * BM + wr * 64 + fr, col0 = u.pn * BM + wc * 32 + 8 * fq;
#pragma unroll
        for (int ai = 0; ai < 2; ++ai)
#pragma unroll
            for (int m = 0; m < 4; ++m) { bf16_t* rowp = O + (size_t)(row0 + ai * HALF + m * 16) * ldc + col0;
#pragma unroll
                for (int bj = 0; bj < 2; ++bj) { const f32x4 v0 = acc[ai][bj][m][0], v1 = acc[ai][bj][m][1];
                    u32x4 w; w.x = cvt_pk_bf16(v0[0], v0[1]); w.y = cvt_pk_bf16(v0[2], v0[3]); w.z = cvt_pk_bf16(v1[0], v1[1]); w.w = cvt_pk_bf16(v1[2], v1[3]);
                    *(u32x4*)(rowp + bj * HALF) = w; } }
    }
};
__device__ __forceinline__ unsigned pk4_fp8(float a, float b, float c, float d) { int w = 0; w = __builtin_amdgcn_cvt_pk_fp8_f32(a, b, w, false); w = __builtin_amdgcn_cvt_pk_fp8_f32(c, d, w, true); return (unsigned)w; }
__device__ __forceinline__ f32x4 clamp_fp8(f32x4 v, float sc) { f32x4 r; r[0] = __builtin_amdgcn_fmed3f(v[0] * sc, -440.f, 440.f); r[1] = __builtin_amdgcn_fmed3f(v[1] * sc, -440.f, 440.f);
    r[2] = __builtin_amdgcn_fmed3f(v[2] * sc, -440.f, 440.f); r[3] = __builtin_amdgcn_fmed3f(v[3] * sc, -440.f, 440.f); return r; }
struct EpiFp8 {
    static constexpr bool PERM = true;
    unsigned char* O; int ldc; float scale;
    __device__ __forceinline__ void operator()(const f32x4 (&acc)[2][2][4][2], const Unit& u, int wr, int wc, int fr, int fq) const {
        const int row0 = u.pm * BM + wr * 64 + fr, col0 = u.pn * BM + wc * 32 + 8 * fq;
#pragma unroll
        for (int ai = 0; ai < 2; ++ai)
#pragma unroll
            for (int m = 0; m < 4; ++m) { unsigned char* rowp = O + (size_t)(row0 + ai * HALF + m * 16) * ldc + col0;
#pragma unroll
                for (int bj = 0; bj < 2; ++bj) { const f32x4 v0 = clamp_fp8(acc[ai][bj][m][0], scale), v1 = clamp_fp8(acc[ai][bj][m][1], scale);
                    u32x2 w; w.x = pk4_fp8(v0[0], v0[1], v0[2], v0[3]); w.y = pk4_fp8(v1[0], v1[1], v1[2], v1[3]);
                    *(u32x2*)(rowp + bj * HALF) = w; } }
    }
};
struct EpiGlu {
    static constexpr bool PERM = true;
    const bf16_t* Ysrc; bf16_t* O; const float* bias;
    __device__ __forceinline__ void operator()(const f32x4 (&acc)[2][2][4][2], const Unit& u, int wr, int wc, int fr, int fq) const {
        const int row0 = u.pm * BM + wr * 64 + fr, col0 = u.pn * BM + wc * 32 + 8 * fq;
#pragma unroll
        for (int ai = 0; ai < 2; ++ai)
#pragma unroll
            for (int m = 0; m < 4; ++m) { const size_t ro = (size_t)(row0 + ai * HALF + m * 16) * 256 + col0;
#pragma unroll
                for (int bj = 0; bj < 2; ++bj) { const f32x4 v0 = acc[ai][bj][m][0], v1 = acc[ai][bj][m][1];
                    const u32x4 yv = *(const u32x4*)(Ysrc + ro + bj * HALF);
                    const f32x4 b0 = *(const f32x4*)(bias + col0 + bj * HALF), b1 = *(const f32x4*)(bias + col0 + bj * HALF + 4);
                    float o[8];
                    o[0] = bflo(yv.x) * sigmoidf_(v0[0] + b0[0]); o[1] = bfhi(yv.x) * sigmoidf_(v0[1] + b0[1]); o[2] = bflo(yv.y) * sigmoidf_(v0[2] + b0[2]); o[3] = bfhi(yv.y) * sigmoidf_(v0[3] + b0[3]);
                    o[4] = bflo(yv.z) * sigmoidf_(v1[0] + b1[0]); o[5] = bfhi(yv.z) * sigmoidf_(v1[1] + b1[1]); o[6] = bflo(yv.w) * sigmoidf_(v1[2] + b1[2]); o[7] = bfhi(yv.w) * sigmoidf_(v1[3] + b1[3]);
                    u32x4 w; w.x = cvt_pk_bf16(o[0], o[1]); w.y = cvt_pk_bf16(o[2], o[3]); w.z = cvt_pk_bf16(o[4], o[5]); w.w = cvt_pk_bf16(o[6], o[7]);
                    *(u32x4*)(O + ro + bj * HALF) = w; } }
    }
};
struct EpiGateMerge {
    static constexpr bool PERM = true;
    const unsigned char* P; bf16_t* Mg; float pinv;
    __device__ __forceinline__ void operator()(const f32x4 (&acc)[2][2][4][2], const Unit& u, int wr, int wc, int fr, int fq) const {
        const int i = u.pn >> 2, mt = u.pn & 3;
        const int row0 = u.pm * BM + wr * 64 + fr, col0 = mt * BM + wc * 32 + 8 * fq;
#pragma unroll
        for (int ai = 0; ai < 2; ++ai) {
            u32x2 pv[4][2]; u32x4 pvb[4][2]; u32x4 mv[4][2];
#pragma unroll
            for (int m = 0; m < 4; ++m)
#pragma unroll
                for (int bj = 0; bj < 2; ++bj) { const size_t r = (size_t)(row0 + ai * HALF + m * 16);
                    pv[m][bj] = PFP8 ? *(const u32x2*)(P + r * 4096 + i * 1024 + col0 + bj * HALF) : (u32x2){0u, 0u}; if (!PFP8) pvb[m][bj] = *(const u32x4*)((const bf16_t*)P + r * 4096 + i * 1024 + col0 + bj * HALF);
                    mv[m][bj] = (u32x4){0u, 0u, 0u, 0u}; if (i > 0) mv[m][bj] = *(const u32x4*)(Mg + r * 1024 + col0 + bj * HALF); }
#pragma unroll
            for (int m = 0; m < 4; ++m)
#pragma unroll
                for (int bj = 0; bj < 2; ++bj) { const size_t r = (size_t)(row0 + ai * HALF + m * 16); const f32x4 v0 = acc[ai][bj][m][0], v1 = acc[ai][bj][m][1]; const u32x2 p8 = pv[m][bj]; const u32x4 m4 = mv[m][bj];
                    f32x2 pa = __builtin_amdgcn_cvt_pk_f32_fp8((int)p8.x, false) * pinv, pb = __builtin_amdgcn_cvt_pk_f32_fp8((int)p8.x, true) * pinv,
                          pc = __builtin_amdgcn_cvt_pk_f32_fp8((int)p8.y, false) * pinv, pd = __builtin_amdgcn_cvt_pk_f32_fp8((int)p8.y, true) * pinv;
                    if (!PFP8) { const u32x4 q4 = pvb[m][bj]; pa = (f32x2){bflo(q4.x), bfhi(q4.x)}; pb = (f32x2){bflo(q4.y), bfhi(q4.y)}; pc = (f32x2){bflo(q4.z), bfhi(q4.z)}; pd = (f32x2){bflo(q4.w), bfhi(q4.w)}; }
                    float o[8];
                    o[0] = bflo(m4.x) + pa[0] * sigmoidf_(v0[0]); o[1] = bfhi(m4.x) + pa[1] * sigmoidf_(v0[1]); o[2] = bflo(m4.y) + pb[0] * sigmoidf_(v0[2]); o[3] = bfhi(m4.y) + pb[1] * sigmoidf_(v0[3]);
                    o[4] = bflo(m4.z) + pc[0] * sigmoidf_(v1[0]); o[5] = bfhi(m4.z) + pc[1] * sigmoidf_(v1[1]); o[6] = bflo(m4.w) + pd[0] * sigmoidf_(v1[2]); o[7] = bfhi(m4.w) + pd[1] * sigmoidf_(v1[3]);
                    u32x4 w; w.x = cvt_pk_bf16(o[0], o[1]); w.y = cvt_pk_bf16(o[2], o[3]); w.z = cvt_pk_bf16(o[4], o[5]); w.w = cvt_pk_bf16(o[6], o[7]);
                    *(u32x4*)(Mg + r * 1024 + col0 + bj * HALF) = w; }
        }
    }
};
struct EpiResid {
    static constexpr bool PERM = false;
    const float* xin; bf16_t* out; const float* gate;
    __device__ __forceinline__ void operator()(const f32x4 (&acc)[2][2][4][2], const Unit& u, int wr, int wc, int fr, int fq) const {
        const int row0 = u.pm * BM + wr * 64 + fr, col0 = u.pn * BM + wc * 32 + 4 * fq;
        const int b = (u.pm * BM) / SEQ;
        f32x4 gv[2][2];
#pragma unroll
        for (int bj = 0; bj < 2; ++bj)
#pragma unroll
            for (int n = 0; n < 2; ++n) gv[bj][n] = *(const f32x4*)(gate + b * 3072 + 2048 + col0 + bj * HALF + n * 16) + 1.0f;
#pragma unroll
        for (int ai = 0; ai < 2; ++ai)
#pragma unroll
            for (int mh = 0; mh < 4; mh += 2) {
                f32x4 xv[2][2][2];
#pragma unroll
                for (int m = 0; m < 2; ++m)
#pragma unroll
                    for (int bj = 0; bj < 2; ++bj)
#pragma unroll
                        for (int n = 0; n < 2; ++n) xv[m][bj][n] = *(const f32x4*)(xin + (size_t)(row0 + ai * HALF + (mh + m) * 16) * D + col0 + bj * HALF + n * 16);
#pragma unroll
                for (int m = 0; m < 2; ++m)
#pragma unroll
                    for (int bj = 0; bj < 2; ++bj)
#pragma unroll
                        for (int n = 0; n < 2; ++n) { const f32x4 v = xv[m][bj][n] * DN_ALPHA + gv[bj][n] * acc[ai][bj][mh + m][n];
                            u32x2 w; w.x = cvt_pk_bf16(v[0], v[1]); w.y = cvt_pk_bf16(v[2], v[3]);
                            *(u32x2*)(out + (size_t)(row0 + ai * HALF + (mh + m) * 16) * D + col0 + bj * HALF + n * 16) = w; } }
    }
};
struct EpiMoe1 {
    static constexpr bool PERM = false;
    bf16_t* Act; const LAS float* gtab;
    __device__ __forceinline__ void operator()(const f32x4 (&acc)[2][2][4][2], const Unit& u, int wr, int wc, int fr, int fq) const {
        const int row0 = u.pm * BM + wr * 64 + fr, f0 = u.pn * 128 + wc * 16 + 4 * fq;
#pragma unroll
        for (int ai = 0; ai < 2; ++ai)
#pragma unroll
            for (int m = 0; m < 4; ++m) { const int r = row0 + ai * HALF + m * 16; const float gt = gtab[u.ab * 256 + wr * 64 + fr + ai * HALF + m * 16];
#pragma unroll
                for (int bj = 0; bj < 2; ++bj) { const f32x4 a = acc[ai][bj][m][0], b = acc[ai][bj][m][1];
                    u32x2 w; w.x = cvt_pk_bf16(siluf_(a[0]) * b[0] * gt, siluf_(a[1]) * b[1] * gt); w.y = cvt_pk_bf16(siluf_(a[2]) * b[2] * gt, siluf_(a[3]) * b[3] * gt);
                    *(u32x2*)(Act + (size_t)r * 256 + f0 + bj * 64) = w; } }
    }
};
}

#define XB_TMO      128
#define XB_XCNT(j)  (256  + 64 * (j))
#define XB_XSUB(j)  (1280 + 64 * (j))
#define XB_XGEN(j)  (2304 + 64 * (j))
#define XB_TOP      3328
#define XB_TOPGEN   3392
#define XCD_BAR_WORDS 3456
#define XB_SPIN_CAP (1u << 22)
__device__ __forceinline__ unsigned xb_ld(unsigned* p)              { return __hip_atomic_load(p, __ATOMIC_RELAXED, __HIP_MEMORY_SCOPE_AGENT); }
__device__ __forceinline__ unsigned xb_add(unsigned* p, unsigned v) { return __hip_atomic_fetch_add(p, v, __ATOMIC_RELAXED, __HIP_MEMORY_SCOPE_AGENT); }
__device__ __forceinline__ unsigned xb_xcc_id() { return (unsigned)__builtin_amdgcn_s_getreg((3 << 11) | 20) & 0xFu; }
#define XB_SPIN(cond, bar) do { unsigned _sp = 0; while (cond) { __builtin_amdgcn_s_sleep(1); \
    if ((++_sp & 255u) == 0u) { if (xb_ld(&(bar)[XB_TMO])) break; if (_sp > XB_SPIN_CAP) { atomicAdd(&(bar)[XB_TMO], 1u); break; } } } } while (0)
struct XcdBarrier { unsigned* bar; unsigned x; volatile LAS unsigned* st; };
__device__ __forceinline__ XcdBarrier xcd_barrier_post(unsigned* bar, volatile LAS unsigned* st) {
    XcdBarrier b; b.bar = bar; b.x = xb_xcc_id(); b.st = st;
    if (threadIdx.x == 0) (void)xb_add(&bar[XB_XCNT(b.x)], 1u);
    return b;
}
__device__ __forceinline__ void xcd_barrier_complete(unsigned* bar, unsigned x, unsigned& nloc, unsigned& nx) {
    const unsigned G = gridDim.x * gridDim.y * gridDim.z;
    unsigned sum, cnt, mine, sp = 0u;
    for (;;) {
        sum = 0u; cnt = 0u; mine = 0u;
#pragma unroll
        for (unsigned j = 0; j < 16; ++j) { const unsigned c = xb_ld(&bar[XB_XCNT(j)]); sum += c; cnt += (c > 0u) ? 1u : 0u; mine = (j == x) ? c : mine; }
        if (sum == G) break;
        __builtin_amdgcn_s_sleep(1);
        if ((++sp & 255u) == 0u) { if (xb_ld(&bar[XB_TMO])) break; if (sp > XB_SPIN_CAP) { atomicAdd(&bar[XB_TMO], 1u); break; } }
    }
    nloc = mine > 0u ? mine : 1u; nx = cnt > 0u ? cnt : 1u;
}
__device__ __forceinline__ void xcd_barrier(const XcdBarrier& b) {
    asm volatile("s_waitcnt vmcnt(0)" ::: "memory");
    __syncthreads();
    if (threadIdx.x == 0) {
        unsigned* bar = b.bar;
        __builtin_amdgcn_s_waitcnt(0);
        unsigned nloc = b.st[0], nx = b.st[1];
        if (nloc == 0u) { xcd_barrier_complete(bar, b.x, nloc, nx); b.st[0] = nloc; b.st[1] = nx; }
        const unsigned old = xb_add(&bar[XB_XSUB(b.x)], 1u);
        const unsigned gen = old / nloc;
        if (old + 1u == (gen + 1u) * nloc) {
            __builtin_amdgcn_fence(__ATOMIC_RELEASE, "agent");
            asm volatile("s_waitcnt vmcnt(0)" ::: "memory");
            const unsigned og = xb_add(&bar[XB_TOP], 1u);
            const unsigned tg = og / nx;
            if (og + 1u == (tg + 1u) * nx) xb_add(&bar[XB_TOPGEN], 1u);
            else XB_SPIN(xb_ld(&bar[XB_TOPGEN]) == tg, bar);
            __builtin_amdgcn_fence(__ATOMIC_ACQUIRE, "agent");
            xb_add(&bar[XB_XGEN(b.x)], 1u);
            asm volatile("s_waitcnt vmcnt(0)" ::: "memory");
        } else {
            XB_SPIN(xb_ld(&bar[XB_XGEN(b.x)]) == gen, bar);
            __builtin_amdgcn_fence(__ATOMIC_ACQUIRE, "agent");
            asm volatile("s_waitcnt vmcnt(0)" ::: "memory");
        }
    }
    __syncthreads();
}

struct Args {
    const float* in[43]; const int* positions; float* out; unsigned char* ws; int ph_lo, ph_hi, dbg, pad;
};
enum { I_X = 0, I_C = 1, I_POS = 2, I_MOD1W = 3, I_MOD1B = 4, I_WIN = 5, I_GMLNG = 6, I_GMLNB = 7, I_GMW = 8, I_GMB = 9,
       I_S5LRE = 10, I_S5LIM = 11, I_S5STEP = 12, I_S5BRE = 13, I_S5BIM = 14, I_S5CRE = 15, I_S5CIM = 16, I_S5D = 17, I_S5GLUW = 18, I_S5GLUB = 19,
       I_CONVW = 20, I_CONVB = 21, I_DTBIAS = 22, I_ALOG = 23, I_SSDD = 24, I_SSDNG = 25, I_WBR = 26, I_WGATE = 27, I_WOUT = 28, I_LN1G = 29, I_LN1B = 30,
       I_MOD2W = 31, I_MOD2B = 32, I_RW = 33, I_RB = 34, I_EW1 = 35, I_EW3 = 36, I_EW2 = 37, I_SW1 = 38, I_SW3 = 39, I_SW2 = 40, I_LN2G = 41, I_LN2B = 42 };

typedef const __attribute__((address_space(4))) Args* ArgsP;
struct Ctx {
    ArgsP a; unsigned char* ws; LAS unsigned char* lds; int tid, lane, wave, c, G, bx, dbg;
    __device__ __forceinline__ const float* in(int i) const { return a->in[i]; }
    __device__ __forceinline__ bf16_t* proj() const { return (bf16_t*)(ws + WS_PROJ); }
    __device__ __forceinline__ bf16_t* hbuf() const { return (bf16_t*)(ws + WS_H); }
    __device__ __forceinline__ bf16_t* ybuf() const { return (bf16_t*)(ws + WS_Y); }
    __device__ __forceinline__ float* modv(int l, int w) const { return (float*)(ws + WS_MODV) + (size_t)(l * 2 + w) * NB * 3072; }
};

__device__ __forceinline__ void ph_prologue(const Ctx& X) {
    { float* ropet = (float*)(X.ws + WS_ROPE); const int* pos = X.a->positions;
      for (int i = X.c * 512 + X.tid; i < M * 8; i += X.G * 512) { const int tok = i >> 3, j = i & 7;
          const float inv = (j == 0) ? 1.0f : (j == 1) ? 0.1939227432f : (j == 2) ? 0.0376060307f : (j == 3) ? 0.00729266461f : (j == 4) ? 0.00141421356f : (j == 5) ? 0.000274248188f : (j == 6) ? 5.31829610e-05f : 1.03133862e-05f;
          float sn, cs; sincos_red((float)pos[tok] * inv, sn, cs); *(f32x2*)(ropet + (size_t)i * 2) = (f32x2){cs, sn}; } }
    LAS float* red = (LAS float*)X.lds;
    for (int it = X.c; it < DEPTH * 2 * 48; it += X.G) {
        const int l = it / 96, w = (it / 48) & 1, jb = it % 48, j = jb * 64 + X.lane;
        const float* W = X.in(w ? I_MOD2W : I_MOD1W) + (size_t)l * D * 3072; const float* cv = X.in(I_C);
        float a0 = 0.f, a1 = 0.f, a2 = 0.f, a3 = 0.f;
        const int k0 = X.wave * 128;
        for (int k = k0; k < k0 + 128; ++k) { const float wv = W[(size_t)k * 3072 + j]; a0 += cv[k] * wv; a1 += cv[D + k] * wv; a2 += cv[2 * D + k] * wv; a3 += cv[3 * D + k] * wv; }
        red[(X.wave * 4 + 0) * 64 + X.lane] = a0; red[(X.wave * 4 + 1) * 64 + X.lane] = a1; red[(X.wave * 4 + 2) * 64 + X.lane] = a2; red[(X.wave * 4 + 3) * 64 + X.lane] = a3;
        __syncthreads();
        if (X.tid < 256) { const int b = X.tid >> 6, ln = X.tid & 63; float s = 0.f;
#pragma unroll
            for (int q = 0; q < 8; ++q) s += red[(q * 4 + b) * 64 + ln];
            const int jj = jb * 64 + ln; X.modv(l, w)[b * 3072 + jj] = s + X.in(w ? I_MOD2B : I_MOD1B)[(size_t)l * 3072 + jj]; }
        __syncthreads();
    }
}

template <class Src>
__device__ __forceinline__ void tr_item(const Src& src, bf16_t* WT, int K, int rowbase, int kb, int nb, LAS float* scr, int lane) {
    const int k0 = 64 * kb, n0 = 32 * nb;
    f32x4 v[8];
#pragma unroll
    for (int i = 0; i < 8; ++i) v[i] = src.load4(k0 + 8 * i + (lane >> 3), n0 + 4 * (lane & 7));
#pragma unroll
    for (int i = 0; i < 8; ++i) { LAS float* d = scr + (8 * i + (lane >> 3)) * 33 + 4 * (lane & 7); d[0] = v[i][0]; d[1] = v[i][1]; d[2] = v[i][2]; d[3] = v[i][3]; }
    asm volatile("s_waitcnt lgkmcnt(0)" ::: "memory");
    const int c = lane & 7;
#pragma unroll
    for (int j = 0; j < 4; ++j) { const int n = (lane >> 3) + 8 * j; const LAS float* s = scr + (8 * c) * 33 + n;
        u32x4 o; o.x = pk2(s[0 * 33], s[1 * 33]); o.y = pk2(s[2 * 33], s[3 * 33]); o.z = pk2(s[4 * 33], s[5 * 33]); o.w = pk2(s[6 * 33], s[7 * 33]);
        *(u32x4*)(WT + (size_t)(rowbase + n0 + n) * K + k0 + 8 * c) = o; }
    asm volatile("s_waitcnt lgkmcnt(0)" ::: "memory");
}
struct SrcPlain { const float* W; int N; __device__ __forceinline__ f32x4 load4(int k, int n) const { return *(const f32x4*)(W + (size_t)k * N + n); } };
struct SrcWin { const float* W; __device__ __forceinline__ f32x4 load4(int k, int n) const {
    if (n >= D_IN) return (f32x4){0.f, 0.f, 0.f, 0.f}; const int o = (n < 1216) ? n : (n < 2240) ? n + 4 : (n < 2244) ? 1216 + (n - 2240) : n; return *(const f32x4*)(W + (size_t)k * D_IN + o); } };
struct Src13 { const float* W1; const float* W3; __device__ __forceinline__ f32x4 load4(int k, int n) const {
    const int f = (n >> 5) * 16 + (n & 15); const long d = (n & 16) ? (long)(W3 - W1) : 0l; return *(const f32x4*)(W1 + d + (long)k * 256 + f); } };

__device__ __forceinline__ void ph_wconv(const Ctx& X, int l) {
    LAS float* scr = (LAS float*)(X.lds + X.wave * 16384);
    unsigned char* wb = X.ws + WS_W;
    const int gw = X.c * 8 + X.wave, NGW = X.G * 8;
    constexpr int I_A = 16 * 72, I_B = 4 * 16 * 32, I_C2 = 4 * 4 * 32, I_D = 16 * 32, I_E = 4 * 8, I_F = NE1 * 16 * 16, I_G = NE1 * 4 * 32;
    constexpr int NIT = I_A + I_B + I_C2 + I_D + I_E + I_F + I_G;
    for (int it = gw; it < NIT; it += NGW) {
        int r = it;
        if (r < I_A) { SrcWin s{X.in(I_WIN) + (size_t)l * D * D_IN}; tr_item(s, (bf16_t*)(wb + WO_IN), 1024, 0, r / 72, r % 72, scr, X.lane); continue; } r -= I_A;
        if (r < I_B) { const int i = r / 512, q = r % 512; SrcPlain s{X.in(I_WGATE) + ((size_t)l * 4 + i) * D * D, D}; tr_item(s, (bf16_t*)(wb + WO_GATE), 1024, i * 1024, q / 32, q % 32, scr, X.lane); continue; } r -= I_B;
        if (r < I_C2) { const int i = r / 128, q = r % 128; SrcPlain s{X.in(I_WBR) + ((size_t)l * 4 + i) * 256 * D, D}; tr_item(s, (bf16_t*)(wb + WO_BR) + (size_t)i * 1024 * 256, 256, 0, q / 32, q % 32, scr, X.lane); continue; } r -= I_C2;
        if (r < I_D) { SrcPlain s{X.in(I_WOUT) + (size_t)l * D * D, D}; tr_item(s, (bf16_t*)(wb + WO_OUT), 1024, 0, r / 32, r % 32, scr, X.lane); continue; } r -= I_D;
        if (r < I_E) { SrcPlain s{X.in(I_S5GLUW) + (size_t)l * 256 * 256, 256}; tr_item(s, (bf16_t*)(wb + WO_GLU), 256, 0, r / 8, r % 8, scr, X.lane); continue; } r -= I_E;
        if (r < I_F) { const int e = r / 256, q = r % 256;
            const Src13 s{(e < NEXP) ? X.in(I_EW1) + ((size_t)l * NEXP + e) * D * 256 : X.in(I_SW1) + (size_t)l * D * 256, (e < NEXP) ? X.in(I_EW3) + ((size_t)l * NEXP + e) * D * 256 : X.in(I_SW3) + (size_t)l * D * 256};
            tr_item(s, (bf16_t*)(wb + WO_13) + (size_t)e * 512 * 1024, 1024, 0, q / 16, q % 16, scr, X.lane); continue; } r -= I_F;
        { const int e = r / 128, q = r % 128; SrcPlain s{e < NEXP ? X.in(I_EW2) + ((size_t)l * NEXP + e) * 256 * D : X.in(I_SW2) + (size_t)l * 256 * D, D};
            tr_item(s, (bf16_t*)(wb + WO_2) + (size_t)e * 1024 * 256, 256, 0, q / 32, q % 32, scr, X.lane); }
    }
    const int gt = X.c * 512 + X.tid, NGT = X.G * 512;
    { bf16_t* gmw = (bf16_t*)(X.ws + WS_GMW); const float* src = X.in(I_GMW) + (size_t)l * 4 * 128 * 128;
      for (int i = gt; i < 4 * 128 * 128; i += NGT) { const int t = (i >> 7) & 127, s = i & 127; gmw[i] = (bf16_t)f2bf(s <= t ? src[i] : 0.f); } }
    for (int i = gt; i < 16 * 64; i += NGT) {
        const int g = i >> 6, p = i & 63;
        const float step = expf(X.in(I_S5STEP)[l * 16 + g]); const float lr = X.in(I_S5LRE)[(size_t)l * 1024 + i], li = X.in(I_S5LIM)[(size_t)l * 1024 + i];
        const float mag = expf(lr * step); float sn, cs; sincos_red(li * step, sn, cs);
        const float abr = mag * cs, abi = mag * sn, den = lr * lr + li * li, nr = abr - 1.0f;
        const float cr = (nr * lr + abi * li) / den, ci = (abi * lr - nr * li) / den;
        float* sa = (float*)(X.ws + WS_S5A); sa[i * 2] = abr; sa[i * 2 + 1] = abi;
        bf16_t* bb = (bf16_t*)(X.ws + WS_S5B); bf16_t* cm = (bf16_t*)(X.ws + WS_S5C);
        const float* bre = X.in(I_S5BRE) + ((size_t)l * 1024 + i) * 16; const float* bim = X.in(I_S5BIM) + ((size_t)l * 1024 + i) * 16;
#pragma unroll
        for (int ch = 0; ch < 16; ++ch) { const float br = bre[ch], bi = bim[ch];
            bb[(g * 128 + p) * 16 + ch] = (bf16_t)f2bf(cr * br - ci * bi); bb[(g * 128 + 64 + p) * 16 + ch] = (bf16_t)f2bf(cr * bi + ci * br);
            cm[(g * 16 + ch) * 128 + p] = (bf16_t)f2bf(X.in(I_S5CRE)[(((size_t)l * 16 + g) * 16 + ch) * 64 + p]);
            cm[(g * 16 + ch) * 128 + 64 + p] = (bf16_t)f2bf(-X.in(I_S5CIM)[(((size_t)l * 16 + g) * 16 + ch) * 64 + p]); }
    }
    { bf16_t* rf = (bf16_t*)(X.ws + WS_RFR); const float* rw = X.in(I_RW) + (size_t)l * D * NEXP;
      for (int i = gt; i < 2 * 32 * 64 * 8; i += NGT) { const int j = i & 7, ln = (i >> 3) & 63, ks = (i >> 9) & 31, rt = i >> 14;
          const float v = rw[(size_t)(ks * 32 + 8 * (ln >> 4) + j) * NEXP + rt * 16 + (ln & 15)]; const unsigned hi = f2bf(v); const float lo = v - bflo(hi);
          rf[i] = (bf16_t)hi; rf[32768 + i] = (bf16_t)f2bf(lo); } }
    if (l == 0) {
        const float* x = X.in(I_X); bf16_t* h = X.hbuf(); const float* mv = X.modv(0, 0);
        for (size_t i = (size_t)gt; i < (size_t)M * D / 8; i += NGT) {
            const size_t e = i * 8; const int col = (int)(e & 1023), b = (int)(e >> 23);
            const f32x4 x0 = *(const f32x4*)(x + e), x1 = *(const f32x4*)(x + e + 4);
            const f32x4 sh0 = *(const f32x4*)(mv + b * 3072 + col), sh1 = *(const f32x4*)(mv + b * 3072 + col + 4), sc0 = *(const f32x4*)(mv + b * 3072 + 1024 + col), sc1 = *(const f32x4*)(mv + b * 3072 + 1024 + col + 4);
            const f32x4 h0 = x0 * (sc0 + 1.0f) + sh0, h1 = x1 * (sc1 + 1.0f) + sh1;
            u32x4 w; w.x = pk2(h0[0], h0[1]); w.y = pk2(h0[2], h0[3]); w.z = pk2(h1[0], h1[1]); w.w = pk2(h1[2], h1[3]);
            *(u32x4*)(h + e) = w; }
    }
}

__device__ __forceinline__ void rope8(const u32x4 a, const u32x4 b, const float* cs, u32x4& wa, u32x4& wb) {
    float t1[8], t2[8]; t1[0] = bflo(a.x); t1[1] = bfhi(a.x); t1[2] = bflo(a.y); t1[3] = bfhi(a.y); t1[4] = bflo(a.z); t1[5] = bfhi(a.z); t1[6] = bflo(a.w); t1[7] = bfhi(a.w);
    t2[0] = bflo(b.x); t2[1] = bfhi(b.x); t2[2] = bflo(b.y); t2[3] = bfhi(b.y); t2[4] = bflo(b.z); t2[5] = bfhi(b.z); t2[6] = bflo(b.w); t2[7] = bfhi(b.w);
    float o1[8], o2[8]; f32x4 c4[4];
#pragma unroll
    for (int q = 0; q < 4; ++q) c4[q] = *(const f32x4*)(cs + 4 * q);
#pragma unroll
    for (int j = 0; j < 8; ++j) { const float cv = c4[j >> 1][(j & 1) * 2], sv = c4[j >> 1][(j & 1) * 2 + 1]; o1[j] = t1[j] * cv - t2[j] * sv; o2[j] = t2[j] * cv + t1[j] * sv; }
    wa.x = pk2(o1[0], o1[1]); wa.y = pk2(o1[2], o1[3]); wa.z = pk2(o1[4], o1[5]); wa.w = pk2(o1[6], o1[7]);
    wb.x = pk2(o2[0], o2[1]); wb.y = pk2(o2[2], o2[3]); wb.z = pk2(o2[4], o2[5]); wb.w = pk2(o2[6], o2[7]);
}
__device__ __forceinline__ void mx_rope(const Ctx& X) {
    bf16_t* pj = X.proj(); const float* ropet = (const float*)(X.ws + WS_ROPE);
    const int gt = X.c * 512 + X.tid, NGT = X.G * 512;
    for (int i = gt; i < M * 10; i += NGT) {
        const int tok = i / 10, hh = i % 10;
        if (hh == 9) { const u32x4* sp = (const u32x4*)(pj + (size_t)tok * PJ + C_V); u32x4* dp = (u32x4*)((bf16_t*)(X.ws + WS_V2) + (size_t)tok * 64);
#pragma unroll
            for (int q = 0; q < 8; ++q) dp[q] = sp[q];
            continue; }
        const int col = (hh < 4) ? C_Q + hh * 64 : (hh < 8) ? C_QI + (hh - 4) * 64 : C_K;
        bf16_t* p = pj + (size_t)tok * PJ + col;
        const u32x4 a = *(const u32x4*)p, b = *(const u32x4*)(p + 8);
        u32x4 wa, wb; rope8(a, b, ropet + (size_t)tok * 16, wa, wb);
        if (hh < 8) { *(u32x4*)p = wa; *(u32x4*)(p + 8) = wb; }
        else { u32x4* dp = (u32x4*)((bf16_t*)(X.ws + WS_K2) + (size_t)tok * 64); const u32x4* sp = (const u32x4*)p; dp[0] = wa; dp[1] = wb;
#pragma unroll
            for (int q = 2; q < 8; ++q) dp[q] = sp[q]; }
    }
    for (int i = gt; i < (M / 16) * 16; i += NGT) {
        const int hf = i & 1, pc = (i >> 1) & 7, tile = i >> 4; const int ks = pc >> 2, fq = pc & 3;
        u32x4* dp = (u32x4*)((bf16_t*)(X.ws + WS_KI2) + (size_t)tile * 1024 + pc * 128 + hf * 64);
#pragma unroll
        for (int j = 0; j < 8; ++j) { const int tok = tile * 16 + hf * 8 + j; const bf16_t* rp = pj + (size_t)tok * PJ + C_KI;
            u32x4 v = *(const u32x4*)(rp + ks * 32 + fq * 8);
            if (pc < 2) { const u32x4 a = *(const u32x4*)rp, b = *(const u32x4*)(rp + 8); u32x4 wa, wb; rope8(a, b, ropet + (size_t)tok * 16, wa, wb); v = pc ? wb : wa; }
            dp[j] = v; }
    }
}

__device__ __forceinline__ void mx_gmlp(const Ctx& X, int l, int unit) {
    const int lane = X.lane, w = X.wave;
    const int row0 = unit * 128;
    LAS bf16_t* Vt = (LAS bf16_t*)X.lds;
    const bf16_t* pj = X.proj();
    const float* lng = X.in(I_GMLNG) + l * 256; const float* lnb = X.in(I_GMLNB) + l * 256;
    float g4[4], b4[4];
#pragma unroll
    for (int j = 0; j < 4; ++j) { g4[j] = lng[lane + 64 * j]; b4[j] = lnb[lane + 64 * j]; }
    for (int i = 0; i < 16; ++i) {
        const int s = w * 16 + i; const bf16_t* rp = pj + (size_t)(row0 + s) * PJ + C_GV;
        float v[4]; float sm = 0.f;
#pragma unroll
        for (int j = 0; j < 4; ++j) { v[j] = gelu_tanh(bf2f(rp[lane + 64 * j])); sm += v[j]; }
        const float mean = wave_sum(sm) * (1.0f / 256.0f); float q = 0.f;
#pragma unroll
        for (int j = 0; j < 4; ++j) { v[j] -= mean; q += v[j] * v[j]; }
        const float rstd = rsqrtf(wave_sum(q) * (1.0f / 256.0f) + LN_EPS);
#pragma unroll
        for (int j = 0; j < 4; ++j) Vt[(lane + 64 * j) * 136 + s] = (bf16_t)f2bf(v[j] * rstd * g4[j] + b4[j]);
    }
    __syncthreads();
    const int g = w >> 1, c0 = g * 64 + (w & 1) * 32, fr = lane & 15, fq = lane >> 4;
    const bf16_t* gmw = (const bf16_t*)(X.ws + WS_GMW) + (size_t)g * 128 * 128;
    const float* gmb = X.in(I_GMB) + ((size_t)l * 4 + g) * 128;
    bf16_t* ya = X.ybuf();
    for (int tt = 0; tt < 8; ++tt) {
        f32x4 acc0 = (f32x4){0.f, 0.f, 0.f, 0.f}, acc1 = acc0;
        for (int ks = 0; ks <= (tt >> 1); ++ks) {
            const bf16x8 wf = *(const bf16x8*)(gmw + (tt * 16 + fr) * 128 + ks * 32 + 8 * fq);
            const bf16x8 v0 = *(const LAS bf16x8*)(Vt + (c0 + fr) * 136 + ks * 32 + 8 * fq), v1 = *(const LAS bf16x8*)(Vt + (c0 + 16 + fr) * 136 + ks * 32 + 8 * fq);
            acc0 = mfma16(v0, wf, acc0); acc1 = mfma16(v1, wf, acc1);
        }
        const int t = tt * 16 + fr; const float bias = gmb[t];
#pragma unroll
        for (int c2 = 0; c2 < 2; ++c2) { const f32x4 a = c2 ? acc1 : acc0; const int cc = c0 + c2 * 16 + 4 * fq;
            const u32x2 uv = *(const u32x2*)(pj + (size_t)(row0 + t) * PJ + C_GU + cc);
            u32x2 o; o.x = pk2(gelu_tanh(bflo(uv.x)) * (a[0] + bias), gelu_tanh(bfhi(uv.x)) * (a[1] + bias)); o.y = pk2(gelu_tanh(bflo(uv.y)) * (a[2] + bias), gelu_tanh(bfhi(uv.y)) * (a[3] + bias));
            *(u32x2*)(ya + (size_t)(row0 + t) * 256 + cc) = o; }
    }
    __syncthreads();
}

template <int PASS>
__device__ __forceinline__ void mx_s5(const Ctx& X, int l, int wu) {
    const int lane = X.lane, fr = lane & 15, fq = lane >> 4;
    const int wgi = wu >> 3, wv = wu & 7; const int b = wgi >> 6, g = ((wgi >> 4) & 3) * 4 + (wv & 3), ch = (wgi & 15) * 2 + (wv >> 2);
    const int tb = b * SEQ + ch * 256;
    LAS float* xl = (LAS float*)(X.lds + X.wave * 16384);
    LAS bf16_t* hb = (LAS bf16_t*)(X.lds + X.wave * 16384 + 8192);
    const bf16_t* pj = X.proj();
    const bf16_t* bbT = (const bf16_t*)(X.ws + WS_S5B) + (size_t)g * 128 * 16;
    bf16x8 Bf[8];
#pragma unroll
    for (int ct = 0; ct < 8; ++ct) { Bf[ct] = (bf16x8){0, 0, 0, 0, 0, 0, 0, 0}; if (fq < 2) Bf[ct] = *(const bf16x8*)(bbT + (ct * 16 + fr) * 16 + 8 * fq); }
    const float* sa = (const float*)(X.ws + WS_S5A) + (g * 64 + lane) * 2; const float ar = sa[0], ai = sa[1];
    float hr = 0.f, hi = 0.f;
    float* st = (float*)(X.ws + WS_S5ST) + (size_t)((b * 16 + g) * 32) * 128;
    bf16x8 Cf[4]; float dsk[4];
    if (PASS == 3) {
        { const float* hin = (const float*)(X.ws + WS_S5HIN) + (size_t)((b * 16 + g) * 32 + ch) * 128; hr = hin[lane]; hi = hin[64 + lane]; }
        const bf16_t* cm = (const bf16_t*)(X.ws + WS_S5C) + (size_t)g * 16 * 128;
#pragma unroll
        for (int ks = 0; ks < 4; ++ks) Cf[ks] = *(const bf16x8*)(cm + fr * 128 + ks * 32 + 8 * fq);
#pragma unroll
        for (int i = 0; i < 4; ++i) dsk[i] = X.in(I_S5D)[l * 256 + g * 16 + 4 * fq + i];
    }
    bf16_t* ycp = (bf16_t*)(X.ws + WS_YCPRE);
    for (int blk = 0; blk < 16; ++blk) {
        const int t0 = tb + blk * 16;
        bf16x8 uf = (bf16x8){0, 0, 0, 0, 0, 0, 0, 0};
        if (fq < 2) uf = *(const bf16x8*)(pj + (size_t)(t0 + fr) * PJ + C_S5 + g * 16 + 8 * fq);
#pragma unroll
        for (int ct = 0; ct < 8; ++ct) { const f32x4 a = mfma16(uf, Bf[ct], (f32x4){0.f, 0.f, 0.f, 0.f});
#pragma unroll
            for (int i = 0; i < 4; ++i) xl[(4 * fq + i) * 128 + ct * 16 + fr] = a[i]; }
#pragma unroll
        for (int t = 0; t < 16; ++t) { const float xr = xl[t * 128 + lane], xi = xl[t * 128 + 64 + lane];
            const float nr = ar * hr - ai * hi + xr, ni = ar * hi + ai * hr + xi; hr = nr; hi = ni;
            if (PASS == 3) { hb[t * 136 + lane] = (bf16_t)f2bf(hr); hb[t * 136 + 64 + lane] = (bf16_t)f2bf(hi); } }
        if (PASS == 3) {
            asm volatile("s_waitcnt lgkmcnt(0)" ::: "memory"); __builtin_amdgcn_wave_barrier();
            f32x4 acc = (f32x4){0.f, 0.f, 0.f, 0.f};
#pragma unroll
            for (int ks = 0; ks < 4; ++ks) { const bf16x8 hf = *(const LAS bf16x8*)(hb + fr * 136 + ks * 32 + 8 * fq); acc = mfma16(Cf[ks], hf, acc); }
            const u32x2 uv = *(const u32x2*)(pj + (size_t)(t0 + fr) * PJ + C_S5 + g * 16 + 4 * fq);
            const float y0 = gelu_tanh(acc[0] + dsk[0] * bflo(uv.x)), y1 = gelu_tanh(acc[1] + dsk[1] * bfhi(uv.x)), y2 = gelu_tanh(acc[2] + dsk[2] * bflo(uv.y)), y3 = gelu_tanh(acc[3] + dsk[3] * bfhi(uv.y));
            u32x2 o; o.x = pk2(y0, y1); o.y = pk2(y2, y3);
            *(u32x2*)(ycp + (size_t)(t0 + fr) * 256 + g * 16 + 4 * fq) = o;
        }
    }
    if (PASS == 1) { st[ch * 128 + lane] = hr; st[ch * 128 + 64 + lane] = hi; }
}

constexpr int SD_CM = 0, SD_BM = 18432, SD_BT = 36864, SD_XT0 = 54272, SD_XT1 = 71680, SD_MM = 89088, SD_SIN0 = 123904, SD_SIN1 = 133120, SD_DT = 142336, SD_AC = 143360 + 64, SD_END = 144384 + 64;
static_assert(SD_END <= LDS_MISC, "ssd lds");
template <int PASS>
__device__ __forceinline__ void mx_ssd(const Ctx& X, int l, int unit) {
    const int tid = X.tid, lane = X.lane, w = X.wave, fr = lane & 15, fq = lane >> 4;
    const int b = unit >> 6, c = unit & 63; const int r0 = unit * 128;
    const bf16_t* pj = X.proj();
    LAS bf16_t* Cm = (LAS bf16_t*)(X.lds + SD_CM); LAS bf16_t* Bm = (LAS bf16_t*)(X.lds + SD_BM); LAS bf16_t* Bt = (LAS bf16_t*)(X.lds + SD_BT);
    LAS bf16_t* Mm = (LAS bf16_t*)(X.lds + SD_MM);
    LAS float* dtv = (LAS float*)(X.lds + SD_DT); LAS float* acm = (LAS float*)(X.lds + SD_AC);
    const float* convw = X.in(I_CONVW) + (size_t)l * 4 * 512; const float* convb = X.in(I_CONVB) + (size_t)l * 512;
    float* sst = (float*)(X.ws + WS_SSDST); float* atot = (float*)(X.ws + WS_ATOT);
    for (int g = 0; g < 2; ++g) {
        if (tid < 256) { const int j = tid >> 7, rl = tid & 127, h = 2 * g + j;
            const float raw = bf2f(pj[(size_t)(r0 + rl) * PJ + C_DT + h]) + X.in(I_DTBIAS)[l * 4 + h];
            const float dt = softplusf_(raw); dtv[j * 128 + rl] = dt; acm[j * 128 + rl] = -expf(X.in(I_ALOG)[l * 4 + h]) * dt; }
        __syncthreads();
        if (tid < 256) {
            float cum = acm[tid];
#pragma unroll
            for (int o = 1; o < 64; o <<= 1) { const float up = __shfl_up(cum, o); if (lane >= o) cum += up; }
            if (lane == 63) dtv[256 + w] = cum;
            __builtin_amdgcn_fence(__ATOMIC_RELEASE, "workgroup");
            acm[tid] = cum; }
        __syncthreads();
        if (tid < 256 && (w & 1)) acm[tid] += dtv[256 + w - 1];
        __syncthreads();
        if (PASS == 1 && tid < 2) atot[(b * 64 + c) * 32 + 2 * g + tid] = acm[tid * 128 + 127];
        constexpr int NCG = (PASS == 1) ? 24 : 32;
        for (int it = tid; it < NCG * 128; it += 512) {
            const int rl = it & 127, cg = it >> 7;
            const int chn = (cg < 16) ? g * 128 + cg * 8 : (cg < 24) ? 256 + g * 64 + (cg - 16) * 8 : 384 + g * 64 + (cg - 24) * 8;
            float a8[8];
            { const f32x4 c0 = *(const f32x4*)(convb + chn), c1 = *(const f32x4*)(convb + chn + 4); a8[0] = c0[0]; a8[1] = c0[1]; a8[2] = c0[2]; a8[3] = c0[3]; a8[4] = c1[0]; a8[5] = c1[1]; a8[6] = c1[2]; a8[7] = c1[3]; }
#pragma unroll
            for (int k = 0; k < 4; ++k) { const int sq = c * 128 + rl - 3 + k;
                if (sq >= 0) { const u32x4 xv = *(const u32x4*)(pj + (size_t)(b * SEQ + sq) * PJ + C_XBC + chn);
                    const f32x4 w0 = *(const f32x4*)(convw + k * 512 + chn), w1 = *(const f32x4*)(convw + k * 512 + chn + 4);
                    a8[0] += w0[0] * bflo(xv.x); a8[1] += w0[1] * bfhi(xv.x); a8[2] += w0[2] * bflo(xv.y); a8[3] += w0[3] * bfhi(xv.y);
                    a8[4] += w1[0] * bflo(xv.z); a8[5] += w1[1] * bfhi(xv.z); a8[6] += w1[2] * bflo(xv.w); a8[7] += w1[3] * bfhi(xv.w); } }
#pragma unroll
            for (int q = 0; q < 8; ++q) a8[q] = siluf_(a8[q]);
            if (cg < 16) { const int j = cg >> 3, p0 = (cg & 7) * 8; LAS bf16_t* Xt = (LAS bf16_t*)(X.lds + (j ? SD_XT1 : SD_XT0));
                float sc = 1.0f; if (PASS == 1) sc = __expf(acm[j * 128 + 127] - acm[j * 128 + rl]) * dtv[j * 128 + rl];
#pragma unroll
                for (int q = 0; q < 8; ++q) Xt[(p0 + q) * 136 + rl] = (bf16_t)f2bf(a8[q] * sc); }
            else if (cg < 24) { const int n0 = (cg - 16) * 8;
                if (PASS == 1) {
#pragma unroll
                    for (int q = 0; q < 8; ++q) Bt[(n0 + q) * 136 + rl] = (bf16_t)f2bf(a8[q]); }
                else { u32x4 o; o.x = pk2(a8[0], a8[1]); o.y = pk2(a8[2], a8[3]); o.z = pk2(a8[4], a8[5]); o.w = pk2(a8[6], a8[7]); *(LAS u32x4*)(Bm + rl * 72 + n0) = o; } }
            else { const int n0 = (cg - 24) * 8; u32x4 o; o.x = pk2(a8[0], a8[1]); o.y = pk2(a8[2], a8[3]); o.z = pk2(a8[4], a8[5]); o.w = pk2(a8[6], a8[7]); *(LAS u32x4*)(Cm + rl * 72 + n0) = o; }
        }
        if (PASS == 3) {
            const bf16_t* sin = (const bf16_t*)(X.ws + WS_SSDSIN) + (size_t)((b * 64 + c) * 4 + 2 * g) * 4096 + tid * 8;
            const int p = tid >> 3, n0 = (tid & 7) * 8;
            *(LAS u32x4*)((LAS bf16_t*)(X.lds + SD_SIN0) + p * 72 + n0) = *(const u32x4*)sin;
            *(LAS u32x4*)((LAS bf16_t*)(X.lds + SD_SIN1) + p * 72 + n0) = *(const u32x4*)(sin + 4096);
        }
        __syncthreads();
        if (PASS == 1) {
            const int j = w >> 2, pt = w & 3; const LAS bf16_t* Xt = (const LAS bf16_t*)(X.lds + (j ? SD_XT1 : SD_XT0));
            f32x4 acc[4];
#pragma unroll
            for (int nt = 0; nt < 4; ++nt) acc[nt] = (f32x4){0.f, 0.f, 0.f, 0.f};
#pragma unroll
            for (int ks = 0; ks < 4; ++ks) { const bf16x8 xf = *(const LAS bf16x8*)(Xt + (pt * 16 + fr) * 136 + ks * 32 + 8 * fq);
#pragma unroll
                for (int nt = 0; nt < 4; ++nt) { const bf16x8 bf = *(const LAS bf16x8*)(Bt + (nt * 16 + fr) * 136 + ks * 32 + 8 * fq); acc[nt] = mfma16(xf, bf, acc[nt]); } }
            float* sp = sst + (size_t)((b * 64 + c) * 4 + 2 * g + j) * 4096;
#pragma unroll
            for (int nt = 0; nt < 4; ++nt)
#pragma unroll
                for (int i = 0; i < 4; ++i) sp[(pt * 16 + 4 * fq + i) * 64 + nt * 16 + fr] = acc[nt][i];
        } else {
            const int lrow = w * 16 + fr;
            float yv[2][4][4];
#pragma unroll
            for (int j = 0; j < 2; ++j) {
                const LAS bf16_t* Xt = (const LAS bf16_t*)(X.lds + (j ? SD_XT1 : SD_XT0)); const LAS bf16_t* Sin = (const LAS bf16_t*)(X.lds + (j ? SD_SIN1 : SD_SIN0));
                const float al = acm[j * 128 + lrow];
                const bf16x8 cf0 = *(const LAS bf16x8*)(Cm + lrow * 72 + 8 * fq), cf1 = *(const LAS bf16x8*)(Cm + lrow * 72 + 32 + 8 * fq);
                const int stmax = w | 1;
                for (int st = 0; st <= stmax; ++st) {
                    f32x4 ag = (f32x4){0.f, 0.f, 0.f, 0.f};
                    if (st <= w) { const bf16x8 b0 = *(const LAS bf16x8*)(Bm + (st * 16 + fr) * 72 + 8 * fq), b1 = *(const LAS bf16x8*)(Bm + (st * 16 + fr) * 72 + 32 + 8 * fq);
                        ag = mfma16(b0, cf0, ag); ag = mfma16(b1, cf1, ag); }
                    float mv[4];
#pragma unroll
                    for (int i = 0; i < 4; ++i) { const int s = st * 16 + 4 * fq + i; mv[i] = (s <= lrow) ? ag[i] * __expf(al - acm[j * 128 + s]) * dtv[j * 128 + s] : 0.f; }
                    u32x2 o; o.x = pk2(mv[0], mv[1]); o.y = pk2(mv[2], mv[3]); *(LAS u32x2*)(Mm + lrow * 136 + st * 16 + 4 * fq) = o;
                }
                const float eal = __expf(al); const float dsk = X.in(I_SSDD)[l * 4 + 2 * g + j];
#pragma unroll
                for (int pt = 0; pt < 4; ++pt) {
                    f32x4 ad = (f32x4){0.f, 0.f, 0.f, 0.f}, ao = ad;
                    for (int ks = 0; ks <= (w >> 1); ++ks) { const bf16x8 xf = *(const LAS bf16x8*)(Xt + (pt * 16 + fr) * 136 + ks * 32 + 8 * fq), mf = *(const LAS bf16x8*)(Mm + lrow * 136 + ks * 32 + 8 * fq); ad = mfma16(xf, mf, ad); }
                    { const bf16x8 s0 = *(const LAS bf16x8*)(Sin + (pt * 16 + fr) * 72 + 8 * fq), s1 = *(const LAS bf16x8*)(Sin + (pt * 16 + fr) * 72 + 32 + 8 * fq); ao = mfma16(s0, cf0, ao); ao = mfma16(s1, cf1, ao); }
                    const int h = 2 * g + j; const u32x2 zv = *(const u32x2*)(pj + (size_t)(r0 + lrow) * PJ + C_Z + h * 64 + pt * 16 + 4 * fq);
                    const float z4[4] = {bflo(zv.x), bfhi(zv.x), bflo(zv.y), bfhi(zv.y)};
#pragma unroll
                    for (int i = 0; i < 4; ++i) { const float xs = bf2f(Xt[(pt * 16 + 4 * fq + i) * 136 + lrow]); yv[j][pt][i] = (ad[i] + eal * ao[i] + dsk * xs) * siluf_(z4[i]); }
                }
            }
            float ss = 0.f;
#pragma unroll
            for (int j = 0; j < 2; ++j)
#pragma unroll
                for (int pt = 0; pt < 4; ++pt)
#pragma unroll
                    for (int i = 0; i < 4; ++i) ss += yv[j][pt][i] * yv[j][pt][i];
            ss += __shfl_xor(ss, 16); ss += __shfl_xor(ss, 32);
            const float rs = rsqrtf(ss * (1.0f / 128.0f) + RMS_EPS);
            const float* ng = X.in(I_SSDNG) + l * 256 + g * 128; bf16_t* yd = X.ybuf() + (size_t)3 * M * 256;
#pragma unroll
            for (int j = 0; j < 2; ++j)
#pragma unroll
                for (int pt = 0; pt < 4; ++pt) { const int cc = j * 64 + pt * 16 + 4 * fq; const f32x4 gv = *(const f32x4*)(ng + cc);
                    u32x2 o; o.x = pk2(yv[j][pt][0] * rs * gv[0], yv[j][pt][1] * rs * gv[1]); o.y = pk2(yv[j][pt][2] * rs * gv[2], yv[j][pt][3] * rs * gv[3]);
                    *(u32x2*)(yd + (size_t)(r0 + lrow) * 256 + g * 128 + cc) = o; }
        }
        __syncthreads();
    }
}

__device__ __forceinline__ void mx_s5_carry(const Ctx& X) {
    const float* st = (const float*)(X.ws + WS_S5ST); float* hin = (float*)(X.ws + WS_S5HIN); const float* sa = (const float*)(X.ws + WS_S5A);
    for (int i = (X.c - 128) * 512 + X.tid; X.c >= 128 && i < NB * 16 * 64; i += X.G * 512) {
        const int p = i & 63, g = (i >> 6) & 15, b = i >> 10;
        float pr = sa[(g * 64 + p) * 2], pi = sa[(g * 64 + p) * 2 + 1];
#pragma unroll
        for (int q = 0; q < 8; ++q) { const float nr = pr * pr - pi * pi, ni = 2.f * pr * pi; pr = nr; pi = ni; }
        float hr = 0.f, hi = 0.f; const size_t base = (size_t)((b * 16 + g) * 32) * 128 + p;
#pragma unroll 8
        for (int ch = 0; ch < 32; ++ch) { hin[base + ch * 128] = hr; hin[base + ch * 128 + 64] = hi;
            const float sr = st[base + ch * 128], si = st[base + ch * 128 + 64]; const float nr = pr * hr - pi * hi + sr, ni = pr * hi + pi * hr + si; hr = nr; hi = ni; }
    }
}

__device__ __forceinline__ void mx_ssd_carry(const Ctx& X) {
    const float* sst = (const float*)(X.ws + WS_SSDST); const float* atot = (const float*)(X.ws + WS_ATOT); bf16_t* sin = (bf16_t*)(X.ws + WS_SSDSIN);
    for (int i = X.c * 512 + X.tid; i < NB * 4 * 4096; i += X.G * 512) {
        const int e1 = i & 4095, h = (i >> 12) & 3, b = i >> 14;
        float S = 0.f;
#pragma unroll 16
        for (int c = 0; c < 64; ++c) { const size_t o = (size_t)((b * 64 + c) * 4 + h) * 4096 + e1;
            sin[o] = (bf16_t)f2bf(S);
            S = S * __expf(atot[(b * 64 + c) * 32 + h]) + sst[o]; }
    }
}

__device__ __forceinline__ unsigned ord16(float s) { const _Float16 hf = (_Float16)s; const unsigned bits = (unsigned)__builtin_bit_cast(unsigned short, hf); return bits ^ ((bits & 0x8000u) ? 0xFFFFu : 0x8000u); }
__device__ __forceinline__ int cnt_ge8(const u32x4 v, unsigned c) {
    int n = 0;
    n += ((v.x & 0xFFFFu) >= c) + ((v.x >> 16) >= c); n += ((v.y & 0xFFFFu) >= c) + ((v.y >> 16) >= c);
    n += ((v.z & 0xFFFFu) >= c) + ((v.z >> 16) >= c); n += ((v.w & 0xFFFFu) >= c) + ((v.w >> 16) >= c);
    return n;
}
template <int CTRL> __device__ __forceinline__ float dpp_f(float v) { return __builtin_bit_cast(float, __builtin_amdgcn_update_dpp(0, __builtin_bit_cast(int, v), CTRL, 0xF, 0xF, true)); }
__device__ __forceinline__ void mx_dsa(const Ctx& X, int b, int t0) {
    const int tid = X.tid, lane = X.lane, w = X.wave, fr = lane & 15, fq = lane >> 4;
    const bf16_t* pj = X.proj() + (size_t)b * SEQ * PJ; const unsigned rb = 0u;
    const bf16_t* ki2 = (const bf16_t*)(X.ws + WS_KI2) + (size_t)b * SEQ * 64; const bf16_t* k2 = (const bf16_t*)(X.ws + WS_K2) + (size_t)b * SEQ * 64; const bf16_t* v2 = (const bf16_t*)(X.ws + WS_V2) + (size_t)b * SEQ * 64;
    LAS unsigned short* sc = (LAS unsigned short*)X.lds;
    const int nk = t0 + 8, nkt = (nk + 15) >> 4;
    LAS unsigned* hist = (LAS unsigned*)(X.lds + 131072 + 8192);
    for (int i = tid; i < 8 * 4 * 128 / 4; i += 512) *(LAS u32x4*)(hist + 4 * i) = (u32x4){0u, 0u, 0u, 0u};
    bf16x8 qf[2][2]; f32x4 wq[2];
#pragma unroll
    for (int ct = 0; ct < 2; ++ct) { const int q = 4 * ct + (fr >> 2), hh = fr & 3; const bf16_t* qp = pj + (unsigned)(t0 + q) * (unsigned)PJ;
        qf[ct][0] = *(const bf16x8*)(qp + C_QI + hh * 64 + 8 * fq); qf[ct][1] = *(const bf16x8*)(qp + C_QI + hh * 64 + 32 + 8 * fq);
        const u32x2 wv = *(const u32x2*)(pj + (unsigned)(t0 + 4 * ct + fq) * (unsigned)PJ + C_WI);
        wq[ct] = (f32x4){bflo(wv.x) * 0.0625f, bfhi(wv.x) * 0.0625f, bflo(wv.y) * 0.0625f, bfhi(wv.y) * 0.0625f}; }
    const int ntw = (nkt > w) ? ((nkt - w + 7) >> 3) : 0;
    __syncthreads();
#define DSA_LOAD4(KF, I0) do { _Pragma("unroll") for (int j = 0; j < 4; ++j) { int kt_ = w + 8 * ((I0) + j); kt_ = kt_ < nkt ? kt_ : nkt - 1; \
        const unsigned ko_ = (unsigned)kt_ * 1024u + (unsigned)lane * 8u; KF[j][0] = *(const bf16x8*)(ki2 + ko_); KF[j][1] = *(const bf16x8*)(ki2 + ko_ + 512u); } } while (0)
#define DSA_COMP4(KF, I0) do { if (DSA_PM == 2 && rs1 > 0) { _Pragma("unroll") for (int j = 0; j < 4; ++j) dummy_ ^= KF[j][0][0] ^ KF[j][1][3]; break; } \
      _Pragma("unroll") for (int jh = 0; jh < 4; jh += 2) { f32x4 ac_[2][2]; \
        _Pragma("unroll") for (int j = 0; j < 2; ++j) _Pragma("unroll") for (int ct = 0; ct < 2; ++ct) { \
            ac_[j][ct] = mfma16(qf[ct][0], KF[jh + j][0], (f32x4){0.f, 0.f, 0.f, 0.f}); ac_[j][ct] = mfma16(qf[ct][1], KF[jh + j][1], ac_[j][ct]); } \
        _Pragma("unroll") for (int j = 0; j < 2; ++j) { if ((I0) + jh + j < ntw) { const int kt_ = w + 8 * ((I0) + jh + j); const bool full_ = (kt_ * 16 + 15 <= t0); const int key_ = kt_ * 16 + fr; \
        _Pragma("unroll") for (int ct = 0; ct < 2; ++ct) { const f32x4 a_ = ac_[j][ct]; \
            float tt_ = __builtin_fmaf(__builtin_amdgcn_fmed3f(a_[0], 0.f, 3.0e38f), wq[ct][0], 0.0f); tt_ = __builtin_fmaf(__builtin_amdgcn_fmed3f(a_[1], 0.f, 3.0e38f), wq[ct][1], tt_); \
            tt_ = __builtin_fmaf(__builtin_amdgcn_fmed3f(a_[2], 0.f, 3.0e38f), wq[ct][2], tt_); tt_ = __builtin_fmaf(__builtin_amdgcn_fmed3f(a_[3], 0.f, 3.0e38f), wq[ct][3], tt_); \
            const int q_ = 4 * ct + fq; unsigned kk_ = ord16(tt_ + 0.0f); \
            if (!full_) kk_ = (key_ <= t0 + q_) ? kk_ : 0u; \
            if (DSA_PM == 1 && rs1 > 0) dummy_ ^= (short)kk_; else sc[q_ * 8192 + key_] = (unsigned short)kk_; \
            if ((R_S1 == 1 || rs1 == 0) && (full_ || kk_ != 0u)) __hip_atomic_fetch_add(hist + (q_ * 4 + (fr & 3)) * 128 + (kk_ >> 9), (kk_ & 0x100u) ? 65536u : 1u, __ATOMIC_RELAXED, __HIP_MEMORY_SCOPE_WORKGROUP); } } } } } while (0)
    short dummy_ = 0;
    _Pragma("nounroll") for (int rs1 = 0; rs1 < (((DSA_SKIP | X.dbg) & 1) ? 0 : R_S1); ++rs1)
    { bf16x8 ka[4][2], kb[4][2];
      if (ntw > 0) { DSA_LOAD4(ka, 0);
#pragma nounroll
        for (int i0 = 0; i0 < ntw; i0 += 8) { DSA_LOAD4(kb, i0 + 4); DSA_COMP4(ka, i0); DSA_LOAD4(ka, i0 + 8); DSA_COMP4(kb, i0 + 4); } } }
#undef DSA_LOAD4
#undef DSA_COMP4
    if (dummy_ == (short)0x1234 && t0 == 123457) sc[0] = 1;
    { const int z0 = nkt * 16, z1 = ((nk + 511) >> 9) << 9;
        for (int i = z0 + tid; i < z1; i += 512) {
#pragma unroll
            for (int q = 0; q < 8; ++q) sc[q * 8192 + i] = 0; } }
    __syncthreads();
    const int t = t0 + w, nv = t + 1;
    LAS unsigned short* row = sc + w * 8192;
    LAS unsigned short* list = (LAS unsigned short*)(X.lds + 131072 + w * 512);
    const int nsel = nv < 256 ? nv : 256;
    if (((DSA_SKIP | X.dbg) & 2) || nv <= 256) { for (int n = lane; n < 256; n += 64) list[n] = (unsigned short)n; }
    else {
        const int nit = (nv + 511) >> 9;
        LAS unsigned* H = hist + w * 512;
        int T1, above1;
        { u32x4 h4 = (u32x4){0u, 0u, 0u, 0u};
#pragma unroll
          for (int c4 = 0; c4 < 4; ++c4) { const u32x2 pw = *(const LAS u32x2*)(H + c4 * 128 + 2 * lane); h4.x += pw.x & 0xFFFFu; h4.y += pw.x >> 16; h4.z += pw.y & 0xFFFFu; h4.w += pw.y >> 16; }
          const int sl = (int)(h4.x + h4.y + h4.z + h4.w);
          int suf = sl;
#pragma unroll
          for (int o = 1; o < 64; o <<= 1) { const int dn = __shfl_down(suf, o); if (lane + o < 64) suf += dn; }
          const unsigned long long bm = __ballot(suf >= 256); const int L = 63 - __builtin_clzll(bm);
          const int hx = __shfl((int)h4.x, L), hy = __shfl((int)h4.y, L), hz = __shfl((int)h4.z, L), hw = __shfl((int)h4.w, L);
          const int sufn = __shfl(suf, L) - (hx + hy + hz + hw);
          int cb = sufn; T1 = 4 * L + 3; above1 = cb;
          if (cb + hw >= 256) { T1 = 4 * L + 3; above1 = cb; } else { cb += hw; if (cb + hz >= 256) { T1 = 4 * L + 2; above1 = cb; } else { cb += hz; if (cb + hy >= 256) { T1 = 4 * L + 1; above1 = cb; } else { cb += hy; T1 = 4 * L; above1 = cb; } } } }
        _Pragma("nounroll") for (int rs2 = 0; rs2 < R_S2; ++rs2) {
        *(LAS u32x4*)(H + 4 * lane) = (u32x4){0u, 0u, 0u, 0u};
        for (int it = 0; it < nit; ++it) { const u32x4 v = *(const LAS u32x4*)(row + (it * 64 + lane) * 8);
            const unsigned e[8] = {v.x & 0xFFFFu, v.x >> 16, v.y & 0xFFFFu, v.y >> 16, v.z & 0xFFFFu, v.z >> 16, v.w & 0xFFFFu, v.w >> 16};
#pragma unroll
            for (int j = 0; j < 8; ++j) if ((int)(e[j] >> 8) == T1) __hip_atomic_fetch_add(H + (e[j] & 255u), 1u, __ATOMIC_RELAXED, __HIP_MEMORY_SCOPE_WORKGROUP); }
        unsigned thr; int cgt, cge;
        { const u32x4 h4 = *(const LAS u32x4*)(H + 4 * lane); const int sl = (int)(h4.x + h4.y + h4.z + h4.w);
          int suf = sl;
#pragma unroll
          for (int o = 1; o < 64; o <<= 1) { const int dn = __shfl_down(suf, o); if (lane + o < 64) suf += dn; }
          const int need = 256 - above1;
          const unsigned long long bm = __ballot(suf >= need); const int L = 63 - __builtin_clzll(bm);
          const int hx = __shfl((int)h4.x, L), hy = __shfl((int)h4.y, L), hz = __shfl((int)h4.z, L), hw = __shfl((int)h4.w, L);
          int cb = __shfl(suf, L) - (hx + hy + hz + hw); int T2, hT;
          if (cb + hw >= need) { T2 = 4 * L + 3; hT = hw; } else { cb += hw; if (cb + hz >= need) { T2 = 4 * L + 2; hT = hz; } else { cb += hz; if (cb + hy >= need) { T2 = 4 * L + 1; hT = hy; } else { cb += hy; T2 = 4 * L; hT = hx; } } }
          thr = ((unsigned)T1 << 8) | (unsigned)T2; cgt = above1 + cb; cge = cgt + hT; }
        const bool exact = (cge == 256);
        const int r = 256 - cgt;
        const unsigned cmin = exact ? thr : thr + 1u;
        const unsigned long long lt_mask = (1ull << lane) - 1ull; int bcnt = 0;
        for (int it = 0; it < nit; ++it) { const u32x4 v = *(const LAS u32x4*)(row + (it * 64 + lane) * 8); const int base = (it * 64 + lane) * 8;
            const unsigned e[8] = {v.x & 0xFFFFu, v.x >> 16, v.y & 0xFFFFu, v.y >> 16, v.z & 0xFFFFu, v.z >> 16, v.w & 0xFFFFu, v.w >> 16};
#pragma unroll
            for (int j = 0; j < 8; ++j) { const bool sl = e[j] >= cmin; const unsigned long long bm = __ballot(sl);
                if (bm != 0ull) { if (sl) list[(bcnt + __popcll(bm & lt_mask)) & 255] = (unsigned short)(base + j); bcnt += __popcll(bm); } } }
        if (!exact) {
            int taken = 0;
            for (int it = 0; it < nit && taken < r; ++it) { const u32x4 v = *(const LAS u32x4*)(row + (it * 64 + lane) * 8); const int base = (it * 64 + lane) * 8;
                const unsigned e[8] = {v.x & 0xFFFFu, v.x >> 16, v.y & 0xFFFFu, v.y >> 16, v.z & 0xFFFFu, v.z >> 16, v.w & 0xFFFFu, v.w >> 16};
                int mcount = 0;
#pragma unroll
                for (int j = 0; j < 8; ++j) mcount += (e[j] == thr);
                if (__ballot(mcount != 0) == 0ull) continue;
                int incl = mcount;
#pragma unroll
                for (int o = 1; o < 64; o <<= 1) { const int up = __shfl_up(incl, o); if (lane >= o) incl += up; }
                const int total = __shfl(incl, 63); int rk = taken + incl - mcount;
#pragma unroll
                for (int j = 0; j < 8; ++j) if (e[j] == thr) { if (rk < r) list[(cgt + rk) & 255] = (unsigned short)(base + j); ++rk; }
                taken += total; }
        }
        }
    }
    __builtin_amdgcn_fence(__ATOMIC_RELEASE, "workgroup"); __builtin_amdgcn_wave_barrier();
    const bf16_t* qrow = pj + (unsigned)t * (unsigned)PJ;
    bf16x8 qb0 = (bf16x8){0, 0, 0, 0, 0, 0, 0, 0}, qb1 = qb0;
    if (fr < 4) { qb0 = *(const bf16x8*)(qrow + C_Q + fr * 64 + 8 * fq); qb1 = *(const bf16x8*)(qrow + C_Q + fr * 64 + 32 + 8 * fq); }
    LAS float* Pb = (LAS float*)row;
    LAS float* pinv = (LAS float*)(X.lds + 131072 + 4096 + 256 + w * 16);
    _Pragma("nounroll") for (int rs3 = 0; rs3 < (((DSA_SKIP | X.dbg) & 4) ? 0 : R_S3); ++rs3) {
    { LAS unsigned char* kbuf = (LAS unsigned char*)row + 4096;
      const int drow = lane >> 3, dchk = (lane & 7) ^ (drow & 7);
#define QK_DMA(G) do { _Pragma("unroll") for (int i_ = 0; i_ < 4; ++i_) { const unsigned ko_ = (unsigned)list[(G) * 32 + i_ * 8 + drow] * 64u + (unsigned)(dchk * 8); \
        __builtin_amdgcn_global_load_lds((const unsigned*)(k2 + ko_), (LAS unsigned*)(kbuf + ((G) % 3) * 4096 + i_ * 1024), 16, 0, 0); } } while (0)
#define QK_COMP(G) do { _Pragma("unroll") for (int j = 0; j < 2; ++j) { const LAS unsigned char* tb_ = kbuf + ((G) % 3) * 4096 + j * 2048 + fr * 128; \
        const bf16x8 k0_ = *(const LAS bf16x8*)(tb_ + ((fq ^ (fr & 7)) * 16)), k1_ = *(const LAS bf16x8*)(tb_ + (((4 + fq) ^ (fr & 7)) * 16)); \
        f32x4 a_ = mfma16(k0_, qb0, (f32x4){0.f, 0.f, 0.f, 0.f}); a_ = mfma16(k1_, qb1, a_); \
        if (fr < 4) { _Pragma("unroll") for (int i = 0; i < 4; ++i) { const int nn_ = ((G) * 2 + j) * 16 + 4 * fq + i; Pb[nn_ * 4 + fr] = (nn_ < nsel) ? a_[i] * 0.125f : -3.0e38f; } } } } while (0)
      asm volatile("s_waitcnt vmcnt(0)" ::: "memory");
      QK_DMA(0); QK_DMA(1);
      asm volatile("s_waitcnt vmcnt(4)" ::: "memory"); QK_COMP(0); QK_DMA(2);
      asm volatile("s_waitcnt vmcnt(4)" ::: "memory"); QK_COMP(1); asm volatile("s_waitcnt lgkmcnt(0)" ::: "memory"); QK_DMA(3);
      asm volatile("s_waitcnt vmcnt(4)" ::: "memory"); QK_COMP(2); asm volatile("s_waitcnt lgkmcnt(0)" ::: "memory"); QK_DMA(4);
      asm volatile("s_waitcnt vmcnt(4)" ::: "memory"); QK_COMP(3); asm volatile("s_waitcnt lgkmcnt(0)" ::: "memory"); QK_DMA(5);
      asm volatile("s_waitcnt vmcnt(4)" ::: "memory"); QK_COMP(4); asm volatile("s_waitcnt lgkmcnt(0)" ::: "memory"); QK_DMA(6);
      asm volatile("s_waitcnt vmcnt(4)" ::: "memory"); QK_COMP(5); asm volatile("s_waitcnt lgkmcnt(0)" ::: "memory"); QK_DMA(7);
      asm volatile("s_waitcnt vmcnt(4)" ::: "memory"); QK_COMP(6);
      asm volatile("s_waitcnt vmcnt(0)" ::: "memory"); QK_COMP(7);
#undef QK_DMA
#undef QK_COMP
    }
    __builtin_amdgcn_fence(__ATOMIC_RELEASE, "workgroup"); __builtin_amdgcn_wave_barrier();
    { const int hd = lane & 3, nb0 = lane >> 2;
        float v16[16]; float mx = -3.0e38f;
#pragma unroll
        for (int j = 0; j < 16; ++j) { v16[j] = Pb[(nb0 + 16 * j) * 4 + hd]; mx = fmaxf(mx, v16[j]); }
        mx = fmaxf(mx, __shfl_xor(mx, 4)); mx = fmaxf(mx, __shfl_xor(mx, 8)); mx = fmaxf(mx, __shfl_xor(mx, 16)); mx = fmaxf(mx, __shfl_xor(mx, 32));
        float sm = 0.f;
#pragma unroll
        for (int j = 0; j < 16; ++j) { const float p = (v16[j] > -1.0e38f) ? __expf(v16[j] - mx) : 0.f; sm += p; Pb[(nb0 + 16 * j) * 4 + hd] = p; }
        sm += __shfl_xor(sm, 4); sm += __shfl_xor(sm, 8); sm += __shfl_xor(sm, 16); sm += __shfl_xor(sm, 32);
        if (lane < 4) pinv[lane] = 1.0f / sm; }
    __builtin_amdgcn_fence(__ATOMIC_RELEASE, "workgroup"); __builtin_amdgcn_wave_barrier();
    f32x2 o2[4][2];
#pragma unroll
    for (int h = 0; h < 4; ++h) { o2[h][0] = (f32x2){0.f, 0.f}; o2[h][1] = (f32x2){0.f, 0.f}; }
    const int d4 = fr * 4;
#define PV_LOAD(VV, B) do { _Pragma("unroll") for (int j = 0; j < 16; ++j) { const unsigned vo_ = (unsigned)list[(B) * 64 + 4 * j + fq] * 64u + (unsigned)d4; VV[j] = *(const u32x2*)(v2 + vo_); } } while (0)
#define PV_COMP(VV, B) do { _Pragma("unroll") for (int j = 0; j < 16; ++j) { const f32x4 p4_ = *(const LAS f32x4*)(Pb + ((B) * 64 + 4 * j + fq) * 4); \
        const f32x2 va_ = (f32x2){bflo(VV[j].x), bfhi(VV[j].x)}, vb_ = (f32x2){bflo(VV[j].y), bfhi(VV[j].y)}; \
        _Pragma("unroll") for (int h = 0; h < 4; ++h) { const f32x2 pp_ = (f32x2){p4_[h], p4_[h]}; o2[h][0] = __builtin_elementwise_fma(va_, pp_, o2[h][0]); o2[h][1] = __builtin_elementwise_fma(vb_, pp_, o2[h][1]); } } } while (0)
    { u32x2 va[16], vb[16]; PV_LOAD(va, 0); PV_LOAD(vb, 1); PV_COMP(va, 0); PV_LOAD(va, 2); PV_COMP(vb, 1); PV_LOAD(vb, 3); PV_COMP(va, 2); PV_COMP(vb, 3); }
#undef PV_LOAD
#undef PV_COMP
    float o4[4][4];
#pragma unroll
    for (int h = 0; h < 4; ++h)
#pragma unroll
        for (int dd = 0; dd < 4; ++dd) { float v = o2[h][dd >> 1][dd & 1]; v += __shfl_xor(v, 16); v += __shfl_xor(v, 32); o4[h][dd] = v; }
    { const int h = fq; const float iv = pinv[h];
        float r4[4];
#pragma unroll
        for (int dd = 0; dd < 4; ++dd) r4[dd] = ((h == 0) ? o4[0][dd] : (h == 1) ? o4[1][dd] : (h == 2) ? o4[2][dd] : o4[3][dd]) * iv;
        u32x2 o; o.x = pk2(r4[0], r4[1]); o.y = pk2(r4[2], r4[3]);
        *(u32x2*)(X.ybuf() + (size_t)1 * M * 256 + ((size_t)b * SEQ + t) * 256 + h * 64 + d4) = o; }
    __builtin_amdgcn_fence(__ATOMIC_RELEASE, "workgroup"); __builtin_amdgcn_wave_barrier(); }
    __syncthreads();
}

constexpr int LR_HH = 0, LR_HL = 33280, LR_PART = 66560, LR_LG = 82944, LR_CNT = 84992, LR_PITCH = 1032;
__device__ __forceinline__ void ph_ln1_router(const Ctx& X, int l) {
    const int lane = X.lane, w = X.wave, tid = X.tid, fr = lane & 15, fq = lane >> 4;
    LAS bf16_t* Hh = (LAS bf16_t*)(X.lds + LR_HH); LAS bf16_t* Hl = (LAS bf16_t*)(X.lds + LR_HL);
    LAS float* part = (LAS float*)(X.lds + LR_PART);
    LAS float* lgt = (LAS float*)(X.lds + LR_LG);
    LAS unsigned* wgcnt = (LAS unsigned*)(X.lds + LR_CNT);
    if (tid < 32) wgcnt[tid] = 0u;
    bf16x8 Ahi[2][4], Alo[2][4];
    { const bf16_t* rf = (const bf16_t*)(X.ws + WS_RFR);
#pragma unroll
      for (int rt = 0; rt < 2; ++rt)
#pragma unroll
          for (int q = 0; q < 4; ++q) { const size_t o = ((size_t)(rt * 32 + 4 * w + q) * 64 + lane) * 8; Ahi[rt][q] = *(const bf16x8*)(rf + o); Alo[rt][q] = *(const bf16x8*)(rf + 32768 + o); } }
    float* xo = X.a->out; bf16_t* hb = X.hbuf(); float* xw = (X.dbg & 8) ? (float*)(X.ws + WS_ACT) : xo; const bf16_t* v16 = (const bf16_t*)(X.ws + WS_V16);
    const int tok0 = X.c * 128, b = tok0 >> 13;
    const float* mv = X.modv(l, 1) + b * 3072;
    const float* lg = X.in(I_LN1G) + l * D; const float* lb = X.in(I_LN1B) + l * D;
    const int e = lane & 31;
    const float rbias = X.in(I_RB)[l * NEXP + e];
    unsigned* pinfo = (unsigned*)(X.ws + WS_PINFO); float* pgate = (float*)(X.ws + WS_PGATE);
    __syncthreads();
    u32x2 raw[2][4];
#pragma unroll
    for (int jj = 0; jj < 2; ++jj)
#pragma unroll
        for (int j = 0; j < 4; ++j) raw[jj][j] = *(const u32x2*)(v16 + (size_t)(tok0 + 2 * w + jj) * D + 4 * lane + 256 * j);
    for (int pass = 0; pass < 8; ++pass) {
        f32x4 vv[2][4];
#pragma unroll
        for (int jj = 0; jj < 2; ++jj)
#pragma unroll
            for (int j = 0; j < 4; ++j) { const u32x2 q2 = raw[jj][j]; vv[jj][j] = (f32x4){bflo(q2.x), bfhi(q2.x), bflo(q2.y), bfhi(q2.y)}; }
        if (pass + 1 < 8) {
#pragma unroll
            for (int jj = 0; jj < 2; ++jj)
#pragma unroll
                for (int j = 0; j < 4; ++j) raw[jj][j] = *(const u32x2*)(v16 + (size_t)(tok0 + (pass + 1) * 16 + 2 * w + jj) * D + 4 * lane + 256 * j); }
#pragma unroll
        for (int jj = 0; jj < 2; ++jj) {
            const int r = 2 * w + jj, tok = tok0 + pass * 16 + r;
            f32x4 v[4]; float s = 0.f;
#pragma unroll
            for (int j = 0; j < 4; ++j) { v[j] = vv[jj][j]; s += (v[j][0] + v[j][1]) + (v[j][2] + v[j][3]); }
            const float mean = wave_sum(s) * (1.0f / D); float q = 0.f;
#pragma unroll
            for (int j = 0; j < 4; ++j) { v[j] = v[j] - mean; q += (v[j][0] * v[j][0] + v[j][1] * v[j][1]) + (v[j][2] * v[j][2] + v[j][3] * v[j][3]); }
            const float rstd = rsqrtf(wave_sum(q) * (1.0f / D) + LN_EPS);
#pragma unroll
            for (int j = 0; j < 4; ++j) { const int col = 4 * lane + 256 * j;
                const f32x4 x1 = v[j] * rstd * *(const f32x4*)(lg + col) + *(const f32x4*)(lb + col);
                *(f32x4*)(xw + (size_t)tok * D + col) = x1 * DN_ALPHA;
                const f32x4 hv = x1 * (*(const f32x4*)(mv + 1024 + col) + 1.0f) + *(const f32x4*)(mv + col);
                const unsigned h0 = f2bf(hv[0]), h1 = f2bf(hv[1]), h2 = f2bf(hv[2]), h3 = f2bf(hv[3]);
                u32x2 o; o.x = h0 | (h1 << 16); o.y = h2 | (h3 << 16); *(u32x2*)(hb + (size_t)tok * D + col) = o;
                *(LAS u32x2*)(Hh + r * LR_PITCH + col) = o;
                u32x2 ol; ol.x = pk2(hv[0] - bflo(h0), hv[1] - bflo(h1)); ol.y = pk2(hv[2] - bflo(h2), hv[3] - bflo(h3)); *(LAS u32x2*)(Hl + r * LR_PITCH + col) = ol; }
        }
        __syncthreads();
        {
            f32x4 acc0 = (f32x4){0.f, 0.f, 0.f, 0.f}, acc1 = acc0;
#pragma unroll
            for (int q = 0; q < 4; ++q) { const int ko = fr * LR_PITCH + (4 * w + q) * 32 + 8 * fq;
                const bf16x8 bh = *(const LAS bf16x8*)(Hh + ko), bl = *(const LAS bf16x8*)(Hl + ko);
                acc0 = mfma16(Ahi[0][q], bh, acc0); acc0 = mfma16(Ahi[0][q], bl, acc0); acc0 = mfma16(Alo[0][q], bh, acc0);
                acc1 = mfma16(Ahi[1][q], bh, acc1); acc1 = mfma16(Ahi[1][q], bl, acc1); acc1 = mfma16(Alo[1][q], bh, acc1); }
#pragma unroll
            for (int i = 0; i < 4; ++i) { part[(w * 32 + 4 * fq + i) * 16 + fr] = acc0[i]; part[(w * 32 + 16 + 4 * fq + i) * 16 + fr] = acc1[i]; }
        }
        __syncthreads();
        { const int ee = tid >> 4, tk = tid & 15; float sm = 0.f;
#pragma unroll
          for (int q = 0; q < 8; ++q) sm += part[(q * 32 + ee) * 16 + tk];
          lgt[tk * 32 + ee] = sm; }
        __syncthreads();
#pragma unroll
        for (int jj = 0; jj < 2; ++jj) {
            const int r = 2 * w + jj, tok = tok0 + pass * 16 + r;
            const float score = sigmoidf_(lgt[r * 32 + e]), biased = score + rbias;
            const int gbase = lane & ~3;
            const float v0 = __shfl(biased, gbase), v1 = __shfl(biased, gbase + 1), v2 = __shfl(biased, gbase + 2), v3 = __shfl(biased, gbase + 3);
            const float a_ = fmaxf(v0, v1), b_ = fminf(v0, v1), c_ = fmaxf(v2, v3), d_ = fminf(v2, v3);
            const float gs = fmaxf(a_, c_) + fmaxf(fminf(a_, c_), fmaxf(b_, d_));
            const int myg = e >> 2; int grank = 0;
#pragma unroll
            for (int g2 = 0; g2 < 8; ++g2) { const float o = __shfl(gs, 4 * g2); grank += (o > gs || (o == gs && g2 < myg)) ? 1 : 0; }
            const float masked = (grank < 4) ? biased : -3.0e38f;
            int erank = 0;
#pragma unroll
            for (int e2 = 0; e2 < 32; ++e2) { const float o = __shfl(masked, e2); erank += (o > masked || (o == masked && e2 < e)) ? 1 : 0; }
            const bool sel = (erank < 8) && (lane < 32);
            const float wsum = wave_sum(sel ? score : 0.f);
            const float gate = score / wsum * 2.5f;
            const unsigned long long bal = __ballot(sel);
            if (sel) { const int k = __popcll(bal & ((1ull << lane) - 1ull));
                const unsigned lr = __hip_atomic_fetch_add(wgcnt + e, 1u, __ATOMIC_RELAXED, __HIP_MEMORY_SCOPE_WORKGROUP);
                pinfo[(size_t)tok * 8 + k] = (unsigned)e | (lr << 8); pgate[(size_t)tok * 8 + k] = gate; }
        }
    }
    __syncthreads();
    if (tid < 32) { const int chunk = tok0 / CHTOK; unsigned* cnt = (unsigned*)(X.ws + WS_CTL) + CW_CNT + (l * NCH + chunk) * 64;
        const unsigned base = __hip_atomic_fetch_add(cnt + tid, wgcnt[tid], __ATOMIC_RELAXED, __HIP_MEMORY_SCOPE_AGENT);
        ((unsigned*)(X.ws + WS_WGBASE))[X.c * 32 + tid] = base; }
    __syncthreads();
}

__device__ __forceinline__ void moe_offsets(const Ctx& X, int l, int chunk, LAS int* off  , LAS int* cntl  ) {
    if (X.tid == 0) { const unsigned* cnt = (const unsigned*)(X.ws + WS_CTL) + CW_CNT + (l * NCH + chunk) * 64; int o = 0;
        for (int e = 0; e < NE1; ++e) { const int cn = (e < NEXP) ? (int)__hip_atomic_load(cnt + e, __ATOMIC_RELAXED, __HIP_MEMORY_SCOPE_AGENT) : CHTOK; off[e] = o; cntl[e] = cn; o += ((cn + 255) >> 8) << 8; }
        off[NE1] = o; }
    __syncthreads();
}
#define ST_WT(p, v) __hip_atomic_store((p), (v), __ATOMIC_RELAXED, __HIP_MEMORY_SCOPE_AGENT)
__device__ __forceinline__ void ph_fill(const Ctx& X, int l) {
    LAS int* off = (LAS int*)(X.lds); LAS int* cntl = off + 64;
    const int tok0 = X.c * 128, chunk = tok0 / CHTOK;
    moe_offsets(X, l, chunk, off, cntl);
    unsigned* rowtok = (unsigned*)(X.ws + WS_ROWTOK) + (size_t)chunk * CH_ROWS; float* rowgate = (float*)(X.ws + WS_ROWGATE) + (size_t)chunk * CH_ROWS;
    const unsigned* pinfo = (const unsigned*)(X.ws + WS_PINFO); const float* pgate = (const float*)(X.ws + WS_PGATE); unsigned* slot = (unsigned*)(X.ws + WS_SLOT);
    const unsigned* wgb = (const unsigned*)(X.ws + WS_WGBASE) + X.c * 32;
    for (int i = X.tid; i < 1024; i += 512) { const size_t pi = (size_t)tok0 * 8 + i; const unsigned inf = pinfo[pi]; const int e = inf & 255, lr = inf >> 8;
        const int pos = off[e] + (int)wgb[e] + lr; ST_WT(rowtok + pos, (unsigned)(tok0 + (i >> 3))); ST_WT((unsigned*)rowgate + pos, __builtin_bit_cast(unsigned, pgate[pi])); slot[pi] = (unsigned)pos; }
    if (X.tid < 128) { const int tok = tok0 + X.tid; const int pos = off[NEXP] + (tok - chunk * CHTOK); ST_WT(rowtok + pos, (unsigned)tok); ST_WT((unsigned*)rowgate + pos, __builtin_bit_cast(unsigned, 1.0f)); }
    const int wl = X.c & 63;
    if (wl < NEXP) { const int e = wl; const int p0 = off[e] + cntl[e], p1 = off[e + 1]; for (int p = p0 + X.tid; p < p1; p += 512) { ST_WT(rowtok + p, (unsigned)(chunk * CHTOK)); ST_WT((unsigned*)rowgate + p, 0u); } }
    __syncthreads();
}

template <int NT, bool GATH>
struct MoeOrder {
    static constexpr bool GATHER = GATH;
    int nwg, G, c; const LAS unsigned char* tile_e; const LAS int* rowtab;
    __device__ __forceinline__ bool next(int i, pg8::Unit& u) const {
        const long L = (long)i * G + c; if (L >= nwg) return false;
        const int wgid = pg8::xcd_remap((int)L, nwg); const int tau = wgid / NT, pn = wgid % NT;
        u.pm = tau; u.pn = pn; u.bt = __builtin_amdgcn_readfirstlane((int)tile_e[tau]) * NT + pn; u.ab = i; return true;
    }
    __device__ __forceinline__ int row_of(const pg8::Unit& u, int r) const { return rowtab[u.ab * 256 + r]; }
    __device__ __forceinline__ void a_ready(const pg8::Unit&) const {}
    __device__ __forceinline__ void done(const pg8::Unit&) const {}
};
struct MoeOrderAll {
    static constexpr bool GATHER = true;
    int nwg, G, c; const LAS unsigned char* tile_e4; const LAS int* tprefix; const LAS int* rowtab;
    __device__ __forceinline__ bool next(int i, pg8::Unit& u) const {
        const long L = (long)i * G + c; if (L >= nwg) return false;
        const int wgid = pg8::xcd_remap((int)L, nwg); const int gt = wgid >> 1, pn = wgid & 1;
        int ch = 0;
#pragma unroll
        for (int q = 1; q < NCH; ++q) ch += (tprefix[q] <= gt) ? 1 : 0;
        ch = __builtin_amdgcn_readfirstlane(ch); const int tau = gt - __builtin_amdgcn_readfirstlane(tprefix[ch]);
        u.pm = ch * CH_TILES + tau; u.pn = pn; u.bt = __builtin_amdgcn_readfirstlane((int)tile_e4[ch * 336 + tau]) * 2 + pn; u.ab = i; return true;
    }
    __device__ __forceinline__ int row_of(const pg8::Unit& u, int r) const { return rowtab[u.ab * 256 + r]; }
    __device__ __forceinline__ void a_ready(const pg8::Unit&) const {}
    __device__ __forceinline__ void done(const pg8::Unit&) const {}
};
__device__ __forceinline__ int moe_tiles(const Ctx& X, int l, int chunk, LAS unsigned char* tile_e, LAS int* off, LAS int* cntl) {
    moe_offsets(X, l, chunk, off, cntl);
    const int ntile = off[NE1] >> 8;
    for (int t = X.tid; t < ntile; t += 512) { int e = 0; for (int q = 1; q < NE1; ++q) e += (off[q] <= t * 256) ? 1 : 0; tile_e[t] = (unsigned char)e; }
    __syncthreads();
    return ntile;
}

__device__ __forceinline__ void ph_combine(const Ctx& X, int l, int chunk, LAS int* off) {
    const int lane = X.lane; const int gw = X.c * 8 + X.wave;
    float* xo = X.a->out; bf16_t* hb = X.hbuf(); float* xw = (X.dbg & 8) ? (float*)(X.ws + WS_ACT) : xo;
    const unsigned char* op = (const unsigned char*)(X.ws + WS_OPAIR); const unsigned* slot = (const unsigned*)(X.ws + WS_SLOT);
    const int b = (chunk * CHTOK) >> 13; const float* mv2 = X.modv(l, 1) + b * 3072;
    const float* lg = X.in(I_LN2G) + l * D; const float* lb = X.in(I_LN2B) + l * D;
    const int offsh = off[NEXP];
    for (int i = 0; i < 4; ++i) {
        const int tok = chunk * CHTOK + gw * 4 + i;
        f32x4 sm[4];
#pragma unroll
        for (int j = 0; j < 4; ++j) sm[j] = (f32x4){0.f, 0.f, 0.f, 0.f};
#pragma unroll
        for (int k = 0; k < 9; ++k) { const int pos = (k < 8) ? (int)slot[(size_t)tok * 8 + k] : offsh + (tok - chunk * CHTOK);
            const unsigned char* rp = op + (size_t)pos * 1024 + 4 * lane;
#pragma unroll
            for (int j = 0; j < 4; ++j) { const int q = (int)*(const unsigned*)(rp + 256 * j); const f32x2 lo = __builtin_amdgcn_cvt_pk_f32_fp8(q, false), hi = __builtin_amdgcn_cvt_pk_f32_fp8(q, true);
                sm[j][0] += lo[0]; sm[j][1] += lo[1]; sm[j][2] += hi[0]; sm[j][3] += hi[1]; } }
        f32x4 v[4]; float s = 0.f;
#pragma unroll
        for (int j = 0; j < 4; ++j) { const int col = 4 * lane + 256 * j; v[j] = *(const f32x4*)(xo + (size_t)tok * D + col) + (*(const f32x4*)(mv2 + 2048 + col) + 1.0f) * (sm[j] * (1.0f / O_SCALE)); s += (v[j][0] + v[j][1]) + (v[j][2] + v[j][3]); }
        const float mean = wave_sum(s) * (1.0f / D); float q = 0.f;
#pragma unroll
        for (int j = 0; j < 4; ++j) { v[j] = v[j] - mean; q += (v[j][0] * v[j][0] + v[j][1] * v[j][1]) + (v[j][2] * v[j][2] + v[j][3] * v[j][3]); }
        const float rstd = rsqrtf(wave_sum(q) * (1.0f / D) + LN_EPS);
#pragma unroll
        for (int j = 0; j < 4; ++j) { const int col = 4 * lane + 256 * j;
            const f32x4 x2 = v[j] * rstd * *(const f32x4*)(lg + col) + *(const f32x4*)(lb + col);
            *(f32x4*)(xw + (size_t)tok * D + col) = x2;
            if (l + 1 < DEPTH) { const float* mv1 = X.modv(l + 1, 0) + b * 3072; const f32x4 hn = x2 * (*(const f32x4*)(mv1 + 1024 + col) + 1.0f) + *(const f32x4*)(mv1 + col);
                u32x2 o; o.x = pk2(hn[0], hn[1]); o.y = pk2(hn[2], hn[3]); *(u32x2*)(hb + (size_t)tok * D + col) = o; } }
    }
}

struct POrder : pg8::StaticOrder { __device__ __forceinline__ bool next(int i, pg8::Unit& u) const { if (!pg8::StaticOrder::next(i, u)) return false; u.ab = u.pn >> 2; return true; } };
struct GOrder { static constexpr bool GATHER = false; int G, c;
    __device__ __forceinline__ bool next(int i, pg8::Unit& u) const { const int tile = (i >> 2) * G + c; if (tile >= 512) return false; const int wg = pg8::xcd_remap(tile, 512); const int br = i & 3, mt = wg & 3;
        u.pm = wg >> 2; u.pn = br * 4 + mt; u.bt = br * 4 + mt; u.ab = 0; return true; }
    __device__ __forceinline__ void a_ready(const pg8::Unit&) const {} __device__ __forceinline__ void done(const pg8::Unit&) const {} };
__global__ void __launch_bounds__(512, 2) fwd_kernel(Args args) {
    extern __shared__ __attribute__((aligned(16))) unsigned char lds_raw[];
    ArgsP ap = (ArgsP)__builtin_amdgcn_kernarg_segment_ptr();
    Ctx X; X.a = ap; X.ws = ap->ws; X.lds = (LAS unsigned char*)lds_raw;
    X.tid = threadIdx.x; X.lane = X.tid & 63; X.wave = __builtin_amdgcn_readfirstlane(X.tid >> 6); X.G = gridDim.x;
    { const int bx = blockIdx.x; X.bx = bx; X.c = (X.G % 8 == 0) ? (bx % 8) * (X.G / 8) + bx / 8 : bx; }
    const int c0_ = X.c, g0_ = X.G, bx0_ = X.bx, wave0_ = X.wave;
    volatile LAS unsigned* misc = (volatile LAS unsigned*)(X.lds + LDS_MISC);
    if (X.tid < 16) misc[X.tid] = 0u;
    __syncthreads();
    XcdBarrier bar; bar.bar = (unsigned*)(X.ws + WS_CTL) + CW_BAR; bar.x = 0; bar.st = misc;
#if !MK_PER_PHASE
    bar = xcd_barrier_post((unsigned*)(X.ws + WS_CTL) + CW_BAR, misc);
#endif
    const int lo = ap->ph_lo, hi = ap->ph_hi; int ph = 0;
#define RELAUNDER() do { int wv_ = wave0_; asm volatile("" : "+s"(wv_)); int t_ = wv_ * 64 + (int)__builtin_amdgcn_mbcnt_hi(~0u, __builtin_amdgcn_mbcnt_lo(~0u, 0u)); asm volatile("" : "+v"(t_)); X.tid = t_; X.lane = t_ & 63; X.wave = wv_; } while (0)
#define REPEAT(N, stmt) _Pragma("nounroll") for (int rp_ = 0; rp_ < (N); ++rp_) { stmt; if (rp_ + 1 < (N)) xcd_barrier(bar); }
#define PH_BEGIN if (ph >= lo && ph < hi) { { ArgsP apl = ap; asm volatile("" : "+s"(apl)); X.a = apl; X.ws = apl->ws; X.dbg = apl->dbg; int wv_ = wave0_; asm volatile("" : "+s"(wv_)); int t_ = wv_ * 64 + (int)__builtin_amdgcn_mbcnt_hi(~0u, __builtin_amdgcn_mbcnt_lo(~0u, 0u)); asm volatile("" : "+v"(t_)); X.tid = t_; X.lane = t_ & 63; X.wave = wv_; int c_ = c0_, g_ = g0_, b_ = bx0_; asm volatile("" : "+s"(c_), "+s"(g_), "+s"(b_)); X.c = c_; X.G = g_; X.bx = b_; } unsigned char* wb = X.ws + WS_W; LAS unsigned char* gl = X.lds; const float* xin = (l_ == 0) ? X.in(I_X) : (const float*)X.a->out; (void)wb; (void)gl; (void)xin;
#if MK_PER_PHASE
#define PH_END } ++ph;
#else
#define PH_END if (ph + 1 < hi) xcd_barrier(bar); } ++ph;
#endif
    int l_ = 0;
    PH_BEGIN if (EN_PROLOGUE) { REPEAT(R_MISC, ph_prologue(X)) } PH_END
    for (int l = 0; l < DEPTH; ++l) {
        l_ = l;
        PH_BEGIN if (EN_WCONV) { REPEAT(R_MISC, ph_wconv(X, l)) } PH_END
        PH_BEGIN if (EN_GWIN)  { pg8::Gemm g{X.hbuf(), (const bf16_t*)(wb + WO_IN), 1024, 0}; pg8::StaticOrder S; S.init(M, PJ, X.G, X.bx); pg8::EpiBf16 E{X.proj(), PJ};
            REPEAT(R_GWIN, (pg8::gemm_phase<pg8::EpiBf16, pg8::StaticOrder, G_ALIGN, G_SP2>(gl, g, S, E, X.tid))) } PH_END
        PH_BEGIN if (EN_MX1)  {
            if (!(X.dbg & 1)) mx_rope(X);
            _Pragma("nounroll") for (int rp_ = 0; rp_ < R_MIX; ++rp_) {
            if (!(X.dbg & 2)) for (int u = X.c; u < 256; u += X.G) mx_gmlp(X, l, u);
            if (!(X.dbg & 4)) for (int wu = X.c * 8 + X.wave; wu < 2048; wu += X.G * 8) mx_s5<1>(X, l, wu);
            __syncthreads();
            if (!(X.dbg & 8)) for (int u = X.c; u < 256; u += X.G) mx_ssd<1>(X, l, u); }
        } PH_END
        PH_BEGIN if (EN_MX2)  {
            if (!(X.dbg & 32)) { mx_ssd_carry(X); mx_s5_carry(X); } RELAUNDER();
            _Pragma("nounroll") for (int rp_ = 0; rp_ < R_DSA; ++rp_)
            for (int r = 0; r < 16; ++r) { const int cl = X.c & 63; const int uu = (r & 1) ? r * 64 + 63 - cl : r * 64 + cl; if (EN_DSA && !(X.dbg & 64) && X.c < 256) mx_dsa(X, X.c >> 6, uu * 8); }
            __syncthreads(); RELAUNDER();
            for (int wu = X.c * 8 + X.wave; EN_S53 && !(X.dbg & 16) && wu < 2048; wu += X.G * 8) mx_s5<3>(X, l, wu);
        } PH_END
        PH_BEGIN if (EN_GLU)  { for (int u = X.c; EN_SSD3 && u < 256; u += X.G) mx_ssd<3>(X, l, u);
            __syncthreads(); RELAUNDER();
            pg8::Gemm g{(const bf16_t*)(X.ws + WS_YCPRE), (const bf16_t*)(wb + WO_GLU), 256, 0}; pg8::StaticOrder S; S.init(M, 256, X.G, X.bx);
            pg8::EpiGlu E{(const bf16_t*)(X.ws + WS_YCPRE), X.ybuf() + (size_t)2 * M * 256, X.in(I_S5GLUB) + l * 256};
            REPEAT(R_GLU, (pg8::gemm_phase<pg8::EpiGlu, pg8::StaticOrder, G_ALIGN, G_SP2>(gl, g, S, E, X.tid))) } PH_END
        PH_BEGIN if (EN_GP)  { pg8::Gemm g{X.ybuf(), (const bf16_t*)(wb + WO_BR), 256, (size_t)M * 256};
            POrder S;
            S.init(M, 4096, X.G, X.bx); pg8::EpiFp8 E{(unsigned char*)(X.ws + WS_P), 4096, P_SCALE};
            REPEAT(R_GP, (pg8::gemm_phase<pg8::EpiFp8, POrder, false, G_SP2>(gl, g, S, E, X.tid))) } PH_END
        PH_BEGIN if (EN_GGATE)  { pg8::Gemm g{X.hbuf(), (const bf16_t*)(wb + WO_GATE), 1024, 0};
            GOrder S{X.G, X.bx};
            pg8::EpiGateMerge E{(const unsigned char*)(X.ws + WS_P), X.ybuf(), 1.0f / P_SCALE};
            REPEAT(R_GGATE, (pg8::gemm_phase<pg8::EpiGateMerge, GOrder, G_ALIGN, G_SP2>(gl, g, S, E, X.tid))) } PH_END
        PH_BEGIN if (EN_GOUT)  { pg8::Gemm g{X.ybuf(), (const bf16_t*)(wb + WO_OUT), 1024, 0}; pg8::StaticOrder S; S.init(M, 1024, X.G, X.bx);
            pg8::EpiResid E{xin, (bf16_t*)(X.ws + WS_V16), X.modv(l, 0)};
            pg8::gemm_phase<pg8::EpiResid, pg8::StaticOrder, G_ALIGN, G_SP2>(gl, g, S, E, X.tid); } PH_END
        PH_BEGIN if (EN_LN1)  ph_ln1_router(X, l); PH_END
        PH_BEGIN if (EN_FILL) { REPEAT(R_MISC, ph_fill(X, l)) } PH_END
        PH_BEGIN if (EN_MOE1)  {
            LAS int* off4 = (LAS int*)(X.lds + LDS_TAB + 1024); LAS unsigned char* tile_e4 = (LAS unsigned char*)(X.lds + LDS_TAB + 2048); LAS int* tprefix = (LAS int*)(X.lds + LDS_TAB + 3584);
            if (X.tid < NCH) { const int chn = X.tid; const unsigned* cnt = (const unsigned*)(X.ws + WS_CTL) + CW_CNT + (l * NCH + chn) * 64; int o = 0;
                for (int e = 0; e < NE1; ++e) { const int cn = (e < NEXP) ? (int)__hip_atomic_load(cnt + e, __ATOMIC_RELAXED, __HIP_MEMORY_SCOPE_AGENT) : CHTOK; off4[chn * 64 + e] = o; o += ((cn + 255) >> 8) << 8; }
                off4[chn * 64 + NE1] = o; }
            __syncthreads();
            if (X.tid == 0) { int a = 0; for (int q = 0; q < NCH; ++q) { tprefix[q] = a; a += off4[q * 64 + NE1] >> 8; } tprefix[NCH] = a; }
            for (int t = X.tid; t < NCH * 336; t += 512) { const int chn = t / 336, tau = t % 336; int e = 0; for (int q = 1; q < NE1; ++q) e += (off4[chn * 64 + q] <= tau * 256) ? 1 : 0; tile_e4[t] = (unsigned char)e; }
            __syncthreads();
            pg8::Gemm g{X.hbuf(), (const bf16_t*)(wb + WO_13), 1024, 0};
            LAS int* rowtab = (LAS int*)(X.lds + LDS_TAB + 4096);
            MoeOrderAll S{tprefix[NCH] * 2, X.G, X.bx, tile_e4, tprefix, rowtab};
            { const unsigned* rowtok = (const unsigned*)(X.ws + WS_ROWTOK); pg8::Unit uu;
              const float* rowgate = (const float*)(X.ws + WS_ROWGATE); LAS float* gtabw = (LAS float*)(X.lds + LDS_TAB + 4096 + 12288);
              _Pragma("nounroll") for (int i = 0; i < 12; ++i) { if (!S.next(i, uu)) break; const int pmu = __builtin_amdgcn_readfirstlane(uu.pm);
                  if (X.tid < 256) { rowtab[i * 256 + X.tid] = (int)rowtok[(size_t)pmu * 256 + X.tid]; gtabw[i * 256 + X.tid] = rowgate[(size_t)pmu * 256 + X.tid]; } } }
            __syncthreads();
            pg8::EpiMoe1 E{(bf16_t*)(X.ws + WS_ACT), (const LAS float*)(X.lds + LDS_TAB + 4096 + 12288)};
            REPEAT(R_MOE, (pg8::gemm_phase<pg8::EpiMoe1, MoeOrderAll, G_ALIGN, G_SP2>(gl, g, S, E, X.tid)))
        } PH_END
        for (int ch = 0; ch < NCH; ++ch) {
            PH_BEGIN if (EN_MOE2)  {
                LAS int* off = (LAS int*)(X.lds + LDS_TAB + 1024); LAS int* cntl = off + 64; LAS unsigned char* tile_e = (LAS unsigned char*)(X.lds + LDS_TAB + 2048);
                const int ntile = moe_tiles(X, l, ch, tile_e, off, cntl);
                pg8::Gemm g{(const bf16_t*)(X.ws + WS_ACT) + (size_t)ch * CH_ROWS * 256, (const bf16_t*)(wb + WO_2), 256, 0};
                MoeOrder<4, false> S{ntile * 4, X.G, X.bx, tile_e, nullptr};
                pg8::EpiFp8 E{(unsigned char*)(X.ws + WS_OPAIR), 1024, O_SCALE};
                REPEAT(R_MOE, (pg8::gemm_phase<pg8::EpiFp8, MoeOrder<4, false>, false, G_SP2>(gl, g, S, E, X.tid)))
            } PH_END
            if (ch + 1 < NCH) {
            PH_BEGIN if (EN_FIN)  { LAS int* off = (LAS int*)(X.lds + LDS_TAB + 1024); LAS int* cntl = off + 64; moe_offsets(X, l, ch, off, cntl); ph_combine(X, l, ch, off); } PH_END
            }
        }
        PH_BEGIN if (EN_FIN)  { LAS int* off = (LAS int*)(X.lds + LDS_TAB + 1024); LAS int* cntl = off + 64; moe_offsets(X, l, NCH - 1, off, cntl); ph_combine(X, l, NCH - 1, off); } PH_END
    }
#undef PH_BEGIN
#undef PH_END
}
constexpr int N_PHASES = 1 + DEPTH * (10 + 2 * NCH + 1);

#ifdef DBG_DUMP_OFF
__global__ void dbg_dump(const bf16_t* src, float* out, size_t n) { for (size_t i = (size_t)blockIdx.x * blockDim.x + threadIdx.x; i < n; i += (size_t)gridDim.x * blockDim.x) {
#ifdef DBG_HASH_OUT
    const unsigned bits = __builtin_bit_cast(unsigned, out[i]); out[i] = (float)((bits * 2654435761u) >> 8) * (1.0f / 16777216.0f);
#else
    const unsigned bits = src[i]; out[i] = (float)(((bits + 1u) * 2654435761u) >> 8) * (1.0f / 16777216.0f);
#endif
} }
#endif
extern "C" void kernel_launch(void* const* d_in, const int* in_sizes, int n_in, void* d_out, int out_size, void* d_ws, size_t ws_size, hipStream_t stream) {
    static int grid = 0;
    if (grid == 0) {
        if (n_in != 43 || out_size != M * D || ws_size < WS_NEED) { fprintf(stderr, "kernel_launch: unexpected shapes (n_in %d out %d ws %zu)\n", n_in, out_size, ws_size); grid = -1; return; }
        int dev = 0, cus = 0, per_cu = 0;
        if (hipGetDevice(&dev) != hipSuccess || hipDeviceGetAttribute(&cus, hipDeviceAttributeMultiprocessorCount, dev) != hipSuccess) { grid = -1; return; }
        if (hipFuncSetAttribute((const void*)fwd_kernel, hipFuncAttributeMaxDynamicSharedMemorySize, LDS_BYTES) != hipSuccess) { fprintf(stderr, "kernel_launch: hipFuncSetAttribute failed\n"); grid = -1; return; }
        if (hipOccupancyMaxActiveBlocksPerMultiprocessor(&per_cu, (const void*)fwd_kernel, 512, LDS_BYTES) != hipSuccess || per_cu < 1) fprintf(stderr, "kernel_launch: occupancy query says %d\n", per_cu);
        (void)hipGetLastError();
        grid = cus < 256 ? cus : 256;
    }
    if (grid < 0) return;
    (void)hipMemsetAsync((char*)d_ws + WS_CTL, 0, CTL_BYTES, stream);
#ifdef DBG_POISON
    (void)hipMemsetAsync((char*)d_ws + CTL_BYTES, 0xFF, WS_NEED - CTL_BYTES, stream);
    (void)hipMemsetAsync((char*)d_out, 0xFF, (size_t)M * D * 4, stream);
#endif
    Args a{};
    for (int i = 0; i < 43; ++i) a.in[i] = (const float*)d_in[i];
    a.positions = (const int*)d_in[I_POS]; a.out = (float*)d_out; a.ws = (unsigned char*)d_ws;
#if MK_PER_PHASE
#ifndef DBG_NPH
#define DBG_NPH N_PHASES
#endif
    for (int p = 0; p < DBG_NPH; ++p) { a.ph_lo = p; a.ph_hi = p + 1; hipLaunchKernelGGL(fwd_kernel, dim3(grid), dim3(512), LDS_BYTES, stream, a); }
#ifdef DBG_DUMP_OFF
    hipLaunchKernelGGL(dbg_dump, dim3(2048), dim3(256), 0, stream, (const bf16_t*)((const char*)d_ws + (size_t)(DBG_DUMP_OFF)), (float*)d_out, (size_t)M * D);
#endif
#else
    a.ph_lo = 0; a.ph_hi = N_PHASES; hipLaunchKernelGGL(fwd_kernel, dim3(grid), dim3(512), LDS_BYTES, stream, a);
#ifdef DBG_EXTRA_PH
    a.dbg = DBG_EXTRA_FLAGS;
    for (int rep = 0; rep < DBG_EXTRA_REP; ++rep) { a.ph_lo = DBG_EXTRA_PH; a.ph_hi = DBG_EXTRA_PH + 1; hipLaunchKernelGGL(fwd_kernel, dim3(grid), dim3(512), LDS_BYTES, stream, a); }
#endif
#endif
}
```

```cpp
#include <hip/hip_runtime.h>
#include <cstdio>
#include <cstdint>


#ifndef DSA_SKIP
#define DSA_SKIP 0
#endif
#ifndef DSA_PM
#define DSA_PM 0
#endif
#ifndef R_S1
#define R_S1 1
#endif
#ifndef R_S2
#define R_S2 1
#endif
#ifndef R_S3
#define R_S3 1
#endif
#ifndef EN_DSA
#define EN_DSA 1
#endif
#ifndef EN_S53
#define EN_S53 1
#endif
#ifndef EN_SSD3
#define EN_SSD3 1
#endif
#ifndef R_GWIN
#define R_GWIN 1
#endif
#ifndef R_GLU
#define R_GLU 1
#endif
#ifndef R_GP
#define R_GP 1
#endif
#ifndef R_GGATE
#define R_GGATE 1
#endif
#ifndef R_DENSE
#define R_DENSE 1
#endif
#ifndef R_MOE
#define R_MOE 1
#endif
#ifndef R_DSA
#define R_DSA 1
#endif
#ifndef R_MIX
#define R_MIX 1
#endif
#ifndef R_MISC
#define R_MISC 1
#endif
#ifndef MK_PER_PHASE
#define MK_PER_PHASE 0
#endif

#ifndef EN_PROLOGUE
#define EN_PROLOGUE 1
#endif
#ifndef EN_WCONV
#define EN_WCONV 1
#endif
#ifndef EN_GWIN
#define EN_GWIN 1
#endif
#ifndef EN_MX1
#define EN_MX1 1
#endif
#ifndef EN_MX2
#define EN_MX2 1
#endif
#ifndef EN_GLU
#define EN_GLU 1
#endif
#ifndef EN_GP
#define EN_GP 1
#endif
#ifndef EN_GGATE
#define EN_GGATE 1
#endif
#ifndef EN_GOUT
#define EN_GOUT 1
#endif
#ifndef EN_LN1
#define EN_LN1 1
#endif
#ifndef EN_FILL
#define EN_FILL 1
#endif
#ifndef EN_MOE1
#define EN_MOE1 1
#endif
#ifndef EN_MOE2
#define EN_MOE2 1
#endif
#ifndef EN_FIN
#define EN_FIN 1
#endif
#ifndef G_ALIGN
#define G_ALIGN true
#endif
#ifndef G_SP2
#define G_SP2 true
#endif
#define LAS __attribute__((address_space(3)))
#define GAS __attribute__((address_space(1)))
typedef unsigned short bf16_t;
typedef short bf16x8 __attribute__((ext_vector_type(8)));
typedef float f32x4 __attribute__((ext_vector_type(4)));
typedef float f32x2 __attribute__((ext_vector_type(2)));
typedef unsigned u32x4 __attribute__((ext_vector_type(4)));
typedef unsigned u32x2 __attribute__((ext_vector_type(2)));

constexpr int NB = 4, SEQ = 8192, M = NB * SEQ, D = 1024, DEPTH = 2;
constexpr int PJ = 2304;
constexpr int C_GU = 0, C_GV = 256, C_Q = 512, C_K = 768, C_V = 832, C_QI = 896, C_KI = 1152, C_S5 = 1216, C_Z = 1472, C_XBC = 1728, C_WI = 2240, C_DT = 2244;
constexpr int D_IN = 2248;
constexpr int NEXP = 32, NE1 = 33;
constexpr int NCH = 4, CHTOK = M / NCH;
constexpr int CH_ROWS = CHTOK * 8 + CHTOK + NE1 * 256;
constexpr float DN_ALPHA = 1.41421356237f;
constexpr float LN_EPS = 1e-5f, RMS_EPS = 1e-6f;
#ifndef PFP8
#define PFP8 1
#endif
constexpr float P_SCALE = 8.0f, O_SCALE = 32.0f;

constexpr size_t MiB = 1u << 20;
constexpr size_t WS_CTL = 0, CTL_BYTES = 1 * MiB;
constexpr size_t WS_MODV = 1 * MiB;
constexpr size_t WS_S5B = WS_MODV + 256 * 1024;
constexpr size_t WS_S5C = WS_S5B + 64 * 1024;
constexpr size_t WS_S5A = WS_S5C + 64 * 1024;
constexpr size_t WS_GMW = WS_S5A + 64 * 1024;
constexpr size_t WS_RFR = WS_GMW + 128 * 1024;
static_assert(WS_RFR + 128 * 1024 <= 2 * MiB, "misc tables");
constexpr size_t WS_S5ST = 2 * MiB;
constexpr size_t WS_ATOT = 3 * MiB;
constexpr size_t WS_WGBASE = 3 * MiB + 64 * 1024;
constexpr size_t WS_PINFO = 4 * MiB;
constexpr size_t WS_PGATE = 5 * MiB;
constexpr size_t WS_SLOT = 6 * MiB;
constexpr size_t WS_ROWTOK = 7 * MiB;
constexpr size_t WS_ROWGATE = 9 * MiB;
constexpr size_t WS_S5HIN = 11 * MiB;
constexpr size_t WS_ROPE = 12 * MiB;
constexpr size_t WS_W = 24 * MiB;
constexpr size_t WO_IN = 0, WO_GATE = WO_IN + (size_t)PJ * 1024 * 2, WO_BR = WO_GATE + (size_t)4096 * 1024 * 2, WO_OUT = WO_BR + (size_t)4 * 1024 * 256 * 2,
                 WO_GLU = WO_OUT + (size_t)1024 * 1024 * 2, WO_13 = WO_GLU + (size_t)256 * 256 * 2, WO_2 = WO_13 + (size_t)NE1 * 512 * 1024 * 2, WO_END = WO_2 + (size_t)NE1 * 1024 * 256 * 2;
static_assert(WO_END <= 72 * MiB, "weights region");
constexpr size_t WS_H = 96 * MiB;
constexpr size_t WS_Y = 160 * MiB;
constexpr size_t WS_PROJ = 224 * MiB;
constexpr size_t WS_P = 224 * MiB;
constexpr size_t WS_SSDST = 368 * MiB;
constexpr size_t WS_SSDSIN = 400 * MiB;
constexpr size_t WS_KI2 = 408 * MiB, WS_K2 = 412 * MiB, WS_V2 = 416 * MiB;
constexpr size_t WS_YCPRE = 384 * MiB;
constexpr size_t WS_V16 = 224 * MiB;
constexpr size_t WS_ACT = 160 * MiB;
constexpr size_t WS_OPAIR = 321 * MiB;
static_assert(CH_ROWS % 256 == 0 && WS_ACT + (size_t)NCH * CH_ROWS * 512 <= WS_OPAIR && WS_OPAIR + (size_t)2 * CH_ROWS * 1024 <= 512 * MiB, "moe buffers");
constexpr int CH_TILES = CH_ROWS / 256;
constexpr size_t WS_NEED = 512 * MiB;
constexpr int CW_BAR = 4096;
constexpr int CW_CNT = 16384;

constexpr int LDS_BYTES = 160 * 1024;
constexpr int LDS_TAB = 131072;
constexpr int LDS_MISC = LDS_BYTES - 256;

__device__ __forceinline__ unsigned f2bf(float f) { unsigned u = __builtin_bit_cast(unsigned, f); return (u + 0x7fffu + ((u >> 16) & 1u)) >> 16; }
__device__ __forceinline__ unsigned pk2(float lo, float hi) { return f2bf(lo) | (f2bf(hi) << 16); }
__device__ __forceinline__ float bf2f(unsigned short b) { return __builtin_bit_cast(float, (unsigned)b << 16); }
__device__ __forceinline__ float bflo(unsigned w) { return __builtin_bit_cast(float, w << 16); }
__device__ __forceinline__ float bfhi(unsigned w) { return __builtin_bit_cast(float, w & 0xffff0000u); }
__device__ __forceinline__ float wave_sum(float v) {
#pragma unroll
    for (int o = 1; o < 64; o <<= 1) v += __shfl_xor(v, o);
    return v;
}
__device__ __forceinline__ float wave_max(float v) {
#pragma unroll
    for (int o = 1; o < 64; o <<= 1) v = fmaxf(v, __shfl_xor(v, o));
    return v;
}
__device__ __forceinline__ int wave_sum_i(int v) {
#pragma unroll
    for (int o = 1; o < 64; o <<= 1) v += __shfl_xor(v, o);
    return v;
}
__device__ __forceinline__ float sigmoidf_(float x) { return __builtin_amdgcn_rcpf(1.0f + __expf(-x)); }
__device__ __forceinline__ float siluf_(float x) { return x * __builtin_amdgcn_rcpf(1.0f + __expf(-x)); }
__device__ __forceinline__ float gelu_tanh(float x) { const float u = 1.5957691216057308f * (x + 0.044715f * x * x * x); return x * __builtin_amdgcn_rcpf(1.0f + __expf(-u)); }
__device__ __forceinline__ float softplusf_(float x) { return fmaxf(x, 0.f) + log1pf(__expf(-fabsf(x))); }
__device__ __forceinline__ void sincos_red(float ang, float& sn, float& cs) {
    const double a = (double)ang; const double q = __builtin_rint(a * 0.63661977236758134308);
    const float r = (float)(a - q * 1.57079632679489661923); const int qi = (int)q & 3;
    const float r2 = r * r;
    const float s = r * (1.0f + r2 * (-1.6666667e-1f + r2 * (8.3333333e-3f + r2 * (-1.9841270e-4f + r2 * 2.7557319e-6f))));
    const float c = 1.0f + r2 * (-0.5f + r2 * (4.1666667e-2f + r2 * (-1.3888889e-3f + r2 * (2.4801587e-5f + r2 * -2.7557319e-7f))));
    sn = (qi == 0) ? s : (qi == 1) ? c : (qi == 2) ? -s : -c;
    cs = (qi == 0) ? c : (qi == 1) ? -s : (qi == 2) ? -c : s;
}
__device__ __forceinline__ f32x4 mfma16(bf16x8 a, bf16x8 b, f32x4 c) { return __builtin_amdgcn_mfma_f32_16x16x32_bf16(a, b, c, 0, 0, 0); }
__device__ __forceinline__ unsigned cvt_pk_bf16(float lo, float hi) { unsigned r; asm volatile("v_cvt_pk_bf16_f32 %0, %1, %2" : "=v"(r) : "v"(lo), "v"(hi)); return r; }

namespace pg8 {
constexpr int BM = 256, BK = 64, HALF = 128, HTB = HALF * BK * 2, STAGE_BYTES = 8 * HTB, NXCD = 8, WGM = 8;
__host__ __device__ __forceinline__ int lds_byte(int r, int c) { const int st = (r >> 4) * 2 + (c >> 5), rr = r & 15, cc = c & 31, ob = rr * 64 + cc * 2; return st * 1024 + (ob ^ (((ob >> 9) & 1) << 5)); }
__host__ __device__ __forceinline__ void stage_rc(int b, int& R, int& C) { const int st = b / 1024, sb = b % 1024, swz = sb ^ (((sb >> 9) & 1) << 5); R = (st >> 1) * 16 + swz / 64; C = (st & 1) * 32 + (swz % 64) / 2; }
__host__ __device__ __forceinline__ int perm32(int rho) { const int n = rho >> 4, i = rho & 15; return 8 * (i >> 2) + 4 * n + (i & 3); }

struct Unit { int pm, pn, bt, ab; };
struct Gemm { const bf16_t* A; const bf16_t* Bt; int K; size_t a_sel_stride; };

__device__ __forceinline__ int xcd_remap(int wgid, int nwg) { const int q = nwg / NXCD, r = nwg % NXCD, xcd = wgid % NXCD, off = wgid / NXCD; return (xcd < r ? xcd * (q + 1) : r * (q + 1) + (xcd - r) * q) + off; }

struct StaticOrder {
    static constexpr bool GATHER = false;
    int nM, nN, nwg, G, c;
    __device__ void init(int Mr, int N, int G_, int c_) { nM = Mr / BM; nN = N / BM; nwg = nM * nN; G = G_; c = c_; }
    __device__ __forceinline__ bool next(int i, Unit& u) const {
        const long L = (long)i * G + c; if (L >= nwg) return false;
        const int wgid = xcd_remap((int)L, nwg);
        const int nig = WGM * nN, gid = wgid / nig, fm = gid * WGM, gsz = (nM - fm) < WGM ? (nM - fm) : WGM;
        u.pm = fm + ((wgid % nig) % gsz); u.pn = (wgid % nig) / gsz; u.bt = u.pn; u.ab = 0; return true;
    }
    __device__ __forceinline__ void a_ready(const Unit&) const {}
    __device__ __forceinline__ void done(const Unit&) const {}
};

template <class Epi, class Sched, bool ALIGN_EPI = false, bool SP2 = true>
__device__ __forceinline__ void gemm_phase(LAS unsigned char* lds, const Gemm g, const Sched& S, const Epi& E, const int tid) {
    const int wid = __builtin_amdgcn_readfirstlane(tid >> 6), lane = tid & 63, wr = wid >> 2, wc = wid & 3, fr = lane & 15, fq = lane >> 4;
    const int K = g.K, nt = K / BK;
    unsigned voffA[2], voffB[2];
#pragma unroll
    for (int i = 0; i < 2; ++i) { int R, C; stage_rc(tid * 16 + i * 8192, R, C); const int Rb = Epi::PERM ? ((R & ~31) + perm32(R & 31)) : R;
        voffA[i] = (unsigned)(R * K + C) * 2u; voffB[i] = (unsigned)(Rb * K + C) * 2u; }
    const size_t kstep = (size_t)(BK * 2);
    const size_t hstep = (size_t)HALF * K * 2;
    const size_t tstep = 2 * hstep;
    const unsigned ldsw = (unsigned)wid * 1024u;
    const int aoff = lds_byte(wr * 64 + fr, fq * 8), boff = lds_byte(wc * 32 + fr, fq * 8);
#define PG8_SA(b, h) (((b) * 2 + (h)) * HTB)
#define PG8_SB(b, h) ((4 + (b) * 2 + (h)) * HTB)
#define PG8_STAGE(bufoff, gbase, voff) do { _Pragma("unroll") for (int _i = 0; _i < 2; ++_i) \
        __builtin_amdgcn_global_load_lds((const unsigned*)((const char*)(gbase) + (voff)[_i]), (LAS unsigned*)(lds + (bufoff) + ldsw + _i * 8192), 16, 0, 0); } while (0)
#define PG8_GO(u) do { _Pragma("unroll") for (int _h = 0; _h < 2; ++_h) _Pragma("unroll") for (int _i = 0; _i < 2; ++_i) { int _R, _C; stage_rc(tid * 16 + _i * 8192, _R, _C); \
        cgo[_h][_i] = (unsigned)S.row_of(u, _h * HALF + _R) * (unsigned)(K * 2) + (unsigned)_C * 2u; } } while (0)
#define PG8_STAGE_A(bufoff, base, h, kb, NX) do { if constexpr (Sched::GATHER) { _Pragma("unroll") for (int _i = 0; _i < 2; ++_i) \
        __builtin_amdgcn_global_load_lds((const unsigned*)((const char*)g.A + (kb) + cgo[h][_i]), (LAS unsigned*)(lds + (bufoff) + ldsw + _i * 8192), 16, 0, 0); } \
        else { PG8_STAGE(bufoff, (base) + (size_t)(h) * hstep + (kb), voffA); } } while (0)
#define PG8_LDA(dst, b, h) do { _Pragma("unroll") for (int m = 0; m < 4; ++m) _Pragma("unroll") for (int k = 0; k < 2; ++k) dst[m][k] = *(const LAS bf16x8*)(lds + PG8_SA(b, h) + aoff + m * 2048 + k * 1024); } while (0)
#define PG8_LDB(dst, b, h) do { _Pragma("unroll") for (int n = 0; n < 2; ++n) _Pragma("unroll") for (int k = 0; k < 2; ++k) dst[n][k] = *(const LAS bf16x8*)(lds + PG8_SB(b, h) + boff + n * 2048 + k * 1024); } while (0)
#define PG8_MMA(ai, bj, At, Bt) do { __builtin_amdgcn_s_setprio(1); _Pragma("unroll") for (int m = 0; m < 4; ++m) _Pragma("unroll") for (int n = 0; n < 2; ++n) _Pragma("unroll") for (int k = 0; k < 2; ++k) \
        acc[ai][bj][m][n] = __builtin_amdgcn_mfma_f32_16x16x32_bf16(Bt[n][k], At[m][k], acc[ai][bj][m][n], 0, 0, 0); __builtin_amdgcn_s_setprio(0); } while (0)
#define PG8_WAIT_V(n) asm volatile("s_waitcnt vmcnt(" #n ")" ::: "memory")
#define PG8_WAIT_L(n) asm volatile("s_waitcnt lgkmcnt(" #n ")" ::: "memory")
#define PG8_BAR __builtin_amdgcn_s_barrier()
#define PG8_SCHED __builtin_amdgcn_sched_barrier(0)
    Unit cur, nxt; int ui = 0;
    if (!S.next(0, cur)) return;
    f32x4 acc[2][2][4][2];
#pragma unroll
    for (int a = 0; a < 2; ++a)
#pragma unroll
        for (int b = 0; b < 2; ++b)
#pragma unroll
            for (int m = 0; m < 4; ++m)
#pragma unroll
                for (int n = 0; n < 2; ++n) acc[a][b][m][n] = (f32x4){0.f, 0.f, 0.f, 0.f};
    bf16x8 At[4][2], B0[2][2], B1[2][2];
    unsigned cgo[2][2];
    if constexpr (Sched::GATHER) PG8_GO(cur);
    const char* cA = (const char*)(g.A + (size_t)cur.ab * g.a_sel_stride) + (size_t)cur.pm * tstep; const char* cB = (const char*)g.Bt + (size_t)cur.bt * tstep;
    S.a_ready(cur);
    if constexpr (SP2) {
        PG8_STAGE(PG8_SB(0, 0), cB, voffB); PG8_STAGE(PG8_SB(0, 1), cB + hstep, voffB); PG8_STAGE_A(PG8_SA(0, 0), cA, 0, (size_t)0, false); PG8_STAGE_A(PG8_SA(0, 1), cA, 1, (size_t)0, false);
        if (wr == 1) PG8_BAR;
        PG8_WAIT_V(2); PG8_BAR;
        PG8_STAGE(PG8_SB(1, 0), cB + kstep, voffB); PG8_STAGE_A(PG8_SA(1, 0), cA, 0, kstep, false); PG8_STAGE(PG8_SB(1, 1), cB + hstep + kstep, voffB);
        PG8_WAIT_V(6); PG8_BAR;
    } else {
        PG8_STAGE(PG8_SB(0, 0), cB, voffB); PG8_STAGE_A(PG8_SA(0, 0), cA, 0, (size_t)0, false); PG8_STAGE(PG8_SB(0, 1), cB + hstep, voffB); PG8_STAGE_A(PG8_SA(0, 1), cA, 1, (size_t)0, false);
        if (wr == 1) PG8_BAR;
        PG8_WAIT_V(4); PG8_BAR;
        PG8_STAGE(PG8_SB(1, 0), cB + kstep, voffB); PG8_STAGE_A(PG8_SA(1, 0), cA, 0, kstep, false); PG8_STAGE(PG8_SB(1, 1), cB + hstep + kstep, voffB);
        PG8_WAIT_V(6); PG8_BAR;
    }
    for (;;) {
        const bool has_next = S.next(ui + 1, nxt);
        const char* nA = has_next ? (const char*)(g.A + (size_t)nxt.ab * g.a_sel_stride) + (size_t)nxt.pm * tstep : cA; const char* nB = has_next ? (const char*)g.Bt + (size_t)nxt.bt * tstep : cB;
#pragma nounroll
        for (int t = 0; t < nt; t += 2) {
            const bool last = (t == nt - 2);
            const size_t k1 = (size_t)(t + 1) * kstep;
            const char* a2b = last ? nA : cA; const size_t k2 = last ? (size_t)0 : (size_t)(t + 2) * kstep; const size_t k3 = k2 + kstep;
            const char* b2 = last ? nB : cB + (size_t)(t + 2) * kstep; const char* b3 = b2 + kstep;
            if (last && has_next) S.a_ready(nxt);
            if constexpr (SP2) {
            PG8_LDB(B0, 0, 0); PG8_LDB(B1, 0, 1); PG8_SCHED; PG8_LDA(At, 0, 0); PG8_STAGE_A(PG8_SA(1, 1), cA, 1, k1, false);
            if constexpr (Sched::GATHER) { if (last && has_next) PG8_GO(nxt); }
            PG8_WAIT_V(8); PG8_WAIT_L(0); PG8_BAR; PG8_MMA(0, 0, At, B0); PG8_MMA(0, 1, At, B1); PG8_BAR; PG8_SCHED;
            PG8_LDA(At, 0, 1); PG8_STAGE(PG8_SB(0, 0), b2, voffB); PG8_STAGE(PG8_SB(0, 1), b2 + hstep, voffB); PG8_STAGE_A(PG8_SA(0, 0), a2b, 0, k2, last);
            PG8_WAIT_V(8); PG8_WAIT_L(0); PG8_BAR; PG8_MMA(1, 0, At, B0); PG8_MMA(1, 1, At, B1); PG8_BAR; PG8_SCHED;
            PG8_LDB(B0, 1, 0); PG8_LDB(B1, 1, 1); PG8_SCHED; PG8_LDA(At, 1, 0); PG8_STAGE_A(PG8_SA(0, 1), a2b, 1, k2, last);
            PG8_WAIT_V(8); PG8_WAIT_L(0); PG8_BAR; PG8_MMA(0, 0, At, B0); PG8_MMA(0, 1, At, B1); PG8_BAR; PG8_SCHED;
            PG8_LDA(At, 1, 1); PG8_STAGE(PG8_SB(1, 0), b3, voffB); PG8_STAGE(PG8_SB(1, 1), b3 + hstep, voffB); PG8_STAGE_A(PG8_SA(1, 0), a2b, 0, k3, last);
            PG8_WAIT_V(8); PG8_WAIT_L(0); PG8_BAR; PG8_MMA(1, 0, At, B0); PG8_MMA(1, 1, At, B1); PG8_BAR; PG8_SCHED;
            } else {
            PG8_LDB(B0, 0, 0); PG8_SCHED; PG8_LDA(At, 0, 0); PG8_STAGE_A(PG8_SA(1, 1), cA, 1, k1, false);
            if constexpr (Sched::GATHER) { if (last && has_next) PG8_GO(nxt); }
            PG8_WAIT_L(8); PG8_BAR; PG8_WAIT_L(0); PG8_MMA(0, 0, At, B0); PG8_BAR; PG8_SCHED;
            PG8_LDB(B1, 0, 1); PG8_STAGE(PG8_SB(0, 0), b2, voffB);
            PG8_BAR; PG8_WAIT_L(0); PG8_MMA(0, 1, At, B1); PG8_BAR;
            PG8_LDA(At, 0, 1); PG8_STAGE_A(PG8_SA(0, 0), a2b, 0, k2, last);
            PG8_BAR; PG8_WAIT_L(0); PG8_MMA(1, 0, At, B0); PG8_BAR; PG8_SCHED;
            PG8_STAGE(PG8_SB(0, 1), b2 + hstep, voffB);
            PG8_WAIT_V(6); PG8_BAR; PG8_MMA(1, 1, At, B1); PG8_BAR;
            PG8_LDB(B0, 1, 0); PG8_SCHED; PG8_LDA(At, 1, 0); PG8_STAGE_A(PG8_SA(0, 1), a2b, 1, k2, last);
            PG8_WAIT_L(8); PG8_BAR; PG8_WAIT_L(0); PG8_MMA(0, 0, At, B0); PG8_BAR; PG8_SCHED;
            PG8_LDB(B1, 1, 1); PG8_STAGE(PG8_SB(1, 0), b3, voffB);
            PG8_BAR; PG8_WAIT_L(0); PG8_MMA(0, 1, At, B1); PG8_BAR;
            PG8_LDA(At, 1, 1); PG8_STAGE_A(PG8_SA(1, 0), a2b, 0, k3, last);
            PG8_BAR; PG8_WAIT_L(0); PG8_MMA(1, 0, At, B0); PG8_BAR; PG8_SCHED;
            PG8_STAGE(PG8_SB(1, 1), b3 + hstep, voffB);
            PG8_WAIT_V(6); PG8_BAR; PG8_MMA(1, 1, At, B1); PG8_BAR;
            }
        }
        if constexpr (ALIGN_EPI) { if (wr == 0) PG8_BAR; }
        E(acc, cur, wr, wc, fr, fq); S.done(cur);
        if (!has_next) break;
#pragma unroll
        for (int a = 0; a < 2; ++a)
#pragma unroll
            for (int b = 0; b < 2; ++b)
#pragma unroll
                for (int m = 0; m < 4; ++m)
#pragma unroll
                    for (int n = 0; n < 2; ++n) acc[a][b][m][n] = (f32x4){0.f, 0.f, 0.f, 0.f};
        cur = nxt; cA = nA; cB = nB; ++ui;
        if constexpr (ALIGN_EPI) { if (wr == 1) PG8_BAR; }
    }
    PG8_WAIT_V(0);
    if constexpr (!ALIGN_EPI) { if (wr == 0) PG8_BAR; }
    PG8_BAR;
#undef PG8_SA
#undef PG8_SB
#undef PG8_STAGE
#undef PG8_STAGE_A
#undef PG8_GO
#undef PG8_LDA
#undef PG8_LDB
#undef PG8_MMA
#undef PG8_WAIT_V
#undef PG8_WAIT_L
#undef PG8_BAR
#undef PG8_SCHED
}

struct EpiBf16 {
    static constexpr bool PERM = true;
    bf16_t* O; int ldc;
    __device__ __forceinline__ void operator()(const f32x4 (&acc)[2][2][4][2], const Unit& u, int wr, int wc, int fr, int fq) const {
        const int row0 = u.pm * BM + wr * 64 + fr, col0 = u.pn * BM + wc * 32 + 8 * fq;
#pragma unroll
        for (int ai = 0; ai < 2; ++ai)
#pragma unroll
            for (int m = 0; m < 4; ++m) { bf16_t* rowp = O + (size_t)(row0 + ai * HALF + m * 16) * ldc + col0;
#pragma unroll
                for (int bj = 0; bj < 2; ++bj) { const f32x4 v0 = acc[ai][bj][m][0], v1 = acc[ai][bj][m][1];
                    u32x4 w; w.x = cvt_pk_bf16(v0[0], v0[1]); w.y = cvt_pk_bf16(v0[2], v0[3]); w.z = cvt_pk_bf16(v1[0], v1[1]); w.w = cvt_pk_bf16(v1[2], v1[3]);
                    *(u32x4*)(rowp + bj * HALF) = w; } }
    }
};
__device__ __forceinline__ unsigned pk4_fp8(float a, float b, float c, float d) { int w = 0; w = __builtin_amdgcn_cvt_pk_fp8_f32(a, b, w, false); w = __builtin_amdgcn_cvt_pk_fp8_f32(c, d, w, true); return (unsigned)w; }
__device__ __forceinline__ f32x4 clamp_fp8(f32x4 v, float sc) { f32x4 r; r[0] = __builtin_amdgcn_fmed3f(v[0] * sc, -440.f, 440.f); r[1] = __builtin_amdgcn_fmed3f(v[1] * sc, -440.f, 440.f);
    r[2] = __builtin_amdgcn_fmed3f(v[2] * sc, -440.f, 440.f); r[3] = __builtin_amdgcn_fmed3f(v[3] * sc, -440.f, 440.f); return r; }
struct EpiFp8 {
    static constexpr bool PERM = true;
    unsigned char* O; int ldc; float scale;
    __device__ __forceinline__ void operator()(const f32x4 (&acc)[2][2][4][2], const Unit& u, int wr, int wc, int fr, int fq) const {
        const int row0 = u.pm * BM + wr * 64 + fr, col0 = u.pn * BM + wc * 32 + 8 * fq;
#pragma unroll
        for (int ai = 0; ai < 2; ++ai)
#pragma unroll
            for (int m = 0; m < 4; ++m) { unsigned char* rowp = O + (size_t)(row0 + ai * HALF + m * 16) * ldc + col0;
#pragma unroll
                for (int bj = 0; bj < 2; ++bj) { const f32x4 v0 = clamp_fp8(acc[ai][bj][m][0], scale), v1 = clamp_fp8(acc[ai][bj][m][1], scale);
                    u32x2 w; w.x = pk4_fp8(v0[0], v0[1], v0[2], v0[3]); w.y = pk4_fp8(v1[0], v1[1], v1[2], v1[3]);
                    *(u32x2*)(rowp + bj * HALF) = w; } }
    }
};
struct EpiGlu {
    static constexpr bool PERM = true;
    const bf16_t* Ysrc; bf16_t* O; const float* bias;
    __device__ __forceinline__ void operator()(const f32x4 (&acc)[2][2][4][2], const Unit& u, int wr, int wc, int fr, int fq) const {
        const int row0 = u.pm * BM + wr * 64 + fr, col0 = u.pn * BM + wc * 32 + 8 * fq;
#pragma unroll
        for (int ai = 0; ai < 2; ++ai)
#pragma unroll
            for (int m = 0; m < 4; ++m) { const size_t ro = (size_t)(row0 + ai * HALF + m * 16) * 256 + col0;
#pragma unroll
                for (int bj = 0; bj < 2; ++bj) { const f32x4 v0 = acc[ai][bj][m][0], v1 = acc[ai][bj][m][1];
                    const u32x4 yv = *(const u32x4*)(Ysrc + ro + bj * HALF);
                    const f32x4 b0 = *(const f32x4*)(bias + col0 + bj * HALF), b1 = *(const f32x4*)(bias + col0 + bj * HALF + 4);
                    float o[8];
                    o[0] = bflo(yv.x) * sigmoidf_(v0[0] + b0[0]); o[1] = bfhi(yv.x) * sigmoidf_(v0[1] + b0[1]); o[2] = bflo(yv.y) * sigmoidf_(v0[2] + b0[2]); o[3] = bfhi(yv.y) * sigmoidf_(v0[3] + b0[3]);
                    o[4] = bflo(yv.z) * sigmoidf_(v1[0] + b1[0]); o[5] = bfhi(yv.z) * sigmoidf_(v1[1] + b1[1]); o[6] = bflo(yv.w) * sigmoidf_(v1[2] + b1[2]); o[7] = bfhi(yv.w) * sigmoidf_(v1[3] + b1[3]);
                    u32x4 w; w.x = cvt_pk_bf16(o[0], o[1]); w.y = cvt_pk_bf16(o[2], o[3]); w.z = cvt_pk_bf16(o[4], o[5]); w.w = cvt_pk_bf16(o[6], o[7]);
                    *(u32x4*)(O + ro + bj * HALF) = w; } }
    }
};
struct EpiGateMerge {
    static constexpr bool PERM = true;
    const unsigned char* P; bf16_t* Mg; float pinv;
    __device__ __forceinline__ void operator()(const f32x4 (&acc)[2][2][4][2], const Unit& u, int wr, int wc, int fr, int fq) const {
        const int i = u.pn >> 2, mt = u.pn & 3;
        const int row0 = u.pm * BM + wr * 64 + fr, col0 = mt * BM + wc * 32 + 8 * fq;
#pragma unroll
        for (int ai = 0; ai < 2; ++ai) {
            u32x2 pv[4][2]; u32x4 pvb[4][2]; u32x4 mv[4][2];
#pragma unroll
            for (int m = 0; m < 4; ++m)
#pragma unroll
                for (int bj = 0; bj < 2; ++bj) { const size_t r = (size_t)(row0 + ai * HALF + m * 16);
                    pv[m][bj] = PFP8 ? *(const u32x2*)(P + r * 4096 + i * 1024 + col0 + bj * HALF) : (u32x2){0u, 0u}; if (!PFP8) pvb[m][bj] = *(const u32x4*)((const bf16_t*)P + r * 4096 + i * 1024 + col0 + bj * HALF);
                    mv[m][bj] = (u32x4){0u, 0u, 0u, 0u}; if (i > 0) mv[m][bj] = *(const u32x4*)(Mg + r * 1024 + col0 + bj * HALF); }
#pragma unroll
            for (int m = 0; m < 4; ++m)
#pragma unroll
                for (int bj = 0; bj < 2; ++bj) { const size_t r = (size_t)(row0 + ai * HALF + m * 16); const f32x4 v0 = acc[ai][bj][m][0], v1 = acc[ai][bj][m][1]; const u32x2 p8 = pv[m][bj]; const u32x4 m4 = mv[m][bj];
                    f32x2 pa = __builtin_amdgcn_cvt_pk_f32_fp8((int)p8.x, false) * pinv, pb = __builtin_amdgcn_cvt_pk_f32_fp8((int)p8.x, true) * pinv,
                          pc = __builtin_amdgcn_cvt_pk_f32_fp8((int)p8.y, false) * pinv, pd = __builtin_amdgcn_cvt_pk_f32_fp8((int)p8.y, true) * pinv;
                    if (!PFP8) { const u32x4 q4 = pvb[m][bj]; pa = (f32x2){bflo(q4.x), bfhi(q4.x)}; pb = (f32x2){bflo(q4.y), bfhi(q4.y)}; pc = (f32x2){bflo(q4.z), bfhi(q4.z)}; pd = (f32x2){bflo(q4.w), bfhi(q4.w)}; }
                    float o[8];
                    o[0] = bflo(m4.x) + pa[0] * sigmoidf_(v0[0]); o[1] = bfhi(m4.x) + pa[1] * sigmoidf_(v0[1]); o[2] = bflo(m4.y) + pb[0] * sigmoidf_(v0[2]); o[3] = bfhi(m4.y) + pb[1] * sigmoidf_(v0[3]);
                    o[4] = bflo(m4.z) + pc[0] * sigmoidf_(v1[0]); o[5] = bfhi(m4.z) + pc[1] * sigmoidf_(v1[1]); o[6] = bflo(m4.w) + pd[0] * sigmoidf_(v1[2]); o[7] = bfhi(m4.w) + pd[1] * sigmoidf_(v1[3]);
                    u32x4 w; w.x = cvt_pk_bf16(o[0], o[1]); w.y = cvt_pk_bf16(o[2], o[3]); w.z = cvt_pk_bf16(o[4], o[5]); w.w = cvt_pk_bf16(o[6], o[7]);
                    *(u32x4*)(Mg + r * 1024 + col0 + bj * HALF) = w; }
        }
    }
};
struct EpiResid {
    static constexpr bool PERM = false;
    const float* xin; bf16_t* out; const float* gate;
    __device__ __forceinline__ void operator()(const f32x4 (&acc)[2][2][4][2], const Unit& u, int wr, int wc, int fr, int fq) const {
        const int row0 = u.pm * BM + wr * 64 + fr, col0 = u.pn * BM + wc * 32 + 4 * fq;
        const int b = (u.pm * BM) / SEQ;
        f32x4 gv[2][2];
#pragma unroll
        for (int bj = 0; bj < 2; ++bj)
#pragma unroll
            for (int n = 0; n < 2; ++n) gv[bj][n] = *(const f32x4*)(gate + b * 3072 + 2048 + col0 + bj * HALF + n * 16) + 1.0f;
#pragma unroll
        for (int ai = 0; ai < 2; ++ai)
#pragma unroll
            for (int mh = 0; mh < 4; mh += 2) {
                f32x4 xv[2][2][2];
#pragma unroll
                for (int m = 0; m < 2; ++m)
#pragma unroll
                    for (int bj = 0; bj < 2; ++bj)
#pragma unroll
                        for (int n = 0; n < 2; ++n) xv[m][bj][n] = *(const f32x4*)(xin + (size_t)(row0 + ai * HALF + (mh + m) * 16) * D + col0 + bj * HALF + n * 16);
#pragma unroll
                for (int m = 0; m < 2; ++m)
#pragma unroll
                    for (int bj = 0; bj < 2; ++bj)
#pragma unroll
                        for (int n = 0; n < 2; ++n) { const f32x4 v = xv[m][bj][n] * DN_ALPHA + gv[bj][n] * acc[ai][bj][mh + m][n];
                            u32x2 w; w.x = cvt_pk_bf16(v[0], v[1]); w.y = cvt_pk_bf16(v[2], v[3]);
                            *(u32x2*)(out + (size_t)(row0 + ai * HALF + (mh + m) * 16) * D + col0 + bj * HALF + n * 16) = w; } }
    }
};
struct EpiMoe1 {
    static constexpr bool PERM = false;
    bf16_t* Act; const LAS float* gtab;
    __device__ __forceinline__ void operator()(const f32x4 (&acc)[2][2][4][2], const Unit& u, int wr, int wc, int fr, int fq) const {
        const int row0 = u.pm * BM + wr * 64 + fr, f0 = u.pn * 128 + wc * 16 + 4 * fq;
#pragma unroll
        for (int ai = 0; ai < 2; ++ai)
#pragma unroll
            for (int m = 0; m < 4; ++m) { const int r = row0 + ai * HALF + m * 16; const float gt = gtab[u.ab * 256 + wr * 64 + fr + ai * HALF + m * 16];
#pragma unroll
                for (int bj = 0; bj < 2; ++bj) { const f32x4 a = acc[ai][bj][m][0], b = acc[ai][bj][m][1];
                    u32x2 w; w.x = cvt_pk_bf16(siluf_(a[0]) * b[0] * gt, siluf_(a[1]) * b[1] * gt); w.y = cvt_pk_bf16(siluf_(a[2]) * b[2] * gt, siluf_(a[3]) * b[3] * gt);
                    *(u32x2*)(Act + (size_t)r * 256 + f0 + bj * 64) = w; } }
    }
};
}

#define XB_TMO      128
#define XB_XCNT(j)  (256  + 64 * (j))
#define XB_XSUB(j)  (1280 + 64 * (j))
#define XB_XGEN(j)  (2304 + 64 * (j))
#define XB_TOP      3328
#define XB_TOPGEN   3392
#define XCD_BAR_WORDS 3456
#define XB_SPIN_CAP (1u << 22)
__device__ __forceinline__ unsigned xb_ld(unsigned* p)              { return __hip_atomic_load(p, __ATOMIC_RELAXED, __HIP_MEMORY_SCOPE_AGENT); }
__device__ __forceinline__ unsigned xb_add(unsigned* p, unsigned v) { return __hip_atomic_fetch_add(p, v, __ATOMIC_RELAXED, __HIP_MEMORY_SCOPE_AGENT); }
__device__ __forceinline__ unsigned xb_xcc_id() { return (unsigned)__builtin_amdgcn_s_getreg((3 << 11) | 20) & 0xFu; }
#define XB_SPIN(cond, bar) do { unsigned _sp = 0; while (cond) { __builtin_amdgcn_s_sleep(1); \
    if ((++_sp & 255u) == 0u) { if (xb_ld(&(bar)[XB_TMO])) break; if (_sp > XB_SPIN_CAP) { atomicAdd(&(bar)[XB_TMO], 1u); break; } } } } while (0)
struct XcdBarrier { unsigned* bar; unsigned x; volatile LAS unsigned* st; };
__device__ __forceinline__ XcdBarrier xcd_barrier_post(unsigned* bar, volatile LAS unsigned* st) {
    XcdBarrier b; b.bar = bar; b.x = xb_xcc_id(); b.st = st;
    if (threadIdx.x == 0) (void)xb_add(&bar[XB_XCNT(b.x)], 1u);
    return b;
}
__device__ __forceinline__ void xcd_barrier_complete(unsigned* bar, unsigned x, unsigned& nloc, unsigned& nx) {
    const unsigned G = gridDim.x * gridDim.y * gridDim.z;
    unsigned sum, cnt, mine, sp = 0u;
    for (;;) {
        sum = 0u; cnt = 0u; mine = 0u;
#pragma unroll
        for (unsigned j = 0; j < 16; ++j) { const unsigned c = xb_ld(&bar[XB_XCNT(j)]); sum += c; cnt += (c > 0u) ? 1u : 0u; mine = (j == x) ? c : mine; }
        if (sum == G) break;
        __builtin_amdgcn_s_sleep(1);
        if ((++sp & 255u) == 0u) { if (xb_ld(&bar[XB_TMO])) break; if (sp > XB_SPIN_CAP) { atomicAdd(&bar[XB_TMO], 1u); break; } }
    }
    nloc = mine > 0u ? mine : 1u; nx = cnt > 0u ? cnt : 1u;
}
__device__ __forceinline__ void xcd_barrier(const XcdBarrier& b) {
    asm volatile("s_waitcnt vmcnt(0)" ::: "memory");
    __syncthreads();
    if (threadIdx.x == 0) {
        unsigned* bar = b.bar;
        __builtin_amdgcn_s_waitcnt(0);
        unsigned nloc = b.st[0], nx = b.st[1];
        if (nloc == 0u) { xcd_barrier_complete(bar, b.x, nloc, nx); b.st[0] = nloc; b.st[1] = nx; }
        const unsigned old = xb_add(&bar[XB_XSUB(b.x)], 1u);
        const unsigned gen = old / nloc;
        if (old + 1u == (gen + 1u) * nloc) {
            __builtin_amdgcn_fence(__ATOMIC_RELEASE, "agent");
            asm volatile("s_waitcnt vmcnt(0)" ::: "memory");
            const unsigned og = xb_add(&bar[XB_TOP], 1u);
            const unsigned tg = og / nx;
            if (og + 1u == (tg + 1u) * nx) xb_add(&bar[XB_TOPGEN], 1u);
            else XB_SPIN(xb_ld(&bar[XB_TOPGEN]) == tg, bar);
            __builtin_amdgcn_fence(__ATOMIC_ACQUIRE, "agent");
            xb_add(&bar[XB_XGEN(b.x)], 1u);
            asm volatile("s_waitcnt vmcnt(0)" ::: "memory");
        } else {
            XB_SPIN(xb_ld(&bar[XB_XGEN(b.x)]) == gen, bar);
            __builtin_amdgcn_fence(__ATOMIC_ACQUIRE, "agent");
            asm volatile("s_waitcnt vmcnt(0)" ::: "memory");
        }
    }
    __syncthreads();
}

struct Args {
    const float* in[43]; const int* positions; float* out; unsigned char* ws; int ph_lo, ph_hi, dbg, pad;
};
enum { I_X = 0, I_C = 1, I_POS = 2, I_MOD1W = 3, I_MOD1B = 4, I_WIN = 5, I_GMLNG = 6, I_GMLNB = 7, I_GMW = 8, I_GMB = 9,
       I_S5LRE = 10, I_S5LIM = 11, I_S5STEP = 12, I_S5BRE = 13, I_S5BIM = 14, I_S5CRE = 15, I_S5CIM = 16, I_S5D = 17, I_S5GLUW = 18, I_S5GLUB = 19,
       I_CONVW = 20, I_CONVB = 21, I_DTBIAS = 22, I_ALOG = 23, I_SSDD = 24, I_SSDNG = 25, I_WBR = 26, I_WGATE = 27, I_WOUT = 28, I_LN1G = 29, I_LN1B = 30,
       I_MOD2W = 31, I_MOD2B = 32, I_RW = 33, I_RB = 34, I_EW1 = 35, I_EW3 = 36, I_EW2 = 37, I_SW1 = 38, I_SW3 = 39, I_SW2 = 40, I_LN2G = 41, I_LN2B = 42 };

typedef const __attribute__((address_space(4))) Args* ArgsP;
struct Ctx {
    ArgsP a; unsigned char* ws; LAS unsigned char* lds; int tid, lane, wave, c, G, bx, dbg;
    __device__ __forceinline__ const float* in(int i) const { return a->in[i]; }
    __device__ __forceinline__ bf16_t* proj() const { return (bf16_t*)(ws + WS_PROJ); }
    __device__ __forceinline__ bf16_t* hbuf() const { return (bf16_t*)(ws + WS_H); }
    __device__ __forceinline__ bf16_t* ybuf() const { return (bf16_t*)(ws + WS_Y); }
    __device__ __forceinline__ float* modv(int l, int w) const { return (float*)(ws + WS_MODV) + (size_t)(l * 2 + w) * NB * 3072; }
};

__device__ __forceinline__ void ph_prologue(const Ctx& X) {
    { float* ropet = (float*)(X.ws + WS_ROPE); const int* pos = X.a->positions;
      for (int i = X.c * 512 + X.tid; i < M * 8; i += X.G * 512) { const int tok = i >> 3, j = i & 7;
          const float inv = (j == 0) ? 1.0f : (j == 1) ? 0.1939227432f : (j == 2) ? 0.0376060307f : (j == 3) ? 0.00729266461f : (j == 4) ? 0.00141421356f : (j == 5) ? 0.000274248188f : (j == 6) ? 5.31829610e-05f : 1.03133862e-05f;
          float sn, cs; sincos_red((float)pos[tok] * inv, sn, cs); *(f32x2*)(ropet + (size_t)i * 2) = (f32x2){cs, sn}; } }
    LAS float* red = (LAS float*)X.lds;
    for (int it = X.c; it < DEPTH * 2 * 48; it += X.G) {
        const int l = it / 96, w = (it / 48) & 1, jb = it % 48, j = jb * 64 + X.lane;
        const float* W = X.in(w ? I_MOD2W : I_MOD1W) + (size_t)l * D * 3072; const float* cv = X.in(I_C);
        float a0 = 0.f, a1 = 0.f, a2 = 0.f, a3 = 0.f;
        const int k0 = X.wave * 128;
        for (int k = k0; k < k0 + 128; ++k) { const float wv = W[(size_t)k * 3072 + j]; a0 += cv[k] * wv; a1 += cv[D + k] * wv; a2 += cv[2 * D + k] * wv; a3 += cv[3 * D + k] * wv; }
        red[(X.wave * 4 + 0) * 64 + X.lane] = a0; red[(X.wave * 4 + 1) * 64 + X.lane] = a1; red[(X.wave * 4 + 2) * 64 + X.lane] = a2; red[(X.wave * 4 + 3) * 64 + X.lane] = a3;
        __syncthreads();
        if (X.tid < 256) { const int b = X.tid >> 6, ln = X.tid & 63; float s = 0.f;
#pragma unroll
            for (int q = 0; q < 8; ++q) s += red[(q * 4 + b) * 64 + ln];
            const int jj = jb * 64 + ln; X.modv(l, w)[b * 3072 + jj] = s + X.in(w ? I_MOD2B : I_MOD1B)[(size_t)l * 3072 + jj]; }
        __syncthreads();
    }
}

template <class Src>
__device__ __forceinline__ void tr_item(const Src& src, bf16_t* WT, int K, int rowbase, int kb, int nb, LAS float* scr, int lane) {
    const int k0 = 64 * kb, n0 = 32 * nb;
    f32x4 v[8];
#pragma unroll
    for (int i = 0; i < 8; ++i) v[i] = src.load4(k0 + 8 * i + (lane >> 3), n0 + 4 * (lane & 7));
#pragma unroll
    for (int i = 0; i < 8; ++i) { LAS float* d = scr + (8 * i + (lane >> 3)) * 33 + 4 * (lane & 7); d[0] = v[i][0]; d[1] = v[i][1]; d[2] = v[i][2]; d[3] = v[i][3]; }
    asm volatile("s_waitcnt lgkmcnt(0)" ::: "memory");
    const int c = lane & 7;
#pragma unroll
    for (int j = 0; j < 4; ++j) { const int n = (lane >> 3) + 8 * j; const LAS float* s = scr + (8 * c) * 33 + n;
        u32x4 o; o.x = pk2(s[0 * 33], s[1 * 33]); o.y = pk2(s[2 * 33], s[3 * 33]); o.z = pk2(s[4 * 33], s[5 * 33]); o.w = pk2(s[6 * 33], s[7 * 33]);
        *(u32x4*)(WT + (size_t)(rowbase + n0 + n) * K + k0 + 8 * c) = o; }
    asm volatile("s_waitcnt lgkmcnt(0)" ::: "memory");
}
struct SrcPlain { const float* W; int N; __device__ __forceinline__ f32x4 load4(int k, int n) const { return *(const f32x4*)(W + (size_t)k * N + n); } };
struct SrcWin { const float* W; __device__ __forceinline__ f32x4 load4(int k, int n) const {
    if (n >= D_IN) return (f32x4){0.f, 0.f, 0.f, 0.f}; const int o = (n < 1216) ? n : (n < 2240) ? n + 4 : (n < 2244) ? 1216 + (n - 2240) : n; return *(const f32x4*)(W + (size_t)k * D_IN + o); } };
struct Src13 { const float* W1; const float* W3; __device__ __forceinline__ f32x4 load4(int k, int n) const {
    const int f = (n >> 5) * 16 + (n & 15); const long d = (n & 16) ? (long)(W3 - W1) : 0l; return *(const f32x4*)(W1 + d + (long)k * 256 + f); } };

__device__ __forceinline__ void ph_wconv(const Ctx& X, int l) {
    LAS float* scr = (LAS float*)(X.lds + X.wave * 16384);
    unsigned char* wb = X.ws + WS_W;
    const int gw = X.c * 8 + X.wave, NGW = X.G * 8;
    constexpr int I_A = 16 * 72, I_B = 4 * 16 * 32, I_C2 = 4 * 4 * 32, I_D = 16 * 32, I_E = 4 * 8, I_F = NE1 * 16 * 16, I_G = NE1 * 4 * 32;
    constexpr int NIT = I_A + I_B + I_C2 + I_D + I_E + I_F + I_G;
    for (int it = gw; it < NIT; it += NGW) {
        int r = it;
        if (r < I_A) { SrcWin s{X.in(I_WIN) + (size_t)l * D * D_IN}; tr_item(s, (bf16_t*)(wb + WO_IN), 1024, 0, r / 72, r % 72, scr, X.lane); continue; } r -= I_A;
        if (r < I_B) { const int i = r / 512, q = r % 512; SrcPlain s{X.in(I_WGATE) + ((size_t)l * 4 + i) * D * D, D}; tr_item(s, (bf16_t*)(wb + WO_GATE), 1024, i * 1024, q / 32, q % 32, scr, X.lane); continue; } r -= I_B;
        if (r < I_C2) { const int i = r / 128, q = r % 128; SrcPlain s{X.in(I_WBR) + ((size_t)l * 4 + i) * 256 * D, D}; tr_item(s, (bf16_t*)(wb + WO_BR) + (size_t)i * 1024 * 256, 256, 0, q / 32, q % 32, scr, X.lane); continue; } r -= I_C2;
        if (r < I_D) { SrcPlain s{X.in(I_WOUT) + (size_t)l * D * D, D}; tr_item(s, (bf16_t*)(wb + WO_OUT), 1024, 0, r / 32, r % 32, scr, X.lane); continue; } r -= I_D;
        if (r < I_E) { SrcPlain s{X.in(I_S5GLUW) + (size_t)l * 256 * 256, 256}; tr_item(s, (bf16_t*)(wb + WO_GLU), 256, 0, r / 8, r % 8, scr, X.lane); continue; } r -= I_E;
        if (r < I_F) { const int e = r / 256, q = r % 256;
            const Src13 s{(e < NEXP) ? X.in(I_EW1) + ((size_t)l * NEXP + e) * D * 256 : X.in(I_SW1) + (size_t)l * D * 256, (e < NEXP) ? X.in(I_EW3) + ((size_t)l * NEXP + e) * D * 256 : X.in(I_SW3) + (size_t)l * D * 256};
            tr_item(s, (bf16_t*)(wb + WO_13) + (size_t)e * 512 * 1024, 1024, 0, q / 16, q % 16, scr, X.lane); continue; } r -= I_F;
        { const int e = r / 128, q = r % 128; SrcPlain s{e < NEXP ? X.in(I_EW2) + ((size_t)l * NEXP + e) * 256 * D : X.in(I_SW2) + (size_t)l * 256 * D, D};
            tr_item(s, (bf16_t*)(wb + WO_2) + (size_t)e * 1024 * 256, 256, 0, q / 32, q % 32, scr, X.lane); }
    }
    const int gt = X.c * 512 + X.tid, NGT = X.G * 512;
    { bf16_t* gmw = (bf16_t*)(X.ws + WS_GMW); const float* src = X.in(I_GMW) + (size_t)l * 4 * 128 * 128;
      for (int i = gt; i < 4 * 128 * 128; i += NGT) { const int t = (i >> 7) & 127, s = i & 127; gmw[i] = (bf16_t)f2bf(s <= t ? src[i] : 0.f); } }
    for (int i = gt; i < 16 * 64; i += NGT) {
        const int g = i >> 6, p = i & 63;
        const float step = expf(X.in(I_S5STEP)[l * 16 + g]); const float lr = X.in(I_S5LRE)[(size_t)l * 1024 + i], li = X.in(I_S5LIM)[(size_t)l * 1024 + i];
        const float mag = expf(lr * step); float sn, cs; sincos_red(li * step, sn, cs);
        const float abr = mag * cs, abi = mag * sn, den = lr * lr + li * li, nr = abr - 1.0f;
        const float cr = (nr * lr + abi * li) / den, ci = (abi * lr - nr * li) / den;
        float* sa = (float*)(X.ws + WS_S5A); sa[i * 2] = abr; sa[i * 2 + 1] = abi;
        bf16_t* bb = (bf16_t*)(X.ws + WS_S5B); bf16_t* cm = (bf16_t*)(X.ws + WS_S5C);
        const float* bre = X.in(I_S5BRE) + ((size_t)l * 1024 + i) * 16; const float* bim = X.in(I_S5BIM) + ((size_t)l * 1024 + i) * 16;
#pragma unroll
        for (int ch = 0; ch < 16; ++ch) { const float br = bre[ch], bi = bim[ch];
            bb[(g * 128 + p) * 16 + ch] = (bf16_t)f2bf(cr * br - ci * bi); bb[(g * 128 + 64 + p) * 16 + ch] = (bf16_t)f2bf(cr * bi + ci * br);
            cm[(g * 16 + ch) * 128 + p] = (bf16_t)f2bf(X.in(I_S5CRE)[(((size_t)l * 16 + g) * 16 + ch) * 64 + p]);
            cm[(g * 16 + ch) * 128 + 64 + p] = (bf16_t)f2bf(-X.in(I_S5CIM)[(((size_t)l * 16 + g) * 16 + ch) * 64 + p]); }
    }
    { bf16_t* rf = (bf16_t*)(X.ws + WS_RFR); const float* rw = X.in(I_RW) + (size_t)l * D * NEXP;
      for (int i = gt; i < 2 * 32 * 64 * 8; i += NGT) { const int j = i & 7, ln = (i >> 3) & 63, ks = (i >> 9) & 31, rt = i >> 14;
          const float v = rw[(size_t)(ks * 32 + 8 * (ln >> 4) + j) * NEXP + rt * 16 + (ln & 15)]; const unsigned hi = f2bf(v); const float lo = v - bflo(hi);
          rf[i] = (bf16_t)hi; rf[32768 + i] = (bf16_t)f2bf(lo); } }
    if (l == 0) {
        const float* x = X.in(I_X); bf16_t* h = X.hbuf(); const float* mv = X.modv(0, 0);
        for (size_t i = (size_t)gt; i < (size_t)M * D / 8; i += NGT) {
            const size_t e = i * 8; const int col = (int)(e & 1023), b = (int)(e >> 23);
            const f32x4 x0 = *(const f32x4*)(x + e), x1 = *(const f32x4*)(x + e + 4);
            const f32x4 sh0 = *(const f32x4*)(mv + b * 3072 + col), sh1 = *(const f32x4*)(mv + b * 3072 + col + 4), sc0 = *(const f32x4*)(mv + b * 3072 + 1024 + col), sc1 = *(const f32x4*)(mv + b * 3072 + 1024 + col + 4);
            const f32x4 h0 = x0 * (sc0 + 1.0f) + sh0, h1 = x1 * (sc1 + 1.0f) + sh1;
            u32x4 w; w.x = pk2(h0[0], h0[1]); w.y = pk2(h0[2], h0[3]); w.z = pk2(h1[0], h1[1]); w.w = pk2(h1[2], h1[3]);
            *(u32x4*)(h + e) = w; }
    }
}

__device__ __forceinline__ void rope8(const u32x4 a, const u32x4 b, const float* cs, u32x4& wa, u32x4& wb) {
    float t1[8], t2[8]; t1[0] = bflo(a.x); t1[1] = bfhi(a.x); t1[2] = bflo(a.y); t1[3] = bfhi(a.y); t1[4] = bflo(a.z); t1[5] = bfhi(a.z); t1[6] = bflo(a.w); t1[7] = bfhi(a.w);
    t2[0] = bflo(b.x); t2[1] = bfhi(b.x); t2[2] = bflo(b.y); t2[3] = bfhi(b.y); t2[4] = bflo(b.z); t2[5] = bfhi(b.z); t2[6] = bflo(b.w); t2[7] = bfhi(b.w);
    float o1[8], o2[8]; f32x4 c4[4];
#pragma unroll
    for (int q = 0; q < 4; ++q) c4[q] = *(const f32x4*)(cs + 4 * q);
#pragma unroll
    for (int j = 0; j < 8; ++j) { const float cv = c4[j >> 1][(j & 1) * 2], sv = c4[j >> 1][(j & 1) * 2 + 1]; o1[j] = t1[j] * cv - t2[j] * sv; o2[j] = t2[j] * cv + t1[j] * sv; }
    wa.x = pk2(o1[0], o1[1]); wa.y = pk2(o1[2], o1[3]); wa.z = pk2(o1[4], o1[5]); wa.w = pk2(o1[6], o1[7]);
    wb.x = pk2(o2[0], o2[1]); wb.y = pk2(o2[2], o2[3]); wb.z = pk2(o2[4], o2[5]); wb.w = pk2(o2[6], o2[7]);
}
__device__ __forceinline__ void mx_rope(const Ctx& X) {
    bf16_t* pj = X.proj(); const float* ropet = (const float*)(X.ws + WS_ROPE);
    const int gt = X.c * 512 + X.tid, NGT = X.G * 512;
    for (int i = gt; i < M * 10; i += NGT) {
        const int tok = i / 10, hh = i % 10;
        if (hh == 9) { const u32x4* sp = (const u32x4*)(pj + (size_t)tok * PJ + C_V); u32x4* dp = (u32x4*)((bf16_t*)(X.ws + WS_V2) + (size_t)tok * 64);
#pragma unroll
            for (int q = 0; q < 8; ++q) dp[q] = sp[q];
            continue; }
        const int col = (hh < 4) ? C_Q + hh * 64 : (hh < 8) ? C_QI + (hh - 4) * 64 : C_K;
        bf16_t* p = pj + (size_t)tok * PJ + col;
        const u32x4 a = *(const u32x4*)p, b = *(const u32x4*)(p + 8);
        u32x4 wa, wb; rope8(a, b, ropet + (size_t)tok * 16, wa, wb);
        if (hh < 8) { *(u32x4*)p = wa; *(u32x4*)(p + 8) = wb; }
        else { u32x4* dp = (u32x4*)((bf16_t*)(X.ws + WS_K2) + (size_t)tok * 64); const u32x4* sp = (const u32x4*)p; dp[0] = wa; dp[1] = wb;
#pragma unroll
            for (int q = 2; q < 8; ++q) dp[q] = sp[q]; }
    }
    for (int i = gt; i < (M / 16) * 16; i += NGT) {
        const int hf = i & 1, pc = (i >> 1) & 7, tile = i >> 4; const int ks = pc >> 2, fq = pc & 3;
        u32x4* dp = (u32x4*)((bf16_t*)(X.ws + WS_KI2) + (size_t)tile * 1024 + pc * 128 + hf * 64);
#pragma unroll
        for (int j = 0; j < 8; ++j) { const int tok = tile * 16 + hf * 8 + j; const bf16_t* rp = pj + (size_t)tok * PJ + C_KI;
            u32x4 v = *(const u32x4*)(rp + ks * 32 + fq * 8);
            if (pc < 2) { const u32x4 a = *(const u32x4*)rp, b = *(const u32x4*)(rp + 8); u32x4 wa, wb; rope8(a, b, ropet + (size_t)tok * 16, wa, wb); v = pc ? wb : wa; }
            dp[j] = v; }
    }
}

__device__ __forceinline__ void mx_gmlp(const Ctx& X, int l, int unit) {
    const int lane = X.lane, w = X.wave;
    const int row0 = unit * 128;
    LAS bf16_t* Vt = (LAS bf16_t*)X.lds;
    const bf16_t* pj = X.proj();
    const float* lng = X.in(I_GMLNG) + l * 256; const float* lnb = X.in(I_GMLNB) + l * 256;
    float g4[4], b4[4];
#pragma unroll
    for (int j = 0; j < 4; ++j) { g4[j] = lng[lane + 64 * j]; b4[j] = lnb[lane + 64 * j]; }
    for (int i = 0; i < 16; ++i) {
        const int s = w * 16 + i; const bf16_t* rp = pj + (size_t)(row0 + s) * PJ + C_GV;
        float v[4]; float sm = 0.f;
#pragma unroll
        for (int j = 0; j < 4; ++j) { v[j] = gelu_tanh(bf2f(rp[lane + 64 * j])); sm += v[j]; }
        const float mean = wave_sum(sm) * (1.0f / 256.0f); float q = 0.f;
#pragma unroll
        for (int j = 0; j < 4; ++j) { v[j] -= mean; q += v[j] * v[j]; }
        const float rstd = rsqrtf(wave_sum(q) * (1.0f / 256.0f) + LN_EPS);
#pragma unroll
        for (int j = 0; j < 4; ++j) Vt[(lane + 64 * j) * 136 + s] = (bf16_t)f2bf(v[j] * rstd * g4[j] + b4[j]);
    }
    __syncthreads();
    const int g = w >> 1, c0 = g * 64 + (w & 1) * 32, fr = lane & 15, fq = lane >> 4;
    const bf16_t* gmw = (const bf16_t*)(X.ws + WS_GMW) + (size_t)g * 128 * 128;
    const float* gmb = X.in(I_GMB) + ((size_t)l * 4 + g) * 128;
    bf16_t* ya = X.ybuf();
    for (int tt = 0; tt < 8; ++tt) {
        f32x4 acc0 = (f32x4){0.f, 0.f, 0.f, 0.f}, acc1 = acc0;
        for (int ks = 0; ks <= (tt >> 1); ++ks) {
            const bf16x8 wf = *(const bf16x8*)(gmw + (tt * 16 + fr) * 128 + ks * 32 + 8 * fq);
            const bf16x8 v0 = *(const LAS bf16x8*)(Vt + (c0 + fr) * 136 + ks * 32 + 8 * fq), v1 = *(const LAS bf16x8*)(Vt + (c0 + 16 + fr) * 136 + ks * 32 + 8 * fq);
            acc0 = mfma16(v0, wf, acc0); acc1 = mfma16(v1, wf, acc1);
        }
        const int t = tt * 16 + fr; const float bias = gmb[t];
#pragma unroll
        for (int c2 = 0; c2 < 2; ++c2) { const f32x4 a = c2 ? acc1 : acc0; const int cc = c0 + c2 * 16 + 4 * fq;
            const u32x2 uv = *(const u32x2*)(pj + (size_t)(row0 + t) * PJ + C_GU + cc);
            u32x2 o; o.x = pk2(gelu_tanh(bflo(uv.x)) * (a[0] + bias), gelu_tanh(bfhi(uv.x)) * (a[1] + bias)); o.y = pk2(gelu_tanh(bflo(uv.y)) * (a[2] + bias), gelu_tanh(bfhi(uv.y)) * (a[3] + bias));
            *(u32x2*)(ya + (size_t)(row0 + t) * 256 + cc) = o; }
    }
    __syncthreads();
}

template <int PASS>
__device__ __forceinline__ void mx_s5(const Ctx& X, int l, int wu) {
    const int lane = X.lane, fr = lane & 15, fq = lane >> 4;
    const int wgi = wu >> 3, wv = wu & 7; const int b = wgi >> 6, g = ((wgi >> 4) & 3) * 4 + (wv & 3), ch = (wgi & 15) * 2 + (wv >> 2);
    const int tb = b * SEQ + ch * 256;
    LAS float* xl = (LAS float*)(X.lds + X.wave * 16384);
    LAS bf16_t* hb = (LAS bf16_t*)(X.lds + X.wave * 16384 + 8192);
    const bf16_t* pj = X.proj();
    const bf16_t* bbT = (const bf16_t*)(X.ws + WS_S5B) + (size_t)g * 128 * 16;
    bf16x8 Bf[8];
#pragma unroll
    for (int ct = 0; ct < 8; ++ct) { Bf[ct] = (bf16x8){0, 0, 0, 0, 0, 0, 0, 0}; if (fq < 2) Bf[ct] = *(const bf16x8*)(bbT + (ct * 16 + fr) * 16 + 8 * fq); }
    const float* sa = (const float*)(X.ws + WS_S5A) + (g * 64 + lane) * 2; const float ar = sa[0], ai = sa[1];
    float hr = 0.f, hi = 0.f;
    float* st = (float*)(X.ws + WS_S5ST) + (size_t)((b * 16 + g) * 32) * 128;
    bf16x8 Cf[4]; float dsk[4];
    if (PASS == 3) {
        { const float* hin = (const float*)(X.ws + WS_S5HIN) + (size_t)((b * 16 + g) * 32 + ch) * 128; hr = hin[lane]; hi = hin[64 + lane]; }
        const bf16_t* cm = (const bf16_t*)(X.ws + WS_S5C) + (size_t)g * 16 * 128;
#pragma unroll
        for (int ks = 0; ks < 4; ++ks) Cf[ks] = *(const bf16x8*)(cm + fr * 128 + ks * 32 + 8 * fq);
#pragma unroll
        for (int i = 0; i < 4; ++i) dsk[i] = X.in(I_S5D)[l * 256 + g * 16 + 4 * fq + i];
    }
    bf16_t* ycp = (bf16_t*)(X.ws + WS_YCPRE);
    for (int blk = 0; blk < 16; ++blk) {
        const int t0 = tb + blk * 16;
        bf16x8 uf = (bf16x8){0, 0, 0, 0, 0, 0, 0, 0};
        if (fq < 2) uf = *(const bf16x8*)(pj + (size_t)(t0 + fr) * PJ + C_S5 + g * 16 + 8 * fq);
#pragma unroll
        for (int ct = 0; ct < 8; ++ct) { const f32x4 a = mfma16(uf, Bf[ct], (f32x4){0.f, 0.f, 0.f, 0.f});
#pragma unroll
            for (int i = 0; i < 4; ++i) xl[(4 * fq + i) * 128 + ct * 16 + fr] = a[i]; }
#pragma unroll
        for (int t = 0; t < 16; ++t) { const float xr = xl[t * 128 + lane], xi = xl[t * 128 + 64 + lane];
            const float nr = ar * hr - ai * hi + xr, ni = ar * hi + ai * hr + xi; hr = nr; hi = ni;
            if (PASS == 3) { hb[t * 136 + lane] = (bf16_t)f2bf(hr); hb[t * 136 + 64 + lane] = (bf16_t)f2bf(hi); } }
        if (PASS == 3) {
            asm volatile("s_waitcnt lgkmcnt(0)" ::: "memory"); __builtin_amdgcn_wave_barrier();
            f32x4 acc = (f32x4){0.f, 0.f, 0.f, 0.f};
#pragma unroll
            for (int ks = 0; ks < 4; ++ks) { const bf16x8 hf = *(const LAS bf16x8*)(hb + fr * 136 + ks * 32 + 8 * fq); acc = mfma16(Cf[ks], hf, acc); }
            const u32x2 uv = *(const u32x2*)(pj + (size_t)(t0 + fr) * PJ + C_S5 + g * 16 + 4 * fq);
            const float y0 = gelu_tanh(acc[0] + dsk[0] * bflo(uv.x)), y1 = gelu_tanh(acc[1] + dsk[1] * bfhi(uv.x)), y2 = gelu_tanh(acc[2] + dsk[2] * bflo(uv.y)), y3 = gelu_tanh(acc[3] + dsk[3] * bfhi(uv.y));
            u32x2 o; o.x = pk2(y0, y1); o.y = pk2(y2, y3);
            *(u32x2*)(ycp + (size_t)(t0 + fr) * 256 + g * 16 + 4 * fq) = o;
        }
    }
    if (PASS == 1) { st[ch * 128 + lane] = hr; st[ch * 128 + 64 + lane] = hi; }
}

constexpr int SD_CM = 0, SD_BM = 18432, SD_BT = 36864, SD_XT0 = 54272, SD_XT1 = 71680, SD_MM = 89088, SD_SIN0 = 123904, SD_SIN1 = 133120, SD_DT = 142336, SD_AC = 143360 + 64, SD_END = 144384 + 64;
static_assert(SD_END <= LDS_MISC, "ssd lds");
template <int PASS>
__device__ __forceinline__ void mx_ssd(const Ctx& X, int l, int unit) {
    const int tid = X.tid, lane = X.lane, w = X.wave, fr = lane & 15, fq = lane >> 4;
    const int b = unit >> 6, c = unit & 63; const int r0 = unit * 128;
    const bf16_t* pj = X.proj();
    LAS bf16_t* Cm = (LAS bf16_t*)(X.lds + SD_CM); LAS bf16_t* Bm = (LAS bf16_t*)(X.lds + SD_BM); LAS bf16_t* Bt = (LAS bf16_t*)(X.lds + SD_BT);
    LAS bf16_t* Mm = (LAS bf16_t*)(X.lds + SD_MM);
    LAS float* dtv = (LAS float*)(X.lds + SD_DT); LAS float* acm = (LAS float*)(X.lds + SD_AC);
    const float* convw = X.in(I_CONVW) + (size_t)l * 4 * 512; const float* convb = X.in(I_CONVB) + (size_t)l * 512;
    float* sst = (float*)(X.ws + WS_SSDST); float* atot = (float*)(X.ws + WS_ATOT);
    for (int g = 0; g < 2; ++g) {
        if (tid < 256) { const int j = tid >> 7, rl = tid & 127, h = 2 * g + j;
            const float raw = bf2f(pj[(size_t)(r0 + rl) * PJ + C_DT + h]) + X.in(I_DTBIAS)[l * 4 + h];
            const float dt = softplusf_(raw); dtv[j * 128 + rl] = dt; acm[j * 128 + rl] = -expf(X.in(I_ALOG)[l * 4 + h]) * dt; }
        __syncthreads();
        if (tid < 256) {
            float cum = acm[tid];
#pragma unroll
            for (int o = 1; o < 64; o <<= 1) { const float up = __shfl_up(cum, o); if (lane >= o) cum += up; }
            if (lane == 63) dtv[256 + w] = cum;
            __builtin_amdgcn_fence(__ATOMIC_RELEASE, "workgroup");
            acm[tid] = cum; }
        __syncthreads();
        if (tid < 256 && (w & 1)) acm[tid] += dtv[256 + w - 1];
        __syncthreads();
        if (PASS == 1 && tid < 2) atot[(b * 64 + c) * 32 + 2 * g + tid] = acm[tid * 128 + 127];
        constexpr int NCG = (PASS == 1) ? 24 : 32;
        for (int it = tid; it < NCG * 128; it += 512) {
            const int rl = it & 127, cg = it >> 7;
            const int chn = (cg < 16) ? g * 128 + cg * 8 : (cg < 24) ? 256 + g * 64 + (cg - 16) * 8 : 384 + g * 64 + (cg - 24) * 8;
            float a8[8];
            { const f32x4 c0 = *(const f32x4*)(convb + chn), c1 = *(const f32x4*)(convb + chn + 4); a8[0] = c0[0]; a8[1] = c0[1]; a8[2] = c0[2]; a8[3] = c0[3]; a8[4] = c1[0]; a8[5] = c1[1]; a8[6] = c1[2]; a8[7] = c1[3]; }
#pragma unroll
            for (int k = 0; k < 4; ++k) { const int sq = c * 128 + rl - 3 + k;
                if (sq >= 0) { const u32x4 xv = *(const u32x4*)(pj + (size_t)(b * SEQ + sq) * PJ + C_XBC + chn);
                    const f32x4 w0 = *(const f32x4*)(convw + k * 512 + chn), w1 = *(const f32x4*)(convw + k * 512 + chn + 4);
                    a8[0] += w0[0] * bflo(xv.x); a8[1] += w0[1] * bfhi(xv.x); a8[2] += w0[2] * bflo(xv.y); a8[3] += w0[3] * bfhi(xv.y);
                    a8[4] += w1[0] * bflo(xv.z); a8[5] += w1[1] * bfhi(xv.z); a8[6] += w1[2] * bflo(xv.w); a8[7] += w1[3] * bfhi(xv.w); } }
#pragma unroll
            for (int q = 0; q < 8; ++q) a8[q] = siluf_(a8[q]);
            if (cg < 16) { const int j = cg >> 3, p0 = (cg & 7) * 8; LAS bf16_t* Xt = (LAS bf16_t*)(X.lds + (j ? SD_XT1 : SD_XT0));
                float sc = 1.0f; if (PASS == 1) sc = __expf(acm[j * 128 + 127] - acm[j * 128 + rl]) * dtv[j * 128 + rl];
#pragma unroll
                for (int q = 0; q < 8; ++q) Xt[(p0 + q) * 136 + rl] = (bf16_t)f2bf(a8[q] * sc); }
            else if (cg < 24) { const int n0 = (cg - 16) * 8;
                if (PASS == 1) {
#pragma unroll
                    for (int q = 0; q < 8; ++q) Bt[(n0 + q) * 136 + rl] = (bf16_t)f2bf(a8[q]); }
                else { u32x4 o; o.x = pk2(a8[0], a8[1]); o.y = pk2(a8[2], a8[3]); o.z = pk2(a8[4], a8[5]); o.w = pk2(a8[6], a8[7]); *(LAS u32x4*)(Bm + rl * 72 + n0) = o; } }
            else { const int n0 = (cg - 24) * 8; u32x4 o; o.x = pk2(a8[0], a8[1]); o.y = pk2(a8[2], a8[3]); o.z = pk2(a8[4], a8[5]); o.w = pk2(a8[6], a8[7]); *(LAS u32x4*)(Cm + rl * 72 + n0) = o; }
        }
        if (PASS == 3) {
            const bf16_t* sin = (const bf16_t*)(X.ws + WS_SSDSIN) + (size_t)((b * 64 + c) * 4 + 2 * g) * 4096 + tid * 8;
            const int p = tid >> 3, n0 = (tid & 7) * 8;
            *(LAS u32x4*)((LAS bf16_t*)(X.lds + SD_SIN0) + p * 72 + n0) = *(const u32x4*)sin;
            *(LAS u32x4*)((LAS bf16_t*)(X.lds + SD_SIN1) + p * 72 + n0) = *(const u32x4*)(sin + 4096);
        }
        __syncthreads();
        if (PASS == 1) {
            const int j = w >> 2, pt = w & 3; const LAS bf16_t* Xt = (const LAS bf16_t*)(X.lds + (j ? SD_XT1 : SD_XT0));
            f32x4 acc[4];
#pragma unroll
            for (int nt = 0; nt < 4; ++nt) acc[nt] = (f32x4){0.f, 0.f, 0.f, 0.f};
#pragma unroll
            for (int ks = 0; ks < 4; ++ks) { const bf16x8 xf = *(const LAS bf16x8*)(Xt + (pt * 16 + fr) * 136 + ks * 32 + 8 * fq);
#pragma unroll
                for (int nt = 0; nt < 4; ++nt) { const bf16x8 bf = *(const LAS bf16x8*)(Bt + (nt * 16 + fr) * 136 + ks * 32 + 8 * fq); acc[nt] = mfma16(xf, bf, acc[nt]); } }
            float* sp = sst + (size_t)((b * 64 + c) * 4 + 2 * g + j) * 4096;
#pragma unroll
            for (int nt = 0; nt < 4; ++nt)
#pragma unroll
                for (int i = 0; i < 4; ++i) sp[(pt * 16 + 4 * fq + i) * 64 + nt * 16 + fr] = acc[nt][i];
        } else {
            const int lrow = w * 16 + fr;
            float yv[2][4][4];
#pragma unroll
            for (int j = 0; j < 2; ++j) {
                const LAS bf16_t* Xt = (const LAS bf16_t*)(X.lds + (j ? SD_XT1 : SD_XT0)); const LAS bf16_t* Sin = (const LAS bf16_t*)(X.lds + (j ? SD_SIN1 : SD_SIN0));
                const float al = acm[j * 128 + lrow];
                const bf16x8 cf0 = *(const LAS bf16x8*)(Cm + lrow * 72 + 8 * fq), cf1 = *(const LAS bf16x8*)(Cm + lrow * 72 + 32 + 8 * fq);
                const int stmax = w | 1;
                for (int st = 0; st <= stmax; ++st) {
                    f32x4 ag = (f32x4){0.f, 0.f, 0.f, 0.f};
                    if (st <= w) { const bf16x8 b0 = *(const LAS bf16x8*)(Bm + (st * 16 + fr) * 72 + 8 * fq), b1 = *(const LAS bf16x8*)(Bm + (st * 16 + fr) * 72 + 32 + 8 * fq);
                        ag = mfma16(b0, cf0, ag); ag = mfma16(b1, cf1, ag); }
                    float mv[4];
#pragma unroll
                    for (int i = 0; i < 4; ++i) { const int s = st * 16 + 4 * fq + i; mv[i] = (s <= lrow) ? ag[i] * __expf(al - acm[j * 128 + s]) * dtv[j * 128 + s] : 0.f; }
                    u32x2 o; o.x = pk2(mv[0], mv[1]); o.y = pk2(mv[2], mv[3]); *(LAS u32x2*)(Mm + lrow * 136 + st * 16 + 4 * fq) = o;
                }
                const float eal = __expf(al); const float dsk = X.in(I_SSDD)[l * 4 + 2 * g + j];
#pragma unroll
                for (int pt = 0; pt < 4; ++pt) {
                    f32x4 ad = (f32x4){0.f, 0.f, 0.f, 0.f}, ao = ad;
                    for (int ks = 0; ks <= (w >> 1); ++ks) { const bf16x8 xf = *(const LAS bf16x8*)(Xt + (pt * 16 + fr) * 136 + ks * 32 + 8 * fq), mf = *(const LAS bf16x8*)(Mm + lrow * 136 + ks * 32 + 8 * fq); ad = mfma16(xf, mf, ad); }
                    { const bf16x8 s0 = *(const LAS bf16x8*)(Sin + (pt * 16 + fr) * 72 + 8 * fq), s1 = *(const LAS bf16x8*)(Sin + (pt * 16 + fr) * 72 + 32 + 8 * fq); ao = mfma16(s0, cf0, ao); ao = mfma16(s1, cf1, ao); }
                    const int h = 2 * g + j; const u32x2 zv = *(const u32x2*)(pj + (size_t)(r0 + lrow) * PJ + C_Z + h * 64 + pt * 16 + 4 * fq);
                    const float z4[4] = {bflo(zv.x), bfhi(zv.x), bflo(zv.y), bfhi(zv.y)};
#pragma unroll
                    for (int i = 0; i < 4; ++i) { const float xs = bf2f(Xt[(pt * 16 + 4 * fq + i) * 136 + lrow]); yv[j][pt][i] = (ad[i] + eal * ao[i] + dsk * xs) * siluf_(z4[i]); }
                }
            }
            float ss = 0.f;
#pragma unroll
            for (int j = 0; j < 2; ++j)
#pragma unroll
                for (int pt = 0; pt < 4; ++pt)
#pragma unroll
                    for (int i = 0; i < 4; ++i) ss += yv[j][pt][i] * yv[j][pt][i];
            ss += __shfl_xor(ss, 16); ss += __shfl_xor(ss, 32);
            const float rs = rsqrtf(ss * (1.0f / 128.0f) + RMS_EPS);
            const float* ng = X.in(I_SSDNG) + l * 256 + g * 128; bf16_t* yd = X.ybuf() + (size_t)3 * M * 256;
#pragma unroll
            for (int j = 0; j < 2; ++j)
#pragma unroll
                for (int pt = 0; pt < 4; ++pt) { const int cc = j * 64 + pt * 16 + 4 * fq; const f32x4 gv = *(const f32x4*)(ng + cc);
                    u32x2 o; o.x = pk2(yv[j][pt][0] * rs * gv[0], yv[j][pt][1] * rs * gv[1]); o.y = pk2(yv[j][pt][2] * rs * gv[2], yv[j][pt][3] * rs * gv[3]);
                    *(u32x2*)(yd + (size_t)(r0 + lrow) * 256 + g * 128 + cc) = o; }
        }
        __syncthreads();
    }
}

__device__ __forceinline__ void mx_s5_carry(const Ctx& X) {
    const float* st = (const float*)(X.ws + WS_S5ST); float* hin = (float*)(X.ws + WS_S5HIN); const float* sa = (const float*)(X.ws + WS_S5A);
    for (int i = X.c * 32 + (X.tid - 256); X.tid >= 256 && X.tid < 288 && i < NB * 16 * 64; i += X.G * 32) {
        const int p = i & 63, g = (i >> 6) & 15, b = i >> 10;
        float pr = sa[(g * 64 + p) * 2], pi = sa[(g * 64 + p) * 2 + 1];
#pragma unroll
        for (int q = 0; q < 8; ++q) { const float nr = pr * pr - pi * pi, ni = 2.f * pr * pi; pr = nr; pi = ni; }
        float hr = 0.f, hi = 0.f; const size_t base = (size_t)((b * 16 + g) * 32) * 128 + p;
#pragma unroll 8
        for (int ch = 0; ch < 32; ++ch) { hin[base + ch * 128] = hr; hin[base + ch * 128 + 64] = hi;
            const float sr = st[base + ch * 128], si = st[base + ch * 128 + 64]; const float nr = pr * hr - pi * hi + sr, ni = pr * hi + pi * hr + si; hr = nr; hi = ni; }
    }
}

__device__ __forceinline__ void mx_ssd_carry(const Ctx& X) {
    const float* sst = (const float*)(X.ws + WS_SSDST); const float* atot = (const float*)(X.ws + WS_ATOT); bf16_t* sin = (bf16_t*)(X.ws + WS_SSDSIN);
    for (int i = X.c * 256 + X.tid; X.tid < 256 && i < NB * 4 * 4096; i += X.G * 256) {
        const int e1 = i & 4095, h = (i >> 12) & 3, b = i >> 14;
        float S = 0.f;
#pragma unroll 16
        for (int c = 0; c < 64; ++c) { const size_t o = (size_t)((b * 64 + c) * 4 + h) * 4096 + e1;
            sin[o] = (bf16_t)f2bf(S);
            S = S * __expf(atot[(b * 64 + c) * 32 + h]) + sst[o]; }
    }
}

__device__ __forceinline__ unsigned ord16(float s) { const _Float16 hf = (_Float16)s; const unsigned bits = (unsigned)__builtin_bit_cast(unsigned short, hf); return bits ^ ((bits & 0x8000u) ? 0xFFFFu : 0x8000u); }
__device__ __forceinline__ int cnt_ge8(const u32x4 v, unsigned c) {
    int n = 0;
    n += ((v.x & 0xFFFFu) >= c) + ((v.x >> 16) >= c); n += ((v.y & 0xFFFFu) >= c) + ((v.y >> 16) >= c);
    n += ((v.z & 0xFFFFu) >= c) + ((v.z >> 16) >= c); n += ((v.w & 0xFFFFu) >= c) + ((v.w >> 16) >= c);
    return n;
}
template <int CTRL> __device__ __forceinline__ float dpp_f(float v) { return __builtin_bit_cast(float, __builtin_amdgcn_update_dpp(0, __builtin_bit_cast(int, v), CTRL, 0xF, 0xF, true)); }
__device__ __forceinline__ void mx_dsa(const Ctx& X, int b, int t0) {
    const int tid = X.tid, lane = X.lane, w = X.wave, fr = lane & 15, fq = lane >> 4;
    const bf16_t* pj = X.proj() + (size_t)b * SEQ * PJ; const unsigned rb = 0u;
    const bf16_t* ki2 = (const bf16_t*)(X.ws + WS_KI2) + (size_t)b * SEQ * 64; const bf16_t* k2 = (const bf16_t*)(X.ws + WS_K2) + (size_t)b * SEQ * 64; const bf16_t* v2 = (const bf16_t*)(X.ws + WS_V2) + (size_t)b * SEQ * 64;
    LAS unsigned short* sc = (LAS unsigned short*)X.lds;
    const int nk = t0 + 8, nkt = (nk + 15) >> 4;
    LAS unsigned* hist = (LAS unsigned*)(X.lds + 131072 + 8192);
    for (int i = tid; i < 8 * 4 * 128 / 4; i += 512) *(LAS u32x4*)(hist + 4 * i) = (u32x4){0u, 0u, 0u, 0u};
    bf16x8 qf[2][2]; f32x4 wq[2];
#pragma unroll
    for (int ct = 0; ct < 2; ++ct) { const int q = 4 * ct + (fr >> 2), hh = fr & 3; const bf16_t* qp = pj + (unsigned)(t0 + q) * (unsigned)PJ;
        qf[ct][0] = *(const bf16x8*)(qp + C_QI + hh * 64 + 8 * fq); qf[ct][1] = *(const bf16x8*)(qp + C_QI + hh * 64 + 32 + 8 * fq);
        const u32x2 wv = *(const u32x2*)(pj + (unsigned)(t0 + 4 * ct + fq) * (unsigned)PJ + C_WI);
        wq[ct] = (f32x4){bflo(wv.x) * 0.0625f, bfhi(wv.x) * 0.0625f, bflo(wv.y) * 0.0625f, bfhi(wv.y) * 0.0625f}; }
    const int ntw = (nkt > w) ? ((nkt - w + 7) >> 3) : 0;
    __syncthreads();
#define DSA_LOAD4(KF, I0) do { _Pragma("unroll") for (int j = 0; j < 4; ++j) { int kt_ = w + 8 * ((I0) + j); kt_ = kt_ < nkt ? kt_ : nkt - 1; \
        const unsigned ko_ = (unsigned)kt_ * 1024u + (unsigned)lane * 8u; KF[j][0] = *(const bf16x8*)(ki2 + ko_); KF[j][1] = *(const bf16x8*)(ki2 + ko_ + 512u); } } while (0)
#define DSA_COMP4(KF, I0) do { if (DSA_PM == 2 && rs1 > 0) { _Pragma("unroll") for (int j = 0; j < 4; ++j) dummy_ ^= KF[j][0][0] ^ KF[j][1][3]; break; } \
      _Pragma("unroll") for (int jh = 0; jh < 4; jh += 2) { f32x4 ac_[2][2]; \
        _Pragma("unroll") for (int j = 0; j < 2; ++j) _Pragma("unroll") for (int ct = 0; ct < 2; ++ct) { \
            ac_[j][ct] = mfma16(qf[ct][0], KF[jh + j][0], (f32x4){0.f, 0.f, 0.f, 0.f}); ac_[j][ct] = mfma16(qf[ct][1], KF[jh + j][1], ac_[j][ct]); } \
        _Pragma("unroll") for (int j = 0; j < 2; ++j) { if ((I0) + jh + j < ntw) { const int kt_ = w + 8 * ((I0) + jh + j); const bool full_ = (kt_ * 16 + 15 <= t0); const int key_ = kt_ * 16 + fr; \
        _Pragma("unroll") for (int ct = 0; ct < 2; ++ct) { const f32x4 a_ = ac_[j][ct]; \
            float tt_ = __builtin_fmaf(__builtin_amdgcn_fmed3f(a_[0], 0.f, 3.0e38f), wq[ct][0], 0.0f); tt_ = __builtin_fmaf(__builtin_amdgcn_fmed3f(a_[1], 0.f, 3.0e38f), wq[ct][1], tt_); \
            tt_ = __builtin_fmaf(__builtin_amdgcn_fmed3f(a_[2], 0.f, 3.0e38f), wq[ct][2], tt_); tt_ = __builtin_fmaf(__builtin_amdgcn_fmed3f(a_[3], 0.f, 3.0e38f), wq[ct][3], tt_); \
            const int q_ = 4 * ct + fq; unsigned kk_ = ord16(tt_ + 0.0f); \
            if (!full_) kk_ = (key_ <= t0 + q_) ? kk_ : 0u; \
            if (DSA_PM == 1 && rs1 > 0) dummy_ ^= (short)kk_; else sc[q_ * 8192 + key_] = (unsigned short)kk_; \
            if ((R_S1 == 1 || rs1 == 0) && (full_ || kk_ != 0u)) __hip_atomic_fetch_add(hist + (q_ * 4 + (fr & 3)) * 128 + (kk_ >> 9), (kk_ & 0x100u) ? 65536u : 1u, __ATOMIC_RELAXED, __HIP_MEMORY_SCOPE_WORKGROUP); } } } } } while (0)
    short dummy_ = 0;
    _Pragma("nounroll") for (int rs1 = 0; rs1 < (((DSA_SKIP | X.dbg) & 1) ? 0 : R_S1); ++rs1)
    { bf16x8 ka[4][2], kb[4][2];
      if (ntw > 0) { DSA_LOAD4(ka, 0);
#pragma nounroll
        for (int i0 = 0; i0 < ntw; i0 += 8) { DSA_LOAD4(kb, i0 + 4); DSA_COMP4(ka, i0); DSA_LOAD4(ka, i0 + 8); DSA_COMP4(kb, i0 + 4); } } }
#undef DSA_LOAD4
#undef DSA_COMP4
    if (dummy_ == (short)0x1234 && t0 == 123457) sc[0] = 1;
    { const int z0 = nkt * 16, z1 = ((nk + 511) >> 9) << 9;
        for (int i = z0 + tid; i < z1; i += 512) {
#pragma unroll
            for (int q = 0; q < 8; ++q) sc[q * 8192 + i] = 0; } }
    __syncthreads();
    const int t = t0 + w, nv = t + 1;
    LAS unsigned short* row = sc + w * 8192;
    LAS unsigned short* list = (LAS unsigned short*)(X.lds + 131072 + w * 512);
    const int nsel = nv < 256 ? nv : 256;
    if (((DSA_SKIP | X.dbg) & 2) || nv <= 256) { for (int n = lane; n < 256; n += 64) list[n] = (unsigned short)n; }
    else {
        const int nit = (nv + 511) >> 9;
        LAS unsigned* H = hist + w * 512;
        int T1, above1;
        { u32x4 h4 = (u32x4){0u, 0u, 0u, 0u};
#pragma unroll
          for (int c4 = 0; c4 < 4; ++c4) { const u32x2 pw = *(const LAS u32x2*)(H + c4 * 128 + 2 * lane); h4.x += pw.x & 0xFFFFu; h4.y += pw.x >> 16; h4.z += pw.y & 0xFFFFu; h4.w += pw.y >> 16; }
          const int sl = (int)(h4.x + h4.y + h4.z + h4.w);
          int suf = sl;
#pragma unroll
          for (int o = 1; o < 64; o <<= 1) { const int dn = __shfl_down(suf, o); if (lane + o < 64) suf += dn; }
          const unsigned long long bm = __ballot(suf >= 256); const int L = 63 - __builtin_clzll(bm);
          const int hx = __shfl((int)h4.x, L), hy = __shfl((int)h4.y, L), hz = __shfl((int)h4.z, L), hw = __shfl((int)h4.w, L);
          const int sufn = __shfl(suf, L) - (hx + hy + hz + hw);
          int cb = sufn; T1 = 4 * L + 3; above1 = cb;
          if (cb + hw >= 256) { T1 = 4 * L + 3; above1 = cb; } else { cb += hw; if (cb + hz >= 256) { T1 = 4 * L + 2; above1 = cb; } else { cb += hz; if (cb + hy >= 256) { T1 = 4 * L + 1; above1 = cb; } else { cb += hy; T1 = 4 * L; above1 = cb; } } } }
        _Pragma("nounroll") for (int rs2 = 0; rs2 < R_S2; ++rs2) {
        *(LAS u32x4*)(H + 4 * lane) = (u32x4){0u, 0u, 0u, 0u};
        for (int it = 0; it < nit; ++it) { const u32x4 v = *(const LAS u32x4*)(row + (it * 64 + lane) * 8);
            const unsigned e[8] = {v.x & 0xFFFFu, v.x >> 16, v.y & 0xFFFFu, v.y >> 16, v.z & 0xFFFFu, v.z >> 16, v.w & 0xFFFFu, v.w >> 16};
#pragma unroll
            for (int j = 0; j < 8; ++j) if ((int)(e[j] >> 8) == T1) __hip_atomic_fetch_add(H + (e[j] & 255u), 1u, __ATOMIC_RELAXED, __HIP_MEMORY_SCOPE_WORKGROUP); }
        unsigned thr; int cgt, cge;
        { const u32x4 h4 = *(const LAS u32x4*)(H + 4 * lane); const int sl = (int)(h4.x + h4.y + h4.z + h4.w);
          int suf = sl;
#pragma unroll
          for (int o = 1; o < 64; o <<= 1) { const int dn = __shfl_down(suf, o); if (lane + o < 64) suf += dn; }
          const int need = 256 - above1;
          const unsigned long long bm = __ballot(suf >= need); const int L = 63 - __builtin_clzll(bm);
          const int hx = __shfl((int)h4.x, L), hy = __shfl((int)h4.y, L), hz = __shfl((int)h4.z, L), hw = __shfl((int)h4.w, L);
          int cb = __shfl(suf, L) - (hx + hy + hz + hw); int T2, hT;
          if (cb + hw >= need) { T2 = 4 * L + 3; hT = hw; } else { cb += hw; if (cb + hz >= need) { T2 = 4 * L + 2; hT = hz; } else { cb += hz; if (cb + hy >= need) { T2 = 4 * L + 1; hT = hy; } else { cb += hy; T2 = 4 * L; hT = hx; } } }
          thr = ((unsigned)T1 << 8) | (unsigned)T2; cgt = above1 + cb; cge = cgt + hT; }
        const bool exact = (cge == 256);
        const int r = 256 - cgt;
        const unsigned cmin = exact ? thr : thr + 1u;
        const unsigned long long lt_mask = (1ull << lane) - 1ull; int bcnt = 0;
        for (int it = 0; it < nit; ++it) { const u32x4 v = *(const LAS u32x4*)(row + (it * 64 + lane) * 8); const int base = (it * 64 + lane) * 8;
            const unsigned e[8] = {v.x & 0xFFFFu, v.x >> 16, v.y & 0xFFFFu, v.y >> 16, v.z & 0xFFFFu, v.z >> 16, v.w & 0xFFFFu, v.w >> 16};
#pragma unroll
            for (int j = 0; j < 8; ++j) { const bool sl = e[j] >= cmin; const unsigned long long bm = __ballot(sl);
                if (bm != 0ull) { if (sl) list[(bcnt + __popcll(bm & lt_mask)) & 255] = (unsigned short)(base + j); bcnt += __popcll(bm); } } }
        if (!exact) {
            int taken = 0;
            for (int it = 0; it < nit && taken < r; ++it) { const u32x4 v = *(const LAS u32x4*)(row + (it * 64 + lane) * 8); const int base = (it * 64 + lane) * 8;
                const unsigned e[8] = {v.x & 0xFFFFu, v.x >> 16, v.y & 0xFFFFu, v.y >> 16, v.z & 0xFFFFu, v.z >> 16, v.w & 0xFFFFu, v.w >> 16};
                int mcount = 0;
#pragma unroll
                for (int j = 0; j < 8; ++j) mcount += (e[j] == thr);
                if (__ballot(mcount != 0) == 0ull) continue;
                int incl = mcount;
#pragma unroll
                for (int o = 1; o < 64; o <<= 1) { const int up = __shfl_up(incl, o); if (lane >= o) incl += up; }
                const int total = __shfl(incl, 63); int rk = taken + incl - mcount;
#pragma unroll
                for (int j = 0; j < 8; ++j) if (e[j] == thr) { if (rk < r) list[(cgt + rk) & 255] = (unsigned short)(base + j); ++rk; }
                taken += total; }
        }
        }
    }
    __builtin_amdgcn_fence(__ATOMIC_RELEASE, "workgroup"); __builtin_amdgcn_wave_barrier();
    const bf16_t* qrow = pj + (unsigned)t * (unsigned)PJ;
    bf16x8 qb0 = (bf16x8){0, 0, 0, 0, 0, 0, 0, 0}, qb1 = qb0;
    if (fr < 4) { qb0 = *(const bf16x8*)(qrow + C_Q + fr * 64 + 8 * fq); qb1 = *(const bf16x8*)(qrow + C_Q + fr * 64 + 32 + 8 * fq); }
    LAS float* Pb = (LAS float*)row;
    LAS float* pinv = (LAS float*)(X.lds + 131072 + 4096 + 256 + w * 16);
    _Pragma("nounroll") for (int rs3 = 0; rs3 < (((DSA_SKIP | X.dbg) & 4) ? 0 : R_S3); ++rs3) {
    { LAS unsigned char* kbuf = (LAS unsigned char*)row + 4096;
      const int drow = lane >> 3, dchk = (lane & 7) ^ (drow & 7);
#define QK_DMA(G) do { _Pragma("unroll") for (int i_ = 0; i_ < 4; ++i_) { const unsigned ko_ = (unsigned)list[(G) * 32 + i_ * 8 + drow] * 64u + (unsigned)(dchk * 8); \
        __builtin_amdgcn_global_load_lds((const unsigned*)(k2 + ko_), (LAS unsigned*)(kbuf + ((G) % 3) * 4096 + i_ * 1024), 16, 0, 0); } } while (0)
#define QK_COMP(G) do { _Pragma("unroll") for (int j = 0; j < 2; ++j) { const LAS unsigned char* tb_ = kbuf + ((G) % 3) * 4096 + j * 2048 + fr * 128; \
        const bf16x8 k0_ = *(const LAS bf16x8*)(tb_ + ((fq ^ (fr & 7)) * 16)), k1_ = *(const LAS bf16x8*)(tb_ + (((4 + fq) ^ (fr & 7)) * 16)); \
        f32x4 a_ = mfma16(k0_, qb0, (f32x4){0.f, 0.f, 0.f, 0.f}); a_ = mfma16(k1_, qb1, a_); \
        if (fr < 4) { _Pragma("unroll") for (int i = 0; i < 4; ++i) { const int nn_ = ((G) * 2 + j) * 16 + 4 * fq + i; Pb[nn_ * 4 + fr] = (nn_ < nsel) ? a_[i] * 0.125f : -3.0e38f; } } } } while (0)
      asm volatile("s_waitcnt vmcnt(0)" ::: "memory");
      QK_DMA(0); QK_DMA(1);
      asm volatile("s_waitcnt vmcnt(4)" ::: "memory"); QK_COMP(0); QK_DMA(2);
      asm volatile("s_waitcnt vmcnt(4)" ::: "memory"); QK_COMP(1); asm volatile("s_waitcnt lgkmcnt(0)" ::: "memory"); QK_DMA(3);
      asm volatile("s_waitcnt vmcnt(4)" ::: "memory"); QK_COMP(2); asm volatile("s_waitcnt lgkmcnt(0)" ::: "memory"); QK_DMA(4);
      asm volatile("s_waitcnt vmcnt(4)" ::: "memory"); QK_COMP(3); asm volatile("s_waitcnt lgkmcnt(0)" ::: "memory"); QK_DMA(5);
      asm volatile("s_waitcnt vmcnt(4)" ::: "memory"); QK_COMP(4); asm volatile("s_waitcnt lgkmcnt(0)" ::: "memory"); QK_DMA(6);
      asm volatile("s_waitcnt vmcnt(4)" ::: "memory"); QK_COMP(5); asm volatile("s_waitcnt lgkmcnt(0)" ::: "memory"); QK_DMA(7);
      asm volatile("s_waitcnt vmcnt(4)" ::: "memory"); QK_COMP(6);
      asm volatile("s_waitcnt vmcnt(0)" ::: "memory"); QK_COMP(7);
#undef QK_DMA
#undef QK_COMP
    }
    __builtin_amdgcn_fence(__ATOMIC_RELEASE, "workgroup"); __builtin_amdgcn_wave_barrier();
    { const int hd = lane & 3, nb0 = lane >> 2;
        float v16[16]; float mx = -3.0e38f;
#pragma unroll
        for (int j = 0; j < 16; ++j) { v16[j] = Pb[(nb0 + 16 * j) * 4 + hd]; mx = fmaxf(mx, v16[j]); }
        mx = fmaxf(mx, __shfl_xor(mx, 4)); mx = fmaxf(mx, __shfl_xor(mx, 8)); mx = fmaxf(mx, __shfl_xor(mx, 16)); mx = fmaxf(mx, __shfl_xor(mx, 32));
        float sm = 0.f;
#pragma unroll
        for (int j = 0; j < 16; ++j) { const float p = (v16[j] > -1.0e38f) ? __expf(v16[j] - mx) : 0.f; sm += p; Pb[(nb0 + 16 * j) * 4 + hd] = p; }
        sm += __shfl_xor(sm, 4); sm += __shfl_xor(sm, 8); sm += __shfl_xor(sm, 16); sm += __shfl_xor(sm, 32);
        if (lane < 4) pinv[lane] = 1.0f / sm; }
    __builtin_amdgcn_fence(__ATOMIC_RELEASE, "workgroup"); __builtin_amdgcn_wave_barrier();
    f32x2 o2[4][2];
#pragma unroll
    for (int h = 0; h < 4; ++h) { o2[h][0] = (f32x2){0.f, 0.f}; o2[h][1] = (f32x2){0.f, 0.f}; }
    const int d4 = fr * 4;
#define PV_LOAD(VV, B) do { _Pragma("unroll") for (int j = 0; j < 16; ++j) { const unsigned vo_ = (unsigned)list[(B) * 64 + 4 * j + fq] * 64u + (unsigned)d4; VV[j] = *(const u32x2*)(v2 + vo_); } } while (0)
#define PV_COMP(VV, B) do { _Pragma("unroll") for (int j = 0; j < 16; ++j) { const f32x4 p4_ = *(const LAS f32x4*)(Pb + ((B) * 64 + 4 * j + fq) * 4); \
        const f32x2 va_ = (f32x2){bflo(VV[j].x), bfhi(VV[j].x)}, vb_ = (f32x2){bflo(VV[j].y), bfhi(VV[j].y)}; \
        _Pragma("unroll") for (int h = 0; h < 4; ++h) { const f32x2 pp_ = (f32x2){p4_[h], p4_[h]}; o2[h][0] = __builtin_elementwise_fma(va_, pp_, o2[h][0]); o2[h][1] = __builtin_elementwise_fma(vb_, pp_, o2[h][1]); } } } while (0)
    { u32x2 va[16], vb[16]; PV_LOAD(va, 0); PV_LOAD(vb, 1); PV_COMP(va, 0); PV_LOAD(va, 2); PV_COMP(vb, 1); PV_LOAD(vb, 3); PV_COMP(va, 2); PV_COMP(vb, 3); }
#undef PV_LOAD
#undef PV_COMP
    float o4[4][4];
#pragma unroll
    for (int h = 0; h < 4; ++h)
#pragma unroll
        for (int dd = 0; dd < 4; ++dd) { float v = o2[h][dd >> 1][dd & 1]; v += __shfl_xor(v, 16); v += __shfl_xor(v, 32); o4[h][dd] = v; }
    { const int h = fq; const float iv = pinv[h];
        float r4[4];
#pragma unroll
        for (int dd = 0; dd < 4; ++dd) r4[dd] = ((h == 0) ? o4[0][dd] : (h == 1) ? o4[1][dd] : (h == 2) ? o4[2][dd] : o4[3][dd]) * iv;
        u32x2 o; o.x = pk2(r4[0], r4[1]); o.y = pk2(r4[2], r4[3]);
        *(u32x2*)(X.ybuf() + (size_t)1 * M * 256 + ((size_t)b * SEQ + t) * 256 + h * 64 + d4) = o; }
    __builtin_amdgcn_fence(__ATOMIC_RELEASE, "workgroup"); __builtin_amdgcn_wave_barrier(); }
    __syncthreads();
}

constexpr int LR_HH = 0, LR_HL = 33280, LR_PART = 66560, LR_LG = 82944, LR_CNT = 84992, LR_PITCH = 1032;
__device__ __forceinline__ void ph_ln1_router(const Ctx& X, int l) {
    const int lane = X.lane, w = X.wave, tid = X.tid, fr = lane & 15, fq = lane >> 4;
    LAS bf16_t* Hh = (LAS bf16_t*)(X.lds + LR_HH); LAS bf16_t* Hl = (LAS bf16_t*)(X.lds + LR_HL);
    LAS float* part = (LAS float*)(X.lds + LR_PART);
    LAS float* lgt = (LAS float*)(X.lds + LR_LG);
    LAS unsigned* wgcnt = (LAS unsigned*)(X.lds + LR_CNT);
    if (tid < 32) wgcnt[tid] = 0u;
    bf16x8 Ahi[2][4], Alo[2][4];
    { const bf16_t* rf = (const bf16_t*)(X.ws + WS_RFR);
#pragma unroll
      for (int rt = 0; rt < 2; ++rt)
#pragma unroll
          for (int q = 0; q < 4; ++q) { const size_t o = ((size_t)(rt * 32 + 4 * w + q) * 64 + lane) * 8; Ahi[rt][q] = *(const bf16x8*)(rf + o); Alo[rt][q] = *(const bf16x8*)(rf + 32768 + o); } }
    float* xo = X.a->out; bf16_t* hb = X.hbuf(); float* xw = (X.dbg & 8) ? (float*)(X.ws + WS_ACT) : xo; const bf16_t* v16 = (const bf16_t*)(X.ws + WS_V16);
    const int tok0 = X.c * 128, b = tok0 >> 13;
    const float* mv = X.modv(l, 1) + b * 3072;
    const float* lg = X.in(I_LN1G) + l * D; const float* lb = X.in(I_LN1B) + l * D;
    const int e = lane & 31;
    const float rbias = X.in(I_RB)[l * NEXP + e];
    unsigned* pinfo = (unsigned*)(X.ws + WS_PINFO); float* pgate = (float*)(X.ws + WS_PGATE);
    __syncthreads();
    u32x2 raw[2][4];
#pragma unroll
    for (int jj = 0; jj < 2; ++jj)
#pragma unroll
        for (int j = 0; j < 4; ++j) raw[jj][j] = *(const u32x2*)(v16 + (size_t)(tok0 + 2 * w + jj) * D + 4 * lane + 256 * j);
    for (int pass = 0; pass < 8; ++pass) {
        f32x4 vv[2][4];
#pragma unroll
        for (int jj = 0; jj < 2; ++jj)
#pragma unroll
            for (int j = 0; j < 4; ++j) { const u32x2 q2 = raw[jj][j]; vv[jj][j] = (f32x4){bflo(q2.x), bfhi(q2.x), bflo(q2.y), bfhi(q2.y)}; }
        if (pass + 1 < 8) {
#pragma unroll
            for (int jj = 0; jj < 2; ++jj)
#pragma unroll
                for (int j = 0; j < 4; ++j) raw[jj][j] = *(const u32x2*)(v16 + (size_t)(tok0 + (pass + 1) * 16 + 2 * w + jj) * D + 4 * lane + 256 * j); }
#pragma unroll
        for (int jj = 0; jj < 2; ++jj) {
            const int r = 2 * w + jj, tok = tok0 + pass * 16 + r;
            f32x4 v[4]; float s = 0.f;
#pragma unroll
            for (int j = 0; j < 4; ++j) { v[j] = vv[jj][j]; s += (v[j][0] + v[j][1]) + (v[j][2] + v[j][3]); }
            const float mean = wave_sum(s) * (1.0f / D); float q = 0.f;
#pragma unroll
            for (int j = 0; j < 4; ++j) { v[j] = v[j] - mean; q += (v[j][0] * v[j][0] + v[j][1] * v[j][1]) + (v[j][2] * v[j][2] + v[j][3] * v[j][3]); }
            const float rstd = rsqrtf(wave_sum(q) * (1.0f / D) + LN_EPS);
#pragma unroll
            for (int j = 0; j < 4; ++j) { const int col = 4 * lane + 256 * j;
                const f32x4 x1 = v[j] * rstd * *(const f32x4*)(lg + col) + *(const f32x4*)(lb + col);
                *(f32x4*)(xw + (size_t)tok * D + col) = x1 * DN_ALPHA;
                const f32x4 hv = x1 * (*(const f32x4*)(mv + 1024 + col) + 1.0f) + *(const f32x4*)(mv + col);
                const unsigned h0 = f2bf(hv[0]), h1 = f2bf(hv[1]), h2 = f2bf(hv[2]), h3 = f2bf(hv[3]);
                u32x2 o; o.x = h0 | (h1 << 16); o.y = h2 | (h3 << 16); *(u32x2*)(hb + (size_t)tok * D + col) = o;
                *(LAS u32x2*)(Hh + r * LR_PITCH + col) = o;
                u32x2 ol; ol.x = pk2(hv[0] - bflo(h0), hv[1] - bflo(h1)); ol.y = pk2(hv[2] - bflo(h2), hv[3] - bflo(h3)); *(LAS u32x2*)(Hl + r * LR_PITCH + col) = ol; }
        }
        __syncthreads();
        {
            f32x4 acc0 = (f32x4){0.f, 0.f, 0.f, 0.f}, acc1 = acc0;
#pragma unroll
            for (int q = 0; q < 4; ++q) { const int ko = fr * LR_PITCH + (4 * w + q) * 32 + 8 * fq;
                const bf16x8 bh = *(const LAS bf16x8*)(Hh + ko), bl = *(const LAS bf16x8*)(Hl + ko);
                acc0 = mfma16(Ahi[0][q], bh, acc0); acc0 = mfma16(Ahi[0][q], bl, acc0); acc0 = mfma16(Alo[0][q], bh, acc0);
                acc1 = mfma16(Ahi[1][q], bh, acc1); acc1 = mfma16(Ahi[1][q], bl, acc1); acc1 = mfma16(Alo[1][q], bh, acc1); }
#pragma unroll
            for (int i = 0; i < 4; ++i) { part[(w * 32 + 4 * fq + i) * 16 + fr] = acc0[i]; part[(w * 32 + 16 + 4 * fq + i) * 16 + fr] = acc1[i]; }
        }
        __syncthreads();
        { const int ee = tid >> 4, tk = tid & 15; float sm = 0.f;
#pragma unroll
          for (int q = 0; q < 8; ++q) sm += part[(q * 32 + ee) * 16 + tk];
          lgt[tk * 32 + ee] = sm; }
        __syncthreads();
#pragma unroll
        for (int jj = 0; jj < 2; ++jj) {
            const int r = 2 * w + jj, tok = tok0 + pass * 16 + r;
            const float score = sigmoidf_(lgt[r * 32 + e]), biased = score + rbias;
            const int gbase = lane & ~3;
            const float v0 = __shfl(biased, gbase), v1 = __shfl(biased, gbase + 1), v2 = __shfl(biased, gbase + 2), v3 = __shfl(biased, gbase + 3);
            const float a_ = fmaxf(v0, v1), b_ = fminf(v0, v1), c_ = fmaxf(v2, v3), d_ = fminf(v2, v3);
            const float gs = fmaxf(a_, c_) + fmaxf(fminf(a_, c_), fmaxf(b_, d_));
            const int myg = e >> 2; int grank = 0;
#pragma unroll
            for (int g2 = 0; g2 < 8; ++g2) { const float o = __shfl(gs, 4 * g2); grank += (o > gs || (o == gs && g2 < myg)) ? 1 : 0; }
            const float masked = (grank < 4) ? biased : -3.0e38f;
            int erank = 0;
#pragma unroll
            for (int e2 = 0; e2 < 32; ++e2) { const float o = __shfl(masked, e2); erank += (o > masked || (o == masked && e2 < e)) ? 1 : 0; }
            const bool sel = (erank < 8) && (lane < 32);
            const float wsum = wave_sum(sel ? score : 0.f);
            const float gate = score / wsum * 2.5f;
            const unsigned long long bal = __ballot(sel);
            if (sel) { const int k = __popcll(bal & ((1ull << lane) - 1ull));
                const unsigned lr = __hip_atomic_fetch_add(wgcnt + e, 1u, __ATOMIC_RELAXED, __HIP_MEMORY_SCOPE_WORKGROUP);
                pinfo[(size_t)tok * 8 + k] = (unsigned)e | (lr << 8); pgate[(size_t)tok * 8 + k] = gate; }
        }
    }
    __syncthreads();
    if (tid < 32) { const int chunk = tok0 / CHTOK; unsigned* cnt = (unsigned*)(X.ws + WS_CTL) + CW_CNT + (l * NCH + chunk) * 64;
        const unsigned base = __hip_atomic_fetch_add(cnt + tid, wgcnt[tid], __ATOMIC_RELAXED, __HIP_MEMORY_SCOPE_AGENT);
        ((unsigned*)(X.ws + WS_WGBASE))[X.c * 32 + tid] = base; }
    __syncthreads();
}

__device__ __forceinline__ void moe_offsets(const Ctx& X, int l, int chunk, LAS int* off  , LAS int* cntl  ) {
    if (X.tid == 0) { const unsigned* cnt = (const unsigned*)(X.ws + WS_CTL) + CW_CNT + (l * NCH + chunk) * 64; int o = 0;
        for (int e = 0; e < NE1; ++e) { const int cn = (e < NEXP) ? (int)__hip_atomic_load(cnt + e, __ATOMIC_RELAXED, __HIP_MEMORY_SCOPE_AGENT) : CHTOK; off[e] = o; cntl[e] = cn; o += ((cn + 255) >> 8) << 8; }
        off[NE1] = o; }
    __syncthreads();
}
#define ST_WT(p, v) __hip_atomic_store((p), (v), __ATOMIC_RELAXED, __HIP_MEMORY_SCOPE_AGENT)
__device__ __forceinline__ void ph_fill(const Ctx& X, int l) {
    LAS int* off = (LAS int*)(X.lds); LAS int* cntl = off + 64;
    const int tok0 = X.c * 128, chunk = tok0 / CHTOK;
    moe_offsets(X, l, chunk, off, cntl);
    unsigned* rowtok = (unsigned*)(X.ws + WS_ROWTOK) + (size_t)chunk * CH_ROWS; float* rowgate = (float*)(X.ws + WS_ROWGATE) + (size_t)chunk * CH_ROWS;
    const unsigned* pinfo = (const unsigned*)(X.ws + WS_PINFO); const float* pgate = (const float*)(X.ws + WS_PGATE); unsigned* slot = (unsigned*)(X.ws + WS_SLOT);
    const unsigned* wgb = (const unsigned*)(X.ws + WS_WGBASE) + X.c * 32;
    for (int i = X.tid; i < 1024; i += 512) { const size_t pi = (size_t)tok0 * 8 + i; const unsigned inf = pinfo[pi]; const int e = inf & 255, lr = inf >> 8;
        const int pos = off[e] + (int)wgb[e] + lr; ST_WT(rowtok + pos, (unsigned)(tok0 + (i >> 3))); ST_WT((unsigned*)rowgate + pos, __builtin_bit_cast(unsigned, pgate[pi])); slot[pi] = (unsigned)pos; }
    if (X.tid < 128) { const int tok = tok0 + X.tid; const int pos = off[NEXP] + (tok - chunk * CHTOK); ST_WT(rowtok + pos, (unsigned)tok); ST_WT((unsigned*)rowgate + pos, __builtin_bit_cast(unsigned, 1.0f)); }
    const int wl = X.c & 63;
    if (wl < NEXP) { const int e = wl; const int p0 = off[e] + cntl[e], p1 = off[e + 1]; for (int p = p0 + X.tid; p < p1; p += 512) { ST_WT(rowtok + p, (unsigned)(chunk * CHTOK)); ST_WT((unsigned*)rowgate + p, 0u); } }
    __syncthreads();
}

template <int NT, bool GATH>
struct MoeOrder {
    static constexpr bool GATHER = GATH;
    int nwg, G, c; const LAS unsigned char* tile_e; const LAS int* rowtab;
    __device__ __forceinline__ bool next(int i, pg8::Unit& u) const {
        const long L = (long)i * G + c; if (L >= nwg) return false;
        const int wgid = pg8::xcd_remap((int)L, nwg); const int tau = wgid / NT, pn = wgid % NT;
        u.pm = tau; u.pn = pn; u.bt = __builtin_amdgcn_readfirstlane((int)tile_e[tau]) * NT + pn; u.ab = i; return true;
    }
    __device__ __forceinline__ int row_of(const pg8::Unit& u, int r) const { return rowtab[u.ab * 256 + r]; }
    __device__ __forceinline__ void a_ready(const pg8::Unit&) const {}
    __device__ __forceinline__ void done(const pg8::Unit&) const {}
};
template <int NT, bool GATH>
struct MoeOrderAll {
    static constexpr bool GATHER = GATH;
    int nwg, G, c; const LAS unsigned char* tile_e4; const LAS int* tprefix; const LAS int* rowtab; int tbase;
    __device__ __forceinline__ bool next(int i, pg8::Unit& u) const {
        const long L = (long)i * G + c; if (L >= nwg) return false;
        const int wgid = pg8::xcd_remap((int)L, nwg); const int gt = tbase + wgid / NT, pn = wgid % NT;
        int ch = 0;
#pragma unroll
        for (int q = 1; q < NCH; ++q) ch += (tprefix[q] <= gt) ? 1 : 0;
        ch = __builtin_amdgcn_readfirstlane(ch); const int tau = gt - __builtin_amdgcn_readfirstlane(tprefix[ch]);
        u.pm = ch * CH_TILES + tau; u.pn = pn; u.bt = __builtin_amdgcn_readfirstlane((int)tile_e4[ch * 336 + tau]) * NT + pn; u.ab = i; return true;
    }
    __device__ __forceinline__ int row_of(const pg8::Unit& u, int r) const { return rowtab[u.ab * 256 + r]; }
    __device__ __forceinline__ void a_ready(const pg8::Unit&) const {}
    __device__ __forceinline__ void done(const pg8::Unit&) const {}
};
__device__ __forceinline__ void moe_tables_all(const Ctx& X, int l, LAS int* off4, LAS unsigned char* tile_e4, LAS int* tprefix) {
    if (X.tid < NCH) { const int chn = X.tid; const unsigned* cnt = (const unsigned*)(X.ws + WS_CTL) + CW_CNT + (l * NCH + chn) * 64; int o = 0;
        for (int e = 0; e < NE1; ++e) { const int cn = (e < NEXP) ? (int)__hip_atomic_load(cnt + e, __ATOMIC_RELAXED, __HIP_MEMORY_SCOPE_AGENT) : CHTOK; off4[chn * 64 + e] = o; o += ((cn + 255) >> 8) << 8; }
        off4[chn * 64 + NE1] = o; }
    __syncthreads();
    if (X.tid == 0) { int a = 0; for (int q = 0; q < NCH; ++q) { tprefix[q] = a; a += off4[q * 64 + NE1] >> 8; } tprefix[NCH] = a; }
    for (int t = X.tid; t < NCH * 336; t += 512) { const int chn = t / 336, tau = t % 336; int e = 0; for (int q = 1; q < NE1; ++q) e += (off4[chn * 64 + q] <= tau * 256) ? 1 : 0; tile_e4[t] = (unsigned char)e; }
    __syncthreads();
}
__device__ __forceinline__ int moe_tiles(const Ctx& X, int l, int chunk, LAS unsigned char* tile_e, LAS int* off, LAS int* cntl) {
    moe_offsets(X, l, chunk, off, cntl);
    const int ntile = off[NE1] >> 8;
    for (int t = X.tid; t < ntile; t += 512) { int e = 0; for (int q = 1; q < NE1; ++q) e += (off[q] <= t * 256) ? 1 : 0; tile_e[t] = (unsigned char)e; }
    __syncthreads();
    return ntile;
}

__device__ __forceinline__ void ph_combine(const Ctx& X, int l, int c0, const LAS int* off4) {
    const int lane = X.lane; const int gw = X.c * 8 + X.wave; const int chunk = c0 + (gw >> 10);
    float* xo = X.a->out; bf16_t* hb = X.hbuf(); float* xw = (X.dbg & 8) ? (float*)(X.ws + WS_ACT) : xo;
    const unsigned char* op = (const unsigned char*)(X.ws + WS_OPAIR) + (size_t)(chunk - c0) * CH_ROWS * 1024; const unsigned* slot = (const unsigned*)(X.ws + WS_SLOT);
    const int b = (chunk * CHTOK) >> 13; const float* mv2 = X.modv(l, 1) + b * 3072;
    const float* lg = X.in(I_LN2G) + l * D; const float* lb = X.in(I_LN2B) + l * D;
    const int offsh = off4[chunk * 64 + NEXP];
#pragma unroll 1
    for (int i = 0; i < 8; i += 2) {
        const int tokA = c0 * CHTOK + gw * 8 + i;
        int pos[2][9];
#pragma unroll
        for (int t = 0; t < 2; ++t) {
            const u32x4 s0 = *(const u32x4*)(slot + (size_t)(tokA + t) * 8), s1 = *(const u32x4*)(slot + (size_t)(tokA + t) * 8 + 4);
            pos[t][0] = (int)s0.x; pos[t][1] = (int)s0.y; pos[t][2] = (int)s0.z; pos[t][3] = (int)s0.w; pos[t][4] = (int)s1.x; pos[t][5] = (int)s1.y; pos[t][6] = (int)s1.z; pos[t][7] = (int)s1.w;
            pos[t][8] = offsh + (tokA + t - chunk * CHTOK); }
        unsigned rw8[2][9][4];
#pragma unroll
        for (int t = 0; t < 2; ++t) {
#pragma unroll
            for (int k = 0; k < 9; ++k) { const unsigned ro = (unsigned)pos[t][k] * 1024u + 4u * (unsigned)lane;
#pragma unroll
                for (int j = 0; j < 4; ++j) rw8[t][k][j] = *(const unsigned*)(op + ro + 256 * j); } }
#pragma unroll
        for (int t = 0; t < 2; ++t) {
            const int tok = tokA + t;
            f32x4 sm[4];
#pragma unroll
            for (int j = 0; j < 4; ++j) sm[j] = (f32x4){0.f, 0.f, 0.f, 0.f};
#pragma unroll
            for (int k = 0; k < 9; ++k)
#pragma unroll
                for (int j = 0; j < 4; ++j) { const int q = (int)rw8[t][k][j]; const f32x2 lo = __builtin_amdgcn_cvt_pk_f32_fp8(q, false), hi = __builtin_amdgcn_cvt_pk_f32_fp8(q, true);
                    sm[j][0] += lo[0]; sm[j][1] += lo[1]; sm[j][2] += hi[0]; sm[j][3] += hi[1]; }
            f32x4 v[4]; float s = 0.f;
#pragma unroll
            for (int j = 0; j < 4; ++j) { const int col = 4 * lane + 256 * j; v[j] = *(const f32x4*)(xo + (size_t)tok * D + col) + (*(const f32x4*)(mv2 + 2048 + col) + 1.0f) * (sm[j] * (1.0f / O_SCALE)); s += (v[j][0] + v[j][1]) + (v[j][2] + v[j][3]); }
            const float mean = wave_sum(s) * (1.0f / D); float q = 0.f;
#pragma unroll
            for (int j = 0; j < 4; ++j) { v[j] = v[j] - mean; q += (v[j][0] * v[j][0] + v[j][1] * v[j][1]) + (v[j][2] * v[j][2] + v[j][3] * v[j][3]); }
            const float rstd = rsqrtf(wave_sum(q) * (1.0f / D) + LN_EPS);
#pragma unroll
            for (int j = 0; j < 4; ++j) { const int col = 4 * lane + 256 * j;
                const f32x4 x2 = v[j] * rstd * *(const f32x4*)(lg + col) + *(const f32x4*)(lb + col);
                *(f32x4*)(xw + (size_t)tok * D + col) = x2;
                if (l + 1 < DEPTH) { const float* mv1 = X.modv(l + 1, 0) + b * 3072; const f32x4 hn = x2 * (*(const f32x4*)(mv1 + 1024 + col) + 1.0f) + *(const f32x4*)(mv1 + col);
                    u32x2 o; o.x = pk2(hn[0], hn[1]); o.y = pk2(hn[2], hn[3]); *(u32x2*)(hb + (size_t)tok * D + col) = o; } }
        }
    }
}

struct POrder : pg8::StaticOrder { __device__ __forceinline__ bool next(int i, pg8::Unit& u) const { if (!pg8::StaticOrder::next(i, u)) return false; u.ab = u.pn >> 2; return true; } };
struct GOrder { static constexpr bool GATHER = false; int G, c;
    __device__ __forceinline__ bool next(int i, pg8::Unit& u) const { const int tile = (i >> 2) * G + c; if (tile >= 512) return false; const int wg = pg8::xcd_remap(tile, 512); const int br = i & 3, mt = wg & 3;
        u.pm = wg >> 2; u.pn = br * 4 + mt; u.bt = br * 4 + mt; u.ab = 0; return true; }
    __device__ __forceinline__ void a_ready(const pg8::Unit&) const {} __device__ __forceinline__ void done(const pg8::Unit&) const {} };
__global__ void __launch_bounds__(512, 2) fwd_kernel(Args args) {
    extern __shared__ __attribute__((aligned(16))) unsigned char lds_raw[];
    ArgsP ap = (ArgsP)__builtin_amdgcn_kernarg_segment_ptr();
    Ctx X; X.a = ap; X.ws = ap->ws; X.lds = (LAS unsigned char*)lds_raw;
    X.tid = threadIdx.x; X.lane = X.tid & 63; X.wave = __builtin_amdgcn_readfirstlane(X.tid >> 6); X.G = gridDim.x;
    { const int bx = blockIdx.x; X.bx = bx; X.c = (X.G % 8 == 0) ? (bx % 8) * (X.G / 8) + bx / 8 : bx; }
    const int c0_ = X.c, g0_ = X.G, bx0_ = X.bx, wave0_ = X.wave;
    volatile LAS unsigned* misc = (volatile LAS unsigned*)(X.lds + LDS_MISC);
    if (X.tid < 16) misc[X.tid] = 0u;
    __syncthreads();
    XcdBarrier bar; bar.bar = (unsigned*)(X.ws + WS_CTL) + CW_BAR; bar.x = 0; bar.st = misc;
#if !MK_PER_PHASE
    bar = xcd_barrier_post((unsigned*)(X.ws + WS_CTL) + CW_BAR, misc);
#endif
    const int lo = ap->ph_lo, hi = ap->ph_hi; int ph = 0;
#define RELAUNDER() do { int wv_ = wave0_; asm volatile("" : "+s"(wv_)); int t_ = wv_ * 64 + (int)__builtin_amdgcn_mbcnt_hi(~0u, __builtin_amdgcn_mbcnt_lo(~0u, 0u)); asm volatile("" : "+v"(t_)); X.tid = t_; X.lane = t_ & 63; X.wave = wv_; } while (0)
#define REPEAT(N, stmt) _Pragma("nounroll") for (int rp_ = 0; rp_ < (N); ++rp_) { stmt; if (rp_ + 1 < (N)) xcd_barrier(bar); }
#define PH_BEGIN if (ph >= lo && ph < hi) { { ArgsP apl = ap; asm volatile("" : "+s"(apl)); X.a = apl; X.ws = apl->ws; X.dbg = apl->dbg; int wv_ = wave0_; asm volatile("" : "+s"(wv_)); int t_ = wv_ * 64 + (int)__builtin_amdgcn_mbcnt_hi(~0u, __builtin_amdgcn_mbcnt_lo(~0u, 0u)); asm volatile("" : "+v"(t_)); X.tid = t_; X.lane = t_ & 63; X.wave = wv_; int c_ = c0_, g_ = g0_, b_ = bx0_; asm volatile("" : "+s"(c_), "+s"(g_), "+s"(b_)); X.c = c_; X.G = g_; X.bx = b_; } unsigned char* wb = X.ws + WS_W; LAS unsigned char* gl = X.lds; const float* xin = (l_ == 0) ? X.in(I_X) : (const float*)X.a->out; (void)wb; (void)gl; (void)xin;
#if MK_PER_PHASE
#define PH_END } ++ph;
#else
#define PH_END if (ph + 1 < hi) xcd_barrier(bar); } ++ph;
#endif
    int l_ = 0;
    PH_BEGIN if (EN_PROLOGUE) { REPEAT(R_MISC, ph_prologue(X)) } PH_END
    for (int l = 0; l < DEPTH; ++l) {
        l_ = l;
        PH_BEGIN if (EN_WCONV) { REPEAT(R_MISC, ph_wconv(X, l)) } PH_END
        PH_BEGIN if (EN_GWIN)  { pg8::Gemm g{X.hbuf(), (const bf16_t*)(wb + WO_IN), 1024, 0}; pg8::StaticOrder S; S.init(M, PJ, X.G, X.bx); pg8::EpiBf16 E{X.proj(), PJ};
            REPEAT(R_GWIN, (pg8::gemm_phase<pg8::EpiBf16, pg8::StaticOrder, G_ALIGN, G_SP2>(gl, g, S, E, X.tid))) } PH_END
        PH_BEGIN if (EN_MX1)  {
            if (!(X.dbg & 1)) mx_rope(X);
            _Pragma("nounroll") for (int rp_ = 0; rp_ < R_MIX; ++rp_) {
            if (!(X.dbg & 2)) for (int u = X.c; u < 256; u += X.G) mx_gmlp(X, l, u);
            if (!(X.dbg & 4)) for (int wu = X.c * 8 + X.wave; wu < 2048; wu += X.G * 8) mx_s5<1>(X, l, wu);
            __syncthreads();
            if (!(X.dbg & 8)) for (int u = X.c; u < 256; u += X.G) mx_ssd<1>(X, l, u); }
        } PH_END
        PH_BEGIN if (EN_MX2)  {
            if (!(X.dbg & 32)) { mx_ssd_carry(X); mx_s5_carry(X); } RELAUNDER();
            _Pragma("nounroll") for (int rp_ = 0; rp_ < R_DSA; ++rp_)
            for (int r = 0; r < 16; ++r) { const int cl = X.c & 63; const int uu = (r & 1) ? r * 64 + 63 - cl : r * 64 + cl; if (EN_DSA && !(X.dbg & 64) && X.c < 256) mx_dsa(X, X.c >> 6, uu * 8); }
            __syncthreads(); RELAUNDER();
            for (int wu = X.c * 8 + X.wave; EN_S53 && !(X.dbg & 16) && wu < 2048; wu += X.G * 8) mx_s5<3>(X, l, wu);
        } PH_END
        PH_BEGIN if (EN_GLU)  { for (int u = X.c; EN_SSD3 && u < 256; u += X.G) mx_ssd<3>(X, l, u);
            __syncthreads(); RELAUNDER();
            pg8::Gemm g{(const bf16_t*)(X.ws + WS_YCPRE), (const bf16_t*)(wb + WO_GLU), 256, 0}; pg8::StaticOrder S; S.init(M, 256, X.G, X.bx);
            pg8::EpiGlu E{(const bf16_t*)(X.ws + WS_YCPRE), X.ybuf() + (size_t)2 * M * 256, X.in(I_S5GLUB) + l * 256};
            REPEAT(R_GLU, (pg8::gemm_phase<pg8::EpiGlu, pg8::StaticOrder, G_ALIGN, G_SP2>(gl, g, S, E, X.tid))) } PH_END
        PH_BEGIN if (EN_GP)  { pg8::Gemm g{X.ybuf(), (const bf16_t*)(wb + WO_BR), 256, (size_t)M * 256};
            POrder S;
            S.init(M, 4096, X.G, X.bx); pg8::EpiFp8 E{(unsigned char*)(X.ws + WS_P), 4096, P_SCALE};
            REPEAT(R_GP, (pg8::gemm_phase<pg8::EpiFp8, POrder, false, G_SP2>(gl, g, S, E, X.tid))) } PH_END
        PH_BEGIN if (EN_GGATE)  { pg8::Gemm g{X.hbuf(), (const bf16_t*)(wb + WO_GATE), 1024, 0};
            GOrder S{X.G, X.bx};
            pg8::EpiGateMerge E{(const unsigned char*)(X.ws + WS_P), X.ybuf(), 1.0f / P_SCALE};
            REPEAT(R_GGATE, (pg8::gemm_phase<pg8::EpiGateMerge, GOrder, G_ALIGN, G_SP2>(gl, g, S, E, X.tid))) } PH_END
        PH_BEGIN if (EN_GOUT)  { pg8::Gemm g{X.ybuf(), (const bf16_t*)(wb + WO_OUT), 1024, 0}; pg8::StaticOrder S; S.init(M, 1024, X.G, X.bx);
            pg8::EpiResid E{xin, (bf16_t*)(X.ws + WS_V16), X.modv(l, 0)};
            pg8::gemm_phase<pg8::EpiResid, pg8::StaticOrder, G_ALIGN, G_SP2>(gl, g, S, E, X.tid); } PH_END
        PH_BEGIN if (EN_LN1)  ph_ln1_router(X, l); PH_END
        PH_BEGIN if (EN_FILL) { REPEAT(R_MISC, ph_fill(X, l)) } PH_END
        PH_BEGIN if (EN_MOE1)  {
            LAS int* off4 = (LAS int*)(X.lds + LDS_TAB + 1024); LAS unsigned char* tile_e4 = (LAS unsigned char*)(X.lds + LDS_TAB + 2048); LAS int* tprefix = (LAS int*)(X.lds + LDS_TAB + 3584);
            moe_tables_all(X, l, off4, tile_e4, tprefix);
            pg8::Gemm g{X.hbuf(), (const bf16_t*)(wb + WO_13), 1024, 0};
            LAS int* rowtab = (LAS int*)(X.lds + LDS_TAB + 4096);
            MoeOrderAll<2, true> S{tprefix[NCH] * 2, X.G, X.bx, tile_e4, tprefix, rowtab, 0};
            { const unsigned* rowtok = (const unsigned*)(X.ws + WS_ROWTOK); pg8::Unit uu;
              const float* rowgate = (const float*)(X.ws + WS_ROWGATE); LAS float* gtabw = (LAS float*)(X.lds + LDS_TAB + 4096 + 12288);
              _Pragma("nounroll") for (int i = 0; i < 12; ++i) { if (!S.next(i, uu)) break; const int pmu = __builtin_amdgcn_readfirstlane(uu.pm);
                  if (X.tid < 256) { rowtab[i * 256 + X.tid] = (int)rowtok[(size_t)pmu * 256 + X.tid]; gtabw[i * 256 + X.tid] = rowgate[(size_t)pmu * 256 + X.tid]; } } }
            __syncthreads();
            pg8::EpiMoe1 E{(bf16_t*)(X.ws + WS_ACT), (const LAS float*)(X.lds + LDS_TAB + 4096 + 12288)};
            REPEAT(R_MOE, (pg8::gemm_phase<pg8::EpiMoe1, MoeOrderAll<2, true>, G_ALIGN, G_SP2>(gl, g, S, E, X.tid)))
        } PH_END
        for (int c0 = 0; c0 < NCH; c0 += 2) {
            PH_BEGIN if (EN_MOE2)  {
                LAS int* off4 = (LAS int*)(X.lds + LDS_TAB + 1024); LAS unsigned char* tile_e4 = (LAS unsigned char*)(X.lds + LDS_TAB + 2048); LAS int* tprefix = (LAS int*)(X.lds + LDS_TAB + 3584);
                moe_tables_all(X, l, off4, tile_e4, tprefix);
                pg8::Gemm g{(const bf16_t*)(X.ws + WS_ACT), (const bf16_t*)(wb + WO_2), 256, 0};
                MoeOrderAll<4, false> S{(tprefix[c0 + 2] - tprefix[c0]) * 4, X.G, X.bx, tile_e4, tprefix, nullptr, tprefix[c0]};
                pg8::EpiFp8 E{(unsigned char*)(X.ws + WS_OPAIR) - (size_t)c0 * CH_ROWS * 1024, 1024, O_SCALE};
                REPEAT(R_MOE, (pg8::gemm_phase<pg8::EpiFp8, MoeOrderAll<4, false>, false, G_SP2>(gl, g, S, E, X.tid)))
            } PH_END
            PH_BEGIN if (EN_FIN)  { LAS int* off4 = (LAS int*)(X.lds + LDS_TAB + 1024); LAS unsigned char* tile_e4 = (LAS unsigned char*)(X.lds + LDS_TAB + 2048); LAS int* tprefix = (LAS int*)(X.lds + LDS_TAB + 3584);
                moe_tables_all(X, l, off4, tile_e4, tprefix); ph_combine(X, l, c0, off4); } PH_END
        }
    }
#undef PH_BEGIN
#undef PH_END
}
constexpr int N_PHASES = 1 + DEPTH * (10 + 1 + NCH);

#ifdef DBG_DUMP_OFF
__global__ void dbg_dump(const bf16_t* src, float* out, size_t n) { for (size_t i = (size_t)blockIdx.x * blockDim.x + threadIdx.x; i < n; i += (size_t)gridDim.x * blockDim.x) {
#ifdef DBG_HASH_OUT
    const unsigned bits = __builtin_bit_cast(unsigned, out[i]); out[i] = (float)((bits * 2654435761u) >> 8) * (1.0f / 16777216.0f);
#else
    const unsigned bits = src[i]; out[i] = (float)(((bits + 1u) * 2654435761u) >> 8) * (1.0f / 16777216.0f);
#endif
} }
#endif
extern "C" void kernel_launch(void* const* d_in, const int* in_sizes, int n_in, void* d_out, int out_size, void* d_ws, size_t ws_size, hipStream_t stream) {
    static int grid = 0;
    if (grid == 0) {
        if (n_in != 43 || out_size != M * D || ws_size < WS_NEED) { fprintf(stderr, "kernel_launch: unexpected shapes (n_in %d out %d ws %zu)\n", n_in, out_size, ws_size); grid = -1; return; }
        int dev = 0, cus = 0, per_cu = 0;
        if (hipGetDevice(&dev) != hipSuccess || hipDeviceGetAttribute(&cus, hipDeviceAttributeMultiprocessorCount, dev) != hipSuccess) { grid = -1; return; }
        if (hipFuncSetAttribute((const void*)fwd_kernel, hipFuncAttributeMaxDynamicSharedMemorySize, LDS_BYTES) != hipSuccess) { fprintf(stderr, "kernel_launch: hipFuncSetAttribute failed\n"); grid = -1; return; }
        if (hipOccupancyMaxActiveBlocksPerMultiprocessor(&per_cu, (const void*)fwd_kernel, 512, LDS_BYTES) != hipSuccess || per_cu < 1) fprintf(stderr, "kernel_launch: occupancy query says %d\n", per_cu);
        (void)hipGetLastError();
        grid = cus < 256 ? cus : 256;
    }
    if (grid < 0) return;
    (void)hipMemsetAsync((char*)d_ws + WS_CTL, 0, CTL_BYTES, stream);
#ifdef DBG_POISON
    (void)hipMemsetAsync((char*)d_ws + CTL_BYTES, 0xFF, WS_NEED - CTL_BYTES, stream);
    (void)hipMemsetAsync((char*)d_out, 0xFF, (size_t)M * D * 4, stream);
#endif
    Args a{};
    for (int i = 0; i < 43; ++i) a.in[i] = (const float*)d_in[i];
    a.positions = (const int*)d_in[I_POS]; a.out = (float*)d_out; a.ws = (unsigned char*)d_ws;
#if MK_PER_PHASE
#ifndef DBG_NPH
#define DBG_NPH N_PHASES
#endif
    for (int p = 0; p < DBG_NPH; ++p) { a.ph_lo = p; a.ph_hi = p + 1; hipLaunchKernelGGL(fwd_kernel, dim3(grid), dim3(512), LDS_BYTES, stream, a); }
#ifdef DBG_DUMP_OFF
    hipLaunchKernelGGL(dbg_dump, dim3(2048), dim3(256), 0, stream, (const bf16_t*)((const char*)d_ws + (size_t)(DBG_DUMP_OFF)), (float*)d_out, (size_t)M * D);
#endif
#else
    a.ph_lo = 0; a.ph_hi = N_PHASES; hipLaunchKernelGGL(fwd_kernel, dim3(grid), dim3(512), LDS_BYTES, stream, a);
#ifdef DBG_EXTRA_PH
    a.dbg = DBG_EXTRA_FLAGS;
    for (int rep = 0; rep < DBG_EXTRA_REP; ++rep) { a.ph_lo = DBG_EXTRA_PH; a.ph_hi = DBG_EXTRA_PH + 1; hipLaunchKernelGGL(fwd_kernel, dim3(grid), dim3(512), LDS_BYTES, stream, a); }
#endif
#endif
}
```

```cpp
#include <hip/hip_runtime.h>
#include <cstdio>
#include <cstdint>


#ifndef DSA_SKIP
#define DSA_SKIP 0
#endif
#ifndef DSA_PM
#define DSA_PM 0
#endif
#ifndef R_S1
#define R_S1 1
#endif
#ifndef R_S2
#define R_S2 1
#endif
#ifndef R_S3
#define R_S3 1
#endif
#ifndef EN_DSA
#define EN_DSA 1
#endif
#ifndef EN_S53
#define EN_S53 1
#endif
#ifndef EN_SSD3
#define EN_SSD3 1
#endif
#ifndef R_GWIN
#define R_GWIN 1
#endif
#ifndef R_GLU
#define R_GLU 1
#endif
#ifndef R_GP
#define R_GP 1
#endif
#ifndef R_GGATE
#define R_GGATE 1
#endif
#ifndef R_DENSE
#define R_DENSE 1
#endif
#ifndef R_MOE
#define R_MOE 1
#endif
#ifndef R_DSA
#define R_DSA 1
#endif
#ifndef R_MIX
#define R_MIX 1
#endif
#ifndef R_MISC
#define R_MISC 1
#endif
#ifndef MK_PER_PHASE
#define MK_PER_PHASE 0
#endif

#ifndef EN_PROLOGUE
#define EN_PROLOGUE 1
#endif
#ifndef EN_WCONV
#define EN_WCONV 1
#endif
#ifndef EN_GWIN
#define EN_GWIN 1
#endif
#ifndef EN_MX1
#define EN_MX1 1
#endif
#ifndef EN_MX2
#define EN_MX2 1
#endif
#ifndef EN_GLU
#define EN_GLU 1
#endif
#ifndef EN_GP
#define EN_GP 1
#endif
#ifndef EN_GGATE
#define EN_GGATE 1
#endif
#ifndef EN_GOUT
#define EN_GOUT 1
#endif
#ifndef EN_LN1
#define EN_LN1 1
#endif
#ifndef EN_FILL
#define EN_FILL 1
#endif
#ifndef EN_MOE1
#define EN_MOE1 1
#endif
#ifndef EN_MOE2
#define EN_MOE2 1
#endif
#ifndef EN_FIN
#define EN_FIN 1
#endif
#ifndef G_ALIGN
#define G_ALIGN true
#endif
#ifndef G_SP2
#define G_SP2 true
#endif
#define LAS __attribute__((address_space(3)))
#define GAS __attribute__((address_space(1)))
typedef unsigned short bf16_t;
typedef short bf16x8 __attribute__((ext_vector_type(8)));
typedef float f32x4 __attribute__((ext_vector_type(4)));
typedef float f32x2 __attribute__((ext_vector_type(2)));
typedef unsigned u32x4 __attribute__((ext_vector_type(4)));
typedef unsigned u32x2 __attribute__((ext_vector_type(2)));

constexpr int NB = 4, SEQ = 8192, M = NB * SEQ, D = 1024, DEPTH = 2;
constexpr int PJ = 2304;
constexpr int C_GU = 0, C_GV = 256, C_Q = 512, C_K = 768, C_V = 832, C_QI = 896, C_KI = 1152, C_S5 = 1216, C_Z = 1472, C_XBC = 1728, C_WI = 2240, C_DT = 2244;
constexpr int D_IN = 2248;
constexpr int NEXP = 32, NE1 = 33;
constexpr int NCH = 4, CHTOK = M / NCH;
constexpr int CH_ROWS = CHTOK * 8 + CHTOK + NE1 * 256;
constexpr float DN_ALPHA = 1.41421356237f;
constexpr float LN_EPS = 1e-5f, RMS_EPS = 1e-6f;
#ifndef PFP8
#define PFP8 1
#endif
constexpr float P_SCALE = 8.0f, O_SCALE = 32.0f;

constexpr size_t MiB = 1u << 20;
constexpr size_t WS_CTL = 0, CTL_BYTES = 1 * MiB;
constexpr size_t WS_MODV = 1 * MiB;
constexpr size_t WS_S5B = WS_MODV + 256 * 1024;
constexpr size_t WS_S5C = WS_S5B + 64 * 1024;
constexpr size_t WS_S5A = WS_S5C + 64 * 1024;
constexpr size_t WS_GMW = WS_S5A + 64 * 1024;
constexpr size_t WS_RFR = WS_GMW + 128 * 1024;
static_assert(WS_RFR + 128 * 1024 <= 2 * MiB, "misc tables");
constexpr size_t WS_S5ST = 2 * MiB;
constexpr size_t WS_ATOT = 3 * MiB;
constexpr size_t WS_WGBASE = 3 * MiB + 64 * 1024;
constexpr size_t WS_PINFO = 4 * MiB;
constexpr size_t WS_PGATE = 5 * MiB;
constexpr size_t WS_SLOT = 6 * MiB;
constexpr size_t WS_ROWTOK = 7 * MiB;
constexpr size_t WS_ROWGATE = 9 * MiB;
constexpr size_t WS_S5HIN = 11 * MiB;
constexpr size_t WS_ROPE = 12 * MiB;
constexpr size_t WS_W = 24 * MiB;
constexpr size_t WO_IN = 0, WO_GATE = WO_IN + (size_t)PJ * 1024 * 2, WO_BR = WO_GATE + (size_t)4096 * 1024 * 2, WO_OUT = WO_BR + (size_t)4 * 1024 * 256 * 2,
                 WO_GLU = WO_OUT + (size_t)1024 * 1024 * 2, WO_13 = WO_GLU + (size_t)256 * 256 * 2, WO_2 = WO_13 + (size_t)NE1 * 512 * 1024 * 2, WO_END = WO_2 + (size_t)NE1 * 1024 * 256 * 2;
static_assert(WO_END <= 72 * MiB, "weights region");
constexpr size_t WS_H = 96 * MiB;
constexpr size_t WS_Y = 160 * MiB;
constexpr size_t WS_PROJ = 224 * MiB;
constexpr size_t WS_P = 224 * MiB;
constexpr size_t WS_SSDST = 368 * MiB;
constexpr size_t WS_SSDSIN = 400 * MiB;
constexpr size_t WS_KI2 = 408 * MiB, WS_K2 = 412 * MiB, WS_V2 = 416 * MiB;
constexpr size_t WS_YCPRE = 384 * MiB;
constexpr size_t WS_V16 = 224 * MiB;
constexpr size_t WS_ACT = 160 * MiB;
constexpr size_t WS_OPAIR = 321 * MiB;
static_assert(CH_ROWS % 256 == 0 && WS_ACT + (size_t)NCH * CH_ROWS * 512 <= WS_OPAIR && WS_OPAIR + (size_t)2 * CH_ROWS * 1024 <= 512 * MiB, "moe buffers");
constexpr int CH_TILES = CH_ROWS / 256;
constexpr size_t WS_NEED = 512 * MiB;
constexpr int CW_BAR = 4096;
constexpr int CW_CNT = 16384;

constexpr int LDS_BYTES = 160 * 1024;
constexpr int LDS_TAB = 131072;
constexpr int LDS_MISC = LDS_BYTES - 256;

__device__ __forceinline__ unsigned f2bf(float f) { unsigned u = __builtin_bit_cast(unsigned, f); return (u + 0x7fffu + ((u >> 16) & 1u)) >> 16; }
__device__ __forceinline__ unsigned pk2(float lo, float hi) { return f2bf(lo) | (f2bf(hi) << 16); }
__device__ __forceinline__ float bf2f(unsigned short b) { return __builtin_bit_cast(float, (unsigned)b << 16); }
__device__ __forceinline__ float bflo(unsigned w) { return __builtin_bit_cast(float, w << 16); }
__device__ __forceinline__ float bfhi(unsigned w) { return __builtin_bit_cast(float, w & 0xffff0000u); }
__device__ __forceinline__ float wave_sum(float v) {
#pragma unroll
    for (int o = 1; o < 64; o <<= 1) v += __shfl_xor(v, o);
    return v;
}
__device__ __forceinline__ float wave_max(float v) {
#pragma unroll
    for (int o = 1; o < 64; o <<= 1) v = fmaxf(v, __shfl_xor(v, o));
    return v;
}
__device__ __forceinline__ int wave_sum_i(int v) {
#pragma unroll
    for (int o = 1; o < 64; o <<= 1) v += __shfl_xor(v, o);
    return v;
}
__device__ __forceinline__ float sigmoidf_(float x) { return __builtin_amdgcn_rcpf(1.0f + __expf(-x)); }
__device__ __forceinline__ float siluf_(float x) { return x * __builtin_amdgcn_rcpf(1.0f + __expf(-x)); }
__device__ __forceinline__ float gelu_tanh(float x) { const float u = 1.5957691216057308f * (x + 0.044715f * x * x * x); return x * __builtin_amdgcn_rcpf(1.0f + __expf(-u)); }
__device__ __forceinline__ float softplusf_(float x) { return fmaxf(x, 0.f) + log1pf(__expf(-fabsf(x))); }
__device__ __forceinline__ void sincos_red(float ang, float& sn, float& cs) {
    const double a = (double)ang; const double q = __builtin_rint(a * 0.63661977236758134308);
    const float r = (float)(a - q * 1.57079632679489661923); const int qi = (int)q & 3;
    const float r2 = r * r;
    const float s = r * (1.0f + r2 * (-1.6666667e-1f + r2 * (8.3333333e-3f + r2 * (-1.9841270e-4f + r2 * 2.7557319e-6f))));
    const float c = 1.0f + r2 * (-0.5f + r2 * (4.1666667e-2f + r2 * (-1.3888889e-3f + r2 * (2.4801587e-5f + r2 * -2.7557319e-7f))));
    sn = (qi == 0) ? s : (qi == 1) ? c : (qi == 2) ? -s : -c;
    cs = (qi == 0) ? c : (qi == 1) ? -s : (qi == 2) ? -c : s;
}
__device__ __forceinline__ f32x4 mfma16(bf16x8 a, bf16x8 b, f32x4 c) { return __builtin_amdgcn_mfma_f32_16x16x32_bf16(a, b, c, 0, 0, 0); }
__device__ __forceinline__ unsigned cvt_pk_bf16(float lo, float hi) { unsigned r; asm volatile("v_cvt_pk_bf16_f32 %0, %1, %2" : "=v"(r) : "v"(lo), "v"(hi)); return r; }

namespace pg8 {
constexpr int BM = 256, BK = 64, HALF = 128, HTB = HALF * BK * 2, STAGE_BYTES = 8 * HTB, NXCD = 8, WGM = 8;
__host__ __device__ __forceinline__ int lds_byte(int r, int c) { const int st = (r >> 4) * 2 + (c >> 5), rr = r & 15, cc = c & 31, ob = rr * 64 + cc * 2; return st * 1024 + (ob ^ (((ob >> 9) & 1) << 5)); }
__host__ __device__ __forceinline__ void stage_rc(int b, int& R, int& C) { const int st = b / 1024, sb = b % 1024, swz = sb ^ (((sb >> 9) & 1) << 5); R = (st >> 1) * 16 + swz / 64; C = (st & 1) * 32 + (swz % 64) / 2; }
__host__ __device__ __forceinline__ int perm32(int rho) { const int n = rho >> 4, i = rho & 15; return 8 * (i >> 2) + 4 * n + (i & 3); }

struct Unit { int pm, pn, bt, ab; };
struct Gemm { const bf16_t* A; const bf16_t* Bt; int K; size_t a_sel_stride; };

__device__ __forceinline__ int xcd_remap(int wgid, int nwg) { const int q = nwg / NXCD, r = nwg % NXCD, xcd = wgid % NXCD, off = wgid / NXCD; return (xcd < r ? xcd * (q + 1) : r * (q + 1) + (xcd - r) * q) + off; }

struct StaticOrder {
    static constexpr bool GATHER = false;
    int nM, nN, nwg, G, c;
    __device__ void init(int Mr, int N, int G_, int c_) { nM = Mr / BM; nN = N / BM; nwg = nM * nN; G = G_; c = c_; }
    __device__ __forceinline__ bool next(int i, Unit& u) const {
        const long L = (long)i * G + c; if (L >= nwg) return false;
        const int wgid = xcd_remap((int)L, nwg);
        const int nig = WGM * nN, gid = wgid / nig, fm = gid * WGM, gsz = (nM - fm) < WGM ? (nM - fm) : WGM;
        u.pm = fm + ((wgid % nig) % gsz); u.pn = (wgid % nig) / gsz; u.bt = u.pn; u.ab = 0; return true;
    }
    __device__ __forceinline__ void a_ready(const Unit&) const {}
    __device__ __forceinline__ void done(const Unit&) const {}
};

template <class Epi, class Sched, bool ALIGN_EPI = false, bool SP2 = true>
__device__ __forceinline__ void gemm_phase(LAS unsigned char* lds, const Gemm g, const Sched& S, const Epi& E, const int tid) {
    const int wid = __builtin_amdgcn_readfirstlane(tid >> 6), lane = tid & 63, wr = wid >> 2, wc = wid & 3, fr = lane & 15, fq = lane >> 4;
    const int K = g.K, nt = K / BK;
    unsigned voffA[2], voffB[2];
#pragma unroll
    for (int i = 0; i < 2; ++i) { int R, C; stage_rc(tid * 16 + i * 8192, R, C); const int Rb = Epi::PERM ? ((R & ~31) + perm32(R & 31)) : R;
        voffA[i] = (unsigned)(R * K + C) * 2u; voffB[i] = (unsigned)(Rb * K + C) * 2u; }
    const size_t kstep = (size_t)(BK * 2);
    const size_t hstep = (size_t)HALF * K * 2;
    const size_t tstep = 2 * hstep;
    const unsigned ldsw = (unsigned)wid * 1024u;
    const int aoff = lds_byte(wr * 64 + fr, fq * 8), boff = lds_byte(wc * 32 + fr, fq * 8);
#define PG8_SA(b, h) (((b) * 2 + (h)) * HTB)
#define PG8_SB(b, h) ((4 + (b) * 2 + (h)) * HTB)
#define PG8_STAGE(bufoff, gbase, voff) do { _Pragma("unroll") for (int _i = 0; _i < 2; ++_i) \
        __builtin_amdgcn_global_load_lds((const unsigned*)((const char*)(gbase) + (voff)[_i]), (LAS unsigned*)(lds + (bufoff) + ldsw + _i * 8192), 16, 0, 0); } while (0)
#define PG8_GO(u) do { _Pragma("unroll") for (int _h = 0; _h < 2; ++_h) _Pragma("unroll") for (int _i = 0; _i < 2; ++_i) { int _R, _C; stage_rc(tid * 16 + _i * 8192, _R, _C); \
        cgo[_h][_i] = (unsigned)S.row_of(u, _h * HALF + _R) * (unsigned)(K * 2) + (unsigned)_C * 2u; } } while (0)
#define PG8_STAGE_A(bufoff, base, h, kb, NX) do { if constexpr (Sched::GATHER) { _Pragma("unroll") for (int _i = 0; _i < 2; ++_i) \
        __builtin_amdgcn_global_load_lds((const unsigned*)((const char*)g.A + (kb) + cgo[h][_i]), (LAS unsigned*)(lds + (bufoff) + ldsw + _i * 8192), 16, 0, 0); } \
        else { PG8_STAGE(bufoff, (base) + (size_t)(h) * hstep + (kb), voffA); } } while (0)
#define PG8_LDA(dst, b, h) do { _Pragma("unroll") for (int m = 0; m < 4; ++m) _Pragma("unroll") for (int k = 0; k < 2; ++k) dst[m][k] = *(const LAS bf16x8*)(lds + PG8_SA(b, h) + aoff + m * 2048 + k * 1024); } while (0)
#define PG8_LDB(dst, b, h) do { _Pragma("unroll") for (int n = 0; n < 2; ++n) _Pragma("unroll") for (int k = 0; k < 2; ++k) dst[n][k] = *(const LAS bf16x8*)(lds + PG8_SB(b, h) + boff + n * 2048 + k * 1024); } while (0)
#define PG8_MMA(ai, bj, At, Bt) do { __builtin_amdgcn_s_setprio(1); _Pragma("unroll") for (int m = 0; m < 4; ++m) _Pragma("unroll") for (int n = 0; n < 2; ++n) _Pragma("unroll") for (int k = 0; k < 2; ++k) \
        acc[ai][bj][m][n] = __builtin_amdgcn_mfma_f32_16x16x32_bf16(Bt[n][k], At[m][k], acc[ai][bj][m][n], 0, 0, 0); __builtin_amdgcn_s_setprio(0); } while (0)
#define PG8_WAIT_V(n) asm volatile("s_waitcnt vmcnt(" #n ")" ::: "memory")
#define PG8_WAIT_L(n) asm volatile("s_waitcnt lgkmcnt(" #n ")" ::: "memory")
#define PG8_BAR __builtin_amdgcn_s_barrier()
#define PG8_SCHED __builtin_amdgcn_sched_barrier(0)
    Unit cur, nxt; int ui = 0;
    if (!S.next(0, cur)) return;
    f32x4 acc[2][2][4][2];
#pragma unroll
    for (int a = 0; a < 2; ++a)
#pragma unroll
        for (int b = 0; b < 2; ++b)
#pragma unroll
            for (int m = 0; m < 4; ++m)
#pragma unroll
                for (int n = 0; n < 2; ++n) acc[a][b][m][n] = (f32x4){0.f, 0.f, 0.f, 0.f};
    bf16x8 At[4][2], B0[2][2], B1[2][2];
    unsigned cgo[2][2];
    if constexpr (Sched::GATHER) PG8_GO(cur);
    const char* cA = (const char*)(g.A + (size_t)cur.ab * g.a_sel_stride) + (size_t)cur.pm * tstep; const char* cB = (const char*)g.Bt + (size_t)cur.bt * tstep;
    S.a_ready(cur);
    if constexpr (SP2) {
        PG8_STAGE(PG8_SB(0, 0), cB, voffB); PG8_STAGE(PG8_SB(0, 1), cB + hstep, voffB); PG8_STAGE_A(PG8_SA(0, 0), cA, 0, (size_t)0, false); PG8_STAGE_A(PG8_SA(0, 1), cA, 1, (size_t)0, false);
        if (wr == 1) PG8_BAR;
        PG8_WAIT_V(2); PG8_BAR;
        PG8_STAGE(PG8_SB(1, 0), cB + kstep, voffB); PG8_STAGE_A(PG8_SA(1, 0), cA, 0, kstep, false); PG8_STAGE(PG8_SB(1, 1), cB + hstep + kstep, voffB);
        PG8_WAIT_V(6); PG8_BAR;
    } else {
        PG8_STAGE(PG8_SB(0, 0), cB, voffB); PG8_STAGE_A(PG8_SA(0, 0), cA, 0, (size_t)0, false); PG8_STAGE(PG8_SB(0, 1), cB + hstep, voffB); PG8_STAGE_A(PG8_SA(0, 1), cA, 1, (size_t)0, false);
        if (wr == 1) PG8_BAR;
        PG8_WAIT_V(4); PG8_BAR;
        PG8_STAGE(PG8_SB(1, 0), cB + kstep, voffB); PG8_STAGE_A(PG8_SA(1, 0), cA, 0, kstep, false); PG8_STAGE(PG8_SB(1, 1), cB + hstep + kstep, voffB);
        PG8_WAIT_V(6); PG8_BAR;
    }
    for (;;) {
        const bool has_next = S.next(ui + 1, nxt);
        const char* nA = has_next ? (const char*)(g.A + (size_t)nxt.ab * g.a_sel_stride) + (size_t)nxt.pm * tstep : cA; const char* nB = has_next ? (const char*)g.Bt + (size_t)nxt.bt * tstep : cB;
#pragma nounroll
        for (int t = 0; t < nt; t += 2) {
            const bool last = (t == nt - 2);
            const size_t k1 = (size_t)(t + 1) * kstep;
            const char* a2b = last ? nA : cA; const size_t k2 = last ? (size_t)0 : (size_t)(t + 2) * kstep; const size_t k3 = k2 + kstep;
            const char* b2 = last ? nB : cB + (size_t)(t + 2) * kstep; const char* b3 = b2 + kstep;
            if (last && has_next) S.a_ready(nxt);
            if constexpr (SP2) {
            PG8_LDB(B0, 0, 0); PG8_LDB(B1, 0, 1); PG8_SCHED; PG8_LDA(At, 0, 0); PG8_STAGE_A(PG8_SA(1, 1), cA, 1, k1, false);
            if constexpr (Sched::GATHER) { if (last && has_next) PG8_GO(nxt); }
            PG8_WAIT_V(8); PG8_WAIT_L(0); PG8_BAR; PG8_MMA(0, 0, At, B0); PG8_MMA(0, 1, At, B1); PG8_BAR; PG8_SCHED;
            PG8_LDA(At, 0, 1); PG8_STAGE(PG8_SB(0, 0), b2, voffB); PG8_STAGE(PG8_SB(0, 1), b2 + hstep, voffB); PG8_STAGE_A(PG8_SA(0, 0), a2b, 0, k2, last);
            PG8_WAIT_V(8); PG8_WAIT_L(0); PG8_BAR; PG8_MMA(1, 0, At, B0); PG8_MMA(1, 1, At, B1); PG8_BAR; PG8_SCHED;
            PG8_LDB(B0, 1, 0); PG8_LDB(B1, 1, 1); PG8_SCHED; PG8_LDA(At, 1, 0); PG8_STAGE_A(PG8_SA(0, 1), a2b, 1, k2, last);
            PG8_WAIT_V(8); PG8_WAIT_L(0); PG8_BAR; PG8_MMA(0, 0, At, B0); PG8_MMA(0, 1, At, B1); PG8_BAR; PG8_SCHED;
            PG8_LDA(At, 1, 1); PG8_STAGE(PG8_SB(1, 0), b3, voffB); PG8_STAGE(PG8_SB(1, 1), b3 + hstep, voffB); PG8_STAGE_A(PG8_SA(1, 0), a2b, 0, k3, last);
            PG8_WAIT_V(8); PG8_WAIT_L(0); PG8_BAR; PG8_MMA(1, 0, At, B0); PG8_MMA(1, 1, At, B1); PG8_BAR; PG8_SCHED;
            } else {
            PG8_LDB(B0, 0, 0); PG8_SCHED; PG8_LDA(At, 0, 0); PG8_STAGE_A(PG8_SA(1, 1), cA, 1, k1, false);
            if constexpr (Sched::GATHER) { if (last && has_next) PG8_GO(nxt); }
            PG8_WAIT_L(8); PG8_BAR; PG8_WAIT_L(0); PG8_MMA(0, 0, At, B0); PG8_BAR; PG8_SCHED;
            PG8_LDB(B1, 0, 1); PG8_STAGE(PG8_SB(0, 0), b2, voffB);
            PG8_BAR; PG8_WAIT_L(0); PG8_MMA(0, 1, At, B1); PG8_BAR;
            PG8_LDA(At, 0, 1); PG8_STAGE_A(PG8_SA(0, 0), a2b, 0, k2, last);
            PG8_BAR; PG8_WAIT_L(0); PG8_MMA(1, 0, At, B0); PG8_BAR; PG8_SCHED;
            PG8_STAGE(PG8_SB(0, 1), b2 + hstep, voffB);
            PG8_WAIT_V(6); PG8_BAR; PG8_MMA(1, 1, At, B1); PG8_BAR;
            PG8_LDB(B0, 1, 0); PG8_SCHED; PG8_LDA(At, 1, 0); PG8_STAGE_A(PG8_SA(0, 1), a2b, 1, k2, last);
            PG8_WAIT_L(8); PG8_BAR; PG8_WAIT_L(0); PG8_MMA(0, 0, At, B0); PG8_BAR; PG8_SCHED;
            PG8_LDB(B1, 1, 1); PG8_STAGE(PG8_SB(1, 0), b3, voffB);
            PG8_BAR; PG8_WAIT_L(0); PG8_MMA(0, 1, At, B1); PG8_BAR;
            PG8_LDA(At, 1, 1); PG8_STAGE_A(PG8_SA(1, 0), a2b, 0, k3, last);
            PG8_BAR; PG8_WAIT_L(0); PG8_MMA(1, 0, At, B0); PG8_BAR; PG8_SCHED;
            PG8_STAGE(PG8_SB(1, 1), b3 + hstep, voffB);
            PG8_WAIT_V(6); PG8_BAR; PG8_MMA(1, 1, At, B1); PG8_BAR;
            }
        }
        if constexpr (ALIGN_EPI) { if (wr == 0) PG8_BAR; }
        E(acc, cur, wr, wc, fr, fq); S.done(cur);
        if (!has_next) break;
#pragma unroll
        for (int a = 0; a < 2; ++a)
#pragma unroll
            for (int b = 0; b < 2; ++b)
#pragma unroll
                for (int m = 0; m < 4; ++m)
#pragma unroll
                    for (int n = 0; n < 2; ++n) acc[a][b][m][n] = (f32x4){0.f, 0.f, 0.f, 0.f};
        cur = nxt; cA = nA; cB = nB; ++ui;
        if constexpr (ALIGN_EPI) { if (wr == 1) PG8_BAR; }
    }
    PG8_WAIT_V(0);
    if constexpr (!ALIGN_EPI) { if (wr == 0) PG8_BAR; }
    PG8_BAR;
#undef PG8_SA
#undef PG8_SB
#undef PG8_STAGE
#undef PG8_STAGE_A
#undef PG8_GO
#undef PG8_LDA
#undef PG8_LDB
#undef PG8_MMA
#undef PG8_WAIT_V
#undef PG8_WAIT_L
#undef PG8_BAR
#undef PG8_SCHED
}

struct EpiBf16 {
    static constexpr bool PERM = true;
    bf16_t* O; int ldc;
    __device__ __forceinline__ void operator()(const f32x4 (&acc)[2][2][4][2], const Unit& u, int wr, int wc, int fr, int fq) const {
        const int row0 = u.pm * BM + wr * 64 + fr, col0 = u.pn * BM + wc * 32 + 8 * fq;
#pragma unroll
        for (int ai = 0; ai < 2; ++ai)
#pragma unroll
            for (int m = 0; m < 4; ++m) { bf16_t* rowp = O + (size_t)(row0 + ai * HALF + m * 16) * ldc + col0;
#pragma unroll
                for (int bj = 0; bj < 2; ++bj) { const f32x4 v0 = acc[ai][bj][m][0], v1 = acc[ai][bj][m][1];
                    u32x4 w; w.x = cvt_pk_bf16(v0[0], v0[1]); w.y = cvt_pk_bf16(v0[2], v0[3]); w.z = cvt_pk_bf16(v1[0], v1[1]); w.w = cvt_pk_bf16(v1[2], v1[3]);
                    *(u32x4*)(rowp + bj * HALF) = w; } }
    }
};
__device__ __forceinline__ unsigned pk4_fp8(float a, float b, float c, float d) { int w = 0; w = __builtin_amdgcn_cvt_pk_fp8_f32(a, b, w, false); w = __builtin_amdgcn_cvt_pk_fp8_f32(c, d, w, true); return (unsigned)w; }
__device__ __forceinline__ f32x4 clamp_fp8(f32x4 v, float sc) { f32x4 r; r[0] = __builtin_amdgcn_fmed3f(v[0] * sc, -440.f, 440.f); r[1] = __builtin_amdgcn_fmed3f(v[1] * sc, -440.f, 440.f);
    r[2] = __builtin_amdgcn_fmed3f(v[2] * sc, -440.f, 440.f); r[3] = __builtin_amdgcn_fmed3f(v[3] * sc, -440.f, 440.f); return r; }
struct EpiFp8 {
    static constexpr bool PERM = true;
    unsigned char* O; int ldc; float scale;
    __device__ __forceinline__ void operator()(const f32x4 (&acc)[2][2][4][2], const Unit& u, int wr, int wc, int fr, int fq) const {
        const int row0 = u.pm * BM + wr * 64 + fr, col0 = u.pn * BM + wc * 32 + 8 * fq;
#pragma unroll
        for (int ai = 0; ai < 2; ++ai)
#pragma unroll
            for (int m = 0; m < 4; ++m) { unsigned char* rowp = O + (size_t)(row0 + ai * HALF + m * 16) * ldc + col0;
#pragma unroll
                for (int bj = 0; bj < 2; ++bj) { const f32x4 v0 = clamp_fp8(acc[ai][bj][m][0], scale), v1 = clamp_fp8(acc[ai][bj][m][1], scale);
                    u32x2 w; w.x = pk4_fp8(v0[0], v0[1], v0[2], v0[3]); w.y = pk4_fp8(v1[0], v1[1], v1[2], v1[3]);
                    *(u32x2*)(rowp + bj * HALF) = w; } }
    }
};
struct EpiGlu {
    static constexpr bool PERM = true;
    const bf16_t* Ysrc; bf16_t* O; const float* bias;
    __device__ __forceinline__ void operator()(const f32x4 (&acc)[2][2][4][2], const Unit& u, int wr, int wc, int fr, int fq) const {
        const int row0 = u.pm * BM + wr * 64 + fr, col0 = u.pn * BM + wc * 32 + 8 * fq;
#pragma unroll
        for (int ai = 0; ai < 2; ++ai)
#pragma unroll
            for (int m = 0; m < 4; ++m) { const size_t ro = (size_t)(row0 + ai * HALF + m * 16) * 256 + col0;
#pragma unroll
                for (int bj = 0; bj < 2; ++bj) { const f32x4 v0 = acc[ai][bj][m][0], v1 = acc[ai][bj][m][1];
                    const u32x4 yv = *(const u32x4*)(Ysrc + ro + bj * HALF);
                    const f32x4 b0 = *(const f32x4*)(bias + col0 + bj * HALF), b1 = *(const f32x4*)(bias + col0 + bj * HALF + 4);
                    float o[8];
                    o[0] = bflo(yv.x) * sigmoidf_(v0[0] + b0[0]); o[1] = bfhi(yv.x) * sigmoidf_(v0[1] + b0[1]); o[2] = bflo(yv.y) * sigmoidf_(v0[2] + b0[2]); o[3] = bfhi(yv.y) * sigmoidf_(v0[3] + b0[3]);
                    o[4] = bflo(yv.z) * sigmoidf_(v1[0] + b1[0]); o[5] = bfhi(yv.z) * sigmoidf_(v1[1] + b1[1]); o[6] = bflo(yv.w) * sigmoidf_(v1[2] + b1[2]); o[7] = bfhi(yv.w) * sigmoidf_(v1[3] + b1[3]);
                    u32x4 w; w.x = cvt_pk_bf16(o[0], o[1]); w.y = cvt_pk_bf16(o[2], o[3]); w.z = cvt_pk_bf16(o[4], o[5]); w.w = cvt_pk_bf16(o[6], o[7]);
                    *(u32x4*)(O + ro + bj * HALF) = w; } }
    }
};
struct EpiGateMerge {
    static constexpr bool PERM = true;
    const unsigned char* P; bf16_t* Mg; float pinv;
    __device__ __forceinline__ void operator()(const f32x4 (&acc)[2][2][4][2], const Unit& u, int wr, int wc, int fr, int fq) const {
        const int i = u.pn >> 2, mt = u.pn & 3;
        const int row0 = u.pm * BM + wr * 64 + fr, col0 = mt * BM + wc * 32 + 8 * fq;
#pragma unroll
        for (int ai = 0; ai < 2; ++ai) {
            u32x2 pv[4][2]; u32x4 pvb[4][2]; u32x4 mv[4][2];
#pragma unroll
            for (int m = 0; m < 4; ++m)
#pragma unroll
                for (int bj = 0; bj < 2; ++bj) { const size_t r = (size_t)(row0 + ai * HALF + m * 16);
                    pv[m][bj] = PFP8 ? *(const u32x2*)(P + r * 4096 + i * 1024 + col0 + bj * HALF) : (u32x2){0u, 0u}; if (!PFP8) pvb[m][bj] = *(const u32x4*)((const bf16_t*)P + r * 4096 + i * 1024 + col0 + bj * HALF);
                    mv[m][bj] = (u32x4){0u, 0u, 0u, 0u}; if (i > 0) mv[m][bj] = *(const u32x4*)(Mg + r * 1024 + col0 + bj * HALF); }
#pragma unroll
            for (int m = 0; m < 4; ++m)
#pragma unroll
                for (int bj = 0; bj < 2; ++bj) { const size_t r = (size_t)(row0 + ai * HALF + m * 16); const f32x4 v0 = acc[ai][bj][m][0], v1 = acc[ai][bj][m][1]; const u32x2 p8 = pv[m][bj]; const u32x4 m4 = mv[m][bj];
                    f32x2 pa = __builtin_amdgcn_cvt_pk_f32_fp8((int)p8.x, false) * pinv, pb = __builtin_amdgcn_cvt_pk_f32_fp8((int)p8.x, true) * pinv,
                          pc = __builtin_amdgcn_cvt_pk_f32_fp8((int)p8.y, false) * pinv, pd = __builtin_amdgcn_cvt_pk_f32_fp8((int)p8.y, true) * pinv;
                    if (!PFP8) { const u32x4 q4 = pvb[m][bj]; pa = (f32x2){bflo(q4.x), bfhi(q4.x)}; pb = (f32x2){bflo(q4.y), bfhi(q4.y)}; pc = (f32x2){bflo(q4.z), bfhi(q4.z)}; pd = (f32x2){bflo(q4.w), bfhi(q4.w)}; }
                    float o[8];
                    o[0] = bflo(m4.x) + pa[0] * sigmoidf_(v0[0]); o[1] = bfhi(m4.x) + pa[1] * sigmoidf_(v0[1]); o[2] = bflo(m4.y) + pb[0] * sigmoidf_(v0[2]); o[3] = bfhi(m4.y) + pb[1] * sigmoidf_(v0[3]);
                    o[4] = bflo(m4.z) + pc[0] * sigmoidf_(v1[0]); o[5] = bfhi(m4.z) + pc[1] * sigmoidf_(v1[1]); o[6] = bflo(m4.w) + pd[0] * sigmoidf_(v1[2]); o[7] = bfhi(m4.w) + pd[1] * sigmoidf_(v1[3]);
                    u32x4 w; w.x = cvt_pk_bf16(o[0], o[1]); w.y = cvt_pk_bf16(o[2], o[3]); w.z = cvt_pk_bf16(o[4], o[5]); w.w = cvt_pk_bf16(o[6], o[7]);
                    *(u32x4*)(Mg + r * 1024 + col0 + bj * HALF) = w; }
        }
    }
};
struct EpiResid {
    static constexpr bool PERM = false;
    const float* xin; bf16_t* out; const float* gate;
    __device__ __forceinline__ void operator()(const f32x4 (&acc)[2][2][4][2], const Unit& u, int wr, int wc, int fr, int fq) const {
        const int row0 = u.pm * BM + wr * 64 + fr, col0 = u.pn * BM + wc * 32 + 4 * fq;
        const int b = (u.pm * BM) / SEQ;
        f32x4 gv[2][2];
#pragma unroll
        for (int bj = 0; bj < 2; ++bj)
#pragma unroll
            for (int n = 0; n < 2; ++n) gv[bj][n] = *(const f32x4*)(gate + b * 3072 + 2048 + col0 + bj * HALF + n * 16) + 1.0f;
#pragma unroll
        for (int ai = 0; ai < 2; ++ai)
#pragma unroll
            for (int mh = 0; mh < 4; mh += 2) {
                f32x4 xv[2][2][2];
#pragma unroll
                for (int m = 0; m < 2; ++m)
#pragma unroll
                    for (int bj = 0; bj < 2; ++bj)
#pragma unroll
                        for (int n = 0; n < 2; ++n) xv[m][bj][n] = *(const f32x4*)(xin + (size_t)(row0 + ai * HALF + (mh + m) * 16) * D + col0 + bj * HALF + n * 16);
#pragma unroll
                for (int m = 0; m < 2; ++m)
#pragma unroll
                    for (int bj = 0; bj < 2; ++bj)
#pragma unroll
                        for (int n = 0; n < 2; ++n) { const f32x4 v = xv[m][bj][n] * DN_ALPHA + gv[bj][n] * acc[ai][bj][mh + m][n];
                            u32x2 w; w.x = cvt_pk_bf16(v[0], v[1]); w.y = cvt_pk_bf16(v[2], v[3]);
                            *(u32x2*)(out + (size_t)(row0 + ai * HALF + (mh + m) * 16) * D + col0 + bj * HALF + n * 16) = w; } }
    }
};
struct EpiMoe1 {
    static constexpr bool PERM = false;
    bf16_t* Act; const LAS float* gtab;
    __device__ __forceinline__ void operator()(const f32x4 (&acc)[2][2][4][2], const Unit& u, int wr, int wc, int fr, int fq) const {
        const int row0 = u.pm * BM + wr * 64 + fr, f0 = u.pn * 128 + wc * 16 + 4 * fq;
#pragma unroll
        for (int ai = 0; ai < 2; ++ai)
#pragma unroll
            for (int m = 0; m < 4; ++m) { const int r = row0 + ai * HALF + m * 16; const float gt = gtab[u.ab * 256 + wr * 64 + fr + ai * HALF + m * 16];
#pragma unroll
                for (int bj = 0; bj < 2; ++bj) { const f32x4 a = acc[ai][bj][m][0], b = acc[ai][bj][m][1];
                    u32x2 w; w.x = cvt_pk_bf16(siluf_(a[0]) * b[0] * gt, siluf_(a[1]) * b[1] * gt); w.y = cvt_pk_bf16(siluf_(a[2]) * b[2] * gt, siluf_(a[3]) * b[3] * gt);
                    *(u32x2*)(Act + (size_t)r * 256 + f0 + bj * 64) = w; } }
    }
};
}

#define XB_TMO      128
#define XB_XCNT(j)  (256  + 64 * (j))
#define XB_XSUB(j)  (1280 + 64 * (j))
#define XB_XGEN(j)  (2304 + 64 * (j))
#define XB_TOP      3328
#define XB_TOPGEN   3392
#define XCD_BAR_WORDS 3456
#define XB_SPIN_CAP (1u << 22)
__device__ __forceinline__ unsigned xb_ld(unsigned* p)              { return __hip_atomic_load(p, __ATOMIC_RELAXED, __HIP_MEMORY_SCOPE_AGENT); }
__device__ __forceinline__ unsigned xb_add(unsigned* p, unsigned v) { return __hip_atomic_fetch_add(p, v, __ATOMIC_RELAXED, __HIP_MEMORY_SCOPE_AGENT); }
__device__ __forceinline__ unsigned xb_xcc_id() { return (unsigned)__builtin_amdgcn_s_getreg((3 << 11) | 20) & 0xFu; }
#define XB_SPIN(cond, bar) do { unsigned _sp = 0; while (cond) { __builtin_amdgcn_s_sleep(1); \
    if ((++_sp & 255u) == 0u) { if (xb_ld(&(bar)[XB_TMO])) break; if (_sp > XB_SPIN_CAP) { atomicAdd(&(bar)[XB_TMO], 1u); break; } } } } while (0)
struct XcdBarrier { unsigned* bar; unsigned x; volatile LAS unsigned* st; };
__device__ __forceinline__ XcdBarrier xcd_barrier_post(unsigned* bar, volatile LAS unsigned* st) {
    XcdBarrier b; b.bar = bar; b.x = xb_xcc_id(); b.st = st;
    if (threadIdx.x == 0) (void)xb_add(&bar[XB_XCNT(b.x)], 1u);
    return b;
}
__device__ __forceinline__ void xcd_barrier_complete(unsigned* bar, unsigned x, unsigned& nloc, unsigned& nx) {
    const unsigned G = gridDim.x * gridDim.y * gridDim.z;
    unsigned sum, cnt, mine, sp = 0u;
    for (;;) {
        sum = 0u; cnt = 0u; mine = 0u;
#pragma unroll
        for (unsigned j = 0; j < 16; ++j) { const unsigned c = xb_ld(&bar[XB_XCNT(j)]); sum += c; cnt += (c > 0u) ? 1u : 0u; mine = (j == x) ? c : mine; }
        if (sum == G) break;
        __builtin_amdgcn_s_sleep(1);
        if ((++sp & 255u) == 0u) { if (xb_ld(&bar[XB_TMO])) break; if (sp > XB_SPIN_CAP) { atomicAdd(&bar[XB_TMO], 1u); break; } }
    }
    nloc = mine > 0u ? mine : 1u; nx = cnt > 0u ? cnt : 1u;
}
__device__ __forceinline__ void xcd_barrier(const XcdBarrier& b) {
    asm volatile("s_waitcnt vmcnt(0)" ::: "memory");
    __syncthreads();
    if (threadIdx.x == 0) {
        unsigned* bar = b.bar;
        __builtin_amdgcn_s_waitcnt(0);
        unsigned nloc = b.st[0], nx = b.st[1];
        if (nloc == 0u) { xcd_barrier_complete(bar, b.x, nloc, nx); b.st[0] = nloc; b.st[1] = nx; }
        const unsigned old = xb_add(&bar[XB_XSUB(b.x)], 1u);
        const unsigned gen = old / nloc;
        if (old + 1u == (gen + 1u) * nloc) {
            __builtin_amdgcn_fence(__ATOMIC_RELEASE, "agent");
            asm volatile("s_waitcnt vmcnt(0)" ::: "memory");
            const unsigned og = xb_add(&bar[XB_TOP], 1u);
            const unsigned tg = og / nx;
            if (og + 1u == (tg + 1u) * nx) xb_add(&bar[XB_TOPGEN], 1u);
            else XB_SPIN(xb_ld(&bar[XB_TOPGEN]) == tg, bar);
            __builtin_amdgcn_fence(__ATOMIC_ACQUIRE, "agent");
            xb_add(&bar[XB_XGEN(b.x)], 1u);
            asm volatile("s_waitcnt vmcnt(0)" ::: "memory");
        } else {
            XB_SPIN(xb_ld(&bar[XB_XGEN(b.x)]) == gen, bar);
            __builtin_amdgcn_fence(__ATOMIC_ACQUIRE, "agent");
            asm volatile("s_waitcnt vmcnt(0)" ::: "memory");
        }
    }
    __syncthreads();
}

struct Args {
    const float* in[43]; const int* positions; float* out; unsigned char* ws; int ph_lo, ph_hi, dbg, pad;
};
enum { I_X = 0, I_C = 1, I_POS = 2, I_MOD1W = 3, I_MOD1B = 4, I_WIN = 5, I_GMLNG = 6, I_GMLNB = 7, I_GMW = 8, I_GMB = 9,
       I_S5LRE = 10, I_S5LIM = 11, I_S5STEP = 12, I_S5BRE = 13, I_S5BIM = 14, I_S5CRE = 15, I_S5CIM = 16, I_S5D = 17, I_S5GLUW = 18, I_S5GLUB = 19,
       I_CONVW = 20, I_CONVB = 21, I_DTBIAS = 22, I_ALOG = 23, I_SSDD = 24, I_SSDNG = 25, I_WBR = 26, I_WGATE = 27, I_WOUT = 28, I_LN1G = 29, I_LN1B = 30,
       I_MOD2W = 31, I_MOD2B = 32, I_RW = 33, I_RB = 34, I_EW1 = 35, I_EW3 = 36, I_EW2 = 37, I_SW1 = 38, I_SW3 = 39, I_SW2 = 40, I_LN2G = 41, I_LN2B = 42 };

typedef const __attribute__((address_space(4))) Args* ArgsP;
struct Ctx {
    ArgsP a; unsigned char* ws; LAS unsigned char* lds; int tid, lane, wave, c, G, bx, dbg;
    __device__ __forceinline__ const float* in(int i) const { return a->in[i]; }
    __device__ __forceinline__ bf16_t* proj() const { return (bf16_t*)(ws + WS_PROJ); }
    __device__ __forceinline__ bf16_t* hbuf() const { return (bf16_t*)(ws + WS_H); }
    __device__ __forceinline__ bf16_t* ybuf() const { return (bf16_t*)(ws + WS_Y); }
    __device__ __forceinline__ float* modv(int l, int w) const { return (float*)(ws + WS_MODV) + (size_t)(l * 2 + w) * NB * 3072; }
};

__device__ __forceinline__ void ph_prologue(const Ctx& X) {
    { float* ropet = (float*)(X.ws + WS_ROPE); const int* pos = X.a->positions;
      for (int i = X.c * 512 + X.tid; i < M * 8; i += X.G * 512) { const int tok = i >> 3, j = i & 7;
          const float inv = (j == 0) ? 1.0f : (j == 1) ? 0.1939227432f : (j == 2) ? 0.0376060307f : (j == 3) ? 0.00729266461f : (j == 4) ? 0.00141421356f : (j == 5) ? 0.000274248188f : (j == 6) ? 5.31829610e-05f : 1.03133862e-05f;
          float sn, cs; sincos_red((float)pos[tok] * inv, sn, cs); *(f32x2*)(ropet + (size_t)i * 2) = (f32x2){cs, sn}; } }
    LAS float* red = (LAS float*)X.lds;
    for (int it = X.c; it < DEPTH * 2 * 48; it += X.G) {
        const int l = it / 96, w = (it / 48) & 1, jb = it % 48, j = jb * 64 + X.lane;
        const float* W = X.in(w ? I_MOD2W : I_MOD1W) + (size_t)l * D * 3072; const float* cv = X.in(I_C);
        float a0 = 0.f, a1 = 0.f, a2 = 0.f, a3 = 0.f;
        const int k0 = X.wave * 128;
        for (int k = k0; k < k0 + 128; ++k) { const float wv = W[(size_t)k * 3072 + j]; a0 += cv[k] * wv; a1 += cv[D + k] * wv; a2 += cv[2 * D + k] * wv; a3 += cv[3 * D + k] * wv; }
        red[(X.wave * 4 + 0) * 64 + X.lane] = a0; red[(X.wave * 4 + 1) * 64 + X.lane] = a1; red[(X.wave * 4 + 2) * 64 + X.lane] = a2; red[(X.wave * 4 + 3) * 64 + X.lane] = a3;
        __syncthreads();
        if (X.tid < 256) { const int b = X.tid >> 6, ln = X.tid & 63; float s = 0.f;
#pragma unroll
            for (int q = 0; q < 8; ++q) s += red[(q * 4 + b) * 64 + ln];
            const int jj = jb * 64 + ln; X.modv(l, w)[b * 3072 + jj] = s + X.in(w ? I_MOD2B : I_MOD1B)[(size_t)l * 3072 + jj]; }
        __syncthreads();
    }
}

template <class Src>
__device__ __forceinline__ void tr_item(const Src& src, bf16_t* WT, int K, int rowbase, int kb, int nb, LAS float* scr, int lane) {
    const int k0 = 64 * kb, n0 = 32 * nb;
    f32x4 v[8];
#pragma unroll
    for (int i = 0; i < 8; ++i) v[i] = src.load4(k0 + 8 * i + (lane >> 3), n0 + 4 * (lane & 7));
#pragma unroll
    for (int i = 0; i < 8; ++i) { LAS float* d = scr + (8 * i + (lane >> 3)) * 33 + 4 * (lane & 7); d[0] = v[i][0]; d[1] = v[i][1]; d[2] = v[i][2]; d[3] = v[i][3]; }
    asm volatile("s_waitcnt lgkmcnt(0)" ::: "memory");
    const int c = lane & 7;
#pragma unroll
    for (int j = 0; j < 4; ++j) { const int n = (lane >> 3) + 8 * j; const LAS float* s = scr + (8 * c) * 33 + n;
        u32x4 o; o.x = pk2(s[0 * 33], s[1 * 33]); o.y = pk2(s[2 * 33], s[3 * 33]); o.z = pk2(s[4 * 33], s[5 * 33]); o.w = pk2(s[6 * 33], s[7 * 33]);
        *(u32x4*)(WT + (size_t)(rowbase + n0 + n) * K + k0 + 8 * c) = o; }
    asm volatile("s_waitcnt lgkmcnt(0)" ::: "memory");
}
struct SrcPlain { const float* W; int N; __device__ __forceinline__ f32x4 load4(int k, int n) const { return *(const f32x4*)(W + (size_t)k * N + n); } };
struct SrcWin { const float* W; __device__ __forceinline__ f32x4 load4(int k, int n) const {
    if (n >= D_IN) return (f32x4){0.f, 0.f, 0.f, 0.f}; const int o = (n < 1216) ? n : (n < 2240) ? n + 4 : (n < 2244) ? 1216 + (n - 2240) : n; return *(const f32x4*)(W + (size_t)k * D_IN + o); } };
struct Src13 { const float* W1; const float* W3; __device__ __forceinline__ f32x4 load4(int k, int n) const {
    const int f = (n >> 5) * 16 + (n & 15); const long d = (n & 16) ? (long)(W3 - W1) : 0l; return *(const f32x4*)(W1 + d + (long)k * 256 + f); } };

__device__ __forceinline__ void ph_wconv(const Ctx& X, int l) {
    LAS float* scr = (LAS float*)(X.lds + X.wave * 16384);
    unsigned char* wb = X.ws + WS_W;
    const int gw = X.c * 8 + X.wave, NGW = X.G * 8;
    constexpr int I_A = 16 * 72, I_B = 4 * 16 * 32, I_C2 = 4 * 4 * 32, I_D = 16 * 32, I_E = 4 * 8, I_F = NE1 * 16 * 16, I_G = NE1 * 4 * 32;
    constexpr int NIT = I_A + I_B + I_C2 + I_D + I_E + I_F + I_G;
    for (int it = gw; it < NIT; it += NGW) {
        int r = it;
        if (r < I_A) { SrcWin s{X.in(I_WIN) + (size_t)l * D * D_IN}; tr_item(s, (bf16_t*)(wb + WO_IN), 1024, 0, r / 72, r % 72, scr, X.lane); continue; } r -= I_A;
        if (r < I_B) { const int i = r / 512, q = r % 512; SrcPlain s{X.in(I_WGATE) + ((size_t)l * 4 + i) * D * D, D}; tr_item(s, (bf16_t*)(wb + WO_GATE), 1024, i * 1024, q / 32, q % 32, scr, X.lane); continue; } r -= I_B;
        if (r < I_C2) { const int i = r / 128, q = r % 128; SrcPlain s{X.in(I_WBR) + ((size_t)l * 4 + i) * 256 * D, D}; tr_item(s, (bf16_t*)(wb + WO_BR) + (size_t)i * 1024 * 256, 256, 0, q / 32, q % 32, scr, X.lane); continue; } r -= I_C2;
        if (r < I_D) { SrcPlain s{X.in(I_WOUT) + (size_t)l * D * D, D}; tr_item(s, (bf16_t*)(wb + WO_OUT), 1024, 0, r / 32, r % 32, scr, X.lane); continue; } r -= I_D;
        if (r < I_E) { SrcPlain s{X.in(I_S5GLUW) + (size_t)l * 256 * 256, 256}; tr_item(s, (bf16_t*)(wb + WO_GLU), 256, 0, r / 8, r % 8, scr, X.lane); continue; } r -= I_E;
        if (r < I_F) { const int e = r / 256, q = r % 256;
            const Src13 s{(e < NEXP) ? X.in(I_EW1) + ((size_t)l * NEXP + e) * D * 256 : X.in(I_SW1) + (size_t)l * D * 256, (e < NEXP) ? X.in(I_EW3) + ((size_t)l * NEXP + e) * D * 256 : X.in(I_SW3) + (size_t)l * D * 256};
            tr_item(s, (bf16_t*)(wb + WO_13) + (size_t)e * 512 * 1024, 1024, 0, q / 16, q % 16, scr, X.lane); continue; } r -= I_F;
        { const int e = r / 128, q = r % 128; SrcPlain s{e < NEXP ? X.in(I_EW2) + ((size_t)l * NEXP + e) * 256 * D : X.in(I_SW2) + (size_t)l * 256 * D, D};
            tr_item(s, (bf16_t*)(wb + WO_2) + (size_t)e * 1024 * 256, 256, 0, q / 32, q % 32, scr, X.lane); }
    }
    const int gt = X.c * 512 + X.tid, NGT = X.G * 512;
    { bf16_t* gmw = (bf16_t*)(X.ws + WS_GMW); const float* src = X.in(I_GMW) + (size_t)l * 4 * 128 * 128;
      for (int i = gt; i < 4 * 128 * 128; i += NGT) { const int t = (i >> 7) & 127, s = i & 127; gmw[i] = (bf16_t)f2bf(s <= t ? src[i] : 0.f); } }
    for (int i = gt; i < 16 * 64; i += NGT) {
        const int g = i >> 6, p = i & 63;
        const float step = expf(X.in(I_S5STEP)[l * 16 + g]); const float lr = X.in(I_S5LRE)[(size_t)l * 1024 + i], li = X.in(I_S5LIM)[(size_t)l * 1024 + i];
        const float mag = expf(lr * step); float sn, cs; sincos_red(li * step, sn, cs);
        const float abr = mag * cs, abi = mag * sn, den = lr * lr + li * li, nr = abr - 1.0f;
        const float cr = (nr * lr + abi * li) / den, ci = (abi * lr - nr * li) / den;
        float* sa = (float*)(X.ws + WS_S5A); sa[i * 2] = abr; sa[i * 2 + 1] = abi;
        bf16_t* bb = (bf16_t*)(X.ws + WS_S5B); bf16_t* cm = (bf16_t*)(X.ws + WS_S5C);
        const float* bre = X.in(I_S5BRE) + ((size_t)l * 1024 + i) * 16; const float* bim = X.in(I_S5BIM) + ((size_t)l * 1024 + i) * 16;
#pragma unroll
        for (int ch = 0; ch < 16; ++ch) { const float br = bre[ch], bi = bim[ch];
            bb[(g * 128 + p) * 16 + ch] = (bf16_t)f2bf(cr * br - ci * bi); bb[(g * 128 + 64 + p) * 16 + ch] = (bf16_t)f2bf(cr * bi + ci * br);
            cm[(g * 16 + ch) * 128 + p] = (bf16_t)f2bf(X.in(I_S5CRE)[(((size_t)l * 16 + g) * 16 + ch) * 64 + p]);
            cm[(g * 16 + ch) * 128 + 64 + p] = (bf16_t)f2bf(-X.in(I_S5CIM)[(((size_t)l * 16 + g) * 16 + ch) * 64 + p]); }
    }
    { bf16_t* rf = (bf16_t*)(X.ws + WS_RFR); const float* rw = X.in(I_RW) + (size_t)l * D * NEXP;
      for (int i = gt; i < 2 * 32 * 64 * 8; i += NGT) { const int j = i & 7, ln = (i >> 3) & 63, ks = (i >> 9) & 31, rt = i >> 14;
          const float v = rw[(size_t)(ks * 32 + 8 * (ln >> 4) + j) * NEXP + rt * 16 + (ln & 15)]; const unsigned hi = f2bf(v); const float lo = v - bflo(hi);
          rf[i] = (bf16_t)hi; rf[32768 + i] = (bf16_t)f2bf(lo); } }
    if (l == 0) {
        const float* x = X.in(I_X); bf16_t* h = X.hbuf(); const float* mv = X.modv(0, 0);
        for (size_t i = (size_t)gt; i < (size_t)M * D / 8; i += NGT) {
            const size_t e = i * 8; const int col = (int)(e & 1023), b = (int)(e >> 23);
            const f32x4 x0 = *(const f32x4*)(x + e), x1 = *(const f32x4*)(x + e + 4);
            const f32x4 sh0 = *(const f32x4*)(mv + b * 3072 + col), sh1 = *(const f32x4*)(mv + b * 3072 + col + 4), sc0 = *(const f32x4*)(mv + b * 3072 + 1024 + col), sc1 = *(const f32x4*)(mv + b * 3072 + 1024 + col + 4);
            const f32x4 h0 = x0 * (sc0 + 1.0f) + sh0, h1 = x1 * (sc1 + 1.0f) + sh1;
            u32x4 w; w.x = pk2(h0[0], h0[1]); w.y = pk2(h0[2], h0[3]); w.z = pk2(h1[0], h1[1]); w.w = pk2(h1[2], h1[3]);
            *(u32x4*)(h + e) = w; }
    }
}

__device__ __forceinline__ void rope8(const u32x4 a, const u32x4 b, const float* cs, u32x4& wa, u32x4& wb) {
    float t1[8], t2[8]; t1[0] = bflo(a.x); t1[1] = bfhi(a.x); t1[2] = bflo(a.y); t1[3] = bfhi(a.y); t1[4] = bflo(a.z); t1[5] = bfhi(a.z); t1[6] = bflo(a.w); t1[7] = bfhi(a.w);
    t2[0] = bflo(b.x); t2[1] = bfhi(b.x); t2[2] = bflo(b.y); t2[3] = bfhi(b.y); t2[4] = bflo(b.z); t2[5] = bfhi(b.z); t2[6] = bflo(b.w); t2[7] = bfhi(b.w);
    float o1[8], o2[8]; f32x4 c4[4];
#pragma unroll
    for (int q = 0; q < 4; ++q) c4[q] = *(const f32x4*)(cs + 4 * q);
#pragma unroll
    for (int j = 0; j < 8; ++j) { const float cv = c4[j >> 1][(j & 1) * 2], sv = c4[j >> 1][(j & 1) * 2 + 1]; o1[j] = t1[j] * cv - t2[j] * sv; o2[j] = t2[j] * cv + t1[j] * sv; }
    wa.x = pk2(o1[0], o1[1]); wa.y = pk2(o1[2], o1[3]); wa.z = pk2(o1[4], o1[5]); wa.w = pk2(o1[6], o1[7]);
    wb.x = pk2(o2[0], o2[1]); wb.y = pk2(o2[2], o2[3]); wb.z = pk2(o2[4], o2[5]); wb.w = pk2(o2[6], o2[7]);
}
__device__ __forceinline__ void mx_rope(const Ctx& X) {
    bf16_t* pj = X.proj(); const float* ropet = (const float*)(X.ws + WS_ROPE);
    const int gt = X.c * 512 + X.tid, NGT = X.G * 512;
    for (int i = gt; i < M * 10; i += NGT) {
        const int tok = i / 10, hh = i % 10;
        if (hh == 9) { const u32x4* sp = (const u32x4*)(pj + (size_t)tok * PJ + C_V); u32x4* dp = (u32x4*)((bf16_t*)(X.ws + WS_V2) + (size_t)tok * 64);
#pragma unroll
            for (int q = 0; q < 8; ++q) dp[q] = sp[q];
            continue; }
        const int col = (hh < 4) ? C_Q + hh * 64 : (hh < 8) ? C_QI + (hh - 4) * 64 : C_K;
        bf16_t* p = pj + (size_t)tok * PJ + col;
        const u32x4 a = *(const u32x4*)p, b = *(const u32x4*)(p + 8);
        u32x4 wa, wb; rope8(a, b, ropet + (size_t)tok * 16, wa, wb);
        if (hh < 8) { *(u32x4*)p = wa; *(u32x4*)(p + 8) = wb; }
        else { u32x4* dp = (u32x4*)((bf16_t*)(X.ws + WS_K2) + (size_t)tok * 64); const u32x4* sp = (const u32x4*)p; dp[0] = wa; dp[1] = wb;
#pragma unroll
            for (int q = 2; q < 8; ++q) dp[q] = sp[q]; }
    }
    for (int i = gt; i < (M / 16) * 16; i += NGT) {
        const int hf = i & 1, pc = (i >> 1) & 7, tile = i >> 4; const int ks = pc >> 2, fq = pc & 3;
        u32x4* dp = (u32x4*)((bf16_t*)(X.ws + WS_KI2) + (size_t)tile * 1024 + pc * 128 + hf * 64);
#pragma unroll
        for (int j = 0; j < 8; ++j) { const int tok = tile * 16 + hf * 8 + j; const bf16_t* rp = pj + (size_t)tok * PJ + C_KI;
            u32x4 v = *(const u32x4*)(rp + ks * 32 + fq * 8);
            if (pc < 2) { const u32x4 a = *(const u32x4*)rp, b = *(const u32x4*)(rp + 8); u32x4 wa, wb; rope8(a, b, ropet + (size_t)tok * 16, wa, wb); v = pc ? wb : wa; }
            dp[j] = v; }
    }
}

__device__ __forceinline__ void mx_gmlp(const Ctx& X, int l, int unit) {
    const int lane = X.lane, w = X.wave;
    const int row0 = unit * 128;
    LAS bf16_t* Vt = (LAS bf16_t*)X.lds;
    const bf16_t* pj = X.proj();
    const float* lng = X.in(I_GMLNG) + l * 256; const float* lnb = X.in(I_GMLNB) + l * 256;
    float g4[4], b4[4];
#pragma unroll
    for (int j = 0; j < 4; ++j) { g4[j] = lng[lane + 64 * j]; b4[j] = lnb[lane + 64 * j]; }
    for (int i = 0; i < 16; ++i) {
        const int s = w * 16 + i; const bf16_t* rp = pj + (size_t)(row0 + s) * PJ + C_GV;
        float v[4]; float sm = 0.f;
#pragma unroll
        for (int j = 0; j < 4; ++j) { v[j] = gelu_tanh(bf2f(rp[lane + 64 * j])); sm += v[j]; }
        const float mean = wave_sum(sm) * (1.0f / 256.0f); float q = 0.f;
#pragma unroll
        for (int j = 0; j < 4; ++j) { v[j] -= mean; q += v[j] * v[j]; }
        const float rstd = rsqrtf(wave_sum(q) * (1.0f / 256.0f) + LN_EPS);
#pragma unroll
        for (int j = 0; j < 4; ++j) Vt[(lane + 64 * j) * 136 + s] = (bf16_t)f2bf(v[j] * rstd * g4[j] + b4[j]);
    }
    __syncthreads();
    const int g = w >> 1, c0 = g * 64 + (w & 1) * 32, fr = lane & 15, fq = lane >> 4;
    const bf16_t* gmw = (const bf16_t*)(X.ws + WS_GMW) + (size_t)g * 128 * 128;
    const float* gmb = X.in(I_GMB) + ((size_t)l * 4 + g) * 128;
    bf16_t* ya = X.ybuf();
    for (int tt = 0; tt < 8; ++tt) {
        f32x4 acc0 = (f32x4){0.f, 0.f, 0.f, 0.f}, acc1 = acc0;
        for (int ks = 0; ks <= (tt >> 1); ++ks) {
            const bf16x8 wf = *(const bf16x8*)(gmw + (tt * 16 + fr) * 128 + ks * 32 + 8 * fq);
            const bf16x8 v0 = *(const LAS bf16x8*)(Vt + (c0 + fr) * 136 + ks * 32 + 8 * fq), v1 = *(const LAS bf16x8*)(Vt + (c0 + 16 + fr) * 136 + ks * 32 + 8 * fq);
            acc0 = mfma16(v0, wf, acc0); acc1 = mfma16(v1, wf, acc1);
        }
        const int t = tt * 16 + fr; const float bias = gmb[t];
#pragma unroll
        for (int c2 = 0; c2 < 2; ++c2) { const f32x4 a = c2 ? acc1 : acc0; const int cc = c0 + c2 * 16 + 4 * fq;
            const u32x2 uv = *(const u32x2*)(pj + (size_t)(row0 + t) * PJ + C_GU + cc);
            u32x2 o; o.x = pk2(gelu_tanh(bflo(uv.x)) * (a[0] + bias), gelu_tanh(bfhi(uv.x)) * (a[1] + bias)); o.y = pk2(gelu_tanh(bflo(uv.y)) * (a[2] + bias), gelu_tanh(bfhi(uv.y)) * (a[3] + bias));
            *(u32x2*)(ya + (size_t)(row0 + t) * 256 + cc) = o; }
    }
    __syncthreads();
}

template <int PASS>
__device__ __forceinline__ void mx_s5(const Ctx& X, int l, int wu) {
    const int lane = X.lane, fr = lane & 15, fq = lane >> 4;
    const int wgi = wu >> 3, wv = wu & 7; const int b = wgi >> 6, g = ((wgi >> 4) & 3) * 4 + (wv & 3), ch = (wgi & 15) * 2 + (wv >> 2);
    const int tb = b * SEQ + ch * 256;
    LAS float* xl = (LAS float*)(X.lds + X.wave * 16384);
    LAS bf16_t* hb = (LAS bf16_t*)(X.lds + X.wave * 16384 + 8192);
    const bf16_t* pj = X.proj();
    const bf16_t* bbT = (const bf16_t*)(X.ws + WS_S5B) + (size_t)g * 128 * 16;
    bf16x8 Bf[8];
#pragma unroll
    for (int ct = 0; ct < 8; ++ct) { Bf[ct] = (bf16x8){0, 0, 0, 0, 0, 0, 0, 0}; if (fq < 2) Bf[ct] = *(const bf16x8*)(bbT + (ct * 16 + fr) * 16 + 8 * fq); }
    const float* sa = (const float*)(X.ws + WS_S5A) + (g * 64 + lane) * 2; const float ar = sa[0], ai = sa[1];
    float hr = 0.f, hi = 0.f;
    float* st = (float*)(X.ws + WS_S5ST) + (size_t)((b * 16 + g) * 32) * 128;
    bf16x8 Cf[4]; float dsk[4];
    if (PASS == 3) {
        { const float* hin = (const float*)(X.ws + WS_S5HIN) + (size_t)((b * 16 + g) * 32 + ch) * 128; hr = hin[lane]; hi = hin[64 + lane]; }
        const bf16_t* cm = (const bf16_t*)(X.ws + WS_S5C) + (size_t)g * 16 * 128;
#pragma unroll
        for (int ks = 0; ks < 4; ++ks) Cf[ks] = *(const bf16x8*)(cm + fr * 128 + ks * 32 + 8 * fq);
#pragma unroll
        for (int i = 0; i < 4; ++i) dsk[i] = X.in(I_S5D)[l * 256 + g * 16 + 4 * fq + i];
    }
    bf16_t* ycp = (bf16_t*)(X.ws + WS_YCPRE);
    for (int blk = 0; blk < 16; ++blk) {
        const int t0 = tb + blk * 16;
        bf16x8 uf = (bf16x8){0, 0, 0, 0, 0, 0, 0, 0};
        if (fq < 2) uf = *(const bf16x8*)(pj + (size_t)(t0 + fr) * PJ + C_S5 + g * 16 + 8 * fq);
#pragma unroll
        for (int ct = 0; ct < 8; ++ct) { const f32x4 a = mfma16(uf, Bf[ct], (f32x4){0.f, 0.f, 0.f, 0.f});
#pragma unroll
            for (int i = 0; i < 4; ++i) xl[(4 * fq + i) * 128 + ct * 16 + fr] = a[i]; }
#pragma unroll
        for (int t = 0; t < 16; ++t) { const float xr = xl[t * 128 + lane], xi = xl[t * 128 + 64 + lane];
            const float nr = ar * hr - ai * hi + xr, ni = ar * hi + ai * hr + xi; hr = nr; hi = ni;
            if (PASS == 3) { hb[t * 136 + lane] = (bf16_t)f2bf(hr); hb[t * 136 + 64 + lane] = (bf16_t)f2bf(hi); } }
        if (PASS == 3) {
            asm volatile("s_waitcnt lgkmcnt(0)" ::: "memory"); __builtin_amdgcn_wave_barrier();
            f32x4 acc = (f32x4){0.f, 0.f, 0.f, 0.f};
#pragma unroll
            for (int ks = 0; ks < 4; ++ks) { const bf16x8 hf = *(const LAS bf16x8*)(hb + fr * 136 + ks * 32 + 8 * fq); acc = mfma16(Cf[ks], hf, acc); }
            const u32x2 uv = *(const u32x2*)(pj + (size_t)(t0 + fr) * PJ + C_S5 + g * 16 + 4 * fq);
            const float y0 = gelu_tanh(acc[0] + dsk[0] * bflo(uv.x)), y1 = gelu_tanh(acc[1] + dsk[1] * bfhi(uv.x)), y2 = gelu_tanh(acc[2] + dsk[2] * bflo(uv.y)), y3 = gelu_tanh(acc[3] + dsk[3] * bfhi(uv.y));
            u32x2 o; o.x = pk2(y0, y1); o.y = pk2(y2, y3);
            *(u32x2*)(ycp + (size_t)(t0 + fr) * 256 + g * 16 + 4 * fq) = o;
        }
    }
    if (PASS == 1) { st[ch * 128 + lane] = hr; st[ch * 128 + 64 + lane] = hi; }
}

constexpr int SD_CM = 0, SD_BM = 18432, SD_XT0 = 36864, SD_XT1 = 55296, SD_MM = 73728, SD_SIN0 = 108544, SD_SIN1 = 117760, SD_DT = 126976, SD_AC = 128000 + 64, SD_END = 129024 + 64;
__device__ __forceinline__ bf16x8 tr_frag8(const LAS bf16_t* base, int pitch, int l0, int c0, int lane) {
    const int g = lane >> 4, i = lane & 15; const unsigned a1 = (unsigned)(unsigned long)(base + (l0 + 8 * g + (i >> 2)) * pitch + c0 + 4 * (i & 3)); const unsigned a2 = a1 + (unsigned)(8 * pitch);
    u32x2 r1, r2;
    asm volatile("ds_read_b64_tr_b16 %0, %2\n\tds_read_b64_tr_b16 %1, %3\n\ts_waitcnt lgkmcnt(0)" : "=&v"(r1), "=&v"(r2) : "v"(a1), "v"(a2) : "memory");
    __builtin_amdgcn_sched_barrier(0);
    const u32x4 o = (u32x4){r1.x, r1.y, r2.x, r2.y}; return __builtin_bit_cast(bf16x8, o);
}
static_assert(SD_END <= LDS_MISC, "ssd lds");
template <int PASS>
__device__ __forceinline__ void mx_ssd(const Ctx& X, int l, int unit) {
    const int tid = X.tid, lane = X.lane, w = X.wave, fr = lane & 15, fq = lane >> 4;
    const int b = unit >> 6, c = unit & 63; const int r0 = unit * 128;
    const bf16_t* pj = X.proj();
    LAS bf16_t* Cm = (LAS bf16_t*)(X.lds + SD_CM); LAS bf16_t* Bm = (LAS bf16_t*)(X.lds + SD_BM);
    LAS bf16_t* Mm = (LAS bf16_t*)(X.lds + SD_MM);
    LAS float* dtv = (LAS float*)(X.lds + SD_DT); LAS float* acm = (LAS float*)(X.lds + SD_AC);
    const float* convw = X.in(I_CONVW) + (size_t)l * 4 * 512; const float* convb = X.in(I_CONVB) + (size_t)l * 512;
    float* sst = (float*)(X.ws + WS_SSDST); float* atot = (float*)(X.ws + WS_ATOT);
    for (int g = 0; g < 2; ++g) {
        if (tid < 256) { const int j = tid >> 7, rl = tid & 127, h = 2 * g + j;
            const float raw = bf2f(pj[(size_t)(r0 + rl) * PJ + C_DT + h]) + X.in(I_DTBIAS)[l * 4 + h];
            const float dt = softplusf_(raw); dtv[j * 128 + rl] = dt; acm[j * 128 + rl] = -expf(X.in(I_ALOG)[l * 4 + h]) * dt; }
        __syncthreads();
        if (tid < 256) {
            float cum = acm[tid];
#pragma unroll
            for (int o = 1; o < 64; o <<= 1) { const float up = __shfl_up(cum, o); if (lane >= o) cum += up; }
            if (lane == 63) dtv[256 + w] = cum;
            __builtin_amdgcn_fence(__ATOMIC_RELEASE, "workgroup");
            acm[tid] = cum; }
        __syncthreads();
        if (tid < 256 && (w & 1)) acm[tid] += dtv[256 + w - 1];
        __syncthreads();
        if (PASS == 1 && tid < 2) atot[(b * 64 + c) * 32 + 2 * g + tid] = acm[tid * 128 + 127];
        if (!(X.dbg & 16)) { const int cg = tid & 31, rb = tid >> 5; constexpr int NCG = (PASS == 1) ? 24 : 32;
          if (cg < NCG) {
            const int chn = (cg < 16) ? g * 128 + cg * 8 : (cg < 24) ? 256 + g * 64 + (cg - 16) * 8 : 384 + g * 64 + (cg - 24) * 8;
            u32x4 xr[11];
#pragma unroll
            for (int k = 0; k < 11; ++k) { const int sq = c * 128 + rb * 8 + k - 3; xr[k] = (u32x4){0u, 0u, 0u, 0u}; if (sq >= 0) xr[k] = *(const u32x4*)(pj + (size_t)(b * SEQ + sq) * PJ + C_XBC + chn); }
            f32x4 w0[4], w1[4];
#pragma unroll
            for (int k = 0; k < 4; ++k) { w0[k] = *(const f32x4*)(convw + k * 512 + chn); w1[k] = *(const f32x4*)(convw + k * 512 + chn + 4); }
            const f32x4 cb0 = *(const f32x4*)(convb + chn), cb1 = *(const f32x4*)(convb + chn + 4);
            LAS bf16_t* dst = (cg < 16) ? (LAS bf16_t*)(X.lds + ((cg >> 3) ? SD_XT1 : SD_XT0)) + (cg & 7) * 8 : (cg < 24) ? Bm + (cg - 16) * 8 : Cm + (cg - 24) * 8;
            const int jh = (cg >> 3) & 1;
#pragma unroll
            for (int r = 0; r < 8; ++r) { const int rl = rb * 8 + r;
                f32x4 s0 = cb0, s1 = cb1;
#pragma unroll
                for (int k = 0; k < 4; ++k) { const u32x4 xv = xr[r + k];
                    s0[0] += w0[k][0] * bflo(xv.x); s0[1] += w0[k][1] * bfhi(xv.x); s0[2] += w0[k][2] * bflo(xv.y); s0[3] += w0[k][3] * bfhi(xv.y);
                    s1[0] += w1[k][0] * bflo(xv.z); s1[1] += w1[k][1] * bfhi(xv.z); s1[2] += w1[k][2] * bflo(xv.w); s1[3] += w1[k][3] * bfhi(xv.w); }
                float sc = 1.0f; if (PASS == 1 && cg < 16) sc = __expf(acm[jh * 128 + 127] - acm[jh * 128 + rl]) * dtv[jh * 128 + rl];
                u32x4 o; o.x = pk2(siluf_(s0[0]) * sc, siluf_(s0[1]) * sc); o.y = pk2(siluf_(s0[2]) * sc, siluf_(s0[3]) * sc); o.z = pk2(siluf_(s1[0]) * sc, siluf_(s1[1]) * sc); o.w = pk2(siluf_(s1[2]) * sc, siluf_(s1[3]) * sc);
                *(LAS u32x4*)(dst + rl * 72) = o; }
          } }
        if (PASS == 3) {
            const bf16_t* sin = (const bf16_t*)(X.ws + WS_SSDSIN) + (size_t)((b * 64 + c) * 4 + 2 * g) * 4096 + tid * 8;
            const int p = tid >> 3, n0 = (tid & 7) * 8;
            *(LAS u32x4*)((LAS bf16_t*)(X.lds + SD_SIN0) + p * 72 + n0) = *(const u32x4*)sin;
            *(LAS u32x4*)((LAS bf16_t*)(X.lds + SD_SIN1) + p * 72 + n0) = *(const u32x4*)(sin + 4096);
        }
        __syncthreads();
        if (PASS == 1) {
            const int j = w >> 2, pt = w & 3; const LAS bf16_t* Xr = (const LAS bf16_t*)(X.lds + (j ? SD_XT1 : SD_XT0));
            f32x4 acc[4];
#pragma unroll
            for (int nt = 0; nt < 4; ++nt) acc[nt] = (f32x4){0.f, 0.f, 0.f, 0.f};
#pragma unroll
            for (int ks = 0; ks < 4; ++ks) { const bf16x8 xf = tr_frag8(Xr, 72, ks * 32, pt * 16, lane);
#pragma unroll
                for (int nt = 0; nt < 4; ++nt) { const bf16x8 bf = tr_frag8(Bm, 72, ks * 32, nt * 16, lane); acc[nt] = mfma16(xf, bf, acc[nt]); } }
            float* sp = sst + (size_t)((b * 64 + c) * 4 + 2 * g + j) * 4096;
#pragma unroll
            for (int nt = 0; nt < 4; ++nt)
#pragma unroll
                for (int i = 0; i < 4; ++i) sp[(pt * 16 + 4 * fq + i) * 64 + nt * 16 + fr] = acc[nt][i];
        } else {
            const int lrow = w * 16 + fr;
            float yv[2][4][4];
#pragma unroll
            for (int j = 0; j < 2; ++j) {
                const LAS bf16_t* Xr = (const LAS bf16_t*)(X.lds + (j ? SD_XT1 : SD_XT0)); const LAS bf16_t* Sin = (const LAS bf16_t*)(X.lds + (j ? SD_SIN1 : SD_SIN0));
                const float al = acm[j * 128 + lrow];
                const bf16x8 cf0 = *(const LAS bf16x8*)(Cm + lrow * 72 + 8 * fq), cf1 = *(const LAS bf16x8*)(Cm + lrow * 72 + 32 + 8 * fq);
                const int stmax = w | 1;
                for (int st = 0; st <= stmax; ++st) {
                    f32x4 ag = (f32x4){0.f, 0.f, 0.f, 0.f};
                    if (st <= w) { const bf16x8 b0 = *(const LAS bf16x8*)(Bm + (st * 16 + fr) * 72 + 8 * fq), b1 = *(const LAS bf16x8*)(Bm + (st * 16 + fr) * 72 + 32 + 8 * fq);
                        ag = mfma16(b0, cf0, ag); ag = mfma16(b1, cf1, ag); }
                    float mv[4];
#pragma unroll
                    for (int i = 0; i < 4; ++i) { const int s = st * 16 + 4 * fq + i; mv[i] = (s <= lrow) ? ag[i] * __expf(al - acm[j * 128 + s]) * dtv[j * 128 + s] : 0.f; }
                    u32x2 o; o.x = pk2(mv[0], mv[1]); o.y = pk2(mv[2], mv[3]); *(LAS u32x2*)(Mm + lrow * 136 + st * 16 + 4 * fq) = o;
                }
                const float eal = __expf(al); const float dsk = X.in(I_SSDD)[l * 4 + 2 * g + j];
#pragma unroll
                for (int pt = 0; pt < 4; ++pt) {
                    f32x4 ad = (f32x4){0.f, 0.f, 0.f, 0.f}, ao = ad;
                    for (int ks = 0; ks <= (w >> 1); ++ks) { const bf16x8 xf = tr_frag8(Xr, 72, ks * 32, pt * 16, lane); const bf16x8 mf = *(const LAS bf16x8*)(Mm + lrow * 136 + ks * 32 + 8 * fq); ad = mfma16(xf, mf, ad); }
                    { const bf16x8 s0 = *(const LAS bf16x8*)(Sin + (pt * 16 + fr) * 72 + 8 * fq), s1 = *(const LAS bf16x8*)(Sin + (pt * 16 + fr) * 72 + 32 + 8 * fq); ao = mfma16(s0, cf0, ao); ao = mfma16(s1, cf1, ao); }
                    const int h = 2 * g + j; const u32x2 zv = *(const u32x2*)(pj + (size_t)(r0 + lrow) * PJ + C_Z + h * 64 + pt * 16 + 4 * fq);
                    const float z4[4] = {bflo(zv.x), bfhi(zv.x), bflo(zv.y), bfhi(zv.y)};
#pragma unroll
                    for (int i = 0; i < 4; ++i) { const float xs = bf2f(Xr[lrow * 72 + pt * 16 + 4 * fq + i]); yv[j][pt][i] = (ad[i] + eal * ao[i] + dsk * xs) * siluf_(z4[i]); }
                }
            }
            float ss = 0.f;
#pragma unroll
            for (int j = 0; j < 2; ++j)
#pragma unroll
                for (int pt = 0; pt < 4; ++pt)
#pragma unroll
                    for (int i = 0; i < 4; ++i) ss += yv[j][pt][i] * yv[j][pt][i];
            ss += __shfl_xor(ss, 16); ss += __shfl_xor(ss, 32);
            const float rs = rsqrtf(ss * (1.0f / 128.0f) + RMS_EPS);
            const float* ng = X.in(I_SSDNG) + l * 256 + g * 128; bf16_t* yd = X.ybuf() + (size_t)3 * M * 256;
#pragma unroll
            for (int j = 0; j < 2; ++j)
#pragma unroll
                for (int pt = 0; pt < 4; ++pt) { const int cc = j * 64 + pt * 16 + 4 * fq; const f32x4 gv = *(const f32x4*)(ng + cc);
                    u32x2 o; o.x = pk2(yv[j][pt][0] * rs * gv[0], yv[j][pt][1] * rs * gv[1]); o.y = pk2(yv[j][pt][2] * rs * gv[2], yv[j][pt][3] * rs * gv[3]);
                    *(u32x2*)(yd + (size_t)(r0 + lrow) * 256 + g * 128 + cc) = o; }
        }
        __syncthreads();
    }
}

__device__ __forceinline__ void mx_s5_carry(const Ctx& X) {
    const float* st = (const float*)(X.ws + WS_S5ST); float* hin = (float*)(X.ws + WS_S5HIN); const float* sa = (const float*)(X.ws + WS_S5A);
    for (int i = X.c * 32 + (X.tid - 256); X.tid >= 256 && X.tid < 288 && i < NB * 16 * 64; i += X.G * 32) {
        const int p = i & 63, g = (i >> 6) & 15, b = i >> 10;
        float pr = sa[(g * 64 + p) * 2], pi = sa[(g * 64 + p) * 2 + 1];
#pragma unroll
        for (int q = 0; q < 8; ++q) { const float nr = pr * pr - pi * pi, ni = 2.f * pr * pi; pr = nr; pi = ni; }
        float hr = 0.f, hi = 0.f; const size_t base = (size_t)((b * 16 + g) * 32) * 128 + p;
#pragma unroll 8
        for (int ch = 0; ch < 32; ++ch) { hin[base + ch * 128] = hr; hin[base + ch * 128 + 64] = hi;
            const float sr = st[base + ch * 128], si = st[base + ch * 128 + 64]; const float nr = pr * hr - pi * hi + sr, ni = pr * hi + pi * hr + si; hr = nr; hi = ni; }
    }
}

__device__ __forceinline__ void mx_ssd_carry(const Ctx& X) {
    const float* sst = (const float*)(X.ws + WS_SSDST); const float* atot = (const float*)(X.ws + WS_ATOT); bf16_t* sin = (bf16_t*)(X.ws + WS_SSDSIN);
    for (int i = X.c * 256 + X.tid; X.tid < 256 && i < NB * 4 * 4096; i += X.G * 256) {
        const int e1 = i & 4095, h = (i >> 12) & 3, b = i >> 14;
        float S = 0.f;
#pragma unroll 16
        for (int c = 0; c < 64; ++c) { const size_t o = (size_t)((b * 64 + c) * 4 + h) * 4096 + e1;
            sin[o] = (bf16_t)f2bf(S);
            S = S * __expf(atot[(b * 64 + c) * 32 + h]) + sst[o]; }
    }
}

__device__ __forceinline__ unsigned ord16(float s) { const _Float16 hf = (_Float16)s; const unsigned bits = (unsigned)__builtin_bit_cast(unsigned short, hf); return bits ^ ((bits & 0x8000u) ? 0xFFFFu : 0x8000u); }
__device__ __forceinline__ int cnt_ge8(const u32x4 v, unsigned c) {
    int n = 0;
    n += ((v.x & 0xFFFFu) >= c) + ((v.x >> 16) >= c); n += ((v.y & 0xFFFFu) >= c) + ((v.y >> 16) >= c);
    n += ((v.z & 0xFFFFu) >= c) + ((v.z >> 16) >= c); n += ((v.w & 0xFFFFu) >= c) + ((v.w >> 16) >= c);
    return n;
}
template <int CTRL> __device__ __forceinline__ float dpp_f(float v) { return __builtin_bit_cast(float, __builtin_amdgcn_update_dpp(0, __builtin_bit_cast(int, v), CTRL, 0xF, 0xF, true)); }
__device__ __forceinline__ void mx_dsa(const Ctx& X, int b, int t0) {
    const int tid = X.tid, lane = X.lane, w = X.wave, fr = lane & 15, fq = lane >> 4;
    const bf16_t* pj = X.proj() + (size_t)b * SEQ * PJ; const unsigned rb = 0u;
    const bf16_t* ki2 = (const bf16_t*)(X.ws + WS_KI2) + (size_t)b * SEQ * 64; const bf16_t* k2 = (const bf16_t*)(X.ws + WS_K2) + (size_t)b * SEQ * 64; const bf16_t* v2 = (const bf16_t*)(X.ws + WS_V2) + (size_t)b * SEQ * 64;
    LAS unsigned short* sc = (LAS unsigned short*)X.lds;
    const int nk = t0 + 8, nkt = (nk + 15) >> 4;
    LAS unsigned* hist = (LAS unsigned*)(X.lds + 131072 + 8192);
    for (int i = tid; i < 8 * 4 * 128 / 4; i += 512) *(LAS u32x4*)(hist + 4 * i) = (u32x4){0u, 0u, 0u, 0u};
    bf16x8 qf[2][2]; f32x4 wq[2];
#pragma unroll
    for (int ct = 0; ct < 2; ++ct) { const int q = 4 * ct + (fr >> 2), hh = fr & 3; const bf16_t* qp = pj + (unsigned)(t0 + q) * (unsigned)PJ;
        qf[ct][0] = *(const bf16x8*)(qp + C_QI + hh * 64 + 8 * fq); qf[ct][1] = *(const bf16x8*)(qp + C_QI + hh * 64 + 32 + 8 * fq);
        const u32x2 wv = *(const u32x2*)(pj + (unsigned)(t0 + 4 * ct + fq) * (unsigned)PJ + C_WI);
        wq[ct] = (f32x4){bflo(wv.x) * 0.0625f, bfhi(wv.x) * 0.0625f, bflo(wv.y) * 0.0625f, bfhi(wv.y) * 0.0625f}; }
    const int ntw = (nkt > w) ? ((nkt - w + 7) >> 3) : 0;
    __syncthreads();
#define DSA_LOAD4(KF, I0) do { _Pragma("unroll") for (int j = 0; j < 4; ++j) { int kt_ = w + 8 * ((I0) + j); kt_ = kt_ < nkt ? kt_ : nkt - 1; \
        const unsigned ko_ = (unsigned)kt_ * 1024u + (unsigned)lane * 8u; KF[j][0] = *(const bf16x8*)(ki2 + ko_); KF[j][1] = *(const bf16x8*)(ki2 + ko_ + 512u); } } while (0)
#define DSA_COMP4(KF, I0) do { if (DSA_PM == 2 && rs1 > 0) { _Pragma("unroll") for (int j = 0; j < 4; ++j) dummy_ ^= KF[j][0][0] ^ KF[j][1][3]; break; } \
      _Pragma("unroll") for (int jh = 0; jh < 4; jh += 2) { f32x4 ac_[2][2]; \
        _Pragma("unroll") for (int j = 0; j < 2; ++j) _Pragma("unroll") for (int ct = 0; ct < 2; ++ct) { \
            ac_[j][ct] = mfma16(qf[ct][0], KF[jh + j][0], (f32x4){0.f, 0.f, 0.f, 0.f}); ac_[j][ct] = mfma16(qf[ct][1], KF[jh + j][1], ac_[j][ct]); } \
        _Pragma("unroll") for (int j = 0; j < 2; ++j) { if ((I0) + jh + j < ntw) { const int kt_ = w + 8 * ((I0) + jh + j); const bool full_ = (kt_ * 16 + 15 <= t0); const int key_ = kt_ * 16 + fr; \
        _Pragma("unroll") for (int ct = 0; ct < 2; ++ct) { const f32x4 a_ = ac_[j][ct]; \
            float tt_ = __builtin_fmaf(__builtin_amdgcn_fmed3f(a_[0], 0.f, 3.0e38f), wq[ct][0], 0.0f); tt_ = __builtin_fmaf(__builtin_amdgcn_fmed3f(a_[1], 0.f, 3.0e38f), wq[ct][1], tt_); \
            tt_ = __builtin_fmaf(__builtin_amdgcn_fmed3f(a_[2], 0.f, 3.0e38f), wq[ct][2], tt_); tt_ = __builtin_fmaf(__builtin_amdgcn_fmed3f(a_[3], 0.f, 3.0e38f), wq[ct][3], tt_); \
            const int q_ = 4 * ct + fq; unsigned kk_ = ord16(tt_ + 0.0f); \
            if (!full_) kk_ = (key_ <= t0 + q_) ? kk_ : 0u; \
            if (DSA_PM == 1 && rs1 > 0) dummy_ ^= (short)kk_; else sc[q_ * 8192 + key_] = (unsigned short)kk_; \
            if ((R_S1 == 1 || rs1 == 0) && (full_ || kk_ != 0u)) __hip_atomic_fetch_add(hist + (q_ * 4 + (fr & 3)) * 128 + (kk_ >> 9), (kk_ & 0x100u) ? 65536u : 1u, __ATOMIC_RELAXED, __HIP_MEMORY_SCOPE_WORKGROUP); } } } } } while (0)
    short dummy_ = 0;
    _Pragma("nounroll") for (int rs1 = 0; rs1 < (((DSA_SKIP | X.dbg) & 1) ? 0 : R_S1); ++rs1)
    { bf16x8 ka[4][2], kb[4][2];
      if (ntw > 0) { DSA_LOAD4(ka, 0);
#pragma nounroll
        for (int i0 = 0; i0 < ntw; i0 += 8) { DSA_LOAD4(kb, i0 + 4); DSA_COMP4(ka, i0); DSA_LOAD4(ka, i0 + 8); DSA_COMP4(kb, i0 + 4); } } }
#undef DSA_LOAD4
#undef DSA_COMP4
    if (dummy_ == (short)0x1234 && t0 == 123457) sc[0] = 1;
    { const int z0 = nkt * 16, z1 = ((nk + 511) >> 9) << 9;
        for (int i = z0 + tid; i < z1; i += 512) {
#pragma unroll
            for (int q = 0; q < 8; ++q) sc[q * 8192 + i] = 0; } }
    __syncthreads();
    const int t = t0 + w, nv = t + 1;
    LAS unsigned short* row = sc + w * 8192;
    LAS unsigned short* list = (LAS unsigned short*)(X.lds + 131072 + w * 512);
    const int nsel = nv < 256 ? nv : 256;
    if (((DSA_SKIP | X.dbg) & 2) || nv <= 256) { for (int n = lane; n < 256; n += 64) list[n] = (unsigned short)n; }
    else {
        const int nit = (nv + 511) >> 9;
        LAS unsigned* H = hist + w * 512;
        int T1, above1;
        { u32x4 h4 = (u32x4){0u, 0u, 0u, 0u};
#pragma unroll
          for (int c4 = 0; c4 < 4; ++c4) { const u32x2 pw = *(const LAS u32x2*)(H + c4 * 128 + 2 * lane); h4.x += pw.x & 0xFFFFu; h4.y += pw.x >> 16; h4.z += pw.y & 0xFFFFu; h4.w += pw.y >> 16; }
          const int sl = (int)(h4.x + h4.y + h4.z + h4.w);
          int suf = sl;
#pragma unroll
          for (int o = 1; o < 64; o <<= 1) { const int dn = __shfl_down(suf, o); if (lane + o < 64) suf += dn; }
          const unsigned long long bm = __ballot(suf >= 256); const int L = 63 - __builtin_clzll(bm);
          const int hx = __shfl((int)h4.x, L), hy = __shfl((int)h4.y, L), hz = __shfl((int)h4.z, L), hw = __shfl((int)h4.w, L);
          const int sufn = __shfl(suf, L) - (hx + hy + hz + hw);
          int cb = sufn; T1 = 4 * L + 3; above1 = cb;
          if (cb + hw >= 256) { T1 = 4 * L + 3; above1 = cb; } else { cb += hw; if (cb + hz >= 256) { T1 = 4 * L + 2; above1 = cb; } else { cb += hz; if (cb + hy >= 256) { T1 = 4 * L + 1; above1 = cb; } else { cb += hy; T1 = 4 * L; above1 = cb; } } } }
        _Pragma("nounroll") for (int rs2 = 0; rs2 < R_S2; ++rs2) {
        *(LAS u32x4*)(H + 4 * lane) = (u32x4){0u, 0u, 0u, 0u};
        for (int it = 0; it < nit; ++it) { const u32x4 v = *(const LAS u32x4*)(row + (it * 64 + lane) * 8);
            const unsigned e[8] = {v.x & 0xFFFFu, v.x >> 16, v.y & 0xFFFFu, v.y >> 16, v.z & 0xFFFFu, v.z >> 16, v.w & 0xFFFFu, v.w >> 16};
#pragma unroll
            for (int j = 0; j < 8; ++j) if ((int)(e[j] >> 8) == T1) __hip_atomic_fetch_add(H + (e[j] & 255u), 1u, __ATOMIC_RELAXED, __HIP_MEMORY_SCOPE_WORKGROUP); }
        unsigned thr; int cgt, cge;
        { const u32x4 h4 = *(const LAS u32x4*)(H + 4 * lane); const int sl = (int)(h4.x + h4.y + h4.z + h4.w);
          int suf = sl;
#pragma unroll
          for (int o = 1; o < 64; o <<= 1) { const int dn = __shfl_down(suf, o); if (lane + o < 64) suf += dn; }
          const int need = 256 - above1;
          const unsigned long long bm = __ballot(suf >= need); const int L = 63 - __builtin_clzll(bm);
          const int hx = __shfl((int)h4.x, L), hy = __shfl((int)h4.y, L), hz = __shfl((int)h4.z, L), hw = __shfl((int)h4.w, L);
          int cb = __shfl(suf, L) - (hx + hy + hz + hw); int T2, hT;
          if (cb + hw >= need) { T2 = 4 * L + 3; hT = hw; } else { cb += hw; if (cb + hz >= need) { T2 = 4 * L + 2; hT = hz; } else { cb += hz; if (cb + hy >= need) { T2 = 4 * L + 1; hT = hy; } else { cb += hy; T2 = 4 * L; hT = hx; } } }
          thr = ((unsigned)T1 << 8) | (unsigned)T2; cgt = above1 + cb; cge = cgt + hT; }
        const bool exact = (cge == 256);
        const int r = 256 - cgt;
        const unsigned cmin = exact ? thr : thr + 1u;
        const unsigned long long lt_mask = (1ull << lane) - 1ull; int bcnt = 0;
        for (int it = 0; it < nit; ++it) { const u32x4 v = *(const LAS u32x4*)(row + (it * 64 + lane) * 8); const int base = (it * 64 + lane) * 8;
            const unsigned e[8] = {v.x & 0xFFFFu, v.x >> 16, v.y & 0xFFFFu, v.y >> 16, v.z & 0xFFFFu, v.z >> 16, v.w & 0xFFFFu, v.w >> 16};
#pragma unroll
            for (int j = 0; j < 8; ++j) { const bool sl = e[j] >= cmin; const unsigned long long bm = __ballot(sl);
                if (bm != 0ull) { if (sl) list[(bcnt + __popcll(bm & lt_mask)) & 255] = (unsigned short)(base + j); bcnt += __popcll(bm); } } }
        if (!exact) {
            int taken = 0;
            for (int it = 0; it < nit && taken < r; ++it) { const u32x4 v = *(const LAS u32x4*)(row + (it * 64 + lane) * 8); const int base = (it * 64 + lane) * 8;
                const unsigned e[8] = {v.x & 0xFFFFu, v.x >> 16, v.y & 0xFFFFu, v.y >> 16, v.z & 0xFFFFu, v.z >> 16, v.w & 0xFFFFu, v.w >> 16};
                int mcount = 0;
#pragma unroll
                for (int j = 0; j < 8; ++j) mcount += (e[j] == thr);
                if (__ballot(mcount != 0) == 0ull) continue;
                int incl = mcount;
#pragma unroll
                for (int o = 1; o < 64; o <<= 1) { const int up = __shfl_up(incl, o); if (lane >= o) incl += up; }
                const int total = __shfl(incl, 63); int rk = taken + incl - mcount;
#pragma unroll
                for (int j = 0; j < 8; ++j) if (e[j] == thr) { if (rk < r) list[(cgt + rk) & 255] = (unsigned short)(base + j); ++rk; }
                taken += total; }
        }
        }
    }
    __builtin_amdgcn_fence(__ATOMIC_RELEASE, "workgroup"); __builtin_amdgcn_wave_barrier();
    const bf16_t* qrow = pj + (unsigned)t * (unsigned)PJ;
    bf16x8 qb0 = (bf16x8){0, 0, 0, 0, 0, 0, 0, 0}, qb1 = qb0;
    if (fr < 4) { qb0 = *(const bf16x8*)(qrow + C_Q + fr * 64 + 8 * fq); qb1 = *(const bf16x8*)(qrow + C_Q + fr * 64 + 32 + 8 * fq); }
    LAS float* Pb = (LAS float*)row;
    LAS float* pinv = (LAS float*)(X.lds + 131072 + 4096 + 256 + w * 16);
    _Pragma("nounroll") for (int rs3 = 0; rs3 < (((DSA_SKIP | X.dbg) & 4) ? 0 : R_S3); ++rs3) {
    { LAS unsigned char* kbuf = (LAS unsigned char*)row + 4096;
      const int drow = lane >> 3, dchk = (lane & 7) ^ (drow & 7);
#define QK_DMA(G) do { _Pragma("unroll") for (int i_ = 0; i_ < 4; ++i_) { const unsigned ko_ = (unsigned)list[(G) * 32 + i_ * 8 + drow] * 64u + (unsigned)(dchk * 8); \
        __builtin_amdgcn_global_load_lds((const unsigned*)(k2 + ko_), (LAS unsigned*)(kbuf + ((G) % 3) * 4096 + i_ * 1024), 16, 0, 0); } } while (0)
#define QK_COMP(G) do { _Pragma("unroll") for (int j = 0; j < 2; ++j) { const LAS unsigned char* tb_ = kbuf + ((G) % 3) * 4096 + j * 2048 + fr * 128; \
        const bf16x8 k0_ = *(const LAS bf16x8*)(tb_ + ((fq ^ (fr & 7)) * 16)), k1_ = *(const LAS bf16x8*)(tb_ + (((4 + fq) ^ (fr & 7)) * 16)); \
        f32x4 a_ = mfma16(k0_, qb0, (f32x4){0.f, 0.f, 0.f, 0.f}); a_ = mfma16(k1_, qb1, a_); \
        if (fr < 4) { _Pragma("unroll") for (int i = 0; i < 4; ++i) { const int nn_ = ((G) * 2 + j) * 16 + 4 * fq + i; Pb[nn_ * 4 + fr] = (nn_ < nsel) ? a_[i] * 0.125f : -3.0e38f; } } } } while (0)
      asm volatile("s_waitcnt vmcnt(0)" ::: "memory");
      QK_DMA(0); QK_DMA(1);
      asm volatile("s_waitcnt vmcnt(4)" ::: "memory"); QK_COMP(0); QK_DMA(2);
      asm volatile("s_waitcnt vmcnt(4)" ::: "memory"); QK_COMP(1); asm volatile("s_waitcnt lgkmcnt(0)" ::: "memory"); QK_DMA(3);
      asm volatile("s_waitcnt vmcnt(4)" ::: "memory"); QK_COMP(2); asm volatile("s_waitcnt lgkmcnt(0)" ::: "memory"); QK_DMA(4);
      asm volatile("s_waitcnt vmcnt(4)" ::: "memory"); QK_COMP(3); asm volatile("s_waitcnt lgkmcnt(0)" ::: "memory"); QK_DMA(5);
      asm volatile("s_waitcnt vmcnt(4)" ::: "memory"); QK_COMP(4); asm volatile("s_waitcnt lgkmcnt(0)" ::: "memory"); QK_DMA(6);
      asm volatile("s_waitcnt vmcnt(4)" ::: "memory"); QK_COMP(5); asm volatile("s_waitcnt lgkmcnt(0)" ::: "memory"); QK_DMA(7);
      asm volatile("s_waitcnt vmcnt(4)" ::: "memory"); QK_COMP(6);
      asm volatile("s_waitcnt vmcnt(0)" ::: "memory"); QK_COMP(7);
#undef QK_DMA
#undef QK_COMP
    }
    __builtin_amdgcn_fence(__ATOMIC_RELEASE, "workgroup"); __builtin_amdgcn_wave_barrier();
    { const int hd = lane & 3, nb0 = lane >> 2;
        float v16[16]; float mx = -3.0e38f;
#pragma unroll
        for (int j = 0; j < 16; ++j) { v16[j] = Pb[(nb0 + 16 * j) * 4 + hd]; mx = fmaxf(mx, v16[j]); }
        mx = fmaxf(mx, __shfl_xor(mx, 4)); mx = fmaxf(mx, __shfl_xor(mx, 8)); mx = fmaxf(mx, __shfl_xor(mx, 16)); mx = fmaxf(mx, __shfl_xor(mx, 32));
        float sm = 0.f;
#pragma unroll
        for (int j = 0; j < 16; ++j) { const float p = (v16[j] > -1.0e38f) ? __expf(v16[j] - mx) : 0.f; sm += p; Pb[(nb0 + 16 * j) * 4 + hd] = p; }
        sm += __shfl_xor(sm, 4); sm += __shfl_xor(sm, 8); sm += __shfl_xor(sm, 16); sm += __shfl_xor(sm, 32);
        if (lane < 4) pinv[lane] = 1.0f / sm; }
    __builtin_amdgcn_fence(__ATOMIC_RELEASE, "workgroup"); __builtin_amdgcn_wave_barrier();
    f32x2 o2[4][2];
#pragma unroll
    for (int h = 0; h < 4; ++h) { o2[h][0] = (f32x2){0.f, 0.f}; o2[h][1] = (f32x2){0.f, 0.f}; }
    const int d4 = fr * 4;
#define PV_LOAD(VV, B) do { _Pragma("unroll") for (int j = 0; j < 16; ++j) { const unsigned vo_ = (unsigned)list[(B) * 64 + 4 * j + fq] * 64u + (unsigned)d4; VV[j] = *(const u32x2*)(v2 + vo_); } } while (0)
#define PV_COMP(VV, B) do { _Pragma("unroll") for (int j = 0; j < 16; ++j) { const f32x4 p4_ = *(const LAS f32x4*)(Pb + ((B) * 64 + 4 * j + fq) * 4); \
        const f32x2 va_ = (f32x2){bflo(VV[j].x), bfhi(VV[j].x)}, vb_ = (f32x2){bflo(VV[j].y), bfhi(VV[j].y)}; \
        _Pragma("unroll") for (int h = 0; h < 4; ++h) { const f32x2 pp_ = (f32x2){p4_[h], p4_[h]}; o2[h][0] = __builtin_elementwise_fma(va_, pp_, o2[h][0]); o2[h][1] = __builtin_elementwise_fma(vb_, pp_, o2[h][1]); } } } while (0)
    { u32x2 va[16], vb[16]; PV_LOAD(va, 0); PV_LOAD(vb, 1); PV_COMP(va, 0); PV_LOAD(va, 2); PV_COMP(vb, 1); PV_LOAD(vb, 3); PV_COMP(va, 2); PV_COMP(vb, 3); }
#undef PV_LOAD
#undef PV_COMP
    float o4[4][4];
#pragma unroll
    for (int h = 0; h < 4; ++h)
#pragma unroll
        for (int dd = 0; dd < 4; ++dd) { float v = o2[h][dd >> 1][dd & 1]; v += __shfl_xor(v, 16); v += __shfl_xor(v, 32); o4[h][dd] = v; }
    { const int h = fq; const float iv = pinv[h];
        float r4[4];
#pragma unroll
        for (int dd = 0; dd < 4; ++dd) r4[dd] = ((h == 0) ? o4[0][dd] : (h == 1) ? o4[1][dd] : (h == 2) ? o4[2][dd] : o4[3][dd]) * iv;
        u32x2 o; o.x = pk2(r4[0], r4[1]); o.y = pk2(r4[2], r4[3]);
        *(u32x2*)(X.ybuf() + (size_t)1 * M * 256 + ((size_t)b * SEQ + t) * 256 + h * 64 + d4) = o; }
    __builtin_amdgcn_fence(__ATOMIC_RELEASE, "workgroup"); __builtin_amdgcn_wave_barrier(); }
    __syncthreads();
}

constexpr int LR_HH = 0, LR_HL = 33280, LR_PART = 66560, LR_LG = 82944, LR_CNT = 84992, LR_PITCH = 1032;
__device__ __forceinline__ void ph_ln1_router(const Ctx& X, int l) {
    const int lane = X.lane, w = X.wave, tid = X.tid, fr = lane & 15, fq = lane >> 4;
    LAS bf16_t* Hh = (LAS bf16_t*)(X.lds + LR_HH); LAS bf16_t* Hl = (LAS bf16_t*)(X.lds + LR_HL);
    LAS float* part = (LAS float*)(X.lds + LR_PART);
    LAS float* lgt = (LAS float*)(X.lds + LR_LG);
    LAS unsigned* wgcnt = (LAS unsigned*)(X.lds + LR_CNT);
    if (tid < 32) wgcnt[tid] = 0u;
    bf16x8 Ahi[2][4], Alo[2][4];
    { const bf16_t* rf = (const bf16_t*)(X.ws + WS_RFR);
#pragma unroll
      for (int rt = 0; rt < 2; ++rt)
#pragma unroll
          for (int q = 0; q < 4; ++q) { const size_t o = ((size_t)(rt * 32 + 4 * w + q) * 64 + lane) * 8; Ahi[rt][q] = *(const bf16x8*)(rf + o); Alo[rt][q] = *(const bf16x8*)(rf + 32768 + o); } }
    float* xo = X.a->out; bf16_t* hb = X.hbuf(); float* xw = (X.dbg & 8) ? (float*)(X.ws + WS_ACT) : xo; const bf16_t* v16 = (const bf16_t*)(X.ws + WS_V16);
    const int tok0 = X.c * 128, b = tok0 >> 13;
    const float* mv = X.modv(l, 1) + b * 3072;
    const float* lg = X.in(I_LN1G) + l * D; const float* lb = X.in(I_LN1B) + l * D;
    const int e = lane & 31;
    const float rbias = X.in(I_RB)[l * NEXP + e];
    unsigned* pinfo = (unsigned*)(X.ws + WS_PINFO); float* pgate = (float*)(X.ws + WS_PGATE);
    __syncthreads();
    u32x2 raw[2][4];
#pragma unroll
    for (int jj = 0; jj < 2; ++jj)
#pragma unroll
        for (int j = 0; j < 4; ++j) raw[jj][j] = *(const u32x2*)(v16 + (size_t)(tok0 + 2 * w + jj) * D + 4 * lane + 256 * j);
    for (int pass = 0; pass < 8; ++pass) {
        f32x4 vv[2][4];
#pragma unroll
        for (int jj = 0; jj < 2; ++jj)
#pragma unroll
            for (int j = 0; j < 4; ++j) { const u32x2 q2 = raw[jj][j]; vv[jj][j] = (f32x4){bflo(q2.x), bfhi(q2.x), bflo(q2.y), bfhi(q2.y)}; }
        if (pass + 1 < 8) {
#pragma unroll
            for (int jj = 0; jj < 2; ++jj)
#pragma unroll
                for (int j = 0; j < 4; ++j) raw[jj][j] = *(const u32x2*)(v16 + (size_t)(tok0 + (pass + 1) * 16 + 2 * w + jj) * D + 4 * lane + 256 * j); }
#pragma unroll
        for (int jj = 0; jj < 2; ++jj) {
            const int r = 2 * w + jj, tok = tok0 + pass * 16 + r;
            f32x4 v[4]; float s = 0.f;
#pragma unroll
            for (int j = 0; j < 4; ++j) { v[j] = vv[jj][j]; s += (v[j][0] + v[j][1]) + (v[j][2] + v[j][3]); }
            const float mean = wave_sum(s) * (1.0f / D); float q = 0.f;
#pragma unroll
            for (int j = 0; j < 4; ++j) { v[j] = v[j] - mean; q += (v[j][0] * v[j][0] + v[j][1] * v[j][1]) + (v[j][2] * v[j][2] + v[j][3] * v[j][3]); }
            const float rstd = rsqrtf(wave_sum(q) * (1.0f / D) + LN_EPS);
#pragma unroll
            for (int j = 0; j < 4; ++j) { const int col = 4 * lane + 256 * j;
                const f32x4 x1 = v[j] * rstd * *(const f32x4*)(lg + col) + *(const f32x4*)(lb + col);
                *(f32x4*)(xw + (size_t)tok * D + col) = x1 * DN_ALPHA;
                const f32x4 hv = x1 * (*(const f32x4*)(mv + 1024 + col) + 1.0f) + *(const f32x4*)(mv + col);
                const unsigned h0 = f2bf(hv[0]), h1 = f2bf(hv[1]), h2 = f2bf(hv[2]), h3 = f2bf(hv[3]);
                u32x2 o; o.x = h0 | (h1 << 16); o.y = h2 | (h3 << 16); *(u32x2*)(hb + (size_t)tok * D + col) = o;
                *(LAS u32x2*)(Hh + r * LR_PITCH + col) = o;
                u32x2 ol; ol.x = pk2(hv[0] - bflo(h0), hv[1] - bflo(h1)); ol.y = pk2(hv[2] - bflo(h2), hv[3] - bflo(h3)); *(LAS u32x2*)(Hl + r * LR_PITCH + col) = ol; }
        }
        __syncthreads();
        {
            f32x4 acc0 = (f32x4){0.f, 0.f, 0.f, 0.f}, acc1 = acc0;
#pragma unroll
            for (int q = 0; q < 4; ++q) { const int ko = fr * LR_PITCH + (4 * w + q) * 32 + 8 * fq;
                const bf16x8 bh = *(const LAS bf16x8*)(Hh + ko), bl = *(const LAS bf16x8*)(Hl + ko);
                acc0 = mfma16(Ahi[0][q], bh, acc0); acc0 = mfma16(Ahi[0][q], bl, acc0); acc0 = mfma16(Alo[0][q], bh, acc0);
                acc1 = mfma16(Ahi[1][q], bh, acc1); acc1 = mfma16(Ahi[1][q], bl, acc1); acc1 = mfma16(Alo[1][q], bh, acc1); }
#pragma unroll
            for (int i = 0; i < 4; ++i) { part[(w * 32 + 4 * fq + i) * 16 + fr] = acc0[i]; part[(w * 32 + 16 + 4 * fq + i) * 16 + fr] = acc1[i]; }
        }
        __syncthreads();
        { const int ee = tid >> 4, tk = tid & 15; float sm = 0.f;
#pragma unroll
          for (int q = 0; q < 8; ++q) sm += part[(q * 32 + ee) * 16 + tk];
          lgt[tk * 32 + ee] = sm; }
        __syncthreads();
#pragma unroll
        for (int jj = 0; jj < 2; ++jj) {
            const int r = 2 * w + jj, tok = tok0 + pass * 16 + r;
            const float score = sigmoidf_(lgt[r * 32 + e]), biased = score + rbias;
            const int gbase = lane & ~3;
            const float v0 = __shfl(biased, gbase), v1 = __shfl(biased, gbase + 1), v2 = __shfl(biased, gbase + 2), v3 = __shfl(biased, gbase + 3);
            const float a_ = fmaxf(v0, v1), b_ = fminf(v0, v1), c_ = fmaxf(v2, v3), d_ = fminf(v2, v3);
            const float gs = fmaxf(a_, c_) + fmaxf(fminf(a_, c_), fmaxf(b_, d_));
            const int myg = e >> 2; int grank = 0;
#pragma unroll
            for (int g2 = 0; g2 < 8; ++g2) { const float o = __shfl(gs, 4 * g2); grank += (o > gs || (o == gs && g2 < myg)) ? 1 : 0; }
            const float masked = (grank < 4) ? biased : -3.0e38f;
            int erank = 0;
#pragma unroll
            for (int e2 = 0; e2 < 32; ++e2) { const float o = __shfl(masked, e2); erank += (o > masked || (o == masked && e2 < e)) ? 1 : 0; }
            const bool sel = (erank < 8) && (lane < 32);
            const float wsum = wave_sum(sel ? score : 0.f);
            const float gate = score / wsum * 2.5f;
            const unsigned long long bal = __ballot(sel);
            if (sel) { const int k = __popcll(bal & ((1ull << lane) - 1ull));
                const unsigned lr = __hip_atomic_fetch_add(wgcnt + e, 1u, __ATOMIC_RELAXED, __HIP_MEMORY_SCOPE_WORKGROUP);
                pinfo[(size_t)tok * 8 + k] = (unsigned)e | (lr << 8); pgate[(size_t)tok * 8 + k] = gate; }
        }
    }
    __syncthreads();
    if (tid < 32) { const int chunk = tok0 / CHTOK; unsigned* cnt = (unsigned*)(X.ws + WS_CTL) + CW_CNT + (l * NCH + chunk) * 64;
        const unsigned base = __hip_atomic_fetch_add(cnt + tid, wgcnt[tid], __ATOMIC_RELAXED, __HIP_MEMORY_SCOPE_AGENT);
        ((unsigned*)(X.ws + WS_WGBASE))[X.c * 32 + tid] = base; }
    __syncthreads();
}

__device__ __forceinline__ void moe_offsets(const Ctx& X, int l, int chunk, LAS int* off  , LAS int* cntl  ) {
    if (X.tid == 0) { const unsigned* cnt = (const unsigned*)(X.ws + WS_CTL) + CW_CNT + (l * NCH + chunk) * 64; int o = 0;
        for (int e = 0; e < NE1; ++e) { const int cn = (e < NEXP) ? (int)__hip_atomic_load(cnt + e, __ATOMIC_RELAXED, __HIP_MEMORY_SCOPE_AGENT) : CHTOK; off[e] = o; cntl[e] = cn; o += ((cn + 255) >> 8) << 8; }
        off[NE1] = o; }
    __syncthreads();
}
#define ST_WT(p, v) __hip_atomic_store((p), (v), __ATOMIC_RELAXED, __HIP_MEMORY_SCOPE_AGENT)
__device__ __forceinline__ void ph_fill(const Ctx& X, int l) {
    LAS int* off = (LAS int*)(X.lds); LAS int* cntl = off + 64;
    const int tok0 = X.c * 128, chunk = tok0 / CHTOK;
    moe_offsets(X, l, chunk, off, cntl);
    unsigned* rowtok = (unsigned*)(X.ws + WS_ROWTOK) + (size_t)chunk * CH_ROWS; float* rowgate = (float*)(X.ws + WS_ROWGATE) + (size_t)chunk * CH_ROWS;
    const unsigned* pinfo = (const unsigned*)(X.ws + WS_PINFO); const float* pgate = (const float*)(X.ws + WS_PGATE); unsigned* slot = (unsigned*)(X.ws + WS_SLOT);
    const unsigned* wgb = (const unsigned*)(X.ws + WS_WGBASE) + X.c * 32;
    for (int i = X.tid; i < 1024; i += 512) { const size_t pi = (size_t)tok0 * 8 + i; const unsigned inf = pinfo[pi]; const int e = inf & 255, lr = inf >> 8;
        const int pos = off[e] + (int)wgb[e] + lr; ST_WT(rowtok + pos, (unsigned)(tok0 + (i >> 3))); ST_WT((unsigned*)rowgate + pos, __builtin_bit_cast(unsigned, pgate[pi])); slot[pi] = (unsigned)pos; }
    if (X.tid < 128) { const int tok = tok0 + X.tid; const int pos = off[NEXP] + (tok - chunk * CHTOK); ST_WT(rowtok + pos, (unsigned)tok); ST_WT((unsigned*)rowgate + pos, __builtin_bit_cast(unsigned, 1.0f)); }
    const int wl = X.c & 63;
    if (wl < NEXP) { const int e = wl; const int p0 = off[e] + cntl[e], p1 = off[e + 1]; for (int p = p0 + X.tid; p < p1; p += 512) { ST_WT(rowtok + p, (unsigned)(chunk * CHTOK)); ST_WT((unsigned*)rowgate + p, 0u); } }
    __syncthreads();
}

template <int NT, bool GATH>
struct MoeOrder {
    static constexpr bool GATHER = GATH;
    int nwg, G, c; const LAS unsigned char* tile_e; const LAS int* rowtab;
    __device__ __forceinline__ bool next(int i, pg8::Unit& u) const {
        const long L = (long)i * G + c; if (L >= nwg) return false;
        const int wgid = pg8::xcd_remap((int)L, nwg); const int tau = wgid / NT, pn = wgid % NT;
        u.pm = tau; u.pn = pn; u.bt = __builtin_amdgcn_readfirstlane((int)tile_e[tau]) * NT + pn; u.ab = i; return true;
    }
    __device__ __forceinline__ int row_of(const pg8::Unit& u, int r) const { return rowtab[u.ab * 256 + r]; }
    __device__ __forceinline__ void a_ready(const pg8::Unit&) const {}
    __device__ __forceinline__ void done(const pg8::Unit&) const {}
};
template <int NT, bool GATH>
struct MoeOrderAll {
    static constexpr bool GATHER = GATH;
    int nwg, G, c; const LAS unsigned char* tile_e4; const LAS int* tprefix; const LAS int* rowtab; int tbase;
    __device__ __forceinline__ bool next(int i, pg8::Unit& u) const {
        const long L = (long)i * G + c; if (L >= nwg) return false;
        const int wgid = pg8::xcd_remap((int)L, nwg); const int gt = tbase + wgid / NT, pn = wgid % NT;
        int ch = 0;
#pragma unroll
        for (int q = 1; q < NCH; ++q) ch += (tprefix[q] <= gt) ? 1 : 0;
        ch = __builtin_amdgcn_readfirstlane(ch); const int tau = gt - __builtin_amdgcn_readfirstlane(tprefix[ch]);
        u.pm = ch * CH_TILES + tau; u.pn = pn; u.bt = __builtin_amdgcn_readfirstlane((int)tile_e4[ch * 336 + tau]) * NT + pn; u.ab = i; return true;
    }
    __device__ __forceinline__ int row_of(const pg8::Unit& u, int r) const { return rowtab[u.ab * 256 + r]; }
    __device__ __forceinline__ void a_ready(const pg8::Unit&) const {}
    __device__ __forceinline__ void done(const pg8::Unit&) const {}
};
__device__ __forceinline__ void moe_tables_all(const Ctx& X, int l, LAS int* off4, LAS unsigned char* tile_e4, LAS int* tprefix) {
    if (X.tid < NCH) { const int chn = X.tid; const unsigned* cnt = (const unsigned*)(X.ws + WS_CTL) + CW_CNT + (l * NCH + chn) * 64; int o = 0;
        for (int e = 0; e < NE1; ++e) { const int cn = (e < NEXP) ? (int)__hip_atomic_load(cnt + e, __ATOMIC_RELAXED, __HIP_MEMORY_SCOPE_AGENT) : CHTOK; off4[chn * 64 + e] = o; o += ((cn + 255) >> 8) << 8; }
        off4[chn * 64 + NE1] = o; }
    __syncthreads();
    if (X.tid == 0) { int a = 0; for (int q = 0; q < NCH; ++q) { tprefix[q] = a; a += off4[q * 64 + NE1] >> 8; } tprefix[NCH] = a; }
    for (int t = X.tid; t < NCH * 336; t += 512) { const int chn = t / 336, tau = t % 336; int e = 0; for (int q = 1; q < NE1; ++q) e += (off4[chn * 64 + q] <= tau * 256) ? 1 : 0; tile_e4[t] = (unsigned char)e; }
    __syncthreads();
}
__device__ __forceinline__ int moe_tiles(const Ctx& X, int l, int chunk, LAS unsigned char* tile_e, LAS int* off, LAS int* cntl) {
    moe_offsets(X, l, chunk, off, cntl);
    const int ntile = off[NE1] >> 8;
    for (int t = X.tid; t < ntile; t += 512) { int e = 0; for (int q = 1; q < NE1; ++q) e += (off[q] <= t * 256) ? 1 : 0; tile_e[t] = (unsigned char)e; }
    __syncthreads();
    return ntile;
}

__device__ __forceinline__ void ph_combine(const Ctx& X, int l, int c0, const LAS int* off4) {
    const int lane = X.lane; const int gw = X.c * 8 + X.wave; const int chunk = c0 + (gw >> 10);
    float* xo = X.a->out; bf16_t* hb = X.hbuf(); float* xw = (X.dbg & 8) ? (float*)(X.ws + WS_ACT) : xo;
    const unsigned char* op = (const unsigned char*)(X.ws + WS_OPAIR) + (size_t)(chunk - c0) * CH_ROWS * 1024; const unsigned* slot = (const unsigned*)(X.ws + WS_SLOT);
    const int b = (chunk * CHTOK) >> 13; const float* mv2 = X.modv(l, 1) + b * 3072;
    const float* lg = X.in(I_LN2G) + l * D; const float* lb = X.in(I_LN2B) + l * D;
    const int offsh = off4[chunk * 64 + NEXP];
#pragma unroll 1
    for (int i = 0; i < 8; i += 2) {
        const int tokA = c0 * CHTOK + gw * 8 + i;
        int pos[2][9];
#pragma unroll
        for (int t = 0; t < 2; ++t) {
            const u32x4 s0 = *(const u32x4*)(slot + (size_t)(tokA + t) * 8), s1 = *(const u32x4*)(slot + (size_t)(tokA + t) * 8 + 4);
            pos[t][0] = (int)s0.x; pos[t][1] = (int)s0.y; pos[t][2] = (int)s0.z; pos[t][3] = (int)s0.w; pos[t][4] = (int)s1.x; pos[t][5] = (int)s1.y; pos[t][6] = (int)s1.z; pos[t][7] = (int)s1.w;
            pos[t][8] = offsh + (tokA + t - chunk * CHTOK); }
        unsigned rw8[2][9][4];
#pragma unroll
        for (int t = 0; t < 2; ++t) {
#pragma unroll
            for (int k = 0; k < 9; ++k) { const unsigned ro = (unsigned)pos[t][k] * 1024u + 4u * (unsigned)lane;
#pragma unroll
                for (int j = 0; j < 4; ++j) rw8[t][k][j] = *(const unsigned*)(op + ro + 256 * j); } }
#pragma unroll
        for (int t = 0; t < 2; ++t) {
            const int tok = tokA + t;
            f32x4 sm[4];
#pragma unroll
            for (int j = 0; j < 4; ++j) sm[j] = (f32x4){0.f, 0.f, 0.f, 0.f};
#pragma unroll
            for (int k = 0; k < 9; ++k)
#pragma unroll
                for (int j = 0; j < 4; ++j) { const int q = (int)rw8[t][k][j]; const f32x2 lo = __builtin_amdgcn_cvt_pk_f32_fp8(q, false), hi = __builtin_amdgcn_cvt_pk_f32_fp8(q, true);
                    sm[j][0] += lo[0]; sm[j][1] += lo[1]; sm[j][2] += hi[0]; sm[j][3] += hi[1]; }
            f32x4 v[4]; float s = 0.f;
#pragma unroll
            for (int j = 0; j < 4; ++j) { const int col = 4 * lane + 256 * j; v[j] = *(const f32x4*)(xo + (size_t)tok * D + col) + (*(const f32x4*)(mv2 + 2048 + col) + 1.0f) * (sm[j] * (1.0f / O_SCALE)); s += (v[j][0] + v[j][1]) + (v[j][2] + v[j][3]); }
            const float mean = wave_sum(s) * (1.0f / D); float q = 0.f;
#pragma unroll
            for (int j = 0; j < 4; ++j) { v[j] = v[j] - mean; q += (v[j][0] * v[j][0] + v[j][1] * v[j][1]) + (v[j][2] * v[j][2] + v[j][3] * v[j][3]); }
            const float rstd = rsqrtf(wave_sum(q) * (1.0f / D) + LN_EPS);
#pragma unroll
            for (int j = 0; j < 4; ++j) { const int col = 4 * lane + 256 * j;
                const f32x4 x2 = v[j] * rstd * *(const f32x4*)(lg + col) + *(const f32x4*)(lb + col);
                *(f32x4*)(xw + (size_t)tok * D + col) = x2;
                if (l + 1 < DEPTH) { const float* mv1 = X.modv(l + 1, 0) + b * 3072; const f32x4 hn = x2 * (*(const f32x4*)(mv1 + 1024 + col) + 1.0f) + *(const f32x4*)(mv1 + col);
                    u32x2 o; o.x = pk2(hn[0], hn[1]); o.y = pk2(hn[2], hn[3]); *(u32x2*)(hb + (size_t)tok * D + col) = o; } }
        }
    }
}

struct POrder : pg8::StaticOrder { __device__ __forceinline__ bool next(int i, pg8::Unit& u) const { if (!pg8::StaticOrder::next(i, u)) return false; u.ab = u.pn >> 2; return true; } };
struct GOrder { static constexpr bool GATHER = false; int G, c;
    __device__ __forceinline__ bool next(int i, pg8::Unit& u) const { const int tile = (i >> 2) * G + c; if (tile >= 512) return false; const int wg = pg8::xcd_remap(tile, 512); const int br = i & 3, mt = wg & 3;
        u.pm = wg >> 2; u.pn = br * 4 + mt; u.bt = br * 4 + mt; u.ab = 0; return true; }
    __device__ __forceinline__ void a_ready(const pg8::Unit&) const {} __device__ __forceinline__ void done(const pg8::Unit&) const {} };
__global__ void __launch_bounds__(512, 2) fwd_kernel(Args args) {
    extern __shared__ __attribute__((aligned(16))) unsigned char lds_raw[];
    ArgsP ap = (ArgsP)__builtin_amdgcn_kernarg_segment_ptr();
    Ctx X; X.a = ap; X.ws = ap->ws; X.lds = (LAS unsigned char*)lds_raw;
    X.tid = threadIdx.x; X.lane = X.tid & 63; X.wave = __builtin_amdgcn_readfirstlane(X.tid >> 6); X.G = gridDim.x;
    { const int bx = blockIdx.x; X.bx = bx; X.c = (X.G % 8 == 0) ? (bx % 8) * (X.G / 8) + bx / 8 : bx; }
    const int c0_ = X.c, g0_ = X.G, bx0_ = X.bx, wave0_ = X.wave;
    volatile LAS unsigned* misc = (volatile LAS unsigned*)(X.lds + LDS_MISC);
    if (X.tid < 16) misc[X.tid] = 0u;
    __syncthreads();
    XcdBarrier bar; bar.bar = (unsigned*)(X.ws + WS_CTL) + CW_BAR; bar.x = 0; bar.st = misc;
#if !MK_PER_PHASE
    bar = xcd_barrier_post((unsigned*)(X.ws + WS_CTL) + CW_BAR, misc);
#endif
    const int lo = ap->ph_lo, hi = ap->ph_hi; int ph = 0;
#define RELAUNDER() do { int wv_ = wave0_; asm volatile("" : "+s"(wv_)); int t_ = wv_ * 64 + (int)__builtin_amdgcn_mbcnt_hi(~0u, __builtin_amdgcn_mbcnt_lo(~0u, 0u)); asm volatile("" : "+v"(t_)); X.tid = t_; X.lane = t_ & 63; X.wave = wv_; } while (0)
#define REPEAT(N, stmt) _Pragma("nounroll") for (int rp_ = 0; rp_ < (N); ++rp_) { stmt; if (rp_ + 1 < (N)) xcd_barrier(bar); }
#define PH_BEGIN if (ph >= lo && ph < hi) { { ArgsP apl = ap; asm volatile("" : "+s"(apl)); X.a = apl; X.ws = apl->ws; X.dbg = apl->dbg; int wv_ = wave0_; asm volatile("" : "+s"(wv_)); int t_ = wv_ * 64 + (int)__builtin_amdgcn_mbcnt_hi(~0u, __builtin_amdgcn_mbcnt_lo(~0u, 0u)); asm volatile("" : "+v"(t_)); X.tid = t_; X.lane = t_ & 63; X.wave = wv_; int c_ = c0_, g_ = g0_, b_ = bx0_; asm volatile("" : "+s"(c_), "+s"(g_), "+s"(b_)); X.c = c_; X.G = g_; X.bx = b_; } unsigned char* wb = X.ws + WS_W; LAS unsigned char* gl = X.lds; const float* xin = (l_ == 0) ? X.in(I_X) : (const float*)X.a->out; (void)wb; (void)gl; (void)xin;
#if MK_PER_PHASE
#define PH_END } ++ph;
#else
#define PH_END if (ph + 1 < hi) xcd_barrier(bar); } ++ph;
#endif
    int l_ = 0;
    PH_BEGIN if (EN_PROLOGUE) { REPEAT(R_MISC, ph_prologue(X)) } PH_END
    for (int l = 0; l < DEPTH; ++l) {
        l_ = l;
        PH_BEGIN if (EN_WCONV) { REPEAT(R_MISC, ph_wconv(X, l)) } PH_END
        PH_BEGIN if (EN_GWIN)  { pg8::Gemm g{X.hbuf(), (const bf16_t*)(wb + WO_IN), 1024, 0}; pg8::StaticOrder S; S.init(M, PJ, X.G, X.bx); pg8::EpiBf16 E{X.proj(), PJ};
            REPEAT(R_GWIN, (pg8::gemm_phase<pg8::EpiBf16, pg8::StaticOrder, G_ALIGN, G_SP2>(gl, g, S, E, X.tid))) } PH_END
        PH_BEGIN if (EN_MX1)  {
            if (!(X.dbg & 1)) mx_rope(X);
            _Pragma("nounroll") for (int rp_ = 0; rp_ < R_MIX; ++rp_) {
            if (!(X.dbg & 2)) for (int u = X.c; u < 256; u += X.G) mx_gmlp(X, l, u);
            if (!(X.dbg & 4)) for (int wu = X.c * 8 + X.wave; wu < 2048; wu += X.G * 8) mx_s5<1>(X, l, wu);
            __syncthreads();
            if (!(X.dbg & 8)) for (int u = X.c; u < 256; u += X.G) mx_ssd<1>(X, l, u); }
        } PH_END
        PH_BEGIN if (EN_MX2)  {
            if (!(X.dbg & 32)) { mx_ssd_carry(X); mx_s5_carry(X); } RELAUNDER();
            _Pragma("nounroll") for (int rp_ = 0; rp_ < R_DSA; ++rp_)
            for (int r = 0; r < 16; ++r) { const int cl = X.c & 63; const int uu = (r & 1) ? r * 64 + 63 - cl : r * 64 + cl; if (EN_DSA && !(X.dbg & 64) && X.c < 256) mx_dsa(X, X.c >> 6, uu * 8); }
            __syncthreads(); RELAUNDER();
            for (int wu = X.c * 8 + X.wave; EN_S53 && !(X.dbg & 16) && wu < 2048; wu += X.G * 8) mx_s5<3>(X, l, wu);
        } PH_END
        PH_BEGIN if (EN_GLU)  { for (int u = X.c; EN_SSD3 && u < 256; u += X.G) mx_ssd<3>(X, l, u);
            __syncthreads(); RELAUNDER();
            pg8::Gemm g{(const bf16_t*)(X.ws + WS_YCPRE), (const bf16_t*)(wb + WO_GLU), 256, 0}; pg8::StaticOrder S; S.init(M, 256, X.G, X.bx);
            pg8::EpiGlu E{(const bf16_t*)(X.ws + WS_YCPRE), X.ybuf() + (size_t)2 * M * 256, X.in(I_S5GLUB) + l * 256};
            REPEAT(R_GLU, (pg8::gemm_phase<pg8::EpiGlu, pg8::StaticOrder, G_ALIGN, G_SP2>(gl, g, S, E, X.tid))) } PH_END
        PH_BEGIN if (EN_GP)  { pg8::Gemm g{X.ybuf(), (const bf16_t*)(wb + WO_BR), 256, (size_t)M * 256};
            POrder S;
            S.init(M, 4096, X.G, X.bx); pg8::EpiFp8 E{(unsigned char*)(X.ws + WS_P), 4096, P_SCALE};
            REPEAT(R_GP, (pg8::gemm_phase<pg8::EpiFp8, POrder, false, G_SP2>(gl, g, S, E, X.tid))) } PH_END
        PH_BEGIN if (EN_GGATE)  { pg8::Gemm g{X.hbuf(), (const bf16_t*)(wb + WO_GATE), 1024, 0};
            GOrder S{X.G, X.bx};
            pg8::EpiGateMerge E{(const unsigned char*)(X.ws + WS_P), X.ybuf(), 1.0f / P_SCALE};
            REPEAT(R_GGATE, (pg8::gemm_phase<pg8::EpiGateMerge, GOrder, G_ALIGN, G_SP2>(gl, g, S, E, X.tid))) } PH_END
        PH_BEGIN if (EN_GOUT)  { pg8::Gemm g{X.ybuf(), (const bf16_t*)(wb + WO_OUT), 1024, 0}; pg8::StaticOrder S; S.init(M, 1024, X.G, X.bx);
            pg8::EpiResid E{xin, (bf16_t*)(X.ws + WS_V16), X.modv(l, 0)};
            pg8::gemm_phase<pg8::EpiResid, pg8::StaticOrder, G_ALIGN, G_SP2>(gl, g, S, E, X.tid); } PH_END
        PH_BEGIN if (EN_LN1)  ph_ln1_router(X, l); PH_END
        PH_BEGIN if (EN_FILL) { REPEAT(R_MISC, ph_fill(X, l)) } PH_END
        PH_BEGIN if (EN_MOE1)  {
            LAS int* off4 = (LAS int*)(X.lds + LDS_TAB + 1024); LAS unsigned char* tile_e4 = (LAS unsigned char*)(X.lds + LDS_TAB + 2048); LAS int* tprefix = (LAS int*)(X.lds + LDS_TAB + 3584);
            moe_tables_all(X, l, off4, tile_e4, tprefix);
            pg8::Gemm g{X.hbuf(), (const bf16_t*)(wb + WO_13), 1024, 0};
            LAS int* rowtab = (LAS int*)(X.lds + LDS_TAB + 4096);
            MoeOrderAll<2, true> S{tprefix[NCH] * 2, X.G, X.bx, tile_e4, tprefix, rowtab, 0};
            { const unsigned* rowtok = (const unsigned*)(X.ws + WS_ROWTOK); pg8::Unit uu;
              const float* rowgate = (const float*)(X.ws + WS_ROWGATE); LAS float* gtabw = (LAS float*)(X.lds + LDS_TAB + 4096 + 12288);
              _Pragma("nounroll") for (int i = 0; i < 12; ++i) { if (!S.next(i, uu)) break; const int pmu = __builtin_amdgcn_readfirstlane(uu.pm);
                  if (X.tid < 256) { rowtab[i * 256 + X.tid] = (int)rowtok[(size_t)pmu * 256 + X.tid]; gtabw[i * 256 + X.tid] = rowgate[(size_t)pmu * 256 + X.tid]; } } }
            __syncthreads();
            pg8::EpiMoe1 E{(bf16_t*)(X.ws + WS_ACT), (const LAS float*)(X.lds + LDS_TAB + 4096 + 12288)};
            REPEAT(R_MOE, (pg8::gemm_phase<pg8::EpiMoe1, MoeOrderAll<2, true>, G_ALIGN, G_SP2>(gl, g, S, E, X.tid)))
        } PH_END
        for (int c0 = 0; c0 < NCH; c0 += 2) {
            PH_BEGIN if (EN_MOE2)  {
                LAS int* off4 = (LAS int*)(X.lds + LDS_TAB + 1024); LAS unsigned char* tile_e4 = (LAS unsigned char*)(X.lds + LDS_TAB + 2048); LAS int* tprefix = (LAS int*)(X.lds + LDS_TAB + 3584);
                moe_tables_all(X, l, off4, tile_e4, tprefix);
                pg8::Gemm g{(const bf16_t*)(X.ws + WS_ACT), (const bf16_t*)(wb + WO_2), 256, 0};
                MoeOrderAll<4, false> S{(tprefix[c0 + 2] - tprefix[c0]) * 4, X.G, X.bx, tile_e4, tprefix, nullptr, tprefix[c0]};
                pg8::EpiFp8 E{(unsigned char*)(X.ws + WS_OPAIR) - (size_t)c0 * CH_ROWS * 1024, 1024, O_SCALE};
                REPEAT(R_MOE, (pg8::gemm_phase<pg8::EpiFp8, MoeOrderAll<4, false>, false, G_SP2>(gl, g, S, E, X.tid)))
            } PH_END
            PH_BEGIN if (EN_FIN)  { LAS int* off4 = (LAS int*)(X.lds + LDS_TAB + 1024); LAS unsigned char* tile_e4 = (LAS unsigned char*)(X.lds + LDS_TAB + 2048); LAS int* tprefix = (LAS int*)(X.lds + LDS_TAB + 3584);
                moe_tables_all(X, l, off4, tile_e4, tprefix); ph_combine(X, l, c0, off4); } PH_END
        }
    }
#undef PH_BEGIN
#undef PH_END
}
constexpr int N_PHASES = 1 + DEPTH * (10 + 1 + NCH);

#ifdef DBG_DUMP_OFF
__global__ void dbg_dump(const bf16_t* src, float* out, size_t n) { for (size_t i = (size_t)blockIdx.x * blockDim.x + threadIdx.x; i < n; i += (size_t)gridDim.x * blockDim.x) {
#ifdef DBG_HASH_OUT
    const unsigned bits = __builtin_bit_cast(unsigned, out[i]); out[i] = (float)((bits * 2654435761u) >> 8) * (1.0f / 16777216.0f);
#else
    const unsigned bits = src[i]; out[i] = (float)(((bits + 1u) * 2654435761u) >> 8) * (1.0f / 16777216.0f);
#endif
} }
#endif
extern "C" void kernel_launch(void* const* d_in, const int* in_sizes, int n_in, void* d_out, int out_size, void* d_ws, size_t ws_size, hipStream_t stream) {
    static int grid = 0;
    if (grid == 0) {
        if (n_in != 43 || out_size != M * D || ws_size < WS_NEED) { fprintf(stderr, "kernel_launch: unexpected shapes (n_in %d out %d ws %zu)\n", n_in, out_size, ws_size); grid = -1; return; }
        int dev = 0, cus = 0, per_cu = 0;
        if (hipGetDevice(&dev) != hipSuccess || hipDeviceGetAttribute(&cus, hipDeviceAttributeMultiprocessorCount, dev) != hipSuccess) { grid = -1; return; }
        if (hipFuncSetAttribute((const void*)fwd_kernel, hipFuncAttributeMaxDynamicSharedMemorySize, LDS_BYTES) != hipSuccess) { fprintf(stderr, "kernel_launch: hipFuncSetAttribute failed\n"); grid = -1; return; }
        if (hipOccupancyMaxActiveBlocksPerMultiprocessor(&per_cu, (const void*)fwd_kernel, 512, LDS_BYTES) != hipSuccess || per_cu < 1) fprintf(stderr, "kernel_launch: occupancy query says %d\n", per_cu);
        (void)hipGetLastError();
        grid = cus < 256 ? cus : 256;
    }
    if (grid < 0) return;
    (void)hipMemsetAsync((char*)d_ws + WS_CTL, 0, CTL_BYTES, stream);
#ifdef DBG_POISON
    (void)hipMemsetAsync((char*)d_ws + CTL_BYTES, 0xFF, WS_NEED - CTL_BYTES, stream);
    (void)hipMemsetAsync((char*)d_out, 0xFF, (size_t)M * D * 4, stream);
#endif
    Args a{};
    for (int i = 0; i < 43; ++i) a.in[i] = (const float*)d_in[i];
    a.positions = (const int*)d_in[I_POS]; a.out = (float*)d_out; a.ws = (unsigned char*)d_ws;
#if MK_PER_PHASE
#ifndef DBG_NPH
#define DBG_NPH N_PHASES
#endif
    for (int p = 0; p < DBG_NPH; ++p) { a.ph_lo = p; a.ph_hi = p + 1; hipLaunchKernelGGL(fwd_kernel, dim3(grid), dim3(512), LDS_BYTES, stream, a); }
#ifdef DBG_DUMP_OFF
    hipLaunchKernelGGL(dbg_dump, dim3(2048), dim3(256), 0, stream, (const bf16_t*)((const char*)d_ws + (size_t)(DBG_DUMP_OFF)), (float*)d_out, (size_t)M * D);
#endif
#else
    a.ph_lo = 0; a.ph_hi = N_PHASES; hipLaunchKernelGGL(fwd_kernel, dim3(grid), dim3(512), LDS_BYTES, stream, a);
#ifdef DBG_EXTRA_PH
    a.dbg = DBG_EXTRA_FLAGS;
    for (int rep = 0; rep < DBG_EXTRA_REP; ++rep) { a.ph_lo = DBG_EXTRA_PH; a.ph_hi = DBG_EXTRA_PH + 1; hipLaunchKernelGGL(fwd_kernel, dim3(grid), dim3(512), LDS_BYTES, stream, a); }
#endif
#endif
}
```

```cpp
#include <hip/hip_runtime.h>
#include <cstdio>
#include <cstdint>


#ifndef DSA_SKIP
#define DSA_SKIP 0
#endif
#ifndef DSA_PM
#define DSA_PM 0
#endif
#ifndef R_S1
#define R_S1 1
#endif
#ifndef R_S2
#define R_S2 1
#endif
#ifndef R_S3
#define R_S3 1
#endif
#ifndef EN_DSA
#define EN_DSA 1
#endif
#ifndef EN_S53
#define EN_S53 1
#endif
#ifndef EN_SSD3
#define EN_SSD3 1
#endif
#ifndef R_GWIN
#define R_GWIN 1
#endif
#ifndef R_GLU
#define R_GLU 1
#endif
#ifndef R_GP
#define R_GP 1
#endif
#ifndef R_GGATE
#define R_GGATE 1
#endif
#ifndef R_DENSE
#define R_DENSE 1
#endif
#ifndef R_MOE
#define R_MOE 1
#endif
#ifndef R_DSA
#define R_DSA 1
#endif
#ifndef R_MIX
#define R_MIX 1
#endif
#ifndef R_MISC
#define R_MISC 1
#endif
#ifndef MK_PER_PHASE
#define MK_PER_PHASE 0
#endif

#ifndef EN_PROLOGUE
#define EN_PROLOGUE 1
#endif
#ifndef EN_WCONV
#define EN_WCONV 1
#endif
#ifndef EN_GWIN
#define EN_GWIN 1
#endif
#ifndef EN_MX1
#define EN_MX1 1
#endif
#ifndef EN_MX2
#define EN_MX2 1
#endif
#ifndef EN_GLU
#define EN_GLU 1
#endif
#ifndef EN_GP
#define EN_GP 1
#endif
#ifndef EN_GGATE
#define EN_GGATE 1
#endif
#ifndef EN_GOUT
#define EN_GOUT 1
#endif
#ifndef EN_LN1
#define EN_LN1 1
#endif
#ifndef EN_FILL
#define EN_FILL 1
#endif
#ifndef EN_MOE1
#define EN_MOE1 1
#endif
#ifndef EN_MOE2
#define EN_MOE2 1
#endif
#ifndef EN_FIN
#define EN_FIN 1
#endif
#ifndef G_ALIGN
#define G_ALIGN true
#endif
#ifndef G_SP2
#define G_SP2 true
#endif
#define LAS __attribute__((address_space(3)))
#define GAS __attribute__((address_space(1)))
typedef unsigned short bf16_t;
typedef short bf16x8 __attribute__((ext_vector_type(8)));
typedef float f32x4 __attribute__((ext_vector_type(4)));
typedef float f32x2 __attribute__((ext_vector_type(2)));
typedef unsigned u32x4 __attribute__((ext_vector_type(4)));
typedef unsigned u32x2 __attribute__((ext_vector_type(2)));

constexpr int NB = 4, SEQ = 8192, M = NB * SEQ, D = 1024, DEPTH = 2;
constexpr int PJ = 2304;
constexpr int C_GU = 0, C_GV = 256, C_Q = 512, C_K = 768, C_V = 832, C_QI = 896, C_KI = 1152, C_S5 = 1216, C_Z = 1472, C_XBC = 1728, C_WI = 2240, C_DT = 2244;
constexpr int D_IN = 2248;
constexpr int NEXP = 32, NE1 = 33;
constexpr int NCH = 4, CHTOK = M / NCH;
constexpr int CH_ROWS = CHTOK * 8 + CHTOK + NE1 * 256;
constexpr float DN_ALPHA = 1.41421356237f;
constexpr float LN_EPS = 1e-5f, RMS_EPS = 1e-6f;
#ifndef PFP8
#define PFP8 1
#endif
constexpr float P_SCALE = 8.0f, O_SCALE = 32.0f;

constexpr size_t MiB = 1u << 20;
constexpr size_t WS_CTL = 0, CTL_BYTES = 1 * MiB;
constexpr size_t WS_MODV = 1 * MiB;
constexpr size_t WS_S5B = WS_MODV + 256 * 1024;
constexpr size_t WS_S5C = WS_S5B + 64 * 1024;
constexpr size_t WS_S5A = WS_S5C + 64 * 1024;
constexpr size_t WS_GMW = WS_S5A + 64 * 1024;
constexpr size_t WS_RFR = WS_GMW + 128 * 1024;
static_assert(WS_RFR + 128 * 1024 <= 2 * MiB, "misc tables");
constexpr size_t WS_S5ST = 2 * MiB;
constexpr size_t WS_ATOT = 3 * MiB;
constexpr size_t WS_WGBASE = 3 * MiB + 64 * 1024;
constexpr size_t WS_PINFO = 4 * MiB;
constexpr size_t WS_PGATE = 5 * MiB;
constexpr size_t WS_SLOT = 6 * MiB;
constexpr size_t WS_ROWTOK = 7 * MiB;
constexpr size_t WS_ROWGATE = 9 * MiB;
constexpr size_t WS_S5HIN = 11 * MiB;
constexpr size_t WS_ROPE = 12 * MiB;
constexpr size_t WS_W = 24 * MiB;
constexpr size_t WO_IN = 0, WO_GATE = WO_IN + (size_t)PJ * 1024 * 2, WO_BR = WO_GATE + (size_t)4096 * 1024 * 2, WO_OUT = WO_BR + (size_t)4 * 1024 * 256 * 2,
                 WO_GLU = WO_OUT + (size_t)1024 * 1024 * 2, WO_13 = WO_GLU + (size_t)256 * 256 * 2, WO_2 = WO_13 + (size_t)NE1 * 512 * 1024 * 2, WO_END = WO_2 + (size_t)NE1 * 1024 * 256 * 2;
static_assert(WO_END <= 72 * MiB, "weights region");
constexpr size_t WS_H = 96 * MiB;
constexpr size_t WS_Y = 160 * MiB;
constexpr size_t WS_PROJ = 224 * MiB;
constexpr size_t WS_P = 224 * MiB;
constexpr size_t WS_SSDST = 368 * MiB;
constexpr size_t WS_SSDSIN = 400 * MiB;
constexpr size_t WS_KI2 = 408 * MiB, WS_K2 = 412 * MiB, WS_V2 = 416 * MiB;
constexpr size_t WS_YCPRE = 384 * MiB;
constexpr size_t WS_V16 = 224 * MiB;
constexpr size_t WS_ACT = 160 * MiB;
constexpr size_t WS_OPAIR = 321 * MiB;
static_assert(CH_ROWS % 256 == 0 && WS_ACT + (size_t)NCH * CH_ROWS * 512 <= WS_OPAIR && WS_OPAIR + (size_t)2 * CH_ROWS * 1024 <= 512 * MiB, "moe buffers");
constexpr int CH_TILES = CH_ROWS / 256;
constexpr size_t WS_NEED = 512 * MiB;
constexpr int CW_BAR = 4096;
constexpr int CW_CNT = 16384;

constexpr int LDS_BYTES = 160 * 1024;
constexpr int LDS_TAB = 131072;
constexpr int LDS_MISC = LDS_BYTES - 256;

__device__ __forceinline__ unsigned f2bf(float f) { unsigned u = __builtin_bit_cast(unsigned, f); return (u + 0x7fffu + ((u >> 16) & 1u)) >> 16; }
__device__ __forceinline__ unsigned pk2(float lo, float hi) { return f2bf(lo) | (f2bf(hi) << 16); }
__device__ __forceinline__ float bf2f(unsigned short b) { return __builtin_bit_cast(float, (unsigned)b << 16); }
__device__ __forceinline__ float bflo(unsigned w) { return __builtin_bit_cast(float, w << 16); }
__device__ __forceinline__ float bfhi(unsigned w) { return __builtin_bit_cast(float, w & 0xffff0000u); }
__device__ __forceinline__ float wave_sum(float v) {
#pragma unroll
    for (int o = 1; o < 64; o <<= 1) v += __shfl_xor(v, o);
    return v;
}
__device__ __forceinline__ float wave_max(float v) {
#pragma unroll
    for (int o = 1; o < 64; o <<= 1) v = fmaxf(v, __shfl_xor(v, o));
    return v;
}
__device__ __forceinline__ int wave_sum_i(int v) {
#pragma unroll
    for (int o = 1; o < 64; o <<= 1) v += __shfl_xor(v, o);
    return v;
}
__device__ __forceinline__ float sigmoidf_(float x) { return __builtin_amdgcn_rcpf(1.0f + __expf(-x)); }
__device__ __forceinline__ float siluf_(float x) { return x * __builtin_amdgcn_rcpf(1.0f + __expf(-x)); }
__device__ __forceinline__ float gelu_tanh(float x) { const float u = 1.5957691216057308f * (x + 0.044715f * x * x * x); return x * __builtin_amdgcn_rcpf(1.0f + __expf(-u)); }
__device__ __forceinline__ float softplusf_(float x) { return fmaxf(x, 0.f) + log1pf(__expf(-fabsf(x))); }
__device__ __forceinline__ void sincos_red(float ang, float& sn, float& cs) {
    const double a = (double)ang; const double q = __builtin_rint(a * 0.63661977236758134308);
    const float r = (float)(a - q * 1.57079632679489661923); const int qi = (int)q & 3;
    const float r2 = r * r;
    const float s = r * (1.0f + r2 * (-1.6666667e-1f + r2 * (8.3333333e-3f + r2 * (-1.9841270e-4f + r2 * 2.7557319e-6f))));
    const float c = 1.0f + r2 * (-0.5f + r2 * (4.1666667e-2f + r2 * (-1.3888889e-3f + r2 * (2.4801587e-5f + r2 * -2.7557319e-7f))));
    sn = (qi == 0) ? s : (qi == 1) ? c : (qi == 2) ? -s : -c;
    cs = (qi == 0) ? c : (qi == 1) ? -s : (qi == 2) ? -c : s;
}
__device__ __forceinline__ f32x4 mfma16(bf16x8 a, bf16x8 b, f32x4 c) { return __builtin_amdgcn_mfma_f32_16x16x32_bf16(a, b, c, 0, 0, 0); }
__device__ __forceinline__ unsigned cvt_pk_bf16(float lo, float hi) { unsigned r; asm volatile("v_cvt_pk_bf16_f32 %0, %1, %2" : "=v"(r) : "v"(lo), "v"(hi)); return r; }

namespace pg8 {
constexpr int BM = 256, BK = 64, HALF = 128, HTB = HALF * BK * 2, STAGE_BYTES = 8 * HTB, NXCD = 8, WGM = 8;
__host__ __device__ __forceinline__ int lds_byte(int r, int c) { const int st = (r >> 4) * 2 + (c >> 5), rr = r & 15, cc = c & 31, ob = rr * 64 + cc * 2; return st * 1024 + (ob ^ (((ob >> 9) & 1) << 5)); }
__host__ __device__ __forceinline__ void stage_rc(int b, int& R, int& C) { const int st = b / 1024, sb = b % 1024, swz = sb ^ (((sb >> 9) & 1) << 5); R = (st >> 1) * 16 + swz / 64; C = (st & 1) * 32 + (swz % 64) / 2; }
__host__ __device__ __forceinline__ int perm32(int rho) { const int n = rho >> 4, i = rho & 15; return 8 * (i >> 2) + 4 * n + (i & 3); }

struct Unit { int pm, pn, bt, ab; };
struct Gemm { const bf16_t* A; const bf16_t* Bt; int K; size_t a_sel_stride; };

__device__ __forceinline__ int xcd_remap(int wgid, int nwg) { const int q = nwg / NXCD, r = nwg % NXCD, xcd = wgid % NXCD, off = wgid / NXCD; return (xcd < r ? xcd * (q + 1) : r * (q + 1) + (xcd - r) * q) + off; }

struct StaticOrder {
    static constexpr bool GATHER = false;
    int nM, nN, nwg, G, c;
    __device__ void init(int Mr, int N, int G_, int c_) { nM = Mr / BM; nN = N / BM; nwg = nM * nN; G = G_; c = c_; }
    __device__ __forceinline__ bool next(int i, Unit& u) const {
        const long L = (long)i * G + c; if (L >= nwg) return false;
        const int wgid = xcd_remap((int)L, nwg);
        const int nig = WGM * nN, gid = wgid / nig, fm = gid * WGM, gsz = (nM - fm) < WGM ? (nM - fm) : WGM;
        u.pm = fm + ((wgid % nig) % gsz); u.pn = (wgid % nig) / gsz; u.bt = u.pn; u.ab = 0; return true;
    }
    __device__ __forceinline__ void a_ready(const Unit&) const {}
    __device__ __forceinline__ void done(const Unit&) const {}
};

template <class Epi, class Sched, bool ALIGN_EPI = false, bool SP2 = true>
__device__ __forceinline__ void gemm_phase(LAS unsigned char* lds, const Gemm g, const Sched& S, const Epi& E, const int tid) {
    const int wid = __builtin_amdgcn_readfirstlane(tid >> 6), lane = tid & 63, wr = wid >> 2, wc = wid & 3, fr = lane & 15, fq = lane >> 4;
    const int K = g.K, nt = K / BK;
    unsigned voffA[2], voffB[2];
#pragma unroll
    for (int i = 0; i < 2; ++i) { int R, C; stage_rc(tid * 16 + i * 8192, R, C); const int Rb = Epi::PERM ? ((R & ~31) + perm32(R & 31)) : R;
        voffA[i] = (unsigned)(R * K + C) * 2u; voffB[i] = (unsigned)(Rb * K + C) * 2u; }
    const size_t kstep = (size_t)(BK * 2);
    const size_t hstep = (size_t)HALF * K * 2;
    const size_t tstep = 2 * hstep;
    const unsigned ldsw = (unsigned)wid * 1024u;
    const int aoff = lds_byte(wr * 64 + fr, fq * 8), boff = lds_byte(wc * 32 + fr, fq * 8);
#define PG8_SA(b, h) (((b) * 2 + (h)) * HTB)
#define PG8_SB(b, h) ((4 + (b) * 2 + (h)) * HTB)
#define PG8_STAGE(bufoff, gbase, voff) do { _Pragma("unroll") for (int _i = 0; _i < 2; ++_i) \
        __builtin_amdgcn_global_load_lds((const unsigned*)((const char*)(gbase) + (voff)[_i]), (LAS unsigned*)(lds + (bufoff) + ldsw + _i * 8192), 16, 0, 0); } while (0)
#define PG8_GO(u) do { _Pragma("unroll") for (int _h = 0; _h < 2; ++_h) _Pragma("unroll") for (int _i = 0; _i < 2; ++_i) { int _R, _C; stage_rc(tid * 16 + _i * 8192, _R, _C); \
        cgo[_h][_i] = (unsigned)S.row_of(u, _h * HALF + _R) * (unsigned)(K * 2) + (unsigned)_C * 2u; } } while (0)
#define PG8_STAGE_A(bufoff, base, h, kb, NX) do { if constexpr (Sched::GATHER) { _Pragma("unroll") for (int _i = 0; _i < 2; ++_i) \
        __builtin_amdgcn_global_load_lds((const unsigned*)((const char*)g.A + (kb) + cgo[h][_i]), (LAS unsigned*)(lds + (bufoff) + ldsw + _i * 8192), 16, 0, 0); } \
        else { PG8_STAGE(bufoff, (base) + (size_t)(h) * hstep + (kb), voffA); } } while (0)
#define PG8_LDA(dst, b, h) do { _Pragma("unroll") for (int m = 0; m < 4; ++m) _Pragma("unroll") for (int k = 0; k < 2; ++k) dst[m][k] = *(const LAS bf16x8*)(lds + PG8_SA(b, h) + aoff + m * 2048 + k * 1024); } while (0)
#define PG8_LDB(dst, b, h) do { _Pragma("unroll") for (int n = 0; n < 2; ++n) _Pragma("unroll") for (int k = 0; k < 2; ++k) dst[n][k] = *(const LAS bf16x8*)(lds + PG8_SB(b, h) + boff + n * 2048 + k * 1024); } while (0)
#define PG8_MMA(ai, bj, At, Bt) do { __builtin_amdgcn_s_setprio(1); _Pragma("unroll") for (int m = 0; m < 4; ++m) _Pragma("unroll") for (int n = 0; n < 2; ++n) _Pragma("unroll") for (int k = 0; k < 2; ++k) \
        acc[ai][bj][m][n] = __builtin_amdgcn_mfma_f32_16x16x32_bf16(Bt[n][k], At[m][k], acc[ai][bj][m][n], 0, 0, 0); __builtin_amdgcn_s_setprio(0); } while (0)
#define PG8_WAIT_V(n) asm volatile("s_waitcnt vmcnt(" #n ")" ::: "memory")
#define PG8_WAIT_L(n) asm volatile("s_waitcnt lgkmcnt(" #n ")" ::: "memory")
#define PG8_BAR __builtin_amdgcn_s_barrier()
#define PG8_SCHED __builtin_amdgcn_sched_barrier(0)
    Unit cur, nxt; int ui = 0;
    if (!S.next(0, cur)) return;
    f32x4 acc[2][2][4][2];
#pragma unroll
    for (int a = 0; a < 2; ++a)
#pragma unroll
        for (int b = 0; b < 2; ++b)
#pragma unroll
            for (int m = 0; m < 4; ++m)
#pragma unroll
                for (int n = 0; n < 2; ++n) acc[a][b][m][n] = (f32x4){0.f, 0.f, 0.f, 0.f};
    bf16x8 At[4][2], B0[2][2], B1[2][2];
    unsigned cgo[2][2];
    if constexpr (Sched::GATHER) PG8_GO(cur);
    const char* cA = (const char*)(g.A + (size_t)cur.ab * g.a_sel_stride) + (size_t)cur.pm * tstep; const char* cB = (const char*)g.Bt + (size_t)cur.bt * tstep;
    S.a_ready(cur);
    if constexpr (SP2) {
        PG8_STAGE(PG8_SB(0, 0), cB, voffB); PG8_STAGE(PG8_SB(0, 1), cB + hstep, voffB); PG8_STAGE_A(PG8_SA(0, 0), cA, 0, (size_t)0, false); PG8_STAGE_A(PG8_SA(0, 1), cA, 1, (size_t)0, false);
        if (wr == 1) PG8_BAR;
        PG8_WAIT_V(2); PG8_BAR;
        PG8_STAGE(PG8_SB(1, 0), cB + kstep, voffB); PG8_STAGE_A(PG8_SA(1, 0), cA, 0, kstep, false); PG8_STAGE(PG8_SB(1, 1), cB + hstep + kstep, voffB);
        PG8_WAIT_V(6); PG8_BAR;
    } else {
        PG8_STAGE(PG8_SB(0, 0), cB, voffB); PG8_STAGE_A(PG8_SA(0, 0), cA, 0, (size_t)0, false); PG8_STAGE(PG8_SB(0, 1), cB + hstep, voffB); PG8_STAGE_A(PG8_SA(0, 1), cA, 1, (size_t)0, false);
        if (wr == 1) PG8_BAR;
        PG8_WAIT_V(4); PG8_BAR;
        PG8_STAGE(PG8_SB(1, 0), cB + kstep, voffB); PG8_STAGE_A(PG8_SA(1, 0), cA, 0, kstep, false); PG8_STAGE(PG8_SB(1, 1), cB + hstep + kstep, voffB);
        PG8_WAIT_V(6); PG8_BAR;
    }
    for (;;) {
        const bool has_next = S.next(ui + 1, nxt);
        const char* nA = has_next ? (const char*)(g.A + (size_t)nxt.ab * g.a_sel_stride) + (size_t)nxt.pm * tstep : cA; const char* nB = has_next ? (const char*)g.Bt + (size_t)nxt.bt * tstep : cB;
#pragma nounroll
        for (int t = 0; t < nt; t += 2) {
            const bool last = (t == nt - 2);
            const size_t k1 = (size_t)(t + 1) * kstep;
            const char* a2b = last ? nA : cA; const size_t k2 = last ? (size_t)0 : (size_t)(t + 2) * kstep; const size_t k3 = k2 + kstep;
            const char* b2 = last ? nB : cB + (size_t)(t + 2) * kstep; const char* b3 = b2 + kstep;
            if (last && has_next) S.a_ready(nxt);
            if constexpr (SP2) {
            PG8_LDB(B0, 0, 0); PG8_LDB(B1, 0, 1); PG8_SCHED; PG8_LDA(At, 0, 0); PG8_STAGE_A(PG8_SA(1, 1), cA, 1, k1, false);
            if constexpr (Sched::GATHER) { if (last && has_next) PG8_GO(nxt); }
            PG8_WAIT_V(8); PG8_WAIT_L(0); PG8_BAR; PG8_MMA(0, 0, At, B0); PG8_MMA(0, 1, At, B1); PG8_BAR; PG8_SCHED;
            PG8_LDA(At, 0, 1); PG8_STAGE(PG8_SB(0, 0), b2, voffB); PG8_STAGE(PG8_SB(0, 1), b2 + hstep, voffB); PG8_STAGE_A(PG8_SA(0, 0), a2b, 0, k2, last);
            PG8_WAIT_V(8); PG8_WAIT_L(0); PG8_BAR; PG8_MMA(1, 0, At, B0); PG8_MMA(1, 1, At, B1); PG8_BAR; PG8_SCHED;
            PG8_LDB(B0, 1, 0); PG8_LDB(B1, 1, 1); PG8_SCHED; PG8_LDA(At, 1, 0); PG8_STAGE_A(PG8_SA(0, 1), a2b, 1, k2, last);
            PG8_WAIT_V(8); PG8_WAIT_L(0); PG8_BAR; PG8_MMA(0, 0, At, B0); PG8_MMA(0, 1, At, B1); PG8_BAR; PG8_SCHED;
            PG8_LDA(At, 1, 1); PG8_STAGE(PG8_SB(1, 0), b3, voffB); PG8_STAGE(PG8_SB(1, 1), b3 + hstep, voffB); PG8_STAGE_A(PG8_SA(1, 0), a2b, 0, k3, last);
            PG8_WAIT_V(8); PG8_WAIT_L(0); PG8_BAR; PG8_MMA(1, 0, At, B0); PG8_MMA(1, 1, At, B1); PG8_BAR; PG8_SCHED;
            } else {
            PG8_LDB(B0, 0, 0); PG8_SCHED; PG8_LDA(At, 0, 0); PG8_STAGE_A(PG8_SA(1, 1), cA, 1, k1, false);
            if constexpr (Sched::GATHER) { if (last && has_next) PG8_GO(nxt); }
            PG8_WAIT_L(8); PG8_BAR; PG8_WAIT_L(0); PG8_MMA(0, 0, At, B0); PG8_BAR; PG8_SCHED;
            PG8_LDB(B1, 0, 1); PG8_STAGE(PG8_SB(0, 0), b2, voffB);
            PG8_BAR; PG8_WAIT_L(0); PG8_MMA(0, 1, At, B1); PG8_BAR;
            PG8_LDA(At, 0, 1); PG8_STAGE_A(PG8_SA(0, 0), a2b, 0, k2, last);
            PG8_BAR; PG8_WAIT_L(0); PG8_MMA(1, 0, At, B0); PG8_BAR; PG8_SCHED;
            PG8_STAGE(PG8_SB(0, 1), b2 + hstep, voffB);
            PG8_WAIT_V(6); PG8_BAR; PG8_MMA(1, 1, At, B1); PG8_BAR;
            PG8_LDB(B0, 1, 0); PG8_SCHED; PG8_LDA(At, 1, 0); PG8_STAGE_A(PG8_SA(0, 1), a2b, 1, k2, last);
            PG8_WAIT_L(8); PG8_BAR; PG8_WAIT_L(0); PG8_MMA(0, 0, At, B0); PG8_BAR; PG8_SCHED;
            PG8_LDB(B1, 1, 1); PG8_STAGE(PG8_SB(1, 0), b3, voffB);
            PG8_BAR; PG8_WAIT_L(0); PG8_MMA(0, 1, At, B1); PG8_BAR;
            PG8_LDA(At, 1, 1); PG8_STAGE_A(PG8_SA(1, 0), a2b, 0, k3, last);
            PG8_BAR; PG8_WAIT_L(0); PG8_MMA(1, 0, At, B0); PG8_BAR; PG8_SCHED;
            PG8_STAGE(PG8_SB(1, 1), b3 + hstep, voffB);
            PG8_WAIT_V(6); PG8_BAR; PG8_MMA(1, 1, At, B1); PG8_BAR;
            }
        }
        if constexpr (ALIGN_EPI) { if (wr == 0) PG8_BAR; }
        E(acc, cur, wr, wc, fr, fq); S.done(cur);
        if (!has_next) break;
#pragma unroll
        for (int a = 0; a < 2; ++a)
#pragma unroll
            for (int b = 0; b < 2; ++b)
#pragma unroll
                for (int m = 0; m < 4; ++m)
#pragma unroll
                    for (int n = 0; n < 2; ++n) acc[a][b][m][n] = (f32x4){0.f, 0.f, 0.f, 0.f};
        cur = nxt; cA = nA; cB = nB; ++ui;
        if constexpr (ALIGN_EPI) { if (wr == 1) PG8_BAR; }
    }
    PG8_WAIT_V(0);
    if constexpr (!ALIGN_EPI) { if (wr == 0) PG8_BAR; }
    PG8_BAR;
#undef PG8_SA
#undef PG8_SB
#undef PG8_STAGE
#undef PG8_STAGE_A
#undef PG8_GO
#undef PG8_LDA
#undef PG8_LDB
#undef PG8_MMA
#undef PG8_WAIT_V
#undef PG8_WAIT_L
#undef PG8_BAR
#undef PG8_SCHED
}

struct EpiBf16 {
    static constexpr bool PERM = true;
    bf16_t* O; int ldc;
    __device__ __forceinline__ void operator()(const f32x4 (&acc)[2][2][4][2], const Unit& u, int wr, int wc, int fr, int fq) const {
        const int row0 = u.pm * BM + wr * 64 + fr, col0 = u.pn * BM + wc * 32 + 8 * fq;
#pragma unroll
        for (int ai = 0; ai < 2; ++ai)
#pragma unroll
            for (int m = 0; m < 4; ++m) { bf16_t* rowp = O + (size_t)(row0 + ai * HALF + m * 16) * ldc + col0;
#pragma unroll
                for (int bj = 0; bj < 2; ++bj) { const f32x4 v0 = acc[ai][bj][m][0], v1 = acc[ai][bj][m][1];
                    u32x4 w; w.x = cvt_pk_bf16(v0[0], v0[1]); w.y = cvt_pk_bf16(v0[2], v0[3]); w.z = cvt_pk_bf16(v1[0], v1[1]); w.w = cvt_pk_bf16(v1[2], v1[3]);
                    *(u32x4*)(rowp + bj * HALF) = w; } }
    }
};
__device__ __forceinline__ unsigned pk4_fp8(float a, float b, float c, float d) { int w = 0; w = __builtin_amdgcn_cvt_pk_fp8_f32(a, b, w, false); w = __builtin_amdgcn_cvt_pk_fp8_f32(c, d, w, true); return (unsigned)w; }
__device__ __forceinline__ f32x4 clamp_fp8(f32x4 v, float sc) { f32x4 r; r[0] = __builtin_amdgcn_fmed3f(v[0] * sc, -440.f, 440.f); r[1] = __builtin_amdgcn_fmed3f(v[1] * sc, -440.f, 440.f);
    r[2] = __builtin_amdgcn_fmed3f(v[2] * sc, -440.f, 440.f); r[3] = __builtin_amdgcn_fmed3f(v[3] * sc, -440.f, 440.f); return r; }
struct EpiFp8 {
    static constexpr bool PERM = true;
    unsigned char* O; int ldc; float scale;
    __device__ __forceinline__ void operator()(const f32x4 (&acc)[2][2][4][2], const Unit& u, int wr, int wc, int fr, int fq) const {
        const int row0 = u.pm * BM + wr * 64 + fr, col0 = u.pn * BM + wc * 32 + 8 * fq;
#pragma unroll
        for (int ai = 0; ai < 2; ++ai)
#pragma unroll
            for (int m = 0; m < 4; ++m) { unsigned char* rowp = O + (size_t)(row0 + ai * HALF + m * 16) * ldc + col0;
#pragma unroll
                for (int bj = 0; bj < 2; ++bj) { const f32x4 v0 = clamp_fp8(acc[ai][bj][m][0], scale), v1 = clamp_fp8(acc[ai][bj][m][1], scale);
                    u32x2 w; w.x = pk4_fp8(v0[0], v0[1], v0[2], v0[3]); w.y = pk4_fp8(v1[0], v1[1], v1[2], v1[3]);
                    *(u32x2*)(rowp + bj * HALF) = w; } }
    }
};
struct EpiGlu {
    static constexpr bool PERM = true;
    const bf16_t* Ysrc; bf16_t* O; const float* bias;
    __device__ __forceinline__ void operator()(const f32x4 (&acc)[2][2][4][2], const Unit& u, int wr, int wc, int fr, int fq) const {
        const int row0 = u.pm * BM + wr * 64 + fr, col0 = u.pn * BM + wc * 32 + 8 * fq;
#pragma unroll
        for (int ai = 0; ai < 2; ++ai)
#pragma unroll
            for (int m = 0; m < 4; ++m) { const size_t ro = (size_t)(row0 + ai * HALF + m * 16) * 256 + col0;
#pragma unroll
                for (int bj = 0; bj < 2; ++bj) { const f32x4 v0 = acc[ai][bj][m][0], v1 = acc[ai][bj][m][1];
                    const u32x4 yv = *(const u32x4*)(Ysrc + ro + bj * HALF);
                    const f32x4 b0 = *(const f32x4*)(bias + col0 + bj * HALF), b1 = *(const f32x4*)(bias + col0 + bj * HALF + 4);
                    float o[8];
                    o[0] = bflo(yv.x) * sigmoidf_(v0[0] + b0[0]); o[1] = bfhi(yv.x) * sigmoidf_(v0[1] + b0[1]); o[2] = bflo(yv.y) * sigmoidf_(v0[2] + b0[2]); o[3] = bfhi(yv.y) * sigmoidf_(v0[3] + b0[3]);
                    o[4] = bflo(yv.z) * sigmoidf_(v1[0] + b1[0]); o[5] = bfhi(yv.z) * sigmoidf_(v1[1] + b1[1]); o[6] = bflo(yv.w) * sigmoidf_(v1[2] + b1[2]); o[7] = bfhi(yv.w) * sigmoidf_(v1[3] + b1[3]);
                    u32x4 w; w.x = cvt_pk_bf16(o[0], o[1]); w.y = cvt_pk_bf16(o[2], o[3]); w.z = cvt_pk_bf16(o[4], o[5]); w.w = cvt_pk_bf16(o[6], o[7]);
                    *(u32x4*)(O + ro + bj * HALF) = w; } }
    }
};
struct EpiGateMerge {
    static constexpr bool PERM = true;
    const unsigned char* P; bf16_t* Mg; float pinv;
    __device__ __forceinline__ void operator()(const f32x4 (&acc)[2][2][4][2], const Unit& u, int wr, int wc, int fr, int fq) const {
        const int i = u.pn >> 2, mt = u.pn & 3;
        const int row0 = u.pm * BM + wr * 64 + fr, col0 = mt * BM + wc * 32 + 8 * fq;
#pragma unroll
        for (int ai = 0; ai < 2; ++ai) {
            u32x2 pv[4][2]; u32x4 pvb[4][2]; u32x4 mv[4][2];
#pragma unroll
            for (int m = 0; m < 4; ++m)
#pragma unroll
                for (int bj = 0; bj < 2; ++bj) { const size_t r = (size_t)(row0 + ai * HALF + m * 16);
                    pv[m][bj] = PFP8 ? *(const u32x2*)(P + r * 4096 + i * 1024 + col0 + bj * HALF) : (u32x2){0u, 0u}; if (!PFP8) pvb[m][bj] = *(const u32x4*)((const bf16_t*)P + r * 4096 + i * 1024 + col0 + bj * HALF);
                    mv[m][bj] = (u32x4){0u, 0u, 0u, 0u}; if (i > 0) mv[m][bj] = *(const u32x4*)(Mg + r * 1024 + col0 + bj * HALF); }
#pragma unroll
            for (int m = 0; m < 4; ++m)
#pragma unroll
                for (int bj = 0; bj < 2; ++bj) { const size_t r = (size_t)(row0 + ai * HALF + m * 16); const f32x4 v0 = acc[ai][bj][m][0], v1 = acc[ai][bj][m][1]; const u32x2 p8 = pv[m][bj]; const u32x4 m4 = mv[m][bj];
                    f32x2 pa = __builtin_amdgcn_cvt_pk_f32_fp8((int)p8.x, false) * pinv, pb = __builtin_amdgcn_cvt_pk_f32_fp8((int)p8.x, true) * pinv,
                          pc = __builtin_amdgcn_cvt_pk_f32_fp8((int)p8.y, false) * pinv, pd = __builtin_amdgcn_cvt_pk_f32_fp8((int)p8.y, true) * pinv;
                    if (!PFP8) { const u32x4 q4 = pvb[m][bj]; pa = (f32x2){bflo(q4.x), bfhi(q4.x)}; pb = (f32x2){bflo(q4.y), bfhi(q4.y)}; pc = (f32x2){bflo(q4.z), bfhi(q4.z)}; pd = (f32x2){bflo(q4.w), bfhi(q4.w)}; }
                    float o[8];
                    o[0] = bflo(m4.x) + pa[0] * sigmoidf_(v0[0]); o[1] = bfhi(m4.x) + pa[1] * sigmoidf_(v0[1]); o[2] = bflo(m4.y) + pb[0] * sigmoidf_(v0[2]); o[3] = bfhi(m4.y) + pb[1] * sigmoidf_(v0[3]);
                    o[4] = bflo(m4.z) + pc[0] * sigmoidf_(v1[0]); o[5] = bfhi(m4.z) + pc[1] * sigmoidf_(v1[1]); o[6] = bflo(m4.w) + pd[0] * sigmoidf_(v1[2]); o[7] = bfhi(m4.w) + pd[1] * sigmoidf_(v1[3]);
                    u32x4 w; w.x = cvt_pk_bf16(o[0], o[1]); w.y = cvt_pk_bf16(o[2], o[3]); w.z = cvt_pk_bf16(o[4], o[5]); w.w = cvt_pk_bf16(o[6], o[7]);
                    *(u32x4*)(Mg + r * 1024 + col0 + bj * HALF) = w; }
        }
    }
};
struct EpiGateMerge4 {
    static constexpr bool PERM = false;
    const unsigned char* P; bf16_t* Mg; float pinv;
    __device__ __forceinline__ void operator()(const f32x4 (&acc)[2][2][4][2], const Unit& u, int wr, int wc, int fr, int fq) const {
        const int row0 = u.pm * BM + wr * 64 + fr, col0 = u.pn * 64 + wc * 16 + 4 * fq;
#pragma unroll
        for (int ai = 0; ai < 2; ++ai) {
            unsigned pv[4][4];
#pragma unroll
            for (int m = 0; m < 4; ++m)
#pragma unroll
                for (int b = 0; b < 4; ++b) pv[m][b] = *(const unsigned*)(P + (size_t)(row0 + ai * HALF + m * 16) * 4096 + b * 1024 + col0);
#pragma unroll
            for (int m = 0; m < 4; ++m) { f32x4 o = (f32x4){0.f, 0.f, 0.f, 0.f};
#pragma unroll
                for (int b = 0; b < 4; ++b) { const f32x4 v = acc[ai][b >> 1][m][b & 1]; const f32x2 pa = __builtin_amdgcn_cvt_pk_f32_fp8((int)pv[m][b], false), pb = __builtin_amdgcn_cvt_pk_f32_fp8((int)pv[m][b], true);
                    o[0] += pa[0] * sigmoidf_(v[0]); o[1] += pa[1] * sigmoidf_(v[1]); o[2] += pb[0] * sigmoidf_(v[2]); o[3] += pb[1] * sigmoidf_(v[3]); }
                u32x2 w; w.x = cvt_pk_bf16(o[0] * pinv, o[1] * pinv); w.y = cvt_pk_bf16(o[2] * pinv, o[3] * pinv);
                *(u32x2*)(Mg + (size_t)(row0 + ai * HALF + m * 16) * 1024 + col0) = w; }
        }
    }
};
struct EpiResid {
    static constexpr bool PERM = false;
    const float* xin; bf16_t* out; const float* gate;
    __device__ __forceinline__ void operator()(const f32x4 (&acc)[2][2][4][2], const Unit& u, int wr, int wc, int fr, int fq) const {
        const int row0 = u.pm * BM + wr * 64 + fr, col0 = u.pn * BM + wc * 32 + 4 * fq;
        const int b = (u.pm * BM) / SEQ;
        f32x4 gv[2][2];
#pragma unroll
        for (int bj = 0; bj < 2; ++bj)
#pragma unroll
            for (int n = 0; n < 2; ++n) gv[bj][n] = *(const f32x4*)(gate + b * 3072 + 2048 + col0 + bj * HALF + n * 16) + 1.0f;
#pragma unroll
        for (int ai = 0; ai < 2; ++ai)
#pragma unroll
            for (int mh = 0; mh < 4; mh += 2) {
                f32x4 xv[2][2][2];
#pragma unroll
                for (int m = 0; m < 2; ++m)
#pragma unroll
                    for (int bj = 0; bj < 2; ++bj)
#pragma unroll
                        for (int n = 0; n < 2; ++n) xv[m][bj][n] = *(const f32x4*)(xin + (size_t)(row0 + ai * HALF + (mh + m) * 16) * D + col0 + bj * HALF + n * 16);
#pragma unroll
                for (int m = 0; m < 2; ++m)
#pragma unroll
                    for (int bj = 0; bj < 2; ++bj)
#pragma unroll
                        for (int n = 0; n < 2; ++n) { const f32x4 v = xv[m][bj][n] * DN_ALPHA + gv[bj][n] * acc[ai][bj][mh + m][n];
                            u32x2 w; w.x = cvt_pk_bf16(v[0], v[1]); w.y = cvt_pk_bf16(v[2], v[3]);
                            *(u32x2*)(out + (size_t)(row0 + ai * HALF + (mh + m) * 16) * D + col0 + bj * HALF + n * 16) = w; } }
    }
};
struct EpiMoe1 {
    static constexpr bool PERM = false;
    bf16_t* Act; const LAS float* gtab;
    __device__ __forceinline__ void operator()(const f32x4 (&acc)[2][2][4][2], const Unit& u, int wr, int wc, int fr, int fq) const {
        const int row0 = u.pm * BM + wr * 64 + fr, f0 = u.pn * 128 + wc * 16 + 4 * fq;
#pragma unroll
        for (int ai = 0; ai < 2; ++ai)
#pragma unroll
            for (int m = 0; m < 4; ++m) { const int r = row0 + ai * HALF + m * 16; const float gt = gtab[u.ab * 256 + wr * 64 + fr + ai * HALF + m * 16];
#pragma unroll
                for (int bj = 0; bj < 2; ++bj) { const f32x4 a = acc[ai][bj][m][0], b = acc[ai][bj][m][1];
                    u32x2 w; w.x = cvt_pk_bf16(siluf_(a[0]) * b[0] * gt, siluf_(a[1]) * b[1] * gt); w.y = cvt_pk_bf16(siluf_(a[2]) * b[2] * gt, siluf_(a[3]) * b[3] * gt);
                    *(u32x2*)(Act + (size_t)r * 256 + f0 + bj * 64) = w; } }
    }
};
}

#define XB_TMO      128
#define XB_XCNT(j)  (256  + 64 * (j))
#define XB_XSUB(j)  (1280 + 64 * (j))
#define XB_XGEN(j)  (2304 + 64 * (j))
#define XB_TOP      3328
#define XB_TOPGEN   3392
#define XCD_BAR_WORDS 3456
#define XB_SPIN_CAP (1u << 22)
__device__ __forceinline__ unsigned xb_ld(unsigned* p)              { return __hip_atomic_load(p, __ATOMIC_RELAXED, __HIP_MEMORY_SCOPE_AGENT); }
__device__ __forceinline__ unsigned xb_add(unsigned* p, unsigned v) { return __hip_atomic_fetch_add(p, v, __ATOMIC_RELAXED, __HIP_MEMORY_SCOPE_AGENT); }
__device__ __forceinline__ unsigned xb_xcc_id() { return (unsigned)__builtin_amdgcn_s_getreg((3 << 11) | 20) & 0xFu; }
#define XB_SPIN(cond, bar) do { unsigned _sp = 0; while (cond) { __builtin_amdgcn_s_sleep(1); \
    if ((++_sp & 255u) == 0u) { if (xb_ld(&(bar)[XB_TMO])) break; if (_sp > XB_SPIN_CAP) { atomicAdd(&(bar)[XB_TMO], 1u); break; } } } } while (0)
struct XcdBarrier { unsigned* bar; unsigned x; volatile LAS unsigned* st; };
__device__ __forceinline__ XcdBarrier xcd_barrier_post(unsigned* bar, volatile LAS unsigned* st) {
    XcdBarrier b; b.bar = bar; b.x = xb_xcc_id(); b.st = st;
    if (threadIdx.x == 0) (void)xb_add(&bar[XB_XCNT(b.x)], 1u);
    return b;
}
__device__ __forceinline__ void xcd_barrier_complete(unsigned* bar, unsigned x, unsigned& nloc, unsigned& nx) {
    const unsigned G = gridDim.x * gridDim.y * gridDim.z;
    unsigned sum, cnt, mine, sp = 0u;
    for (;;) {
        sum = 0u; cnt = 0u; mine = 0u;
#pragma unroll
        for (unsigned j = 0; j < 16; ++j) { const unsigned c = xb_ld(&bar[XB_XCNT(j)]); sum += c; cnt += (c > 0u) ? 1u : 0u; mine = (j == x) ? c : mine; }
        if (sum == G) break;
        __builtin_amdgcn_s_sleep(1);
        if ((++sp & 255u) == 0u) { if (xb_ld(&bar[XB_TMO])) break; if (sp > XB_SPIN_CAP) { atomicAdd(&bar[XB_TMO], 1u); break; } }
    }
    nloc = mine > 0u ? mine : 1u; nx = cnt > 0u ? cnt : 1u;
}
__device__ __forceinline__ void xcd_barrier(const XcdBarrier& b) {
    asm volatile("s_waitcnt vmcnt(0)" ::: "memory");
    __syncthreads();
    if (threadIdx.x == 0) {
        unsigned* bar = b.bar;
        __builtin_amdgcn_s_waitcnt(0);
        unsigned nloc = b.st[0], nx = b.st[1];
        if (nloc == 0u) { xcd_barrier_complete(bar, b.x, nloc, nx); b.st[0] = nloc; b.st[1] = nx; }
        const unsigned old = xb_add(&bar[XB_XSUB(b.x)], 1u);
        const unsigned gen = old / nloc;
        if (old + 1u == (gen + 1u) * nloc) {
            __builtin_amdgcn_fence(__ATOMIC_RELEASE, "agent");
            asm volatile("s_waitcnt vmcnt(0)" ::: "memory");
            const unsigned og = xb_add(&bar[XB_TOP], 1u);
            const unsigned tg = og / nx;
            if (og + 1u == (tg + 1u) * nx) xb_add(&bar[XB_TOPGEN], 1u);
            else XB_SPIN(xb_ld(&bar[XB_TOPGEN]) == tg, bar);
            __builtin_amdgcn_fence(__ATOMIC_ACQUIRE, "agent");
            xb_add(&bar[XB_XGEN(b.x)], 1u);
            asm volatile("s_waitcnt vmcnt(0)" ::: "memory");
        } else {
            XB_SPIN(xb_ld(&bar[XB_XGEN(b.x)]) == gen, bar);
            __builtin_amdgcn_fence(__ATOMIC_ACQUIRE, "agent");
            asm volatile("s_waitcnt vmcnt(0)" ::: "memory");
        }
    }
    __syncthreads();
}

struct Args {
    const float* in[43]; const int* positions; float* out; unsigned char* ws; int ph_lo, ph_hi, dbg, pad;
};
enum { I_X = 0, I_C = 1, I_POS = 2, I_MOD1W = 3, I_MOD1B = 4, I_WIN = 5, I_GMLNG = 6, I_GMLNB = 7, I_GMW = 8, I_GMB = 9,
       I_S5LRE = 10, I_S5LIM = 11, I_S5STEP = 12, I_S5BRE = 13, I_S5BIM = 14, I_S5CRE = 15, I_S5CIM = 16, I_S5D = 17, I_S5GLUW = 18, I_S5GLUB = 19,
       I_CONVW = 20, I_CONVB = 21, I_DTBIAS = 22, I_ALOG = 23, I_SSDD = 24, I_SSDNG = 25, I_WBR = 26, I_WGATE = 27, I_WOUT = 28, I_LN1G = 29, I_LN1B = 30,
       I_MOD2W = 31, I_MOD2B = 32, I_RW = 33, I_RB = 34, I_EW1 = 35, I_EW3 = 36, I_EW2 = 37, I_SW1 = 38, I_SW3 = 39, I_SW2 = 40, I_LN2G = 41, I_LN2B = 42 };

typedef const __attribute__((address_space(4))) Args* ArgsP;
struct Ctx {
    ArgsP a; unsigned char* ws; LAS unsigned char* lds; int tid, lane, wave, c, G, bx, dbg;
    __device__ __forceinline__ const float* in(int i) const { return a->in[i]; }
    __device__ __forceinline__ bf16_t* proj() const { return (bf16_t*)(ws + WS_PROJ); }
    __device__ __forceinline__ bf16_t* hbuf() const { return (bf16_t*)(ws + WS_H); }
    __device__ __forceinline__ bf16_t* ybuf() const { return (bf16_t*)(ws + WS_Y); }
    __device__ __forceinline__ float* modv(int l, int w) const { return (float*)(ws + WS_MODV) + (size_t)(l * 2 + w) * NB * 3072; }
};

__device__ __forceinline__ void ph_prologue(const Ctx& X) {
    { float* ropet = (float*)(X.ws + WS_ROPE); const int* pos = X.a->positions;
      for (int i = X.c * 512 + X.tid; i < M * 8; i += X.G * 512) { const int tok = i >> 3, j = i & 7;
          const float inv = (j == 0) ? 1.0f : (j == 1) ? 0.1939227432f : (j == 2) ? 0.0376060307f : (j == 3) ? 0.00729266461f : (j == 4) ? 0.00141421356f : (j == 5) ? 0.000274248188f : (j == 6) ? 5.31829610e-05f : 1.03133862e-05f;
          float sn, cs; sincos_red((float)pos[tok] * inv, sn, cs); *(f32x2*)(ropet + (size_t)i * 2) = (f32x2){cs, sn}; } }
    LAS float* red = (LAS float*)X.lds;
    for (int it = X.c; it < DEPTH * 2 * 48; it += X.G) {
        const int l = it / 96, w = (it / 48) & 1, jb = it % 48, j = jb * 64 + X.lane;
        const float* W = X.in(w ? I_MOD2W : I_MOD1W) + (size_t)l * D * 3072; const float* cv = X.in(I_C);
        float a0 = 0.f, a1 = 0.f, a2 = 0.f, a3 = 0.f;
        const int k0 = X.wave * 128;
        for (int k = k0; k < k0 + 128; ++k) { const float wv = W[(size_t)k * 3072 + j]; a0 += cv[k] * wv; a1 += cv[D + k] * wv; a2 += cv[2 * D + k] * wv; a3 += cv[3 * D + k] * wv; }
        red[(X.wave * 4 + 0) * 64 + X.lane] = a0; red[(X.wave * 4 + 1) * 64 + X.lane] = a1; red[(X.wave * 4 + 2) * 64 + X.lane] = a2; red[(X.wave * 4 + 3) * 64 + X.lane] = a3;
        __syncthreads();
        if (X.tid < 256) { const int b = X.tid >> 6, ln = X.tid & 63; float s = 0.f;
#pragma unroll
            for (int q = 0; q < 8; ++q) s += red[(q * 4 + b) * 64 + ln];
            const int jj = jb * 64 + ln; X.modv(l, w)[b * 3072 + jj] = s + X.in(w ? I_MOD2B : I_MOD1B)[(size_t)l * 3072 + jj]; }
        __syncthreads();
    }
}

template <class Src, bool GPERM = false>
__device__ __forceinline__ void tr_item(const Src& src, bf16_t* WT, int K, int rowbase, int kb, int nb, LAS float* scr, int lane) {
    const int k0 = 64 * kb, n0 = 32 * nb;
    f32x4 v[8];
#pragma unroll
    for (int i = 0; i < 8; ++i) v[i] = src.load4(k0 + 8 * i + (lane >> 3), n0 + 4 * (lane & 7));
#pragma unroll
    for (int i = 0; i < 8; ++i) { LAS float* d = scr + (8 * i + (lane >> 3)) * 33 + 4 * (lane & 7); d[0] = v[i][0]; d[1] = v[i][1]; d[2] = v[i][2]; d[3] = v[i][3]; }
    asm volatile("s_waitcnt lgkmcnt(0)" ::: "memory");
    const int c = lane & 7;
#pragma unroll
    for (int j = 0; j < 4; ++j) { const int n = (lane >> 3) + 8 * j; const LAS float* s = scr + (8 * c) * 33 + n;
        u32x4 o; o.x = pk2(s[0 * 33], s[1 * 33]); o.y = pk2(s[2 * 33], s[3 * 33]); o.z = pk2(s[4 * 33], s[5 * 33]); o.w = pk2(s[6 * 33], s[7 * 33]);
        int row = rowbase + n0 + n;
        if constexpr (GPERM) { const int cc = n0 + n, bi = rowbase >> 10; row = 256 * (cc >> 6) + 128 * (bi >> 1) + 32 * ((cc >> 4) & 3) + 16 * (bi & 1) + (cc & 15); }
        *(u32x4*)(WT + (size_t)row * K + k0 + 8 * c) = o; }
    asm volatile("s_waitcnt lgkmcnt(0)" ::: "memory");
}
struct SrcPlain { const float* W; int N; __device__ __forceinline__ f32x4 load4(int k, int n) const { return *(const f32x4*)(W + (size_t)k * N + n); } };
struct SrcWin { const float* W; __device__ __forceinline__ f32x4 load4(int k, int n) const {
    if (n >= D_IN) return (f32x4){0.f, 0.f, 0.f, 0.f}; const int o = (n < 1216) ? n : (n < 2240) ? n + 4 : (n < 2244) ? 1216 + (n - 2240) : n; return *(const f32x4*)(W + (size_t)k * D_IN + o); } };
struct Src13 { const float* W1; const float* W3; __device__ __forceinline__ f32x4 load4(int k, int n) const {
    const int f = (n >> 5) * 16 + (n & 15); const long d = (n & 16) ? (long)(W3 - W1) : 0l; return *(const f32x4*)(W1 + d + (long)k * 256 + f); } };

__device__ __forceinline__ void ph_wconv(const Ctx& X, int l) {
    LAS float* scr = (LAS float*)(X.lds + X.wave * 16384);
    unsigned char* wb = X.ws + WS_W;
    const int gw = X.c * 8 + X.wave, NGW = X.G * 8;
    constexpr int I_A = 16 * 72, I_B = 4 * 16 * 32, I_C2 = 4 * 4 * 32, I_D = 16 * 32, I_E = 4 * 8, I_F = NE1 * 16 * 16, I_G = NE1 * 4 * 32;
    constexpr int NIT = I_A + I_B + I_C2 + I_D + I_E + I_F + I_G;
    for (int it = gw; it < NIT; it += NGW) {
        int r = it;
        if (r < I_A) { SrcWin s{X.in(I_WIN) + (size_t)l * D * D_IN}; tr_item(s, (bf16_t*)(wb + WO_IN), 1024, 0, r / 72, r % 72, scr, X.lane); continue; } r -= I_A;
        if (r < I_B) { const int i = r / 512, q = r % 512; SrcPlain s{X.in(I_WGATE) + ((size_t)l * 4 + i) * D * D, D}; tr_item<SrcPlain, true>(s, (bf16_t*)(wb + WO_GATE), 1024, i * 1024, q / 32, q % 32, scr, X.lane); continue; } r -= I_B;
        if (r < I_C2) { const int i = r / 128, q = r % 128; SrcPlain s{X.in(I_WBR) + ((size_t)l * 4 + i) * 256 * D, D}; tr_item(s, (bf16_t*)(wb + WO_BR) + (size_t)i * 1024 * 256, 256, 0, q / 32, q % 32, scr, X.lane); continue; } r -= I_C2;
        if (r < I_D) { SrcPlain s{X.in(I_WOUT) + (size_t)l * D * D, D}; tr_item(s, (bf16_t*)(wb + WO_OUT), 1024, 0, r / 32, r % 32, scr, X.lane); continue; } r -= I_D;
        if (r < I_E) { SrcPlain s{X.in(I_S5GLUW) + (size_t)l * 256 * 256, 256}; tr_item(s, (bf16_t*)(wb + WO_GLU), 256, 0, r / 8, r % 8, scr, X.lane); continue; } r -= I_E;
        if (r < I_F) { const int e = r / 256, q = r % 256;
            const Src13 s{(e < NEXP) ? X.in(I_EW1) + ((size_t)l * NEXP + e) * D * 256 : X.in(I_SW1) + (size_t)l * D * 256, (e < NEXP) ? X.in(I_EW3) + ((size_t)l * NEXP + e) * D * 256 : X.in(I_SW3) + (size_t)l * D * 256};
            tr_item(s, (bf16_t*)(wb + WO_13) + (size_t)e * 512 * 1024, 1024, 0, q / 16, q % 16, scr, X.lane); continue; } r -= I_F;
        { const int e = r / 128, q = r % 128; SrcPlain s{e < NEXP ? X.in(I_EW2) + ((size_t)l * NEXP + e) * 256 * D : X.in(I_SW2) + (size_t)l * 256 * D, D};
            tr_item(s, (bf16_t*)(wb + WO_2) + (size_t)e * 1024 * 256, 256, 0, q / 32, q % 32, scr, X.lane); }
    }
    const int gt = X.c * 512 + X.tid, NGT = X.G * 512;
    { bf16_t* gmw = (bf16_t*)(X.ws + WS_GMW); const float* src = X.in(I_GMW) + (size_t)l * 4 * 128 * 128;
      for (int i = gt; i < 4 * 128 * 128; i += NGT) { const int t = (i >> 7) & 127, s = i & 127; gmw[i] = (bf16_t)f2bf(s <= t ? src[i] : 0.f); } }
    for (int i = gt; i < 16 * 64; i += NGT) {
        const int g = i >> 6, p = i & 63;
        const float step = expf(X.in(I_S5STEP)[l * 16 + g]); const float lr = X.in(I_S5LRE)[(size_t)l * 1024 + i], li = X.in(I_S5LIM)[(size_t)l * 1024 + i];
        const float mag = expf(lr * step); float sn, cs; sincos_red(li * step, sn, cs);
        const float abr = mag * cs, abi = mag * sn, den = lr * lr + li * li, nr = abr - 1.0f;
        const float cr = (nr * lr + abi * li) / den, ci = (abi * lr - nr * li) / den;
        float* sa = (float*)(X.ws + WS_S5A); sa[i * 2] = abr; sa[i * 2 + 1] = abi;
        bf16_t* bb = (bf16_t*)(X.ws + WS_S5B); bf16_t* cm = (bf16_t*)(X.ws + WS_S5C);
        const float* bre = X.in(I_S5BRE) + ((size_t)l * 1024 + i) * 16; const float* bim = X.in(I_S5BIM) + ((size_t)l * 1024 + i) * 16;
#pragma unroll
        for (int ch = 0; ch < 16; ++ch) { const float br = bre[ch], bi = bim[ch];
            bb[(g * 128 + p) * 16 + ch] = (bf16_t)f2bf(cr * br - ci * bi); bb[(g * 128 + 64 + p) * 16 + ch] = (bf16_t)f2bf(cr * bi + ci * br);
            cm[(g * 16 + ch) * 128 + p] = (bf16_t)f2bf(X.in(I_S5CRE)[(((size_t)l * 16 + g) * 16 + ch) * 64 + p]);
            cm[(g * 16 + ch) * 128 + 64 + p] = (bf16_t)f2bf(-X.in(I_S5CIM)[(((size_t)l * 16 + g) * 16 + ch) * 64 + p]); }
    }
    { bf16_t* rf = (bf16_t*)(X.ws + WS_RFR); const float* rw = X.in(I_RW) + (size_t)l * D * NEXP;
      for (int i = gt; i < 2 * 32 * 64 * 8; i += NGT) { const int j = i & 7, ln = (i >> 3) & 63, ks = (i >> 9) & 31, rt = i >> 14;
          const float v = rw[(size_t)(ks * 32 + 8 * (ln >> 4) + j) * NEXP + rt * 16 + (ln & 15)]; const unsigned hi = f2bf(v); const float lo = v - bflo(hi);
          rf[i] = (bf16_t)hi; rf[32768 + i] = (bf16_t)f2bf(lo); } }
    if (l == 0) {
        const float* x = X.in(I_X); bf16_t* h = X.hbuf(); const float* mv = X.modv(0, 0);
        for (size_t i = (size_t)gt; i < (size_t)M * D / 8; i += NGT) {
            const size_t e = i * 8; const int col = (int)(e & 1023), b = (int)(e >> 23);
            const f32x4 x0 = *(const f32x4*)(x + e), x1 = *(const f32x4*)(x + e + 4);
            const f32x4 sh0 = *(const f32x4*)(mv + b * 3072 + col), sh1 = *(const f32x4*)(mv + b * 3072 + col + 4), sc0 = *(const f32x4*)(mv + b * 3072 + 1024 + col), sc1 = *(const f32x4*)(mv + b * 3072 + 1024 + col + 4);
            const f32x4 h0 = x0 * (sc0 + 1.0f) + sh0, h1 = x1 * (sc1 + 1.0f) + sh1;
            u32x4 w; w.x = pk2(h0[0], h0[1]); w.y = pk2(h0[2], h0[3]); w.z = pk2(h1[0], h1[1]); w.w = pk2(h1[2], h1[3]);
            *(u32x4*)(h + e) = w; }
    }
}

__device__ __forceinline__ void rope8(const u32x4 a, const u32x4 b, const float* cs, u32x4& wa, u32x4& wb) {
    float t1[8], t2[8]; t1[0] = bflo(a.x); t1[1] = bfhi(a.x); t1[2] = bflo(a.y); t1[3] = bfhi(a.y); t1[4] = bflo(a.z); t1[5] = bfhi(a.z); t1[6] = bflo(a.w); t1[7] = bfhi(a.w);
    t2[0] = bflo(b.x); t2[1] = bfhi(b.x); t2[2] = bflo(b.y); t2[3] = bfhi(b.y); t2[4] = bflo(b.z); t2[5] = bfhi(b.z); t2[6] = bflo(b.w); t2[7] = bfhi(b.w);
    float o1[8], o2[8]; f32x4 c4[4];
#pragma unroll
    for (int q = 0; q < 4; ++q) c4[q] = *(const f32x4*)(cs + 4 * q);
#pragma unroll
    for (int j = 0; j < 8; ++j) { const float cv = c4[j >> 1][(j & 1) * 2], sv = c4[j >> 1][(j & 1) * 2 + 1]; o1[j] = t1[j] * cv - t2[j] * sv; o2[j] = t2[j] * cv + t1[j] * sv; }
    wa.x = pk2(o1[0], o1[1]); wa.y = pk2(o1[2], o1[3]); wa.z = pk2(o1[4], o1[5]); wa.w = pk2(o1[6], o1[7]);
    wb.x = pk2(o2[0], o2[1]); wb.y = pk2(o2[2], o2[3]); wb.z = pk2(o2[4], o2[5]); wb.w = pk2(o2[6], o2[7]);
}
__device__ __forceinline__ void mx_rope(const Ctx& X) {
    bf16_t* pj = X.proj(); const float* ropet = (const float*)(X.ws + WS_ROPE);
    const int gt = X.c * 512 + X.tid, NGT = X.G * 512;
    for (int i = gt; i < M * 10; i += NGT) {
        const int tok = i / 10, hh = i % 10;
        if (hh == 9) { const u32x4* sp = (const u32x4*)(pj + (size_t)tok * PJ + C_V); u32x4* dp = (u32x4*)((bf16_t*)(X.ws + WS_V2) + (size_t)tok * 64);
#pragma unroll
            for (int q = 0; q < 8; ++q) dp[q] = sp[q];
            continue; }
        const int col = (hh < 4) ? C_Q + hh * 64 : (hh < 8) ? C_QI + (hh - 4) * 64 : C_K;
        bf16_t* p = pj + (size_t)tok * PJ + col;
        const u32x4 a = *(const u32x4*)p, b = *(const u32x4*)(p + 8);
        u32x4 wa, wb; rope8(a, b, ropet + (size_t)tok * 16, wa, wb);
        if (hh < 8) { *(u32x4*)p = wa; *(u32x4*)(p + 8) = wb; }
        else { u32x4* dp = (u32x4*)((bf16_t*)(X.ws + WS_K2) + (size_t)tok * 64); const u32x4* sp = (const u32x4*)p; dp[0] = wa; dp[1] = wb;
#pragma unroll
            for (int q = 2; q < 8; ++q) dp[q] = sp[q]; }
    }
    for (int i = gt; i < (M / 16) * 16; i += NGT) {
        const int hf = i & 1, pc = (i >> 1) & 7, tile = i >> 4; const int ks = pc >> 2, fq = pc & 3;
        u32x4* dp = (u32x4*)((bf16_t*)(X.ws + WS_KI2) + (size_t)tile * 1024 + pc * 128 + hf * 64);
#pragma unroll
        for (int j = 0; j < 8; ++j) { const int tok = tile * 16 + hf * 8 + j; const bf16_t* rp = pj + (size_t)tok * PJ + C_KI;
            u32x4 v = *(const u32x4*)(rp + ks * 32 + fq * 8);
            if (pc < 2) { const u32x4 a = *(const u32x4*)rp, b = *(const u32x4*)(rp + 8); u32x4 wa, wb; rope8(a, b, ropet + (size_t)tok * 16, wa, wb); v = pc ? wb : wa; }
            dp[j] = v; }
    }
}

__device__ __forceinline__ void mx_gmlp(const Ctx& X, int l, int unit) {
    const int lane = X.lane, w = X.wave;
    const int row0 = unit * 128;
    LAS bf16_t* Vt = (LAS bf16_t*)X.lds;
    const bf16_t* pj = X.proj();
    const float* lng = X.in(I_GMLNG) + l * 256; const float* lnb = X.in(I_GMLNB) + l * 256;
    float g4[4], b4[4];
#pragma unroll
    for (int j = 0; j < 4; ++j) { g4[j] = lng[lane + 64 * j]; b4[j] = lnb[lane + 64 * j]; }
    for (int i = 0; i < 16; ++i) {
        const int s = w * 16 + i; const bf16_t* rp = pj + (size_t)(row0 + s) * PJ + C_GV;
        float v[4]; float sm = 0.f;
#pragma unroll
        for (int j = 0; j < 4; ++j) { v[j] = gelu_tanh(bf2f(rp[lane + 64 * j])); sm += v[j]; }
        const float mean = wave_sum(sm) * (1.0f / 256.0f); float q = 0.f;
#pragma unroll
        for (int j = 0; j < 4; ++j) { v[j] -= mean; q += v[j] * v[j]; }
        const float rstd = rsqrtf(wave_sum(q) * (1.0f / 256.0f) + LN_EPS);
#pragma unroll
        for (int j = 0; j < 4; ++j) Vt[(lane + 64 * j) * 136 + s] = (bf16_t)f2bf(v[j] * rstd * g4[j] + b4[j]);
    }
    __syncthreads();
    const int g = w >> 1, c0 = g * 64 + (w & 1) * 32, fr = lane & 15, fq = lane >> 4;
    const bf16_t* gmw = (const bf16_t*)(X.ws + WS_GMW) + (size_t)g * 128 * 128;
    const float* gmb = X.in(I_GMB) + ((size_t)l * 4 + g) * 128;
    bf16_t* ya = X.ybuf();
    for (int tt = 0; tt < 8; ++tt) {
        f32x4 acc0 = (f32x4){0.f, 0.f, 0.f, 0.f}, acc1 = acc0;
        for (int ks = 0; ks <= (tt >> 1); ++ks) {
            const bf16x8 wf = *(const bf16x8*)(gmw + (tt * 16 + fr) * 128 + ks * 32 + 8 * fq);
            const bf16x8 v0 = *(const LAS bf16x8*)(Vt + (c0 + fr) * 136 + ks * 32 + 8 * fq), v1 = *(const LAS bf16x8*)(Vt + (c0 + 16 + fr) * 136 + ks * 32 + 8 * fq);
            acc0 = mfma16(v0, wf, acc0); acc1 = mfma16(v1, wf, acc1);
        }
        const int t = tt * 16 + fr; const float bias = gmb[t];
#pragma unroll
        for (int c2 = 0; c2 < 2; ++c2) { const f32x4 a = c2 ? acc1 : acc0; const int cc = c0 + c2 * 16 + 4 * fq;
            const u32x2 uv = *(const u32x2*)(pj + (size_t)(row0 + t) * PJ + C_GU + cc);
            u32x2 o; o.x = pk2(gelu_tanh(bflo(uv.x)) * (a[0] + bias), gelu_tanh(bfhi(uv.x)) * (a[1] + bias)); o.y = pk2(gelu_tanh(bflo(uv.y)) * (a[2] + bias), gelu_tanh(bfhi(uv.y)) * (a[3] + bias));
            *(u32x2*)(ya + (size_t)(row0 + t) * 256 + cc) = o; }
    }
    __syncthreads();
}

template <int PASS>
__device__ __forceinline__ void mx_s5(const Ctx& X, int l, int wu) {
    const int lane = X.lane, fr = lane & 15, fq = lane >> 4;
    const int wgi = wu >> 3, wv = wu & 7; const int b = wgi >> 6, g = ((wgi >> 4) & 3) * 4 + (wv & 3), ch = (wgi & 15) * 2 + (wv >> 2);
    const int tb = b * SEQ + ch * 256;
    LAS float* xl = (LAS float*)(X.lds + X.wave * 16384);
    LAS bf16_t* hb = (LAS bf16_t*)(X.lds + X.wave * 16384 + 8192);
    const bf16_t* pj = X.proj();
    const bf16_t* bbT = (const bf16_t*)(X.ws + WS_S5B) + (size_t)g * 128 * 16;
    bf16x8 Bf[8];
#pragma unroll
    for (int ct = 0; ct < 8; ++ct) { Bf[ct] = (bf16x8){0, 0, 0, 0, 0, 0, 0, 0}; if (fq < 2) Bf[ct] = *(const bf16x8*)(bbT + (ct * 16 + fr) * 16 + 8 * fq); }
    const float* sa = (const float*)(X.ws + WS_S5A) + (g * 64 + lane) * 2; const float ar = sa[0], ai = sa[1];
    float hr = 0.f, hi = 0.f;
    float* st = (float*)(X.ws + WS_S5ST) + (size_t)((b * 16 + g) * 32) * 128;
    bf16x8 Cf[4]; float dsk[4];
    if (PASS == 3) {
        { const float* hin = (const float*)(X.ws + WS_S5HIN) + (size_t)((b * 16 + g) * 32 + ch) * 128; hr = hin[lane]; hi = hin[64 + lane]; }
        const bf16_t* cm = (const bf16_t*)(X.ws + WS_S5C) + (size_t)g * 16 * 128;
#pragma unroll
        for (int ks = 0; ks < 4; ++ks) Cf[ks] = *(const bf16x8*)(cm + fr * 128 + ks * 32 + 8 * fq);
#pragma unroll
        for (int i = 0; i < 4; ++i) dsk[i] = X.in(I_S5D)[l * 256 + g * 16 + 4 * fq + i];
    }
    bf16_t* ycp = (bf16_t*)(X.ws + WS_YCPRE);
    for (int blk = 0; blk < 16; ++blk) {
        const int t0 = tb + blk * 16;
        bf16x8 uf = (bf16x8){0, 0, 0, 0, 0, 0, 0, 0};
        if (fq < 2) uf = *(const bf16x8*)(pj + (size_t)(t0 + fr) * PJ + C_S5 + g * 16 + 8 * fq);
#pragma unroll
        for (int ct = 0; ct < 8; ++ct) { const f32x4 a = mfma16(uf, Bf[ct], (f32x4){0.f, 0.f, 0.f, 0.f});
#pragma unroll
            for (int i = 0; i < 4; ++i) xl[(4 * fq + i) * 128 + ct * 16 + fr] = a[i]; }
#pragma unroll
        for (int t = 0; t < 16; ++t) { const float xr = xl[t * 128 + lane], xi = xl[t * 128 + 64 + lane];
            const float nr = ar * hr - ai * hi + xr, ni = ar * hi + ai * hr + xi; hr = nr; hi = ni;
            if (PASS == 3) { hb[t * 136 + lane] = (bf16_t)f2bf(hr); hb[t * 136 + 64 + lane] = (bf16_t)f2bf(hi); } }
        if (PASS == 3) {
            asm volatile("s_waitcnt lgkmcnt(0)" ::: "memory"); __builtin_amdgcn_wave_barrier();
            f32x4 acc = (f32x4){0.f, 0.f, 0.f, 0.f};
#pragma unroll
            for (int ks = 0; ks < 4; ++ks) { const bf16x8 hf = *(const LAS bf16x8*)(hb + fr * 136 + ks * 32 + 8 * fq); acc = mfma16(Cf[ks], hf, acc); }
            const u32x2 uv = *(const u32x2*)(pj + (size_t)(t0 + fr) * PJ + C_S5 + g * 16 + 4 * fq);
            const float y0 = gelu_tanh(acc[0] + dsk[0] * bflo(uv.x)), y1 = gelu_tanh(acc[1] + dsk[1] * bfhi(uv.x)), y2 = gelu_tanh(acc[2] + dsk[2] * bflo(uv.y)), y3 = gelu_tanh(acc[3] + dsk[3] * bfhi(uv.y));
            u32x2 o; o.x = pk2(y0, y1); o.y = pk2(y2, y3);
            *(u32x2*)(ycp + (size_t)(t0 + fr) * 256 + g * 16 + 4 * fq) = o;
        }
    }
    if (PASS == 1) { st[ch * 128 + lane] = hr; st[ch * 128 + 64 + lane] = hi; }
}

constexpr int SD_CM = 0, SD_BM = 18432, SD_XT0 = 36864, SD_XT1 = 55296, SD_MM = 73728, SD_SIN0 = 108544, SD_SIN1 = 117760, SD_DT = 126976, SD_AC = 128000 + 64, SD_END = 129024 + 64;
__device__ __forceinline__ bf16x8 tr_frag8(const LAS bf16_t* base, int pitch, int l0, int c0, int lane) {
    const int g = lane >> 4, i = lane & 15; const unsigned a1 = (unsigned)(unsigned long)(base + (l0 + 8 * g + (i >> 2)) * pitch + c0 + 4 * (i & 3)); const unsigned a2 = a1 + (unsigned)(8 * pitch);
    u32x2 r1, r2;
    asm volatile("ds_read_b64_tr_b16 %0, %2\n\tds_read_b64_tr_b16 %1, %3\n\ts_waitcnt lgkmcnt(0)" : "=&v"(r1), "=&v"(r2) : "v"(a1), "v"(a2) : "memory");
    __builtin_amdgcn_sched_barrier(0);
    const u32x4 o = (u32x4){r1.x, r1.y, r2.x, r2.y}; return __builtin_bit_cast(bf16x8, o);
}
static_assert(SD_END <= LDS_MISC, "ssd lds");
template <int PASS>
__device__ __forceinline__ void mx_ssd(const Ctx& X, int l, int unit) {
    const int tid = X.tid, lane = X.lane, w = X.wave, fr = lane & 15, fq = lane >> 4;
    const int b = unit >> 6, c = unit & 63; const int r0 = unit * 128;
    const bf16_t* pj = X.proj();
    LAS bf16_t* Cm = (LAS bf16_t*)(X.lds + SD_CM); LAS bf16_t* Bm = (LAS bf16_t*)(X.lds + SD_BM);
    LAS bf16_t* Mm = (LAS bf16_t*)(X.lds + SD_MM);
    LAS float* dtv = (LAS float*)(X.lds + SD_DT); LAS float* acm = (LAS float*)(X.lds + SD_AC);
    const float* convw = X.in(I_CONVW) + (size_t)l * 4 * 512; const float* convb = X.in(I_CONVB) + (size_t)l * 512;
    float* sst = (float*)(X.ws + WS_SSDST); float* atot = (float*)(X.ws + WS_ATOT);
    for (int g = 0; g < 2; ++g) {
        if (tid < 256) { const int j = tid >> 7, rl = tid & 127, h = 2 * g + j;
            const float raw = bf2f(pj[(size_t)(r0 + rl) * PJ + C_DT + h]) + X.in(I_DTBIAS)[l * 4 + h];
            const float dt = softplusf_(raw); dtv[j * 128 + rl] = dt; acm[j * 128 + rl] = -expf(X.in(I_ALOG)[l * 4 + h]) * dt; }
        __syncthreads();
        if (tid < 256) {
            float cum = acm[tid];
#pragma unroll
            for (int o = 1; o < 64; o <<= 1) { const float up = __shfl_up(cum, o); if (lane >= o) cum += up; }
            if (lane == 63) dtv[256 + w] = cum;
            __builtin_amdgcn_fence(__ATOMIC_RELEASE, "workgroup");
            acm[tid] = cum; }
        __syncthreads();
        if (tid < 256 && (w & 1)) acm[tid] += dtv[256 + w - 1];
        __syncthreads();
        if (PASS == 1 && tid < 2) atot[(b * 64 + c) * 32 + 2 * g + tid] = acm[tid * 128 + 127];
        if (!(X.dbg & 16)) { const int cg = tid & 31, rb = tid >> 5; constexpr int NCG = (PASS == 1) ? 24 : 32;
          if (cg < NCG) {
            const int chn = (cg < 16) ? g * 128 + cg * 8 : (cg < 24) ? 256 + g * 64 + (cg - 16) * 8 : 384 + g * 64 + (cg - 24) * 8;
            u32x4 xr[11];
#pragma unroll
            for (int k = 0; k < 11; ++k) { const int sq = c * 128 + rb * 8 + k - 3; xr[k] = (u32x4){0u, 0u, 0u, 0u}; if (sq >= 0) xr[k] = *(const u32x4*)(pj + (size_t)(b * SEQ + sq) * PJ + C_XBC + chn); }
            f32x4 w0[4], w1[4];
#pragma unroll
            for (int k = 0; k < 4; ++k) { w0[k] = *(const f32x4*)(convw + k * 512 + chn); w1[k] = *(const f32x4*)(convw + k * 512 + chn + 4); }
            const f32x4 cb0 = *(const f32x4*)(convb + chn), cb1 = *(const f32x4*)(convb + chn + 4);
            LAS bf16_t* dst = (cg < 16) ? (LAS bf16_t*)(X.lds + ((cg >> 3) ? SD_XT1 : SD_XT0)) + (cg & 7) * 8 : (cg < 24) ? Bm + (cg - 16) * 8 : Cm + (cg - 24) * 8;
            const int jh = (cg >> 3) & 1;
#pragma unroll
            for (int r = 0; r < 8; ++r) { const int rl = rb * 8 + r;
                f32x4 s0 = cb0, s1 = cb1;
#pragma unroll
                for (int k = 0; k < 4; ++k) { const u32x4 xv = xr[r + k];
                    s0[0] += w0[k][0] * bflo(xv.x); s0[1] += w0[k][1] * bfhi(xv.x); s0[2] += w0[k][2] * bflo(xv.y); s0[3] += w0[k][3] * bfhi(xv.y);
                    s1[0] += w1[k][0] * bflo(xv.z); s1[1] += w1[k][1] * bfhi(xv.z); s1[2] += w1[k][2] * bflo(xv.w); s1[3] += w1[k][3] * bfhi(xv.w); }
                float sc = 1.0f; if (PASS == 1 && cg < 16) sc = __expf(acm[jh * 128 + 127] - acm[jh * 128 + rl]) * dtv[jh * 128 + rl];
                u32x4 o; o.x = pk2(siluf_(s0[0]) * sc, siluf_(s0[1]) * sc); o.y = pk2(siluf_(s0[2]) * sc, siluf_(s0[3]) * sc); o.z = pk2(siluf_(s1[0]) * sc, siluf_(s1[1]) * sc); o.w = pk2(siluf_(s1[2]) * sc, siluf_(s1[3]) * sc);
                *(LAS u32x4*)(dst + rl * 72) = o; }
          } }
        if (PASS == 3) {
            const bf16_t* sin = (const bf16_t*)(X.ws + WS_SSDSIN) + (size_t)((b * 64 + c) * 4 + 2 * g) * 4096 + tid * 8;
            const int p = tid >> 3, n0 = (tid & 7) * 8;
            *(LAS u32x4*)((LAS bf16_t*)(X.lds + SD_SIN0) + p * 72 + n0) = *(const u32x4*)sin;
            *(LAS u32x4*)((LAS bf16_t*)(X.lds + SD_SIN1) + p * 72 + n0) = *(const u32x4*)(sin + 4096);
        }
        __syncthreads();
        if (PASS == 1) {
            const int j = w >> 2, pt = w & 3; const LAS bf16_t* Xr = (const LAS bf16_t*)(X.lds + (j ? SD_XT1 : SD_XT0));
            f32x4 acc[4];
#pragma unroll
            for (int nt = 0; nt < 4; ++nt) acc[nt] = (f32x4){0.f, 0.f, 0.f, 0.f};
#pragma unroll
            for (int ks = 0; ks < 4; ++ks) { const bf16x8 xf = tr_frag8(Xr, 72, ks * 32, pt * 16, lane);
#pragma unroll
                for (int nt = 0; nt < 4; ++nt) { const bf16x8 bf = tr_frag8(Bm, 72, ks * 32, nt * 16, lane); acc[nt] = mfma16(xf, bf, acc[nt]); } }
            float* sp = sst + (size_t)((b * 64 + c) * 4 + 2 * g + j) * 4096;
#pragma unroll
            for (int nt = 0; nt < 4; ++nt)
#pragma unroll
                for (int i = 0; i < 4; ++i) sp[(pt * 16 + 4 * fq + i) * 64 + nt * 16 + fr] = acc[nt][i];
        } else {
            const int lrow = w * 16 + fr;
            float yv[2][4][4];
#pragma unroll
            for (int j = 0; j < 2; ++j) {
                const LAS bf16_t* Xr = (const LAS bf16_t*)(X.lds + (j ? SD_XT1 : SD_XT0)); const LAS bf16_t* Sin = (const LAS bf16_t*)(X.lds + (j ? SD_SIN1 : SD_SIN0));
                const float al = acm[j * 128 + lrow];
                const bf16x8 cf0 = *(const LAS bf16x8*)(Cm + lrow * 72 + 8 * fq), cf1 = *(const LAS bf16x8*)(Cm + lrow * 72 + 32 + 8 * fq);
                const int stmax = w | 1;
                for (int st = 0; st <= stmax; ++st) {
                    f32x4 ag = (f32x4){0.f, 0.f, 0.f, 0.f};
                    if (st <= w) { const bf16x8 b0 = *(const LAS bf16x8*)(Bm + (st * 16 + fr) * 72 + 8 * fq), b1 = *(const LAS bf16x8*)(Bm + (st * 16 + fr) * 72 + 32 + 8 * fq);
                        ag = mfma16(b0, cf0, ag); ag = mfma16(b1, cf1, ag); }
                    float mv[4];
#pragma unroll
                    for (int i = 0; i < 4; ++i) { const int s = st * 16 + 4 * fq + i; mv[i] = (s <= lrow) ? ag[i] * __expf(al - acm[j * 128 + s]) * dtv[j * 128 + s] : 0.f; }
                    u32x2 o; o.x = pk2(mv[0], mv[1]); o.y = pk2(mv[2], mv[3]); *(LAS u32x2*)(Mm + lrow * 136 + st * 16 + 4 * fq) = o;
                }
                const float eal = __expf(al); const float dsk = X.in(I_SSDD)[l * 4 + 2 * g + j];
#pragma unroll
                for (int pt = 0; pt < 4; ++pt) {
                    f32x4 ad = (f32x4){0.f, 0.f, 0.f, 0.f}, ao = ad;
                    for (int ks = 0; ks <= (w >> 1); ++ks) { const bf16x8 xf = tr_frag8(Xr, 72, ks * 32, pt * 16, lane); const bf16x8 mf = *(const LAS bf16x8*)(Mm + lrow * 136 + ks * 32 + 8 * fq); ad = mfma16(xf, mf, ad); }
                    { const bf16x8 s0 = *(const LAS bf16x8*)(Sin + (pt * 16 + fr) * 72 + 8 * fq), s1 = *(const LAS bf16x8*)(Sin + (pt * 16 + fr) * 72 + 32 + 8 * fq); ao = mfma16(s0, cf0, ao); ao = mfma16(s1, cf1, ao); }
                    const int h = 2 * g + j; const u32x2 zv = *(const u32x2*)(pj + (size_t)(r0 + lrow) * PJ + C_Z + h * 64 + pt * 16 + 4 * fq);
                    const float z4[4] = {bflo(zv.x), bfhi(zv.x), bflo(zv.y), bfhi(zv.y)};
#pragma unroll
                    for (int i = 0; i < 4; ++i) { const float xs = bf2f(Xr[lrow * 72 + pt * 16 + 4 * fq + i]); yv[j][pt][i] = (ad[i] + eal * ao[i] + dsk * xs) * siluf_(z4[i]); }
                }
            }
            float ss = 0.f;
#pragma unroll
            for (int j = 0; j < 2; ++j)
#pragma unroll
                for (int pt = 0; pt < 4; ++pt)
#pragma unroll
                    for (int i = 0; i < 4; ++i) ss += yv[j][pt][i] * yv[j][pt][i];
            ss += __shfl_xor(ss, 16); ss += __shfl_xor(ss, 32);
            const float rs = rsqrtf(ss * (1.0f / 128.0f) + RMS_EPS);
            const float* ng = X.in(I_SSDNG) + l * 256 + g * 128; bf16_t* yd = X.ybuf() + (size_t)3 * M * 256;
#pragma unroll
            for (int j = 0; j < 2; ++j)
#pragma unroll
                for (int pt = 0; pt < 4; ++pt) { const int cc = j * 64 + pt * 16 + 4 * fq; const f32x4 gv = *(const f32x4*)(ng + cc);
                    u32x2 o; o.x = pk2(yv[j][pt][0] * rs * gv[0], yv[j][pt][1] * rs * gv[1]); o.y = pk2(yv[j][pt][2] * rs * gv[2], yv[j][pt][3] * rs * gv[3]);
                    *(u32x2*)(yd + (size_t)(r0 + lrow) * 256 + g * 128 + cc) = o; }
        }
        __syncthreads();
    }
}

__device__ __forceinline__ void mx_s5_carry(const Ctx& X) {
    const float* st = (const float*)(X.ws + WS_S5ST); float* hin = (float*)(X.ws + WS_S5HIN); const float* sa = (const float*)(X.ws + WS_S5A);
    for (int i = X.c * 32 + (X.tid - 256); X.tid >= 256 && X.tid < 288 && i < NB * 16 * 64; i += X.G * 32) {
        const int p = i & 63, g = (i >> 6) & 15, b = i >> 10;
        float pr = sa[(g * 64 + p) * 2], pi = sa[(g * 64 + p) * 2 + 1];
#pragma unroll
        for (int q = 0; q < 8; ++q) { const float nr = pr * pr - pi * pi, ni = 2.f * pr * pi; pr = nr; pi = ni; }
        float hr = 0.f, hi = 0.f; const size_t base = (size_t)((b * 16 + g) * 32) * 128 + p;
#pragma unroll 8
        for (int ch = 0; ch < 32; ++ch) { hin[base + ch * 128] = hr; hin[base + ch * 128 + 64] = hi;
            const float sr = st[base + ch * 128], si = st[base + ch * 128 + 64]; const float nr = pr * hr - pi * hi + sr, ni = pr * hi + pi * hr + si; hr = nr; hi = ni; }
    }
}

__device__ __forceinline__ void mx_ssd_carry(const Ctx& X) {
    const float* sst = (const float*)(X.ws + WS_SSDST); const float* atot = (const float*)(X.ws + WS_ATOT); bf16_t* sin = (bf16_t*)(X.ws + WS_SSDSIN);
    for (int i = X.c * 256 + X.tid; X.tid < 256 && i < NB * 4 * 4096; i += X.G * 256) {
        const int e1 = i & 4095, h = (i >> 12) & 3, b = i >> 14;
        float S = 0.f;
#pragma unroll 16
        for (int c = 0; c < 64; ++c) { const size_t o = (size_t)((b * 64 + c) * 4 + h) * 4096 + e1;
            sin[o] = (bf16_t)f2bf(S);
            S = S * __expf(atot[(b * 64 + c) * 32 + h]) + sst[o]; }
    }
}

__device__ __forceinline__ unsigned ord16(float s) { const _Float16 hf = (_Float16)s; const unsigned bits = (unsigned)__builtin_bit_cast(unsigned short, hf); return bits ^ ((bits & 0x8000u) ? 0xFFFFu : 0x8000u); }
__device__ __forceinline__ int cnt_ge8(const u32x4 v, unsigned c) {
    int n = 0;
    n += ((v.x & 0xFFFFu) >= c) + ((v.x >> 16) >= c); n += ((v.y & 0xFFFFu) >= c) + ((v.y >> 16) >= c);
    n += ((v.z & 0xFFFFu) >= c) + ((v.z >> 16) >= c); n += ((v.w & 0xFFFFu) >= c) + ((v.w >> 16) >= c);
    return n;
}
template <int CTRL> __device__ __forceinline__ float dpp_f(float v) { return __builtin_bit_cast(float, __builtin_amdgcn_update_dpp(0, __builtin_bit_cast(int, v), CTRL, 0xF, 0xF, true)); }
__device__ __forceinline__ void mx_dsa(const Ctx& X, int b, int t0) {
    const int tid = X.tid, lane = X.lane, w = X.wave, fr = lane & 15, fq = lane >> 4;
    const bf16_t* pj = X.proj() + (size_t)b * SEQ * PJ; const unsigned rb = 0u;
    const bf16_t* ki2 = (const bf16_t*)(X.ws + WS_KI2) + (size_t)b * SEQ * 64; const bf16_t* k2 = (const bf16_t*)(X.ws + WS_K2) + (size_t)b * SEQ * 64; const bf16_t* v2 = (const bf16_t*)(X.ws + WS_V2) + (size_t)b * SEQ * 64;
    LAS unsigned short* sc = (LAS unsigned short*)X.lds;
    const int nk = t0 + 8, nkt = (nk + 15) >> 4;
    LAS unsigned* hist = (LAS unsigned*)(X.lds + 131072 + 8192);
    for (int i = tid; i < 8 * 4 * 128 / 4; i += 512) *(LAS u32x4*)(hist + 4 * i) = (u32x4){0u, 0u, 0u, 0u};
    bf16x8 qf[2][2]; f32x4 wq[2];
#pragma unroll
    for (int ct = 0; ct < 2; ++ct) { const int q = 4 * ct + (fr >> 2), hh = fr & 3; const bf16_t* qp = pj + (unsigned)(t0 + q) * (unsigned)PJ;
        qf[ct][0] = *(const bf16x8*)(qp + C_QI + hh * 64 + 8 * fq); qf[ct][1] = *(const bf16x8*)(qp + C_QI + hh * 64 + 32 + 8 * fq);
        const u32x2 wv = *(const u32x2*)(pj + (unsigned)(t0 + 4 * ct + fq) * (unsigned)PJ + C_WI);
        wq[ct] = (f32x4){bflo(wv.x) * 0.0625f, bfhi(wv.x) * 0.0625f, bflo(wv.y) * 0.0625f, bfhi(wv.y) * 0.0625f}; }
    const int ntw = (nkt > w) ? ((nkt - w + 7) >> 3) : 0;
    __syncthreads();
#define DSA_LOAD4(KF, I0) do { _Pragma("unroll") for (int j = 0; j < 4; ++j) { int kt_ = w + 8 * ((I0) + j); kt_ = kt_ < nkt ? kt_ : nkt - 1; \
        const unsigned ko_ = (unsigned)kt_ * 1024u + (unsigned)lane * 8u; KF[j][0] = *(const bf16x8*)(ki2 + ko_); KF[j][1] = *(const bf16x8*)(ki2 + ko_ + 512u); } } while (0)
#define DSA_COMP4(KF, I0) do { if (DSA_PM == 2 && rs1 > 0) { _Pragma("unroll") for (int j = 0; j < 4; ++j) dummy_ ^= KF[j][0][0] ^ KF[j][1][3]; break; } \
      _Pragma("unroll") for (int jh = 0; jh < 4; jh += 2) { f32x4 ac_[2][2]; \
        _Pragma("unroll") for (int j = 0; j < 2; ++j) _Pragma("unroll") for (int ct = 0; ct < 2; ++ct) { \
            ac_[j][ct] = mfma16(qf[ct][0], KF[jh + j][0], (f32x4){0.f, 0.f, 0.f, 0.f}); ac_[j][ct] = mfma16(qf[ct][1], KF[jh + j][1], ac_[j][ct]); } \
        _Pragma("unroll") for (int j = 0; j < 2; ++j) { if ((I0) + jh + j < ntw) { const int kt_ = w + 8 * ((I0) + jh + j); const bool full_ = (kt_ * 16 + 15 <= t0); const int key_ = kt_ * 16 + fr; \
        _Pragma("unroll") for (int ct = 0; ct < 2; ++ct) { const f32x4 a_ = ac_[j][ct]; \
            float tt_ = __builtin_fmaf(__builtin_amdgcn_fmed3f(a_[0], 0.f, 3.0e38f), wq[ct][0], 0.0f); tt_ = __builtin_fmaf(__builtin_amdgcn_fmed3f(a_[1], 0.f, 3.0e38f), wq[ct][1], tt_); \
            tt_ = __builtin_fmaf(__builtin_amdgcn_fmed3f(a_[2], 0.f, 3.0e38f), wq[ct][2], tt_); tt_ = __builtin_fmaf(__builtin_amdgcn_fmed3f(a_[3], 0.f, 3.0e38f), wq[ct][3], tt_); \
            const int q_ = 4 * ct + fq; unsigned kk_ = ord16(tt_ + 0.0f); \
            if (!full_) kk_ = (key_ <= t0 + q_) ? kk_ : 0u; \
            if (DSA_PM == 1 && rs1 > 0) dummy_ ^= (short)kk_; else sc[q_ * 8192 + key_] = (unsigned short)kk_; \
            if ((R_S1 == 1 || rs1 == 0) && (full_ || kk_ != 0u)) __hip_atomic_fetch_add(hist + (q_ * 4 + (fr & 3)) * 128 + (kk_ >> 9), (kk_ & 0x100u) ? 65536u : 1u, __ATOMIC_RELAXED, __HIP_MEMORY_SCOPE_WORKGROUP); } } } } } while (0)
    short dummy_ = 0;
    _Pragma("nounroll") for (int rs1 = 0; rs1 < (((DSA_SKIP | X.dbg) & 1) ? 0 : R_S1); ++rs1)
    { bf16x8 ka[4][2], kb[4][2];
      if (ntw > 0) { DSA_LOAD4(ka, 0);
#pragma nounroll
        for (int i0 = 0; i0 < ntw; i0 += 8) { DSA_LOAD4(kb, i0 + 4); DSA_COMP4(ka, i0); DSA_LOAD4(ka, i0 + 8); DSA_COMP4(kb, i0 + 4); } } }
#undef DSA_LOAD4
#undef DSA_COMP4
    if (dummy_ == (short)0x1234 && t0 == 123457) sc[0] = 1;
    { const int z0 = nkt * 16, z1 = ((nk + 511) >> 9) << 9;
        for (int i = z0 + tid; i < z1; i += 512) {
#pragma unroll
            for (int q = 0; q < 8; ++q) sc[q * 8192 + i] = 0; } }
    __syncthreads();
    const int t = t0 + w, nv = t + 1;
    LAS unsigned short* row = sc + w * 8192;
    LAS unsigned short* list = (LAS unsigned short*)(X.lds + 131072 + w * 512);
    const int nsel = nv < 256 ? nv : 256;
    if (((DSA_SKIP | X.dbg) & 2) || nv <= 256) { for (int n = lane; n < 256; n += 64) list[n] = (unsigned short)n; }
    else {
        const int nit = (nv + 511) >> 9;
        LAS unsigned* H = hist + w * 512;
        int T1, above1;
        { u32x4 h4 = (u32x4){0u, 0u, 0u, 0u};
#pragma unroll
          for (int c4 = 0; c4 < 4; ++c4) { const u32x2 pw = *(const LAS u32x2*)(H + c4 * 128 + 2 * lane); h4.x += pw.x & 0xFFFFu; h4.y += pw.x >> 16; h4.z += pw.y & 0xFFFFu; h4.w += pw.y >> 16; }
          const int sl = (int)(h4.x + h4.y + h4.z + h4.w);
          int suf = sl;
#pragma unroll
          for (int o = 1; o < 64; o <<= 1) { const int dn = __shfl_down(suf, o); if (lane + o < 64) suf += dn; }
          const unsigned long long bm = __ballot(suf >= 256); const int L = 63 - __builtin_clzll(bm);
          const int hx = __shfl((int)h4.x, L), hy = __shfl((int)h4.y, L), hz = __shfl((int)h4.z, L), hw = __shfl((int)h4.w, L);
          const int sufn = __shfl(suf, L) - (hx + hy + hz + hw);
          int cb = sufn; T1 = 4 * L + 3; above1 = cb;
          if (cb + hw >= 256) { T1 = 4 * L + 3; above1 = cb; } else { cb += hw; if (cb + hz >= 256) { T1 = 4 * L + 2; above1 = cb; } else { cb += hz; if (cb + hy >= 256) { T1 = 4 * L + 1; above1 = cb; } else { cb += hy; T1 = 4 * L; above1 = cb; } } } }
        _Pragma("nounroll") for (int rs2 = 0; rs2 < R_S2; ++rs2) {
        *(LAS u32x4*)(H + 4 * lane) = (u32x4){0u, 0u, 0u, 0u};
        for (int it = 0; it < nit; ++it) { const u32x4 v = *(const LAS u32x4*)(row + (it * 64 + lane) * 8);
            const unsigned e[8] = {v.x & 0xFFFFu, v.x >> 16, v.y & 0xFFFFu, v.y >> 16, v.z & 0xFFFFu, v.z >> 16, v.w & 0xFFFFu, v.w >> 16};
#pragma unroll
            for (int j = 0; j < 8; ++j) if ((int)(e[j] >> 8) == T1) __hip_atomic_fetch_add(H + (e[j] & 255u), 1u, __ATOMIC_RELAXED, __HIP_MEMORY_SCOPE_WORKGROUP); }
        unsigned thr; int cgt, cge;
        { const u32x4 h4 = *(const LAS u32x4*)(H + 4 * lane); const int sl = (int)(h4.x + h4.y + h4.z + h4.w);
          int suf = sl;
#pragma unroll
          for (int o = 1; o < 64; o <<= 1) { const int dn = __shfl_down(suf, o); if (lane + o < 64) suf += dn; }
          const int need = 256 - above1;
          const unsigned long long bm = __ballot(suf >= need); const int L = 63 - __builtin_clzll(bm);
          const int hx = __shfl((int)h4.x, L), hy = __shfl((int)h4.y, L), hz = __shfl((int)h4.z, L), hw = __shfl((int)h4.w, L);
          int cb = __shfl(suf, L) - (hx + hy + hz + hw); int T2, hT;
          if (cb + hw >= need) { T2 = 4 * L + 3; hT = hw; } else { cb += hw; if (cb + hz >= need) { T2 = 4 * L + 2; hT = hz; } else { cb += hz; if (cb + hy >= need) { T2 = 4 * L + 1; hT = hy; } else { cb += hy; T2 = 4 * L; hT = hx; } } }
          thr = ((unsigned)T1 << 8) | (unsigned)T2; cgt = above1 + cb; cge = cgt + hT; }
        const bool exact = (cge == 256);
        const int r = 256 - cgt;
        const unsigned cmin = exact ? thr : thr + 1u;
        const unsigned long long lt_mask = (1ull << lane) - 1ull; int bcnt = 0;
        for (int it = 0; it < nit; ++it) { const u32x4 v = *(const LAS u32x4*)(row + (it * 64 + lane) * 8); const int base = (it * 64 + lane) * 8;
            const unsigned e[8] = {v.x & 0xFFFFu, v.x >> 16, v.y & 0xFFFFu, v.y >> 16, v.z & 0xFFFFu, v.z >> 16, v.w & 0xFFFFu, v.w >> 16};
#pragma unroll
            for (int j = 0; j < 8; ++j) { const bool sl = e[j] >= cmin; const unsigned long long bm = __ballot(sl);
                if (bm != 0ull) { if (sl) list[(bcnt + __popcll(bm & lt_mask)) & 255] = (unsigned short)(base + j); bcnt += __popcll(bm); } } }
        if (!exact) {
            int taken = 0;
            for (int it = 0; it < nit && taken < r; ++it) { const u32x4 v = *(const LAS u32x4*)(row + (it * 64 + lane) * 8); const int base = (it * 64 + lane) * 8;
                const unsigned e[8] = {v.x & 0xFFFFu, v.x >> 16, v.y & 0xFFFFu, v.y >> 16, v.z & 0xFFFFu, v.z >> 16, v.w & 0xFFFFu, v.w >> 16};
                int mcount = 0;
#pragma unroll
                for (int j = 0; j < 8; ++j) mcount += (e[j] == thr);
                if (__ballot(mcount != 0) == 0ull) continue;
                int incl = mcount;
#pragma unroll
                for (int o = 1; o < 64; o <<= 1) { const int up = __shfl_up(incl, o); if (lane >= o) incl += up; }
                const int total = __shfl(incl, 63); int rk = taken + incl - mcount;
#pragma unroll
                for (int j = 0; j < 8; ++j) if (e[j] == thr) { if (rk < r) list[(cgt + rk) & 255] = (unsigned short)(base + j); ++rk; }
                taken += total; }
        }
        }
    }
    __builtin_amdgcn_fence(__ATOMIC_RELEASE, "workgroup"); __builtin_amdgcn_wave_barrier();
    const bf16_t* qrow = pj + (unsigned)t * (unsigned)PJ;
    bf16x8 qb0 = (bf16x8){0, 0, 0, 0, 0, 0, 0, 0}, qb1 = qb0;
    if (fr < 4) { qb0 = *(const bf16x8*)(qrow + C_Q + fr * 64 + 8 * fq); qb1 = *(const bf16x8*)(qrow + C_Q + fr * 64 + 32 + 8 * fq); }
    LAS float* Pb = (LAS float*)row;
    LAS float* pinv = (LAS float*)(X.lds + 131072 + 4096 + 256 + w * 16);
    _Pragma("nounroll") for (int rs3 = 0; rs3 < (((DSA_SKIP | X.dbg) & 4) ? 0 : R_S3); ++rs3) {
    { LAS unsigned char* kbuf = (LAS unsigned char*)row + 4096;
      const int drow = lane >> 3, dchk = (lane & 7) ^ (drow & 7);
#define QK_DMA(G) do { _Pragma("unroll") for (int i_ = 0; i_ < 4; ++i_) { const unsigned ko_ = (unsigned)list[(G) * 32 + i_ * 8 + drow] * 64u + (unsigned)(dchk * 8); \
        __builtin_amdgcn_global_load_lds((const unsigned*)(k2 + ko_), (LAS unsigned*)(kbuf + ((G) % 3) * 4096 + i_ * 1024), 16, 0, 0); } } while (0)
#define QK_COMP(G) do { _Pragma("unroll") for (int j = 0; j < 2; ++j) { const LAS unsigned char* tb_ = kbuf + ((G) % 3) * 4096 + j * 2048 + fr * 128; \
        const bf16x8 k0_ = *(const LAS bf16x8*)(tb_ + ((fq ^ (fr & 7)) * 16)), k1_ = *(const LAS bf16x8*)(tb_ + (((4 + fq) ^ (fr & 7)) * 16)); \
        f32x4 a_ = mfma16(k0_, qb0, (f32x4){0.f, 0.f, 0.f, 0.f}); a_ = mfma16(k1_, qb1, a_); \
        if (fr < 4) { _Pragma("unroll") for (int i = 0; i < 4; ++i) { const int nn_ = ((G) * 2 + j) * 16 + 4 * fq + i; Pb[nn_ * 4 + fr] = (nn_ < nsel) ? a_[i] * 0.125f : -3.0e38f; } } } } while (0)
      asm volatile("s_waitcnt vmcnt(0)" ::: "memory");
      QK_DMA(0); QK_DMA(1);
      asm volatile("s_waitcnt vmcnt(4)" ::: "memory"); QK_COMP(0); QK_DMA(2);
      asm volatile("s_waitcnt vmcnt(4)" ::: "memory"); QK_COMP(1); asm volatile("s_waitcnt lgkmcnt(0)" ::: "memory"); QK_DMA(3);
      asm volatile("s_waitcnt vmcnt(4)" ::: "memory"); QK_COMP(2); asm volatile("s_waitcnt lgkmcnt(0)" ::: "memory"); QK_DMA(4);
      asm volatile("s_waitcnt vmcnt(4)" ::: "memory"); QK_COMP(3); asm volatile("s_waitcnt lgkmcnt(0)" ::: "memory"); QK_DMA(5);
      asm volatile("s_waitcnt vmcnt(4)" ::: "memory"); QK_COMP(4); asm volatile("s_waitcnt lgkmcnt(0)" ::: "memory"); QK_DMA(6);
      asm volatile("s_waitcnt vmcnt(4)" ::: "memory"); QK_COMP(5); asm volatile("s_waitcnt lgkmcnt(0)" ::: "memory"); QK_DMA(7);
      asm volatile("s_waitcnt vmcnt(4)" ::: "memory"); QK_COMP(6);
      asm volatile("s_waitcnt vmcnt(0)" ::: "memory"); QK_COMP(7);
#undef QK_DMA
#undef QK_COMP
    }
    __builtin_amdgcn_fence(__ATOMIC_RELEASE, "workgroup"); __builtin_amdgcn_wave_barrier();
    { const int hd = lane & 3, nb0 = lane >> 2;
        float v16[16]; float mx = -3.0e38f;
#pragma unroll
        for (int j = 0; j < 16; ++j) { v16[j] = Pb[(nb0 + 16 * j) * 4 + hd]; mx = fmaxf(mx, v16[j]); }
        mx = fmaxf(mx, __shfl_xor(mx, 4)); mx = fmaxf(mx, __shfl_xor(mx, 8)); mx = fmaxf(mx, __shfl_xor(mx, 16)); mx = fmaxf(mx, __shfl_xor(mx, 32));
        float sm = 0.f;
#pragma unroll
        for (int j = 0; j < 16; ++j) { const float p = (v16[j] > -1.0e38f) ? __expf(v16[j] - mx) : 0.f; sm += p; Pb[(nb0 + 16 * j) * 4 + hd] = p; }
        sm += __shfl_xor(sm, 4); sm += __shfl_xor(sm, 8); sm += __shfl_xor(sm, 16); sm += __shfl_xor(sm, 32);
        if (lane < 4) pinv[lane] = 1.0f / sm; }
    __builtin_amdgcn_fence(__ATOMIC_RELEASE, "workgroup"); __builtin_amdgcn_wave_barrier();
    f32x2 o2[4][2];
#pragma unroll
    for (int h = 0; h < 4; ++h) { o2[h][0] = (f32x2){0.f, 0.f}; o2[h][1] = (f32x2){0.f, 0.f}; }
    const int d4 = fr * 4;
#define PV_LOAD(VV, B) do { _Pragma("unroll") for (int j = 0; j < 16; ++j) { const unsigned vo_ = (unsigned)list[(B) * 64 + 4 * j + fq] * 64u + (unsigned)d4; VV[j] = *(const u32x2*)(v2 + vo_); } } while (0)
#define PV_COMP(VV, B) do { _Pragma("unroll") for (int j = 0; j < 16; ++j) { const f32x4 p4_ = *(const LAS f32x4*)(Pb + ((B) * 64 + 4 * j + fq) * 4); \
        const f32x2 va_ = (f32x2){bflo(VV[j].x), bfhi(VV[j].x)}, vb_ = (f32x2){bflo(VV[j].y), bfhi(VV[j].y)}; \
        _Pragma("unroll") for (int h = 0; h < 4; ++h) { const f32x2 pp_ = (f32x2){p4_[h], p4_[h]}; o2[h][0] = __builtin_elementwise_fma(va_, pp_, o2[h][0]); o2[h][1] = __builtin_elementwise_fma(vb_, pp_, o2[h][1]); } } } while (0)
    { u32x2 va[16], vb[16]; PV_LOAD(va, 0); PV_LOAD(vb, 1); PV_COMP(va, 0); PV_LOAD(va, 2); PV_COMP(vb, 1); PV_LOAD(vb, 3); PV_COMP(va, 2); PV_COMP(vb, 3); }
#undef PV_LOAD
#undef PV_COMP
    float o4[4][4];
#pragma unroll
    for (int h = 0; h < 4; ++h)
#pragma unroll
        for (int dd = 0; dd < 4; ++dd) { float v = o2[h][dd >> 1][dd & 1]; v += __shfl_xor(v, 16); v += __shfl_xor(v, 32); o4[h][dd] = v; }
    { const int h = fq; const float iv = pinv[h];
        float r4[4];
#pragma unroll
        for (int dd = 0; dd < 4; ++dd) r4[dd] = ((h == 0) ? o4[0][dd] : (h == 1) ? o4[1][dd] : (h == 2) ? o4[2][dd] : o4[3][dd]) * iv;
        u32x2 o; o.x = pk2(r4[0], r4[1]); o.y = pk2(r4[2], r4[3]);
        *(u32x2*)(X.ybuf() + (size_t)1 * M * 256 + ((size_t)b * SEQ + t) * 256 + h * 64 + d4) = o; }
    __builtin_amdgcn_fence(__ATOMIC_RELEASE, "workgroup"); __builtin_amdgcn_wave_barrier(); }
    __syncthreads();
}

constexpr int LR_HH = 0, LR_HL = 33280, LR_PART = 66560, LR_LG = 82944, LR_CNT = 84992, LR_PITCH = 1032;
__device__ __forceinline__ void ph_ln1_router(const Ctx& X, int l) {
    const int lane = X.lane, w = X.wave, tid = X.tid, fr = lane & 15, fq = lane >> 4;
    LAS bf16_t* Hh = (LAS bf16_t*)(X.lds + LR_HH); LAS bf16_t* Hl = (LAS bf16_t*)(X.lds + LR_HL);
    LAS float* part = (LAS float*)(X.lds + LR_PART);
    LAS float* lgt = (LAS float*)(X.lds + LR_LG);
    LAS unsigned* wgcnt = (LAS unsigned*)(X.lds + LR_CNT);
    if (tid < 32) wgcnt[tid] = 0u;
    bf16x8 Ahi[2][4], Alo[2][4];
    { const bf16_t* rf = (const bf16_t*)(X.ws + WS_RFR);
#pragma unroll
      for (int rt = 0; rt < 2; ++rt)
#pragma unroll
          for (int q = 0; q < 4; ++q) { const size_t o = ((size_t)(rt * 32 + 4 * w + q) * 64 + lane) * 8; Ahi[rt][q] = *(const bf16x8*)(rf + o); Alo[rt][q] = *(const bf16x8*)(rf + 32768 + o); } }
    float* xo = X.a->out; bf16_t* hb = X.hbuf(); float* xw = (X.dbg & 8) ? (float*)(X.ws + WS_ACT) : xo; const bf16_t* v16 = (const bf16_t*)(X.ws + WS_V16);
    const int tok0 = X.c * 128, b = tok0 >> 13;
    const float* mv = X.modv(l, 1) + b * 3072;
    const float* lg = X.in(I_LN1G) + l * D; const float* lb = X.in(I_LN1B) + l * D;
    const int e = lane & 31;
    const float rbias = X.in(I_RB)[l * NEXP + e];
    unsigned* pinfo = (unsigned*)(X.ws + WS_PINFO); float* pgate = (float*)(X.ws + WS_PGATE);
    __syncthreads();
    u32x2 raw[2][4];
#pragma unroll
    for (int jj = 0; jj < 2; ++jj)
#pragma unroll
        for (int j = 0; j < 4; ++j) raw[jj][j] = *(const u32x2*)(v16 + (size_t)(tok0 + 2 * w + jj) * D + 4 * lane + 256 * j);
    for (int pass = 0; pass < 8; ++pass) {
        f32x4 vv[2][4];
#pragma unroll
        for (int jj = 0; jj < 2; ++jj)
#pragma unroll
            for (int j = 0; j < 4; ++j) { const u32x2 q2 = raw[jj][j]; vv[jj][j] = (f32x4){bflo(q2.x), bfhi(q2.x), bflo(q2.y), bfhi(q2.y)}; }
        if (pass + 1 < 8) {
#pragma unroll
            for (int jj = 0; jj < 2; ++jj)
#pragma unroll
                for (int j = 0; j < 4; ++j) raw[jj][j] = *(const u32x2*)(v16 + (size_t)(tok0 + (pass + 1) * 16 + 2 * w + jj) * D + 4 * lane + 256 * j); }
#pragma unroll
        for (int jj = 0; jj < 2; ++jj) {
            const int r = 2 * w + jj, tok = tok0 + pass * 16 + r;
            f32x4 v[4]; float s = 0.f;
#pragma unroll
            for (int j = 0; j < 4; ++j) { v[j] = vv[jj][j]; s += (v[j][0] + v[j][1]) + (v[j][2] + v[j][3]); }
            const float mean = wave_sum(s) * (1.0f / D); float q = 0.f;
#pragma unroll
            for (int j = 0; j < 4; ++j) { v[j] = v[j] - mean; q += (v[j][0] * v[j][0] + v[j][1] * v[j][1]) + (v[j][2] * v[j][2] + v[j][3] * v[j][3]); }
            const float rstd = rsqrtf(wave_sum(q) * (1.0f / D) + LN_EPS);
#pragma unroll
            for (int j = 0; j < 4; ++j) { const int col = 4 * lane + 256 * j;
                const f32x4 x1 = v[j] * rstd * *(const f32x4*)(lg + col) + *(const f32x4*)(lb + col);
                *(f32x4*)(xw + (size_t)tok * D + col) = x1 * DN_ALPHA;
                const f32x4 hv = x1 * (*(const f32x4*)(mv + 1024 + col) + 1.0f) + *(const f32x4*)(mv + col);
                const unsigned h0 = f2bf(hv[0]), h1 = f2bf(hv[1]), h2 = f2bf(hv[2]), h3 = f2bf(hv[3]);
                u32x2 o; o.x = h0 | (h1 << 16); o.y = h2 | (h3 << 16); *(u32x2*)(hb + (size_t)tok * D + col) = o;
                *(LAS u32x2*)(Hh + r * LR_PITCH + col) = o;
                u32x2 ol; ol.x = pk2(hv[0] - bflo(h0), hv[1] - bflo(h1)); ol.y = pk2(hv[2] - bflo(h2), hv[3] - bflo(h3)); *(LAS u32x2*)(Hl + r * LR_PITCH + col) = ol; }
        }
        __syncthreads();
        {
            f32x4 acc0 = (f32x4){0.f, 0.f, 0.f, 0.f}, acc1 = acc0;
#pragma unroll
            for (int q = 0; q < 4; ++q) { const int ko = fr * LR_PITCH + (4 * w + q) * 32 + 8 * fq;
                const bf16x8 bh = *(const LAS bf16x8*)(Hh + ko), bl = *(const LAS bf16x8*)(Hl + ko);
                acc0 = mfma16(Ahi[0][q], bh, acc0); acc0 = mfma16(Ahi[0][q], bl, acc0); acc0 = mfma16(Alo[0][q], bh, acc0);
                acc1 = mfma16(Ahi[1][q], bh, acc1); acc1 = mfma16(Ahi[1][q], bl, acc1); acc1 = mfma16(Alo[1][q], bh, acc1); }
#pragma unroll
            for (int i = 0; i < 4; ++i) { part[(w * 32 + 4 * fq + i) * 16 + fr] = acc0[i]; part[(w * 32 + 16 + 4 * fq + i) * 16 + fr] = acc1[i]; }
        }
        __syncthreads();
        { const int ee = tid >> 4, tk = tid & 15; float sm = 0.f;
#pragma unroll
          for (int q = 0; q < 8; ++q) sm += part[(q * 32 + ee) * 16 + tk];
          lgt[tk * 32 + ee] = sm; }
        __syncthreads();
#pragma unroll
        for (int jj = 0; jj < 2; ++jj) {
            const int r = 2 * w + jj, tok = tok0 + pass * 16 + r;
            const float score = sigmoidf_(lgt[r * 32 + e]), biased = score + rbias;
            const int gbase = lane & ~3;
            const float v0 = __shfl(biased, gbase), v1 = __shfl(biased, gbase + 1), v2 = __shfl(biased, gbase + 2), v3 = __shfl(biased, gbase + 3);
            const float a_ = fmaxf(v0, v1), b_ = fminf(v0, v1), c_ = fmaxf(v2, v3), d_ = fminf(v2, v3);
            const float gs = fmaxf(a_, c_) + fmaxf(fminf(a_, c_), fmaxf(b_, d_));
            const int myg = e >> 2; int grank = 0;
#pragma unroll
            for (int g2 = 0; g2 < 8; ++g2) { const float o = __shfl(gs, 4 * g2); grank += (o > gs || (o == gs && g2 < myg)) ? 1 : 0; }
            const float masked = (grank < 4) ? biased : -3.0e38f;
            int erank = 0;
#pragma unroll
            for (int e2 = 0; e2 < 32; ++e2) { const float o = __shfl(masked, e2); erank += (o > masked || (o == masked && e2 < e)) ? 1 : 0; }
            const bool sel = (erank < 8) && (lane < 32);
            const float wsum = wave_sum(sel ? score : 0.f);
            const float gate = score / wsum * 2.5f;
            const unsigned long long bal = __ballot(sel);
            if (sel) { const int k = __popcll(bal & ((1ull << lane) - 1ull));
                const unsigned lr = __hip_atomic_fetch_add(wgcnt + e, 1u, __ATOMIC_RELAXED, __HIP_MEMORY_SCOPE_WORKGROUP);
                pinfo[(size_t)tok * 8 + k] = (unsigned)e | (lr << 8); pgate[(size_t)tok * 8 + k] = gate; }
        }
    }
    __syncthreads();
    if (tid < 32) { const int chunk = tok0 / CHTOK; unsigned* cnt = (unsigned*)(X.ws + WS_CTL) + CW_CNT + (l * NCH + chunk) * 64;
        const unsigned base = __hip_atomic_fetch_add(cnt + tid, wgcnt[tid], __ATOMIC_RELAXED, __HIP_MEMORY_SCOPE_AGENT);
        ((unsigned*)(X.ws + WS_WGBASE))[X.c * 32 + tid] = base; }
    __syncthreads();
}

__device__ __forceinline__ void moe_offsets(const Ctx& X, int l, int chunk, LAS int* off  , LAS int* cntl  ) {
    if (X.tid == 0) { const unsigned* cnt = (const unsigned*)(X.ws + WS_CTL) + CW_CNT + (l * NCH + chunk) * 64; int o = 0;
        for (int e = 0; e < NE1; ++e) { const int cn = (e < NEXP) ? (int)__hip_atomic_load(cnt + e, __ATOMIC_RELAXED, __HIP_MEMORY_SCOPE_AGENT) : CHTOK; off[e] = o; cntl[e] = cn; o += ((cn + 255) >> 8) << 8; }
        off[NE1] = o; }
    __syncthreads();
}
#define ST_WT(p, v) __hip_atomic_store((p), (v), __ATOMIC_RELAXED, __HIP_MEMORY_SCOPE_AGENT)
__device__ __forceinline__ void ph_fill(const Ctx& X, int l) {
    LAS int* off = (LAS int*)(X.lds); LAS int* cntl = off + 64;
    const int tok0 = X.c * 128, chunk = tok0 / CHTOK;
    moe_offsets(X, l, chunk, off, cntl);
    unsigned* rowtok = (unsigned*)(X.ws + WS_ROWTOK) + (size_t)chunk * CH_ROWS; float* rowgate = (float*)(X.ws + WS_ROWGATE) + (size_t)chunk * CH_ROWS;
    const unsigned* pinfo = (const unsigned*)(X.ws + WS_PINFO); const float* pgate = (const float*)(X.ws + WS_PGATE); unsigned* slot = (unsigned*)(X.ws + WS_SLOT);
    const unsigned* wgb = (const unsigned*)(X.ws + WS_WGBASE) + X.c * 32;
    for (int i = X.tid; i < 1024; i += 512) { const size_t pi = (size_t)tok0 * 8 + i; const unsigned inf = pinfo[pi]; const int e = inf & 255, lr = inf >> 8;
        const int pos = off[e] + (int)wgb[e] + lr; ST_WT(rowtok + pos, (unsigned)(tok0 + (i >> 3))); ST_WT((unsigned*)rowgate + pos, __builtin_bit_cast(unsigned, pgate[pi])); slot[pi] = (unsigned)pos; }
    if (X.tid < 128) { const int tok = tok0 + X.tid; const int pos = off[NEXP] + (tok - chunk * CHTOK); ST_WT(rowtok + pos, (unsigned)tok); ST_WT((unsigned*)rowgate + pos, __builtin_bit_cast(unsigned, 1.0f)); }
    const int wl = X.c & 63;
    if (wl < NEXP) { const int e = wl; const int p0 = off[e] + cntl[e], p1 = off[e + 1]; for (int p = p0 + X.tid; p < p1; p += 512) { ST_WT(rowtok + p, (unsigned)(chunk * CHTOK)); ST_WT((unsigned*)rowgate + p, 0u); } }
    __syncthreads();
}

template <int NT, bool GATH>
struct MoeOrder {
    static constexpr bool GATHER = GATH;
    int nwg, G, c; const LAS unsigned char* tile_e; const LAS int* rowtab;
    __device__ __forceinline__ bool next(int i, pg8::Unit& u) const {
        const long L = (long)i * G + c; if (L >= nwg) return false;
        const int wgid = pg8::xcd_remap((int)L, nwg); const int tau = wgid / NT, pn = wgid % NT;
        u.pm = tau; u.pn = pn; u.bt = __builtin_amdgcn_readfirstlane((int)tile_e[tau]) * NT + pn; u.ab = i; return true;
    }
    __device__ __forceinline__ int row_of(const pg8::Unit& u, int r) const { return rowtab[u.ab * 256 + r]; }
    __device__ __forceinline__ void a_ready(const pg8::Unit&) const {}
    __device__ __forceinline__ void done(const pg8::Unit&) const {}
};
template <int NT, bool GATH>
struct MoeOrderAll {
    static constexpr bool GATHER = GATH;
    int nwg, G, c; const LAS unsigned char* tile_e4; const LAS int* tprefix; const LAS int* rowtab; int tbase;
    __device__ __forceinline__ bool next(int i, pg8::Unit& u) const {
        const long L = (long)i * G + c; if (L >= nwg) return false;
        const int wgid = pg8::xcd_remap((int)L, nwg); const int gt = tbase + wgid / NT, pn = wgid % NT;
        int ch = 0;
#pragma unroll
        for (int q = 1; q < NCH; ++q) ch += (tprefix[q] <= gt) ? 1 : 0;
        ch = __builtin_amdgcn_readfirstlane(ch); const int tau = gt - __builtin_amdgcn_readfirstlane(tprefix[ch]);
        u.pm = ch * CH_TILES + tau; u.pn = pn; u.bt = __builtin_amdgcn_readfirstlane((int)tile_e4[ch * 336 + tau]) * NT + pn; u.ab = i; return true;
    }
    __device__ __forceinline__ int row_of(const pg8::Unit& u, int r) const { return rowtab[u.ab * 256 + r]; }
    __device__ __forceinline__ void a_ready(const pg8::Unit&) const {}
    __device__ __forceinline__ void done(const pg8::Unit&) const {}
};
__device__ __forceinline__ void moe_tables_all(const Ctx& X, int l, LAS int* off4, LAS unsigned char* tile_e4, LAS int* tprefix) {
    if (X.tid < NCH) { const int chn = X.tid; const unsigned* cnt = (const unsigned*)(X.ws + WS_CTL) + CW_CNT + (l * NCH + chn) * 64; int o = 0;
        for (int e = 0; e < NE1; ++e) { const int cn = (e < NEXP) ? (int)__hip_atomic_load(cnt + e, __ATOMIC_RELAXED, __HIP_MEMORY_SCOPE_AGENT) : CHTOK; off4[chn * 64 + e] = o; o += ((cn + 255) >> 8) << 8; }
        off4[chn * 64 + NE1] = o; }
    __syncthreads();
    if (X.tid == 0) { int a = 0; for (int q = 0; q < NCH; ++q) { tprefix[q] = a; a += off4[q * 64 + NE1] >> 8; } tprefix[NCH] = a; }
    for (int t = X.tid; t < NCH * 336; t += 512) { const int chn = t / 336, tau = t % 336; int e = 0; for (int q = 1; q < NE1; ++q) e += (off4[chn * 64 + q] <= tau * 256) ? 1 : 0; tile_e4[t] = (unsigned char)e; }
    __syncthreads();
}
__device__ __forceinline__ int moe_tiles(const Ctx& X, int l, int chunk, LAS unsigned char* tile_e, LAS int* off, LAS int* cntl) {
    moe_offsets(X, l, chunk, off, cntl);
    const int ntile = off[NE1] >> 8;
    for (int t = X.tid; t < ntile; t += 512) { int e = 0; for (int q = 1; q < NE1; ++q) e += (off[q] <= t * 256) ? 1 : 0; tile_e[t] = (unsigned char)e; }
    __syncthreads();
    return ntile;
}

__device__ __forceinline__ void ph_combine(const Ctx& X, int l, int c0, const LAS int* off4) {
    const int lane = X.lane; const int gw = X.c * 8 + X.wave; const int chunk = c0 + (gw >> 10);
    float* xo = X.a->out; bf16_t* hb = X.hbuf(); float* xw = (X.dbg & 8) ? (float*)(X.ws + WS_ACT) : xo;
    const unsigned char* op = (const unsigned char*)(X.ws + WS_OPAIR) + (size_t)(chunk - c0) * CH_ROWS * 1024; const unsigned* slot = (const unsigned*)(X.ws + WS_SLOT);
    const int b = (chunk * CHTOK) >> 13; const float* mv2 = X.modv(l, 1) + b * 3072;
    const float* lg = X.in(I_LN2G) + l * D; const float* lb = X.in(I_LN2B) + l * D;
    const int offsh = off4[chunk * 64 + NEXP];
#pragma unroll 1
    for (int i = 0; i < 8; i += 2) {
        const int tokA = c0 * CHTOK + gw * 8 + i;
        int pos[2][9];
#pragma unroll
        for (int t = 0; t < 2; ++t) {
            const u32x4 s0 = *(const u32x4*)(slot + (size_t)(tokA + t) * 8), s1 = *(const u32x4*)(slot + (size_t)(tokA + t) * 8 + 4);
            pos[t][0] = (int)s0.x; pos[t][1] = (int)s0.y; pos[t][2] = (int)s0.z; pos[t][3] = (int)s0.w; pos[t][4] = (int)s1.x; pos[t][5] = (int)s1.y; pos[t][6] = (int)s1.z; pos[t][7] = (int)s1.w;
            pos[t][8] = offsh + (tokA + t - chunk * CHTOK); }
        unsigned rw8[2][9][4];
#pragma unroll
        for (int t = 0; t < 2; ++t) {
#pragma unroll
            for (int k = 0; k < 9; ++k) { const unsigned ro = (unsigned)pos[t][k] * 1024u + 4u * (unsigned)lane;
#pragma unroll
                for (int j = 0; j < 4; ++j) rw8[t][k][j] = *(const unsigned*)(op + ro + 256 * j); } }
#pragma unroll
        for (int t = 0; t < 2; ++t) {
            const int tok = tokA + t;
            f32x4 sm[4];
#pragma unroll
            for (int j = 0; j < 4; ++j) sm[j] = (f32x4){0.f, 0.f, 0.f, 0.f};
#pragma unroll
            for (int k = 0; k < 9; ++k)
#pragma unroll
                for (int j = 0; j < 4; ++j) { const int q = (int)rw8[t][k][j]; const f32x2 lo = __builtin_amdgcn_cvt_pk_f32_fp8(q, false), hi = __builtin_amdgcn_cvt_pk_f32_fp8(q, true);
                    sm[j][0] += lo[0]; sm[j][1] += lo[1]; sm[j][2] += hi[0]; sm[j][3] += hi[1]; }
            f32x4 v[4]; float s = 0.f;
#pragma unroll
            for (int j = 0; j < 4; ++j) { const int col = 4 * lane + 256 * j; v[j] = *(const f32x4*)(xo + (size_t)tok * D + col) + (*(const f32x4*)(mv2 + 2048 + col) + 1.0f) * (sm[j] * (1.0f / O_SCALE)); s += (v[j][0] + v[j][1]) + (v[j][2] + v[j][3]); }
            const float mean = wave_sum(s) * (1.0f / D); float q = 0.f;
#pragma unroll
            for (int j = 0; j < 4; ++j) { v[j] = v[j] - mean; q += (v[j][0] * v[j][0] + v[j][1] * v[j][1]) + (v[j][2] * v[j][2] + v[j][3] * v[j][3]); }
            const float rstd = rsqrtf(wave_sum(q) * (1.0f / D) + LN_EPS);
#pragma unroll
            for (int j = 0; j < 4; ++j) { const int col = 4 * lane + 256 * j;
                const f32x4 x2 = v[j] * rstd * *(const f32x4*)(lg + col) + *(const f32x4*)(lb + col);
                *(f32x4*)(xw + (size_t)tok * D + col) = x2;
                if (l + 1 < DEPTH) { const float* mv1 = X.modv(l + 1, 0) + b * 3072; const f32x4 hn = x2 * (*(const f32x4*)(mv1 + 1024 + col) + 1.0f) + *(const f32x4*)(mv1 + col);
                    u32x2 o; o.x = pk2(hn[0], hn[1]); o.y = pk2(hn[2], hn[3]); *(u32x2*)(hb + (size_t)tok * D + col) = o; } }
        }
    }
}

struct POrder : pg8::StaticOrder { __device__ __forceinline__ bool next(int i, pg8::Unit& u) const { if (!pg8::StaticOrder::next(i, u)) return false; u.ab = u.pn >> 2; return true; } };
struct GOrder { static constexpr bool GATHER = false; int G, c;
    __device__ __forceinline__ bool next(int i, pg8::Unit& u) const { const int tile = (i >> 2) * G + c; if (tile >= 512) return false; const int wg = pg8::xcd_remap(tile, 512); const int br = i & 3, mt = wg & 3;
        u.pm = wg >> 2; u.pn = br * 4 + mt; u.bt = br * 4 + mt; u.ab = 0; return true; }
    __device__ __forceinline__ void a_ready(const pg8::Unit&) const {} __device__ __forceinline__ void done(const pg8::Unit&) const {} };
__global__ void __launch_bounds__(512, 2) fwd_kernel(Args args) {
    extern __shared__ __attribute__((aligned(16))) unsigned char lds_raw[];
    ArgsP ap = (ArgsP)__builtin_amdgcn_kernarg_segment_ptr();
    Ctx X; X.a = ap; X.ws = ap->ws; X.lds = (LAS unsigned char*)lds_raw;
    X.tid = threadIdx.x; X.lane = X.tid & 63; X.wave = __builtin_amdgcn_readfirstlane(X.tid >> 6); X.G = gridDim.x;
    { const int bx = blockIdx.x; X.bx = bx; X.c = (X.G % 8 == 0) ? (bx % 8) * (X.G / 8) + bx / 8 : bx; }
    const int c0_ = X.c, g0_ = X.G, bx0_ = X.bx, wave0_ = X.wave;
    volatile LAS unsigned* misc = (volatile LAS unsigned*)(X.lds + LDS_MISC);
    if (X.tid < 16) misc[X.tid] = 0u;
    __syncthreads();
    XcdBarrier bar; bar.bar = (unsigned*)(X.ws + WS_CTL) + CW_BAR; bar.x = 0; bar.st = misc;
#if !MK_PER_PHASE
    bar = xcd_barrier_post((unsigned*)(X.ws + WS_CTL) + CW_BAR, misc);
#endif
    const int lo = ap->ph_lo, hi = ap->ph_hi; int ph = 0;
#define RELAUNDER() do { int wv_ = wave0_; asm volatile("" : "+s"(wv_)); int t_ = wv_ * 64 + (int)__builtin_amdgcn_mbcnt_hi(~0u, __builtin_amdgcn_mbcnt_lo(~0u, 0u)); asm volatile("" : "+v"(t_)); X.tid = t_; X.lane = t_ & 63; X.wave = wv_; } while (0)
#define REPEAT(N, stmt) _Pragma("nounroll") for (int rp_ = 0; rp_ < (N); ++rp_) { stmt; if (rp_ + 1 < (N)) xcd_barrier(bar); }
#define PH_BEGIN if (ph >= lo && ph < hi) { { ArgsP apl = ap; asm volatile("" : "+s"(apl)); X.a = apl; X.ws = apl->ws; X.dbg = apl->dbg; int wv_ = wave0_; asm volatile("" : "+s"(wv_)); int t_ = wv_ * 64 + (int)__builtin_amdgcn_mbcnt_hi(~0u, __builtin_amdgcn_mbcnt_lo(~0u, 0u)); asm volatile("" : "+v"(t_)); X.tid = t_; X.lane = t_ & 63; X.wave = wv_; int c_ = c0_, g_ = g0_, b_ = bx0_; asm volatile("" : "+s"(c_), "+s"(g_), "+s"(b_)); X.c = c_; X.G = g_; X.bx = b_; } unsigned char* wb = X.ws + WS_W; LAS unsigned char* gl = X.lds; const float* xin = (l_ == 0) ? X.in(I_X) : (const float*)X.a->out; (void)wb; (void)gl; (void)xin;
#if MK_PER_PHASE
#define PH_END } ++ph;
#else
#define PH_END if (ph + 1 < hi) xcd_barrier(bar); } ++ph;
#endif
    int l_ = 0;
    PH_BEGIN if (EN_PROLOGUE) { REPEAT(R_MISC, ph_prologue(X)) } PH_END
    for (int l = 0; l < DEPTH; ++l) {
        l_ = l;
        PH_BEGIN if (EN_WCONV) { REPEAT(R_MISC, ph_wconv(X, l)) } PH_END
        PH_BEGIN if (EN_GWIN)  { pg8::Gemm g{X.hbuf(), (const bf16_t*)(wb + WO_IN), 1024, 0}; pg8::StaticOrder S; S.init(M, PJ, X.G, X.bx); pg8::EpiBf16 E{X.proj(), PJ};
            REPEAT(R_GWIN, (pg8::gemm_phase<pg8::EpiBf16, pg8::StaticOrder, G_ALIGN, G_SP2>(gl, g, S, E, X.tid))) } PH_END
        PH_BEGIN if (EN_MX1)  {
            if (!(X.dbg & 1)) mx_rope(X);
            _Pragma("nounroll") for (int rp_ = 0; rp_ < R_MIX; ++rp_) {
            if (!(X.dbg & 2)) for (int u = X.c; u < 256; u += X.G) mx_gmlp(X, l, u);
            if (!(X.dbg & 4)) for (int wu = X.c * 8 + X.wave; wu < 2048; wu += X.G * 8) mx_s5<1>(X, l, wu);
            __syncthreads();
            if (!(X.dbg & 8)) for (int u = X.c; u < 256; u += X.G) mx_ssd<1>(X, l, u); }
        } PH_END
        PH_BEGIN if (EN_MX2)  {
            if (!(X.dbg & 32)) { mx_ssd_carry(X); mx_s5_carry(X); } RELAUNDER();
            _Pragma("nounroll") for (int rp_ = 0; rp_ < R_DSA; ++rp_)
            for (int r = 0; r < 16; ++r) { const int cl = X.c & 63; const int uu = (r & 1) ? r * 64 + 63 - cl : r * 64 + cl; if (EN_DSA && !(X.dbg & 64) && X.c < 256) mx_dsa(X, X.c >> 6, uu * 8); }
            __syncthreads(); RELAUNDER();
            for (int wu = X.c * 8 + X.wave; EN_S53 && !(X.dbg & 16) && wu < 2048; wu += X.G * 8) mx_s5<3>(X, l, wu);
        } PH_END
        PH_BEGIN if (EN_GLU)  { for (int u = X.c; EN_SSD3 && u < 256; u += X.G) mx_ssd<3>(X, l, u);
            __syncthreads(); RELAUNDER();
            pg8::Gemm g{(const bf16_t*)(X.ws + WS_YCPRE), (const bf16_t*)(wb + WO_GLU), 256, 0}; pg8::StaticOrder S; S.init(M, 256, X.G, X.bx);
            pg8::EpiGlu E{(const bf16_t*)(X.ws + WS_YCPRE), X.ybuf() + (size_t)2 * M * 256, X.in(I_S5GLUB) + l * 256};
            REPEAT(R_GLU, (pg8::gemm_phase<pg8::EpiGlu, pg8::StaticOrder, G_ALIGN, G_SP2>(gl, g, S, E, X.tid))) } PH_END
        PH_BEGIN if (EN_GP)  { pg8::Gemm g{X.ybuf(), (const bf16_t*)(wb + WO_BR), 256, (size_t)M * 256};
            POrder S;
            S.init(M, 4096, X.G, X.bx); pg8::EpiFp8 E{(unsigned char*)(X.ws + WS_P), 4096, P_SCALE};
            REPEAT(R_GP, (pg8::gemm_phase<pg8::EpiFp8, POrder, false, G_SP2>(gl, g, S, E, X.tid))) } PH_END
        PH_BEGIN if (EN_GGATE)  { pg8::Gemm g{X.hbuf(), (const bf16_t*)(wb + WO_GATE), 1024, 0};
            pg8::StaticOrder S; S.init(M, 4096, X.G, X.bx);
            pg8::EpiGateMerge4 E{(const unsigned char*)(X.ws + WS_P), X.ybuf(), 1.0f / P_SCALE};
            REPEAT(R_GGATE, (pg8::gemm_phase<pg8::EpiGateMerge4, pg8::StaticOrder, G_ALIGN, G_SP2>(gl, g, S, E, X.tid))) } PH_END
        PH_BEGIN if (EN_GOUT)  { pg8::Gemm g{X.ybuf(), (const bf16_t*)(wb + WO_OUT), 1024, 0}; pg8::StaticOrder S; S.init(M, 1024, X.G, X.bx);
            pg8::EpiResid E{xin, (bf16_t*)(X.ws + WS_V16), X.modv(l, 0)};
            pg8::gemm_phase<pg8::EpiResid, pg8::StaticOrder, G_ALIGN, G_SP2>(gl, g, S, E, X.tid); } PH_END
        PH_BEGIN if (EN_LN1)  ph_ln1_router(X, l); PH_END
        PH_BEGIN if (EN_FILL) { REPEAT(R_MISC, ph_fill(X, l)) } PH_END
        PH_BEGIN if (EN_MOE1)  {
            LAS int* off4 = (LAS int*)(X.lds + LDS_TAB + 1024); LAS unsigned char* tile_e4 = (LAS unsigned char*)(X.lds + LDS_TAB + 2048); LAS int* tprefix = (LAS int*)(X.lds + LDS_TAB + 3584);
            moe_tables_all(X, l, off4, tile_e4, tprefix);
            pg8::Gemm g{X.hbuf(), (const bf16_t*)(wb + WO_13), 1024, 0};
            LAS int* rowtab = (LAS int*)(X.lds + LDS_TAB + 4096);
            MoeOrderAll<2, true> S{tprefix[NCH] * 2, X.G, X.bx, tile_e4, tprefix, rowtab, 0};
            { const unsigned* rowtok = (const unsigned*)(X.ws + WS_ROWTOK); pg8::Unit uu;
              const float* rowgate = (const float*)(X.ws + WS_ROWGATE); LAS float* gtabw = (LAS float*)(X.lds + LDS_TAB + 4096 + 12288);
              _Pragma("nounroll") for (int i = 0; i < 12; ++i) { if (!S.next(i, uu)) break; const int pmu = __builtin_amdgcn_readfirstlane(uu.pm);
                  if (X.tid < 256) { rowtab[i * 256 + X.tid] = (int)rowtok[(size_t)pmu * 256 + X.tid]; gtabw[i * 256 + X.tid] = rowgate[(size_t)pmu * 256 + X.tid]; } } }
            __syncthreads();
            pg8::EpiMoe1 E{(bf16_t*)(X.ws + WS_ACT), (const LAS float*)(X.lds + LDS_TAB + 4096 + 12288)};
            REPEAT(R_MOE, (pg8::gemm_phase<pg8::EpiMoe1, MoeOrderAll<2, true>, G_ALIGN, G_SP2>(gl, g, S, E, X.tid)))
        } PH_END
        for (int c0 = 0; c0 < NCH; c0 += 2) {
            PH_BEGIN if (EN_MOE2)  {
                LAS int* off4 = (LAS int*)(X.lds + LDS_TAB + 1024); LAS unsigned char* tile_e4 = (LAS unsigned char*)(X.lds + LDS_TAB + 2048); LAS int* tprefix = (LAS int*)(X.lds + LDS_TAB + 3584);
                moe_tables_all(X, l, off4, tile_e4, tprefix);
                pg8::Gemm g{(const bf16_t*)(X.ws + WS_ACT), (const bf16_t*)(wb + WO_2), 256, 0};
                MoeOrderAll<4, false> S{(tprefix[c0 + 2] - tprefix[c0]) * 4, X.G, X.bx, tile_e4, tprefix, nullptr, tprefix[c0]};
                pg8::EpiFp8 E{(unsigned char*)(X.ws + WS_OPAIR) - (size_t)c0 * CH_ROWS * 1024, 1024, O_SCALE};
                REPEAT(R_MOE, (pg8::gemm_phase<pg8::EpiFp8, MoeOrderAll<4, false>, false, G_SP2>(gl, g, S, E, X.tid)))
            } PH_END
            PH_BEGIN if (EN_FIN)  { LAS int* off4 = (LAS int*)(X.lds + LDS_TAB + 1024); LAS unsigned char* tile_e4 = (LAS unsigned char*)(X.lds + LDS_TAB + 2048); LAS int* tprefix = (LAS int*)(X.lds + LDS_TAB + 3584);
                moe_tables_all(X, l, off4, tile_e4, tprefix); ph_combine(X, l, c0, off4); } PH_END
        }
    }
#undef PH_BEGIN
#undef PH_END
}
constexpr int N_PHASES = 1 + DEPTH * (10 + 1 + NCH);

#ifdef DBG_DUMP_OFF
__global__ void dbg_dump(const bf16_t* src, float* out, size_t n) { for (size_t i = (size_t)blockIdx.x * blockDim.x + threadIdx.x; i < n; i += (size_t)gridDim.x * blockDim.x) {
#ifdef DBG_HASH_OUT
    const unsigned bits = __builtin_bit_cast(unsigned, out[i]); out[i] = (float)((bits * 2654435761u) >> 8) * (1.0f / 16777216.0f);
#else
    const unsigned bits = src[i]; out[i] = (float)(((bits + 1u) * 2654435761u) >> 8) * (1.0f / 16777216.0f);
#endif
} }
#endif
extern "C" void kernel_launch(void* const* d_in, const int* in_sizes, int n_in, void* d_out, int out_size, void* d_ws, size_t ws_size, hipStream_t stream) {
    static int grid = 0;
    if (grid == 0) {
        if (n_in != 43 || out_size != M * D || ws_size < WS_NEED) { fprintf(stderr, "kernel_launch: unexpected shapes (n_in %d out %d ws %zu)\n", n_in, out_size, ws_size); grid = -1; return; }
        int dev = 0, cus = 0, per_cu = 0;
        if (hipGetDevice(&dev) != hipSuccess || hipDeviceGetAttribute(&cus, hipDeviceAttributeMultiprocessorCount, dev) != hipSuccess) { grid = -1; return; }
        if (hipFuncSetAttribute((const void*)fwd_kernel, hipFuncAttributeMaxDynamicSharedMemorySize, LDS_BYTES) != hipSuccess) { fprintf(stderr, "kernel_launch: hipFuncSetAttribute failed\n"); grid = -1; return; }
        if (hipOccupancyMaxActiveBlocksPerMultiprocessor(&per_cu, (const void*)fwd_kernel, 512, LDS_BYTES) != hipSuccess || per_cu < 1) fprintf(stderr, "kernel_launch: occupancy query says %d\n", per_cu);
        (void)hipGetLastError();
        grid = cus < 256 ? cus : 256;
    }
    if (grid < 0) return;
    (void)hipMemsetAsync((char*)d_ws + WS_CTL, 0, CTL_BYTES, stream);
#ifdef DBG_POISON
    (void)hipMemsetAsync((char*)d_ws + CTL_BYTES, 0xFF, WS_NEED - CTL_BYTES, stream);
    (void)hipMemsetAsync((char*)d_out, 0xFF, (size_t)M * D * 4, stream);
#endif
    Args a{};
    for (int i = 0; i < 43; ++i) a.in[i] = (const float*)d_in[i];
    a.positions = (const int*)d_in[I_POS]; a.out = (float*)d_out; a.ws = (unsigned char*)d_ws;
#if MK_PER_PHASE
#ifndef DBG_NPH
#define DBG_NPH N_PHASES
#endif
    for (int p = 0; p < DBG_NPH; ++p) { a.ph_lo = p; a.ph_hi = p + 1; hipLaunchKernelGGL(fwd_kernel, dim3(grid), dim3(512), LDS_BYTES, stream, a); }
#ifdef DBG_DUMP_OFF
    hipLaunchKernelGGL(dbg_dump, dim3(2048), dim3(256), 0, stream, (const bf16_t*)((const char*)d_ws + (size_t)(DBG_DUMP_OFF)), (float*)d_out, (size_t)M * D);
#endif
#else
    a.ph_lo = 0; a.ph_hi = N_PHASES; hipLaunchKernelGGL(fwd_kernel, dim3(grid), dim3(512), LDS_BYTES, stream, a);
#ifdef DBG_EXTRA_PH
    a.dbg = DBG_EXTRA_FLAGS;
    for (int rep = 0; rep < DBG_EXTRA_REP; ++rep) { a.ph_lo = DBG_EXTRA_PH; a.ph_hi = DBG_EXTRA_PH + 1; hipLaunchKernelGGL(fwd_kernel, dim3(grid), dim3(512), LDS_BYTES, stream, a); }
#endif
#endif
}
```

```cpp
#include <hip/hip_runtime.h>
#include <cstdio>
#include <cstdint>


#ifndef DSA_SKIP
#define DSA_SKIP 0
#endif
#ifndef DSA_PM
#define DSA_PM 0
#endif
#ifndef R_S1
#define R_S1 1
#endif
#ifndef R_S2
#define R_S2 1
#endif
#ifndef R_S3
#define R_S3 1
#endif
#ifndef EN_DSA
#define EN_DSA 1
#endif
#ifndef EN_S53
#define EN_S53 1
#endif
#ifndef EN_SSD3
#define EN_SSD3 1
#endif
#ifndef R_GWIN
#define R_GWIN 1
#endif
#ifndef R_GLU
#define R_GLU 1
#endif
#ifndef R_GP
#define R_GP 1
#endif
#ifndef MOE_PAIR
#define MOE_PAIR 1
#endif
#ifndef PW_GP
#define PW_GP 1
#endif
#ifndef PW_GGATE
#define PW_GGATE 1
#endif
#ifndef PW_GOUT
#define PW_GOUT 1
#endif
#ifndef MOE_PAIR4
#define MOE_PAIR4 2
#endif
#ifndef MOE_PAIR2
#define MOE_PAIR2 1
#endif
#ifndef R_GGATE
#define R_GGATE 1
#endif
#ifndef R_DENSE
#define R_DENSE 1
#endif
#ifndef R_MOE
#define R_MOE 1
#endif
#ifndef R_DSA
#define R_DSA 1
#endif
#ifndef R_MIX
#define R_MIX 1
#endif
#ifndef R_MISC
#define R_MISC 1
#endif
#ifndef MK_PER_PHASE
#define MK_PER_PHASE 0
#endif

#ifndef EN_PROLOGUE
#define EN_PROLOGUE 1
#endif
#ifndef EN_WCONV
#define EN_WCONV 1
#endif
#ifndef EN_GWIN
#define EN_GWIN 1
#endif
#ifndef EN_MX1
#define EN_MX1 1
#endif
#ifndef EN_MX2
#define EN_MX2 1
#endif
#ifndef EN_GLU
#define EN_GLU 1
#endif
#ifndef EN_GP
#define EN_GP 1
#endif
#ifndef EN_GGATE
#define EN_GGATE 1
#endif
#ifndef EN_GOUT
#define EN_GOUT 1
#endif
#ifndef EN_LN1
#define EN_LN1 1
#endif
#ifndef EN_FILL
#define EN_FILL 1
#endif
#ifndef EN_MOE1
#define EN_MOE1 1
#endif
#ifndef EN_MOE2
#define EN_MOE2 1
#endif
#ifndef EN_FIN
#define EN_FIN 1
#endif
#ifndef G_ALIGN
#define G_ALIGN true
#endif
#ifndef G_SP2
#define G_SP2 true
#endif
#define LAS __attribute__((address_space(3)))
#define GAS __attribute__((address_space(1)))
typedef unsigned short bf16_t;
typedef short bf16x8 __attribute__((ext_vector_type(8)));
typedef float f32x4 __attribute__((ext_vector_type(4)));
typedef float f32x2 __attribute__((ext_vector_type(2)));
typedef unsigned u32x4 __attribute__((ext_vector_type(4)));
typedef unsigned u32x2 __attribute__((ext_vector_type(2)));

constexpr int NB = 4, SEQ = 8192, M = NB * SEQ, D = 1024, DEPTH = 2;
constexpr int PJ = 2304;
constexpr int C_GU = 0, C_GV = 256, C_Q = 512, C_K = 768, C_V = 832, C_QI = 896, C_KI = 1152, C_S5 = 1216, C_Z = 1472, C_XBC = 1728, C_WI = 2240, C_DT = 2244;
constexpr int D_IN = 2248;
constexpr int NEXP = 32, NE1 = 33;
constexpr int NCH = 4, CHTOK = M / NCH;
constexpr int CH_ROWS = CHTOK * 8 + CHTOK + NE1 * 256;
constexpr float DN_ALPHA = 1.41421356237f;
constexpr float LN_EPS = 1e-5f, RMS_EPS = 1e-6f;
#ifndef PFP8
#define PFP8 1
#endif
constexpr float P_SCALE = 8.0f, O_SCALE = 32.0f;

constexpr size_t MiB = 1u << 20;
constexpr size_t WS_CTL = 0, CTL_BYTES = 1 * MiB;
constexpr size_t WS_MODV = 1 * MiB;
constexpr size_t WS_S5B = WS_MODV + 256 * 1024;
constexpr size_t WS_S5C = WS_S5B + 64 * 1024;
constexpr size_t WS_S5A = WS_S5C + 64 * 1024;
constexpr size_t WS_GMW = WS_S5A + 64 * 1024;
constexpr size_t WS_RFR = WS_GMW + 128 * 1024;
static_assert(WS_RFR + 128 * 1024 <= 2 * MiB, "misc tables");
constexpr size_t WS_S5ST = 2 * MiB;
constexpr size_t WS_ATOT = 3 * MiB;
constexpr size_t WS_WGBASE = 3 * MiB + 64 * 1024;
constexpr size_t WS_PINFO = 4 * MiB;
constexpr size_t WS_PGATE = 5 * MiB;
constexpr size_t WS_SLOT = 6 * MiB;
constexpr size_t WS_ROWTOK = 7 * MiB;
constexpr size_t WS_ROWGATE = 9 * MiB;
constexpr size_t WS_S5HIN = 11 * MiB;
constexpr size_t WS_ROPE = 12 * MiB;
constexpr size_t WS_W = 24 * MiB;
constexpr size_t WO_IN = 0, WO_GATE = WO_IN + (size_t)PJ * 1024 * 2, WO_BR = WO_GATE + (size_t)4096 * 1024 * 2, WO_OUT = WO_BR + (size_t)4 * 1024 * 256 * 2,
                 WO_GLU = WO_OUT + (size_t)1024 * 1024 * 2, WO_13 = WO_GLU + (size_t)256 * 256 * 2, WO_2 = WO_13 + (size_t)NE1 * 512 * 1024 * 2, WO_END = WO_2 + (size_t)NE1 * 1024 * 256 * 2;
static_assert(WO_END <= 72 * MiB, "weights region");
constexpr size_t WS_H = 96 * MiB;
constexpr size_t WS_Y = 160 * MiB;
constexpr size_t WS_PROJ = 224 * MiB;
constexpr size_t WS_P = 224 * MiB;
constexpr size_t WS_SSDST = 368 * MiB;
constexpr size_t WS_SSDSIN = 400 * MiB;
constexpr size_t WS_KI2 = 408 * MiB, WS_K2 = 412 * MiB, WS_V2 = 416 * MiB;
constexpr size_t WS_YCPRE = 384 * MiB;
constexpr size_t WS_V16 = 224 * MiB;
constexpr size_t WS_ACT = 160 * MiB;
constexpr size_t WS_OPAIR = 321 * MiB;
static_assert(CH_ROWS % 256 == 0 && WS_ACT + (size_t)NCH * CH_ROWS * 512 <= WS_OPAIR && WS_OPAIR + (size_t)2 * CH_ROWS * 1024 <= 512 * MiB, "moe buffers");
constexpr int CH_TILES = CH_ROWS / 256;
constexpr size_t WS_NEED = 512 * MiB;
constexpr int CW_BAR = 4096;
constexpr int CW_CNT = 16384;

constexpr int LDS_BYTES = 160 * 1024;
constexpr int LDS_TAB = 131072;
constexpr int LDS_MISC = LDS_BYTES - 256;

__device__ __forceinline__ unsigned f2bf(float f) { unsigned u = __builtin_bit_cast(unsigned, f); return (u + 0x7fffu + ((u >> 16) & 1u)) >> 16; }
__device__ __forceinline__ unsigned pk2(float lo, float hi) { return f2bf(lo) | (f2bf(hi) << 16); }
__device__ __forceinline__ float bf2f(unsigned short b) { return __builtin_bit_cast(float, (unsigned)b << 16); }
__device__ __forceinline__ float bflo(unsigned w) { return __builtin_bit_cast(float, w << 16); }
__device__ __forceinline__ float bfhi(unsigned w) { return __builtin_bit_cast(float, w & 0xffff0000u); }
__device__ __forceinline__ float wave_sum(float v) {
#pragma unroll
    for (int o = 1; o < 64; o <<= 1) v += __shfl_xor(v, o);
    return v;
}
__device__ __forceinline__ float wave_max(float v) {
#pragma unroll
    for (int o = 1; o < 64; o <<= 1) v = fmaxf(v, __shfl_xor(v, o));
    return v;
}
__device__ __forceinline__ int wave_sum_i(int v) {
#pragma unroll
    for (int o = 1; o < 64; o <<= 1) v += __shfl_xor(v, o);
    return v;
}
__device__ __forceinline__ float sigmoidf_(float x) { return __builtin_amdgcn_rcpf(1.0f + __expf(-x)); }
__device__ __forceinline__ float siluf_(float x) { return x * __builtin_amdgcn_rcpf(1.0f + __expf(-x)); }
__device__ __forceinline__ float gelu_tanh(float x) { const float u = 1.5957691216057308f * (x + 0.044715f * x * x * x); return x * __builtin_amdgcn_rcpf(1.0f + __expf(-u)); }
__device__ __forceinline__ float softplusf_(float x) { return fmaxf(x, 0.f) + log1pf(__expf(-fabsf(x))); }
__device__ __forceinline__ void sincos_red(float ang, float& sn, float& cs) {
    const double a = (double)ang; const double q = __builtin_rint(a * 0.63661977236758134308);
    const float r = (float)(a - q * 1.57079632679489661923); const int qi = (int)q & 3;
    const float r2 = r * r;
    const float s = r * (1.0f + r2 * (-1.6666667e-1f + r2 * (8.3333333e-3f + r2 * (-1.9841270e-4f + r2 * 2.7557319e-6f))));
    const float c = 1.0f + r2 * (-0.5f + r2 * (4.1666667e-2f + r2 * (-1.3888889e-3f + r2 * (2.4801587e-5f + r2 * -2.7557319e-7f))));
    sn = (qi == 0) ? s : (qi == 1) ? c : (qi == 2) ? -s : -c;
    cs = (qi == 0) ? c : (qi == 1) ? -s : (qi == 2) ? -c : s;
}
__device__ __forceinline__ f32x4 mfma16(bf16x8 a, bf16x8 b, f32x4 c) { return __builtin_amdgcn_mfma_f32_16x16x32_bf16(a, b, c, 0, 0, 0); }
__device__ __forceinline__ unsigned cvt_pk_bf16(float lo, float hi) { unsigned r; asm volatile("v_cvt_pk_bf16_f32 %0, %1, %2" : "=v"(r) : "v"(lo), "v"(hi)); return r; }

namespace pg8 {
constexpr int BM = 256, BK = 64, HALF = 128, HTB = HALF * BK * 2, STAGE_BYTES = 8 * HTB, NXCD = 8, WGM = 8;
__host__ __device__ __forceinline__ int lds_byte(int r, int c) { const int st = (r >> 4) * 2 + (c >> 5), rr = r & 15, cc = c & 31, ob = rr * 64 + cc * 2; return st * 1024 + (ob ^ (((ob >> 9) & 1) << 5)); }
__host__ __device__ __forceinline__ void stage_rc(int b, int& R, int& C) { const int st = b / 1024, sb = b % 1024, swz = sb ^ (((sb >> 9) & 1) << 5); R = (st >> 1) * 16 + swz / 64; C = (st & 1) * 32 + (swz % 64) / 2; }
__host__ __device__ __forceinline__ int perm32(int rho) { const int n = rho >> 4, i = rho & 15; return 8 * (i >> 2) + 4 * n + (i & 3); }

struct Unit { int pm, pn, bt, ab; };
struct Gemm { const bf16_t* A; const bf16_t* Bt; int K; size_t a_sel_stride; };

__device__ __forceinline__ int xcd_remap(int wgid, int nwg) { const int q = nwg / NXCD, r = nwg % NXCD, xcd = wgid % NXCD, off = wgid / NXCD; return (xcd < r ? xcd * (q + 1) : r * (q + 1) + (xcd - r) * q) + off; }

struct StaticOrder {
    static constexpr bool GATHER = false;
    int nM, nN, nwg, G, c;
    __device__ void init(int Mr, int N, int G_, int c_) { nM = Mr / BM; nN = N / BM; nwg = nM * nN; G = G_; c = c_; }
    __device__ __forceinline__ bool next(int i, Unit& u) const {
        const long L = (long)i * G + c; if (L >= nwg) return false;
        const int wgid = xcd_remap((int)L, nwg);
        const int nig = WGM * nN, gid = wgid / nig, fm = gid * WGM, gsz = (nM - fm) < WGM ? (nM - fm) : WGM;
        u.pm = fm + ((wgid % nig) % gsz); u.pn = (wgid % nig) / gsz; u.bt = u.pn; u.ab = 0; return true;
    }
    __device__ __forceinline__ void a_ready(const Unit&) const {}
    __device__ __forceinline__ void done(const Unit&) const {}
};

template <class Epi, class Sched, bool ALIGN_EPI = false, bool SP2 = true>
__device__ __forceinline__ void gemm_phase(LAS unsigned char* lds, const Gemm g, const Sched& S, const Epi& E, const int tid) {
    const int wid = __builtin_amdgcn_readfirstlane(tid >> 6), lane = tid & 63, wr = wid >> 2, wc = wid & 3, fr = lane & 15, fq = lane >> 4;
    const int K = g.K, nt = K / BK;
    unsigned voffA[2], voffB[2];
#pragma unroll
    for (int i = 0; i < 2; ++i) { int R, C; stage_rc(tid * 16 + i * 8192, R, C); const int Rb = Epi::PERM ? ((R & ~31) + perm32(R & 31)) : R;
        voffA[i] = (unsigned)(R * K + C) * 2u; voffB[i] = (unsigned)(Rb * K + C) * 2u; }
    const size_t kstep = (size_t)(BK * 2);
    const size_t hstep = (size_t)HALF * K * 2;
    const size_t tstep = 2 * hstep;
    const unsigned ldsw = (unsigned)wid * 1024u;
    const int aoff = lds_byte(wr * 64 + fr, fq * 8), boff = lds_byte(wc * 32 + fr, fq * 8);
#define PG8_SA(b, h) (((b) * 2 + (h)) * HTB)
#define PG8_SB(b, h) ((4 + (b) * 2 + (h)) * HTB)
#define PG8_STAGE(bufoff, gbase, voff) do { _Pragma("unroll") for (int _i = 0; _i < 2; ++_i) \
        __builtin_amdgcn_global_load_lds((const unsigned*)((const char*)(gbase) + (voff)[_i]), (LAS unsigned*)(lds + (bufoff) + ldsw + _i * 8192), 16, 0, 0); } while (0)
#define PG8_GO(u) do { _Pragma("unroll") for (int _h = 0; _h < 2; ++_h) _Pragma("unroll") for (int _i = 0; _i < 2; ++_i) { int _R, _C; stage_rc(tid * 16 + _i * 8192, _R, _C); \
        cgo[_h][_i] = (unsigned)S.row_of(u, _h * HALF + _R) * (unsigned)(K * 2) + (unsigned)_C * 2u; } } while (0)
#define PG8_STAGE_A(bufoff, base, h, kb, NX) do { if constexpr (Sched::GATHER) { _Pragma("unroll") for (int _i = 0; _i < 2; ++_i) \
        __builtin_amdgcn_global_load_lds((const unsigned*)((const char*)g.A + (kb) + cgo[h][_i]), (LAS unsigned*)(lds + (bufoff) + ldsw + _i * 8192), 16, 0, 0); } \
        else { PG8_STAGE(bufoff, (base) + (size_t)(h) * hstep + (kb), voffA); } } while (0)
#define PG8_LDA(dst, b, h) do { _Pragma("unroll") for (int m = 0; m < 4; ++m) _Pragma("unroll") for (int k = 0; k < 2; ++k) dst[m][k] = *(const LAS bf16x8*)(lds + PG8_SA(b, h) + aoff + m * 2048 + k * 1024); } while (0)
#define PG8_LDB(dst, b, h) do { _Pragma("unroll") for (int n = 0; n < 2; ++n) _Pragma("unroll") for (int k = 0; k < 2; ++k) dst[n][k] = *(const LAS bf16x8*)(lds + PG8_SB(b, h) + boff + n * 2048 + k * 1024); } while (0)
#define PG8_MMA(ai, bj, At, Bt) do { __builtin_amdgcn_s_setprio(1); _Pragma("unroll") for (int m = 0; m < 4; ++m) _Pragma("unroll") for (int n = 0; n < 2; ++n) _Pragma("unroll") for (int k = 0; k < 2; ++k) \
        acc[ai][bj][m][n] = __builtin_amdgcn_mfma_f32_16x16x32_bf16(Bt[n][k], At[m][k], acc[ai][bj][m][n], 0, 0, 0); __builtin_amdgcn_s_setprio(0); } while (0)
#define PG8_WAIT_V(n) asm volatile("s_waitcnt vmcnt(" #n ")" ::: "memory")
#define PG8_WAIT_L(n) asm volatile("s_waitcnt lgkmcnt(" #n ")" ::: "memory")
#define PG8_BAR __builtin_amdgcn_s_barrier()
#define PG8_SCHED __builtin_amdgcn_sched_barrier(0)
    Unit cur, nxt; int ui = 0;
    if (!S.next(0, cur)) return;
    f32x4 acc[2][2][4][2];
#pragma unroll
    for (int a = 0; a < 2; ++a)
#pragma unroll
        for (int b = 0; b < 2; ++b)
#pragma unroll
            for (int m = 0; m < 4; ++m)
#pragma unroll
                for (int n = 0; n < 2; ++n) acc[a][b][m][n] = (f32x4){0.f, 0.f, 0.f, 0.f};
    bf16x8 At[4][2], B0[2][2], B1[2][2];
    unsigned cgo[2][2];
    if constexpr (Sched::GATHER) PG8_GO(cur);
    const char* cA = (const char*)(g.A + (size_t)cur.ab * g.a_sel_stride) + (size_t)cur.pm * tstep; const char* cB = (const char*)g.Bt + (size_t)cur.bt * tstep;
    S.a_ready(cur);
    if constexpr (SP2) {
        PG8_STAGE(PG8_SB(0, 0), cB, voffB); PG8_STAGE(PG8_SB(0, 1), cB + hstep, voffB); PG8_STAGE_A(PG8_SA(0, 0), cA, 0, (size_t)0, false); PG8_STAGE_A(PG8_SA(0, 1), cA, 1, (size_t)0, false);
        if (wr == 1) PG8_BAR;
        PG8_WAIT_V(2); PG8_BAR;
        PG8_STAGE(PG8_SB(1, 0), cB + kstep, voffB); PG8_STAGE_A(PG8_SA(1, 0), cA, 0, kstep, false); PG8_STAGE(PG8_SB(1, 1), cB + hstep + kstep, voffB);
        PG8_WAIT_V(6); PG8_BAR;
    } else {
        PG8_STAGE(PG8_SB(0, 0), cB, voffB); PG8_STAGE_A(PG8_SA(0, 0), cA, 0, (size_t)0, false); PG8_STAGE(PG8_SB(0, 1), cB + hstep, voffB); PG8_STAGE_A(PG8_SA(0, 1), cA, 1, (size_t)0, false);
        if (wr == 1) PG8_BAR;
        PG8_WAIT_V(4); PG8_BAR;
        PG8_STAGE(PG8_SB(1, 0), cB + kstep, voffB); PG8_STAGE_A(PG8_SA(1, 0), cA, 0, kstep, false); PG8_STAGE(PG8_SB(1, 1), cB + hstep + kstep, voffB);
        PG8_WAIT_V(6); PG8_BAR;
    }
    for (;;) {
        const bool has_next = S.next(ui + 1, nxt);
        const char* nA = has_next ? (const char*)(g.A + (size_t)nxt.ab * g.a_sel_stride) + (size_t)nxt.pm * tstep : cA; const char* nB = has_next ? (const char*)g.Bt + (size_t)nxt.bt * tstep : cB;
#pragma nounroll
        for (int t = 0; t < nt; t += 2) {
            const bool last = (t == nt - 2);
            const size_t k1 = (size_t)(t + 1) * kstep;
            const char* a2b = last ? nA : cA; const size_t k2 = last ? (size_t)0 : (size_t)(t + 2) * kstep; const size_t k3 = k2 + kstep;
            const char* b2 = last ? nB : cB + (size_t)(t + 2) * kstep; const char* b3 = b2 + kstep;
            if (last && has_next) S.a_ready(nxt);
            if constexpr (SP2) {
            PG8_LDB(B0, 0, 0); PG8_LDB(B1, 0, 1); PG8_SCHED; PG8_LDA(At, 0, 0); PG8_STAGE_A(PG8_SA(1, 1), cA, 1, k1, false);
            if constexpr (Sched::GATHER) { if (last && has_next) PG8_GO(nxt); }
            PG8_WAIT_V(8); PG8_WAIT_L(0); PG8_BAR; PG8_MMA(0, 0, At, B0); PG8_MMA(0, 1, At, B1); PG8_BAR; PG8_SCHED;
            PG8_LDA(At, 0, 1); PG8_STAGE(PG8_SB(0, 0), b2, voffB); PG8_STAGE(PG8_SB(0, 1), b2 + hstep, voffB); PG8_STAGE_A(PG8_SA(0, 0), a2b, 0, k2, last);
            PG8_WAIT_V(8); PG8_WAIT_L(0); PG8_BAR; PG8_MMA(1, 0, At, B0); PG8_MMA(1, 1, At, B1); PG8_BAR; PG8_SCHED;
            PG8_LDB(B0, 1, 0); PG8_LDB(B1, 1, 1); PG8_SCHED; PG8_LDA(At, 1, 0); PG8_STAGE_A(PG8_SA(0, 1), a2b, 1, k2, last);
            PG8_WAIT_V(8); PG8_WAIT_L(0); PG8_BAR; PG8_MMA(0, 0, At, B0); PG8_MMA(0, 1, At, B1); PG8_BAR; PG8_SCHED;
            PG8_LDA(At, 1, 1); PG8_STAGE(PG8_SB(1, 0), b3, voffB); PG8_STAGE(PG8_SB(1, 1), b3 + hstep, voffB); PG8_STAGE_A(PG8_SA(1, 0), a2b, 0, k3, last);
            PG8_WAIT_V(8); PG8_WAIT_L(0); PG8_BAR; PG8_MMA(1, 0, At, B0); PG8_MMA(1, 1, At, B1); PG8_BAR; PG8_SCHED;
            } else {
            PG8_LDB(B0, 0, 0); PG8_SCHED; PG8_LDA(At, 0, 0); PG8_STAGE_A(PG8_SA(1, 1), cA, 1, k1, false);
            if constexpr (Sched::GATHER) { if (last && has_next) PG8_GO(nxt); }
            PG8_WAIT_L(8); PG8_BAR; PG8_WAIT_L(0); PG8_MMA(0, 0, At, B0); PG8_BAR; PG8_SCHED;
            PG8_LDB(B1, 0, 1); PG8_STAGE(PG8_SB(0, 0), b2, voffB);
            PG8_BAR; PG8_WAIT_L(0); PG8_MMA(0, 1, At, B1); PG8_BAR;
            PG8_LDA(At, 0, 1); PG8_STAGE_A(PG8_SA(0, 0), a2b, 0, k2, last);
            PG8_BAR; PG8_WAIT_L(0); PG8_MMA(1, 0, At, B0); PG8_BAR; PG8_SCHED;
            PG8_STAGE(PG8_SB(0, 1), b2 + hstep, voffB);
            PG8_WAIT_V(6); PG8_BAR; PG8_MMA(1, 1, At, B1); PG8_BAR;
            PG8_LDB(B0, 1, 0); PG8_SCHED; PG8_LDA(At, 1, 0); PG8_STAGE_A(PG8_SA(0, 1), a2b, 1, k2, last);
            PG8_WAIT_L(8); PG8_BAR; PG8_WAIT_L(0); PG8_MMA(0, 0, At, B0); PG8_BAR; PG8_SCHED;
            PG8_LDB(B1, 1, 1); PG8_STAGE(PG8_SB(1, 0), b3, voffB);
            PG8_BAR; PG8_WAIT_L(0); PG8_MMA(0, 1, At, B1); PG8_BAR;
            PG8_LDA(At, 1, 1); PG8_STAGE_A(PG8_SA(1, 0), a2b, 0, k3, last);
            PG8_BAR; PG8_WAIT_L(0); PG8_MMA(1, 0, At, B0); PG8_BAR; PG8_SCHED;
            PG8_STAGE(PG8_SB(1, 1), b3 + hstep, voffB);
            PG8_WAIT_V(6); PG8_BAR; PG8_MMA(1, 1, At, B1); PG8_BAR;
            }
        }
        if constexpr (ALIGN_EPI) { if (wr == 0) PG8_BAR; }
        E(acc, cur, wr, wc, fr, fq); S.done(cur);
        if (!has_next) break;
#pragma unroll
        for (int a = 0; a < 2; ++a)
#pragma unroll
            for (int b = 0; b < 2; ++b)
#pragma unroll
                for (int m = 0; m < 4; ++m)
#pragma unroll
                    for (int n = 0; n < 2; ++n) acc[a][b][m][n] = (f32x4){0.f, 0.f, 0.f, 0.f};
        cur = nxt; cA = nA; cB = nB; ++ui;
        if constexpr (ALIGN_EPI) { if (wr == 1) PG8_BAR; }
    }
    PG8_WAIT_V(0);
    if constexpr (!ALIGN_EPI) { if (wr == 0) PG8_BAR; }
    PG8_BAR;
#undef PG8_SA
#undef PG8_SB
#undef PG8_STAGE
#undef PG8_STAGE_A
#undef PG8_GO
#undef PG8_LDA
#undef PG8_LDB
#undef PG8_MMA
#undef PG8_WAIT_V
#undef PG8_WAIT_L
#undef PG8_BAR
#undef PG8_SCHED
}

struct EpiBf16 {
    static constexpr bool PERM = true;
    bf16_t* O; int ldc;
    __device__ __forceinline__ void operator()(const f32x4 (&acc)[2][2][4][2], const Unit& u, int wr, int wc, int fr, int fq) const {
        const int row0 = u.pm * BM + wr * 64 + fr, col0 = u.pn * BM + wc * 32 + 8 * fq;
#pragma unroll
        for (int ai = 0; ai < 2; ++ai)
#pragma unroll
            for (int m = 0; m < 4; ++m) { bf16_t* rowp = O + (size_t)(row0 + ai * HALF + m * 16) * ldc + col0;
#pragma unroll
                for (int bj = 0; bj < 2; ++bj) { const f32x4 v0 = acc[ai][bj][m][0], v1 = acc[ai][bj][m][1];
                    u32x4 w; w.x = cvt_pk_bf16(v0[0], v0[1]); w.y = cvt_pk_bf16(v0[2], v0[3]); w.z = cvt_pk_bf16(v1[0], v1[1]); w.w = cvt_pk_bf16(v1[2], v1[3]);
                    *(u32x4*)(rowp + bj * HALF) = w; } }
    }
};
__device__ __forceinline__ unsigned pk4_fp8(float a, float b, float c, float d) { int w = 0; w = __builtin_amdgcn_cvt_pk_fp8_f32(a, b, w, false); w = __builtin_amdgcn_cvt_pk_fp8_f32(c, d, w, true); return (unsigned)w; }
__device__ __forceinline__ f32x4 clamp_fp8(f32x4 v, float sc) { f32x4 r; r[0] = __builtin_amdgcn_fmed3f(v[0] * sc, -440.f, 440.f); r[1] = __builtin_amdgcn_fmed3f(v[1] * sc, -440.f, 440.f);
    r[2] = __builtin_amdgcn_fmed3f(v[2] * sc, -440.f, 440.f); r[3] = __builtin_amdgcn_fmed3f(v[3] * sc, -440.f, 440.f); return r; }
struct EpiFp8 {
    static constexpr bool PERM = false;
    unsigned char* O; int ldc; float scale;
    __device__ __forceinline__ void operator()(const f32x4 (&acc)[2][2][4][2], const Unit& u, int wr, int wc, int fr, int fq) const {
        const int row0 = u.pm * BM + wr * 64 + fr, col0 = u.pn * BM + wc * 64 + 16 * fq;
#pragma unroll
        for (int ai = 0; ai < 2; ++ai)
#pragma unroll
            for (int m = 0; m < 4; ++m) { unsigned char* rowp = O + (size_t)(row0 + ai * HALF + m * 16) * ldc + col0;
                const f32x4 v0 = clamp_fp8(acc[ai][0][m][0], scale), v1 = clamp_fp8(acc[ai][0][m][1], scale), v2 = clamp_fp8(acc[ai][1][m][0], scale), v3 = clamp_fp8(acc[ai][1][m][1], scale);
                u32x4 w; w.x = pk4_fp8(v0[0], v0[1], v0[2], v0[3]); w.y = pk4_fp8(v1[0], v1[1], v1[2], v1[3]); w.z = pk4_fp8(v2[0], v2[1], v2[2], v2[3]); w.w = pk4_fp8(v3[0], v3[1], v3[2], v3[3]);
                *(u32x4*)rowp = w; }
    }
};
struct EpiGlu {
    static constexpr bool PERM = true;
    const bf16_t* Ysrc; bf16_t* O; const float* bias;
    __device__ __forceinline__ void operator()(const f32x4 (&acc)[2][2][4][2], const Unit& u, int wr, int wc, int fr, int fq) const {
        const int row0 = u.pm * BM + wr * 64 + fr, col0 = u.pn * BM + wc * 32 + 8 * fq;
#pragma unroll
        for (int ai = 0; ai < 2; ++ai)
#pragma unroll
            for (int m = 0; m < 4; ++m) { const size_t ro = (size_t)(row0 + ai * HALF + m * 16) * 256 + col0;
#pragma unroll
                for (int bj = 0; bj < 2; ++bj) { const f32x4 v0 = acc[ai][bj][m][0], v1 = acc[ai][bj][m][1];
                    const u32x4 yv = *(const u32x4*)(Ysrc + ro + bj * HALF);
                    const f32x4 b0 = *(const f32x4*)(bias + col0 + bj * HALF), b1 = *(const f32x4*)(bias + col0 + bj * HALF + 4);
                    float o[8];
                    o[0] = bflo(yv.x) * sigmoidf_(v0[0] + b0[0]); o[1] = bfhi(yv.x) * sigmoidf_(v0[1] + b0[1]); o[2] = bflo(yv.y) * sigmoidf_(v0[2] + b0[2]); o[3] = bfhi(yv.y) * sigmoidf_(v0[3] + b0[3]);
                    o[4] = bflo(yv.z) * sigmoidf_(v1[0] + b1[0]); o[5] = bfhi(yv.z) * sigmoidf_(v1[1] + b1[1]); o[6] = bflo(yv.w) * sigmoidf_(v1[2] + b1[2]); o[7] = bfhi(yv.w) * sigmoidf_(v1[3] + b1[3]);
                    u32x4 w; w.x = cvt_pk_bf16(o[0], o[1]); w.y = cvt_pk_bf16(o[2], o[3]); w.z = cvt_pk_bf16(o[4], o[5]); w.w = cvt_pk_bf16(o[6], o[7]);
                    *(u32x4*)(O + ro + bj * HALF) = w; } }
    }
};
struct EpiGateMerge {
    static constexpr bool PERM = true;
    const unsigned char* P; bf16_t* Mg; float pinv;
    __device__ __forceinline__ void operator()(const f32x4 (&acc)[2][2][4][2], const Unit& u, int wr, int wc, int fr, int fq) const {
        const int i = u.pn >> 2, mt = u.pn & 3;
        const int row0 = u.pm * BM + wr * 64 + fr, col0 = mt * BM + wc * 32 + 8 * fq;
#pragma unroll
        for (int ai = 0; ai < 2; ++ai) {
            u32x2 pv[4][2]; u32x4 pvb[4][2]; u32x4 mv[4][2];
#pragma unroll
            for (int m = 0; m < 4; ++m)
#pragma unroll
                for (int bj = 0; bj < 2; ++bj) { const size_t r = (size_t)(row0 + ai * HALF + m * 16);
                    pv[m][bj] = PFP8 ? *(const u32x2*)(P + r * 4096 + i * 1024 + col0 + bj * HALF) : (u32x2){0u, 0u}; if (!PFP8) pvb[m][bj] = *(const u32x4*)((const bf16_t*)P + r * 4096 + i * 1024 + col0 + bj * HALF);
                    mv[m][bj] = (u32x4){0u, 0u, 0u, 0u}; if (i > 0) mv[m][bj] = *(const u32x4*)(Mg + r * 1024 + col0 + bj * HALF); }
#pragma unroll
            for (int m = 0; m < 4; ++m)
#pragma unroll
                for (int bj = 0; bj < 2; ++bj) { const size_t r = (size_t)(row0 + ai * HALF + m * 16); const f32x4 v0 = acc[ai][bj][m][0], v1 = acc[ai][bj][m][1]; const u32x2 p8 = pv[m][bj]; const u32x4 m4 = mv[m][bj];
                    f32x2 pa = __builtin_amdgcn_cvt_pk_f32_fp8((int)p8.x, false) * pinv, pb = __builtin_amdgcn_cvt_pk_f32_fp8((int)p8.x, true) * pinv,
                          pc = __builtin_amdgcn_cvt_pk_f32_fp8((int)p8.y, false) * pinv, pd = __builtin_amdgcn_cvt_pk_f32_fp8((int)p8.y, true) * pinv;
                    if (!PFP8) { const u32x4 q4 = pvb[m][bj]; pa = (f32x2){bflo(q4.x), bfhi(q4.x)}; pb = (f32x2){bflo(q4.y), bfhi(q4.y)}; pc = (f32x2){bflo(q4.z), bfhi(q4.z)}; pd = (f32x2){bflo(q4.w), bfhi(q4.w)}; }
                    float o[8];
                    o[0] = bflo(m4.x) + pa[0] * sigmoidf_(v0[0]); o[1] = bfhi(m4.x) + pa[1] * sigmoidf_(v0[1]); o[2] = bflo(m4.y) + pb[0] * sigmoidf_(v0[2]); o[3] = bfhi(m4.y) + pb[1] * sigmoidf_(v0[3]);
                    o[4] = bflo(m4.z) + pc[0] * sigmoidf_(v1[0]); o[5] = bfhi(m4.z) + pc[1] * sigmoidf_(v1[1]); o[6] = bflo(m4.w) + pd[0] * sigmoidf_(v1[2]); o[7] = bfhi(m4.w) + pd[1] * sigmoidf_(v1[3]);
                    u32x4 w; w.x = cvt_pk_bf16(o[0], o[1]); w.y = cvt_pk_bf16(o[2], o[3]); w.z = cvt_pk_bf16(o[4], o[5]); w.w = cvt_pk_bf16(o[6], o[7]);
                    *(u32x4*)(Mg + r * 1024 + col0 + bj * HALF) = w; }
        }
    }
};
struct EpiGateMerge4 {
    static constexpr bool PERM = false;
    const unsigned char* P; bf16_t* Mg; float pinv;
    __device__ __forceinline__ void operator()(const f32x4 (&acc)[2][2][4][2], const Unit& u, int wr, int wc, int fr, int fq) const {
        const int row0 = u.pm * BM + wr * 64 + fr, col0 = u.pn * 64 + wc * 16 + 4 * fq;
#pragma unroll
        for (int ai = 0; ai < 2; ++ai) {
            unsigned pv[4][4];
#pragma unroll
            for (int m = 0; m < 4; ++m)
#pragma unroll
                for (int b = 0; b < 4; ++b) pv[m][b] = *(const unsigned*)(P + (size_t)(row0 + ai * HALF + m * 16) * 4096 + b * 1024 + col0);
#pragma unroll
            for (int m = 0; m < 4; ++m) { f32x4 o = (f32x4){0.f, 0.f, 0.f, 0.f};
#pragma unroll
                for (int b = 0; b < 4; ++b) { const f32x4 v = acc[ai][b >> 1][m][b & 1]; const f32x2 pa = __builtin_amdgcn_cvt_pk_f32_fp8((int)pv[m][b], false), pb = __builtin_amdgcn_cvt_pk_f32_fp8((int)pv[m][b], true);
                    o[0] += pa[0] * sigmoidf_(v[0]); o[1] += pa[1] * sigmoidf_(v[1]); o[2] += pb[0] * sigmoidf_(v[2]); o[3] += pb[1] * sigmoidf_(v[3]); }
                u32x2 w; w.x = cvt_pk_bf16(o[0] * pinv, o[1] * pinv); w.y = cvt_pk_bf16(o[2] * pinv, o[3] * pinv);
                *(u32x2*)(Mg + (size_t)(row0 + ai * HALF + m * 16) * 1024 + col0) = w; }
        }
    }
};
struct EpiResid {
    static constexpr bool PERM = false;
    const float* xin; bf16_t* out; const float* gate;
    __device__ __forceinline__ void operator()(const f32x4 (&acc)[2][2][4][2], const Unit& u, int wr, int wc, int fr, int fq) const {
        const int row0 = u.pm * BM + wr * 64 + fr, col0 = u.pn * BM + wc * 32 + 4 * fq;
        const int b = (u.pm * BM) / SEQ;
        f32x4 gv[2][2];
#pragma unroll
        for (int bj = 0; bj < 2; ++bj)
#pragma unroll
            for (int n = 0; n < 2; ++n) gv[bj][n] = *(const f32x4*)(gate + b * 3072 + 2048 + col0 + bj * HALF + n * 16) + 1.0f;
#pragma unroll
        for (int ai = 0; ai < 2; ++ai)
#pragma unroll
            for (int mh = 0; mh < 4; mh += 2) {
                f32x4 xv[2][2][2];
#pragma unroll
                for (int m = 0; m < 2; ++m)
#pragma unroll
                    for (int bj = 0; bj < 2; ++bj)
#pragma unroll
                        for (int n = 0; n < 2; ++n) xv[m][bj][n] = *(const f32x4*)(xin + (size_t)(row0 + ai * HALF + (mh + m) * 16) * D + col0 + bj * HALF + n * 16);
#pragma unroll
                for (int m = 0; m < 2; ++m)
#pragma unroll
                    for (int bj = 0; bj < 2; ++bj)
#pragma unroll
                        for (int n = 0; n < 2; ++n) { const f32x4 v = xv[m][bj][n] * DN_ALPHA + gv[bj][n] * acc[ai][bj][mh + m][n];
                            u32x2 w; w.x = cvt_pk_bf16(v[0], v[1]); w.y = cvt_pk_bf16(v[2], v[3]);
                            *(u32x2*)(out + (size_t)(row0 + ai * HALF + (mh + m) * 16) * D + col0 + bj * HALF + n * 16) = w; } }
    }
};
struct EpiMoe1 {
    static constexpr bool PERM = false;
    bf16_t* Act; const LAS float* gtab;
    __device__ __forceinline__ void operator()(const f32x4 (&acc)[2][2][4][2], const Unit& u, int wr, int wc, int fr, int fq) const {
        const int row0 = u.pm * BM + wr * 64 + fr, f0 = u.pn * 128 + wc * 32 + 8 * fq;
#pragma unroll
        for (int ai = 0; ai < 2; ++ai)
#pragma unroll
            for (int m = 0; m < 4; ++m) { const int r = row0 + ai * HALF + m * 16; const float gt = gtab[u.ab * 256 + wr * 64 + fr + ai * HALF + m * 16];
                const f32x4 a0 = acc[ai][0][m][0], b0 = acc[ai][0][m][1], a1 = acc[ai][1][m][0], b1 = acc[ai][1][m][1];
                u32x4 w; w.x = cvt_pk_bf16(siluf_(a0[0]) * b0[0] * gt, siluf_(a0[1]) * b0[1] * gt); w.y = cvt_pk_bf16(siluf_(a0[2]) * b0[2] * gt, siluf_(a0[3]) * b0[3] * gt);
                w.z = cvt_pk_bf16(siluf_(a1[0]) * b1[0] * gt, siluf_(a1[1]) * b1[1] * gt); w.w = cvt_pk_bf16(siluf_(a1[2]) * b1[2] * gt, siluf_(a1[3]) * b1[3] * gt);
                *(u32x4*)(Act + (size_t)r * 256 + f0) = w; }
    }
};
}

#define XB_TMO      128
#define XB_XCNT(j)  (256  + 64 * (j))
#define XB_XSUB(j)  (1280 + 64 * (j))
#define XB_XGEN(j)  (2304 + 64 * (j))
#define XB_TOP      3328
#define XB_TOPGEN   3392
#define XCD_BAR_WORDS 3456
#define XB_SPIN_CAP (1u << 22)
__device__ __forceinline__ unsigned xb_ld(unsigned* p)              { return __hip_atomic_load(p, __ATOMIC_RELAXED, __HIP_MEMORY_SCOPE_AGENT); }
__device__ __forceinline__ unsigned xb_add(unsigned* p, unsigned v) { return __hip_atomic_fetch_add(p, v, __ATOMIC_RELAXED, __HIP_MEMORY_SCOPE_AGENT); }
__device__ __forceinline__ unsigned xb_xcc_id() { return (unsigned)__builtin_amdgcn_s_getreg((3 << 11) | 20) & 0xFu; }
#define XB_SPIN(cond, bar) do { unsigned _sp = 0; while (cond) { __builtin_amdgcn_s_sleep(1); \
    if ((++_sp & 255u) == 0u) { if (xb_ld(&(bar)[XB_TMO])) break; if (_sp > XB_SPIN_CAP) { atomicAdd(&(bar)[XB_TMO], 1u); break; } } } } while (0)
struct XcdBarrier { unsigned* bar; unsigned x; volatile LAS unsigned* st; };
__device__ __forceinline__ XcdBarrier xcd_barrier_post(unsigned* bar, volatile LAS unsigned* st) {
    XcdBarrier b; b.bar = bar; b.x = xb_xcc_id(); b.st = st;
    if (threadIdx.x == 0) (void)xb_add(&bar[XB_XCNT(b.x)], 1u);
    return b;
}
__device__ __forceinline__ void xcd_barrier_complete(unsigned* bar, unsigned x, unsigned& nloc, unsigned& nx) {
    const unsigned G = gridDim.x * gridDim.y * gridDim.z;
    unsigned sum, cnt, mine, sp = 0u;
    for (;;) {
        sum = 0u; cnt = 0u; mine = 0u;
#pragma unroll
        for (unsigned j = 0; j < 16; ++j) { const unsigned c = xb_ld(&bar[XB_XCNT(j)]); sum += c; cnt += (c > 0u) ? 1u : 0u; mine = (j == x) ? c : mine; }
        if (sum == G) break;
        __builtin_amdgcn_s_sleep(1);
        if ((++sp & 255u) == 0u) { if (xb_ld(&bar[XB_TMO])) break; if (sp > XB_SPIN_CAP) { atomicAdd(&bar[XB_TMO], 1u); break; } }
    }
    nloc = mine > 0u ? mine : 1u; nx = cnt > 0u ? cnt : 1u;
}
__device__ __forceinline__ void xcd_barrier(const XcdBarrier& b) {
    asm volatile("s_waitcnt vmcnt(0)" ::: "memory");
    __syncthreads();
    if (threadIdx.x == 0) {
        unsigned* bar = b.bar;
        __builtin_amdgcn_s_waitcnt(0);
        unsigned nloc = b.st[0], nx = b.st[1];
        if (nloc == 0u) { xcd_barrier_complete(bar, b.x, nloc, nx); b.st[0] = nloc; b.st[1] = nx; }
        const unsigned old = xb_add(&bar[XB_XSUB(b.x)], 1u);
        const unsigned gen = old / nloc;
        if (old + 1u == (gen + 1u) * nloc) {
            __builtin_amdgcn_fence(__ATOMIC_RELEASE, "agent");
            asm volatile("s_waitcnt vmcnt(0)" ::: "memory");
            const unsigned og = xb_add(&bar[XB_TOP], 1u);
            const unsigned tg = og / nx;
            if (og + 1u == (tg + 1u) * nx) xb_add(&bar[XB_TOPGEN], 1u);
            else XB_SPIN(xb_ld(&bar[XB_TOPGEN]) == tg, bar);
            __builtin_amdgcn_fence(__ATOMIC_ACQUIRE, "agent");
            xb_add(&bar[XB_XGEN(b.x)], 1u);
            asm volatile("s_waitcnt vmcnt(0)" ::: "memory");
        } else {
            XB_SPIN(xb_ld(&bar[XB_XGEN(b.x)]) == gen, bar);
            __builtin_amdgcn_fence(__ATOMIC_ACQUIRE, "agent");
            asm volatile("s_waitcnt vmcnt(0)" ::: "memory");
        }
    }
    __syncthreads();
}

struct Args {
    const float* in[43]; const int* positions; float* out; unsigned char* ws; int ph_lo, ph_hi, dbg, pad;
};
enum { I_X = 0, I_C = 1, I_POS = 2, I_MOD1W = 3, I_MOD1B = 4, I_WIN = 5, I_GMLNG = 6, I_GMLNB = 7, I_GMW = 8, I_GMB = 9,
       I_S5LRE = 10, I_S5LIM = 11, I_S5STEP = 12, I_S5BRE = 13, I_S5BIM = 14, I_S5CRE = 15, I_S5CIM = 16, I_S5D = 17, I_S5GLUW = 18, I_S5GLUB = 19,
       I_CONVW = 20, I_CONVB = 21, I_DTBIAS = 22, I_ALOG = 23, I_SSDD = 24, I_SSDNG = 25, I_WBR = 26, I_WGATE = 27, I_WOUT = 28, I_LN1G = 29, I_LN1B = 30,
       I_MOD2W = 31, I_MOD2B = 32, I_RW = 33, I_RB = 34, I_EW1 = 35, I_EW3 = 36, I_EW2 = 37, I_SW1 = 38, I_SW3 = 39, I_SW2 = 40, I_LN2G = 41, I_LN2B = 42 };

typedef const __attribute__((address_space(4))) Args* ArgsP;
struct Ctx {
    ArgsP a; unsigned char* ws; LAS unsigned char* lds; int tid, lane, wave, c, G, bx, dbg;
    __device__ __forceinline__ const float* in(int i) const { return a->in[i]; }
    __device__ __forceinline__ bf16_t* proj() const { return (bf16_t*)(ws + WS_PROJ); }
    __device__ __forceinline__ bf16_t* hbuf() const { return (bf16_t*)(ws + WS_H); }
    __device__ __forceinline__ bf16_t* ybuf() const { return (bf16_t*)(ws + WS_Y); }
    __device__ __forceinline__ float* modv(int l, int w) const { return (float*)(ws + WS_MODV) + (size_t)(l * 2 + w) * NB * 3072; }
};

__device__ __forceinline__ void ph_prologue(const Ctx& X) {
    { float* ropet = (float*)(X.ws + WS_ROPE); const int* pos = X.a->positions;
      for (int i = X.c * 512 + X.tid; i < M * 8; i += X.G * 512) { const int tok = i >> 3, j = i & 7;
          const float inv = (j == 0) ? 1.0f : (j == 1) ? 0.1939227432f : (j == 2) ? 0.0376060307f : (j == 3) ? 0.00729266461f : (j == 4) ? 0.00141421356f : (j == 5) ? 0.000274248188f : (j == 6) ? 5.31829610e-05f : 1.03133862e-05f;
          float sn, cs; sincos_red((float)pos[tok] * inv, sn, cs); *(f32x2*)(ropet + (size_t)i * 2) = (f32x2){cs, sn}; } }
    LAS float* red = (LAS float*)X.lds;
    for (int it = X.c; it < DEPTH * 2 * 48; it += X.G) {
        const int l = it / 96, w = (it / 48) & 1, jb = it % 48, j = jb * 64 + X.lane;
        const float* W = X.in(w ? I_MOD2W : I_MOD1W) + (size_t)l * D * 3072; const float* cv = X.in(I_C);
        float a0 = 0.f, a1 = 0.f, a2 = 0.f, a3 = 0.f;
        const int k0 = X.wave * 128;
        for (int k = k0; k < k0 + 128; ++k) { const float wv = W[(size_t)k * 3072 + j]; a0 += cv[k] * wv; a1 += cv[D + k] * wv; a2 += cv[2 * D + k] * wv; a3 += cv[3 * D + k] * wv; }
        red[(X.wave * 4 + 0) * 64 + X.lane] = a0; red[(X.wave * 4 + 1) * 64 + X.lane] = a1; red[(X.wave * 4 + 2) * 64 + X.lane] = a2; red[(X.wave * 4 + 3) * 64 + X.lane] = a3;
        __syncthreads();
        if (X.tid < 256) { const int b = X.tid >> 6, ln = X.tid & 63; float s = 0.f;
#pragma unroll
            for (int q = 0; q < 8; ++q) s += red[(q * 4 + b) * 64 + ln];
            const int jj = jb * 64 + ln; X.modv(l, w)[b * 3072 + jj] = s + X.in(w ? I_MOD2B : I_MOD1B)[(size_t)l * 3072 + jj]; }
        __syncthreads();
    }
}

template <class Src, int RMODE = 0>
__device__ __forceinline__ void tr_item(const Src& src, bf16_t* WT, int K, int rowbase, int kb, int nb, LAS float* scr, int lane) {
    const int k0 = 64 * kb, n0 = 32 * nb;
    f32x4 v[8];
#pragma unroll
    for (int i = 0; i < 8; ++i) v[i] = src.load4(k0 + 8 * i + (lane >> 3), n0 + 4 * (lane & 7));
#pragma unroll
    for (int i = 0; i < 8; ++i) { LAS float* d = scr + (8 * i + (lane >> 3)) * 33 + 4 * (lane & 7); d[0] = v[i][0]; d[1] = v[i][1]; d[2] = v[i][2]; d[3] = v[i][3]; }
    asm volatile("s_waitcnt lgkmcnt(0)" ::: "memory");
    const int c = lane & 7;
#pragma unroll
    for (int j = 0; j < 4; ++j) { const int n = (lane >> 3) + 8 * j; const LAS float* s = scr + (8 * c) * 33 + n;
        u32x4 o; o.x = pk2(s[0 * 33], s[1 * 33]); o.y = pk2(s[2 * 33], s[3 * 33]); o.z = pk2(s[4 * 33], s[5 * 33]); o.w = pk2(s[6 * 33], s[7 * 33]);
        int row = rowbase + n0 + n;
        if constexpr (RMODE == 1) { const int cc = n0 + n, bi = rowbase >> 10; row = 256 * (cc >> 6) + 128 * (bi >> 1) + 32 * ((cc >> 4) & 3) + 16 * (bi & 1) + (cc & 15); }
        if constexpr (RMODE == 2) { const int cc = n0 + n; row = rowbase + (cc & ~255) + 128 * ((cc >> 3) & 1) + 32 * ((cc >> 6) & 3) + 16 * ((cc >> 2) & 1) + 4 * ((cc >> 4) & 3) + (cc & 3); }
        if constexpr (RMODE == 3) { const int cc = n0 + n; row = rowbase + (cc & ~255) + 128 * ((cc >> 5) & 1) + 32 * ((cc >> 6) & 3) + 16 * ((cc >> 2) & 1) + 4 * ((cc >> 3) & 3) + (cc & 3); }
        *(u32x4*)(WT + (size_t)row * K + k0 + 8 * c) = o; }
    asm volatile("s_waitcnt lgkmcnt(0)" ::: "memory");
}
struct SrcPlain { const float* W; int N; __device__ __forceinline__ f32x4 load4(int k, int n) const { return *(const f32x4*)(W + (size_t)k * N + n); } };
struct SrcWin { const float* W; __device__ __forceinline__ f32x4 load4(int k, int n) const {
    if (n >= D_IN) return (f32x4){0.f, 0.f, 0.f, 0.f}; const int o = (n < 1216) ? n : (n < 2240) ? n + 4 : (n < 2244) ? 1216 + (n - 2240) : n; return *(const f32x4*)(W + (size_t)k * D_IN + o); } };
struct Src13 { const float* W1; const float* W3; __device__ __forceinline__ f32x4 load4(int k, int n) const {
    const int f = (n >> 8) * 128 + ((n >> 5) & 3) * 32 + ((n >> 2) & 3) * 8 + ((n >> 7) & 1) * 4 + (n & 3); const long d = (n & 16) ? (long)(W3 - W1) : 0l;     return *(const f32x4*)(W1 + d + (long)k * 256 + f); } };

__device__ __forceinline__ void ph_wconv(const Ctx& X, int l) {
    LAS float* scr = (LAS float*)(X.lds + X.wave * 16384);
    unsigned char* wb = X.ws + WS_W;
    const int gw = X.c * 8 + X.wave, NGW = X.G * 8;
    constexpr int I_A = 16 * 72, I_B = 4 * 16 * 32, I_C2 = 4 * 4 * 32, I_D = 16 * 32, I_E = 4 * 8, I_F = NE1 * 16 * 16, I_G = NE1 * 4 * 32;
    constexpr int NIT = I_A + I_B + I_C2 + I_D + I_E + I_F + I_G;
    for (int it = gw; it < NIT; it += NGW) {
        int r = it;
        if (r < I_A) { SrcWin s{X.in(I_WIN) + (size_t)l * D * D_IN}; tr_item(s, (bf16_t*)(wb + WO_IN), 1024, 0, r / 72, r % 72, scr, X.lane); continue; } r -= I_A;
        if (r < I_B) { const int i = r / 512, q = r % 512; SrcPlain s{X.in(I_WGATE) + ((size_t)l * 4 + i) * D * D, D}; tr_item<SrcPlain, 1>(s, (bf16_t*)(wb + WO_GATE), 1024, i * 1024, q / 32, q % 32, scr, X.lane); continue; } r -= I_B;
        if (r < I_C2) { const int i = r / 128, q = r % 128; SrcPlain s{X.in(I_WBR) + ((size_t)l * 4 + i) * 256 * D, D}; tr_item<SrcPlain, 2>(s, (bf16_t*)(wb + WO_BR) + (size_t)i * 1024 * 256, 256, 0, q / 32, q % 32, scr, X.lane); continue; } r -= I_C2;
        if (r < I_D) { SrcPlain s{X.in(I_WOUT) + (size_t)l * D * D, D}; tr_item(s, (bf16_t*)(wb + WO_OUT), 1024, 0, r / 32, r % 32, scr, X.lane); continue; } r -= I_D;
        if (r < I_E) { SrcPlain s{X.in(I_S5GLUW) + (size_t)l * 256 * 256, 256}; tr_item(s, (bf16_t*)(wb + WO_GLU), 256, 0, r / 8, r % 8, scr, X.lane); continue; } r -= I_E;
        if (r < I_F) { const int e = r / 256, q = r % 256;
            const Src13 s{(e < NEXP) ? X.in(I_EW1) + ((size_t)l * NEXP + e) * D * 256 : X.in(I_SW1) + (size_t)l * D * 256, (e < NEXP) ? X.in(I_EW3) + ((size_t)l * NEXP + e) * D * 256 : X.in(I_SW3) + (size_t)l * D * 256};
            tr_item(s, (bf16_t*)(wb + WO_13) + (size_t)e * 512 * 1024, 1024, 0, q / 16, q % 16, scr, X.lane); continue; } r -= I_F;
        { const int e = r / 128, q = r % 128; SrcPlain s{e < NEXP ? X.in(I_EW2) + ((size_t)l * NEXP + e) * 256 * D : X.in(I_SW2) + (size_t)l * 256 * D, D};
            tr_item<SrcPlain, 2>(s, (bf16_t*)(wb + WO_2) + (size_t)e * 1024 * 256, 256, 0, q / 32, q % 32, scr, X.lane); }
    }
    const int gt = X.c * 512 + X.tid, NGT = X.G * 512;
    { bf16_t* gmw = (bf16_t*)(X.ws + WS_GMW); const float* src = X.in(I_GMW) + (size_t)l * 4 * 128 * 128;
      for (int i = gt; i < 4 * 128 * 128; i += NGT) { const int t = (i >> 7) & 127, s = i & 127; gmw[i] = (bf16_t)f2bf(s <= t ? src[i] : 0.f); } }
    for (int i = gt; i < 16 * 64; i += NGT) {
        const int g = i >> 6, p = i & 63;
        const float step = expf(X.in(I_S5STEP)[l * 16 + g]); const float lr = X.in(I_S5LRE)[(size_t)l * 1024 + i], li = X.in(I_S5LIM)[(size_t)l * 1024 + i];
        const float mag = expf(lr * step); float sn, cs; sincos_red(li * step, sn, cs);
        const float abr = mag * cs, abi = mag * sn, den = lr * lr + li * li, nr = abr - 1.0f;
        const float cr = (nr * lr + abi * li) / den, ci = (abi * lr - nr * li) / den;
        float* sa = (float*)(X.ws + WS_S5A); sa[i * 2] = abr; sa[i * 2 + 1] = abi;
        bf16_t* bb = (bf16_t*)(X.ws + WS_S5B); bf16_t* cm = (bf16_t*)(X.ws + WS_S5C);
        const float* bre = X.in(I_S5BRE) + ((size_t)l * 1024 + i) * 16; const float* bim = X.in(I_S5BIM) + ((size_t)l * 1024 + i) * 16;
#pragma unroll
        for (int ch = 0; ch < 16; ++ch) { const float br = bre[ch], bi = bim[ch];
            bb[(g * 128 + p) * 16 + ch] = (bf16_t)f2bf(cr * br - ci * bi); bb[(g * 128 + 64 + p) * 16 + ch] = (bf16_t)f2bf(cr * bi + ci * br);
            cm[(g * 16 + ch) * 128 + p] = (bf16_t)f2bf(X.in(I_S5CRE)[(((size_t)l * 16 + g) * 16 + ch) * 64 + p]);
            cm[(g * 16 + ch) * 128 + 64 + p] = (bf16_t)f2bf(-X.in(I_S5CIM)[(((size_t)l * 16 + g) * 16 + ch) * 64 + p]); }
    }
    { bf16_t* rf = (bf16_t*)(X.ws + WS_RFR); const float* rw = X.in(I_RW) + (size_t)l * D * NEXP;
      for (int i = gt; i < 2 * 32 * 64 * 8; i += NGT) { const int j = i & 7, ln = (i >> 3) & 63, ks = (i >> 9) & 31, rt = i >> 14;
          const float v = rw[(size_t)(ks * 32 + 8 * (ln >> 4) + j) * NEXP + rt * 16 + (ln & 15)]; const unsigned hi = f2bf(v); const float lo = v - bflo(hi);
          rf[i] = (bf16_t)hi; rf[32768 + i] = (bf16_t)f2bf(lo); } }
    if (l == 0) {
        const float* x = X.in(I_X); bf16_t* h = X.hbuf(); const float* mv = X.modv(0, 0);
        for (size_t i = (size_t)gt; i < (size_t)M * D / 8; i += NGT) {
            const size_t e = i * 8; const int col = (int)(e & 1023), b = (int)(e >> 23);
            const f32x4 x0 = *(const f32x4*)(x + e), x1 = *(const f32x4*)(x + e + 4);
            const f32x4 sh0 = *(const f32x4*)(mv + b * 3072 + col), sh1 = *(const f32x4*)(mv + b * 3072 + col + 4), sc0 = *(const f32x4*)(mv + b * 3072 + 1024 + col), sc1 = *(const f32x4*)(mv + b * 3072 + 1024 + col + 4);
            const f32x4 h0 = x0 * (sc0 + 1.0f) + sh0, h1 = x1 * (sc1 + 1.0f) + sh1;
            u32x4 w; w.x = pk2(h0[0], h0[1]); w.y = pk2(h0[2], h0[3]); w.z = pk2(h1[0], h1[1]); w.w = pk2(h1[2], h1[3]);
            *(u32x4*)(h + e) = w; }
    }
}

__device__ __forceinline__ void rope8(const u32x4 a, const u32x4 b, const float* cs, u32x4& wa, u32x4& wb) {
    float t1[8], t2[8]; t1[0] = bflo(a.x); t1[1] = bfhi(a.x); t1[2] = bflo(a.y); t1[3] = bfhi(a.y); t1[4] = bflo(a.z); t1[5] = bfhi(a.z); t1[6] = bflo(a.w); t1[7] = bfhi(a.w);
    t2[0] = bflo(b.x); t2[1] = bfhi(b.x); t2[2] = bflo(b.y); t2[3] = bfhi(b.y); t2[4] = bflo(b.z); t2[5] = bfhi(b.z); t2[6] = bflo(b.w); t2[7] = bfhi(b.w);
    float o1[8], o2[8]; f32x4 c4[4];
#pragma unroll
    for (int q = 0; q < 4; ++q) c4[q] = *(const f32x4*)(cs + 4 * q);
#pragma unroll
    for (int j = 0; j < 8; ++j) { const float cv = c4[j >> 1][(j & 1) * 2], sv = c4[j >> 1][(j & 1) * 2 + 1]; o1[j] = t1[j] * cv - t2[j] * sv; o2[j] = t2[j] * cv + t1[j] * sv; }
    wa.x = pk2(o1[0], o1[1]); wa.y = pk2(o1[2], o1[3]); wa.z = pk2(o1[4], o1[5]); wa.w = pk2(o1[6], o1[7]);
    wb.x = pk2(o2[0], o2[1]); wb.y = pk2(o2[2], o2[3]); wb.z = pk2(o2[4], o2[5]); wb.w = pk2(o2[6], o2[7]);
}
__device__ __forceinline__ void mx_rope(const Ctx& X) {
    bf16_t* pj = X.proj(); const float* ropet = (const float*)(X.ws + WS_ROPE);
    const int gt = X.c * 512 + X.tid, NGT = X.G * 512;
    for (int i = gt; i < M * 10; i += NGT) {
        const int tok = i / 10, hh = i % 10;
        if (hh == 9) { const u32x4* sp = (const u32x4*)(pj + (size_t)tok * PJ + C_V); u32x4* dp = (u32x4*)((bf16_t*)(X.ws + WS_V2) + (size_t)tok * 64);
#pragma unroll
            for (int q = 0; q < 8; ++q) dp[q] = sp[q];
            continue; }
        const int col = (hh < 4) ? C_Q + hh * 64 : (hh < 8) ? C_QI + (hh - 4) * 64 : C_K;
        bf16_t* p = pj + (size_t)tok * PJ + col;
        const u32x4 a = *(const u32x4*)p, b = *(const u32x4*)(p + 8);
        u32x4 wa, wb; rope8(a, b, ropet + (size_t)tok * 16, wa, wb);
        if (hh < 8) { *(u32x4*)p = wa; *(u32x4*)(p + 8) = wb; }
        else { u32x4* dp = (u32x4*)((bf16_t*)(X.ws + WS_K2) + (size_t)tok * 64); const u32x4* sp = (const u32x4*)p; dp[0] = wa; dp[1] = wb;
#pragma unroll
            for (int q = 2; q < 8; ++q) dp[q] = sp[q]; }
    }
    for (int i = gt; i < (M / 16) * 16; i += NGT) {
        const int hf = i & 1, pc = (i >> 1) & 7, tile = i >> 4; const int ks = pc >> 2, fq = pc & 3;
        u32x4* dp = (u32x4*)((bf16_t*)(X.ws + WS_KI2) + (size_t)tile * 1024 + pc * 128 + hf * 64);
#pragma unroll
        for (int j = 0; j < 8; ++j) { const int tok = tile * 16 + hf * 8 + j; const bf16_t* rp = pj + (size_t)tok * PJ + C_KI;
            u32x4 v = *(const u32x4*)(rp + ks * 32 + fq * 8);
            if (pc < 2) { const u32x4 a = *(const u32x4*)rp, b = *(const u32x4*)(rp + 8); u32x4 wa, wb; rope8(a, b, ropet + (size_t)tok * 16, wa, wb); v = pc ? wb : wa; }
            dp[j] = v; }
    }
}

__device__ __forceinline__ void mx_gmlp(const Ctx& X, int l, int unit) {
    const int lane = X.lane, w = X.wave;
    const int row0 = unit * 128;
    LAS bf16_t* Vt = (LAS bf16_t*)X.lds;
    const bf16_t* pj = X.proj();
    const float* lng = X.in(I_GMLNG) + l * 256; const float* lnb = X.in(I_GMLNB) + l * 256;
    float g4[4], b4[4];
#pragma unroll
    for (int j = 0; j < 4; ++j) { g4[j] = lng[lane + 64 * j]; b4[j] = lnb[lane + 64 * j]; }
    for (int i = 0; i < 16; ++i) {
        const int s = w * 16 + i; const bf16_t* rp = pj + (size_t)(row0 + s) * PJ + C_GV;
        float v[4]; float sm = 0.f;
#pragma unroll
        for (int j = 0; j < 4; ++j) { v[j] = gelu_tanh(bf2f(rp[lane + 64 * j])); sm += v[j]; }
        const float mean = wave_sum(sm) * (1.0f / 256.0f); float q = 0.f;
#pragma unroll
        for (int j = 0; j < 4; ++j) { v[j] -= mean; q += v[j] * v[j]; }
        const float rstd = rsqrtf(wave_sum(q) * (1.0f / 256.0f) + LN_EPS);
#pragma unroll
        for (int j = 0; j < 4; ++j) Vt[(lane + 64 * j) * 136 + s] = (bf16_t)f2bf(v[j] * rstd * g4[j] + b4[j]);
    }
    __syncthreads();
    const int g = w >> 1, c0 = g * 64 + (w & 1) * 32, fr = lane & 15, fq = lane >> 4;
    const bf16_t* gmw = (const bf16_t*)(X.ws + WS_GMW) + (size_t)g * 128 * 128;
    const float* gmb = X.in(I_GMB) + ((size_t)l * 4 + g) * 128;
    bf16_t* ya = X.ybuf();
    for (int tt = 0; tt < 8; ++tt) {
        f32x4 acc0 = (f32x4){0.f, 0.f, 0.f, 0.f}, acc1 = acc0;
        for (int ks = 0; ks <= (tt >> 1); ++ks) {
            const bf16x8 wf = *(const bf16x8*)(gmw + (tt * 16 + fr) * 128 + ks * 32 + 8 * fq);
            const bf16x8 v0 = *(const LAS bf16x8*)(Vt + (c0 + fr) * 136 + ks * 32 + 8 * fq), v1 = *(const LAS bf16x8*)(Vt + (c0 + 16 + fr) * 136 + ks * 32 + 8 * fq);
            acc0 = mfma16(v0, wf, acc0); acc1 = mfma16(v1, wf, acc1);
        }
        const int t = tt * 16 + fr; const float bias = gmb[t];
#pragma unroll
        for (int c2 = 0; c2 < 2; ++c2) { const f32x4 a = c2 ? acc1 : acc0; const int cc = c0 + c2 * 16 + 4 * fq;
            const u32x2 uv = *(const u32x2*)(pj + (size_t)(row0 + t) * PJ + C_GU + cc);
            u32x2 o; o.x = pk2(gelu_tanh(bflo(uv.x)) * (a[0] + bias), gelu_tanh(bfhi(uv.x)) * (a[1] + bias)); o.y = pk2(gelu_tanh(bflo(uv.y)) * (a[2] + bias), gelu_tanh(bfhi(uv.y)) * (a[3] + bias));
            *(u32x2*)(ya + (size_t)(row0 + t) * 256 + cc) = o; }
    }
    __syncthreads();
}

template <int PASS>
__device__ __forceinline__ void mx_s5(const Ctx& X, int l, int wu) {
    const int lane = X.lane, fr = lane & 15, fq = lane >> 4;
    const int wgi = wu >> 3, wv = wu & 7; const int b = wgi >> 6, g = ((wgi >> 4) & 3) * 4 + (wv & 3), ch = (wgi & 15) * 2 + (wv >> 2);
    const int tb = b * SEQ + ch * 256;
    LAS float* xl = (LAS float*)(X.lds + X.wave * 16384);
    LAS bf16_t* hb = (LAS bf16_t*)(X.lds + X.wave * 16384 + 8192);
    const bf16_t* pj = X.proj();
    const bf16_t* bbT = (const bf16_t*)(X.ws + WS_S5B) + (size_t)g * 128 * 16;
    bf16x8 Bf[8];
#pragma unroll
    for (int ct = 0; ct < 8; ++ct) { Bf[ct] = (bf16x8){0, 0, 0, 0, 0, 0, 0, 0}; if (fq < 2) Bf[ct] = *(const bf16x8*)(bbT + (ct * 16 + fr) * 16 + 8 * fq); }
    const float* sa = (const float*)(X.ws + WS_S5A) + (g * 64 + lane) * 2; const float ar = sa[0], ai = sa[1];
    float hr = 0.f, hi = 0.f;
    float* st = (float*)(X.ws + WS_S5ST) + (size_t)((b * 16 + g) * 32) * 128;
    bf16x8 Cf[4]; float dsk[4];
    if (PASS == 3) {
        { const float* hin = (const float*)(X.ws + WS_S5HIN) + (size_t)((b * 16 + g) * 32 + ch) * 128; hr = hin[lane]; hi = hin[64 + lane]; }
        const bf16_t* cm = (const bf16_t*)(X.ws + WS_S5C) + (size_t)g * 16 * 128;
#pragma unroll
        for (int ks = 0; ks < 4; ++ks) Cf[ks] = *(const bf16x8*)(cm + fr * 128 + ks * 32 + 8 * fq);
#pragma unroll
        for (int i = 0; i < 4; ++i) dsk[i] = X.in(I_S5D)[l * 256 + g * 16 + 4 * fq + i];
    }
    bf16_t* ycp = (bf16_t*)(X.ws + WS_YCPRE);
    for (int blk = 0; blk < 16; ++blk) {
        const int t0 = tb + blk * 16;
        bf16x8 uf = (bf16x8){0, 0, 0, 0, 0, 0, 0, 0};
        if (fq < 2) uf = *(const bf16x8*)(pj + (size_t)(t0 + fr) * PJ + C_S5 + g * 16 + 8 * fq);
#pragma unroll
        for (int ct = 0; ct < 8; ++ct) { const f32x4 a = mfma16(uf, Bf[ct], (f32x4){0.f, 0.f, 0.f, 0.f});
#pragma unroll
            for (int i = 0; i < 4; ++i) xl[(4 * fq + i) * 128 + ct * 16 + fr] = a[i]; }
#pragma unroll
        for (int t = 0; t < 16; ++t) { const float xr = xl[t * 128 + lane], xi = xl[t * 128 + 64 + lane];
            const float nr = ar * hr - ai * hi + xr, ni = ar * hi + ai * hr + xi; hr = nr; hi = ni;
            if (PASS == 3) { hb[t * 136 + lane] = (bf16_t)f2bf(hr); hb[t * 136 + 64 + lane] = (bf16_t)f2bf(hi); } }
        if (PASS == 3) {
            asm volatile("s_waitcnt lgkmcnt(0)" ::: "memory"); __builtin_amdgcn_wave_barrier();
            f32x4 acc = (f32x4){0.f, 0.f, 0.f, 0.f};
#pragma unroll
            for (int ks = 0; ks < 4; ++ks) { const bf16x8 hf = *(const LAS bf16x8*)(hb + fr * 136 + ks * 32 + 8 * fq); acc = mfma16(Cf[ks], hf, acc); }
            const u32x2 uv = *(const u32x2*)(pj + (size_t)(t0 + fr) * PJ + C_S5 + g * 16 + 4 * fq);
            const float y0 = gelu_tanh(acc[0] + dsk[0] * bflo(uv.x)), y1 = gelu_tanh(acc[1] + dsk[1] * bfhi(uv.x)), y2 = gelu_tanh(acc[2] + dsk[2] * bflo(uv.y)), y3 = gelu_tanh(acc[3] + dsk[3] * bfhi(uv.y));
            u32x2 o; o.x = pk2(y0, y1); o.y = pk2(y2, y3);
            *(u32x2*)(ycp + (size_t)(t0 + fr) * 256 + g * 16 + 4 * fq) = o;
        }
    }
    if (PASS == 1) { st[ch * 128 + lane] = hr; st[ch * 128 + 64 + lane] = hi; }
}

constexpr int SD_CM = 0, SD_BM = 18432, SD_XT0 = 36864, SD_XT1 = 55296, SD_MM = 73728, SD_SIN0 = 108544, SD_SIN1 = 117760, SD_DT = 126976, SD_AC = 128000 + 64, SD_END = 129024 + 64;
__device__ __forceinline__ bf16x8 tr_frag8(const LAS bf16_t* base, int pitch, int l0, int c0, int lane) {
    const int g = lane >> 4, i = lane & 15; const unsigned a1 = (unsigned)(unsigned long)(base + (l0 + 8 * g + (i >> 2)) * pitch + c0 + 4 * (i & 3)); const unsigned a2 = a1 + (unsigned)(8 * pitch);
    u32x2 r1, r2;
    asm volatile("ds_read_b64_tr_b16 %0, %2\n\tds_read_b64_tr_b16 %1, %3\n\ts_waitcnt lgkmcnt(0)" : "=&v"(r1), "=&v"(r2) : "v"(a1), "v"(a2) : "memory");
    __builtin_amdgcn_sched_barrier(0);
    const u32x4 o = (u32x4){r1.x, r1.y, r2.x, r2.y}; return __builtin_bit_cast(bf16x8, o);
}
static_assert(SD_END <= LDS_MISC, "ssd lds");
template <int PASS>
__device__ __forceinline__ void mx_ssd(const Ctx& X, int l, int unit) {
    const int tid = X.tid, lane = X.lane, w = X.wave, fr = lane & 15, fq = lane >> 4;
    const int b = unit >> 6, c = unit & 63; const int r0 = unit * 128;
    const bf16_t* pj = X.proj();
    LAS bf16_t* Cm = (LAS bf16_t*)(X.lds + SD_CM); LAS bf16_t* Bm = (LAS bf16_t*)(X.lds + SD_BM);
    LAS bf16_t* Mm = (LAS bf16_t*)(X.lds + SD_MM);
    LAS float* dtv = (LAS float*)(X.lds + SD_DT); LAS float* acm = (LAS float*)(X.lds + SD_AC);
    const float* convw = X.in(I_CONVW) + (size_t)l * 4 * 512; const float* convb = X.in(I_CONVB) + (size_t)l * 512;
    float* sst = (float*)(X.ws + WS_SSDST); float* atot = (float*)(X.ws + WS_ATOT);
    for (int g = 0; g < 2; ++g) {
        if (tid < 256) { const int j = tid >> 7, rl = tid & 127, h = 2 * g + j;
            const float raw = bf2f(pj[(size_t)(r0 + rl) * PJ + C_DT + h]) + X.in(I_DTBIAS)[l * 4 + h];
            const float dt = softplusf_(raw); dtv[j * 128 + rl] = dt; acm[j * 128 + rl] = -expf(X.in(I_ALOG)[l * 4 + h]) * dt; }
        __syncthreads();
        if (tid < 256) {
            float cum = acm[tid];
#pragma unroll
            for (int o = 1; o < 64; o <<= 1) { const float up = __shfl_up(cum, o); if (lane >= o) cum += up; }
            if (lane == 63) dtv[256 + w] = cum;
            __builtin_amdgcn_fence(__ATOMIC_RELEASE, "workgroup");
            acm[tid] = cum; }
        __syncthreads();
        if (tid < 256 && (w & 1)) acm[tid] += dtv[256 + w - 1];
        __syncthreads();
        if (PASS == 1 && tid < 2) atot[(b * 64 + c) * 32 + 2 * g + tid] = acm[tid * 128 + 127];
        if (!(X.dbg & 16)) { const int cg = tid & 31, rb = tid >> 5; constexpr int NCG = (PASS == 1) ? 24 : 32;
          if (cg < NCG) {
            const int chn = (cg < 16) ? g * 128 + cg * 8 : (cg < 24) ? 256 + g * 64 + (cg - 16) * 8 : 384 + g * 64 + (cg - 24) * 8;
            u32x4 xr[11];
#pragma unroll
            for (int k = 0; k < 11; ++k) { const int sq = c * 128 + rb * 8 + k - 3; xr[k] = (u32x4){0u, 0u, 0u, 0u}; if (sq >= 0) xr[k] = *(const u32x4*)(pj + (size_t)(b * SEQ + sq) * PJ + C_XBC + chn); }
            f32x4 w0[4], w1[4];
#pragma unroll
            for (int k = 0; k < 4; ++k) { w0[k] = *(const f32x4*)(convw + k * 512 + chn); w1[k] = *(const f32x4*)(convw + k * 512 + chn + 4); }
            const f32x4 cb0 = *(const f32x4*)(convb + chn), cb1 = *(const f32x4*)(convb + chn + 4);
            LAS bf16_t* dst = (cg < 16) ? (LAS bf16_t*)(X.lds + ((cg >> 3) ? SD_XT1 : SD_XT0)) + (cg & 7) * 8 : (cg < 24) ? Bm + (cg - 16) * 8 : Cm + (cg - 24) * 8;
            const int jh = (cg >> 3) & 1;
#pragma unroll
            for (int r = 0; r < 8; ++r) { const int rl = rb * 8 + r;
                f32x4 s0 = cb0, s1 = cb1;
#pragma unroll
                for (int k = 0; k < 4; ++k) { const u32x4 xv = xr[r + k];
                    s0[0] += w0[k][0] * bflo(xv.x); s0[1] += w0[k][1] * bfhi(xv.x); s0[2] += w0[k][2] * bflo(xv.y); s0[3] += w0[k][3] * bfhi(xv.y);
                    s1[0] += w1[k][0] * bflo(xv.z); s1[1] += w1[k][1] * bfhi(xv.z); s1[2] += w1[k][2] * bflo(xv.w); s1[3] += w1[k][3] * bfhi(xv.w); }
                float sc = 1.0f; if (PASS == 1 && cg < 16) sc = __expf(acm[jh * 128 + 127] - acm[jh * 128 + rl]) * dtv[jh * 128 + rl];
                u32x4 o; o.x = pk2(siluf_(s0[0]) * sc, siluf_(s0[1]) * sc); o.y = pk2(siluf_(s0[2]) * sc, siluf_(s0[3]) * sc); o.z = pk2(siluf_(s1[0]) * sc, siluf_(s1[1]) * sc); o.w = pk2(siluf_(s1[2]) * sc, siluf_(s1[3]) * sc);
                *(LAS u32x4*)(dst + rl * 72) = o; }
          } }
        if (PASS == 3) {
            const bf16_t* sin = (const bf16_t*)(X.ws + WS_SSDSIN) + (size_t)((b * 64 + c) * 4 + 2 * g) * 4096 + tid * 8;
            const int p = tid >> 3, n0 = (tid & 7) * 8;
            *(LAS u32x4*)((LAS bf16_t*)(X.lds + SD_SIN0) + p * 72 + n0) = *(const u32x4*)sin;
            *(LAS u32x4*)((LAS bf16_t*)(X.lds + SD_SIN1) + p * 72 + n0) = *(const u32x4*)(sin + 4096);
        }
        __syncthreads();
        if (PASS == 1) {
            const int j = w >> 2, pt = w & 3; const LAS bf16_t* Xr = (const LAS bf16_t*)(X.lds + (j ? SD_XT1 : SD_XT0));
            f32x4 acc[4];
#pragma unroll
            for (int nt = 0; nt < 4; ++nt) acc[nt] = (f32x4){0.f, 0.f, 0.f, 0.f};
#pragma unroll
            for (int ks = 0; ks < 4; ++ks) { const bf16x8 xf = tr_frag8(Xr, 72, ks * 32, pt * 16, lane);
#pragma unroll
                for (int nt = 0; nt < 4; ++nt) { const bf16x8 bf = tr_frag8(Bm, 72, ks * 32, nt * 16, lane); acc[nt] = mfma16(xf, bf, acc[nt]); } }
            float* sp = sst + (size_t)((b * 64 + c) * 4 + 2 * g + j) * 4096;
#pragma unroll
            for (int nt = 0; nt < 4; ++nt)
#pragma unroll
                for (int i = 0; i < 4; ++i) sp[(pt * 16 + 4 * fq + i) * 64 + nt * 16 + fr] = acc[nt][i];
        } else {
            const int lrow = w * 16 + fr;
            float yv[2][4][4];
#pragma unroll
            for (int j = 0; j < 2; ++j) {
                const LAS bf16_t* Xr = (const LAS bf16_t*)(X.lds + (j ? SD_XT1 : SD_XT0)); const LAS bf16_t* Sin = (const LAS bf16_t*)(X.lds + (j ? SD_SIN1 : SD_SIN0));
                const float al = acm[j * 128 + lrow];
                const bf16x8 cf0 = *(const LAS bf16x8*)(Cm + lrow * 72 + 8 * fq), cf1 = *(const LAS bf16x8*)(Cm + lrow * 72 + 32 + 8 * fq);
                const int stmax = w | 1;
                for (int st = 0; st <= stmax; ++st) {
                    f32x4 ag = (f32x4){0.f, 0.f, 0.f, 0.f};
                    if (st <= w) { const bf16x8 b0 = *(const LAS bf16x8*)(Bm + (st * 16 + fr) * 72 + 8 * fq), b1 = *(const LAS bf16x8*)(Bm + (st * 16 + fr) * 72 + 32 + 8 * fq);
                        ag = mfma16(b0, cf0, ag); ag = mfma16(b1, cf1, ag); }
                    float mv[4];
#pragma unroll
                    for (int i = 0; i < 4; ++i) { const int s = st * 16 + 4 * fq + i; mv[i] = (s <= lrow) ? ag[i] * __expf(al - acm[j * 128 + s]) * dtv[j * 128 + s] : 0.f; }
                    u32x2 o; o.x = pk2(mv[0], mv[1]); o.y = pk2(mv[2], mv[3]); *(LAS u32x2*)(Mm + lrow * 136 + st * 16 + 4 * fq) = o;
                }
                const float eal = __expf(al); const float dsk = X.in(I_SSDD)[l * 4 + 2 * g + j];
#pragma unroll
                for (int pt = 0; pt < 4; ++pt) {
                    f32x4 ad = (f32x4){0.f, 0.f, 0.f, 0.f}, ao = ad;
                    for (int ks = 0; ks <= (w >> 1); ++ks) { const bf16x8 xf = tr_frag8(Xr, 72, ks * 32, pt * 16, lane); const bf16x8 mf = *(const LAS bf16x8*)(Mm + lrow * 136 + ks * 32 + 8 * fq); ad = mfma16(xf, mf, ad); }
                    { const bf16x8 s0 = *(const LAS bf16x8*)(Sin + (pt * 16 + fr) * 72 + 8 * fq), s1 = *(const LAS bf16x8*)(Sin + (pt * 16 + fr) * 72 + 32 + 8 * fq); ao = mfma16(s0, cf0, ao); ao = mfma16(s1, cf1, ao); }
                    const int h = 2 * g + j; const u32x2 zv = *(const u32x2*)(pj + (size_t)(r0 + lrow) * PJ + C_Z + h * 64 + pt * 16 + 4 * fq);
                    const float z4[4] = {bflo(zv.x), bfhi(zv.x), bflo(zv.y), bfhi(zv.y)};
#pragma unroll
                    for (int i = 0; i < 4; ++i) { const float xs = bf2f(Xr[lrow * 72 + pt * 16 + 4 * fq + i]); yv[j][pt][i] = (ad[i] + eal * ao[i] + dsk * xs) * siluf_(z4[i]); }
                }
            }
            float ss = 0.f;
#pragma unroll
            for (int j = 0; j < 2; ++j)
#pragma unroll
                for (int pt = 0; pt < 4; ++pt)
#pragma unroll
                    for (int i = 0; i < 4; ++i) ss += yv[j][pt][i] * yv[j][pt][i];
            ss += __shfl_xor(ss, 16); ss += __shfl_xor(ss, 32);
            const float rs = rsqrtf(ss * (1.0f / 128.0f) + RMS_EPS);
            const float* ng = X.in(I_SSDNG) + l * 256 + g * 128; bf16_t* yd = X.ybuf() + (size_t)3 * M * 256;
#pragma unroll
            for (int j = 0; j < 2; ++j)
#pragma unroll
                for (int pt = 0; pt < 4; ++pt) { const int cc = j * 64 + pt * 16 + 4 * fq; const f32x4 gv = *(const f32x4*)(ng + cc);
                    u32x2 o; o.x = pk2(yv[j][pt][0] * rs * gv[0], yv[j][pt][1] * rs * gv[1]); o.y = pk2(yv[j][pt][2] * rs * gv[2], yv[j][pt][3] * rs * gv[3]);
                    *(u32x2*)(yd + (size_t)(r0 + lrow) * 256 + g * 128 + cc) = o; }
        }
        __syncthreads();
    }
}

__device__ __forceinline__ void mx_s5_carry(const Ctx& X) {
    const float* st = (const float*)(X.ws + WS_S5ST); float* hin = (float*)(X.ws + WS_S5HIN); const float* sa = (const float*)(X.ws + WS_S5A);
    for (int i = X.c * 32 + (X.tid - 256); X.tid >= 256 && X.tid < 288 && i < NB * 16 * 64; i += X.G * 32) {
        const int p = i & 63, g = (i >> 6) & 15, b = i >> 10;
        float pr = sa[(g * 64 + p) * 2], pi = sa[(g * 64 + p) * 2 + 1];
#pragma unroll
        for (int q = 0; q < 8; ++q) { const float nr = pr * pr - pi * pi, ni = 2.f * pr * pi; pr = nr; pi = ni; }
        float hr = 0.f, hi = 0.f; const size_t base = (size_t)((b * 16 + g) * 32) * 128 + p;
#pragma unroll 8
        for (int ch = 0; ch < 32; ++ch) { hin[base + ch * 128] = hr; hin[base + ch * 128 + 64] = hi;
            const float sr = st[base + ch * 128], si = st[base + ch * 128 + 64]; const float nr = pr * hr - pi * hi + sr, ni = pr * hi + pi * hr + si; hr = nr; hi = ni; }
    }
}

__device__ __forceinline__ void mx_ssd_carry(const Ctx& X) {
    const float* sst = (const float*)(X.ws + WS_SSDST); const float* atot = (const float*)(X.ws + WS_ATOT); bf16_t* sin = (bf16_t*)(X.ws + WS_SSDSIN);
    for (int i = X.c * 256 + X.tid; X.tid < 256 && i < NB * 4 * 4096; i += X.G * 256) {
        const int e1 = i & 4095, h = (i >> 12) & 3, b = i >> 14;
        float S = 0.f;
#pragma unroll 16
        for (int c = 0; c < 64; ++c) { const size_t o = (size_t)((b * 64 + c) * 4 + h) * 4096 + e1;
            sin[o] = (bf16_t)f2bf(S);
            S = S * __expf(atot[(b * 64 + c) * 32 + h]) + sst[o]; }
    }
}

__device__ __forceinline__ unsigned ord16(float s) { const _Float16 hf = (_Float16)s; const unsigned bits = (unsigned)__builtin_bit_cast(unsigned short, hf); return bits ^ ((bits & 0x8000u) ? 0xFFFFu : 0x8000u); }
__device__ __forceinline__ int cnt_ge8(const u32x4 v, unsigned c) {
    int n = 0;
    n += ((v.x & 0xFFFFu) >= c) + ((v.x >> 16) >= c); n += ((v.y & 0xFFFFu) >= c) + ((v.y >> 16) >= c);
    n += ((v.z & 0xFFFFu) >= c) + ((v.z >> 16) >= c); n += ((v.w & 0xFFFFu) >= c) + ((v.w >> 16) >= c);
    return n;
}
template <int CTRL> __device__ __forceinline__ float dpp_f(float v) { return __builtin_bit_cast(float, __builtin_amdgcn_update_dpp(0, __builtin_bit_cast(int, v), CTRL, 0xF, 0xF, true)); }
__device__ __forceinline__ void mx_dsa(const Ctx& X, int b, int t0) {
    const int tid = X.tid, lane = X.lane, w = X.wave, fr = lane & 15, fq = lane >> 4;
    const bf16_t* pj = X.proj() + (size_t)b * SEQ * PJ; const unsigned rb = 0u;
    const bf16_t* ki2 = (const bf16_t*)(X.ws + WS_KI2) + (size_t)b * SEQ * 64; const bf16_t* k2 = (const bf16_t*)(X.ws + WS_K2) + (size_t)b * SEQ * 64; const bf16_t* v2 = (const bf16_t*)(X.ws + WS_V2) + (size_t)b * SEQ * 64;
    LAS unsigned short* sc = (LAS unsigned short*)X.lds;
    const int nk = t0 + 8, nkt = (nk + 15) >> 4;
    LAS unsigned* hist = (LAS unsigned*)(X.lds + 131072 + 8192);
    for (int i = tid; i < 8 * 4 * 128 / 4; i += 512) *(LAS u32x4*)(hist + 4 * i) = (u32x4){0u, 0u, 0u, 0u};
    bf16x8 qf[2][2]; f32x4 wq[2];
#pragma unroll
    for (int ct = 0; ct < 2; ++ct) { const int q = 4 * ct + (fr >> 2), hh = fr & 3; const bf16_t* qp = pj + (unsigned)(t0 + q) * (unsigned)PJ;
        qf[ct][0] = *(const bf16x8*)(qp + C_QI + hh * 64 + 8 * fq); qf[ct][1] = *(const bf16x8*)(qp + C_QI + hh * 64 + 32 + 8 * fq);
        const u32x2 wv = *(const u32x2*)(pj + (unsigned)(t0 + 4 * ct + fq) * (unsigned)PJ + C_WI);
        wq[ct] = (f32x4){bflo(wv.x) * 0.0625f, bfhi(wv.x) * 0.0625f, bflo(wv.y) * 0.0625f, bfhi(wv.y) * 0.0625f}; }
    const int ntw = (nkt > w) ? ((nkt - w + 7) >> 3) : 0;
    __syncthreads();
#define DSA_LOAD4(KF, I0) do { _Pragma("unroll") for (int j = 0; j < 4; ++j) { int kt_ = w + 8 * ((I0) + j); kt_ = kt_ < nkt ? kt_ : nkt - 1; \
        const unsigned ko_ = (unsigned)kt_ * 1024u + (unsigned)lane * 8u; KF[j][0] = *(const bf16x8*)(ki2 + ko_); KF[j][1] = *(const bf16x8*)(ki2 + ko_ + 512u); } } while (0)
#define DSA_COMP4(KF, I0) do { if (DSA_PM == 2 && rs1 > 0) { _Pragma("unroll") for (int j = 0; j < 4; ++j) dummy_ ^= KF[j][0][0] ^ KF[j][1][3]; break; } \
      _Pragma("unroll") for (int jh = 0; jh < 4; jh += 2) { f32x4 ac_[2][2]; \
        _Pragma("unroll") for (int j = 0; j < 2; ++j) _Pragma("unroll") for (int ct = 0; ct < 2; ++ct) { \
            ac_[j][ct] = mfma16(qf[ct][0], KF[jh + j][0], (f32x4){0.f, 0.f, 0.f, 0.f}); ac_[j][ct] = mfma16(qf[ct][1], KF[jh + j][1], ac_[j][ct]); } \
        _Pragma("unroll") for (int j = 0; j < 2; ++j) { if ((I0) + jh + j < ntw) { const int kt_ = w + 8 * ((I0) + jh + j); const bool full_ = (kt_ * 16 + 15 <= t0); const int key_ = kt_ * 16 + fr; \
        _Pragma("unroll") for (int ct = 0; ct < 2; ++ct) { const f32x4 a_ = ac_[j][ct]; \
            float tt_ = __builtin_fmaf(__builtin_amdgcn_fmed3f(a_[0], 0.f, 3.0e38f), wq[ct][0], 0.0f); tt_ = __builtin_fmaf(__builtin_amdgcn_fmed3f(a_[1], 0.f, 3.0e38f), wq[ct][1], tt_); \
            tt_ = __builtin_fmaf(__builtin_amdgcn_fmed3f(a_[2], 0.f, 3.0e38f), wq[ct][2], tt_); tt_ = __builtin_fmaf(__builtin_amdgcn_fmed3f(a_[3], 0.f, 3.0e38f), wq[ct][3], tt_); \
            const int q_ = 4 * ct + fq; unsigned kk_ = ord16(tt_ + 0.0f); \
            if (!full_) kk_ = (key_ <= t0 + q_) ? kk_ : 0u; \
            if (DSA_PM == 1 && rs1 > 0) dummy_ ^= (short)kk_; else sc[q_ * 8192 + key_] = (unsigned short)kk_; \
            if ((R_S1 == 1 || rs1 == 0) && (full_ || kk_ != 0u)) __hip_atomic_fetch_add(hist + (q_ * 4 + (fr & 3)) * 128 + (kk_ >> 9), (kk_ & 0x100u) ? 65536u : 1u, __ATOMIC_RELAXED, __HIP_MEMORY_SCOPE_WORKGROUP); } } } } } while (0)
    short dummy_ = 0;
    _Pragma("nounroll") for (int rs1 = 0; rs1 < (((DSA_SKIP | X.dbg) & 1) ? 0 : R_S1); ++rs1)
    { bf16x8 ka[4][2], kb[4][2];
      if (ntw > 0) { DSA_LOAD4(ka, 0);
#pragma nounroll
        for (int i0 = 0; i0 < ntw; i0 += 8) { DSA_LOAD4(kb, i0 + 4); DSA_COMP4(ka, i0); DSA_LOAD4(ka, i0 + 8); DSA_COMP4(kb, i0 + 4); } } }
#undef DSA_LOAD4
#undef DSA_COMP4
    if (dummy_ == (short)0x1234 && t0 == 123457) sc[0] = 1;
    { const int z0 = nkt * 16, z1 = ((nk + 511) >> 9) << 9;
        for (int i = z0 + tid; i < z1; i += 512) {
#pragma unroll
            for (int q = 0; q < 8; ++q) sc[q * 8192 + i] = 0; } }
    __syncthreads();
    const int t = t0 + w, nv = t + 1;
    LAS unsigned short* row = sc + w * 8192;
    LAS unsigned short* list = (LAS unsigned short*)(X.lds + 131072 + w * 512);
    const int nsel = nv < 256 ? nv : 256;
    if (((DSA_SKIP | X.dbg) & 2) || nv <= 256) { for (int n = lane; n < 256; n += 64) list[n] = (unsigned short)n; }
    else {
        const int nit = (nv + 511) >> 9;
        LAS unsigned* H = hist + w * 512;
        int T1, above1;
        { u32x4 h4 = (u32x4){0u, 0u, 0u, 0u};
#pragma unroll
          for (int c4 = 0; c4 < 4; ++c4) { const u32x2 pw = *(const LAS u32x2*)(H + c4 * 128 + 2 * lane); h4.x += pw.x & 0xFFFFu; h4.y += pw.x >> 16; h4.z += pw.y & 0xFFFFu; h4.w += pw.y >> 16; }
          const int sl = (int)(h4.x + h4.y + h4.z + h4.w);
          int suf = sl;
#pragma unroll
          for (int o = 1; o < 64; o <<= 1) { const int dn = __shfl_down(suf, o); if (lane + o < 64) suf += dn; }
          const unsigned long long bm = __ballot(suf >= 256); const int L = 63 - __builtin_clzll(bm);
          const int hx = __shfl((int)h4.x, L), hy = __shfl((int)h4.y, L), hz = __shfl((int)h4.z, L), hw = __shfl((int)h4.w, L);
          const int sufn = __shfl(suf, L) - (hx + hy + hz + hw);
          int cb = sufn; T1 = 4 * L + 3; above1 = cb;
          if (cb + hw >= 256) { T1 = 4 * L + 3; above1 = cb; } else { cb += hw; if (cb + hz >= 256) { T1 = 4 * L + 2; above1 = cb; } else { cb += hz; if (cb + hy >= 256) { T1 = 4 * L + 1; above1 = cb; } else { cb += hy; T1 = 4 * L; above1 = cb; } } } }
        _Pragma("nounroll") for (int rs2 = 0; rs2 < R_S2; ++rs2) {
        *(LAS u32x4*)(H + 4 * lane) = (u32x4){0u, 0u, 0u, 0u};
        for (int it = 0; it < nit; ++it) { const u32x4 v = *(const LAS u32x4*)(row + (it * 64 + lane) * 8);
            const unsigned e[8] = {v.x & 0xFFFFu, v.x >> 16, v.y & 0xFFFFu, v.y >> 16, v.z & 0xFFFFu, v.z >> 16, v.w & 0xFFFFu, v.w >> 16};
#pragma unroll
            for (int j = 0; j < 8; ++j) if ((int)(e[j] >> 8) == T1) __hip_atomic_fetch_add(H + (e[j] & 255u), 1u, __ATOMIC_RELAXED, __HIP_MEMORY_SCOPE_WORKGROUP); }
        unsigned thr; int cgt, cge;
        { const u32x4 h4 = *(const LAS u32x4*)(H + 4 * lane); const int sl = (int)(h4.x + h4.y + h4.z + h4.w);
          int suf = sl;
#pragma unroll
          for (int o = 1; o < 64; o <<= 1) { const int dn = __shfl_down(suf, o); if (lane + o < 64) suf += dn; }
          const int need = 256 - above1;
          const unsigned long long bm = __ballot(suf >= need); const int L = 63 - __builtin_clzll(bm);
          const int hx = __shfl((int)h4.x, L), hy = __shfl((int)h4.y, L), hz = __shfl((int)h4.z, L), hw = __shfl((int)h4.w, L);
          int cb = __shfl(suf, L) - (hx + hy + hz + hw); int T2, hT;
          if (cb + hw >= need) { T2 = 4 * L + 3; hT = hw; } else { cb += hw; if (cb + hz >= need) { T2 = 4 * L + 2; hT = hz; } else { cb += hz; if (cb + hy >= need) { T2 = 4 * L + 1; hT = hy; } else { cb += hy; T2 = 4 * L; hT = hx; } } }
          thr = ((unsigned)T1 << 8) | (unsigned)T2; cgt = above1 + cb; cge = cgt + hT; }
        const bool exact = (cge == 256);
        const int r = 256 - cgt;
        const unsigned cmin = exact ? thr : thr + 1u;
        const unsigned long long lt_mask = (1ull << lane) - 1ull; int bcnt = 0;
        for (int it = 0; it < nit; ++it) { const u32x4 v = *(const LAS u32x4*)(row + (it * 64 + lane) * 8); const int base = (it * 64 + lane) * 8;
            const unsigned e[8] = {v.x & 0xFFFFu, v.x >> 16, v.y & 0xFFFFu, v.y >> 16, v.z & 0xFFFFu, v.z >> 16, v.w & 0xFFFFu, v.w >> 16};
#pragma unroll
            for (int j = 0; j < 8; ++j) { const bool sl = e[j] >= cmin; const unsigned long long bm = __ballot(sl);
                if (bm != 0ull) { if (sl) list[(bcnt + __popcll(bm & lt_mask)) & 255] = (unsigned short)(base + j); bcnt += __popcll(bm); } } }
        if (!exact) {
            int taken = 0;
            for (int it = 0; it < nit && taken < r; ++it) { const u32x4 v = *(const LAS u32x4*)(row + (it * 64 + lane) * 8); const int base = (it * 64 + lane) * 8;
                const unsigned e[8] = {v.x & 0xFFFFu, v.x >> 16, v.y & 0xFFFFu, v.y >> 16, v.z & 0xFFFFu, v.z >> 16, v.w & 0xFFFFu, v.w >> 16};
                int mcount = 0;
#pragma unroll
                for (int j = 0; j < 8; ++j) mcount += (e[j] == thr);
                if (__ballot(mcount != 0) == 0ull) continue;
                int incl = mcount;
#pragma unroll
                for (int o = 1; o < 64; o <<= 1) { const int up = __shfl_up(incl, o); if (lane >= o) incl += up; }
                const int total = __shfl(incl, 63); int rk = taken + incl - mcount;
#pragma unroll
                for (int j = 0; j < 8; ++j) if (e[j] == thr) { if (rk < r) list[(cgt + rk) & 255] = (unsigned short)(base + j); ++rk; }
                taken += total; }
        }
        }
    }
    __builtin_amdgcn_fence(__ATOMIC_RELEASE, "workgroup"); __builtin_amdgcn_wave_barrier();
    const bf16_t* qrow = pj + (unsigned)t * (unsigned)PJ;
    bf16x8 qb0 = (bf16x8){0, 0, 0, 0, 0, 0, 0, 0}, qb1 = qb0;
    if (fr < 4) { qb0 = *(const bf16x8*)(qrow + C_Q + fr * 64 + 8 * fq); qb1 = *(const bf16x8*)(qrow + C_Q + fr * 64 + 32 + 8 * fq); }
    LAS float* Pb = (LAS float*)row;
    LAS float* pinv = (LAS float*)(X.lds + 131072 + 4096 + 256 + w * 16);
    _Pragma("nounroll") for (int rs3 = 0; rs3 < (((DSA_SKIP | X.dbg) & 4) ? 0 : R_S3); ++rs3) {
    { LAS unsigned char* kbuf = (LAS unsigned char*)row + 4096;
      const int drow = lane >> 3, dchk = (lane & 7) ^ (drow & 7);
#define QK_DMA(G) do { _Pragma("unroll") for (int i_ = 0; i_ < 4; ++i_) { const unsigned ko_ = (unsigned)list[(G) * 32 + i_ * 8 + drow] * 64u + (unsigned)(dchk * 8); \
        __builtin_amdgcn_global_load_lds((const unsigned*)(k2 + ko_), (LAS unsigned*)(kbuf + ((G) % 3) * 4096 + i_ * 1024), 16, 0, 0); } } while (0)
#define QK_COMP(G) do { _Pragma("unroll") for (int j = 0; j < 2; ++j) { const LAS unsigned char* tb_ = kbuf + ((G) % 3) * 4096 + j * 2048 + fr * 128; \
        const bf16x8 k0_ = *(const LAS bf16x8*)(tb_ + ((fq ^ (fr & 7)) * 16)), k1_ = *(const LAS bf16x8*)(tb_ + (((4 + fq) ^ (fr & 7)) * 16)); \
        f32x4 a_ = mfma16(k0_, qb0, (f32x4){0.f, 0.f, 0.f, 0.f}); a_ = mfma16(k1_, qb1, a_); \
        if (fr < 4) { _Pragma("unroll") for (int i = 0; i < 4; ++i) { const int nn_ = ((G) * 2 + j) * 16 + 4 * fq + i; Pb[nn_ * 4 + fr] = (nn_ < nsel) ? a_[i] * 0.125f : -3.0e38f; } } } } while (0)
      asm volatile("s_waitcnt vmcnt(0)" ::: "memory");
      QK_DMA(0); QK_DMA(1);
      asm volatile("s_waitcnt vmcnt(4)" ::: "memory"); QK_COMP(0); QK_DMA(2);
      asm volatile("s_waitcnt vmcnt(4)" ::: "memory"); QK_COMP(1); asm volatile("s_waitcnt lgkmcnt(0)" ::: "memory"); QK_DMA(3);
      asm volatile("s_waitcnt vmcnt(4)" ::: "memory"); QK_COMP(2); asm volatile("s_waitcnt lgkmcnt(0)" ::: "memory"); QK_DMA(4);
      asm volatile("s_waitcnt vmcnt(4)" ::: "memory"); QK_COMP(3); asm volatile("s_waitcnt lgkmcnt(0)" ::: "memory"); QK_DMA(5);
      asm volatile("s_waitcnt vmcnt(4)" ::: "memory"); QK_COMP(4); asm volatile("s_waitcnt lgkmcnt(0)" ::: "memory"); QK_DMA(6);
      asm volatile("s_waitcnt vmcnt(4)" ::: "memory"); QK_COMP(5); asm volatile("s_waitcnt lgkmcnt(0)" ::: "memory"); QK_DMA(7);
      asm volatile("s_waitcnt vmcnt(4)" ::: "memory"); QK_COMP(6);
      asm volatile("s_waitcnt vmcnt(0)" ::: "memory"); QK_COMP(7);
#undef QK_DMA
#undef QK_COMP
    }
    __builtin_amdgcn_fence(__ATOMIC_RELEASE, "workgroup"); __builtin_amdgcn_wave_barrier();
    { const int hd = lane & 3, nb0 = lane >> 2;
        float v16[16]; float mx = -3.0e38f;
#pragma unroll
        for (int j = 0; j < 16; ++j) { v16[j] = Pb[(nb0 + 16 * j) * 4 + hd]; mx = fmaxf(mx, v16[j]); }
        mx = fmaxf(mx, __shfl_xor(mx, 4)); mx = fmaxf(mx, __shfl_xor(mx, 8)); mx = fmaxf(mx, __shfl_xor(mx, 16)); mx = fmaxf(mx, __shfl_xor(mx, 32));
        float sm = 0.f;
#pragma unroll
        for (int j = 0; j < 16; ++j) { const float p = (v16[j] > -1.0e38f) ? __expf(v16[j] - mx) : 0.f; sm += p; Pb[(nb0 + 16 * j) * 4 + hd] = p; }
        sm += __shfl_xor(sm, 4); sm += __shfl_xor(sm, 8); sm += __shfl_xor(sm, 16); sm += __shfl_xor(sm, 32);
        if (lane < 4) pinv[lane] = 1.0f / sm; }
    __builtin_amdgcn_fence(__ATOMIC_RELEASE, "workgroup"); __builtin_amdgcn_wave_barrier();
    f32x2 o2[4][2];
#pragma unroll
    for (int h = 0; h < 4; ++h) { o2[h][0] = (f32x2){0.f, 0.f}; o2[h][1] = (f32x2){0.f, 0.f}; }
    const int d4 = fr * 4;
#define PV_LOAD(VV, B) do { _Pragma("unroll") for (int j = 0; j < 16; ++j) { const unsigned vo_ = (unsigned)list[(B) * 64 + 4 * j + fq] * 64u + (unsigned)d4; VV[j] = *(const u32x2*)(v2 + vo_); } } while (0)
#define PV_COMP(VV, B) do { _Pragma("unroll") for (int j = 0; j < 16; ++j) { const f32x4 p4_ = *(const LAS f32x4*)(Pb + ((B) * 64 + 4 * j + fq) * 4); \
        const f32x2 va_ = (f32x2){bflo(VV[j].x), bfhi(VV[j].x)}, vb_ = (f32x2){bflo(VV[j].y), bfhi(VV[j].y)}; \
        _Pragma("unroll") for (int h = 0; h < 4; ++h) { const f32x2 pp_ = (f32x2){p4_[h], p4_[h]}; o2[h][0] = __builtin_elementwise_fma(va_, pp_, o2[h][0]); o2[h][1] = __builtin_elementwise_fma(vb_, pp_, o2[h][1]); } } } while (0)
    { u32x2 va[16], vb[16]; PV_LOAD(va, 0); PV_LOAD(vb, 1); PV_COMP(va, 0); PV_LOAD(va, 2); PV_COMP(vb, 1); PV_LOAD(vb, 3); PV_COMP(va, 2); PV_COMP(vb, 3); }
#undef PV_LOAD
#undef PV_COMP
    float o4[4][4];
#pragma unroll
    for (int h = 0; h < 4; ++h)
#pragma unroll
        for (int dd = 0; dd < 4; ++dd) { float v = o2[h][dd >> 1][dd & 1]; v += __shfl_xor(v, 16); v += __shfl_xor(v, 32); o4[h][dd] = v; }
    { const int h = fq; const float iv = pinv[h];
        float r4[4];
#pragma unroll
        for (int dd = 0; dd < 4; ++dd) r4[dd] = ((h == 0) ? o4[0][dd] : (h == 1) ? o4[1][dd] : (h == 2) ? o4[2][dd] : o4[3][dd]) * iv;
        u32x2 o; o.x = pk2(r4[0], r4[1]); o.y = pk2(r4[2], r4[3]);
        *(u32x2*)(X.ybuf() + (size_t)1 * M * 256 + ((size_t)b * SEQ + t) * 256 + h * 64 + d4) = o; }
    __builtin_amdgcn_fence(__ATOMIC_RELEASE, "workgroup"); __builtin_amdgcn_wave_barrier(); }
    __syncthreads();
}

constexpr int LR_HH = 0, LR_HL = 33280, LR_PART = 66560, LR_LG = 82944, LR_CNT = 84992, LR_PITCH = 1032;
__device__ __forceinline__ void ph_ln1_router(const Ctx& X, int l) {
    const int lane = X.lane, w = X.wave, tid = X.tid, fr = lane & 15, fq = lane >> 4;
    LAS bf16_t* Hh = (LAS bf16_t*)(X.lds + LR_HH); LAS bf16_t* Hl = (LAS bf16_t*)(X.lds + LR_HL);
    LAS float* part = (LAS float*)(X.lds + LR_PART);
    LAS float* lgt = (LAS float*)(X.lds + LR_LG);
    LAS unsigned* wgcnt = (LAS unsigned*)(X.lds + LR_CNT);
    if (tid < 32) wgcnt[tid] = 0u;
    bf16x8 Ahi[2][4], Alo[2][4];
    { const bf16_t* rf = (const bf16_t*)(X.ws + WS_RFR);
#pragma unroll
      for (int rt = 0; rt < 2; ++rt)
#pragma unroll
          for (int q = 0; q < 4; ++q) { const size_t o = ((size_t)(rt * 32 + 4 * w + q) * 64 + lane) * 8; Ahi[rt][q] = *(const bf16x8*)(rf + o); Alo[rt][q] = *(const bf16x8*)(rf + 32768 + o); } }
    float* xo = X.a->out; bf16_t* hb = X.hbuf(); float* xw = (X.dbg & 8) ? (float*)(X.ws + WS_ACT) : xo; const bf16_t* v16 = (const bf16_t*)(X.ws + WS_V16);
    const int tok0 = X.c * 128, b = tok0 >> 13;
    const float* mv = X.modv(l, 1) + b * 3072;
    const float* lg = X.in(I_LN1G) + l * D; const float* lb = X.in(I_LN1B) + l * D;
    const int e = lane & 31;
    const float rbias = X.in(I_RB)[l * NEXP + e];
    unsigned* pinfo = (unsigned*)(X.ws + WS_PINFO); float* pgate = (float*)(X.ws + WS_PGATE);
    __syncthreads();
    u32x2 raw[2][4];
#pragma unroll
    for (int jj = 0; jj < 2; ++jj)
#pragma unroll
        for (int j = 0; j < 4; ++j) raw[jj][j] = *(const u32x2*)(v16 + (size_t)(tok0 + 2 * w + jj) * D + 4 * lane + 256 * j);
    for (int pass = 0; pass < 8; ++pass) {
        f32x4 vv[2][4];
#pragma unroll
        for (int jj = 0; jj < 2; ++jj)
#pragma unroll
            for (int j = 0; j < 4; ++j) { const u32x2 q2 = raw[jj][j]; vv[jj][j] = (f32x4){bflo(q2.x), bfhi(q2.x), bflo(q2.y), bfhi(q2.y)}; }
        if (pass + 1 < 8) {
#pragma unroll
            for (int jj = 0; jj < 2; ++jj)
#pragma unroll
                for (int j = 0; j < 4; ++j) raw[jj][j] = *(const u32x2*)(v16 + (size_t)(tok0 + (pass + 1) * 16 + 2 * w + jj) * D + 4 * lane + 256 * j); }
#pragma unroll
        for (int jj = 0; jj < 2; ++jj) {
            const int r = 2 * w + jj, tok = tok0 + pass * 16 + r;
            f32x4 v[4]; float s = 0.f;
#pragma unroll
            for (int j = 0; j < 4; ++j) { v[j] = vv[jj][j]; s += (v[j][0] + v[j][1]) + (v[j][2] + v[j][3]); }
            const float mean = wave_sum(s) * (1.0f / D); float q = 0.f;
#pragma unroll
            for (int j = 0; j < 4; ++j) { v[j] = v[j] - mean; q += (v[j][0] * v[j][0] + v[j][1] * v[j][1]) + (v[j][2] * v[j][2] + v[j][3] * v[j][3]); }
            const float rstd = rsqrtf(wave_sum(q) * (1.0f / D) + LN_EPS);
#pragma unroll
            for (int j = 0; j < 4; ++j) { const int col = 4 * lane + 256 * j;
                const f32x4 x1 = v[j] * rstd * *(const f32x4*)(lg + col) + *(const f32x4*)(lb + col);
                *(f32x4*)(xw + (size_t)tok * D + col) = x1 * DN_ALPHA;
                const f32x4 hv = x1 * (*(const f32x4*)(mv + 1024 + col) + 1.0f) + *(const f32x4*)(mv + col);
                const unsigned h0 = f2bf(hv[0]), h1 = f2bf(hv[1]), h2 = f2bf(hv[2]), h3 = f2bf(hv[3]);
                u32x2 o; o.x = h0 | (h1 << 16); o.y = h2 | (h3 << 16); *(u32x2*)(hb + (size_t)tok * D + col) = o;
                *(LAS u32x2*)(Hh + r * LR_PITCH + col) = o;
                u32x2 ol; ol.x = pk2(hv[0] - bflo(h0), hv[1] - bflo(h1)); ol.y = pk2(hv[2] - bflo(h2), hv[3] - bflo(h3)); *(LAS u32x2*)(Hl + r * LR_PITCH + col) = ol; }
        }
        __syncthreads();
        {
            f32x4 acc0 = (f32x4){0.f, 0.f, 0.f, 0.f}, acc1 = acc0;
#pragma unroll
            for (int q = 0; q < 4; ++q) { const int ko = fr * LR_PITCH + (4 * w + q) * 32 + 8 * fq;
                const bf16x8 bh = *(const LAS bf16x8*)(Hh + ko), bl = *(const LAS bf16x8*)(Hl + ko);
                acc0 = mfma16(Ahi[0][q], bh, acc0); acc0 = mfma16(Ahi[0][q], bl, acc0); acc0 = mfma16(Alo[0][q], bh, acc0);
                acc1 = mfma16(Ahi[1][q], bh, acc1); acc1 = mfma16(Ahi[1][q], bl, acc1); acc1 = mfma16(Alo[1][q], bh, acc1); }
#pragma unroll
            for (int i = 0; i < 4; ++i) { part[(w * 32 + 4 * fq + i) * 16 + fr] = acc0[i]; part[(w * 32 + 16 + 4 * fq + i) * 16 + fr] = acc1[i]; }
        }
        __syncthreads();
        { const int ee = tid >> 4, tk = tid & 15; float sm = 0.f;
#pragma unroll
          for (int q = 0; q < 8; ++q) sm += part[(q * 32 + ee) * 16 + tk];
          lgt[tk * 32 + ee] = sm; }
        __syncthreads();
#pragma unroll
        for (int jj = 0; jj < 2; ++jj) {
            const int r = 2 * w + jj, tok = tok0 + pass * 16 + r;
            const float score = sigmoidf_(lgt[r * 32 + e]), biased = score + rbias;
            const int gbase = lane & ~3;
            const float v0 = __shfl(biased, gbase), v1 = __shfl(biased, gbase + 1), v2 = __shfl(biased, gbase + 2), v3 = __shfl(biased, gbase + 3);
            const float a_ = fmaxf(v0, v1), b_ = fminf(v0, v1), c_ = fmaxf(v2, v3), d_ = fminf(v2, v3);
            const float gs = fmaxf(a_, c_) + fmaxf(fminf(a_, c_), fmaxf(b_, d_));
            const int myg = e >> 2; int grank = 0;
#pragma unroll
            for (int g2 = 0; g2 < 8; ++g2) { const float o = __shfl(gs, 4 * g2); grank += (o > gs || (o == gs && g2 < myg)) ? 1 : 0; }
            const float masked = (grank < 4) ? biased : -3.0e38f;
            int erank = 0;
#pragma unroll
            for (int e2 = 0; e2 < 32; ++e2) { const float o = __shfl(masked, e2); erank += (o > masked || (o == masked && e2 < e)) ? 1 : 0; }
            const bool sel = (erank < 8) && (lane < 32);
            const float wsum = wave_sum(sel ? score : 0.f);
            const float gate = score / wsum * 2.5f;
            const unsigned long long bal = __ballot(sel);
            if (sel) { const int k = __popcll(bal & ((1ull << lane) - 1ull));
                const unsigned lr = __hip_atomic_fetch_add(wgcnt + e, 1u, __ATOMIC_RELAXED, __HIP_MEMORY_SCOPE_WORKGROUP);
                pinfo[(size_t)tok * 8 + k] = (unsigned)e | (lr << 8); pgate[(size_t)tok * 8 + k] = gate; }
        }
    }
    __syncthreads();
    if (tid < 32) { const int chunk = tok0 / CHTOK; unsigned* cnt = (unsigned*)(X.ws + WS_CTL) + CW_CNT + (l * NCH + chunk) * 64;
        const unsigned base = __hip_atomic_fetch_add(cnt + tid, wgcnt[tid], __ATOMIC_RELAXED, __HIP_MEMORY_SCOPE_AGENT);
        ((unsigned*)(X.ws + WS_WGBASE))[X.c * 32 + tid] = base; }
    __syncthreads();
}

__device__ __forceinline__ void moe_offsets(const Ctx& X, int l, int chunk, LAS int* off  , LAS int* cntl  ) {
    if (X.tid == 0) { const unsigned* cnt = (const unsigned*)(X.ws + WS_CTL) + CW_CNT + (l * NCH + chunk) * 64; int o = 0;
        for (int e = 0; e < NE1; ++e) { const int cn = (e < NEXP) ? (int)__hip_atomic_load(cnt + e, __ATOMIC_RELAXED, __HIP_MEMORY_SCOPE_AGENT) : CHTOK; off[e] = o; cntl[e] = cn; o += ((cn + 255) >> 8) << 8; }
        off[NE1] = o; }
    __syncthreads();
}
#define ST_WT(p, v) __hip_atomic_store((p), (v), __ATOMIC_RELAXED, __HIP_MEMORY_SCOPE_AGENT)
__device__ __forceinline__ void ph_fill(const Ctx& X, int l) {
    LAS int* off = (LAS int*)(X.lds); LAS int* cntl = off + 64;
    const int tok0 = X.c * 128, chunk = tok0 / CHTOK;
    moe_offsets(X, l, chunk, off, cntl);
    unsigned* rowtok = (unsigned*)(X.ws + WS_ROWTOK) + (size_t)chunk * CH_ROWS; float* rowgate = (float*)(X.ws + WS_ROWGATE) + (size_t)chunk * CH_ROWS;
    const unsigned* pinfo = (const unsigned*)(X.ws + WS_PINFO); const float* pgate = (const float*)(X.ws + WS_PGATE); unsigned* slot = (unsigned*)(X.ws + WS_SLOT);
    const unsigned* wgb = (const unsigned*)(X.ws + WS_WGBASE) + X.c * 32;
    for (int i = X.tid; i < 1024; i += 512) { const size_t pi = (size_t)tok0 * 8 + i; const unsigned inf = pinfo[pi]; const int e = inf & 255, lr = inf >> 8;
        const int pos = off[e] + (int)wgb[e] + lr; ST_WT(rowtok + pos, (unsigned)(tok0 + (i >> 3))); ST_WT((unsigned*)rowgate + pos, __builtin_bit_cast(unsigned, pgate[pi])); slot[pi] = (unsigned)pos; }
    if (X.tid < 128) { const int tok = tok0 + X.tid; const int pos = off[NEXP] + (tok - chunk * CHTOK); ST_WT(rowtok + pos, (unsigned)tok); ST_WT((unsigned*)rowgate + pos, __builtin_bit_cast(unsigned, 1.0f)); }
    const int wl = X.c & 63;
    if (wl < NEXP) { const int e = wl; const int p0 = off[e] + cntl[e], p1 = off[e + 1]; for (int p = p0 + X.tid; p < p1; p += 512) { ST_WT(rowtok + p, (unsigned)(chunk * CHTOK)); ST_WT((unsigned*)rowgate + p, 0u); } }
    __syncthreads();
}

template <int NT, bool GATH>
struct MoeOrder {
    static constexpr bool GATHER = GATH;
    int nwg, G, c; const LAS unsigned char* tile_e; const LAS int* rowtab;
    __device__ __forceinline__ bool next(int i, pg8::Unit& u) const {
        const long L = (long)i * G + c; if (L >= nwg) return false;
        const int wgid = pg8::xcd_remap((int)L, nwg); const int tau = wgid / NT, pn = wgid % NT;
        u.pm = tau; u.pn = pn; u.bt = __builtin_amdgcn_readfirstlane((int)tile_e[tau]) * NT + pn; u.ab = i; return true;
    }
    __device__ __forceinline__ int row_of(const pg8::Unit& u, int r) const { return rowtab[u.ab * 256 + r]; }
    __device__ __forceinline__ void a_ready(const pg8::Unit&) const {}
    __device__ __forceinline__ void done(const pg8::Unit&) const {}
};
template <int NT, bool GATH>
struct MoeOrderAll {
    static constexpr bool GATHER = GATH;
    int nwg, G, c; const LAS unsigned char* tile_e4; const LAS int* tprefix; const LAS int* rowtab; int tbase;
    __device__ __forceinline__ bool next(int i, pg8::Unit& u) const {
#if MOE_PAIR
        constexpr int PAIRW = (NT == 4) ? MOE_PAIR4 : MOE_PAIR2;
        const int ip = i / PAIRW, sp = i % PAIRW; const int npair = nwg / PAIRW;
        const long L = (long)ip * G + c; if (L >= npair) return false;
        const int wp = pg8::xcd_remap((int)L, npair); const int gt = tbase + wp / (NT / PAIRW), pn = (wp % (NT / PAIRW)) * PAIRW + sp;
#else
        const long L = (long)i * G + c; if (L >= nwg) return false;
        const int wgid = pg8::xcd_remap((int)L, nwg); const int gt = tbase + wgid / NT, pn = wgid % NT;
#endif
        int ch = 0;
#pragma unroll
        for (int q = 1; q < NCH; ++q) ch += (tprefix[q] <= gt) ? 1 : 0;
        ch = __builtin_amdgcn_readfirstlane(ch); const int tau = gt - __builtin_amdgcn_readfirstlane(tprefix[ch]);
        u.pm = ch * CH_TILES + tau; u.pn = pn; u.bt = __builtin_amdgcn_readfirstlane((int)tile_e4[ch * 336 + tau]) * NT + pn; u.ab = i; return true;
    }
    __device__ __forceinline__ int row_of(const pg8::Unit& u, int r) const { return rowtab[u.ab * 256 + r]; }
    __device__ __forceinline__ void a_ready(const pg8::Unit&) const {}
    __device__ __forceinline__ void done(const pg8::Unit&) const {}
};
__device__ __forceinline__ void moe_tables_all(const Ctx& X, int l, LAS int* off4, LAS unsigned char* tile_e4, LAS int* tprefix) {
    if (X.tid < NCH) { const int chn = X.tid; const unsigned* cnt = (const unsigned*)(X.ws + WS_CTL) + CW_CNT + (l * NCH + chn) * 64; int o = 0;
        for (int e = 0; e < NE1; ++e) { const int cn = (e < NEXP) ? (int)__hip_atomic_load(cnt + e, __ATOMIC_RELAXED, __HIP_MEMORY_SCOPE_AGENT) : CHTOK; off4[chn * 64 + e] = o; o += ((cn + 255) >> 8) << 8; }
        off4[chn * 64 + NE1] = o; }
    __syncthreads();
    if (X.tid == 0) { int a = 0; for (int q = 0; q < NCH; ++q) { tprefix[q] = a; a += off4[q * 64 + NE1] >> 8; } tprefix[NCH] = a; }
    for (int t = X.tid; t < NCH * 336; t += 512) { const int chn = t / 336, tau = t % 336; int e = 0; for (int q = 1; q < NE1; ++q) e += (off4[chn * 64 + q] <= tau * 256) ? 1 : 0; tile_e4[t] = (unsigned char)e; }
    __syncthreads();
}
__device__ __forceinline__ int moe_tiles(const Ctx& X, int l, int chunk, LAS unsigned char* tile_e, LAS int* off, LAS int* cntl) {
    moe_offsets(X, l, chunk, off, cntl);
    const int ntile = off[NE1] >> 8;
    for (int t = X.tid; t < ntile; t += 512) { int e = 0; for (int q = 1; q < NE1; ++q) e += (off[q] <= t * 256) ? 1 : 0; tile_e[t] = (unsigned char)e; }
    __syncthreads();
    return ntile;
}

__device__ __forceinline__ void ph_combine(const Ctx& X, int l, int c0, const LAS int* off4) {
    const int lane = X.lane; const int gw = X.c * 8 + X.wave; const int chunk = c0 + (gw >> 10);
    float* xo = X.a->out; bf16_t* hb = X.hbuf(); float* xw = (X.dbg & 8) ? (float*)(X.ws + WS_ACT) : xo;
    const unsigned char* op = (const unsigned char*)(X.ws + WS_OPAIR) + (size_t)(chunk - c0) * CH_ROWS * 1024; const unsigned* slot = (const unsigned*)(X.ws + WS_SLOT);
    const int b = (chunk * CHTOK) >> 13; const float* mv2 = X.modv(l, 1) + b * 3072;
    const float* lg = X.in(I_LN2G) + l * D; const float* lb = X.in(I_LN2B) + l * D;
    const int offsh = off4[chunk * 64 + NEXP];
#pragma unroll 1
    for (int i = 0; i < 8; i += 2) {
        const int tokA = c0 * CHTOK + gw * 8 + i;
        int pos[2][9];
#pragma unroll
        for (int t = 0; t < 2; ++t) {
            const u32x4 s0 = *(const u32x4*)(slot + (size_t)(tokA + t) * 8), s1 = *(const u32x4*)(slot + (size_t)(tokA + t) * 8 + 4);
            pos[t][0] = (int)s0.x; pos[t][1] = (int)s0.y; pos[t][2] = (int)s0.z; pos[t][3] = (int)s0.w; pos[t][4] = (int)s1.x; pos[t][5] = (int)s1.y; pos[t][6] = (int)s1.z; pos[t][7] = (int)s1.w;
            pos[t][8] = offsh + (tokA + t - chunk * CHTOK); }
        unsigned rw8[2][9][4];
#pragma unroll
        for (int t = 0; t < 2; ++t) {
#pragma unroll
            for (int k = 0; k < 9; ++k) { const unsigned ro = (unsigned)pos[t][k] * 1024u + 4u * (unsigned)lane;
#pragma unroll
                for (int j = 0; j < 4; ++j) rw8[t][k][j] = *(const unsigned*)(op + ro + 256 * j); } }
#pragma unroll
        for (int t = 0; t < 2; ++t) {
            const int tok = tokA + t;
            f32x4 sm[4];
#pragma unroll
            for (int j = 0; j < 4; ++j) sm[j] = (f32x4){0.f, 0.f, 0.f, 0.f};
#pragma unroll
            for (int k = 0; k < 9; ++k)
#pragma unroll
                for (int j = 0; j < 4; ++j) { const int q = (int)rw8[t][k][j]; const f32x2 lo = __builtin_amdgcn_cvt_pk_f32_fp8(q, false), hi = __builtin_amdgcn_cvt_pk_f32_fp8(q, true);
                    sm[j][0] += lo[0]; sm[j][1] += lo[1]; sm[j][2] += hi[0]; sm[j][3] += hi[1]; }
            f32x4 v[4]; float s = 0.f;
#pragma unroll
            for (int j = 0; j < 4; ++j) { const int col = 4 * lane + 256 * j; v[j] = *(const f32x4*)(xo + (size_t)tok * D + col) + (*(const f32x4*)(mv2 + 2048 + col) + 1.0f) * (sm[j] * (1.0f / O_SCALE)); s += (v[j][0] + v[j][1]) + (v[j][2] + v[j][3]); }
            const float mean = wave_sum(s) * (1.0f / D); float q = 0.f;
#pragma unroll
            for (int j = 0; j < 4; ++j) { v[j] = v[j] - mean; q += (v[j][0] * v[j][0] + v[j][1] * v[j][1]) + (v[j][2] * v[j][2] + v[j][3] * v[j][3]); }
            const float rstd = rsqrtf(wave_sum(q) * (1.0f / D) + LN_EPS);
#pragma unroll
            for (int j = 0; j < 4; ++j) { const int col = 4 * lane + 256 * j;
                const f32x4 x2 = v[j] * rstd * *(const f32x4*)(lg + col) + *(const f32x4*)(lb + col);
                *(f32x4*)(xw + (size_t)tok * D + col) = x2;
                if (l + 1 < DEPTH) { const float* mv1 = X.modv(l + 1, 0) + b * 3072; const f32x4 hn = x2 * (*(const f32x4*)(mv1 + 1024 + col) + 1.0f) + *(const f32x4*)(mv1 + col);
                    u32x2 o; o.x = pk2(hn[0], hn[1]); o.y = pk2(hn[2], hn[3]); *(u32x2*)(hb + (size_t)tok * D + col) = o; } }
        }
    }
}

template <int PW, bool ABSEL> struct PairOrder : pg8::StaticOrder { __device__ __forceinline__ bool next(int i, pg8::Unit& u) const { if (!pg8::StaticOrder::next(i / PW, u)) return false;
    u.pn = u.pn * PW + i % PW; u.bt = u.pn; u.ab = ABSEL ? (u.pn >> 2) : 0; return true; } };
struct POrder : pg8::StaticOrder { __device__ __forceinline__ bool next(int i, pg8::Unit& u) const { if (!pg8::StaticOrder::next(i, u)) return false; u.ab = u.pn >> 2; return true; } };
struct GOrder { static constexpr bool GATHER = false; int G, c;
    __device__ __forceinline__ bool next(int i, pg8::Unit& u) const { const int tile = (i >> 2) * G + c; if (tile >= 512) return false; const int wg = pg8::xcd_remap(tile, 512); const int br = i & 3, mt = wg & 3;
        u.pm = wg >> 2; u.pn = br * 4 + mt; u.bt = br * 4 + mt; u.ab = 0; return true; }
    __device__ __forceinline__ void a_ready(const pg8::Unit&) const {} __device__ __forceinline__ void done(const pg8::Unit&) const {} };
__global__ void __launch_bounds__(512, 2) fwd_kernel(Args args) {
    extern __shared__ __attribute__((aligned(16))) unsigned char lds_raw[];
    ArgsP ap = (ArgsP)__builtin_amdgcn_kernarg_segment_ptr();
    Ctx X; X.a = ap; X.ws = ap->ws; X.lds = (LAS unsigned char*)lds_raw;
    X.tid = threadIdx.x; X.lane = X.tid & 63; X.wave = __builtin_amdgcn_readfirstlane(X.tid >> 6); X.G = gridDim.x;
    { const int bx = blockIdx.x; X.bx = bx; X.c = (X.G % 8 == 0) ? (bx % 8) * (X.G / 8) + bx / 8 : bx; }
    const int c0_ = X.c, g0_ = X.G, bx0_ = X.bx, wave0_ = X.wave;
    volatile LAS unsigned* misc = (volatile LAS unsigned*)(X.lds + LDS_MISC);
    if (X.tid < 16) misc[X.tid] = 0u;
    __syncthreads();
    XcdBarrier bar; bar.bar = (unsigned*)(X.ws + WS_CTL) + CW_BAR; bar.x = 0; bar.st = misc;
#if !MK_PER_PHASE
    bar = xcd_barrier_post((unsigned*)(X.ws + WS_CTL) + CW_BAR, misc);
#endif
    const int lo = ap->ph_lo, hi = ap->ph_hi; int ph = 0;
#define RELAUNDER() do { int wv_ = wave0_; asm volatile("" : "+s"(wv_)); int t_ = wv_ * 64 + (int)__builtin_amdgcn_mbcnt_hi(~0u, __builtin_amdgcn_mbcnt_lo(~0u, 0u)); asm volatile("" : "+v"(t_)); X.tid = t_; X.lane = t_ & 63; X.wave = wv_; } while (0)
#define REPEAT(N, stmt) _Pragma("nounroll") for (int rp_ = 0; rp_ < (N); ++rp_) { stmt; if (rp_ + 1 < (N)) xcd_barrier(bar); }
#define PH_BEGIN if (ph >= lo && ph < hi) { { ArgsP apl = ap; asm volatile("" : "+s"(apl)); X.a = apl; X.ws = apl->ws; X.dbg = apl->dbg; int wv_ = wave0_; asm volatile("" : "+s"(wv_)); int t_ = wv_ * 64 + (int)__builtin_amdgcn_mbcnt_hi(~0u, __builtin_amdgcn_mbcnt_lo(~0u, 0u)); asm volatile("" : "+v"(t_)); X.tid = t_; X.lane = t_ & 63; X.wave = wv_; int c_ = c0_, g_ = g0_, b_ = bx0_; asm volatile("" : "+s"(c_), "+s"(g_), "+s"(b_)); X.c = c_; X.G = g_; X.bx = b_; } unsigned char* wb = X.ws + WS_W; LAS unsigned char* gl = X.lds; const float* xin = (l_ == 0) ? X.in(I_X) : (const float*)X.a->out; (void)wb; (void)gl; (void)xin;
#if MK_PER_PHASE
#define PH_END } ++ph;
#else
#define PH_END if (ph + 1 < hi) xcd_barrier(bar); } ++ph;
#endif
    int l_ = 0;
    PH_BEGIN if (EN_PROLOGUE) { REPEAT(R_MISC, ph_prologue(X)) } PH_END
    for (int l = 0; l < DEPTH; ++l) {
        l_ = l;
        PH_BEGIN if (EN_WCONV) { REPEAT(R_MISC, ph_wconv(X, l)) } PH_END
        PH_BEGIN if (EN_GWIN)  { pg8::Gemm g{X.hbuf(), (const bf16_t*)(wb + WO_IN), 1024, 0}; pg8::StaticOrder S; S.init(M, PJ, X.G, X.bx); pg8::EpiBf16 E{X.proj(), PJ};
            REPEAT(R_GWIN, (pg8::gemm_phase<pg8::EpiBf16, pg8::StaticOrder, G_ALIGN, G_SP2>(gl, g, S, E, X.tid))) } PH_END
        PH_BEGIN if (EN_MX1)  {
            if (!(X.dbg & 1)) mx_rope(X);
            _Pragma("nounroll") for (int rp_ = 0; rp_ < R_MIX; ++rp_) {
            if (!(X.dbg & 2)) for (int u = X.c; u < 256; u += X.G) mx_gmlp(X, l, u);
            if (!(X.dbg & 4)) for (int wu = X.c * 8 + X.wave; wu < 2048; wu += X.G * 8) mx_s5<1>(X, l, wu);
            __syncthreads();
            if (!(X.dbg & 8)) for (int u = X.c; u < 256; u += X.G) mx_ssd<1>(X, l, u); }
        } PH_END
        PH_BEGIN if (EN_MX2)  {
            if (!(X.dbg & 32)) { mx_ssd_carry(X); mx_s5_carry(X); } RELAUNDER();
            _Pragma("nounroll") for (int rp_ = 0; rp_ < R_DSA; ++rp_)
            for (int r = 0; r < 16; ++r) { const int cl = X.c & 63; const int uu = (r & 1) ? r * 64 + 63 - cl : r * 64 + cl; if (EN_DSA && !(X.dbg & 64) && X.c < 256) mx_dsa(X, X.c >> 6, uu * 8); }
            __syncthreads(); RELAUNDER();
            for (int wu = X.c * 8 + X.wave; EN_S53 && !(X.dbg & 16) && wu < 2048; wu += X.G * 8) mx_s5<3>(X, l, wu);
        } PH_END
        PH_BEGIN if (EN_GLU)  { for (int u = X.c; EN_SSD3 && u < 256; u += X.G) mx_ssd<3>(X, l, u);
            __syncthreads(); RELAUNDER();
            pg8::Gemm g{(const bf16_t*)(X.ws + WS_YCPRE), (const bf16_t*)(wb + WO_GLU), 256, 0}; pg8::StaticOrder S; S.init(M, 256, X.G, X.bx);
            pg8::EpiGlu E{(const bf16_t*)(X.ws + WS_YCPRE), X.ybuf() + (size_t)2 * M * 256, X.in(I_S5GLUB) + l * 256};
            REPEAT(R_GLU, (pg8::gemm_phase<pg8::EpiGlu, pg8::StaticOrder, G_ALIGN, G_SP2>(gl, g, S, E, X.tid))) } PH_END
        PH_BEGIN if (EN_GP)  { pg8::Gemm g{X.ybuf(), (const bf16_t*)(wb + WO_BR), 256, (size_t)M * 256};
            PairOrder<PW_GP, true> S;
            S.init(M, 4096 / PW_GP, X.G, X.bx); pg8::EpiFp8 E{(unsigned char*)(X.ws + WS_P), 4096, P_SCALE};
            REPEAT(R_GP, (pg8::gemm_phase<pg8::EpiFp8, PairOrder<PW_GP, true>, false, G_SP2>(gl, g, S, E, X.tid))) } PH_END
        PH_BEGIN if (EN_GGATE)  { pg8::Gemm g{X.hbuf(), (const bf16_t*)(wb + WO_GATE), 1024, 0};
            PairOrder<PW_GGATE, false> S; S.init(M, 4096 / PW_GGATE, X.G, X.bx);
            pg8::EpiGateMerge4 E{(const unsigned char*)(X.ws + WS_P), X.ybuf(), 1.0f / P_SCALE};
            REPEAT(R_GGATE, (pg8::gemm_phase<pg8::EpiGateMerge4, PairOrder<PW_GGATE, false>, G_ALIGN, G_SP2>(gl, g, S, E, X.tid))) } PH_END
        PH_BEGIN if (EN_GOUT)  { pg8::Gemm g{X.ybuf(), (const bf16_t*)(wb + WO_OUT), 1024, 0}; PairOrder<PW_GOUT, false> S; S.init(M, 1024 / PW_GOUT, X.G, X.bx);
            pg8::EpiResid E{xin, (bf16_t*)(X.ws + WS_V16), X.modv(l, 0)};
            pg8::gemm_phase<pg8::EpiResid, PairOrder<PW_GOUT, false>, G_ALIGN, G_SP2>(gl, g, S, E, X.tid); } PH_END
        PH_BEGIN if (EN_LN1)  ph_ln1_router(X, l); PH_END
        PH_BEGIN if (EN_FILL) { REPEAT(R_MISC, ph_fill(X, l)) } PH_END
        PH_BEGIN if (EN_MOE1)  {
            LAS int* off4 = (LAS int*)(X.lds + LDS_TAB + 1024); LAS unsigned char* tile_e4 = (LAS unsigned char*)(X.lds + LDS_TAB + 2048); LAS int* tprefix = (LAS int*)(X.lds + LDS_TAB + 3584);
            moe_tables_all(X, l, off4, tile_e4, tprefix);
            pg8::Gemm g{X.hbuf(), (const bf16_t*)(wb + WO_13), 1024, 0};
            LAS int* rowtab = (LAS int*)(X.lds + LDS_TAB + 4096);
            MoeOrderAll<2, true> S{tprefix[NCH] * 2, X.G, X.bx, tile_e4, tprefix, rowtab, 0};
            { const unsigned* rowtok = (const unsigned*)(X.ws + WS_ROWTOK); pg8::Unit uu;
              const float* rowgate = (const float*)(X.ws + WS_ROWGATE); LAS float* gtabw = (LAS float*)(X.lds + LDS_TAB + 4096 + 12288);
              _Pragma("nounroll") for (int i = 0; i < 12; ++i) { if (!S.next(i, uu)) break; const int pmu = __builtin_amdgcn_readfirstlane(uu.pm);
                  if (X.tid < 256) { rowtab[i * 256 + X.tid] = (int)rowtok[(size_t)pmu * 256 + X.tid]; gtabw[i * 256 + X.tid] = rowgate[(size_t)pmu * 256 + X.tid]; } } }
            __syncthreads();
            pg8::EpiMoe1 E{(bf16_t*)(X.ws + WS_ACT), (const LAS float*)(X.lds + LDS_TAB + 4096 + 12288)};
            REPEAT(R_MOE, (pg8::gemm_phase<pg8::EpiMoe1, MoeOrderAll<2, true>, G_ALIGN, G_SP2>(gl, g, S, E, X.tid)))
        } PH_END
        for (int c0 = 0; c0 < NCH; c0 += 2) {
            PH_BEGIN if (EN_MOE2)  {
                LAS int* off4 = (LAS int*)(X.lds + LDS_TAB + 1024); LAS unsigned char* tile_e4 = (LAS unsigned char*)(X.lds + LDS_TAB + 2048); LAS int* tprefix = (LAS int*)(X.lds + LDS_TAB + 3584);
                moe_tables_all(X, l, off4, tile_e4, tprefix);
                pg8::Gemm g{(const bf16_t*)(X.ws + WS_ACT), (const bf16_t*)(wb + WO_2), 256, 0};
                MoeOrderAll<4, false> S{(tprefix[c0 + 2] - tprefix[c0]) * 4, X.G, X.bx, tile_e4, tprefix, nullptr, tprefix[c0]};
                pg8::EpiFp8 E{(unsigned char*)(X.ws + WS_OPAIR) - (size_t)c0 * CH_ROWS * 1024, 1024, O_SCALE};
                REPEAT(R_MOE, (pg8::gemm_phase<pg8::EpiFp8, MoeOrderAll<4, false>, false, G_SP2>(gl, g, S, E, X.tid)))
            } PH_END
            PH_BEGIN if (EN_FIN)  { LAS int* off4 = (LAS int*)(X.lds + LDS_TAB + 1024); LAS unsigned char* tile_e4 = (LAS unsigned char*)(X.lds + LDS_TAB + 2048); LAS int* tprefix = (LAS int*)(X.lds + LDS_TAB + 3584);
                moe_tables_all(X, l, off4, tile_e4, tprefix); ph_combine(X, l, c0, off4); } PH_END
        }
    }
#undef PH_BEGIN
#undef PH_END
}
constexpr int N_PHASES = 1 + DEPTH * (10 + 1 + NCH);

#ifdef DBG_DUMP_OFF
__global__ void dbg_dump(const bf16_t* src, float* out, size_t n) { for (size_t i = (size_t)blockIdx.x * blockDim.x + threadIdx.x; i < n; i += (size_t)gridDim.x * blockDim.x) {
#ifdef DBG_HASH_OUT
    const unsigned bits = __builtin_bit_cast(unsigned, out[i]); out[i] = (float)((bits * 2654435761u) >> 8) * (1.0f / 16777216.0f);
#else
    const unsigned bits = src[i]; out[i] = (float)(((bits + 1u) * 2654435761u) >> 8) * (1.0f / 16777216.0f);
#endif
} }
#endif
extern "C" void kernel_launch(void* const* d_in, const int* in_sizes, int n_in, void* d_out, int out_size, void* d_ws, size_t ws_size, hipStream_t stream) {
    static int grid = 0;
    if (grid == 0) {
        if (n_in != 43 || out_size != M * D || ws_size < WS_NEED) { fprintf(stderr, "kernel_launch: unexpected shapes (n_in %d out %d ws %zu)\n", n_in, out_size, ws_size); grid = -1; return; }
        int dev = 0, cus = 0, per_cu = 0;
        if (hipGetDevice(&dev) != hipSuccess || hipDeviceGetAttribute(&cus, hipDeviceAttributeMultiprocessorCount, dev) != hipSuccess) { grid = -1; return; }
        if (hipFuncSetAttribute((const void*)fwd_kernel, hipFuncAttributeMaxDynamicSharedMemorySize, LDS_BYTES) != hipSuccess) { fprintf(stderr, "kernel_launch: hipFuncSetAttribute failed\n"); grid = -1; return; }
        if (hipOccupancyMaxActiveBlocksPerMultiprocessor(&per_cu, (const void*)fwd_kernel, 512, LDS_BYTES) != hipSuccess || per_cu < 1) fprintf(stderr, "kernel_launch: occupancy query says %d\n", per_cu);
        (void)hipGetLastError();
        grid = cus < 256 ? cus : 256;
    }
    if (grid < 0) return;
    (void)hipMemsetAsync((char*)d_ws + WS_CTL, 0, CTL_BYTES, stream);
#ifdef DBG_POISON
    (void)hipMemsetAsync((char*)d_ws + CTL_BYTES, 0xFF, WS_NEED - CTL_BYTES, stream);
    (void)hipMemsetAsync((char*)d_out, 0xFF, (size_t)M * D * 4, stream);
#endif
    Args a{};
    for (int i = 0; i < 43; ++i) a.in[i] = (const float*)d_in[i];
    a.positions = (const int*)d_in[I_POS]; a.out = (float*)d_out; a.ws = (unsigned char*)d_ws;
#if MK_PER_PHASE
#ifndef DBG_NPH
#define DBG_NPH N_PHASES
#endif
    for (int p = 0; p < DBG_NPH; ++p) { a.ph_lo = p; a.ph_hi = p + 1; hipLaunchKernelGGL(fwd_kernel, dim3(grid), dim3(512), LDS_BYTES, stream, a); }
#ifdef DBG_DUMP_OFF
    hipLaunchKernelGGL(dbg_dump, dim3(2048), dim3(256), 0, stream, (const bf16_t*)((const char*)d_ws + (size_t)(DBG_DUMP_OFF)), (float*)d_out, (size_t)M * D);
#endif
#else
    a.ph_lo = 0; a.ph_hi = N_PHASES; hipLaunchKernelGGL(fwd_kernel, dim3(grid), dim3(512), LDS_BYTES, stream, a);
#ifdef DBG_EXTRA_PH
    a.dbg = DBG_EXTRA_FLAGS;
    for (int rep = 0; rep < DBG_EXTRA_REP; ++rep) { a.ph_lo = DBG_EXTRA_PH; a.ph_hi = DBG_EXTRA_PH + 1; hipLaunchKernelGGL(fwd_kernel, dim3(grid), dim3(512), LDS_BYTES, stream, a); }
#endif
#endif
}
```

```cpp
#include <hip/hip_runtime.h>
#include <cstdio>
#include <cstdint>


#ifndef DSA_SKIP
#define DSA_SKIP 0
#endif
#ifndef DSA_PM
#define DSA_PM 0
#endif
#ifndef R_S1
#define R_S1 1
#endif
#ifndef R_S2
#define R_S2 1
#endif
#ifndef R_S3
#define R_S3 1
#endif
#ifndef EN_DSA
#define EN_DSA 1
#endif
#ifndef EN_S53
#define EN_S53 1
#endif
#ifndef EN_SSD3
#define EN_SSD3 1
#endif
#ifndef R_GWIN
#define R_GWIN 1
#endif
#ifndef R_GLU
#define R_GLU 1
#endif
#ifndef R_GP
#define R_GP 1
#endif
#ifndef MOE_PAIR
#define MOE_PAIR 1
#endif
#ifndef PEEL_GWIN
#define PEEL_GWIN false
#endif
#ifndef PEEL_MOE1
#define PEEL_MOE1 false
#endif
#ifndef PW_GP
#define PW_GP 1
#endif
#ifndef PW_GGATE
#define PW_GGATE 1
#endif
#ifndef PW_GOUT
#define PW_GOUT 1
#endif
#ifndef MOE_PAIR4
#define MOE_PAIR4 2
#endif
#ifndef MOE_PAIR2
#define MOE_PAIR2 1
#endif
#ifndef R_GGATE
#define R_GGATE 1
#endif
#ifndef R_DENSE
#define R_DENSE 1
#endif
#ifndef R_MOE
#define R_MOE 1
#endif
#ifndef R_DSA
#define R_DSA 1
#endif
#ifndef R_MIX
#define R_MIX 1
#endif
#ifndef R_MISC
#define R_MISC 1
#endif
#ifndef MK_PER_PHASE
#define MK_PER_PHASE 0
#endif

#ifndef EN_PROLOGUE
#define EN_PROLOGUE 1
#endif
#ifndef EN_WCONV
#define EN_WCONV 1
#endif
#ifndef EN_GWIN
#define EN_GWIN 1
#endif
#ifndef EN_MX1
#define EN_MX1 1
#endif
#ifndef EN_MX2
#define EN_MX2 1
#endif
#ifndef EN_GLU
#define EN_GLU 1
#endif
#ifndef EN_GP
#define EN_GP 1
#endif
#ifndef EN_GGATE
#define EN_GGATE 1
#endif
#ifndef EN_GOUT
#define EN_GOUT 1
#endif
#ifndef EN_LN1
#define EN_LN1 1
#endif
#ifndef EN_FILL
#define EN_FILL 1
#endif
#ifndef EN_MOE1
#define EN_MOE1 1
#endif
#ifndef EN_MOE2
#define EN_MOE2 1
#endif
#ifndef EN_FIN
#define EN_FIN 1
#endif
#ifndef G_ALIGN
#define G_ALIGN true
#endif
#ifndef G_SP2
#define G_SP2 true
#endif
#define LAS __attribute__((address_space(3)))
#define GAS __attribute__((address_space(1)))
typedef unsigned short bf16_t;
typedef short bf16x8 __attribute__((ext_vector_type(8)));
typedef float f32x4 __attribute__((ext_vector_type(4)));
typedef float f32x2 __attribute__((ext_vector_type(2)));
typedef unsigned u32x4 __attribute__((ext_vector_type(4)));
typedef unsigned u32x2 __attribute__((ext_vector_type(2)));

constexpr int NB = 4, SEQ = 8192, M = NB * SEQ, D = 1024, DEPTH = 2;
constexpr int PJ = 2304;
constexpr int C_GU = 0, C_GV = 256, C_Q = 512, C_K = 768, C_V = 832, C_QI = 896, C_KI = 1152, C_S5 = 1216, C_Z = 1472, C_XBC = 1728, C_WI = 2240, C_DT = 2244;
constexpr int D_IN = 2248;
constexpr int NEXP = 32, NE1 = 33;
constexpr int NCH = 4, CHTOK = M / NCH;
constexpr int CH_ROWS = CHTOK * 8 + CHTOK + NE1 * 256;
constexpr float DN_ALPHA = 1.41421356237f;
constexpr float LN_EPS = 1e-5f, RMS_EPS = 1e-6f;
#ifndef PFP8
#define PFP8 1
#endif
constexpr float P_SCALE = 8.0f, O_SCALE = 32.0f;

constexpr size_t MiB = 1u << 20;
constexpr size_t WS_CTL = 0, CTL_BYTES = 1 * MiB;
constexpr size_t WS_MODV = 1 * MiB;
constexpr size_t WS_S5B = WS_MODV + 256 * 1024;
constexpr size_t WS_S5C = WS_S5B + 64 * 1024;
constexpr size_t WS_S5A = WS_S5C + 64 * 1024;
constexpr size_t WS_GMW = WS_S5A + 64 * 1024;
constexpr size_t WS_RFR = WS_GMW + 128 * 1024;
static_assert(WS_RFR + 128 * 1024 <= 2 * MiB, "misc tables");
constexpr size_t WS_S5ST = 2 * MiB;
constexpr size_t WS_ATOT = 3 * MiB;
constexpr size_t WS_WGBASE = 3 * MiB + 64 * 1024;
constexpr size_t WS_PINFO = 4 * MiB;
constexpr size_t WS_PGATE = 5 * MiB;
constexpr size_t WS_SLOT = 6 * MiB;
constexpr size_t WS_ROWTOK = 7 * MiB;
constexpr size_t WS_ROWGATE = 9 * MiB;
constexpr size_t WS_S5HIN = 11 * MiB;
constexpr size_t WS_ROPE = 12 * MiB;
constexpr size_t WS_W = 24 * MiB;
constexpr size_t WO_IN = 0, WO_GATE = WO_IN + (size_t)PJ * 1024 * 2, WO_BR = WO_GATE + (size_t)4096 * 1024 * 2, WO_OUT = WO_BR + (size_t)4 * 1024 * 256 * 2,
                 WO_GLU = WO_OUT + (size_t)1024 * 1024 * 2, WO_13 = WO_GLU + (size_t)256 * 256 * 2, WO_2 = WO_13 + (size_t)NE1 * 512 * 1024 * 2, WO_END = WO_2 + (size_t)NE1 * 1024 * 256 * 2;
static_assert(WO_END <= 72 * MiB, "weights region");
constexpr size_t WS_H = 96 * MiB;
constexpr size_t WS_Y = 160 * MiB;
constexpr size_t WS_PROJ = 224 * MiB;
constexpr size_t WS_P = 224 * MiB;
constexpr size_t WS_SSDST = 368 * MiB;
constexpr size_t WS_SSDSIN = 400 * MiB;
constexpr size_t WS_KI2 = 408 * MiB, WS_K2 = 412 * MiB, WS_V2 = 416 * MiB;
constexpr size_t WS_YCPRE = 384 * MiB;
constexpr size_t WS_V16 = 224 * MiB;
constexpr size_t WS_ACT = 160 * MiB;
constexpr size_t WS_OPAIR = 321 * MiB;
static_assert(CH_ROWS % 256 == 0 && WS_ACT + (size_t)NCH * CH_ROWS * 512 <= WS_OPAIR && WS_OPAIR + (size_t)2 * CH_ROWS * 1024 <= 512 * MiB, "moe buffers");
constexpr int CH_TILES = CH_ROWS / 256;
constexpr size_t WS_NEED = 512 * MiB;
constexpr int CW_BAR = 4096;
constexpr int CW_CNT = 16384;

constexpr int LDS_BYTES = 160 * 1024;
constexpr int LDS_TAB = 131072;
constexpr int LDS_MISC = LDS_BYTES - 256;

__device__ __forceinline__ unsigned f2bf(float f) { unsigned u = __builtin_bit_cast(unsigned, f); return (u + 0x7fffu + ((u >> 16) & 1u)) >> 16; }
__device__ __forceinline__ unsigned pk2(float lo, float hi) { return f2bf(lo) | (f2bf(hi) << 16); }
__device__ __forceinline__ float bf2f(unsigned short b) { return __builtin_bit_cast(float, (unsigned)b << 16); }
__device__ __forceinline__ float bflo(unsigned w) { return __builtin_bit_cast(float, w << 16); }
__device__ __forceinline__ float bfhi(unsigned w) { return __builtin_bit_cast(float, w & 0xffff0000u); }
__device__ __forceinline__ float wave_sum(float v) {
#pragma unroll
    for (int o = 1; o < 64; o <<= 1) v += __shfl_xor(v, o);
    return v;
}
__device__ __forceinline__ float wave_max(float v) {
#pragma unroll
    for (int o = 1; o < 64; o <<= 1) v = fmaxf(v, __shfl_xor(v, o));
    return v;
}
__device__ __forceinline__ int wave_sum_i(int v) {
#pragma unroll
    for (int o = 1; o < 64; o <<= 1) v += __shfl_xor(v, o);
    return v;
}
__device__ __forceinline__ float sigmoidf_(float x) { return __builtin_amdgcn_rcpf(1.0f + __expf(-x)); }
__device__ __forceinline__ float siluf_(float x) { return x * __builtin_amdgcn_rcpf(1.0f + __expf(-x)); }
__device__ __forceinline__ float gelu_tanh(float x) { const float u = 1.5957691216057308f * (x + 0.044715f * x * x * x); return x * __builtin_amdgcn_rcpf(1.0f + __expf(-u)); }
__device__ __forceinline__ float softplusf_(float x) { return fmaxf(x, 0.f) + log1pf(__expf(-fabsf(x))); }
__device__ __forceinline__ void sincos_red(float ang, float& sn, float& cs) {
    const double a = (double)ang; const double q = __builtin_rint(a * 0.63661977236758134308);
    const float r = (float)(a - q * 1.57079632679489661923); const int qi = (int)q & 3;
    const float r2 = r * r;
    const float s = r * (1.0f + r2 * (-1.6666667e-1f + r2 * (8.3333333e-3f + r2 * (-1.9841270e-4f + r2 * 2.7557319e-6f))));
    const float c = 1.0f + r2 * (-0.5f + r2 * (4.1666667e-2f + r2 * (-1.3888889e-3f + r2 * (2.4801587e-5f + r2 * -2.7557319e-7f))));
    sn = (qi == 0) ? s : (qi == 1) ? c : (qi == 2) ? -s : -c;
    cs = (qi == 0) ? c : (qi == 1) ? -s : (qi == 2) ? -c : s;
}
__device__ __forceinline__ f32x4 mfma16(bf16x8 a, bf16x8 b, f32x4 c) { return __builtin_amdgcn_mfma_f32_16x16x32_bf16(a, b, c, 0, 0, 0); }
__device__ __forceinline__ unsigned cvt_pk_bf16(float lo, float hi) { unsigned r; asm volatile("v_cvt_pk_bf16_f32 %0, %1, %2" : "=v"(r) : "v"(lo), "v"(hi)); return r; }

namespace pg8 {
constexpr int BM = 256, BK = 64, HALF = 128, HTB = HALF * BK * 2, STAGE_BYTES = 8 * HTB, NXCD = 8, WGM = 8;
__host__ __device__ __forceinline__ int lds_byte(int r, int c) { const int st = (r >> 4) * 2 + (c >> 5), rr = r & 15, cc = c & 31, ob = rr * 64 + cc * 2; return st * 1024 + (ob ^ (((ob >> 9) & 1) << 5)); }
__host__ __device__ __forceinline__ void stage_rc(int b, int& R, int& C) { const int st = b / 1024, sb = b % 1024, swz = sb ^ (((sb >> 9) & 1) << 5); R = (st >> 1) * 16 + swz / 64; C = (st & 1) * 32 + (swz % 64) / 2; }
__host__ __device__ __forceinline__ int perm32(int rho) { const int n = rho >> 4, i = rho & 15; return 8 * (i >> 2) + 4 * n + (i & 3); }

struct Unit { int pm, pn, bt, ab; };
struct Gemm { const bf16_t* A; const bf16_t* Bt; int K; size_t a_sel_stride; };

__device__ __forceinline__ int xcd_remap(int wgid, int nwg) { const int q = nwg / NXCD, r = nwg % NXCD, xcd = wgid % NXCD, off = wgid / NXCD; return (xcd < r ? xcd * (q + 1) : r * (q + 1) + (xcd - r) * q) + off; }

struct StaticOrder {
    static constexpr bool GATHER = false;
    int nM, nN, nwg, G, c;
    __device__ void init(int Mr, int N, int G_, int c_) { nM = Mr / BM; nN = N / BM; nwg = nM * nN; G = G_; c = c_; }
    __device__ __forceinline__ bool next(int i, Unit& u) const {
        const long L = (long)i * G + c; if (L >= nwg) return false;
        const int wgid = xcd_remap((int)L, nwg);
        const int nig = WGM * nN, gid = wgid / nig, fm = gid * WGM, gsz = (nM - fm) < WGM ? (nM - fm) : WGM;
        u.pm = fm + ((wgid % nig) % gsz); u.pn = (wgid % nig) / gsz; u.bt = u.pn; u.ab = 0; return true;
    }
    __device__ __forceinline__ void a_ready(const Unit&) const {}
    __device__ __forceinline__ void done(const Unit&) const {}
};

template <class Epi, class Sched, bool ALIGN_EPI = false, bool SP2 = true, bool PEEL = false>
__device__ __forceinline__ void gemm_phase(LAS unsigned char* lds, const Gemm g, const Sched& S, const Epi& E, const int tid) {
    const int wid = __builtin_amdgcn_readfirstlane(tid >> 6), lane = tid & 63, wr = wid >> 2, wc = wid & 3, fr = lane & 15, fq = lane >> 4;
    const int K = g.K, nt = K / BK;
    unsigned voffA[2], voffB[2];
#pragma unroll
    for (int i = 0; i < 2; ++i) { int R, C; stage_rc(tid * 16 + i * 8192, R, C); const int Rb = Epi::PERM ? ((R & ~31) + perm32(R & 31)) : R;
        voffA[i] = (unsigned)(R * K + C) * 2u; voffB[i] = (unsigned)(Rb * K + C) * 2u; }
    const size_t kstep = (size_t)(BK * 2);
    const size_t hstep = (size_t)HALF * K * 2;
    const size_t tstep = 2 * hstep;
    const unsigned ldsw = (unsigned)wid * 1024u;
    const int aoff = lds_byte(wr * 64 + fr, fq * 8), boff = lds_byte(wc * 32 + fr, fq * 8);
#define PG8_SA(b, h) (((b) * 2 + (h)) * HTB)
#define PG8_SB(b, h) ((4 + (b) * 2 + (h)) * HTB)
#define PG8_STAGE(bufoff, gbase, voff) do { _Pragma("unroll") for (int _i = 0; _i < 2; ++_i) \
        __builtin_amdgcn_global_load_lds((const unsigned*)((const char*)(gbase) + (voff)[_i]), (LAS unsigned*)(lds + (bufoff) + ldsw + _i * 8192), 16, 0, 0); } while (0)
#define PG8_GO(u) do { _Pragma("unroll") for (int _h = 0; _h < 2; ++_h) _Pragma("unroll") for (int _i = 0; _i < 2; ++_i) { int _R, _C; stage_rc(tid * 16 + _i * 8192, _R, _C); \
        cgo[_h][_i] = (unsigned)S.row_of(u, _h * HALF + _R) * (unsigned)(K * 2) + (unsigned)_C * 2u; } } while (0)
#define PG8_STAGE_A(bufoff, base, h, kb, NX) do { if constexpr (Sched::GATHER) { _Pragma("unroll") for (int _i = 0; _i < 2; ++_i) \
        __builtin_amdgcn_global_load_lds((const unsigned*)((const char*)g.A + (kb) + cgo[h][_i]), (LAS unsigned*)(lds + (bufoff) + ldsw + _i * 8192), 16, 0, 0); } \
        else { PG8_STAGE(bufoff, (base) + (size_t)(h) * hstep + (kb), voffA); } } while (0)
#define PG8_LDA(dst, b, h) do { _Pragma("unroll") for (int m = 0; m < 4; ++m) _Pragma("unroll") for (int k = 0; k < 2; ++k) dst[m][k] = *(const LAS bf16x8*)(lds + PG8_SA(b, h) + aoff + m * 2048 + k * 1024); } while (0)
#define PG8_LDB(dst, b, h) do { _Pragma("unroll") for (int n = 0; n < 2; ++n) _Pragma("unroll") for (int k = 0; k < 2; ++k) dst[n][k] = *(const LAS bf16x8*)(lds + PG8_SB(b, h) + boff + n * 2048 + k * 1024); } while (0)
#define PG8_MMA(ai, bj, At, Bt) do { __builtin_amdgcn_s_setprio(1); _Pragma("unroll") for (int m = 0; m < 4; ++m) _Pragma("unroll") for (int n = 0; n < 2; ++n) _Pragma("unroll") for (int k = 0; k < 2; ++k) \
        acc[ai][bj][m][n] = __builtin_amdgcn_mfma_f32_16x16x32_bf16(Bt[n][k], At[m][k], acc[ai][bj][m][n], 0, 0, 0); __builtin_amdgcn_s_setprio(0); } while (0)
#define PG8_MMAZ(ai, bj, At, Bt) do { __builtin_amdgcn_s_setprio(1); _Pragma("unroll") for (int m = 0; m < 4; ++m) _Pragma("unroll") for (int n = 0; n < 2; ++n) { \
        acc[ai][bj][m][n] = __builtin_amdgcn_mfma_f32_16x16x32_bf16(Bt[n][0], At[m][0], zc_, 0, 0, 0); \
        acc[ai][bj][m][n] = __builtin_amdgcn_mfma_f32_16x16x32_bf16(Bt[n][1], At[m][1], acc[ai][bj][m][n], 0, 0, 0); } __builtin_amdgcn_s_setprio(0); } while (0)
#define PG8_WAIT_V(n) asm volatile("s_waitcnt vmcnt(" #n ")" ::: "memory")
#define PG8_WAIT_L(n) asm volatile("s_waitcnt lgkmcnt(" #n ")" ::: "memory")
#define PG8_BAR __builtin_amdgcn_s_barrier()
#define PG8_SCHED __builtin_amdgcn_sched_barrier(0)
    Unit cur, nxt; int ui = 0;
    if (!S.next(0, cur)) return;
    f32x4 acc[2][2][4][2];
#define PG8_ZERO do { _Pragma("unroll") for (int a = 0; a < 2; ++a) _Pragma("unroll") for (int b = 0; b < 2; ++b) _Pragma("unroll") for (int m = 0; m < 4; ++m) _Pragma("unroll") for (int n = 0; n < 2; ++n) acc[a][b][m][n] = (f32x4){0.f, 0.f, 0.f, 0.f}; } while (0)
    if constexpr (!PEEL) PG8_ZERO;
    bf16x8 At[4][2], B0[2][2], B1[2][2];
    unsigned cgo[2][2];
    if constexpr (Sched::GATHER) PG8_GO(cur);
    const char* cA = (const char*)(g.A + (size_t)cur.ab * g.a_sel_stride) + (size_t)cur.pm * tstep; const char* cB = (const char*)g.Bt + (size_t)cur.bt * tstep;
    S.a_ready(cur);
    if constexpr (SP2) {
        PG8_STAGE(PG8_SB(0, 0), cB, voffB); PG8_STAGE(PG8_SB(0, 1), cB + hstep, voffB); PG8_STAGE_A(PG8_SA(0, 0), cA, 0, (size_t)0, false); PG8_STAGE_A(PG8_SA(0, 1), cA, 1, (size_t)0, false);
        if (wr == 1) PG8_BAR;
        PG8_WAIT_V(2); PG8_BAR;
        PG8_STAGE(PG8_SB(1, 0), cB + kstep, voffB); PG8_STAGE_A(PG8_SA(1, 0), cA, 0, kstep, false); PG8_STAGE(PG8_SB(1, 1), cB + hstep + kstep, voffB);
        PG8_WAIT_V(6); PG8_BAR;
    } else {
        PG8_STAGE(PG8_SB(0, 0), cB, voffB); PG8_STAGE_A(PG8_SA(0, 0), cA, 0, (size_t)0, false); PG8_STAGE(PG8_SB(0, 1), cB + hstep, voffB); PG8_STAGE_A(PG8_SA(0, 1), cA, 1, (size_t)0, false);
        if (wr == 1) PG8_BAR;
        PG8_WAIT_V(4); PG8_BAR;
        PG8_STAGE(PG8_SB(1, 0), cB + kstep, voffB); PG8_STAGE_A(PG8_SA(1, 0), cA, 0, kstep, false); PG8_STAGE(PG8_SB(1, 1), cB + hstep + kstep, voffB);
        PG8_WAIT_V(6); PG8_BAR;
    }
    static_assert(SP2, "only the SP2 schedule is kept");
#define PG8_ITER(MMA_FIRST) do { \
            const bool last = (t == nt - 2); \
            const size_t k1 = (size_t)(t + 1) * kstep; \
            const char* a2b = last ? nA : cA; const size_t k2 = last ? (size_t)0 : (size_t)(t + 2) * kstep; const size_t k3 = k2 + kstep; \
            const char* b2 = last ? nB : cB + (size_t)(t + 2) * kstep; const char* b3 = b2 + kstep; \
            if (last && has_next) S.a_ready(nxt); \
            PG8_LDB(B0, 0, 0); PG8_LDB(B1, 0, 1); PG8_SCHED; PG8_LDA(At, 0, 0); PG8_STAGE_A(PG8_SA(1, 1), cA, 1, k1, false); \
            if constexpr (Sched::GATHER) { if (last && has_next) PG8_GO(nxt); } \
            PG8_WAIT_V(8); PG8_WAIT_L(0); PG8_BAR; MMA_FIRST(0, 0, At, B0); MMA_FIRST(0, 1, At, B1); PG8_BAR; PG8_SCHED; \
            PG8_LDA(At, 0, 1); PG8_STAGE(PG8_SB(0, 0), b2, voffB); PG8_STAGE(PG8_SB(0, 1), b2 + hstep, voffB); PG8_STAGE_A(PG8_SA(0, 0), a2b, 0, k2, last); \
            PG8_WAIT_V(8); PG8_WAIT_L(0); PG8_BAR; MMA_FIRST(1, 0, At, B0); MMA_FIRST(1, 1, At, B1); PG8_BAR; PG8_SCHED; \
            PG8_LDB(B0, 1, 0); PG8_LDB(B1, 1, 1); PG8_SCHED; PG8_LDA(At, 1, 0); PG8_STAGE_A(PG8_SA(0, 1), a2b, 1, k2, last); \
            PG8_WAIT_V(8); PG8_WAIT_L(0); PG8_BAR; PG8_MMA(0, 0, At, B0); PG8_MMA(0, 1, At, B1); PG8_BAR; PG8_SCHED; \
            PG8_LDA(At, 1, 1); PG8_STAGE(PG8_SB(1, 0), b3, voffB); PG8_STAGE(PG8_SB(1, 1), b3 + hstep, voffB); PG8_STAGE_A(PG8_SA(1, 0), a2b, 0, k3, last); \
            PG8_WAIT_V(8); PG8_WAIT_L(0); PG8_BAR; PG8_MMA(1, 0, At, B0); PG8_MMA(1, 1, At, B1); PG8_BAR; PG8_SCHED; } while (0)
    for (;;) {
        const bool has_next = S.next(ui + 1, nxt);
        const char* nA = has_next ? (const char*)(g.A + (size_t)nxt.ab * g.a_sel_stride) + (size_t)nxt.pm * tstep : cA; const char* nB = has_next ? (const char*)g.Bt + (size_t)nxt.bt * tstep : cB;
        if constexpr (PEEL) { { const int t = 0; f32x4 zc_ = (f32x4){0.f, 0.f, 0.f, 0.f}; asm volatile("" : "+v"(zc_)); PG8_ITER(PG8_MMAZ); }
#pragma nounroll
            for (int t = 2; t < nt; t += 2) { PG8_ITER(PG8_MMA); } }
        else {
#pragma nounroll
            for (int t = 0; t < nt; t += 2) { PG8_ITER(PG8_MMA); } }
        if constexpr (ALIGN_EPI) { if (wr == 0) PG8_BAR; }
        E(acc, cur, wr, wc, fr, fq); S.done(cur);
        if (!has_next) break;
        if constexpr (!PEEL) PG8_ZERO;
        cur = nxt; cA = nA; cB = nB; ++ui;
        if constexpr (ALIGN_EPI) { if (wr == 1) PG8_BAR; }
    }
#undef PG8_ITER
#undef PG8_ZERO
#undef PG8_MMAZ
    PG8_WAIT_V(0);
    if constexpr (!ALIGN_EPI) { if (wr == 0) PG8_BAR; }
    PG8_BAR;
#undef PG8_SA
#undef PG8_SB
#undef PG8_STAGE
#undef PG8_STAGE_A
#undef PG8_GO
#undef PG8_LDA
#undef PG8_LDB
#undef PG8_MMA
#undef PG8_WAIT_V
#undef PG8_WAIT_L
#undef PG8_BAR
#undef PG8_SCHED
}

struct EpiBf16 {
    static constexpr bool PERM = true;
    bf16_t* O; int ldc;
    __device__ __forceinline__ void operator()(const f32x4 (&acc)[2][2][4][2], const Unit& u, int wr, int wc, int fr, int fq) const {
        const int row0 = u.pm * BM + wr * 64 + fr, col0 = u.pn * BM + wc * 32 + 8 * fq;
#pragma unroll
        for (int ai = 0; ai < 2; ++ai)
#pragma unroll
            for (int m = 0; m < 4; ++m) { bf16_t* rowp = O + (size_t)(row0 + ai * HALF + m * 16) * ldc + col0;
#pragma unroll
                for (int bj = 0; bj < 2; ++bj) { const f32x4 v0 = acc[ai][bj][m][0], v1 = acc[ai][bj][m][1];
                    u32x4 w; w.x = cvt_pk_bf16(v0[0], v0[1]); w.y = cvt_pk_bf16(v0[2], v0[3]); w.z = cvt_pk_bf16(v1[0], v1[1]); w.w = cvt_pk_bf16(v1[2], v1[3]);
                    *(u32x4*)(rowp + bj * HALF) = w; } }
    }
};
__device__ __forceinline__ unsigned pk4_fp8(float a, float b, float c, float d) { int w = 0; w = __builtin_amdgcn_cvt_pk_fp8_f32(a, b, w, false); w = __builtin_amdgcn_cvt_pk_fp8_f32(c, d, w, true); return (unsigned)w; }
__device__ __forceinline__ f32x4 clamp_fp8(f32x4 v, float sc) { f32x4 r; r[0] = __builtin_amdgcn_fmed3f(v[0] * sc, -440.f, 440.f); r[1] = __builtin_amdgcn_fmed3f(v[1] * sc, -440.f, 440.f);
    r[2] = __builtin_amdgcn_fmed3f(v[2] * sc, -440.f, 440.f); r[3] = __builtin_amdgcn_fmed3f(v[3] * sc, -440.f, 440.f); return r; }
struct EpiFp8 {
    static constexpr bool PERM = false;
    unsigned char* O; int ldc; float scale;
    __device__ __forceinline__ void operator()(const f32x4 (&acc)[2][2][4][2], const Unit& u, int wr, int wc, int fr, int fq) const {
        const int row0 = u.pm * BM + wr * 64 + fr, col0 = u.pn * BM + wc * 64 + 16 * fq;
#pragma unroll
        for (int ai = 0; ai < 2; ++ai)
#pragma unroll
            for (int m = 0; m < 4; ++m) { unsigned char* rowp = O + (size_t)(row0 + ai * HALF + m * 16) * ldc + col0;
                const f32x4 v0 = clamp_fp8(acc[ai][0][m][0], scale), v1 = clamp_fp8(acc[ai][0][m][1], scale), v2 = clamp_fp8(acc[ai][1][m][0], scale), v3 = clamp_fp8(acc[ai][1][m][1], scale);
                u32x4 w; w.x = pk4_fp8(v0[0], v0[1], v0[2], v0[3]); w.y = pk4_fp8(v1[0], v1[1], v1[2], v1[3]); w.z = pk4_fp8(v2[0], v2[1], v2[2], v2[3]); w.w = pk4_fp8(v3[0], v3[1], v3[2], v3[3]);
                *(u32x4*)rowp = w; }
    }
};
struct EpiGlu {
    static constexpr bool PERM = true;
    const bf16_t* Ysrc; bf16_t* O; const float* bias;
    __device__ __forceinline__ void operator()(const f32x4 (&acc)[2][2][4][2], const Unit& u, int wr, int wc, int fr, int fq) const {
        const int row0 = u.pm * BM + wr * 64 + fr, col0 = u.pn * BM + wc * 32 + 8 * fq;
#pragma unroll
        for (int ai = 0; ai < 2; ++ai)
#pragma unroll
            for (int m = 0; m < 4; ++m) { const size_t ro = (size_t)(row0 + ai * HALF + m * 16) * 256 + col0;
#pragma unroll
                for (int bj = 0; bj < 2; ++bj) { const f32x4 v0 = acc[ai][bj][m][0], v1 = acc[ai][bj][m][1];
                    const u32x4 yv = *(const u32x4*)(Ysrc + ro + bj * HALF);
                    const f32x4 b0 = *(const f32x4*)(bias + col0 + bj * HALF), b1 = *(const f32x4*)(bias + col0 + bj * HALF + 4);
                    float o[8];
                    o[0] = bflo(yv.x) * sigmoidf_(v0[0] + b0[0]); o[1] = bfhi(yv.x) * sigmoidf_(v0[1] + b0[1]); o[2] = bflo(yv.y) * sigmoidf_(v0[2] + b0[2]); o[3] = bfhi(yv.y) * sigmoidf_(v0[3] + b0[3]);
                    o[4] = bflo(yv.z) * sigmoidf_(v1[0] + b1[0]); o[5] = bfhi(yv.z) * sigmoidf_(v1[1] + b1[1]); o[6] = bflo(yv.w) * sigmoidf_(v1[2] + b1[2]); o[7] = bfhi(yv.w) * sigmoidf_(v1[3] + b1[3]);
                    u32x4 w; w.x = cvt_pk_bf16(o[0], o[1]); w.y = cvt_pk_bf16(o[2], o[3]); w.z = cvt_pk_bf16(o[4], o[5]); w.w = cvt_pk_bf16(o[6], o[7]);
                    *(u32x4*)(O + ro + bj * HALF) = w; } }
    }
};
struct EpiGateMerge {
    static constexpr bool PERM = true;
    const unsigned char* P; bf16_t* Mg; float pinv;
    __device__ __forceinline__ void operator()(const f32x4 (&acc)[2][2][4][2], const Unit& u, int wr, int wc, int fr, int fq) const {
        const int i = u.pn >> 2, mt = u.pn & 3;
        const int row0 = u.pm * BM + wr * 64 + fr, col0 = mt * BM + wc * 32 + 8 * fq;
#pragma unroll
        for (int ai = 0; ai < 2; ++ai) {
            u32x2 pv[4][2]; u32x4 pvb[4][2]; u32x4 mv[4][2];
#pragma unroll
            for (int m = 0; m < 4; ++m)
#pragma unroll
                for (int bj = 0; bj < 2; ++bj) { const size_t r = (size_t)(row0 + ai * HALF + m * 16);
                    pv[m][bj] = PFP8 ? *(const u32x2*)(P + r * 4096 + i * 1024 + col0 + bj * HALF) : (u32x2){0u, 0u}; if (!PFP8) pvb[m][bj] = *(const u32x4*)((const bf16_t*)P + r * 4096 + i * 1024 + col0 + bj * HALF);
                    mv[m][bj] = (u32x4){0u, 0u, 0u, 0u}; if (i > 0) mv[m][bj] = *(const u32x4*)(Mg + r * 1024 + col0 + bj * HALF); }
#pragma unroll
            for (int m = 0; m < 4; ++m)
#pragma unroll
                for (int bj = 0; bj < 2; ++bj) { const size_t r = (size_t)(row0 + ai * HALF + m * 16); const f32x4 v0 = acc[ai][bj][m][0], v1 = acc[ai][bj][m][1]; const u32x2 p8 = pv[m][bj]; const u32x4 m4 = mv[m][bj];
                    f32x2 pa = __builtin_amdgcn_cvt_pk_f32_fp8((int)p8.x, false) * pinv, pb = __builtin_amdgcn_cvt_pk_f32_fp8((int)p8.x, true) * pinv,
                          pc = __builtin_amdgcn_cvt_pk_f32_fp8((int)p8.y, false) * pinv, pd = __builtin_amdgcn_cvt_pk_f32_fp8((int)p8.y, true) * pinv;
                    if (!PFP8) { const u32x4 q4 = pvb[m][bj]; pa = (f32x2){bflo(q4.x), bfhi(q4.x)}; pb = (f32x2){bflo(q4.y), bfhi(q4.y)}; pc = (f32x2){bflo(q4.z), bfhi(q4.z)}; pd = (f32x2){bflo(q4.w), bfhi(q4.w)}; }
                    float o[8];
                    o[0] = bflo(m4.x) + pa[0] * sigmoidf_(v0[0]); o[1] = bfhi(m4.x) + pa[1] * sigmoidf_(v0[1]); o[2] = bflo(m4.y) + pb[0] * sigmoidf_(v0[2]); o[3] = bfhi(m4.y) + pb[1] * sigmoidf_(v0[3]);
                    o[4] = bflo(m4.z) + pc[0] * sigmoidf_(v1[0]); o[5] = bfhi(m4.z) + pc[1] * sigmoidf_(v1[1]); o[6] = bflo(m4.w) + pd[0] * sigmoidf_(v1[2]); o[7] = bfhi(m4.w) + pd[1] * sigmoidf_(v1[3]);
                    u32x4 w; w.x = cvt_pk_bf16(o[0], o[1]); w.y = cvt_pk_bf16(o[2], o[3]); w.z = cvt_pk_bf16(o[4], o[5]); w.w = cvt_pk_bf16(o[6], o[7]);
                    *(u32x4*)(Mg + r * 1024 + col0 + bj * HALF) = w; }
        }
    }
};
struct EpiGateMerge4 {
    static constexpr bool PERM = false;
    const unsigned char* P; bf16_t* Mg; float pinv;
    __device__ __forceinline__ void operator()(const f32x4 (&acc)[2][2][4][2], const Unit& u, int wr, int wc, int fr, int fq) const {
        const int row0 = u.pm * BM + wr * 64 + fr, col0 = u.pn * 64 + wc * 16 + 4 * fq;
#pragma unroll
        for (int ai = 0; ai < 2; ++ai) {
            unsigned pv[4][4];
#pragma unroll
            for (int m = 0; m < 4; ++m)
#pragma unroll
                for (int b = 0; b < 4; ++b) pv[m][b] = *(const unsigned*)(P + (size_t)(row0 + ai * HALF + m * 16) * 4096 + b * 1024 + col0);
#pragma unroll
            for (int m = 0; m < 4; ++m) { f32x4 o = (f32x4){0.f, 0.f, 0.f, 0.f};
#pragma unroll
                for (int b = 0; b < 4; ++b) { const f32x4 v = acc[ai][b >> 1][m][b & 1]; const f32x2 pa = __builtin_amdgcn_cvt_pk_f32_fp8((int)pv[m][b], false), pb = __builtin_amdgcn_cvt_pk_f32_fp8((int)pv[m][b], true);
                    o[0] += pa[0] * sigmoidf_(v[0]); o[1] += pa[1] * sigmoidf_(v[1]); o[2] += pb[0] * sigmoidf_(v[2]); o[3] += pb[1] * sigmoidf_(v[3]); }
                u32x2 w; w.x = cvt_pk_bf16(o[0] * pinv, o[1] * pinv); w.y = cvt_pk_bf16(o[2] * pinv, o[3] * pinv);
                *(u32x2*)(Mg + (size_t)(row0 + ai * HALF + m * 16) * 1024 + col0) = w; }
        }
    }
};
struct EpiResid {
    static constexpr bool PERM = false;
    const float* xin; bf16_t* out; const float* gate;
    __device__ __forceinline__ void operator()(const f32x4 (&acc)[2][2][4][2], const Unit& u, int wr, int wc, int fr, int fq) const {
        const int row0 = u.pm * BM + wr * 64 + fr, col0 = u.pn * BM + wc * 64 + 8 * fq;
        const int b = (u.pm * BM) / SEQ;
        f32x4 gv[2][2];
#pragma unroll
        for (int bj = 0; bj < 2; ++bj)
#pragma unroll
            for (int n = 0; n < 2; ++n) gv[bj][n] = *(const f32x4*)(gate + b * 3072 + 2048 + col0 + bj * 32 + n * 4) + 1.0f;
#pragma unroll
        for (int ai = 0; ai < 2; ++ai)
#pragma unroll
            for (int mh = 0; mh < 4; mh += 2) {
                f32x4 xv[2][2][2];
#pragma unroll
                for (int m = 0; m < 2; ++m)
#pragma unroll
                    for (int bj = 0; bj < 2; ++bj)
#pragma unroll
                        for (int n = 0; n < 2; ++n) xv[m][bj][n] = *(const f32x4*)(xin + (size_t)(row0 + ai * HALF + (mh + m) * 16) * D + col0 + bj * 32 + n * 4);
#pragma unroll
                for (int m = 0; m < 2; ++m)
#pragma unroll
                    for (int bj = 0; bj < 2; ++bj) { const f32x4 v0 = xv[m][bj][0] * DN_ALPHA + gv[bj][0] * acc[ai][bj][mh + m][0], v1 = xv[m][bj][1] * DN_ALPHA + gv[bj][1] * acc[ai][bj][mh + m][1];
                        u32x4 w; w.x = cvt_pk_bf16(v0[0], v0[1]); w.y = cvt_pk_bf16(v0[2], v0[3]); w.z = cvt_pk_bf16(v1[0], v1[1]); w.w = cvt_pk_bf16(v1[2], v1[3]);
                        *(u32x4*)(out + (size_t)(row0 + ai * HALF + (mh + m) * 16) * D + col0 + bj * 32) = w; } }
    }
};
struct EpiMoe1 {
    static constexpr bool PERM = false;
    bf16_t* Act; const LAS float* gtab;
    __device__ __forceinline__ void operator()(const f32x4 (&acc)[2][2][4][2], const Unit& u, int wr, int wc, int fr, int fq) const {
        const int row0 = u.pm * BM + wr * 64 + fr, f0 = u.pn * 128 + wc * 32 + 8 * fq;
#pragma unroll
        for (int ai = 0; ai < 2; ++ai)
#pragma unroll
            for (int m = 0; m < 4; ++m) { const int r = row0 + ai * HALF + m * 16; const float gt = gtab[u.ab * 256 + wr * 64 + fr + ai * HALF + m * 16];
                const f32x4 a0 = acc[ai][0][m][0], b0 = acc[ai][0][m][1], a1 = acc[ai][1][m][0], b1 = acc[ai][1][m][1];
                u32x4 w; w.x = cvt_pk_bf16(siluf_(a0[0]) * b0[0] * gt, siluf_(a0[1]) * b0[1] * gt); w.y = cvt_pk_bf16(siluf_(a0[2]) * b0[2] * gt, siluf_(a0[3]) * b0[3] * gt);
                w.z = cvt_pk_bf16(siluf_(a1[0]) * b1[0] * gt, siluf_(a1[1]) * b1[1] * gt); w.w = cvt_pk_bf16(siluf_(a1[2]) * b1[2] * gt, siluf_(a1[3]) * b1[3] * gt);
                *(u32x4*)(Act + (size_t)r * 256 + f0) = w; }
    }
};
}

#define XB_TMO      128
#define XB_XCNT(j)  (256  + 64 * (j))
#define XB_XSUB(j)  (1280 + 64 * (j))
#define XB_XGEN(j)  (2304 + 64 * (j))
#define XB_TOP      3328
#define XB_TOPGEN   3392
#define XCD_BAR_WORDS 3456
#define XB_SPIN_CAP (1u << 22)
__device__ __forceinline__ unsigned xb_ld(unsigned* p)              { return __hip_atomic_load(p, __ATOMIC_RELAXED, __HIP_MEMORY_SCOPE_AGENT); }
__device__ __forceinline__ unsigned xb_add(unsigned* p, unsigned v) { return __hip_atomic_fetch_add(p, v, __ATOMIC_RELAXED, __HIP_MEMORY_SCOPE_AGENT); }
__device__ __forceinline__ unsigned xb_xcc_id() { return (unsigned)__builtin_amdgcn_s_getreg((3 << 11) | 20) & 0xFu; }
#define XB_SPIN(cond, bar) do { unsigned _sp = 0; while (cond) { __builtin_amdgcn_s_sleep(1); \
    if ((++_sp & 255u) == 0u) { if (xb_ld(&(bar)[XB_TMO])) break; if (_sp > XB_SPIN_CAP) { atomicAdd(&(bar)[XB_TMO], 1u); break; } } } } while (0)
struct XcdBarrier { unsigned* bar; unsigned x; volatile LAS unsigned* st; };
__device__ __forceinline__ XcdBarrier xcd_barrier_post(unsigned* bar, volatile LAS unsigned* st) {
    XcdBarrier b; b.bar = bar; b.x = xb_xcc_id(); b.st = st;
    if (threadIdx.x == 0) (void)xb_add(&bar[XB_XCNT(b.x)], 1u);
    return b;
}
__device__ __forceinline__ void xcd_barrier_complete(unsigned* bar, unsigned x, unsigned& nloc, unsigned& nx) {
    const unsigned G = gridDim.x * gridDim.y * gridDim.z;
    unsigned sum, cnt, mine, sp = 0u;
    for (;;) {
        sum = 0u; cnt = 0u; mine = 0u;
#pragma unroll
        for (unsigned j = 0; j < 16; ++j) { const unsigned c = xb_ld(&bar[XB_XCNT(j)]); sum += c; cnt += (c > 0u) ? 1u : 0u; mine = (j == x) ? c : mine; }
        if (sum == G) break;
        __builtin_amdgcn_s_sleep(1);
        if ((++sp & 255u) == 0u) { if (xb_ld(&bar[XB_TMO])) break; if (sp > XB_SPIN_CAP) { atomicAdd(&bar[XB_TMO], 1u); break; } }
    }
    nloc = mine > 0u ? mine : 1u; nx = cnt > 0u ? cnt : 1u;
}
__device__ __forceinline__ void xcd_barrier(const XcdBarrier& b) {
    asm volatile("s_waitcnt vmcnt(0)" ::: "memory");
    __syncthreads();
    if (threadIdx.x == 0) {
        unsigned* bar = b.bar; asm volatile("" : "+s"(bar));
        __builtin_amdgcn_s_waitcnt(0);
        unsigned nloc = b.st[0], nx = b.st[1];
        if (nloc == 0u) { xcd_barrier_complete(bar, b.x, nloc, nx); b.st[0] = nloc; b.st[1] = nx; }
        const unsigned old = xb_add(&bar[XB_XSUB(b.x)], 1u);
        const unsigned gen = old / nloc;
        if (old + 1u == (gen + 1u) * nloc) {
            __builtin_amdgcn_fence(__ATOMIC_RELEASE, "agent");
            asm volatile("s_waitcnt vmcnt(0)" ::: "memory");
            const unsigned og = xb_add(&bar[XB_TOP], 1u);
            const unsigned tg = og / nx;
            if (og + 1u == (tg + 1u) * nx) xb_add(&bar[XB_TOPGEN], 1u);
            else XB_SPIN(xb_ld(&bar[XB_TOPGEN]) == tg, bar);
            __builtin_amdgcn_fence(__ATOMIC_ACQUIRE, "agent");
            xb_add(&bar[XB_XGEN(b.x)], 1u);
            asm volatile("s_waitcnt vmcnt(0)" ::: "memory");
        } else {
            XB_SPIN(xb_ld(&bar[XB_XGEN(b.x)]) == gen, bar);
            __builtin_amdgcn_fence(__ATOMIC_ACQUIRE, "agent");
            asm volatile("s_waitcnt vmcnt(0)" ::: "memory");
        }
    }
    __syncthreads();
}

struct Args {
    const float* in[43]; const int* positions; float* out; unsigned char* ws; int ph_lo, ph_hi, dbg, pad;
};
enum { I_X = 0, I_C = 1, I_POS = 2, I_MOD1W = 3, I_MOD1B = 4, I_WIN = 5, I_GMLNG = 6, I_GMLNB = 7, I_GMW = 8, I_GMB = 9,
       I_S5LRE = 10, I_S5LIM = 11, I_S5STEP = 12, I_S5BRE = 13, I_S5BIM = 14, I_S5CRE = 15, I_S5CIM = 16, I_S5D = 17, I_S5GLUW = 18, I_S5GLUB = 19,
       I_CONVW = 20, I_CONVB = 21, I_DTBIAS = 22, I_ALOG = 23, I_SSDD = 24, I_SSDNG = 25, I_WBR = 26, I_WGATE = 27, I_WOUT = 28, I_LN1G = 29, I_LN1B = 30,
       I_MOD2W = 31, I_MOD2B = 32, I_RW = 33, I_RB = 34, I_EW1 = 35, I_EW3 = 36, I_EW2 = 37, I_SW1 = 38, I_SW3 = 39, I_SW2 = 40, I_LN2G = 41, I_LN2B = 42 };

typedef const __attribute__((address_space(4))) Args* ArgsP;
struct Ctx {
    ArgsP a; unsigned char* ws; LAS unsigned char* lds; int tid, lane, wave, c, G, bx, dbg;
    __device__ __forceinline__ const float* in(int i) const { return a->in[i]; }
    __device__ __forceinline__ bf16_t* proj() const { return (bf16_t*)(ws + WS_PROJ); }
    __device__ __forceinline__ bf16_t* hbuf() const { return (bf16_t*)(ws + WS_H); }
    __device__ __forceinline__ bf16_t* ybuf() const { return (bf16_t*)(ws + WS_Y); }
    __device__ __forceinline__ float* modv(int l, int w) const { return (float*)(ws + WS_MODV) + (size_t)(l * 2 + w) * NB * 3072; }
};

__device__ __forceinline__ void ph_prologue(const Ctx& X) {
    { float* ropet = (float*)(X.ws + WS_ROPE); const int* pos = X.a->positions;
      for (int i = X.c * 512 + X.tid; i < M * 8; i += X.G * 512) { const int tok = i >> 3, j = i & 7;
          const float inv = (j == 0) ? 1.0f : (j == 1) ? 0.1939227432f : (j == 2) ? 0.0376060307f : (j == 3) ? 0.00729266461f : (j == 4) ? 0.00141421356f : (j == 5) ? 0.000274248188f : (j == 6) ? 5.31829610e-05f : 1.03133862e-05f;
          float sn, cs; sincos_red((float)pos[tok] * inv, sn, cs); *(f32x2*)(ropet + (size_t)i * 2) = (f32x2){cs, sn}; } }
    LAS float* red = (LAS float*)X.lds;
    for (int it = X.c; it < DEPTH * 2 * 48; it += X.G) {
        const int l = it / 96, w = (it / 48) & 1, jb = it % 48, j = jb * 64 + X.lane;
        const float* W = X.in(w ? I_MOD2W : I_MOD1W) + (size_t)l * D * 3072; const float* cv = X.in(I_C);
        float a0 = 0.f, a1 = 0.f, a2 = 0.f, a3 = 0.f;
        const int k0 = X.wave * 128;
        for (int k = k0; k < k0 + 128; ++k) { const float wv = W[(size_t)k * 3072 + j]; a0 += cv[k] * wv; a1 += cv[D + k] * wv; a2 += cv[2 * D + k] * wv; a3 += cv[3 * D + k] * wv; }
        red[(X.wave * 4 + 0) * 64 + X.lane] = a0; red[(X.wave * 4 + 1) * 64 + X.lane] = a1; red[(X.wave * 4 + 2) * 64 + X.lane] = a2; red[(X.wave * 4 + 3) * 64 + X.lane] = a3;
        __syncthreads();
        if (X.tid < 256) { const int b = X.tid >> 6, ln = X.tid & 63; float s = 0.f;
#pragma unroll
            for (int q = 0; q < 8; ++q) s += red[(q * 4 + b) * 64 + ln];
            const int jj = jb * 64 + ln; X.modv(l, w)[b * 3072 + jj] = s + X.in(w ? I_MOD2B : I_MOD1B)[(size_t)l * 3072 + jj]; }
        __syncthreads();
    }
}

template <class Src, int RMODE = 0>
__device__ __forceinline__ void tr_item(const Src& src, bf16_t* WT, int K, int rowbase, int kb, int nb, LAS float* scr, int lane) {
    const int k0 = 64 * kb, n0 = 32 * nb;
    f32x4 v[8];
#pragma unroll
    for (int i = 0; i < 8; ++i) v[i] = src.load4(k0 + 8 * i + (lane >> 3), n0 + 4 * (lane & 7));
#pragma unroll
    for (int i = 0; i < 8; ++i) { LAS float* d = scr + (8 * i + (lane >> 3)) * 33 + 4 * (lane & 7); d[0] = v[i][0]; d[1] = v[i][1]; d[2] = v[i][2]; d[3] = v[i][3]; }
    asm volatile("s_waitcnt lgkmcnt(0)" ::: "memory");
    const int c = lane & 7;
#pragma unroll
    for (int j = 0; j < 4; ++j) { const int n = (lane >> 3) + 8 * j; const LAS float* s = scr + (8 * c) * 33 + n;
        u32x4 o; o.x = pk2(s[0 * 33], s[1 * 33]); o.y = pk2(s[2 * 33], s[3 * 33]); o.z = pk2(s[4 * 33], s[5 * 33]); o.w = pk2(s[6 * 33], s[7 * 33]);
        int row = rowbase + n0 + n;
        if constexpr (RMODE == 1) { const int cc = n0 + n, bi = rowbase >> 10; row = 256 * (cc >> 6) + 128 * (bi >> 1) + 32 * ((cc >> 4) & 3) + 16 * (bi & 1) + (cc & 15); }
        if constexpr (RMODE == 2) { const int cc = n0 + n; row = rowbase + (cc & ~255) + 128 * ((cc >> 3) & 1) + 32 * ((cc >> 6) & 3) + 16 * ((cc >> 2) & 1) + 4 * ((cc >> 4) & 3) + (cc & 3); }
        if constexpr (RMODE == 3) { const int cc = n0 + n; row = rowbase + (cc & ~255) + 128 * ((cc >> 5) & 1) + 32 * ((cc >> 6) & 3) + 16 * ((cc >> 2) & 1) + 4 * ((cc >> 3) & 3) + (cc & 3); }
        *(u32x4*)(WT + (size_t)row * K + k0 + 8 * c) = o; }
    asm volatile("s_waitcnt lgkmcnt(0)" ::: "memory");
}
struct SrcPlain { const float* W; int N; __device__ __forceinline__ f32x4 load4(int k, int n) const { return *(const f32x4*)(W + (size_t)k * N + n); } };
struct SrcWin { const float* W; __device__ __forceinline__ f32x4 load4(int k, int n) const {
    if (n >= D_IN) return (f32x4){0.f, 0.f, 0.f, 0.f}; const int o = (n < 1216) ? n : (n < 2240) ? n + 4 : (n < 2244) ? 1216 + (n - 2240) : n; return *(const f32x4*)(W + (size_t)k * D_IN + o); } };
struct Src13 { const float* W1; const float* W3; __device__ __forceinline__ f32x4 load4(int k, int n) const {
    const int f = (n >> 8) * 128 + ((n >> 5) & 3) * 32 + ((n >> 2) & 3) * 8 + ((n >> 7) & 1) * 4 + (n & 3); const long d = (n & 16) ? (long)(W3 - W1) : 0l;     return *(const f32x4*)(W1 + d + (long)k * 256 + f); } };

__device__ __forceinline__ void ph_wconv(const Ctx& X, int l) {
    LAS float* scr = (LAS float*)(X.lds + X.wave * 16384);
    unsigned char* wb = X.ws + WS_W;
    const int gw = X.c * 8 + X.wave, NGW = X.G * 8;
    constexpr int I_A = 16 * 72, I_B = 4 * 16 * 32, I_C2 = 4 * 4 * 32, I_D = 16 * 32, I_E = 4 * 8, I_F = NE1 * 16 * 16, I_G = NE1 * 4 * 32;
    constexpr int NIT = I_A + I_B + I_C2 + I_D + I_E + I_F + I_G;
    for (int it = gw; it < NIT; it += NGW) {
        int r = it;
        if (r < I_A) { SrcWin s{X.in(I_WIN) + (size_t)l * D * D_IN}; tr_item(s, (bf16_t*)(wb + WO_IN), 1024, 0, r / 72, r % 72, scr, X.lane); continue; } r -= I_A;
        if (r < I_B) { const int i = r / 512, q = r % 512; SrcPlain s{X.in(I_WGATE) + ((size_t)l * 4 + i) * D * D, D}; tr_item<SrcPlain, 1>(s, (bf16_t*)(wb + WO_GATE), 1024, i * 1024, q / 32, q % 32, scr, X.lane); continue; } r -= I_B;
        if (r < I_C2) { const int i = r / 128, q = r % 128; SrcPlain s{X.in(I_WBR) + ((size_t)l * 4 + i) * 256 * D, D}; tr_item<SrcPlain, 2>(s, (bf16_t*)(wb + WO_BR) + (size_t)i * 1024 * 256, 256, 0, q / 32, q % 32, scr, X.lane); continue; } r -= I_C2;
        if (r < I_D) { SrcPlain s{X.in(I_WOUT) + (size_t)l * D * D, D}; tr_item<SrcPlain, 3>(s, (bf16_t*)(wb + WO_OUT), 1024, 0, r / 32, r % 32, scr, X.lane); continue; } r -= I_D;
        if (r < I_E) { SrcPlain s{X.in(I_S5GLUW) + (size_t)l * 256 * 256, 256}; tr_item(s, (bf16_t*)(wb + WO_GLU), 256, 0, r / 8, r % 8, scr, X.lane); continue; } r -= I_E;
        if (r < I_F) { const int e = r / 256, q = r % 256;
            const Src13 s{(e < NEXP) ? X.in(I_EW1) + ((size_t)l * NEXP + e) * D * 256 : X.in(I_SW1) + (size_t)l * D * 256, (e < NEXP) ? X.in(I_EW3) + ((size_t)l * NEXP + e) * D * 256 : X.in(I_SW3) + (size_t)l * D * 256};
            tr_item(s, (bf16_t*)(wb + WO_13) + (size_t)e * 512 * 1024, 1024, 0, q / 16, q % 16, scr, X.lane); continue; } r -= I_F;
        { const int e = r / 128, q = r % 128; SrcPlain s{e < NEXP ? X.in(I_EW2) + ((size_t)l * NEXP + e) * 256 * D : X.in(I_SW2) + (size_t)l * 256 * D, D};
            tr_item<SrcPlain, 2>(s, (bf16_t*)(wb + WO_2) + (size_t)e * 1024 * 256, 256, 0, q / 32, q % 32, scr, X.lane); }
    }
    const int gt = X.c * 512 + X.tid, NGT = X.G * 512;
    { bf16_t* gmw = (bf16_t*)(X.ws + WS_GMW); const float* src = X.in(I_GMW) + (size_t)l * 4 * 128 * 128;
      for (int i = gt; i < 4 * 128 * 128; i += NGT) { const int t = (i >> 7) & 127, s = i & 127; gmw[i] = (bf16_t)f2bf(s <= t ? src[i] : 0.f); } }
    for (int i = gt; i < 16 * 64; i += NGT) {
        const int g = i >> 6, p = i & 63;
        const float step = expf(X.in(I_S5STEP)[l * 16 + g]); const float lr = X.in(I_S5LRE)[(size_t)l * 1024 + i], li = X.in(I_S5LIM)[(size_t)l * 1024 + i];
        const float mag = expf(lr * step); float sn, cs; sincos_red(li * step, sn, cs);
        const float abr = mag * cs, abi = mag * sn, den = lr * lr + li * li, nr = abr - 1.0f;
        const float cr = (nr * lr + abi * li) / den, ci = (abi * lr - nr * li) / den;
        float* sa = (float*)(X.ws + WS_S5A); sa[i * 2] = abr; sa[i * 2 + 1] = abi;
        bf16_t* bb = (bf16_t*)(X.ws + WS_S5B); bf16_t* cm = (bf16_t*)(X.ws + WS_S5C);
        const float* bre = X.in(I_S5BRE) + ((size_t)l * 1024 + i) * 16; const float* bim = X.in(I_S5BIM) + ((size_t)l * 1024 + i) * 16;
#pragma unroll
        for (int ch = 0; ch < 16; ++ch) { const float br = bre[ch], bi = bim[ch];
            bb[(g * 128 + p) * 16 + ch] = (bf16_t)f2bf(cr * br - ci * bi); bb[(g * 128 + 64 + p) * 16 + ch] = (bf16_t)f2bf(cr * bi + ci * br);
            cm[(g * 16 + ch) * 128 + p] = (bf16_t)f2bf(X.in(I_S5CRE)[(((size_t)l * 16 + g) * 16 + ch) * 64 + p]);
            cm[(g * 16 + ch) * 128 + 64 + p] = (bf16_t)f2bf(-X.in(I_S5CIM)[(((size_t)l * 16 + g) * 16 + ch) * 64 + p]); }
    }
    { bf16_t* rf = (bf16_t*)(X.ws + WS_RFR); const float* rw = X.in(I_RW) + (size_t)l * D * NEXP;
      for (int i = gt; i < 2 * 32 * 64 * 8; i += NGT) { const int j = i & 7, ln = (i >> 3) & 63, ks = (i >> 9) & 31, rt = i >> 14;
          const float v = rw[(size_t)(ks * 32 + 8 * (ln >> 4) + j) * NEXP + rt * 16 + (ln & 15)]; const unsigned hi = f2bf(v); const float lo = v - bflo(hi);
          rf[i] = (bf16_t)hi; rf[32768 + i] = (bf16_t)f2bf(lo); } }
    if (l == 0) {
        const float* x = X.in(I_X); bf16_t* h = X.hbuf(); const float* mv = X.modv(0, 0);
        for (size_t i = (size_t)gt; i < (size_t)M * D / 8; i += NGT) {
            const size_t e = i * 8; const int col = (int)(e & 1023), b = (int)(e >> 23);
            const f32x4 x0 = *(const f32x4*)(x + e), x1 = *(const f32x4*)(x + e + 4);
            const f32x4 sh0 = *(const f32x4*)(mv + b * 3072 + col), sh1 = *(const f32x4*)(mv + b * 3072 + col + 4), sc0 = *(const f32x4*)(mv + b * 3072 + 1024 + col), sc1 = *(const f32x4*)(mv + b * 3072 + 1024 + col + 4);
            const f32x4 h0 = x0 * (sc0 + 1.0f) + sh0, h1 = x1 * (sc1 + 1.0f) + sh1;
            u32x4 w; w.x = pk2(h0[0], h0[1]); w.y = pk2(h0[2], h0[3]); w.z = pk2(h1[0], h1[1]); w.w = pk2(h1[2], h1[3]);
            *(u32x4*)(h + e) = w; }
    }
}

__device__ __forceinline__ void rope8(const u32x4 a, const u32x4 b, const float* cs, u32x4& wa, u32x4& wb) {
    float t1[8], t2[8]; t1[0] = bflo(a.x); t1[1] = bfhi(a.x); t1[2] = bflo(a.y); t1[3] = bfhi(a.y); t1[4] = bflo(a.z); t1[5] = bfhi(a.z); t1[6] = bflo(a.w); t1[7] = bfhi(a.w);
    t2[0] = bflo(b.x); t2[1] = bfhi(b.x); t2[2] = bflo(b.y); t2[3] = bfhi(b.y); t2[4] = bflo(b.z); t2[5] = bfhi(b.z); t2[6] = bflo(b.w); t2[7] = bfhi(b.w);
    float o1[8], o2[8]; f32x4 c4[4];
#pragma unroll
    for (int q = 0; q < 4; ++q) c4[q] = *(const f32x4*)(cs + 4 * q);
#pragma unroll
    for (int j = 0; j < 8; ++j) { const float cv = c4[j >> 1][(j & 1) * 2], sv = c4[j >> 1][(j & 1) * 2 + 1]; o1[j] = t1[j] * cv - t2[j] * sv; o2[j] = t2[j] * cv + t1[j] * sv; }
    wa.x = pk2(o1[0], o1[1]); wa.y = pk2(o1[2], o1[3]); wa.z = pk2(o1[4], o1[5]); wa.w = pk2(o1[6], o1[7]);
    wb.x = pk2(o2[0], o2[1]); wb.y = pk2(o2[2], o2[3]); wb.z = pk2(o2[4], o2[5]); wb.w = pk2(o2[6], o2[7]);
}
__device__ __forceinline__ void mx_rope(const Ctx& X) {
    bf16_t* pj = X.proj(); const float* ropet = (const float*)(X.ws + WS_ROPE);
    const int gt = X.c * 512 + X.tid, NGT = X.G * 512;
    for (int i = gt; i < M * 10; i += NGT) {
        const int tok = i / 10, hh = i % 10;
        if (hh == 9) { const u32x4* sp = (const u32x4*)(pj + (size_t)tok * PJ + C_V); u32x4* dp = (u32x4*)((bf16_t*)(X.ws + WS_V2) + (size_t)tok * 64);
#pragma unroll
            for (int q = 0; q < 8; ++q) dp[q] = sp[q];
            continue; }
        const int col = (hh < 4) ? C_Q + hh * 64 : (hh < 8) ? C_QI + (hh - 4) * 64 : C_K;
        bf16_t* p = pj + (size_t)tok * PJ + col;
        const u32x4 a = *(const u32x4*)p, b = *(const u32x4*)(p + 8);
        u32x4 wa, wb; rope8(a, b, ropet + (size_t)tok * 16, wa, wb);
        if (hh < 8) { *(u32x4*)p = wa; *(u32x4*)(p + 8) = wb; }
        else { u32x4* dp = (u32x4*)((bf16_t*)(X.ws + WS_K2) + (size_t)tok * 64); const u32x4* sp = (const u32x4*)p; dp[0] = wa; dp[1] = wb;
#pragma unroll
            for (int q = 2; q < 8; ++q) dp[q] = sp[q]; }
    }
    for (int i = gt; i < (M / 16) * 16; i += NGT) {
        const int hf = i & 1, pc = (i >> 1) & 7, tile = i >> 4; const int ks = pc >> 2, fq = pc & 3;
        u32x4* dp = (u32x4*)((bf16_t*)(X.ws + WS_KI2) + (size_t)tile * 1024 + pc * 128 + hf * 64);
#pragma unroll
        for (int j = 0; j < 8; ++j) { const int tok = tile * 16 + hf * 8 + j; const bf16_t* rp = pj + (size_t)tok * PJ + C_KI;
            u32x4 v = *(const u32x4*)(rp + ks * 32 + fq * 8);
            if (pc < 2) { const u32x4 a = *(const u32x4*)rp, b = *(const u32x4*)(rp + 8); u32x4 wa, wb; rope8(a, b, ropet + (size_t)tok * 16, wa, wb); v = pc ? wb : wa; }
            dp[j] = v; }
    }
}

__device__ __forceinline__ void mx_gmlp(const Ctx& X, int l, int unit) {
    const int lane = X.lane, w = X.wave;
    const int row0 = unit * 128;
    LAS bf16_t* Vt = (LAS bf16_t*)X.lds;
    const bf16_t* pj = X.proj();
    const float* lng = X.in(I_GMLNG) + l * 256; const float* lnb = X.in(I_GMLNB) + l * 256;
    float g4[4], b4[4];
#pragma unroll
    for (int j = 0; j < 4; ++j) { g4[j] = lng[lane + 64 * j]; b4[j] = lnb[lane + 64 * j]; }
    for (int i = 0; i < 16; ++i) {
        const int s = w * 16 + i; const bf16_t* rp = pj + (size_t)(row0 + s) * PJ + C_GV;
        float v[4]; float sm = 0.f;
#pragma unroll
        for (int j = 0; j < 4; ++j) { v[j] = gelu_tanh(bf2f(rp[lane + 64 * j])); sm += v[j]; }
        const float mean = wave_sum(sm) * (1.0f / 256.0f); float q = 0.f;
#pragma unroll
        for (int j = 0; j < 4; ++j) { v[j] -= mean; q += v[j] * v[j]; }
        const float rstd = rsqrtf(wave_sum(q) * (1.0f / 256.0f) + LN_EPS);
#pragma unroll
        for (int j = 0; j < 4; ++j) Vt[(lane + 64 * j) * 136 + s] = (bf16_t)f2bf(v[j] * rstd * g4[j] + b4[j]);
    }
    __syncthreads();
    const int g = w >> 1, c0 = g * 64 + (w & 1) * 32, fr = lane & 15, fq = lane >> 4;
    const bf16_t* gmw = (const bf16_t*)(X.ws + WS_GMW) + (size_t)g * 128 * 128;
    const float* gmb = X.in(I_GMB) + ((size_t)l * 4 + g) * 128;
    bf16_t* ya = X.ybuf();
    for (int tt = 0; tt < 8; ++tt) {
        f32x4 acc0 = (f32x4){0.f, 0.f, 0.f, 0.f}, acc1 = acc0;
        for (int ks = 0; ks <= (tt >> 1); ++ks) {
            const bf16x8 wf = *(const bf16x8*)(gmw + (tt * 16 + fr) * 128 + ks * 32 + 8 * fq);
            const bf16x8 v0 = *(const LAS bf16x8*)(Vt + (c0 + fr) * 136 + ks * 32 + 8 * fq), v1 = *(const LAS bf16x8*)(Vt + (c0 + 16 + fr) * 136 + ks * 32 + 8 * fq);
            acc0 = mfma16(v0, wf, acc0); acc1 = mfma16(v1, wf, acc1);
        }
        const int t = tt * 16 + fr; const float bias = gmb[t];
#pragma unroll
        for (int c2 = 0; c2 < 2; ++c2) { const f32x4 a = c2 ? acc1 : acc0; const int cc = c0 + c2 * 16 + 4 * fq;
            const u32x2 uv = *(const u32x2*)(pj + (size_t)(row0 + t) * PJ + C_GU + cc);
            u32x2 o; o.x = pk2(gelu_tanh(bflo(uv.x)) * (a[0] + bias), gelu_tanh(bfhi(uv.x)) * (a[1] + bias)); o.y = pk2(gelu_tanh(bflo(uv.y)) * (a[2] + bias), gelu_tanh(bfhi(uv.y)) * (a[3] + bias));
            *(u32x2*)(ya + (size_t)(row0 + t) * 256 + cc) = o; }
    }
    __syncthreads();
}

template <int PASS>
__device__ __forceinline__ void mx_s5(const Ctx& X, int l, int wu) {
    const int lane = X.lane, fr = lane & 15, fq = lane >> 4;
    const int wgi = wu >> 3, wv = wu & 7; const int b = wgi >> 6, g = ((wgi >> 4) & 3) * 4 + (wv & 3), ch = (wgi & 15) * 2 + (wv >> 2);
    const int tb = b * SEQ + ch * 256;
    LAS float* xl = (LAS float*)(X.lds + X.wave * 16384);
    LAS bf16_t* hb = (LAS bf16_t*)(X.lds + X.wave * 16384 + 8192);
    const bf16_t* pj = X.proj();
    const bf16_t* bbT = (const bf16_t*)(X.ws + WS_S5B) + (size_t)g * 128 * 16;
    bf16x8 Bf[8];
#pragma unroll
    for (int ct = 0; ct < 8; ++ct) { Bf[ct] = (bf16x8){0, 0, 0, 0, 0, 0, 0, 0}; if (fq < 2) Bf[ct] = *(const bf16x8*)(bbT + (ct * 16 + fr) * 16 + 8 * fq); }
    const float* sa = (const float*)(X.ws + WS_S5A) + (g * 64 + lane) * 2; const float ar = sa[0], ai = sa[1];
    float hr = 0.f, hi = 0.f;
    float* st = (float*)(X.ws + WS_S5ST) + (size_t)((b * 16 + g) * 32) * 128;
    bf16x8 Cf[4]; float dsk[4];
    if (PASS == 3) {
        { const float* hin = (const float*)(X.ws + WS_S5HIN) + (size_t)((b * 16 + g) * 32 + ch) * 128; hr = hin[lane]; hi = hin[64 + lane]; }
        const bf16_t* cm = (const bf16_t*)(X.ws + WS_S5C) + (size_t)g * 16 * 128;
#pragma unroll
        for (int ks = 0; ks < 4; ++ks) Cf[ks] = *(const bf16x8*)(cm + fr * 128 + ks * 32 + 8 * fq);
#pragma unroll
        for (int i = 0; i < 4; ++i) dsk[i] = X.in(I_S5D)[l * 256 + g * 16 + 4 * fq + i];
    }
    bf16_t* ycp = (bf16_t*)(X.ws + WS_YCPRE);
    for (int blk = 0; blk < 16; ++blk) {
        const int t0 = tb + blk * 16;
        bf16x8 uf = (bf16x8){0, 0, 0, 0, 0, 0, 0, 0};
        if (fq < 2) uf = *(const bf16x8*)(pj + (size_t)(t0 + fr) * PJ + C_S5 + g * 16 + 8 * fq);
#pragma unroll
        for (int ct = 0; ct < 8; ++ct) { const f32x4 a = mfma16(uf, Bf[ct], (f32x4){0.f, 0.f, 0.f, 0.f});
#pragma unroll
            for (int i = 0; i < 4; ++i) xl[(4 * fq + i) * 128 + ct * 16 + fr] = a[i]; }
#pragma unroll
        for (int t = 0; t < 16; ++t) { const float xr = xl[t * 128 + lane], xi = xl[t * 128 + 64 + lane];
            const float nr = ar * hr - ai * hi + xr, ni = ar * hi + ai * hr + xi; hr = nr; hi = ni;
            if (PASS == 3) { hb[t * 136 + lane] = (bf16_t)f2bf(hr); hb[t * 136 + 64 + lane] = (bf16_t)f2bf(hi); } }
        if (PASS == 3) {
            asm volatile("s_waitcnt lgkmcnt(0)" ::: "memory"); __builtin_amdgcn_wave_barrier();
            f32x4 acc = (f32x4){0.f, 0.f, 0.f, 0.f};
#pragma unroll
            for (int ks = 0; ks < 4; ++ks) { const bf16x8 hf = *(const LAS bf16x8*)(hb + fr * 136 + ks * 32 + 8 * fq); acc = mfma16(Cf[ks], hf, acc); }
            const u32x2 uv = *(const u32x2*)(pj + (size_t)(t0 + fr) * PJ + C_S5 + g * 16 + 4 * fq);
            const float y0 = gelu_tanh(acc[0] + dsk[0] * bflo(uv.x)), y1 = gelu_tanh(acc[1] + dsk[1] * bfhi(uv.x)), y2 = gelu_tanh(acc[2] + dsk[2] * bflo(uv.y)), y3 = gelu_tanh(acc[3] + dsk[3] * bfhi(uv.y));
            u32x2 o; o.x = pk2(y0, y1); o.y = pk2(y2, y3);
            *(u32x2*)(ycp + (size_t)(t0 + fr) * 256 + g * 16 + 4 * fq) = o;
        }
    }
    if (PASS == 1) { st[ch * 128 + lane] = hr; st[ch * 128 + 64 + lane] = hi; }
}

constexpr int SD_CM = 0, SD_BM = 18432, SD_XT0 = 36864, SD_XT1 = 55296, SD_MM = 73728, SD_SIN0 = 108544, SD_SIN1 = 117760, SD_DT = 126976, SD_AC = 128000 + 64, SD_END = 129024 + 64;
__device__ __forceinline__ bf16x8 tr_frag8(const LAS bf16_t* base, int pitch, int l0, int c0, int lane) {
    const int g = lane >> 4, i = lane & 15; const unsigned a1 = (unsigned)(unsigned long)(base + (l0 + 8 * g + (i >> 2)) * pitch + c0 + 4 * (i & 3)); const unsigned a2 = a1 + (unsigned)(8 * pitch);
    u32x2 r1, r2;
    asm volatile("ds_read_b64_tr_b16 %0, %2\n\tds_read_b64_tr_b16 %1, %3\n\ts_waitcnt lgkmcnt(0)" : "=&v"(r1), "=&v"(r2) : "v"(a1), "v"(a2) : "memory");
    __builtin_amdgcn_sched_barrier(0);
    const u32x4 o = (u32x4){r1.x, r1.y, r2.x, r2.y}; return __builtin_bit_cast(bf16x8, o);
}
static_assert(SD_END <= LDS_MISC, "ssd lds");
template <int PASS>
__device__ __forceinline__ void mx_ssd(const Ctx& X, int l, int unit) {
    const int tid = X.tid, lane = X.lane, w = X.wave, fr = lane & 15, fq = lane >> 4;
    const int b = unit >> 6, c = unit & 63; const int r0 = unit * 128;
    const bf16_t* pj = X.proj();
    LAS bf16_t* Cm = (LAS bf16_t*)(X.lds + SD_CM); LAS bf16_t* Bm = (LAS bf16_t*)(X.lds + SD_BM);
    LAS bf16_t* Mm = (LAS bf16_t*)(X.lds + SD_MM);
    LAS float* dtv = (LAS float*)(X.lds + SD_DT); LAS float* acm = (LAS float*)(X.lds + SD_AC);
    const float* convw = X.in(I_CONVW) + (size_t)l * 4 * 512; const float* convb = X.in(I_CONVB) + (size_t)l * 512;
    float* sst = (float*)(X.ws + WS_SSDST); float* atot = (float*)(X.ws + WS_ATOT);
    for (int g = 0; g < 2; ++g) {
        if (tid < 256) { const int j = tid >> 7, rl = tid & 127, h = 2 * g + j;
            const float raw = bf2f(pj[(size_t)(r0 + rl) * PJ + C_DT + h]) + X.in(I_DTBIAS)[l * 4 + h];
            const float dt = softplusf_(raw); dtv[j * 128 + rl] = dt; acm[j * 128 + rl] = -expf(X.in(I_ALOG)[l * 4 + h]) * dt; }
        __syncthreads();
        if (tid < 256) {
            float cum = acm[tid];
#pragma unroll
            for (int o = 1; o < 64; o <<= 1) { const float up = __shfl_up(cum, o); if (lane >= o) cum += up; }
            if (lane == 63) dtv[256 + w] = cum;
            __builtin_amdgcn_fence(__ATOMIC_RELEASE, "workgroup");
            acm[tid] = cum; }
        __syncthreads();
        if (tid < 256 && (w & 1)) acm[tid] += dtv[256 + w - 1];
        __syncthreads();
        if (PASS == 1 && tid < 2) atot[(b * 64 + c) * 32 + 2 * g + tid] = acm[tid * 128 + 127];
        if (!(X.dbg & 16)) { const int cg = tid & 31, rb = tid >> 5; constexpr int NCG = (PASS == 1) ? 24 : 32;
          if (cg < NCG) {
            const int chn = (cg < 16) ? g * 128 + cg * 8 : (cg < 24) ? 256 + g * 64 + (cg - 16) * 8 : 384 + g * 64 + (cg - 24) * 8;
            u32x4 xr[11];
#pragma unroll
            for (int k = 0; k < 11; ++k) { const int sq = c * 128 + rb * 8 + k - 3; xr[k] = (u32x4){0u, 0u, 0u, 0u}; if (sq >= 0) xr[k] = *(const u32x4*)(pj + (size_t)(b * SEQ + sq) * PJ + C_XBC + chn); }
            f32x4 w0[4], w1[4];
#pragma unroll
            for (int k = 0; k < 4; ++k) { w0[k] = *(const f32x4*)(convw + k * 512 + chn); w1[k] = *(const f32x4*)(convw + k * 512 + chn + 4); }
            const f32x4 cb0 = *(const f32x4*)(convb + chn), cb1 = *(const f32x4*)(convb + chn + 4);
            LAS bf16_t* dst = (cg < 16) ? (LAS bf16_t*)(X.lds + ((cg >> 3) ? SD_XT1 : SD_XT0)) + (cg & 7) * 8 : (cg < 24) ? Bm + (cg - 16) * 8 : Cm + (cg - 24) * 8;
            const int jh = (cg >> 3) & 1;
#pragma unroll
            for (int r = 0; r < 8; ++r) { const int rl = rb * 8 + r;
                f32x4 s0 = cb0, s1 = cb1;
#pragma unroll
                for (int k = 0; k < 4; ++k) { const u32x4 xv = xr[r + k];
                    s0[0] += w0[k][0] * bflo(xv.x); s0[1] += w0[k][1] * bfhi(xv.x); s0[2] += w0[k][2] * bflo(xv.y); s0[3] += w0[k][3] * bfhi(xv.y);
                    s1[0] += w1[k][0] * bflo(xv.z); s1[1] += w1[k][1] * bfhi(xv.z); s1[2] += w1[k][2] * bflo(xv.w); s1[3] += w1[k][3] * bfhi(xv.w); }
                float sc = 1.0f; if (PASS == 1 && cg < 16) sc = __expf(acm[jh * 128 + 127] - acm[jh * 128 + rl]) * dtv[jh * 128 + rl];
                u32x4 o; o.x = pk2(siluf_(s0[0]) * sc, siluf_(s0[1]) * sc); o.y = pk2(siluf_(s0[2]) * sc, siluf_(s0[3]) * sc); o.z = pk2(siluf_(s1[0]) * sc, siluf_(s1[1]) * sc); o.w = pk2(siluf_(s1[2]) * sc, siluf_(s1[3]) * sc);
                *(LAS u32x4*)(dst + rl * 72) = o; }
          } }
        if (PASS == 3) {
            const bf16_t* sin = (const bf16_t*)(X.ws + WS_SSDSIN) + (size_t)((b * 64 + c) * 4 + 2 * g) * 4096 + tid * 8;
            const int p = tid >> 3, n0 = (tid & 7) * 8;
            *(LAS u32x4*)((LAS bf16_t*)(X.lds + SD_SIN0) + p * 72 + n0) = *(const u32x4*)sin;
            *(LAS u32x4*)((LAS bf16_t*)(X.lds + SD_SIN1) + p * 72 + n0) = *(const u32x4*)(sin + 4096);
        }
        __syncthreads();
        if (PASS == 1) {
            const int j = w >> 2, pt = w & 3; const LAS bf16_t* Xr = (const LAS bf16_t*)(X.lds + (j ? SD_XT1 : SD_XT0));
            f32x4 acc[4];
#pragma unroll
            for (int nt = 0; nt < 4; ++nt) acc[nt] = (f32x4){0.f, 0.f, 0.f, 0.f};
#pragma unroll
            for (int ks = 0; ks < 4; ++ks) { const bf16x8 xf = tr_frag8(Xr, 72, ks * 32, pt * 16, lane);
#pragma unroll
                for (int nt = 0; nt < 4; ++nt) { const bf16x8 bf = tr_frag8(Bm, 72, ks * 32, nt * 16, lane); acc[nt] = mfma16(xf, bf, acc[nt]); } }
            float* sp = sst + (size_t)((b * 64 + c) * 4 + 2 * g + j) * 4096;
#pragma unroll
            for (int nt = 0; nt < 4; ++nt)
#pragma unroll
                for (int i = 0; i < 4; ++i) sp[(pt * 16 + 4 * fq + i) * 64 + nt * 16 + fr] = acc[nt][i];
        } else {
            const int lrow = w * 16 + fr;
            float yv[2][4][4];
#pragma unroll
            for (int j = 0; j < 2; ++j) {
                const LAS bf16_t* Xr = (const LAS bf16_t*)(X.lds + (j ? SD_XT1 : SD_XT0)); const LAS bf16_t* Sin = (const LAS bf16_t*)(X.lds + (j ? SD_SIN1 : SD_SIN0));
                const float al = acm[j * 128 + lrow];
                const bf16x8 cf0 = *(const LAS bf16x8*)(Cm + lrow * 72 + 8 * fq), cf1 = *(const LAS bf16x8*)(Cm + lrow * 72 + 32 + 8 * fq);
                const int stmax = w | 1;
                for (int st = 0; st <= stmax; ++st) {
                    f32x4 ag = (f32x4){0.f, 0.f, 0.f, 0.f};
                    if (st <= w) { const bf16x8 b0 = *(const LAS bf16x8*)(Bm + (st * 16 + fr) * 72 + 8 * fq), b1 = *(const LAS bf16x8*)(Bm + (st * 16 + fr) * 72 + 32 + 8 * fq);
                        ag = mfma16(b0, cf0, ag); ag = mfma16(b1, cf1, ag); }
                    float mv[4];
#pragma unroll
                    for (int i = 0; i < 4; ++i) { const int s = st * 16 + 4 * fq + i; mv[i] = (s <= lrow) ? ag[i] * __expf(al - acm[j * 128 + s]) * dtv[j * 128 + s] : 0.f; }
                    u32x2 o; o.x = pk2(mv[0], mv[1]); o.y = pk2(mv[2], mv[3]); *(LAS u32x2*)(Mm + lrow * 136 + st * 16 + 4 * fq) = o;
                }
                const float eal = __expf(al); const float dsk = X.in(I_SSDD)[l * 4 + 2 * g + j];
#pragma unroll
                for (int pt = 0; pt < 4; ++pt) {
                    f32x4 ad = (f32x4){0.f, 0.f, 0.f, 0.f}, ao = ad;
                    for (int ks = 0; ks <= (w >> 1); ++ks) { const bf16x8 xf = tr_frag8(Xr, 72, ks * 32, pt * 16, lane); const bf16x8 mf = *(const LAS bf16x8*)(Mm + lrow * 136 + ks * 32 + 8 * fq); ad = mfma16(xf, mf, ad); }
                    { const bf16x8 s0 = *(const LAS bf16x8*)(Sin + (pt * 16 + fr) * 72 + 8 * fq), s1 = *(const LAS bf16x8*)(Sin + (pt * 16 + fr) * 72 + 32 + 8 * fq); ao = mfma16(s0, cf0, ao); ao = mfma16(s1, cf1, ao); }
                    const int h = 2 * g + j; const u32x2 zv = *(const u32x2*)(pj + (size_t)(r0 + lrow) * PJ + C_Z + h * 64 + pt * 16 + 4 * fq);
                    const float z4[4] = {bflo(zv.x), bfhi(zv.x), bflo(zv.y), bfhi(zv.y)};
#pragma unroll
                    for (int i = 0; i < 4; ++i) { const float xs = bf2f(Xr[lrow * 72 + pt * 16 + 4 * fq + i]); yv[j][pt][i] = (ad[i] + eal * ao[i] + dsk * xs) * siluf_(z4[i]); }
                }
            }
            float ss = 0.f;
#pragma unroll
            for (int j = 0; j < 2; ++j)
#pragma unroll
                for (int pt = 0; pt < 4; ++pt)
#pragma unroll
                    for (int i = 0; i < 4; ++i) ss += yv[j][pt][i] * yv[j][pt][i];
            ss += __shfl_xor(ss, 16); ss += __shfl_xor(ss, 32);
            const float rs = rsqrtf(ss * (1.0f / 128.0f) + RMS_EPS);
            const float* ng = X.in(I_SSDNG) + l * 256 + g * 128; bf16_t* yd = X.ybuf() + (size_t)3 * M * 256;
#pragma unroll
            for (int j = 0; j < 2; ++j)
#pragma unroll
                for (int pt = 0; pt < 4; ++pt) { const int cc = j * 64 + pt * 16 + 4 * fq; const f32x4 gv = *(const f32x4*)(ng + cc);
                    u32x2 o; o.x = pk2(yv[j][pt][0] * rs * gv[0], yv[j][pt][1] * rs * gv[1]); o.y = pk2(yv[j][pt][2] * rs * gv[2], yv[j][pt][3] * rs * gv[3]);
                    *(u32x2*)(yd + (size_t)(r0 + lrow) * 256 + g * 128 + cc) = o; }
        }
        __syncthreads();
    }
}

__device__ __forceinline__ void mx_s5_carry(const Ctx& X) {
    const float* st = (const float*)(X.ws + WS_S5ST); float* hin = (float*)(X.ws + WS_S5HIN); const float* sa = (const float*)(X.ws + WS_S5A);
    for (int i = X.c * 32 + (X.tid - 256); X.tid >= 256 && X.tid < 288 && i < NB * 16 * 64; i += X.G * 32) {
        const int p = i & 63, g = (i >> 6) & 15, b = i >> 10;
        float pr = sa[(g * 64 + p) * 2], pi = sa[(g * 64 + p) * 2 + 1];
#pragma unroll
        for (int q = 0; q < 8; ++q) { const float nr = pr * pr - pi * pi, ni = 2.f * pr * pi; pr = nr; pi = ni; }
        float hr = 0.f, hi = 0.f; const size_t base = (size_t)((b * 16 + g) * 32) * 128 + p;
#pragma unroll 8
        for (int ch = 0; ch < 32; ++ch) { hin[base + ch * 128] = hr; hin[base + ch * 128 + 64] = hi;
            const float sr = st[base + ch * 128], si = st[base + ch * 128 + 64]; const float nr = pr * hr - pi * hi + sr, ni = pr * hi + pi * hr + si; hr = nr; hi = ni; }
    }
}

__device__ __forceinline__ void mx_ssd_carry(const Ctx& X) {
    const float* sst = (const float*)(X.ws + WS_SSDST); const float* atot = (const float*)(X.ws + WS_ATOT); bf16_t* sin = (bf16_t*)(X.ws + WS_SSDSIN);
    for (int i = X.c * 256 + X.tid; X.tid < 256 && i < NB * 4 * 4096; i += X.G * 256) {
        const int e1 = i & 4095, h = (i >> 12) & 3, b = i >> 14;
        float S = 0.f;
#pragma unroll 16
        for (int c = 0; c < 64; ++c) { const size_t o = (size_t)((b * 64 + c) * 4 + h) * 4096 + e1;
            sin[o] = (bf16_t)f2bf(S);
            S = S * __expf(atot[(b * 64 + c) * 32 + h]) + sst[o]; }
    }
}

__device__ __forceinline__ unsigned ord16(float s) { const _Float16 hf = (_Float16)s; const unsigned bits = (unsigned)__builtin_bit_cast(unsigned short, hf); return bits ^ ((bits & 0x8000u) ? 0xFFFFu : 0x8000u); }
__device__ __forceinline__ int cnt_ge8(const u32x4 v, unsigned c) {
    int n = 0;
    n += ((v.x & 0xFFFFu) >= c) + ((v.x >> 16) >= c); n += ((v.y & 0xFFFFu) >= c) + ((v.y >> 16) >= c);
    n += ((v.z & 0xFFFFu) >= c) + ((v.z >> 16) >= c); n += ((v.w & 0xFFFFu) >= c) + ((v.w >> 16) >= c);
    return n;
}
template <int CTRL> __device__ __forceinline__ float dpp_f(float v) { return __builtin_bit_cast(float, __builtin_amdgcn_update_dpp(0, __builtin_bit_cast(int, v), CTRL, 0xF, 0xF, true)); }
__device__ __forceinline__ void mx_dsa(const Ctx& X, int b, int t0) {
    const int tid = X.tid, lane = X.lane, w = X.wave, fr = lane & 15, fq = lane >> 4;
    const bf16_t* pj = X.proj() + (size_t)b * SEQ * PJ; const unsigned rb = 0u;
    const bf16_t* ki2 = (const bf16_t*)(X.ws + WS_KI2) + (size_t)b * SEQ * 64; const bf16_t* k2 = (const bf16_t*)(X.ws + WS_K2) + (size_t)b * SEQ * 64; const bf16_t* v2 = (const bf16_t*)(X.ws + WS_V2) + (size_t)b * SEQ * 64;
    LAS unsigned short* sc = (LAS unsigned short*)X.lds;
    const int nk = t0 + 8, nkt = (nk + 15) >> 4;
    LAS unsigned* hist = (LAS unsigned*)(X.lds + 131072 + 8192);
    for (int i = tid; i < 8 * 4 * 128 / 4; i += 512) *(LAS u32x4*)(hist + 4 * i) = (u32x4){0u, 0u, 0u, 0u};
    bf16x8 qf[2][2]; f32x4 wq[2];
#pragma unroll
    for (int ct = 0; ct < 2; ++ct) { const int q = 4 * ct + (fr >> 2), hh = fr & 3; const bf16_t* qp = pj + (unsigned)(t0 + q) * (unsigned)PJ;
        qf[ct][0] = *(const bf16x8*)(qp + C_QI + hh * 64 + 8 * fq); qf[ct][1] = *(const bf16x8*)(qp + C_QI + hh * 64 + 32 + 8 * fq);
        const u32x2 wv = *(const u32x2*)(pj + (unsigned)(t0 + 4 * ct + fq) * (unsigned)PJ + C_WI);
        wq[ct] = (f32x4){bflo(wv.x) * 0.0625f, bfhi(wv.x) * 0.0625f, bflo(wv.y) * 0.0625f, bfhi(wv.y) * 0.0625f}; }
    const int ntw = (nkt > w) ? ((nkt - w + 7) >> 3) : 0;
    __syncthreads();
#define DSA_LOAD4(KF, I0) do { _Pragma("unroll") for (int j = 0; j < 4; ++j) { int kt_ = w + 8 * ((I0) + j); kt_ = kt_ < nkt ? kt_ : nkt - 1; \
        const unsigned ko_ = (unsigned)kt_ * 1024u + (unsigned)lane * 8u; KF[j][0] = *(const bf16x8*)(ki2 + ko_); KF[j][1] = *(const bf16x8*)(ki2 + ko_ + 512u); } } while (0)
#define DSA_COMP4(KF, I0) do { if (DSA_PM == 2 && rs1 > 0) { _Pragma("unroll") for (int j = 0; j < 4; ++j) dummy_ ^= KF[j][0][0] ^ KF[j][1][3]; break; } \
      _Pragma("unroll") for (int jh = 0; jh < 4; jh += 2) { f32x4 ac_[2][2]; \
        _Pragma("unroll") for (int j = 0; j < 2; ++j) _Pragma("unroll") for (int ct = 0; ct < 2; ++ct) { \
            ac_[j][ct] = mfma16(qf[ct][0], KF[jh + j][0], (f32x4){0.f, 0.f, 0.f, 0.f}); ac_[j][ct] = mfma16(qf[ct][1], KF[jh + j][1], ac_[j][ct]); } \
        _Pragma("unroll") for (int j = 0; j < 2; ++j) { if ((I0) + jh + j < ntw) { const int kt_ = w + 8 * ((I0) + jh + j); const bool full_ = (kt_ * 16 + 15 <= t0); const int key_ = kt_ * 16 + fr; \
        _Pragma("unroll") for (int ct = 0; ct < 2; ++ct) { const f32x4 a_ = ac_[j][ct]; \
            float tt_ = __builtin_fmaf(__builtin_amdgcn_fmed3f(a_[0], 0.f, 3.0e38f), wq[ct][0], 0.0f); tt_ = __builtin_fmaf(__builtin_amdgcn_fmed3f(a_[1], 0.f, 3.0e38f), wq[ct][1], tt_); \
            tt_ = __builtin_fmaf(__builtin_amdgcn_fmed3f(a_[2], 0.f, 3.0e38f), wq[ct][2], tt_); tt_ = __builtin_fmaf(__builtin_amdgcn_fmed3f(a_[3], 0.f, 3.0e38f), wq[ct][3], tt_); \
            const int q_ = 4 * ct + fq; unsigned kk_ = ord16(tt_ + 0.0f); \
            if (!full_) kk_ = (key_ <= t0 + q_) ? kk_ : 0u; \
            if (DSA_PM == 1 && rs1 > 0) dummy_ ^= (short)kk_; else sc[q_ * 8192 + key_] = (unsigned short)kk_; \
            if ((R_S1 == 1 || rs1 == 0) && (full_ || kk_ != 0u)) __hip_atomic_fetch_add(hist + (q_ * 4 + (fr & 3)) * 128 + (kk_ >> 9), (kk_ & 0x100u) ? 65536u : 1u, __ATOMIC_RELAXED, __HIP_MEMORY_SCOPE_WORKGROUP); } } } } } while (0)
    short dummy_ = 0;
    _Pragma("nounroll") for (int rs1 = 0; rs1 < (((DSA_SKIP | X.dbg) & 1) ? 0 : R_S1); ++rs1)
    { bf16x8 ka[4][2], kb[4][2];
      if (ntw > 0) { DSA_LOAD4(ka, 0);
#pragma nounroll
        for (int i0 = 0; i0 < ntw; i0 += 8) { DSA_LOAD4(kb, i0 + 4); DSA_COMP4(ka, i0); DSA_LOAD4(ka, i0 + 8); DSA_COMP4(kb, i0 + 4); } } }
#undef DSA_LOAD4
#undef DSA_COMP4
    if (dummy_ == (short)0x1234 && t0 == 123457) sc[0] = 1;
    { const int z0 = nkt * 16, z1 = ((nk + 511) >> 9) << 9;
        for (int i = z0 + tid; i < z1; i += 512) {
#pragma unroll
            for (int q = 0; q < 8; ++q) sc[q * 8192 + i] = 0; } }
    __syncthreads();
    const int t = t0 + w, nv = t + 1;
    LAS unsigned short* row = sc + w * 8192;
    LAS unsigned short* list = (LAS unsigned short*)(X.lds + 131072 + w * 512);
    const int nsel = nv < 256 ? nv : 256;
    if (((DSA_SKIP | X.dbg) & 2) || nv <= 256) { for (int n = lane; n < 256; n += 64) list[n] = (unsigned short)n; }
    else {
        const int nit = (nv + 511) >> 9;
        LAS unsigned* H = hist + w * 512;
        int T1, above1;
        { u32x4 h4 = (u32x4){0u, 0u, 0u, 0u};
#pragma unroll
          for (int c4 = 0; c4 < 4; ++c4) { const u32x2 pw = *(const LAS u32x2*)(H + c4 * 128 + 2 * lane); h4.x += pw.x & 0xFFFFu; h4.y += pw.x >> 16; h4.z += pw.y & 0xFFFFu; h4.w += pw.y >> 16; }
          const int sl = (int)(h4.x + h4.y + h4.z + h4.w);
          int suf = sl;
#pragma unroll
          for (int o = 1; o < 64; o <<= 1) { const int dn = __shfl_down(suf, o); if (lane + o < 64) suf += dn; }
          const unsigned long long bm = __ballot(suf >= 256); const int L = 63 - __builtin_clzll(bm);
          const int hx = __shfl((int)h4.x, L), hy = __shfl((int)h4.y, L), hz = __shfl((int)h4.z, L), hw = __shfl((int)h4.w, L);
          const int sufn = __shfl(suf, L) - (hx + hy + hz + hw);
          int cb = sufn; T1 = 4 * L + 3; above1 = cb;
          if (cb + hw >= 256) { T1 = 4 * L + 3; above1 = cb; } else { cb += hw; if (cb + hz >= 256) { T1 = 4 * L + 2; above1 = cb; } else { cb += hz; if (cb + hy >= 256) { T1 = 4 * L + 1; above1 = cb; } else { cb += hy; T1 = 4 * L; above1 = cb; } } } }
        _Pragma("nounroll") for (int rs2 = 0; rs2 < R_S2; ++rs2) {
        *(LAS u32x4*)(H + 4 * lane) = (u32x4){0u, 0u, 0u, 0u};
        for (int it = 0; it < nit; ++it) { const u32x4 v = *(const LAS u32x4*)(row + (it * 64 + lane) * 8);
            const unsigned e[8] = {v.x & 0xFFFFu, v.x >> 16, v.y & 0xFFFFu, v.y >> 16, v.z & 0xFFFFu, v.z >> 16, v.w & 0xFFFFu, v.w >> 16};
#pragma unroll
            for (int j = 0; j < 8; ++j) if ((int)(e[j] >> 8) == T1) __hip_atomic_fetch_add(H + (e[j] & 255u), 1u, __ATOMIC_RELAXED, __HIP_MEMORY_SCOPE_WORKGROUP); }
        unsigned thr; int cgt, cge;
        { const u32x4 h4 = *(const LAS u32x4*)(H + 4 * lane); const int sl = (int)(h4.x + h4.y + h4.z + h4.w);
          int suf = sl;
#pragma unroll
          for (int o = 1; o < 64; o <<= 1) { const int dn = __shfl_down(suf, o); if (lane + o < 64) suf += dn; }
          const int need = 256 - above1;
          const unsigned long long bm = __ballot(suf >= need); const int L = 63 - __builtin_clzll(bm);
          const int hx = __shfl((int)h4.x, L), hy = __shfl((int)h4.y, L), hz = __shfl((int)h4.z, L), hw = __shfl((int)h4.w, L);
          int cb = __shfl(suf, L) - (hx + hy + hz + hw); int T2, hT;
          if (cb + hw >= need) { T2 = 4 * L + 3; hT = hw; } else { cb += hw; if (cb + hz >= need) { T2 = 4 * L + 2; hT = hz; } else { cb += hz; if (cb + hy >= need) { T2 = 4 * L + 1; hT = hy; } else { cb += hy; T2 = 4 * L; hT = hx; } } }
          thr = ((unsigned)T1 << 8) | (unsigned)T2; cgt = above1 + cb; cge = cgt + hT; }
        const bool exact = (cge == 256);
        const int r = 256 - cgt;
        const unsigned cmin = exact ? thr : thr + 1u;
        const unsigned long long lt_mask = (1ull << lane) - 1ull; int bcnt = 0;
        for (int it = 0; it < nit; ++it) { const u32x4 v = *(const LAS u32x4*)(row + (it * 64 + lane) * 8); const int base = (it * 64 + lane) * 8;
            const unsigned e[8] = {v.x & 0xFFFFu, v.x >> 16, v.y & 0xFFFFu, v.y >> 16, v.z & 0xFFFFu, v.z >> 16, v.w & 0xFFFFu, v.w >> 16};
#pragma unroll
            for (int j = 0; j < 8; ++j) { const bool sl = e[j] >= cmin; const unsigned long long bm = __ballot(sl);
                if (bm != 0ull) { if (sl) list[(bcnt + __popcll(bm & lt_mask)) & 255] = (unsigned short)(base + j); bcnt += __popcll(bm); } } }
        if (!exact) {
            int taken = 0;
            for (int it = 0; it < nit && taken < r; ++it) { const u32x4 v = *(const LAS u32x4*)(row + (it * 64 + lane) * 8); const int base = (it * 64 + lane) * 8;
                const unsigned e[8] = {v.x & 0xFFFFu, v.x >> 16, v.y & 0xFFFFu, v.y >> 16, v.z & 0xFFFFu, v.z >> 16, v.w & 0xFFFFu, v.w >> 16};
                int mcount = 0;
#pragma unroll
                for (int j = 0; j < 8; ++j) mcount += (e[j] == thr);
                if (__ballot(mcount != 0) == 0ull) continue;
                int incl = mcount;
#pragma unroll
                for (int o = 1; o < 64; o <<= 1) { const int up = __shfl_up(incl, o); if (lane >= o) incl += up; }
                const int total = __shfl(incl, 63); int rk = taken + incl - mcount;
#pragma unroll
                for (int j = 0; j < 8; ++j) if (e[j] == thr) { if (rk < r) list[(cgt + rk) & 255] = (unsigned short)(base + j); ++rk; }
                taken += total; }
        }
        }
    }
    __builtin_amdgcn_fence(__ATOMIC_RELEASE, "workgroup"); __builtin_amdgcn_wave_barrier();
    const bf16_t* qrow = pj + (unsigned)t * (unsigned)PJ;
    bf16x8 qb0 = (bf16x8){0, 0, 0, 0, 0, 0, 0, 0}, qb1 = qb0;
    if (fr < 4) { qb0 = *(const bf16x8*)(qrow + C_Q + fr * 64 + 8 * fq); qb1 = *(const bf16x8*)(qrow + C_Q + fr * 64 + 32 + 8 * fq); }
    LAS float* Pb = (LAS float*)row;
    LAS float* pinv = (LAS float*)(X.lds + 131072 + 4096 + 256 + w * 16);
    _Pragma("nounroll") for (int rs3 = 0; rs3 < (((DSA_SKIP | X.dbg) & 4) ? 0 : R_S3); ++rs3) {
    { LAS unsigned char* kbuf = (LAS unsigned char*)row + 4096;
      const int drow = lane >> 3, dchk = (lane & 7) ^ (drow & 7);
#define QK_DMA(G) do { _Pragma("unroll") for (int i_ = 0; i_ < 4; ++i_) { const unsigned ko_ = (unsigned)list[(G) * 32 + i_ * 8 + drow] * 64u + (unsigned)(dchk * 8); \
        __builtin_amdgcn_global_load_lds((const unsigned*)(k2 + ko_), (LAS unsigned*)(kbuf + ((G) % 3) * 4096 + i_ * 1024), 16, 0, 0); } } while (0)
#define QK_COMP(G) do { _Pragma("unroll") for (int j = 0; j < 2; ++j) { const LAS unsigned char* tb_ = kbuf + ((G) % 3) * 4096 + j * 2048 + fr * 128; \
        const bf16x8 k0_ = *(const LAS bf16x8*)(tb_ + ((fq ^ (fr & 7)) * 16)), k1_ = *(const LAS bf16x8*)(tb_ + (((4 + fq) ^ (fr & 7)) * 16)); \
        f32x4 a_ = mfma16(k0_, qb0, (f32x4){0.f, 0.f, 0.f, 0.f}); a_ = mfma16(k1_, qb1, a_); \
        if (fr < 4) { _Pragma("unroll") for (int i = 0; i < 4; ++i) { const int nn_ = ((G) * 2 + j) * 16 + 4 * fq + i; Pb[nn_ * 4 + fr] = (nn_ < nsel) ? a_[i] * 0.125f : -3.0e38f; } } } } while (0)
      asm volatile("s_waitcnt vmcnt(0)" ::: "memory");
      QK_DMA(0); QK_DMA(1);
      asm volatile("s_waitcnt vmcnt(4)" ::: "memory"); QK_COMP(0); QK_DMA(2);
      asm volatile("s_waitcnt vmcnt(4)" ::: "memory"); QK_COMP(1); asm volatile("s_waitcnt lgkmcnt(0)" ::: "memory"); QK_DMA(3);
      asm volatile("s_waitcnt vmcnt(4)" ::: "memory"); QK_COMP(2); asm volatile("s_waitcnt lgkmcnt(0)" ::: "memory"); QK_DMA(4);
      asm volatile("s_waitcnt vmcnt(4)" ::: "memory"); QK_COMP(3); asm volatile("s_waitcnt lgkmcnt(0)" ::: "memory"); QK_DMA(5);
      asm volatile("s_waitcnt vmcnt(4)" ::: "memory"); QK_COMP(4); asm volatile("s_waitcnt lgkmcnt(0)" ::: "memory"); QK_DMA(6);
      asm volatile("s_waitcnt vmcnt(4)" ::: "memory"); QK_COMP(5); asm volatile("s_waitcnt lgkmcnt(0)" ::: "memory"); QK_DMA(7);
      asm volatile("s_waitcnt vmcnt(4)" ::: "memory"); QK_COMP(6);
      asm volatile("s_waitcnt vmcnt(0)" ::: "memory"); QK_COMP(7);
#undef QK_DMA
#undef QK_COMP
    }
    __builtin_amdgcn_fence(__ATOMIC_RELEASE, "workgroup"); __builtin_amdgcn_wave_barrier();
    { const int hd = lane & 3, nb0 = lane >> 2;
        float v16[16]; float mx = -3.0e38f;
#pragma unroll
        for (int j = 0; j < 16; ++j) { v16[j] = Pb[(nb0 + 16 * j) * 4 + hd]; mx = fmaxf(mx, v16[j]); }
        mx = fmaxf(mx, __shfl_xor(mx, 4)); mx = fmaxf(mx, __shfl_xor(mx, 8)); mx = fmaxf(mx, __shfl_xor(mx, 16)); mx = fmaxf(mx, __shfl_xor(mx, 32));
        float sm = 0.f;
#pragma unroll
        for (int j = 0; j < 16; ++j) { const float p = (v16[j] > -1.0e38f) ? __expf(v16[j] - mx) : 0.f; sm += p; Pb[(nb0 + 16 * j) * 4 + hd] = p; }
        sm += __shfl_xor(sm, 4); sm += __shfl_xor(sm, 8); sm += __shfl_xor(sm, 16); sm += __shfl_xor(sm, 32);
        if (lane < 4) pinv[lane] = 1.0f / sm; }
    __builtin_amdgcn_fence(__ATOMIC_RELEASE, "workgroup"); __builtin_amdgcn_wave_barrier();
    f32x2 o2[4][2];
#pragma unroll
    for (int h = 0; h < 4; ++h) { o2[h][0] = (f32x2){0.f, 0.f}; o2[h][1] = (f32x2){0.f, 0.f}; }
    const int d4 = fr * 4;
#define PV_LOAD(VV, B) do { _Pragma("unroll") for (int j = 0; j < 16; ++j) { const unsigned vo_ = (unsigned)list[(B) * 64 + 4 * j + fq] * 64u + (unsigned)d4; VV[j] = *(const u32x2*)(v2 + vo_); } } while (0)
#define PV_COMP(VV, B) do { _Pragma("unroll") for (int j = 0; j < 16; ++j) { const f32x4 p4_ = *(const LAS f32x4*)(Pb + ((B) * 64 + 4 * j + fq) * 4); \
        const f32x2 va_ = (f32x2){bflo(VV[j].x), bfhi(VV[j].x)}, vb_ = (f32x2){bflo(VV[j].y), bfhi(VV[j].y)}; \
        _Pragma("unroll") for (int h = 0; h < 4; ++h) { const f32x2 pp_ = (f32x2){p4_[h], p4_[h]}; o2[h][0] = __builtin_elementwise_fma(va_, pp_, o2[h][0]); o2[h][1] = __builtin_elementwise_fma(vb_, pp_, o2[h][1]); } } } while (0)
    { u32x2 va[16], vb[16]; PV_LOAD(va, 0); PV_LOAD(vb, 1); PV_COMP(va, 0); PV_LOAD(va, 2); PV_COMP(vb, 1); PV_LOAD(vb, 3); PV_COMP(va, 2); PV_COMP(vb, 3); }
#undef PV_LOAD
#undef PV_COMP
    float o4[4][4];
#pragma unroll
    for (int h = 0; h < 4; ++h)
#pragma unroll
        for (int dd = 0; dd < 4; ++dd) { float v = o2[h][dd >> 1][dd & 1]; v += __shfl_xor(v, 16); v += __shfl_xor(v, 32); o4[h][dd] = v; }
    { const int h = fq; const float iv = pinv[h];
        float r4[4];
#pragma unroll
        for (int dd = 0; dd < 4; ++dd) r4[dd] = ((h == 0) ? o4[0][dd] : (h == 1) ? o4[1][dd] : (h == 2) ? o4[2][dd] : o4[3][dd]) * iv;
        u32x2 o; o.x = pk2(r4[0], r4[1]); o.y = pk2(r4[2], r4[3]);
        *(u32x2*)(X.ybuf() + (size_t)1 * M * 256 + ((size_t)b * SEQ + t) * 256 + h * 64 + d4) = o; }
    __builtin_amdgcn_fence(__ATOMIC_RELEASE, "workgroup"); __builtin_amdgcn_wave_barrier(); }
    __syncthreads();
}

constexpr int LR_HH = 0, LR_HL = 33280, LR_PART = 66560, LR_LG = 82944, LR_CNT = 84992, LR_PITCH = 1032;
__device__ __forceinline__ void ph_ln1_router(const Ctx& X, int l) {
    const int lane = X.lane, w = X.wave, tid = X.tid, fr = lane & 15, fq = lane >> 4;
    LAS bf16_t* Hh = (LAS bf16_t*)(X.lds + LR_HH); LAS bf16_t* Hl = (LAS bf16_t*)(X.lds + LR_HL);
    LAS float* part = (LAS float*)(X.lds + LR_PART);
    LAS float* lgt = (LAS float*)(X.lds + LR_LG);
    LAS unsigned* wgcnt = (LAS unsigned*)(X.lds + LR_CNT);
    if (tid < 32) wgcnt[tid] = 0u;
    bf16x8 Ahi[2][4], Alo[2][4];
    { const bf16_t* rf = (const bf16_t*)(X.ws + WS_RFR);
#pragma unroll
      for (int rt = 0; rt < 2; ++rt)
#pragma unroll
          for (int q = 0; q < 4; ++q) { const size_t o = ((size_t)(rt * 32 + 4 * w + q) * 64 + lane) * 8; Ahi[rt][q] = *(const bf16x8*)(rf + o); Alo[rt][q] = *(const bf16x8*)(rf + 32768 + o); } }
    float* xo = X.a->out; bf16_t* hb = X.hbuf(); float* xw = (X.dbg & 8) ? (float*)(X.ws + WS_ACT) : xo; const bf16_t* v16 = (const bf16_t*)(X.ws + WS_V16);
    const int tok0 = X.c * 128, b = tok0 >> 13;
    const float* mv = X.modv(l, 1) + b * 3072;
    const float* lg = X.in(I_LN1G) + l * D; const float* lb = X.in(I_LN1B) + l * D;
    const int e = lane & 31;
    const float rbias = X.in(I_RB)[l * NEXP + e];
    unsigned* pinfo = (unsigned*)(X.ws + WS_PINFO); float* pgate = (float*)(X.ws + WS_PGATE);
    __syncthreads();
    u32x2 raw[2][4];
#pragma unroll
    for (int jj = 0; jj < 2; ++jj)
#pragma unroll
        for (int j = 0; j < 4; ++j) raw[jj][j] = *(const u32x2*)(v16 + (size_t)(tok0 + 2 * w + jj) * D + 4 * lane + 256 * j);
    for (int pass = 0; pass < 8; ++pass) {
        f32x4 vv[2][4];
#pragma unroll
        for (int jj = 0; jj < 2; ++jj)
#pragma unroll
            for (int j = 0; j < 4; ++j) { const u32x2 q2 = raw[jj][j]; vv[jj][j] = (f32x4){bflo(q2.x), bfhi(q2.x), bflo(q2.y), bfhi(q2.y)}; }
        if (pass + 1 < 8) {
#pragma unroll
            for (int jj = 0; jj < 2; ++jj)
#pragma unroll
                for (int j = 0; j < 4; ++j) raw[jj][j] = *(const u32x2*)(v16 + (size_t)(tok0 + (pass + 1) * 16 + 2 * w + jj) * D + 4 * lane + 256 * j); }
#pragma unroll
        for (int jj = 0; jj < 2; ++jj) {
            const int r = 2 * w + jj, tok = tok0 + pass * 16 + r;
            f32x4 v[4]; float s = 0.f;
#pragma unroll
            for (int j = 0; j < 4; ++j) { v[j] = vv[jj][j]; s += (v[j][0] + v[j][1]) + (v[j][2] + v[j][3]); }
            const float mean = wave_sum(s) * (1.0f / D); float q = 0.f;
#pragma unroll
            for (int j = 0; j < 4; ++j) { v[j] = v[j] - mean; q += (v[j][0] * v[j][0] + v[j][1] * v[j][1]) + (v[j][2] * v[j][2] + v[j][3] * v[j][3]); }
            const float rstd = rsqrtf(wave_sum(q) * (1.0f / D) + LN_EPS);
#pragma unroll
            for (int j = 0; j < 4; ++j) { const int col = 4 * lane + 256 * j;
                const f32x4 x1 = v[j] * rstd * *(const f32x4*)(lg + col) + *(const f32x4*)(lb + col);
                *(f32x4*)(xw + (size_t)tok * D + col) = x1 * DN_ALPHA;
                const f32x4 hv = x1 * (*(const f32x4*)(mv + 1024 + col) + 1.0f) + *(const f32x4*)(mv + col);
                const unsigned h0 = f2bf(hv[0]), h1 = f2bf(hv[1]), h2 = f2bf(hv[2]), h3 = f2bf(hv[3]);
                u32x2 o; o.x = h0 | (h1 << 16); o.y = h2 | (h3 << 16); *(u32x2*)(hb + (size_t)tok * D + col) = o;
                *(LAS u32x2*)(Hh + r * LR_PITCH + col) = o;
                u32x2 ol; ol.x = pk2(hv[0] - bflo(h0), hv[1] - bflo(h1)); ol.y = pk2(hv[2] - bflo(h2), hv[3] - bflo(h3)); *(LAS u32x2*)(Hl + r * LR_PITCH + col) = ol; }
        }
        __syncthreads();
        {
            f32x4 acc0 = (f32x4){0.f, 0.f, 0.f, 0.f}, acc1 = acc0;
#pragma unroll
            for (int q = 0; q < 4; ++q) { const int ko = fr * LR_PITCH + (4 * w + q) * 32 + 8 * fq;
                const bf16x8 bh = *(const LAS bf16x8*)(Hh + ko), bl = *(const LAS bf16x8*)(Hl + ko);
                acc0 = mfma16(Ahi[0][q], bh, acc0); acc0 = mfma16(Ahi[0][q], bl, acc0); acc0 = mfma16(Alo[0][q], bh, acc0);
                acc1 = mfma16(Ahi[1][q], bh, acc1); acc1 = mfma16(Ahi[1][q], bl, acc1); acc1 = mfma16(Alo[1][q], bh, acc1); }
#pragma unroll
            for (int i = 0; i < 4; ++i) { part[(w * 32 + 4 * fq + i) * 16 + fr] = acc0[i]; part[(w * 32 + 16 + 4 * fq + i) * 16 + fr] = acc1[i]; }
        }
        __syncthreads();
        { const int ee = tid >> 4, tk = tid & 15; float sm = 0.f;
#pragma unroll
          for (int q = 0; q < 8; ++q) sm += part[(q * 32 + ee) * 16 + tk];
          lgt[tk * 32 + ee] = sm; }
        __syncthreads();
#pragma unroll
        for (int jj = 0; jj < 2; ++jj) {
            const int r = 2 * w + jj, tok = tok0 + pass * 16 + r;
            const float score = sigmoidf_(lgt[r * 32 + e]), biased = score + rbias;
            const int gbase = lane & ~3;
            const float v0 = __shfl(biased, gbase), v1 = __shfl(biased, gbase + 1), v2 = __shfl(biased, gbase + 2), v3 = __shfl(biased, gbase + 3);
            const float a_ = fmaxf(v0, v1), b_ = fminf(v0, v1), c_ = fmaxf(v2, v3), d_ = fminf(v2, v3);
            const float gs = fmaxf(a_, c_) + fmaxf(fminf(a_, c_), fmaxf(b_, d_));
            const int myg = e >> 2; int grank = 0;
#pragma unroll
            for (int g2 = 0; g2 < 8; ++g2) { const float o = __shfl(gs, 4 * g2); grank += (o > gs || (o == gs && g2 < myg)) ? 1 : 0; }
            const float masked = (grank < 4) ? biased : -3.0e38f;
            int erank = 0;
#pragma unroll
            for (int e2 = 0; e2 < 32; ++e2) { const float o = __shfl(masked, e2); erank += (o > masked || (o == masked && e2 < e)) ? 1 : 0; }
            const bool sel = (erank < 8) && (lane < 32);
            const float wsum = wave_sum(sel ? score : 0.f);
            const float gate = score / wsum * 2.5f;
            const unsigned long long bal = __ballot(sel);
            if (sel) { const int k = __popcll(bal & ((1ull << lane) - 1ull));
                const unsigned lr = __hip_atomic_fetch_add(wgcnt + e, 1u, __ATOMIC_RELAXED, __HIP_MEMORY_SCOPE_WORKGROUP);
                pinfo[(size_t)tok * 8 + k] = (unsigned)e | (lr << 8); pgate[(size_t)tok * 8 + k] = gate; }
        }
    }
    __syncthreads();
    if (tid < 32) { const int chunk = tok0 / CHTOK; unsigned* cnt = (unsigned*)(X.ws + WS_CTL) + CW_CNT + (l * NCH + chunk) * 64;
        const unsigned base = __hip_atomic_fetch_add(cnt + tid, wgcnt[tid], __ATOMIC_RELAXED, __HIP_MEMORY_SCOPE_AGENT);
        ((unsigned*)(X.ws + WS_WGBASE))[X.c * 32 + tid] = base; }
    __syncthreads();
}

__device__ __forceinline__ void moe_offsets(const Ctx& X, int l, int chunk, LAS int* off  , LAS int* cntl  ) {
    if (X.tid == 0) { const unsigned* cnt = (const unsigned*)(X.ws + WS_CTL) + CW_CNT + (l * NCH + chunk) * 64; int o = 0;
        for (int e = 0; e < NE1; ++e) { const int cn = (e < NEXP) ? (int)__hip_atomic_load(cnt + e, __ATOMIC_RELAXED, __HIP_MEMORY_SCOPE_AGENT) : CHTOK; off[e] = o; cntl[e] = cn; o += ((cn + 255) >> 8) << 8; }
        off[NE1] = o; }
    __syncthreads();
}
#define ST_WT(p, v) __hip_atomic_store((p), (v), __ATOMIC_RELAXED, __HIP_MEMORY_SCOPE_AGENT)
__device__ __forceinline__ void ph_fill(const Ctx& X, int l) {
    LAS int* off = (LAS int*)(X.lds); LAS int* cntl = off + 64;
    const int tok0 = X.c * 128, chunk = tok0 / CHTOK;
    moe_offsets(X, l, chunk, off, cntl);
    unsigned* rowtok = (unsigned*)(X.ws + WS_ROWTOK) + (size_t)chunk * CH_ROWS; float* rowgate = (float*)(X.ws + WS_ROWGATE) + (size_t)chunk * CH_ROWS;
    const unsigned* pinfo = (const unsigned*)(X.ws + WS_PINFO); const float* pgate = (const float*)(X.ws + WS_PGATE); unsigned* slot = (unsigned*)(X.ws + WS_SLOT);
    const unsigned* wgb = (const unsigned*)(X.ws + WS_WGBASE) + X.c * 32;
    for (int i = X.tid; i < 1024; i += 512) { const size_t pi = (size_t)tok0 * 8 + i; const unsigned inf = pinfo[pi]; const int e = inf & 255, lr = inf >> 8;
        const int pos = off[e] + (int)wgb[e] + lr; ST_WT(rowtok + pos, (unsigned)(tok0 + (i >> 3))); ST_WT((unsigned*)rowgate + pos, __builtin_bit_cast(unsigned, pgate[pi])); slot[pi] = (unsigned)pos; }
    if (X.tid < 128) { const int tok = tok0 + X.tid; const int pos = off[NEXP] + (tok - chunk * CHTOK); ST_WT(rowtok + pos, (unsigned)tok); ST_WT((unsigned*)rowgate + pos, __builtin_bit_cast(unsigned, 1.0f)); }
    const int wl = X.c & 63;
    if (wl < NEXP) { const int e = wl; const int p0 = off[e] + cntl[e], p1 = off[e + 1]; for (int p = p0 + X.tid; p < p1; p += 512) { ST_WT(rowtok + p, (unsigned)(chunk * CHTOK)); ST_WT((unsigned*)rowgate + p, 0u); } }
    __syncthreads();
}

template <int NT, bool GATH>
struct MoeOrder {
    static constexpr bool GATHER = GATH;
    int nwg, G, c; const LAS unsigned char* tile_e; const LAS int* rowtab;
    __device__ __forceinline__ bool next(int i, pg8::Unit& u) const {
        const long L = (long)i * G + c; if (L >= nwg) return false;
        const int wgid = pg8::xcd_remap((int)L, nwg); const int tau = wgid / NT, pn = wgid % NT;
        u.pm = tau; u.pn = pn; u.bt = __builtin_amdgcn_readfirstlane((int)tile_e[tau]) * NT + pn; u.ab = i; return true;
    }
    __device__ __forceinline__ int row_of(const pg8::Unit& u, int r) const { return rowtab[u.ab * 256 + r]; }
    __device__ __forceinline__ void a_ready(const pg8::Unit&) const {}
    __device__ __forceinline__ void done(const pg8::Unit&) const {}
};
template <int NT, bool GATH>
struct MoeOrderAll {
    static constexpr bool GATHER = GATH;
    int nwg, G, c; const LAS unsigned char* tile_e4; const LAS int* tprefix; const LAS int* rowtab; int tbase;
    __device__ __forceinline__ bool next(int i, pg8::Unit& u) const {
#if MOE_PAIR
        constexpr int PAIRW = (NT == 4) ? MOE_PAIR4 : MOE_PAIR2;
        const int ip = i / PAIRW, sp = i % PAIRW; const int npair = nwg / PAIRW;
        const long L = (long)ip * G + c; if (L >= npair) return false;
        const int wp = pg8::xcd_remap((int)L, npair); const int gt = tbase + wp / (NT / PAIRW), pn = (wp % (NT / PAIRW)) * PAIRW + sp;
#else
        const long L = (long)i * G + c; if (L >= nwg) return false;
        const int wgid = pg8::xcd_remap((int)L, nwg); const int gt = tbase + wgid / NT, pn = wgid % NT;
#endif
        int ch = 0;
#pragma unroll
        for (int q = 1; q < NCH; ++q) ch += (tprefix[q] <= gt) ? 1 : 0;
        ch = __builtin_amdgcn_readfirstlane(ch); const int tau = gt - __builtin_amdgcn_readfirstlane(tprefix[ch]);
        u.pm = ch * CH_TILES + tau; u.pn = pn; u.bt = __builtin_amdgcn_readfirstlane((int)tile_e4[ch * 336 + tau]) * NT + pn; u.ab = i; return true;
    }
    __device__ __forceinline__ int row_of(const pg8::Unit& u, int r) const { return rowtab[u.ab * 256 + r]; }
    __device__ __forceinline__ void a_ready(const pg8::Unit&) const {}
    __device__ __forceinline__ void done(const pg8::Unit&) const {}
};
__device__ __forceinline__ void moe_tables_all(const Ctx& X, int l, LAS int* off4, LAS unsigned char* tile_e4, LAS int* tprefix) {
    if (X.tid < NCH) { const int chn = X.tid; const unsigned* cnt = (const unsigned*)(X.ws + WS_CTL) + CW_CNT + (l * NCH + chn) * 64; int o = 0;
        for (int e = 0; e < NE1; ++e) { const int cn = (e < NEXP) ? (int)__hip_atomic_load(cnt + e, __ATOMIC_RELAXED, __HIP_MEMORY_SCOPE_AGENT) : CHTOK; off4[chn * 64 + e] = o; o += ((cn + 255) >> 8) << 8; }
        off4[chn * 64 + NE1] = o; }
    __syncthreads();
    if (X.tid == 0) { int a = 0; for (int q = 0; q < NCH; ++q) { tprefix[q] = a; a += off4[q * 64 + NE1] >> 8; } tprefix[NCH] = a; }
    for (int t = X.tid; t < NCH * 336; t += 512) { const int chn = t / 336, tau = t % 336; int e = 0; for (int q = 1; q < NE1; ++q) e += (off4[chn * 64 + q] <= tau * 256) ? 1 : 0; tile_e4[t] = (unsigned char)e; }
    __syncthreads();
}
__device__ __forceinline__ int moe_tiles(const Ctx& X, int l, int chunk, LAS unsigned char* tile_e, LAS int* off, LAS int* cntl) {
    moe_offsets(X, l, chunk, off, cntl);
    const int ntile = off[NE1] >> 8;
    for (int t = X.tid; t < ntile; t += 512) { int e = 0; for (int q = 1; q < NE1; ++q) e += (off[q] <= t * 256) ? 1 : 0; tile_e[t] = (unsigned char)e; }
    __syncthreads();
    return ntile;
}

__device__ __forceinline__ void ph_combine(const Ctx& X, int l, int c0, const LAS int* off4) {
    const int lane = X.lane; const int gw = X.c * 8 + X.wave; const int chunk = c0 + (gw >> 10);
    float* xo = X.a->out; bf16_t* hb = X.hbuf(); float* xw = (X.dbg & 8) ? (float*)(X.ws + WS_ACT) : xo;
    const unsigned char* op = (const unsigned char*)(X.ws + WS_OPAIR) + (size_t)(chunk - c0) * CH_ROWS * 1024; const unsigned* slot = (const unsigned*)(X.ws + WS_SLOT);
    const int b = (chunk * CHTOK) >> 13; const float* mv2 = X.modv(l, 1) + b * 3072;
    const float* lg = X.in(I_LN2G) + l * D; const float* lb = X.in(I_LN2B) + l * D;
    const int offsh = off4[chunk * 64 + NEXP];
#pragma unroll 1
    for (int i = 0; i < 8; i += 2) {
        const int tokA = c0 * CHTOK + gw * 8 + i;
        int pos[2][9];
#pragma unroll
        for (int t = 0; t < 2; ++t) {
            const u32x4 s0 = *(const u32x4*)(slot + (size_t)(tokA + t) * 8), s1 = *(const u32x4*)(slot + (size_t)(tokA + t) * 8 + 4);
            pos[t][0] = (int)s0.x; pos[t][1] = (int)s0.y; pos[t][2] = (int)s0.z; pos[t][3] = (int)s0.w; pos[t][4] = (int)s1.x; pos[t][5] = (int)s1.y; pos[t][6] = (int)s1.z; pos[t][7] = (int)s1.w;
            pos[t][8] = offsh + (tokA + t - chunk * CHTOK); }
        unsigned rw8[2][9][4];
#pragma unroll
        for (int t = 0; t < 2; ++t) {
#pragma unroll
            for (int k = 0; k < 9; ++k) { const unsigned ro = (unsigned)pos[t][k] * 1024u + 4u * (unsigned)lane;
#pragma unroll
                for (int j = 0; j < 4; ++j) rw8[t][k][j] = *(const unsigned*)(op + ro + 256 * j); } }
#pragma unroll
        for (int t = 0; t < 2; ++t) {
            const int tok = tokA + t;
            f32x4 sm[4];
#pragma unroll
            for (int j = 0; j < 4; ++j) sm[j] = (f32x4){0.f, 0.f, 0.f, 0.f};
#pragma unroll
            for (int k = 0; k < 9; ++k)
#pragma unroll
                for (int j = 0; j < 4; ++j) { const int q = (int)rw8[t][k][j]; const f32x2 lo = __builtin_amdgcn_cvt_pk_f32_fp8(q, false), hi = __builtin_amdgcn_cvt_pk_f32_fp8(q, true);
                    sm[j][0] += lo[0]; sm[j][1] += lo[1]; sm[j][2] += hi[0]; sm[j][3] += hi[1]; }
            f32x4 v[4]; float s = 0.f;
#pragma unroll
            for (int j = 0; j < 4; ++j) { const int col = 4 * lane + 256 * j; v[j] = *(const f32x4*)(xo + (size_t)tok * D + col) + (*(const f32x4*)(mv2 + 2048 + col) + 1.0f) * (sm[j] * (1.0f / O_SCALE)); s += (v[j][0] + v[j][1]) + (v[j][2] + v[j][3]); }
            const float mean = wave_sum(s) * (1.0f / D); float q = 0.f;
#pragma unroll
            for (int j = 0; j < 4; ++j) { v[j] = v[j] - mean; q += (v[j][0] * v[j][0] + v[j][1] * v[j][1]) + (v[j][2] * v[j][2] + v[j][3] * v[j][3]); }
            const float rstd = rsqrtf(wave_sum(q) * (1.0f / D) + LN_EPS);
#pragma unroll
            for (int j = 0; j < 4; ++j) { const int col = 4 * lane + 256 * j;
                const f32x4 x2 = v[j] * rstd * *(const f32x4*)(lg + col) + *(const f32x4*)(lb + col);
                *(f32x4*)(xw + (size_t)tok * D + col) = x2;
                if (l + 1 < DEPTH) { const float* mv1 = X.modv(l + 1, 0) + b * 3072; const f32x4 hn = x2 * (*(const f32x4*)(mv1 + 1024 + col) + 1.0f) + *(const f32x4*)(mv1 + col);
                    u32x2 o; o.x = pk2(hn[0], hn[1]); o.y = pk2(hn[2], hn[3]); *(u32x2*)(hb + (size_t)tok * D + col) = o; } }
        }
    }
}

template <int PW, bool ABSEL> struct PairOrder : pg8::StaticOrder { __device__ __forceinline__ bool next(int i, pg8::Unit& u) const { if (!pg8::StaticOrder::next(i / PW, u)) return false;
    u.pn = u.pn * PW + i % PW; u.bt = u.pn; u.ab = ABSEL ? (u.pn >> 2) : 0; return true; } };
struct POrder : pg8::StaticOrder { __device__ __forceinline__ bool next(int i, pg8::Unit& u) const { if (!pg8::StaticOrder::next(i, u)) return false; u.ab = u.pn >> 2; return true; } };
struct GOrder { static constexpr bool GATHER = false; int G, c;
    __device__ __forceinline__ bool next(int i, pg8::Unit& u) const { const int tile = (i >> 2) * G + c; if (tile >= 512) return false; const int wg = pg8::xcd_remap(tile, 512); const int br = i & 3, mt = wg & 3;
        u.pm = wg >> 2; u.pn = br * 4 + mt; u.bt = br * 4 + mt; u.ab = 0; return true; }
    __device__ __forceinline__ void a_ready(const pg8::Unit&) const {} __device__ __forceinline__ void done(const pg8::Unit&) const {} };
__global__ void __launch_bounds__(512, 2) fwd_kernel(Args args) {
    extern __shared__ __attribute__((aligned(16))) unsigned char lds_raw[];
    ArgsP ap = (ArgsP)__builtin_amdgcn_kernarg_segment_ptr();
    Ctx X; X.a = ap; X.ws = ap->ws; X.lds = (LAS unsigned char*)lds_raw;
    X.tid = threadIdx.x; X.lane = X.tid & 63; X.wave = __builtin_amdgcn_readfirstlane(X.tid >> 6); X.G = gridDim.x;
    { const int bx = blockIdx.x; X.bx = bx; X.c = (X.G % 8 == 0) ? (bx % 8) * (X.G / 8) + bx / 8 : bx; }
    const int c0_ = X.c, g0_ = X.G, bx0_ = X.bx, wave0_ = X.wave;
    volatile LAS unsigned* misc = (volatile LAS unsigned*)(X.lds + LDS_MISC);
    if (X.tid < 16) misc[X.tid] = 0u;
    __syncthreads();
    XcdBarrier bar; bar.bar = (unsigned*)(X.ws + WS_CTL) + CW_BAR; bar.x = 0; bar.st = misc;
#if !MK_PER_PHASE
    bar = xcd_barrier_post((unsigned*)(X.ws + WS_CTL) + CW_BAR, misc);
#endif
    const int lo = ap->ph_lo, hi = ap->ph_hi; int ph = 0;
#define RELAUNDER() do { int wv_ = wave0_; asm volatile("" : "+s"(wv_)); unsigned am_ = ~0u; asm volatile("" : "+s"(am_)); int t_ = wv_ * 64 + (int)__builtin_amdgcn_mbcnt_hi(am_, __builtin_amdgcn_mbcnt_lo(am_, 0u)); asm volatile("" : "+v"(t_)); X.tid = t_; X.lane = t_ & 63; X.wave = wv_; } while (0)
#define REPEAT(N, stmt) _Pragma("nounroll") for (int rp_ = 0; rp_ < (N); ++rp_) { stmt; if (rp_ + 1 < (N)) xcd_barrier(bar); }
#define PH_BEGIN if (ph >= lo && ph < hi) { { ArgsP apl = ap; asm volatile("" : "+s"(apl)); X.a = apl; X.ws = apl->ws; X.dbg = apl->dbg; int wv_ = wave0_; asm volatile("" : "+s"(wv_)); unsigned am_ = ~0u; asm volatile("" : "+s"(am_)); int t_ = wv_ * 64 + (int)__builtin_amdgcn_mbcnt_hi(am_, __builtin_amdgcn_mbcnt_lo(am_, 0u)); asm volatile("" : "+v"(t_)); X.tid = t_; X.lane = t_ & 63; X.wave = wv_; int c_ = c0_, g_ = g0_, b_ = bx0_; asm volatile("" : "+s"(c_), "+s"(g_), "+s"(b_)); X.c = c_; X.G = g_; X.bx = b_; { LAS unsigned char* lp_ = (LAS unsigned char*)lds_raw; asm volatile("" : "+s"(lp_)); X.lds = lp_; } } unsigned char* wb = X.ws + WS_W; LAS unsigned char* gl = X.lds; const float* xin = (l_ == 0) ? X.in(I_X) : (const float*)X.a->out; (void)wb; (void)gl; (void)xin;
#if MK_PER_PHASE
#define PH_END } ++ph;
#else
#define PH_END if (ph + 1 < hi) xcd_barrier(bar); } ++ph;
#endif
    int l_ = 0;
    PH_BEGIN if (EN_PROLOGUE) { REPEAT(R_MISC, ph_prologue(X)) } PH_END
    auto layer = [&](const int l) __attribute__((always_inline)) {
        l_ = l;
        PH_BEGIN if (EN_WCONV) { REPEAT(R_MISC, ph_wconv(X, l)) } PH_END
        PH_BEGIN if (EN_GWIN)  { pg8::Gemm g{X.hbuf(), (const bf16_t*)(wb + WO_IN), 1024, 0}; pg8::StaticOrder S; S.init(M, PJ, X.G, X.bx); pg8::EpiBf16 E{X.proj(), PJ};
            REPEAT(R_GWIN, (pg8::gemm_phase<pg8::EpiBf16, pg8::StaticOrder, G_ALIGN, G_SP2, PEEL_GWIN>(gl, g, S, E, X.tid))) } PH_END
        PH_BEGIN if (EN_MX1)  {
            if (!(X.dbg & 1)) mx_rope(X);
            _Pragma("nounroll") for (int rp_ = 0; rp_ < R_MIX; ++rp_) {
            if (!(X.dbg & 2)) for (int u = X.c; u < 256; u += X.G) mx_gmlp(X, l, u);
            if (!(X.dbg & 4)) for (int wu = X.c * 8 + X.wave; wu < 2048; wu += X.G * 8) mx_s5<1>(X, l, wu);
            __syncthreads();
            if (!(X.dbg & 8)) for (int u = X.c; u < 256; u += X.G) mx_ssd<1>(X, l, u); }
        } PH_END
        PH_BEGIN if (EN_MX2)  {
            if (!(X.dbg & 32)) { mx_ssd_carry(X); mx_s5_carry(X); } RELAUNDER();
            _Pragma("nounroll") for (int rp_ = 0; rp_ < R_DSA; ++rp_)
            for (int r = 0; r < 16; ++r) { const int cl = X.c & 63; const int uu = (r & 1) ? r * 64 + 63 - cl : r * 64 + cl; if (EN_DSA && !(X.dbg & 64) && X.c < 256) mx_dsa(X, X.c >> 6, uu * 8); }
            __syncthreads(); RELAUNDER();
            for (int wu = X.c * 8 + X.wave; EN_S53 && !(X.dbg & 16) && wu < 2048; wu += X.G * 8) mx_s5<3>(X, l, wu);
        } PH_END
        PH_BEGIN if (EN_GLU)  { for (int u = X.c; EN_SSD3 && u < 256; u += X.G) mx_ssd<3>(X, l, u);
            __syncthreads(); RELAUNDER();
            pg8::Gemm g{(const bf16_t*)(X.ws + WS_YCPRE), (const bf16_t*)(wb + WO_GLU), 256, 0}; pg8::StaticOrder S; S.init(M, 256, X.G, X.bx);
            pg8::EpiGlu E{(const bf16_t*)(X.ws + WS_YCPRE), X.ybuf() + (size_t)2 * M * 256, X.in(I_S5GLUB) + l * 256};
            REPEAT(R_GLU, (pg8::gemm_phase<pg8::EpiGlu, pg8::StaticOrder, G_ALIGN, G_SP2, true>(gl, g, S, E, X.tid))) } PH_END
        PH_BEGIN if (EN_GP)  { pg8::Gemm g{X.ybuf(), (const bf16_t*)(wb + WO_BR), 256, (size_t)M * 256};
            PairOrder<PW_GP, true> S;
            S.init(M, 4096 / PW_GP, X.G, X.bx); pg8::EpiFp8 E{(unsigned char*)(X.ws + WS_P), 4096, P_SCALE};
            REPEAT(R_GP, (pg8::gemm_phase<pg8::EpiFp8, PairOrder<PW_GP, true>, false, G_SP2, true>(gl, g, S, E, X.tid))) } PH_END
        PH_BEGIN if (EN_GGATE)  { pg8::Gemm g{X.hbuf(), (const bf16_t*)(wb + WO_GATE), 1024, 0};
            PairOrder<PW_GGATE, false> S; S.init(M, 4096 / PW_GGATE, X.G, X.bx);
            pg8::EpiGateMerge4 E{(const unsigned char*)(X.ws + WS_P), X.ybuf(), 1.0f / P_SCALE};
            REPEAT(R_GGATE, (pg8::gemm_phase<pg8::EpiGateMerge4, PairOrder<PW_GGATE, false>, G_ALIGN, G_SP2, true>(gl, g, S, E, X.tid))) } PH_END
        PH_BEGIN if (EN_GOUT)  { pg8::Gemm g{X.ybuf(), (const bf16_t*)(wb + WO_OUT), 1024, 0}; PairOrder<PW_GOUT, false> S; S.init(M, 1024 / PW_GOUT, X.G, X.bx);
            pg8::EpiResid E{xin, (bf16_t*)(X.ws + WS_V16), X.modv(l, 0)};
            pg8::gemm_phase<pg8::EpiResid, PairOrder<PW_GOUT, false>, G_ALIGN, G_SP2, true>(gl, g, S, E, X.tid); } PH_END
        PH_BEGIN if (EN_LN1)  ph_ln1_router(X, l); PH_END
        PH_BEGIN if (EN_FILL) { REPEAT(R_MISC, ph_fill(X, l)) } PH_END
        PH_BEGIN if (EN_MOE1)  {
            LAS int* off4 = (LAS int*)(X.lds + LDS_TAB + 1024); LAS unsigned char* tile_e4 = (LAS unsigned char*)(X.lds + LDS_TAB + 2048); LAS int* tprefix = (LAS int*)(X.lds + LDS_TAB + 3584);
            moe_tables_all(X, l, off4, tile_e4, tprefix);
            pg8::Gemm g{X.hbuf(), (const bf16_t*)(wb + WO_13), 1024, 0};
            LAS int* rowtab = (LAS int*)(X.lds + LDS_TAB + 4096);
            MoeOrderAll<2, true> S{tprefix[NCH] * 2, X.G, X.bx, tile_e4, tprefix, rowtab, 0};
            { const unsigned* rowtok = (const unsigned*)(X.ws + WS_ROWTOK); pg8::Unit uu;
              const float* rowgate = (const float*)(X.ws + WS_ROWGATE); LAS float* gtabw = (LAS float*)(X.lds + LDS_TAB + 4096 + 12288);
              _Pragma("nounroll") for (int i = 0; i < 12; ++i) { if (!S.next(i, uu)) break; const int pmu = __builtin_amdgcn_readfirstlane(uu.pm);
                  if (X.tid < 256) { rowtab[i * 256 + X.tid] = (int)rowtok[(size_t)pmu * 256 + X.tid]; gtabw[i * 256 + X.tid] = rowgate[(size_t)pmu * 256 + X.tid]; } } }
            __syncthreads();
            pg8::EpiMoe1 E{(bf16_t*)(X.ws + WS_ACT), (const LAS float*)(X.lds + LDS_TAB + 4096 + 12288)};
            REPEAT(R_MOE, (pg8::gemm_phase<pg8::EpiMoe1, MoeOrderAll<2, true>, G_ALIGN, G_SP2, PEEL_MOE1>(gl, g, S, E, X.tid)))
        } PH_END
        for (int c0 = 0; c0 < NCH; c0 += 2) {
            PH_BEGIN if (EN_MOE2)  {
                LAS int* off4 = (LAS int*)(X.lds + LDS_TAB + 1024); LAS unsigned char* tile_e4 = (LAS unsigned char*)(X.lds + LDS_TAB + 2048); LAS int* tprefix = (LAS int*)(X.lds + LDS_TAB + 3584);
                moe_tables_all(X, l, off4, tile_e4, tprefix);
                pg8::Gemm g{(const bf16_t*)(X.ws + WS_ACT), (const bf16_t*)(wb + WO_2), 256, 0};
                MoeOrderAll<4, false> S{(tprefix[c0 + 2] - tprefix[c0]) * 4, X.G, X.bx, tile_e4, tprefix, nullptr, tprefix[c0]};
                pg8::EpiFp8 E{(unsigned char*)(X.ws + WS_OPAIR) - (size_t)c0 * CH_ROWS * 1024, 1024, O_SCALE};
                REPEAT(R_MOE, (pg8::gemm_phase<pg8::EpiFp8, MoeOrderAll<4, false>, false, G_SP2, true>(gl, g, S, E, X.tid)))
            } PH_END
            PH_BEGIN if (EN_FIN)  { LAS int* off4 = (LAS int*)(X.lds + LDS_TAB + 1024); LAS unsigned char* tile_e4 = (LAS unsigned char*)(X.lds + LDS_TAB + 2048); LAS int* tprefix = (LAS int*)(X.lds + LDS_TAB + 3584);
                moe_tables_all(X, l, off4, tile_e4, tprefix); ph_combine(X, l, c0, off4); } PH_END
        }
    };
    layer(0); layer(1); static_assert(DEPTH == 2, "two layers");
#undef PH_BEGIN
#undef PH_END
}
constexpr int N_PHASES = 1 + DEPTH * (10 + 1 + NCH);

#ifdef DBG_DUMP_OFF
__global__ void dbg_dump(const bf16_t* src, float* out, size_t n) { for (size_t i = (size_t)blockIdx.x * blockDim.x + threadIdx.x; i < n; i += (size_t)gridDim.x * blockDim.x) {
#ifdef DBG_HASH_OUT
    const unsigned bits = __builtin_bit_cast(unsigned, out[i]); out[i] = (float)((bits * 2654435761u) >> 8) * (1.0f / 16777216.0f);
#else
    const unsigned bits = src[i]; out[i] = (float)(((bits + 1u) * 2654435761u) >> 8) * (1.0f / 16777216.0f);
#endif
} }
#endif
extern "C" void kernel_launch(void* const* d_in, const int* in_sizes, int n_in, void* d_out, int out_size, void* d_ws, size_t ws_size, hipStream_t stream) {
    static int grid = 0;
    if (grid == 0) {
        if (n_in != 43 || out_size != M * D || ws_size < WS_NEED) { fprintf(stderr, "kernel_launch: unexpected shapes (n_in %d out %d ws %zu)\n", n_in, out_size, ws_size); grid = -1; return; }
        int dev = 0, cus = 0, per_cu = 0;
        if (hipGetDevice(&dev) != hipSuccess || hipDeviceGetAttribute(&cus, hipDeviceAttributeMultiprocessorCount, dev) != hipSuccess) { grid = -1; return; }
        if (hipFuncSetAttribute((const void*)fwd_kernel, hipFuncAttributeMaxDynamicSharedMemorySize, LDS_BYTES) != hipSuccess) { fprintf(stderr, "kernel_launch: hipFuncSetAttribute failed\n"); grid = -1; return; }
        if (hipOccupancyMaxActiveBlocksPerMultiprocessor(&per_cu, (const void*)fwd_kernel, 512, LDS_BYTES) != hipSuccess || per_cu < 1) fprintf(stderr, "kernel_launch: occupancy query says %d\n", per_cu);
        (void)hipGetLastError();
        grid = cus < 256 ? cus : 256;
    }
    if (grid < 0) return;
    (void)hipMemsetAsync((char*)d_ws + WS_CTL, 0, CTL_BYTES, stream);
#ifdef DBG_POISON
    (void)hipMemsetAsync((char*)d_ws + CTL_BYTES, 0xFF, WS_NEED - CTL_BYTES, stream);
    (void)hipMemsetAsync((char*)d_out, 0xFF, (size_t)M * D * 4, stream);
#endif
    Args a{};
    for (int i = 0; i < 43; ++i) a.in[i] = (const float*)d_in[i];
    a.positions = (const int*)d_in[I_POS]; a.out = (float*)d_out; a.ws = (unsigned char*)d_ws;
#if MK_PER_PHASE
#ifndef DBG_NPH
#define DBG_NPH N_PHASES
#endif
    for (int p = 0; p < DBG_NPH; ++p) { a.ph_lo = p; a.ph_hi = p + 1; hipLaunchKernelGGL(fwd_kernel, dim3(grid), dim3(512), LDS_BYTES, stream, a); }
#ifdef DBG_DUMP_OFF
    hipLaunchKernelGGL(dbg_dump, dim3(2048), dim3(256), 0, stream, (const bf16_t*)((const char*)d_ws + (size_t)(DBG_DUMP_OFF)), (float*)d_out, (size_t)M * D);
#endif
#else
    a.ph_lo = 0; a.ph_hi = N_PHASES; hipLaunchKernelGGL(fwd_kernel, dim3(grid), dim3(512), LDS_BYTES, stream, a);
#ifdef DBG_EXTRA_PH
    a.dbg = DBG_EXTRA_FLAGS;
    for (int rep = 0; rep < DBG_EXTRA_REP; ++rep) { a.ph_lo = DBG_EXTRA_PH; a.ph_hi = DBG_EXTRA_PH + 1; hipLaunchKernelGGL(fwd_kernel, dim3(grid), dim3(512), LDS_BYTES, stream, a); }
#endif
#endif
}
```

```cpp
#include <hip/hip_runtime.h>
#include <cstdio>
#include <cstdint>


#ifndef DSA_SKIP
#define DSA_SKIP 0
#endif
#ifndef DSA_PM
#define DSA_PM 0
#endif
#ifndef R_S1
#define R_S1 1
#endif
#ifndef R_S2
#define R_S2 1
#endif
#ifndef R_S3
#define R_S3 1
#endif
#ifndef EN_DSA
#define EN_DSA 1
#endif
#ifndef EN_S53
#define EN_S53 1
#endif
#ifndef EN_SSD3
#define EN_SSD3 1
#endif
#ifndef R_GWIN
#define R_GWIN 1
#endif
#ifndef R_GLU
#define R_GLU 1
#endif
#ifndef R_GP
#define R_GP 1
#endif
#ifndef MOE_PAIR
#define MOE_PAIR 1
#endif
#ifndef R_QK
#define R_QK 1
#endif
#ifndef PEEL_GWIN
#define PEEL_GWIN false
#endif
#ifndef PEEL_MOE1
#define PEEL_MOE1 true
#endif
#ifndef ALIGN_MOE1
#define ALIGN_MOE1 G_ALIGN
#endif
#ifndef PW_GP
#define PW_GP 1
#endif
#ifndef PW_GGATE
#define PW_GGATE 2
#endif
#ifndef PW_GOUT
#define PW_GOUT 1
#endif
#ifndef MOE_PAIR4
#define MOE_PAIR4 2
#endif
#ifndef MOE_PAIR2
#define MOE_PAIR2 1
#endif
#ifndef R_GGATE
#define R_GGATE 1
#endif
#ifndef R_DENSE
#define R_DENSE 1
#endif
#ifndef R_MOE
#define R_MOE 1
#endif
#ifndef R_DSA
#define R_DSA 1
#endif
#ifndef R_MIX
#define R_MIX 1
#endif
#ifndef R_MISC
#define R_MISC 1
#endif
#ifndef MK_PER_PHASE
#define MK_PER_PHASE 0
#endif

#ifndef EN_PROLOGUE
#define EN_PROLOGUE 1
#endif
#ifndef EN_WCONV
#define EN_WCONV 1
#endif
#ifndef EN_GWIN
#define EN_GWIN 1
#endif
#ifndef EN_MX1
#define EN_MX1 1
#endif
#ifndef EN_MX2
#define EN_MX2 1
#endif
#ifndef EN_GLU
#define EN_GLU 1
#endif
#ifndef EN_GP
#define EN_GP 1
#endif
#ifndef EN_GGATE
#define EN_GGATE 1
#endif
#ifndef EN_GOUT
#define EN_GOUT 1
#endif
#ifndef EN_LN1
#define EN_LN1 1
#endif
#ifndef EN_FILL
#define EN_FILL 1
#endif
#ifndef EN_MOE1
#define EN_MOE1 1
#endif
#ifndef EN_MOE2
#define EN_MOE2 1
#endif
#ifndef EN_FIN
#define EN_FIN 1
#endif
#ifndef G_ALIGN
#define G_ALIGN true
#endif
#ifndef G_SP2
#define G_SP2 true
#endif
#define LAS __attribute__((address_space(3)))
#define GAS __attribute__((address_space(1)))
typedef unsigned short bf16_t;
typedef short bf16x8 __attribute__((ext_vector_type(8)));
typedef float f32x4 __attribute__((ext_vector_type(4)));
typedef float f32x2 __attribute__((ext_vector_type(2)));
typedef unsigned u32x4 __attribute__((ext_vector_type(4)));
typedef unsigned u32x2 __attribute__((ext_vector_type(2)));

constexpr int NB = 4, SEQ = 8192, M = NB * SEQ, D = 1024, DEPTH = 2;
constexpr int PJ = 2304;
constexpr int C_GU = 0, C_GV = 256, C_Q = 512, C_K = 768, C_V = 832, C_QI = 896, C_KI = 1152, C_S5 = 1216, C_Z = 1472, C_XBC = 1728, C_WI = 2240, C_DT = 2244;
constexpr int D_IN = 2248;
constexpr int NEXP = 32, NE1 = 33;
constexpr int NCH = 4, CHTOK = M / NCH;
constexpr int CH_ROWS = CHTOK * 8 + CHTOK + NE1 * 256;
constexpr float DN_ALPHA = 1.41421356237f;
constexpr float LN_EPS = 1e-5f, RMS_EPS = 1e-6f;
#ifndef PFP8
#define PFP8 1
#endif
constexpr float K_SCALE = 8.0f, Q_SCALE = 8.0f;
constexpr float V_SCALE = 8.0f;
constexpr float P_SCALE = 8.0f, O_SCALE = 32.0f;

constexpr size_t MiB = 1u << 20;
constexpr size_t WS_CTL = 0, CTL_BYTES = 1 * MiB;
constexpr size_t WS_MODV = 1 * MiB;
constexpr size_t WS_S5B = WS_MODV + 256 * 1024;
constexpr size_t WS_S5C = WS_S5B + 64 * 1024;
constexpr size_t WS_S5A = WS_S5C + 64 * 1024;
constexpr size_t WS_GMW = WS_S5A + 64 * 1024;
constexpr size_t WS_RFR = WS_GMW + 128 * 1024;
static_assert(WS_RFR + 128 * 1024 <= 2 * MiB, "misc tables");
constexpr size_t WS_S5ST = 2 * MiB;
constexpr size_t WS_ATOT = 3 * MiB;
constexpr size_t WS_WGBASE = 3 * MiB + 64 * 1024;
constexpr size_t WS_PINFO = 4 * MiB;
constexpr size_t WS_PGATE = 5 * MiB;
constexpr size_t WS_SLOT = 6 * MiB;
constexpr size_t WS_ROWTOK = 7 * MiB;
constexpr size_t WS_ROWGATE = 9 * MiB;
constexpr size_t WS_S5HIN = 11 * MiB;
constexpr size_t WS_ROPE = 12 * MiB;
constexpr size_t WS_W = 24 * MiB;
constexpr size_t WO_IN = 0, WO_GATE = WO_IN + (size_t)PJ * 1024 * 2, WO_BR = WO_GATE + (size_t)4096 * 1024 * 2, WO_OUT = WO_BR + (size_t)4 * 1024 * 256 * 2,
                 WO_GLU = WO_OUT + (size_t)1024 * 1024 * 2, WO_13 = WO_GLU + (size_t)256 * 256 * 2, WO_2 = WO_13 + (size_t)NE1 * 512 * 1024 * 2, WO_END = WO_2 + (size_t)NE1 * 1024 * 256 * 2;
static_assert(WO_END <= 72 * MiB, "weights region");
constexpr size_t WS_H = 96 * MiB;
constexpr size_t WS_Y = 160 * MiB;
constexpr size_t WS_PROJ = 224 * MiB;
constexpr size_t WS_P = 224 * MiB;
constexpr size_t WS_SSDST = 368 * MiB;
constexpr size_t WS_SSDSIN = 400 * MiB;
constexpr size_t WS_KI2 = 408 * MiB, WS_K2 = 412 * MiB, WS_V2 = 416 * MiB;
constexpr size_t WS_YCPRE = 384 * MiB;
constexpr size_t WS_V16 = 224 * MiB;
constexpr size_t WS_ACT = 160 * MiB;
constexpr size_t WS_OPAIR = 321 * MiB;
static_assert(CH_ROWS % 256 == 0 && WS_ACT + (size_t)NCH * CH_ROWS * 512 <= WS_OPAIR && WS_OPAIR + (size_t)2 * CH_ROWS * 1024 <= 512 * MiB, "moe buffers");
constexpr int CH_TILES = CH_ROWS / 256;
constexpr size_t WS_NEED = 512 * MiB;
constexpr int CW_BAR = 4096;
constexpr int CW_CNT = 16384;

constexpr int LDS_BYTES = 160 * 1024;
constexpr int LDS_TAB = 131072;
constexpr int LDS_MISC = LDS_BYTES - 256;

__device__ __forceinline__ unsigned f2bf(float f) { unsigned u = __builtin_bit_cast(unsigned, f); return (u + 0x7fffu + ((u >> 16) & 1u)) >> 16; }
__device__ __forceinline__ unsigned pk2(float lo, float hi) { return f2bf(lo) | (f2bf(hi) << 16); }
__device__ __forceinline__ float bf2f(unsigned short b) { return __builtin_bit_cast(float, (unsigned)b << 16); }
__device__ __forceinline__ float bflo(unsigned w) { return __builtin_bit_cast(float, w << 16); }
__device__ __forceinline__ float bfhi(unsigned w) { return __builtin_bit_cast(float, w & 0xffff0000u); }
__device__ __forceinline__ int lane_id_opaque() { unsigned am = ~0u; asm volatile("" : "+s"(am)); return (int)__builtin_amdgcn_mbcnt_hi(am, __builtin_amdgcn_mbcnt_lo(am, 0u)); }
__device__ __forceinline__ int lshfl(int v, int src, int) { return __builtin_amdgcn_ds_bpermute(src << 2, v); }
__device__ __forceinline__ float lshfl(float v, int src, int) { return __builtin_bit_cast(float, __builtin_amdgcn_ds_bpermute(src << 2, __builtin_bit_cast(int, v))); }
template <int CTRL> __device__ __forceinline__ float dppx(float v) { return __builtin_bit_cast(float, __builtin_amdgcn_update_dpp(0, __builtin_bit_cast(int, v), CTRL, 0xF, 0xF, true)); }
__device__ __forceinline__ float rdl(float v, int l) { return __builtin_bit_cast(float, __builtin_amdgcn_readlane(__builtin_bit_cast(int, v), l)); }
__device__ __forceinline__ float wave_sum(float v) {
    v += dppx<0xB1>(v); v += dppx<0x4E>(v); v += dppx<0x141>(v); v += dppx<0x140>(v);
    return (rdl(v, 0) + rdl(v, 16)) + (rdl(v, 32) + rdl(v, 48));
}
__device__ __forceinline__ float wave_max(float v) {
    v = fmaxf(v, dppx<0xB1>(v)); v = fmaxf(v, dppx<0x4E>(v)); v = fmaxf(v, dppx<0x141>(v)); v = fmaxf(v, dppx<0x140>(v));
    return fmaxf(fmaxf(rdl(v, 0), rdl(v, 16)), fmaxf(rdl(v, 32), rdl(v, 48)));
}
template <int CTRL, int RMASK, bool BC> __device__ __forceinline__ int dppi(int v) { return __builtin_amdgcn_update_dpp(0, v, CTRL, RMASK, 0xF, BC); }
__device__ __forceinline__ int wave_prefix_incl(int v) {
    v += dppi<0x111, 0xF, true>(v); v += dppi<0x112, 0xF, true>(v); v += dppi<0x114, 0xF, true>(v); v += dppi<0x118, 0xF, true>(v);
    v += dppi<0x142, 0xA, false>(v); v += dppi<0x143, 0xC, false>(v);
    return v;
}
__device__ __forceinline__ float wave_prefix_incl(float v) {
    v += __builtin_bit_cast(float, dppi<0x111, 0xF, true>(__builtin_bit_cast(int, v))); v += __builtin_bit_cast(float, dppi<0x112, 0xF, true>(__builtin_bit_cast(int, v)));
    v += __builtin_bit_cast(float, dppi<0x114, 0xF, true>(__builtin_bit_cast(int, v))); v += __builtin_bit_cast(float, dppi<0x118, 0xF, true>(__builtin_bit_cast(int, v)));
    v += __builtin_bit_cast(float, dppi<0x142, 0xA, false>(__builtin_bit_cast(int, v))); v += __builtin_bit_cast(float, dppi<0x143, 0xC, false>(__builtin_bit_cast(int, v)));
    return v;
}
__device__ __forceinline__ int wave_suffix_incl(int x) { const int p = wave_prefix_incl(x); return __builtin_amdgcn_readlane(p, 63) - p + x; }
__device__ __forceinline__ int wave_sum_i(int v) {
    const int l = lane_id_opaque();
#pragma unroll
    for (int o = 1; o < 64; o <<= 1) v += lshfl(v, l ^ o, 0);
    return v;
}
__device__ __forceinline__ float sig2_(float y) { return __builtin_amdgcn_rcpf(1.0f + __builtin_amdgcn_exp2f(y)); }
__device__ __forceinline__ float sigmoidf_(float x) { return __builtin_amdgcn_rcpf(1.0f + __expf(-x)); }
__device__ __forceinline__ float siluf_(float x) { return x * __builtin_amdgcn_rcpf(1.0f + __expf(-x)); }
__device__ __forceinline__ float gelu_tanh(float x) { const float u = 1.5957691216057308f * (x + 0.044715f * x * x * x); return x * __builtin_amdgcn_rcpf(1.0f + __expf(-u)); }
__device__ __forceinline__ float softplusf_(float x) { return fmaxf(x, 0.f) + log1pf(__expf(-fabsf(x))); }
__device__ __forceinline__ void sincos_red(float ang, float& sn, float& cs) {
    const double a = (double)ang; const double q = __builtin_rint(a * 0.63661977236758134308);
    const float r = (float)(a - q * 1.57079632679489661923); const int qi = (int)q & 3;
    const float r2 = r * r;
    const float s = r * (1.0f + r2 * (-1.6666667e-1f + r2 * (8.3333333e-3f + r2 * (-1.9841270e-4f + r2 * 2.7557319e-6f))));
    const float c = 1.0f + r2 * (-0.5f + r2 * (4.1666667e-2f + r2 * (-1.3888889e-3f + r2 * (2.4801587e-5f + r2 * -2.7557319e-7f))));
    sn = (qi == 0) ? s : (qi == 1) ? c : (qi == 2) ? -s : -c;
    cs = (qi == 0) ? c : (qi == 1) ? -s : (qi == 2) ? -c : s;
}
__device__ __forceinline__ f32x4 mfma16(bf16x8 a, bf16x8 b, f32x4 c) { return __builtin_amdgcn_mfma_f32_16x16x32_bf16(a, b, c, 0, 0, 0); }
__device__ __forceinline__ unsigned cvt_pk_bf16(float lo, float hi) { unsigned r; asm volatile("v_cvt_pk_bf16_f32 %0, %1, %2" : "=v"(r) : "v"(lo), "v"(hi)); return r; }

namespace pg8 {
constexpr int BM = 256, BK = 64, HALF = 128, HTB = HALF * BK * 2, STAGE_BYTES = 8 * HTB, NXCD = 8, WGM = 8;
__host__ __device__ __forceinline__ int lds_byte(int r, int c) { const int st = (r >> 4) * 2 + (c >> 5), rr = r & 15, cc = c & 31, ob = rr * 64 + cc * 2; return st * 1024 + (ob ^ (((ob >> 9) & 1) << 5)); }
__host__ __device__ __forceinline__ void stage_rc(int b, int& R, int& C) { const int st = b / 1024, sb = b % 1024, swz = sb ^ (((sb >> 9) & 1) << 5); R = (st >> 1) * 16 + swz / 64; C = (st & 1) * 32 + (swz % 64) / 2; }
__host__ __device__ __forceinline__ int perm32(int rho) { const int n = rho >> 4, i = rho & 15; return 8 * (i >> 2) + 4 * n + (i & 3); }

struct Unit { int pm, pn, bt, ab; };
struct Gemm { const bf16_t* A; const bf16_t* Bt; int K; size_t a_sel_stride; };

__device__ __forceinline__ int xcd_remap(int wgid, int nwg) { const int q = nwg / NXCD, r = nwg % NXCD, xcd = wgid % NXCD, off = wgid / NXCD; return (xcd < r ? xcd * (q + 1) : r * (q + 1) + (xcd - r) * q) + off; }

struct StaticOrder {
    static constexpr bool GATHER = false;
    int nM, nN, nwg, G, c;
    __device__ void init(int Mr, int N, int G_, int c_) { nM = Mr / BM; nN = N / BM; nwg = nM * nN; G = G_; c = c_; }
    __device__ __forceinline__ bool next(int i, Unit& u) const {
        const long L = (long)i * G + c; if (L >= nwg) return false;
        const int wgid = xcd_remap((int)L, nwg);
        const int nig = WGM * nN, gid = wgid / nig, fm = gid * WGM, gsz = (nM - fm) < WGM ? (nM - fm) : WGM;
        u.pm = fm + ((wgid % nig) % gsz); u.pn = (wgid % nig) / gsz; u.bt = u.pn; u.ab = 0; return true;
    }
    __device__ __forceinline__ void a_ready(const Unit&) const {}
    __device__ __forceinline__ void done(const Unit&) const {}
};

template <class Epi, class Sched, bool ALIGN_EPI = false, bool SP2 = true, bool PEEL = false>
__device__ __forceinline__ void gemm_phase(LAS unsigned char* lds, const Gemm g, const Sched& S, const Epi& E, const int tid) {
    const int wid = __builtin_amdgcn_readfirstlane(tid >> 6), lane = tid & 63, wr = wid >> 2, wc = wid & 3, fr = lane & 15, fq = lane >> 4;
    const int K = g.K, nt = K / BK;
    unsigned voffA[2], voffB[2];
#pragma unroll
    for (int i = 0; i < 2; ++i) { int R, C; stage_rc(tid * 16 + i * 8192, R, C); const int Rb = Epi::PERM ? ((R & ~31) + perm32(R & 31)) : R;
        voffA[i] = (unsigned)(R * K + C) * 2u; voffB[i] = (unsigned)(Rb * K + C) * 2u; }
    const size_t kstep = (size_t)(BK * 2);
    const size_t hstep = (size_t)HALF * K * 2;
    const size_t tstep = 2 * hstep;
    const unsigned ldsw = (unsigned)wid * 1024u;
    const int aoff = lds_byte(wr * 64 + fr, fq * 8), boff = lds_byte(wc * 32 + fr, fq * 8);
#define PG8_SA(b, h) (((b) * 2 + (h)) * HTB)
#define PG8_SB(b, h) ((4 + (b) * 2 + (h)) * HTB)
#define PG8_STAGE(bufoff, gbase, voff) do { _Pragma("unroll") for (int _i = 0; _i < 2; ++_i) \
        __builtin_amdgcn_global_load_lds((const unsigned*)((const char*)(gbase) + (voff)[_i]), (LAS unsigned*)(lds + (bufoff) + ldsw + _i * 8192), 16, 0, 0); } while (0)
#define PG8_GO(u) do { _Pragma("unroll") for (int _h = 0; _h < 2; ++_h) _Pragma("unroll") for (int _i = 0; _i < 2; ++_i) { int _R, _C; stage_rc(tid * 16 + _i * 8192, _R, _C); \
        cgo[_h][_i] = (unsigned)S.row_of(u, _h * HALF + _R) * (unsigned)(K * 2) + (unsigned)_C * 2u; } } while (0)
#define PG8_STAGE_A(bufoff, base, h, kb, NX) do { if constexpr (Sched::GATHER) { _Pragma("unroll") for (int _i = 0; _i < 2; ++_i) \
        __builtin_amdgcn_global_load_lds((const unsigned*)((const char*)g.A + (kb) + cgo[h][_i]), (LAS unsigned*)(lds + (bufoff) + ldsw + _i * 8192), 16, 0, 0); } \
        else { PG8_STAGE(bufoff, (base) + (size_t)(h) * hstep + (kb), voffA); } } while (0)
#define PG8_LDA(dst, b, h) do { _Pragma("unroll") for (int m = 0; m < 4; ++m) _Pragma("unroll") for (int k = 0; k < 2; ++k) dst[m][k] = *(const LAS bf16x8*)(lds + PG8_SA(b, h) + aoff + m * 2048 + k * 1024); } while (0)
#define PG8_LDB(dst, b, h) do { _Pragma("unroll") for (int n = 0; n < 2; ++n) _Pragma("unroll") for (int k = 0; k < 2; ++k) dst[n][k] = *(const LAS bf16x8*)(lds + PG8_SB(b, h) + boff + n * 2048 + k * 1024); } while (0)
#define PG8_MMA(ai, bj, At, Bt) do { __builtin_amdgcn_s_setprio(1); _Pragma("unroll") for (int m = 0; m < 4; ++m) _Pragma("unroll") for (int n = 0; n < 2; ++n) _Pragma("unroll") for (int k = 0; k < 2; ++k) \
        acc[ai][bj][m][n] = __builtin_amdgcn_mfma_f32_16x16x32_bf16(Bt[n][k], At[m][k], acc[ai][bj][m][n], 0, 0, 0); __builtin_amdgcn_s_setprio(0); } while (0)
#define PG8_MMAZ(ai, bj, At, Bt) do { __builtin_amdgcn_s_setprio(1); _Pragma("unroll") for (int m = 0; m < 4; ++m) _Pragma("unroll") for (int n = 0; n < 2; ++n) { \
        acc[ai][bj][m][n] = __builtin_amdgcn_mfma_f32_16x16x32_bf16(Bt[n][0], At[m][0], zc_, 0, 0, 0); \
        acc[ai][bj][m][n] = __builtin_amdgcn_mfma_f32_16x16x32_bf16(Bt[n][1], At[m][1], acc[ai][bj][m][n], 0, 0, 0); } __builtin_amdgcn_s_setprio(0); } while (0)
#define PG8_WAIT_V(n) asm volatile("s_waitcnt vmcnt(" #n ")" ::: "memory")
#define PG8_WAIT_L(n) asm volatile("s_waitcnt lgkmcnt(" #n ")" ::: "memory")
#define PG8_BAR __builtin_amdgcn_s_barrier()
#define PG8_SCHED __builtin_amdgcn_sched_barrier(0)
    Unit cur, nxt; int ui = 0;
    if (!S.next(0, cur)) return;
    f32x4 acc[2][2][4][2];
#define PG8_ZERO do { _Pragma("unroll") for (int a = 0; a < 2; ++a) _Pragma("unroll") for (int b = 0; b < 2; ++b) _Pragma("unroll") for (int m = 0; m < 4; ++m) _Pragma("unroll") for (int n = 0; n < 2; ++n) acc[a][b][m][n] = (f32x4){0.f, 0.f, 0.f, 0.f}; } while (0)
    if constexpr (!PEEL) PG8_ZERO;
    bf16x8 At[4][2], B0[2][2], B1[2][2];
    unsigned cgo[2][2];
    if constexpr (Sched::GATHER) PG8_GO(cur);
    const char* cA = (const char*)(g.A + (size_t)cur.ab * g.a_sel_stride) + (size_t)cur.pm * tstep; const char* cB = (const char*)g.Bt + (size_t)cur.bt * tstep;
    S.a_ready(cur);
    if constexpr (SP2) {
        PG8_STAGE(PG8_SB(0, 0), cB, voffB); PG8_STAGE(PG8_SB(0, 1), cB + hstep, voffB); PG8_STAGE_A(PG8_SA(0, 0), cA, 0, (size_t)0, false); PG8_STAGE_A(PG8_SA(0, 1), cA, 1, (size_t)0, false);
        if (wr == 1) PG8_BAR;
        PG8_WAIT_V(2); PG8_BAR;
        PG8_STAGE(PG8_SB(1, 0), cB + kstep, voffB); PG8_STAGE_A(PG8_SA(1, 0), cA, 0, kstep, false); PG8_STAGE(PG8_SB(1, 1), cB + hstep + kstep, voffB);
        PG8_WAIT_V(6); PG8_BAR;
    } else {
        PG8_STAGE(PG8_SB(0, 0), cB, voffB); PG8_STAGE_A(PG8_SA(0, 0), cA, 0, (size_t)0, false); PG8_STAGE(PG8_SB(0, 1), cB + hstep, voffB); PG8_STAGE_A(PG8_SA(0, 1), cA, 1, (size_t)0, false);
        if (wr == 1) PG8_BAR;
        PG8_WAIT_V(4); PG8_BAR;
        PG8_STAGE(PG8_SB(1, 0), cB + kstep, voffB); PG8_STAGE_A(PG8_SA(1, 0), cA, 0, kstep, false); PG8_STAGE(PG8_SB(1, 1), cB + hstep + kstep, voffB);
        PG8_WAIT_V(6); PG8_BAR;
    }
    static_assert(SP2, "only the SP2 schedule is kept");
#define PG8_ITER(MMA_FIRST) do { \
            if constexpr (Epi::PRE) { if (t == nt - 4) E.pre(cur, lds, wid, wr, wc, lane); }     \
            const bool last = (t == nt - 2); \
            const size_t k1 = (size_t)(t + 1) * kstep; \
            const char* a2b = last ? nA : cA; const size_t k2 = last ? (size_t)0 : (size_t)(t + 2) * kstep; const size_t k3 = k2 + kstep; \
            const char* b2 = last ? nB : cB + (size_t)(t + 2) * kstep; const char* b3 = b2 + kstep; \
            if (last && has_next) S.a_ready(nxt); \
            PG8_LDB(B0, 0, 0); PG8_LDB(B1, 0, 1); PG8_SCHED; PG8_LDA(At, 0, 0); PG8_STAGE_A(PG8_SA(1, 1), cA, 1, k1, false); \
            if constexpr (Sched::GATHER) { if (last && has_next) PG8_GO(nxt); } \
            PG8_WAIT_V(8); PG8_WAIT_L(0); PG8_BAR; MMA_FIRST(0, 0, At, B0); MMA_FIRST(0, 1, At, B1); PG8_BAR; PG8_SCHED; \
            PG8_LDA(At, 0, 1); PG8_STAGE(PG8_SB(0, 0), b2, voffB); PG8_STAGE(PG8_SB(0, 1), b2 + hstep, voffB); PG8_STAGE_A(PG8_SA(0, 0), a2b, 0, k2, last); \
            PG8_WAIT_V(8); PG8_WAIT_L(0); PG8_BAR; MMA_FIRST(1, 0, At, B0); MMA_FIRST(1, 1, At, B1); PG8_BAR; PG8_SCHED; \
            PG8_LDB(B0, 1, 0); PG8_LDB(B1, 1, 1); PG8_SCHED; PG8_LDA(At, 1, 0); PG8_STAGE_A(PG8_SA(0, 1), a2b, 1, k2, last); \
            PG8_WAIT_V(8); PG8_WAIT_L(0); PG8_BAR; PG8_MMA(0, 0, At, B0); PG8_MMA(0, 1, At, B1); PG8_BAR; PG8_SCHED; \
            PG8_LDA(At, 1, 1); PG8_STAGE(PG8_SB(1, 0), b3, voffB); PG8_STAGE(PG8_SB(1, 1), b3 + hstep, voffB); PG8_STAGE_A(PG8_SA(1, 0), a2b, 0, k3, last); \
            PG8_WAIT_V(8); PG8_WAIT_L(0); PG8_BAR; PG8_MMA(1, 0, At, B0); PG8_MMA(1, 1, At, B1); PG8_BAR; PG8_SCHED; } while (0)
    for (;;) {
        const bool has_next = S.next(ui + 1, nxt);
        const char* nA = has_next ? (const char*)(g.A + (size_t)nxt.ab * g.a_sel_stride) + (size_t)nxt.pm * tstep : cA; const char* nB = has_next ? (const char*)g.Bt + (size_t)nxt.bt * tstep : cB;
        if constexpr (PEEL) { { const int t = 0; f32x4 zc_ = (f32x4){0.f, 0.f, 0.f, 0.f}; asm volatile("" : "+v"(zc_)); PG8_ITER(PG8_MMAZ); }
#pragma nounroll
            for (int t = 2; t < nt; t += 2) { PG8_ITER(PG8_MMA); } }
        else {
#pragma nounroll
            for (int t = 0; t < nt; t += 2) { PG8_ITER(PG8_MMA); } }
        if constexpr (ALIGN_EPI) { if (wr == 0) PG8_BAR; }
        { const int le_ = lane_id_opaque(); if constexpr (Epi::PRE) E(acc, cur, wr, wc, le_ & 15, le_ >> 4, lds, wid); else E(acc, cur, wr, wc, le_ & 15, le_ >> 4); }
        S.done(cur);
        if (!has_next) break;
        if constexpr (!PEEL) PG8_ZERO;
        cur = nxt; cA = nA; cB = nB; ++ui;
        if constexpr (ALIGN_EPI) { if (wr == 1) PG8_BAR; }
    }
#undef PG8_ITER
#undef PG8_ZERO
#undef PG8_MMAZ
    PG8_WAIT_V(0);
    if constexpr (!ALIGN_EPI) { if (wr == 0) PG8_BAR; }
    PG8_BAR;
#undef PG8_SA
#undef PG8_SB
#undef PG8_STAGE
#undef PG8_STAGE_A
#undef PG8_GO
#undef PG8_LDA
#undef PG8_LDB
#undef PG8_MMA
#undef PG8_WAIT_V
#undef PG8_WAIT_L
#undef PG8_BAR
#undef PG8_SCHED
}

struct EpiBf16 {
    static constexpr bool PRE = false; static constexpr bool PERM = true;
    bf16_t* O; int ldc;
    __device__ __forceinline__ void operator()(const f32x4 (&acc)[2][2][4][2], const Unit& u, int wr, int wc, int fr, int fq) const {
        const int row0 = u.pm * BM + wr * 64 + fr, col0 = u.pn * BM + wc * 32 + 8 * fq;
#pragma unroll
        for (int ai = 0; ai < 2; ++ai)
#pragma unroll
            for (int m = 0; m < 4; ++m) { bf16_t* rowp = O + (size_t)(row0 + ai * HALF + m * 16) * ldc + col0;
#pragma unroll
                for (int bj = 0; bj < 2; ++bj) { const f32x4 v0 = acc[ai][bj][m][0], v1 = acc[ai][bj][m][1];
                    u32x4 w; w.x = cvt_pk_bf16(v0[0], v0[1]); w.y = cvt_pk_bf16(v0[2], v0[3]); w.z = cvt_pk_bf16(v1[0], v1[1]); w.w = cvt_pk_bf16(v1[2], v1[3]);
                    *(u32x4*)(rowp + bj * HALF) = w; } }
    }
};
__device__ __forceinline__ unsigned pk4_fp8(float a, float b, float c, float d) { int w = 0; w = __builtin_amdgcn_cvt_pk_fp8_f32(a, b, w, false); w = __builtin_amdgcn_cvt_pk_fp8_f32(c, d, w, true); return (unsigned)w; }
__device__ __forceinline__ f32x4 clamp_fp8(f32x4 v, float sc) { f32x4 r; r[0] = __builtin_amdgcn_fmed3f(v[0] * sc, -440.f, 440.f); r[1] = __builtin_amdgcn_fmed3f(v[1] * sc, -440.f, 440.f);
    r[2] = __builtin_amdgcn_fmed3f(v[2] * sc, -440.f, 440.f); r[3] = __builtin_amdgcn_fmed3f(v[3] * sc, -440.f, 440.f); return r; }
__device__ __forceinline__ f32x4 clamp_fp8n(f32x4 v) { f32x4 r; r[0] = __builtin_amdgcn_fmed3f(v[0], -440.f, 440.f); r[1] = __builtin_amdgcn_fmed3f(v[1], -440.f, 440.f); r[2] = __builtin_amdgcn_fmed3f(v[2], -440.f, 440.f); r[3] = __builtin_amdgcn_fmed3f(v[3], -440.f, 440.f); return r; }
struct EpiFp8 {
    static constexpr bool PRE = false; static constexpr bool PERM = false;
    unsigned char* O; int ldc; float scale;
    __device__ __forceinline__ void operator()(const f32x4 (&acc)[2][2][4][2], const Unit& u, int wr, int wc, int fr, int fq) const {
        const int row0 = u.pm * BM + wr * 64 + fr, col0 = u.pn * BM + wc * 64 + 16 * fq;
#pragma unroll
        for (int ai = 0; ai < 2; ++ai)
#pragma unroll
            for (int m = 0; m < 4; ++m) { unsigned char* rowp = O + (size_t)(row0 + ai * HALF + m * 16) * ldc + col0;
                const f32x4 v0 = clamp_fp8n(acc[ai][0][m][0]), v1 = clamp_fp8n(acc[ai][0][m][1]), v2 = clamp_fp8n(acc[ai][1][m][0]), v3 = clamp_fp8n(acc[ai][1][m][1]);
                u32x4 w; w.x = pk4_fp8(v0[0], v0[1], v0[2], v0[3]); w.y = pk4_fp8(v1[0], v1[1], v1[2], v1[3]); w.z = pk4_fp8(v2[0], v2[1], v2[2], v2[3]); w.w = pk4_fp8(v3[0], v3[1], v3[2], v3[3]);
                *(u32x4*)rowp = w; }
    }
};
struct EpiGlu {
    static constexpr bool PRE = false; static constexpr bool PERM = true;
    const bf16_t* Ysrc; bf16_t* O; const float* bias;
    __device__ __forceinline__ void operator()(const f32x4 (&acc)[2][2][4][2], const Unit& u, int wr, int wc, int fr, int fq) const {
        const int row0 = u.pm * BM + wr * 64 + fr, col0 = u.pn * BM + wc * 32 + 8 * fq;
#pragma unroll
        for (int ai = 0; ai < 2; ++ai)
#pragma unroll
            for (int m = 0; m < 4; ++m) { const size_t ro = (size_t)(row0 + ai * HALF + m * 16) * 256 + col0;
#pragma unroll
                for (int bj = 0; bj < 2; ++bj) { const f32x4 v0 = acc[ai][bj][m][0], v1 = acc[ai][bj][m][1];
                    const u32x4 yv = *(const u32x4*)(Ysrc + ro + bj * HALF);
                    const f32x4 b0 = *(const f32x4*)(bias + col0 + bj * HALF), b1 = *(const f32x4*)(bias + col0 + bj * HALF + 4);
                    float o[8];
                    o[0] = bflo(yv.x) * sigmoidf_(v0[0] + b0[0]); o[1] = bfhi(yv.x) * sigmoidf_(v0[1] + b0[1]); o[2] = bflo(yv.y) * sigmoidf_(v0[2] + b0[2]); o[3] = bfhi(yv.y) * sigmoidf_(v0[3] + b0[3]);
                    o[4] = bflo(yv.z) * sigmoidf_(v1[0] + b1[0]); o[5] = bfhi(yv.z) * sigmoidf_(v1[1] + b1[1]); o[6] = bflo(yv.w) * sigmoidf_(v1[2] + b1[2]); o[7] = bfhi(yv.w) * sigmoidf_(v1[3] + b1[3]);
                    u32x4 w; w.x = cvt_pk_bf16(o[0], o[1]); w.y = cvt_pk_bf16(o[2], o[3]); w.z = cvt_pk_bf16(o[4], o[5]); w.w = cvt_pk_bf16(o[6], o[7]);
                    *(u32x4*)(O + ro + bj * HALF) = w; } }
    }
};
struct EpiGateMerge {
    static constexpr bool PRE = false; static constexpr bool PERM = true;
    const unsigned char* P; bf16_t* Mg; float pinv;
    __device__ __forceinline__ void operator()(const f32x4 (&acc)[2][2][4][2], const Unit& u, int wr, int wc, int fr, int fq) const {
        const int i = u.pn >> 2, mt = u.pn & 3;
        const int row0 = u.pm * BM + wr * 64 + fr, col0 = mt * BM + wc * 32 + 8 * fq;
#pragma unroll
        for (int ai = 0; ai < 2; ++ai) {
            u32x2 pv[4][2]; u32x4 pvb[4][2]; u32x4 mv[4][2];
#pragma unroll
            for (int m = 0; m < 4; ++m)
#pragma unroll
                for (int bj = 0; bj < 2; ++bj) { const size_t r = (size_t)(row0 + ai * HALF + m * 16);
                    pv[m][bj] = PFP8 ? *(const u32x2*)(P + r * 4096 + i * 1024 + col0 + bj * HALF) : (u32x2){0u, 0u}; if (!PFP8) pvb[m][bj] = *(const u32x4*)((const bf16_t*)P + r * 4096 + i * 1024 + col0 + bj * HALF);
                    mv[m][bj] = (u32x4){0u, 0u, 0u, 0u}; if (i > 0) mv[m][bj] = *(const u32x4*)(Mg + r * 1024 + col0 + bj * HALF); }
#pragma unroll
            for (int m = 0; m < 4; ++m)
#pragma unroll
                for (int bj = 0; bj < 2; ++bj) { const size_t r = (size_t)(row0 + ai * HALF + m * 16); const f32x4 v0 = acc[ai][bj][m][0], v1 = acc[ai][bj][m][1]; const u32x2 p8 = pv[m][bj]; const u32x4 m4 = mv[m][bj];
                    f32x2 pa = __builtin_amdgcn_cvt_pk_f32_fp8((int)p8.x, false) * pinv, pb = __builtin_amdgcn_cvt_pk_f32_fp8((int)p8.x, true) * pinv,
                          pc = __builtin_amdgcn_cvt_pk_f32_fp8((int)p8.y, false) * pinv, pd = __builtin_amdgcn_cvt_pk_f32_fp8((int)p8.y, true) * pinv;
                    if (!PFP8) { const u32x4 q4 = pvb[m][bj]; pa = (f32x2){bflo(q4.x), bfhi(q4.x)}; pb = (f32x2){bflo(q4.y), bfhi(q4.y)}; pc = (f32x2){bflo(q4.z), bfhi(q4.z)}; pd = (f32x2){bflo(q4.w), bfhi(q4.w)}; }
                    float o[8];
                    o[0] = bflo(m4.x) + pa[0] * sigmoidf_(v0[0]); o[1] = bfhi(m4.x) + pa[1] * sigmoidf_(v0[1]); o[2] = bflo(m4.y) + pb[0] * sigmoidf_(v0[2]); o[3] = bfhi(m4.y) + pb[1] * sigmoidf_(v0[3]);
                    o[4] = bflo(m4.z) + pc[0] * sigmoidf_(v1[0]); o[5] = bfhi(m4.z) + pc[1] * sigmoidf_(v1[1]); o[6] = bflo(m4.w) + pd[0] * sigmoidf_(v1[2]); o[7] = bfhi(m4.w) + pd[1] * sigmoidf_(v1[3]);
                    u32x4 w; w.x = cvt_pk_bf16(o[0], o[1]); w.y = cvt_pk_bf16(o[2], o[3]); w.z = cvt_pk_bf16(o[4], o[5]); w.w = cvt_pk_bf16(o[6], o[7]);
                    *(u32x4*)(Mg + r * 1024 + col0 + bj * HALF) = w; }
        }
    }
};
struct EpiGateMerge4 {
    static constexpr bool PRE = true; static constexpr bool PERM = false;
    const unsigned char* P; bf16_t* Mg; float pinv;
    static constexpr int PRE_BASE = 131072, PRE_SLOT = 3072;
    __device__ __forceinline__ void pre(const Unit& u, LAS unsigned char* lds, int wid, int wr, int wc, int lane) const {
        const unsigned char* src = P + (size_t)(u.pm * BM + wr * 64 + lane) * 4096 + u.pn * 64 + wc * 16;
#pragma unroll
        for (int b = 0; b < 3; ++b) __builtin_amdgcn_global_load_lds((const unsigned*)(src + b * 1024), (LAS unsigned*)(lds + PRE_BASE + wid * PRE_SLOT + b * 1024), 16, 0, 0);
    }
    __device__ __forceinline__ void operator()(const f32x4 (&acc)[2][2][4][2], const Unit& u, int wr, int wc, int fr, int fq, LAS unsigned char* lds, int wid) const {
        const int row0 = u.pm * BM + wr * 64 + fr, col0 = u.pn * 64 + wc * 16 + 4 * fq;
        const int lane = fr + 16 * fq;
        unsigned p3[2][4];
#pragma unroll
        for (int ai = 0; ai < 2; ++ai)
#pragma unroll
            for (int m = 0; m < 4; ++m) p3[ai][m] = *(const unsigned*)(P + (size_t)(row0 + ai * HALF + m * 16) * 4096 + 3 * 1024 + col0);
        LAS unsigned char* slotb = lds + PRE_BASE + wid * PRE_SLOT;
        const LAS unsigned* slot = (const LAS unsigned*)slotb + fr * 4 + fq;
#pragma unroll
        for (int ai = 0; ai < 2; ++ai) {
            unsigned pv[4][4];
#pragma unroll
            for (int m = 0; m < 4; ++m)
#pragma unroll
                for (int b = 0; b < 4; ++b) pv[m][b] = (b < 3) ? slot[b * 256 + m * 64] : p3[ai][m];
            if (ai == 0) {
                asm volatile("s_waitcnt lgkmcnt(0)" ::: "memory");
                const unsigned char* src = P + (size_t)(u.pm * BM + HALF + wr * 64 + lane) * 4096 + u.pn * 64 + wc * 16;
#pragma unroll
                for (int b = 0; b < 3; ++b) __builtin_amdgcn_global_load_lds((const unsigned*)(src + b * 1024), (LAS unsigned*)(slotb + b * 1024), 16, 0, 0);
            }
            f32x4 o[4];
#pragma unroll
            for (int m = 0; m < 4; ++m) o[m] = (f32x4){0.f, 0.f, 0.f, 0.f};
#pragma unroll
            for (int b = 0; b < 4; ++b)
#pragma unroll
                for (int m = 0; m < 4; ++m) { const f32x4 v = acc[ai][b >> 1][m][b & 1]; const f32x2 pa = __builtin_amdgcn_cvt_pk_f32_fp8((int)pv[m][b], false), pb = __builtin_amdgcn_cvt_pk_f32_fp8((int)pv[m][b], true);
                    o[m][0] += pa[0] * sig2_(v[0]); o[m][1] += pa[1] * sig2_(v[1]); o[m][2] += pb[0] * sig2_(v[2]); o[m][3] += pb[1] * sig2_(v[3]); }
            u32x2 wv[4];
#pragma unroll
            for (int m = 0; m < 4; ++m) { wv[m].x = cvt_pk_bf16(o[m][0] * pinv, o[m][1] * pinv); wv[m].y = cvt_pk_bf16(o[m][2] * pinv, o[m][3] * pinv); }
            if (ai == 0) asm volatile("s_waitcnt vmcnt(0)" ::: "memory");
#pragma unroll
            for (int m = 0; m < 4; ++m) *(u32x2*)(Mg + (size_t)(row0 + ai * HALF + m * 16) * 1024 + col0) = wv[m];
        }
    }
};
template <bool XBF> struct EpiResidT {
    static constexpr bool PRE = false; static constexpr bool PERM = false;
    const void* xin; bf16_t* out; const float* gate;
    __device__ __forceinline__ void operator()(const f32x4 (&acc)[2][2][4][2], const Unit& u, int wr, int wc, int fr, int fq) const {
        const int row0 = u.pm * BM + wr * 64 + fr, col0 = u.pn * BM + wc * 64 + 8 * fq;
        const int b = (u.pm * BM) / SEQ;
        f32x4 gv[2][2];
#pragma unroll
        for (int bj = 0; bj < 2; ++bj)
#pragma unroll
            for (int n = 0; n < 2; ++n) gv[bj][n] = *(const f32x4*)(gate + b * 3072 + 2048 + col0 + bj * 32 + n * 4) + 1.0f;
#pragma unroll
        for (int ai = 0; ai < 2; ++ai)
#pragma unroll
            for (int mh = 0; mh < 4; mh += 2) {
                f32x4 xv[2][2][2];
#pragma unroll
                for (int m = 0; m < 2; ++m)
#pragma unroll
                    for (int bj = 0; bj < 2; ++bj)
#pragma unroll
                        for (int n = 0; n < 2; ++n) { const size_t eo = (size_t)(row0 + ai * HALF + (mh + m) * 16) * D + col0 + bj * 32 + n * 4;
                            if constexpr (XBF) { const u32x2 q = *(const u32x2*)((const bf16_t*)xin + eo); xv[m][bj][n] = (f32x4){bflo(q.x), bfhi(q.x), bflo(q.y), bfhi(q.y)}; }
                            else xv[m][bj][n] = *(const f32x4*)((const float*)xin + eo); }
#pragma unroll
                for (int m = 0; m < 2; ++m)
#pragma unroll
                    for (int bj = 0; bj < 2; ++bj) { const f32x4 v0 = xv[m][bj][0] * DN_ALPHA + gv[bj][0] * acc[ai][bj][mh + m][0], v1 = xv[m][bj][1] * DN_ALPHA + gv[bj][1] * acc[ai][bj][mh + m][1];
                        u32x4 w; w.x = cvt_pk_bf16(v0[0], v0[1]); w.y = cvt_pk_bf16(v0[2], v0[3]); w.z = cvt_pk_bf16(v1[0], v1[1]); w.w = cvt_pk_bf16(v1[2], v1[3]);
                        *(u32x4*)(out + (size_t)(row0 + ai * HALF + (mh + m) * 16) * D + col0 + bj * 32) = w; } }
    }
};
struct EpiMoe1 {
    static constexpr bool PRE = false; static constexpr bool PERM = false;
    bf16_t* Act; const LAS float* gtab;
    __device__ __forceinline__ void operator()(const f32x4 (&acc)[2][2][4][2], const Unit& u, int wr, int wc, int fr, int fq) const {
        const int row0 = u.pm * BM + wr * 64 + fr, f0 = u.pn * 128 + wc * 32 + 8 * fq;
#pragma unroll
        for (int ai = 0; ai < 2; ++ai)
#pragma unroll
            for (int m = 0; m < 4; ++m) { const int r = row0 + ai * HALF + m * 16; const float gt = gtab[u.ab * 256 + wr * 64 + fr + ai * HALF + m * 16];
                const f32x4 a0 = acc[ai][0][m][0], b0 = acc[ai][0][m][1], a1 = acc[ai][1][m][0], b1 = acc[ai][1][m][1];
                u32x4 w; w.x = cvt_pk_bf16(siluf_(a0[0]) * b0[0] * gt, siluf_(a0[1]) * b0[1] * gt); w.y = cvt_pk_bf16(siluf_(a0[2]) * b0[2] * gt, siluf_(a0[3]) * b0[3] * gt);
                w.z = cvt_pk_bf16(siluf_(a1[0]) * b1[0] * gt, siluf_(a1[1]) * b1[1] * gt); w.w = cvt_pk_bf16(siluf_(a1[2]) * b1[2] * gt, siluf_(a1[3]) * b1[3] * gt);
                *(u32x4*)(Act + (size_t)r * 256 + f0) = w; }
    }
};
}

#define XB_TMO      128
#define XB_XCNT(j)  (256  + 64 * (j))
#define XB_XSUB(j)  (1280 + 64 * (j))
#define XB_XGEN(j)  (2304 + 64 * (j))
#define XB_TOP      3328
#define XB_TOPGEN   3392
#define XCD_BAR_WORDS 3456
#define XB_SPIN_CAP (1u << 22)
__device__ __forceinline__ unsigned xb_ld(unsigned* p)              { return __hip_atomic_load(p, __ATOMIC_RELAXED, __HIP_MEMORY_SCOPE_AGENT); }
__device__ __forceinline__ unsigned xb_add(unsigned* p, unsigned v) { return __hip_atomic_fetch_add(p, v, __ATOMIC_RELAXED, __HIP_MEMORY_SCOPE_AGENT); }
__device__ __forceinline__ unsigned xb_xcc_id() { return (unsigned)__builtin_amdgcn_s_getreg((3 << 11) | 20) & 0xFu; }
#define XB_SPIN(cond, bar) do { unsigned _sp = 0; while (cond) { __builtin_amdgcn_s_sleep(1); \
    if ((++_sp & 255u) == 0u) { if (xb_ld(&(bar)[XB_TMO])) break; if (_sp > XB_SPIN_CAP) { atomicAdd(&(bar)[XB_TMO], 1u); break; } } } } while (0)
struct XcdBarrier { unsigned* bar; unsigned x; volatile LAS unsigned* st; };
__device__ __forceinline__ XcdBarrier xcd_barrier_post(unsigned* bar, volatile LAS unsigned* st) {
    XcdBarrier b; b.bar = bar; b.x = xb_xcc_id(); b.st = st;
    if (threadIdx.x == 0) (void)xb_add(&bar[XB_XCNT(b.x)], 1u);
    return b;
}
__device__ __forceinline__ void xcd_barrier_complete(unsigned* bar, unsigned x, unsigned& nloc, unsigned& nx) {
    const unsigned G = gridDim.x * gridDim.y * gridDim.z;
    unsigned sum, cnt, mine, sp = 0u;
    for (;;) {
        sum = 0u; cnt = 0u; mine = 0u;
#pragma unroll
        for (unsigned j = 0; j < 16; ++j) { const unsigned c = xb_ld(&bar[XB_XCNT(j)]); sum += c; cnt += (c > 0u) ? 1u : 0u; mine = (j == x) ? c : mine; }
        if (sum == G) break;
        __builtin_amdgcn_s_sleep(1);
        if ((++sp & 255u) == 0u) { if (xb_ld(&bar[XB_TMO])) break; if (sp > XB_SPIN_CAP) { atomicAdd(&bar[XB_TMO], 1u); break; } }
    }
    nloc = mine > 0u ? mine : 1u; nx = cnt > 0u ? cnt : 1u;
}
__device__ __forceinline__ void xcd_barrier(const XcdBarrier& b) {
    asm volatile("s_waitcnt vmcnt(0)" ::: "memory");
    __syncthreads();
    if (threadIdx.x == 0) {
        unsigned* bar = b.bar; asm volatile("" : "+s"(bar));
        __builtin_amdgcn_s_waitcnt(0);
        unsigned nloc = b.st[0], nx = b.st[1];
        if (nloc == 0u) { xcd_barrier_complete(bar, b.x, nloc, nx); b.st[0] = nloc; b.st[1] = nx; }
        const unsigned old = xb_add(&bar[XB_XSUB(b.x)], 1u);
        const unsigned gen = old / nloc;
        if (old + 1u == (gen + 1u) * nloc) {
            __builtin_amdgcn_fence(__ATOMIC_RELEASE, "agent");
            asm volatile("s_waitcnt vmcnt(0)" ::: "memory");
            const unsigned og = xb_add(&bar[XB_TOP], 1u);
            const unsigned tg = og / nx;
            if (og + 1u == (tg + 1u) * nx) xb_add(&bar[XB_TOPGEN], 1u);
            else XB_SPIN(xb_ld(&bar[XB_TOPGEN]) == tg, bar);
            __builtin_amdgcn_fence(__ATOMIC_ACQUIRE, "agent");
            xb_add(&bar[XB_XGEN(b.x)], 1u);
            asm volatile("s_waitcnt vmcnt(0)" ::: "memory");
        } else {
            XB_SPIN(xb_ld(&bar[XB_XGEN(b.x)]) == gen, bar);
            __builtin_amdgcn_fence(__ATOMIC_ACQUIRE, "agent");
            asm volatile("s_waitcnt vmcnt(0)" ::: "memory");
        }
    }
    __syncthreads();
}

struct Args {
    const float* in[43]; const int* positions; float* out; unsigned char* ws; int ph_lo, ph_hi, dbg, pad;
};
enum { I_X = 0, I_C = 1, I_POS = 2, I_MOD1W = 3, I_MOD1B = 4, I_WIN = 5, I_GMLNG = 6, I_GMLNB = 7, I_GMW = 8, I_GMB = 9,
       I_S5LRE = 10, I_S5LIM = 11, I_S5STEP = 12, I_S5BRE = 13, I_S5BIM = 14, I_S5CRE = 15, I_S5CIM = 16, I_S5D = 17, I_S5GLUW = 18, I_S5GLUB = 19,
       I_CONVW = 20, I_CONVB = 21, I_DTBIAS = 22, I_ALOG = 23, I_SSDD = 24, I_SSDNG = 25, I_WBR = 26, I_WGATE = 27, I_WOUT = 28, I_LN1G = 29, I_LN1B = 30,
       I_MOD2W = 31, I_MOD2B = 32, I_RW = 33, I_RB = 34, I_EW1 = 35, I_EW3 = 36, I_EW2 = 37, I_SW1 = 38, I_SW3 = 39, I_SW2 = 40, I_LN2G = 41, I_LN2B = 42 };

typedef const __attribute__((address_space(4))) Args* ArgsP;
struct Ctx {
    ArgsP a; unsigned char* ws; LAS unsigned char* lds; int tid, lane, wave, c, G, bx, dbg;
    __device__ __forceinline__ const float* in(int i) const { return a->in[i]; }
    __device__ __forceinline__ bf16_t* proj() const { return (bf16_t*)(ws + WS_PROJ); }
    __device__ __forceinline__ bf16_t* hbuf() const { return (bf16_t*)(ws + WS_H); }
    __device__ __forceinline__ bf16_t* ybuf() const { return (bf16_t*)(ws + WS_Y); }
    __device__ __forceinline__ float* modv(int l, int w) const { return (float*)(ws + WS_MODV) + (size_t)(l * 2 + w) * NB * 3072; }
};

__device__ __forceinline__ void ph_prologue(const Ctx& X) {
    { float* ropet = (float*)(X.ws + WS_ROPE); const int* pos = X.a->positions;
      for (int i = X.c * 512 + X.tid; i < M * 8; i += X.G * 512) { const int tok = i >> 3, j = i & 7;
          const float inv = (j == 0) ? 1.0f : (j == 1) ? 0.1939227432f : (j == 2) ? 0.0376060307f : (j == 3) ? 0.00729266461f : (j == 4) ? 0.00141421356f : (j == 5) ? 0.000274248188f : (j == 6) ? 5.31829610e-05f : 1.03133862e-05f;
          float sn, cs; sincos_red((float)pos[tok] * inv, sn, cs); *(f32x2*)(ropet + (size_t)i * 2) = (f32x2){cs, sn}; } }
    LAS float* red = (LAS float*)X.lds;
    for (int it = X.c; it < DEPTH * 2 * 48; it += X.G) {
        const int l = it / 96, w = (it / 48) & 1, jb = it % 48, j = jb * 64 + X.lane;
        const float* W = X.in(w ? I_MOD2W : I_MOD1W) + (size_t)l * D * 3072; const float* cv = X.in(I_C);
        float a0 = 0.f, a1 = 0.f, a2 = 0.f, a3 = 0.f;
        const int k0 = X.wave * 128;
        for (int k = k0; k < k0 + 128; ++k) { const float wv = W[(size_t)k * 3072 + j]; a0 += cv[k] * wv; a1 += cv[D + k] * wv; a2 += cv[2 * D + k] * wv; a3 += cv[3 * D + k] * wv; }
        red[(X.wave * 4 + 0) * 64 + X.lane] = a0; red[(X.wave * 4 + 1) * 64 + X.lane] = a1; red[(X.wave * 4 + 2) * 64 + X.lane] = a2; red[(X.wave * 4 + 3) * 64 + X.lane] = a3;
        __syncthreads();
        if (X.tid < 256) { const int b = X.tid >> 6, ln = X.tid & 63; float s = 0.f;
#pragma unroll
            for (int q = 0; q < 8; ++q) s += red[(q * 4 + b) * 64 + ln];
            const int jj = jb * 64 + ln; X.modv(l, w)[b * 3072 + jj] = s + X.in(w ? I_MOD2B : I_MOD1B)[(size_t)l * 3072 + jj]; }
        __syncthreads();
    }
}

template <class Src, int RMODE = 0>
__device__ __forceinline__ void tr_item(const Src& src, bf16_t* WT, int K, int rowbase, int kb, int nb, LAS float* scr, int lane, const float wsc = 1.0f) {
    const int k0 = 64 * kb, n0 = 32 * nb;
    f32x4 v[8];
#pragma unroll
    for (int i = 0; i < 8; ++i) v[i] = src.load4(k0 + 8 * i + (lane >> 3), n0 + 4 * (lane & 7));
#pragma unroll
    for (int i = 0; i < 8; ++i) { LAS float* d = scr + (8 * i + (lane >> 3)) * 33 + 4 * (lane & 7); d[0] = v[i][0]; d[1] = v[i][1]; d[2] = v[i][2]; d[3] = v[i][3]; }
    asm volatile("s_waitcnt lgkmcnt(0)" ::: "memory");
    const int c = lane & 7;
#pragma unroll
    for (int j = 0; j < 4; ++j) { const int n = (lane >> 3) + 8 * j; const LAS float* s = scr + (8 * c) * 33 + n;
        u32x4 o; o.x = pk2(s[0 * 33] * wsc, s[1 * 33] * wsc); o.y = pk2(s[2 * 33] * wsc, s[3 * 33] * wsc); o.z = pk2(s[4 * 33] * wsc, s[5 * 33] * wsc); o.w = pk2(s[6 * 33] * wsc, s[7 * 33] * wsc);
        int row = rowbase + n0 + n;
        if constexpr (RMODE == 1) { const int cc = n0 + n, bi = rowbase >> 10; row = 256 * (cc >> 6) + 128 * (bi >> 1) + 32 * ((cc >> 4) & 3) + 16 * (bi & 1) + (cc & 15); }
        if constexpr (RMODE == 2) { const int cc = n0 + n; row = rowbase + (cc & ~255) + 128 * ((cc >> 3) & 1) + 32 * ((cc >> 6) & 3) + 16 * ((cc >> 2) & 1) + 4 * ((cc >> 4) & 3) + (cc & 3); }
        if constexpr (RMODE == 3) { const int cc = n0 + n; row = rowbase + (cc & ~255) + 128 * ((cc >> 5) & 1) + 32 * ((cc >> 6) & 3) + 16 * ((cc >> 2) & 1) + 4 * ((cc >> 3) & 3) + (cc & 3); }
        *(u32x4*)(WT + (size_t)row * K + k0 + 8 * c) = o; }
    asm volatile("s_waitcnt lgkmcnt(0)" ::: "memory");
}
struct SrcPlain { const float* W; int N; __device__ __forceinline__ f32x4 load4(int k, int n) const { return *(const f32x4*)(W + (size_t)k * N + n); } };
struct SrcWin { const float* W; __device__ __forceinline__ f32x4 load4(int k, int n) const {
    if (n >= D_IN) return (f32x4){0.f, 0.f, 0.f, 0.f}; const int o = (n < 1216) ? n : (n < 2240) ? n + 4 : (n < 2244) ? 1216 + (n - 2240) : n; return *(const f32x4*)(W + (size_t)k * D_IN + o); } };
struct Src13 { const float* W1; const float* W3; __device__ __forceinline__ f32x4 load4(int k, int n) const {
    const int f = (n >> 8) * 128 + ((n >> 5) & 3) * 32 + ((n >> 2) & 3) * 8 + ((n >> 7) & 1) * 4 + (n & 3); const long d = (n & 16) ? (long)(W3 - W1) : 0l;     return *(const f32x4*)(W1 + d + (long)k * 256 + f); } };

__device__ __forceinline__ void ph_wconv(const Ctx& X, int l) {
    LAS float* scr = (LAS float*)(X.lds + X.wave * 16384);
    unsigned char* wb = X.ws + WS_W;
    const int gw = X.c * 8 + X.wave, NGW = X.G * 8;
    constexpr int I_A = 16 * 72, I_B = 4 * 16 * 32, I_C2 = 4 * 4 * 32, I_D = 16 * 32, I_E = 4 * 8, I_F = NE1 * 16 * 16, I_G = NE1 * 4 * 32;
    constexpr int NIT = I_A + I_B + I_C2 + I_D + I_E + I_F + I_G;
    for (int it = gw; it < NIT; it += NGW) {
        int r = it;
        if (r < I_A) { SrcWin s{X.in(I_WIN) + (size_t)l * D * D_IN}; tr_item(s, (bf16_t*)(wb + WO_IN), 1024, 0, r / 72, r % 72, scr, X.lane); continue; } r -= I_A;
        if (r < I_B) { const int i = r / 512, q = r % 512; SrcPlain s{X.in(I_WGATE) + ((size_t)l * 4 + i) * D * D, D}; tr_item<SrcPlain, 1>(s, (bf16_t*)(wb + WO_GATE), 1024, i * 1024, q / 32, q % 32, scr, X.lane, -1.4426950408889634f);        continue; } r -= I_B;
        if (r < I_C2) { const int i = r / 128, q = r % 128; SrcPlain s{X.in(I_WBR) + ((size_t)l * 4 + i) * 256 * D, D}; tr_item<SrcPlain, 2>(s, (bf16_t*)(wb + WO_BR) + (size_t)i * 1024 * 256, 256, 0, q / 32, q % 32, scr, X.lane, P_SCALE); continue; } r -= I_C2;
        if (r < I_D) { SrcPlain s{X.in(I_WOUT) + (size_t)l * D * D, D}; tr_item<SrcPlain, 3>(s, (bf16_t*)(wb + WO_OUT), 1024, 0, r / 32, r % 32, scr, X.lane); continue; } r -= I_D;
        if (r < I_E) { SrcPlain s{X.in(I_S5GLUW) + (size_t)l * 256 * 256, 256}; tr_item(s, (bf16_t*)(wb + WO_GLU), 256, 0, r / 8, r % 8, scr, X.lane); continue; } r -= I_E;
        if (r < I_F) { const int e = r / 256, q = r % 256;
            const Src13 s{(e < NEXP) ? X.in(I_EW1) + ((size_t)l * NEXP + e) * D * 256 : X.in(I_SW1) + (size_t)l * D * 256, (e < NEXP) ? X.in(I_EW3) + ((size_t)l * NEXP + e) * D * 256 : X.in(I_SW3) + (size_t)l * D * 256};
            tr_item(s, (bf16_t*)(wb + WO_13) + (size_t)e * 512 * 1024, 1024, 0, q / 16, q % 16, scr, X.lane); continue; } r -= I_F;
        { const int e = r / 128, q = r % 128; SrcPlain s{e < NEXP ? X.in(I_EW2) + ((size_t)l * NEXP + e) * 256 * D : X.in(I_SW2) + (size_t)l * 256 * D, D};
            tr_item<SrcPlain, 2>(s, (bf16_t*)(wb + WO_2) + (size_t)e * 1024 * 256, 256, 0, q / 32, q % 32, scr, X.lane, O_SCALE); }
    }
    const int gt = X.c * 512 + X.tid, NGT = X.G * 512;
    { bf16_t* gmw = (bf16_t*)(X.ws + WS_GMW); const float* src = X.in(I_GMW) + (size_t)l * 4 * 128 * 128;
      for (int i = gt; i < 4 * 128 * 128; i += NGT) { const int t = (i >> 7) & 127, s = i & 127; gmw[i] = (bf16_t)f2bf(s <= t ? src[i] : 0.f); } }
    for (int i = gt; i < 16 * 64; i += NGT) {
        const int g = i >> 6, p = i & 63;
        const float step = expf(X.in(I_S5STEP)[l * 16 + g]); const float lr = X.in(I_S5LRE)[(size_t)l * 1024 + i], li = X.in(I_S5LIM)[(size_t)l * 1024 + i];
        const float mag = expf(lr * step); float sn, cs; sincos_red(li * step, sn, cs);
        const float abr = mag * cs, abi = mag * sn, den = lr * lr + li * li, nr = abr - 1.0f;
        const float cr = (nr * lr + abi * li) / den, ci = (abi * lr - nr * li) / den;
        float* sa = (float*)(X.ws + WS_S5A); sa[i * 2] = abr; sa[i * 2 + 1] = abi;
        bf16_t* bb = (bf16_t*)(X.ws + WS_S5B); bf16_t* cm = (bf16_t*)(X.ws + WS_S5C);
        const float* bre = X.in(I_S5BRE) + ((size_t)l * 1024 + i) * 16; const float* bim = X.in(I_S5BIM) + ((size_t)l * 1024 + i) * 16;
#pragma unroll
        for (int ch = 0; ch < 16; ++ch) { const float br = bre[ch], bi = bim[ch];
            bb[(g * 128 + p) * 16 + ch] = (bf16_t)f2bf(cr * br - ci * bi); bb[(g * 128 + 64 + p) * 16 + ch] = (bf16_t)f2bf(cr * bi + ci * br);
            cm[(g * 16 + ch) * 128 + p] = (bf16_t)f2bf(X.in(I_S5CRE)[(((size_t)l * 16 + g) * 16 + ch) * 64 + p]);
            cm[(g * 16 + ch) * 128 + 64 + p] = (bf16_t)f2bf(-X.in(I_S5CIM)[(((size_t)l * 16 + g) * 16 + ch) * 64 + p]); }
    }
    { bf16_t* rf = (bf16_t*)(X.ws + WS_RFR); const float* rw = X.in(I_RW) + (size_t)l * D * NEXP;
      for (int i = gt; i < 2 * 32 * 64 * 8; i += NGT) { const int j = i & 7, ln = (i >> 3) & 63, ks = (i >> 9) & 31, rt = i >> 14;
          const float v = rw[(size_t)(ks * 32 + 8 * (ln >> 4) + j) * NEXP + rt * 16 + (ln & 15)]; const unsigned hi = f2bf(v); const float lo = v - bflo(hi);
          rf[i] = (bf16_t)hi; rf[32768 + i] = (bf16_t)f2bf(lo); } }
    if (l == 0) {
        const float* x = X.in(I_X); bf16_t* h = X.hbuf(); const float* mv = X.modv(0, 0);
        for (size_t i = (size_t)gt; i < (size_t)M * D / 8; i += NGT) {
            const size_t e = i * 8; const int col = (int)(e & 1023), b = (int)(e >> 23);
            const f32x4 x0 = *(const f32x4*)(x + e), x1 = *(const f32x4*)(x + e + 4);
            const f32x4 sh0 = *(const f32x4*)(mv + b * 3072 + col), sh1 = *(const f32x4*)(mv + b * 3072 + col + 4), sc0 = *(const f32x4*)(mv + b * 3072 + 1024 + col), sc1 = *(const f32x4*)(mv + b * 3072 + 1024 + col + 4);
            const f32x4 h0 = x0 * (sc0 + 1.0f) + sh0, h1 = x1 * (sc1 + 1.0f) + sh1;
            u32x4 w; w.x = pk2(h0[0], h0[1]); w.y = pk2(h0[2], h0[3]); w.z = pk2(h1[0], h1[1]); w.w = pk2(h1[2], h1[3]);
            *(u32x4*)(h + e) = w; }
    }
}

__device__ __forceinline__ void rope8(const u32x4 a, const u32x4 b, const float* cs, u32x4& wa, u32x4& wb) {
    float t1[8], t2[8]; t1[0] = bflo(a.x); t1[1] = bfhi(a.x); t1[2] = bflo(a.y); t1[3] = bfhi(a.y); t1[4] = bflo(a.z); t1[5] = bfhi(a.z); t1[6] = bflo(a.w); t1[7] = bfhi(a.w);
    t2[0] = bflo(b.x); t2[1] = bfhi(b.x); t2[2] = bflo(b.y); t2[3] = bfhi(b.y); t2[4] = bflo(b.z); t2[5] = bfhi(b.z); t2[6] = bflo(b.w); t2[7] = bfhi(b.w);
    float o1[8], o2[8]; f32x4 c4[4];
#pragma unroll
    for (int q = 0; q < 4; ++q) c4[q] = *(const f32x4*)(cs + 4 * q);
#pragma unroll
    for (int j = 0; j < 8; ++j) { const float cv = c4[j >> 1][(j & 1) * 2], sv = c4[j >> 1][(j & 1) * 2 + 1]; o1[j] = t1[j] * cv - t2[j] * sv; o2[j] = t2[j] * cv + t1[j] * sv; }
    wa.x = pk2(o1[0], o1[1]); wa.y = pk2(o1[2], o1[3]); wa.z = pk2(o1[4], o1[5]); wa.w = pk2(o1[6], o1[7]);
    wb.x = pk2(o2[0], o2[1]); wb.y = pk2(o2[2], o2[3]); wb.z = pk2(o2[4], o2[5]); wb.w = pk2(o2[6], o2[7]);
}
__device__ __forceinline__ void rope8r(const u32x4 a, const u32x4 b, const f32x4 (&c4)[4], u32x4& wa, u32x4& wb) {
    float t1[8], t2[8]; t1[0] = bflo(a.x); t1[1] = bfhi(a.x); t1[2] = bflo(a.y); t1[3] = bfhi(a.y); t1[4] = bflo(a.z); t1[5] = bfhi(a.z); t1[6] = bflo(a.w); t1[7] = bfhi(a.w);
    t2[0] = bflo(b.x); t2[1] = bfhi(b.x); t2[2] = bflo(b.y); t2[3] = bfhi(b.y); t2[4] = bflo(b.z); t2[5] = bfhi(b.z); t2[6] = bflo(b.w); t2[7] = bfhi(b.w);
    float o1[8], o2[8];
#pragma unroll
    for (int j = 0; j < 8; ++j) { const float cv = c4[j >> 1][(j & 1) * 2], sv = c4[j >> 1][(j & 1) * 2 + 1]; o1[j] = t1[j] * cv - t2[j] * sv; o2[j] = t2[j] * cv + t1[j] * sv; }
    wa.x = pk2(o1[0], o1[1]); wa.y = pk2(o1[2], o1[3]); wa.z = pk2(o1[4], o1[5]); wa.w = pk2(o1[6], o1[7]);
    wb.x = pk2(o2[0], o2[1]); wb.y = pk2(o2[2], o2[3]); wb.z = pk2(o2[4], o2[5]); wb.w = pk2(o2[6], o2[7]);
}
__device__ __forceinline__ float kclamp8(float v) { return __builtin_amdgcn_fmed3f(v * K_SCALE, -440.f, 440.f); }
__device__ __forceinline__ float vclamp8(float v) { return __builtin_amdgcn_fmed3f(v * V_SCALE, -440.f, 440.f); }
__device__ __forceinline__ void mx_rope(const Ctx& X) {
    bf16_t* pj = X.proj(); const float* ropet = (const float*)(X.ws + WS_ROPE);
    const int gt = X.c * 512 + X.tid, NGT = X.G * 512;
    for (int i = gt; i < M * 10; i += NGT) {
        const int tok = i / 10, hh = i % 10;
        if (hh == 9) { const u32x4* sp = (const u32x4*)(pj + (size_t)tok * PJ + C_V); u32x4* dp = (u32x4*)((unsigned char*)(X.ws + WS_V2) + (size_t)tok * 64);
#pragma unroll
            for (int q = 0; q < 4; ++q) { const u32x4 a = sp[2 * q], b = sp[2 * q + 1]; u32x4 o;
                o.x = pg8::pk4_fp8(vclamp8(bflo(a.x)), vclamp8(bfhi(a.x)), vclamp8(bflo(a.y)), vclamp8(bfhi(a.y))); o.y = pg8::pk4_fp8(vclamp8(bflo(a.z)), vclamp8(bfhi(a.z)), vclamp8(bflo(a.w)), vclamp8(bfhi(a.w)));
                o.z = pg8::pk4_fp8(vclamp8(bflo(b.x)), vclamp8(bfhi(b.x)), vclamp8(bflo(b.y)), vclamp8(bfhi(b.y))); o.w = pg8::pk4_fp8(vclamp8(bflo(b.z)), vclamp8(bfhi(b.z)), vclamp8(bflo(b.w)), vclamp8(bfhi(b.w)));
                dp[q] = o; }
            continue; }
        const int col = (hh < 4) ? C_Q + hh * 64 : (hh < 8) ? C_QI + (hh - 4) * 64 : C_K;
        bf16_t* p = pj + (size_t)tok * PJ + col;
        const u32x4 a = *(const u32x4*)p, b = *(const u32x4*)(p + 8);
        u32x4 wa, wb; rope8(a, b, ropet + (size_t)tok * 16, wa, wb);
        if (hh < 8) { *(u32x4*)p = wa; *(u32x4*)(p + 8) = wb; }
        else { u32x4* dp = (u32x4*)((unsigned char*)(X.ws + WS_K2) + (size_t)tok * 64); const u32x4* sp = (const u32x4*)p;
#pragma unroll
            for (int q = 0; q < 4; ++q) { const u32x4 a = (q == 0) ? wa : sp[2 * q], b = (q == 0) ? wb : sp[2 * q + 1]; u32x4 o;
                o.x = pg8::pk4_fp8(kclamp8(bflo(a.x)), kclamp8(bfhi(a.x)), kclamp8(bflo(a.y)), kclamp8(bfhi(a.y))); o.y = pg8::pk4_fp8(kclamp8(bflo(a.z)), kclamp8(bfhi(a.z)), kclamp8(bflo(a.w)), kclamp8(bfhi(a.w)));
                o.z = pg8::pk4_fp8(kclamp8(bflo(b.x)), kclamp8(bfhi(b.x)), kclamp8(bflo(b.y)), kclamp8(bfhi(b.y))); o.w = pg8::pk4_fp8(kclamp8(bflo(b.z)), kclamp8(bfhi(b.z)), kclamp8(bflo(b.w)), kclamp8(bfhi(b.w)));
                dp[q] = o; } }
    }
    for (int i = gt; i < (M / 16) * 16; i += NGT) {
        const int hf = i & 1, pc = (i >> 1) & 7, tile = i >> 4; const int ks = pc >> 2, fq = pc & 3;
        u32x4* dp = (u32x4*)((bf16_t*)(X.ws + WS_KI2) + (size_t)tile * 1024 + pc * 128 + hf * 64);
#pragma unroll
        for (int j0 = 0; j0 < 8; j0 += 4) { u32x4 v[4], o[4]; f32x4 cs[4][4];
#pragma unroll
            for (int j = 0; j < 4; ++j) { const int tok = tile * 16 + hf * 8 + j0 + j; const bf16_t* rp = pj + (size_t)tok * PJ + C_KI;
                v[j] = *(const u32x4*)(rp + ks * 32 + fq * 8);
                if (pc < 2) { o[j] = *(const u32x4*)(rp + (pc ? 0 : 8));
#pragma unroll
                    for (int q = 0; q < 4; ++q) cs[j][q] = *(const f32x4*)(ropet + (size_t)tok * 16 + 4 * q); } }
#pragma unroll
            for (int j = 0; j < 4; ++j) { u32x4 r = v[j];
                if (pc < 2) { u32x4 wa, wb; rope8r(pc ? o[j] : v[j], pc ? v[j] : o[j], cs[j], wa, wb); r = pc ? wb : wa; }
                dp[j0 + j] = r; } }
    }
}

__device__ __forceinline__ void mx_gmlp(const Ctx& X, int l, int unit) {
    const int lane = X.lane, w = X.wave;
    const int row0 = unit * 128;
    LAS bf16_t* Vt = (LAS bf16_t*)X.lds;
    const bf16_t* pj = X.proj();
    const float* lng = X.in(I_GMLNG) + l * 256; const float* lnb = X.in(I_GMLNB) + l * 256;
    const f32x4 g4 = *(const f32x4*)(lng + 4 * lane), b4 = *(const f32x4*)(lnb + 4 * lane);
#pragma nounroll
    for (int hb8 = 0; hb8 < 16; hb8 += 8) {
    u32x2 rv[8];
#pragma unroll
    for (int i = 0; i < 8; ++i) rv[i] = *(const u32x2*)(pj + (size_t)(row0 + w * 16 + hb8 + i) * PJ + C_GV + 4 * lane);
#pragma unroll
    for (int i = 0; i < 8; ++i) {
        const int s = w * 16 + hb8 + i;
        float v[4]; v[0] = gelu_tanh(bflo(rv[i].x)); v[1] = gelu_tanh(bfhi(rv[i].x)); v[2] = gelu_tanh(bflo(rv[i].y)); v[3] = gelu_tanh(bfhi(rv[i].y));
        const float sm = (v[0] + v[1]) + (v[2] + v[3]);
        const float mean = wave_sum(sm) * (1.0f / 256.0f); float q = 0.f;
#pragma unroll
        for (int j = 0; j < 4; ++j) { v[j] -= mean; q += v[j] * v[j]; }
        const float rstd = rsqrtf(wave_sum(q) * (1.0f / 256.0f) + LN_EPS);
#pragma unroll
        for (int j = 0; j < 4; ++j) Vt[(4 * lane + j) * 136 + s] = (bf16_t)f2bf(v[j] * rstd * g4[j] + b4[j]);
    } }
    __syncthreads();
    const int g = w >> 1, c0 = g * 64 + (w & 1) * 32, fr = lane & 15, fq = lane >> 4;
    const bf16_t* gmw = (const bf16_t*)(X.ws + WS_GMW) + (size_t)g * 128 * 128;
    const float* gmb = X.in(I_GMB) + ((size_t)l * 4 + g) * 128;
    bf16_t* ya = X.ybuf();
    bf16x8 wfv[20]; u32x2 uvv[8][2]; float biasv[8];
#pragma unroll
    for (int tt = 0; tt < 8; ++tt) {
#pragma unroll
        for (int ks = 0; ks < 4; ++ks) if (ks <= (tt >> 1)) wfv[(tt >> 1) * ((tt >> 1) + 1) + (tt & 1) * ((tt >> 1) + 1) + ks] = *(const bf16x8*)(gmw + (tt * 16 + fr) * 128 + ks * 32 + 8 * fq);
        const int t = tt * 16 + fr; biasv[tt] = gmb[t];
#pragma unroll
        for (int c2 = 0; c2 < 2; ++c2) uvv[tt][c2] = *(const u32x2*)(pj + (size_t)(row0 + t) * PJ + C_GU + c0 + c2 * 16 + 4 * fq);
    }
#pragma unroll
    for (int tt = 0; tt < 8; ++tt) {
        f32x4 acc0 = (f32x4){0.f, 0.f, 0.f, 0.f}, acc1 = acc0;
#pragma unroll
        for (int ks = 0; ks < 4; ++ks) if (ks <= (tt >> 1)) {
            const bf16x8 wf = wfv[(tt >> 1) * ((tt >> 1) + 1) + (tt & 1) * ((tt >> 1) + 1) + ks];
            const bf16x8 v0 = *(const LAS bf16x8*)(Vt + (c0 + fr) * 136 + ks * 32 + 8 * fq), v1 = *(const LAS bf16x8*)(Vt + (c0 + 16 + fr) * 136 + ks * 32 + 8 * fq);
            acc0 = mfma16(v0, wf, acc0); acc1 = mfma16(v1, wf, acc1);
        }
        const int t = tt * 16 + fr; const float bias = biasv[tt];
#pragma unroll
        for (int c2 = 0; c2 < 2; ++c2) { const f32x4 a = c2 ? acc1 : acc0; const int cc = c0 + c2 * 16 + 4 * fq;
            const u32x2 uv = uvv[tt][c2];
            u32x2 o; o.x = pk2(gelu_tanh(bflo(uv.x)) * (a[0] + bias), gelu_tanh(bfhi(uv.x)) * (a[1] + bias)); o.y = pk2(gelu_tanh(bflo(uv.y)) * (a[2] + bias), gelu_tanh(bfhi(uv.y)) * (a[3] + bias));
            *(u32x2*)(ya + (size_t)(row0 + t) * 256 + cc) = o; }
    }
    __syncthreads();
}

template <int PASS>
__device__ __forceinline__ void mx_s5(const Ctx& X, int l, int wu) {
    const int lane = X.lane, fr = lane & 15, fq = lane >> 4;
    const int wgi = wu >> 3, wv = wu & 7; const int b = wgi >> 6, g = ((wgi >> 4) & 3) * 4 + (wv & 3), ch = (wgi & 15) * 2 + (wv >> 2);
    const int tb = b * SEQ + ch * 256;
    LAS float* xl = (LAS float*)(X.lds + X.wave * 16384);
    LAS bf16_t* hb = (LAS bf16_t*)(X.lds + X.wave * 16384 + 8192);
    const bf16_t* pj = X.proj();
    const bf16_t* bbT = (const bf16_t*)(X.ws + WS_S5B) + (size_t)g * 128 * 16;
    bf16x8 Bf[8];
#pragma unroll
    for (int ct = 0; ct < 8; ++ct) { Bf[ct] = (bf16x8){0, 0, 0, 0, 0, 0, 0, 0}; if (fq < 2) Bf[ct] = *(const bf16x8*)(bbT + (ct * 16 + fr) * 16 + 8 * fq); }
    const float* sa = (const float*)(X.ws + WS_S5A) + (g * 64 + lane) * 2; const float ar = sa[0], ai = sa[1];
    float hr = 0.f, hi = 0.f;
    float* st = (float*)(X.ws + WS_S5ST) + (size_t)((b * 16 + g) * 32) * 128;
    bf16x8 Cf[4]; float dsk[4];
    if (PASS == 3) {
        { float pr = ar, pi = ai;
#pragma unroll
          for (int q = 0; q < 8; ++q) { const float nr = pr * pr - pi * pi, ni = 2.f * pr * pi; pr = nr; pi = ni; }
          float srv[31], siv[31];
#pragma unroll
          for (int c = 0; c < 31; ++c) { srv[c] = 0.f; siv[c] = 0.f; if (c < ch) { srv[c] = st[c * 128 + lane]; siv[c] = st[c * 128 + 64 + lane]; } }
#pragma unroll
          for (int c = 0; c < 31; ++c) if (c < ch) { const float nr = pr * hr - pi * hi + srv[c], ni = pr * hi + pi * hr + siv[c]; hr = nr; hi = ni; } }
        const bf16_t* cm = (const bf16_t*)(X.ws + WS_S5C) + (size_t)g * 16 * 128;
#pragma unroll
        for (int ks = 0; ks < 4; ++ks) Cf[ks] = *(const bf16x8*)(cm + fr * 128 + ks * 32 + 8 * fq);
#pragma unroll
        for (int i = 0; i < 4; ++i) dsk[i] = X.in(I_S5D)[l * 256 + g * 16 + 4 * fq + i];
    }
    bf16_t* ycp = (bf16_t*)(X.ws + WS_YCPRE);
    bf16x8 ufn = (bf16x8){0, 0, 0, 0, 0, 0, 0, 0}; u32x2 uvn = (u32x2){0u, 0u};
    if (fq < 2) ufn = *(const bf16x8*)(pj + (size_t)(tb + fr) * PJ + C_S5 + g * 16 + 8 * fq);
    if (PASS == 3) uvn = *(const u32x2*)(pj + (size_t)(tb + fr) * PJ + C_S5 + g * 16 + 4 * fq);
    for (int blk = 0; blk < 16; ++blk) {
        const int t0 = tb + blk * 16;
        const bf16x8 uf = ufn; const u32x2 uv = uvn;
        if (blk + 1 < 16) { if (fq < 2) ufn = *(const bf16x8*)(pj + (size_t)(t0 + 16 + fr) * PJ + C_S5 + g * 16 + 8 * fq);
            if (PASS == 3) uvn = *(const u32x2*)(pj + (size_t)(t0 + 16 + fr) * PJ + C_S5 + g * 16 + 4 * fq); }
#pragma unroll
        for (int ct = 0; ct < 8; ++ct) { const f32x4 a = mfma16(uf, Bf[ct], (f32x4){0.f, 0.f, 0.f, 0.f});
#pragma unroll
            for (int i = 0; i < 4; ++i) xl[(4 * fq + i) * 128 + ct * 16 + fr] = a[i]; }
#pragma unroll
        for (int t = 0; t < 16; ++t) { const float xr = xl[t * 128 + lane], xi = xl[t * 128 + 64 + lane];
            const float nr = ar * hr - ai * hi + xr, ni = ar * hi + ai * hr + xi; hr = nr; hi = ni;
            if (PASS == 3) { hb[t * 136 + lane] = (bf16_t)f2bf(hr); hb[t * 136 + 64 + lane] = (bf16_t)f2bf(hi); } }
        if (PASS == 3) {
            asm volatile("s_waitcnt lgkmcnt(0)" ::: "memory"); __builtin_amdgcn_wave_barrier();
            f32x4 acc = (f32x4){0.f, 0.f, 0.f, 0.f};
#pragma unroll
            for (int ks = 0; ks < 4; ++ks) { const bf16x8 hf = *(const LAS bf16x8*)(hb + fr * 136 + ks * 32 + 8 * fq); acc = mfma16(Cf[ks], hf, acc); }
            const float y0 = gelu_tanh(acc[0] + dsk[0] * bflo(uv.x)), y1 = gelu_tanh(acc[1] + dsk[1] * bfhi(uv.x)), y2 = gelu_tanh(acc[2] + dsk[2] * bflo(uv.y)), y3 = gelu_tanh(acc[3] + dsk[3] * bfhi(uv.y));
            u32x2 o; o.x = pk2(y0, y1); o.y = pk2(y2, y3);
            *(u32x2*)(ycp + (size_t)(t0 + fr) * 256 + g * 16 + 4 * fq) = o;
        }
    }
    if (PASS == 1) { st[ch * 128 + lane] = hr; st[ch * 128 + 64 + lane] = hi; }
}

constexpr int SD_CM = 0, SD_BM = 18432, SD_XT0 = 36864, SD_XT1 = 55296, SD_MM = 73728, SD_SIN0 = 108544, SD_SIN1 = 117760, SD_DT = 126976, SD_AC = 128000 + 64, SD_END = 129024 + 64;
__device__ __forceinline__ bf16x8 tr_frag8(const LAS bf16_t* base, int pitch, int l0, int c0, int lane) {
    const int g = lane >> 4, i = lane & 15; const unsigned a1 = (unsigned)(unsigned long)(base + (l0 + 8 * g + (i >> 2)) * pitch + c0 + 4 * (i & 3)); const unsigned a2 = a1 + (unsigned)(8 * pitch);
    u32x2 r1, r2;
    asm volatile("ds_read_b64_tr_b16 %0, %2\n\tds_read_b64_tr_b16 %1, %3\n\ts_waitcnt lgkmcnt(0)" : "=&v"(r1), "=&v"(r2) : "v"(a1), "v"(a2) : "memory");
    __builtin_amdgcn_sched_barrier(0);
    const u32x4 o = (u32x4){r1.x, r1.y, r2.x, r2.y}; return __builtin_bit_cast(bf16x8, o);
}
static_assert(SD_END <= LDS_MISC, "ssd lds");
template <int PASS>
__device__ __forceinline__ void mx_ssd(const Ctx& X, int l, int unit) {
    const int tid = X.tid, lane = X.lane, w = X.wave, fr = lane & 15, fq = lane >> 4;
    const int b = unit >> 6, c = unit & 63; const int r0 = unit * 128;
    const bf16_t* pj = X.proj();
    LAS bf16_t* Cm = (LAS bf16_t*)(X.lds + SD_CM); LAS bf16_t* Bm = (LAS bf16_t*)(X.lds + SD_BM);
    LAS bf16_t* Mm = (LAS bf16_t*)(X.lds + SD_MM);
    LAS float* dtv = (LAS float*)(X.lds + SD_DT); LAS float* acm = (LAS float*)(X.lds + SD_AC);
    const float* convw = X.in(I_CONVW) + (size_t)l * 4 * 512; const float* convb = X.in(I_CONVB) + (size_t)l * 512;
    float* sst = (float*)(X.ws + WS_SSDST); float* atot = (float*)(X.ws + WS_ATOT);
    for (int g = 0; g < 2; ++g) {
        if (tid < 256) { const int j = tid >> 7, rl = tid & 127, h = 2 * g + j;
            const float raw = bf2f(pj[(size_t)(r0 + rl) * PJ + C_DT + h]) + X.in(I_DTBIAS)[l * 4 + h];
            const float dt = softplusf_(raw); dtv[j * 128 + rl] = dt; acm[j * 128 + rl] = -expf(X.in(I_ALOG)[l * 4 + h]) * dt; }
        __syncthreads();
        if (tid < 256) {
            float cum = acm[tid];
            cum = wave_prefix_incl(cum);
            if (lane == 63) dtv[256 + w] = cum;
            __builtin_amdgcn_fence(__ATOMIC_RELEASE, "workgroup");
            acm[tid] = cum; }
        __syncthreads();
        if (tid < 256 && (w & 1)) acm[tid] += dtv[256 + w - 1];
        __syncthreads();
        if (PASS == 1 && tid < 2) atot[(b * 64 + c) * 32 + 2 * g + tid] = acm[tid * 128 + 127];
        if (!(X.dbg & 16)) { const int cg = tid & 31, rb = tid >> 5; constexpr int NCG = (PASS == 1) ? 24 : 32;
          if (cg < NCG) {
            const int chn = (cg < 16) ? g * 128 + cg * 8 : (cg < 24) ? 256 + g * 64 + (cg - 16) * 8 : 384 + g * 64 + (cg - 24) * 8;
            u32x4 xr[11];
#pragma unroll
            for (int k = 0; k < 11; ++k) { const int sq = c * 128 + rb * 8 + k - 3; xr[k] = (u32x4){0u, 0u, 0u, 0u}; if (sq >= 0) xr[k] = *(const u32x4*)(pj + (size_t)(b * SEQ + sq) * PJ + C_XBC + chn); }
            f32x4 w0[4], w1[4];
#pragma unroll
            for (int k = 0; k < 4; ++k) { w0[k] = *(const f32x4*)(convw + k * 512 + chn); w1[k] = *(const f32x4*)(convw + k * 512 + chn + 4); }
            const f32x4 cb0 = *(const f32x4*)(convb + chn), cb1 = *(const f32x4*)(convb + chn + 4);
            LAS bf16_t* dst = (cg < 16) ? (LAS bf16_t*)(X.lds + ((cg >> 3) ? SD_XT1 : SD_XT0)) + (cg & 7) * 8 : (cg < 24) ? Bm + (cg - 16) * 8 : Cm + (cg - 24) * 8;
            const int jh = (cg >> 3) & 1;
#pragma unroll
            for (int r = 0; r < 8; ++r) { const int rl = rb * 8 + r;
                f32x4 s0 = cb0, s1 = cb1;
#pragma unroll
                for (int k = 0; k < 4; ++k) { const u32x4 xv = xr[r + k];
                    s0[0] += w0[k][0] * bflo(xv.x); s0[1] += w0[k][1] * bfhi(xv.x); s0[2] += w0[k][2] * bflo(xv.y); s0[3] += w0[k][3] * bfhi(xv.y);
                    s1[0] += w1[k][0] * bflo(xv.z); s1[1] += w1[k][1] * bfhi(xv.z); s1[2] += w1[k][2] * bflo(xv.w); s1[3] += w1[k][3] * bfhi(xv.w); }
                float sc = 1.0f; if (PASS == 1 && cg < 16) sc = __expf(acm[jh * 128 + 127] - acm[jh * 128 + rl]) * dtv[jh * 128 + rl];
                u32x4 o; o.x = pk2(siluf_(s0[0]) * sc, siluf_(s0[1]) * sc); o.y = pk2(siluf_(s0[2]) * sc, siluf_(s0[3]) * sc); o.z = pk2(siluf_(s1[0]) * sc, siluf_(s1[1]) * sc); o.w = pk2(siluf_(s1[2]) * sc, siluf_(s1[3]) * sc);
                *(LAS u32x4*)(dst + rl * 72) = o; }
          } }
        if (PASS == 3) {
            const bf16_t* sin = (const bf16_t*)(X.ws + WS_SSDSIN) + (size_t)((b * 64 + c) * 4 + 2 * g) * 4096 + tid * 8;
            const int p = tid >> 3, n0 = (tid & 7) * 8;
            *(LAS u32x4*)((LAS bf16_t*)(X.lds + SD_SIN0) + p * 72 + n0) = *(const u32x4*)sin;
            *(LAS u32x4*)((LAS bf16_t*)(X.lds + SD_SIN1) + p * 72 + n0) = *(const u32x4*)(sin + 4096);
        }
        __syncthreads();
        if (PASS == 1) {
            const int j = w >> 2, pt = w & 3; const LAS bf16_t* Xr = (const LAS bf16_t*)(X.lds + (j ? SD_XT1 : SD_XT0));
            f32x4 acc[4];
#pragma unroll
            for (int nt = 0; nt < 4; ++nt) acc[nt] = (f32x4){0.f, 0.f, 0.f, 0.f};
#pragma unroll
            for (int ks = 0; ks < 4; ++ks) { const bf16x8 xf = tr_frag8(Xr, 72, ks * 32, pt * 16, lane);
#pragma unroll
                for (int nt = 0; nt < 4; ++nt) { const bf16x8 bf = tr_frag8(Bm, 72, ks * 32, nt * 16, lane); acc[nt] = mfma16(xf, bf, acc[nt]); } }
            float* sp = sst + (size_t)((b * 64 + c) * 4 + 2 * g + j) * 4096;
#pragma unroll
            for (int nt = 0; nt < 4; ++nt)
#pragma unroll
                for (int i = 0; i < 4; ++i) sp[(pt * 16 + 4 * fq + i) * 64 + nt * 16 + fr] = acc[nt][i];
        } else {
            const int lrow = w * 16 + fr;
            float yv[2][4][4];
            u32x2 zvv[2][4]; float dskv[2];
#pragma unroll
            for (int j = 0; j < 2; ++j) { dskv[j] = X.in(I_SSDD)[l * 4 + 2 * g + j];
#pragma unroll
                for (int pt = 0; pt < 4; ++pt) zvv[j][pt] = *(const u32x2*)(pj + (size_t)(r0 + lrow) * PJ + C_Z + (2 * g + j) * 64 + pt * 16 + 4 * fq); }
#pragma unroll
            for (int j = 0; j < 2; ++j) {
                const LAS bf16_t* Xr = (const LAS bf16_t*)(X.lds + (j ? SD_XT1 : SD_XT0)); const LAS bf16_t* Sin = (const LAS bf16_t*)(X.lds + (j ? SD_SIN1 : SD_SIN0));
                const float al = acm[j * 128 + lrow];
                const bf16x8 cf0 = *(const LAS bf16x8*)(Cm + lrow * 72 + 8 * fq), cf1 = *(const LAS bf16x8*)(Cm + lrow * 72 + 32 + 8 * fq);
                const int stmax = w | 1;
                for (int st = 0; st <= stmax; ++st) {
                    f32x4 ag = (f32x4){0.f, 0.f, 0.f, 0.f};
                    if (st <= w) { const bf16x8 b0 = *(const LAS bf16x8*)(Bm + (st * 16 + fr) * 72 + 8 * fq), b1 = *(const LAS bf16x8*)(Bm + (st * 16 + fr) * 72 + 32 + 8 * fq);
                        ag = mfma16(b0, cf0, ag); ag = mfma16(b1, cf1, ag); }
                    float mv[4];
#pragma unroll
                    for (int i = 0; i < 4; ++i) { const int s = st * 16 + 4 * fq + i; mv[i] = (s <= lrow) ? ag[i] * __expf(al - acm[j * 128 + s]) * dtv[j * 128 + s] : 0.f; }
                    u32x2 o; o.x = pk2(mv[0], mv[1]); o.y = pk2(mv[2], mv[3]); *(LAS u32x2*)(Mm + lrow * 136 + st * 16 + 4 * fq) = o;
                }
                const float eal = __expf(al); const float dsk = dskv[j];
#pragma unroll
                for (int pt = 0; pt < 4; ++pt) {
                    f32x4 ad = (f32x4){0.f, 0.f, 0.f, 0.f}, ao = ad;
                    for (int ks = 0; ks <= (w >> 1); ++ks) { const bf16x8 xf = tr_frag8(Xr, 72, ks * 32, pt * 16, lane); const bf16x8 mf = *(const LAS bf16x8*)(Mm + lrow * 136 + ks * 32 + 8 * fq); ad = mfma16(xf, mf, ad); }
                    { const bf16x8 s0 = *(const LAS bf16x8*)(Sin + (pt * 16 + fr) * 72 + 8 * fq), s1 = *(const LAS bf16x8*)(Sin + (pt * 16 + fr) * 72 + 32 + 8 * fq); ao = mfma16(s0, cf0, ao); ao = mfma16(s1, cf1, ao); }
                    const u32x2 zv = zvv[j][pt];
                    const float z4[4] = {bflo(zv.x), bfhi(zv.x), bflo(zv.y), bfhi(zv.y)};
#pragma unroll
                    for (int i = 0; i < 4; ++i) { const float xs = bf2f(Xr[lrow * 72 + pt * 16 + 4 * fq + i]); yv[j][pt][i] = (ad[i] + eal * ao[i] + dsk * xs) * siluf_(z4[i]); }
                }
            }
            float ss = 0.f;
#pragma unroll
            for (int j = 0; j < 2; ++j)
#pragma unroll
                for (int pt = 0; pt < 4; ++pt)
#pragma unroll
                    for (int i = 0; i < 4; ++i) ss += yv[j][pt][i] * yv[j][pt][i];
            ss += lshfl(ss, lane ^ 16, lane); ss += lshfl(ss, lane ^ 32, lane);
            const float rs = rsqrtf(ss * (1.0f / 128.0f) + RMS_EPS);
            const float* ng = X.in(I_SSDNG) + l * 256 + g * 128; bf16_t* yd = X.ybuf() + (size_t)3 * M * 256;
#pragma unroll
            for (int j = 0; j < 2; ++j)
#pragma unroll
                for (int pt = 0; pt < 4; ++pt) { const int cc = j * 64 + pt * 16 + 4 * fq; const f32x4 gv = *(const f32x4*)(ng + cc);
                    u32x2 o; o.x = pk2(yv[j][pt][0] * rs * gv[0], yv[j][pt][1] * rs * gv[1]); o.y = pk2(yv[j][pt][2] * rs * gv[2], yv[j][pt][3] * rs * gv[3]);
                    *(u32x2*)(yd + (size_t)(r0 + lrow) * 256 + g * 128 + cc) = o; }
        }
        __syncthreads();
    }
}

__device__ __forceinline__ void mx_s5_carry(const Ctx& X) {
    const float* st = (const float*)(X.ws + WS_S5ST); float* hin = (float*)(X.ws + WS_S5HIN); const float* sa = (const float*)(X.ws + WS_S5A);
    for (int i = X.c * 32 + (X.tid - 256); X.tid >= 256 && X.tid < 288 && i < NB * 16 * 64; i += X.G * 32) {
        const int p = i & 63, g = (i >> 6) & 15, b = i >> 10;
        float pr = sa[(g * 64 + p) * 2], pi = sa[(g * 64 + p) * 2 + 1];
#pragma unroll
        for (int q = 0; q < 8; ++q) { const float nr = pr * pr - pi * pi, ni = 2.f * pr * pi; pr = nr; pi = ni; }
        float hr = 0.f, hi = 0.f; const size_t base = (size_t)((b * 16 + g) * 32) * 128 + p;
#pragma unroll 8
        for (int ch = 0; ch < 32; ++ch) { hin[base + ch * 128] = hr; hin[base + ch * 128 + 64] = hi;
            const float sr = st[base + ch * 128], si = st[base + ch * 128 + 64]; const float nr = pr * hr - pi * hi + sr, ni = pr * hi + pi * hr + si; hr = nr; hi = ni; }
    }
}

__device__ __forceinline__ void mx_ssd_carry(const Ctx& X) {
    const float* sst = (const float*)(X.ws + WS_SSDST); const float* atot = (const float*)(X.ws + WS_ATOT); bf16_t* sin = (bf16_t*)(X.ws + WS_SSDSIN);
    for (int i = X.c * 256 + X.tid; X.tid < 256 && i < NB * 4 * 4096; i += X.G * 256) {
        const int e1 = i & 4095, h = (i >> 12) & 3, b = i >> 14;
        float S = 0.f;
#pragma unroll 16
        for (int c = 0; c < 64; ++c) { const size_t o = (size_t)((b * 64 + c) * 4 + h) * 4096 + e1;
            sin[o] = (bf16_t)f2bf(S);
            S = S * __expf(atot[(b * 64 + c) * 32 + h]) + sst[o]; }
    }
}

__device__ __forceinline__ unsigned ord16(float s) { const _Float16 hf = (_Float16)s; const unsigned bits = (unsigned)__builtin_bit_cast(unsigned short, hf); return bits ^ ((bits & 0x8000u) ? 0xFFFFu : 0x8000u); }
__device__ __forceinline__ int cnt_ge8(const u32x4 v, unsigned c) {
    int n = 0;
    n += ((v.x & 0xFFFFu) >= c) + ((v.x >> 16) >= c); n += ((v.y & 0xFFFFu) >= c) + ((v.y >> 16) >= c);
    n += ((v.z & 0xFFFFu) >= c) + ((v.z >> 16) >= c); n += ((v.w & 0xFFFFu) >= c) + ((v.w >> 16) >= c);
    return n;
}
template <int CTRL> __device__ __forceinline__ float dpp_f(float v) { return __builtin_bit_cast(float, __builtin_amdgcn_update_dpp(0, __builtin_bit_cast(int, v), CTRL, 0xF, 0xF, true)); }
__device__ __forceinline__ void q_split4(unsigned w0, unsigned w1, unsigned& hi, unsigned& lo) {
    const float f0 = __builtin_amdgcn_fmed3f(bflo(w0) * Q_SCALE, -440.f, 440.f), f1 = __builtin_amdgcn_fmed3f(bfhi(w0) * Q_SCALE, -440.f, 440.f), f2 = __builtin_amdgcn_fmed3f(bflo(w1) * Q_SCALE, -440.f, 440.f), f3 = __builtin_amdgcn_fmed3f(bfhi(w1) * Q_SCALE, -440.f, 440.f);
    hi = pg8::pk4_fp8(f0, f1, f2, f3);
    const f32x2 a = __builtin_amdgcn_cvt_pk_f32_fp8((int)hi, false), c = __builtin_amdgcn_cvt_pk_f32_fp8((int)hi, true);
    lo = pg8::pk4_fp8(f0 - a[0], f1 - a[1], f2 - c[0], f3 - c[1]);
}
__device__ __forceinline__ void dsa_hist_clear(const Ctx& X) { LAS unsigned* hist = (LAS unsigned*)(X.lds + 131072 + 8192);
    for (int i = X.tid; i < 8 * 4 * 128 / 4; i += 512) *(LAS u32x4*)(hist + 4 * i) = (u32x4){0u, 0u, 0u, 0u};
    __syncthreads(); }
__device__ __forceinline__ void mx_dsa(const Ctx& X, int b, int t0) {
    const int tid = X.tid, lane = X.lane, w = X.wave, fr = lane & 15, fq = lane >> 4;
    const bf16_t* pj = X.proj() + (size_t)b * SEQ * PJ; const unsigned rb = 0u;
    const bf16_t* ki2 = (const bf16_t*)(X.ws + WS_KI2) + (size_t)b * SEQ * 64; const unsigned char* k2 = (const unsigned char*)(X.ws + WS_K2) + (size_t)b * SEQ * 64; const unsigned char* v2 = (const unsigned char*)(X.ws + WS_V2) + (size_t)b * SEQ * 64;
    LAS unsigned short* sc = (LAS unsigned short*)X.lds;
    const int nk = t0 + 8, nkt = (nk + 15) >> 4;
    LAS unsigned* hist = (LAS unsigned*)(X.lds + 131072 + 8192);
    bf16x8 qf[2][2]; f32x4 wq[2];
#pragma unroll
    for (int ct = 0; ct < 2; ++ct) { const int q = 4 * ct + (fr >> 2), hh = fr & 3; const bf16_t* qp = pj + (unsigned)(t0 + q) * (unsigned)PJ;
        qf[ct][0] = *(const bf16x8*)(qp + C_QI + hh * 64 + 8 * fq); qf[ct][1] = *(const bf16x8*)(qp + C_QI + hh * 64 + 32 + 8 * fq);
        const u32x2 wv = *(const u32x2*)(pj + (unsigned)(t0 + 4 * ct + fq) * (unsigned)PJ + C_WI);
        wq[ct] = (f32x4){bflo(wv.x) * 0.0625f, bfhi(wv.x) * 0.0625f, bflo(wv.y) * 0.0625f, bfhi(wv.y) * 0.0625f}; }
    const int ntw = (nkt > w) ? ((nkt - w + 7) >> 3) : 0;
#define DSA_LOAD4(KF, I0) do { _Pragma("unroll") for (int j = 0; j < 4; ++j) { int kt_ = w + 8 * ((I0) + j); kt_ = kt_ < nkt ? kt_ : nkt - 1; \
        const unsigned ko_ = (unsigned)kt_ * 1024u + (unsigned)lane * 8u; KF[j][0] = *(const bf16x8*)(ki2 + ko_); KF[j][1] = *(const bf16x8*)(ki2 + ko_ + 512u); } } while (0)
#define DSA_COMP4(KF, I0) do { if (DSA_PM == 2 && rs1 > 0) { _Pragma("unroll") for (int j = 0; j < 4; ++j) dummy_ ^= KF[j][0][0] ^ KF[j][1][3]; break; } \
      _Pragma("unroll") for (int jh = 0; jh < 4; jh += 2) { f32x4 ac_[2][2]; \
        _Pragma("unroll") for (int j = 0; j < 2; ++j) _Pragma("unroll") for (int ct = 0; ct < 2; ++ct) { \
            ac_[j][ct] = mfma16(qf[ct][0], KF[jh + j][0], (f32x4){0.f, 0.f, 0.f, 0.f}); ac_[j][ct] = mfma16(qf[ct][1], KF[jh + j][1], ac_[j][ct]); } \
        _Pragma("unroll") for (int j = 0; j < 2; ++j) { if ((I0) + jh + j < ntw) { const int kt_ = w + 8 * ((I0) + jh + j); const bool full_ = (kt_ * 16 + 15 <= t0); const int key_ = kt_ * 16 + fr; \
        _Pragma("unroll") for (int ct = 0; ct < 2; ++ct) { const f32x4 a_ = ac_[j][ct]; \
            float tt_ = __builtin_fmaf(__builtin_amdgcn_fmed3f(a_[0], 0.f, 3.0e38f), wq[ct][0], 0.0f); tt_ = __builtin_fmaf(__builtin_amdgcn_fmed3f(a_[1], 0.f, 3.0e38f), wq[ct][1], tt_); \
            tt_ = __builtin_fmaf(__builtin_amdgcn_fmed3f(a_[2], 0.f, 3.0e38f), wq[ct][2], tt_); tt_ = __builtin_fmaf(__builtin_amdgcn_fmed3f(a_[3], 0.f, 3.0e38f), wq[ct][3], tt_); \
            const int q_ = 4 * ct + fq; unsigned kk_ = ord16(tt_ + 0.0f); \
            if (!full_) kk_ = (key_ <= t0 + q_) ? kk_ : 0u; \
            if (DSA_PM == 1 && rs1 > 0) dummy_ ^= (short)kk_; else sc[q_ * 8192 + key_] = (unsigned short)kk_; \
            if ((R_S1 == 1 || rs1 == 0) && (full_ || kk_ != 0u)) __hip_atomic_fetch_add(hist + (q_ * 4 + (fr & 3)) * 128 + (kk_ >> 9), (kk_ & 0x100u) ? 65536u : 1u, __ATOMIC_RELAXED, __HIP_MEMORY_SCOPE_WORKGROUP); } } } } } while (0)
    short dummy_ = 0;
    _Pragma("nounroll") for (int rs1 = 0; rs1 < (((DSA_SKIP | X.dbg) & 1) ? 0 : R_S1); ++rs1)
    { bf16x8 ka[4][2], kb[4][2];
      if (ntw > 0) { DSA_LOAD4(ka, 0);
#pragma nounroll
        for (int i0 = 0; i0 < ntw; i0 += 8) { DSA_LOAD4(kb, i0 + 4); DSA_COMP4(ka, i0); DSA_LOAD4(ka, i0 + 8); DSA_COMP4(kb, i0 + 4); } } }
#undef DSA_LOAD4
#undef DSA_COMP4
    if (dummy_ == (short)0x1234 && t0 == 123457) sc[0] = 1;
    { const int z0 = nkt * 16, z1 = ((nk + 511) >> 9) << 9;
        for (int i = z0 + tid; i < z1; i += 512) {
#pragma unroll
            for (int q = 0; q < 8; ++q) sc[q * 8192 + i] = 0; } }
    __syncthreads();
    const int t = t0 + w, nv = t + 1;
    LAS unsigned short* row = sc + w * 8192;
    LAS unsigned short* list = (LAS unsigned short*)(X.lds + 131072 + w * 512);
    const int nsel = nv < 256 ? nv : 256;
    if (((DSA_SKIP | X.dbg) & 2) || nv <= 256) { for (int n = lane; n < 256; n += 64) list[n] = (unsigned short)n; }
    else {
        const int nit = (nv + 511) >> 9;
        LAS unsigned* H = hist + w * 512;
        int T1, above1;
        { u32x4 h4 = (u32x4){0u, 0u, 0u, 0u};
#pragma unroll
          for (int c4 = 0; c4 < 4; ++c4) { const u32x2 pw = *(const LAS u32x2*)(H + c4 * 128 + 2 * lane); h4.x += pw.x & 0xFFFFu; h4.y += pw.x >> 16; h4.z += pw.y & 0xFFFFu; h4.w += pw.y >> 16; }
          const int sl = (int)(h4.x + h4.y + h4.z + h4.w);
          const int suf = wave_suffix_incl(sl);
          const unsigned long long bm = __ballot(suf >= 256); const int L = 63 - __builtin_clzll(bm);
          const int Lu = __builtin_amdgcn_readfirstlane(L);
          const int hx = __builtin_amdgcn_readlane((int)h4.x, Lu), hy = __builtin_amdgcn_readlane((int)h4.y, Lu), hz = __builtin_amdgcn_readlane((int)h4.z, Lu), hw = __builtin_amdgcn_readlane((int)h4.w, Lu);
          const int sufn = __builtin_amdgcn_readlane(suf, Lu) - (hx + hy + hz + hw);
          int cb = sufn; T1 = 4 * L + 3; above1 = cb;
          if (cb + hw >= 256) { T1 = 4 * L + 3; above1 = cb; } else { cb += hw; if (cb + hz >= 256) { T1 = 4 * L + 2; above1 = cb; } else { cb += hz; if (cb + hy >= 256) { T1 = 4 * L + 1; above1 = cb; } else { cb += hy; T1 = 4 * L; above1 = cb; } } } }
        _Pragma("nounroll") for (int rs2 = 0; rs2 < R_S2; ++rs2) {
        *(LAS u32x4*)(H + 4 * lane) = (u32x4){0u, 0u, 0u, 0u};
        for (int it = 0; it < nit; ++it) { const u32x4 v = *(const LAS u32x4*)(row + (it * 64 + lane) * 8);
            const unsigned e[8] = {v.x & 0xFFFFu, v.x >> 16, v.y & 0xFFFFu, v.y >> 16, v.z & 0xFFFFu, v.z >> 16, v.w & 0xFFFFu, v.w >> 16};
#pragma unroll
            for (int j = 0; j < 8; ++j) if ((int)(e[j] >> 8) == T1) __hip_atomic_fetch_add(H + (e[j] & 255u), 1u, __ATOMIC_RELAXED, __HIP_MEMORY_SCOPE_WORKGROUP); }
        unsigned thr; int cgt, cge;
        { const u32x4 h4 = *(const LAS u32x4*)(H + 4 * lane); const int sl = (int)(h4.x + h4.y + h4.z + h4.w);
          const int suf = wave_suffix_incl(sl);
          const int need = 256 - above1;
          const unsigned long long bm = __ballot(suf >= need); const int L = 63 - __builtin_clzll(bm);
          const int Lu = __builtin_amdgcn_readfirstlane(L);
          const int hx = __builtin_amdgcn_readlane((int)h4.x, Lu), hy = __builtin_amdgcn_readlane((int)h4.y, Lu), hz = __builtin_amdgcn_readlane((int)h4.z, Lu), hw = __builtin_amdgcn_readlane((int)h4.w, Lu);
          int cb = __builtin_amdgcn_readlane(suf, Lu) - (hx + hy + hz + hw); int T2, hT;
          if (cb + hw >= need) { T2 = 4 * L + 3; hT = hw; } else { cb += hw; if (cb + hz >= need) { T2 = 4 * L + 2; hT = hz; } else { cb += hz; if (cb + hy >= need) { T2 = 4 * L + 1; hT = hy; } else { cb += hy; T2 = 4 * L; hT = hx; } } }
          thr = ((unsigned)T1 << 8) | (unsigned)T2; cgt = above1 + cb; cge = cgt + hT; }
        const bool exact = (cge == 256);
        const int r = 256 - cgt;
        const unsigned cmin = exact ? thr : thr + 1u;
        const unsigned long long lt_mask = (1ull << lane) - 1ull; int bcnt = 0;
        for (int it = 0; it < nit; ++it) { const u32x4 v = *(const LAS u32x4*)(row + (it * 64 + lane) * 8); const int base = (it * 64 + lane) * 8;
            const unsigned e[8] = {v.x & 0xFFFFu, v.x >> 16, v.y & 0xFFFFu, v.y >> 16, v.z & 0xFFFFu, v.z >> 16, v.w & 0xFFFFu, v.w >> 16};
#pragma unroll
            for (int j = 0; j < 8; ++j) { const bool sl = e[j] >= cmin; const unsigned long long bm = __ballot(sl);
                if (bm != 0ull) { if (sl) list[(bcnt + __popcll(bm & lt_mask)) & 255] = (unsigned short)(base + j); bcnt += __popcll(bm); } } }
        if (!exact) {
            int taken = 0;
            for (int it = 0; it < nit && taken < r; ++it) { const u32x4 v = *(const LAS u32x4*)(row + (it * 64 + lane) * 8); const int base = (it * 64 + lane) * 8;
                const unsigned e[8] = {v.x & 0xFFFFu, v.x >> 16, v.y & 0xFFFFu, v.y >> 16, v.z & 0xFFFFu, v.z >> 16, v.w & 0xFFFFu, v.w >> 16};
                int mcount = 0;
#pragma unroll
                for (int j = 0; j < 8; ++j) mcount += (e[j] == thr);
                if (__ballot(mcount != 0) == 0ull) continue;
                const int incl = wave_prefix_incl(mcount);
                const int total = __builtin_amdgcn_readlane(incl, 63); int rk = taken + incl - mcount;
#pragma unroll
                for (int j = 0; j < 8; ++j) if (e[j] == thr) { if (rk < r) list[(cgt + rk) & 255] = (unsigned short)(base + j); ++rk; }
                taken += total; }
        }
        }
    }
    { LAS unsigned* Hc = hist + w * 512; *(LAS u32x4*)(Hc + 4 * lane) = (u32x4){0u, 0u, 0u, 0u}; *(LAS u32x4*)(Hc + 256 + 4 * lane) = (u32x4){0u, 0u, 0u, 0u}; }
    __builtin_amdgcn_fence(__ATOMIC_RELEASE, "workgroup"); __builtin_amdgcn_wave_barrier();
    const bf16_t* qrow = pj + (unsigned)t * (unsigned)PJ;
    long qh0 = 0, ql0 = 0, qh1 = 0, ql1 = 0;
    if (fr < 4) { const u32x4 r0 = *(const u32x4*)(qrow + C_Q + fr * 64 + 8 * fq), r1 = *(const u32x4*)(qrow + C_Q + fr * 64 + 32 + 8 * fq);
        unsigned hA, hB, lA, lB;
        q_split4(r0.x, r0.y, hA, lA); q_split4(r0.z, r0.w, hB, lB); qh0 = (long)(((unsigned long long)hB << 32) | hA); ql0 = (long)(((unsigned long long)lB << 32) | lA);
        q_split4(r1.x, r1.y, hA, lA); q_split4(r1.z, r1.w, hB, lB); qh1 = (long)(((unsigned long long)hB << 32) | hA); ql1 = (long)(((unsigned long long)lB << 32) | lA); }
    LAS float* Pb = (LAS float*)row;
    LAS float* pinv = (LAS float*)(X.lds + 131072 + 4096 + 256 + w * 16);
    _Pragma("nounroll") for (int rs3 = 0; rs3 < (((DSA_SKIP | X.dbg) & 4) ? 0 : R_S3); ++rs3) {
    const int kr = lane >> 3, d8 = (lane & 7) * 8;
    u32x2 vv[4][8];
#pragma unroll
    for (int B = 0; B < 4; ++B)
#pragma unroll
        for (int j = 0; j < 8; ++j) { const unsigned vo_ = (unsigned)list[B * 64 + 8 * j + kr] * 64u + (unsigned)d8; vv[B][j] = *(const u32x2*)(v2 + vo_); }
    { LAS unsigned char* kbuf = (LAS unsigned char*)row + 4096;
      const int drow = lane >> 2, dchk = (lane & 3) ^ (drow >> 2);
#define QK_DMA(G) do { _Pragma("unroll") for (int i_ = 0; i_ < 2; ++i_) { const unsigned ko_ = (unsigned)list[(G) * 32 + i_ * 16 + drow] * 64u + (unsigned)(dchk * 16); \
        __builtin_amdgcn_global_load_lds((const unsigned*)(k2 + ko_), (LAS unsigned*)(kbuf + ((G) % 6) * 2048 + i_ * 1024), 16, 0, 0); } } while (0)
#define QK_COMP(G) do { _Pragma("unroll") for (int j = 0; j < 2; ++j) { const LAS unsigned char* tb_ = kbuf + ((G) % 6) * 2048 + j * 1024 + fr * 64 + (fq & 1) * 8; \
        const long k0_ = *(const LAS long*)(tb_ + (((fq >> 1) ^ (fr >> 2)) * 16)), k1_ = *(const LAS long*)(tb_ + (((2 + (fq >> 1)) ^ (fr >> 2)) * 16)); \
        f32x4 a_ = __builtin_amdgcn_mfma_f32_16x16x32_fp8_fp8(k0_, qh0, (f32x4){0.f, 0.f, 0.f, 0.f}, 0, 0, 0); a_ = __builtin_amdgcn_mfma_f32_16x16x32_fp8_fp8(k0_, ql0, a_, 0, 0, 0); \
        a_ = __builtin_amdgcn_mfma_f32_16x16x32_fp8_fp8(k1_, qh1, a_, 0, 0, 0); a_ = __builtin_amdgcn_mfma_f32_16x16x32_fp8_fp8(k1_, ql1, a_, 0, 0, 0); \
        if (fr < 4) { _Pragma("unroll") for (int i = 0; i < 4; ++i) { const int nn_ = ((G) * 2 + j) * 16 + 4 * fq + i; Pb[nn_ * 4 + fr] = (nn_ < nsel) ? a_[i] * (0.125f / (K_SCALE * Q_SCALE)) : -3.0e38f; } } } } while (0)
      _Pragma("nounroll") for (int rqk = 0; rqk < R_QK; ++rqk) {
      QK_DMA(0); QK_DMA(1); QK_DMA(2); QK_DMA(3); QK_DMA(4);
      asm volatile("s_waitcnt vmcnt(8)" ::: "memory"); QK_COMP(0); asm volatile("s_waitcnt lgkmcnt(0)" ::: "memory"); QK_DMA(5);
      asm volatile("s_waitcnt vmcnt(8)" ::: "memory"); QK_COMP(1); asm volatile("s_waitcnt lgkmcnt(0)" ::: "memory"); QK_DMA(6);
      asm volatile("s_waitcnt vmcnt(8)" ::: "memory"); QK_COMP(2); asm volatile("s_waitcnt lgkmcnt(0)" ::: "memory"); QK_DMA(7);
      asm volatile("s_waitcnt vmcnt(8)" ::: "memory"); QK_COMP(3);
      asm volatile("s_waitcnt vmcnt(6)" ::: "memory"); QK_COMP(4);
      asm volatile("s_waitcnt vmcnt(4)" ::: "memory"); QK_COMP(5);
      asm volatile("s_waitcnt vmcnt(2)" ::: "memory"); QK_COMP(6);
      asm volatile("s_waitcnt vmcnt(0)" ::: "memory"); QK_COMP(7);
      if (R_QK > 1) asm volatile("s_waitcnt lgkmcnt(0)" ::: "memory"); }
#undef QK_DMA
#undef QK_COMP
    }
    __builtin_amdgcn_fence(__ATOMIC_RELEASE, "workgroup"); __builtin_amdgcn_wave_barrier();
    { const int hd = lane & 3, nb0 = lane >> 2;
        float v16[16]; float mx = -3.0e38f;
#pragma unroll
        for (int j = 0; j < 16; ++j) { v16[j] = Pb[(nb0 + 16 * j) * 4 + hd]; mx = fmaxf(mx, v16[j]); }
        mx = fmaxf(mx, lshfl(mx, lane ^ 4, lane)); mx = fmaxf(mx, lshfl(mx, lane ^ 8, lane)); mx = fmaxf(mx, lshfl(mx, lane ^ 16, lane)); mx = fmaxf(mx, lshfl(mx, lane ^ 32, lane));
        float sm = 0.f;
#pragma unroll
        for (int j = 0; j < 16; ++j) { const float p = (v16[j] > -1.0e38f) ? __expf(v16[j] - mx) : 0.f; sm += p; Pb[(nb0 + 16 * j) * 4 + hd] = p; }
        sm += lshfl(sm, lane ^ 4, lane); sm += lshfl(sm, lane ^ 8, lane); sm += lshfl(sm, lane ^ 16, lane); sm += lshfl(sm, lane ^ 32, lane);
        if (lane < 4) pinv[lane] = 1.0f / sm; }
    __builtin_amdgcn_fence(__ATOMIC_RELEASE, "workgroup"); __builtin_amdgcn_wave_barrier();
    f32x2 o2[4][4];
#pragma unroll
    for (int h = 0; h < 4; ++h)
#pragma unroll
        for (int q = 0; q < 4; ++q) o2[h][q] = (f32x2){0.f, 0.f};
#define PV_COMP(VV, B) do { _Pragma("unroll") for (int j = 0; j < 8; ++j) { const f32x4 p4_ = *(const LAS f32x4*)(Pb + ((B) * 64 + 8 * j + kr) * 4); \
        const f32x2 v0_ = __builtin_amdgcn_cvt_pk_f32_fp8((int)VV[j].x, false), v1_ = __builtin_amdgcn_cvt_pk_f32_fp8((int)VV[j].x, true), v2_ = __builtin_amdgcn_cvt_pk_f32_fp8((int)VV[j].y, false), v3_ = __builtin_amdgcn_cvt_pk_f32_fp8((int)VV[j].y, true); \
        _Pragma("unroll") for (int h = 0; h < 4; ++h) { const f32x2 pp_ = (f32x2){p4_[h], p4_[h]}; o2[h][0] = __builtin_elementwise_fma(v0_, pp_, o2[h][0]); o2[h][1] = __builtin_elementwise_fma(v1_, pp_, o2[h][1]); \
            o2[h][2] = __builtin_elementwise_fma(v2_, pp_, o2[h][2]); o2[h][3] = __builtin_elementwise_fma(v3_, pp_, o2[h][3]); } } } while (0)
    PV_COMP(vv[0], 0); PV_COMP(vv[1], 1); PV_COMP(vv[2], 2); PV_COMP(vv[3], 3);
#undef PV_COMP
    { f32x2 r2[2][4];
      const bool b5 = (lane & 32) != 0, b4 = (lane & 16) != 0, b3 = (lane & 8) != 0;
#pragma unroll
      for (int hh = 0; hh < 2; ++hh)
#pragma unroll
          for (int q = 0; q < 4; ++q) {
#pragma unroll
              for (int c = 0; c < 2; ++c) { const float keep = b5 ? o2[2 + hh][q][c] : o2[hh][q][c], give = b5 ? o2[hh][q][c] : o2[2 + hh][q][c]; r2[hh][q][c] = keep + lshfl(give, lane ^ 32, lane); } }
      f32x2 r1[4];
#pragma unroll
      for (int q = 0; q < 4; ++q)
#pragma unroll
          for (int c = 0; c < 2; ++c) { const float keep = b4 ? r2[1][q][c] : r2[0][q][c], give = b4 ? r2[0][q][c] : r2[1][q][c]; r1[q][c] = keep + lshfl(give, lane ^ 16, lane); }
      f32x2 r0[2];
#pragma unroll
      for (int q = 0; q < 2; ++q)
#pragma unroll
          for (int c = 0; c < 2; ++c) { const float keep = b3 ? r1[2 + q][c] : r1[q][c], give = b3 ? r1[q][c] : r1[2 + q][c]; r0[q][c] = keep + lshfl(give, lane ^ 8, lane); }
      const int h = (b5 ? 2 : 0) + (b4 ? 1 : 0); const float iv = pinv[h] * (1.0f / V_SCALE);
      u32x2 o; o.x = pk2(r0[0][0] * iv, r0[0][1] * iv); o.y = pk2(r0[1][0] * iv, r0[1][1] * iv);
      *(u32x2*)(X.ybuf() + (size_t)1 * M * 256 + ((size_t)b * SEQ + t) * 256 + h * 64 + d8 + (b3 ? 4 : 0)) = o; }
    __builtin_amdgcn_fence(__ATOMIC_RELEASE, "workgroup"); __builtin_amdgcn_wave_barrier(); }
    __syncthreads();
}

constexpr int LR_HH = 0, LR_HL = 33280, LR_PART = 66560, LR_LG = 82944, LR_CNT = 84992, LR_PITCH = 1032;
__device__ __forceinline__ void ph_ln1_router(const Ctx& X, int l) {
    const int lane = X.lane, w = X.wave, tid = X.tid, fr = lane & 15, fq = lane >> 4;
    LAS bf16_t* Hh = (LAS bf16_t*)(X.lds + LR_HH); LAS bf16_t* Hl = (LAS bf16_t*)(X.lds + LR_HL);
    LAS float* part = (LAS float*)(X.lds + LR_PART);
    LAS float* lgt = (LAS float*)(X.lds + LR_LG);
    LAS unsigned* wgcnt = (LAS unsigned*)(X.lds + LR_CNT);
    if (tid < 32) wgcnt[tid] = 0u;
    bf16x8 Ahi[2][4], Alo[2][4];
    { const bf16_t* rf = (const bf16_t*)(X.ws + WS_RFR);
#pragma unroll
      for (int rt = 0; rt < 2; ++rt)
#pragma unroll
          for (int q = 0; q < 4; ++q) { const size_t o = ((size_t)(rt * 32 + 4 * w + q) * 64 + lane) * 8; Ahi[rt][q] = *(const bf16x8*)(rf + o); Alo[rt][q] = *(const bf16x8*)(rf + 32768 + o); } }
    float* xo = X.a->out; bf16_t* hb = X.hbuf(); float* xw = (X.dbg & 8) ? (float*)(X.ws + WS_ACT) : xo; const bf16_t* v16 = (const bf16_t*)(X.ws + WS_V16);
    const int tok0 = X.c * 128, b = tok0 >> 13;
    const float* mv = X.modv(l, 1) + b * 3072;
    const float* lg = X.in(I_LN1G) + l * D; const float* lb = X.in(I_LN1B) + l * D;
    const int e = lane & 31;
    const float rbias = X.in(I_RB)[l * NEXP + e];
    unsigned* pinfo = (unsigned*)(X.ws + WS_PINFO); float* pgate = (float*)(X.ws + WS_PGATE);
    __syncthreads();
    f32x4 pg_[4], pb_[4], ps_[4], pt_[4];
#pragma unroll
    for (int j = 0; j < 4; ++j) { const int col = 4 * lane + 256 * j; pg_[j] = *(const f32x4*)(lg + col); pb_[j] = *(const f32x4*)(lb + col); ps_[j] = *(const f32x4*)(mv + 1024 + col) + 1.0f; pt_[j] = *(const f32x4*)(mv + col); }
    u32x2 raw[2][4];
#pragma unroll
    for (int jj = 0; jj < 2; ++jj)
#pragma unroll
        for (int j = 0; j < 4; ++j) raw[jj][j] = *(const u32x2*)(v16 + (size_t)(tok0 + 2 * w + jj) * D + 4 * lane + 256 * j);
    for (int pass = 0; pass < 8; ++pass) {
        f32x4 vv[2][4];
#pragma unroll
        for (int jj = 0; jj < 2; ++jj)
#pragma unroll
            for (int j = 0; j < 4; ++j) { const u32x2 q2 = raw[jj][j]; vv[jj][j] = (f32x4){bflo(q2.x), bfhi(q2.x), bflo(q2.y), bfhi(q2.y)}; }
        if (pass + 1 < 8) {
#pragma unroll
            for (int jj = 0; jj < 2; ++jj)
#pragma unroll
                for (int j = 0; j < 4; ++j) raw[jj][j] = *(const u32x2*)(v16 + (size_t)(tok0 + (pass + 1) * 16 + 2 * w + jj) * D + 4 * lane + 256 * j); }
#pragma unroll
        for (int jj = 0; jj < 2; ++jj) {
            const int r = 2 * w + jj, tok = tok0 + pass * 16 + r;
            f32x4 v[4]; float s = 0.f;
#pragma unroll
            for (int j = 0; j < 4; ++j) { v[j] = vv[jj][j]; s += (v[j][0] + v[j][1]) + (v[j][2] + v[j][3]); }
            const float mean = wave_sum(s) * (1.0f / D); float q = 0.f;
#pragma unroll
            for (int j = 0; j < 4; ++j) { v[j] = v[j] - mean; q += (v[j][0] * v[j][0] + v[j][1] * v[j][1]) + (v[j][2] * v[j][2] + v[j][3] * v[j][3]); }
            const float rstd = rsqrtf(wave_sum(q) * (1.0f / D) + LN_EPS);
#pragma unroll
            for (int j = 0; j < 4; ++j) { const int col = 4 * lane + 256 * j;
                const f32x4 x1 = v[j] * rstd * pg_[j] + pb_[j];
                { const f32x4 xa = x1 * DN_ALPHA; u32x2 ox; ox.x = pk2(xa[0], xa[1]); ox.y = pk2(xa[2], xa[3]);
                  if (l == 0) *(u32x2*)((bf16_t*)xo + (size_t)tok * D + col) = ox; else *(u32x2*)((bf16_t*)xw + (size_t)tok * 2 * D + D + col) = ox; }
                const f32x4 hv = x1 * ps_[j] + pt_[j];
                const unsigned h0 = f2bf(hv[0]), h1 = f2bf(hv[1]), h2 = f2bf(hv[2]), h3 = f2bf(hv[3]);
                u32x2 o; o.x = h0 | (h1 << 16); o.y = h2 | (h3 << 16); *(u32x2*)(hb + (size_t)tok * D + col) = o;
                *(LAS u32x2*)(Hh + r * LR_PITCH + col) = o;
                u32x2 ol; ol.x = pk2(hv[0] - bflo(h0), hv[1] - bflo(h1)); ol.y = pk2(hv[2] - bflo(h2), hv[3] - bflo(h3)); *(LAS u32x2*)(Hl + r * LR_PITCH + col) = ol; }
        }
        __syncthreads();
        {
            f32x4 acc0 = (f32x4){0.f, 0.f, 0.f, 0.f}, acc1 = acc0;
#pragma unroll
            for (int q = 0; q < 4; ++q) { const int ko = fr * LR_PITCH + (4 * w + q) * 32 + 8 * fq;
                const bf16x8 bh = *(const LAS bf16x8*)(Hh + ko), bl = *(const LAS bf16x8*)(Hl + ko);
                acc0 = mfma16(Ahi[0][q], bh, acc0); acc0 = mfma16(Ahi[0][q], bl, acc0); acc0 = mfma16(Alo[0][q], bh, acc0);
                acc1 = mfma16(Ahi[1][q], bh, acc1); acc1 = mfma16(Ahi[1][q], bl, acc1); acc1 = mfma16(Alo[1][q], bh, acc1); }
#pragma unroll
            for (int i = 0; i < 4; ++i) { part[(w * 32 + 4 * fq + i) * 16 + fr] = acc0[i]; part[(w * 32 + 16 + 4 * fq + i) * 16 + fr] = acc1[i]; }
        }
        __syncthreads();
        { const int ee = tid >> 4, tk = tid & 15; float sm = 0.f;
#pragma unroll
          for (int q = 0; q < 8; ++q) sm += part[(q * 32 + ee) * 16 + tk];
          lgt[tk * 32 + ee] = sm; }
        __syncthreads();
#pragma unroll
        for (int jj = 0; jj < 2; ++jj) {
            const int r = 2 * w + jj, tok = tok0 + pass * 16 + r;
            const float score = sigmoidf_(lgt[r * 32 + e]), biased = score + rbias;
            const int gbase = lane & ~3;
            const float v0 = dppx<0x00>(biased), v1 = dppx<0x55>(biased), v2 = dppx<0xAA>(biased), v3 = dppx<0xFF>(biased);
            const float a_ = fmaxf(v0, v1), b_ = fminf(v0, v1), c_ = fmaxf(v2, v3), d_ = fminf(v2, v3);
            const float gs = fmaxf(a_, c_) + fmaxf(fminf(a_, c_), fmaxf(b_, d_));
            const int myg = e >> 2; int grank = 0;
#pragma unroll
            for (int g2 = 0; g2 < 8; ++g2) { const float o = rdl(gs, 4 * g2); grank += (o > gs || (o == gs && g2 < myg)) ? 1 : 0; }
            const float masked = (grank < 4) ? biased : -3.0e38f;
            int erank = 0;
#pragma unroll
            for (int e2 = 0; e2 < 32; ++e2) { const float o = rdl(masked, e2); erank += (o > masked || (o == masked && e2 < e)) ? 1 : 0; }
            const bool sel = (erank < 8) && (lane < 32);
            const float wsum = wave_sum(sel ? score : 0.f);
            const float gate = score / wsum * 2.5f;
            const unsigned long long bal = __ballot(sel);
            if (sel) { const int k = __popcll(bal & ((1ull << lane) - 1ull));
                const unsigned lr = __hip_atomic_fetch_add(wgcnt + e, 1u, __ATOMIC_RELAXED, __HIP_MEMORY_SCOPE_WORKGROUP);
                pinfo[(size_t)tok * 8 + k] = (unsigned)e | (lr << 8); pgate[(size_t)tok * 8 + k] = gate; }
        }
    }
    __syncthreads();
    if (tid < 32) { const int chunk = tok0 / CHTOK; unsigned* cnt = (unsigned*)(X.ws + WS_CTL) + CW_CNT + (l * NCH + chunk) * 64;
        const unsigned base = __hip_atomic_fetch_add(cnt + tid, wgcnt[tid], __ATOMIC_RELAXED, __HIP_MEMORY_SCOPE_AGENT);
        ((unsigned*)(X.ws + WS_WGBASE))[X.c * 32 + tid] = base; }
    __syncthreads();
}

__device__ __forceinline__ void moe_offsets(const Ctx& X, int l, int chunk, LAS int* off  , LAS int* cntl  ) {
    if (X.tid < NEXP) { const unsigned* cnt = (const unsigned*)(X.ws + WS_CTL) + CW_CNT + (l * NCH + chunk) * 64; cntl[X.tid] = (int)__hip_atomic_load(cnt + X.tid, __ATOMIC_RELAXED, __HIP_MEMORY_SCOPE_AGENT); }
    if (X.tid == NEXP) cntl[NEXP] = CHTOK;
    __syncthreads();
    if (X.tid == 0) { int o = 0;
        for (int e = 0; e < NE1; ++e) { const int cn = cntl[e]; off[e] = o; o += ((cn + 255) >> 8) << 8; }
        off[NE1] = o; }
    __syncthreads();
}
#define ST_WT(p, v) __hip_atomic_store((p), (v), __ATOMIC_RELAXED, __HIP_MEMORY_SCOPE_AGENT)
__device__ __forceinline__ void ph_fill(const Ctx& X, int l) {
    LAS int* off = (LAS int*)(X.lds); LAS int* cntl = off + 64;
    const int tok0 = X.c * 128, chunk = tok0 / CHTOK;
    moe_offsets(X, l, chunk, off, cntl);
    unsigned* rowtok = (unsigned*)(X.ws + WS_ROWTOK) + (size_t)chunk * CH_ROWS; float* rowgate = (float*)(X.ws + WS_ROWGATE) + (size_t)chunk * CH_ROWS;
    const unsigned* pinfo = (const unsigned*)(X.ws + WS_PINFO); const float* pgate = (const float*)(X.ws + WS_PGATE); unsigned* slot = (unsigned*)(X.ws + WS_SLOT);
    const unsigned* wgb = (const unsigned*)(X.ws + WS_WGBASE) + X.c * 32;
    for (int i = X.tid; i < 1024; i += 512) { const size_t pi = (size_t)tok0 * 8 + i; const unsigned inf = pinfo[pi]; const int e = inf & 255, lr = inf >> 8;
        const int pos = off[e] + (int)wgb[e] + lr; ST_WT(rowtok + pos, (unsigned)(tok0 + (i >> 3))); ST_WT((unsigned*)rowgate + pos, __builtin_bit_cast(unsigned, pgate[pi])); slot[pi] = (unsigned)pos; }
    if (X.tid < 128) { const int tok = tok0 + X.tid; const int pos = off[NEXP] + (tok - chunk * CHTOK); ST_WT(rowtok + pos, (unsigned)tok); ST_WT((unsigned*)rowgate + pos, __builtin_bit_cast(unsigned, 1.0f)); }
    const int wl = X.c & 63;
    if (wl < NEXP) { const int e = wl; const int p0 = off[e] + cntl[e], p1 = off[e + 1]; for (int p = p0 + X.tid; p < p1; p += 512) { ST_WT(rowtok + p, (unsigned)(chunk * CHTOK)); ST_WT((unsigned*)rowgate + p, 0u); } }
    __syncthreads();
}

template <int NT, bool GATH>
struct MoeOrder {
    static constexpr bool GATHER = GATH;
    int nwg, G, c; const LAS unsigned char* tile_e; const LAS int* rowtab;
    __device__ __forceinline__ bool next(int i, pg8::Unit& u) const {
        const long L = (long)i * G + c; if (L >= nwg) return false;
        const int wgid = pg8::xcd_remap((int)L, nwg); const int tau = wgid / NT, pn = wgid % NT;
        u.pm = tau; u.pn = pn; u.bt = __builtin_amdgcn_readfirstlane((int)tile_e[tau]) * NT + pn; u.ab = i; return true;
    }
    __device__ __forceinline__ int row_of(const pg8::Unit& u, int r) const { return rowtab[u.ab * 256 + r]; }
    __device__ __forceinline__ void a_ready(const pg8::Unit&) const {}
    __device__ __forceinline__ void done(const pg8::Unit&) const {}
};
template <int NT, bool GATH>
struct MoeOrderAll {
    static constexpr bool GATHER = GATH;
    int nwg, G, c; const LAS unsigned char* tile_e4; const LAS int* tprefix; const LAS int* rowtab; int tbase;
    __device__ __forceinline__ bool next(int i, pg8::Unit& u) const {
#if MOE_PAIR
        constexpr int PAIRW = (NT == 4) ? MOE_PAIR4 : MOE_PAIR2;
        const int ip = i / PAIRW, sp = i % PAIRW; const int npair = nwg / PAIRW;
        const long L = (long)ip * G + c; if (L >= npair) return false;
        const int wp = pg8::xcd_remap((int)L, npair); const int gt = tbase + wp / (NT / PAIRW), pn = (wp % (NT / PAIRW)) * PAIRW + sp;
#else
        const long L = (long)i * G + c; if (L >= nwg) return false;
        const int wgid = pg8::xcd_remap((int)L, nwg); const int gt = tbase + wgid / NT, pn = wgid % NT;
#endif
        int ch = 0;
#pragma unroll
        for (int q = 1; q < NCH; ++q) ch += (tprefix[q] <= gt) ? 1 : 0;
        ch = __builtin_amdgcn_readfirstlane(ch); const int tau = gt - __builtin_amdgcn_readfirstlane(tprefix[ch]);
        u.pm = ch * CH_TILES + tau; u.pn = pn; u.bt = __builtin_amdgcn_readfirstlane((int)tile_e4[ch * 336 + tau]) * NT + pn; u.ab = i; return true;
    }
    __device__ __forceinline__ int row_of(const pg8::Unit& u, int r) const { return rowtab[u.ab * 256 + r]; }
    __device__ __forceinline__ void a_ready(const pg8::Unit&) const {}
    __device__ __forceinline__ void done(const pg8::Unit&) const {}
};
__device__ __forceinline__ void moe_tables_all(const Ctx& X, int l, LAS int* off4, LAS unsigned char* tile_e4, LAS int* tprefix) {
    const int w = X.wave, lane = X.lane;
    if (w < NCH) {
        const unsigned* cnt = (const unsigned*)(X.ws + WS_CTL) + CW_CNT + (l * NCH + w) * 64;
        int cn = 0;
        if (lane < NEXP) cn = (int)__hip_atomic_load(cnt + lane, __ATOMIC_RELAXED, __HIP_MEMORY_SCOPE_AGENT);
        if (lane == NEXP) cn = CHTOK;
        const int pad = ((cn + 255) >> 8) << 8;
        const int incl = wave_prefix_incl(pad), excl = incl - pad;
        if (lane <= NE1) off4[w * 64 + lane] = excl;
        if (lane <= NEXP) for (int t = excl >> 8; t < (incl >> 8); ++t) tile_e4[w * 336 + t] = (unsigned char)lane;
    }
    __syncthreads();
    if (X.tid == 0) { int a = 0; for (int q = 0; q < NCH; ++q) { tprefix[q] = a; a += off4[q * 64 + NE1] >> 8; } tprefix[NCH] = a; }
    __syncthreads();
}
__device__ __forceinline__ int moe_tiles(const Ctx& X, int l, int chunk, LAS unsigned char* tile_e, LAS int* off, LAS int* cntl) {
    moe_offsets(X, l, chunk, off, cntl);
    const int ntile = off[NE1] >> 8;
    for (int t = X.tid; t < ntile; t += 512) { int e = 0; for (int q = 1; q < NE1; ++q) e += (off[q] <= t * 256) ? 1 : 0; tile_e[t] = (unsigned char)e; }
    __syncthreads();
    return ntile;
}

__device__ __forceinline__ void ph_combine(const Ctx& X, int l, int c0, const LAS int* off4) {
    const int lane = X.lane; const int gw = X.c * 8 + X.wave; const int chunk = c0 + (gw >> 10);
    float* xo = X.a->out; bf16_t* hb = X.hbuf(); float* xw = (X.dbg & 8) ? (float*)(X.ws + WS_ACT) : xo;
    const unsigned char* op = (const unsigned char*)(X.ws + WS_OPAIR) + (size_t)(chunk - c0) * CH_ROWS * 1024; const unsigned* slot = (const unsigned*)(X.ws + WS_SLOT);
    const int b = (chunk * CHTOK) >> 13; const float* mv2 = X.modv(l, 1) + b * 3072;
    const float* lg = X.in(I_LN2G) + l * D; const float* lb = X.in(I_LN2B) + l * D;
    const int offsh = off4[chunk * 64 + NEXP];
    f32x4 cg_[4], pg_[4], pb_[4], ps_[4], pt_[4];
#pragma unroll
    for (int j = 0; j < 4; ++j) { const int col = 4 * lane + 256 * j; cg_[j] = (*(const f32x4*)(mv2 + 2048 + col) + 1.0f) * (1.0f / O_SCALE); pg_[j] = *(const f32x4*)(lg + col); pb_[j] = *(const f32x4*)(lb + col);
        ps_[j] = (f32x4){0.f, 0.f, 0.f, 0.f}; pt_[j] = ps_[j];
        if (l + 1 < DEPTH) { const float* mv1 = X.modv(l + 1, 0) + b * 3072; ps_[j] = *(const f32x4*)(mv1 + 1024 + col) + 1.0f; pt_[j] = *(const f32x4*)(mv1 + col); } }
#pragma unroll 1
    for (int i = 0; i < 8; i += 2) {
        const int tokA = c0 * CHTOK + gw * 8 + i;
        int pos[2][9];
#pragma unroll
        for (int t = 0; t < 2; ++t) {
            const u32x4 s0 = *(const u32x4*)(slot + (size_t)(tokA + t) * 8), s1 = *(const u32x4*)(slot + (size_t)(tokA + t) * 8 + 4);
            pos[t][0] = (int)s0.x; pos[t][1] = (int)s0.y; pos[t][2] = (int)s0.z; pos[t][3] = (int)s0.w; pos[t][4] = (int)s1.x; pos[t][5] = (int)s1.y; pos[t][6] = (int)s1.z; pos[t][7] = (int)s1.w;
            pos[t][8] = offsh + (tokA + t - chunk * CHTOK); }
        unsigned rw8[2][9][4];
#pragma unroll
        for (int t = 0; t < 2; ++t) {
#pragma unroll
            for (int k = 0; k < 9; ++k) { const unsigned ro = (unsigned)pos[t][k] * 1024u + 4u * (unsigned)lane;
#pragma unroll
                for (int j = 0; j < 4; ++j) rw8[t][k][j] = *(const unsigned*)(op + ro + 256 * j); } }
#pragma unroll
        for (int t = 0; t < 2; ++t) {
            const int tok = tokA + t;
            f32x4 sm[4];
#pragma unroll
            for (int j = 0; j < 4; ++j) sm[j] = (f32x4){0.f, 0.f, 0.f, 0.f};
#pragma unroll
            for (int k = 0; k < 9; ++k)
#pragma unroll
                for (int j = 0; j < 4; ++j) { const int q = (int)rw8[t][k][j]; const f32x2 lo = __builtin_amdgcn_cvt_pk_f32_fp8(q, false), hi = __builtin_amdgcn_cvt_pk_f32_fp8(q, true);
                    sm[j][0] += lo[0]; sm[j][1] += lo[1]; sm[j][2] += hi[0]; sm[j][3] += hi[1]; }
            f32x4 v[4]; float s = 0.f;
#pragma unroll
            for (int j = 0; j < 4; ++j) { const int col = 4 * lane + 256 * j; const u32x2 q2 = (l == 0) ? *(const u32x2*)((const bf16_t*)xo + (size_t)tok * D + col) : *(const u32x2*)((const bf16_t*)xw + (size_t)tok * 2 * D + D + col); const f32x4 xr1 = (f32x4){bflo(q2.x), bfhi(q2.x), bflo(q2.y), bfhi(q2.y)};
                v[j] = xr1 + cg_[j] * sm[j]; s += (v[j][0] + v[j][1]) + (v[j][2] + v[j][3]); }
            const float mean = wave_sum(s) * (1.0f / D); float q = 0.f;
#pragma unroll
            for (int j = 0; j < 4; ++j) { v[j] = v[j] - mean; q += (v[j][0] * v[j][0] + v[j][1] * v[j][1]) + (v[j][2] * v[j][2] + v[j][3] * v[j][3]); }
            const float rstd = rsqrtf(wave_sum(q) * (1.0f / D) + LN_EPS);
#pragma unroll
            for (int j = 0; j < 4; ++j) { const int col = 4 * lane + 256 * j;
                const f32x4 x2 = v[j] * rstd * pg_[j] + pb_[j];
                if (l == 0) { u32x2 ox; ox.x = pk2(x2[0], x2[1]); ox.y = pk2(x2[2], x2[3]); *(u32x2*)((bf16_t*)xo + (size_t)M * D + (size_t)tok * D + col) = ox; }
                else *(f32x4*)(xw + (size_t)tok * D + col) = x2;
                if (l + 1 < DEPTH) { const f32x4 hn = x2 * ps_[j] + pt_[j];
                    u32x2 o; o.x = pk2(hn[0], hn[1]); o.y = pk2(hn[2], hn[3]); *(u32x2*)(hb + (size_t)tok * D + col) = o; } }
        }
    }
}

template <int PW, bool ABSEL> struct PairOrder : pg8::StaticOrder { __device__ __forceinline__ bool next(int i, pg8::Unit& u) const { if (!pg8::StaticOrder::next(i / PW, u)) return false;
    u.pn = u.pn * PW + i % PW; u.bt = u.pn; u.ab = ABSEL ? (u.pn >> 2) : 0; return true; } };
struct POrder : pg8::StaticOrder { __device__ __forceinline__ bool next(int i, pg8::Unit& u) const { if (!pg8::StaticOrder::next(i, u)) return false; u.ab = u.pn >> 2; return true; } };
struct GOrder { static constexpr bool GATHER = false; int G, c;
    __device__ __forceinline__ bool next(int i, pg8::Unit& u) const { const int tile = (i >> 2) * G + c; if (tile >= 512) return false; const int wg = pg8::xcd_remap(tile, 512); const int br = i & 3, mt = wg & 3;
        u.pm = wg >> 2; u.pn = br * 4 + mt; u.bt = br * 4 + mt; u.ab = 0; return true; }
    __device__ __forceinline__ void a_ready(const pg8::Unit&) const {} __device__ __forceinline__ void done(const pg8::Unit&) const {} };
__global__ void __launch_bounds__(512, 2) fwd_kernel(Args args) {
    extern __shared__ __attribute__((aligned(16))) unsigned char lds_raw[];
    ArgsP ap = (ArgsP)__builtin_amdgcn_kernarg_segment_ptr();
    Ctx X; X.a = ap; X.ws = ap->ws; X.lds = (LAS unsigned char*)lds_raw;
    X.tid = threadIdx.x; X.lane = X.tid & 63; X.wave = __builtin_amdgcn_readfirstlane(X.tid >> 6); X.G = gridDim.x;
    { const int bx = blockIdx.x; X.bx = bx; X.c = (X.G % 8 == 0) ? (bx % 8) * (X.G / 8) + bx / 8 : bx; }
    const int c0_ = X.c, g0_ = X.G, bx0_ = X.bx, wave0_ = X.wave;
    volatile LAS unsigned* misc = (volatile LAS unsigned*)(X.lds + LDS_MISC);
    if (X.tid < 16) misc[X.tid] = 0u;
    __syncthreads();
    XcdBarrier bar; bar.bar = (unsigned*)(X.ws + WS_CTL) + CW_BAR; bar.x = 0; bar.st = misc;
#if !MK_PER_PHASE
    bar = xcd_barrier_post((unsigned*)(X.ws + WS_CTL) + CW_BAR, misc);
#endif
    const int lo = ap->ph_lo, hi = ap->ph_hi; int ph = 0;
#define RELAUNDER() do { int wv_ = wave0_; asm volatile("" : "+s"(wv_)); unsigned am_ = ~0u; asm volatile("" : "+s"(am_)); int t_ = wv_ * 64 + (int)__builtin_amdgcn_mbcnt_hi(am_, __builtin_amdgcn_mbcnt_lo(am_, 0u)); asm volatile("" : "+v"(t_)); X.tid = t_; X.lane = t_ & 63; X.wave = wv_; } while (0)
#define REPEAT(N, stmt) _Pragma("nounroll") for (int rp_ = 0; rp_ < (N); ++rp_) { stmt; if (rp_ + 1 < (N)) xcd_barrier(bar); }
#define PH_BEGIN if (ph >= lo && ph < hi) { { ArgsP apl = ap; asm volatile("" : "+s"(apl)); X.a = apl; X.ws = apl->ws; X.dbg = apl->dbg; int wv_ = wave0_; asm volatile("" : "+s"(wv_)); unsigned am_ = ~0u; asm volatile("" : "+s"(am_)); int t_ = wv_ * 64 + (int)__builtin_amdgcn_mbcnt_hi(am_, __builtin_amdgcn_mbcnt_lo(am_, 0u)); asm volatile("" : "+v"(t_)); X.tid = t_; X.lane = t_ & 63; X.wave = wv_; int c_ = c0_, g_ = g0_, b_ = bx0_; asm volatile("" : "+s"(c_), "+s"(g_), "+s"(b_)); X.c = c_; X.G = g_; X.bx = b_; { LAS unsigned char* lp_ = (LAS unsigned char*)lds_raw; asm volatile("" : "+s"(lp_)); X.lds = lp_; } } unsigned char* wb = X.ws + WS_W; LAS unsigned char* gl = X.lds; const float* xin = (l_ == 0) ? X.in(I_X) : (const float*)X.a->out; (void)wb; (void)gl; (void)xin;
#if MK_PER_PHASE
#define PH_END } ++ph;
#else
#define PH_END if (ph + 1 < hi) xcd_barrier(bar); } ++ph;
#endif
    int l_ = 0;
    PH_BEGIN if (EN_PROLOGUE) { REPEAT(R_MISC, ph_prologue(X)) } PH_END
    auto layer = [&](const int l) __attribute__((always_inline)) {
        l_ = l;
        if (l == 0) { PH_BEGIN if (EN_WCONV) { REPEAT(R_MISC, ph_wconv(X, l)) } PH_END }
        PH_BEGIN if (EN_GWIN)  { pg8::Gemm g{X.hbuf(), (const bf16_t*)(wb + WO_IN), 1024, 0}; pg8::StaticOrder S; S.init(M, PJ, X.G, X.bx); pg8::EpiBf16 E{X.proj(), PJ};
            REPEAT(R_GWIN, (pg8::gemm_phase<pg8::EpiBf16, pg8::StaticOrder, G_ALIGN, G_SP2, PEEL_GWIN>(gl, g, S, E, X.tid))) } PH_END
        PH_BEGIN if (EN_MX1)  {
            if (!(X.dbg & 1)) mx_rope(X);
            _Pragma("nounroll") for (int rp_ = 0; rp_ < R_MIX; ++rp_) {
            if (!(X.dbg & 2)) for (int u = X.c; u < 256; u += X.G) mx_gmlp(X, l, u);
            if (!(X.dbg & 4)) for (int wu = X.c * 8 + X.wave; wu < 2048; wu += X.G * 8) mx_s5<1>(X, l, wu);
            __syncthreads();
            if (!(X.dbg & 8)) for (int u = X.c; u < 256; u += X.G) mx_ssd<1>(X, l, u); }
        } PH_END
        PH_BEGIN if (EN_MX2)  {
            if (!(X.dbg & 32)) { mx_ssd_carry(X); } RELAUNDER();
            _Pragma("nounroll") for (int rp_ = 0; rp_ < R_DSA; ++rp_)
            { dsa_hist_clear(X); }
            for (int r = 0; r < 16; ++r) { const int cl = X.c & 63; const int uu = (r & 1) ? r * 64 + 63 - cl : r * 64 + cl; if (EN_DSA && !(X.dbg & 64) && X.c < 256) mx_dsa(X, X.c >> 6, uu * 8); }
            __syncthreads(); RELAUNDER();
            for (int wu = X.c * 8 + X.wave; EN_S53 && !(X.dbg & 16) && wu < 2048; wu += X.G * 8) mx_s5<3>(X, l, wu);
        } PH_END
        PH_BEGIN if (EN_GLU)  { for (int u = X.c; EN_SSD3 && u < 256; u += X.G) mx_ssd<3>(X, l, u);
            __syncthreads(); RELAUNDER();
            pg8::Gemm g{(const bf16_t*)(X.ws + WS_YCPRE), (const bf16_t*)(wb + WO_GLU), 256, 0}; pg8::StaticOrder S; S.init(M, 256, X.G, X.bx);
            pg8::EpiGlu E{(const bf16_t*)(X.ws + WS_YCPRE), X.ybuf() + (size_t)2 * M * 256, X.in(I_S5GLUB) + l * 256};
            REPEAT(R_GLU, (pg8::gemm_phase<pg8::EpiGlu, pg8::StaticOrder, G_ALIGN, G_SP2, true>(gl, g, S, E, X.tid))) } PH_END
        PH_BEGIN if (EN_GP)  { pg8::Gemm g{X.ybuf(), (const bf16_t*)(wb + WO_BR), 256, (size_t)M * 256};
            PairOrder<PW_GP, true> S;
            S.init(M, 4096 / PW_GP, X.G, X.bx); pg8::EpiFp8 E{(unsigned char*)(X.ws + WS_P), 4096, P_SCALE};
            REPEAT(R_GP, (pg8::gemm_phase<pg8::EpiFp8, PairOrder<PW_GP, true>, false, G_SP2, true>(gl, g, S, E, X.tid))) } PH_END
        PH_BEGIN if (EN_GGATE)  { pg8::Gemm g{X.hbuf(), (const bf16_t*)(wb + WO_GATE), 1024, 0};
            PairOrder<PW_GGATE, false> S; S.init(M, 4096 / PW_GGATE, X.G, X.bx);
            pg8::EpiGateMerge4 E{(const unsigned char*)(X.ws + WS_P), X.ybuf(), 1.0f / P_SCALE};
            REPEAT(R_GGATE, (pg8::gemm_phase<pg8::EpiGateMerge4, PairOrder<PW_GGATE, false>, G_ALIGN, G_SP2, true>(gl, g, S, E, X.tid))) } PH_END
        PH_BEGIN if (EN_GOUT)  { pg8::Gemm g{X.ybuf(), (const bf16_t*)(wb + WO_OUT), 1024, 0}; PairOrder<PW_GOUT, false> S; S.init(M, 1024 / PW_GOUT, X.G, X.bx);
            if (l == 0) { pg8::EpiResidT<false> E{xin, (bf16_t*)(X.ws + WS_V16), X.modv(l, 0)};
                pg8::gemm_phase<pg8::EpiResidT<false>, PairOrder<PW_GOUT, false>, G_ALIGN, G_SP2, true>(gl, g, S, E, X.tid); }
            else { pg8::EpiResidT<true> E{(const bf16_t*)X.a->out + (size_t)M * D, (bf16_t*)(X.ws + WS_V16), X.modv(l, 0)};
                pg8::gemm_phase<pg8::EpiResidT<true>, PairOrder<PW_GOUT, false>, G_ALIGN, G_SP2, true>(gl, g, S, E, X.tid); } } PH_END
        PH_BEGIN if (EN_LN1)  ph_ln1_router(X, l); PH_END
        PH_BEGIN if (EN_FILL) { REPEAT(R_MISC, ph_fill(X, l)) } PH_END
        PH_BEGIN if (EN_MOE1)  {
            LAS int* off4 = (LAS int*)(X.lds + LDS_TAB + 1024); LAS unsigned char* tile_e4 = (LAS unsigned char*)(X.lds + LDS_TAB + 2048); LAS int* tprefix = (LAS int*)(X.lds + LDS_TAB + 3584);
            moe_tables_all(X, l, off4, tile_e4, tprefix);
            pg8::Gemm g{X.hbuf(), (const bf16_t*)(wb + WO_13), 1024, 0};
            LAS int* rowtab = (LAS int*)(X.lds + LDS_TAB + 4096);
            MoeOrderAll<2, true> S{tprefix[NCH] * 2, X.G, X.bx, tile_e4, tprefix, rowtab, 0};
            { const unsigned* rowtok = (const unsigned*)(X.ws + WS_ROWTOK); pg8::Unit uu;
              const float* rowgate = (const float*)(X.ws + WS_ROWGATE); LAS float* gtabw = (LAS float*)(X.lds + LDS_TAB + 4096 + 12288);
              _Pragma("nounroll") for (int i2 = 0; i2 < 12; i2 += 2) { if (!S.next(i2, uu)) break; const int i = i2 + (X.wave >> 2);
                  if (S.next(i, uu)) { const int pmu = __builtin_amdgcn_readfirstlane(uu.pm), t = X.tid & 255;
                      rowtab[i * 256 + t] = (int)rowtok[(size_t)pmu * 256 + t]; gtabw[i * 256 + t] = rowgate[(size_t)pmu * 256 + t]; } } }
            __syncthreads();
            pg8::EpiMoe1 E{(bf16_t*)(X.ws + WS_ACT), (const LAS float*)(X.lds + LDS_TAB + 4096 + 12288)};
            REPEAT(R_MOE, (pg8::gemm_phase<pg8::EpiMoe1, MoeOrderAll<2, true>, ALIGN_MOE1, G_SP2, PEEL_MOE1>(gl, g, S, E, X.tid)))
        } PH_END
        for (int c0 = 0; c0 < NCH; c0 += 2) {
            PH_BEGIN if (EN_MOE2)  {
                LAS int* off4 = (LAS int*)(X.lds + LDS_TAB + 1024); LAS unsigned char* tile_e4 = (LAS unsigned char*)(X.lds + LDS_TAB + 2048); LAS int* tprefix = (LAS int*)(X.lds + LDS_TAB + 3584);
                moe_tables_all(X, l, off4, tile_e4, tprefix);
                pg8::Gemm g{(const bf16_t*)(X.ws + WS_ACT), (const bf16_t*)(wb + WO_2), 256, 0};
                MoeOrderAll<4, false> S{(tprefix[c0 + 2] - tprefix[c0]) * 4, X.G, X.bx, tile_e4, tprefix, nullptr, tprefix[c0]};
                pg8::EpiFp8 E{(unsigned char*)(X.ws + WS_OPAIR) - (size_t)c0 * CH_ROWS * 1024, 1024, O_SCALE};
                REPEAT(R_MOE, (pg8::gemm_phase<pg8::EpiFp8, MoeOrderAll<4, false>, false, G_SP2, true>(gl, g, S, E, X.tid)))
            } PH_END
            PH_BEGIN if (EN_FIN)  { LAS int* off4 = (LAS int*)(X.lds + LDS_TAB + 1024); LAS unsigned char* tile_e4 = (LAS unsigned char*)(X.lds + LDS_TAB + 2048); LAS int* tprefix = (LAS int*)(X.lds + LDS_TAB + 3584);
                moe_tables_all(X, l, off4, tile_e4, tprefix); ph_combine(X, l, c0, off4);
                if (EN_WCONV && l + 1 < DEPTH && c0 + 2 >= NCH) { __syncthreads(); RELAUNDER(); ph_wconv(X, l + 1); } } PH_END
        }
    };
    layer(0); layer(1); static_assert(DEPTH == 2, "two layers");
#undef PH_BEGIN
#undef PH_END
}
constexpr int N_PHASES = 1 + DEPTH * (10 + 1 + NCH) - (DEPTH - 1);

#ifdef DBG_DUMP_OFF
__global__ void dbg_dump(const bf16_t* src, float* out, size_t n) { for (size_t i = (size_t)blockIdx.x * blockDim.x + threadIdx.x; i < n; i += (size_t)gridDim.x * blockDim.x) {
#ifdef DBG_HASH_OUT
    const unsigned bits = __builtin_bit_cast(unsigned, out[i]); out[i] = (float)((bits * 2654435761u) >> 8) * (1.0f / 16777216.0f);
#else
    const unsigned bits = src[i]; out[i] = (float)(((bits + 1u) * 2654435761u) >> 8) * (1.0f / 16777216.0f);
#endif
} }
#endif
extern "C" void kernel_launch(void* const* d_in, const int* in_sizes, int n_in, void* d_out, int out_size, void* d_ws, size_t ws_size, hipStream_t stream) {
    static int grid = 0;
    if (grid == 0) {
        if (n_in != 43 || out_size != M * D || ws_size < WS_NEED) { fprintf(stderr, "kernel_launch: unexpected shapes (n_in %d out %d ws %zu)\n", n_in, out_size, ws_size); grid = -1; return; }
        int dev = 0, cus = 0, per_cu = 0;
        if (hipGetDevice(&dev) != hipSuccess || hipDeviceGetAttribute(&cus, hipDeviceAttributeMultiprocessorCount, dev) != hipSuccess) { grid = -1; return; }
        if (hipFuncSetAttribute((const void*)fwd_kernel, hipFuncAttributeMaxDynamicSharedMemorySize, LDS_BYTES) != hipSuccess) { fprintf(stderr, "kernel_launch: hipFuncSetAttribute failed\n"); grid = -1; return; }
        if (hipOccupancyMaxActiveBlocksPerMultiprocessor(&per_cu, (const void*)fwd_kernel, 512, LDS_BYTES) != hipSuccess || per_cu < 1) fprintf(stderr, "kernel_launch: occupancy query says %d\n", per_cu);
        (void)hipGetLastError();
        grid = cus < 256 ? cus : 256;
    }
    if (grid < 0) return;
    (void)hipMemsetAsync((char*)d_ws + WS_CTL, 0, CTL_BYTES, stream);
#ifdef DBG_POISON
    (void)hipMemsetAsync((char*)d_ws + CTL_BYTES, 0xFF, WS_NEED - CTL_BYTES, stream);
    (void)hipMemsetAsync((char*)d_out, 0xFF, (size_t)M * D * 4, stream);
#endif
    Args a{};
    for (int i = 0; i < 43; ++i) a.in[i] = (const float*)d_in[i];
    a.positions = (const int*)d_in[I_POS]; a.out = (float*)d_out; a.ws = (unsigned char*)d_ws;
#if MK_PER_PHASE
#ifndef DBG_NPH
#define DBG_NPH N_PHASES
#endif
    for (int p = 0; p < DBG_NPH; ++p) { a.ph_lo = p; a.ph_hi = p + 1; hipLaunchKernelGGL(fwd_kernel, dim3(grid), dim3(512), LDS_BYTES, stream, a); }
#ifdef DBG_DUMP_OFF
    hipLaunchKernelGGL(dbg_dump, dim3(2048), dim3(256), 0, stream, (const bf16_t*)((const char*)d_ws + (size_t)(DBG_DUMP_OFF)), (float*)d_out, (size_t)M * D);
#endif
#else
    a.ph_lo = 0; a.ph_hi = N_PHASES; hipLaunchKernelGGL(fwd_kernel, dim3(grid), dim3(512), LDS_BYTES, stream, a);
#ifdef DBG_EXTRA_PH
    a.dbg = DBG_EXTRA_FLAGS;
    for (int rep = 0; rep < DBG_EXTRA_REP; ++rep) { a.ph_lo = DBG_EXTRA_PH; a.ph_hi = DBG_EXTRA_PH + 1; hipLaunchKernelGGL(fwd_kernel, dim3(grid), dim3(512), LDS_BYTES, stream, a); }
#endif
#endif
}
```
